# Optimizing an MI355X kernel written in HIP

```python
import math
import jax
import jax.numpy as jnp
from jax import lax
import numpy as np

D_MODEL = 1024
BATCH = 4
SEQ = 4096
DEPTH = 2

RMS_EPS = 1e-6
GN_EPS = 1e-5
ATTN_BLOCK = 128

RET_HEADS = 4
RET_DK = 64
RET_DV = 64
RET_CHUNK = 128
RET_THETA = 10000.0

MLA_HEADS = 4
MLA_Q_RANK = 256
MLA_KV_RANK = 128
MLA_NOPE = 64
MLA_ROPE = 32
MLA_V = 64

SSM_HEADS = 4
SSM_HEAD_DIM = 64
SSM_GROUPS = 2
SSM_STATE = 128
SSM_CONV = 5
SSM_CHUNK = 128
SSM_INNER = SSM_HEADS * SSM_HEAD_DIM
SSM_CONV_DIM = SSM_INNER + 2 * SSM_GROUPS * SSM_STATE

DIL_HEADS = 4
DIL_HEAD_DIM = 64
DIL_PATTERNS = ((128, 1), (512, 4), (2048, 16))

ROPE_THETA = 500000.0
ROPE_DIM = DIL_HEAD_DIM // 4

N_EXPERTS = 16
EXPERT_FF = 2048
EC_CAPACITY_FACTOR = 2

PROJ_SIZES = (
    RET_HEADS * RET_DK, RET_HEADS * RET_DK, RET_HEADS * RET_DV, RET_HEADS * RET_DV,
    MLA_Q_RANK, MLA_KV_RANK, MLA_ROPE,
    SSM_INNER, SSM_CONV_DIM, 2 * SSM_HEADS,
    DIL_HEADS * DIL_HEAD_DIM, DIL_HEADS * DIL_HEAD_DIM, DIL_HEADS * DIL_HEAD_DIM,
)
PROJ_WIDTH = sum(PROJ_SIZES)
MIX_WIDTH = RET_HEADS * RET_DV + MLA_HEADS * MLA_V + SSM_INNER + DIL_HEADS * DIL_HEAD_DIM

kernel_name = 'hybrid_parallel_mixer_ec_moe_encoder'


def _split_points():
    pts, acc = [], 0
    for size in PROJ_SIZES[:-1]:
        acc += size
        pts.append(acc)
    return pts


def rms_norm(x, w, eps=RMS_EPS):
    xf = x.astype(jnp.float32)
    y = xf * lax.rsqrt(jnp.mean(xf * xf, axis=-1, keepdims=True) + eps)
    return (y * w.astype(jnp.float32)).astype(x.dtype)


def rotary(x, rot_dim, theta):
    s = x.shape[-2]
    inv = 1.0 / (theta ** (jnp.arange(0, rot_dim, 2, dtype=jnp.float32) / rot_dim))
    ang = jnp.arange(s, dtype=jnp.float32)[:, None] * inv[None, :]
    cos, sin = jnp.cos(ang), jnp.sin(ang)
    xr = x[..., :rot_dim].astype(jnp.float32)
    x1, x2 = xr[..., :rot_dim // 2], xr[..., rot_dim // 2:]
    rot = jnp.concatenate([x1 * cos - x2 * sin, x2 * cos + x1 * sin], axis=-1).astype(x.dtype)
    return jnp.concatenate([rot, x[..., rot_dim:]], axis=-1)


def split_heads(t, n_heads):
    b, s, w = t.shape
    return t.reshape(b, s, n_heads, w // n_heads).transpose(0, 2, 1, 3)


def merge_heads(t):
    b, h, s, d = t.shape
    return t.transpose(0, 2, 1, 3).reshape(b, s, h * d)


def retention_log_decays(offset):
    exps = -5.0 - offset - jnp.arange(RET_HEADS, dtype=jnp.float32)
    return jnp.log1p(-jnp.exp2(exps))


def retention_direction(q, k, v, log_gamma, strict):
    b, h, s, dk = q.shape
    dv = v.shape[-1]
    nc = s // RET_CHUNK
    qc = q.reshape(b, h, nc, RET_CHUNK, dk)
    kc = k.reshape(b, h, nc, RET_CHUNK, dk)
    vc = v.reshape(b, h, nc, RET_CHUNK, dv)
    pos = jnp.arange(RET_CHUNK, dtype=jnp.float32)
    diff = pos[:, None] - pos[None, :]
    mask = diff > 0 if strict else diff >= 0
    decay = jnp.where(mask, jnp.exp(log_gamma[:, None, None] * jnp.maximum(diff, 0.0)), 0.0)
    scores = jnp.einsum('bhcid,bhcjd->bhcij', qc, kc) * decay[None, :, None]
    inner = jnp.einsum('bhcij,bhcje->bhcie', scores, vc)
    zeta = jnp.exp(log_gamma[:, None] * (RET_CHUNK - 1.0 - pos))
    xi = jnp.exp(log_gamma[:, None] * (pos + 1.0))
    chunk_decay = jnp.exp(log_gamma * RET_CHUNK)[None, :, None, None]
    updates = jnp.einsum('bhcjd,hj,bhcje->cbhde', kc, zeta, vc)

    def step(state, upd):
        return state * chunk_decay + upd, state

    _, prev = lax.scan(step, jnp.zeros((b, h, dk, dv), jnp.float32), updates)
    cross = jnp.einsum('bhcid,cbhde,hi->bhcie', qc, prev, xi)
    return (inner + cross).reshape(b, h, s, dv)


def retention_mixer(q, k, v, g):
    dtype = g.dtype
    q = rotary(split_heads(q, RET_HEADS).astype(jnp.float32), RET_DK, RET_THETA) * (RET_DK ** -0.5)
    k = rotary(split_heads(k, RET_HEADS).astype(jnp.float32), RET_DK, RET_THETA)
    v = split_heads(v, RET_HEADS).astype(jnp.float32)
    flip = lambda t: jnp.flip(t, axis=2)
    o = (retention_direction(q, k, v, retention_log_decays(0.0), False)
         + flip(retention_direction(flip(q), flip(k), flip(v), retention_log_decays(0.5), True)))
    mu = jnp.mean(o, axis=-1, keepdims=True)
    var = jnp.mean(jnp.square(o - mu), axis=-1, keepdims=True)
    o = (o - mu) * lax.rsqrt(var + GN_EPS)
    return (jax.nn.silu(g.astype(jnp.float32)) * merge_heads(o)).astype(dtype)


def blocked_dense_attention(q, k, v, scale):
    b, h, s, d = q.shape
    dv = v.shape[-1]
    nb = s // ATTN_BLOCK
    qb = jnp.moveaxis(q.reshape(b, h, nb, ATTN_BLOCK, d), 2, 0)

    def block(qi):
        sc = jnp.einsum('bhqd,bhkd->bhqk', qi, k).astype(jnp.float32) * scale
        p = jax.nn.softmax(sc, axis=-1)
        return jnp.einsum('bhqk,bhkd->bhqd', p.astype(v.dtype), v)

    o = lax.map(block, qb)
    return jnp.moveaxis(o, 0, 2).reshape(b, h, s, dv)


def mla_mixer(c_q, c_kv, k_rope, q_norm_w, kv_norm_w, w_uq, w_ukv):
    b, s, _ = c_q.shape
    q = split_heads(rms_norm(c_q, q_norm_w) @ w_uq, MLA_HEADS)
    kv = split_heads(rms_norm(c_kv, kv_norm_w) @ w_ukv, MLA_HEADS)
    k_nope, v = kv[..., :MLA_NOPE], kv[..., MLA_NOPE:]
    q = jnp.concatenate([q[..., :MLA_NOPE], rotary(q[..., MLA_NOPE:], MLA_ROPE, ROPE_THETA)], axis=-1)
    kr = rotary(k_rope[:, None], MLA_ROPE, ROPE_THETA)
    k = jnp.concatenate([k_nope, jnp.broadcast_to(kr, (b, MLA_HEADS, s, MLA_ROPE))], axis=-1)
    o = blocked_dense_attention(q, k, v, (MLA_NOPE + MLA_ROPE) ** -0.5)
    return merge_heads(o)


def ssd_direction(x, dt, a, bm, cm, strict):
    b, s, h, p = x.shape
    n = bm.shape[-1]
    nc = s // SSM_CHUNK
    rep = h // SSM_GROUPS
    bh = jnp.repeat(bm, rep, axis=2).reshape(b, nc, SSM_CHUNK, h, n)
    ch = jnp.repeat(cm, rep, axis=2).reshape(b, nc, SSM_CHUNK, h, n)
    xdt = (x * dt[..., None]).reshape(b, nc, SSM_CHUNK, h, p)
    cs = jnp.cumsum((dt * a).reshape(b, nc, SSM_CHUNK, h), axis=2)
    seg = cs[:, :, :, None, :] - cs[:, :, None, :, :]
    pos = jnp.arange(SSM_CHUNK)
    mask = pos[:, None] > pos[None, :] if strict else pos[:, None] >= pos[None, :]
    decay = jnp.where(mask[None, None, :, :, None], jnp.exp(jnp.minimum(seg, 0.0)), 0.0)
    scores = jnp.einsum('bclhn,bcshn->bclsh', ch, bh) * decay
    y_diag = jnp.einsum('bclsh,bcshp->bclhp', scores, xdt)
    to_end = jnp.exp(cs[:, :, -1:, :] - cs)
    states = jnp.einsum('bclhn,bclh,bclhp->cbhpn', bh, to_end, xdt)
    chunk_decay = jnp.moveaxis(jnp.exp(cs[:, :, -1, :]), 1, 0)

    def step(state, inp):
        upd, dec = inp
        return state * dec[:, :, None, None] + upd, state

    _, prev = lax.scan(step, jnp.zeros((b, h, p, n), jnp.float32), (states, chunk_decay))
    y_off = jnp.einsum('bclhn,cbhpn,bclh->bclhp', ch, prev, jnp.exp(cs))
    return (y_diag + y_off).reshape(b, s, h, p)


def mamba2_mixer(z, xbc, dt, conv_w, conv_b, a_log, dt_bias, d_skip, norm_w):
    b, s, _ = z.shape
    pad = SSM_CONV // 2
    xbc = lax.conv_general_dilated(xbc, conv_w[:, None, :].astype(xbc.dtype), (1,), [(pad, pad)],
                                   dimension_numbers=('NWC', 'WIO', 'NWC'),
                                   feature_group_count=SSM_CONV_DIM)
    xbc = jax.nn.silu((xbc + conv_b.astype(xbc.dtype)).astype(jnp.float32))
    xs = xbc[..., :SSM_INNER].reshape(b, s, SSM_HEADS, SSM_HEAD_DIM)
    bm = xbc[..., SSM_INNER:SSM_INNER + SSM_GROUPS * SSM_STATE].reshape(b, s, SSM_GROUPS, SSM_STATE)
    cm = xbc[..., SSM_INNER + SSM_GROUPS * SSM_STATE:].reshape(b, s, SSM_GROUPS, SSM_STATE)
    dt = jax.nn.softplus(dt.astype(jnp.float32).reshape(b, s, 2, SSM_HEADS) + dt_bias.astype(jnp.float32))
    a = -jnp.exp(a_log.astype(jnp.float32))
    flip = lambda t: jnp.flip(t, axis=1)
    y_fwd = ssd_direction(xs, dt[:, :, 0], a[0], bm, cm, False)
    y_bwd = flip(ssd_direction(flip(xs), flip(dt[:, :, 1]), a[1], flip(bm), flip(cm), True))
    y = y_fwd + y_bwd + d_skip.astype(jnp.float32)[:, None] * xs
    y = y.reshape(b, s, SSM_INNER) * jax.nn.silu(z.astype(jnp.float32))
    return rms_norm(y, norm_w).astype(z.dtype)


def dilated_attention(q, k, v, scale):
    b, h, s, d = q.shape
    nb = s // ATTN_BLOCK
    offsets = [dil * jnp.arange(-(win // (2 * dil)), win // (2 * dil) + 1) for win, dil in DIL_PATTERNS]

    def block(i):
        start = i * ATTN_BLOCK
        qi = lax.dynamic_slice_in_dim(q, start, ATTN_BLOCK, axis=2).astype(jnp.float32)
        qpos = start + jnp.arange(ATTN_BLOCK)
        maxes, denoms, outs = [], [], []
        for off in offsets:
            kpos = qpos[:, None] + off[None, :]
            valid = (kpos >= 0) & (kpos < s)
            kpos = jnp.clip(kpos, 0, s - 1)
            kg = jnp.take(k, kpos, axis=2).astype(jnp.float32)
            vg = jnp.take(v, kpos, axis=2).astype(jnp.float32)
            sc = jnp.einsum('bhqd,bhqkd->bhqk', qi, kg) * scale
            sc = jnp.where(valid, sc, -jnp.inf)
            m = jnp.max(sc, axis=-1, keepdims=True)
            p = jnp.exp(sc - m)
            l = jnp.sum(p, axis=-1, keepdims=True)
            outs.append(jnp.einsum('bhqk,bhqkd->bhqd', p, vg) / l)
            maxes.append(m)
            denoms.append(l)
        m_st = jnp.stack(maxes)
        w = jnp.stack(denoms) * jnp.exp(m_st - jnp.max(m_st, axis=0, keepdims=True))
        return (jnp.sum(w * jnp.stack(outs), axis=0) / jnp.sum(w, axis=0)).astype(q.dtype)

    o = lax.map(block, jnp.arange(nb))
    return jnp.moveaxis(o, 0, 2).reshape(b, h, s, d)


def dilated_mixer(q, k, v):
    q = rotary(split_heads(q, DIL_HEADS), ROPE_DIM, ROPE_THETA)
    k = rotary(split_heads(k, DIL_HEADS), ROPE_DIM, ROPE_THETA)
    v = split_heads(v, DIL_HEADS)
    return merge_heads(dilated_attention(q, k, v, DIL_HEAD_DIM ** -0.5))


def expert_choice_ffn(h, router_w, w_gate, w_up, w_down):
    b, s, d = h.shape
    capacity = EC_CAPACITY_FACTOR * s // N_EXPERTS
    logits = jnp.einsum('bsd,de->bse', h, router_w).astype(jnp.float32)
    affinity = jax.nn.softmax(logits, axis=-1)
    gate, token_idx = lax.top_k(jnp.swapaxes(affinity, 1, 2), capacity)
    xin = jax.vmap(lambda hb, ib: hb[ib])(h, token_idx)
    hid = (jax.nn.silu(jnp.einsum('becd,edf->becf', xin, w_gate))
           * jnp.einsum('becd,edf->becf', xin, w_up))
    out = jnp.einsum('becf,efd->becd', hid, w_down) * gate[..., None].astype(h.dtype)

    def combine(ob, ib):
        return jnp.zeros((s, d), ob.dtype).at[ib.reshape(-1)].add(ob.reshape(-1, d))

    return jax.vmap(combine)(out, token_idx)


def setup_inputs(seed: int = 0) -> dict:
    key = jax.random.key(seed)
    ks = jax.random.split(key, 20)
    f32 = jnp.float32

    def dense(k, shape, fan_in):
        return jax.random.normal(k, shape, f32) * (fan_in ** -0.5)

    def gain(k, shape):
        return 1.0 + 0.02 * jax.random.normal(k, shape, f32)

    dt_init = jnp.exp(jax.random.uniform(ks[10], (DEPTH, 2, SSM_HEADS), f32,
                                         math.log(1e-3), math.log(1e-1)))
    return {
        'x': jax.random.normal(ks[0], (BATCH, SEQ, D_MODEL), f32),
        'ln1_w': gain(ks[1], (DEPTH, D_MODEL)),
        'w_in': dense(ks[2], (DEPTH, D_MODEL, PROJ_WIDTH), D_MODEL),
        'mla_q_norm_w': gain(ks[3], (DEPTH, MLA_Q_RANK)),
        'mla_kv_norm_w': gain(ks[4], (DEPTH, MLA_KV_RANK)),
        'mla_w_uq': dense(ks[5], (DEPTH, MLA_Q_RANK, MLA_HEADS * (MLA_NOPE + MLA_ROPE)), MLA_Q_RANK),
        'mla_w_ukv': dense(ks[6], (DEPTH, MLA_KV_RANK, MLA_HEADS * (MLA_NOPE + MLA_V)), MLA_KV_RANK),
        'ssm_conv_w': dense(ks[7], (DEPTH, SSM_CONV, SSM_CONV_DIM), SSM_CONV),
        'ssm_conv_b': 0.02 * jax.random.normal(ks[8], (DEPTH, SSM_CONV_DIM), f32),
        'ssm_a_log': jnp.log(jax.random.uniform(ks[9], (DEPTH, 2, SSM_HEADS), f32, 1.0, 16.0)),
        'ssm_dt_bias': dt_init + jnp.log(-jnp.expm1(-dt_init)),
        'ssm_d': gain(ks[11], (DEPTH, SSM_HEADS)),
        'ssm_norm_w': gain(ks[12], (DEPTH, SSM_INNER)),
        'w_out': dense(ks[13], (DEPTH, MIX_WIDTH, D_MODEL), MIX_WIDTH),
        'ln2_w': gain(ks[14], (DEPTH, D_MODEL)),
        'router_w': dense(ks[15], (DEPTH, D_MODEL, N_EXPERTS), D_MODEL),
        'exp_w_gate': dense(ks[16], (DEPTH, N_EXPERTS, D_MODEL, EXPERT_FF), D_MODEL),
        'exp_w_up': dense(ks[17], (DEPTH, N_EXPERTS, D_MODEL, EXPERT_FF), D_MODEL),
        'exp_w_down': dense(ks[18], (DEPTH, N_EXPERTS, EXPERT_FF, D_MODEL), EXPERT_FF),
        'final_norm_w': gain(ks[19], (D_MODEL,)),
    }


def reference(x, ln1_w, w_in, mla_q_norm_w, mla_kv_norm_w, mla_w_uq, mla_w_ukv,
              ssm_conv_w, ssm_conv_b, ssm_a_log, ssm_dt_bias, ssm_d, ssm_norm_w,
              w_out, ln2_w, router_w, exp_w_gate, exp_w_up, exp_w_down, final_norm_w):
    split_pts = _split_points()
    for i in range(DEPTH):
        hn = rms_norm(x, ln1_w[i])
        proj = hn @ w_in[i]
        (r_q, r_k, r_v, r_g, m_cq, m_ckv, m_kr,
         s_z, s_xbc, s_dt, d_q, d_k, d_v) = jnp.split(proj, split_pts, axis=-1)
        y_a = retention_mixer(r_q, r_k, r_v, r_g)
        y_b = mla_mixer(m_cq, m_ckv, m_kr, mla_q_norm_w[i], mla_kv_norm_w[i], mla_w_uq[i], mla_w_ukv[i])
        y_c = mamba2_mixer(s_z, s_xbc, s_dt, ssm_conv_w[i], ssm_conv_b[i], ssm_a_log[i],
                           ssm_dt_bias[i], ssm_d[i], ssm_norm_w[i])
        y_d = dilated_mixer(d_q, d_k, d_v)
        mixed = jnp.concatenate([y_a, y_b.astype(x.dtype), y_c, y_d.astype(x.dtype)], axis=-1)
        x = x + mixed @ w_out[i]
        x = x + expert_choice_ffn(rms_norm(x, ln2_w[i]), router_w[i], exp_w_gate[i],
                                  exp_w_up[i], exp_w_down[i])
    return rms_norm(x, final_norm_w)
```

```cpp
#include <hip/hip_runtime.h>
#include <hip/hip_cooperative_groups.h>
#include <cstdio>
#include <cstdint>
namespace cg = cooperative_groups;

#define DI __device__ __forceinline__
typedef unsigned short u16;
typedef __attribute__((ext_vector_type(8))) short bf16x8;
typedef __attribute__((ext_vector_type(4))) float f32x4;

#ifndef REPS_INIT
#define REPS_INIT {1, 1, 1, 1, 1, 1, 1, 1, 1, 1, 1, 1, 0, 1, 1, 1}
#endif
constexpr int NTHR = 512;
constexpr int T = 16384, SEQ = 4096, DM = 1024;
constexpr int PW = 3240, PWP = 3328;
constexpr int C_RQ = 0, C_RK = 256, C_RV = 512, C_RG = 768, C_CQ = 1024, C_CKV = 1280, C_KR = 1408,
              C_Z = 1440, C_XBC = 1696, C_DT = 2464, C_DQ = 2472, C_DK = 2728, C_DV = 2984;
constexpr int LDS_BYTES = 132096;

struct Params {
  const float *x, *ln1_w, *w_in, *q_norm_w, *kv_norm_w, *w_uq, *w_ukv, *conv_w, *conv_b, *a_log, *dt_bias,
      *ssm_d, *ssm_norm_w, *w_out, *ln2_w, *router_w, *w_gate, *w_up, *w_down, *final_w;
  float* out;
  u16 *WinT, *WuqT, *WukvT, *WoutT, *WguT, *WdT;
  float* xres;
  u16 *hn, *proj, *cqn, *ckvn, *mq, *mkv, *xbc, *mixed, *hid, *kfull, *vT, *rS, *sS;
  float *dtv, *cs, *ybuf, *aff, *gate, *rU, *sU, *cdec, *rtab, *dpart;
  int* tok;
  int* inv;
  unsigned* bar;
  float* xres2;
  int rep[16];
};

typedef __attribute__((ext_vector_type(2))) __bf16 bf16x2_t;
typedef __attribute__((ext_vector_type(2))) float f32x2_t;
typedef __attribute__((ext_vector_type(16))) float f32x16;
typedef __attribute__((ext_vector_type(4))) short s16x4;
DI unsigned pack2(float a, float b) {
  f32x2_t v = {a, b};
  return __builtin_bit_cast(unsigned, __builtin_convertvector(v, bf16x2_t));
}
DI u16 f2bf(float f) { return (u16)(pack2(f, 0.f) & 0xffffu); }
DI float bf2f(u16 h) { return __uint_as_float(((unsigned)h) << 16); }
DI void unpack8(const uint4& v, float* f) {
  f[0] = __uint_as_float(v.x << 16); f[1] = __uint_as_float(v.x & 0xffff0000u);
  f[2] = __uint_as_float(v.y << 16); f[3] = __uint_as_float(v.y & 0xffff0000u);
  f[4] = __uint_as_float(v.z << 16); f[5] = __uint_as_float(v.z & 0xffff0000u);
  f[6] = __uint_as_float(v.w << 16); f[7] = __uint_as_float(v.w & 0xffff0000u);
}
DI void ld8(const u16* p, float* f) { uint4 v = *reinterpret_cast<const uint4*>(p); unpack8(v, f); }
DI float wave_sum(float v) {
#pragma unroll
  for (int o = 32; o > 0; o >>= 1) v += __shfl_xor(v, o);
  return v;
}
DI float dot2acc(unsigned a, unsigned b, float c) {
  return __builtin_amdgcn_fdot2_f32_bf16(__builtin_bit_cast(bf16x2_t, a), __builtin_bit_cast(bf16x2_t, b), c, false);
}
DI float dot8(const uint4& a, const uint4& b, float c) {
  c = dot2acc(a.x, b.x, c); c = dot2acc(a.y, b.y, c); c = dot2acc(a.z, b.z, c); c = dot2acc(a.w, b.w, c);
  return c;
}
DI int otid() { int t = threadIdx.x; asm volatile("" : "+v"(t)); return t; }
DI int obid() { int b = blockIdx.x; asm volatile("" : "+s"(b)); return b; }
DI float silu(float x) { return x / (1.f + __expf(-x)); }
DI float fast_silu(float x) { return x * __builtin_amdgcn_rcpf(1.f + __expf(-x)); }


#define XB_TMO      128
#define XB_XCNT(j)  (256  + 64 * (j))
#define XB_XSUB(j)  (1280 + 64 * (j))
#define XB_XGEN(j)  (2304 + 64 * (j))
#define XB_TOP      3328
#define XB_TOPGEN   3392
#define XCD_BAR_WORDS 3456
#define XB_SPIN_CAP (1u << 20)
#define LAS __attribute__((address_space(3)))
DI unsigned xb_ld(unsigned* p) { return __hip_atomic_load(p, __ATOMIC_RELAXED, __HIP_MEMORY_SCOPE_AGENT); }
DI unsigned xb_add(unsigned* p, unsigned v) { return __hip_atomic_fetch_add(p, v, __ATOMIC_RELAXED, __HIP_MEMORY_SCOPE_AGENT); }
DI unsigned xb_xcc_id() { return (unsigned)__builtin_amdgcn_s_getreg((3 << 11) | 20) & 0xFu; }
#define XB_SPIN(cond, bar) do { unsigned _sp = 0; while (cond) { __builtin_amdgcn_s_sleep(1); \
    if ((++_sp & 255u) == 0u) { if (xb_ld(&(bar)[XB_TMO])) break; if (_sp > XB_SPIN_CAP) { atomicAdd(&(bar)[XB_TMO], 1u); break; } } } } while (0)
struct XcdBarrier { unsigned* bar; unsigned x; volatile LAS unsigned* st; };
DI XcdBarrier xcd_barrier_post(unsigned* bar, volatile LAS unsigned* st) {
  XcdBarrier b; b.bar = bar; b.x = xb_xcc_id(); b.st = st;
  if (threadIdx.x == 0) (void)xb_add(&bar[XB_XCNT(b.x)], 1u);
  return b;
}
DI void xcd_barrier_complete(unsigned* bar, unsigned x, unsigned& nloc, unsigned& nx) {
  const unsigned G = gridDim.x * gridDim.y * gridDim.z;
  unsigned sum, cnt, mine, sp = 0u;
  for (;;) {
    sum = 0u; cnt = 0u; mine = 0u;
#pragma unroll
    for (unsigned j = 0; j < 16; ++j) { const unsigned c = xb_ld(&bar[XB_XCNT(j)]); sum += c; cnt += (c > 0u) ? 1u : 0u; mine = (j == x) ? c : mine; }
    if (sum == G) break;
    __builtin_amdgcn_s_sleep(1);
    if ((++sp & 255u) == 0u) { if (xb_ld(&bar[XB_TMO])) break; if (sp > XB_SPIN_CAP) { atomicAdd(&bar[XB_TMO], 1u); break; } }
  }
  nloc = mine > 0u ? mine : 1u; nx = cnt > 0u ? cnt : 1u;
}
DI void xcd_barrier(const XcdBarrier& b) {
  asm volatile("s_waitcnt vmcnt(0)" ::: "memory");
  __syncthreads();
  if (threadIdx.x == 0) {
    unsigned* bar = b.bar;
    __builtin_amdgcn_s_waitcnt(0);
    unsigned nloc = b.st[0], nx = b.st[1];
    if (nloc == 0u) { xcd_barrier_complete(bar, b.x, nloc, nx); b.st[0] = nloc; b.st[1] = nx; }
    const unsigned old = xb_add(&bar[XB_XSUB(b.x)], 1u);
    const unsigned gen = old / nloc;
    if (old + 1u == (gen + 1u) * nloc) {
      __builtin_amdgcn_fence(__ATOMIC_RELEASE, "agent");
      asm volatile("s_waitcnt vmcnt(0)" ::: "memory");
      const unsigned og = xb_add(&bar[XB_TOP], 1u);
      const unsigned tg = og / nx;
      if (og + 1u == (tg + 1u) * nx) xb_add(&bar[XB_TOPGEN], 1u);
      else XB_SPIN(xb_ld(&bar[XB_TOPGEN]) == tg, bar);
      __builtin_amdgcn_fence(__ATOMIC_ACQUIRE, "agent");
      xb_add(&bar[XB_XGEN(b.x)], 1u);
      asm volatile("s_waitcnt vmcnt(0)" ::: "memory");
    } else {
      XB_SPIN(xb_ld(&bar[XB_XGEN(b.x)]) == gen, bar);
      __builtin_amdgcn_fence(__ATOMIC_ACQUIRE, "agent");
      asm volatile("s_waitcnt vmcnt(0)" ::: "memory");
    }
  }
  __syncthreads();
}

template <class F>
DI void transpose_convert(const float* __restrict__ src, int K, int N, int Npad, u16* __restrict__ dst, F rowmap,
                          int bid, int nb, char* smem) {
  u16* tile = reinterpret_cast<u16*>(smem);
  const int tid = otid();
  const int ntn = Npad / 64, ntk = K / 64;
  for (int t = bid; t < ntn * ntk; t += nb) {
    const int n0 = (t % ntn) * 64, k0 = (t / ntn) * 64;
#pragma unroll
    for (int i = 0; i < 2; ++i) {
      const int kk = (tid >> 4) + 32 * i, nn = (tid & 15) * 4;
      float4 v = make_float4(0.f, 0.f, 0.f, 0.f);
      if (n0 + nn < N) { const f32x4 t4 = __builtin_nontemporal_load(reinterpret_cast<const f32x4*>(src + (size_t)(k0 + kk) * N + n0 + nn)); v = make_float4(t4[0], t4[1], t4[2], t4[3]); }
      tile[(nn + 0) * 72 + kk] = f2bf(v.x); tile[(nn + 1) * 72 + kk] = f2bf(v.y);
      tile[(nn + 2) * 72 + kk] = f2bf(v.z); tile[(nn + 3) * 72 + kk] = f2bf(v.w);
    }
    __syncthreads();
    {
      const int nn = tid >> 3, k8 = (tid & 7) * 8;
      uint4 v = *reinterpret_cast<const uint4*>(tile + nn * 72 + k8);
      *reinterpret_cast<uint4*>(dst + (size_t)rowmap(n0 + nn) * K + k0 + k8) = v;
    }
    __syncthreads();
  }
}

DI void ph_convert(const Params& p, char* smem) {
  const int nb = gridDim.x;
  int bid = obid();
  for (int idx = bid * NTHR + otid(); idx < SEQ * 56; idx += nb * NTHR) {
    const int pos = idx / 56, f = idx - pos * 56;
    float inv;
    if (f < 32) inv = exp2f(-(float)f * (13.287712379549449f / 32.f));
    else if (f < 40) inv = exp2f(-(float)(f - 32) * (18.931568569324174f / 8.f));
    else inv = exp2f(-(float)(f - 40) * (18.931568569324174f / 16.f));
    float sn, cs;
    sincosf((float)pos * inv, &sn, &cs);
    p.rtab[(size_t)idx * 2] = cs;
    p.rtab[(size_t)idx * 2 + 1] = sn;
  }
  auto ident = [](int n) { return n; };
  for (int L = 0; L < 2; ++L) {
    transpose_convert(p.w_in + (size_t)L * DM * PW, DM, PW, PWP, p.WinT + (size_t)L * PWP * DM, ident, bid, nb, smem);
    transpose_convert(p.w_uq + (size_t)L * 256 * 384, 256, 384, 384, p.WuqT + (size_t)L * 384 * 256, ident, bid, nb, smem);
    transpose_convert(p.w_ukv + (size_t)L * 128 * 512, 128, 512, 512, p.WukvT + (size_t)L * 512 * 128, ident, bid, nb, smem);
    transpose_convert(p.w_out + (size_t)L * DM * DM, DM, DM, DM, p.WoutT + (size_t)L * DM * DM, ident, bid, nb, smem);
    for (int e = 0; e < 16; ++e) {
      const size_t le = (size_t)(L * 16 + e);
      auto gmap = [](int n) { return (n >> 7) * 256 + (n & 127); };
      auto umap = [](int n) { return (n >> 7) * 256 + 128 + (n & 127); };
      transpose_convert(p.w_gate + le * DM * 2048, DM, 2048, 2048, p.WguT + le * 4096 * DM, gmap, bid, nb, smem);
      transpose_convert(p.w_up + le * DM * 2048, DM, 2048, 2048, p.WguT + le * 4096 * DM, umap, bid, nb, smem);
      transpose_convert(p.w_down + le * 2048 * DM, 2048, DM, DM, p.WdT + le * DM * 2048, ident, bid, nb, smem);
    }
  }
}

template <class RowPtr, class Epi>
DI void gemm_tile(RowPtr arow, const u16* __restrict__ bt, int ldb, int K, char* smem, Epi epi) {
  u16* sa = reinterpret_cast<u16*>(smem);
  u16* sb = sa + 2 * 256 * 72;
  const int tid = otid(), wid = tid >> 6, lane = tid & 63, wr = wid >> 1, wc = wid & 1, fr = lane & 15, fq = lane >> 4;
  f32x4 acc[4][4];
#pragma unroll
  for (int m = 0; m < 4; ++m)
#pragma unroll
    for (int n = 0; n < 4; ++n) acc[m][n] = f32x4{0.f, 0.f, 0.f, 0.f};
  const int lr = tid >> 3, lc = (tid & 7) * 8;
  const u16* ap[4];
#pragma unroll
  for (int i = 0; i < 4; ++i) ap[i] = arow(lr + 64 * i) + lc;
  const u16* bp[2];
#pragma unroll
  for (int i = 0; i < 2; ++i) bp[i] = bt + (size_t)(lr + 64 * i) * ldb + lc;
  uint4 ra[4], rb[2];
  const int nk = K / 64;
#pragma unroll
  for (int i = 0; i < 4; ++i) ra[i] = *reinterpret_cast<const uint4*>(ap[i]);
#pragma unroll
  for (int i = 0; i < 2; ++i) rb[i] = *reinterpret_cast<const uint4*>(bp[i]);
#pragma unroll
  for (int i = 0; i < 4; ++i) *reinterpret_cast<uint4*>(sa + (lr + 64 * i) * 72 + lc) = ra[i];
#pragma unroll
  for (int i = 0; i < 2; ++i) *reinterpret_cast<uint4*>(sb + (lr + 64 * i) * 72 + lc) = rb[i];
  __syncthreads();
  for (int kt = 0; kt < nk; ++kt) {
    const int cur = kt & 1;
    if (kt + 1 < nk) {
#pragma unroll
      for (int i = 0; i < 4; ++i) ra[i] = *reinterpret_cast<const uint4*>(ap[i] + (kt + 1) * 64);
#pragma unroll
      for (int i = 0; i < 2; ++i) rb[i] = *reinterpret_cast<const uint4*>(bp[i] + (kt + 1) * 64);
    }
    const u16* ca = sa + cur * 256 * 72;
    const u16* cb = sb + cur * 128 * 72;
#pragma unroll
    for (int kk = 0; kk < 2; ++kk) {
      bf16x8 af[4], bfr[4];
#pragma unroll
      for (int m = 0; m < 4; ++m) af[m] = *reinterpret_cast<const bf16x8*>(ca + (wr * 64 + m * 16 + fr) * 72 + kk * 32 + fq * 8);
#pragma unroll
      for (int n = 0; n < 4; ++n) bfr[n] = *reinterpret_cast<const bf16x8*>(cb + (wc * 64 + n * 16 + fr) * 72 + kk * 32 + fq * 8);
#pragma unroll
      for (int m = 0; m < 4; ++m)
#pragma unroll
        for (int n = 0; n < 4; ++n) acc[m][n] = __builtin_amdgcn_mfma_f32_16x16x32_bf16(af[m], bfr[n], acc[m][n], 0, 0, 0);
    }
    if (kt + 1 < nk) {
      u16* na = sa + (cur ^ 1) * 256 * 72;
      u16* nbp = sb + (cur ^ 1) * 128 * 72;
#pragma unroll
      for (int i = 0; i < 4; ++i) *reinterpret_cast<uint4*>(na + (lr + 64 * i) * 72 + lc) = ra[i];
#pragma unroll
      for (int i = 0; i < 2; ++i) *reinterpret_cast<uint4*>(nbp + (lr + 64 * i) * 72 + lc) = rb[i];
    }
    __syncthreads();
  }
  epi(acc, wr, wc, fr, fq);
}

#define WAIT_V(n) asm volatile("s_waitcnt vmcnt(%0)" ::"n"(n) : "memory")
DI int lds_byte2(int r, int c) {
  const int st = (r >> 4) * 2 + (c >> 5), ob = (r & 15) * 64 + (c & 31) * 2;
  return st * 1024 + (ob ^ (((ob >> 9) & 1) << 5));
}
DI void stage_rc2(int b, int& R, int& C) {
  const int st = b >> 10, sb = b & 1023, swz = sb ^ (((sb >> 9) & 1) << 5);
  R = (st >> 1) * 16 + swz / 64;
  C = (st & 1) * 32 + (swz % 64) / 2;
}
typedef __attribute__((address_space(3))) unsigned lds_u32;
template <class RowPtr, class Epi>
DI void gemm256(RowPtr arow, const u16* __restrict__ bt, int ldb, int K, char* smem, Epi epi) {
  constexpr int TILE_B = 256 * 64 * 2, STAGE_B = 2 * TILE_B;
  const int tid = otid(), wid = tid >> 6, lane = tid & 63, wr = wid >> 2, wc = wid & 3, fr = lane & 15, fq = lane >> 4;
  const u16* ap[4];
  const u16* bp[4];
#pragma unroll
  for (int i = 0; i < 4; ++i) {
    int R, C;
    stage_rc2(wid * 1024 + i * 8192 + lane * 16, R, C);
    ap[i] = arow(R) + C;
    bp[i] = bt + (size_t)R * ldb + C;
  }
  f32x4 acc[8][4];
#pragma unroll
  for (int m = 0; m < 8; ++m)
#pragma unroll
    for (int n = 0; n < 4; ++n) acc[m][n] = f32x4{0.f, 0.f, 0.f, 0.f};
#define G2_STAGE(buf, kt)                                                                                              \
  do {                                                                                                                 \
    _Pragma("unroll") for (int i = 0; i < 4; ++i) {                                                                    \
      __builtin_amdgcn_global_load_lds((const unsigned*)(ap[i] + (kt) * 64),                                           \
                                       (lds_u32*)(smem + (buf) * STAGE_B + wid * 1024 + i * 8192), 16, 0, 0);          \
      __builtin_amdgcn_global_load_lds((const unsigned*)(bp[i] + (kt) * 64),                                           \
                                       (lds_u32*)(smem + (buf) * STAGE_B + TILE_B + wid * 1024 + i * 8192), 16, 0, 0); \
    }                                                                                                                  \
  } while (0)
  const int nt = K / 64;
  G2_STAGE(0, 0);
  WAIT_V(0);
  __syncthreads();
  for (int t = 0; t < nt; ++t) {
    const int cur = t & 1;
    if (t + 1 < nt) G2_STAGE(cur ^ 1, t + 1);
    const char* sA = smem + cur * STAGE_B;
    const char* sB = sA + TILE_B;
#pragma unroll
    for (int ks = 0; ks < 2; ++ks) {
      bf16x8 At[8], Bf[4];
#pragma unroll
      for (int m = 0; m < 8; ++m) At[m] = *reinterpret_cast<const bf16x8*>(sA + lds_byte2(wr * 128 + m * 16 + fr, ks * 32 + fq * 8));
#pragma unroll
      for (int n = 0; n < 4; ++n) Bf[n] = *reinterpret_cast<const bf16x8*>(sB + lds_byte2(wc * 64 + n * 16 + fr, ks * 32 + fq * 8));
#pragma unroll
      for (int m = 0; m < 8; ++m)
#pragma unroll
        for (int n = 0; n < 4; ++n) acc[m][n] = __builtin_amdgcn_mfma_f32_16x16x32_bf16(Bf[n], At[m], acc[m][n], 0, 0, 0);
      __builtin_amdgcn_sched_barrier(0);
    }
    WAIT_V(0);
    __syncthreads();
  }
  epi(acc, wr, wc, fr, fq);
}

namespace pg8 {
constexpr int BM = 256, BK = 64, HALF = 128, HTB = HALF * BK * 2;
DI int lds_byte(int r, int c) { const int st = (r >> 4) * 2 + (c >> 5), rr = r & 15, cc = c & 31, ob = rr * 64 + cc * 2; return st * 1024 + (ob ^ (((ob >> 9) & 1) << 5)); }
DI void stage_rc(int b, int& R, int& C) { const int st = b / 1024, sb = b % 1024, swz = sb ^ (((sb >> 9) & 1) << 5); R = (st >> 1) * 16 + swz / 64; C = (st & 1) * 32 + (swz % 64) / 2; }
DI int perm32(int rho) { const int n = rho >> 4, i = rho & 15; return 8 * (i >> 2) + 4 * n + (i & 3); }
struct Unit { int pm, pn; };
typedef __attribute__((address_space(3))) unsigned char lds_u8;
typedef __attribute__((address_space(3))) unsigned lds_u32;
typedef __attribute__((address_space(3))) bf16x8 lds_bf16x8;

template <class Cfg>
DI void gemm_phase(lds_u8* lds, const Cfg& S) {
  const int tid = otid(), wid = __builtin_amdgcn_readfirstlane(tid >> 6), lane = tid & 63, wr = wid >> 2, wc = wid & 3, fr = lane & 15, fq = lane >> 4;
  const int K = S.K, nt = K / BK;
  int R0, C0, R1, C1;
  stage_rc(tid * 16, R0, C0);
  stage_rc(tid * 16 + 8192, R1, C1);
  unsigned voffB[2];
  {
    const int Rb0 = Cfg::PERM ? ((R0 & ~31) + perm32(R0 & 31)) : R0, Rb1 = Cfg::PERM ? ((R1 & ~31) + perm32(R1 & 31)) : R1;
    voffB[0] = (unsigned)(Rb0 * K + C0) * 2u; voffB[1] = (unsigned)(Rb1 * K + C1) * 2u;
  }
  const size_t kstep = (size_t)(BK * 2);
  const size_t hstep = (size_t)HALF * K * 2;
  const unsigned ldsw = (unsigned)wid * 1024u;
  const int aoff = lds_byte(wr * 64 + fr, fq * 8), boff = lds_byte(wc * 32 + fr, fq * 8);
#define PG8_SA(b, h) (((b) * 2 + (h)) * HTB)
#define PG8_SB(b, h) ((4 + (b) * 2 + (h)) * HTB)
#define PG8_STAGE2(bufoff, gbase, o0, o1) do { \
    __builtin_amdgcn_global_load_lds((const unsigned*)((const char*)(gbase) + (o0)), (lds_u32*)(lds + (bufoff) + ldsw), 16, 0, 0); \
    __builtin_amdgcn_global_load_lds((const unsigned*)((const char*)(gbase) + (o1)), (lds_u32*)(lds + (bufoff) + ldsw + 8192), 16, 0, 0); } while (0)
#define PG8_STAGEB(bufoff, gbase) PG8_STAGE2(bufoff, gbase, voffB[0], voffB[1])
#define PG8_LDA(dst, b, h) do { _Pragma("unroll") for (int m = 0; m < 4; ++m) _Pragma("unroll") for (int k = 0; k < 2; ++k) dst[m][k] = *(const lds_bf16x8*)(lds + PG8_SA(b, h) + aoff + m * 2048 + k * 1024); } while (0)
#define PG8_LDB(dst, b, h) do { _Pragma("unroll") for (int n = 0; n < 2; ++n) _Pragma("unroll") for (int k = 0; k < 2; ++k) dst[n][k] = *(const lds_bf16x8*)(lds + PG8_SB(b, h) + boff + n * 2048 + k * 1024); } while (0)
#define PG8_MMA(ai, bj, At, Bt) do { __builtin_amdgcn_s_setprio(1); _Pragma("unroll") for (int m = 0; m < 4; ++m) _Pragma("unroll") for (int n = 0; n < 2; ++n) _Pragma("unroll") for (int k = 0; k < 2; ++k) \
    acc[ai][bj][m][n] = __builtin_amdgcn_mfma_f32_16x16x32_bf16(Bt[n][k], At[m][k], acc[ai][bj][m][n], 0, 0, 0); __builtin_amdgcn_s_setprio(0); } while (0)
#define PG8_WAIT_V(n) asm volatile("s_waitcnt vmcnt(" #n ")" ::: "memory")
#define PG8_WAIT_L(n) asm volatile("s_waitcnt lgkmcnt(" #n ")" ::: "memory")
#define PG8_BAR __builtin_amdgcn_s_barrier()
#define PG8_SCHED __builtin_amdgcn_sched_barrier(0)
  Unit cur, nxt; int ui = 0;
  if (!S.next(0, cur)) return;
  f32x4 acc[2][2][4][2];
#pragma unroll
  for (int a = 0; a < 2; ++a)
#pragma unroll
    for (int b = 0; b < 2; ++b)
#pragma unroll
      for (int m = 0; m < 4; ++m)
#pragma unroll
        for (int n = 0; n < 2; ++n) acc[a][b][m][n] = f32x4{0.f, 0.f, 0.f, 0.f};
  bf16x8 At[4][2], B0[2][2], B1[2][2];
  const char* cA = S.a_base(cur);
  const char* cB = S.b_base(cur);
  unsigned vc[4], vn[4];
  S.a_off(cur, R0, C0, R1, C1, vc);
  PG8_STAGEB(PG8_SB(0, 0), cB); PG8_STAGE2(PG8_SA(0, 0), cA, vc[0], vc[1]); PG8_STAGEB(PG8_SB(0, 1), cB + hstep); PG8_STAGE2(PG8_SA(0, 1), cA, vc[2], vc[3]);
  if (wr == 1) PG8_BAR;
  PG8_WAIT_V(4); PG8_BAR;
  PG8_STAGEB(PG8_SB(1, 0), cB + kstep); PG8_STAGE2(PG8_SA(1, 0), cA + kstep, vc[0], vc[1]); PG8_STAGEB(PG8_SB(1, 1), cB + hstep + kstep);
  PG8_WAIT_V(6); PG8_BAR;
  for (;;) {
    const bool has_next = S.next(ui + 1, nxt);
    const char* nA = has_next ? S.a_base(nxt) : cA;
    const char* nB = has_next ? S.b_base(nxt) : cB;
    if (has_next) S.a_off(nxt, R0, C0, R1, C1, vn);
    else { vn[0] = vc[0]; vn[1] = vc[1]; vn[2] = vc[2]; vn[3] = vc[3]; }
    for (int t = 0; t < nt; t += 2) {
      const bool last = (t == nt - 2);
      const char* a1 = cA + (size_t)(t + 1) * kstep;
      const char* a2 = last ? nA : cA + (size_t)(t + 2) * kstep;
      const char* b2 = last ? nB : cB + (size_t)(t + 2) * kstep;
      const char* a3 = a2 + kstep;
      const char* b3 = b2 + kstep;
      const unsigned w0 = last ? vn[0] : vc[0], w1 = last ? vn[1] : vc[1], w2 = last ? vn[2] : vc[2], w3 = last ? vn[3] : vc[3];
      PG8_LDB(B0, 0, 0); PG8_SCHED; PG8_LDA(At, 0, 0); PG8_STAGE2(PG8_SA(1, 1), a1, vc[2], vc[3]);
      PG8_WAIT_L(8); PG8_BAR; PG8_WAIT_L(0); PG8_MMA(0, 0, At, B0); PG8_BAR; PG8_SCHED;
      PG8_LDB(B1, 0, 1); PG8_STAGEB(PG8_SB(0, 0), b2);
      PG8_BAR; PG8_WAIT_L(0); PG8_MMA(0, 1, At, B1); PG8_BAR;
      PG8_LDA(At, 0, 1); PG8_STAGE2(PG8_SA(0, 0), a2, w0, w1);
      PG8_BAR; PG8_WAIT_L(0); PG8_MMA(1, 0, At, B0); PG8_BAR; PG8_SCHED;
      PG8_STAGEB(PG8_SB(0, 1), b2 + hstep);
      PG8_WAIT_V(6); PG8_BAR; PG8_MMA(1, 1, At, B1); PG8_BAR;
      PG8_LDB(B0, 1, 0); PG8_SCHED; PG8_LDA(At, 1, 0); PG8_STAGE2(PG8_SA(0, 1), a2, w2, w3);
      PG8_WAIT_L(8); PG8_BAR; PG8_WAIT_L(0); PG8_MMA(0, 0, At, B0); PG8_BAR; PG8_SCHED;
      PG8_LDB(B1, 1, 1); PG8_STAGEB(PG8_SB(1, 0), b3);
      PG8_BAR; PG8_WAIT_L(0); PG8_MMA(0, 1, At, B1); PG8_BAR;
      PG8_LDA(At, 1, 1); PG8_STAGE2(PG8_SA(1, 0), a3, w0, w1);
      PG8_BAR; PG8_WAIT_L(0); PG8_MMA(1, 0, At, B0); PG8_BAR; PG8_SCHED;
      PG8_STAGEB(PG8_SB(1, 1), b3 + hstep);
      PG8_WAIT_V(6); PG8_BAR; PG8_MMA(1, 1, At, B1); PG8_BAR;
    }
    S.epi(acc, cur, wr, wc, fr, fq);
    if (!has_next) break;
#pragma unroll
    for (int a = 0; a < 2; ++a)
#pragma unroll
      for (int b = 0; b < 2; ++b)
#pragma unroll
        for (int m = 0; m < 4; ++m)
#pragma unroll
          for (int n = 0; n < 2; ++n) acc[a][b][m][n] = f32x4{0.f, 0.f, 0.f, 0.f};
    cur = nxt; cA = nA; cB = nB; ++ui;
    vc[0] = vn[0]; vc[1] = vn[1]; vc[2] = vn[2]; vc[3] = vn[3];
  }
  PG8_WAIT_V(0);
  if (wr == 0) PG8_BAR;
  PG8_BAR;
#undef PG8_SA
#undef PG8_SB
#undef PG8_STAGE2
#undef PG8_STAGEB
#undef PG8_LDA
#undef PG8_LDB
#undef PG8_MMA
#undef PG8_WAIT_V
#undef PG8_WAIT_L
#undef PG8_BAR
#undef PG8_SCHED
}
}

struct CfgInproj {
  static constexpr bool PERM = true;
  int K; const Params* p; int L; int bid, nb;
  DI bool next(int i, pg8::Unit& u) const { const int t = i * nb + bid; if (t >= 64 * 13) return false; u.pm = t & 63; u.pn = t >> 6; return true; }
  DI const char* a_base(const pg8::Unit& u) const { return (const char*)(p->hn + (size_t)u.pm * 256 * DM); }
  DI const char* b_base(const pg8::Unit& u) const { return (const char*)(p->WinT + ((size_t)L * PWP + (size_t)u.pn * 256) * DM); }
  DI void a_off(const pg8::Unit&, int R0, int C0, int R1, int C1, unsigned (&vo)[4]) const {
    vo[0] = (unsigned)(R0 * DM + C0) * 2u; vo[1] = (unsigned)(R1 * DM + C1) * 2u;
    vo[2] = vo[0] + 128u * DM * 2u; vo[3] = vo[1] + 128u * DM * 2u;
  }
  DI void epi(const f32x4 (&acc)[2][2][4][2], const pg8::Unit& u, int wr, int wc, int fr, int fq) const {
    const int row0 = u.pm * 256 + wr * 64 + fr, col0 = u.pn * 256 + wc * 32 + 8 * fq;
#pragma unroll
    for (int ai = 0; ai < 2; ++ai)
#pragma unroll
      for (int m = 0; m < 4; ++m) {
        u16* rowp = p->proj + (size_t)(row0 + ai * 128 + m * 16) * PWP + col0;
#pragma unroll
        for (int bj = 0; bj < 2; ++bj) {
          uint4 w;
          w.x = pack2(acc[ai][bj][m][0][0], acc[ai][bj][m][0][1]); w.y = pack2(acc[ai][bj][m][0][2], acc[ai][bj][m][0][3]);
          w.z = pack2(acc[ai][bj][m][1][0], acc[ai][bj][m][1][1]); w.w = pack2(acc[ai][bj][m][1][2], acc[ai][bj][m][1][3]);
          *reinterpret_cast<uint4*>(rowp + bj * 128) = w;
        }
      }
  }
};
DI void ph_inproj_tail(const Params& p, int L, char* smem, int t) {
  const int m0 = (t & 63) * 256, n0 = 3072 + (t >> 6) * 128;
  const u16* Bt = p.WinT + ((size_t)L * PWP + n0) * DM;
  gemm_tile([&](int r) { return p.hn + (size_t)(m0 + r) * DM; }, Bt, DM, DM, smem,
            [&](f32x4 (&acc)[4][4], int wr, int wc, int fr, int fq) {
#pragma unroll
              for (int m = 0; m < 4; ++m)
#pragma unroll
                for (int n = 0; n < 4; ++n)
#pragma unroll
                  for (int j = 0; j < 4; ++j)
                    p.proj[(size_t)(m0 + wr * 64 + m * 16 + fq * 4 + j) * PWP + n0 + wc * 64 + n * 16 + fr] = f2bf(acc[m][n][j]);
            });
}
DI void ph_inproj(const Params& p, int L, char* smem) {
  CfgInproj c; c.K = DM; c.p = &p; c.L = L; c.bid = obid(); c.nb = gridDim.x;
  pg8::gemm_phase((pg8::lds_u8*)smem, c);
}

DI void ph_gemm_store_bf16(const u16* A, int lda, const u16* Bt, int K, int M, int N, u16* C, int ldc, char* smem, int rot) {
  const int mt = M / 256, nt = N / 128;
  const int nb = gridDim.x;
  for (int t = (obid() + rot) % nb; t < mt * nt; t += nb) {
    const int m0 = (t % mt) * 256, n0 = (t / mt) * 128;
    gemm_tile([&](int r) { return A + (size_t)(m0 + r) * lda; }, Bt + (size_t)n0 * K, K, K, smem,
              [&](f32x4 (&acc)[4][4], int wr, int wc, int fr, int fq) {
#pragma unroll
                for (int m = 0; m < 4; ++m)
#pragma unroll
                  for (int n = 0; n < 4; ++n)
#pragma unroll
                    for (int j = 0; j < 4; ++j) {
                      const int row = m0 + wr * 64 + m * 16 + fq * 4 + j, col = n0 + wc * 64 + n * 16 + fr;
                      C[(size_t)row * ldc + col] = f2bf(acc[m][n][j]);
                    }
              });
  }
}

DI void ph_rmsnorm_bf16(const float* __restrict__ xin, const float* __restrict__ w, u16* __restrict__ outp) {
  const int tid_ = otid(); const int lane = tid_ & 63, gw = (obid() * NTHR + tid_) >> 6, nw = gridDim.x * (NTHR / 64);
  for (int t = gw; t < T; t += nw) {
    const float* xr = xin + (size_t)t * DM;
    float4 v[4];
    float ss = 0.f;
#pragma unroll
    for (int i = 0; i < 4; ++i) {
      v[i] = *reinterpret_cast<const float4*>(xr + (i * 64 + lane) * 4);
      ss += v[i].x * v[i].x + v[i].y * v[i].y + v[i].z * v[i].z + v[i].w * v[i].w;
    }
    ss = wave_sum(ss);
    const float rstd = rsqrtf(ss * (1.f / DM) + 1e-6f);
#pragma unroll
    for (int i = 0; i < 4; ++i) {
      const int c = (i * 64 + lane) * 4;
      const float4 ww = *reinterpret_cast<const float4*>(w + c);
      uint2 o;
      o.x = pack2(v[i].x * rstd * ww.x, v[i].y * rstd * ww.y);
      o.y = pack2(v[i].z * rstd * ww.z, v[i].w * rstd * ww.w);
      *reinterpret_cast<uint2*>(outp + (size_t)t * DM + c) = o;
    }
  }
}

DI void ph_final_norm(const float* __restrict__ xin, const float* __restrict__ w, float* __restrict__ outp) {
  const int tid_ = otid(); const int lane = tid_ & 63, gw = (obid() * NTHR + tid_) >> 6, nw = gridDim.x * (NTHR / 64);
  for (int t = gw; t < T; t += nw) {
    const float* xr = xin + (size_t)t * DM;
    float4 v[4];
    float ss = 0.f;
#pragma unroll
    for (int i = 0; i < 4; ++i) {
      v[i] = *reinterpret_cast<const float4*>(xr + (i * 64 + lane) * 4);
      ss += v[i].x * v[i].x + v[i].y * v[i].y + v[i].z * v[i].z + v[i].w * v[i].w;
    }
    ss = wave_sum(ss);
    const float rstd = rsqrtf(ss * (1.f / DM) + 1e-6f);
#pragma unroll
    for (int i = 0; i < 4; ++i) {
      const int c = (i * 64 + lane) * 4;
      const float4 ww = *reinterpret_cast<const float4*>(w + c);
      float4 o = make_float4(v[i].x * rstd * ww.x, v[i].y * rstd * ww.y, v[i].z * rstd * ww.z, v[i].w * rstd * ww.w);
      *reinterpret_cast<float4*>(outp + (size_t)t * DM + c) = o;
    }
  }
}

DI void rot8(const u16* x1p, const u16* x2p, const float* tab  , float scale, uint4& o1, uint4& o2) {
  float x1[8], x2[8], y1[8], y2[8];
  ld8(x1p, x1); ld8(x2p, x2);
#pragma unroll
  for (int e = 0; e < 8; e += 2) {
    const float4 cs = *reinterpret_cast<const float4*>(tab + e * 2);
    y1[e] = (x1[e] * cs.x - x2[e] * cs.y) * scale;
    y2[e] = (x2[e] * cs.x + x1[e] * cs.y) * scale;
    y1[e + 1] = (x1[e + 1] * cs.z - x2[e + 1] * cs.w) * scale;
    y2[e + 1] = (x2[e + 1] * cs.z + x1[e + 1] * cs.w) * scale;
  }
  o1.x = pack2(y1[0], y1[1]); o1.y = pack2(y1[2], y1[3]); o1.z = pack2(y1[4], y1[5]); o1.w = pack2(y1[6], y1[7]);
  o2.x = pack2(y2[0], y2[1]); o2.y = pack2(y2[2], y2[3]); o2.z = pack2(y2[4], y2[5]); o2.w = pack2(y2[6], y2[7]);
}
DI void ph_post(const Params& p, int L) {
  const int tid = otid();
  const int gt = obid() * NTHR + tid, gs = gridDim.x * NTHR;
  const int lane = tid & 63, gw = gt >> 6, nw = gs >> 6;
  const float* qnw = p.q_norm_w + L * 256;
  const float* kvnw = p.kv_norm_w + L * 128;
  const float* cw = p.conv_w + L * 5 * 768;
  const float* cb = p.conv_b + L * 768;
  const float* dtb = p.dt_bias + L * 8;
  for (int idx = gt; idx < T * 96; idx += gs) {
    const int t = idx / 96, cg = idx - t * 96, s = t & (SEQ - 1);
    float acc[8];
    {
      const float4 b0 = *reinterpret_cast<const float4*>(cb + cg * 8), b1 = *reinterpret_cast<const float4*>(cb + cg * 8 + 4);
      acc[0] = b0.x; acc[1] = b0.y; acc[2] = b0.z; acc[3] = b0.w; acc[4] = b1.x; acc[5] = b1.y; acc[6] = b1.z; acc[7] = b1.w;
    }
#pragma unroll
    for (int w = 0; w < 5; ++w) {
      const int ss = s + w - 2;
      if (ss >= 0 && ss < SEQ) {
        float xv[8];
        ld8(p.proj + (size_t)(t + w - 2) * PWP + C_XBC + cg * 8, xv);
        const float4 w0 = *reinterpret_cast<const float4*>(cw + w * 768 + cg * 8), w1 = *reinterpret_cast<const float4*>(cw + w * 768 + cg * 8 + 4);
        acc[0] += xv[0] * w0.x; acc[1] += xv[1] * w0.y; acc[2] += xv[2] * w0.z; acc[3] += xv[3] * w0.w;
        acc[4] += xv[4] * w1.x; acc[5] += xv[5] * w1.y; acc[6] += xv[6] * w1.z; acc[7] += xv[7] * w1.w;
      }
    }
    uint4 o;
    o.x = pack2(fast_silu(acc[0]), fast_silu(acc[1])); o.y = pack2(fast_silu(acc[2]), fast_silu(acc[3]));
    o.z = pack2(fast_silu(acc[4]), fast_silu(acc[5])); o.w = pack2(fast_silu(acc[6]), fast_silu(acc[7]));
    *reinterpret_cast<uint4*>(p.xbc + (size_t)t * 768 + cg * 8) = o;
  }
  for (int idx = gt; idx < T * 8; idx += gs) {
    const int t = idx >> 3, k = idx & 7;
    const float v = bf2f(p.proj[(size_t)t * PWP + C_DT + k]) + dtb[k];
    p.dtv[idx] = (v > 20.f) ? v : log1pf(expf(v));
  }
  {
    const int sub = lane >> 4, l16 = lane & 15;
    for (int t = gw * 4 + sub; t < T; t += nw * 4) {
      const u16* pr = p.proj + (size_t)t * PWP;
      float v[16], u[8];
      ld8(pr + C_CQ + l16 * 16, v); ld8(pr + C_CQ + l16 * 16 + 8, v + 8);
      ld8(pr + C_CKV + l16 * 8, u);
      float ss = 0.f, s2 = 0.f;
#pragma unroll
      for (int i = 0; i < 16; ++i) ss += v[i] * v[i];
#pragma unroll
      for (int i = 0; i < 8; ++i) s2 += u[i] * u[i];
#pragma unroll
      for (int o = 1; o < 16; o <<= 1) { ss += __shfl_xor(ss, o); s2 += __shfl_xor(s2, o); }
      const float rstd = rsqrtf(ss * (1.f / 256.f) + 1e-6f), r2 = rsqrtf(s2 * (1.f / 128.f) + 1e-6f);
      uint4 o;
      const float* qw = qnw + l16 * 16;
      o.x = pack2(v[0] * rstd * qw[0], v[1] * rstd * qw[1]); o.y = pack2(v[2] * rstd * qw[2], v[3] * rstd * qw[3]);
      o.z = pack2(v[4] * rstd * qw[4], v[5] * rstd * qw[5]); o.w = pack2(v[6] * rstd * qw[6], v[7] * rstd * qw[7]);
      *reinterpret_cast<uint4*>(p.cqn + (size_t)t * 256 + l16 * 16) = o;
      o.x = pack2(v[8] * rstd * qw[8], v[9] * rstd * qw[9]); o.y = pack2(v[10] * rstd * qw[10], v[11] * rstd * qw[11]);
      o.z = pack2(v[12] * rstd * qw[12], v[13] * rstd * qw[13]); o.w = pack2(v[14] * rstd * qw[14], v[15] * rstd * qw[15]);
      *reinterpret_cast<uint4*>(p.cqn + (size_t)t * 256 + l16 * 16 + 8) = o;
      const float* kw = kvnw + l16 * 8;
      o.x = pack2(u[0] * r2 * kw[0], u[1] * r2 * kw[1]); o.y = pack2(u[2] * r2 * kw[2], u[3] * r2 * kw[3]);
      o.z = pack2(u[4] * r2 * kw[4], u[5] * r2 * kw[5]); o.w = pack2(u[6] * r2 * kw[6], u[7] * r2 * kw[7]);
      *reinterpret_cast<uint4*>(p.ckvn + (size_t)t * 128 + l16 * 8) = o;
    }
  }
  for (int idx = gt; idx < T * 42; idx += gs) {
    const int t = idx / 42, ri = idx - t * 42, s = t & (SEQ - 1);
    u16* pr = p.proj + (size_t)t * PWP;
    uint4 o1, o2;
    if (ri < 32) {
      const int isk = ri >> 4, h = (ri >> 2) & 3, i0 = (ri & 3) * 8;
      u16* a = pr + (isk ? C_RK : C_RQ) + h * 64 + i0;
      rot8(a, a + 32, p.rtab + ((size_t)s * 56 + i0) * 2, isk ? 1.f : 0.125f, o1, o2);
      *reinterpret_cast<uint4*>(a) = o1;
      *reinterpret_cast<uint4*>(a + 32) = o2;
    } else if (ri < 40) {
      const int j = ri - 32, isk = j >> 2, h = j & 3;
      u16* a = pr + (isk ? C_DK : C_DQ) + h * 64;
      rot8(a, a + 8, p.rtab + ((size_t)s * 56 + 32) * 2, 1.f, o1, o2);
      *reinterpret_cast<uint4*>(a) = o1;
      *reinterpret_cast<uint4*>(a + 8) = o2;
    } else {
      const int i0 = (ri - 40) * 8;
      u16* a = pr + C_KR + i0;
      rot8(a, a + 16, p.rtab + ((size_t)s * 56 + 40 + i0) * 2, 1.f, o1, o2);
      *reinterpret_cast<uint4*>(a) = o1;
      *reinterpret_cast<uint4*>(a + 16) = o2;
      const int bb = t >> 12;
#pragma unroll
      for (int hd = 0; hd < 4; ++hd) {
        u16* kf = p.kfull + ((size_t)(bb * 4 + hd) * SEQ + s) * 96 + 64 + i0;
        *reinterpret_cast<uint4*>(kf) = o1;
        *reinterpret_cast<uint4*>(kf + 16) = o2;
      }
    }
  }
}

DI void ph_mla_up_q(const Params& p, int L, char* smem, int t) {
  const int mt = T / 256;
  const u16* Bq = p.WuqT + (size_t)L * 384 * 256;
  {
    const int m0 = (t % mt) * 256, n0 = (t / mt) * 128;
    gemm_tile([&](int r) { return p.cqn + (size_t)(m0 + r) * 256; }, Bq + (size_t)n0 * 256, 256, 256, smem,
              [&](f32x4 (&acc)[4][4], int wr, int wc, int fr, int fq) {
                const float scale = 0.10206207261596575f * 1.4426950408889634f;
#pragma unroll
                for (int m = 0; m < 4; ++m)
#pragma unroll
                  for (int j = 0; j < 4; ++j) {
                    const int row = m0 + wr * 64 + m * 16 + fq * 4 + j;
                    const float2 cssn = *reinterpret_cast<const float2*>(p.rtab + ((size_t)(row & (SEQ - 1)) * 56 + 40 + fr) * 2);
                    const float cs = cssn.x, sn = cssn.y;
#pragma unroll
                    for (int n2 = 0; n2 < 4; n2 += 2) {
                      const int cb = n0 + wc * 64 + n2 * 16;
                      float x1 = acc[m][n2][j], x2 = acc[m][n2 + 1][j];
                      if (cb % 96 == 64) {
                        const float y1 = x1 * cs - x2 * sn, y2 = x2 * cs + x1 * sn;
                        x1 = y1; x2 = y2;
                      }
                      p.mq[(size_t)row * 384 + cb + fr] = f2bf(x1 * scale);
                      p.mq[(size_t)row * 384 + cb + 16 + fr] = f2bf(x2 * scale);
                    }
                  }
              });
  }
}
DI void ph_mla_up_kv(const Params& p, int L, char* smem, int t) {
  const int mt = T / 256;
  const u16* Bkv = p.WukvT + (size_t)L * 512 * 128;
  {
    const int m0 = (t % mt) * 256, h = t / mt, n0 = h * 128;
    gemm_tile([&](int r) { return p.ckvn + (size_t)(m0 + r) * 128; }, Bkv + (size_t)n0 * 128, 128, 128, smem,
              [&](f32x4 (&acc)[4][4], int wr, int wc, int fr, int fq) {
#pragma unroll
                for (int m = 0; m < 4; ++m) {
                  const int row = m0 + wr * 64 + m * 16 + fq * 4;
                  const int bb = row >> 12, sq = row & (SEQ - 1);
                  const size_t bh = (size_t)(bb * 4 + h);
#pragma unroll
                  for (int n = 0; n < 4; ++n) {
                    if (wc == 0) {
#pragma unroll
                      for (int j = 0; j < 4; ++j) p.kfull[(bh * SEQ + sq + j) * 96 + n * 16 + fr] = f2bf(acc[m][n][j]);
                    } else {
                      uint2 v;
                      v.x = pack2(acc[m][n][0], acc[m][n][1]);
                      v.y = pack2(acc[m][n][2], acc[m][n][3]);
                      const int sqp = (sq & ~12) | ((sq & 4) << 1) | ((sq & 8) >> 1);
                      *reinterpret_cast<uint2*>(p.vT + (bh * 64 + n * 16 + fr) * SEQ + sqp) = v;
                    }
                  }
                }
              });
  }
}

DI void ph_cumsum(const Params& p, int L) {
  const int tid_ = otid(); const int lane = tid_ & 63, gw = (obid() * NTHR + tid_) >> 6, nw = gridDim.x * (NTHR / 64);
  for (int it = gw; it < 32; it += nw) {
    const int h = it & 3, dir = (it >> 2) & 1, b = it >> 3;
    const float a = -expf(p.a_log[L * 8 + dir * 4 + h]);
    float running = 0.f;
    for (int c = 0; c < 64; ++c) {
      const int i = c * 64 + lane;
      const int s = dir ? (SEQ - 1 - i) : i;
      const size_t off = (size_t)(b * SEQ + s) * 8 + dir * 4 + h;
      float v = p.dtv[off] * a;
#pragma unroll
      for (int o = 1; o < 64; o <<= 1) {
        const float u = __shfl_up(v, o);
        if (lane >= o) v += u;
      }
      v += running;
      p.cs[off] = v;
      running = __shfl(v, 63);
    }
  }
}

DI void ph_ret_naive(const Params& p) {
  const int gt = obid() * NTHR + otid(), gs = gridDim.x * NTHR;
  for (int it = gt; it < 4 * 4 * SEQ; it += gs) {
    const int n = it & (SEQ - 1), h = (it >> 12) & 3, b = it >> 14;
    const u16* base = p.proj + (size_t)(b * SEQ) * PWP;
    uint4 qp[8];
    float o[64];
#pragma unroll
    for (int d = 0; d < 8; ++d) qp[d] = *reinterpret_cast<const uint4*>(base + (size_t)n * PWP + C_RQ + h * 64 + d * 8);
#pragma unroll
    for (int d = 0; d < 64; ++d) o[d] = 0.f;
    const float lg0 = log1pf(-exp2f(-5.f - (float)h)), lg1 = log1pf(-exp2f(-5.5f - (float)h));
#pragma unroll 1
    for (int m = 0; m < SEQ; ++m) {
      const u16* kr = base + (size_t)m * PWP + C_RK + h * 64;
      const u16* vr = base + (size_t)m * PWP + C_RV + h * 64;
      float s = 0.f;
#pragma unroll
      for (int d = 0; d < 8; ++d) s = dot8(qp[d], *reinterpret_cast<const uint4*>(kr + d * 8), s);
      const float w = (m <= n) ? expf(lg0 * (float)(n - m)) : expf(lg1 * (float)(m - n));
      s *= w;
#pragma unroll
      for (int d = 0; d < 64; d += 8) {
        float vf[8];
        ld8(vr + d, vf);
#pragma unroll
        for (int j = 0; j < 8; ++j) o[d + j] += s * vf[j];
      }
    }
    float mu = 0.f;
#pragma unroll
    for (int d = 0; d < 64; ++d) mu += o[d];
    mu *= (1.f / 64.f);
    float var = 0.f;
#pragma unroll
    for (int d = 0; d < 64; ++d) var += (o[d] - mu) * (o[d] - mu);
    var *= (1.f / 64.f);
    const float rs = rsqrtf(var + 1e-5f);
    const size_t t = (size_t)b * SEQ + n;
#pragma unroll
    for (int d = 0; d < 64; d += 8) {
      float g[8];
      ld8(p.proj + t * PWP + C_RG + h * 64 + d, g);
      uint4 ov;
      ov.x = pack2(silu(g[0]) * (o[d + 0] - mu) * rs, silu(g[1]) * (o[d + 1] - mu) * rs);
      ov.y = pack2(silu(g[2]) * (o[d + 2] - mu) * rs, silu(g[3]) * (o[d + 3] - mu) * rs);
      ov.z = pack2(silu(g[4]) * (o[d + 4] - mu) * rs, silu(g[5]) * (o[d + 5] - mu) * rs);
      ov.w = pack2(silu(g[6]) * (o[d + 6] - mu) * rs, silu(g[7]) * (o[d + 7] - mu) * rs);
      *reinterpret_cast<uint4*>(p.mixed + t * DM + h * 64 + d) = ov;
    }
  }
}

DI void ph_mla_naive(const Params& p) {
  const int gt = obid() * NTHR + otid(), gs = gridDim.x * NTHR;
  for (int it = gt; it < 2 * 4 * 4 * SEQ; it += gs) {
    const int n = it & (SEQ - 1), vh = (it >> 12) & 1, h = (it >> 13) & 3, b = it >> 15;
    const size_t t = (size_t)b * SEQ + n;
    uint4 qp[12];
    float o[32];
#pragma unroll
    for (int d = 0; d < 12; ++d) qp[d] = *reinterpret_cast<const uint4*>(p.mq + t * 384 + h * 96 + d * 8);
    const size_t tb = (size_t)b * SEQ;
    float mx = -1e30f;
#pragma unroll 1
    for (int m = 0; m < SEQ; ++m) {
      const u16* kn = p.mkv + (tb + m) * 512 + h * 128;
      const u16* kr = p.proj + (tb + m) * PWP + C_KR;
      float s = 0.f;
#pragma unroll
      for (int d = 0; d < 8; ++d) s = dot8(qp[d], *reinterpret_cast<const uint4*>(kn + d * 8), s);
#pragma unroll
      for (int d = 0; d < 4; ++d) s = dot8(qp[8 + d], *reinterpret_cast<const uint4*>(kr + d * 8), s);
      mx = fmaxf(mx, s);
    }
#pragma unroll
    for (int d = 0; d < 32; ++d) o[d] = 0.f;
    float l = 0.f;
#pragma unroll 1
    for (int m = 0; m < SEQ; ++m) {
      const u16* kn = p.mkv + (tb + m) * 512 + h * 128;
      const u16* kr = p.proj + (tb + m) * PWP + C_KR;
      float s = 0.f;
#pragma unroll
      for (int d = 0; d < 8; ++d) s = dot8(qp[d], *reinterpret_cast<const uint4*>(kn + d * 8), s);
#pragma unroll
      for (int d = 0; d < 4; ++d) s = dot8(qp[8 + d], *reinterpret_cast<const uint4*>(kr + d * 8), s);
      const float pe = exp2f(s - mx);
      l += pe;
#pragma unroll
      for (int d = 0; d < 32; d += 8) {
        float vf[8];
        ld8(kn + 64 + vh * 32 + d, vf);
#pragma unroll
        for (int j = 0; j < 8; ++j) o[d + j] += pe * vf[j];
      }
    }
    const float il = 1.f / l;
#pragma unroll
    for (int d = 0; d < 32; d += 8) {
      uint4 ov;
      ov.x = pack2(o[d + 0] * il, o[d + 1] * il);
      ov.y = pack2(o[d + 2] * il, o[d + 3] * il);
      ov.z = pack2(o[d + 4] * il, o[d + 5] * il);
      ov.w = pack2(o[d + 6] * il, o[d + 7] * il);
      *reinterpret_cast<uint4*>(p.mixed + t * DM + 256 + h * 64 + vh * 32 + d) = ov;
    }
  }
}

#define MFMA32(a, b, c) __builtin_amdgcn_mfma_f32_32x32x16_bf16((a), (b), (c), 0, 0, 0)
DI float max16(const f32x16& v) {
  float a = fmaxf(fmaxf(v[0], v[1]), v[2]), b = fmaxf(fmaxf(v[3], v[4]), v[5]), c = fmaxf(fmaxf(v[6], v[7]), v[8]);
  float d = fmaxf(fmaxf(v[9], v[10]), v[11]), e = fmaxf(fmaxf(v[12], v[13]), v[14]);
  return fmaxf(fmaxf(fmaxf(a, b), fmaxf(c, d)), fmaxf(e, v[15]));
}
DI void ph_mla_attn(const Params& p, char* smem) {
  const int tid = otid(), wid = tid >> 6, lane = tid & 63, l32 = lane & 31, hh = lane >> 5;
  u16* sK = reinterpret_cast<u16*>(smem);
  u16* sV = sK + 2 * 128 * 104;
  uint4 konev = make_uint4(hh == 0 ? 0x00003F80u : 0u, 0u, 0u, 0u);
  const bf16x8 kone = __builtin_bit_cast(bf16x8, konev);
  for (int item = obid(); item < 256; item += gridDim.x) {
    const int xcd_ = item & 7, jx_ = item >> 3, bh = xcd_ * 2 + (jx_ >> 4), qt = jx_ & 15, b = bh >> 2, h = bh & 3;
    const size_t t0 = (size_t)b * SEQ + qt * 256 + wid * 32;
    bf16x8 qf[6];
#pragma unroll
    for (int ks = 0; ks < 6; ++ks) qf[ks] = *reinterpret_cast<const bf16x8*>(p.mq + (t0 + l32) * 384 + h * 96 + ks * 16 + hh * 8);
    const u16* kg = p.kfull + (size_t)bh * SEQ * 96;
    const u16* vg = p.vT + (size_t)bh * 64 * SEQ;
    f32x16 o0, o1;
#pragma unroll
    for (int i = 0; i < 16; ++i) { o0[i] = 0.f; o1[i] = 0.f; }
    float m = 0.f, l = 0.f;
    bf16x8 qf6 = __builtin_bit_cast(bf16x8, make_uint4(0u, 0u, 0u, 0u));
    const int kr0 = tid / 12, kc0 = tid % 12, kr1 = (512 + tid) / 12, kc1 = (512 + tid) % 12, kr2 = (1024 + tid) / 12, kc2 = (1024 + tid) % 12;
    const int vd0 = tid >> 4, vd1 = 32 + (tid >> 4), vkc = (tid & 15) * 8;
    uint4 ak0, ak1, ak2, av0, av1;
#define MLA_LD(dst_, ptr_) asm volatile("global_load_dwordx4 %0, %1, off" : "=v"(dst_) : "v"(ptr_) : "memory")
#define MLA_GLOAD(K0, K1, K2, V0, V1, kt_)                                               \
    {                                                                                    \
      const u16* kb_ = kg + (size_t)(kt_) * 128 * 96 + tid * 8;                          \
      MLA_LD(K0, kb_); MLA_LD(K1, kb_ + 512 * 8); MLA_LD(K2, kb_ + 1024 * 8);            \
      const u16* vp_ = vg + (size_t)vd0 * SEQ + (kt_) * 128 + vkc;                       \
      MLA_LD(V0, vp_); MLA_LD(V1, vp_ + (size_t)32 * SEQ);                               \
    }
#define MLA_SSTORE(K0, K1, K2, V0, V1, buf_)                                             \
    {                                                                                    \
      u16* kb_ = sK + (buf_) * 128 * 104;                                                \
      u16* vb_ = sV + (buf_) * 64 * 136;                                                 \
      *reinterpret_cast<uint4*>(kb_ + kr0 * 104 + kc0 * 8) = K0;                         \
      *reinterpret_cast<uint4*>(kb_ + kr1 * 104 + kc1 * 8) = K1;                         \
      *reinterpret_cast<uint4*>(kb_ + kr2 * 104 + kc2 * 8) = K2;                         \
      *reinterpret_cast<uint4*>(vb_ + vd0 * 136 + vkc) = V0;                             \
      *reinterpret_cast<uint4*>(vb_ + vd1 * 136 + vkc) = V1;                             \
    }
    float mxrun = 0.f;
#define SGB(mask, n) __builtin_amdgcn_sched_group_barrier((mask), (n), 0)
#define MLA_KFRAG(kb_, sub_, ks_) (*reinterpret_cast<const bf16x8*>((kb_) + ((sub_) * 32 + l32) * 104 + (ks_) * 16 + hh * 8))
#define MLA_VFRAG(dst_, vb_, sub_, ks2_, dvt_) \
    dst_ = *reinterpret_cast<const bf16x8*>((vb_) + ((dvt_) * 32 + l32) * 136 + (sub_) * 32 + (ks2_) * 16 + hh * 8)
#define MLA_SOFTMAX(sc_, pa_, pb_)                                                                         \
    {                                                                                                      \
      mxrun = fmaxf(mxrun, max16(sc_));                                                                    \
      float ps0_ = 0.f, ps1_ = 0.f;                                                                        \
      _Pragma("unroll") for (int i = 0; i < 16; i += 2) {                                                  \
        sc_[i] = __builtin_amdgcn_exp2f(sc_[i]); sc_[i + 1] = __builtin_amdgcn_exp2f(sc_[i + 1]);          \
        ps0_ += sc_[i]; ps1_ += sc_[i + 1];                                                                \
      }                                                                                                    \
      l += ps0_ + ps1_;                                                                                    \
      uint4 pk_;                                                                                           \
      pk_.x = pack2(sc_[0], sc_[1]); pk_.y = pack2(sc_[2], sc_[3]); pk_.z = pack2(sc_[4], sc_[5]); pk_.w = pack2(sc_[6], sc_[7]); \
      pa_ = __builtin_bit_cast(bf16x8, pk_);                                                               \
      pk_.x = pack2(sc_[8], sc_[9]); pk_.y = pack2(sc_[10], sc_[11]); pk_.z = pack2(sc_[12], sc_[13]); pk_.w = pack2(sc_[14], sc_[15]); \
      pb_ = __builtin_bit_cast(bf16x8, pk_);                                                               \
    }
    auto compute_tile = [&](int cur, int half) {
      const u16* kb = sK + cur * 128 * 104 + half * 64 * 104;
      const u16* vb = sV + cur * 64 * 136 + half * 64;
      bf16x8 k0[6], k1[6];
#pragma unroll
      for (int ks = 0; ks < 6; ++ks) { k0[ks] = MLA_KFRAG(kb, 0, ks); k1[ks] = MLA_KFRAG(kb, 1, ks); }
      f32x16 s0, s1;
#pragma unroll
      for (int i = 0; i < 16; ++i) { s0[i] = 0.f; s1[i] = 0.f; }
#pragma unroll
      for (int ks = 0; ks < 6; ++ks) s0 = MFMA32(k0[ks], qf[ks], s0);
      s0 = MFMA32(kone, qf6, s0);
      bf16x8 v00, v01, v02, v03, v10, v11, v12, v13;
      MLA_VFRAG(v00, vb, 0, 0, 0); MLA_VFRAG(v01, vb, 0, 0, 1); MLA_VFRAG(v02, vb, 0, 1, 0); MLA_VFRAG(v03, vb, 0, 1, 1);
#pragma unroll
      for (int ks = 0; ks < 6; ++ks) s1 = MFMA32(k1[ks], qf[ks], s1);
      s1 = MFMA32(kone, qf6, s1);
      MLA_VFRAG(v10, vb, 1, 0, 0); MLA_VFRAG(v11, vb, 1, 0, 1); MLA_VFRAG(v12, vb, 1, 1, 0); MLA_VFRAG(v13, vb, 1, 1, 1);
      bf16x8 p0a, p0b, p1a, p1b;
      MLA_SOFTMAX(s0, p0a, p0b);
      o0 = MFMA32(v00, p0a, o0); o1 = MFMA32(v01, p0a, o1); o0 = MFMA32(v02, p0b, o0); o1 = MFMA32(v03, p0b, o1);
      MLA_SOFTMAX(s1, p1a, p1b);
      o0 = MFMA32(v10, p1a, o0); o1 = MFMA32(v11, p1a, o1); o0 = MFMA32(v12, p1b, o0); o1 = MFMA32(v13, p1b, o1);
      SGB(0x100, 12);
#pragma unroll
      for (int i = 0; i < 7; ++i) { SGB(0x008, 1); if (i < 4) SGB(0x100, 1); }
#pragma unroll
      for (int i = 0; i < 7; ++i) { SGB(0x008, 1); if (i < 4) SGB(0x100, 1); SGB(0x402, 7); }
#pragma unroll
      for (int i = 0; i < 4; ++i) { SGB(0x008, 1); SGB(0x402, 12); }
#pragma unroll
      for (int i = 0; i < 4; ++i) SGB(0x008, 1);
    };
    auto lazy_update = [&]() {
      const float mxr = fmaxf(mxrun, __shfl_xor(mxrun, 32));
      if (__builtin_amdgcn_ballot_w64(mxr > 8.f) != 0ull) {
        float d = (mxr > 8.f) ? mxr : 0.f;
        const float mnew = bf2f(f2bf(m + d));
        d = mnew - m;
        m = mnew;
        const float alpha = __builtin_amdgcn_exp2f(-d);
        l *= alpha;
        mxrun -= d;
#pragma unroll
        for (int i = 0; i < 16; ++i) { o0[i] *= alpha; o1[i] *= alpha; }
        uint4 qv = make_uint4(0u, 0u, 0u, 0u);
        if (hh == 0) qv.x = (unsigned)f2bf(-m);
        qf6 = __builtin_bit_cast(bf16x8, qv);
      }
    };
    MLA_GLOAD(ak0, ak1, ak2, av0, av1, 0);
    asm volatile("s_waitcnt vmcnt(0)" ::: "memory");
    MLA_SSTORE(ak0, ak1, ak2, av0, av1, 0);
    __syncthreads();
    {
      f32x16 s0, s1;
#pragma unroll
      for (int i = 0; i < 16; ++i) { s0[i] = 0.f; s1[i] = 0.f; }
#pragma unroll
      for (int ks = 0; ks < 6; ++ks) { s0 = MFMA32(MLA_KFRAG(sK, 0, ks), qf[ks], s0); s1 = MFMA32(MLA_KFRAG(sK, 1, ks), qf[ks], s1); }
      float mx = fmaxf(max16(s0), max16(s1));
      mx = fmaxf(mx, __shfl_xor(mx, 32));
      m = bf2f(f2bf(mx));
      uint4 qv = make_uint4(0u, 0u, 0u, 0u);
      if (hh == 0) qv.x = (unsigned)f2bf(-m);
      qf6 = __builtin_bit_cast(bf16x8, qv);
    }
#pragma unroll 1
    for (int kt = 0; kt < 32; kt += 2) {
      MLA_GLOAD(ak0, ak1, ak2, av0, av1, kt + 1);
#pragma unroll 1
      for (int half = 0; half < 2; ++half) compute_tile(0, half);
      asm volatile("s_waitcnt vmcnt(0)" ::: "memory");
      MLA_SSTORE(ak0, ak1, ak2, av0, av1, 1);
      __syncthreads();
      lazy_update();
      if (kt + 2 < 32) MLA_GLOAD(ak0, ak1, ak2, av0, av1, kt + 2);
#pragma unroll 1
      for (int half = 0; half < 2; ++half) compute_tile(1, half);
      if (kt + 2 < 32) {
        asm volatile("s_waitcnt vmcnt(0)" ::: "memory");
        MLA_SSTORE(ak0, ak1, ak2, av0, av1, 0);
      }
      __syncthreads();
      lazy_update();
    }
    l += __shfl_xor(l, 32);
    const float il = 1.f / l;
    u16* orow = p.mixed + (t0 + l32) * DM + 256 + h * 64 + hh * 4;
#pragma unroll
    for (int g = 0; g < 4; ++g) {
      uint2 v;
      v.x = pack2(o0[4 * g + 0] * il, o0[4 * g + 1] * il);
      v.y = pack2(o0[4 * g + 2] * il, o0[4 * g + 3] * il);
      *reinterpret_cast<uint2*>(orow + g * 8) = v;
      v.x = pack2(o1[4 * g + 0] * il, o1[4 * g + 1] * il);
      v.y = pack2(o1[4 * g + 2] * il, o1[4 * g + 3] * il);
      *reinterpret_cast<uint2*>(orow + 32 + g * 8) = v;
    }
  }
}

typedef __attribute__((address_space(3))) s16x4 lds_s16x4;
template <int MODE>
DI void ph_dil_pass(const Params& p, char* smem, int blk_) {
  const int tid = otid(), wid = tid >> 6, lane = tid & 63, l32 = lane & 31, hh = lane >> 5;
  u16* sV = reinterpret_cast<u16*>(smem) + wid * (2 * 32 * 72);
  const int i16 = lane & 15, tq = i16 >> 2, tp = i16 & 3, tblk = (lane >> 4) & 1;
  {
    constexpr int NT = (MODE == 0) ? 13 : 5;
    const int it = wid, xcd_ = blk_ & 7, jx_ = blk_ >> 3, bh = xcd_ * 2 + (jx_ >> 4), r = jx_ & 15, b = bh >> 2, h = bh & 3;
    const int i0 = it * 32;
    const int q0 = (r * 8 + it) * 32;
    const int qpos = (MODE == 0) ? (r + 16 * (i0 + l32)) : (q0 + l32);
    const size_t tb = (size_t)b * SEQ;
    const u16* kbase = p.proj + tb * PWP + C_DK + h * 64;
    const u16* vbase = p.proj + tb * PWP + C_DV + h * 64;
    bf16x8 qf[4];
    {
      const u16* qp = p.proj + (tb + qpos) * PWP + C_DQ + h * 64 + hh * 8;
#pragma unroll
      for (int ks = 0; ks < 4; ++ks) qf[ks] = *reinterpret_cast<const bf16x8*>(qp + ks * 16);
    }
    f32x16 o0, o1;
#pragma unroll
    for (int i = 0; i < 16; ++i) { o0[i] = 0.f; o1[i] = 0.f; }
    float m = -1e30f, l = 0.f;
    auto tile_params = [&](int tt, int& d, int& rd, int& ub, int& ulim, int& qb, int& qs) {
      if (MODE == 0) {
        if (tt < 5) { d = 16; rd = r; qb = i0; qs = 1; ulim = 256; ub = qb - 64 + 32 * tt; }
        else { d = 4; rd = r & 3; qb = (r >> 2) + 4 * i0; qs = 4; ulim = 1024; ub = qb - 64 + 32 * (tt - 5); }
      } else { d = 1; rd = 0; qb = q0; qs = 1; ulim = 4096; ub = qb - 64 + 32 * tt; }
    };
    bf16x8 ka0, ka1, ka2, ka3, kb0, kb1, kb2, kb3;
    uint4 va0, va1, va2, va3, vb0, vb1, vb2, vb3;
#define DIL_LD(dst_, ptr_) asm volatile("global_load_dwordx4 %0, %1, off" : "=v"(dst_) : "v"(ptr_) : "memory")
#define DIL_GLOAD(K0, K1, K2, K3, V0, V1, V2, V3, tt_)                                                   \
    {                                                                                                    \
      int d_, rd_, ub_, ulim_, qb_, qs_;                                                                 \
      tile_params((tt_), d_, rd_, ub_, ulim_, qb_, qs_);                                                 \
      int u_ = min(max(ub_ + l32, 0), ulim_ - 1);                                                        \
      const u16* kp_ = kbase + (size_t)(rd_ + d_ * u_) * PWP + hh * 8;                                   \
      DIL_LD(K0, kp_); DIL_LD(K1, kp_ + 16); DIL_LD(K2, kp_ + 32); DIL_LD(K3, kp_ + 48);                 \
      const int kr_ = ub_ + (lane >> 3);                                                                 \
      const u16* vp_;                                                                                    \
      u_ = min(max(kr_, 0), ulim_ - 1);      vp_ = vbase + (size_t)(rd_ + d_ * u_) * PWP + (lane & 7) * 8; DIL_LD(V0, vp_); \
      u_ = min(max(kr_ + 8, 0), ulim_ - 1);  vp_ = vbase + (size_t)(rd_ + d_ * u_) * PWP + (lane & 7) * 8; DIL_LD(V1, vp_); \
      u_ = min(max(kr_ + 16, 0), ulim_ - 1); vp_ = vbase + (size_t)(rd_ + d_ * u_) * PWP + (lane & 7) * 8; DIL_LD(V2, vp_); \
      u_ = min(max(kr_ + 24, 0), ulim_ - 1); vp_ = vbase + (size_t)(rd_ + d_ * u_) * PWP + (lane & 7) * 8; DIL_LD(V3, vp_); \
    }
#define DIL_VSTORE(V0, V1, V2, V3, buf_)                                                                 \
    {                                                                                                    \
      u16* vb_ = sV + (buf_) * 32 * 72 + (lane >> 3) * 72 + (lane & 7) * 8;                              \
      *reinterpret_cast<uint4*>(vb_) = V0;                                                               \
      *reinterpret_cast<uint4*>(vb_ + 8 * 72) = V1;                                                      \
      *reinterpret_cast<uint4*>(vb_ + 16 * 72) = V2;                                                     \
      *reinterpret_cast<uint4*>(vb_ + 24 * 72) = V3;                                                     \
    }
    auto tile_rest = [&](int tt, f32x16 sc, int cur) {
      int d, rd, ub, ulim, qb, qs;
      tile_params(tt, d, rd, ub, ulim, qb, qs);
      const int uq = qb + qs * l32;
      const float cs = 0.125f * 1.4426950408889634f;
      float mx = -1e30f;
#pragma unroll
      for (int i = 0; i < 16; ++i) {
        const int u = ub + (i & 3) + 8 * (i >> 2) + 4 * hh;
        const int du = u - uq;
        const bool valid = (u >= 0) && (u < ulim) && (du <= 64) && (du >= -64);
        sc[i] = valid ? sc[i] * cs : -1e30f;
        mx = fmaxf(mx, sc[i]);
      }
      mx = fmaxf(mx, __shfl_xor(mx, 32));
      const float mn = fmaxf(m, mx);
      const float alpha = __builtin_amdgcn_exp2f(m - mn);
      m = mn;
      float ps = 0.f;
#pragma unroll
      for (int i = 0; i < 16; ++i) {
        float pe = __builtin_amdgcn_exp2f(sc[i] - mn);
        pe = (sc[i] > -1e29f) ? pe : 0.f;
        ps += pe;
        sc[i] = pe;
      }
      l = l * alpha + ps;
#pragma unroll
      for (int i = 0; i < 16; ++i) { o0[i] *= alpha; o1[i] *= alpha; }
      const u16* vb = sV + cur * 32 * 72;
#pragma unroll
      for (int ks2 = 0; ks2 < 2; ++ks2) {
        uint4 pk;
        pk.x = pack2(sc[8 * ks2 + 0], sc[8 * ks2 + 1]);
        pk.y = pack2(sc[8 * ks2 + 2], sc[8 * ks2 + 3]);
        pk.z = pack2(sc[8 * ks2 + 4], sc[8 * ks2 + 5]);
        pk.w = pack2(sc[8 * ks2 + 6], sc[8 * ks2 + 7]);
        const bf16x8 pb = __builtin_bit_cast(bf16x8, pk);
#pragma unroll
        for (int dvt = 0; dvt < 2; ++dvt) {
          const u16* a0 = vb + (16 * ks2 + 4 * hh + tq) * 72 + dvt * 32 + tblk * 16 + tp * 4;
          const s16x4 lo = __builtin_amdgcn_ds_read_tr16_b64_v4i16((lds_s16x4*)(a0));
          const s16x4 hi = __builtin_amdgcn_ds_read_tr16_b64_v4i16((lds_s16x4*)(a0 + 8 * 72));
          const bf16x8 a = __builtin_shufflevector(lo, hi, 0, 1, 2, 3, 4, 5, 6, 7);
          if (dvt == 0) o0 = MFMA32(a, pb, o0); else o1 = MFMA32(a, pb, o1);
        }
      }
    };
    DIL_GLOAD(ka0, ka1, ka2, ka3, va0, va1, va2, va3, 0);
    DIL_GLOAD(kb0, kb1, kb2, kb3, vb0, vb1, vb2, vb3, 1);
    asm volatile("s_waitcnt vmcnt(8)" ::: "memory");
    DIL_VSTORE(va0, va1, va2, va3, 0);
#pragma unroll 1
    for (int tt = 0; tt < NT; tt += 2) {
      {
        f32x16 sc;
#pragma unroll
        for (int i = 0; i < 16; ++i) sc[i] = 0.f;
        sc = MFMA32(ka0, qf[0], sc); sc = MFMA32(ka1, qf[1], sc); sc = MFMA32(ka2, qf[2], sc); sc = MFMA32(ka3, qf[3], sc);
        asm volatile("" :: "v"(sc));
        if (tt + 2 < NT) DIL_GLOAD(ka0, ka1, ka2, ka3, va0, va1, va2, va3, tt + 2);
        tile_rest(tt, sc, 0);
        if (tt + 1 < NT) {
          if (tt + 2 < NT) asm volatile("s_waitcnt vmcnt(8)" ::: "memory"); else asm volatile("s_waitcnt vmcnt(0)" ::: "memory");
          DIL_VSTORE(vb0, vb1, vb2, vb3, 1);
        }
      }
      if (tt + 1 < NT) {
        f32x16 sc;
#pragma unroll
        for (int i = 0; i < 16; ++i) sc[i] = 0.f;
        sc = MFMA32(kb0, qf[0], sc); sc = MFMA32(kb1, qf[1], sc); sc = MFMA32(kb2, qf[2], sc); sc = MFMA32(kb3, qf[3], sc);
        asm volatile("" :: "v"(sc));
        if (tt + 3 < NT) DIL_GLOAD(kb0, kb1, kb2, kb3, vb0, vb1, vb2, vb3, tt + 3);
        tile_rest(tt + 1, sc, 1);
        if (tt + 2 < NT) {
          if (tt + 3 < NT) asm volatile("s_waitcnt vmcnt(8)" ::: "memory"); else asm volatile("s_waitcnt vmcnt(0)" ::: "memory");
          DIL_VSTORE(va0, va1, va2, va3, 0);
        }
      }
    }
    l += __shfl_xor(l, 32);
    float* part = p.dpart + ((tb + qpos) * 4 + h) * 68 + hh * 4;
    if (MODE == 0) {
#pragma unroll
      for (int g = 0; g < 4; ++g) {
        *reinterpret_cast<float4*>(part + g * 8) = make_float4(o0[4 * g + 0], o0[4 * g + 1], o0[4 * g + 2], o0[4 * g + 3]);
        *reinterpret_cast<float4*>(part + 32 + g * 8) = make_float4(o1[4 * g + 0], o1[4 * g + 1], o1[4 * g + 2], o1[4 * g + 3]);
      }
      if (hh == 0) { part[64] = m; part[65] = l; }
    } else {
      const float mA = part[64 - hh * 4], lA = part[65 - hh * 4];
      const float M = fmaxf(m, mA), sa = __builtin_amdgcn_exp2f(m - M), sb = __builtin_amdgcn_exp2f(mA - M);
      const float il = 1.f / (l * sa + lA * sb);
      u16* orow = p.mixed + (tb + qpos) * DM + 768 + h * 64 + hh * 4;
#pragma unroll
      for (int g = 0; g < 4; ++g) {
        const float4 a0 = *reinterpret_cast<const float4*>(part + g * 8), a1 = *reinterpret_cast<const float4*>(part + 32 + g * 8);
        uint2 v;
        v.x = pack2((o0[4 * g + 0] * sa + a0.x * sb) * il, (o0[4 * g + 1] * sa + a0.y * sb) * il);
        v.y = pack2((o0[4 * g + 2] * sa + a0.z * sb) * il, (o0[4 * g + 3] * sa + a0.w * sb) * il);
        *reinterpret_cast<uint2*>(orow + g * 8) = v;
        v.x = pack2((o1[4 * g + 0] * sa + a1.x * sb) * il, (o1[4 * g + 1] * sa + a1.y * sb) * il);
        v.y = pack2((o1[4 * g + 2] * sa + a1.z * sb) * il, (o1[4 * g + 3] * sa + a1.w * sb) * il);
        *reinterpret_cast<uint2*>(orow + 32 + g * 8) = v;
      }
    }
  }
}

DI void ph_dil_naive(const Params& p) {
  const int gt = obid() * NTHR + otid(), gs = gridDim.x * NTHR;
  for (int it = gt; it < 4 * 4 * SEQ; it += gs) {
    const int n = it & (SEQ - 1), h = (it >> 12) & 3, b = it >> 14;
    const size_t tb = (size_t)b * SEQ;
    uint4 qp[8];
    float o[64];
#pragma unroll
    for (int d = 0; d < 8; ++d) qp[d] = *reinterpret_cast<const uint4*>(p.proj + (tb + n) * PWP + C_DQ + h * 64 + d * 8);
    float mx = -1e30f;
    for (int pat = 0; pat < 3; ++pat) {
      const int dil = (pat == 0) ? 1 : (pat == 1 ? 4 : 16);
#pragma unroll 1
      for (int j = -64; j <= 64; ++j) {
        const int pos = n + j * dil;
        if (pos < 0 || pos >= SEQ) continue;
        const u16* kr = p.proj + (tb + pos) * PWP + C_DK + h * 64;
        float s = 0.f;
#pragma unroll
        for (int d = 0; d < 8; ++d) s = dot8(qp[d], *reinterpret_cast<const uint4*>(kr + d * 8), s);
        s *= 0.125f;
        mx = fmaxf(mx, s);
      }
    }
#pragma unroll
    for (int d = 0; d < 64; ++d) o[d] = 0.f;
    float l = 0.f;
    for (int pat = 0; pat < 3; ++pat) {
      const int dil = (pat == 0) ? 1 : (pat == 1 ? 4 : 16);
#pragma unroll 1
      for (int j = -64; j <= 64; ++j) {
        const int pos = n + j * dil;
        if (pos < 0 || pos >= SEQ) continue;
        const u16* kr = p.proj + (tb + pos) * PWP + C_DK + h * 64;
        const u16* vr = p.proj + (tb + pos) * PWP + C_DV + h * 64;
        float s = 0.f;
#pragma unroll
        for (int d = 0; d < 8; ++d) s = dot8(qp[d], *reinterpret_cast<const uint4*>(kr + d * 8), s);
        s *= 0.125f;
        const float pe = __expf(s - mx);
        l += pe;
#pragma unroll
        for (int d = 0; d < 64; d += 8) {
          float vf[8];
          ld8(vr + d, vf);
#pragma unroll
          for (int jj = 0; jj < 8; ++jj) o[d + jj] += pe * vf[jj];
        }
      }
    }
    const float il = 1.f / l;
#pragma unroll
    for (int d = 0; d < 64; d += 8) {
      uint4 ov;
      ov.x = pack2(o[d + 0] * il, o[d + 1] * il);
      ov.y = pack2(o[d + 2] * il, o[d + 3] * il);
      ov.z = pack2(o[d + 4] * il, o[d + 5] * il);
      ov.w = pack2(o[d + 6] * il, o[d + 7] * il);
      *reinterpret_cast<uint4*>(p.mixed + (tb + n) * DM + 768 + h * 64 + d) = ov;
    }
  }
}

DI void ph_ssd_naive(const Params& p, int L) {
  const int gt = obid() * NTHR + otid(), gs = gridDim.x * NTHR;
  for (int it = gt; it < 4 * 4 * 4 * SEQ; it += gs) {
    const int l = it & (SEQ - 1), pq = (it >> 12) & 3, h = (it >> 14) & 3, b = it >> 16;
    const int g = h >> 1;
    const size_t tb = (size_t)b * SEQ;
    uint4 cl[16];
    float acc[16];
#pragma unroll
    for (int d = 0; d < 16; ++d) cl[d] = *reinterpret_cast<const uint4*>(p.xbc + (tb + l) * 768 + 512 + g * 128 + d * 8);
#pragma unroll
    for (int d = 0; d < 16; ++d) acc[d] = 0.f;
    const float pl = p.cs[(tb + l) * 8 + h], rl = p.cs[(tb + l) * 8 + 4 + h];
#pragma unroll 1
    for (int s = 0; s < SEQ; ++s) {
      const u16* br = p.xbc + (tb + s) * 768 + 256 + g * 128;
      float cbv = 0.f;
#pragma unroll
      for (int d = 0; d < 16; ++d) cbv = dot8(cl[d], *reinterpret_cast<const uint4*>(br + d * 8), cbv);
      float w;
      if (s <= l) w = expf(pl - p.cs[(tb + s) * 8 + h]) * p.dtv[(tb + s) * 8 + h];
      else w = expf(rl - p.cs[(tb + s) * 8 + 4 + h]) * p.dtv[(tb + s) * 8 + 4 + h];
      cbv *= w;
      const u16* xr = p.xbc + (tb + s) * 768 + h * 64 + pq * 16;
#pragma unroll
      for (int d = 0; d < 16; d += 8) {
        float xf[8];
        ld8(xr + d, xf);
#pragma unroll
        for (int j = 0; j < 8; ++j) acc[d + j] += cbv * xf[j];
      }
    }
    const float dsk = p.ssm_d[L * 4 + h];
#pragma unroll
    for (int d = 0; d < 16; ++d) {
      const int c = h * 64 + pq * 16 + d;
      const float xv = bf2f(p.xbc[(tb + l) * 768 + c]);
      const float z = bf2f(p.proj[(tb + l) * PWP + C_Z + c]);
      p.ybuf[(tb + l) * 256 + c] = (acc[d] + dsk * xv) * silu(z);
    }
  }
}

DI void ph_ssd_norm(const Params& p, int L) {
  const int tid_ = otid(); const int lane = tid_ & 63, gw = (obid() * NTHR + tid_) >> 6, nw = gridDim.x * (NTHR / 64);
  const float* nwt = p.ssm_norm_w + L * 256;
  for (int t = gw; t < T; t += nw) {
    const float4 v = *reinterpret_cast<const float4*>(p.ybuf + (size_t)t * 256 + lane * 4);
    float ss = wave_sum(v.x * v.x + v.y * v.y + v.z * v.z + v.w * v.w);
    const float rstd = rsqrtf(ss * (1.f / 256.f) + 1e-6f);
    const float4 ww = *reinterpret_cast<const float4*>(nwt + lane * 4);
    uint2 o;
    o.x = pack2(v.x * rstd * ww.x, v.y * rstd * ww.y);
    o.y = pack2(v.z * rstd * ww.z, v.w * rstd * ww.w);
    *reinterpret_cast<uint2*>(p.mixed + (size_t)t * DM + 512 + lane * 4) = o;
  }
}

#define MFMA16(a, b, c) __builtin_amdgcn_mfma_f32_16x16x32_bf16((a), (b), (c), 0, 0, 0)
template <int MT, int NT, int KS>
DI void wave_mm(f32x4 (&acc)[MT][NT], const u16* a0, int lda, const u16* b0, int ldb, int fr, int fq) {
#pragma unroll
  for (int ks = 0; ks < KS; ++ks) {
    bf16x8 af[MT], bfv[NT];
#pragma unroll
    for (int m = 0; m < MT; ++m) af[m] = *reinterpret_cast<const bf16x8*>(a0 + (m * 16 + fr) * lda + ks * 32 + fq * 8);
#pragma unroll
    for (int n = 0; n < NT; ++n) bfv[n] = *reinterpret_cast<const bf16x8*>(b0 + (n * 16 + fr) * ldb + ks * 32 + fq * 8);
#pragma unroll
    for (int m = 0; m < MT; ++m)
#pragma unroll
      for (int n = 0; n < NT; ++n) acc[m][n] = MFMA16(af[m], bfv[n], acc[m][n]);
  }
}
template <int MT, int NT>
DI void zero_acc(f32x4 (&acc)[MT][NT]) {
#pragma unroll
  for (int m = 0; m < MT; ++m)
#pragma unroll
    for (int n = 0; n < NT; ++n) acc[m][n] = f32x4{0.f, 0.f, 0.f, 0.f};
}
template <int NROWS, int NCOLS>
DI void stage_rows(u16* dst, int ldd, const u16* src, size_t lsrc, int tid) {
  constexpr int CPR = NCOLS / 8, NCH = NROWS * CPR / NTHR;
  static_assert(NROWS * CPR % NTHR == 0, "tile must be a multiple of 512 chunks");
  uint4 r[NCH];
#pragma unroll
  for (int i = 0; i < NCH; ++i) {
    const int c = tid + i * NTHR, row = c / CPR, cc = c % CPR;
    r[i] = *reinterpret_cast<const uint4*>(src + (size_t)row * lsrc + cc * 8);
  }
#pragma unroll
  for (int i = 0; i < NCH; ++i) {
    const int c = tid + i * NTHR, row = c / CPR, cc = c % CPR;
    *reinterpret_cast<uint4*>(dst + row * ldd + cc * 8) = r[i];
  }
}
template <int NCOLS, class W>
DI void stage_T(u16* dst, int ldd, const u16* src, size_t lsrc, int tid, W w) {
  constexpr int NCH = 128 * (NCOLS / 8) / NTHR;
  uint4 r[NCH];
#pragma unroll
  for (int i = 0; i < NCH; ++i) {
    const int c = tid + i * NTHR, j = c & 127, cc = c >> 7;
    r[i] = *reinterpret_cast<const uint4*>(src + (size_t)j * lsrc + cc * 8);
  }
#pragma unroll
  for (int i = 0; i < NCH; ++i) {
    const int c = tid + i * NTHR, j = c & 127, cc = c >> 7;
    float f[8];
    unpack8(r[i], f);
    const float wj = w(j);
#pragma unroll
    for (int e = 0; e < 8; ++e) dst[(cc * 8 + e) * ldd + j] = f2bf(f[e] * wj);
  }
}

template <int NROWS, int NCOLS>
DI void stage_rows_ld(uint4 (&r)[NROWS * (NCOLS / 8) / NTHR], const u16* src, size_t lsrc, int tid) {
  constexpr int CPR = NCOLS / 8, NCH = NROWS * CPR / NTHR;
#pragma unroll
  for (int i = 0; i < NCH; ++i) {
    const int c = tid + i * NTHR, row = c / CPR, cc = c % CPR;
    r[i] = *reinterpret_cast<const uint4*>(src + (size_t)row * lsrc + cc * 8);
  }
}
template <int NROWS, int NCOLS>
DI void stage_rows_st(u16* dst, int ldd, const uint4 (&r)[NROWS * (NCOLS / 8) / NTHR], int tid) {
  constexpr int CPR = NCOLS / 8, NCH = NROWS * CPR / NTHR;
#pragma unroll
  for (int i = 0; i < NCH; ++i) {
    const int c = tid + i * NTHR, row = c / CPR, cc = c % CPR;
    *reinterpret_cast<uint4*>(dst + row * ldd + cc * 8) = r[i];
  }
}
template <int NCOLS>
DI void stage_T_ld(uint4 (&r)[128 * (NCOLS / 8) / NTHR], const u16* src, size_t lsrc, int tid) {
  constexpr int NCH = 128 * (NCOLS / 8) / NTHR;
#pragma unroll
  for (int i = 0; i < NCH; ++i) {
    const int c = tid + i * NTHR, j = c & 127, cc = c >> 7;
    r[i] = *reinterpret_cast<const uint4*>(src + (size_t)j * lsrc + cc * 8);
  }
}
template <int NCOLS, class W>
DI void stage_T_st(u16* dst, int ldd, const uint4 (&r)[128 * (NCOLS / 8) / NTHR], int tid, W w) {
  constexpr int NCH = 128 * (NCOLS / 8) / NTHR;
#pragma unroll
  for (int i = 0; i < NCH; ++i) {
    const int c = tid + i * NTHR, j = c & 127, cc = c >> 7;
    float f[8];
    unpack8(r[i], f);
    const float wj = w(j);
#pragma unroll
    for (int e = 0; e < 8; ++e) dst[(cc * 8 + e) * ldd + j] = f2bf(f[e] * wj);
  }
}

DI void ph_ret_a(const Params& p, char* smem, int item) {
  const int tid = otid(), wid = tid >> 6, lane = tid & 63, fr = lane & 15, fq = lane >> 4;
  u16* sVt = reinterpret_cast<u16*>(smem);
  u16* sKf = sVt + 64 * 136;
  u16* sKb = sKf + 64 * 136;
  {
    const int c = item & 31, bh = item >> 5, b = bh >> 2, h = bh & 3;
    const float lg0 = log1pf(-exp2f(-5.f - (float)h)), lg1 = log1pf(-exp2f(-5.5f - (float)h));
    const u16* src = p.proj + ((size_t)b * SEQ + c * 128) * PWP;
    {
      uint4 rv[2], rk[2];
      stage_T_ld<64>(rv, src + C_RV + h * 64, PWP, tid);
      stage_T_ld<64>(rk, src + C_RK + h * 64, PWP, tid);
      stage_T_st<64>(sVt, 136, rv, tid, [](int) { return 1.f; });
      stage_T_st<64>(sKf, 136, rk, tid, [&](int j) { return __expf(lg0 * (float)(127 - j)); });
      stage_T_st<64>(sKb, 136, rk, tid, [&](int j) { return __expf(lg1 * (float)j); });
    }
    __syncthreads();
    const int dir = wid >> 2, q = wid & 3;
    f32x4 acc[1][4];
    zero_acc(acc);
    wave_mm<1, 4, 4>(acc, sVt + q * 16 * 136, 136, dir ? sKb : sKf, 136, fr, fq);
    float* out = p.rU + ((size_t)(bh * 32 + c) * 2 + dir) * 4096;
#pragma unroll
    for (int n = 0; n < 4; ++n)
#pragma unroll
      for (int j = 0; j < 4; ++j) out[(q * 16 + fq * 4 + j) * 64 + n * 16 + fr] = acc[0][n][j];
    __syncthreads();
  }
}
DI void ph_ret_scan(const Params& p) {
  const int gt = obid() * NTHR + otid(), gs = gridDim.x * NTHR;
  for (int it = gt; it < 16 * 2 * 4096; it += gs) {
    const int e = it & 4095, dir = (it >> 12) & 1, bh = it >> 13, h = bh & 3;
    const float lg = log1pf(-exp2f((dir ? -5.5f : -5.f) - (float)h));
    const float cd = __expf(lg * 128.f);
    float u[32];
#pragma unroll
    for (int c = 0; c < 32; ++c) u[c] = p.rU[((size_t)(bh * 32 + c) * 2 + dir) * 4096 + e];
    float st = 0.f;
    if (dir == 0) {
#pragma unroll
      for (int c = 0; c < 32; ++c) {
        p.rS[((size_t)(bh * 32 + c) * 2 + dir) * 4096 + e] = f2bf(st);
        st = st * cd + u[c];
      }
    } else {
#pragma unroll
      for (int c = 31; c >= 0; --c) {
        p.rS[((size_t)(bh * 32 + c) * 2 + dir) * 4096 + e] = f2bf(st);
        st = st * cd + u[c];
      }
    }
  }
}
DI void ph_ret_c(const Params& p, char* smem, int item) {
  const int tid = otid(), wid = tid >> 6, lane = tid & 63, fr = lane & 15, fq = lane >> 4;
  u16* sQ = reinterpret_cast<u16*>(smem);
  u16* sK = sQ + 128 * 72;
  u16* sVt = sK + 128 * 72;
  u16* sSf = sVt + 64 * 136;
  u16* sSb = sSf + 64 * 72;
  u16* sP = sSb + 64 * 72;
  {
    const int c = item & 31, bh = item >> 5, b = bh >> 2, h = bh & 3;
    const float lg0 = log1pf(-exp2f(-5.f - (float)h)), lg1 = log1pf(-exp2f(-5.5f - (float)h));
    const size_t t0 = (size_t)b * SEQ + c * 128;
    const u16* src = p.proj + t0 * PWP;
    {
      uint4 rq[2], rk[2], rv[2], rf[1], rb[1];
      stage_rows_ld<128, 64>(rq, src + C_RQ + h * 64, PWP, tid);
      stage_rows_ld<128, 64>(rk, src + C_RK + h * 64, PWP, tid);
      stage_T_ld<64>(rv, src + C_RV + h * 64, PWP, tid);
      stage_rows_ld<64, 64>(rf, p.rS + ((size_t)(bh * 32 + c) * 2 + 0) * 4096, 64, tid);
      stage_rows_ld<64, 64>(rb, p.rS + ((size_t)(bh * 32 + c) * 2 + 1) * 4096, 64, tid);
      stage_rows_st<128, 64>(sQ, 72, rq, tid);
      stage_rows_st<128, 64>(sK, 72, rk, tid);
      stage_T_st<64>(sVt, 136, rv, tid, [](int) { return 1.f; });
      stage_rows_st<64, 64>(sSf, 72, rf, tid);
      stage_rows_st<64, 64>(sSb, 72, rb, tid);
    }
    __syncthreads();
    {
      const int wr = wid >> 1, wc = wid & 1;
      f32x4 sacc[2][4];
      zero_acc(sacc);
      wave_mm<2, 4, 2>(sacc, sQ + wr * 32 * 72, 72, sK + wc * 64 * 72, 72, fr, fq);
#pragma unroll
      for (int m = 0; m < 2; ++m)
#pragma unroll
        for (int n = 0; n < 4; ++n)
#pragma unroll
          for (int j = 0; j < 4; ++j) {
            const int i = wr * 32 + m * 16 + fq * 4 + j, jj = wc * 64 + n * 16 + fr;
            const float dcy = (jj <= i) ? __expf(lg0 * (float)(i - jj)) : __expf(lg1 * (float)(jj - i));
            sP[i * 136 + jj] = f2bf(sacc[m][n][j] * dcy);
          }
    }
    __syncthreads();
    {
      f32x4 ai[1][4], af_[1][4], ab_[1][4];
      zero_acc(ai); zero_acc(af_); zero_acc(ab_);
      wave_mm<1, 4, 4>(ai, sP + wid * 16 * 136, 136, sVt, 136, fr, fq);
      wave_mm<1, 4, 2>(af_, sQ + wid * 16 * 72, 72, sSf, 72, fr, fq);
      wave_mm<1, 4, 2>(ab_, sQ + wid * 16 * 72, 72, sSb, 72, fr, fq);
#pragma unroll
      for (int j = 0; j < 4; ++j) {
        const int i = wid * 16 + fq * 4 + j;
        const float xf = __expf(lg0 * (float)(i + 1)), xb = __expf(lg1 * (float)(128 - i));
        float o[4], sum = 0.f;
#pragma unroll
        for (int n = 0; n < 4; ++n) { o[n] = ai[0][n][j] + xf * af_[0][n][j] + xb * ab_[0][n][j]; sum += o[n]; }
#pragma unroll
        for (int sft = 1; sft < 16; sft <<= 1) sum += __shfl_xor(sum, sft);
        const float mu = sum * (1.f / 64.f);
        float var = 0.f;
#pragma unroll
        for (int n = 0; n < 4; ++n) var += (o[n] - mu) * (o[n] - mu);
#pragma unroll
        for (int sft = 1; sft < 16; sft <<= 1) var += __shfl_xor(var, sft);
        const float rs = rsqrtf(var * (1.f / 64.f) + 1e-5f);
#pragma unroll
        for (int n = 0; n < 4; ++n) {
          const float g = bf2f(p.proj[(t0 + i) * PWP + C_RG + h * 64 + n * 16 + fr]);
          p.mixed[(t0 + i) * DM + h * 64 + n * 16 + fr] = f2bf(silu(g) * (o[n] - mu) * rs);
        }
      }
    }
    __syncthreads();
  }
}

DI void ssd_local_cumsum(const Params& p, int L, size_t t0, float* cum, float* dtl, int wid, int lane) {
  const int dir = wid >> 2, h = wid & 3;
  const float a = -__expf(p.a_log[L * 8 + dir * 4 + h]);
  float d0, d1;
  if (dir == 0) { d0 = p.dtv[(t0 + 2 * lane) * 8 + h]; d1 = p.dtv[(t0 + 2 * lane + 1) * 8 + h]; }
  else { d0 = p.dtv[(t0 + 127 - 2 * lane) * 8 + 4 + h]; d1 = p.dtv[(t0 + 126 - 2 * lane) * 8 + 4 + h]; }
  float v0 = d0 * a, v1 = v0 + d1 * a;
  float run = v1;
#pragma unroll
  for (int o = 1; o < 64; o <<= 1) {
    const float u = __shfl_up(run, o);
    if (lane >= o) run += u;
  }
  const float excl = run - v1;
  v0 += excl; v1 += excl;
  float* cr = cum + (dir * 4 + h) * 128;
  float* dr = dtl + (dir * 4 + h) * 128;
  if (dir == 0) { cr[2 * lane] = v0; cr[2 * lane + 1] = v1; dr[2 * lane] = d0; dr[2 * lane + 1] = d1; }
  else { cr[127 - 2 * lane] = v0; cr[126 - 2 * lane] = v1; dr[127 - 2 * lane] = d0; dr[126 - 2 * lane] = d1; }
}

DI void ph_ssd_a(const Params& p, int L, char* smem, int item) {
  const int tid = otid(), wid = tid >> 6, lane = tid & 63, fr = lane & 15, fq = lane >> 4;
  u16* sBt = reinterpret_cast<u16*>(smem);
  u16* sXf = sBt + 2 * 128 * 136;
  u16* sXb = sXf + 64 * 136;
  float* cum = reinterpret_cast<float*>(sXb + 64 * 136);
  float* dtl = cum + 8 * 128;
  {
    const int c = item & 31, b = item >> 5;
    const size_t t0 = (size_t)b * SEQ + c * 128;
    ssd_local_cumsum(p, L, t0, cum, dtl, wid, lane);
    stage_T<256>(sBt, 136, p.xbc + t0 * 768 + 256, 768, tid, [](int) { return 1.f; });
    __syncthreads();
    if (tid < 8) {
      const int dir = tid >> 2;
      p.cdec[(size_t)item * 8 + tid] = __expf(dir ? cum[tid * 128 + 0] : cum[tid * 128 + 127]);
    }
    for (int h = 0; h < 4; ++h) {
      const float* cf = cum + h * 128;
      const float* cb = cum + (4 + h) * 128;
      const float* df = dtl + h * 128;
      const float* db = dtl + (4 + h) * 128;
      const float endf = cf[127], endb = cb[0];
      {
        uint4 rx[2];
        stage_T_ld<64>(rx, p.xbc + t0 * 768 + h * 64, 768, tid);
        stage_T_st<64>(sXf, 136, rx, tid, [&](int l) { return __expf(endf - cf[l]) * df[l]; });
        stage_T_st<64>(sXb, 136, rx, tid, [&](int l) { return __expf(endb - cb[l]) * db[l]; });
      }
      __syncthreads();
      const int dir = wid >> 2, q = wid & 3, g = h >> 1;
      f32x4 acc[4][2];
      zero_acc(acc);
      wave_mm<4, 2, 4>(acc, dir ? sXb : sXf, 136, sBt + (g * 128 + q * 32) * 136, 136, fr, fq);
      float* out = p.sU + ((size_t)item * 8 + h * 2 + dir) * 8192;
#pragma unroll
      for (int m = 0; m < 4; ++m)
#pragma unroll
        for (int n = 0; n < 2; ++n)
#pragma unroll
          for (int j = 0; j < 4; ++j) out[(m * 16 + fq * 4 + j) * 128 + q * 32 + n * 16 + fr] = acc[m][n][j];
      __syncthreads();
    }
  }
}
DI void ph_ssd_scan(const Params& p) {
  const int gt = obid() * NTHR + otid(), gs = gridDim.x * NTHR;
  for (int it = gt; it < 4 * 8 * 8192; it += gs) {
    const int e = it & 8191, hd = (it >> 13) & 7, b = it >> 16;
    const int dir = hd & 1, h = hd >> 1;
    float u[32];
#pragma unroll
    for (int c = 0; c < 32; ++c) u[c] = p.sU[((size_t)(b * 32 + c) * 8 + hd) * 8192 + e];
    float st = 0.f;
    if (dir == 0) {
#pragma unroll
      for (int c = 0; c < 32; ++c) {
        p.sS[((size_t)(b * 32 + c) * 8 + hd) * 8192 + e] = f2bf(st);
        st = st * p.cdec[(size_t)(b * 32 + c) * 8 + dir * 4 + h] + u[c];
      }
    } else {
#pragma unroll
      for (int c = 31; c >= 0; --c) {
        p.sS[((size_t)(b * 32 + c) * 8 + hd) * 8192 + e] = f2bf(st);
        st = st * p.cdec[(size_t)(b * 32 + c) * 8 + dir * 4 + h] + u[c];
      }
    }
  }
}
DI void ph_ssd_c(const Params& p, int L, char* smem, int item) {
  const int tid = otid(), wid = tid >> 6, lane = tid & 63, fr = lane & 15, fq = lane >> 4;
  u16* sC = reinterpret_cast<u16*>(smem);
  u16* sB = sC + 128 * 136;
  u16* sXt = sB + 128 * 136;
  u16* sSf = sXt + 64 * 136;
  u16* sSb = sSf + 64 * 136;
  float* cum = reinterpret_cast<float*>(sSb + 64 * 136);
  float* dtl = cum + 8 * 128;
  {
    const int c = item & 31, b = item >> 5;
    const size_t t0 = (size_t)b * SEQ + c * 128;
    ssd_local_cumsum(p, L, t0, cum, dtl, wid, lane);
    float ssq[4] = {0.f, 0.f, 0.f, 0.f};
#pragma unroll 1
    for (int g = 0; g < 2; ++g) {
      {
        uint4 rc[4], rb4[4];
        stage_rows_ld<128, 128>(rc, p.xbc + t0 * 768 + 512 + g * 128, 768, tid);
        stage_rows_ld<128, 128>(rb4, p.xbc + t0 * 768 + 256 + g * 128, 768, tid);
        stage_rows_st<128, 128>(sC, 136, rc, tid);
        stage_rows_st<128, 128>(sB, 136, rb4, tid);
      }
      __syncthreads();
      const int wr = wid >> 1, wc = wid & 1;
      f32x4 G[2][4];
      zero_acc(G);
      wave_mm<2, 4, 4>(G, sC + wr * 32 * 136, 136, sB + wc * 64 * 136, 136, fr, fq);
      __syncthreads();
#pragma unroll 1
      for (int hl = 0; hl < 2; ++hl) {
        const int h = g * 2 + hl;
        const float* cf = cum + h * 128;
        const float* cb = cum + (4 + h) * 128;
        const float* df = dtl + h * 128;
        const float* db = dtl + (4 + h) * 128;
        uint4 rxt[2], rsf[2], rsb[2];
        stage_T_ld<64>(rxt, p.xbc + t0 * 768 + h * 64, 768, tid);
        stage_rows_ld<64, 128>(rsf, p.sS + ((size_t)item * 8 + h * 2 + 0) * 8192, 128, tid);
        stage_rows_ld<64, 128>(rsb, p.sS + ((size_t)item * 8 + h * 2 + 1) * 8192, 128, tid);
#pragma unroll
        for (int m = 0; m < 2; ++m)
#pragma unroll
          for (int n = 0; n < 4; ++n)
#pragma unroll
            for (int j = 0; j < 4; ++j) {
              const int l = wr * 32 + m * 16 + fq * 4 + j, sx = wc * 64 + n * 16 + fr;
              const float w = (sx <= l) ? __expf(cf[l] - cf[sx]) * df[sx] : __expf(cb[l] - cb[sx]) * db[sx];
              sB[l * 136 + sx] = f2bf(G[m][n][j] * w);
            }
        stage_T_st<64>(sXt, 136, rxt, tid, [](int) { return 1.f; });
        stage_rows_st<64, 128>(sSf, 136, rsf, tid);
        stage_rows_st<64, 128>(sSb, 136, rsb, tid);
        __syncthreads();
        f32x4 yd[1][4], yf[1][4], yb[1][4];
        zero_acc(yd); zero_acc(yf); zero_acc(yb);
        wave_mm<1, 4, 4>(yd, sB + wid * 16 * 136, 136, sXt, 136, fr, fq);
        wave_mm<1, 4, 4>(yf, sC + wid * 16 * 136, 136, sSf, 136, fr, fq);
        wave_mm<1, 4, 4>(yb, sC + wid * 16 * 136, 136, sSb, 136, fr, fq);
        const float dsk = p.ssm_d[L * 4 + h];
#pragma unroll
        for (int j = 0; j < 4; ++j) {
          const int l = wid * 16 + fq * 4 + j;
          const float ef = __expf(cf[l]), eb = __expf(cb[l]);
#pragma unroll
          for (int n = 0; n < 4; ++n) {
            const int ch = h * 64 + n * 16 + fr;
            const float xv = bf2f(p.xbc[(t0 + l) * 768 + ch]);
            const float z = bf2f(p.proj[(t0 + l) * PWP + C_Z + ch]);
            const float yv = (yd[0][n][j] + ef * yf[0][n][j] + eb * yb[0][n][j] + dsk * xv) * silu(z);
            ssq[j] += yv * yv;
            p.ybuf[(t0 + l) * 256 + ch] = yv;
          }
        }
        __syncthreads();
      }
    }
    const float* nwt = p.ssm_norm_w + L * 256;
#pragma unroll
    for (int j = 0; j < 4; ++j) {
      float ss = ssq[j];
#pragma unroll
      for (int sft = 1; sft < 16; sft <<= 1) ss += __shfl_xor(ss, sft);
      const float rstd = rsqrtf(ss * (1.f / 256.f) + 1e-6f);
      const int l = wid * 16 + fq * 4 + j;
#pragma unroll
      for (int hn = 0; hn < 16; ++hn) {
        const int ch = hn * 16 + fr;
        p.mixed[(t0 + l) * DM + 512 + ch] = f2bf(p.ybuf[(t0 + l) * 256 + ch] * rstd * nwt[ch]);
      }
    }
  }
}

struct CfgOutproj {
  static constexpr bool PERM = false;
  int K; const Params* p; int L; int bid, nb; const float* xin; float* xout;
  DI bool next(int i, pg8::Unit& u) const { const int t = i * nb + bid; if (t >= 64 * 4) return false; u.pm = t & 63; u.pn = t >> 6; return true; }
  DI const char* a_base(const pg8::Unit& u) const { return (const char*)(p->mixed + (size_t)u.pm * 256 * DM); }
  DI const char* b_base(const pg8::Unit& u) const { return (const char*)(p->WoutT + ((size_t)L * DM + (size_t)u.pn * 256) * DM); }
  DI void a_off(const pg8::Unit&, int R0, int C0, int R1, int C1, unsigned (&vo)[4]) const {
    vo[0] = (unsigned)(R0 * DM + C0) * 2u; vo[1] = (unsigned)(R1 * DM + C1) * 2u;
    vo[2] = vo[0] + 128u * DM * 2u; vo[3] = vo[1] + 128u * DM * 2u;
  }
  DI void epi(const f32x4 (&acc)[2][2][4][2], const pg8::Unit& u, int wr, int wc, int fr, int fq) const {
    const int row0 = u.pm * 256 + wr * 64 + fr, col0 = u.pn * 256 + wc * 32 + 4 * fq;
#pragma unroll
    for (int ai = 0; ai < 2; ++ai)
#pragma unroll
      for (int m = 0; m < 4; ++m) {
        const size_t ro = (size_t)(row0 + ai * 128 + m * 16) * DM + col0;
#pragma unroll
        for (int bj = 0; bj < 2; ++bj)
#pragma unroll
          for (int n = 0; n < 2; ++n) {
            const size_t o = ro + bj * 128 + n * 16;
            const float4 xi = *reinterpret_cast<const float4*>(xin + o);
            const f32x4 a = acc[ai][bj][m][n];
            *reinterpret_cast<float4*>(xout + o) = make_float4(xi.x + a[0], xi.y + a[1], xi.z + a[2], xi.w + a[3]);
          }
      }
  }
};
DI void ph_outproj(const Params& p, int L, const float* xin, float* xout, char* smem) {
  CfgOutproj c; c.K = DM; c.p = &p; c.L = L; c.bid = obid(); c.nb = gridDim.x; c.xin = xin; c.xout = xout;
  pg8::gemm_phase((pg8::lds_u8*)smem, c);
}

DI void ph_rms2_router(const Params& p, int L, const float* xres, char* smem) {
  const int tid = otid(), lane = tid & 63, gw = (obid() * NTHR + tid) >> 6, nw = gridDim.x * (NTHR / 64);
  const float* w = p.ln2_w + L * DM;
  const float* rw = p.router_w + (size_t)L * DM * 16;
  float4* srw = reinterpret_cast<float4*>(smem);
  for (int i = tid; i < 4096; i += NTHR) {
    const int c = i >> 2, e4 = i & 3;
    srw[(e4 * 4 + (c & 3)) * 256 + (c >> 2)] = *reinterpret_cast<const float4*>(rw + (size_t)i * 4);
  }
  __syncthreads();
  const int b5 = (lane >> 5) & 1, b4 = (lane >> 4) & 1, b3 = (lane >> 3) & 1, b2 = (lane >> 2) & 1;
  const int my_e = 8 * b5 + 4 * b4 + 2 * b3 + b2;
  for (int t = gw; t < T; t += nw) {
    const float* xr = xres + (size_t)t * DM;
    float4 v[4];
    float ss = 0.f;
#pragma unroll
    for (int i = 0; i < 4; ++i) {
      v[i] = *reinterpret_cast<const float4*>(xr + (i * 64 + lane) * 4);
      ss += v[i].x * v[i].x + v[i].y * v[i].y + v[i].z * v[i].z + v[i].w * v[i].w;
    }
    ss = wave_sum(ss);
    const float rstd = rsqrtf(ss * (1.f / DM) + 1e-6f);
    float lg[16];
#pragma unroll
    for (int e = 0; e < 16; ++e) lg[e] = 0.f;
#pragma unroll
    for (int i = 0; i < 4; ++i) {
      const int q = i * 64 + lane;
      const float4 ww = *reinterpret_cast<const float4*>(w + q * 4);
      const float hv[4] = {v[i].x * rstd * ww.x, v[i].y * rstd * ww.y, v[i].z * rstd * ww.z, v[i].w * rstd * ww.w};
      uint2 o;
      o.x = pack2(hv[0], hv[1]);
      o.y = pack2(hv[2], hv[3]);
      *reinterpret_cast<uint2*>(p.hn + (size_t)t * DM + q * 4) = o;
#pragma unroll
      for (int j = 0; j < 4; ++j)
#pragma unroll
        for (int e4 = 0; e4 < 4; ++e4) {
          const float4 r = srw[(e4 * 4 + j) * 256 + q];
          lg[e4 * 4 + 0] += hv[j] * r.x; lg[e4 * 4 + 1] += hv[j] * r.y;
          lg[e4 * 4 + 2] += hv[j] * r.z; lg[e4 * 4 + 3] += hv[j] * r.w;
        }
      __builtin_amdgcn_sched_barrier(0);
    }
#pragma unroll
    for (int k = 0; k < 8; ++k) {
      const float send = b5 ? lg[k] : lg[k + 8], keep = b5 ? lg[k + 8] : lg[k];
      lg[k] = keep + __shfl_xor(send, 32);
    }
#pragma unroll
    for (int k = 0; k < 4; ++k) {
      const float send = b4 ? lg[k] : lg[k + 4], keep = b4 ? lg[k + 4] : lg[k];
      lg[k] = keep + __shfl_xor(send, 16);
    }
#pragma unroll
    for (int k = 0; k < 2; ++k) {
      const float send = b3 ? lg[k] : lg[k + 2], keep = b3 ? lg[k + 2] : lg[k];
      lg[k] = keep + __shfl_xor(send, 8);
    }
    float lv;
    {
      const float send = b2 ? lg[0] : lg[1], keep = b2 ? lg[1] : lg[0];
      lv = keep + __shfl_xor(send, 4);
    }
    lv += __shfl_xor(lv, 2);
    lv += __shfl_xor(lv, 1);
    float mx = lv;
    mx = fmaxf(mx, __shfl_xor(mx, 4)); mx = fmaxf(mx, __shfl_xor(mx, 8));
    mx = fmaxf(mx, __shfl_xor(mx, 16)); mx = fmaxf(mx, __shfl_xor(mx, 32));
    const float ex = expf(lv - mx);
    float den = ex;
    den += __shfl_xor(den, 4); den += __shfl_xor(den, 8); den += __shfl_xor(den, 16); den += __shfl_xor(den, 32);
    if ((lane & 3) == 0) { p.aff[(size_t)t * 16 + my_e] = ex / den; p.inv[(size_t)t * 16 + my_e] = -1; }
  }
}

DI int block_sum_i(int v, int* red, int tid) {
#pragma unroll
  for (int o = 32; o > 0; o >>= 1) v += __shfl_xor(v, o);
  __syncthreads();
  if ((tid & 63) == 0) red[tid >> 6] = v;
  __syncthreads();
  int t = 0;
#pragma unroll
  for (int w = 0; w < NTHR / 64; ++w) t += red[w];
  return t;
}
DI void ph_topk(const Params& p, char* smem) {
  int* red = reinterpret_cast<int*>(smem);
  int* wsum = red + 16;
  const int tid = otid(), wid = tid >> 6, lane = tid & 63;
  for (int it = obid(); it < 64; it += gridDim.x) {
    const int e = it & 15, b = it >> 4;
    unsigned v[8];
#pragma unroll
    for (int i = 0; i < 8; ++i) v[i] = __float_as_uint(p.aff[(size_t)(b * SEQ + tid * 8 + i) * 16 + e]);
    unsigned thr = 0;
#pragma unroll 1
    for (int bit = 30; bit >= 0; --bit) {
      const unsigned cand = thr | (1u << bit);
      int cnt = 0;
#pragma unroll
      for (int i = 0; i < 8; ++i) cnt += (v[i] >= cand) ? 1 : 0;
      if (block_sum_i(cnt, red, tid) >= 512) thr = cand;
    }
    int ngt = 0, ntie = 0;
#pragma unroll
    for (int i = 0; i < 8; ++i) { ngt += (v[i] > thr) ? 1 : 0; ntie += (v[i] == thr) ? 1 : 0; }
    int ig = ngt, itie = ntie;
#pragma unroll
    for (int o = 1; o < 64; o <<= 1) {
      const int a = __shfl_up(ig, o), c = __shfl_up(itie, o);
      if (lane >= o) { ig += a; itie += c; }
    }
    __syncthreads();
    if (lane == 63) { wsum[wid] = ig; wsum[8 + wid] = itie; }
    __syncthreads();
    int og = 0, ot = 0, totg = 0;
#pragma unroll
    for (int w = 0; w < 8; ++w) {
      const int a = wsum[w], c = wsum[8 + w];
      if (w < wid) { og += a; ot += c; }
      totg += a;
    }
    int pg = og + ig - ngt, pt = ot + itie - ntie;
    const int base = (e * 4 + b) * 512;
#pragma unroll
    for (int i = 0; i < 8; ++i) {
      int slot = -1;
      if (v[i] > thr) { slot = pg; ++pg; }
      else if (v[i] == thr) { if (totg + pt < 512) slot = totg + pt; ++pt; }
      if (slot >= 0) {
        p.tok[base + slot] = b * SEQ + tid * 8 + i;
        p.inv[(size_t)(b * SEQ + tid * 8 + i) * 16 + e] = base + slot;
        p.gate[base + slot] = __uint_as_float(v[i]);
      }
    }
    __syncthreads();
  }
}

struct CfgMoe1 {
  static constexpr bool PERM = true;
  int K; const Params* p; int L; int bid, nb;
  DI bool next(int i, pg8::Unit& u) const {
    const int t = i * nb + bid; if (t >= 16 * 16 * 8) return false;
    const int rnd = t >> 8, w = t & 255, xcd = w & 7, jx = w >> 3, pid = xcd * 4 + (jx >> 3);
    const int mt = jx & 7, nt = pid & 15, e = rnd * 2 + (pid >> 4);
    u.pm = e * 8 + mt; u.pn = e * 16 + nt; return true;
  }
  DI const char* a_base(const pg8::Unit&) const { return (const char*)p->hn; }
  DI const char* b_base(const pg8::Unit& u) const { return (const char*)(p->WguT + ((size_t)L * 16 * 4096 + (size_t)u.pn * 256) * DM); }
  DI void a_off(const pg8::Unit& u, int R0, int C0, int R1, int C1, unsigned (&vo)[4]) const {
    const int* tk = p->tok + u.pm * 256;
    vo[0] = (unsigned)(tk[R0] * DM + C0) * 2u; vo[1] = (unsigned)(tk[R1] * DM + C1) * 2u;
    vo[2] = (unsigned)(tk[128 + R0] * DM + C0) * 2u; vo[3] = (unsigned)(tk[128 + R1] * DM + C1) * 2u;
  }
  DI void epi(const f32x4 (&acc)[2][2][4][2], const pg8::Unit& u, int wr, int wc, int fr, int fq) const {
    const int row0 = u.pm * 256 + wr * 64 + fr, col0 = (u.pn & 15) * 128 + wc * 32 + 8 * fq;
#pragma unroll
    for (int ai = 0; ai < 2; ++ai)
#pragma unroll
      for (int m = 0; m < 4; ++m) {
        const f32x4 g0 = acc[ai][0][m][0], g1 = acc[ai][0][m][1], u0 = acc[ai][1][m][0], u1 = acc[ai][1][m][1];
        uint4 w;
        w.x = pack2(fast_silu(g0[0]) * u0[0], fast_silu(g0[1]) * u0[1]); w.y = pack2(fast_silu(g0[2]) * u0[2], fast_silu(g0[3]) * u0[3]);
        w.z = pack2(fast_silu(g1[0]) * u1[0], fast_silu(g1[1]) * u1[1]); w.w = pack2(fast_silu(g1[2]) * u1[2], fast_silu(g1[3]) * u1[3]);
        *reinterpret_cast<uint4*>(p->hid + (size_t)(row0 + ai * 128 + m * 16) * 2048 + col0) = w;
      }
  }
};
DI void ph_moe1(const Params& p, int L, char* smem) {
  CfgMoe1 c; c.K = DM; c.p = &p; c.L = L; c.bid = obid(); c.nb = gridDim.x;
  pg8::gemm_phase((pg8::lds_u8*)smem, c);
}
struct CfgMoe2 {
  static constexpr bool PERM = true;
  int K; const Params* p; int L; int bid, nb;
  DI bool next(int i, pg8::Unit& u) const {
    const int t = i * nb + bid; if (t >= 16 * 4 * 8) return false;
    const int rnd = t >> 8, w = t & 255, xcd = w & 7, jx = w >> 3, pid = rnd * 32 + xcd * 4 + (jx >> 3);
    u.pm = (pid >> 2) * 8 + (jx & 7); u.pn = pid; return true;
  }
  DI const char* a_base(const pg8::Unit& u) const { return (const char*)(p->hid + (size_t)u.pm * 256 * 2048); }
  DI const char* b_base(const pg8::Unit& u) const { return (const char*)(p->WdT + ((size_t)L * 16 * DM + (size_t)u.pn * 256) * 2048); }
  DI void a_off(const pg8::Unit&, int R0, int C0, int R1, int C1, unsigned (&vo)[4]) const {
    vo[0] = (unsigned)(R0 * 2048 + C0) * 2u; vo[1] = (unsigned)(R1 * 2048 + C1) * 2u;
    vo[2] = vo[0] + 128u * 2048u * 2u; vo[3] = vo[1] + 128u * 2048u * 2u;
  }
  DI void epi(const f32x4 (&acc)[2][2][4][2], const pg8::Unit& u, int wr, int wc, int fr, int fq) const {
    u16* eo = p->proj;
    const int row0 = u.pm * 256 + wr * 64 + fr, col0 = (u.pn & 3) * 256 + wc * 32 + 8 * fq;
#pragma unroll
    for (int ai = 0; ai < 2; ++ai)
#pragma unroll
      for (int m = 0; m < 4; ++m) {
        const int row = row0 + ai * 128 + m * 16;
        const float gt = p->gate[row];
#pragma unroll
        for (int bj = 0; bj < 2; ++bj) {
          const f32x4 a0 = acc[ai][bj][m][0], a1 = acc[ai][bj][m][1];
          uint4 w;
          w.x = pack2(gt * a0[0], gt * a0[1]); w.y = pack2(gt * a0[2], gt * a0[3]);
          w.z = pack2(gt * a1[0], gt * a1[1]); w.w = pack2(gt * a1[2], gt * a1[3]);
          *reinterpret_cast<uint4*>(eo + (size_t)row * DM + col0 + bj * 128) = w;
        }
      }
  }
};
DI void ph_moe2(const Params& p, int L, char* smem) {
  CfgMoe2 c; c.K = 2048; c.p = &p; c.L = L; c.bid = obid(); c.nb = gridDim.x;
  pg8::gemm_phase((pg8::lds_u8*)smem, c);
}
template <bool FINAL>
DI void ph_combine_norm(const Params& p, const float* __restrict__ xa, float* __restrict__ xnew, const float* __restrict__ w,
                        u16* __restrict__ hn_out, float* __restrict__ f_out) {
  const int tid_ = otid(), lane = tid_ & 63, gw = (obid() * NTHR + tid_) >> 6, nw = gridDim.x * (NTHR / 64);
  const u16* eo = p.proj;
  for (int t = gw; t < T; t += nw) {
    float4 v[4];
#pragma unroll
    for (int i = 0; i < 4; ++i) v[i] = *reinterpret_cast<const float4*>(xa + (size_t)t * DM + (i * 64 + lane) * 4);
    const int myrow = (lane < 16) ? p.inv[(size_t)t * 16 + lane] : -1;
#pragma unroll 1
    for (int e = 0; e < 16; ++e) {
      const int r = __shfl(myrow, e);
      if (r >= 0) {
#pragma unroll
        for (int i = 0; i < 4; ++i) {
          const uint2 q = *reinterpret_cast<const uint2*>(eo + (size_t)r * DM + (i * 64 + lane) * 4);
          v[i].x += __uint_as_float(q.x << 16); v[i].y += __uint_as_float(q.x & 0xffff0000u);
          v[i].z += __uint_as_float(q.y << 16); v[i].w += __uint_as_float(q.y & 0xffff0000u);
        }
      }
    }
    float ss = 0.f;
#pragma unroll
    for (int i = 0; i < 4; ++i) ss += v[i].x * v[i].x + v[i].y * v[i].y + v[i].z * v[i].z + v[i].w * v[i].w;
    ss = wave_sum(ss);
    const float rstd = rsqrtf(ss * (1.f / DM) + 1e-6f);
#pragma unroll
    for (int i = 0; i < 4; ++i) {
      const int c = (i * 64 + lane) * 4;
      const float4 ww = *reinterpret_cast<const float4*>(w + c);
      if (FINAL) {
        *reinterpret_cast<float4*>(f_out + (size_t)t * DM + c) = make_float4(v[i].x * rstd * ww.x, v[i].y * rstd * ww.y, v[i].z * rstd * ww.z, v[i].w * rstd * ww.w);
      } else {
        *reinterpret_cast<float4*>(xnew + (size_t)t * DM + c) = v[i];
        uint2 o;
        o.x = pack2(v[i].x * rstd * ww.x, v[i].y * rstd * ww.y);
        o.y = pack2(v[i].z * rstd * ww.z, v[i].w * rstd * ww.w);
        *reinterpret_cast<uint2*>(hn_out + (size_t)t * DM + c) = o;
      }
    }
  }
}

__global__ void __launch_bounds__(NTHR) mk(Params p) {
  extern __shared__ __attribute__((aligned(16))) char smem[];
  cg::grid_group grid = cg::this_grid();
  __shared__ uint4 xb_words;
  if (threadIdx.x == 0) xb_words = make_uint4(0u, 0u, 0u, 0u);
  __syncthreads();
  XcdBarrier xb = xcd_barrier_post(p.bar, (volatile LAS unsigned*)&xb_words);
  for (int rep = 0; rep < p.rep[0]; ++rep) ph_convert(p, smem);
  grid.sync();
  for (int L = 0; L < 2; ++L) {
    const float* xin = (L == 0) ? p.x : p.xres2;
    float* xout = p.xres;
    for (int rep = 0; rep < p.rep[1]; ++rep) {
      if (L == 0) ph_rmsnorm_bf16(xin, p.ln1_w, p.hn);
      else ph_combine_norm<false>(p, p.xres, p.xres2, p.ln1_w + DM, p.hn, nullptr);
    }
    xcd_barrier(xb);
    for (int rp = 0; rp < p.rep[3]; ++rp) {
      for (int rep = 0; rep < p.rep[2]; ++rep) ph_inproj(p, L, smem);
      xcd_barrier(xb);
      ph_post(p, L);
      xcd_barrier(xb);
    }
    for (int rep = 0; rep < p.rep[12]; ++rep) xcd_barrier(xb);
    {
      unsigned* ctr = p.bar + XCD_BAR_WORDS + 8 + L;
      __shared__ int q1_item;
      for (;;) {
        if (threadIdx.x == 0) q1_item = (int)atomicAdd(ctr, 1u);
        __syncthreads();
        const int it = q1_item;
        __syncthreads();
        if (it >= 1344) break;
        if (it < 256) ph_dil_pass<0>(p, smem, it);
        else if (it < 384) ph_ssd_a(p, L, smem, it - 256);
        else if (it < 576) ph_mla_up_q(p, L, smem, it - 384);
        else if (it < 832) ph_mla_up_kv(p, L, smem, it - 576);
        else ph_ret_a(p, smem, it - 832);
      }
    }
    xcd_barrier(xb);
    for (int rep = 0; rep < p.rep[5]; ++rep) {
      for (int r2 = 0; r2 < p.rep[13]; ++r2) { ph_ret_scan(p); ph_ssd_scan(p); }
      for (int r2 = 0; r2 < p.rep[14]; ++r2) ph_mla_attn(p, smem);
      for (int r2 = 0; r2 < p.rep[15]; ++r2) for (int bi = obid(); bi < 256; bi += gridDim.x) ph_dil_pass<1>(p, smem, bi);
    }
    xcd_barrier(xb);
    {
      unsigned* ctr = p.bar + XCD_BAR_WORDS + L;
      __shared__ int q_item;
      for (;;) {
        if (threadIdx.x == 0) q_item = (int)atomicAdd(ctr, 1u);
        __syncthreads();
        const int it = q_item;
        __syncthreads();
        if (it >= 640) break;
        if (it < 128) ph_ssd_c(p, L, smem, it);
        else ph_ret_c(p, smem, it - 128);
      }
    }
    xcd_barrier(xb);
    for (int rep = 0; rep < p.rep[7]; ++rep) ph_outproj(p, L, xin, xout, smem);
    xcd_barrier(xb);
    for (int rep = 0; rep < p.rep[8]; ++rep) ph_rms2_router(p, L, xout, smem);
    xcd_barrier(xb);
    for (int rep = 0; rep < p.rep[9]; ++rep) ph_topk(p, smem);
    xcd_barrier(xb);
    for (int rep = 0; rep < p.rep[10]; ++rep) ph_moe1(p, L, smem);
    xcd_barrier(xb);
    for (int rep = 0; rep < p.rep[11]; ++rep) ph_moe2(p, L, smem);
    xcd_barrier(xb);
  }
  ph_combine_norm<true>(p, p.xres, nullptr, p.final_w, nullptr, p.out);
}

extern "C" void kernel_launch(void* const* d_in, const int* in_sizes, int n_in, void* d_out, int out_size, void* d_ws,
                              size_t ws_size, hipStream_t stream) {
  static int grid_blocks = 0;
  if (!grid_blocks) {
    int dev = 0, cus = 0, per_cu = 0;
    (void)hipGetDevice(&dev);
    (void)hipDeviceGetAttribute(&cus, hipDeviceAttributeMultiprocessorCount, dev);
    (void)hipFuncSetAttribute((const void*)mk, hipFuncAttributeMaxDynamicSharedMemorySize, LDS_BYTES);
    (void)hipOccupancyMaxActiveBlocksPerMultiprocessor(&per_cu, (const void*)mk, NTHR, LDS_BYTES);
    if (per_cu < 1) { fprintf(stderr, "occupancy query says %d blocks/CU\n", per_cu); per_cu = 1; }
    grid_blocks = cus * 1;
  }
  Params p{};
  const float** fp = reinterpret_cast<const float**>(&p);
  for (int i = 0; i < 20; ++i) fp[i] = (const float*)d_in[i];
  p.out = (float*)d_out;
  char* w = (char*)d_ws;
  size_t off = 0;
  auto take = [&](size_t bytes) { char* r = w + off; off += (bytes + 255) & ~(size_t)255; return r; };
  p.WinT = (u16*)take((size_t)2 * PWP * DM * 2);
  p.WuqT = (u16*)take((size_t)2 * 384 * 256 * 2);
  p.WukvT = (u16*)take((size_t)2 * 512 * 128 * 2);
  p.WoutT = (u16*)take((size_t)2 * DM * DM * 2);
  p.WguT = (u16*)take((size_t)2 * 16 * 4096 * DM * 2);
  p.WdT = (u16*)take((size_t)2 * 16 * DM * 2048 * 2);
  p.xres = (float*)take((size_t)T * DM * 4);
  p.hn = (u16*)take((size_t)T * DM * 2);
  p.proj = (u16*)take((size_t)T * PWP * 2);
  p.cqn = (u16*)take((size_t)T * 256 * 2);
  p.ckvn = (u16*)take((size_t)T * 128 * 2);
  p.mq = (u16*)take((size_t)T * 384 * 2);
  p.mkv = nullptr;
  p.xbc = (u16*)take((size_t)T * 768 * 2);
  p.mixed = (u16*)take((size_t)T * DM * 2);
  p.hid = (u16*)take((size_t)32768 * 2048 * 2);
  p.kfull = (u16*)take((size_t)T * 4 * 96 * 2);
  p.rS = (u16*)take((size_t)16 * 32 * 2 * 4096 * 2);
  p.sS = (u16*)take((size_t)128 * 8 * 8192 * 2);
  p.rU = (float*)take((size_t)16 * 32 * 2 * 4096 * 4);
  p.sU = (float*)take((size_t)128 * 8 * 8192 * 4);
  p.cdec = (float*)take((size_t)128 * 8 * 4);
  p.vT = (u16*)take((size_t)T * 4 * 64 * 2);
  p.rtab = (float*)take((size_t)SEQ * 56 * 2 * 4);
  p.dpart = (float*)take((size_t)T * 4 * 68 * 4);
  p.dtv = (float*)take((size_t)T * 8 * 4);
  p.cs = (float*)take((size_t)T * 8 * 4);
  p.ybuf = (float*)take((size_t)T * 256 * 4);
  p.aff = (float*)take((size_t)T * 16 * 4);
  p.gate = (float*)take((size_t)64 * 512 * 4);
  p.tok = (int*)take((size_t)64 * 512 * 4);
  p.inv = (int*)take((size_t)T * 16 * 4);
  p.bar = (unsigned*)take((size_t)(XCD_BAR_WORDS + 64) * 4);
  p.xres2 = (float*)take((size_t)T * DM * 4);
  { const int reps[16] = REPS_INIT; for (int i = 0; i < 16; ++i) p.rep[i] = reps[i]; }
  if (off > ws_size) { fprintf(stderr, "workspace too small: need %zu have %zu\n", off, ws_size); return; }
  (void)hipMemsetAsync(p.bar, 0, (size_t)(XCD_BAR_WORDS + 64) * 4, stream);
  void* args[] = {&p};
  hipError_t e = hipLaunchCooperativeKernel((void*)mk, dim3(grid_blocks), dim3(NTHR), args, LDS_BYTES, stream);
  if (e != hipSuccess) fprintf(stderr, "cooperative launch failed: %s (grid %d)\n", hipGetErrorString(e), grid_blocks);
}
```

```cpp
#include <hip/hip_runtime.h>
#include <hip/hip_cooperative_groups.h>
#include <cstdio>
#include <cstdint>
namespace cg = cooperative_groups;

#define DI __device__ __forceinline__
typedef unsigned short u16;
typedef __attribute__((ext_vector_type(8))) short bf16x8;
typedef __attribute__((ext_vector_type(4))) float f32x4;

#ifndef REPS_INIT
#define REPS_INIT {1, 1, 1, 1, 1, 1, 1, 1, 1, 1, 1, 1, 0, 1, 1, 1}
#endif
constexpr int NTHR = 512;
constexpr int T = 16384, SEQ = 4096, DM = 1024;
constexpr int PW = 3240, PWP = 3328;
constexpr int C_RQ = 0, C_RK = 256, C_RV = 512, C_RG = 768, C_CQ = 1024, C_CKV = 1280, C_KR = 1408,
              C_Z = 1440, C_XBC = 1696, C_DT = 2464, C_DQ = 2472, C_DK = 2728, C_DV = 2984;
constexpr int LDS_BYTES = 132096;

struct Params {
  const float *x, *ln1_w, *w_in, *q_norm_w, *kv_norm_w, *w_uq, *w_ukv, *conv_w, *conv_b, *a_log, *dt_bias,
      *ssm_d, *ssm_norm_w, *w_out, *ln2_w, *router_w, *w_gate, *w_up, *w_down, *final_w;
  float* out;
  u16 *WinT, *WuqT, *WukvT, *WoutT, *WguT, *WdT;
  float* xres;
  u16 *hn, *proj, *cqn, *ckvn, *mq, *mkv, *xbc, *mixed, *hid, *kfull, *vT, *rS, *sS;
  float *dtv, *cs, *ybuf, *aff, *gate, *rU, *sU, *cdec, *rtab, *dpart;
  int* tok;
  int* inv;
  unsigned* bar;
  float* xres2;
  int rep[16];
};

typedef __attribute__((ext_vector_type(2))) __bf16 bf16x2_t;
typedef __attribute__((ext_vector_type(2))) float f32x2_t;
typedef __attribute__((ext_vector_type(16))) float f32x16;
typedef __attribute__((ext_vector_type(4))) short s16x4;
DI unsigned pack2(float a, float b) {
  f32x2_t v = {a, b};
  return __builtin_bit_cast(unsigned, __builtin_convertvector(v, bf16x2_t));
}
DI u16 f2bf(float f) { return (u16)(pack2(f, 0.f) & 0xffffu); }
DI float bf2f(u16 h) { return __uint_as_float(((unsigned)h) << 16); }
DI void unpack8(const uint4& v, float* f) {
  f[0] = __uint_as_float(v.x << 16); f[1] = __uint_as_float(v.x & 0xffff0000u);
  f[2] = __uint_as_float(v.y << 16); f[3] = __uint_as_float(v.y & 0xffff0000u);
  f[4] = __uint_as_float(v.z << 16); f[5] = __uint_as_float(v.z & 0xffff0000u);
  f[6] = __uint_as_float(v.w << 16); f[7] = __uint_as_float(v.w & 0xffff0000u);
}
DI void ld8(const u16* p, float* f) { uint4 v = *reinterpret_cast<const uint4*>(p); unpack8(v, f); }
DI float wave_sum(float v) {
#pragma unroll
  for (int o = 32; o > 0; o >>= 1) v += __shfl_xor(v, o);
  return v;
}
DI float dot2acc(unsigned a, unsigned b, float c) {
  return __builtin_amdgcn_fdot2_f32_bf16(__builtin_bit_cast(bf16x2_t, a), __builtin_bit_cast(bf16x2_t, b), c, false);
}
DI float dot8(const uint4& a, const uint4& b, float c) {
  c = dot2acc(a.x, b.x, c); c = dot2acc(a.y, b.y, c); c = dot2acc(a.z, b.z, c); c = dot2acc(a.w, b.w, c);
  return c;
}
DI int otid() { int t = threadIdx.x; asm volatile("" : "+v"(t)); return t; }
DI int obid() { int b = blockIdx.x; asm volatile("" : "+s"(b)); return b; }
DI float silu(float x) { return x / (1.f + __expf(-x)); }
DI float fast_silu(float x) { return x * __builtin_amdgcn_rcpf(1.f + __expf(-x)); }


#define XB_TMO      128
#define XB_XCNT(j)  (256  + 64 * (j))
#define XB_XSUB(j)  (1280 + 64 * (j))
#define XB_XGEN(j)  (2304 + 64 * (j))
#define XB_TOP      3328
#define XB_TOPGEN   3392
#define XCD_BAR_WORDS 3456
#define XB_SPIN_CAP (1u << 20)
#define LAS __attribute__((address_space(3)))
DI unsigned xb_ld(unsigned* p) { return __hip_atomic_load(p, __ATOMIC_RELAXED, __HIP_MEMORY_SCOPE_AGENT); }
DI unsigned xb_add(unsigned* p, unsigned v) { return __hip_atomic_fetch_add(p, v, __ATOMIC_RELAXED, __HIP_MEMORY_SCOPE_AGENT); }
DI unsigned xb_xcc_id() { return (unsigned)__builtin_amdgcn_s_getreg((3 << 11) | 20) & 0xFu; }
#define XB_SPIN(cond, bar) do { unsigned _sp = 0; while (cond) { __builtin_amdgcn_s_sleep(1); \
    if ((++_sp & 255u) == 0u) { if (xb_ld(&(bar)[XB_TMO])) break; if (_sp > XB_SPIN_CAP) { atomicAdd(&(bar)[XB_TMO], 1u); break; } } } } while (0)
struct XcdBarrier { unsigned* bar; unsigned x; volatile LAS unsigned* st; };
DI XcdBarrier xcd_barrier_post(unsigned* bar, volatile LAS unsigned* st) {
  XcdBarrier b; b.bar = bar; b.x = xb_xcc_id(); b.st = st;
  if (threadIdx.x == 0) (void)xb_add(&bar[XB_XCNT(b.x)], 1u);
  return b;
}
DI void xcd_barrier_complete(unsigned* bar, unsigned x, unsigned& nloc, unsigned& nx) {
  const unsigned G = gridDim.x * gridDim.y * gridDim.z;
  unsigned sum, cnt, mine, sp = 0u;
  for (;;) {
    sum = 0u; cnt = 0u; mine = 0u;
#pragma unroll
    for (unsigned j = 0; j < 16; ++j) { const unsigned c = xb_ld(&bar[XB_XCNT(j)]); sum += c; cnt += (c > 0u) ? 1u : 0u; mine = (j == x) ? c : mine; }
    if (sum == G) break;
    __builtin_amdgcn_s_sleep(1);
    if ((++sp & 255u) == 0u) { if (xb_ld(&bar[XB_TMO])) break; if (sp > XB_SPIN_CAP) { atomicAdd(&bar[XB_TMO], 1u); break; } }
  }
  nloc = mine > 0u ? mine : 1u; nx = cnt > 0u ? cnt : 1u;
}
DI void xcd_barrier(const XcdBarrier& b) {
  asm volatile("s_waitcnt vmcnt(0)" ::: "memory");
  __syncthreads();
  if (threadIdx.x == 0) {
    unsigned* bar = b.bar;
    __builtin_amdgcn_s_waitcnt(0);
    unsigned nloc = b.st[0], nx = b.st[1];
    if (nloc == 0u) { xcd_barrier_complete(bar, b.x, nloc, nx); b.st[0] = nloc; b.st[1] = nx; }
    const unsigned old = xb_add(&bar[XB_XSUB(b.x)], 1u);
    const unsigned gen = old / nloc;
    if (old + 1u == (gen + 1u) * nloc) {
      __builtin_amdgcn_fence(__ATOMIC_RELEASE, "agent");
      asm volatile("s_waitcnt vmcnt(0)" ::: "memory");
      const unsigned og = xb_add(&bar[XB_TOP], 1u);
      const unsigned tg = og / nx;
      if (og + 1u == (tg + 1u) * nx) xb_add(&bar[XB_TOPGEN], 1u);
      else XB_SPIN(xb_ld(&bar[XB_TOPGEN]) == tg, bar);
      __builtin_amdgcn_fence(__ATOMIC_ACQUIRE, "agent");
      xb_add(&bar[XB_XGEN(b.x)], 1u);
      asm volatile("s_waitcnt vmcnt(0)" ::: "memory");
    } else {
      XB_SPIN(xb_ld(&bar[XB_XGEN(b.x)]) == gen, bar);
      __builtin_amdgcn_fence(__ATOMIC_ACQUIRE, "agent");
      asm volatile("s_waitcnt vmcnt(0)" ::: "memory");
    }
  }
  __syncthreads();
}

template <class F>
DI void transpose_convert(const float* __restrict__ src, int K, int N, int Npad, u16* __restrict__ dst, F rowmap,
                          int bid, int nb, char* smem) {
  u16* tile = reinterpret_cast<u16*>(smem);
  const int tid = otid();
  const int ntn = Npad / 64, ntk = K / 64;
  for (int t = bid; t < ntn * ntk; t += nb) {
    const int n0 = (t % ntn) * 64, k0 = (t / ntn) * 64;
#pragma unroll
    for (int i = 0; i < 2; ++i) {
      const int kk = (tid >> 4) + 32 * i, nn = (tid & 15) * 4;
      float4 v = make_float4(0.f, 0.f, 0.f, 0.f);
      if (n0 + nn < N) { const f32x4 t4 = __builtin_nontemporal_load(reinterpret_cast<const f32x4*>(src + (size_t)(k0 + kk) * N + n0 + nn)); v = make_float4(t4[0], t4[1], t4[2], t4[3]); }
      tile[(nn + 0) * 72 + kk] = f2bf(v.x); tile[(nn + 1) * 72 + kk] = f2bf(v.y);
      tile[(nn + 2) * 72 + kk] = f2bf(v.z); tile[(nn + 3) * 72 + kk] = f2bf(v.w);
    }
    __syncthreads();
    {
      const int nn = tid >> 3, k8 = (tid & 7) * 8;
      uint4 v = *reinterpret_cast<const uint4*>(tile + nn * 72 + k8);
      *reinterpret_cast<uint4*>(dst + (size_t)rowmap(n0 + nn) * K + k0 + k8) = v;
    }
    __syncthreads();
  }
}

DI void ph_convert(const Params& p, char* smem) {
  const int nb = gridDim.x;
  int bid = obid();
  for (int idx = bid * NTHR + otid(); idx < SEQ * 56; idx += nb * NTHR) {
    const int pos = idx / 56, f = idx - pos * 56;
    float inv;
    if (f < 32) inv = exp2f(-(float)f * (13.287712379549449f / 32.f));
    else if (f < 40) inv = exp2f(-(float)(f - 32) * (18.931568569324174f / 8.f));
    else inv = exp2f(-(float)(f - 40) * (18.931568569324174f / 16.f));
    float sn, cs;
    sincosf((float)pos * inv, &sn, &cs);
    p.rtab[(size_t)idx * 2] = cs;
    p.rtab[(size_t)idx * 2 + 1] = sn;
  }
  auto ident = [](int n) { return n; };
  for (int L = 0; L < 2; ++L) {
    transpose_convert(p.w_in + (size_t)L * DM * PW, DM, PW, PWP, p.WinT + (size_t)L * PWP * DM, ident, bid, nb, smem);
    transpose_convert(p.w_uq + (size_t)L * 256 * 384, 256, 384, 384, p.WuqT + (size_t)L * 384 * 256, ident, bid, nb, smem);
    transpose_convert(p.w_ukv + (size_t)L * 128 * 512, 128, 512, 512, p.WukvT + (size_t)L * 512 * 128, ident, bid, nb, smem);
    transpose_convert(p.w_out + (size_t)L * DM * DM, DM, DM, DM, p.WoutT + (size_t)L * DM * DM, ident, bid, nb, smem);
    for (int e = 0; e < 16; ++e) {
      const size_t le = (size_t)(L * 16 + e);
      auto gmap = [](int n) { return (n >> 7) * 256 + (n & 127); };
      auto umap = [](int n) { return (n >> 7) * 256 + 128 + (n & 127); };
      transpose_convert(p.w_gate + le * DM * 2048, DM, 2048, 2048, p.WguT + le * 4096 * DM, gmap, bid, nb, smem);
      transpose_convert(p.w_up + le * DM * 2048, DM, 2048, 2048, p.WguT + le * 4096 * DM, umap, bid, nb, smem);
      transpose_convert(p.w_down + le * 2048 * DM, 2048, DM, DM, p.WdT + le * DM * 2048, ident, bid, nb, smem);
    }
  }
}

template <class RowPtr, class Epi>
DI void gemm_tile(RowPtr arow, const u16* __restrict__ bt, int ldb, int K, char* smem, Epi epi) {
  u16* sa = reinterpret_cast<u16*>(smem);
  u16* sb = sa + 2 * 256 * 72;
  const int tid = otid(), wid = tid >> 6, lane = tid & 63, wr = wid >> 1, wc = wid & 1, fr = lane & 15, fq = lane >> 4;
  f32x4 acc[4][4];
#pragma unroll
  for (int m = 0; m < 4; ++m)
#pragma unroll
    for (int n = 0; n < 4; ++n) acc[m][n] = f32x4{0.f, 0.f, 0.f, 0.f};
  const int lr = tid >> 3, lc = (tid & 7) * 8;
  const u16* ap[4];
#pragma unroll
  for (int i = 0; i < 4; ++i) ap[i] = arow(lr + 64 * i) + lc;
  const u16* bp[2];
#pragma unroll
  for (int i = 0; i < 2; ++i) bp[i] = bt + (size_t)(lr + 64 * i) * ldb + lc;
  uint4 ra[4], rb[2];
  const int nk = K / 64;
#pragma unroll
  for (int i = 0; i < 4; ++i) ra[i] = *reinterpret_cast<const uint4*>(ap[i]);
#pragma unroll
  for (int i = 0; i < 2; ++i) rb[i] = *reinterpret_cast<const uint4*>(bp[i]);
#pragma unroll
  for (int i = 0; i < 4; ++i) *reinterpret_cast<uint4*>(sa + (lr + 64 * i) * 72 + lc) = ra[i];
#pragma unroll
  for (int i = 0; i < 2; ++i) *reinterpret_cast<uint4*>(sb + (lr + 64 * i) * 72 + lc) = rb[i];
  __syncthreads();
  for (int kt = 0; kt < nk; ++kt) {
    const int cur = kt & 1;
    if (kt + 1 < nk) {
#pragma unroll
      for (int i = 0; i < 4; ++i) ra[i] = *reinterpret_cast<const uint4*>(ap[i] + (kt + 1) * 64);
#pragma unroll
      for (int i = 0; i < 2; ++i) rb[i] = *reinterpret_cast<const uint4*>(bp[i] + (kt + 1) * 64);
    }
    const u16* ca = sa + cur * 256 * 72;
    const u16* cb = sb + cur * 128 * 72;
#pragma unroll
    for (int kk = 0; kk < 2; ++kk) {
      bf16x8 af[4], bfr[4];
#pragma unroll
      for (int m = 0; m < 4; ++m) af[m] = *reinterpret_cast<const bf16x8*>(ca + (wr * 64 + m * 16 + fr) * 72 + kk * 32 + fq * 8);
#pragma unroll
      for (int n = 0; n < 4; ++n) bfr[n] = *reinterpret_cast<const bf16x8*>(cb + (wc * 64 + n * 16 + fr) * 72 + kk * 32 + fq * 8);
#pragma unroll
      for (int m = 0; m < 4; ++m)
#pragma unroll
        for (int n = 0; n < 4; ++n) acc[m][n] = __builtin_amdgcn_mfma_f32_16x16x32_bf16(af[m], bfr[n], acc[m][n], 0, 0, 0);
    }
    if (kt + 1 < nk) {
      u16* na = sa + (cur ^ 1) * 256 * 72;
      u16* nbp = sb + (cur ^ 1) * 128 * 72;
#pragma unroll
      for (int i = 0; i < 4; ++i) *reinterpret_cast<uint4*>(na + (lr + 64 * i) * 72 + lc) = ra[i];
#pragma unroll
      for (int i = 0; i < 2; ++i) *reinterpret_cast<uint4*>(nbp + (lr + 64 * i) * 72 + lc) = rb[i];
    }
    __syncthreads();
  }
  epi(acc, wr, wc, fr, fq);
}

#define WAIT_V(n) asm volatile("s_waitcnt vmcnt(%0)" ::"n"(n) : "memory")
DI int lds_byte2(int r, int c) {
  const int st = (r >> 4) * 2 + (c >> 5), ob = (r & 15) * 64 + (c & 31) * 2;
  return st * 1024 + (ob ^ (((ob >> 9) & 1) << 5));
}
DI void stage_rc2(int b, int& R, int& C) {
  const int st = b >> 10, sb = b & 1023, swz = sb ^ (((sb >> 9) & 1) << 5);
  R = (st >> 1) * 16 + swz / 64;
  C = (st & 1) * 32 + (swz % 64) / 2;
}
typedef __attribute__((address_space(3))) unsigned lds_u32;
template <class RowPtr, class Epi>
DI void gemm256(RowPtr arow, const u16* __restrict__ bt, int ldb, int K, char* smem, Epi epi) {
  constexpr int TILE_B = 256 * 64 * 2, STAGE_B = 2 * TILE_B;
  const int tid = otid(), wid = tid >> 6, lane = tid & 63, wr = wid >> 2, wc = wid & 3, fr = lane & 15, fq = lane >> 4;
  const u16* ap[4];
  const u16* bp[4];
#pragma unroll
  for (int i = 0; i < 4; ++i) {
    int R, C;
    stage_rc2(wid * 1024 + i * 8192 + lane * 16, R, C);
    ap[i] = arow(R) + C;
    bp[i] = bt + (size_t)R * ldb + C;
  }
  f32x4 acc[8][4];
#pragma unroll
  for (int m = 0; m < 8; ++m)
#pragma unroll
    for (int n = 0; n < 4; ++n) acc[m][n] = f32x4{0.f, 0.f, 0.f, 0.f};
#define G2_STAGE(buf, kt)                                                                                              \
  do {                                                                                                                 \
    _Pragma("unroll") for (int i = 0; i < 4; ++i) {                                                                    \
      __builtin_amdgcn_global_load_lds((const unsigned*)(ap[i] + (kt) * 64),                                           \
                                       (lds_u32*)(smem + (buf) * STAGE_B + wid * 1024 + i * 8192), 16, 0, 0);          \
      __builtin_amdgcn_global_load_lds((const unsigned*)(bp[i] + (kt) * 64),                                           \
                                       (lds_u32*)(smem + (buf) * STAGE_B + TILE_B + wid * 1024 + i * 8192), 16, 0, 0); \
    }                                                                                                                  \
  } while (0)
  const int nt = K / 64;
  G2_STAGE(0, 0);
  WAIT_V(0);
  __syncthreads();
  for (int t = 0; t < nt; ++t) {
    const int cur = t & 1;
    if (t + 1 < nt) G2_STAGE(cur ^ 1, t + 1);
    const char* sA = smem + cur * STAGE_B;
    const char* sB = sA + TILE_B;
#pragma unroll
    for (int ks = 0; ks < 2; ++ks) {
      bf16x8 At[8], Bf[4];
#pragma unroll
      for (int m = 0; m < 8; ++m) At[m] = *reinterpret_cast<const bf16x8*>(sA + lds_byte2(wr * 128 + m * 16 + fr, ks * 32 + fq * 8));
#pragma unroll
      for (int n = 0; n < 4; ++n) Bf[n] = *reinterpret_cast<const bf16x8*>(sB + lds_byte2(wc * 64 + n * 16 + fr, ks * 32 + fq * 8));
#pragma unroll
      for (int m = 0; m < 8; ++m)
#pragma unroll
        for (int n = 0; n < 4; ++n) acc[m][n] = __builtin_amdgcn_mfma_f32_16x16x32_bf16(Bf[n], At[m], acc[m][n], 0, 0, 0);
      __builtin_amdgcn_sched_barrier(0);
    }
    WAIT_V(0);
    __syncthreads();
  }
  epi(acc, wr, wc, fr, fq);
}

namespace pg8 {
constexpr int BM = 256, BK = 64, HALF = 128, HTB = HALF * BK * 2;
DI int lds_byte(int r, int c) { const int st = (r >> 4) * 2 + (c >> 5), rr = r & 15, cc = c & 31, ob = rr * 64 + cc * 2; return st * 1024 + (ob ^ (((ob >> 9) & 1) << 5)); }
DI void stage_rc(int b, int& R, int& C) { const int st = b / 1024, sb = b % 1024, swz = sb ^ (((sb >> 9) & 1) << 5); R = (st >> 1) * 16 + swz / 64; C = (st & 1) * 32 + (swz % 64) / 2; }
DI int perm32(int rho) { const int n = rho >> 4, i = rho & 15; return 8 * (i >> 2) + 4 * n + (i & 3); }
struct Unit { int pm, pn; };
typedef __attribute__((address_space(3))) unsigned char lds_u8;
typedef __attribute__((address_space(3))) unsigned lds_u32;
typedef __attribute__((address_space(3))) bf16x8 lds_bf16x8;

template <class Cfg>
DI void gemm_phase(lds_u8* lds, const Cfg& S) {
  const int tid = otid(), wid = __builtin_amdgcn_readfirstlane(tid >> 6), lane = tid & 63, wr = wid >> 2, wc = wid & 3, fr = lane & 15, fq = lane >> 4;
  const int K = S.K, nt = K / BK;
  int R0, C0, R1, C1;
  stage_rc(tid * 16, R0, C0);
  stage_rc(tid * 16 + 8192, R1, C1);
  unsigned voffB[2];
  {
    const int Rb0 = Cfg::PERM ? ((R0 & ~31) + perm32(R0 & 31)) : R0, Rb1 = Cfg::PERM ? ((R1 & ~31) + perm32(R1 & 31)) : R1;
    voffB[0] = (unsigned)(Rb0 * K + C0) * 2u; voffB[1] = (unsigned)(Rb1 * K + C1) * 2u;
  }
  const size_t kstep = (size_t)(BK * 2);
  const size_t hstep = (size_t)HALF * K * 2;
  const unsigned ldsw = (unsigned)wid * 1024u;
  const int aoff = lds_byte(wr * 64 + fr, fq * 8), boff = lds_byte(wc * 32 + fr, fq * 8);
#define PG8_SA(b, h) (((b) * 2 + (h)) * HTB)
#define PG8_SB(b, h) ((4 + (b) * 2 + (h)) * HTB)
#define PG8_STAGE2(bufoff, gbase, o0, o1) do { \
    __builtin_amdgcn_global_load_lds((const unsigned*)((const char*)(gbase) + (o0)), (lds_u32*)(lds + (bufoff) + ldsw), 16, 0, 0); \
    __builtin_amdgcn_global_load_lds((const unsigned*)((const char*)(gbase) + (o1)), (lds_u32*)(lds + (bufoff) + ldsw + 8192), 16, 0, 0); } while (0)
#define PG8_STAGEB(bufoff, gbase) PG8_STAGE2(bufoff, gbase, voffB[0], voffB[1])
#define PG8_LDA(dst, b, h) do { _Pragma("unroll") for (int m = 0; m < 4; ++m) _Pragma("unroll") for (int k = 0; k < 2; ++k) dst[m][k] = *(const lds_bf16x8*)(lds + PG8_SA(b, h) + aoff + m * 2048 + k * 1024); } while (0)
#define PG8_LDB(dst, b, h) do { _Pragma("unroll") for (int n = 0; n < 2; ++n) _Pragma("unroll") for (int k = 0; k < 2; ++k) dst[n][k] = *(const lds_bf16x8*)(lds + PG8_SB(b, h) + boff + n * 2048 + k * 1024); } while (0)
#define PG8_MMA(ai, bj, At, Bt) do { __builtin_amdgcn_s_setprio(1); _Pragma("unroll") for (int m = 0; m < 4; ++m) _Pragma("unroll") for (int n = 0; n < 2; ++n) _Pragma("unroll") for (int k = 0; k < 2; ++k) \
    acc[ai][bj][m][n] = __builtin_amdgcn_mfma_f32_16x16x32_bf16(Bt[n][k], At[m][k], acc[ai][bj][m][n], 0, 0, 0); __builtin_amdgcn_s_setprio(0); } while (0)
#define PG8_WAIT_V(n) asm volatile("s_waitcnt vmcnt(" #n ")" ::: "memory")
#define PG8_WAIT_L(n) asm volatile("s_waitcnt lgkmcnt(" #n ")" ::: "memory")
#define PG8_BAR __builtin_amdgcn_s_barrier()
#define PG8_SCHED __builtin_amdgcn_sched_barrier(0)
  Unit cur, nxt; int ui = 0;
  if (!S.next(0, cur)) return;
  f32x4 acc[2][2][4][2];
#pragma unroll
  for (int a = 0; a < 2; ++a)
#pragma unroll
    for (int b = 0; b < 2; ++b)
#pragma unroll
      for (int m = 0; m < 4; ++m)
#pragma unroll
        for (int n = 0; n < 2; ++n) acc[a][b][m][n] = f32x4{0.f, 0.f, 0.f, 0.f};
  bf16x8 At[4][2], B0[2][2], B1[2][2];
  const char* cA = S.a_base(cur);
  const char* cB = S.b_base(cur);
  unsigned vc[4], vn[4];
  S.a_off(cur, R0, C0, R1, C1, vc);
  PG8_STAGEB(PG8_SB(0, 0), cB); PG8_STAGE2(PG8_SA(0, 0), cA, vc[0], vc[1]); PG8_STAGEB(PG8_SB(0, 1), cB + hstep); PG8_STAGE2(PG8_SA(0, 1), cA, vc[2], vc[3]);
  if (wr == 1) PG8_BAR;
  PG8_WAIT_V(4); PG8_BAR;
  PG8_STAGEB(PG8_SB(1, 0), cB + kstep); PG8_STAGE2(PG8_SA(1, 0), cA + kstep, vc[0], vc[1]); PG8_STAGEB(PG8_SB(1, 1), cB + hstep + kstep);
  PG8_WAIT_V(6); PG8_BAR;
  for (;;) {
    const bool has_next = S.next(ui + 1, nxt);
    const char* nA = has_next ? S.a_base(nxt) : cA;
    const char* nB = has_next ? S.b_base(nxt) : cB;
    if (has_next) S.a_off(nxt, R0, C0, R1, C1, vn);
    else { vn[0] = vc[0]; vn[1] = vc[1]; vn[2] = vc[2]; vn[3] = vc[3]; }
    for (int t = 0; t < nt; t += 2) {
      const bool last = (t == nt - 2);
      const char* a1 = cA + (size_t)(t + 1) * kstep;
      const char* a2 = last ? nA : cA + (size_t)(t + 2) * kstep;
      const char* b2 = last ? nB : cB + (size_t)(t + 2) * kstep;
      const char* a3 = a2 + kstep;
      const char* b3 = b2 + kstep;
      const unsigned w0 = last ? vn[0] : vc[0], w1 = last ? vn[1] : vc[1], w2 = last ? vn[2] : vc[2], w3 = last ? vn[3] : vc[3];
      PG8_LDB(B0, 0, 0); PG8_SCHED; PG8_LDA(At, 0, 0); PG8_STAGE2(PG8_SA(1, 1), a1, vc[2], vc[3]);
      PG8_WAIT_L(8); PG8_BAR; PG8_WAIT_L(0); PG8_MMA(0, 0, At, B0); PG8_BAR; PG8_SCHED;
      PG8_LDB(B1, 0, 1); PG8_STAGEB(PG8_SB(0, 0), b2);
      PG8_BAR; PG8_WAIT_L(0); PG8_MMA(0, 1, At, B1); PG8_BAR;
      PG8_LDA(At, 0, 1); PG8_STAGE2(PG8_SA(0, 0), a2, w0, w1);
      PG8_BAR; PG8_WAIT_L(0); PG8_MMA(1, 0, At, B0); PG8_BAR; PG8_SCHED;
      PG8_STAGEB(PG8_SB(0, 1), b2 + hstep);
      PG8_WAIT_V(6); PG8_BAR; PG8_MMA(1, 1, At, B1); PG8_BAR;
      PG8_LDB(B0, 1, 0); PG8_SCHED; PG8_LDA(At, 1, 0); PG8_STAGE2(PG8_SA(0, 1), a2, w2, w3);
      PG8_WAIT_L(8); PG8_BAR; PG8_WAIT_L(0); PG8_MMA(0, 0, At, B0); PG8_BAR; PG8_SCHED;
      PG8_LDB(B1, 1, 1); PG8_STAGEB(PG8_SB(1, 0), b3);
      PG8_BAR; PG8_WAIT_L(0); PG8_MMA(0, 1, At, B1); PG8_BAR;
      PG8_LDA(At, 1, 1); PG8_STAGE2(PG8_SA(1, 0), a3, w0, w1);
      PG8_BAR; PG8_WAIT_L(0); PG8_MMA(1, 0, At, B0); PG8_BAR; PG8_SCHED;
      PG8_STAGEB(PG8_SB(1, 1), b3 + hstep);
      PG8_WAIT_V(6); PG8_BAR; PG8_MMA(1, 1, At, B1); PG8_BAR;
    }
    S.epi(acc, cur, wr, wc, fr, fq);
    if (!has_next) break;
#pragma unroll
    for (int a = 0; a < 2; ++a)
#pragma unroll
      for (int b = 0; b < 2; ++b)
#pragma unroll
        for (int m = 0; m < 4; ++m)
#pragma unroll
          for (int n = 0; n < 2; ++n) acc[a][b][m][n] = f32x4{0.f, 0.f, 0.f, 0.f};
    cur = nxt; cA = nA; cB = nB; ++ui;
    vc[0] = vn[0]; vc[1] = vn[1]; vc[2] = vn[2]; vc[3] = vn[3];
  }
  PG8_WAIT_V(0);
  if (wr == 0) PG8_BAR;
  PG8_BAR;
#undef PG8_SA
#undef PG8_SB
#undef PG8_STAGE2
#undef PG8_STAGEB
#undef PG8_LDA
#undef PG8_LDB
#undef PG8_MMA
#undef PG8_WAIT_V
#undef PG8_WAIT_L
#undef PG8_BAR
#undef PG8_SCHED
}
}

struct CfgInproj {
  static constexpr bool PERM = true;
  int K; const Params* p; int L; int bid, nb;
  DI bool next(int i, pg8::Unit& u) const { const int t = i * nb + bid; if (t >= 64 * 13) return false; u.pm = t & 63; u.pn = t >> 6; return true; }
  DI const char* a_base(const pg8::Unit& u) const { return (const char*)(p->hn + (size_t)u.pm * 256 * DM); }
  DI const char* b_base(const pg8::Unit& u) const { return (const char*)(p->WinT + ((size_t)L * PWP + (size_t)u.pn * 256) * DM); }
  DI void a_off(const pg8::Unit&, int R0, int C0, int R1, int C1, unsigned (&vo)[4]) const {
    vo[0] = (unsigned)(R0 * DM + C0) * 2u; vo[1] = (unsigned)(R1 * DM + C1) * 2u;
    vo[2] = vo[0] + 128u * DM * 2u; vo[3] = vo[1] + 128u * DM * 2u;
  }
  DI void epi(const f32x4 (&acc)[2][2][4][2], const pg8::Unit& u, int wr, int wc, int fr, int fq) const {
    const int row0 = u.pm * 256 + wr * 64 + fr, col0 = u.pn * 256 + wc * 32 + 8 * fq;
#pragma unroll
    for (int ai = 0; ai < 2; ++ai)
#pragma unroll
      for (int m = 0; m < 4; ++m) {
        u16* rowp = p->proj + (size_t)(row0 + ai * 128 + m * 16) * PWP + col0;
#pragma unroll
        for (int bj = 0; bj < 2; ++bj) {
          uint4 w;
          w.x = pack2(acc[ai][bj][m][0][0], acc[ai][bj][m][0][1]); w.y = pack2(acc[ai][bj][m][0][2], acc[ai][bj][m][0][3]);
          w.z = pack2(acc[ai][bj][m][1][0], acc[ai][bj][m][1][1]); w.w = pack2(acc[ai][bj][m][1][2], acc[ai][bj][m][1][3]);
          *reinterpret_cast<uint4*>(rowp + bj * 128) = w;
        }
      }
  }
};
DI void ph_inproj_tail(const Params& p, int L, char* smem, int t) {
  const int m0 = (t & 63) * 256, n0 = 3072 + (t >> 6) * 128;
  const u16* Bt = p.WinT + ((size_t)L * PWP + n0) * DM;
  gemm_tile([&](int r) { return p.hn + (size_t)(m0 + r) * DM; }, Bt, DM, DM, smem,
            [&](f32x4 (&acc)[4][4], int wr, int wc, int fr, int fq) {
#pragma unroll
              for (int m = 0; m < 4; ++m)
#pragma unroll
                for (int n = 0; n < 4; ++n)
#pragma unroll
                  for (int j = 0; j < 4; ++j)
                    p.proj[(size_t)(m0 + wr * 64 + m * 16 + fq * 4 + j) * PWP + n0 + wc * 64 + n * 16 + fr] = f2bf(acc[m][n][j]);
            });
}
DI void ph_inproj(const Params& p, int L, char* smem) {
  CfgInproj c; c.K = DM; c.p = &p; c.L = L; c.bid = obid(); c.nb = gridDim.x;
  pg8::gemm_phase((pg8::lds_u8*)smem, c);
}

DI void ph_gemm_store_bf16(const u16* A, int lda, const u16* Bt, int K, int M, int N, u16* C, int ldc, char* smem, int rot) {
  const int mt = M / 256, nt = N / 128;
  const int nb = gridDim.x;
  for (int t = (obid() + rot) % nb; t < mt * nt; t += nb) {
    const int m0 = (t % mt) * 256, n0 = (t / mt) * 128;
    gemm_tile([&](int r) { return A + (size_t)(m0 + r) * lda; }, Bt + (size_t)n0 * K, K, K, smem,
              [&](f32x4 (&acc)[4][4], int wr, int wc, int fr, int fq) {
#pragma unroll
                for (int m = 0; m < 4; ++m)
#pragma unroll
                  for (int n = 0; n < 4; ++n)
#pragma unroll
                    for (int j = 0; j < 4; ++j) {
                      const int row = m0 + wr * 64 + m * 16 + fq * 4 + j, col = n0 + wc * 64 + n * 16 + fr;
                      C[(size_t)row * ldc + col] = f2bf(acc[m][n][j]);
                    }
              });
  }
}

DI void ph_rmsnorm_bf16(const float* __restrict__ xin, const float* __restrict__ w, u16* __restrict__ outp) {
  const int tid_ = otid(); const int lane = tid_ & 63, gw = (obid() * NTHR + tid_) >> 6, nw = gridDim.x * (NTHR / 64);
  for (int t = gw; t < T; t += nw) {
    const float* xr = xin + (size_t)t * DM;
    float4 v[4];
    float ss = 0.f;
#pragma unroll
    for (int i = 0; i < 4; ++i) {
      v[i] = *reinterpret_cast<const float4*>(xr + (i * 64 + lane) * 4);
      ss += v[i].x * v[i].x + v[i].y * v[i].y + v[i].z * v[i].z + v[i].w * v[i].w;
    }
    ss = wave_sum(ss);
    const float rstd = rsqrtf(ss * (1.f / DM) + 1e-6f);
#pragma unroll
    for (int i = 0; i < 4; ++i) {
      const int c = (i * 64 + lane) * 4;
      const float4 ww = *reinterpret_cast<const float4*>(w + c);
      uint2 o;
      o.x = pack2(v[i].x * rstd * ww.x, v[i].y * rstd * ww.y);
      o.y = pack2(v[i].z * rstd * ww.z, v[i].w * rstd * ww.w);
      *reinterpret_cast<uint2*>(outp + (size_t)t * DM + c) = o;
    }
  }
}

DI void ph_final_norm(const float* __restrict__ xin, const float* __restrict__ w, float* __restrict__ outp) {
  const int tid_ = otid(); const int lane = tid_ & 63, gw = (obid() * NTHR + tid_) >> 6, nw = gridDim.x * (NTHR / 64);
  for (int t = gw; t < T; t += nw) {
    const float* xr = xin + (size_t)t * DM;
    float4 v[4];
    float ss = 0.f;
#pragma unroll
    for (int i = 0; i < 4; ++i) {
      v[i] = *reinterpret_cast<const float4*>(xr + (i * 64 + lane) * 4);
      ss += v[i].x * v[i].x + v[i].y * v[i].y + v[i].z * v[i].z + v[i].w * v[i].w;
    }
    ss = wave_sum(ss);
    const float rstd = rsqrtf(ss * (1.f / DM) + 1e-6f);
#pragma unroll
    for (int i = 0; i < 4; ++i) {
      const int c = (i * 64 + lane) * 4;
      const float4 ww = *reinterpret_cast<const float4*>(w + c);
      float4 o = make_float4(v[i].x * rstd * ww.x, v[i].y * rstd * ww.y, v[i].z * rstd * ww.z, v[i].w * rstd * ww.w);
      *reinterpret_cast<float4*>(outp + (size_t)t * DM + c) = o;
    }
  }
}

DI void rot8(const u16* x1p, const u16* x2p, const float* tab  , float scale, uint4& o1, uint4& o2) {
  float x1[8], x2[8], y1[8], y2[8];
  ld8(x1p, x1); ld8(x2p, x2);
#pragma unroll
  for (int e = 0; e < 8; e += 2) {
    const float4 cs = *reinterpret_cast<const float4*>(tab + e * 2);
    y1[e] = (x1[e] * cs.x - x2[e] * cs.y) * scale;
    y2[e] = (x2[e] * cs.x + x1[e] * cs.y) * scale;
    y1[e + 1] = (x1[e + 1] * cs.z - x2[e + 1] * cs.w) * scale;
    y2[e + 1] = (x2[e + 1] * cs.z + x1[e + 1] * cs.w) * scale;
  }
  o1.x = pack2(y1[0], y1[1]); o1.y = pack2(y1[2], y1[3]); o1.z = pack2(y1[4], y1[5]); o1.w = pack2(y1[6], y1[7]);
  o2.x = pack2(y2[0], y2[1]); o2.y = pack2(y2[2], y2[3]); o2.z = pack2(y2[4], y2[5]); o2.w = pack2(y2[6], y2[7]);
}
DI void ph_post(const Params& p, int L) {
  const int tid = otid();
  const int gt = obid() * NTHR + tid, gs = gridDim.x * NTHR;
  const int lane = tid & 63, gw = gt >> 6, nw = gs >> 6;
  const float* qnw = p.q_norm_w + L * 256;
  const float* kvnw = p.kv_norm_w + L * 128;
  const float* cw = p.conv_w + L * 5 * 768;
  const float* cb = p.conv_b + L * 768;
  const float* dtb = p.dt_bias + L * 8;
  for (int idx = gt; idx < T * 96; idx += gs) {
    const int t = idx / 96, cg = idx - t * 96, s = t & (SEQ - 1);
    float acc[8];
    {
      const float4 b0 = *reinterpret_cast<const float4*>(cb + cg * 8), b1 = *reinterpret_cast<const float4*>(cb + cg * 8 + 4);
      acc[0] = b0.x; acc[1] = b0.y; acc[2] = b0.z; acc[3] = b0.w; acc[4] = b1.x; acc[5] = b1.y; acc[6] = b1.z; acc[7] = b1.w;
    }
#pragma unroll
    for (int w = 0; w < 5; ++w) {
      const int ss = s + w - 2;
      if (ss >= 0 && ss < SEQ) {
        float xv[8];
        ld8(p.proj + (size_t)(t + w - 2) * PWP + C_XBC + cg * 8, xv);
        const float4 w0 = *reinterpret_cast<const float4*>(cw + w * 768 + cg * 8), w1 = *reinterpret_cast<const float4*>(cw + w * 768 + cg * 8 + 4);
        acc[0] += xv[0] * w0.x; acc[1] += xv[1] * w0.y; acc[2] += xv[2] * w0.z; acc[3] += xv[3] * w0.w;
        acc[4] += xv[4] * w1.x; acc[5] += xv[5] * w1.y; acc[6] += xv[6] * w1.z; acc[7] += xv[7] * w1.w;
      }
    }
    uint4 o;
    o.x = pack2(fast_silu(acc[0]), fast_silu(acc[1])); o.y = pack2(fast_silu(acc[2]), fast_silu(acc[3]));
    o.z = pack2(fast_silu(acc[4]), fast_silu(acc[5])); o.w = pack2(fast_silu(acc[6]), fast_silu(acc[7]));
    *reinterpret_cast<uint4*>(p.xbc + (size_t)t * 768 + cg * 8) = o;
  }
  for (int idx = gt; idx < T * 8; idx += gs) {
    const int t = idx >> 3, k = idx & 7;
    const float v = bf2f(p.proj[(size_t)t * PWP + C_DT + k]) + dtb[k];
    p.dtv[idx] = (v > 20.f) ? v : log1pf(expf(v));
  }
  {
    const int sub = lane >> 4, l16 = lane & 15;
    for (int t = gw * 4 + sub; t < T; t += nw * 4) {
      const u16* pr = p.proj + (size_t)t * PWP;
      float v[16], u[8];
      ld8(pr + C_CQ + l16 * 16, v); ld8(pr + C_CQ + l16 * 16 + 8, v + 8);
      ld8(pr + C_CKV + l16 * 8, u);
      float ss = 0.f, s2 = 0.f;
#pragma unroll
      for (int i = 0; i < 16; ++i) ss += v[i] * v[i];
#pragma unroll
      for (int i = 0; i < 8; ++i) s2 += u[i] * u[i];
#pragma unroll
      for (int o = 1; o < 16; o <<= 1) { ss += __shfl_xor(ss, o); s2 += __shfl_xor(s2, o); }
      const float rstd = rsqrtf(ss * (1.f / 256.f) + 1e-6f), r2 = rsqrtf(s2 * (1.f / 128.f) + 1e-6f);
      uint4 o;
      const float* qw = qnw + l16 * 16;
      o.x = pack2(v[0] * rstd * qw[0], v[1] * rstd * qw[1]); o.y = pack2(v[2] * rstd * qw[2], v[3] * rstd * qw[3]);
      o.z = pack2(v[4] * rstd * qw[4], v[5] * rstd * qw[5]); o.w = pack2(v[6] * rstd * qw[6], v[7] * rstd * qw[7]);
      *reinterpret_cast<uint4*>(p.cqn + (size_t)t * 256 + l16 * 16) = o;
      o.x = pack2(v[8] * rstd * qw[8], v[9] * rstd * qw[9]); o.y = pack2(v[10] * rstd * qw[10], v[11] * rstd * qw[11]);
      o.z = pack2(v[12] * rstd * qw[12], v[13] * rstd * qw[13]); o.w = pack2(v[14] * rstd * qw[14], v[15] * rstd * qw[15]);
      *reinterpret_cast<uint4*>(p.cqn + (size_t)t * 256 + l16 * 16 + 8) = o;
      const float* kw = kvnw + l16 * 8;
      o.x = pack2(u[0] * r2 * kw[0], u[1] * r2 * kw[1]); o.y = pack2(u[2] * r2 * kw[2], u[3] * r2 * kw[3]);
      o.z = pack2(u[4] * r2 * kw[4], u[5] * r2 * kw[5]); o.w = pack2(u[6] * r2 * kw[6], u[7] * r2 * kw[7]);
      *reinterpret_cast<uint4*>(p.ckvn + (size_t)t * 128 + l16 * 8) = o;
    }
  }
  for (int idx = gt; idx < T * 42; idx += gs) {
    const int t = idx / 42, ri = idx - t * 42, s = t & (SEQ - 1);
    u16* pr = p.proj + (size_t)t * PWP;
    uint4 o1, o2;
    if (ri < 32) {
      const int isk = ri >> 4, h = (ri >> 2) & 3, i0 = (ri & 3) * 8;
      u16* a = pr + (isk ? C_RK : C_RQ) + h * 64 + i0;
      rot8(a, a + 32, p.rtab + ((size_t)s * 56 + i0) * 2, isk ? 1.f : 0.125f, o1, o2);
      *reinterpret_cast<uint4*>(a) = o1;
      *reinterpret_cast<uint4*>(a + 32) = o2;
    } else if (ri < 40) {
      const int j = ri - 32, isk = j >> 2, h = j & 3;
      u16* a = pr + (isk ? C_DK : C_DQ) + h * 64;
      rot8(a, a + 8, p.rtab + ((size_t)s * 56 + 32) * 2, 1.f, o1, o2);
      *reinterpret_cast<uint4*>(a) = o1;
      *reinterpret_cast<uint4*>(a + 8) = o2;
    } else {
      const int i0 = (ri - 40) * 8;
      u16* a = pr + C_KR + i0;
      rot8(a, a + 16, p.rtab + ((size_t)s * 56 + 40 + i0) * 2, 1.f, o1, o2);
      *reinterpret_cast<uint4*>(a) = o1;
      *reinterpret_cast<uint4*>(a + 16) = o2;
      const int bb = t >> 12;
#pragma unroll
      for (int hd = 0; hd < 4; ++hd) {
        u16* kf = p.kfull + ((size_t)(bb * 4 + hd) * SEQ + s) * 96 + 64 + i0;
        *reinterpret_cast<uint4*>(kf) = o1;
        *reinterpret_cast<uint4*>(kf + 16) = o2;
      }
    }
  }
}

DI void ph_mla_up_q(const Params& p, int L, char* smem, int t) {
  const int mt = T / 256;
  const u16* Bq = p.WuqT + (size_t)L * 384 * 256;
  {
    const int m0 = (t % mt) * 256, n0 = (t / mt) * 128;
    gemm_tile([&](int r) { return p.cqn + (size_t)(m0 + r) * 256; }, Bq + (size_t)n0 * 256, 256, 256, smem,
              [&](f32x4 (&acc)[4][4], int wr, int wc, int fr, int fq) {
                const float scale = 0.10206207261596575f * 1.4426950408889634f;
#pragma unroll
                for (int m = 0; m < 4; ++m)
#pragma unroll
                  for (int j = 0; j < 4; ++j) {
                    const int row = m0 + wr * 64 + m * 16 + fq * 4 + j;
                    const float2 cssn = *reinterpret_cast<const float2*>(p.rtab + ((size_t)(row & (SEQ - 1)) * 56 + 40 + fr) * 2);
                    const float cs = cssn.x, sn = cssn.y;
#pragma unroll
                    for (int n2 = 0; n2 < 4; n2 += 2) {
                      const int cb = n0 + wc * 64 + n2 * 16;
                      float x1 = acc[m][n2][j], x2 = acc[m][n2 + 1][j];
                      if (cb % 96 == 64) {
                        const float y1 = x1 * cs - x2 * sn, y2 = x2 * cs + x1 * sn;
                        x1 = y1; x2 = y2;
                      }
                      p.mq[(size_t)row * 384 + cb + fr] = f2bf(x1 * scale);
                      p.mq[(size_t)row * 384 + cb + 16 + fr] = f2bf(x2 * scale);
                    }
                  }
              });
  }
}
DI void ph_mla_up_kv(const Params& p, int L, char* smem, int t) {
  const int mt = T / 256;
  const u16* Bkv = p.WukvT + (size_t)L * 512 * 128;
  {
    const int m0 = (t % mt) * 256, h = t / mt, n0 = h * 128;
    gemm_tile([&](int r) { return p.ckvn + (size_t)(m0 + r) * 128; }, Bkv + (size_t)n0 * 128, 128, 128, smem,
              [&](f32x4 (&acc)[4][4], int wr, int wc, int fr, int fq) {
#pragma unroll
                for (int m = 0; m < 4; ++m) {
                  const int row = m0 + wr * 64 + m * 16 + fq * 4;
                  const int bb = row >> 12, sq = row & (SEQ - 1);
                  const size_t bh = (size_t)(bb * 4 + h);
#pragma unroll
                  for (int n = 0; n < 4; ++n) {
                    if (wc == 0) {
#pragma unroll
                      for (int j = 0; j < 4; ++j) p.kfull[(bh * SEQ + sq + j) * 96 + n * 16 + fr] = f2bf(acc[m][n][j]);
                    } else {
                      uint2 v;
                      v.x = pack2(acc[m][n][0], acc[m][n][1]);
                      v.y = pack2(acc[m][n][2], acc[m][n][3]);
                      const int sqp = (sq & ~12) | ((sq & 4) << 1) | ((sq & 8) >> 1);
                      *reinterpret_cast<uint2*>(p.vT + (bh * 64 + n * 16 + fr) * SEQ + sqp) = v;
                    }
                  }
                }
              });
  }
}

DI void ph_cumsum(const Params& p, int L) {
  const int tid_ = otid(); const int lane = tid_ & 63, gw = (obid() * NTHR + tid_) >> 6, nw = gridDim.x * (NTHR / 64);
  for (int it = gw; it < 32; it += nw) {
    const int h = it & 3, dir = (it >> 2) & 1, b = it >> 3;
    const float a = -expf(p.a_log[L * 8 + dir * 4 + h]);
    float running = 0.f;
    for (int c = 0; c < 64; ++c) {
      const int i = c * 64 + lane;
      const int s = dir ? (SEQ - 1 - i) : i;
      const size_t off = (size_t)(b * SEQ + s) * 8 + dir * 4 + h;
      float v = p.dtv[off] * a;
#pragma unroll
      for (int o = 1; o < 64; o <<= 1) {
        const float u = __shfl_up(v, o);
        if (lane >= o) v += u;
      }
      v += running;
      p.cs[off] = v;
      running = __shfl(v, 63);
    }
  }
}

DI void ph_ret_naive(const Params& p) {
  const int gt = obid() * NTHR + otid(), gs = gridDim.x * NTHR;
  for (int it = gt; it < 4 * 4 * SEQ; it += gs) {
    const int n = it & (SEQ - 1), h = (it >> 12) & 3, b = it >> 14;
    const u16* base = p.proj + (size_t)(b * SEQ) * PWP;
    uint4 qp[8];
    float o[64];
#pragma unroll
    for (int d = 0; d < 8; ++d) qp[d] = *reinterpret_cast<const uint4*>(base + (size_t)n * PWP + C_RQ + h * 64 + d * 8);
#pragma unroll
    for (int d = 0; d < 64; ++d) o[d] = 0.f;
    const float lg0 = log1pf(-exp2f(-5.f - (float)h)), lg1 = log1pf(-exp2f(-5.5f - (float)h));
#pragma unroll 1
    for (int m = 0; m < SEQ; ++m) {
      const u16* kr = base + (size_t)m * PWP + C_RK + h * 64;
      const u16* vr = base + (size_t)m * PWP + C_RV + h * 64;
      float s = 0.f;
#pragma unroll
      for (int d = 0; d < 8; ++d) s = dot8(qp[d], *reinterpret_cast<const uint4*>(kr + d * 8), s);
      const float w = (m <= n) ? expf(lg0 * (float)(n - m)) : expf(lg1 * (float)(m - n));
      s *= w;
#pragma unroll
      for (int d = 0; d < 64; d += 8) {
        float vf[8];
        ld8(vr + d, vf);
#pragma unroll
        for (int j = 0; j < 8; ++j) o[d + j] += s * vf[j];
      }
    }
    float mu = 0.f;
#pragma unroll
    for (int d = 0; d < 64; ++d) mu += o[d];
    mu *= (1.f / 64.f);
    float var = 0.f;
#pragma unroll
    for (int d = 0; d < 64; ++d) var += (o[d] - mu) * (o[d] - mu);
    var *= (1.f / 64.f);
    const float rs = rsqrtf(var + 1e-5f);
    const size_t t = (size_t)b * SEQ + n;
#pragma unroll
    for (int d = 0; d < 64; d += 8) {
      float g[8];
      ld8(p.proj + t * PWP + C_RG + h * 64 + d, g);
      uint4 ov;
      ov.x = pack2(silu(g[0]) * (o[d + 0] - mu) * rs, silu(g[1]) * (o[d + 1] - mu) * rs);
      ov.y = pack2(silu(g[2]) * (o[d + 2] - mu) * rs, silu(g[3]) * (o[d + 3] - mu) * rs);
      ov.z = pack2(silu(g[4]) * (o[d + 4] - mu) * rs, silu(g[5]) * (o[d + 5] - mu) * rs);
      ov.w = pack2(silu(g[6]) * (o[d + 6] - mu) * rs, silu(g[7]) * (o[d + 7] - mu) * rs);
      *reinterpret_cast<uint4*>(p.mixed + t * DM + h * 64 + d) = ov;
    }
  }
}

DI void ph_mla_naive(const Params& p) {
  const int gt = obid() * NTHR + otid(), gs = gridDim.x * NTHR;
  for (int it = gt; it < 2 * 4 * 4 * SEQ; it += gs) {
    const int n = it & (SEQ - 1), vh = (it >> 12) & 1, h = (it >> 13) & 3, b = it >> 15;
    const size_t t = (size_t)b * SEQ + n;
    uint4 qp[12];
    float o[32];
#pragma unroll
    for (int d = 0; d < 12; ++d) qp[d] = *reinterpret_cast<const uint4*>(p.mq + t * 384 + h * 96 + d * 8);
    const size_t tb = (size_t)b * SEQ;
    float mx = -1e30f;
#pragma unroll 1
    for (int m = 0; m < SEQ; ++m) {
      const u16* kn = p.mkv + (tb + m) * 512 + h * 128;
      const u16* kr = p.proj + (tb + m) * PWP + C_KR;
      float s = 0.f;
#pragma unroll
      for (int d = 0; d < 8; ++d) s = dot8(qp[d], *reinterpret_cast<const uint4*>(kn + d * 8), s);
#pragma unroll
      for (int d = 0; d < 4; ++d) s = dot8(qp[8 + d], *reinterpret_cast<const uint4*>(kr + d * 8), s);
      mx = fmaxf(mx, s);
    }
#pragma unroll
    for (int d = 0; d < 32; ++d) o[d] = 0.f;
    float l = 0.f;
#pragma unroll 1
    for (int m = 0; m < SEQ; ++m) {
      const u16* kn = p.mkv + (tb + m) * 512 + h * 128;
      const u16* kr = p.proj + (tb + m) * PWP + C_KR;
      float s = 0.f;
#pragma unroll
      for (int d = 0; d < 8; ++d) s = dot8(qp[d], *reinterpret_cast<const uint4*>(kn + d * 8), s);
#pragma unroll
      for (int d = 0; d < 4; ++d) s = dot8(qp[8 + d], *reinterpret_cast<const uint4*>(kr + d * 8), s);
      const float pe = exp2f(s - mx);
      l += pe;
#pragma unroll
      for (int d = 0; d < 32; d += 8) {
        float vf[8];
        ld8(kn + 64 + vh * 32 + d, vf);
#pragma unroll
        for (int j = 0; j < 8; ++j) o[d + j] += pe * vf[j];
      }
    }
    const float il = 1.f / l;
#pragma unroll
    for (int d = 0; d < 32; d += 8) {
      uint4 ov;
      ov.x = pack2(o[d + 0] * il, o[d + 1] * il);
      ov.y = pack2(o[d + 2] * il, o[d + 3] * il);
      ov.z = pack2(o[d + 4] * il, o[d + 5] * il);
      ov.w = pack2(o[d + 6] * il, o[d + 7] * il);
      *reinterpret_cast<uint4*>(p.mixed + t * DM + 256 + h * 64 + vh * 32 + d) = ov;
    }
  }
}

#define MFMA32(a, b, c) __builtin_amdgcn_mfma_f32_32x32x16_bf16((a), (b), (c), 0, 0, 0)
DI float max16(const f32x16& v) {
  float a = fmaxf(fmaxf(v[0], v[1]), v[2]), b = fmaxf(fmaxf(v[3], v[4]), v[5]), c = fmaxf(fmaxf(v[6], v[7]), v[8]);
  float d = fmaxf(fmaxf(v[9], v[10]), v[11]), e = fmaxf(fmaxf(v[12], v[13]), v[14]);
  return fmaxf(fmaxf(fmaxf(a, b), fmaxf(c, d)), fmaxf(e, v[15]));
}
DI void ph_mla_attn(const Params& p, char* smem) {
  const int tid = otid(), wid = tid >> 6, lane = tid & 63, l32 = lane & 31, hh = lane >> 5;
  u16* sK = reinterpret_cast<u16*>(smem);
  u16* sV = sK + 2 * 128 * 104;
  uint4 konev = make_uint4(hh == 0 ? 0x00003F80u : 0u, 0u, 0u, 0u);
  const bf16x8 kone = __builtin_bit_cast(bf16x8, konev);
  for (int item = obid(); item < 256; item += gridDim.x) {
    const int xcd_ = item & 7, jx_ = item >> 3, bh = xcd_ * 2 + (jx_ >> 4), qt = jx_ & 15, b = bh >> 2, h = bh & 3;
    const size_t t0 = (size_t)b * SEQ + qt * 256 + wid * 32;
    bf16x8 qf[6];
#pragma unroll
    for (int ks = 0; ks < 6; ++ks) qf[ks] = *reinterpret_cast<const bf16x8*>(p.mq + (t0 + l32) * 384 + h * 96 + ks * 16 + hh * 8);
    const u16* kg = p.kfull + (size_t)bh * SEQ * 96;
    const u16* vg = p.vT + (size_t)bh * 64 * SEQ;
    f32x16 o0, o1;
#pragma unroll
    for (int i = 0; i < 16; ++i) { o0[i] = 0.f; o1[i] = 0.f; }
    float m = 0.f, l = 0.f;
    bf16x8 qf6 = __builtin_bit_cast(bf16x8, make_uint4(0u, 0u, 0u, 0u));
    const int kr0 = tid / 12, kc0 = tid % 12, kr1 = (512 + tid) / 12, kc1 = (512 + tid) % 12, kr2 = (1024 + tid) / 12, kc2 = (1024 + tid) % 12;
    const int vd0 = tid >> 4, vd1 = 32 + (tid >> 4), vkc = (tid & 15) * 8;
    uint4 ak0, ak1, ak2, av0, av1;
#define MLA_LD(dst_, ptr_) asm volatile("global_load_dwordx4 %0, %1, off" : "=v"(dst_) : "v"(ptr_) : "memory")
#define MLA_GLOAD(K0, K1, K2, V0, V1, kt_)                                               \
    {                                                                                    \
      const u16* kb_ = kg + (size_t)(kt_) * 128 * 96 + tid * 8;                          \
      MLA_LD(K0, kb_); MLA_LD(K1, kb_ + 512 * 8); MLA_LD(K2, kb_ + 1024 * 8);            \
      const u16* vp_ = vg + (size_t)vd0 * SEQ + (kt_) * 128 + vkc;                       \
      MLA_LD(V0, vp_); MLA_LD(V1, vp_ + (size_t)32 * SEQ);                               \
    }
#define MLA_SSTORE(K0, K1, K2, V0, V1, buf_)                                             \
    {                                                                                    \
      u16* kb_ = sK + (buf_) * 128 * 104;                                                \
      u16* vb_ = sV + (buf_) * 64 * 136;                                                 \
      *reinterpret_cast<uint4*>(kb_ + kr0 * 104 + kc0 * 8) = K0;                         \
      *reinterpret_cast<uint4*>(kb_ + kr1 * 104 + kc1 * 8) = K1;                         \
      *reinterpret_cast<uint4*>(kb_ + kr2 * 104 + kc2 * 8) = K2;                         \
      *reinterpret_cast<uint4*>(vb_ + vd0 * 136 + vkc) = V0;                             \
      *reinterpret_cast<uint4*>(vb_ + vd1 * 136 + vkc) = V1;                             \
    }
    float mxrun = 0.f;
#define SGB(mask, n) __builtin_amdgcn_sched_group_barrier((mask), (n), 0)
#define MLA_KFRAG(kb_, sub_, ks_) (*reinterpret_cast<const bf16x8*>((kb_) + ((sub_) * 32 + l32) * 104 + (ks_) * 16 + hh * 8))
#define MLA_VFRAG(dst_, vb_, sub_, ks2_, dvt_) \
    dst_ = *reinterpret_cast<const bf16x8*>((vb_) + ((dvt_) * 32 + l32) * 136 + (sub_) * 32 + (ks2_) * 16 + hh * 8)
#define MLA_SOFTMAX(sc_, pa_, pb_)                                                                         \
    {                                                                                                      \
      mxrun = fmaxf(mxrun, max16(sc_));                                                                    \
      float ps0_ = 0.f, ps1_ = 0.f;                                                                        \
      _Pragma("unroll") for (int i = 0; i < 16; i += 2) {                                                  \
        sc_[i] = __builtin_amdgcn_exp2f(sc_[i]); sc_[i + 1] = __builtin_amdgcn_exp2f(sc_[i + 1]);          \
        ps0_ += sc_[i]; ps1_ += sc_[i + 1];                                                                \
      }                                                                                                    \
      l += ps0_ + ps1_;                                                                                    \
      uint4 pk_;                                                                                           \
      pk_.x = pack2(sc_[0], sc_[1]); pk_.y = pack2(sc_[2], sc_[3]); pk_.z = pack2(sc_[4], sc_[5]); pk_.w = pack2(sc_[6], sc_[7]); \
      pa_ = __builtin_bit_cast(bf16x8, pk_);                                                               \
      pk_.x = pack2(sc_[8], sc_[9]); pk_.y = pack2(sc_[10], sc_[11]); pk_.z = pack2(sc_[12], sc_[13]); pk_.w = pack2(sc_[14], sc_[15]); \
      pb_ = __builtin_bit_cast(bf16x8, pk_);                                                               \
    }
    auto compute_tile = [&](int cur, int half) {
      const u16* kb = sK + cur * 128 * 104 + half * 64 * 104;
      const u16* vb = sV + cur * 64 * 136 + half * 64;
      bf16x8 k0[6], k1[6];
#pragma unroll
      for (int ks = 0; ks < 6; ++ks) { k0[ks] = MLA_KFRAG(kb, 0, ks); k1[ks] = MLA_KFRAG(kb, 1, ks); }
      f32x16 s0, s1;
#pragma unroll
      for (int i = 0; i < 16; ++i) { s0[i] = 0.f; s1[i] = 0.f; }
#pragma unroll
      for (int ks = 0; ks < 6; ++ks) s0 = MFMA32(k0[ks], qf[ks], s0);
      s0 = MFMA32(kone, qf6, s0);
      bf16x8 v00, v01, v02, v03, v10, v11, v12, v13;
      MLA_VFRAG(v00, vb, 0, 0, 0); MLA_VFRAG(v01, vb, 0, 0, 1); MLA_VFRAG(v02, vb, 0, 1, 0); MLA_VFRAG(v03, vb, 0, 1, 1);
#pragma unroll
      for (int ks = 0; ks < 6; ++ks) s1 = MFMA32(k1[ks], qf[ks], s1);
      s1 = MFMA32(kone, qf6, s1);
      MLA_VFRAG(v10, vb, 1, 0, 0); MLA_VFRAG(v11, vb, 1, 0, 1); MLA_VFRAG(v12, vb, 1, 1, 0); MLA_VFRAG(v13, vb, 1, 1, 1);
      bf16x8 p0a, p0b, p1a, p1b;
      MLA_SOFTMAX(s0, p0a, p0b);
      o0 = MFMA32(v00, p0a, o0); o1 = MFMA32(v01, p0a, o1); o0 = MFMA32(v02, p0b, o0); o1 = MFMA32(v03, p0b, o1);
      MLA_SOFTMAX(s1, p1a, p1b);
      o0 = MFMA32(v10, p1a, o0); o1 = MFMA32(v11, p1a, o1); o0 = MFMA32(v12, p1b, o0); o1 = MFMA32(v13, p1b, o1);
      SGB(0x100, 12);
#pragma unroll
      for (int i = 0; i < 7; ++i) { SGB(0x008, 1); if (i < 4) SGB(0x100, 1); }
#pragma unroll
      for (int i = 0; i < 7; ++i) { SGB(0x008, 1); if (i < 4) SGB(0x100, 1); SGB(0x402, 7); }
#pragma unroll
      for (int i = 0; i < 4; ++i) { SGB(0x008, 1); SGB(0x402, 12); }
#pragma unroll
      for (int i = 0; i < 4; ++i) SGB(0x008, 1);
    };
    auto lazy_update = [&]() {
      const float mxr = fmaxf(mxrun, __shfl_xor(mxrun, 32));
      if (__builtin_amdgcn_ballot_w64(mxr > 8.f) != 0ull) {
        float d = (mxr > 8.f) ? mxr : 0.f;
        const float mnew = bf2f(f2bf(m + d));
        d = mnew - m;
        m = mnew;
        const float alpha = __builtin_amdgcn_exp2f(-d);
        l *= alpha;
        mxrun -= d;
#pragma unroll
        for (int i = 0; i < 16; ++i) { o0[i] *= alpha; o1[i] *= alpha; }
        uint4 qv = make_uint4(0u, 0u, 0u, 0u);
        if (hh == 0) qv.x = (unsigned)f2bf(-m);
        qf6 = __builtin_bit_cast(bf16x8, qv);
      }
    };
    MLA_GLOAD(ak0, ak1, ak2, av0, av1, 0);
    asm volatile("s_waitcnt vmcnt(0)" ::: "memory");
    MLA_SSTORE(ak0, ak1, ak2, av0, av1, 0);
    __syncthreads();
    {
      f32x16 s0, s1;
#pragma unroll
      for (int i = 0; i < 16; ++i) { s0[i] = 0.f; s1[i] = 0.f; }
#pragma unroll
      for (int ks = 0; ks < 6; ++ks) { s0 = MFMA32(MLA_KFRAG(sK, 0, ks), qf[ks], s0); s1 = MFMA32(MLA_KFRAG(sK, 1, ks), qf[ks], s1); }
      float mx = fmaxf(max16(s0), max16(s1));
      mx = fmaxf(mx, __shfl_xor(mx, 32));
      m = bf2f(f2bf(mx));
      uint4 qv = make_uint4(0u, 0u, 0u, 0u);
      if (hh == 0) qv.x = (unsigned)f2bf(-m);
      qf6 = __builtin_bit_cast(bf16x8, qv);
    }
#pragma unroll 1
    for (int kt = 0; kt < 32; kt += 2) {
      MLA_GLOAD(ak0, ak1, ak2, av0, av1, kt + 1);
#pragma unroll 1
      for (int half = 0; half < 2; ++half) compute_tile(0, half);
      asm volatile("s_waitcnt vmcnt(0)" ::: "memory");
      MLA_SSTORE(ak0, ak1, ak2, av0, av1, 1);
      __syncthreads();
      lazy_update();
      if (kt + 2 < 32) MLA_GLOAD(ak0, ak1, ak2, av0, av1, kt + 2);
#pragma unroll 1
      for (int half = 0; half < 2; ++half) compute_tile(1, half);
      if (kt + 2 < 32) {
        asm volatile("s_waitcnt vmcnt(0)" ::: "memory");
        MLA_SSTORE(ak0, ak1, ak2, av0, av1, 0);
      }
      __syncthreads();
      lazy_update();
    }
    l += __shfl_xor(l, 32);
    const float il = 1.f / l;
    u16* orow = p.mixed + (t0 + l32) * DM + 256 + h * 64 + hh * 4;
#pragma unroll
    for (int g = 0; g < 4; ++g) {
      uint2 v;
      v.x = pack2(o0[4 * g + 0] * il, o0[4 * g + 1] * il);
      v.y = pack2(o0[4 * g + 2] * il, o0[4 * g + 3] * il);
      *reinterpret_cast<uint2*>(orow + g * 8) = v;
      v.x = pack2(o1[4 * g + 0] * il, o1[4 * g + 1] * il);
      v.y = pack2(o1[4 * g + 2] * il, o1[4 * g + 3] * il);
      *reinterpret_cast<uint2*>(orow + 32 + g * 8) = v;
    }
  }
}

typedef __attribute__((address_space(3))) s16x4 lds_s16x4;
template <int MODE>
DI void ph_dil_pass(const Params& p, char* smem, int blk_) {
  const int tid = otid(), wid = tid >> 6, lane = tid & 63, l32 = lane & 31, hh = lane >> 5;
  u16* sV = reinterpret_cast<u16*>(smem) + wid * (2 * 32 * 72);
  const int i16 = lane & 15, tq = i16 >> 2, tp = i16 & 3, tblk = (lane >> 4) & 1;
  {
    constexpr int NT = (MODE == 0) ? 13 : 5;
    const int it = wid, xcd_ = blk_ & 7, jx_ = blk_ >> 3, bh = xcd_ * 2 + (jx_ >> 4), r = jx_ & 15, b = bh >> 2, h = bh & 3;
    const int i0 = it * 32;
    const int q0 = (r * 8 + it) * 32;
    const int qpos = (MODE == 0) ? (r + 16 * (i0 + l32)) : (q0 + l32);
    const size_t tb = (size_t)b * SEQ;
    const u16* kbase = p.proj + tb * PWP + C_DK + h * 64;
    const u16* vbase = p.proj + tb * PWP + C_DV + h * 64;
    bf16x8 qf[4];
    {
      const u16* qp = p.proj + (tb + qpos) * PWP + C_DQ + h * 64 + hh * 8;
#pragma unroll
      for (int ks = 0; ks < 4; ++ks) qf[ks] = *reinterpret_cast<const bf16x8*>(qp + ks * 16);
    }
    f32x16 o0, o1;
#pragma unroll
    for (int i = 0; i < 16; ++i) { o0[i] = 0.f; o1[i] = 0.f; }
    float m = -1e30f, l = 0.f;
    auto tile_params = [&](int tt, int& d, int& rd, int& ub, int& ulim, int& qb, int& qs) {
      if (MODE == 0) {
        if (tt < 5) { d = 16; rd = r; qb = i0; qs = 1; ulim = 256; ub = qb - 64 + 32 * tt; }
        else { d = 4; rd = r & 3; qb = (r >> 2) + 4 * i0; qs = 4; ulim = 1024; ub = qb - 64 + 32 * (tt - 5); }
      } else { d = 1; rd = 0; qb = q0; qs = 1; ulim = 4096; ub = qb - 64 + 32 * tt; }
    };
    bf16x8 ka0, ka1, ka2, ka3, kb0, kb1, kb2, kb3;
    uint4 va0, va1, va2, va3, vb0, vb1, vb2, vb3;
#define DIL_LD(dst_, ptr_) asm volatile("global_load_dwordx4 %0, %1, off" : "=v"(dst_) : "v"(ptr_) : "memory")
#define DIL_GLOAD(K0, K1, K2, K3, V0, V1, V2, V3, tt_)                                                   \
    {                                                                                                    \
      int d_, rd_, ub_, ulim_, qb_, qs_;                                                                 \
      tile_params((tt_), d_, rd_, ub_, ulim_, qb_, qs_);                                                 \
      int u_ = min(max(ub_ + l32, 0), ulim_ - 1);                                                        \
      const u16* kp_ = kbase + (size_t)(rd_ + d_ * u_) * PWP + hh * 8;                                   \
      DIL_LD(K0, kp_); DIL_LD(K1, kp_ + 16); DIL_LD(K2, kp_ + 32); DIL_LD(K3, kp_ + 48);                 \
      const int kr_ = ub_ + (lane >> 3);                                                                 \
      const u16* vp_;                                                                                    \
      u_ = min(max(kr_, 0), ulim_ - 1);      vp_ = vbase + (size_t)(rd_ + d_ * u_) * PWP + (lane & 7) * 8; DIL_LD(V0, vp_); \
      u_ = min(max(kr_ + 8, 0), ulim_ - 1);  vp_ = vbase + (size_t)(rd_ + d_ * u_) * PWP + (lane & 7) * 8; DIL_LD(V1, vp_); \
      u_ = min(max(kr_ + 16, 0), ulim_ - 1); vp_ = vbase + (size_t)(rd_ + d_ * u_) * PWP + (lane & 7) * 8; DIL_LD(V2, vp_); \
      u_ = min(max(kr_ + 24, 0), ulim_ - 1); vp_ = vbase + (size_t)(rd_ + d_ * u_) * PWP + (lane & 7) * 8; DIL_LD(V3, vp_); \
    }
#define DIL_VSTORE(V0, V1, V2, V3, buf_)                                                                 \
    {                                                                                                    \
      u16* vb_ = sV + (buf_) * 32 * 72 + (lane >> 3) * 72 + (lane & 7) * 8;                              \
      *reinterpret_cast<uint4*>(vb_) = V0;                                                               \
      *reinterpret_cast<uint4*>(vb_ + 8 * 72) = V1;                                                      \
      *reinterpret_cast<uint4*>(vb_ + 16 * 72) = V2;                                                     \
      *reinterpret_cast<uint4*>(vb_ + 24 * 72) = V3;                                                     \
    }
    auto tile_rest = [&](int tt, f32x16 sc, int cur) {
      int d, rd, ub, ulim, qb, qs;
      tile_params(tt, d, rd, ub, ulim, qb, qs);
      const int uq = qb + qs * l32;
      const float cs = 0.125f * 1.4426950408889634f;
      float mx = -1e30f;
#pragma unroll
      for (int i = 0; i < 16; ++i) {
        const int u = ub + (i & 3) + 8 * (i >> 2) + 4 * hh;
        const int du = u - uq;
        const bool valid = (u >= 0) && (u < ulim) && (du <= 64) && (du >= -64);
        sc[i] = valid ? sc[i] * cs : -1e30f;
        mx = fmaxf(mx, sc[i]);
      }
      mx = fmaxf(mx, __shfl_xor(mx, 32));
      const float mn = fmaxf(m, mx);
      const float alpha = __builtin_amdgcn_exp2f(m - mn);
      m = mn;
      float ps = 0.f;
#pragma unroll
      for (int i = 0; i < 16; ++i) {
        float pe = __builtin_amdgcn_exp2f(sc[i] - mn);
        pe = (sc[i] > -1e29f) ? pe : 0.f;
        ps += pe;
        sc[i] = pe;
      }
      l = l * alpha + ps;
#pragma unroll
      for (int i = 0; i < 16; ++i) { o0[i] *= alpha; o1[i] *= alpha; }
      const u16* vb = sV + cur * 32 * 72;
#pragma unroll
      for (int ks2 = 0; ks2 < 2; ++ks2) {
        uint4 pk;
        pk.x = pack2(sc[8 * ks2 + 0], sc[8 * ks2 + 1]);
        pk.y = pack2(sc[8 * ks2 + 2], sc[8 * ks2 + 3]);
        pk.z = pack2(sc[8 * ks2 + 4], sc[8 * ks2 + 5]);
        pk.w = pack2(sc[8 * ks2 + 6], sc[8 * ks2 + 7]);
        const bf16x8 pb = __builtin_bit_cast(bf16x8, pk);
#pragma unroll
        for (int dvt = 0; dvt < 2; ++dvt) {
          const u16* a0 = vb + (16 * ks2 + 4 * hh + tq) * 72 + dvt * 32 + tblk * 16 + tp * 4;
          const s16x4 lo = __builtin_amdgcn_ds_read_tr16_b64_v4i16((lds_s16x4*)(a0));
          const s16x4 hi = __builtin_amdgcn_ds_read_tr16_b64_v4i16((lds_s16x4*)(a0 + 8 * 72));
          const bf16x8 a = __builtin_shufflevector(lo, hi, 0, 1, 2, 3, 4, 5, 6, 7);
          if (dvt == 0) o0 = MFMA32(a, pb, o0); else o1 = MFMA32(a, pb, o1);
        }
      }
    };
    DIL_GLOAD(ka0, ka1, ka2, ka3, va0, va1, va2, va3, 0);
    DIL_GLOAD(kb0, kb1, kb2, kb3, vb0, vb1, vb2, vb3, 1);
    asm volatile("s_waitcnt vmcnt(8)" ::: "memory");
    DIL_VSTORE(va0, va1, va2, va3, 0);
#pragma unroll 1
    for (int tt = 0; tt < NT; tt += 2) {
      {
        f32x16 sc;
#pragma unroll
        for (int i = 0; i < 16; ++i) sc[i] = 0.f;
        sc = MFMA32(ka0, qf[0], sc); sc = MFMA32(ka1, qf[1], sc); sc = MFMA32(ka2, qf[2], sc); sc = MFMA32(ka3, qf[3], sc);
        asm volatile("" :: "v"(sc));
        if (tt + 2 < NT) DIL_GLOAD(ka0, ka1, ka2, ka3, va0, va1, va2, va3, tt + 2);
        tile_rest(tt, sc, 0);
        if (tt + 1 < NT) {
          if (tt + 2 < NT) asm volatile("s_waitcnt vmcnt(8)" ::: "memory"); else asm volatile("s_waitcnt vmcnt(0)" ::: "memory");
          DIL_VSTORE(vb0, vb1, vb2, vb3, 1);
        }
      }
      if (tt + 1 < NT) {
        f32x16 sc;
#pragma unroll
        for (int i = 0; i < 16; ++i) sc[i] = 0.f;
        sc = MFMA32(kb0, qf[0], sc); sc = MFMA32(kb1, qf[1], sc); sc = MFMA32(kb2, qf[2], sc); sc = MFMA32(kb3, qf[3], sc);
        asm volatile("" :: "v"(sc));
        if (tt + 3 < NT) DIL_GLOAD(kb0, kb1, kb2, kb3, vb0, vb1, vb2, vb3, tt + 3);
        tile_rest(tt + 1, sc, 1);
        if (tt + 2 < NT) {
          if (tt + 3 < NT) asm volatile("s_waitcnt vmcnt(8)" ::: "memory"); else asm volatile("s_waitcnt vmcnt(0)" ::: "memory");
          DIL_VSTORE(va0, va1, va2, va3, 0);
        }
      }
    }
    l += __shfl_xor(l, 32);
    float* part = p.dpart + ((tb + qpos) * 4 + h) * 68 + hh * 4;
    if (MODE == 0) {
#pragma unroll
      for (int g = 0; g < 4; ++g) {
        *reinterpret_cast<float4*>(part + g * 8) = make_float4(o0[4 * g + 0], o0[4 * g + 1], o0[4 * g + 2], o0[4 * g + 3]);
        *reinterpret_cast<float4*>(part + 32 + g * 8) = make_float4(o1[4 * g + 0], o1[4 * g + 1], o1[4 * g + 2], o1[4 * g + 3]);
      }
      if (hh == 0) { part[64] = m; part[65] = l; }
    } else {
      const float mA = part[64 - hh * 4], lA = part[65 - hh * 4];
      const float M = fmaxf(m, mA), sa = __builtin_amdgcn_exp2f(m - M), sb = __builtin_amdgcn_exp2f(mA - M);
      const float il = 1.f / (l * sa + lA * sb);
      u16* orow = p.mixed + (tb + qpos) * DM + 768 + h * 64 + hh * 4;
#pragma unroll
      for (int g = 0; g < 4; ++g) {
        const float4 a0 = *reinterpret_cast<const float4*>(part + g * 8), a1 = *reinterpret_cast<const float4*>(part + 32 + g * 8);
        uint2 v;
        v.x = pack2((o0[4 * g + 0] * sa + a0.x * sb) * il, (o0[4 * g + 1] * sa + a0.y * sb) * il);
        v.y = pack2((o0[4 * g + 2] * sa + a0.z * sb) * il, (o0[4 * g + 3] * sa + a0.w * sb) * il);
        *reinterpret_cast<uint2*>(orow + g * 8) = v;
        v.x = pack2((o1[4 * g + 0] * sa + a1.x * sb) * il, (o1[4 * g + 1] * sa + a1.y * sb) * il);
        v.y = pack2((o1[4 * g + 2] * sa + a1.z * sb) * il, (o1[4 * g + 3] * sa + a1.w * sb) * il);
        *reinterpret_cast<uint2*>(orow + 32 + g * 8) = v;
      }
    }
  }
}

DI void ph_dil_naive(const Params& p) {
  const int gt = obid() * NTHR + otid(), gs = gridDim.x * NTHR;
  for (int it = gt; it < 4 * 4 * SEQ; it += gs) {
    const int n = it & (SEQ - 1), h = (it >> 12) & 3, b = it >> 14;
    const size_t tb = (size_t)b * SEQ;
    uint4 qp[8];
    float o[64];
#pragma unroll
    for (int d = 0; d < 8; ++d) qp[d] = *reinterpret_cast<const uint4*>(p.proj + (tb + n) * PWP + C_DQ + h * 64 + d * 8);
    float mx = -1e30f;
    for (int pat = 0; pat < 3; ++pat) {
      const int dil = (pat == 0) ? 1 : (pat == 1 ? 4 : 16);
#pragma unroll 1
      for (int j = -64; j <= 64; ++j) {
        const int pos = n + j * dil;
        if (pos < 0 || pos >= SEQ) continue;
        const u16* kr = p.proj + (tb + pos) * PWP + C_DK + h * 64;
        float s = 0.f;
#pragma unroll
        for (int d = 0; d < 8; ++d) s = dot8(qp[d], *reinterpret_cast<const uint4*>(kr + d * 8), s);
        s *= 0.125f;
        mx = fmaxf(mx, s);
      }
    }
#pragma unroll
    for (int d = 0; d < 64; ++d) o[d] = 0.f;
    float l = 0.f;
    for (int pat = 0; pat < 3; ++pat) {
      const int dil = (pat == 0) ? 1 : (pat == 1 ? 4 : 16);
#pragma unroll 1
      for (int j = -64; j <= 64; ++j) {
        const int pos = n + j * dil;
        if (pos < 0 || pos >= SEQ) continue;
        const u16* kr = p.proj + (tb + pos) * PWP + C_DK + h * 64;
        const u16* vr = p.proj + (tb + pos) * PWP + C_DV + h * 64;
        float s = 0.f;
#pragma unroll
        for (int d = 0; d < 8; ++d) s = dot8(qp[d], *reinterpret_cast<const uint4*>(kr + d * 8), s);
        s *= 0.125f;
        const float pe = __expf(s - mx);
        l += pe;
#pragma unroll
        for (int d = 0; d < 64; d += 8) {
          float vf[8];
          ld8(vr + d, vf);
#pragma unroll
          for (int jj = 0; jj < 8; ++jj) o[d + jj] += pe * vf[jj];
        }
      }
    }
    const float il = 1.f / l;
#pragma unroll
    for (int d = 0; d < 64; d += 8) {
      uint4 ov;
      ov.x = pack2(o[d + 0] * il, o[d + 1] * il);
      ov.y = pack2(o[d + 2] * il, o[d + 3] * il);
      ov.z = pack2(o[d + 4] * il, o[d + 5] * il);
      ov.w = pack2(o[d + 6] * il, o[d + 7] * il);
      *reinterpret_cast<uint4*>(p.mixed + (tb + n) * DM + 768 + h * 64 + d) = ov;
    }
  }
}

DI void ph_ssd_naive(const Params& p, int L) {
  const int gt = obid() * NTHR + otid(), gs = gridDim.x * NTHR;
  for (int it = gt; it < 4 * 4 * 4 * SEQ; it += gs) {
    const int l = it & (SEQ - 1), pq = (it >> 12) & 3, h = (it >> 14) & 3, b = it >> 16;
    const int g = h >> 1;
    const size_t tb = (size_t)b * SEQ;
    uint4 cl[16];
    float acc[16];
#pragma unroll
    for (int d = 0; d < 16; ++d) cl[d] = *reinterpret_cast<const uint4*>(p.xbc + (tb + l) * 768 + 512 + g * 128 + d * 8);
#pragma unroll
    for (int d = 0; d < 16; ++d) acc[d] = 0.f;
    const float pl = p.cs[(tb + l) * 8 + h], rl = p.cs[(tb + l) * 8 + 4 + h];
#pragma unroll 1
    for (int s = 0; s < SEQ; ++s) {
      const u16* br = p.xbc + (tb + s) * 768 + 256 + g * 128;
      float cbv = 0.f;
#pragma unroll
      for (int d = 0; d < 16; ++d) cbv = dot8(cl[d], *reinterpret_cast<const uint4*>(br + d * 8), cbv);
      float w;
      if (s <= l) w = expf(pl - p.cs[(tb + s) * 8 + h]) * p.dtv[(tb + s) * 8 + h];
      else w = expf(rl - p.cs[(tb + s) * 8 + 4 + h]) * p.dtv[(tb + s) * 8 + 4 + h];
      cbv *= w;
      const u16* xr = p.xbc + (tb + s) * 768 + h * 64 + pq * 16;
#pragma unroll
      for (int d = 0; d < 16; d += 8) {
        float xf[8];
        ld8(xr + d, xf);
#pragma unroll
        for (int j = 0; j < 8; ++j) acc[d + j] += cbv * xf[j];
      }
    }
    const float dsk = p.ssm_d[L * 4 + h];
#pragma unroll
    for (int d = 0; d < 16; ++d) {
      const int c = h * 64 + pq * 16 + d;
      const float xv = bf2f(p.xbc[(tb + l) * 768 + c]);
      const float z = bf2f(p.proj[(tb + l) * PWP + C_Z + c]);
      p.ybuf[(tb + l) * 256 + c] = (acc[d] + dsk * xv) * silu(z);
    }
  }
}

DI void ph_ssd_norm(const Params& p, int L) {
  const int tid_ = otid(); const int lane = tid_ & 63, gw = (obid() * NTHR + tid_) >> 6, nw = gridDim.x * (NTHR / 64);
  const float* nwt = p.ssm_norm_w + L * 256;
  for (int t = gw; t < T; t += nw) {
    const float4 v = *reinterpret_cast<const float4*>(p.ybuf + (size_t)t * 256 + lane * 4);
    float ss = wave_sum(v.x * v.x + v.y * v.y + v.z * v.z + v.w * v.w);
    const float rstd = rsqrtf(ss * (1.f / 256.f) + 1e-6f);
    const float4 ww = *reinterpret_cast<const float4*>(nwt + lane * 4);
    uint2 o;
    o.x = pack2(v.x * rstd * ww.x, v.y * rstd * ww.y);
    o.y = pack2(v.z * rstd * ww.z, v.w * rstd * ww.w);
    *reinterpret_cast<uint2*>(p.mixed + (size_t)t * DM + 512 + lane * 4) = o;
  }
}

#define MFMA16(a, b, c) __builtin_amdgcn_mfma_f32_16x16x32_bf16((a), (b), (c), 0, 0, 0)
template <int MT, int NT, int KS>
DI void wave_mm(f32x4 (&acc)[MT][NT], const u16* a0, int lda, const u16* b0, int ldb, int fr, int fq) {
#pragma unroll
  for (int ks = 0; ks < KS; ++ks) {
    bf16x8 af[MT], bfv[NT];
#pragma unroll
    for (int m = 0; m < MT; ++m) af[m] = *reinterpret_cast<const bf16x8*>(a0 + (m * 16 + fr) * lda + ks * 32 + fq * 8);
#pragma unroll
    for (int n = 0; n < NT; ++n) bfv[n] = *reinterpret_cast<const bf16x8*>(b0 + (n * 16 + fr) * ldb + ks * 32 + fq * 8);
#pragma unroll
    for (int m = 0; m < MT; ++m)
#pragma unroll
      for (int n = 0; n < NT; ++n) acc[m][n] = MFMA16(af[m], bfv[n], acc[m][n]);
  }
}
template <int MT, int NT>
DI void zero_acc(f32x4 (&acc)[MT][NT]) {
#pragma unroll
  for (int m = 0; m < MT; ++m)
#pragma unroll
    for (int n = 0; n < NT; ++n) acc[m][n] = f32x4{0.f, 0.f, 0.f, 0.f};
}
template <int NROWS, int NCOLS>
DI void stage_rows(u16* dst, int ldd, const u16* src, size_t lsrc, int tid) {
  constexpr int CPR = NCOLS / 8, NCH = NROWS * CPR / NTHR;
  static_assert(NROWS * CPR % NTHR == 0, "tile must be a multiple of 512 chunks");
  uint4 r[NCH];
#pragma unroll
  for (int i = 0; i < NCH; ++i) {
    const int c = tid + i * NTHR, row = c / CPR, cc = c % CPR;
    r[i] = *reinterpret_cast<const uint4*>(src + (size_t)row * lsrc + cc * 8);
  }
#pragma unroll
  for (int i = 0; i < NCH; ++i) {
    const int c = tid + i * NTHR, row = c / CPR, cc = c % CPR;
    *reinterpret_cast<uint4*>(dst + row * ldd + cc * 8) = r[i];
  }
}
template <int NCOLS, class W>
DI void stage_T(u16* dst, int ldd, const u16* src, size_t lsrc, int tid, W w) {
  constexpr int NCH = 128 * (NCOLS / 8) / NTHR;
  uint4 r[NCH];
#pragma unroll
  for (int i = 0; i < NCH; ++i) {
    const int c = tid + i * NTHR, j = c & 127, cc = c >> 7;
    r[i] = *reinterpret_cast<const uint4*>(src + (size_t)j * lsrc + cc * 8);
  }
#pragma unroll
  for (int i = 0; i < NCH; ++i) {
    const int c = tid + i * NTHR, j = c & 127, cc = c >> 7;
    float f[8];
    unpack8(r[i], f);
    const float wj = w(j);
#pragma unroll
    for (int e = 0; e < 8; ++e) dst[(cc * 8 + e) * ldd + j] = f2bf(f[e] * wj);
  }
}

template <int NROWS, int NCOLS>
DI void stage_rows_ld(uint4 (&r)[NROWS * (NCOLS / 8) / NTHR], const u16* src, size_t lsrc, int tid) {
  constexpr int CPR = NCOLS / 8, NCH = NROWS * CPR / NTHR;
#pragma unroll
  for (int i = 0; i < NCH; ++i) {
    const int c = tid + i * NTHR, row = c / CPR, cc = c % CPR;
    r[i] = *reinterpret_cast<const uint4*>(src + (size_t)row * lsrc + cc * 8);
  }
}
template <int NROWS, int NCOLS>
DI void stage_rows_st(u16* dst, int ldd, const uint4 (&r)[NROWS * (NCOLS / 8) / NTHR], int tid) {
  constexpr int CPR = NCOLS / 8, NCH = NROWS * CPR / NTHR;
#pragma unroll
  for (int i = 0; i < NCH; ++i) {
    const int c = tid + i * NTHR, row = c / CPR, cc = c % CPR;
    *reinterpret_cast<uint4*>(dst + row * ldd + cc * 8) = r[i];
  }
}
template <int NCOLS>
DI void stage_T_ld(uint4 (&r)[128 * (NCOLS / 8) / NTHR], const u16* src, size_t lsrc, int tid) {
  constexpr int NCH = 128 * (NCOLS / 8) / NTHR;
#pragma unroll
  for (int i = 0; i < NCH; ++i) {
    const int c = tid + i * NTHR, j = c & 127, cc = c >> 7;
    r[i] = *reinterpret_cast<const uint4*>(src + (size_t)j * lsrc + cc * 8);
  }
}
template <int NCOLS, class W>
DI void stage_T_st(u16* dst, int ldd, const uint4 (&r)[128 * (NCOLS / 8) / NTHR], int tid, W w) {
  constexpr int NCH = 128 * (NCOLS / 8) / NTHR;
#pragma unroll
  for (int i = 0; i < NCH; ++i) {
    const int c = tid + i * NTHR, j = c & 127, cc = c >> 7;
    float f[8];
    unpack8(r[i], f);
    const float wj = w(j);
#pragma unroll
    for (int e = 0; e < 8; ++e) dst[(cc * 8 + e) * ldd + j] = f2bf(f[e] * wj);
  }
}

DI void ph_ret_a(const Params& p, char* smem, int item) {
  const int tid = otid(), wid = tid >> 6, lane = tid & 63, fr = lane & 15, fq = lane >> 4;
  u16* sVt = reinterpret_cast<u16*>(smem);
  u16* sKf = sVt + 64 * 136;
  u16* sKb = sKf + 64 * 136;
  {
    const int c = item & 31, bh = item >> 5, b = bh >> 2, h = bh & 3;
    const float lg0 = log1pf(-exp2f(-5.f - (float)h)), lg1 = log1pf(-exp2f(-5.5f - (float)h));
    const u16* src = p.proj + ((size_t)b * SEQ + c * 128) * PWP;
    {
      uint4 rv[2], rk[2];
      stage_T_ld<64>(rv, src + C_RV + h * 64, PWP, tid);
      stage_T_ld<64>(rk, src + C_RK + h * 64, PWP, tid);
      stage_T_st<64>(sVt, 136, rv, tid, [](int) { return 1.f; });
      stage_T_st<64>(sKf, 136, rk, tid, [&](int j) { return __expf(lg0 * (float)(127 - j)); });
      stage_T_st<64>(sKb, 136, rk, tid, [&](int j) { return __expf(lg1 * (float)j); });
    }
    __syncthreads();
    const int dir = wid >> 2, q = wid & 3;
    f32x4 acc[1][4];
    zero_acc(acc);
    wave_mm<1, 4, 4>(acc, sVt + q * 16 * 136, 136, dir ? sKb : sKf, 136, fr, fq);
    float* out = p.rU + ((size_t)(bh * 32 + c) * 2 + dir) * 4096;
#pragma unroll
    for (int n = 0; n < 4; ++n)
#pragma unroll
      for (int j = 0; j < 4; ++j) out[(q * 16 + fq * 4 + j) * 64 + n * 16 + fr] = acc[0][n][j];
    __syncthreads();
  }
}
DI void ph_ret_scan(const Params& p) {
  const int gt = obid() * NTHR + otid(), gs = gridDim.x * NTHR;
  for (int it = gt; it < 16 * 2 * 4096; it += gs) {
    const int e = it & 4095, dir = (it >> 12) & 1, bh = it >> 13, h = bh & 3;
    const float lg = log1pf(-exp2f((dir ? -5.5f : -5.f) - (float)h));
    const float cd = __expf(lg * 128.f);
    float u[32];
#pragma unroll
    for (int c = 0; c < 32; ++c) u[c] = p.rU[((size_t)(bh * 32 + c) * 2 + dir) * 4096 + e];
    float st = 0.f;
    if (dir == 0) {
#pragma unroll
      for (int c = 0; c < 32; ++c) {
        p.rS[((size_t)(bh * 32 + c) * 2 + dir) * 4096 + e] = f2bf(st);
        st = st * cd + u[c];
      }
    } else {
#pragma unroll
      for (int c = 31; c >= 0; --c) {
        p.rS[((size_t)(bh * 32 + c) * 2 + dir) * 4096 + e] = f2bf(st);
        st = st * cd + u[c];
      }
    }
  }
}
DI void ph_ret_c(const Params& p, char* smem, int item) {
  const int tid = otid(), wid = tid >> 6, lane = tid & 63, fr = lane & 15, fq = lane >> 4;
  u16* sQ = reinterpret_cast<u16*>(smem);
  u16* sK = sQ + 128 * 72;
  u16* sVt = sK + 128 * 72;
  u16* sSf = sVt + 64 * 136;
  u16* sSb = sSf + 64 * 72;
  u16* sP = sSb + 64 * 72;
  {
    const int c = item & 31, bh = item >> 5, b = bh >> 2, h = bh & 3;
    const float lg0 = log1pf(-exp2f(-5.f - (float)h)), lg1 = log1pf(-exp2f(-5.5f - (float)h));
    const size_t t0 = (size_t)b * SEQ + c * 128;
    const u16* src = p.proj + t0 * PWP;
    {
      uint4 rq[2], rk[2], rv[2], rf[1], rb[1];
      stage_rows_ld<128, 64>(rq, src + C_RQ + h * 64, PWP, tid);
      stage_rows_ld<128, 64>(rk, src + C_RK + h * 64, PWP, tid);
      stage_T_ld<64>(rv, src + C_RV + h * 64, PWP, tid);
      stage_rows_ld<64, 64>(rf, p.rS + ((size_t)(bh * 32 + c) * 2 + 0) * 4096, 64, tid);
      stage_rows_ld<64, 64>(rb, p.rS + ((size_t)(bh * 32 + c) * 2 + 1) * 4096, 64, tid);
      stage_rows_st<128, 64>(sQ, 72, rq, tid);
      stage_rows_st<128, 64>(sK, 72, rk, tid);
      stage_T_st<64>(sVt, 136, rv, tid, [](int) { return 1.f; });
      stage_rows_st<64, 64>(sSf, 72, rf, tid);
      stage_rows_st<64, 64>(sSb, 72, rb, tid);
    }
    __syncthreads();
    {
      const int wr = wid >> 1, wc = wid & 1;
      f32x4 sacc[2][4];
      zero_acc(sacc);
      wave_mm<2, 4, 2>(sacc, sQ + wr * 32 * 72, 72, sK + wc * 64 * 72, 72, fr, fq);
#pragma unroll
      for (int m = 0; m < 2; ++m)
#pragma unroll
        for (int n = 0; n < 4; ++n)
#pragma unroll
          for (int j = 0; j < 4; ++j) {
            const int i = wr * 32 + m * 16 + fq * 4 + j, jj = wc * 64 + n * 16 + fr;
            const float dcy = (jj <= i) ? __expf(lg0 * (float)(i - jj)) : __expf(lg1 * (float)(jj - i));
            sP[i * 136 + jj] = f2bf(sacc[m][n][j] * dcy);
          }
    }
    __syncthreads();
    {
      f32x4 ai[1][4], af_[1][4], ab_[1][4];
      zero_acc(ai); zero_acc(af_); zero_acc(ab_);
      wave_mm<1, 4, 4>(ai, sP + wid * 16 * 136, 136, sVt, 136, fr, fq);
      wave_mm<1, 4, 2>(af_, sQ + wid * 16 * 72, 72, sSf, 72, fr, fq);
      wave_mm<1, 4, 2>(ab_, sQ + wid * 16 * 72, 72, sSb, 72, fr, fq);
#pragma unroll
      for (int j = 0; j < 4; ++j) {
        const int i = wid * 16 + fq * 4 + j;
        const float xf = __expf(lg0 * (float)(i + 1)), xb = __expf(lg1 * (float)(128 - i));
        float o[4], sum = 0.f;
#pragma unroll
        for (int n = 0; n < 4; ++n) { o[n] = ai[0][n][j] + xf * af_[0][n][j] + xb * ab_[0][n][j]; sum += o[n]; }
#pragma unroll
        for (int sft = 1; sft < 16; sft <<= 1) sum += __shfl_xor(sum, sft);
        const float mu = sum * (1.f / 64.f);
        float var = 0.f;
#pragma unroll
        for (int n = 0; n < 4; ++n) var += (o[n] - mu) * (o[n] - mu);
#pragma unroll
        for (int sft = 1; sft < 16; sft <<= 1) var += __shfl_xor(var, sft);
        const float rs = rsqrtf(var * (1.f / 64.f) + 1e-5f);
#pragma unroll
        for (int n = 0; n < 4; ++n) {
          const float g = bf2f(p.proj[(t0 + i) * PWP + C_RG + h * 64 + n * 16 + fr]);
          p.mixed[(t0 + i) * DM + h * 64 + n * 16 + fr] = f2bf(silu(g) * (o[n] - mu) * rs);
        }
      }
    }
    __syncthreads();
  }
}

DI void ssd_local_cumsum(const Params& p, int L, size_t t0, float* cum, float* dtl, int wid, int lane) {
  const int dir = wid >> 2, h = wid & 3;
  const float a = -__expf(p.a_log[L * 8 + dir * 4 + h]);
  float d0, d1;
  if (dir == 0) { d0 = p.dtv[(t0 + 2 * lane) * 8 + h]; d1 = p.dtv[(t0 + 2 * lane + 1) * 8 + h]; }
  else { d0 = p.dtv[(t0 + 127 - 2 * lane) * 8 + 4 + h]; d1 = p.dtv[(t0 + 126 - 2 * lane) * 8 + 4 + h]; }
  float v0 = d0 * a, v1 = v0 + d1 * a;
  float run = v1;
#pragma unroll
  for (int o = 1; o < 64; o <<= 1) {
    const float u = __shfl_up(run, o);
    if (lane >= o) run += u;
  }
  const float excl = run - v1;
  v0 += excl; v1 += excl;
  float* cr = cum + (dir * 4 + h) * 128;
  float* dr = dtl + (dir * 4 + h) * 128;
  if (dir == 0) { cr[2 * lane] = v0; cr[2 * lane + 1] = v1; dr[2 * lane] = d0; dr[2 * lane + 1] = d1; }
  else { cr[127 - 2 * lane] = v0; cr[126 - 2 * lane] = v1; dr[127 - 2 * lane] = d0; dr[126 - 2 * lane] = d1; }
}

DI void ph_ssd_a(const Params& p, int L, char* smem, int item) {
  const int tid = otid(), wid = tid >> 6, lane = tid & 63, fr = lane & 15, fq = lane >> 4;
  u16* sBt = reinterpret_cast<u16*>(smem);
  u16* sXf = sBt + 2 * 128 * 136;
  u16* sXb = sXf + 64 * 136;
  float* cum = reinterpret_cast<float*>(sXb + 64 * 136);
  float* dtl = cum + 8 * 128;
  {
    const int c = item & 31, b = item >> 5;
    const size_t t0 = (size_t)b * SEQ + c * 128;
    ssd_local_cumsum(p, L, t0, cum, dtl, wid, lane);
    stage_T<256>(sBt, 136, p.xbc + t0 * 768 + 256, 768, tid, [](int) { return 1.f; });
    __syncthreads();
    if (tid < 8) {
      const int dir = tid >> 2;
      p.cdec[(size_t)item * 8 + tid] = __expf(dir ? cum[tid * 128 + 0] : cum[tid * 128 + 127]);
    }
    for (int h = 0; h < 4; ++h) {
      const float* cf = cum + h * 128;
      const float* cb = cum + (4 + h) * 128;
      const float* df = dtl + h * 128;
      const float* db = dtl + (4 + h) * 128;
      const float endf = cf[127], endb = cb[0];
      {
        uint4 rx[2];
        stage_T_ld<64>(rx, p.xbc + t0 * 768 + h * 64, 768, tid);
        stage_T_st<64>(sXf, 136, rx, tid, [&](int l) { return __expf(endf - cf[l]) * df[l]; });
        stage_T_st<64>(sXb, 136, rx, tid, [&](int l) { return __expf(endb - cb[l]) * db[l]; });
      }
      __syncthreads();
      const int dir = wid >> 2, q = wid & 3, g = h >> 1;
      f32x4 acc[4][2];
      zero_acc(acc);
      wave_mm<4, 2, 4>(acc, dir ? sXb : sXf, 136, sBt + (g * 128 + q * 32) * 136, 136, fr, fq);
      float* out = p.sU + ((size_t)item * 8 + h * 2 + dir) * 8192;
#pragma unroll
      for (int m = 0; m < 4; ++m)
#pragma unroll
        for (int n = 0; n < 2; ++n)
#pragma unroll
          for (int j = 0; j < 4; ++j) out[(m * 16 + fq * 4 + j) * 128 + q * 32 + n * 16 + fr] = acc[m][n][j];
      __syncthreads();
    }
  }
}
DI void ph_ssd_scan(const Params& p) {
  const int gt = obid() * NTHR + otid(), gs = gridDim.x * NTHR;
  for (int it = gt; it < 4 * 8 * 8192; it += gs) {
    const int e = it & 8191, hd = (it >> 13) & 7, b = it >> 16;
    const int dir = hd & 1, h = hd >> 1;
    float u[32];
#pragma unroll
    for (int c = 0; c < 32; ++c) u[c] = p.sU[((size_t)(b * 32 + c) * 8 + hd) * 8192 + e];
    float st = 0.f;
    if (dir == 0) {
#pragma unroll
      for (int c = 0; c < 32; ++c) {
        p.sS[((size_t)(b * 32 + c) * 8 + hd) * 8192 + e] = f2bf(st);
        st = st * p.cdec[(size_t)(b * 32 + c) * 8 + dir * 4 + h] + u[c];
      }
    } else {
#pragma unroll
      for (int c = 31; c >= 0; --c) {
        p.sS[((size_t)(b * 32 + c) * 8 + hd) * 8192 + e] = f2bf(st);
        st = st * p.cdec[(size_t)(b * 32 + c) * 8 + dir * 4 + h] + u[c];
      }
    }
  }
}
DI void ph_ssd_c(const Params& p, int L, char* smem, int item) {
  const int tid = otid(), wid = tid >> 6, lane = tid & 63, fr = lane & 15, fq = lane >> 4;
  u16* sC = reinterpret_cast<u16*>(smem);
  u16* sB = sC + 128 * 136;
  u16* sXt = sB + 128 * 136;
  u16* sSf = sXt + 64 * 136;
  u16* sSb = sSf + 64 * 136;
  float* cum = reinterpret_cast<float*>(sSb + 64 * 136);
  float* dtl = cum + 8 * 128;
  {
    const int c = item & 31, b = item >> 5;
    const size_t t0 = (size_t)b * SEQ + c * 128;
    ssd_local_cumsum(p, L, t0, cum, dtl, wid, lane);
    float ssq[4] = {0.f, 0.f, 0.f, 0.f};
#pragma unroll 1
    for (int g = 0; g < 2; ++g) {
      {
        uint4 rc[4], rb4[4];
        stage_rows_ld<128, 128>(rc, p.xbc + t0 * 768 + 512 + g * 128, 768, tid);
        stage_rows_ld<128, 128>(rb4, p.xbc + t0 * 768 + 256 + g * 128, 768, tid);
        stage_rows_st<128, 128>(sC, 136, rc, tid);
        stage_rows_st<128, 128>(sB, 136, rb4, tid);
      }
      __syncthreads();
      const int wr = wid >> 1, wc = wid & 1;
      f32x4 G[2][4];
      zero_acc(G);
      wave_mm<2, 4, 4>(G, sC + wr * 32 * 136, 136, sB + wc * 64 * 136, 136, fr, fq);
      __syncthreads();
#pragma unroll 1
      for (int hl = 0; hl < 2; ++hl) {
        const int h = g * 2 + hl;
        const float* cf = cum + h * 128;
        const float* cb = cum + (4 + h) * 128;
        const float* df = dtl + h * 128;
        const float* db = dtl + (4 + h) * 128;
        uint4 rxt[2], rsf[2], rsb[2];
        stage_T_ld<64>(rxt, p.xbc + t0 * 768 + h * 64, 768, tid);
        stage_rows_ld<64, 128>(rsf, p.sS + ((size_t)item * 8 + h * 2 + 0) * 8192, 128, tid);
        stage_rows_ld<64, 128>(rsb, p.sS + ((size_t)item * 8 + h * 2 + 1) * 8192, 128, tid);
#pragma unroll
        for (int m = 0; m < 2; ++m)
#pragma unroll
          for (int n = 0; n < 4; ++n)
#pragma unroll
            for (int j = 0; j < 4; ++j) {
              const int l = wr * 32 + m * 16 + fq * 4 + j, sx = wc * 64 + n * 16 + fr;
              const float w = (sx <= l) ? __expf(cf[l] - cf[sx]) * df[sx] : __expf(cb[l] - cb[sx]) * db[sx];
              sB[l * 136 + sx] = f2bf(G[m][n][j] * w);
            }
        stage_T_st<64>(sXt, 136, rxt, tid, [](int) { return 1.f; });
        stage_rows_st<64, 128>(sSf, 136, rsf, tid);
        stage_rows_st<64, 128>(sSb, 136, rsb, tid);
        __syncthreads();
        f32x4 yd[1][4], yf[1][4], yb[1][4];
        zero_acc(yd); zero_acc(yf); zero_acc(yb);
        wave_mm<1, 4, 4>(yd, sB + wid * 16 * 136, 136, sXt, 136, fr, fq);
        wave_mm<1, 4, 4>(yf, sC + wid * 16 * 136, 136, sSf, 136, fr, fq);
        wave_mm<1, 4, 4>(yb, sC + wid * 16 * 136, 136, sSb, 136, fr, fq);
        const float dsk = p.ssm_d[L * 4 + h];
#pragma unroll
        for (int j = 0; j < 4; ++j) {
          const int l = wid * 16 + fq * 4 + j;
          const float ef = __expf(cf[l]), eb = __expf(cb[l]);
#pragma unroll
          for (int n = 0; n < 4; ++n) {
            const int ch = h * 64 + n * 16 + fr;
            const float xv = bf2f(p.xbc[(t0 + l) * 768 + ch]);
            const float z = bf2f(p.proj[(t0 + l) * PWP + C_Z + ch]);
            const float yv = (yd[0][n][j] + ef * yf[0][n][j] + eb * yb[0][n][j] + dsk * xv) * silu(z);
            ssq[j] += yv * yv;
            p.ybuf[(t0 + l) * 256 + ch] = yv;
          }
        }
        __syncthreads();
      }
    }
    const float* nwt = p.ssm_norm_w + L * 256;
#pragma unroll
    for (int j = 0; j < 4; ++j) {
      float ss = ssq[j];
#pragma unroll
      for (int sft = 1; sft < 16; sft <<= 1) ss += __shfl_xor(ss, sft);
      const float rstd = rsqrtf(ss * (1.f / 256.f) + 1e-6f);
      const int l = wid * 16 + fq * 4 + j;
#pragma unroll
      for (int hn = 0; hn < 16; ++hn) {
        const int ch = hn * 16 + fr;
        p.mixed[(t0 + l) * DM + 512 + ch] = f2bf(p.ybuf[(t0 + l) * 256 + ch] * rstd * nwt[ch]);
      }
    }
  }
}

struct CfgOutproj {
  static constexpr bool PERM = false;
  int K; const Params* p; int L; int bid, nb; const float* xin; float* xout;
  DI bool next(int i, pg8::Unit& u) const { const int t = i * nb + bid; if (t >= 64 * 4) return false; u.pm = t & 63; u.pn = t >> 6; return true; }
  DI const char* a_base(const pg8::Unit& u) const { return (const char*)(p->mixed + (size_t)u.pm * 256 * DM); }
  DI const char* b_base(const pg8::Unit& u) const { return (const char*)(p->WoutT + ((size_t)L * DM + (size_t)u.pn * 256) * DM); }
  DI void a_off(const pg8::Unit&, int R0, int C0, int R1, int C1, unsigned (&vo)[4]) const {
    vo[0] = (unsigned)(R0 * DM + C0) * 2u; vo[1] = (unsigned)(R1 * DM + C1) * 2u;
    vo[2] = vo[0] + 128u * DM * 2u; vo[3] = vo[1] + 128u * DM * 2u;
  }
  DI void epi(const f32x4 (&acc)[2][2][4][2], const pg8::Unit& u, int wr, int wc, int fr, int fq) const {
    const int row0 = u.pm * 256 + wr * 64 + fr, col0 = u.pn * 256 + wc * 32 + 4 * fq;
#pragma unroll
    for (int ai = 0; ai < 2; ++ai)
#pragma unroll
      for (int m = 0; m < 4; ++m) {
        const size_t ro = (size_t)(row0 + ai * 128 + m * 16) * DM + col0;
#pragma unroll
        for (int bj = 0; bj < 2; ++bj)
#pragma unroll
          for (int n = 0; n < 2; ++n) {
            const size_t o = ro + bj * 128 + n * 16;
            const float4 xi = *reinterpret_cast<const float4*>(xin + o);
            const f32x4 a = acc[ai][bj][m][n];
            *reinterpret_cast<float4*>(xout + o) = make_float4(xi.x + a[0], xi.y + a[1], xi.z + a[2], xi.w + a[3]);
          }
      }
  }
};
DI void ph_outproj(const Params& p, int L, const float* xin, float* xout, char* smem) {
  CfgOutproj c; c.K = DM; c.p = &p; c.L = L; c.bid = obid(); c.nb = gridDim.x; c.xin = xin; c.xout = xout;
  pg8::gemm_phase((pg8::lds_u8*)smem, c);
}

DI void ph_rms2_router(const Params& p, int L, const float* xres, char* smem) {
  const int tid = otid(), lane = tid & 63, gw = (obid() * NTHR + tid) >> 6, nw = gridDim.x * (NTHR / 64);
  const float* w = p.ln2_w + L * DM;
  const float* rw = p.router_w + (size_t)L * DM * 16;
  float4* srw = reinterpret_cast<float4*>(smem);
  for (int i = tid; i < 4096; i += NTHR) {
    const int c = i >> 2, e4 = i & 3;
    srw[(e4 * 4 + (c & 3)) * 256 + (c >> 2)] = *reinterpret_cast<const float4*>(rw + (size_t)i * 4);
  }
  __syncthreads();
  const int b5 = (lane >> 5) & 1, b4 = (lane >> 4) & 1, b3 = (lane >> 3) & 1, b2 = (lane >> 2) & 1;
  const int my_e = 8 * b5 + 4 * b4 + 2 * b3 + b2;
  for (int t = gw; t < T; t += nw) {
    const float* xr = xres + (size_t)t * DM;
    float4 v[4];
    float ss = 0.f;
#pragma unroll
    for (int i = 0; i < 4; ++i) {
      v[i] = *reinterpret_cast<const float4*>(xr + (i * 64 + lane) * 4);
      ss += v[i].x * v[i].x + v[i].y * v[i].y + v[i].z * v[i].z + v[i].w * v[i].w;
    }
    ss = wave_sum(ss);
    const float rstd = rsqrtf(ss * (1.f / DM) + 1e-6f);
    float lg[16];
#pragma unroll
    for (int e = 0; e < 16; ++e) lg[e] = 0.f;
#pragma unroll
    for (int i = 0; i < 4; ++i) {
      const int q = i * 64 + lane;
      const float4 ww = *reinterpret_cast<const float4*>(w + q * 4);
      const float hv[4] = {v[i].x * rstd * ww.x, v[i].y * rstd * ww.y, v[i].z * rstd * ww.z, v[i].w * rstd * ww.w};
      uint2 o;
      o.x = pack2(hv[0], hv[1]);
      o.y = pack2(hv[2], hv[3]);
      *reinterpret_cast<uint2*>(p.hn + (size_t)t * DM + q * 4) = o;
#pragma unroll
      for (int j = 0; j < 4; ++j)
#pragma unroll
        for (int e4 = 0; e4 < 4; ++e4) {
          const float4 r = srw[(e4 * 4 + j) * 256 + q];
          lg[e4 * 4 + 0] += hv[j] * r.x; lg[e4 * 4 + 1] += hv[j] * r.y;
          lg[e4 * 4 + 2] += hv[j] * r.z; lg[e4 * 4 + 3] += hv[j] * r.w;
        }
      __builtin_amdgcn_sched_barrier(0);
    }
#pragma unroll
    for (int k = 0; k < 8; ++k) {
      const float send = b5 ? lg[k] : lg[k + 8], keep = b5 ? lg[k + 8] : lg[k];
      lg[k] = keep + __shfl_xor(send, 32);
    }
#pragma unroll
    for (int k = 0; k < 4; ++k) {
      const float send = b4 ? lg[k] : lg[k + 4], keep = b4 ? lg[k + 4] : lg[k];
      lg[k] = keep + __shfl_xor(send, 16);
    }
#pragma unroll
    for (int k = 0; k < 2; ++k) {
      const float send = b3 ? lg[k] : lg[k + 2], keep = b3 ? lg[k + 2] : lg[k];
      lg[k] = keep + __shfl_xor(send, 8);
    }
    float lv;
    {
      const float send = b2 ? lg[0] : lg[1], keep = b2 ? lg[1] : lg[0];
      lv = keep + __shfl_xor(send, 4);
    }
    lv += __shfl_xor(lv, 2);
    lv += __shfl_xor(lv, 1);
    float mx = lv;
    mx = fmaxf(mx, __shfl_xor(mx, 4)); mx = fmaxf(mx, __shfl_xor(mx, 8));
    mx = fmaxf(mx, __shfl_xor(mx, 16)); mx = fmaxf(mx, __shfl_xor(mx, 32));
    const float ex = expf(lv - mx);
    float den = ex;
    den += __shfl_xor(den, 4); den += __shfl_xor(den, 8); den += __shfl_xor(den, 16); den += __shfl_xor(den, 32);
    if ((lane & 3) == 0) { p.aff[(size_t)t * 16 + my_e] = ex / den; p.inv[(size_t)t * 16 + my_e] = -1; }
  }
}

DI int block_sum_i(int v, int* red, int tid) {
#pragma unroll
  for (int o = 32; o > 0; o >>= 1) v += __shfl_xor(v, o);
  __syncthreads();
  if ((tid & 63) == 0) red[tid >> 6] = v;
  __syncthreads();
  int t = 0;
#pragma unroll
  for (int w = 0; w < NTHR / 64; ++w) t += red[w];
  return t;
}
DI void ph_topk(const Params& p, char* smem) {
  int* red = reinterpret_cast<int*>(smem);
  int* wsum = red + 16;
  const int tid = otid(), wid = tid >> 6, lane = tid & 63;
  for (int it = obid(); it < 64; it += gridDim.x) {
    const int e = it & 15, b = it >> 4;
    unsigned v[8];
#pragma unroll
    for (int i = 0; i < 8; ++i) v[i] = __float_as_uint(p.aff[(size_t)(b * SEQ + tid * 8 + i) * 16 + e]);
    unsigned thr = 0;
#pragma unroll 1
    for (int bit = 30; bit >= 0; --bit) {
      const unsigned cand = thr | (1u << bit);
      int cnt = 0;
#pragma unroll
      for (int i = 0; i < 8; ++i) cnt += (v[i] >= cand) ? 1 : 0;
      if (block_sum_i(cnt, red, tid) >= 512) thr = cand;
    }
    int ngt = 0, ntie = 0;
#pragma unroll
    for (int i = 0; i < 8; ++i) { ngt += (v[i] > thr) ? 1 : 0; ntie += (v[i] == thr) ? 1 : 0; }
    int ig = ngt, itie = ntie;
#pragma unroll
    for (int o = 1; o < 64; o <<= 1) {
      const int a = __shfl_up(ig, o), c = __shfl_up(itie, o);
      if (lane >= o) { ig += a; itie += c; }
    }
    __syncthreads();
    if (lane == 63) { wsum[wid] = ig; wsum[8 + wid] = itie; }
    __syncthreads();
    int og = 0, ot = 0, totg = 0;
#pragma unroll
    for (int w = 0; w < 8; ++w) {
      const int a = wsum[w], c = wsum[8 + w];
      if (w < wid) { og += a; ot += c; }
      totg += a;
    }
    int pg = og + ig - ngt, pt = ot + itie - ntie;
    const int base = (e * 4 + b) * 512;
#pragma unroll
    for (int i = 0; i < 8; ++i) {
      int slot = -1;
      if (v[i] > thr) { slot = pg; ++pg; }
      else if (v[i] == thr) { if (totg + pt < 512) slot = totg + pt; ++pt; }
      if (slot >= 0) {
        p.tok[base + slot] = b * SEQ + tid * 8 + i;
        p.inv[(size_t)(b * SEQ + tid * 8 + i) * 16 + e] = base + slot;
        p.gate[base + slot] = __uint_as_float(v[i]);
      }
    }
    __syncthreads();
  }
}

struct CfgMoe1 {
  static constexpr bool PERM = true;
  int K; const Params* p; int L; int bid, nb;
  DI bool next(int i, pg8::Unit& u) const {
    const int t = i * nb + bid; if (t >= 16 * 16 * 8) return false;
    const int rnd = t >> 8, w = t & 255, xcd = w & 7, jx = w >> 3, pid = xcd * 4 + (jx >> 3);
    const int mt = jx & 7, nt = pid & 15, e = rnd * 2 + (pid >> 4);
    u.pm = e * 8 + mt; u.pn = e * 16 + nt; return true;
  }
  DI const char* a_base(const pg8::Unit&) const { return (const char*)p->hn; }
  DI const char* b_base(const pg8::Unit& u) const { return (const char*)(p->WguT + ((size_t)L * 16 * 4096 + (size_t)u.pn * 256) * DM); }
  DI void a_off(const pg8::Unit& u, int R0, int C0, int R1, int C1, unsigned (&vo)[4]) const {
    const int* tk = p->tok + u.pm * 256;
    vo[0] = (unsigned)(tk[R0] * DM + C0) * 2u; vo[1] = (unsigned)(tk[R1] * DM + C1) * 2u;
    vo[2] = (unsigned)(tk[128 + R0] * DM + C0) * 2u; vo[3] = (unsigned)(tk[128 + R1] * DM + C1) * 2u;
  }
  DI void epi(const f32x4 (&acc)[2][2][4][2], const pg8::Unit& u, int wr, int wc, int fr, int fq) const {
    const int row0 = u.pm * 256 + wr * 64 + fr, col0 = (u.pn & 15) * 128 + wc * 32 + 8 * fq;
#pragma unroll
    for (int ai = 0; ai < 2; ++ai)
#pragma unroll
      for (int m = 0; m < 4; ++m) {
        const f32x4 g0 = acc[ai][0][m][0], g1 = acc[ai][0][m][1], u0 = acc[ai][1][m][0], u1 = acc[ai][1][m][1];
        uint4 w;
        w.x = pack2(fast_silu(g0[0]) * u0[0], fast_silu(g0[1]) * u0[1]); w.y = pack2(fast_silu(g0[2]) * u0[2], fast_silu(g0[3]) * u0[3]);
        w.z = pack2(fast_silu(g1[0]) * u1[0], fast_silu(g1[1]) * u1[1]); w.w = pack2(fast_silu(g1[2]) * u1[2], fast_silu(g1[3]) * u1[3]);
        *reinterpret_cast<uint4*>(p->hid + (size_t)(row0 + ai * 128 + m * 16) * 2048 + col0) = w;
      }
  }
};
DI void ph_moe1(const Params& p, int L, char* smem) {
  CfgMoe1 c; c.K = DM; c.p = &p; c.L = L; c.bid = obid(); c.nb = gridDim.x;
  pg8::gemm_phase((pg8::lds_u8*)smem, c);
}
struct CfgMoe2 {
  static constexpr bool PERM = true;
  int K; const Params* p; int L; int bid, nb;
  DI bool next(int i, pg8::Unit& u) const {
    const int t = i * nb + bid; if (t >= 16 * 4 * 8) return false;
    const int rnd = t >> 8, w = t & 255, xcd = w & 7, jx = w >> 3, pid = rnd * 32 + xcd * 4 + (jx >> 3);
    u.pm = (pid >> 2) * 8 + (jx & 7); u.pn = pid; return true;
  }
  DI const char* a_base(const pg8::Unit& u) const { return (const char*)(p->hid + (size_t)u.pm * 256 * 2048); }
  DI const char* b_base(const pg8::Unit& u) const { return (const char*)(p->WdT + ((size_t)L * 16 * DM + (size_t)u.pn * 256) * 2048); }
  DI void a_off(const pg8::Unit&, int R0, int C0, int R1, int C1, unsigned (&vo)[4]) const {
    vo[0] = (unsigned)(R0 * 2048 + C0) * 2u; vo[1] = (unsigned)(R1 * 2048 + C1) * 2u;
    vo[2] = vo[0] + 128u * 2048u * 2u; vo[3] = vo[1] + 128u * 2048u * 2u;
  }
  DI void epi(const f32x4 (&acc)[2][2][4][2], const pg8::Unit& u, int wr, int wc, int fr, int fq) const {
    u16* eo = p->proj;
    const int row0 = u.pm * 256 + wr * 64 + fr, col0 = (u.pn & 3) * 256 + wc * 32 + 8 * fq;
#pragma unroll
    for (int ai = 0; ai < 2; ++ai)
#pragma unroll
      for (int m = 0; m < 4; ++m) {
        const int row = row0 + ai * 128 + m * 16;
        const float gt = p->gate[row];
#pragma unroll
        for (int bj = 0; bj < 2; ++bj) {
          const f32x4 a0 = acc[ai][bj][m][0], a1 = acc[ai][bj][m][1];
          uint4 w;
          w.x = pack2(gt * a0[0], gt * a0[1]); w.y = pack2(gt * a0[2], gt * a0[3]);
          w.z = pack2(gt * a1[0], gt * a1[1]); w.w = pack2(gt * a1[2], gt * a1[3]);
          *reinterpret_cast<uint4*>(eo + (size_t)row * DM + col0 + bj * 128) = w;
        }
      }
  }
};
DI void ph_moe2(const Params& p, int L, char* smem) {
  CfgMoe2 c; c.K = 2048; c.p = &p; c.L = L; c.bid = obid(); c.nb = gridDim.x;
  pg8::gemm_phase((pg8::lds_u8*)smem, c);
}
template <bool FINAL>
DI void ph_combine_norm(const Params& p, const float* __restrict__ xa, float* __restrict__ xnew, const float* __restrict__ w,
                        u16* __restrict__ hn_out, float* __restrict__ f_out) {
  const int tid_ = otid(), lane = tid_ & 63, gw = (obid() * NTHR + tid_) >> 6, nw = gridDim.x * (NTHR / 64);
  const u16* eo = p.proj;
  for (int t = gw; t < T; t += nw) {
    float4 v[4];
#pragma unroll
    for (int i = 0; i < 4; ++i) v[i] = *reinterpret_cast<const float4*>(xa + (size_t)t * DM + (i * 64 + lane) * 4);
    const int myrow = (lane < 16) ? p.inv[(size_t)t * 16 + lane] : -1;
#pragma unroll 1
    for (int e = 0; e < 16; ++e) {
      const int r = __shfl(myrow, e);
      if (r >= 0) {
#pragma unroll
        for (int i = 0; i < 4; ++i) {
          const uint2 q = *reinterpret_cast<const uint2*>(eo + (size_t)r * DM + (i * 64 + lane) * 4);
          v[i].x += __uint_as_float(q.x << 16); v[i].y += __uint_as_float(q.x & 0xffff0000u);
          v[i].z += __uint_as_float(q.y << 16); v[i].w += __uint_as_float(q.y & 0xffff0000u);
        }
      }
    }
    float ss = 0.f;
#pragma unroll
    for (int i = 0; i < 4; ++i) ss += v[i].x * v[i].x + v[i].y * v[i].y + v[i].z * v[i].z + v[i].w * v[i].w;
    ss = wave_sum(ss);
    const float rstd = rsqrtf(ss * (1.f / DM) + 1e-6f);
#pragma unroll
    for (int i = 0; i < 4; ++i) {
      const int c = (i * 64 + lane) * 4;
      const float4 ww = *reinterpret_cast<const float4*>(w + c);
      if (FINAL) {
        *reinterpret_cast<float4*>(f_out + (size_t)t * DM + c) = make_float4(v[i].x * rstd * ww.x, v[i].y * rstd * ww.y, v[i].z * rstd * ww.z, v[i].w * rstd * ww.w);
      } else {
        *reinterpret_cast<float4*>(xnew + (size_t)t * DM + c) = v[i];
        uint2 o;
        o.x = pack2(v[i].x * rstd * ww.x, v[i].y * rstd * ww.y);
        o.y = pack2(v[i].z * rstd * ww.z, v[i].w * rstd * ww.w);
        *reinterpret_cast<uint2*>(hn_out + (size_t)t * DM + c) = o;
      }
    }
  }
}

__global__ void __launch_bounds__(NTHR) mk(Params p) {
  extern __shared__ __attribute__((aligned(16))) char smem[];
  cg::grid_group grid = cg::this_grid();
  __shared__ uint4 xb_words;
  if (threadIdx.x == 0) xb_words = make_uint4(0u, 0u, 0u, 0u);
  __syncthreads();
  XcdBarrier xb = xcd_barrier_post(p.bar, (volatile LAS unsigned*)&xb_words);
  for (int rep = 0; rep < p.rep[0]; ++rep) ph_convert(p, smem);
  ph_rmsnorm_bf16(p.x, p.ln1_w, p.hn);
  grid.sync();
  for (int L = 0; L < 2; ++L) {
    const float* xin = (L == 0) ? p.x : p.xres2;
    float* xout = p.xres;
    if (L == 1) {
      for (int rep = 0; rep < p.rep[1]; ++rep) ph_combine_norm<false>(p, p.xres, p.xres2, p.ln1_w + DM, p.hn, nullptr);
      xcd_barrier(xb);
    }
    for (int rp = 0; rp < p.rep[3]; ++rp) {
      for (int rep = 0; rep < p.rep[2]; ++rep) ph_inproj(p, L, smem);
      xcd_barrier(xb);
      ph_post(p, L);
      xcd_barrier(xb);
    }
    for (int rep = 0; rep < p.rep[12]; ++rep) xcd_barrier(xb);
    {
      unsigned* ctr = p.bar + XCD_BAR_WORDS + 8 + L;
      __shared__ int q1_item;
      for (;;) {
        if (threadIdx.x == 0) q1_item = (int)atomicAdd(ctr, 1u);
        __syncthreads();
        const int it = q1_item;
        __syncthreads();
        if (it >= 1344) break;
        if (it < 256) ph_dil_pass<0>(p, smem, it);
        else if (it < 384) ph_ssd_a(p, L, smem, it - 256);
        else if (it < 576) ph_mla_up_q(p, L, smem, it - 384);
        else if (it < 832) ph_mla_up_kv(p, L, smem, it - 576);
        else ph_ret_a(p, smem, it - 832);
      }
    }
    xcd_barrier(xb);
    for (int rep = 0; rep < p.rep[5]; ++rep) {
      for (int r2 = 0; r2 < p.rep[13]; ++r2) { ph_ret_scan(p); ph_ssd_scan(p); }
      for (int r2 = 0; r2 < p.rep[14]; ++r2) ph_mla_attn(p, smem);
      for (int r2 = 0; r2 < p.rep[15]; ++r2) for (int bi = obid(); bi < 256; bi += gridDim.x) ph_dil_pass<1>(p, smem, bi);
    }
    xcd_barrier(xb);
    {
      unsigned* ctr = p.bar + XCD_BAR_WORDS + L;
      __shared__ int q_item;
      for (;;) {
        if (threadIdx.x == 0) q_item = (int)atomicAdd(ctr, 1u);
        __syncthreads();
        const int it = q_item;
        __syncthreads();
        if (it >= 640) break;
        if (it < 128) ph_ssd_c(p, L, smem, it);
        else ph_ret_c(p, smem, it - 128);
      }
    }
    xcd_barrier(xb);
    for (int rep = 0; rep < p.rep[7]; ++rep) ph_outproj(p, L, xin, xout, smem);
    xcd_barrier(xb);
    for (int rep = 0; rep < p.rep[8]; ++rep) ph_rms2_router(p, L, xout, smem);
    xcd_barrier(xb);
    for (int rep = 0; rep < p.rep[9]; ++rep) ph_topk(p, smem);
    xcd_barrier(xb);
    for (int rep = 0; rep < p.rep[10]; ++rep) ph_moe1(p, L, smem);
    xcd_barrier(xb);
    for (int rep = 0; rep < p.rep[11]; ++rep) ph_moe2(p, L, smem);
    xcd_barrier(xb);
  }
  ph_combine_norm<true>(p, p.xres, nullptr, p.final_w, nullptr, p.out);
}

extern "C" void kernel_launch(void* const* d_in, const int* in_sizes, int n_in, void* d_out, int out_size, void* d_ws,
                              size_t ws_size, hipStream_t stream) {
  static int grid_blocks = 0;
  if (!grid_blocks) {
    int dev = 0, cus = 0, per_cu = 0;
    (void)hipGetDevice(&dev);
    (void)hipDeviceGetAttribute(&cus, hipDeviceAttributeMultiprocessorCount, dev);
    (void)hipFuncSetAttribute((const void*)mk, hipFuncAttributeMaxDynamicSharedMemorySize, LDS_BYTES);
    (void)hipOccupancyMaxActiveBlocksPerMultiprocessor(&per_cu, (const void*)mk, NTHR, LDS_BYTES);
    if (per_cu < 1) { fprintf(stderr, "occupancy query says %d blocks/CU\n", per_cu); per_cu = 1; }
    grid_blocks = cus * 1;
  }
  Params p{};
  const float** fp = reinterpret_cast<const float**>(&p);
  for (int i = 0; i < 20; ++i) fp[i] = (const float*)d_in[i];
  p.out = (float*)d_out;
  char* w = (char*)d_ws;
  size_t off = 0;
  auto take = [&](size_t bytes) { char* r = w + off; off += (bytes + 255) & ~(size_t)255; return r; };
  p.WinT = (u16*)take((size_t)2 * PWP * DM * 2);
  p.WuqT = (u16*)take((size_t)2 * 384 * 256 * 2);
  p.WukvT = (u16*)take((size_t)2 * 512 * 128 * 2);
  p.WoutT = (u16*)take((size_t)2 * DM * DM * 2);
  p.WguT = (u16*)take((size_t)2 * 16 * 4096 * DM * 2);
  p.WdT = (u16*)take((size_t)2 * 16 * DM * 2048 * 2);
  p.xres = (float*)take((size_t)T * DM * 4);
  p.hn = (u16*)take((size_t)T * DM * 2);
  p.proj = (u16*)take((size_t)T * PWP * 2);
  p.cqn = (u16*)take((size_t)T * 256 * 2);
  p.ckvn = (u16*)take((size_t)T * 128 * 2);
  p.mq = (u16*)take((size_t)T * 384 * 2);
  p.mkv = nullptr;
  p.xbc = (u16*)take((size_t)T * 768 * 2);
  p.mixed = (u16*)take((size_t)T * DM * 2);
  p.hid = (u16*)take((size_t)32768 * 2048 * 2);
  p.kfull = (u16*)take((size_t)T * 4 * 96 * 2);
  p.rS = (u16*)take((size_t)16 * 32 * 2 * 4096 * 2);
  p.sS = (u16*)take((size_t)128 * 8 * 8192 * 2);
  p.rU = (float*)take((size_t)16 * 32 * 2 * 4096 * 4);
  p.sU = (float*)take((size_t)128 * 8 * 8192 * 4);
  p.cdec = (float*)take((size_t)128 * 8 * 4);
  p.vT = (u16*)take((size_t)T * 4 * 64 * 2);
  p.rtab = (float*)take((size_t)SEQ * 56 * 2 * 4);
  p.dpart = (float*)take((size_t)T * 4 * 68 * 4);
  p.dtv = (float*)take((size_t)T * 8 * 4);
  p.cs = (float*)take((size_t)T * 8 * 4);
  p.ybuf = (float*)take((size_t)T * 256 * 4);
  p.aff = (float*)take((size_t)T * 16 * 4);
  p.gate = (float*)take((size_t)64 * 512 * 4);
  p.tok = (int*)take((size_t)64 * 512 * 4);
  p.inv = (int*)take((size_t)T * 16 * 4);
  p.bar = (unsigned*)take((size_t)(XCD_BAR_WORDS + 64) * 4);
  p.xres2 = (float*)take((size_t)T * DM * 4);
  { const int reps[16] = REPS_INIT; for (int i = 0; i < 16; ++i) p.rep[i] = reps[i]; }
  if (off > ws_size) { fprintf(stderr, "workspace too small: need %zu have %zu\n", off, ws_size); return; }
  (void)hipMemsetAsync(p.bar, 0, (size_t)(XCD_BAR_WORDS + 64) * 4, stream);
  void* args[] = {&p};
  hipError_t e = hipLaunchCooperativeKernel((void*)mk, dim3(grid_blocks), dim3(NTHR), args, LDS_BYTES, stream);
  if (e != hipSuccess) fprintf(stderr, "cooperative launch failed: %s (grid %d)\n", hipGetErrorString(e), grid_blocks);
}
```

```cpp
#include <hip/hip_runtime.h>
#include <hip/hip_cooperative_groups.h>
#include <cstdio>
#include <cstdint>
namespace cg = cooperative_groups;

#define DI __device__ __forceinline__
typedef unsigned short u16;
typedef __attribute__((ext_vector_type(8))) short bf16x8;
typedef __attribute__((ext_vector_type(4))) float f32x4;

#ifndef REPS_INIT
#define REPS_INIT {1, 1, 1, 1, 1, 1, 1, 1, 1, 1, 1, 1, 0, 1, 1, 1}
#endif
constexpr int NTHR = 512;
constexpr int T = 16384, SEQ = 4096, DM = 1024;
constexpr int PW = 3240, PWP = 3328;
constexpr int C_RQ = 0, C_RK = 256, C_RV = 512, C_RG = 768, C_CQ = 1024, C_CKV = 1280, C_KR = 1408,
              C_Z = 1440, C_XBC = 1696, C_DT = 2464, C_DQ = 2472, C_DK = 2728, C_DV = 2984;
constexpr int LDS_BYTES = 132096;

struct Params {
  const float *x, *ln1_w, *w_in, *q_norm_w, *kv_norm_w, *w_uq, *w_ukv, *conv_w, *conv_b, *a_log, *dt_bias,
      *ssm_d, *ssm_norm_w, *w_out, *ln2_w, *router_w, *w_gate, *w_up, *w_down, *final_w;
  float* out;
  u16 *WinT, *WuqT, *WukvT, *WoutT, *WguT, *WdT;
  float* xres;
  u16 *hn, *proj, *cqn, *ckvn, *mq, *mkv, *xbc, *mixed, *hid, *kfull, *vT, *rS, *sS;
  float *dtv, *cs, *ybuf, *aff, *gate, *rU, *sU, *cdec, *rtab, *dpart;
  int* tok;
  int* inv;
  unsigned* bar;
  float* xres2;
  int rep[16];
};

typedef __attribute__((ext_vector_type(2))) __bf16 bf16x2_t;
typedef __attribute__((ext_vector_type(2))) float f32x2_t;
typedef __attribute__((ext_vector_type(16))) float f32x16;
typedef __attribute__((ext_vector_type(4))) short s16x4;
DI unsigned pack2(float a, float b) {
  f32x2_t v = {a, b};
  return __builtin_bit_cast(unsigned, __builtin_convertvector(v, bf16x2_t));
}
DI u16 f2bf(float f) { return (u16)(pack2(f, 0.f) & 0xffffu); }
DI float bf2f(u16 h) { return __uint_as_float(((unsigned)h) << 16); }
DI void unpack8(const uint4& v, float* f) {
  f[0] = __uint_as_float(v.x << 16); f[1] = __uint_as_float(v.x & 0xffff0000u);
  f[2] = __uint_as_float(v.y << 16); f[3] = __uint_as_float(v.y & 0xffff0000u);
  f[4] = __uint_as_float(v.z << 16); f[5] = __uint_as_float(v.z & 0xffff0000u);
  f[6] = __uint_as_float(v.w << 16); f[7] = __uint_as_float(v.w & 0xffff0000u);
}
DI void ld8(const u16* p, float* f) { uint4 v = *reinterpret_cast<const uint4*>(p); unpack8(v, f); }
DI float wave_sum(float v) {
#pragma unroll
  for (int o = 32; o > 0; o >>= 1) v += __shfl_xor(v, o);
  return v;
}
DI float dot2acc(unsigned a, unsigned b, float c) {
  return __builtin_amdgcn_fdot2_f32_bf16(__builtin_bit_cast(bf16x2_t, a), __builtin_bit_cast(bf16x2_t, b), c, false);
}
DI float dot8(const uint4& a, const uint4& b, float c) {
  c = dot2acc(a.x, b.x, c); c = dot2acc(a.y, b.y, c); c = dot2acc(a.z, b.z, c); c = dot2acc(a.w, b.w, c);
  return c;
}
DI int otid() { int t = threadIdx.x; asm volatile("" : "+v"(t)); return t; }
DI int obid() { int b = blockIdx.x; asm volatile("" : "+s"(b)); return b; }
DI float silu(float x) { return x / (1.f + __expf(-x)); }
DI float fast_silu(float x) { return x * __builtin_amdgcn_rcpf(1.f + __expf(-x)); }


#define XB_TMO      128
#define XB_XCNT(j)  (256  + 64 * (j))
#define XB_XSUB(j)  (1280 + 64 * (j))
#define XB_XGEN(j)  (2304 + 64 * (j))
#define XB_TOP      3328
#define XB_TOPGEN   3392
#define XCD_BAR_WORDS 3456
#define XB_SPIN_CAP (1u << 20)
#define LAS __attribute__((address_space(3)))
DI unsigned xb_ld(unsigned* p) { return __hip_atomic_load(p, __ATOMIC_RELAXED, __HIP_MEMORY_SCOPE_AGENT); }
DI unsigned xb_add(unsigned* p, unsigned v) { return __hip_atomic_fetch_add(p, v, __ATOMIC_RELAXED, __HIP_MEMORY_SCOPE_AGENT); }
DI unsigned xb_xcc_id() { return (unsigned)__builtin_amdgcn_s_getreg((3 << 11) | 20) & 0xFu; }
#define XB_SPIN(cond, bar) do { unsigned _sp = 0; while (cond) { __builtin_amdgcn_s_sleep(1); \
    if ((++_sp & 255u) == 0u) { if (xb_ld(&(bar)[XB_TMO])) break; if (_sp > XB_SPIN_CAP) { atomicAdd(&(bar)[XB_TMO], 1u); break; } } } } while (0)
struct XcdBarrier { unsigned* bar; unsigned x; volatile LAS unsigned* st; };
DI XcdBarrier xcd_barrier_post(unsigned* bar, volatile LAS unsigned* st) {
  XcdBarrier b; b.bar = bar; b.x = xb_xcc_id(); b.st = st;
  if (threadIdx.x == 0) (void)xb_add(&bar[XB_XCNT(b.x)], 1u);
  return b;
}
DI void xcd_barrier_complete(unsigned* bar, unsigned x, unsigned& nloc, unsigned& nx) {
  const unsigned G = gridDim.x * gridDim.y * gridDim.z;
  unsigned sum, cnt, mine, sp = 0u;
  for (;;) {
    sum = 0u; cnt = 0u; mine = 0u;
#pragma unroll
    for (unsigned j = 0; j < 16; ++j) { const unsigned c = xb_ld(&bar[XB_XCNT(j)]); sum += c; cnt += (c > 0u) ? 1u : 0u; mine = (j == x) ? c : mine; }
    if (sum == G) break;
    __builtin_amdgcn_s_sleep(1);
    if ((++sp & 255u) == 0u) { if (xb_ld(&bar[XB_TMO])) break; if (sp > XB_SPIN_CAP) { atomicAdd(&bar[XB_TMO], 1u); break; } }
  }
  nloc = mine > 0u ? mine : 1u; nx = cnt > 0u ? cnt : 1u;
}
DI void xcd_barrier(const XcdBarrier& b) {
  asm volatile("s_waitcnt vmcnt(0)" ::: "memory");
  __syncthreads();
  if (threadIdx.x == 0) {
    unsigned* bar = b.bar;
    __builtin_amdgcn_s_waitcnt(0);
    unsigned nloc = b.st[0], nx = b.st[1];
    if (nloc == 0u) { xcd_barrier_complete(bar, b.x, nloc, nx); b.st[0] = nloc; b.st[1] = nx; }
    const unsigned old = xb_add(&bar[XB_XSUB(b.x)], 1u);
    const unsigned gen = old / nloc;
    if (old + 1u == (gen + 1u) * nloc) {
      __builtin_amdgcn_fence(__ATOMIC_RELEASE, "agent");
      asm volatile("s_waitcnt vmcnt(0)" ::: "memory");
      const unsigned og = xb_add(&bar[XB_TOP], 1u);
      const unsigned tg = og / nx;
      if (og + 1u == (tg + 1u) * nx) xb_add(&bar[XB_TOPGEN], 1u);
      else XB_SPIN(xb_ld(&bar[XB_TOPGEN]) == tg, bar);
      __builtin_amdgcn_fence(__ATOMIC_ACQUIRE, "agent");
      xb_add(&bar[XB_XGEN(b.x)], 1u);
      asm volatile("s_waitcnt vmcnt(0)" ::: "memory");
    } else {
      XB_SPIN(xb_ld(&bar[XB_XGEN(b.x)]) == gen, bar);
      __builtin_amdgcn_fence(__ATOMIC_ACQUIRE, "agent");
      asm volatile("s_waitcnt vmcnt(0)" ::: "memory");
    }
  }
  __syncthreads();
}

template <class F>
DI void transpose_convert(const float* __restrict__ src, int K, int N, int Npad, u16* __restrict__ dst, F rowmap,
                          int bid, int nb, char* smem) {
  u16* tile = reinterpret_cast<u16*>(smem);
  const int tid = otid();
  const int ntn = Npad / 128, ntk = K / 64;
  for (int t = bid; t < ntn * ntk; t += nb) {
    const int n0 = (t % ntn) * 128, k0 = (t / ntn) * 64;
    f32x4 v[4];
#pragma unroll
    for (int i = 0; i < 4; ++i) {
      const int kk = (tid >> 5) + 16 * i, nn = (tid & 31) * 4;
      v[i] = f32x4{0.f, 0.f, 0.f, 0.f};
      if (n0 + nn < N) v[i] = __builtin_nontemporal_load(reinterpret_cast<const f32x4*>(src + (size_t)(k0 + kk) * N + n0 + nn));
    }
#pragma unroll
    for (int i = 0; i < 4; ++i) {
      const int kk = (tid >> 5) + 16 * i, nn = (tid & 31) * 4;
      tile[(nn + 0) * 72 + kk] = f2bf(v[i][0]); tile[(nn + 1) * 72 + kk] = f2bf(v[i][1]);
      tile[(nn + 2) * 72 + kk] = f2bf(v[i][2]); tile[(nn + 3) * 72 + kk] = f2bf(v[i][3]);
    }
    __syncthreads();
#pragma unroll
    for (int j = 0; j < 2; ++j) {
      const int c = tid + NTHR * j, nn = c >> 3, k8 = (c & 7) * 8;
      const uint4 o = *reinterpret_cast<const uint4*>(tile + nn * 72 + k8);
      *reinterpret_cast<uint4*>(dst + (size_t)rowmap(n0 + nn) * K + k0 + k8) = o;
    }
    __syncthreads();
  }
}

DI void ph_convert(const Params& p, char* smem) {
  const int nb = gridDim.x;
  int bid = obid();
  for (int idx = bid * NTHR + otid(); idx < SEQ * 56; idx += nb * NTHR) {
    const int pos = idx / 56, f = idx - pos * 56;
    float inv;
    if (f < 32) inv = exp2f(-(float)f * (13.287712379549449f / 32.f));
    else if (f < 40) inv = exp2f(-(float)(f - 32) * (18.931568569324174f / 8.f));
    else inv = exp2f(-(float)(f - 40) * (18.931568569324174f / 16.f));
    float sn, cs;
    sincosf((float)pos * inv, &sn, &cs);
    p.rtab[(size_t)idx * 2] = cs;
    p.rtab[(size_t)idx * 2 + 1] = sn;
  }
  auto ident = [](int n) { return n; };
  for (int L = 0; L < 2; ++L) {
    transpose_convert(p.w_in + (size_t)L * DM * PW, DM, PW, PWP, p.WinT + (size_t)L * PWP * DM, ident, bid, nb, smem);
    transpose_convert(p.w_uq + (size_t)L * 256 * 384, 256, 384, 384, p.WuqT + (size_t)L * 384 * 256, ident, bid, nb, smem);
    transpose_convert(p.w_ukv + (size_t)L * 128 * 512, 128, 512, 512, p.WukvT + (size_t)L * 512 * 128, ident, bid, nb, smem);
    transpose_convert(p.w_out + (size_t)L * DM * DM, DM, DM, DM, p.WoutT + (size_t)L * DM * DM, ident, bid, nb, smem);
    for (int e = 0; e < 16; ++e) {
      const size_t le = (size_t)(L * 16 + e);
      auto gmap = [](int n) { return (n >> 7) * 256 + (n & 127); };
      auto umap = [](int n) { return (n >> 7) * 256 + 128 + (n & 127); };
      transpose_convert(p.w_gate + le * DM * 2048, DM, 2048, 2048, p.WguT + le * 4096 * DM, gmap, bid, nb, smem);
      transpose_convert(p.w_up + le * DM * 2048, DM, 2048, 2048, p.WguT + le * 4096 * DM, umap, bid, nb, smem);
      transpose_convert(p.w_down + le * 2048 * DM, 2048, DM, DM, p.WdT + le * DM * 2048, ident, bid, nb, smem);
    }
  }
}

template <class RowPtr, class Epi>
DI void gemm_tile(RowPtr arow, const u16* __restrict__ bt, int ldb, int K, char* smem, Epi epi) {
  u16* sa = reinterpret_cast<u16*>(smem);
  u16* sb = sa + 2 * 256 * 72;
  const int tid = otid(), wid = tid >> 6, lane = tid & 63, wr = wid >> 1, wc = wid & 1, fr = lane & 15, fq = lane >> 4;
  f32x4 acc[4][4];
#pragma unroll
  for (int m = 0; m < 4; ++m)
#pragma unroll
    for (int n = 0; n < 4; ++n) acc[m][n] = f32x4{0.f, 0.f, 0.f, 0.f};
  const int lr = tid >> 3, lc = (tid & 7) * 8;
  const u16* ap[4];
#pragma unroll
  for (int i = 0; i < 4; ++i) ap[i] = arow(lr + 64 * i) + lc;
  const u16* bp[2];
#pragma unroll
  for (int i = 0; i < 2; ++i) bp[i] = bt + (size_t)(lr + 64 * i) * ldb + lc;
  uint4 ra[4], rb[2];
  const int nk = K / 64;
#pragma unroll
  for (int i = 0; i < 4; ++i) ra[i] = *reinterpret_cast<const uint4*>(ap[i]);
#pragma unroll
  for (int i = 0; i < 2; ++i) rb[i] = *reinterpret_cast<const uint4*>(bp[i]);
#pragma unroll
  for (int i = 0; i < 4; ++i) *reinterpret_cast<uint4*>(sa + (lr + 64 * i) * 72 + lc) = ra[i];
#pragma unroll
  for (int i = 0; i < 2; ++i) *reinterpret_cast<uint4*>(sb + (lr + 64 * i) * 72 + lc) = rb[i];
  __syncthreads();
  for (int kt = 0; kt < nk; ++kt) {
    const int cur = kt & 1;
    if (kt + 1 < nk) {
#pragma unroll
      for (int i = 0; i < 4; ++i) ra[i] = *reinterpret_cast<const uint4*>(ap[i] + (kt + 1) * 64);
#pragma unroll
      for (int i = 0; i < 2; ++i) rb[i] = *reinterpret_cast<const uint4*>(bp[i] + (kt + 1) * 64);
    }
    const u16* ca = sa + cur * 256 * 72;
    const u16* cb = sb + cur * 128 * 72;
#pragma unroll
    for (int kk = 0; kk < 2; ++kk) {
      bf16x8 af[4], bfr[4];
#pragma unroll
      for (int m = 0; m < 4; ++m) af[m] = *reinterpret_cast<const bf16x8*>(ca + (wr * 64 + m * 16 + fr) * 72 + kk * 32 + fq * 8);
#pragma unroll
      for (int n = 0; n < 4; ++n) bfr[n] = *reinterpret_cast<const bf16x8*>(cb + (wc * 64 + n * 16 + fr) * 72 + kk * 32 + fq * 8);
#pragma unroll
      for (int m = 0; m < 4; ++m)
#pragma unroll
        for (int n = 0; n < 4; ++n) acc[m][n] = __builtin_amdgcn_mfma_f32_16x16x32_bf16(af[m], bfr[n], acc[m][n], 0, 0, 0);
    }
    if (kt + 1 < nk) {
      u16* na = sa + (cur ^ 1) * 256 * 72;
      u16* nbp = sb + (cur ^ 1) * 128 * 72;
#pragma unroll
      for (int i = 0; i < 4; ++i) *reinterpret_cast<uint4*>(na + (lr + 64 * i) * 72 + lc) = ra[i];
#pragma unroll
      for (int i = 0; i < 2; ++i) *reinterpret_cast<uint4*>(nbp + (lr + 64 * i) * 72 + lc) = rb[i];
    }
    __syncthreads();
  }
  epi(acc, wr, wc, fr, fq);
}

#define WAIT_V(n) asm volatile("s_waitcnt vmcnt(%0)" ::"n"(n) : "memory")
DI int lds_byte2(int r, int c) {
  const int st = (r >> 4) * 2 + (c >> 5), ob = (r & 15) * 64 + (c & 31) * 2;
  return st * 1024 + (ob ^ (((ob >> 9) & 1) << 5));
}
DI void stage_rc2(int b, int& R, int& C) {
  const int st = b >> 10, sb = b & 1023, swz = sb ^ (((sb >> 9) & 1) << 5);
  R = (st >> 1) * 16 + swz / 64;
  C = (st & 1) * 32 + (swz % 64) / 2;
}
typedef __attribute__((address_space(3))) unsigned lds_u32;
template <class RowPtr, class Epi>
DI void gemm256(RowPtr arow, const u16* __restrict__ bt, int ldb, int K, char* smem, Epi epi) {
  constexpr int TILE_B = 256 * 64 * 2, STAGE_B = 2 * TILE_B;
  const int tid = otid(), wid = tid >> 6, lane = tid & 63, wr = wid >> 2, wc = wid & 3, fr = lane & 15, fq = lane >> 4;
  const u16* ap[4];
  const u16* bp[4];
#pragma unroll
  for (int i = 0; i < 4; ++i) {
    int R, C;
    stage_rc2(wid * 1024 + i * 8192 + lane * 16, R, C);
    ap[i] = arow(R) + C;
    bp[i] = bt + (size_t)R * ldb + C;
  }
  f32x4 acc[8][4];
#pragma unroll
  for (int m = 0; m < 8; ++m)
#pragma unroll
    for (int n = 0; n < 4; ++n) acc[m][n] = f32x4{0.f, 0.f, 0.f, 0.f};
#define G2_STAGE(buf, kt)                                                                                              \
  do {                                                                                                                 \
    _Pragma("unroll") for (int i = 0; i < 4; ++i) {                                                                    \
      __builtin_amdgcn_global_load_lds((const unsigned*)(ap[i] + (kt) * 64),                                           \
                                       (lds_u32*)(smem + (buf) * STAGE_B + wid * 1024 + i * 8192), 16, 0, 0);          \
      __builtin_amdgcn_global_load_lds((const unsigned*)(bp[i] + (kt) * 64),                                           \
                                       (lds_u32*)(smem + (buf) * STAGE_B + TILE_B + wid * 1024 + i * 8192), 16, 0, 0); \
    }                                                                                                                  \
  } while (0)
  const int nt = K / 64;
  G2_STAGE(0, 0);
  WAIT_V(0);
  __syncthreads();
  for (int t = 0; t < nt; ++t) {
    const int cur = t & 1;
    if (t + 1 < nt) G2_STAGE(cur ^ 1, t + 1);
    const char* sA = smem + cur * STAGE_B;
    const char* sB = sA + TILE_B;
#pragma unroll
    for (int ks = 0; ks < 2; ++ks) {
      bf16x8 At[8], Bf[4];
#pragma unroll
      for (int m = 0; m < 8; ++m) At[m] = *reinterpret_cast<const bf16x8*>(sA + lds_byte2(wr * 128 + m * 16 + fr, ks * 32 + fq * 8));
#pragma unroll
      for (int n = 0; n < 4; ++n) Bf[n] = *reinterpret_cast<const bf16x8*>(sB + lds_byte2(wc * 64 + n * 16 + fr, ks * 32 + fq * 8));
#pragma unroll
      for (int m = 0; m < 8; ++m)
#pragma unroll
        for (int n = 0; n < 4; ++n) acc[m][n] = __builtin_amdgcn_mfma_f32_16x16x32_bf16(Bf[n], At[m], acc[m][n], 0, 0, 0);
      __builtin_amdgcn_sched_barrier(0);
    }
    WAIT_V(0);
    __syncthreads();
  }
  epi(acc, wr, wc, fr, fq);
}

namespace pg8 {
constexpr int BM = 256, BK = 64, HALF = 128, HTB = HALF * BK * 2;
DI int lds_byte(int r, int c) { const int st = (r >> 4) * 2 + (c >> 5), rr = r & 15, cc = c & 31, ob = rr * 64 + cc * 2; return st * 1024 + (ob ^ (((ob >> 9) & 1) << 5)); }
DI void stage_rc(int b, int& R, int& C) { const int st = b / 1024, sb = b % 1024, swz = sb ^ (((sb >> 9) & 1) << 5); R = (st >> 1) * 16 + swz / 64; C = (st & 1) * 32 + (swz % 64) / 2; }
DI int perm32(int rho) { const int n = rho >> 4, i = rho & 15; return 8 * (i >> 2) + 4 * n + (i & 3); }
struct Unit { int pm, pn; };
typedef __attribute__((address_space(3))) unsigned char lds_u8;
typedef __attribute__((address_space(3))) unsigned lds_u32;
typedef __attribute__((address_space(3))) bf16x8 lds_bf16x8;

template <class Cfg>
DI void gemm_phase(lds_u8* lds, const Cfg& S) {
  const int tid = otid(), wid = __builtin_amdgcn_readfirstlane(tid >> 6), lane = tid & 63, wr = wid >> 2, wc = wid & 3, fr = lane & 15, fq = lane >> 4;
  const int K = S.K, nt = K / BK;
  int R0, C0, R1, C1;
  stage_rc(tid * 16, R0, C0);
  stage_rc(tid * 16 + 8192, R1, C1);
  unsigned voffB[2];
  {
    const int Rb0 = Cfg::PERM ? ((R0 & ~31) + perm32(R0 & 31)) : R0, Rb1 = Cfg::PERM ? ((R1 & ~31) + perm32(R1 & 31)) : R1;
    voffB[0] = (unsigned)(Rb0 * K + C0) * 2u; voffB[1] = (unsigned)(Rb1 * K + C1) * 2u;
  }
  const size_t kstep = (size_t)(BK * 2);
  const size_t hstep = (size_t)HALF * K * 2;
  const unsigned ldsw = (unsigned)wid * 1024u;
  const int aoff = lds_byte(wr * 64 + fr, fq * 8), boff = lds_byte(wc * 32 + fr, fq * 8);
#define PG8_SA(b, h) (((b) * 2 + (h)) * HTB)
#define PG8_SB(b, h) ((4 + (b) * 2 + (h)) * HTB)
#define PG8_STAGE2(bufoff, gbase, o0, o1) do { \
    __builtin_amdgcn_global_load_lds((const unsigned*)((const char*)(gbase) + (o0)), (lds_u32*)(lds + (bufoff) + ldsw), 16, 0, 0); \
    __builtin_amdgcn_global_load_lds((const unsigned*)((const char*)(gbase) + (o1)), (lds_u32*)(lds + (bufoff) + ldsw + 8192), 16, 0, 0); } while (0)
#define PG8_STAGEB(bufoff, gbase) PG8_STAGE2(bufoff, gbase, voffB[0], voffB[1])
#define PG8_LDA(dst, b, h) do { _Pragma("unroll") for (int m = 0; m < 4; ++m) _Pragma("unroll") for (int k = 0; k < 2; ++k) dst[m][k] = *(const lds_bf16x8*)(lds + PG8_SA(b, h) + aoff + m * 2048 + k * 1024); } while (0)
#define PG8_LDB(dst, b, h) do { _Pragma("unroll") for (int n = 0; n < 2; ++n) _Pragma("unroll") for (int k = 0; k < 2; ++k) dst[n][k] = *(const lds_bf16x8*)(lds + PG8_SB(b, h) + boff + n * 2048 + k * 1024); } while (0)
#define PG8_MMA(ai, bj, At, Bt) do { __builtin_amdgcn_s_setprio(1); _Pragma("unroll") for (int m = 0; m < 4; ++m) _Pragma("unroll") for (int n = 0; n < 2; ++n) _Pragma("unroll") for (int k = 0; k < 2; ++k) \
    acc[ai][bj][m][n] = __builtin_amdgcn_mfma_f32_16x16x32_bf16(Bt[n][k], At[m][k], acc[ai][bj][m][n], 0, 0, 0); __builtin_amdgcn_s_setprio(0); } while (0)
#define PG8_WAIT_V(n) asm volatile("s_waitcnt vmcnt(" #n ")" ::: "memory")
#define PG8_WAIT_L(n) asm volatile("s_waitcnt lgkmcnt(" #n ")" ::: "memory")
#define PG8_BAR __builtin_amdgcn_s_barrier()
#define PG8_SCHED __builtin_amdgcn_sched_barrier(0)
  Unit cur, nxt; int ui = 0;
  if (!S.next(0, cur)) return;
  f32x4 acc[2][2][4][2];
#pragma unroll
  for (int a = 0; a < 2; ++a)
#pragma unroll
    for (int b = 0; b < 2; ++b)
#pragma unroll
      for (int m = 0; m < 4; ++m)
#pragma unroll
        for (int n = 0; n < 2; ++n) acc[a][b][m][n] = f32x4{0.f, 0.f, 0.f, 0.f};
  bf16x8 At[4][2], B0[2][2], B1[2][2];
  const char* cA = S.a_base(cur);
  const char* cB = S.b_base(cur);
  unsigned vc[4], vn[4];
  S.a_off(cur, R0, C0, R1, C1, vc);
  PG8_STAGEB(PG8_SB(0, 0), cB); PG8_STAGE2(PG8_SA(0, 0), cA, vc[0], vc[1]); PG8_STAGEB(PG8_SB(0, 1), cB + hstep); PG8_STAGE2(PG8_SA(0, 1), cA, vc[2], vc[3]);
  if (wr == 1) PG8_BAR;
  PG8_WAIT_V(4); PG8_BAR;
  PG8_STAGEB(PG8_SB(1, 0), cB + kstep); PG8_STAGE2(PG8_SA(1, 0), cA + kstep, vc[0], vc[1]); PG8_STAGEB(PG8_SB(1, 1), cB + hstep + kstep);
  PG8_WAIT_V(6); PG8_BAR;
  for (;;) {
    const bool has_next = S.next(ui + 1, nxt);
    const char* nA = has_next ? S.a_base(nxt) : cA;
    const char* nB = has_next ? S.b_base(nxt) : cB;
    if (has_next) S.a_off(nxt, R0, C0, R1, C1, vn);
    else { vn[0] = vc[0]; vn[1] = vc[1]; vn[2] = vc[2]; vn[3] = vc[3]; }
    for (int t = 0; t < nt; t += 2) {
      const bool last = (t == nt - 2);
      const char* a1 = cA + (size_t)(t + 1) * kstep;
      const char* a2 = last ? nA : cA + (size_t)(t + 2) * kstep;
      const char* b2 = last ? nB : cB + (size_t)(t + 2) * kstep;
      const char* a3 = a2 + kstep;
      const char* b3 = b2 + kstep;
      const unsigned w0 = last ? vn[0] : vc[0], w1 = last ? vn[1] : vc[1], w2 = last ? vn[2] : vc[2], w3 = last ? vn[3] : vc[3];
      PG8_LDB(B0, 0, 0); PG8_SCHED; PG8_LDA(At, 0, 0); PG8_STAGE2(PG8_SA(1, 1), a1, vc[2], vc[3]);
      PG8_WAIT_L(8); PG8_BAR; PG8_WAIT_L(0); PG8_MMA(0, 0, At, B0); PG8_BAR; PG8_SCHED;
      PG8_LDB(B1, 0, 1); PG8_STAGEB(PG8_SB(0, 0), b2);
      PG8_BAR; PG8_WAIT_L(0); PG8_MMA(0, 1, At, B1); PG8_BAR;
      PG8_LDA(At, 0, 1); PG8_STAGE2(PG8_SA(0, 0), a2, w0, w1);
      PG8_BAR; PG8_WAIT_L(0); PG8_MMA(1, 0, At, B0); PG8_BAR; PG8_SCHED;
      PG8_STAGEB(PG8_SB(0, 1), b2 + hstep);
      PG8_WAIT_V(6); PG8_BAR; PG8_MMA(1, 1, At, B1); PG8_BAR;
      PG8_LDB(B0, 1, 0); PG8_SCHED; PG8_LDA(At, 1, 0); PG8_STAGE2(PG8_SA(0, 1), a2, w2, w3);
      PG8_WAIT_L(8); PG8_BAR; PG8_WAIT_L(0); PG8_MMA(0, 0, At, B0); PG8_BAR; PG8_SCHED;
      PG8_LDB(B1, 1, 1); PG8_STAGEB(PG8_SB(1, 0), b3);
      PG8_BAR; PG8_WAIT_L(0); PG8_MMA(0, 1, At, B1); PG8_BAR;
      PG8_LDA(At, 1, 1); PG8_STAGE2(PG8_SA(1, 0), a3, w0, w1);
      PG8_BAR; PG8_WAIT_L(0); PG8_MMA(1, 0, At, B0); PG8_BAR; PG8_SCHED;
      PG8_STAGEB(PG8_SB(1, 1), b3 + hstep);
      PG8_WAIT_V(6); PG8_BAR; PG8_MMA(1, 1, At, B1); PG8_BAR;
    }
    S.epi(acc, cur, wr, wc, fr, fq);
    if (!has_next) break;
#pragma unroll
    for (int a = 0; a < 2; ++a)
#pragma unroll
      for (int b = 0; b < 2; ++b)
#pragma unroll
        for (int m = 0; m < 4; ++m)
#pragma unroll
          for (int n = 0; n < 2; ++n) acc[a][b][m][n] = f32x4{0.f, 0.f, 0.f, 0.f};
    cur = nxt; cA = nA; cB = nB; ++ui;
    vc[0] = vn[0]; vc[1] = vn[1]; vc[2] = vn[2]; vc[3] = vn[3];
  }
  PG8_WAIT_V(0);
  if (wr == 0) PG8_BAR;
  PG8_BAR;
#undef PG8_SA
#undef PG8_SB
#undef PG8_STAGE2
#undef PG8_STAGEB
#undef PG8_LDA
#undef PG8_LDB
#undef PG8_MMA
#undef PG8_WAIT_V
#undef PG8_WAIT_L
#undef PG8_BAR
#undef PG8_SCHED
}
}

struct CfgInproj {
  static constexpr bool PERM = true;
  int K; const Params* p; int L; int bid, nb;
  DI bool next(int i, pg8::Unit& u) const { const int t = i * nb + bid; if (t >= 64 * 13) return false; u.pm = t & 63; u.pn = t >> 6; return true; }
  DI const char* a_base(const pg8::Unit& u) const { return (const char*)(p->hn + (size_t)u.pm * 256 * DM); }
  DI const char* b_base(const pg8::Unit& u) const { return (const char*)(p->WinT + ((size_t)L * PWP + (size_t)u.pn * 256) * DM); }
  DI void a_off(const pg8::Unit&, int R0, int C0, int R1, int C1, unsigned (&vo)[4]) const {
    vo[0] = (unsigned)(R0 * DM + C0) * 2u; vo[1] = (unsigned)(R1 * DM + C1) * 2u;
    vo[2] = vo[0] + 128u * DM * 2u; vo[3] = vo[1] + 128u * DM * 2u;
  }
  DI void epi(const f32x4 (&acc)[2][2][4][2], const pg8::Unit& u, int wr, int wc, int fr, int fq) const {
    const int row0 = u.pm * 256 + wr * 64 + fr, col0 = u.pn * 256 + wc * 32 + 8 * fq;
#pragma unroll
    for (int ai = 0; ai < 2; ++ai)
#pragma unroll
      for (int m = 0; m < 4; ++m) {
        u16* rowp = p->proj + (size_t)(row0 + ai * 128 + m * 16) * PWP + col0;
#pragma unroll
        for (int bj = 0; bj < 2; ++bj) {
          uint4 w;
          w.x = pack2(acc[ai][bj][m][0][0], acc[ai][bj][m][0][1]); w.y = pack2(acc[ai][bj][m][0][2], acc[ai][bj][m][0][3]);
          w.z = pack2(acc[ai][bj][m][1][0], acc[ai][bj][m][1][1]); w.w = pack2(acc[ai][bj][m][1][2], acc[ai][bj][m][1][3]);
          *reinterpret_cast<uint4*>(rowp + bj * 128) = w;
        }
      }
  }
};
DI void ph_inproj_tail(const Params& p, int L, char* smem, int t) {
  const int m0 = (t & 63) * 256, n0 = 3072 + (t >> 6) * 128;
  const u16* Bt = p.WinT + ((size_t)L * PWP + n0) * DM;
  gemm_tile([&](int r) { return p.hn + (size_t)(m0 + r) * DM; }, Bt, DM, DM, smem,
            [&](f32x4 (&acc)[4][4], int wr, int wc, int fr, int fq) {
#pragma unroll
              for (int m = 0; m < 4; ++m)
#pragma unroll
                for (int n = 0; n < 4; ++n)
#pragma unroll
                  for (int j = 0; j < 4; ++j)
                    p.proj[(size_t)(m0 + wr * 64 + m * 16 + fq * 4 + j) * PWP + n0 + wc * 64 + n * 16 + fr] = f2bf(acc[m][n][j]);
            });
}
DI void ph_inproj(const Params& p, int L, char* smem) {
  CfgInproj c; c.K = DM; c.p = &p; c.L = L; c.bid = obid(); c.nb = gridDim.x;
  pg8::gemm_phase((pg8::lds_u8*)smem, c);
}

DI void ph_gemm_store_bf16(const u16* A, int lda, const u16* Bt, int K, int M, int N, u16* C, int ldc, char* smem, int rot) {
  const int mt = M / 256, nt = N / 128;
  const int nb = gridDim.x;
  for (int t = (obid() + rot) % nb; t < mt * nt; t += nb) {
    const int m0 = (t % mt) * 256, n0 = (t / mt) * 128;
    gemm_tile([&](int r) { return A + (size_t)(m0 + r) * lda; }, Bt + (size_t)n0 * K, K, K, smem,
              [&](f32x4 (&acc)[4][4], int wr, int wc, int fr, int fq) {
#pragma unroll
                for (int m = 0; m < 4; ++m)
#pragma unroll
                  for (int n = 0; n < 4; ++n)
#pragma unroll
                    for (int j = 0; j < 4; ++j) {
                      const int row = m0 + wr * 64 + m * 16 + fq * 4 + j, col = n0 + wc * 64 + n * 16 + fr;
                      C[(size_t)row * ldc + col] = f2bf(acc[m][n][j]);
                    }
              });
  }
}

DI void ph_rmsnorm_bf16(const float* __restrict__ xin, const float* __restrict__ w, u16* __restrict__ outp) {
  const int tid_ = otid(); const int lane = tid_ & 63, gw = (obid() * NTHR + tid_) >> 6, nw = gridDim.x * (NTHR / 64);
  for (int t = gw; t < T; t += nw) {
    const float* xr = xin + (size_t)t * DM;
    float4 v[4];
    float ss = 0.f;
#pragma unroll
    for (int i = 0; i < 4; ++i) {
      v[i] = *reinterpret_cast<const float4*>(xr + (i * 64 + lane) * 4);
      ss += v[i].x * v[i].x + v[i].y * v[i].y + v[i].z * v[i].z + v[i].w * v[i].w;
    }
    ss = wave_sum(ss);
    const float rstd = rsqrtf(ss * (1.f / DM) + 1e-6f);
#pragma unroll
    for (int i = 0; i < 4; ++i) {
      const int c = (i * 64 + lane) * 4;
      const float4 ww = *reinterpret_cast<const float4*>(w + c);
      uint2 o;
      o.x = pack2(v[i].x * rstd * ww.x, v[i].y * rstd * ww.y);
      o.y = pack2(v[i].z * rstd * ww.z, v[i].w * rstd * ww.w);
      *reinterpret_cast<uint2*>(outp + (size_t)t * DM + c) = o;
    }
  }
}

DI void ph_final_norm(const float* __restrict__ xin, const float* __restrict__ w, float* __restrict__ outp) {
  const int tid_ = otid(); const int lane = tid_ & 63, gw = (obid() * NTHR + tid_) >> 6, nw = gridDim.x * (NTHR / 64);
  for (int t = gw; t < T; t += nw) {
    const float* xr = xin + (size_t)t * DM;
    float4 v[4];
    float ss = 0.f;
#pragma unroll
    for (int i = 0; i < 4; ++i) {
      v[i] = *reinterpret_cast<const float4*>(xr + (i * 64 + lane) * 4);
      ss += v[i].x * v[i].x + v[i].y * v[i].y + v[i].z * v[i].z + v[i].w * v[i].w;
    }
    ss = wave_sum(ss);
    const float rstd = rsqrtf(ss * (1.f / DM) + 1e-6f);
#pragma unroll
    for (int i = 0; i < 4; ++i) {
      const int c = (i * 64 + lane) * 4;
      const float4 ww = *reinterpret_cast<const float4*>(w + c);
      float4 o = make_float4(v[i].x * rstd * ww.x, v[i].y * rstd * ww.y, v[i].z * rstd * ww.z, v[i].w * rstd * ww.w);
      *reinterpret_cast<float4*>(outp + (size_t)t * DM + c) = o;
    }
  }
}

DI void rot8(const u16* x1p, const u16* x2p, const float* tab  , float scale, uint4& o1, uint4& o2) {
  float x1[8], x2[8], y1[8], y2[8];
  ld8(x1p, x1); ld8(x2p, x2);
#pragma unroll
  for (int e = 0; e < 8; e += 2) {
    const float4 cs = *reinterpret_cast<const float4*>(tab + e * 2);
    y1[e] = (x1[e] * cs.x - x2[e] * cs.y) * scale;
    y2[e] = (x2[e] * cs.x + x1[e] * cs.y) * scale;
    y1[e + 1] = (x1[e + 1] * cs.z - x2[e + 1] * cs.w) * scale;
    y2[e + 1] = (x2[e + 1] * cs.z + x1[e + 1] * cs.w) * scale;
  }
  o1.x = pack2(y1[0], y1[1]); o1.y = pack2(y1[2], y1[3]); o1.z = pack2(y1[4], y1[5]); o1.w = pack2(y1[6], y1[7]);
  o2.x = pack2(y2[0], y2[1]); o2.y = pack2(y2[2], y2[3]); o2.z = pack2(y2[4], y2[5]); o2.w = pack2(y2[6], y2[7]);
}
DI void ph_post(const Params& p, int L) {
  const int tid = otid();
  const int gt = obid() * NTHR + tid, gs = gridDim.x * NTHR;
  const int lane = tid & 63, gw = gt >> 6, nw = gs >> 6;
  const float* qnw = p.q_norm_w + L * 256;
  const float* kvnw = p.kv_norm_w + L * 128;
  const float* cw = p.conv_w + L * 5 * 768;
  const float* cb = p.conv_b + L * 768;
  const float* dtb = p.dt_bias + L * 8;
  for (int idx = gt; idx < T * 96; idx += gs) {
    const int t = idx / 96, cg = idx - t * 96, s = t & (SEQ - 1);
    float acc[8];
    {
      const float4 b0 = *reinterpret_cast<const float4*>(cb + cg * 8), b1 = *reinterpret_cast<const float4*>(cb + cg * 8 + 4);
      acc[0] = b0.x; acc[1] = b0.y; acc[2] = b0.z; acc[3] = b0.w; acc[4] = b1.x; acc[5] = b1.y; acc[6] = b1.z; acc[7] = b1.w;
    }
#pragma unroll
    for (int w = 0; w < 5; ++w) {
      const int ss = s + w - 2;
      if (ss >= 0 && ss < SEQ) {
        float xv[8];
        ld8(p.proj + (size_t)(t + w - 2) * PWP + C_XBC + cg * 8, xv);
        const float4 w0 = *reinterpret_cast<const float4*>(cw + w * 768 + cg * 8), w1 = *reinterpret_cast<const float4*>(cw + w * 768 + cg * 8 + 4);
        acc[0] += xv[0] * w0.x; acc[1] += xv[1] * w0.y; acc[2] += xv[2] * w0.z; acc[3] += xv[3] * w0.w;
        acc[4] += xv[4] * w1.x; acc[5] += xv[5] * w1.y; acc[6] += xv[6] * w1.z; acc[7] += xv[7] * w1.w;
      }
    }
    uint4 o;
    o.x = pack2(fast_silu(acc[0]), fast_silu(acc[1])); o.y = pack2(fast_silu(acc[2]), fast_silu(acc[3]));
    o.z = pack2(fast_silu(acc[4]), fast_silu(acc[5])); o.w = pack2(fast_silu(acc[6]), fast_silu(acc[7]));
    *reinterpret_cast<uint4*>(p.xbc + (size_t)t * 768 + cg * 8) = o;
  }
  for (int idx = gt; idx < T * 8; idx += gs) {
    const int t = idx >> 3, k = idx & 7;
    const float v = bf2f(p.proj[(size_t)t * PWP + C_DT + k]) + dtb[k];
    p.dtv[idx] = (v > 20.f) ? v : log1pf(expf(v));
  }
  {
    const int sub = lane >> 4, l16 = lane & 15;
    for (int t = gw * 4 + sub; t < T; t += nw * 4) {
      const u16* pr = p.proj + (size_t)t * PWP;
      float v[16], u[8];
      ld8(pr + C_CQ + l16 * 16, v); ld8(pr + C_CQ + l16 * 16 + 8, v + 8);
      ld8(pr + C_CKV + l16 * 8, u);
      float ss = 0.f, s2 = 0.f;
#pragma unroll
      for (int i = 0; i < 16; ++i) ss += v[i] * v[i];
#pragma unroll
      for (int i = 0; i < 8; ++i) s2 += u[i] * u[i];
#pragma unroll
      for (int o = 1; o < 16; o <<= 1) { ss += __shfl_xor(ss, o); s2 += __shfl_xor(s2, o); }
      const float rstd = rsqrtf(ss * (1.f / 256.f) + 1e-6f), r2 = rsqrtf(s2 * (1.f / 128.f) + 1e-6f);
      uint4 o;
      const float* qw = qnw + l16 * 16;
      o.x = pack2(v[0] * rstd * qw[0], v[1] * rstd * qw[1]); o.y = pack2(v[2] * rstd * qw[2], v[3] * rstd * qw[3]);
      o.z = pack2(v[4] * rstd * qw[4], v[5] * rstd * qw[5]); o.w = pack2(v[6] * rstd * qw[6], v[7] * rstd * qw[7]);
      *reinterpret_cast<uint4*>(p.cqn + (size_t)t * 256 + l16 * 16) = o;
      o.x = pack2(v[8] * rstd * qw[8], v[9] * rstd * qw[9]); o.y = pack2(v[10] * rstd * qw[10], v[11] * rstd * qw[11]);
      o.z = pack2(v[12] * rstd * qw[12], v[13] * rstd * qw[13]); o.w = pack2(v[14] * rstd * qw[14], v[15] * rstd * qw[15]);
      *reinterpret_cast<uint4*>(p.cqn + (size_t)t * 256 + l16 * 16 + 8) = o;
      const float* kw = kvnw + l16 * 8;
      o.x = pack2(u[0] * r2 * kw[0], u[1] * r2 * kw[1]); o.y = pack2(u[2] * r2 * kw[2], u[3] * r2 * kw[3]);
      o.z = pack2(u[4] * r2 * kw[4], u[5] * r2 * kw[5]); o.w = pack2(u[6] * r2 * kw[6], u[7] * r2 * kw[7]);
      *reinterpret_cast<uint4*>(p.ckvn + (size_t)t * 128 + l16 * 8) = o;
    }
  }
  for (int idx = gt; idx < T * 42; idx += gs) {
    const int t = idx / 42, ri = idx - t * 42, s = t & (SEQ - 1);
    u16* pr = p.proj + (size_t)t * PWP;
    uint4 o1, o2;
    if (ri < 32) {
      const int isk = ri >> 4, h = (ri >> 2) & 3, i0 = (ri & 3) * 8;
      u16* a = pr + (isk ? C_RK : C_RQ) + h * 64 + i0;
      rot8(a, a + 32, p.rtab + ((size_t)s * 56 + i0) * 2, isk ? 1.f : 0.125f, o1, o2);
      *reinterpret_cast<uint4*>(a) = o1;
      *reinterpret_cast<uint4*>(a + 32) = o2;
    } else if (ri < 40) {
      const int j = ri - 32, isk = j >> 2, h = j & 3;
      u16* a = pr + (isk ? C_DK : C_DQ) + h * 64;
      rot8(a, a + 8, p.rtab + ((size_t)s * 56 + 32) * 2, 1.f, o1, o2);
      *reinterpret_cast<uint4*>(a) = o1;
      *reinterpret_cast<uint4*>(a + 8) = o2;
    } else {
      const int i0 = (ri - 40) * 8;
      u16* a = pr + C_KR + i0;
      rot8(a, a + 16, p.rtab + ((size_t)s * 56 + 40 + i0) * 2, 1.f, o1, o2);
      *reinterpret_cast<uint4*>(a) = o1;
      *reinterpret_cast<uint4*>(a + 16) = o2;
      const int bb = t >> 12;
#pragma unroll
      for (int hd = 0; hd < 4; ++hd) {
        u16* kf = p.kfull + ((size_t)(bb * 4 + hd) * SEQ + s) * 96 + 64 + i0;
        *reinterpret_cast<uint4*>(kf) = o1;
        *reinterpret_cast<uint4*>(kf + 16) = o2;
      }
    }
  }
}

DI void ph_mla_up_q(const Params& p, int L, char* smem, int t) {
  const int mt = T / 256;
  const u16* Bq = p.WuqT + (size_t)L * 384 * 256;
  {
    const int m0 = (t % mt) * 256, n0 = (t / mt) * 128;
    gemm_tile([&](int r) { return p.cqn + (size_t)(m0 + r) * 256; }, Bq + (size_t)n0 * 256, 256, 256, smem,
              [&](f32x4 (&acc)[4][4], int wr, int wc, int fr, int fq) {
                const float scale = 0.10206207261596575f * 1.4426950408889634f;
#pragma unroll
                for (int m = 0; m < 4; ++m)
#pragma unroll
                  for (int j = 0; j < 4; ++j) {
                    const int row = m0 + wr * 64 + m * 16 + fq * 4 + j;
                    const float2 cssn = *reinterpret_cast<const float2*>(p.rtab + ((size_t)(row & (SEQ - 1)) * 56 + 40 + fr) * 2);
                    const float cs = cssn.x, sn = cssn.y;
#pragma unroll
                    for (int n2 = 0; n2 < 4; n2 += 2) {
                      const int cb = n0 + wc * 64 + n2 * 16;
                      float x1 = acc[m][n2][j], x2 = acc[m][n2 + 1][j];
                      if (cb % 96 == 64) {
                        const float y1 = x1 * cs - x2 * sn, y2 = x2 * cs + x1 * sn;
                        x1 = y1; x2 = y2;
                      }
                      p.mq[(size_t)row * 384 + cb + fr] = f2bf(x1 * scale);
                      p.mq[(size_t)row * 384 + cb + 16 + fr] = f2bf(x2 * scale);
                    }
                  }
              });
  }
}
DI void ph_mla_up_kv(const Params& p, int L, char* smem, int t) {
  const int mt = T / 256;
  const u16* Bkv = p.WukvT + (size_t)L * 512 * 128;
  {
    const int m0 = (t % mt) * 256, h = t / mt, n0 = h * 128;
    gemm_tile([&](int r) { return p.ckvn + (size_t)(m0 + r) * 128; }, Bkv + (size_t)n0 * 128, 128, 128, smem,
              [&](f32x4 (&acc)[4][4], int wr, int wc, int fr, int fq) {
#pragma unroll
                for (int m = 0; m < 4; ++m) {
                  const int row = m0 + wr * 64 + m * 16 + fq * 4;
                  const int bb = row >> 12, sq = row & (SEQ - 1);
                  const size_t bh = (size_t)(bb * 4 + h);
#pragma unroll
                  for (int n = 0; n < 4; ++n) {
                    if (wc == 0) {
#pragma unroll
                      for (int j = 0; j < 4; ++j) p.kfull[(bh * SEQ + sq + j) * 96 + n * 16 + fr] = f2bf(acc[m][n][j]);
                    } else {
                      uint2 v;
                      v.x = pack2(acc[m][n][0], acc[m][n][1]);
                      v.y = pack2(acc[m][n][2], acc[m][n][3]);
                      const int sqp = (sq & ~12) | ((sq & 4) << 1) | ((sq & 8) >> 1);
                      *reinterpret_cast<uint2*>(p.vT + (bh * 64 + n * 16 + fr) * SEQ + sqp) = v;
                    }
                  }
                }
              });
  }
}

DI void ph_cumsum(const Params& p, int L) {
  const int tid_ = otid(); const int lane = tid_ & 63, gw = (obid() * NTHR + tid_) >> 6, nw = gridDim.x * (NTHR / 64);
  for (int it = gw; it < 32; it += nw) {
    const int h = it & 3, dir = (it >> 2) & 1, b = it >> 3;
    const float a = -expf(p.a_log[L * 8 + dir * 4 + h]);
    float running = 0.f;
    for (int c = 0; c < 64; ++c) {
      const int i = c * 64 + lane;
      const int s = dir ? (SEQ - 1 - i) : i;
      const size_t off = (size_t)(b * SEQ + s) * 8 + dir * 4 + h;
      float v = p.dtv[off] * a;
#pragma unroll
      for (int o = 1; o < 64; o <<= 1) {
        const float u = __shfl_up(v, o);
        if (lane >= o) v += u;
      }
      v += running;
      p.cs[off] = v;
      running = __shfl(v, 63);
    }
  }
}

DI void ph_ret_naive(const Params& p) {
  const int gt = obid() * NTHR + otid(), gs = gridDim.x * NTHR;
  for (int it = gt; it < 4 * 4 * SEQ; it += gs) {
    const int n = it & (SEQ - 1), h = (it >> 12) & 3, b = it >> 14;
    const u16* base = p.proj + (size_t)(b * SEQ) * PWP;
    uint4 qp[8];
    float o[64];
#pragma unroll
    for (int d = 0; d < 8; ++d) qp[d] = *reinterpret_cast<const uint4*>(base + (size_t)n * PWP + C_RQ + h * 64 + d * 8);
#pragma unroll
    for (int d = 0; d < 64; ++d) o[d] = 0.f;
    const float lg0 = log1pf(-exp2f(-5.f - (float)h)), lg1 = log1pf(-exp2f(-5.5f - (float)h));
#pragma unroll 1
    for (int m = 0; m < SEQ; ++m) {
      const u16* kr = base + (size_t)m * PWP + C_RK + h * 64;
      const u16* vr = base + (size_t)m * PWP + C_RV + h * 64;
      float s = 0.f;
#pragma unroll
      for (int d = 0; d < 8; ++d) s = dot8(qp[d], *reinterpret_cast<const uint4*>(kr + d * 8), s);
      const float w = (m <= n) ? expf(lg0 * (float)(n - m)) : expf(lg1 * (float)(m - n));
      s *= w;
#pragma unroll
      for (int d = 0; d < 64; d += 8) {
        float vf[8];
        ld8(vr + d, vf);
#pragma unroll
        for (int j = 0; j < 8; ++j) o[d + j] += s * vf[j];
      }
    }
    float mu = 0.f;
#pragma unroll
    for (int d = 0; d < 64; ++d) mu += o[d];
    mu *= (1.f / 64.f);
    float var = 0.f;
#pragma unroll
    for (int d = 0; d < 64; ++d) var += (o[d] - mu) * (o[d] - mu);
    var *= (1.f / 64.f);
    const float rs = rsqrtf(var + 1e-5f);
    const size_t t = (size_t)b * SEQ + n;
#pragma unroll
    for (int d = 0; d < 64; d += 8) {
      float g[8];
      ld8(p.proj + t * PWP + C_RG + h * 64 + d, g);
      uint4 ov;
      ov.x = pack2(silu(g[0]) * (o[d + 0] - mu) * rs, silu(g[1]) * (o[d + 1] - mu) * rs);
      ov.y = pack2(silu(g[2]) * (o[d + 2] - mu) * rs, silu(g[3]) * (o[d + 3] - mu) * rs);
      ov.z = pack2(silu(g[4]) * (o[d + 4] - mu) * rs, silu(g[5]) * (o[d + 5] - mu) * rs);
      ov.w = pack2(silu(g[6]) * (o[d + 6] - mu) * rs, silu(g[7]) * (o[d + 7] - mu) * rs);
      *reinterpret_cast<uint4*>(p.mixed + t * DM + h * 64 + d) = ov;
    }
  }
}

DI void ph_mla_naive(const Params& p) {
  const int gt = obid() * NTHR + otid(), gs = gridDim.x * NTHR;
  for (int it = gt; it < 2 * 4 * 4 * SEQ; it += gs) {
    const int n = it & (SEQ - 1), vh = (it >> 12) & 1, h = (it >> 13) & 3, b = it >> 15;
    const size_t t = (size_t)b * SEQ + n;
    uint4 qp[12];
    float o[32];
#pragma unroll
    for (int d = 0; d < 12; ++d) qp[d] = *reinterpret_cast<const uint4*>(p.mq + t * 384 + h * 96 + d * 8);
    const size_t tb = (size_t)b * SEQ;
    float mx = -1e30f;
#pragma unroll 1
    for (int m = 0; m < SEQ; ++m) {
      const u16* kn = p.mkv + (tb + m) * 512 + h * 128;
      const u16* kr = p.proj + (tb + m) * PWP + C_KR;
      float s = 0.f;
#pragma unroll
      for (int d = 0; d < 8; ++d) s = dot8(qp[d], *reinterpret_cast<const uint4*>(kn + d * 8), s);
#pragma unroll
      for (int d = 0; d < 4; ++d) s = dot8(qp[8 + d], *reinterpret_cast<const uint4*>(kr + d * 8), s);
      mx = fmaxf(mx, s);
    }
#pragma unroll
    for (int d = 0; d < 32; ++d) o[d] = 0.f;
    float l = 0.f;
#pragma unroll 1
    for (int m = 0; m < SEQ; ++m) {
      const u16* kn = p.mkv + (tb + m) * 512 + h * 128;
      const u16* kr = p.proj + (tb + m) * PWP + C_KR;
      float s = 0.f;
#pragma unroll
      for (int d = 0; d < 8; ++d) s = dot8(qp[d], *reinterpret_cast<const uint4*>(kn + d * 8), s);
#pragma unroll
      for (int d = 0; d < 4; ++d) s = dot8(qp[8 + d], *reinterpret_cast<const uint4*>(kr + d * 8), s);
      const float pe = exp2f(s - mx);
      l += pe;
#pragma unroll
      for (int d = 0; d < 32; d += 8) {
        float vf[8];
        ld8(kn + 64 + vh * 32 + d, vf);
#pragma unroll
        for (int j = 0; j < 8; ++j) o[d + j] += pe * vf[j];
      }
    }
    const float il = 1.f / l;
#pragma unroll
    for (int d = 0; d < 32; d += 8) {
      uint4 ov;
      ov.x = pack2(o[d + 0] * il, o[d + 1] * il);
      ov.y = pack2(o[d + 2] * il, o[d + 3] * il);
      ov.z = pack2(o[d + 4] * il, o[d + 5] * il);
      ov.w = pack2(o[d + 6] * il, o[d + 7] * il);
      *reinterpret_cast<uint4*>(p.mixed + t * DM + 256 + h * 64 + vh * 32 + d) = ov;
    }
  }
}

#define MFMA32(a, b, c) __builtin_amdgcn_mfma_f32_32x32x16_bf16((a), (b), (c), 0, 0, 0)
DI float max16(const f32x16& v) {
  float a = fmaxf(fmaxf(v[0], v[1]), v[2]), b = fmaxf(fmaxf(v[3], v[4]), v[5]), c = fmaxf(fmaxf(v[6], v[7]), v[8]);
  float d = fmaxf(fmaxf(v[9], v[10]), v[11]), e = fmaxf(fmaxf(v[12], v[13]), v[14]);
  return fmaxf(fmaxf(fmaxf(a, b), fmaxf(c, d)), fmaxf(e, v[15]));
}
DI void ph_mla_attn(const Params& p, char* smem) {
  const int tid = otid(), wid = tid >> 6, lane = tid & 63, l32 = lane & 31, hh = lane >> 5;
  u16* sK = reinterpret_cast<u16*>(smem);
  u16* sV = sK + 2 * 128 * 104;
  uint4 konev = make_uint4(hh == 0 ? 0x00003F80u : 0u, 0u, 0u, 0u);
  const bf16x8 kone = __builtin_bit_cast(bf16x8, konev);
  for (int item = obid(); item < 256; item += gridDim.x) {
    const int xcd_ = item & 7, jx_ = item >> 3, bh = xcd_ * 2 + (jx_ >> 4), qt = jx_ & 15, b = bh >> 2, h = bh & 3;
    const size_t t0 = (size_t)b * SEQ + qt * 256 + wid * 32;
    bf16x8 qf[6];
#pragma unroll
    for (int ks = 0; ks < 6; ++ks) qf[ks] = *reinterpret_cast<const bf16x8*>(p.mq + (t0 + l32) * 384 + h * 96 + ks * 16 + hh * 8);
    const u16* kg = p.kfull + (size_t)bh * SEQ * 96;
    const u16* vg = p.vT + (size_t)bh * 64 * SEQ;
    f32x16 o0, o1;
#pragma unroll
    for (int i = 0; i < 16; ++i) { o0[i] = 0.f; o1[i] = 0.f; }
    float m = 0.f, l = 0.f;
    bf16x8 qf6 = __builtin_bit_cast(bf16x8, make_uint4(0u, 0u, 0u, 0u));
    const int kr0 = tid / 12, kc0 = tid % 12, kr1 = (512 + tid) / 12, kc1 = (512 + tid) % 12, kr2 = (1024 + tid) / 12, kc2 = (1024 + tid) % 12;
    const int vd0 = tid >> 4, vd1 = 32 + (tid >> 4), vkc = (tid & 15) * 8;
    uint4 ak0, ak1, ak2, av0, av1;
#define MLA_LD(dst_, ptr_) asm volatile("global_load_dwordx4 %0, %1, off" : "=v"(dst_) : "v"(ptr_) : "memory")
#define MLA_GLOAD(K0, K1, K2, V0, V1, kt_)                                               \
    {                                                                                    \
      const u16* kb_ = kg + (size_t)(kt_) * 128 * 96 + tid * 8;                          \
      MLA_LD(K0, kb_); MLA_LD(K1, kb_ + 512 * 8); MLA_LD(K2, kb_ + 1024 * 8);            \
      const u16* vp_ = vg + (size_t)vd0 * SEQ + (kt_) * 128 + vkc;                       \
      MLA_LD(V0, vp_); MLA_LD(V1, vp_ + (size_t)32 * SEQ);                               \
    }
#define MLA_SSTORE(K0, K1, K2, V0, V1, buf_)                                             \
    {                                                                                    \
      u16* kb_ = sK + (buf_) * 128 * 104;                                                \
      u16* vb_ = sV + (buf_) * 64 * 136;                                                 \
      *reinterpret_cast<uint4*>(kb_ + kr0 * 104 + kc0 * 8) = K0;                         \
      *reinterpret_cast<uint4*>(kb_ + kr1 * 104 + kc1 * 8) = K1;                         \
      *reinterpret_cast<uint4*>(kb_ + kr2 * 104 + kc2 * 8) = K2;                         \
      *reinterpret_cast<uint4*>(vb_ + vd0 * 136 + vkc) = V0;                             \
      *reinterpret_cast<uint4*>(vb_ + vd1 * 136 + vkc) = V1;                             \
    }
    float mxrun = 0.f;
#define SGB(mask, n) __builtin_amdgcn_sched_group_barrier((mask), (n), 0)
#define MLA_KFRAG(kb_, sub_, ks_) (*reinterpret_cast<const bf16x8*>((kb_) + ((sub_) * 32 + l32) * 104 + (ks_) * 16 + hh * 8))
#define MLA_VFRAG(dst_, vb_, sub_, ks2_, dvt_) \
    dst_ = *reinterpret_cast<const bf16x8*>((vb_) + ((dvt_) * 32 + l32) * 136 + (sub_) * 32 + (ks2_) * 16 + hh * 8)
#define MLA_SOFTMAX(sc_, pa_, pb_)                                                                         \
    {                                                                                                      \
      mxrun = fmaxf(mxrun, max16(sc_));                                                                    \
      float ps0_ = 0.f, ps1_ = 0.f;                                                                        \
      _Pragma("unroll") for (int i = 0; i < 16; i += 2) {                                                  \
        sc_[i] = __builtin_amdgcn_exp2f(sc_[i]); sc_[i + 1] = __builtin_amdgcn_exp2f(sc_[i + 1]);          \
        ps0_ += sc_[i]; ps1_ += sc_[i + 1];                                                                \
      }                                                                                                    \
      l += ps0_ + ps1_;                                                                                    \
      uint4 pk_;                                                                                           \
      pk_.x = pack2(sc_[0], sc_[1]); pk_.y = pack2(sc_[2], sc_[3]); pk_.z = pack2(sc_[4], sc_[5]); pk_.w = pack2(sc_[6], sc_[7]); \
      pa_ = __builtin_bit_cast(bf16x8, pk_);                                                               \
      pk_.x = pack2(sc_[8], sc_[9]); pk_.y = pack2(sc_[10], sc_[11]); pk_.z = pack2(sc_[12], sc_[13]); pk_.w = pack2(sc_[14], sc_[15]); \
      pb_ = __builtin_bit_cast(bf16x8, pk_);                                                               \
    }
    auto compute_tile = [&](int cur, int half) {
      const u16* kb = sK + cur * 128 * 104 + half * 64 * 104;
      const u16* vb = sV + cur * 64 * 136 + half * 64;
      bf16x8 k0[6], k1[6];
#pragma unroll
      for (int ks = 0; ks < 6; ++ks) { k0[ks] = MLA_KFRAG(kb, 0, ks); k1[ks] = MLA_KFRAG(kb, 1, ks); }
      f32x16 s0, s1;
#pragma unroll
      for (int i = 0; i < 16; ++i) { s0[i] = 0.f; s1[i] = 0.f; }
#pragma unroll
      for (int ks = 0; ks < 6; ++ks) s0 = MFMA32(k0[ks], qf[ks], s0);
      s0 = MFMA32(kone, qf6, s0);
      bf16x8 v00, v01, v02, v03, v10, v11, v12, v13;
      MLA_VFRAG(v00, vb, 0, 0, 0); MLA_VFRAG(v01, vb, 0, 0, 1); MLA_VFRAG(v02, vb, 0, 1, 0); MLA_VFRAG(v03, vb, 0, 1, 1);
#pragma unroll
      for (int ks = 0; ks < 6; ++ks) s1 = MFMA32(k1[ks], qf[ks], s1);
      s1 = MFMA32(kone, qf6, s1);
      MLA_VFRAG(v10, vb, 1, 0, 0); MLA_VFRAG(v11, vb, 1, 0, 1); MLA_VFRAG(v12, vb, 1, 1, 0); MLA_VFRAG(v13, vb, 1, 1, 1);
      bf16x8 p0a, p0b, p1a, p1b;
      MLA_SOFTMAX(s0, p0a, p0b);
      o0 = MFMA32(v00, p0a, o0); o1 = MFMA32(v01, p0a, o1); o0 = MFMA32(v02, p0b, o0); o1 = MFMA32(v03, p0b, o1);
      MLA_SOFTMAX(s1, p1a, p1b);
      o0 = MFMA32(v10, p1a, o0); o1 = MFMA32(v11, p1a, o1); o0 = MFMA32(v12, p1b, o0); o1 = MFMA32(v13, p1b, o1);
      SGB(0x100, 12);
#pragma unroll
      for (int i = 0; i < 7; ++i) { SGB(0x008, 1); if (i < 4) SGB(0x100, 1); }
#pragma unroll
      for (int i = 0; i < 7; ++i) { SGB(0x008, 1); if (i < 4) SGB(0x100, 1); SGB(0x402, 7); }
#pragma unroll
      for (int i = 0; i < 4; ++i) { SGB(0x008, 1); SGB(0x402, 12); }
#pragma unroll
      for (int i = 0; i < 4; ++i) SGB(0x008, 1);
    };
    auto lazy_update = [&]() {
      const float mxr = fmaxf(mxrun, __shfl_xor(mxrun, 32));
      if (__builtin_amdgcn_ballot_w64(mxr > 8.f) != 0ull) {
        float d = (mxr > 8.f) ? mxr : 0.f;
        const float mnew = bf2f(f2bf(m + d));
        d = mnew - m;
        m = mnew;
        const float alpha = __builtin_amdgcn_exp2f(-d);
        l *= alpha;
        mxrun -= d;
#pragma unroll
        for (int i = 0; i < 16; ++i) { o0[i] *= alpha; o1[i] *= alpha; }
        uint4 qv = make_uint4(0u, 0u, 0u, 0u);
        if (hh == 0) qv.x = (unsigned)f2bf(-m);
        qf6 = __builtin_bit_cast(bf16x8, qv);
      }
    };
    MLA_GLOAD(ak0, ak1, ak2, av0, av1, 0);
    asm volatile("s_waitcnt vmcnt(0)" ::: "memory");
    MLA_SSTORE(ak0, ak1, ak2, av0, av1, 0);
    __syncthreads();
    {
      f32x16 s0, s1;
#pragma unroll
      for (int i = 0; i < 16; ++i) { s0[i] = 0.f; s1[i] = 0.f; }
#pragma unroll
      for (int ks = 0; ks < 6; ++ks) { s0 = MFMA32(MLA_KFRAG(sK, 0, ks), qf[ks], s0); s1 = MFMA32(MLA_KFRAG(sK, 1, ks), qf[ks], s1); }
      float mx = fmaxf(max16(s0), max16(s1));
      mx = fmaxf(mx, __shfl_xor(mx, 32));
      m = bf2f(f2bf(mx));
      uint4 qv = make_uint4(0u, 0u, 0u, 0u);
      if (hh == 0) qv.x = (unsigned)f2bf(-m);
      qf6 = __builtin_bit_cast(bf16x8, qv);
    }
#pragma unroll 1
    for (int kt = 0; kt < 32; kt += 2) {
      MLA_GLOAD(ak0, ak1, ak2, av0, av1, kt + 1);
#pragma unroll 1
      for (int half = 0; half < 2; ++half) compute_tile(0, half);
      asm volatile("s_waitcnt vmcnt(0)" ::: "memory");
      MLA_SSTORE(ak0, ak1, ak2, av0, av1, 1);
      __syncthreads();
      lazy_update();
      if (kt + 2 < 32) MLA_GLOAD(ak0, ak1, ak2, av0, av1, kt + 2);
#pragma unroll 1
      for (int half = 0; half < 2; ++half) compute_tile(1, half);
      if (kt + 2 < 32) {
        asm volatile("s_waitcnt vmcnt(0)" ::: "memory");
        MLA_SSTORE(ak0, ak1, ak2, av0, av1, 0);
      }
      __syncthreads();
      lazy_update();
    }
    l += __shfl_xor(l, 32);
    const float il = 1.f / l;
    u16* orow = p.mixed + (t0 + l32) * DM + 256 + h * 64 + hh * 4;
#pragma unroll
    for (int g = 0; g < 4; ++g) {
      uint2 v;
      v.x = pack2(o0[4 * g + 0] * il, o0[4 * g + 1] * il);
      v.y = pack2(o0[4 * g + 2] * il, o0[4 * g + 3] * il);
      *reinterpret_cast<uint2*>(orow + g * 8) = v;
      v.x = pack2(o1[4 * g + 0] * il, o1[4 * g + 1] * il);
      v.y = pack2(o1[4 * g + 2] * il, o1[4 * g + 3] * il);
      *reinterpret_cast<uint2*>(orow + 32 + g * 8) = v;
    }
  }
}

typedef __attribute__((address_space(3))) s16x4 lds_s16x4;
template <int MODE>
DI void ph_dil_pass(const Params& p, char* smem, int blk_) {
  const int tid = otid(), wid = tid >> 6, lane = tid & 63, l32 = lane & 31, hh = lane >> 5;
  u16* sV = reinterpret_cast<u16*>(smem) + wid * (2 * 32 * 72);
  const int i16 = lane & 15, tq = i16 >> 2, tp = i16 & 3, tblk = (lane >> 4) & 1;
  {
    constexpr int NT = (MODE == 0) ? 13 : 5;
    const int it = wid, xcd_ = blk_ & 7, jx_ = blk_ >> 3, bh = xcd_ * 2 + (jx_ >> 4), r = jx_ & 15, b = bh >> 2, h = bh & 3;
    const int i0 = it * 32;
    const int q0 = (r * 8 + it) * 32;
    const int qpos = (MODE == 0) ? (r + 16 * (i0 + l32)) : (q0 + l32);
    const size_t tb = (size_t)b * SEQ;
    const u16* kbase = p.proj + tb * PWP + C_DK + h * 64;
    const u16* vbase = p.proj + tb * PWP + C_DV + h * 64;
    bf16x8 qf[4];
    {
      const u16* qp = p.proj + (tb + qpos) * PWP + C_DQ + h * 64 + hh * 8;
#pragma unroll
      for (int ks = 0; ks < 4; ++ks) qf[ks] = *reinterpret_cast<const bf16x8*>(qp + ks * 16);
    }
    f32x16 o0, o1;
#pragma unroll
    for (int i = 0; i < 16; ++i) { o0[i] = 0.f; o1[i] = 0.f; }
    float m = -1e30f, l = 0.f;
    auto tile_params = [&](int tt, int& d, int& rd, int& ub, int& ulim, int& qb, int& qs) {
      if (MODE == 0) {
        if (tt < 5) { d = 16; rd = r; qb = i0; qs = 1; ulim = 256; ub = qb - 64 + 32 * tt; }
        else { d = 4; rd = r & 3; qb = (r >> 2) + 4 * i0; qs = 4; ulim = 1024; ub = qb - 64 + 32 * (tt - 5); }
      } else { d = 1; rd = 0; qb = q0; qs = 1; ulim = 4096; ub = qb - 64 + 32 * tt; }
    };
    bf16x8 ka0, ka1, ka2, ka3, kb0, kb1, kb2, kb3;
    uint4 va0, va1, va2, va3, vb0, vb1, vb2, vb3;
#define DIL_LD(dst_, ptr_) asm volatile("global_load_dwordx4 %0, %1, off" : "=v"(dst_) : "v"(ptr_) : "memory")
#define DIL_GLOAD(K0, K1, K2, K3, V0, V1, V2, V3, tt_)                                                   \
    {                                                                                                    \
      int d_, rd_, ub_, ulim_, qb_, qs_;                                                                 \
      tile_params((tt_), d_, rd_, ub_, ulim_, qb_, qs_);                                                 \
      int u_ = min(max(ub_ + l32, 0), ulim_ - 1);                                                        \
      const u16* kp_ = kbase + (size_t)(rd_ + d_ * u_) * PWP + hh * 8;                                   \
      DIL_LD(K0, kp_); DIL_LD(K1, kp_ + 16); DIL_LD(K2, kp_ + 32); DIL_LD(K3, kp_ + 48);                 \
      const int kr_ = ub_ + (lane >> 3);                                                                 \
      const u16* vp_;                                                                                    \
      u_ = min(max(kr_, 0), ulim_ - 1);      vp_ = vbase + (size_t)(rd_ + d_ * u_) * PWP + (lane & 7) * 8; DIL_LD(V0, vp_); \
      u_ = min(max(kr_ + 8, 0), ulim_ - 1);  vp_ = vbase + (size_t)(rd_ + d_ * u_) * PWP + (lane & 7) * 8; DIL_LD(V1, vp_); \
      u_ = min(max(kr_ + 16, 0), ulim_ - 1); vp_ = vbase + (size_t)(rd_ + d_ * u_) * PWP + (lane & 7) * 8; DIL_LD(V2, vp_); \
      u_ = min(max(kr_ + 24, 0), ulim_ - 1); vp_ = vbase + (size_t)(rd_ + d_ * u_) * PWP + (lane & 7) * 8; DIL_LD(V3, vp_); \
    }
#define DIL_VSTORE(V0, V1, V2, V3, buf_)                                                                 \
    {                                                                                                    \
      u16* vb_ = sV + (buf_) * 32 * 72 + (lane >> 3) * 72 + (lane & 7) * 8;                              \
      *reinterpret_cast<uint4*>(vb_) = V0;                                                               \
      *reinterpret_cast<uint4*>(vb_ + 8 * 72) = V1;                                                      \
      *reinterpret_cast<uint4*>(vb_ + 16 * 72) = V2;                                                     \
      *reinterpret_cast<uint4*>(vb_ + 24 * 72) = V3;                                                     \
    }
    auto tile_rest = [&](int tt, f32x16 sc, int cur) {
      int d, rd, ub, ulim, qb, qs;
      tile_params(tt, d, rd, ub, ulim, qb, qs);
      const int uq = qb + qs * l32;
      const float cs = 0.125f * 1.4426950408889634f;
      float mx = -1e30f;
#pragma unroll
      for (int i = 0; i < 16; ++i) {
        const int u = ub + (i & 3) + 8 * (i >> 2) + 4 * hh;
        const int du = u - uq;
        const bool valid = (u >= 0) && (u < ulim) && (du <= 64) && (du >= -64);
        sc[i] = valid ? sc[i] * cs : -1e30f;
        mx = fmaxf(mx, sc[i]);
      }
      mx = fmaxf(mx, __shfl_xor(mx, 32));
      const float mn = fmaxf(m, mx);
      const float alpha = __builtin_amdgcn_exp2f(m - mn);
      m = mn;
      float ps = 0.f;
#pragma unroll
      for (int i = 0; i < 16; ++i) {
        float pe = __builtin_amdgcn_exp2f(sc[i] - mn);
        pe = (sc[i] > -1e29f) ? pe : 0.f;
        ps += pe;
        sc[i] = pe;
      }
      l = l * alpha + ps;
#pragma unroll
      for (int i = 0; i < 16; ++i) { o0[i] *= alpha; o1[i] *= alpha; }
      const u16* vb = sV + cur * 32 * 72;
#pragma unroll
      for (int ks2 = 0; ks2 < 2; ++ks2) {
        uint4 pk;
        pk.x = pack2(sc[8 * ks2 + 0], sc[8 * ks2 + 1]);
        pk.y = pack2(sc[8 * ks2 + 2], sc[8 * ks2 + 3]);
        pk.z = pack2(sc[8 * ks2 + 4], sc[8 * ks2 + 5]);
        pk.w = pack2(sc[8 * ks2 + 6], sc[8 * ks2 + 7]);
        const bf16x8 pb = __builtin_bit_cast(bf16x8, pk);
#pragma unroll
        for (int dvt = 0; dvt < 2; ++dvt) {
          const u16* a0 = vb + (16 * ks2 + 4 * hh + tq) * 72 + dvt * 32 + tblk * 16 + tp * 4;
          const s16x4 lo = __builtin_amdgcn_ds_read_tr16_b64_v4i16((lds_s16x4*)(a0));
          const s16x4 hi = __builtin_amdgcn_ds_read_tr16_b64_v4i16((lds_s16x4*)(a0 + 8 * 72));
          const bf16x8 a = __builtin_shufflevector(lo, hi, 0, 1, 2, 3, 4, 5, 6, 7);
          if (dvt == 0) o0 = MFMA32(a, pb, o0); else o1 = MFMA32(a, pb, o1);
        }
      }
    };
    DIL_GLOAD(ka0, ka1, ka2, ka3, va0, va1, va2, va3, 0);
    DIL_GLOAD(kb0, kb1, kb2, kb3, vb0, vb1, vb2, vb3, 1);
    asm volatile("s_waitcnt vmcnt(8)" ::: "memory");
    DIL_VSTORE(va0, va1, va2, va3, 0);
#pragma unroll 1
    for (int tt = 0; tt < NT; tt += 2) {
      {
        f32x16 sc;
#pragma unroll
        for (int i = 0; i < 16; ++i) sc[i] = 0.f;
        sc = MFMA32(ka0, qf[0], sc); sc = MFMA32(ka1, qf[1], sc); sc = MFMA32(ka2, qf[2], sc); sc = MFMA32(ka3, qf[3], sc);
        asm volatile("" :: "v"(sc));
        if (tt + 2 < NT) DIL_GLOAD(ka0, ka1, ka2, ka3, va0, va1, va2, va3, tt + 2);
        tile_rest(tt, sc, 0);
        if (tt + 1 < NT) {
          if (tt + 2 < NT) asm volatile("s_waitcnt vmcnt(8)" ::: "memory"); else asm volatile("s_waitcnt vmcnt(0)" ::: "memory");
          DIL_VSTORE(vb0, vb1, vb2, vb3, 1);
        }
      }
      if (tt + 1 < NT) {
        f32x16 sc;
#pragma unroll
        for (int i = 0; i < 16; ++i) sc[i] = 0.f;
        sc = MFMA32(kb0, qf[0], sc); sc = MFMA32(kb1, qf[1], sc); sc = MFMA32(kb2, qf[2], sc); sc = MFMA32(kb3, qf[3], sc);
        asm volatile("" :: "v"(sc));
        if (tt + 3 < NT) DIL_GLOAD(kb0, kb1, kb2, kb3, vb0, vb1, vb2, vb3, tt + 3);
        tile_rest(tt + 1, sc, 1);
        if (tt + 2 < NT) {
          if (tt + 3 < NT) asm volatile("s_waitcnt vmcnt(8)" ::: "memory"); else asm volatile("s_waitcnt vmcnt(0)" ::: "memory");
          DIL_VSTORE(va0, va1, va2, va3, 0);
        }
      }
    }
    l += __shfl_xor(l, 32);
    float* part = p.dpart + ((tb + qpos) * 4 + h) * 68 + hh * 4;
    if (MODE == 0) {
#pragma unroll
      for (int g = 0; g < 4; ++g) {
        *reinterpret_cast<float4*>(part + g * 8) = make_float4(o0[4 * g + 0], o0[4 * g + 1], o0[4 * g + 2], o0[4 * g + 3]);
        *reinterpret_cast<float4*>(part + 32 + g * 8) = make_float4(o1[4 * g + 0], o1[4 * g + 1], o1[4 * g + 2], o1[4 * g + 3]);
      }
      if (hh == 0) { part[64] = m; part[65] = l; }
    } else {
      const float mA = part[64 - hh * 4], lA = part[65 - hh * 4];
      const float M = fmaxf(m, mA), sa = __builtin_amdgcn_exp2f(m - M), sb = __builtin_amdgcn_exp2f(mA - M);
      const float il = 1.f / (l * sa + lA * sb);
      u16* orow = p.mixed + (tb + qpos) * DM + 768 + h * 64 + hh * 4;
#pragma unroll
      for (int g = 0; g < 4; ++g) {
        const float4 a0 = *reinterpret_cast<const float4*>(part + g * 8), a1 = *reinterpret_cast<const float4*>(part + 32 + g * 8);
        uint2 v;
        v.x = pack2((o0[4 * g + 0] * sa + a0.x * sb) * il, (o0[4 * g + 1] * sa + a0.y * sb) * il);
        v.y = pack2((o0[4 * g + 2] * sa + a0.z * sb) * il, (o0[4 * g + 3] * sa + a0.w * sb) * il);
        *reinterpret_cast<uint2*>(orow + g * 8) = v;
        v.x = pack2((o1[4 * g + 0] * sa + a1.x * sb) * il, (o1[4 * g + 1] * sa + a1.y * sb) * il);
        v.y = pack2((o1[4 * g + 2] * sa + a1.z * sb) * il, (o1[4 * g + 3] * sa + a1.w * sb) * il);
        *reinterpret_cast<uint2*>(orow + 32 + g * 8) = v;
      }
    }
  }
}

DI void ph_dil_naive(const Params& p) {
  const int gt = obid() * NTHR + otid(), gs = gridDim.x * NTHR;
  for (int it = gt; it < 4 * 4 * SEQ; it += gs) {
    const int n = it & (SEQ - 1), h = (it >> 12) & 3, b = it >> 14;
    const size_t tb = (size_t)b * SEQ;
    uint4 qp[8];
    float o[64];
#pragma unroll
    for (int d = 0; d < 8; ++d) qp[d] = *reinterpret_cast<const uint4*>(p.proj + (tb + n) * PWP + C_DQ + h * 64 + d * 8);
    float mx = -1e30f;
    for (int pat = 0; pat < 3; ++pat) {
      const int dil = (pat == 0) ? 1 : (pat == 1 ? 4 : 16);
#pragma unroll 1
      for (int j = -64; j <= 64; ++j) {
        const int pos = n + j * dil;
        if (pos < 0 || pos >= SEQ) continue;
        const u16* kr = p.proj + (tb + pos) * PWP + C_DK + h * 64;
        float s = 0.f;
#pragma unroll
        for (int d = 0; d < 8; ++d) s = dot8(qp[d], *reinterpret_cast<const uint4*>(kr + d * 8), s);
        s *= 0.125f;
        mx = fmaxf(mx, s);
      }
    }
#pragma unroll
    for (int d = 0; d < 64; ++d) o[d] = 0.f;
    float l = 0.f;
    for (int pat = 0; pat < 3; ++pat) {
      const int dil = (pat == 0) ? 1 : (pat == 1 ? 4 : 16);
#pragma unroll 1
      for (int j = -64; j <= 64; ++j) {
        const int pos = n + j * dil;
        if (pos < 0 || pos >= SEQ) continue;
        const u16* kr = p.proj + (tb + pos) * PWP + C_DK + h * 64;
        const u16* vr = p.proj + (tb + pos) * PWP + C_DV + h * 64;
        float s = 0.f;
#pragma unroll
        for (int d = 0; d < 8; ++d) s = dot8(qp[d], *reinterpret_cast<const uint4*>(kr + d * 8), s);
        s *= 0.125f;
        const float pe = __expf(s - mx);
        l += pe;
#pragma unroll
        for (int d = 0; d < 64; d += 8) {
          float vf[8];
          ld8(vr + d, vf);
#pragma unroll
          for (int jj = 0; jj < 8; ++jj) o[d + jj] += pe * vf[jj];
        }
      }
    }
    const float il = 1.f / l;
#pragma unroll
    for (int d = 0; d < 64; d += 8) {
      uint4 ov;
      ov.x = pack2(o[d + 0] * il, o[d + 1] * il);
      ov.y = pack2(o[d + 2] * il, o[d + 3] * il);
      ov.z = pack2(o[d + 4] * il, o[d + 5] * il);
      ov.w = pack2(o[d + 6] * il, o[d + 7] * il);
      *reinterpret_cast<uint4*>(p.mixed + (tb + n) * DM + 768 + h * 64 + d) = ov;
    }
  }
}

DI void ph_ssd_naive(const Params& p, int L) {
  const int gt = obid() * NTHR + otid(), gs = gridDim.x * NTHR;
  for (int it = gt; it < 4 * 4 * 4 * SEQ; it += gs) {
    const int l = it & (SEQ - 1), pq = (it >> 12) & 3, h = (it >> 14) & 3, b = it >> 16;
    const int g = h >> 1;
    const size_t tb = (size_t)b * SEQ;
    uint4 cl[16];
    float acc[16];
#pragma unroll
    for (int d = 0; d < 16; ++d) cl[d] = *reinterpret_cast<const uint4*>(p.xbc + (tb + l) * 768 + 512 + g * 128 + d * 8);
#pragma unroll
    for (int d = 0; d < 16; ++d) acc[d] = 0.f;
    const float pl = p.cs[(tb + l) * 8 + h], rl = p.cs[(tb + l) * 8 + 4 + h];
#pragma unroll 1
    for (int s = 0; s < SEQ; ++s) {
      const u16* br = p.xbc + (tb + s) * 768 + 256 + g * 128;
      float cbv = 0.f;
#pragma unroll
      for (int d = 0; d < 16; ++d) cbv = dot8(cl[d], *reinterpret_cast<const uint4*>(br + d * 8), cbv);
      float w;
      if (s <= l) w = expf(pl - p.cs[(tb + s) * 8 + h]) * p.dtv[(tb + s) * 8 + h];
      else w = expf(rl - p.cs[(tb + s) * 8 + 4 + h]) * p.dtv[(tb + s) * 8 + 4 + h];
      cbv *= w;
      const u16* xr = p.xbc + (tb + s) * 768 + h * 64 + pq * 16;
#pragma unroll
      for (int d = 0; d < 16; d += 8) {
        float xf[8];
        ld8(xr + d, xf);
#pragma unroll
        for (int j = 0; j < 8; ++j) acc[d + j] += cbv * xf[j];
      }
    }
    const float dsk = p.ssm_d[L * 4 + h];
#pragma unroll
    for (int d = 0; d < 16; ++d) {
      const int c = h * 64 + pq * 16 + d;
      const float xv = bf2f(p.xbc[(tb + l) * 768 + c]);
      const float z = bf2f(p.proj[(tb + l) * PWP + C_Z + c]);
      p.ybuf[(tb + l) * 256 + c] = (acc[d] + dsk * xv) * silu(z);
    }
  }
}

DI void ph_ssd_norm(const Params& p, int L) {
  const int tid_ = otid(); const int lane = tid_ & 63, gw = (obid() * NTHR + tid_) >> 6, nw = gridDim.x * (NTHR / 64);
  const float* nwt = p.ssm_norm_w + L * 256;
  for (int t = gw; t < T; t += nw) {
    const float4 v = *reinterpret_cast<const float4*>(p.ybuf + (size_t)t * 256 + lane * 4);
    float ss = wave_sum(v.x * v.x + v.y * v.y + v.z * v.z + v.w * v.w);
    const float rstd = rsqrtf(ss * (1.f / 256.f) + 1e-6f);
    const float4 ww = *reinterpret_cast<const float4*>(nwt + lane * 4);
    uint2 o;
    o.x = pack2(v.x * rstd * ww.x, v.y * rstd * ww.y);
    o.y = pack2(v.z * rstd * ww.z, v.w * rstd * ww.w);
    *reinterpret_cast<uint2*>(p.mixed + (size_t)t * DM + 512 + lane * 4) = o;
  }
}

#define MFMA16(a, b, c) __builtin_amdgcn_mfma_f32_16x16x32_bf16((a), (b), (c), 0, 0, 0)
template <int MT, int NT, int KS>
DI void wave_mm(f32x4 (&acc)[MT][NT], const u16* a0, int lda, const u16* b0, int ldb, int fr, int fq) {
#pragma unroll
  for (int ks = 0; ks < KS; ++ks) {
    bf16x8 af[MT], bfv[NT];
#pragma unroll
    for (int m = 0; m < MT; ++m) af[m] = *reinterpret_cast<const bf16x8*>(a0 + (m * 16 + fr) * lda + ks * 32 + fq * 8);
#pragma unroll
    for (int n = 0; n < NT; ++n) bfv[n] = *reinterpret_cast<const bf16x8*>(b0 + (n * 16 + fr) * ldb + ks * 32 + fq * 8);
#pragma unroll
    for (int m = 0; m < MT; ++m)
#pragma unroll
      for (int n = 0; n < NT; ++n) acc[m][n] = MFMA16(af[m], bfv[n], acc[m][n]);
  }
}
template <int MT, int NT>
DI void zero_acc(f32x4 (&acc)[MT][NT]) {
#pragma unroll
  for (int m = 0; m < MT; ++m)
#pragma unroll
    for (int n = 0; n < NT; ++n) acc[m][n] = f32x4{0.f, 0.f, 0.f, 0.f};
}
template <int NROWS, int NCOLS>
DI void stage_rows(u16* dst, int ldd, const u16* src, size_t lsrc, int tid) {
  constexpr int CPR = NCOLS / 8, NCH = NROWS * CPR / NTHR;
  static_assert(NROWS * CPR % NTHR == 0, "tile must be a multiple of 512 chunks");
  uint4 r[NCH];
#pragma unroll
  for (int i = 0; i < NCH; ++i) {
    const int c = tid + i * NTHR, row = c / CPR, cc = c % CPR;
    r[i] = *reinterpret_cast<const uint4*>(src + (size_t)row * lsrc + cc * 8);
  }
#pragma unroll
  for (int i = 0; i < NCH; ++i) {
    const int c = tid + i * NTHR, row = c / CPR, cc = c % CPR;
    *reinterpret_cast<uint4*>(dst + row * ldd + cc * 8) = r[i];
  }
}
template <int NCOLS, class W>
DI void stage_T(u16* dst, int ldd, const u16* src, size_t lsrc, int tid, W w) {
  constexpr int NCH = 128 * (NCOLS / 8) / NTHR;
  uint4 r[NCH];
#pragma unroll
  for (int i = 0; i < NCH; ++i) {
    const int c = tid + i * NTHR, j = c & 127, cc = c >> 7;
    r[i] = *reinterpret_cast<const uint4*>(src + (size_t)j * lsrc + cc * 8);
  }
#pragma unroll
  for (int i = 0; i < NCH; ++i) {
    const int c = tid + i * NTHR, j = c & 127, cc = c >> 7;
    float f[8];
    unpack8(r[i], f);
    const float wj = w(j);
#pragma unroll
    for (int e = 0; e < 8; ++e) dst[(cc * 8 + e) * ldd + j] = f2bf(f[e] * wj);
  }
}

template <int NROWS, int NCOLS>
DI void stage_rows_ld(uint4 (&r)[NROWS * (NCOLS / 8) / NTHR], const u16* src, size_t lsrc, int tid) {
  constexpr int CPR = NCOLS / 8, NCH = NROWS * CPR / NTHR;
#pragma unroll
  for (int i = 0; i < NCH; ++i) {
    const int c = tid + i * NTHR, row = c / CPR, cc = c % CPR;
    r[i] = *reinterpret_cast<const uint4*>(src + (size_t)row * lsrc + cc * 8);
  }
}
template <int NROWS, int NCOLS>
DI void stage_rows_st(u16* dst, int ldd, const uint4 (&r)[NROWS * (NCOLS / 8) / NTHR], int tid) {
  constexpr int CPR = NCOLS / 8, NCH = NROWS * CPR / NTHR;
#pragma unroll
  for (int i = 0; i < NCH; ++i) {
    const int c = tid + i * NTHR, row = c / CPR, cc = c % CPR;
    *reinterpret_cast<uint4*>(dst + row * ldd + cc * 8) = r[i];
  }
}
template <int NCOLS>
DI void stage_T_ld(uint4 (&r)[128 * (NCOLS / 8) / NTHR], const u16* src, size_t lsrc, int tid) {
  constexpr int NCH = 128 * (NCOLS / 8) / NTHR;
#pragma unroll
  for (int i = 0; i < NCH; ++i) {
    const int c = tid + i * NTHR, j = c & 127, cc = c >> 7;
    r[i] = *reinterpret_cast<const uint4*>(src + (size_t)j * lsrc + cc * 8);
  }
}
template <int NCOLS, class W>
DI void stage_T_st(u16* dst, int ldd, const uint4 (&r)[128 * (NCOLS / 8) / NTHR], int tid, W w) {
  constexpr int NCH = 128 * (NCOLS / 8) / NTHR;
#pragma unroll
  for (int i = 0; i < NCH; ++i) {
    const int c = tid + i * NTHR, j = c & 127, cc = c >> 7;
    float f[8];
    unpack8(r[i], f);
    const float wj = w(j);
#pragma unroll
    for (int e = 0; e < 8; ++e) dst[(cc * 8 + e) * ldd + j] = f2bf(f[e] * wj);
  }
}

DI void ph_ret_a(const Params& p, char* smem, int item) {
  const int tid = otid(), wid = tid >> 6, lane = tid & 63, fr = lane & 15, fq = lane >> 4;
  u16* sVt = reinterpret_cast<u16*>(smem);
  u16* sKf = sVt + 64 * 136;
  u16* sKb = sKf + 64 * 136;
  {
    const int c = item & 31, bh = item >> 5, b = bh >> 2, h = bh & 3;
    const float lg0 = log1pf(-exp2f(-5.f - (float)h)), lg1 = log1pf(-exp2f(-5.5f - (float)h));
    const u16* src = p.proj + ((size_t)b * SEQ + c * 128) * PWP;
    {
      uint4 rv[2], rk[2];
      stage_T_ld<64>(rv, src + C_RV + h * 64, PWP, tid);
      stage_T_ld<64>(rk, src + C_RK + h * 64, PWP, tid);
      stage_T_st<64>(sVt, 136, rv, tid, [](int) { return 1.f; });
      stage_T_st<64>(sKf, 136, rk, tid, [&](int j) { return __expf(lg0 * (float)(127 - j)); });
      stage_T_st<64>(sKb, 136, rk, tid, [&](int j) { return __expf(lg1 * (float)j); });
    }
    __syncthreads();
    const int dir = wid >> 2, q = wid & 3;
    f32x4 acc[1][4];
    zero_acc(acc);
    wave_mm<1, 4, 4>(acc, sVt + q * 16 * 136, 136, dir ? sKb : sKf, 136, fr, fq);
    float* out = p.rU + ((size_t)(bh * 32 + c) * 2 + dir) * 4096;
#pragma unroll
    for (int n = 0; n < 4; ++n)
#pragma unroll
      for (int j = 0; j < 4; ++j) out[(q * 16 + fq * 4 + j) * 64 + n * 16 + fr] = acc[0][n][j];
    __syncthreads();
  }
}
DI void ph_ret_scan(const Params& p) {
  const int gt = obid() * NTHR + otid(), gs = gridDim.x * NTHR;
  for (int it = gt; it < 16 * 2 * 4096; it += gs) {
    const int e = it & 4095, dir = (it >> 12) & 1, bh = it >> 13, h = bh & 3;
    const float lg = log1pf(-exp2f((dir ? -5.5f : -5.f) - (float)h));
    const float cd = __expf(lg * 128.f);
    float u[32];
#pragma unroll
    for (int c = 0; c < 32; ++c) u[c] = p.rU[((size_t)(bh * 32 + c) * 2 + dir) * 4096 + e];
    float st = 0.f;
    if (dir == 0) {
#pragma unroll
      for (int c = 0; c < 32; ++c) {
        p.rS[((size_t)(bh * 32 + c) * 2 + dir) * 4096 + e] = f2bf(st);
        st = st * cd + u[c];
      }
    } else {
#pragma unroll
      for (int c = 31; c >= 0; --c) {
        p.rS[((size_t)(bh * 32 + c) * 2 + dir) * 4096 + e] = f2bf(st);
        st = st * cd + u[c];
      }
    }
  }
}
DI void ph_ret_c(const Params& p, char* smem, int item) {
  const int tid = otid(), wid = tid >> 6, lane = tid & 63, fr = lane & 15, fq = lane >> 4;
  u16* sQ = reinterpret_cast<u16*>(smem);
  u16* sK = sQ + 128 * 72;
  u16* sVt = sK + 128 * 72;
  u16* sSf = sVt + 64 * 136;
  u16* sSb = sSf + 64 * 72;
  u16* sP = sSb + 64 * 72;
  {
    const int c = item & 31, bh = item >> 5, b = bh >> 2, h = bh & 3;
    const float lg0 = log1pf(-exp2f(-5.f - (float)h)), lg1 = log1pf(-exp2f(-5.5f - (float)h));
    const size_t t0 = (size_t)b * SEQ + c * 128;
    const u16* src = p.proj + t0 * PWP;
    {
      uint4 rq[2], rk[2], rv[2], rf[1], rb[1];
      stage_rows_ld<128, 64>(rq, src + C_RQ + h * 64, PWP, tid);
      stage_rows_ld<128, 64>(rk, src + C_RK + h * 64, PWP, tid);
      stage_T_ld<64>(rv, src + C_RV + h * 64, PWP, tid);
      stage_rows_ld<64, 64>(rf, p.rS + ((size_t)(bh * 32 + c) * 2 + 0) * 4096, 64, tid);
      stage_rows_ld<64, 64>(rb, p.rS + ((size_t)(bh * 32 + c) * 2 + 1) * 4096, 64, tid);
      stage_rows_st<128, 64>(sQ, 72, rq, tid);
      stage_rows_st<128, 64>(sK, 72, rk, tid);
      stage_T_st<64>(sVt, 136, rv, tid, [](int) { return 1.f; });
      stage_rows_st<64, 64>(sSf, 72, rf, tid);
      stage_rows_st<64, 64>(sSb, 72, rb, tid);
    }
    __syncthreads();
    {
      const int wr = wid >> 1, wc = wid & 1;
      f32x4 sacc[2][4];
      zero_acc(sacc);
      wave_mm<2, 4, 2>(sacc, sQ + wr * 32 * 72, 72, sK + wc * 64 * 72, 72, fr, fq);
#pragma unroll
      for (int m = 0; m < 2; ++m)
#pragma unroll
        for (int n = 0; n < 4; ++n)
#pragma unroll
          for (int j = 0; j < 4; ++j) {
            const int i = wr * 32 + m * 16 + fq * 4 + j, jj = wc * 64 + n * 16 + fr;
            const float dcy = (jj <= i) ? __expf(lg0 * (float)(i - jj)) : __expf(lg1 * (float)(jj - i));
            sP[i * 136 + jj] = f2bf(sacc[m][n][j] * dcy);
          }
    }
    __syncthreads();
    {
      f32x4 ai[1][4], af_[1][4], ab_[1][4];
      zero_acc(ai); zero_acc(af_); zero_acc(ab_);
      wave_mm<1, 4, 4>(ai, sP + wid * 16 * 136, 136, sVt, 136, fr, fq);
      wave_mm<1, 4, 2>(af_, sQ + wid * 16 * 72, 72, sSf, 72, fr, fq);
      wave_mm<1, 4, 2>(ab_, sQ + wid * 16 * 72, 72, sSb, 72, fr, fq);
#pragma unroll
      for (int j = 0; j < 4; ++j) {
        const int i = wid * 16 + fq * 4 + j;
        const float xf = __expf(lg0 * (float)(i + 1)), xb = __expf(lg1 * (float)(128 - i));
        float o[4], sum = 0.f;
#pragma unroll
        for (int n = 0; n < 4; ++n) { o[n] = ai[0][n][j] + xf * af_[0][n][j] + xb * ab_[0][n][j]; sum += o[n]; }
#pragma unroll
        for (int sft = 1; sft < 16; sft <<= 1) sum += __shfl_xor(sum, sft);
        const float mu = sum * (1.f / 64.f);
        float var = 0.f;
#pragma unroll
        for (int n = 0; n < 4; ++n) var += (o[n] - mu) * (o[n] - mu);
#pragma unroll
        for (int sft = 1; sft < 16; sft <<= 1) var += __shfl_xor(var, sft);
        const float rs = rsqrtf(var * (1.f / 64.f) + 1e-5f);
#pragma unroll
        for (int n = 0; n < 4; ++n) {
          const float g = bf2f(p.proj[(t0 + i) * PWP + C_RG + h * 64 + n * 16 + fr]);
          p.mixed[(t0 + i) * DM + h * 64 + n * 16 + fr] = f2bf(silu(g) * (o[n] - mu) * rs);
        }
      }
    }
    __syncthreads();
  }
}

DI void ssd_local_cumsum(const Params& p, int L, size_t t0, float* cum, float* dtl, int wid, int lane) {
  const int dir = wid >> 2, h = wid & 3;
  const float a = -__expf(p.a_log[L * 8 + dir * 4 + h]);
  float d0, d1;
  if (dir == 0) { d0 = p.dtv[(t0 + 2 * lane) * 8 + h]; d1 = p.dtv[(t0 + 2 * lane + 1) * 8 + h]; }
  else { d0 = p.dtv[(t0 + 127 - 2 * lane) * 8 + 4 + h]; d1 = p.dtv[(t0 + 126 - 2 * lane) * 8 + 4 + h]; }
  float v0 = d0 * a, v1 = v0 + d1 * a;
  float run = v1;
#pragma unroll
  for (int o = 1; o < 64; o <<= 1) {
    const float u = __shfl_up(run, o);
    if (lane >= o) run += u;
  }
  const float excl = run - v1;
  v0 += excl; v1 += excl;
  float* cr = cum + (dir * 4 + h) * 128;
  float* dr = dtl + (dir * 4 + h) * 128;
  if (dir == 0) { cr[2 * lane] = v0; cr[2 * lane + 1] = v1; dr[2 * lane] = d0; dr[2 * lane + 1] = d1; }
  else { cr[127 - 2 * lane] = v0; cr[126 - 2 * lane] = v1; dr[127 - 2 * lane] = d0; dr[126 - 2 * lane] = d1; }
}

DI void ph_ssd_a(const Params& p, int L, char* smem, int item) {
  const int tid = otid(), wid = tid >> 6, lane = tid & 63, fr = lane & 15, fq = lane >> 4;
  u16* sBt = reinterpret_cast<u16*>(smem);
  u16* sXf = sBt + 2 * 128 * 136;
  u16* sXb = sXf + 64 * 136;
  float* cum = reinterpret_cast<float*>(sXb + 64 * 136);
  float* dtl = cum + 8 * 128;
  {
    const int c = item & 31, b = item >> 5;
    const size_t t0 = (size_t)b * SEQ + c * 128;
    ssd_local_cumsum(p, L, t0, cum, dtl, wid, lane);
    stage_T<256>(sBt, 136, p.xbc + t0 * 768 + 256, 768, tid, [](int) { return 1.f; });
    __syncthreads();
    if (tid < 8) {
      const int dir = tid >> 2;
      p.cdec[(size_t)item * 8 + tid] = __expf(dir ? cum[tid * 128 + 0] : cum[tid * 128 + 127]);
    }
    for (int h = 0; h < 4; ++h) {
      const float* cf = cum + h * 128;
      const float* cb = cum + (4 + h) * 128;
      const float* df = dtl + h * 128;
      const float* db = dtl + (4 + h) * 128;
      const float endf = cf[127], endb = cb[0];
      {
        uint4 rx[2];
        stage_T_ld<64>(rx, p.xbc + t0 * 768 + h * 64, 768, tid);
        stage_T_st<64>(sXf, 136, rx, tid, [&](int l) { return __expf(endf - cf[l]) * df[l]; });
        stage_T_st<64>(sXb, 136, rx, tid, [&](int l) { return __expf(endb - cb[l]) * db[l]; });
      }
      __syncthreads();
      const int dir = wid >> 2, q = wid & 3, g = h >> 1;
      f32x4 acc[4][2];
      zero_acc(acc);
      wave_mm<4, 2, 4>(acc, dir ? sXb : sXf, 136, sBt + (g * 128 + q * 32) * 136, 136, fr, fq);
      float* out = p.sU + ((size_t)item * 8 + h * 2 + dir) * 8192;
#pragma unroll
      for (int m = 0; m < 4; ++m)
#pragma unroll
        for (int n = 0; n < 2; ++n)
#pragma unroll
          for (int j = 0; j < 4; ++j) out[(m * 16 + fq * 4 + j) * 128 + q * 32 + n * 16 + fr] = acc[m][n][j];
      __syncthreads();
    }
  }
}
DI void ph_ssd_scan(const Params& p) {
  const int gt = obid() * NTHR + otid(), gs = gridDim.x * NTHR;
  for (int it = gt; it < 4 * 8 * 8192; it += gs) {
    const int e = it & 8191, hd = (it >> 13) & 7, b = it >> 16;
    const int dir = hd & 1, h = hd >> 1;
    float u[32];
#pragma unroll
    for (int c = 0; c < 32; ++c) u[c] = p.sU[((size_t)(b * 32 + c) * 8 + hd) * 8192 + e];
    float st = 0.f;
    if (dir == 0) {
#pragma unroll
      for (int c = 0; c < 32; ++c) {
        p.sS[((size_t)(b * 32 + c) * 8 + hd) * 8192 + e] = f2bf(st);
        st = st * p.cdec[(size_t)(b * 32 + c) * 8 + dir * 4 + h] + u[c];
      }
    } else {
#pragma unroll
      for (int c = 31; c >= 0; --c) {
        p.sS[((size_t)(b * 32 + c) * 8 + hd) * 8192 + e] = f2bf(st);
        st = st * p.cdec[(size_t)(b * 32 + c) * 8 + dir * 4 + h] + u[c];
      }
    }
  }
}
DI void ph_ssd_c(const Params& p, int L, char* smem, int item) {
  const int tid = otid(), wid = tid >> 6, lane = tid & 63, fr = lane & 15, fq = lane >> 4;
  u16* sC = reinterpret_cast<u16*>(smem);
  u16* sB = sC + 128 * 136;
  u16* sXt = sB + 128 * 136;
  u16* sSf = sXt + 64 * 136;
  u16* sSb = sSf + 64 * 136;
  float* cum = reinterpret_cast<float*>(sSb + 64 * 136);
  float* dtl = cum + 8 * 128;
  {
    const int c = item & 31, b = item >> 5;
    const size_t t0 = (size_t)b * SEQ + c * 128;
    ssd_local_cumsum(p, L, t0, cum, dtl, wid, lane);
    float ssq[4] = {0.f, 0.f, 0.f, 0.f};
#pragma unroll 1
    for (int g = 0; g < 2; ++g) {
      {
        uint4 rc[4], rb4[4];
        stage_rows_ld<128, 128>(rc, p.xbc + t0 * 768 + 512 + g * 128, 768, tid);
        stage_rows_ld<128, 128>(rb4, p.xbc + t0 * 768 + 256 + g * 128, 768, tid);
        stage_rows_st<128, 128>(sC, 136, rc, tid);
        stage_rows_st<128, 128>(sB, 136, rb4, tid);
      }
      __syncthreads();
      const int wr = wid >> 1, wc = wid & 1;
      f32x4 G[2][4];
      zero_acc(G);
      wave_mm<2, 4, 4>(G, sC + wr * 32 * 136, 136, sB + wc * 64 * 136, 136, fr, fq);
      __syncthreads();
#pragma unroll 1
      for (int hl = 0; hl < 2; ++hl) {
        const int h = g * 2 + hl;
        const float* cf = cum + h * 128;
        const float* cb = cum + (4 + h) * 128;
        const float* df = dtl + h * 128;
        const float* db = dtl + (4 + h) * 128;
        uint4 rxt[2], rsf[2], rsb[2];
        stage_T_ld<64>(rxt, p.xbc + t0 * 768 + h * 64, 768, tid);
        stage_rows_ld<64, 128>(rsf, p.sS + ((size_t)item * 8 + h * 2 + 0) * 8192, 128, tid);
        stage_rows_ld<64, 128>(rsb, p.sS + ((size_t)item * 8 + h * 2 + 1) * 8192, 128, tid);
#pragma unroll
        for (int m = 0; m < 2; ++m)
#pragma unroll
          for (int n = 0; n < 4; ++n)
#pragma unroll
            for (int j = 0; j < 4; ++j) {
              const int l = wr * 32 + m * 16 + fq * 4 + j, sx = wc * 64 + n * 16 + fr;
              const float w = (sx <= l) ? __expf(cf[l] - cf[sx]) * df[sx] : __expf(cb[l] - cb[sx]) * db[sx];
              sB[l * 136 + sx] = f2bf(G[m][n][j] * w);
            }
        stage_T_st<64>(sXt, 136, rxt, tid, [](int) { return 1.f; });
        stage_rows_st<64, 128>(sSf, 136, rsf, tid);
        stage_rows_st<64, 128>(sSb, 136, rsb, tid);
        __syncthreads();
        f32x4 yd[1][4], yf[1][4], yb[1][4];
        zero_acc(yd); zero_acc(yf); zero_acc(yb);
        wave_mm<1, 4, 4>(yd, sB + wid * 16 * 136, 136, sXt, 136, fr, fq);
        wave_mm<1, 4, 4>(yf, sC + wid * 16 * 136, 136, sSf, 136, fr, fq);
        wave_mm<1, 4, 4>(yb, sC + wid * 16 * 136, 136, sSb, 136, fr, fq);
        const float dsk = p.ssm_d[L * 4 + h];
#pragma unroll
        for (int j = 0; j < 4; ++j) {
          const int l = wid * 16 + fq * 4 + j;
          const float ef = __expf(cf[l]), eb = __expf(cb[l]);
#pragma unroll
          for (int n = 0; n < 4; ++n) {
            const int ch = h * 64 + n * 16 + fr;
            const float xv = bf2f(p.xbc[(t0 + l) * 768 + ch]);
            const float z = bf2f(p.proj[(t0 + l) * PWP + C_Z + ch]);
            const float yv = (yd[0][n][j] + ef * yf[0][n][j] + eb * yb[0][n][j] + dsk * xv) * silu(z);
            ssq[j] += yv * yv;
            p.ybuf[(t0 + l) * 256 + ch] = yv;
          }
        }
        __syncthreads();
      }
    }
    const float* nwt = p.ssm_norm_w + L * 256;
#pragma unroll
    for (int j = 0; j < 4; ++j) {
      float ss = ssq[j];
#pragma unroll
      for (int sft = 1; sft < 16; sft <<= 1) ss += __shfl_xor(ss, sft);
      const float rstd = rsqrtf(ss * (1.f / 256.f) + 1e-6f);
      const int l = wid * 16 + fq * 4 + j;
#pragma unroll
      for (int hn = 0; hn < 16; ++hn) {
        const int ch = hn * 16 + fr;
        p.mixed[(t0 + l) * DM + 512 + ch] = f2bf(p.ybuf[(t0 + l) * 256 + ch] * rstd * nwt[ch]);
      }
    }
  }
}

struct CfgOutproj {
  static constexpr bool PERM = false;
  int K; const Params* p; int L; int bid, nb; const float* xin; float* xout;
  DI bool next(int i, pg8::Unit& u) const { const int t = i * nb + bid; if (t >= 64 * 4) return false; u.pm = t & 63; u.pn = t >> 6; return true; }
  DI const char* a_base(const pg8::Unit& u) const { return (const char*)(p->mixed + (size_t)u.pm * 256 * DM); }
  DI const char* b_base(const pg8::Unit& u) const { return (const char*)(p->WoutT + ((size_t)L * DM + (size_t)u.pn * 256) * DM); }
  DI void a_off(const pg8::Unit&, int R0, int C0, int R1, int C1, unsigned (&vo)[4]) const {
    vo[0] = (unsigned)(R0 * DM + C0) * 2u; vo[1] = (unsigned)(R1 * DM + C1) * 2u;
    vo[2] = vo[0] + 128u * DM * 2u; vo[3] = vo[1] + 128u * DM * 2u;
  }
  DI void epi(const f32x4 (&acc)[2][2][4][2], const pg8::Unit& u, int wr, int wc, int fr, int fq) const {
    const int row0 = u.pm * 256 + wr * 64 + fr, col0 = u.pn * 256 + wc * 32 + 4 * fq;
#pragma unroll
    for (int ai = 0; ai < 2; ++ai)
#pragma unroll
      for (int m = 0; m < 4; ++m) {
        const size_t ro = (size_t)(row0 + ai * 128 + m * 16) * DM + col0;
#pragma unroll
        for (int bj = 0; bj < 2; ++bj)
#pragma unroll
          for (int n = 0; n < 2; ++n) {
            const size_t o = ro + bj * 128 + n * 16;
            const float4 xi = *reinterpret_cast<const float4*>(xin + o);
            const f32x4 a = acc[ai][bj][m][n];
            *reinterpret_cast<float4*>(xout + o) = make_float4(xi.x + a[0], xi.y + a[1], xi.z + a[2], xi.w + a[3]);
          }
      }
  }
};
DI void ph_outproj(const Params& p, int L, const float* xin, float* xout, char* smem) {
  CfgOutproj c; c.K = DM; c.p = &p; c.L = L; c.bid = obid(); c.nb = gridDim.x; c.xin = xin; c.xout = xout;
  pg8::gemm_phase((pg8::lds_u8*)smem, c);
}

DI void ph_rms2_router(const Params& p, int L, const float* xres, char* smem) {
  const int tid = otid(), lane = tid & 63, gw = (obid() * NTHR + tid) >> 6, nw = gridDim.x * (NTHR / 64);
  const float* w = p.ln2_w + L * DM;
  const float* rw = p.router_w + (size_t)L * DM * 16;
  float4* srw = reinterpret_cast<float4*>(smem);
  for (int i = tid; i < 4096; i += NTHR) {
    const int c = i >> 2, e4 = i & 3;
    srw[(e4 * 4 + (c & 3)) * 256 + (c >> 2)] = *reinterpret_cast<const float4*>(rw + (size_t)i * 4);
  }
  __syncthreads();
  const int b5 = (lane >> 5) & 1, b4 = (lane >> 4) & 1, b3 = (lane >> 3) & 1, b2 = (lane >> 2) & 1;
  const int my_e = 8 * b5 + 4 * b4 + 2 * b3 + b2;
  for (int t = gw; t < T; t += nw) {
    const float* xr = xres + (size_t)t * DM;
    float4 v[4];
    float ss = 0.f;
#pragma unroll
    for (int i = 0; i < 4; ++i) {
      v[i] = *reinterpret_cast<const float4*>(xr + (i * 64 + lane) * 4);
      ss += v[i].x * v[i].x + v[i].y * v[i].y + v[i].z * v[i].z + v[i].w * v[i].w;
    }
    ss = wave_sum(ss);
    const float rstd = rsqrtf(ss * (1.f / DM) + 1e-6f);
    float lg[16];
#pragma unroll
    for (int e = 0; e < 16; ++e) lg[e] = 0.f;
#pragma unroll
    for (int i = 0; i < 4; ++i) {
      const int q = i * 64 + lane;
      const float4 ww = *reinterpret_cast<const float4*>(w + q * 4);
      const float hv[4] = {v[i].x * rstd * ww.x, v[i].y * rstd * ww.y, v[i].z * rstd * ww.z, v[i].w * rstd * ww.w};
      uint2 o;
      o.x = pack2(hv[0], hv[1]);
      o.y = pack2(hv[2], hv[3]);
      *reinterpret_cast<uint2*>(p.hn + (size_t)t * DM + q * 4) = o;
#pragma unroll
      for (int j = 0; j < 4; ++j)
#pragma unroll
        for (int e4 = 0; e4 < 4; ++e4) {
          const float4 r = srw[(e4 * 4 + j) * 256 + q];
          lg[e4 * 4 + 0] += hv[j] * r.x; lg[e4 * 4 + 1] += hv[j] * r.y;
          lg[e4 * 4 + 2] += hv[j] * r.z; lg[e4 * 4 + 3] += hv[j] * r.w;
        }
      __builtin_amdgcn_sched_barrier(0);
    }
#pragma unroll
    for (int k = 0; k < 8; ++k) {
      const float send = b5 ? lg[k] : lg[k + 8], keep = b5 ? lg[k + 8] : lg[k];
      lg[k] = keep + __shfl_xor(send, 32);
    }
#pragma unroll
    for (int k = 0; k < 4; ++k) {
      const float send = b4 ? lg[k] : lg[k + 4], keep = b4 ? lg[k + 4] : lg[k];
      lg[k] = keep + __shfl_xor(send, 16);
    }
#pragma unroll
    for (int k = 0; k < 2; ++k) {
      const float send = b3 ? lg[k] : lg[k + 2], keep = b3 ? lg[k + 2] : lg[k];
      lg[k] = keep + __shfl_xor(send, 8);
    }
    float lv;
    {
      const float send = b2 ? lg[0] : lg[1], keep = b2 ? lg[1] : lg[0];
      lv = keep + __shfl_xor(send, 4);
    }
    lv += __shfl_xor(lv, 2);
    lv += __shfl_xor(lv, 1);
    float mx = lv;
    mx = fmaxf(mx, __shfl_xor(mx, 4)); mx = fmaxf(mx, __shfl_xor(mx, 8));
    mx = fmaxf(mx, __shfl_xor(mx, 16)); mx = fmaxf(mx, __shfl_xor(mx, 32));
    const float ex = expf(lv - mx);
    float den = ex;
    den += __shfl_xor(den, 4); den += __shfl_xor(den, 8); den += __shfl_xor(den, 16); den += __shfl_xor(den, 32);
    if ((lane & 3) == 0) { p.aff[(size_t)t * 16 + my_e] = ex / den; p.inv[(size_t)t * 16 + my_e] = -1; }
  }
}

DI int block_sum_i(int v, int* red, int tid) {
#pragma unroll
  for (int o = 32; o > 0; o >>= 1) v += __shfl_xor(v, o);
  __syncthreads();
  if ((tid & 63) == 0) red[tid >> 6] = v;
  __syncthreads();
  int t = 0;
#pragma unroll
  for (int w = 0; w < NTHR / 64; ++w) t += red[w];
  return t;
}
DI void ph_topk(const Params& p, char* smem) {
  int* red = reinterpret_cast<int*>(smem);
  int* wsum = red + 16;
  const int tid = otid(), wid = tid >> 6, lane = tid & 63;
  for (int it = obid(); it < 64; it += gridDim.x) {
    const int e = it & 15, b = it >> 4;
    unsigned v[8];
#pragma unroll
    for (int i = 0; i < 8; ++i) v[i] = __float_as_uint(p.aff[(size_t)(b * SEQ + tid * 8 + i) * 16 + e]);
    unsigned thr = 0;
#pragma unroll 1
    for (int bit = 30; bit >= 0; --bit) {
      const unsigned cand = thr | (1u << bit);
      int cnt = 0;
#pragma unroll
      for (int i = 0; i < 8; ++i) cnt += (v[i] >= cand) ? 1 : 0;
      if (block_sum_i(cnt, red, tid) >= 512) thr = cand;
    }
    int ngt = 0, ntie = 0;
#pragma unroll
    for (int i = 0; i < 8; ++i) { ngt += (v[i] > thr) ? 1 : 0; ntie += (v[i] == thr) ? 1 : 0; }
    int ig = ngt, itie = ntie;
#pragma unroll
    for (int o = 1; o < 64; o <<= 1) {
      const int a = __shfl_up(ig, o), c = __shfl_up(itie, o);
      if (lane >= o) { ig += a; itie += c; }
    }
    __syncthreads();
    if (lane == 63) { wsum[wid] = ig; wsum[8 + wid] = itie; }
    __syncthreads();
    int og = 0, ot = 0, totg = 0;
#pragma unroll
    for (int w = 0; w < 8; ++w) {
      const int a = wsum[w], c = wsum[8 + w];
      if (w < wid) { og += a; ot += c; }
      totg += a;
    }
    int pg = og + ig - ngt, pt = ot + itie - ntie;
    const int base = (e * 4 + b) * 512;
#pragma unroll
    for (int i = 0; i < 8; ++i) {
      int slot = -1;
      if (v[i] > thr) { slot = pg; ++pg; }
      else if (v[i] == thr) { if (totg + pt < 512) slot = totg + pt; ++pt; }
      if (slot >= 0) {
        p.tok[base + slot] = b * SEQ + tid * 8 + i;
        p.inv[(size_t)(b * SEQ + tid * 8 + i) * 16 + e] = base + slot;
        p.gate[base + slot] = __uint_as_float(v[i]);
      }
    }
    __syncthreads();
  }
}

struct CfgMoe1 {
  static constexpr bool PERM = true;
  int K; const Params* p; int L; int bid, nb;
  DI bool next(int i, pg8::Unit& u) const {
    const int t = i * nb + bid; if (t >= 16 * 16 * 8) return false;
    const int rnd = t >> 8, w = t & 255, xcd = w & 7, jx = w >> 3, pid = xcd * 4 + (jx >> 3);
    const int mt = jx & 7, nt = pid & 15, e = rnd * 2 + (pid >> 4);
    u.pm = e * 8 + mt; u.pn = e * 16 + nt; return true;
  }
  DI const char* a_base(const pg8::Unit&) const { return (const char*)p->hn; }
  DI const char* b_base(const pg8::Unit& u) const { return (const char*)(p->WguT + ((size_t)L * 16 * 4096 + (size_t)u.pn * 256) * DM); }
  DI void a_off(const pg8::Unit& u, int R0, int C0, int R1, int C1, unsigned (&vo)[4]) const {
    const int* tk = p->tok + u.pm * 256;
    vo[0] = (unsigned)(tk[R0] * DM + C0) * 2u; vo[1] = (unsigned)(tk[R1] * DM + C1) * 2u;
    vo[2] = (unsigned)(tk[128 + R0] * DM + C0) * 2u; vo[3] = (unsigned)(tk[128 + R1] * DM + C1) * 2u;
  }
  DI void epi(const f32x4 (&acc)[2][2][4][2], const pg8::Unit& u, int wr, int wc, int fr, int fq) const {
    const int row0 = u.pm * 256 + wr * 64 + fr, col0 = (u.pn & 15) * 128 + wc * 32 + 8 * fq;
#pragma unroll
    for (int ai = 0; ai < 2; ++ai)
#pragma unroll
      for (int m = 0; m < 4; ++m) {
        const f32x4 g0 = acc[ai][0][m][0], g1 = acc[ai][0][m][1], u0 = acc[ai][1][m][0], u1 = acc[ai][1][m][1];
        uint4 w;
        w.x = pack2(fast_silu(g0[0]) * u0[0], fast_silu(g0[1]) * u0[1]); w.y = pack2(fast_silu(g0[2]) * u0[2], fast_silu(g0[3]) * u0[3]);
        w.z = pack2(fast_silu(g1[0]) * u1[0], fast_silu(g1[1]) * u1[1]); w.w = pack2(fast_silu(g1[2]) * u1[2], fast_silu(g1[3]) * u1[3]);
        *reinterpret_cast<uint4*>(p->hid + (size_t)(row0 + ai * 128 + m * 16) * 2048 + col0) = w;
      }
  }
};
DI void ph_moe1(const Params& p, int L, char* smem) {
  CfgMoe1 c; c.K = DM; c.p = &p; c.L = L; c.bid = obid(); c.nb = gridDim.x;
  pg8::gemm_phase((pg8::lds_u8*)smem, c);
}
struct CfgMoe2 {
  static constexpr bool PERM = true;
  int K; const Params* p; int L; int bid, nb;
  DI bool next(int i, pg8::Unit& u) const {
    const int t = i * nb + bid; if (t >= 16 * 4 * 8) return false;
    const int rnd = t >> 8, w = t & 255, xcd = w & 7, jx = w >> 3, pid = rnd * 32 + xcd * 4 + (jx >> 3);
    u.pm = (pid >> 2) * 8 + (jx & 7); u.pn = pid; return true;
  }
  DI const char* a_base(const pg8::Unit& u) const { return (const char*)(p->hid + (size_t)u.pm * 256 * 2048); }
  DI const char* b_base(const pg8::Unit& u) const { return (const char*)(p->WdT + ((size_t)L * 16 * DM + (size_t)u.pn * 256) * 2048); }
  DI void a_off(const pg8::Unit&, int R0, int C0, int R1, int C1, unsigned (&vo)[4]) const {
    vo[0] = (unsigned)(R0 * 2048 + C0) * 2u; vo[1] = (unsigned)(R1 * 2048 + C1) * 2u;
    vo[2] = vo[0] + 128u * 2048u * 2u; vo[3] = vo[1] + 128u * 2048u * 2u;
  }
  DI void epi(const f32x4 (&acc)[2][2][4][2], const pg8::Unit& u, int wr, int wc, int fr, int fq) const {
    u16* eo = p->proj;
    const int row0 = u.pm * 256 + wr * 64 + fr, col0 = (u.pn & 3) * 256 + wc * 32 + 8 * fq;
#pragma unroll
    for (int ai = 0; ai < 2; ++ai)
#pragma unroll
      for (int m = 0; m < 4; ++m) {
        const int row = row0 + ai * 128 + m * 16;
        const float gt = p->gate[row];
#pragma unroll
        for (int bj = 0; bj < 2; ++bj) {
          const f32x4 a0 = acc[ai][bj][m][0], a1 = acc[ai][bj][m][1];
          uint4 w;
          w.x = pack2(gt * a0[0], gt * a0[1]); w.y = pack2(gt * a0[2], gt * a0[3]);
          w.z = pack2(gt * a1[0], gt * a1[1]); w.w = pack2(gt * a1[2], gt * a1[3]);
          *reinterpret_cast<uint4*>(eo + (size_t)row * DM + col0 + bj * 128) = w;
        }
      }
  }
};
DI void ph_moe2(const Params& p, int L, char* smem) {
  CfgMoe2 c; c.K = 2048; c.p = &p; c.L = L; c.bid = obid(); c.nb = gridDim.x;
  pg8::gemm_phase((pg8::lds_u8*)smem, c);
}
template <bool FINAL>
DI void ph_combine_norm(const Params& p, const float* __restrict__ xa, float* __restrict__ xnew, const float* __restrict__ w,
                        u16* __restrict__ hn_out, float* __restrict__ f_out) {
  const int tid_ = otid(), lane = tid_ & 63, gw = (obid() * NTHR + tid_) >> 6, nw = gridDim.x * (NTHR / 64);
  const u16* eo = p.proj;
  for (int t = gw; t < T; t += nw) {
    float4 v[4];
#pragma unroll
    for (int i = 0; i < 4; ++i) v[i] = *reinterpret_cast<const float4*>(xa + (size_t)t * DM + (i * 64 + lane) * 4);
    const int myrow = (lane < 16) ? p.inv[(size_t)t * 16 + lane] : -1;
#pragma unroll 1
    for (int e = 0; e < 16; ++e) {
      const int r = __shfl(myrow, e);
      if (r >= 0) {
#pragma unroll
        for (int i = 0; i < 4; ++i) {
          const uint2 q = *reinterpret_cast<const uint2*>(eo + (size_t)r * DM + (i * 64 + lane) * 4);
          v[i].x += __uint_as_float(q.x << 16); v[i].y += __uint_as_float(q.x & 0xffff0000u);
          v[i].z += __uint_as_float(q.y << 16); v[i].w += __uint_as_float(q.y & 0xffff0000u);
        }
      }
    }
    float ss = 0.f;
#pragma unroll
    for (int i = 0; i < 4; ++i) ss += v[i].x * v[i].x + v[i].y * v[i].y + v[i].z * v[i].z + v[i].w * v[i].w;
    ss = wave_sum(ss);
    const float rstd = rsqrtf(ss * (1.f / DM) + 1e-6f);
#pragma unroll
    for (int i = 0; i < 4; ++i) {
      const int c = (i * 64 + lane) * 4;
      const float4 ww = *reinterpret_cast<const float4*>(w + c);
      if (FINAL) {
        *reinterpret_cast<float4*>(f_out + (size_t)t * DM + c) = make_float4(v[i].x * rstd * ww.x, v[i].y * rstd * ww.y, v[i].z * rstd * ww.z, v[i].w * rstd * ww.w);
      } else {
        *reinterpret_cast<float4*>(xnew + (size_t)t * DM + c) = v[i];
        uint2 o;
        o.x = pack2(v[i].x * rstd * ww.x, v[i].y * rstd * ww.y);
        o.y = pack2(v[i].z * rstd * ww.z, v[i].w * rstd * ww.w);
        *reinterpret_cast<uint2*>(hn_out + (size_t)t * DM + c) = o;
      }
    }
  }
}

__global__ void __launch_bounds__(NTHR) mk(Params p) {
  extern __shared__ __attribute__((aligned(16))) char smem[];
  cg::grid_group grid = cg::this_grid();
  __shared__ uint4 xb_words;
  if (threadIdx.x == 0) xb_words = make_uint4(0u, 0u, 0u, 0u);
  __syncthreads();
  XcdBarrier xb = xcd_barrier_post(p.bar, (volatile LAS unsigned*)&xb_words);
  for (int rep = 0; rep < p.rep[0]; ++rep) ph_convert(p, smem);
  ph_rmsnorm_bf16(p.x, p.ln1_w, p.hn);
  grid.sync();
  for (int L = 0; L < 2; ++L) {
    const float* xin = (L == 0) ? p.x : p.xres2;
    float* xout = p.xres;
    if (L == 1) {
      for (int rep = 0; rep < p.rep[1]; ++rep) ph_combine_norm<false>(p, p.xres, p.xres2, p.ln1_w + DM, p.hn, nullptr);
      xcd_barrier(xb);
    }
    for (int rp = 0; rp < p.rep[3]; ++rp) {
      for (int rep = 0; rep < p.rep[2]; ++rep) ph_inproj(p, L, smem);
      xcd_barrier(xb);
      ph_post(p, L);
      xcd_barrier(xb);
    }
    for (int rep = 0; rep < p.rep[12]; ++rep) xcd_barrier(xb);
    {
      unsigned* ctr = p.bar + XCD_BAR_WORDS + 8 + L;
      __shared__ int q1_item;
      for (;;) {
        if (threadIdx.x == 0) q1_item = (int)atomicAdd(ctr, 1u);
        __syncthreads();
        const int it = q1_item;
        __syncthreads();
        if (it >= 1344) break;
        if (it < 256) ph_dil_pass<0>(p, smem, it);
        else if (it < 384) ph_ssd_a(p, L, smem, it - 256);
        else if (it < 576) ph_mla_up_q(p, L, smem, it - 384);
        else if (it < 832) ph_mla_up_kv(p, L, smem, it - 576);
        else ph_ret_a(p, smem, it - 832);
      }
    }
    xcd_barrier(xb);
    for (int rep = 0; rep < p.rep[5]; ++rep) {
      for (int r2 = 0; r2 < p.rep[13]; ++r2) { ph_ret_scan(p); ph_ssd_scan(p); }
      for (int r2 = 0; r2 < p.rep[14]; ++r2) ph_mla_attn(p, smem);
      for (int r2 = 0; r2 < p.rep[15]; ++r2) for (int bi = obid(); bi < 256; bi += gridDim.x) ph_dil_pass<1>(p, smem, bi);
    }
    xcd_barrier(xb);
    {
      unsigned* ctr = p.bar + XCD_BAR_WORDS + L;
      __shared__ int q_item;
      for (;;) {
        if (threadIdx.x == 0) q_item = (int)atomicAdd(ctr, 1u);
        __syncthreads();
        const int it = q_item;
        __syncthreads();
        if (it >= 640) break;
        if (it < 128) ph_ssd_c(p, L, smem, it);
        else ph_ret_c(p, smem, it - 128);
      }
    }
    xcd_barrier(xb);
    for (int rep = 0; rep < p.rep[7]; ++rep) ph_outproj(p, L, xin, xout, smem);
    xcd_barrier(xb);
    for (int rep = 0; rep < p.rep[8]; ++rep) ph_rms2_router(p, L, xout, smem);
    xcd_barrier(xb);
    for (int rep = 0; rep < p.rep[9]; ++rep) ph_topk(p, smem);
    xcd_barrier(xb);
    for (int rep = 0; rep < p.rep[10]; ++rep) ph_moe1(p, L, smem);
    xcd_barrier(xb);
    for (int rep = 0; rep < p.rep[11]; ++rep) ph_moe2(p, L, smem);
    xcd_barrier(xb);
  }
  ph_combine_norm<true>(p, p.xres, nullptr, p.final_w, nullptr, p.out);
}

extern "C" void kernel_launch(void* const* d_in, const int* in_sizes, int n_in, void* d_out, int out_size, void* d_ws,
                              size_t ws_size, hipStream_t stream) {
  static int grid_blocks = 0;
  if (!grid_blocks) {
    int dev = 0, cus = 0, per_cu = 0;
    (void)hipGetDevice(&dev);
    (void)hipDeviceGetAttribute(&cus, hipDeviceAttributeMultiprocessorCount, dev);
    (void)hipFuncSetAttribute((const void*)mk, hipFuncAttributeMaxDynamicSharedMemorySize, LDS_BYTES);
    (void)hipOccupancyMaxActiveBlocksPerMultiprocessor(&per_cu, (const void*)mk, NTHR, LDS_BYTES);
    if (per_cu < 1) { fprintf(stderr, "occupancy query says %d blocks/CU\n", per_cu); per_cu = 1; }
    grid_blocks = cus * 1;
  }
  Params p{};
  const float** fp = reinterpret_cast<const float**>(&p);
  for (int i = 0; i < 20; ++i) fp[i] = (const float*)d_in[i];
  p.out = (float*)d_out;
  char* w = (char*)d_ws;
  size_t off = 0;
  auto take = [&](size_t bytes) { char* r = w + off; off += (bytes + 255) & ~(size_t)255; return r; };
  p.WinT = (u16*)take((size_t)2 * PWP * DM * 2);
  p.WuqT = (u16*)take((size_t)2 * 384 * 256 * 2);
  p.WukvT = (u16*)take((size_t)2 * 512 * 128 * 2);
  p.WoutT = (u16*)take((size_t)2 * DM * DM * 2);
  p.WguT = (u16*)take((size_t)2 * 16 * 4096 * DM * 2);
  p.WdT = (u16*)take((size_t)2 * 16 * DM * 2048 * 2);
  p.xres = (float*)take((size_t)T * DM * 4);
  p.hn = (u16*)take((size_t)T * DM * 2);
  p.proj = (u16*)take((size_t)T * PWP * 2);
  p.cqn = (u16*)take((size_t)T * 256 * 2);
  p.ckvn = (u16*)take((size_t)T * 128 * 2);
  p.mq = (u16*)take((size_t)T * 384 * 2);
  p.mkv = nullptr;
  p.xbc = (u16*)take((size_t)T * 768 * 2);
  p.mixed = (u16*)take((size_t)T * DM * 2);
  p.hid = (u16*)take((size_t)32768 * 2048 * 2);
  p.kfull = (u16*)take((size_t)T * 4 * 96 * 2);
  p.rS = (u16*)take((size_t)16 * 32 * 2 * 4096 * 2);
  p.sS = (u16*)take((size_t)128 * 8 * 8192 * 2);
  p.rU = (float*)take((size_t)16 * 32 * 2 * 4096 * 4);
  p.sU = (float*)take((size_t)128 * 8 * 8192 * 4);
  p.cdec = (float*)take((size_t)128 * 8 * 4);
  p.vT = (u16*)take((size_t)T * 4 * 64 * 2);
  p.rtab = (float*)take((size_t)SEQ * 56 * 2 * 4);
  p.dpart = (float*)take((size_t)T * 4 * 68 * 4);
  p.dtv = (float*)take((size_t)T * 8 * 4);
  p.cs = (float*)take((size_t)T * 8 * 4);
  p.ybuf = (float*)take((size_t)T * 256 * 4);
  p.aff = (float*)take((size_t)T * 16 * 4);
  p.gate = (float*)take((size_t)64 * 512 * 4);
  p.tok = (int*)take((size_t)64 * 512 * 4);
  p.inv = (int*)take((size_t)T * 16 * 4);
  p.bar = (unsigned*)take((size_t)(XCD_BAR_WORDS + 64) * 4);
  p.xres2 = (float*)take((size_t)T * DM * 4);
  { const int reps[16] = REPS_INIT; for (int i = 0; i < 16; ++i) p.rep[i] = reps[i]; }
  if (off > ws_size) { fprintf(stderr, "workspace too small: need %zu have %zu\n", off, ws_size); return; }
  (void)hipMemsetAsync(p.bar, 0, (size_t)(XCD_BAR_WORDS + 64) * 4, stream);
  void* args[] = {&p};
  hipError_t e = hipLaunchCooperativeKernel((void*)mk, dim3(grid_blocks), dim3(NTHR), args, LDS_BYTES, stream);
  if (e != hipSuccess) fprintf(stderr, "cooperative launch failed: %s (grid %d)\n", hipGetErrorString(e), grid_blocks);
}
```

```cpp
#include <hip/hip_runtime.h>
#include <hip/hip_cooperative_groups.h>
#include <cstdio>
#include <cstdint>
namespace cg = cooperative_groups;

#define DI __device__ __forceinline__
typedef unsigned short u16;
typedef __attribute__((ext_vector_type(8))) short bf16x8;
typedef __attribute__((ext_vector_type(4))) float f32x4;

#ifndef REPS_INIT
#define REPS_INIT {1, 1, 1, 1, 1, 1, 1, 1, 1, 1, 1, 1, 0, 1, 1, 1}
#endif
constexpr int NTHR = 512;
constexpr int T = 16384, SEQ = 4096, DM = 1024;
constexpr int PW = 3240, PWP = 3328;
constexpr int C_RQ = 0, C_RK = 256, C_RV = 512, C_RG = 768, C_CQ = 1024, C_CKV = 1280, C_KR = 1408,
              C_Z = 1440, C_XBC = 1696, C_DT = 2464, C_DQ = 2472, C_DK = 2728, C_DV = 2984;
constexpr int LDS_BYTES = 132096;

struct WsOff {
  size_t WinT;
  size_t WuqT;
  size_t WukvT;
  size_t WoutT;
  size_t Wgu8;
  size_t Wd8;
  size_t hn8;
  size_t xres;
  size_t hn;
  size_t proj;
  size_t cqn;
  size_t ckvn;
  size_t mq;
  size_t xbc;
  size_t mixed;
  size_t hid8;
  size_t kfull;
  size_t rS;
  size_t sS;
  size_t rU;
  size_t sU;
  size_t cdec;
  size_t vT;
  size_t rtab;
  size_t dpart;
  size_t dtv;
  size_t cs;
  size_t ybuf;
  size_t aff;
  size_t gate;
  size_t tok;
  size_t inv;
  size_t bar;
  size_t xres2;
  size_t total;
};
constexpr WsOff ws_layout() {
  WsOff o{};
  size_t off = 0;
  o.WinT = off; off += (((size_t)2 * PWP * DM * 2) + 255) & ~(size_t)255;
  o.WuqT = off; off += (((size_t)2 * 384 * 256 * 2) + 255) & ~(size_t)255;
  o.WukvT = off; off += (((size_t)2 * 512 * 128 * 2) + 255) & ~(size_t)255;
  o.WoutT = off; off += (((size_t)2 * DM * DM * 2) + 255) & ~(size_t)255;
  o.Wgu8 = off; off += (((size_t)2 * 16 * 4096 * DM) + 255) & ~(size_t)255;
  o.Wd8 = off; off += (((size_t)2 * 16 * DM * 2048) + 255) & ~(size_t)255;
  o.hn8 = off; off += (((size_t)T * DM) + 255) & ~(size_t)255;
  o.xres = off; off += (((size_t)T * DM * 4) + 255) & ~(size_t)255;
  o.hn = off; off += (((size_t)T * DM * 2) + 255) & ~(size_t)255;
  o.proj = off; off += (((size_t)T * PWP * 2) + 255) & ~(size_t)255;
  o.cqn = off; off += (((size_t)T * 256 * 2) + 255) & ~(size_t)255;
  o.ckvn = off; off += (((size_t)T * 128 * 2) + 255) & ~(size_t)255;
  o.mq = off; off += (((size_t)T * 384 * 2) + 255) & ~(size_t)255;
  o.xbc = off; off += (((size_t)T * 768 * 2) + 255) & ~(size_t)255;
  o.mixed = off; off += (((size_t)T * DM * 2) + 255) & ~(size_t)255;
  o.hid8 = off; off += (((size_t)32768 * 2048) + 255) & ~(size_t)255;
  o.kfull = off; off += (((size_t)T * 4 * 96 * 2) + 255) & ~(size_t)255;
  o.rS = off; off += (((size_t)16 * 32 * 2 * 4096 * 2) + 255) & ~(size_t)255;
  o.sS = off; off += (((size_t)128 * 8 * 8192 * 2) + 255) & ~(size_t)255;
  o.rU = off; off += (((size_t)16 * 32 * 2 * 4096 * 4) + 255) & ~(size_t)255;
  o.sU = off; off += (((size_t)128 * 8 * 8192 * 4) + 255) & ~(size_t)255;
  o.cdec = off; off += (((size_t)128 * 8 * 4) + 255) & ~(size_t)255;
  o.vT = off; off += (((size_t)T * 4 * 64 * 2) + 255) & ~(size_t)255;
  o.rtab = off; off += (((size_t)SEQ * 56 * 2 * 4) + 255) & ~(size_t)255;
  o.dpart = off; off += (((size_t)T * 4 * 68 * 4) + 255) & ~(size_t)255;
  o.dtv = off; off += (((size_t)T * 8 * 4) + 255) & ~(size_t)255;
  o.cs = off; off += (((size_t)T * 8 * 4) + 255) & ~(size_t)255;
  o.ybuf = off; off += (((size_t)T * 256 * 4) + 255) & ~(size_t)255;
  o.aff = off; off += (((size_t)T * 16 * 4) + 255) & ~(size_t)255;
  o.gate = off; off += (((size_t)64 * 512 * 4) + 255) & ~(size_t)255;
  o.tok = off; off += (((size_t)64 * 512 * 4) + 255) & ~(size_t)255;
  o.inv = off; off += (((size_t)T * 16 * 4) + 255) & ~(size_t)255;
  o.bar = off; off += (((size_t)(3456 + 64) * 4) + 255) & ~(size_t)255;
  o.xres2 = off; off += (((size_t)T * DM * 4) + 255) & ~(size_t)255;
  o.total = off;
  return o;
}
constexpr WsOff WSO = ws_layout();
struct Params {
  const float *x, *ln1_w, *w_in, *q_norm_w, *kv_norm_w, *w_uq, *w_ukv, *conv_w, *conv_b, *a_log, *dt_bias,
      *ssm_d, *ssm_norm_w, *w_out, *ln2_w, *router_w, *w_gate, *w_up, *w_down, *final_w;
  float* out;
  char* ws;
  int rep[16];
  __host__ DI u16* WinT() const { return reinterpret_cast<u16*>(ws + WSO.WinT); }
  __host__ DI u16* WuqT() const { return reinterpret_cast<u16*>(ws + WSO.WuqT); }
  __host__ DI u16* WukvT() const { return reinterpret_cast<u16*>(ws + WSO.WukvT); }
  __host__ DI u16* WoutT() const { return reinterpret_cast<u16*>(ws + WSO.WoutT); }
  __host__ DI unsigned char* Wgu8() const { return reinterpret_cast<unsigned char*>(ws + WSO.Wgu8); }
  __host__ DI unsigned char* Wd8() const { return reinterpret_cast<unsigned char*>(ws + WSO.Wd8); }
  __host__ DI unsigned char* hn8() const { return reinterpret_cast<unsigned char*>(ws + WSO.hn8); }
  __host__ DI float* xres() const { return reinterpret_cast<float*>(ws + WSO.xres); }
  __host__ DI u16* hn() const { return reinterpret_cast<u16*>(ws + WSO.hn); }
  __host__ DI u16* proj() const { return reinterpret_cast<u16*>(ws + WSO.proj); }
  __host__ DI u16* cqn() const { return reinterpret_cast<u16*>(ws + WSO.cqn); }
  __host__ DI u16* ckvn() const { return reinterpret_cast<u16*>(ws + WSO.ckvn); }
  __host__ DI u16* mq() const { return reinterpret_cast<u16*>(ws + WSO.mq); }
  __host__ DI u16* xbc() const { return reinterpret_cast<u16*>(ws + WSO.xbc); }
  __host__ DI u16* mixed() const { return reinterpret_cast<u16*>(ws + WSO.mixed); }
  __host__ DI unsigned char* hid8() const { return reinterpret_cast<unsigned char*>(ws + WSO.hid8); }
  __host__ DI u16* kfull() const { return reinterpret_cast<u16*>(ws + WSO.kfull); }
  __host__ DI u16* rS() const { return reinterpret_cast<u16*>(ws + WSO.rS); }
  __host__ DI u16* sS() const { return reinterpret_cast<u16*>(ws + WSO.sS); }
  __host__ DI float* rU() const { return reinterpret_cast<float*>(ws + WSO.rU); }
  __host__ DI float* sU() const { return reinterpret_cast<float*>(ws + WSO.sU); }
  __host__ DI float* cdec() const { return reinterpret_cast<float*>(ws + WSO.cdec); }
  __host__ DI u16* vT() const { return reinterpret_cast<u16*>(ws + WSO.vT); }
  __host__ DI float* rtab() const { return reinterpret_cast<float*>(ws + WSO.rtab); }
  __host__ DI float* dpart() const { return reinterpret_cast<float*>(ws + WSO.dpart); }
  __host__ DI float* dtv() const { return reinterpret_cast<float*>(ws + WSO.dtv); }
  __host__ DI float* cs() const { return reinterpret_cast<float*>(ws + WSO.cs); }
  __host__ DI float* ybuf() const { return reinterpret_cast<float*>(ws + WSO.ybuf); }
  __host__ DI float* aff() const { return reinterpret_cast<float*>(ws + WSO.aff); }
  __host__ DI float* gate() const { return reinterpret_cast<float*>(ws + WSO.gate); }
  __host__ DI int* tok() const { return reinterpret_cast<int*>(ws + WSO.tok); }
  __host__ DI int* inv() const { return reinterpret_cast<int*>(ws + WSO.inv); }
  __host__ DI unsigned* bar() const { return reinterpret_cast<unsigned*>(ws + WSO.bar); }
  __host__ DI float* xres2() const { return reinterpret_cast<float*>(ws + WSO.xres2); }
};


typedef __attribute__((ext_vector_type(2))) __bf16 bf16x2_t;
typedef __attribute__((ext_vector_type(2))) float f32x2_t;
typedef __attribute__((ext_vector_type(16))) float f32x16;
typedef __attribute__((ext_vector_type(4))) short s16x4;
typedef __attribute__((ext_vector_type(8))) int i32x8;
typedef __attribute__((ext_vector_type(4))) int i32x4;
DI unsigned pack2(float a, float b) {
  f32x2_t v = {a, b};
  return __builtin_bit_cast(unsigned, __builtin_convertvector(v, bf16x2_t));
}
DI u16 f2bf(float f) { return (u16)(pack2(f, 0.f) & 0xffffu); }
DI float bf2f(u16 h) { return __uint_as_float(((unsigned)h) << 16); }
DI void unpack8(const uint4& v, float* f) {
  f[0] = __uint_as_float(v.x << 16); f[1] = __uint_as_float(v.x & 0xffff0000u);
  f[2] = __uint_as_float(v.y << 16); f[3] = __uint_as_float(v.y & 0xffff0000u);
  f[4] = __uint_as_float(v.z << 16); f[5] = __uint_as_float(v.z & 0xffff0000u);
  f[6] = __uint_as_float(v.w << 16); f[7] = __uint_as_float(v.w & 0xffff0000u);
}
DI void ld8(const u16* p, float* f) { uint4 v = *reinterpret_cast<const uint4*>(p); unpack8(v, f); }
DI unsigned pk4_f8(float a, float b, float c, float d) {
  a = __builtin_amdgcn_fmed3f(a, -448.f, 448.f); b = __builtin_amdgcn_fmed3f(b, -448.f, 448.f);
  c = __builtin_amdgcn_fmed3f(c, -448.f, 448.f); d = __builtin_amdgcn_fmed3f(d, -448.f, 448.f);
  int w = __builtin_amdgcn_cvt_pk_fp8_f32(a, b, 0, false);
  w = __builtin_amdgcn_cvt_pk_fp8_f32(c, d, w, true);
  return (unsigned)w;
}
constexpr float F8_W_SCALE = 256.f, F8_H_SCALE = 16.f, F8_HID_SCALE = 8.f;
DI float wave_sum(float v) {
#pragma unroll
  for (int o = 32; o > 0; o >>= 1) v += __shfl_xor(v, o);
  return v;
}
DI float dot2acc(unsigned a, unsigned b, float c) {
  return __builtin_amdgcn_fdot2_f32_bf16(__builtin_bit_cast(bf16x2_t, a), __builtin_bit_cast(bf16x2_t, b), c, false);
}
DI float dot8(const uint4& a, const uint4& b, float c) {
  c = dot2acc(a.x, b.x, c); c = dot2acc(a.y, b.y, c); c = dot2acc(a.z, b.z, c); c = dot2acc(a.w, b.w, c);
  return c;
}
DI int otid() { int t = threadIdx.x; asm volatile("" : "+v"(t)); return t; }
DI int obid() { int b = blockIdx.x; asm volatile("" : "+s"(b)); return b; }
DI float silu(float x) { return x / (1.f + __expf(-x)); }
DI float fast_silu(float x) { return x * __builtin_amdgcn_rcpf(1.f + __expf(-x)); }


#define XB_TMO      128
#define XB_XCNT(j)  (256  + 64 * (j))
#define XB_XSUB(j)  (1280 + 64 * (j))
#define XB_XGEN(j)  (2304 + 64 * (j))
#define XB_TOP      3328
#define XB_TOPGEN   3392
#define XCD_BAR_WORDS 3456
#define XB_SPIN_CAP (1u << 20)
#define LAS __attribute__((address_space(3)))
DI unsigned xb_ld(unsigned* p) { return __hip_atomic_load(p, __ATOMIC_RELAXED, __HIP_MEMORY_SCOPE_AGENT); }
DI unsigned xb_add(unsigned* p, unsigned v) { return __hip_atomic_fetch_add(p, v, __ATOMIC_RELAXED, __HIP_MEMORY_SCOPE_AGENT); }
DI unsigned xb_xcc_id() { return (unsigned)__builtin_amdgcn_s_getreg((3 << 11) | 20) & 0xFu; }
#define XB_SPIN(cond, bar) do { unsigned _sp = 0; while (cond) { __builtin_amdgcn_s_sleep(1); \
    if ((++_sp & 255u) == 0u) { if (xb_ld(&(bar)[XB_TMO])) break; if (_sp > XB_SPIN_CAP) { atomicAdd(&(bar)[XB_TMO], 1u); break; } } } } while (0)
struct XcdBarrier { unsigned* bar; unsigned x; volatile LAS unsigned* st; };
DI XcdBarrier xcd_barrier_post(unsigned* bar, volatile LAS unsigned* st) {
  XcdBarrier b; b.bar = bar; b.x = xb_xcc_id(); b.st = st;
  if (threadIdx.x == 0) (void)xb_add(&bar[XB_XCNT(b.x)], 1u);
  return b;
}
DI void xcd_barrier_complete(unsigned* bar, unsigned x, unsigned& nloc, unsigned& nx) {
  const unsigned G = gridDim.x * gridDim.y * gridDim.z;
  unsigned sum, cnt, mine, sp = 0u;
  for (;;) {
    sum = 0u; cnt = 0u; mine = 0u;
#pragma unroll
    for (unsigned j = 0; j < 16; ++j) { const unsigned c = xb_ld(&bar[XB_XCNT(j)]); sum += c; cnt += (c > 0u) ? 1u : 0u; mine = (j == x) ? c : mine; }
    if (sum == G) break;
    __builtin_amdgcn_s_sleep(1);
    if ((++sp & 255u) == 0u) { if (xb_ld(&bar[XB_TMO])) break; if (sp > XB_SPIN_CAP) { atomicAdd(&bar[XB_TMO], 1u); break; } }
  }
  nloc = mine > 0u ? mine : 1u; nx = cnt > 0u ? cnt : 1u;
}
DI void xcd_barrier(const XcdBarrier& b) {
  asm volatile("s_waitcnt vmcnt(0)" ::: "memory");
  __syncthreads();
  if (threadIdx.x == 0) {
    unsigned* bar = b.bar;
    __builtin_amdgcn_s_waitcnt(0);
    unsigned nloc = b.st[0], nx = b.st[1];
    if (nloc == 0u) { xcd_barrier_complete(bar, b.x, nloc, nx); b.st[0] = nloc; b.st[1] = nx; }
    const unsigned old = xb_add(&bar[XB_XSUB(b.x)], 1u);
    const unsigned gen = old / nloc;
    if (old + 1u == (gen + 1u) * nloc) {
      __builtin_amdgcn_fence(__ATOMIC_RELEASE, "agent");
      asm volatile("s_waitcnt vmcnt(0)" ::: "memory");
      const unsigned og = xb_add(&bar[XB_TOP], 1u);
      const unsigned tg = og / nx;
      if (og + 1u == (tg + 1u) * nx) xb_add(&bar[XB_TOPGEN], 1u);
      else XB_SPIN(xb_ld(&bar[XB_TOPGEN]) == tg, bar);
      __builtin_amdgcn_fence(__ATOMIC_ACQUIRE, "agent");
      xb_add(&bar[XB_XGEN(b.x)], 1u);
      asm volatile("s_waitcnt vmcnt(0)" ::: "memory");
    } else {
      XB_SPIN(xb_ld(&bar[XB_XGEN(b.x)]) == gen, bar);
      __builtin_amdgcn_fence(__ATOMIC_ACQUIRE, "agent");
      asm volatile("s_waitcnt vmcnt(0)" ::: "memory");
    }
  }
  __syncthreads();
}

template <class F>
DI void transpose_convert(const float* __restrict__ src, int K, int N, int Npad, u16* __restrict__ dst, F rowmap,
                          int bid, int nb, char* smem) {
  u16* tile = reinterpret_cast<u16*>(smem);
  const int tid = otid();
  const int ntn = Npad / 128, ntk = K / 64;
  for (int t = bid; t < ntn * ntk; t += nb) {
    const int n0 = (t % ntn) * 128, k0 = (t / ntn) * 64;
    f32x4 v[4];
#pragma unroll
    for (int i = 0; i < 4; ++i) {
      const int kk = (tid >> 5) + 16 * i, nn = (tid & 31) * 4;
      v[i] = f32x4{0.f, 0.f, 0.f, 0.f};
      if (n0 + nn < N) v[i] = __builtin_nontemporal_load(reinterpret_cast<const f32x4*>(src + (size_t)(k0 + kk) * N + n0 + nn));
    }
#pragma unroll
    for (int i = 0; i < 4; ++i) {
      const int kk = (tid >> 5) + 16 * i, nn = (tid & 31) * 4;
      tile[(nn + 0) * 72 + kk] = f2bf(v[i][0]); tile[(nn + 1) * 72 + kk] = f2bf(v[i][1]);
      tile[(nn + 2) * 72 + kk] = f2bf(v[i][2]); tile[(nn + 3) * 72 + kk] = f2bf(v[i][3]);
    }
    __syncthreads();
#pragma unroll
    for (int j = 0; j < 2; ++j) {
      const int c = tid + NTHR * j, nn = c >> 3, k8 = (c & 7) * 8;
      const uint4 o = *reinterpret_cast<const uint4*>(tile + nn * 72 + k8);
      *reinterpret_cast<uint4*>(dst + (size_t)rowmap(n0 + nn) * K + k0 + k8) = o;
    }
    __syncthreads();
  }
}

template <class F>
DI void transpose_convert_f8(const float* __restrict__ src, int K, int N, unsigned char* __restrict__ dst, F rowmap,
                             int bid, int nb, char* smem) {
  unsigned char* tile = reinterpret_cast<unsigned char*>(smem);
  const int tid = otid();
  const int ntn = N / 128, ntk = K / 64;
  for (int t = bid; t < ntn * ntk; t += nb) {
    const int n0 = (t % ntn) * 128, k0 = (t / ntn) * 64;
    const int kq = (tid >> 5) * 4, nn = (tid & 31) * 4;
    f32x4 v[4];
#pragma unroll
    for (int r = 0; r < 4; ++r) v[r] = __builtin_nontemporal_load(reinterpret_cast<const f32x4*>(src + (size_t)(k0 + kq + r) * N + n0 + nn));
#pragma unroll
    for (int e = 0; e < 4; ++e)
      *reinterpret_cast<unsigned*>(tile + (nn + e) * 80 + kq) =
          pk4_f8(v[0][e] * F8_W_SCALE, v[1][e] * F8_W_SCALE, v[2][e] * F8_W_SCALE, v[3][e] * F8_W_SCALE);
    __syncthreads();
    {
      const int rn = tid >> 2, kc = (tid & 3) * 16;
      const uint4 o = *reinterpret_cast<const uint4*>(tile + rn * 80 + kc);
      *reinterpret_cast<uint4*>(dst + (size_t)rowmap(n0 + rn) * K + k0 + kc) = o;
    }
    __syncthreads();
  }
}

DI void ph_convert(const Params& p, char* smem) {
  const int nb = gridDim.x;
  int bid = obid();
  for (int idx = bid * NTHR + otid(); idx < SEQ * 56; idx += nb * NTHR) {
    const int pos = idx / 56, f = idx - pos * 56;
    float inv;
    if (f < 32) inv = exp2f(-(float)f * (13.287712379549449f / 32.f));
    else if (f < 40) inv = exp2f(-(float)(f - 32) * (18.931568569324174f / 8.f));
    else inv = exp2f(-(float)(f - 40) * (18.931568569324174f / 16.f));
    float sn, cs;
    sincosf((float)pos * inv, &sn, &cs);
    p.rtab()[(size_t)idx * 2] = cs;
    p.rtab()[(size_t)idx * 2 + 1] = sn;
  }
  auto ident = [](int n) { return n; };
  for (int L = 0; L < 2; ++L) {
    transpose_convert(p.w_in + (size_t)L * DM * PW, DM, PW, PWP, p.WinT() + (size_t)L * PWP * DM, ident, bid, nb, smem);
    transpose_convert(p.w_uq + (size_t)L * 256 * 384, 256, 384, 384, p.WuqT() + (size_t)L * 384 * 256, ident, bid, nb, smem);
    transpose_convert(p.w_ukv + (size_t)L * 128 * 512, 128, 512, 512, p.WukvT() + (size_t)L * 512 * 128, ident, bid, nb, smem);
    transpose_convert(p.w_out + (size_t)L * DM * DM, DM, DM, DM, p.WoutT() + (size_t)L * DM * DM, ident, bid, nb, smem);
    for (int e = 0; e < 16; ++e) {
      const size_t le = (size_t)(L * 16 + e);
      auto gmap = [](int n) { return (n >> 7) * 256 + (n & 127); };
      auto umap = [](int n) { return (n >> 7) * 256 + 128 + (n & 127); };
      transpose_convert_f8(p.w_gate + le * DM * 2048, DM, 2048, p.Wgu8() + le * 4096 * DM, gmap, bid, nb, smem);
      transpose_convert_f8(p.w_up + le * DM * 2048, DM, 2048, p.Wgu8() + le * 4096 * DM, umap, bid, nb, smem);
      transpose_convert_f8(p.w_down + le * 2048 * DM, 2048, DM, p.Wd8() + le * DM * 2048, ident, bid, nb, smem);
    }
  }
}

template <class RowPtr, class Epi>
DI void gemm_tile(RowPtr arow, const u16* __restrict__ bt, int ldb, int K, char* smem, Epi epi) {
  u16* sa = reinterpret_cast<u16*>(smem);
  u16* sb = sa + 2 * 256 * 72;
  const int tid = otid(), wid = tid >> 6, lane = tid & 63, wr = wid >> 1, wc = wid & 1, fr = lane & 15, fq = lane >> 4;
  f32x4 acc[4][4];
#pragma unroll
  for (int m = 0; m < 4; ++m)
#pragma unroll
    for (int n = 0; n < 4; ++n) acc[m][n] = f32x4{0.f, 0.f, 0.f, 0.f};
  const int lr = tid >> 3, lc = (tid & 7) * 8;
  const u16* ap[4];
#pragma unroll
  for (int i = 0; i < 4; ++i) ap[i] = arow(lr + 64 * i) + lc;
  const u16* bp[2];
#pragma unroll
  for (int i = 0; i < 2; ++i) bp[i] = bt + (size_t)(lr + 64 * i) * ldb + lc;
  uint4 ra[4], rb[2];
  const int nk = K / 64;
#pragma unroll
  for (int i = 0; i < 4; ++i) ra[i] = *reinterpret_cast<const uint4*>(ap[i]);
#pragma unroll
  for (int i = 0; i < 2; ++i) rb[i] = *reinterpret_cast<const uint4*>(bp[i]);
#pragma unroll
  for (int i = 0; i < 4; ++i) *reinterpret_cast<uint4*>(sa + (lr + 64 * i) * 72 + lc) = ra[i];
#pragma unroll
  for (int i = 0; i < 2; ++i) *reinterpret_cast<uint4*>(sb + (lr + 64 * i) * 72 + lc) = rb[i];
  __syncthreads();
  for (int kt = 0; kt < nk; ++kt) {
    const int cur = kt & 1;
    if (kt + 1 < nk) {
#pragma unroll
      for (int i = 0; i < 4; ++i) ra[i] = *reinterpret_cast<const uint4*>(ap[i] + (kt + 1) * 64);
#pragma unroll
      for (int i = 0; i < 2; ++i) rb[i] = *reinterpret_cast<const uint4*>(bp[i] + (kt + 1) * 64);
    }
    const u16* ca = sa + cur * 256 * 72;
    const u16* cb = sb + cur * 128 * 72;
#pragma unroll
    for (int kk = 0; kk < 2; ++kk) {
      bf16x8 af[4], bfr[4];
#pragma unroll
      for (int m = 0; m < 4; ++m) af[m] = *reinterpret_cast<const bf16x8*>(ca + (wr * 64 + m * 16 + fr) * 72 + kk * 32 + fq * 8);
#pragma unroll
      for (int n = 0; n < 4; ++n) bfr[n] = *reinterpret_cast<const bf16x8*>(cb + (wc * 64 + n * 16 + fr) * 72 + kk * 32 + fq * 8);
#pragma unroll
      for (int m = 0; m < 4; ++m)
#pragma unroll
        for (int n = 0; n < 4; ++n) acc[m][n] = __builtin_amdgcn_mfma_f32_16x16x32_bf16(af[m], bfr[n], acc[m][n], 0, 0, 0);
    }
    if (kt + 1 < nk) {
      u16* na = sa + (cur ^ 1) * 256 * 72;
      u16* nbp = sb + (cur ^ 1) * 128 * 72;
#pragma unroll
      for (int i = 0; i < 4; ++i) *reinterpret_cast<uint4*>(na + (lr + 64 * i) * 72 + lc) = ra[i];
#pragma unroll
      for (int i = 0; i < 2; ++i) *reinterpret_cast<uint4*>(nbp + (lr + 64 * i) * 72 + lc) = rb[i];
    }
    __syncthreads();
  }
  epi(acc, wr, wc, fr, fq);
}

#define WAIT_V(n) asm volatile("s_waitcnt vmcnt(%0)" ::"n"(n) : "memory")
DI int lds_byte2(int r, int c) {
  const int st = (r >> 4) * 2 + (c >> 5), ob = (r & 15) * 64 + (c & 31) * 2;
  return st * 1024 + (ob ^ (((ob >> 9) & 1) << 5));
}
DI void stage_rc2(int b, int& R, int& C) {
  const int st = b >> 10, sb = b & 1023, swz = sb ^ (((sb >> 9) & 1) << 5);
  R = (st >> 1) * 16 + swz / 64;
  C = (st & 1) * 32 + (swz % 64) / 2;
}
typedef __attribute__((address_space(3))) unsigned lds_u32;
template <class RowPtr, class Epi>
DI void gemm256(RowPtr arow, const u16* __restrict__ bt, int ldb, int K, char* smem, Epi epi) {
  constexpr int TILE_B = 256 * 64 * 2, STAGE_B = 2 * TILE_B;
  const int tid = otid(), wid = tid >> 6, lane = tid & 63, wr = wid >> 2, wc = wid & 3, fr = lane & 15, fq = lane >> 4;
  const u16* ap[4];
  const u16* bp[4];
#pragma unroll
  for (int i = 0; i < 4; ++i) {
    int R, C;
    stage_rc2(wid * 1024 + i * 8192 + lane * 16, R, C);
    ap[i] = arow(R) + C;
    bp[i] = bt + (size_t)R * ldb + C;
  }
  f32x4 acc[8][4];
#pragma unroll
  for (int m = 0; m < 8; ++m)
#pragma unroll
    for (int n = 0; n < 4; ++n) acc[m][n] = f32x4{0.f, 0.f, 0.f, 0.f};
#define G2_STAGE(buf, kt)                                                                                              \
  do {                                                                                                                 \
    _Pragma("unroll") for (int i = 0; i < 4; ++i) {                                                                    \
      __builtin_amdgcn_global_load_lds((const unsigned*)(ap[i] + (kt) * 64),                                           \
                                       (lds_u32*)(smem + (buf) * STAGE_B + wid * 1024 + i * 8192), 16, 0, 0);          \
      __builtin_amdgcn_global_load_lds((const unsigned*)(bp[i] + (kt) * 64),                                           \
                                       (lds_u32*)(smem + (buf) * STAGE_B + TILE_B + wid * 1024 + i * 8192), 16, 0, 0); \
    }                                                                                                                  \
  } while (0)
  const int nt = K / 64;
  G2_STAGE(0, 0);
  WAIT_V(0);
  __syncthreads();
  for (int t = 0; t < nt; ++t) {
    const int cur = t & 1;
    if (t + 1 < nt) G2_STAGE(cur ^ 1, t + 1);
    const char* sA = smem + cur * STAGE_B;
    const char* sB = sA + TILE_B;
#pragma unroll
    for (int ks = 0; ks < 2; ++ks) {
      bf16x8 At[8], Bf[4];
#pragma unroll
      for (int m = 0; m < 8; ++m) At[m] = *reinterpret_cast<const bf16x8*>(sA + lds_byte2(wr * 128 + m * 16 + fr, ks * 32 + fq * 8));
#pragma unroll
      for (int n = 0; n < 4; ++n) Bf[n] = *reinterpret_cast<const bf16x8*>(sB + lds_byte2(wc * 64 + n * 16 + fr, ks * 32 + fq * 8));
#pragma unroll
      for (int m = 0; m < 8; ++m)
#pragma unroll
        for (int n = 0; n < 4; ++n) acc[m][n] = __builtin_amdgcn_mfma_f32_16x16x32_bf16(Bf[n], At[m], acc[m][n], 0, 0, 0);
      __builtin_amdgcn_sched_barrier(0);
    }
    WAIT_V(0);
    __syncthreads();
  }
  epi(acc, wr, wc, fr, fq);
}

namespace pg8 {
constexpr int BM = 256, BK = 64, HALF = 128, HTB = HALF * BK * 2;
DI int lds_byte(int r, int c) { const int st = (r >> 4) * 2 + (c >> 5), rr = r & 15, cc = c & 31, ob = rr * 64 + cc * 2; return st * 1024 + (ob ^ (((ob >> 9) & 1) << 5)); }
DI void stage_rc(int b, int& R, int& C) { const int st = b / 1024, sb = b % 1024, swz = sb ^ (((sb >> 9) & 1) << 5); R = (st >> 1) * 16 + swz / 64; C = (st & 1) * 32 + (swz % 64) / 2; }
DI int perm32(int rho) { const int n = rho >> 4, i = rho & 15; return 8 * (i >> 2) + 4 * n + (i & 3); }
struct Unit { int pm, pn; };
typedef __attribute__((address_space(3))) unsigned char lds_u8;
typedef __attribute__((address_space(3))) unsigned lds_u32;
typedef __attribute__((address_space(3))) bf16x8 lds_bf16x8;
typedef __attribute__((address_space(3))) i32x4 lds_i32x4;

template <class Cfg>
DI void gemm_phase(lds_u8* lds, const Cfg& S) {
  const int tid = otid(), wid = __builtin_amdgcn_readfirstlane(tid >> 6), lane = tid & 63, wr = wid >> 2, wc = wid & 3, fr = lane & 15, fq = lane >> 4;
  const int K = S.K, nt = K / BK;
  int R0, C0, R1, C1;
  stage_rc(tid * 16, R0, C0);
  stage_rc(tid * 16 + 8192, R1, C1);
  unsigned voffB[2];
  {
    const int Rb0 = Cfg::PERM ? ((R0 & ~31) + perm32(R0 & 31)) : R0, Rb1 = Cfg::PERM ? ((R1 & ~31) + perm32(R1 & 31)) : R1;
    voffB[0] = (unsigned)(Rb0 * K + C0) * 2u; voffB[1] = (unsigned)(Rb1 * K + C1) * 2u;
  }
  const size_t kstep = (size_t)(BK * 2);
  const size_t hstep = (size_t)HALF * K * 2;
  const unsigned ldsw = (unsigned)wid * 1024u;
  const int aoff = lds_byte(wr * 64 + fr, fq * 8), boff = lds_byte(wc * 32 + fr, fq * 8);
#define PG8_SA(b, h) (((b) * 2 + (h)) * HTB)
#define PG8_SB(b, h) ((4 + (b) * 2 + (h)) * HTB)
#define PG8_STAGE2(bufoff, gbase, o0, o1) do { \
    __builtin_amdgcn_global_load_lds((const unsigned*)((const char*)(gbase) + (o0)), (lds_u32*)(lds + (bufoff) + ldsw), 16, 0, 0); \
    __builtin_amdgcn_global_load_lds((const unsigned*)((const char*)(gbase) + (o1)), (lds_u32*)(lds + (bufoff) + ldsw + 8192), 16, 0, 0); } while (0)
#define PG8_STAGEB(bufoff, gbase) PG8_STAGE2(bufoff, gbase, voffB[0], voffB[1])
#define PG8_LDA(dst, b, h) do { _Pragma("unroll") for (int m = 0; m < 4; ++m) _Pragma("unroll") for (int k = 0; k < 2; ++k) dst[m][k] = *(const lds_bf16x8*)(lds + PG8_SA(b, h) + aoff + m * 2048 + k * 1024); } while (0)
#define PG8_LDB(dst, b, h) do { _Pragma("unroll") for (int n = 0; n < 2; ++n) _Pragma("unroll") for (int k = 0; k < 2; ++k) dst[n][k] = *(const lds_bf16x8*)(lds + PG8_SB(b, h) + boff + n * 2048 + k * 1024); } while (0)
#define PG8_MMA(ai, bj, At, Bt) do { __builtin_amdgcn_s_setprio(1); _Pragma("unroll") for (int m = 0; m < 4; ++m) _Pragma("unroll") for (int n = 0; n < 2; ++n) _Pragma("unroll") for (int k = 0; k < 2; ++k) \
    acc[ai][bj][m][n] = __builtin_amdgcn_mfma_f32_16x16x32_bf16(Bt[n][k], At[m][k], acc[ai][bj][m][n], 0, 0, 0); __builtin_amdgcn_s_setprio(0); } while (0)
#define PG8_WAIT_V(n) asm volatile("s_waitcnt vmcnt(" #n ")" ::: "memory")
#define PG8_WAIT_L(n) asm volatile("s_waitcnt lgkmcnt(" #n ")" ::: "memory")
#define PG8_BAR __builtin_amdgcn_s_barrier()
#define PG8_SCHED __builtin_amdgcn_sched_barrier(0)
  Unit cur, nxt; int ui = 0;
  if (!S.next(0, cur)) return;
  f32x4 acc[2][2][4][2];
#pragma unroll
  for (int a = 0; a < 2; ++a)
#pragma unroll
    for (int b = 0; b < 2; ++b)
#pragma unroll
      for (int m = 0; m < 4; ++m)
#pragma unroll
        for (int n = 0; n < 2; ++n) acc[a][b][m][n] = f32x4{0.f, 0.f, 0.f, 0.f};
  bf16x8 At[4][2], B0[2][2], B1[2][2];
  const char* cA = S.a_base(cur);
  const char* cB = S.b_base(cur);
  unsigned vc[4], vn[4];
  S.a_off(cur, R0, C0, R1, C1, vc);
  PG8_STAGEB(PG8_SB(0, 0), cB); PG8_STAGE2(PG8_SA(0, 0), cA, vc[0], vc[1]); PG8_STAGEB(PG8_SB(0, 1), cB + hstep); PG8_STAGE2(PG8_SA(0, 1), cA, vc[2], vc[3]);
  if (wr == 1) PG8_BAR;
  PG8_WAIT_V(4); PG8_BAR;
  PG8_STAGEB(PG8_SB(1, 0), cB + kstep); PG8_STAGE2(PG8_SA(1, 0), cA + kstep, vc[0], vc[1]); PG8_STAGEB(PG8_SB(1, 1), cB + hstep + kstep);
  PG8_WAIT_V(6); PG8_BAR;
  for (;;) {
    const bool has_next = S.next(ui + 1, nxt);
    const char* nA = has_next ? S.a_base(nxt) : cA;
    const char* nB = has_next ? S.b_base(nxt) : cB;
    if (has_next) S.a_off(nxt, R0, C0, R1, C1, vn);
    else { vn[0] = vc[0]; vn[1] = vc[1]; vn[2] = vc[2]; vn[3] = vc[3]; }
    for (int t = 0; t < nt; t += 2) {
      const bool last = (t == nt - 2);
      const char* a1 = cA + (size_t)(t + 1) * kstep;
      const char* a2 = last ? nA : cA + (size_t)(t + 2) * kstep;
      const char* b2 = last ? nB : cB + (size_t)(t + 2) * kstep;
      const char* a3 = a2 + kstep;
      const char* b3 = b2 + kstep;
      const unsigned w0 = last ? vn[0] : vc[0], w1 = last ? vn[1] : vc[1], w2 = last ? vn[2] : vc[2], w3 = last ? vn[3] : vc[3];
      PG8_LDB(B0, 0, 0); PG8_SCHED; PG8_LDA(At, 0, 0); PG8_STAGE2(PG8_SA(1, 1), a1, vc[2], vc[3]);
      PG8_WAIT_L(8); PG8_BAR; PG8_WAIT_L(0); PG8_MMA(0, 0, At, B0); PG8_BAR; PG8_SCHED;
      PG8_LDB(B1, 0, 1); PG8_STAGEB(PG8_SB(0, 0), b2);
      PG8_BAR; PG8_WAIT_L(0); PG8_MMA(0, 1, At, B1); PG8_BAR;
      PG8_LDA(At, 0, 1); PG8_STAGE2(PG8_SA(0, 0), a2, w0, w1);
      PG8_BAR; PG8_WAIT_L(0); PG8_MMA(1, 0, At, B0); PG8_BAR; PG8_SCHED;
      PG8_STAGEB(PG8_SB(0, 1), b2 + hstep);
      PG8_WAIT_V(6); PG8_BAR; PG8_MMA(1, 1, At, B1); PG8_BAR;
      PG8_LDB(B0, 1, 0); PG8_SCHED; PG8_LDA(At, 1, 0); PG8_STAGE2(PG8_SA(0, 1), a2, w2, w3);
      PG8_WAIT_L(8); PG8_BAR; PG8_WAIT_L(0); PG8_MMA(0, 0, At, B0); PG8_BAR; PG8_SCHED;
      PG8_LDB(B1, 1, 1); PG8_STAGEB(PG8_SB(1, 0), b3);
      PG8_BAR; PG8_WAIT_L(0); PG8_MMA(0, 1, At, B1); PG8_BAR;
      PG8_LDA(At, 1, 1); PG8_STAGE2(PG8_SA(1, 0), a3, w0, w1);
      PG8_BAR; PG8_WAIT_L(0); PG8_MMA(1, 0, At, B0); PG8_BAR; PG8_SCHED;
      PG8_STAGEB(PG8_SB(1, 1), b3 + hstep);
      PG8_WAIT_V(6); PG8_BAR; PG8_MMA(1, 1, At, B1); PG8_BAR;
    }
    S.epi(acc, cur, wr, wc, fr, fq);
    if (!has_next) break;
#pragma unroll
    for (int a = 0; a < 2; ++a)
#pragma unroll
      for (int b = 0; b < 2; ++b)
#pragma unroll
        for (int m = 0; m < 4; ++m)
#pragma unroll
          for (int n = 0; n < 2; ++n) acc[a][b][m][n] = f32x4{0.f, 0.f, 0.f, 0.f};
    cur = nxt; cA = nA; cB = nB; ++ui;
    vc[0] = vn[0]; vc[1] = vn[1]; vc[2] = vn[2]; vc[3] = vn[3];
  }
  PG8_WAIT_V(0);
  if (wr == 0) PG8_BAR;
  PG8_BAR;
#undef PG8_SA
#undef PG8_SB
#undef PG8_STAGE2
#undef PG8_STAGEB
#undef PG8_LDA
#undef PG8_LDB
#undef PG8_MMA
#undef PG8_WAIT_V
#undef PG8_WAIT_L
#undef PG8_BAR
#undef PG8_SCHED
}
template <class Cfg>
DI void gemm_phase_f8(lds_u8* lds, const Cfg& S) {
  const int tid = otid(), wid = __builtin_amdgcn_readfirstlane(tid >> 6), lane = tid & 63, wr = wid >> 2, wc = wid & 3, fr = lane & 15, fq = lane >> 4;
  const int K = S.K, nt = K / BK;
  int R0, C0, R1, C1;
  stage_rc(tid * 16, R0, C0);
  stage_rc(tid * 16 + 8192, R1, C1);
  unsigned voffB[2];
  {
    const int Rb0 = Cfg::PERM ? ((R0 & ~31) + perm32(R0 & 31)) : R0, Rb1 = Cfg::PERM ? ((R1 & ~31) + perm32(R1 & 31)) : R1;
    voffB[0] = (unsigned)(Rb0 * K + C0) * 2u; voffB[1] = (unsigned)(Rb1 * K + C1) * 2u;
  }
  const size_t kstep = (size_t)(BK * 2);
  const size_t hstep = (size_t)HALF * K * 2;
  const unsigned ldsw = (unsigned)wid * 1024u;
  const int aoffL = lds_byte(wr * 64 + fr, 2 * fq * 8), boffL = lds_byte(wc * 32 + fr, 2 * fq * 8);
#define PG8_SA(b, h) (((b) * 2 + (h)) * HTB)
#define PG8_SB(b, h) ((4 + (b) * 2 + (h)) * HTB)
#define PG8_STAGE2(bufoff, gbase, o0, o1) do { \
    __builtin_amdgcn_global_load_lds((const unsigned*)((const char*)(gbase) + (o0)), (lds_u32*)(lds + (bufoff) + ldsw), 16, 0, 0); \
    __builtin_amdgcn_global_load_lds((const unsigned*)((const char*)(gbase) + (o1)), (lds_u32*)(lds + (bufoff) + ldsw + 8192), 16, 0, 0); } while (0)
#define PG8_STAGEB(bufoff, gbase) PG8_STAGE2(bufoff, gbase, voffB[0], voffB[1])
#define PG8_LDA(dst, b, h) do { _Pragma("unroll") for (int m = 0; m < 4; ++m) { const i32x4 lo_ = *(const lds_i32x4*)(lds + PG8_SA(b, h) + aoffL + m * 2048), hi_ = *(const lds_i32x4*)(lds + PG8_SA(b, h) + aoffL + m * 2048 + 16); dst[m] = __builtin_shufflevector(lo_, hi_, 0, 1, 2, 3, 4, 5, 6, 7); } } while (0)
#define PG8_LDB(dst, b, h) do { _Pragma("unroll") for (int n = 0; n < 2; ++n) { const i32x4 lo_ = *(const lds_i32x4*)(lds + PG8_SB(b, h) + boffL + n * 2048), hi_ = *(const lds_i32x4*)(lds + PG8_SB(b, h) + boffL + n * 2048 + 16); dst[n] = __builtin_shufflevector(lo_, hi_, 0, 1, 2, 3, 4, 5, 6, 7); } } while (0)
#define PG8_MMA(ai, bj, At, Bt) do { __builtin_amdgcn_s_setprio(1); _Pragma("unroll") for (int m = 0; m < 4; ++m) _Pragma("unroll") for (int n = 0; n < 2; ++n) \
    asm volatile("v_mfma_f32_16x16x128_f8f6f4 %0, %1, %2, %0" : "+v"(acc[ai][bj][m][n]) : "v"(Bt[n]), "v"(At[m])); __builtin_amdgcn_s_setprio(0); } while (0)
#define PG8_WAIT_V(n) asm volatile("s_waitcnt vmcnt(" #n ")" ::: "memory")
#define PG8_WAIT_L(n) asm volatile("s_waitcnt lgkmcnt(" #n ")" ::: "memory")
#define PG8_BAR __builtin_amdgcn_s_barrier()
#define PG8_SCHED __builtin_amdgcn_sched_barrier(0)
  Unit cur, nxt; int ui = 0;
  if (!S.next(0, cur)) return;
  f32x4 acc[2][2][4][2];
#pragma unroll
  for (int a = 0; a < 2; ++a)
#pragma unroll
    for (int b = 0; b < 2; ++b)
#pragma unroll
      for (int m = 0; m < 4; ++m)
#pragma unroll
        for (int n = 0; n < 2; ++n) acc[a][b][m][n] = f32x4{0.f, 0.f, 0.f, 0.f};
  i32x8 At[4], B0[2], B1[2];
  const char* cA = S.a_base(cur);
  const char* cB = S.b_base(cur);
  unsigned vc[4], vn[4];
  S.a_off(cur, R0, C0, R1, C1, vc);
  PG8_STAGEB(PG8_SB(0, 0), cB); PG8_STAGE2(PG8_SA(0, 0), cA, vc[0], vc[1]); PG8_STAGEB(PG8_SB(0, 1), cB + hstep); PG8_STAGE2(PG8_SA(0, 1), cA, vc[2], vc[3]);
  if (wr == 1) PG8_BAR;
  PG8_WAIT_V(4); PG8_BAR;
  PG8_STAGEB(PG8_SB(1, 0), cB + kstep); PG8_STAGE2(PG8_SA(1, 0), cA + kstep, vc[0], vc[1]); PG8_STAGEB(PG8_SB(1, 1), cB + hstep + kstep);
  PG8_WAIT_V(6); PG8_BAR;
  for (;;) {
    const bool has_next = S.next(ui + 1, nxt);
    const char* nA = has_next ? S.a_base(nxt) : cA;
    const char* nB = has_next ? S.b_base(nxt) : cB;
    if (has_next) S.a_off(nxt, R0, C0, R1, C1, vn);
    else { vn[0] = vc[0]; vn[1] = vc[1]; vn[2] = vc[2]; vn[3] = vc[3]; }
    for (int t = 0; t < nt; t += 2) {
      const bool last = (t == nt - 2);
      const char* a1 = cA + (size_t)(t + 1) * kstep;
      const char* a2 = last ? nA : cA + (size_t)(t + 2) * kstep;
      const char* b2 = last ? nB : cB + (size_t)(t + 2) * kstep;
      const char* a3 = a2 + kstep;
      const char* b3 = b2 + kstep;
      const unsigned w0 = last ? vn[0] : vc[0], w1 = last ? vn[1] : vc[1], w2 = last ? vn[2] : vc[2], w3 = last ? vn[3] : vc[3];
      PG8_LDB(B0, 0, 0); PG8_SCHED; PG8_LDA(At, 0, 0); PG8_STAGE2(PG8_SA(1, 1), a1, vc[2], vc[3]);
      PG8_WAIT_L(8); PG8_BAR; PG8_WAIT_L(0); PG8_MMA(0, 0, At, B0); PG8_BAR; PG8_SCHED;
      PG8_LDB(B1, 0, 1); PG8_STAGEB(PG8_SB(0, 0), b2);
      PG8_BAR; PG8_WAIT_L(0); PG8_MMA(0, 1, At, B1); PG8_BAR;
      PG8_LDA(At, 0, 1); PG8_STAGE2(PG8_SA(0, 0), a2, w0, w1);
      PG8_BAR; PG8_WAIT_L(0); PG8_MMA(1, 0, At, B0); PG8_BAR; PG8_SCHED;
      PG8_STAGEB(PG8_SB(0, 1), b2 + hstep);
      PG8_WAIT_V(6); PG8_BAR; PG8_MMA(1, 1, At, B1); PG8_BAR;
      PG8_LDB(B0, 1, 0); PG8_SCHED; PG8_LDA(At, 1, 0); PG8_STAGE2(PG8_SA(0, 1), a2, w2, w3);
      PG8_WAIT_L(8); PG8_BAR; PG8_WAIT_L(0); PG8_MMA(0, 0, At, B0); PG8_BAR; PG8_SCHED;
      PG8_LDB(B1, 1, 1); PG8_STAGEB(PG8_SB(1, 0), b3);
      PG8_BAR; PG8_WAIT_L(0); PG8_MMA(0, 1, At, B1); PG8_BAR;
      PG8_LDA(At, 1, 1); PG8_STAGE2(PG8_SA(1, 0), a3, w0, w1);
      PG8_BAR; PG8_WAIT_L(0); PG8_MMA(1, 0, At, B0); PG8_BAR; PG8_SCHED;
      PG8_STAGEB(PG8_SB(1, 1), b3 + hstep);
      PG8_WAIT_V(6); PG8_BAR; PG8_MMA(1, 1, At, B1); PG8_BAR;
    }
    asm volatile("s_nop 15\n\ts_nop 15" ::: "memory");
    S.epi(acc, cur, wr, wc, fr, fq);
    if (!has_next) break;
#pragma unroll
    for (int a = 0; a < 2; ++a)
#pragma unroll
      for (int b = 0; b < 2; ++b)
#pragma unroll
        for (int m = 0; m < 4; ++m)
#pragma unroll
          for (int n = 0; n < 2; ++n) acc[a][b][m][n] = f32x4{0.f, 0.f, 0.f, 0.f};
    cur = nxt; cA = nA; cB = nB; ++ui;
    vc[0] = vn[0]; vc[1] = vn[1]; vc[2] = vn[2]; vc[3] = vn[3];
  }
  PG8_WAIT_V(0);
  if (wr == 0) PG8_BAR;
  PG8_BAR;
#undef PG8_SA
#undef PG8_SB
#undef PG8_STAGE2
#undef PG8_STAGEB
#undef PG8_LDA
#undef PG8_LDB
#undef PG8_MMA
#undef PG8_WAIT_V
#undef PG8_WAIT_L
#undef PG8_BAR
#undef PG8_SCHED
}
}

struct CfgInproj {
  static constexpr bool PERM = true;
  int K; const Params* p; int L; int bid, nb;
  DI bool next(int i, pg8::Unit& u) const { const int t = i * nb + bid; if (t >= 64 * 13) return false; u.pm = t & 63; u.pn = t >> 6; return true; }
  DI const char* a_base(const pg8::Unit& u) const { return (const char*)(p->hn() + (size_t)u.pm * 256 * DM); }
  DI const char* b_base(const pg8::Unit& u) const { return (const char*)(p->WinT() + ((size_t)L * PWP + (size_t)u.pn * 256) * DM); }
  DI void a_off(const pg8::Unit&, int R0, int C0, int R1, int C1, unsigned (&vo)[4]) const {
    vo[0] = (unsigned)(R0 * DM + C0) * 2u; vo[1] = (unsigned)(R1 * DM + C1) * 2u;
    vo[2] = vo[0] + 128u * DM * 2u; vo[3] = vo[1] + 128u * DM * 2u;
  }
  DI void epi(const f32x4 (&acc)[2][2][4][2], const pg8::Unit& u, int wr, int wc, int fr, int fq) const {
    const int row0 = u.pm * 256 + wr * 64 + fr, col0 = u.pn * 256 + wc * 32 + 8 * fq;
#pragma unroll
    for (int ai = 0; ai < 2; ++ai)
#pragma unroll
      for (int m = 0; m < 4; ++m) {
        u16* rowp = p->proj() + (size_t)(row0 + ai * 128 + m * 16) * PWP + col0;
#pragma unroll
        for (int bj = 0; bj < 2; ++bj) {
          uint4 w;
          w.x = pack2(acc[ai][bj][m][0][0], acc[ai][bj][m][0][1]); w.y = pack2(acc[ai][bj][m][0][2], acc[ai][bj][m][0][3]);
          w.z = pack2(acc[ai][bj][m][1][0], acc[ai][bj][m][1][1]); w.w = pack2(acc[ai][bj][m][1][2], acc[ai][bj][m][1][3]);
          *reinterpret_cast<uint4*>(rowp + bj * 128) = w;
        }
      }
  }
};
DI void ph_inproj_tail(const Params& p, int L, char* smem, int t) {
  const int m0 = (t & 63) * 256, n0 = 3072 + (t >> 6) * 128;
  const u16* Bt = p.WinT() + ((size_t)L * PWP + n0) * DM;
  gemm_tile([&](int r) { return p.hn() + (size_t)(m0 + r) * DM; }, Bt, DM, DM, smem,
            [&](f32x4 (&acc)[4][4], int wr, int wc, int fr, int fq) {
#pragma unroll
              for (int m = 0; m < 4; ++m)
#pragma unroll
                for (int n = 0; n < 4; ++n)
#pragma unroll
                  for (int j = 0; j < 4; ++j)
                    p.proj()[(size_t)(m0 + wr * 64 + m * 16 + fq * 4 + j) * PWP + n0 + wc * 64 + n * 16 + fr] = f2bf(acc[m][n][j]);
            });
}
DI void ph_inproj(const Params& p, int L, char* smem) {
  CfgInproj c; c.K = DM; c.p = &p; c.L = L; c.bid = obid(); c.nb = gridDim.x;
  pg8::gemm_phase((pg8::lds_u8*)smem, c);
}

DI void ph_gemm_store_bf16(const u16* A, int lda, const u16* Bt, int K, int M, int N, u16* C, int ldc, char* smem, int rot) {
  const int mt = M / 256, nt = N / 128;
  const int nb = gridDim.x;
  for (int t = (obid() + rot) % nb; t < mt * nt; t += nb) {
    const int m0 = (t % mt) * 256, n0 = (t / mt) * 128;
    gemm_tile([&](int r) { return A + (size_t)(m0 + r) * lda; }, Bt + (size_t)n0 * K, K, K, smem,
              [&](f32x4 (&acc)[4][4], int wr, int wc, int fr, int fq) {
#pragma unroll
                for (int m = 0; m < 4; ++m)
#pragma unroll
                  for (int n = 0; n < 4; ++n)
#pragma unroll
                    for (int j = 0; j < 4; ++j) {
                      const int row = m0 + wr * 64 + m * 16 + fq * 4 + j, col = n0 + wc * 64 + n * 16 + fr;
                      C[(size_t)row * ldc + col] = f2bf(acc[m][n][j]);
                    }
              });
  }
}

DI void ph_rmsnorm_bf16(const float* __restrict__ xin, const float* __restrict__ w, u16* __restrict__ outp) {
  const int tid_ = otid(); const int lane = tid_ & 63, gw = (obid() * NTHR + tid_) >> 6, nw = gridDim.x * (NTHR / 64);
  for (int t = gw; t < T; t += nw) {
    const float* xr = xin + (size_t)t * DM;
    float4 v[4];
    float ss = 0.f;
#pragma unroll
    for (int i = 0; i < 4; ++i) {
      v[i] = *reinterpret_cast<const float4*>(xr + (i * 64 + lane) * 4);
      ss += v[i].x * v[i].x + v[i].y * v[i].y + v[i].z * v[i].z + v[i].w * v[i].w;
    }
    ss = wave_sum(ss);
    const float rstd = rsqrtf(ss * (1.f / DM) + 1e-6f);
#pragma unroll
    for (int i = 0; i < 4; ++i) {
      const int c = (i * 64 + lane) * 4;
      const float4 ww = *reinterpret_cast<const float4*>(w + c);
      uint2 o;
      o.x = pack2(v[i].x * rstd * ww.x, v[i].y * rstd * ww.y);
      o.y = pack2(v[i].z * rstd * ww.z, v[i].w * rstd * ww.w);
      *reinterpret_cast<uint2*>(outp + (size_t)t * DM + c) = o;
    }
  }
}

DI void ph_final_norm(const float* __restrict__ xin, const float* __restrict__ w, float* __restrict__ outp) {
  const int tid_ = otid(); const int lane = tid_ & 63, gw = (obid() * NTHR + tid_) >> 6, nw = gridDim.x * (NTHR / 64);
  for (int t = gw; t < T; t += nw) {
    const float* xr = xin + (size_t)t * DM;
    float4 v[4];
    float ss = 0.f;
#pragma unroll
    for (int i = 0; i < 4; ++i) {
      v[i] = *reinterpret_cast<const float4*>(xr + (i * 64 + lane) * 4);
      ss += v[i].x * v[i].x + v[i].y * v[i].y + v[i].z * v[i].z + v[i].w * v[i].w;
    }
    ss = wave_sum(ss);
    const float rstd = rsqrtf(ss * (1.f / DM) + 1e-6f);
#pragma unroll
    for (int i = 0; i < 4; ++i) {
      const int c = (i * 64 + lane) * 4;
      const float4 ww = *reinterpret_cast<const float4*>(w + c);
      float4 o = make_float4(v[i].x * rstd * ww.x, v[i].y * rstd * ww.y, v[i].z * rstd * ww.z, v[i].w * rstd * ww.w);
      *reinterpret_cast<float4*>(outp + (size_t)t * DM + c) = o;
    }
  }
}

DI void rot8(const u16* x1p, const u16* x2p, const float* tab  , float scale, uint4& o1, uint4& o2) {
  float x1[8], x2[8], y1[8], y2[8];
  ld8(x1p, x1); ld8(x2p, x2);
#pragma unroll
  for (int e = 0; e < 8; e += 2) {
    const float4 cs = *reinterpret_cast<const float4*>(tab + e * 2);
    y1[e] = (x1[e] * cs.x - x2[e] * cs.y) * scale;
    y2[e] = (x2[e] * cs.x + x1[e] * cs.y) * scale;
    y1[e + 1] = (x1[e + 1] * cs.z - x2[e + 1] * cs.w) * scale;
    y2[e + 1] = (x2[e + 1] * cs.z + x1[e + 1] * cs.w) * scale;
  }
  o1.x = pack2(y1[0], y1[1]); o1.y = pack2(y1[2], y1[3]); o1.z = pack2(y1[4], y1[5]); o1.w = pack2(y1[6], y1[7]);
  o2.x = pack2(y2[0], y2[1]); o2.y = pack2(y2[2], y2[3]); o2.z = pack2(y2[4], y2[5]); o2.w = pack2(y2[6], y2[7]);
}
DI void ph_post(const Params& p, int L) {
  const int tid = otid();
  const int gt = obid() * NTHR + tid, gs = gridDim.x * NTHR;
  const int lane = tid & 63, gw = gt >> 6, nw = gs >> 6;
  const float* qnw = p.q_norm_w + L * 256;
  const float* kvnw = p.kv_norm_w + L * 128;
  const float* cw = p.conv_w + L * 5 * 768;
  const float* cb = p.conv_b + L * 768;
  const float* dtb = p.dt_bias + L * 8;
  for (int idx = gt; idx < T * 96; idx += gs) {
    const int t = idx / 96, cg = idx - t * 96, s = t & (SEQ - 1);
    float acc[8];
    {
      const float4 b0 = *reinterpret_cast<const float4*>(cb + cg * 8), b1 = *reinterpret_cast<const float4*>(cb + cg * 8 + 4);
      acc[0] = b0.x; acc[1] = b0.y; acc[2] = b0.z; acc[3] = b0.w; acc[4] = b1.x; acc[5] = b1.y; acc[6] = b1.z; acc[7] = b1.w;
    }
#pragma unroll
    for (int w = 0; w < 5; ++w) {
      const int ss = s + w - 2;
      if (ss >= 0 && ss < SEQ) {
        float xv[8];
        ld8(p.proj() + (size_t)(t + w - 2) * PWP + C_XBC + cg * 8, xv);
        const float4 w0 = *reinterpret_cast<const float4*>(cw + w * 768 + cg * 8), w1 = *reinterpret_cast<const float4*>(cw + w * 768 + cg * 8 + 4);
        acc[0] += xv[0] * w0.x; acc[1] += xv[1] * w0.y; acc[2] += xv[2] * w0.z; acc[3] += xv[3] * w0.w;
        acc[4] += xv[4] * w1.x; acc[5] += xv[5] * w1.y; acc[6] += xv[6] * w1.z; acc[7] += xv[7] * w1.w;
      }
    }
    uint4 o;
    o.x = pack2(fast_silu(acc[0]), fast_silu(acc[1])); o.y = pack2(fast_silu(acc[2]), fast_silu(acc[3]));
    o.z = pack2(fast_silu(acc[4]), fast_silu(acc[5])); o.w = pack2(fast_silu(acc[6]), fast_silu(acc[7]));
    *reinterpret_cast<uint4*>(p.xbc() + (size_t)t * 768 + cg * 8) = o;
  }
  for (int idx = gt; idx < T * 8; idx += gs) {
    const int t = idx >> 3, k = idx & 7;
    const float v = bf2f(p.proj()[(size_t)t * PWP + C_DT + k]) + dtb[k];
    p.dtv()[idx] = (v > 20.f) ? v : log1pf(expf(v));
  }
  {
    const int sub = lane >> 4, l16 = lane & 15;
    for (int t = gw * 4 + sub; t < T; t += nw * 4) {
      const u16* pr = p.proj() + (size_t)t * PWP;
      float v[16], u[8];
      ld8(pr + C_CQ + l16 * 16, v); ld8(pr + C_CQ + l16 * 16 + 8, v + 8);
      ld8(pr + C_CKV + l16 * 8, u);
      float ss = 0.f, s2 = 0.f;
#pragma unroll
      for (int i = 0; i < 16; ++i) ss += v[i] * v[i];
#pragma unroll
      for (int i = 0; i < 8; ++i) s2 += u[i] * u[i];
#pragma unroll
      for (int o = 1; o < 16; o <<= 1) { ss += __shfl_xor(ss, o); s2 += __shfl_xor(s2, o); }
      const float rstd = rsqrtf(ss * (1.f / 256.f) + 1e-6f), r2 = rsqrtf(s2 * (1.f / 128.f) + 1e-6f);
      uint4 o;
      const float* qw = qnw + l16 * 16;
      o.x = pack2(v[0] * rstd * qw[0], v[1] * rstd * qw[1]); o.y = pack2(v[2] * rstd * qw[2], v[3] * rstd * qw[3]);
      o.z = pack2(v[4] * rstd * qw[4], v[5] * rstd * qw[5]); o.w = pack2(v[6] * rstd * qw[6], v[7] * rstd * qw[7]);
      *reinterpret_cast<uint4*>(p.cqn() + (size_t)t * 256 + l16 * 16) = o;
      o.x = pack2(v[8] * rstd * qw[8], v[9] * rstd * qw[9]); o.y = pack2(v[10] * rstd * qw[10], v[11] * rstd * qw[11]);
      o.z = pack2(v[12] * rstd * qw[12], v[13] * rstd * qw[13]); o.w = pack2(v[14] * rstd * qw[14], v[15] * rstd * qw[15]);
      *reinterpret_cast<uint4*>(p.cqn() + (size_t)t * 256 + l16 * 16 + 8) = o;
      const float* kw = kvnw + l16 * 8;
      o.x = pack2(u[0] * r2 * kw[0], u[1] * r2 * kw[1]); o.y = pack2(u[2] * r2 * kw[2], u[3] * r2 * kw[3]);
      o.z = pack2(u[4] * r2 * kw[4], u[5] * r2 * kw[5]); o.w = pack2(u[6] * r2 * kw[6], u[7] * r2 * kw[7]);
      *reinterpret_cast<uint4*>(p.ckvn() + (size_t)t * 128 + l16 * 8) = o;
    }
  }
  for (int idx = gt; idx < T * 42; idx += gs) {
    const int t = idx / 42, ri = idx - t * 42, s = t & (SEQ - 1);
    u16* pr = p.proj() + (size_t)t * PWP;
    uint4 o1, o2;
    if (ri < 32) {
      const int isk = ri >> 4, h = (ri >> 2) & 3, i0 = (ri & 3) * 8;
      u16* a = pr + (isk ? C_RK : C_RQ) + h * 64 + i0;
      rot8(a, a + 32, p.rtab() + ((size_t)s * 56 + i0) * 2, isk ? 1.f : 0.125f, o1, o2);
      *reinterpret_cast<uint4*>(a) = o1;
      *reinterpret_cast<uint4*>(a + 32) = o2;
    } else if (ri < 40) {
      const int j = ri - 32, isk = j >> 2, h = j & 3;
      u16* a = pr + (isk ? C_DK : C_DQ) + h * 64;
      rot8(a, a + 8, p.rtab() + ((size_t)s * 56 + 32) * 2, 1.f, o1, o2);
      *reinterpret_cast<uint4*>(a) = o1;
      *reinterpret_cast<uint4*>(a + 8) = o2;
    } else {
      const int i0 = (ri - 40) * 8;
      u16* a = pr + C_KR + i0;
      rot8(a, a + 16, p.rtab() + ((size_t)s * 56 + 40 + i0) * 2, 1.f, o1, o2);
      *reinterpret_cast<uint4*>(a) = o1;
      *reinterpret_cast<uint4*>(a + 16) = o2;
      const int bb = t >> 12;
#pragma unroll
      for (int hd = 0; hd < 4; ++hd) {
        u16* kf = p.kfull() + ((size_t)(bb * 4 + hd) * SEQ + s) * 96 + 64 + i0;
        *reinterpret_cast<uint4*>(kf) = o1;
        *reinterpret_cast<uint4*>(kf + 16) = o2;
      }
    }
  }
}

DI void ph_mla_up_q(const Params& p, int L, char* smem, int t) {
  const int mt = T / 256;
  const u16* Bq = p.WuqT() + (size_t)L * 384 * 256;
  {
    const int m0 = (t % mt) * 256, n0 = (t / mt) * 128;
    gemm_tile([&](int r) { return p.cqn() + (size_t)(m0 + r) * 256; }, Bq + (size_t)n0 * 256, 256, 256, smem,
              [&](f32x4 (&acc)[4][4], int wr, int wc, int fr, int fq) {
                const float scale = 0.10206207261596575f * 1.4426950408889634f;
#pragma unroll
                for (int m = 0; m < 4; ++m)
#pragma unroll
                  for (int j = 0; j < 4; ++j) {
                    const int row = m0 + wr * 64 + m * 16 + fq * 4 + j;
                    const float2 cssn = *reinterpret_cast<const float2*>(p.rtab() + ((size_t)(row & (SEQ - 1)) * 56 + 40 + fr) * 2);
                    const float cs = cssn.x, sn = cssn.y;
#pragma unroll
                    for (int n2 = 0; n2 < 4; n2 += 2) {
                      const int cb = n0 + wc * 64 + n2 * 16;
                      float x1 = acc[m][n2][j], x2 = acc[m][n2 + 1][j];
                      if (cb % 96 == 64) {
                        const float y1 = x1 * cs - x2 * sn, y2 = x2 * cs + x1 * sn;
                        x1 = y1; x2 = y2;
                      }
                      p.mq()[(size_t)row * 384 + cb + fr] = f2bf(x1 * scale);
                      p.mq()[(size_t)row * 384 + cb + 16 + fr] = f2bf(x2 * scale);
                    }
                  }
              });
  }
}
DI void ph_mla_up_kv(const Params& p, int L, char* smem, int t) {
  const int mt = T / 256;
  const u16* Bkv = p.WukvT() + (size_t)L * 512 * 128;
  {
    const int m0 = (t % mt) * 256, h = t / mt, n0 = h * 128;
    gemm_tile([&](int r) { return p.ckvn() + (size_t)(m0 + r) * 128; }, Bkv + (size_t)n0 * 128, 128, 128, smem,
              [&](f32x4 (&acc)[4][4], int wr, int wc, int fr, int fq) {
#pragma unroll
                for (int m = 0; m < 4; ++m) {
                  const int row = m0 + wr * 64 + m * 16 + fq * 4;
                  const int bb = row >> 12, sq = row & (SEQ - 1);
                  const size_t bh = (size_t)(bb * 4 + h);
#pragma unroll
                  for (int n = 0; n < 4; ++n) {
                    if (wc == 0) {
#pragma unroll
                      for (int j = 0; j < 4; ++j) p.kfull()[(bh * SEQ + sq + j) * 96 + n * 16 + fr] = f2bf(acc[m][n][j]);
                    } else {
                      uint2 v;
                      v.x = pack2(acc[m][n][0], acc[m][n][1]);
                      v.y = pack2(acc[m][n][2], acc[m][n][3]);
                      const int sqp = (sq & ~12) | ((sq & 4) << 1) | ((sq & 8) >> 1);
                      *reinterpret_cast<uint2*>(p.vT() + (bh * 64 + n * 16 + fr) * SEQ + sqp) = v;
                    }
                  }
                }
              });
  }
}

DI void ph_cumsum(const Params& p, int L) {
  const int tid_ = otid(); const int lane = tid_ & 63, gw = (obid() * NTHR + tid_) >> 6, nw = gridDim.x * (NTHR / 64);
  for (int it = gw; it < 32; it += nw) {
    const int h = it & 3, dir = (it >> 2) & 1, b = it >> 3;
    const float a = -expf(p.a_log[L * 8 + dir * 4 + h]);
    float running = 0.f;
    for (int c = 0; c < 64; ++c) {
      const int i = c * 64 + lane;
      const int s = dir ? (SEQ - 1 - i) : i;
      const size_t off = (size_t)(b * SEQ + s) * 8 + dir * 4 + h;
      float v = p.dtv()[off] * a;
#pragma unroll
      for (int o = 1; o < 64; o <<= 1) {
        const float u = __shfl_up(v, o);
        if (lane >= o) v += u;
      }
      v += running;
      p.cs()[off] = v;
      running = __shfl(v, 63);
    }
  }
}

DI void ph_ret_naive(const Params& p) {
  const int gt = obid() * NTHR + otid(), gs = gridDim.x * NTHR;
  for (int it = gt; it < 4 * 4 * SEQ; it += gs) {
    const int n = it & (SEQ - 1), h = (it >> 12) & 3, b = it >> 14;
    const u16* base = p.proj() + (size_t)(b * SEQ) * PWP;
    uint4 qp[8];
    float o[64];
#pragma unroll
    for (int d = 0; d < 8; ++d) qp[d] = *reinterpret_cast<const uint4*>(base + (size_t)n * PWP + C_RQ + h * 64 + d * 8);
#pragma unroll
    for (int d = 0; d < 64; ++d) o[d] = 0.f;
    const float lg0 = log1pf(-exp2f(-5.f - (float)h)), lg1 = log1pf(-exp2f(-5.5f - (float)h));
#pragma unroll 1
    for (int m = 0; m < SEQ; ++m) {
      const u16* kr = base + (size_t)m * PWP + C_RK + h * 64;
      const u16* vr = base + (size_t)m * PWP + C_RV + h * 64;
      float s = 0.f;
#pragma unroll
      for (int d = 0; d < 8; ++d) s = dot8(qp[d], *reinterpret_cast<const uint4*>(kr + d * 8), s);
      const float w = (m <= n) ? expf(lg0 * (float)(n - m)) : expf(lg1 * (float)(m - n));
      s *= w;
#pragma unroll
      for (int d = 0; d < 64; d += 8) {
        float vf[8];
        ld8(vr + d, vf);
#pragma unroll
        for (int j = 0; j < 8; ++j) o[d + j] += s * vf[j];
      }
    }
    float mu = 0.f;
#pragma unroll
    for (int d = 0; d < 64; ++d) mu += o[d];
    mu *= (1.f / 64.f);
    float var = 0.f;
#pragma unroll
    for (int d = 0; d < 64; ++d) var += (o[d] - mu) * (o[d] - mu);
    var *= (1.f / 64.f);
    const float rs = rsqrtf(var + 1e-5f);
    const size_t t = (size_t)b * SEQ + n;
#pragma unroll
    for (int d = 0; d < 64; d += 8) {
      float g[8];
      ld8(p.proj() + t * PWP + C_RG + h * 64 + d, g);
      uint4 ov;
      ov.x = pack2(silu(g[0]) * (o[d + 0] - mu) * rs, silu(g[1]) * (o[d + 1] - mu) * rs);
      ov.y = pack2(silu(g[2]) * (o[d + 2] - mu) * rs, silu(g[3]) * (o[d + 3] - mu) * rs);
      ov.z = pack2(silu(g[4]) * (o[d + 4] - mu) * rs, silu(g[5]) * (o[d + 5] - mu) * rs);
      ov.w = pack2(silu(g[6]) * (o[d + 6] - mu) * rs, silu(g[7]) * (o[d + 7] - mu) * rs);
      *reinterpret_cast<uint4*>(p.mixed() + t * DM + h * 64 + d) = ov;
    }
  }
}

DI void ph_mla_naive(const Params& p) {
  const int gt = obid() * NTHR + otid(), gs = gridDim.x * NTHR;
  for (int it = gt; it < 2 * 4 * 4 * SEQ; it += gs) {
    const int n = it & (SEQ - 1), vh = (it >> 12) & 1, h = (it >> 13) & 3, b = it >> 15;
    const size_t t = (size_t)b * SEQ + n;
    uint4 qp[12];
    float o[32];
#pragma unroll
    for (int d = 0; d < 12; ++d) qp[d] = *reinterpret_cast<const uint4*>(p.mq() + t * 384 + h * 96 + d * 8);
    const size_t tb = (size_t)b * SEQ;
    float mx = -1e30f;
#pragma unroll 1
    for (int m = 0; m < SEQ; ++m) {
      const u16* kn = ((u16*)nullptr) + (tb + m) * 512 + h * 128;
      const u16* kr = p.proj() + (tb + m) * PWP + C_KR;
      float s = 0.f;
#pragma unroll
      for (int d = 0; d < 8; ++d) s = dot8(qp[d], *reinterpret_cast<const uint4*>(kn + d * 8), s);
#pragma unroll
      for (int d = 0; d < 4; ++d) s = dot8(qp[8 + d], *reinterpret_cast<const uint4*>(kr + d * 8), s);
      mx = fmaxf(mx, s);
    }
#pragma unroll
    for (int d = 0; d < 32; ++d) o[d] = 0.f;
    float l = 0.f;
#pragma unroll 1
    for (int m = 0; m < SEQ; ++m) {
      const u16* kn = ((u16*)nullptr) + (tb + m) * 512 + h * 128;
      const u16* kr = p.proj() + (tb + m) * PWP + C_KR;
      float s = 0.f;
#pragma unroll
      for (int d = 0; d < 8; ++d) s = dot8(qp[d], *reinterpret_cast<const uint4*>(kn + d * 8), s);
#pragma unroll
      for (int d = 0; d < 4; ++d) s = dot8(qp[8 + d], *reinterpret_cast<const uint4*>(kr + d * 8), s);
      const float pe = exp2f(s - mx);
      l += pe;
#pragma unroll
      for (int d = 0; d < 32; d += 8) {
        float vf[8];
        ld8(kn + 64 + vh * 32 + d, vf);
#pragma unroll
        for (int j = 0; j < 8; ++j) o[d + j] += pe * vf[j];
      }
    }
    const float il = 1.f / l;
#pragma unroll
    for (int d = 0; d < 32; d += 8) {
      uint4 ov;
      ov.x = pack2(o[d + 0] * il, o[d + 1] * il);
      ov.y = pack2(o[d + 2] * il, o[d + 3] * il);
      ov.z = pack2(o[d + 4] * il, o[d + 5] * il);
      ov.w = pack2(o[d + 6] * il, o[d + 7] * il);
      *reinterpret_cast<uint4*>(p.mixed() + t * DM + 256 + h * 64 + vh * 32 + d) = ov;
    }
  }
}

#define MFMA32(a, b, c) __builtin_amdgcn_mfma_f32_32x32x16_bf16((a), (b), (c), 0, 0, 0)
DI float max16(const f32x16& v) {
  float a = fmaxf(fmaxf(v[0], v[1]), v[2]), b = fmaxf(fmaxf(v[3], v[4]), v[5]), c = fmaxf(fmaxf(v[6], v[7]), v[8]);
  float d = fmaxf(fmaxf(v[9], v[10]), v[11]), e = fmaxf(fmaxf(v[12], v[13]), v[14]);
  return fmaxf(fmaxf(fmaxf(a, b), fmaxf(c, d)), fmaxf(e, v[15]));
}
DI void ph_mla_attn(const Params& p, char* smem) {
  const int tid = otid(), wid = tid >> 6, lane = tid & 63, l32 = lane & 31, hh = lane >> 5;
  u16* sK = reinterpret_cast<u16*>(smem);
  u16* sV = sK + 2 * 128 * 104;
  uint4 konev = make_uint4(hh == 0 ? 0x00003F80u : 0u, 0u, 0u, 0u);
  const bf16x8 kone = __builtin_bit_cast(bf16x8, konev);
  for (int item = obid(); item < 256; item += gridDim.x) {
    const int xcd_ = item & 7, jx_ = item >> 3, bh = xcd_ * 2 + (jx_ >> 4), qt = jx_ & 15, b = bh >> 2, h = bh & 3;
    const size_t t0 = (size_t)b * SEQ + qt * 256 + wid * 32;
    bf16x8 qf[6];
#pragma unroll
    for (int ks = 0; ks < 6; ++ks) qf[ks] = *reinterpret_cast<const bf16x8*>(p.mq() + (t0 + l32) * 384 + h * 96 + ks * 16 + hh * 8);
    const u16* kg = p.kfull() + (size_t)bh * SEQ * 96;
    const u16* vg = p.vT() + (size_t)bh * 64 * SEQ;
    f32x16 o0, o1;
#pragma unroll
    for (int i = 0; i < 16; ++i) { o0[i] = 0.f; o1[i] = 0.f; }
    float m = 0.f, l = 0.f;
    bf16x8 qf6 = __builtin_bit_cast(bf16x8, make_uint4(0u, 0u, 0u, 0u));
    const int kr0 = tid / 12, kc0 = tid % 12, kr1 = (512 + tid) / 12, kc1 = (512 + tid) % 12, kr2 = (1024 + tid) / 12, kc2 = (1024 + tid) % 12;
    const int vd0 = tid >> 4, vd1 = 32 + (tid >> 4), vkc = (tid & 15) * 8;
    uint4 ak0, ak1, ak2, av0, av1;
#define MLA_LD(dst_, ptr_) asm volatile("global_load_dwordx4 %0, %1, off" : "=v"(dst_) : "v"(ptr_) : "memory")
#define MLA_GLOAD(K0, K1, K2, V0, V1, kt_)                                               \
    {                                                                                    \
      const u16* kb_ = kg + (size_t)(kt_) * 128 * 96 + tid * 8;                          \
      MLA_LD(K0, kb_); MLA_LD(K1, kb_ + 512 * 8); MLA_LD(K2, kb_ + 1024 * 8);            \
      const u16* vp_ = vg + (size_t)vd0 * SEQ + (kt_) * 128 + vkc;                       \
      MLA_LD(V0, vp_); MLA_LD(V1, vp_ + (size_t)32 * SEQ);                               \
    }
#define MLA_SSTORE(K0, K1, K2, V0, V1, buf_)                                             \
    {                                                                                    \
      u16* kb_ = sK + (buf_) * 128 * 104;                                                \
      u16* vb_ = sV + (buf_) * 64 * 136;                                                 \
      *reinterpret_cast<uint4*>(kb_ + kr0 * 104 + kc0 * 8) = K0;                         \
      *reinterpret_cast<uint4*>(kb_ + kr1 * 104 + kc1 * 8) = K1;                         \
      *reinterpret_cast<uint4*>(kb_ + kr2 * 104 + kc2 * 8) = K2;                         \
      *reinterpret_cast<uint4*>(vb_ + vd0 * 136 + vkc) = V0;                             \
      *reinterpret_cast<uint4*>(vb_ + vd1 * 136 + vkc) = V1;                             \
    }
    float mxrun = 0.f;
#define SGB(mask, n) __builtin_amdgcn_sched_group_barrier((mask), (n), 0)
#define MLA_KFRAG(kb_, sub_, ks_) (*reinterpret_cast<const bf16x8*>((kb_) + ((sub_) * 32 + l32) * 104 + (ks_) * 16 + hh * 8))
#define MLA_VFRAG(dst_, vb_, sub_, ks2_, dvt_) \
    dst_ = *reinterpret_cast<const bf16x8*>((vb_) + ((dvt_) * 32 + l32) * 136 + (sub_) * 32 + (ks2_) * 16 + hh * 8)
#define MLA_SOFTMAX(sc_, pa_, pb_)                                                                         \
    {                                                                                                      \
      mxrun = fmaxf(mxrun, max16(sc_));                                                                    \
      float ps0_ = 0.f, ps1_ = 0.f;                                                                        \
      _Pragma("unroll") for (int i = 0; i < 16; i += 2) {                                                  \
        sc_[i] = __builtin_amdgcn_exp2f(sc_[i]); sc_[i + 1] = __builtin_amdgcn_exp2f(sc_[i + 1]);          \
        ps0_ += sc_[i]; ps1_ += sc_[i + 1];                                                                \
      }                                                                                                    \
      l += ps0_ + ps1_;                                                                                    \
      uint4 pk_;                                                                                           \
      pk_.x = pack2(sc_[0], sc_[1]); pk_.y = pack2(sc_[2], sc_[3]); pk_.z = pack2(sc_[4], sc_[5]); pk_.w = pack2(sc_[6], sc_[7]); \
      pa_ = __builtin_bit_cast(bf16x8, pk_);                                                               \
      pk_.x = pack2(sc_[8], sc_[9]); pk_.y = pack2(sc_[10], sc_[11]); pk_.z = pack2(sc_[12], sc_[13]); pk_.w = pack2(sc_[14], sc_[15]); \
      pb_ = __builtin_bit_cast(bf16x8, pk_);                                                               \
    }
    auto compute_tile = [&](int cur, int half) {
      const u16* kb = sK + cur * 128 * 104 + half * 64 * 104;
      const u16* vb = sV + cur * 64 * 136 + half * 64;
      bf16x8 k0[6], k1[6];
#pragma unroll
      for (int ks = 0; ks < 6; ++ks) { k0[ks] = MLA_KFRAG(kb, 0, ks); k1[ks] = MLA_KFRAG(kb, 1, ks); }
      f32x16 s0, s1;
#pragma unroll
      for (int i = 0; i < 16; ++i) { s0[i] = 0.f; s1[i] = 0.f; }
#pragma unroll
      for (int ks = 0; ks < 6; ++ks) s0 = MFMA32(k0[ks], qf[ks], s0);
      s0 = MFMA32(kone, qf6, s0);
      bf16x8 v00, v01, v02, v03, v10, v11, v12, v13;
      MLA_VFRAG(v00, vb, 0, 0, 0); MLA_VFRAG(v01, vb, 0, 0, 1); MLA_VFRAG(v02, vb, 0, 1, 0); MLA_VFRAG(v03, vb, 0, 1, 1);
#pragma unroll
      for (int ks = 0; ks < 6; ++ks) s1 = MFMA32(k1[ks], qf[ks], s1);
      s1 = MFMA32(kone, qf6, s1);
      MLA_VFRAG(v10, vb, 1, 0, 0); MLA_VFRAG(v11, vb, 1, 0, 1); MLA_VFRAG(v12, vb, 1, 1, 0); MLA_VFRAG(v13, vb, 1, 1, 1);
      bf16x8 p0a, p0b, p1a, p1b;
      MLA_SOFTMAX(s0, p0a, p0b);
      o0 = MFMA32(v00, p0a, o0); o1 = MFMA32(v01, p0a, o1); o0 = MFMA32(v02, p0b, o0); o1 = MFMA32(v03, p0b, o1);
      MLA_SOFTMAX(s1, p1a, p1b);
      o0 = MFMA32(v10, p1a, o0); o1 = MFMA32(v11, p1a, o1); o0 = MFMA32(v12, p1b, o0); o1 = MFMA32(v13, p1b, o1);
      SGB(0x100, 12);
#pragma unroll
      for (int i = 0; i < 7; ++i) { SGB(0x008, 1); if (i < 4) SGB(0x100, 1); }
#pragma unroll
      for (int i = 0; i < 7; ++i) { SGB(0x008, 1); if (i < 4) SGB(0x100, 1); SGB(0x402, 7); }
#pragma unroll
      for (int i = 0; i < 4; ++i) { SGB(0x008, 1); SGB(0x402, 12); }
#pragma unroll
      for (int i = 0; i < 4; ++i) SGB(0x008, 1);
    };
    auto lazy_update = [&]() {
      const float mxr = fmaxf(mxrun, __shfl_xor(mxrun, 32));
      if (__builtin_amdgcn_ballot_w64(mxr > 8.f) != 0ull) {
        float d = (mxr > 8.f) ? mxr : 0.f;
        const float mnew = bf2f(f2bf(m + d));
        d = mnew - m;
        m = mnew;
        const float alpha = __builtin_amdgcn_exp2f(-d);
        l *= alpha;
        mxrun -= d;
#pragma unroll
        for (int i = 0; i < 16; ++i) { o0[i] *= alpha; o1[i] *= alpha; }
        uint4 qv = make_uint4(0u, 0u, 0u, 0u);
        if (hh == 0) qv.x = (unsigned)f2bf(-m);
        qf6 = __builtin_bit_cast(bf16x8, qv);
      }
    };
    MLA_GLOAD(ak0, ak1, ak2, av0, av1, 0);
    asm volatile("s_waitcnt vmcnt(0)" ::: "memory");
    MLA_SSTORE(ak0, ak1, ak2, av0, av1, 0);
    __syncthreads();
    {
      f32x16 s0, s1;
#pragma unroll
      for (int i = 0; i < 16; ++i) { s0[i] = 0.f; s1[i] = 0.f; }
#pragma unroll
      for (int ks = 0; ks < 6; ++ks) { s0 = MFMA32(MLA_KFRAG(sK, 0, ks), qf[ks], s0); s1 = MFMA32(MLA_KFRAG(sK, 1, ks), qf[ks], s1); }
      float mx = fmaxf(max16(s0), max16(s1));
      mx = fmaxf(mx, __shfl_xor(mx, 32));
      m = bf2f(f2bf(mx));
      uint4 qv = make_uint4(0u, 0u, 0u, 0u);
      if (hh == 0) qv.x = (unsigned)f2bf(-m);
      qf6 = __builtin_bit_cast(bf16x8, qv);
    }
#pragma unroll 1
    for (int kt = 0; kt < 32; kt += 2) {
      MLA_GLOAD(ak0, ak1, ak2, av0, av1, kt + 1);
#pragma unroll 1
      for (int half = 0; half < 2; ++half) compute_tile(0, half);
      asm volatile("s_waitcnt vmcnt(0)" ::: "memory");
      MLA_SSTORE(ak0, ak1, ak2, av0, av1, 1);
      __syncthreads();
      lazy_update();
      if (kt + 2 < 32) MLA_GLOAD(ak0, ak1, ak2, av0, av1, kt + 2);
#pragma unroll 1
      for (int half = 0; half < 2; ++half) compute_tile(1, half);
      if (kt + 2 < 32) {
        asm volatile("s_waitcnt vmcnt(0)" ::: "memory");
        MLA_SSTORE(ak0, ak1, ak2, av0, av1, 0);
      }
      __syncthreads();
      lazy_update();
    }
    l += __shfl_xor(l, 32);
    const float il = 1.f / l;
    u16* orow = p.mixed() + (t0 + l32) * DM + 256 + h * 64 + hh * 4;
#pragma unroll
    for (int g = 0; g < 4; ++g) {
      uint2 v;
      v.x = pack2(o0[4 * g + 0] * il, o0[4 * g + 1] * il);
      v.y = pack2(o0[4 * g + 2] * il, o0[4 * g + 3] * il);
      *reinterpret_cast<uint2*>(orow + g * 8) = v;
      v.x = pack2(o1[4 * g + 0] * il, o1[4 * g + 1] * il);
      v.y = pack2(o1[4 * g + 2] * il, o1[4 * g + 3] * il);
      *reinterpret_cast<uint2*>(orow + 32 + g * 8) = v;
    }
  }
}

typedef __attribute__((address_space(3))) s16x4 lds_s16x4;
template <int MODE>
DI void ph_dil_pass(const Params& p, char* smem, int blk_) {
  const int tid = otid(), wid = tid >> 6, lane = tid & 63, l32 = lane & 31, hh = lane >> 5;
  u16* sV = reinterpret_cast<u16*>(smem) + wid * (2 * 32 * 72);
  const int i16 = lane & 15, tq = i16 >> 2, tp = i16 & 3, tblk = (lane >> 4) & 1;
  {
    constexpr int NT = (MODE == 0) ? 13 : 5;
    const int it = wid, xcd_ = blk_ & 7, jx_ = blk_ >> 3, bh = xcd_ * 2 + (jx_ >> 4), r = jx_ & 15, b = bh >> 2, h = bh & 3;
    const int i0 = it * 32;
    const int q0 = (r * 8 + it) * 32;
    const int qpos = (MODE == 0) ? (r + 16 * (i0 + l32)) : (q0 + l32);
    const size_t tb = (size_t)b * SEQ;
    const u16* kbase = p.proj() + tb * PWP + C_DK + h * 64;
    const u16* vbase = p.proj() + tb * PWP + C_DV + h * 64;
    bf16x8 qf[4];
    {
      const u16* qp = p.proj() + (tb + qpos) * PWP + C_DQ + h * 64 + hh * 8;
#pragma unroll
      for (int ks = 0; ks < 4; ++ks) qf[ks] = *reinterpret_cast<const bf16x8*>(qp + ks * 16);
    }
    f32x16 o0, o1;
#pragma unroll
    for (int i = 0; i < 16; ++i) { o0[i] = 0.f; o1[i] = 0.f; }
    float m = -1e30f, l = 0.f;
    auto tile_params = [&](int tt, int& d, int& rd, int& ub, int& ulim, int& qb, int& qs) {
      if (MODE == 0) {
        if (tt < 5) { d = 16; rd = r; qb = i0; qs = 1; ulim = 256; ub = qb - 64 + 32 * tt; }
        else { d = 4; rd = r & 3; qb = (r >> 2) + 4 * i0; qs = 4; ulim = 1024; ub = qb - 64 + 32 * (tt - 5); }
      } else { d = 1; rd = 0; qb = q0; qs = 1; ulim = 4096; ub = qb - 64 + 32 * tt; }
    };
    bf16x8 ka0, ka1, ka2, ka3, kb0, kb1, kb2, kb3;
    uint4 va0, va1, va2, va3, vb0, vb1, vb2, vb3;
#define DIL_LD(dst_, ptr_) asm volatile("global_load_dwordx4 %0, %1, off" : "=v"(dst_) : "v"(ptr_) : "memory")
#define DIL_GLOAD(K0, K1, K2, K3, V0, V1, V2, V3, tt_)                                                   \
    {                                                                                                    \
      int d_, rd_, ub_, ulim_, qb_, qs_;                                                                 \
      tile_params((tt_), d_, rd_, ub_, ulim_, qb_, qs_);                                                 \
      int u_ = min(max(ub_ + l32, 0), ulim_ - 1);                                                        \
      const u16* kp_ = kbase + (size_t)(rd_ + d_ * u_) * PWP + hh * 8;                                   \
      DIL_LD(K0, kp_); DIL_LD(K1, kp_ + 16); DIL_LD(K2, kp_ + 32); DIL_LD(K3, kp_ + 48);                 \
      const int kr_ = ub_ + (lane >> 3);                                                                 \
      const u16* vp_;                                                                                    \
      u_ = min(max(kr_, 0), ulim_ - 1);      vp_ = vbase + (size_t)(rd_ + d_ * u_) * PWP + (lane & 7) * 8; DIL_LD(V0, vp_); \
      u_ = min(max(kr_ + 8, 0), ulim_ - 1);  vp_ = vbase + (size_t)(rd_ + d_ * u_) * PWP + (lane & 7) * 8; DIL_LD(V1, vp_); \
      u_ = min(max(kr_ + 16, 0), ulim_ - 1); vp_ = vbase + (size_t)(rd_ + d_ * u_) * PWP + (lane & 7) * 8; DIL_LD(V2, vp_); \
      u_ = min(max(kr_ + 24, 0), ulim_ - 1); vp_ = vbase + (size_t)(rd_ + d_ * u_) * PWP + (lane & 7) * 8; DIL_LD(V3, vp_); \
    }
#define DIL_VSTORE(V0, V1, V2, V3, buf_)                                                                 \
    {                                                                                                    \
      u16* vb_ = sV + (buf_) * 32 * 72 + (lane >> 3) * 72 + (lane & 7) * 8;                              \
      *reinterpret_cast<uint4*>(vb_) = V0;                                                               \
      *reinterpret_cast<uint4*>(vb_ + 8 * 72) = V1;                                                      \
      *reinterpret_cast<uint4*>(vb_ + 16 * 72) = V2;                                                     \
      *reinterpret_cast<uint4*>(vb_ + 24 * 72) = V3;                                                     \
    }
    auto tile_rest = [&](int tt, f32x16 sc, int cur) {
      int d, rd, ub, ulim, qb, qs;
      tile_params(tt, d, rd, ub, ulim, qb, qs);
      const int uq = qb + qs * l32;
      const float cs = 0.125f * 1.4426950408889634f;
      float mx = -1e30f;
#pragma unroll
      for (int i = 0; i < 16; ++i) {
        const int u = ub + (i & 3) + 8 * (i >> 2) + 4 * hh;
        const int du = u - uq;
        const bool valid = (u >= 0) && (u < ulim) && (du <= 64) && (du >= -64);
        sc[i] = valid ? sc[i] * cs : -1e30f;
        mx = fmaxf(mx, sc[i]);
      }
      mx = fmaxf(mx, __shfl_xor(mx, 32));
      const float mn = fmaxf(m, mx);
      const float alpha = __builtin_amdgcn_exp2f(m - mn);
      m = mn;
      float ps = 0.f;
#pragma unroll
      for (int i = 0; i < 16; ++i) {
        float pe = __builtin_amdgcn_exp2f(sc[i] - mn);
        pe = (sc[i] > -1e29f) ? pe : 0.f;
        ps += pe;
        sc[i] = pe;
      }
      l = l * alpha + ps;
#pragma unroll
      for (int i = 0; i < 16; ++i) { o0[i] *= alpha; o1[i] *= alpha; }
      const u16* vb = sV + cur * 32 * 72;
#pragma unroll
      for (int ks2 = 0; ks2 < 2; ++ks2) {
        uint4 pk;
        pk.x = pack2(sc[8 * ks2 + 0], sc[8 * ks2 + 1]);
        pk.y = pack2(sc[8 * ks2 + 2], sc[8 * ks2 + 3]);
        pk.z = pack2(sc[8 * ks2 + 4], sc[8 * ks2 + 5]);
        pk.w = pack2(sc[8 * ks2 + 6], sc[8 * ks2 + 7]);
        const bf16x8 pb = __builtin_bit_cast(bf16x8, pk);
#pragma unroll
        for (int dvt = 0; dvt < 2; ++dvt) {
          const u16* a0 = vb + (16 * ks2 + 4 * hh + tq) * 72 + dvt * 32 + tblk * 16 + tp * 4;
          const s16x4 lo = __builtin_amdgcn_ds_read_tr16_b64_v4i16((lds_s16x4*)(a0));
          const s16x4 hi = __builtin_amdgcn_ds_read_tr16_b64_v4i16((lds_s16x4*)(a0 + 8 * 72));
          const bf16x8 a = __builtin_shufflevector(lo, hi, 0, 1, 2, 3, 4, 5, 6, 7);
          if (dvt == 0) o0 = MFMA32(a, pb, o0); else o1 = MFMA32(a, pb, o1);
        }
      }
    };
    DIL_GLOAD(ka0, ka1, ka2, ka3, va0, va1, va2, va3, 0);
    DIL_GLOAD(kb0, kb1, kb2, kb3, vb0, vb1, vb2, vb3, 1);
    asm volatile("s_waitcnt vmcnt(8)" ::: "memory");
    DIL_VSTORE(va0, va1, va2, va3, 0);
#pragma unroll 1
    for (int tt = 0; tt < NT; tt += 2) {
      {
        f32x16 sc;
#pragma unroll
        for (int i = 0; i < 16; ++i) sc[i] = 0.f;
        sc = MFMA32(ka0, qf[0], sc); sc = MFMA32(ka1, qf[1], sc); sc = MFMA32(ka2, qf[2], sc); sc = MFMA32(ka3, qf[3], sc);
        asm volatile("" :: "v"(sc));
        if (tt + 2 < NT) DIL_GLOAD(ka0, ka1, ka2, ka3, va0, va1, va2, va3, tt + 2);
        tile_rest(tt, sc, 0);
        if (tt + 1 < NT) {
          if (tt + 2 < NT) asm volatile("s_waitcnt vmcnt(8)" ::: "memory"); else asm volatile("s_waitcnt vmcnt(0)" ::: "memory");
          DIL_VSTORE(vb0, vb1, vb2, vb3, 1);
        }
      }
      if (tt + 1 < NT) {
        f32x16 sc;
#pragma unroll
        for (int i = 0; i < 16; ++i) sc[i] = 0.f;
        sc = MFMA32(kb0, qf[0], sc); sc = MFMA32(kb1, qf[1], sc); sc = MFMA32(kb2, qf[2], sc); sc = MFMA32(kb3, qf[3], sc);
        asm volatile("" :: "v"(sc));
        if (tt + 3 < NT) DIL_GLOAD(kb0, kb1, kb2, kb3, vb0, vb1, vb2, vb3, tt + 3);
        tile_rest(tt + 1, sc, 1);
        if (tt + 2 < NT) {
          if (tt + 3 < NT) asm volatile("s_waitcnt vmcnt(8)" ::: "memory"); else asm volatile("s_waitcnt vmcnt(0)" ::: "memory");
          DIL_VSTORE(va0, va1, va2, va3, 0);
        }
      }
    }
    l += __shfl_xor(l, 32);
    float* part = p.dpart() + ((tb + qpos) * 4 + h) * 68 + hh * 4;
    if (MODE == 0) {
#pragma unroll
      for (int g = 0; g < 4; ++g) {
        *reinterpret_cast<float4*>(part + g * 8) = make_float4(o0[4 * g + 0], o0[4 * g + 1], o0[4 * g + 2], o0[4 * g + 3]);
        *reinterpret_cast<float4*>(part + 32 + g * 8) = make_float4(o1[4 * g + 0], o1[4 * g + 1], o1[4 * g + 2], o1[4 * g + 3]);
      }
      if (hh == 0) { part[64] = m; part[65] = l; }
    } else {
      const float mA = part[64 - hh * 4], lA = part[65 - hh * 4];
      const float M = fmaxf(m, mA), sa = __builtin_amdgcn_exp2f(m - M), sb = __builtin_amdgcn_exp2f(mA - M);
      const float il = 1.f / (l * sa + lA * sb);
      u16* orow = p.mixed() + (tb + qpos) * DM + 768 + h * 64 + hh * 4;
#pragma unroll
      for (int g = 0; g < 4; ++g) {
        const float4 a0 = *reinterpret_cast<const float4*>(part + g * 8), a1 = *reinterpret_cast<const float4*>(part + 32 + g * 8);
        uint2 v;
        v.x = pack2((o0[4 * g + 0] * sa + a0.x * sb) * il, (o0[4 * g + 1] * sa + a0.y * sb) * il);
        v.y = pack2((o0[4 * g + 2] * sa + a0.z * sb) * il, (o0[4 * g + 3] * sa + a0.w * sb) * il);
        *reinterpret_cast<uint2*>(orow + g * 8) = v;
        v.x = pack2((o1[4 * g + 0] * sa + a1.x * sb) * il, (o1[4 * g + 1] * sa + a1.y * sb) * il);
        v.y = pack2((o1[4 * g + 2] * sa + a1.z * sb) * il, (o1[4 * g + 3] * sa + a1.w * sb) * il);
        *reinterpret_cast<uint2*>(orow + 32 + g * 8) = v;
      }
    }
  }
}

DI void ph_dil_naive(const Params& p) {
  const int gt = obid() * NTHR + otid(), gs = gridDim.x * NTHR;
  for (int it = gt; it < 4 * 4 * SEQ; it += gs) {
    const int n = it & (SEQ - 1), h = (it >> 12) & 3, b = it >> 14;
    const size_t tb = (size_t)b * SEQ;
    uint4 qp[8];
    float o[64];
#pragma unroll
    for (int d = 0; d < 8; ++d) qp[d] = *reinterpret_cast<const uint4*>(p.proj() + (tb + n) * PWP + C_DQ + h * 64 + d * 8);
    float mx = -1e30f;
    for (int pat = 0; pat < 3; ++pat) {
      const int dil = (pat == 0) ? 1 : (pat == 1 ? 4 : 16);
#pragma unroll 1
      for (int j = -64; j <= 64; ++j) {
        const int pos = n + j * dil;
        if (pos < 0 || pos >= SEQ) continue;
        const u16* kr = p.proj() + (tb + pos) * PWP + C_DK + h * 64;
        float s = 0.f;
#pragma unroll
        for (int d = 0; d < 8; ++d) s = dot8(qp[d], *reinterpret_cast<const uint4*>(kr + d * 8), s);
        s *= 0.125f;
        mx = fmaxf(mx, s);
      }
    }
#pragma unroll
    for (int d = 0; d < 64; ++d) o[d] = 0.f;
    float l = 0.f;
    for (int pat = 0; pat < 3; ++pat) {
      const int dil = (pat == 0) ? 1 : (pat == 1 ? 4 : 16);
#pragma unroll 1
      for (int j = -64; j <= 64; ++j) {
        const int pos = n + j * dil;
        if (pos < 0 || pos >= SEQ) continue;
        const u16* kr = p.proj() + (tb + pos) * PWP + C_DK + h * 64;
        const u16* vr = p.proj() + (tb + pos) * PWP + C_DV + h * 64;
        float s = 0.f;
#pragma unroll
        for (int d = 0; d < 8; ++d) s = dot8(qp[d], *reinterpret_cast<const uint4*>(kr + d * 8), s);
        s *= 0.125f;
        const float pe = __expf(s - mx);
        l += pe;
#pragma unroll
        for (int d = 0; d < 64; d += 8) {
          float vf[8];
          ld8(vr + d, vf);
#pragma unroll
          for (int jj = 0; jj < 8; ++jj) o[d + jj] += pe * vf[jj];
        }
      }
    }
    const float il = 1.f / l;
#pragma unroll
    for (int d = 0; d < 64; d += 8) {
      uint4 ov;
      ov.x = pack2(o[d + 0] * il, o[d + 1] * il);
      ov.y = pack2(o[d + 2] * il, o[d + 3] * il);
      ov.z = pack2(o[d + 4] * il, o[d + 5] * il);
      ov.w = pack2(o[d + 6] * il, o[d + 7] * il);
      *reinterpret_cast<uint4*>(p.mixed() + (tb + n) * DM + 768 + h * 64 + d) = ov;
    }
  }
}

DI void ph_ssd_naive(const Params& p, int L) {
  const int gt = obid() * NTHR + otid(), gs = gridDim.x * NTHR;
  for (int it = gt; it < 4 * 4 * 4 * SEQ; it += gs) {
    const int l = it & (SEQ - 1), pq = (it >> 12) & 3, h = (it >> 14) & 3, b = it >> 16;
    const int g = h >> 1;
    const size_t tb = (size_t)b * SEQ;
    uint4 cl[16];
    float acc[16];
#pragma unroll
    for (int d = 0; d < 16; ++d) cl[d] = *reinterpret_cast<const uint4*>(p.xbc() + (tb + l) * 768 + 512 + g * 128 + d * 8);
#pragma unroll
    for (int d = 0; d < 16; ++d) acc[d] = 0.f;
    const float pl = p.cs()[(tb + l) * 8 + h], rl = p.cs()[(tb + l) * 8 + 4 + h];
#pragma unroll 1
    for (int s = 0; s < SEQ; ++s) {
      const u16* br = p.xbc() + (tb + s) * 768 + 256 + g * 128;
      float cbv = 0.f;
#pragma unroll
      for (int d = 0; d < 16; ++d) cbv = dot8(cl[d], *reinterpret_cast<const uint4*>(br + d * 8), cbv);
      float w;
      if (s <= l) w = expf(pl - p.cs()[(tb + s) * 8 + h]) * p.dtv()[(tb + s) * 8 + h];
      else w = expf(rl - p.cs()[(tb + s) * 8 + 4 + h]) * p.dtv()[(tb + s) * 8 + 4 + h];
      cbv *= w;
      const u16* xr = p.xbc() + (tb + s) * 768 + h * 64 + pq * 16;
#pragma unroll
      for (int d = 0; d < 16; d += 8) {
        float xf[8];
        ld8(xr + d, xf);
#pragma unroll
        for (int j = 0; j < 8; ++j) acc[d + j] += cbv * xf[j];
      }
    }
    const float dsk = p.ssm_d[L * 4 + h];
#pragma unroll
    for (int d = 0; d < 16; ++d) {
      const int c = h * 64 + pq * 16 + d;
      const float xv = bf2f(p.xbc()[(tb + l) * 768 + c]);
      const float z = bf2f(p.proj()[(tb + l) * PWP + C_Z + c]);
      p.ybuf()[(tb + l) * 256 + c] = (acc[d] + dsk * xv) * silu(z);
    }
  }
}

DI void ph_ssd_norm(const Params& p, int L) {
  const int tid_ = otid(); const int lane = tid_ & 63, gw = (obid() * NTHR + tid_) >> 6, nw = gridDim.x * (NTHR / 64);
  const float* nwt = p.ssm_norm_w + L * 256;
  for (int t = gw; t < T; t += nw) {
    const float4 v = *reinterpret_cast<const float4*>(p.ybuf() + (size_t)t * 256 + lane * 4);
    float ss = wave_sum(v.x * v.x + v.y * v.y + v.z * v.z + v.w * v.w);
    const float rstd = rsqrtf(ss * (1.f / 256.f) + 1e-6f);
    const float4 ww = *reinterpret_cast<const float4*>(nwt + lane * 4);
    uint2 o;
    o.x = pack2(v.x * rstd * ww.x, v.y * rstd * ww.y);
    o.y = pack2(v.z * rstd * ww.z, v.w * rstd * ww.w);
    *reinterpret_cast<uint2*>(p.mixed() + (size_t)t * DM + 512 + lane * 4) = o;
  }
}

#define MFMA16(a, b, c) __builtin_amdgcn_mfma_f32_16x16x32_bf16((a), (b), (c), 0, 0, 0)
template <int MT, int NT, int KS>
DI void wave_mm(f32x4 (&acc)[MT][NT], const u16* a0, int lda, const u16* b0, int ldb, int fr, int fq) {
#pragma unroll
  for (int ks = 0; ks < KS; ++ks) {
    bf16x8 af[MT], bfv[NT];
#pragma unroll
    for (int m = 0; m < MT; ++m) af[m] = *reinterpret_cast<const bf16x8*>(a0 + (m * 16 + fr) * lda + ks * 32 + fq * 8);
#pragma unroll
    for (int n = 0; n < NT; ++n) bfv[n] = *reinterpret_cast<const bf16x8*>(b0 + (n * 16 + fr) * ldb + ks * 32 + fq * 8);
#pragma unroll
    for (int m = 0; m < MT; ++m)
#pragma unroll
      for (int n = 0; n < NT; ++n) acc[m][n] = MFMA16(af[m], bfv[n], acc[m][n]);
  }
}
template <int MT, int NT>
DI void zero_acc(f32x4 (&acc)[MT][NT]) {
#pragma unroll
  for (int m = 0; m < MT; ++m)
#pragma unroll
    for (int n = 0; n < NT; ++n) acc[m][n] = f32x4{0.f, 0.f, 0.f, 0.f};
}
template <int NROWS, int NCOLS>
DI void stage_rows(u16* dst, int ldd, const u16* src, size_t lsrc, int tid) {
  constexpr int CPR = NCOLS / 8, NCH = NROWS * CPR / NTHR;
  static_assert(NROWS * CPR % NTHR == 0, "tile must be a multiple of 512 chunks");
  uint4 r[NCH];
#pragma unroll
  for (int i = 0; i < NCH; ++i) {
    const int c = tid + i * NTHR, row = c / CPR, cc = c % CPR;
    r[i] = *reinterpret_cast<const uint4*>(src + (size_t)row * lsrc + cc * 8);
  }
#pragma unroll
  for (int i = 0; i < NCH; ++i) {
    const int c = tid + i * NTHR, row = c / CPR, cc = c % CPR;
    *reinterpret_cast<uint4*>(dst + row * ldd + cc * 8) = r[i];
  }
}
template <int NCOLS, class W>
DI void stage_T(u16* dst, int ldd, const u16* src, size_t lsrc, int tid, W w) {
  constexpr int NCH = 128 * (NCOLS / 8) / NTHR;
  uint4 r[NCH];
#pragma unroll
  for (int i = 0; i < NCH; ++i) {
    const int c = tid + i * NTHR, j = c & 127, cc = c >> 7;
    r[i] = *reinterpret_cast<const uint4*>(src + (size_t)j * lsrc + cc * 8);
  }
#pragma unroll
  for (int i = 0; i < NCH; ++i) {
    const int c = tid + i * NTHR, j = c & 127, cc = c >> 7;
    float f[8];
    unpack8(r[i], f);
    const float wj = w(j);
#pragma unroll
    for (int e = 0; e < 8; ++e) dst[(cc * 8 + e) * ldd + j] = f2bf(f[e] * wj);
  }
}

template <int NROWS, int NCOLS>
DI void stage_rows_ld(uint4 (&r)[NROWS * (NCOLS / 8) / NTHR], const u16* src, size_t lsrc, int tid) {
  constexpr int CPR = NCOLS / 8, NCH = NROWS * CPR / NTHR;
#pragma unroll
  for (int i = 0; i < NCH; ++i) {
    const int c = tid + i * NTHR, row = c / CPR, cc = c % CPR;
    r[i] = *reinterpret_cast<const uint4*>(src + (size_t)row * lsrc + cc * 8);
  }
}
template <int NROWS, int NCOLS>
DI void stage_rows_st(u16* dst, int ldd, const uint4 (&r)[NROWS * (NCOLS / 8) / NTHR], int tid) {
  constexpr int CPR = NCOLS / 8, NCH = NROWS * CPR / NTHR;
#pragma unroll
  for (int i = 0; i < NCH; ++i) {
    const int c = tid + i * NTHR, row = c / CPR, cc = c % CPR;
    *reinterpret_cast<uint4*>(dst + row * ldd + cc * 8) = r[i];
  }
}
template <int NCOLS>
DI void stage_T_ld(uint4 (&r)[128 * (NCOLS / 8) / NTHR], const u16* src, size_t lsrc, int tid) {
  constexpr int NCH = 128 * (NCOLS / 8) / NTHR;
#pragma unroll
  for (int i = 0; i < NCH; ++i) {
    const int c = tid + i * NTHR, j = c & 127, cc = c >> 7;
    r[i] = *reinterpret_cast<const uint4*>(src + (size_t)j * lsrc + cc * 8);
  }
}
template <int NCOLS, class W>
DI void stage_T_st(u16* dst, int ldd, const uint4 (&r)[128 * (NCOLS / 8) / NTHR], int tid, W w) {
  constexpr int NCH = 128 * (NCOLS / 8) / NTHR;
#pragma unroll
  for (int i = 0; i < NCH; ++i) {
    const int c = tid + i * NTHR, j = c & 127, cc = c >> 7;
    float f[8];
    unpack8(r[i], f);
    const float wj = w(j);
#pragma unroll
    for (int e = 0; e < 8; ++e) dst[(cc * 8 + e) * ldd + j] = f2bf(f[e] * wj);
  }
}

DI void ph_ret_a(const Params& p, char* smem, int item) {
  const int tid = otid(), wid = tid >> 6, lane = tid & 63, fr = lane & 15, fq = lane >> 4;
  u16* sVt = reinterpret_cast<u16*>(smem);
  u16* sKf = sVt + 64 * 136;
  u16* sKb = sKf + 64 * 136;
  {
    const int c = item & 31, bh = item >> 5, b = bh >> 2, h = bh & 3;
    const float lg0 = log1pf(-exp2f(-5.f - (float)h)), lg1 = log1pf(-exp2f(-5.5f - (float)h));
    const u16* src = p.proj() + ((size_t)b * SEQ + c * 128) * PWP;
    {
      uint4 rv[2], rk[2];
      stage_T_ld<64>(rv, src + C_RV + h * 64, PWP, tid);
      stage_T_ld<64>(rk, src + C_RK + h * 64, PWP, tid);
      stage_T_st<64>(sVt, 136, rv, tid, [](int) { return 1.f; });
      stage_T_st<64>(sKf, 136, rk, tid, [&](int j) { return __expf(lg0 * (float)(127 - j)); });
      stage_T_st<64>(sKb, 136, rk, tid, [&](int j) { return __expf(lg1 * (float)j); });
    }
    __syncthreads();
    const int dir = wid >> 2, q = wid & 3;
    f32x4 acc[1][4];
    zero_acc(acc);
    wave_mm<1, 4, 4>(acc, sVt + q * 16 * 136, 136, dir ? sKb : sKf, 136, fr, fq);
    float* out = p.rU() + ((size_t)(bh * 32 + c) * 2 + dir) * 4096;
#pragma unroll
    for (int n = 0; n < 4; ++n)
#pragma unroll
      for (int j = 0; j < 4; ++j) out[(q * 16 + fq * 4 + j) * 64 + n * 16 + fr] = acc[0][n][j];
    __syncthreads();
  }
}
DI void ph_ret_scan(const Params& p) {
  const int gt = obid() * NTHR + otid(), gs = gridDim.x * NTHR;
  for (int it = gt; it < 16 * 2 * 4096; it += gs) {
    const int e = it & 4095, dir = (it >> 12) & 1, bh = it >> 13, h = bh & 3;
    const float lg = log1pf(-exp2f((dir ? -5.5f : -5.f) - (float)h));
    const float cd = __expf(lg * 128.f);
    float u[32];
#pragma unroll
    for (int c = 0; c < 32; ++c) u[c] = p.rU()[((size_t)(bh * 32 + c) * 2 + dir) * 4096 + e];
    float st = 0.f;
    if (dir == 0) {
#pragma unroll
      for (int c = 0; c < 32; ++c) {
        p.rS()[((size_t)(bh * 32 + c) * 2 + dir) * 4096 + e] = f2bf(st);
        st = st * cd + u[c];
      }
    } else {
#pragma unroll
      for (int c = 31; c >= 0; --c) {
        p.rS()[((size_t)(bh * 32 + c) * 2 + dir) * 4096 + e] = f2bf(st);
        st = st * cd + u[c];
      }
    }
  }
}
DI void ph_ret_c(const Params& p, char* smem, int item) {
  const int tid = otid(), wid = tid >> 6, lane = tid & 63, fr = lane & 15, fq = lane >> 4;
  u16* sQ = reinterpret_cast<u16*>(smem);
  u16* sK = sQ + 128 * 72;
  u16* sVt = sK + 128 * 72;
  u16* sSf = sVt + 64 * 136;
  u16* sSb = sSf + 64 * 72;
  u16* sP = sSb + 64 * 72;
  {
    const int c = item & 31, bh = item >> 5, b = bh >> 2, h = bh & 3;
    const float lg0 = log1pf(-exp2f(-5.f - (float)h)), lg1 = log1pf(-exp2f(-5.5f - (float)h));
    const size_t t0 = (size_t)b * SEQ + c * 128;
    const u16* src = p.proj() + t0 * PWP;
    {
      uint4 rq[2], rk[2], rv[2], rf[1], rb[1];
      stage_rows_ld<128, 64>(rq, src + C_RQ + h * 64, PWP, tid);
      stage_rows_ld<128, 64>(rk, src + C_RK + h * 64, PWP, tid);
      stage_T_ld<64>(rv, src + C_RV + h * 64, PWP, tid);
      stage_rows_ld<64, 64>(rf, p.rS() + ((size_t)(bh * 32 + c) * 2 + 0) * 4096, 64, tid);
      stage_rows_ld<64, 64>(rb, p.rS() + ((size_t)(bh * 32 + c) * 2 + 1) * 4096, 64, tid);
      stage_rows_st<128, 64>(sQ, 72, rq, tid);
      stage_rows_st<128, 64>(sK, 72, rk, tid);
      stage_T_st<64>(sVt, 136, rv, tid, [](int) { return 1.f; });
      stage_rows_st<64, 64>(sSf, 72, rf, tid);
      stage_rows_st<64, 64>(sSb, 72, rb, tid);
    }
    __syncthreads();
    {
      const int wr = wid >> 1, wc = wid & 1;
      f32x4 sacc[2][4];
      zero_acc(sacc);
      wave_mm<2, 4, 2>(sacc, sQ + wr * 32 * 72, 72, sK + wc * 64 * 72, 72, fr, fq);
#pragma unroll
      for (int m = 0; m < 2; ++m)
#pragma unroll
        for (int n = 0; n < 4; ++n)
#pragma unroll
          for (int j = 0; j < 4; ++j) {
            const int i = wr * 32 + m * 16 + fq * 4 + j, jj = wc * 64 + n * 16 + fr;
            const float dcy = (jj <= i) ? __expf(lg0 * (float)(i - jj)) : __expf(lg1 * (float)(jj - i));
            sP[i * 136 + jj] = f2bf(sacc[m][n][j] * dcy);
          }
    }
    __syncthreads();
    {
      f32x4 ai[1][4], af_[1][4], ab_[1][4];
      zero_acc(ai); zero_acc(af_); zero_acc(ab_);
      wave_mm<1, 4, 4>(ai, sP + wid * 16 * 136, 136, sVt, 136, fr, fq);
      wave_mm<1, 4, 2>(af_, sQ + wid * 16 * 72, 72, sSf, 72, fr, fq);
      wave_mm<1, 4, 2>(ab_, sQ + wid * 16 * 72, 72, sSb, 72, fr, fq);
#pragma unroll
      for (int j = 0; j < 4; ++j) {
        const int i = wid * 16 + fq * 4 + j;
        const float xf = __expf(lg0 * (float)(i + 1)), xb = __expf(lg1 * (float)(128 - i));
        float o[4], sum = 0.f;
#pragma unroll
        for (int n = 0; n < 4; ++n) { o[n] = ai[0][n][j] + xf * af_[0][n][j] + xb * ab_[0][n][j]; sum += o[n]; }
#pragma unroll
        for (int sft = 1; sft < 16; sft <<= 1) sum += __shfl_xor(sum, sft);
        const float mu = sum * (1.f / 64.f);
        float var = 0.f;
#pragma unroll
        for (int n = 0; n < 4; ++n) var += (o[n] - mu) * (o[n] - mu);
#pragma unroll
        for (int sft = 1; sft < 16; sft <<= 1) var += __shfl_xor(var, sft);
        const float rs = rsqrtf(var * (1.f / 64.f) + 1e-5f);
#pragma unroll
        for (int n = 0; n < 4; ++n) {
          const float g = bf2f(p.proj()[(t0 + i) * PWP + C_RG + h * 64 + n * 16 + fr]);
          p.mixed()[(t0 + i) * DM + h * 64 + n * 16 + fr] = f2bf(silu(g) * (o[n] - mu) * rs);
        }
      }
    }
    __syncthreads();
  }
}

DI void ssd_local_cumsum(const Params& p, int L, size_t t0, float* cum, float* dtl, int wid, int lane) {
  const int dir = wid >> 2, h = wid & 3;
  const float a = -__expf(p.a_log[L * 8 + dir * 4 + h]);
  float d0, d1;
  if (dir == 0) { d0 = p.dtv()[(t0 + 2 * lane) * 8 + h]; d1 = p.dtv()[(t0 + 2 * lane + 1) * 8 + h]; }
  else { d0 = p.dtv()[(t0 + 127 - 2 * lane) * 8 + 4 + h]; d1 = p.dtv()[(t0 + 126 - 2 * lane) * 8 + 4 + h]; }
  float v0 = d0 * a, v1 = v0 + d1 * a;
  float run = v1;
#pragma unroll
  for (int o = 1; o < 64; o <<= 1) {
    const float u = __shfl_up(run, o);
    if (lane >= o) run += u;
  }
  const float excl = run - v1;
  v0 += excl; v1 += excl;
  float* cr = cum + (dir * 4 + h) * 128;
  float* dr = dtl + (dir * 4 + h) * 128;
  if (dir == 0) { cr[2 * lane] = v0; cr[2 * lane + 1] = v1; dr[2 * lane] = d0; dr[2 * lane + 1] = d1; }
  else { cr[127 - 2 * lane] = v0; cr[126 - 2 * lane] = v1; dr[127 - 2 * lane] = d0; dr[126 - 2 * lane] = d1; }
}

DI void ph_ssd_a(const Params& p, int L, char* smem, int item) {
  const int tid = otid(), wid = tid >> 6, lane = tid & 63, fr = lane & 15, fq = lane >> 4;
  u16* sBt = reinterpret_cast<u16*>(smem);
  u16* sXf = sBt + 2 * 128 * 136;
  u16* sXb = sXf + 64 * 136;
  float* cum = reinterpret_cast<float*>(sXb + 64 * 136);
  float* dtl = cum + 8 * 128;
  {
    const int c = item & 31, b = item >> 5;
    const size_t t0 = (size_t)b * SEQ + c * 128;
    ssd_local_cumsum(p, L, t0, cum, dtl, wid, lane);
    stage_T<256>(sBt, 136, p.xbc() + t0 * 768 + 256, 768, tid, [](int) { return 1.f; });
    __syncthreads();
    if (tid < 8) {
      const int dir = tid >> 2;
      p.cdec()[(size_t)item * 8 + tid] = __expf(dir ? cum[tid * 128 + 0] : cum[tid * 128 + 127]);
    }
    for (int h = 0; h < 4; ++h) {
      const float* cf = cum + h * 128;
      const float* cb = cum + (4 + h) * 128;
      const float* df = dtl + h * 128;
      const float* db = dtl + (4 + h) * 128;
      const float endf = cf[127], endb = cb[0];
      {
        uint4 rx[2];
        stage_T_ld<64>(rx, p.xbc() + t0 * 768 + h * 64, 768, tid);
        stage_T_st<64>(sXf, 136, rx, tid, [&](int l) { return __expf(endf - cf[l]) * df[l]; });
        stage_T_st<64>(sXb, 136, rx, tid, [&](int l) { return __expf(endb - cb[l]) * db[l]; });
      }
      __syncthreads();
      const int dir = wid >> 2, q = wid & 3, g = h >> 1;
      f32x4 acc[4][2];
      zero_acc(acc);
      wave_mm<4, 2, 4>(acc, dir ? sXb : sXf, 136, sBt + (g * 128 + q * 32) * 136, 136, fr, fq);
      float* out = p.sU() + ((size_t)item * 8 + h * 2 + dir) * 8192;
#pragma unroll
      for (int m = 0; m < 4; ++m)
#pragma unroll
        for (int n = 0; n < 2; ++n)
#pragma unroll
          for (int j = 0; j < 4; ++j) out[(m * 16 + fq * 4 + j) * 128 + q * 32 + n * 16 + fr] = acc[m][n][j];
      __syncthreads();
    }
  }
}
DI void ph_ssd_scan(const Params& p) {
  const int gt = obid() * NTHR + otid(), gs = gridDim.x * NTHR;
  for (int it = gt; it < 4 * 8 * 8192; it += gs) {
    const int e = it & 8191, hd = (it >> 13) & 7, b = it >> 16;
    const int dir = hd & 1, h = hd >> 1;
    float u[32];
#pragma unroll
    for (int c = 0; c < 32; ++c) u[c] = p.sU()[((size_t)(b * 32 + c) * 8 + hd) * 8192 + e];
    float st = 0.f;
    if (dir == 0) {
#pragma unroll
      for (int c = 0; c < 32; ++c) {
        p.sS()[((size_t)(b * 32 + c) * 8 + hd) * 8192 + e] = f2bf(st);
        st = st * p.cdec()[(size_t)(b * 32 + c) * 8 + dir * 4 + h] + u[c];
      }
    } else {
#pragma unroll
      for (int c = 31; c >= 0; --c) {
        p.sS()[((size_t)(b * 32 + c) * 8 + hd) * 8192 + e] = f2bf(st);
        st = st * p.cdec()[(size_t)(b * 32 + c) * 8 + dir * 4 + h] + u[c];
      }
    }
  }
}
DI void ph_ssd_c(const Params& p, int L, char* smem, int item) {
  const int tid = otid(), wid = tid >> 6, lane = tid & 63, fr = lane & 15, fq = lane >> 4;
  u16* sC = reinterpret_cast<u16*>(smem);
  u16* sB = sC + 128 * 136;
  u16* sXt = sB + 128 * 136;
  u16* sSf = sXt + 64 * 136;
  u16* sSb = sSf + 64 * 136;
  float* cum = reinterpret_cast<float*>(sSb + 64 * 136);
  float* dtl = cum + 8 * 128;
  {
    const int c = item & 31, b = item >> 5;
    const size_t t0 = (size_t)b * SEQ + c * 128;
    ssd_local_cumsum(p, L, t0, cum, dtl, wid, lane);
    float ssq[4] = {0.f, 0.f, 0.f, 0.f};
#pragma unroll 1
    for (int g = 0; g < 2; ++g) {
      {
        uint4 rc[4], rb4[4];
        stage_rows_ld<128, 128>(rc, p.xbc() + t0 * 768 + 512 + g * 128, 768, tid);
        stage_rows_ld<128, 128>(rb4, p.xbc() + t0 * 768 + 256 + g * 128, 768, tid);
        stage_rows_st<128, 128>(sC, 136, rc, tid);
        stage_rows_st<128, 128>(sB, 136, rb4, tid);
      }
      __syncthreads();
      const int wr = wid >> 1, wc = wid & 1;
      f32x4 G[2][4];
      zero_acc(G);
      wave_mm<2, 4, 4>(G, sC + wr * 32 * 136, 136, sB + wc * 64 * 136, 136, fr, fq);
      __syncthreads();
#pragma unroll 1
      for (int hl = 0; hl < 2; ++hl) {
        const int h = g * 2 + hl;
        const float* cf = cum + h * 128;
        const float* cb = cum + (4 + h) * 128;
        const float* df = dtl + h * 128;
        const float* db = dtl + (4 + h) * 128;
        uint4 rxt[2], rsf[2], rsb[2];
        stage_T_ld<64>(rxt, p.xbc() + t0 * 768 + h * 64, 768, tid);
        stage_rows_ld<64, 128>(rsf, p.sS() + ((size_t)item * 8 + h * 2 + 0) * 8192, 128, tid);
        stage_rows_ld<64, 128>(rsb, p.sS() + ((size_t)item * 8 + h * 2 + 1) * 8192, 128, tid);
#pragma unroll
        for (int m = 0; m < 2; ++m)
#pragma unroll
          for (int n = 0; n < 4; ++n)
#pragma unroll
            for (int j = 0; j < 4; ++j) {
              const int l = wr * 32 + m * 16 + fq * 4 + j, sx = wc * 64 + n * 16 + fr;
              const float w = (sx <= l) ? __expf(cf[l] - cf[sx]) * df[sx] : __expf(cb[l] - cb[sx]) * db[sx];
              sB[l * 136 + sx] = f2bf(G[m][n][j] * w);
            }
        stage_T_st<64>(sXt, 136, rxt, tid, [](int) { return 1.f; });
        stage_rows_st<64, 128>(sSf, 136, rsf, tid);
        stage_rows_st<64, 128>(sSb, 136, rsb, tid);
        __syncthreads();
        f32x4 yd[1][4], yf[1][4], yb[1][4];
        zero_acc(yd); zero_acc(yf); zero_acc(yb);
        wave_mm<1, 4, 4>(yd, sB + wid * 16 * 136, 136, sXt, 136, fr, fq);
        wave_mm<1, 4, 4>(yf, sC + wid * 16 * 136, 136, sSf, 136, fr, fq);
        wave_mm<1, 4, 4>(yb, sC + wid * 16 * 136, 136, sSb, 136, fr, fq);
        const float dsk = p.ssm_d[L * 4 + h];
#pragma unroll
        for (int j = 0; j < 4; ++j) {
          const int l = wid * 16 + fq * 4 + j;
          const float ef = __expf(cf[l]), eb = __expf(cb[l]);
#pragma unroll
          for (int n = 0; n < 4; ++n) {
            const int ch = h * 64 + n * 16 + fr;
            const float xv = bf2f(p.xbc()[(t0 + l) * 768 + ch]);
            const float z = bf2f(p.proj()[(t0 + l) * PWP + C_Z + ch]);
            const float yv = (yd[0][n][j] + ef * yf[0][n][j] + eb * yb[0][n][j] + dsk * xv) * silu(z);
            ssq[j] += yv * yv;
            p.ybuf()[(t0 + l) * 256 + ch] = yv;
          }
        }
        __syncthreads();
      }
    }
    const float* nwt = p.ssm_norm_w + L * 256;
#pragma unroll
    for (int j = 0; j < 4; ++j) {
      float ss = ssq[j];
#pragma unroll
      for (int sft = 1; sft < 16; sft <<= 1) ss += __shfl_xor(ss, sft);
      const float rstd = rsqrtf(ss * (1.f / 256.f) + 1e-6f);
      const int l = wid * 16 + fq * 4 + j;
#pragma unroll
      for (int hn = 0; hn < 16; ++hn) {
        const int ch = hn * 16 + fr;
        p.mixed()[(t0 + l) * DM + 512 + ch] = f2bf(p.ybuf()[(t0 + l) * 256 + ch] * rstd * nwt[ch]);
      }
    }
  }
}

struct CfgOutproj {
  static constexpr bool PERM = false;
  int K; const Params* p; int L; int bid, nb; const float* xin; float* xout;
  DI bool next(int i, pg8::Unit& u) const { const int t = i * nb + bid; if (t >= 64 * 4) return false; u.pm = t & 63; u.pn = t >> 6; return true; }
  DI const char* a_base(const pg8::Unit& u) const { return (const char*)(p->mixed() + (size_t)u.pm * 256 * DM); }
  DI const char* b_base(const pg8::Unit& u) const { return (const char*)(p->WoutT() + ((size_t)L * DM + (size_t)u.pn * 256) * DM); }
  DI void a_off(const pg8::Unit&, int R0, int C0, int R1, int C1, unsigned (&vo)[4]) const {
    vo[0] = (unsigned)(R0 * DM + C0) * 2u; vo[1] = (unsigned)(R1 * DM + C1) * 2u;
    vo[2] = vo[0] + 128u * DM * 2u; vo[3] = vo[1] + 128u * DM * 2u;
  }
  DI void epi(const f32x4 (&acc)[2][2][4][2], const pg8::Unit& u, int wr, int wc, int fr, int fq) const {
    const int row0 = u.pm * 256 + wr * 64 + fr, col0 = u.pn * 256 + wc * 32 + 4 * fq;
#pragma unroll
    for (int ai = 0; ai < 2; ++ai)
#pragma unroll
      for (int m = 0; m < 4; ++m) {
        const size_t ro = (size_t)(row0 + ai * 128 + m * 16) * DM + col0;
#pragma unroll
        for (int bj = 0; bj < 2; ++bj)
#pragma unroll
          for (int n = 0; n < 2; ++n) {
            const size_t o = ro + bj * 128 + n * 16;
            const float4 xi = *reinterpret_cast<const float4*>(xin + o);
            const f32x4 a = acc[ai][bj][m][n];
            *reinterpret_cast<float4*>(xout + o) = make_float4(xi.x + a[0], xi.y + a[1], xi.z + a[2], xi.w + a[3]);
          }
      }
  }
};
DI void ph_outproj(const Params& p, int L, const float* xin, float* xout, char* smem) {
  CfgOutproj c; c.K = DM; c.p = &p; c.L = L; c.bid = obid(); c.nb = gridDim.x; c.xin = xin; c.xout = xout;
  pg8::gemm_phase((pg8::lds_u8*)smem, c);
}

DI void ph_rms2_router(const Params& p, int L, const float* xres, char* smem) {
  const int tid = otid(), lane = tid & 63, gw = (obid() * NTHR + tid) >> 6, nw = gridDim.x * (NTHR / 64);
  const float* w = p.ln2_w + L * DM;
  const float* rw = p.router_w + (size_t)L * DM * 16;
  float4* srw = reinterpret_cast<float4*>(smem);
  for (int i = tid; i < 4096; i += NTHR) {
    const int c = i >> 2, e4 = i & 3;
    srw[(e4 * 4 + (c & 3)) * 256 + (c >> 2)] = *reinterpret_cast<const float4*>(rw + (size_t)i * 4);
  }
  __syncthreads();
  const int b5 = (lane >> 5) & 1, b4 = (lane >> 4) & 1, b3 = (lane >> 3) & 1, b2 = (lane >> 2) & 1;
  const int my_e = 8 * b5 + 4 * b4 + 2 * b3 + b2;
  for (int t = gw; t < T; t += nw) {
    const float* xr = xres + (size_t)t * DM;
    float4 v[4];
    float ss = 0.f;
#pragma unroll
    for (int i = 0; i < 4; ++i) {
      v[i] = *reinterpret_cast<const float4*>(xr + (i * 64 + lane) * 4);
      ss += v[i].x * v[i].x + v[i].y * v[i].y + v[i].z * v[i].z + v[i].w * v[i].w;
    }
    ss = wave_sum(ss);
    const float rstd = rsqrtf(ss * (1.f / DM) + 1e-6f);
    float lg[16];
#pragma unroll
    for (int e = 0; e < 16; ++e) lg[e] = 0.f;
#pragma unroll
    for (int i = 0; i < 4; ++i) {
      const int q = i * 64 + lane;
      const float4 ww = *reinterpret_cast<const float4*>(w + q * 4);
      const float hv[4] = {v[i].x * rstd * ww.x, v[i].y * rstd * ww.y, v[i].z * rstd * ww.z, v[i].w * rstd * ww.w};
      *reinterpret_cast<unsigned*>(p.hn8() + (size_t)t * DM + q * 4) =
          pk4_f8(hv[0] * F8_H_SCALE, hv[1] * F8_H_SCALE, hv[2] * F8_H_SCALE, hv[3] * F8_H_SCALE);
#pragma unroll
      for (int j = 0; j < 4; ++j)
#pragma unroll
        for (int e4 = 0; e4 < 4; ++e4) {
          const float4 r = srw[(e4 * 4 + j) * 256 + q];
          lg[e4 * 4 + 0] += hv[j] * r.x; lg[e4 * 4 + 1] += hv[j] * r.y;
          lg[e4 * 4 + 2] += hv[j] * r.z; lg[e4 * 4 + 3] += hv[j] * r.w;
        }
      __builtin_amdgcn_sched_barrier(0);
    }
#pragma unroll
    for (int k = 0; k < 8; ++k) {
      const float send = b5 ? lg[k] : lg[k + 8], keep = b5 ? lg[k + 8] : lg[k];
      lg[k] = keep + __shfl_xor(send, 32);
    }
#pragma unroll
    for (int k = 0; k < 4; ++k) {
      const float send = b4 ? lg[k] : lg[k + 4], keep = b4 ? lg[k + 4] : lg[k];
      lg[k] = keep + __shfl_xor(send, 16);
    }
#pragma unroll
    for (int k = 0; k < 2; ++k) {
      const float send = b3 ? lg[k] : lg[k + 2], keep = b3 ? lg[k + 2] : lg[k];
      lg[k] = keep + __shfl_xor(send, 8);
    }
    float lv;
    {
      const float send = b2 ? lg[0] : lg[1], keep = b2 ? lg[1] : lg[0];
      lv = keep + __shfl_xor(send, 4);
    }
    lv += __shfl_xor(lv, 2);
    lv += __shfl_xor(lv, 1);
    float mx = lv;
    mx = fmaxf(mx, __shfl_xor(mx, 4)); mx = fmaxf(mx, __shfl_xor(mx, 8));
    mx = fmaxf(mx, __shfl_xor(mx, 16)); mx = fmaxf(mx, __shfl_xor(mx, 32));
    const float ex = expf(lv - mx);
    float den = ex;
    den += __shfl_xor(den, 4); den += __shfl_xor(den, 8); den += __shfl_xor(den, 16); den += __shfl_xor(den, 32);
    if ((lane & 3) == 0) { p.aff()[(size_t)t * 16 + my_e] = ex / den; p.inv()[(size_t)t * 16 + my_e] = -1; }
  }
}

DI int block_sum_i(int v, int* red, int tid) {
#pragma unroll
  for (int o = 32; o > 0; o >>= 1) v += __shfl_xor(v, o);
  __syncthreads();
  if ((tid & 63) == 0) red[tid >> 6] = v;
  __syncthreads();
  int t = 0;
#pragma unroll
  for (int w = 0; w < NTHR / 64; ++w) t += red[w];
  return t;
}
DI void ph_topk(const Params& p, char* smem) {
  int* red = reinterpret_cast<int*>(smem);
  int* wsum = red + 16;
  const int tid = otid(), wid = tid >> 6, lane = tid & 63;
  for (int it = obid(); it < 64; it += gridDim.x) {
    const int e = it & 15, b = it >> 4;
    unsigned v[8];
#pragma unroll
    for (int i = 0; i < 8; ++i) v[i] = __float_as_uint(p.aff()[(size_t)(b * SEQ + tid * 8 + i) * 16 + e]);
    unsigned thr = 0;
#pragma unroll 1
    for (int bit = 30; bit >= 0; --bit) {
      const unsigned cand = thr | (1u << bit);
      int cnt = 0;
#pragma unroll
      for (int i = 0; i < 8; ++i) cnt += (v[i] >= cand) ? 1 : 0;
      if (block_sum_i(cnt, red, tid) >= 512) thr = cand;
    }
    int ngt = 0, ntie = 0;
#pragma unroll
    for (int i = 0; i < 8; ++i) { ngt += (v[i] > thr) ? 1 : 0; ntie += (v[i] == thr) ? 1 : 0; }
    int ig = ngt, itie = ntie;
#pragma unroll
    for (int o = 1; o < 64; o <<= 1) {
      const int a = __shfl_up(ig, o), c = __shfl_up(itie, o);
      if (lane >= o) { ig += a; itie += c; }
    }
    __syncthreads();
    if (lane == 63) { wsum[wid] = ig; wsum[8 + wid] = itie; }
    __syncthreads();
    int og = 0, ot = 0, totg = 0;
#pragma unroll
    for (int w = 0; w < 8; ++w) {
      const int a = wsum[w], c = wsum[8 + w];
      if (w < wid) { og += a; ot += c; }
      totg += a;
    }
    int pg = og + ig - ngt, pt = ot + itie - ntie;
    const int base = (e * 4 + b) * 512;
#pragma unroll
    for (int i = 0; i < 8; ++i) {
      int slot = -1;
      if (v[i] > thr) { slot = pg; ++pg; }
      else if (v[i] == thr) { if (totg + pt < 512) slot = totg + pt; ++pt; }
      if (slot >= 0) {
        p.tok()[base + slot] = b * SEQ + tid * 8 + i;
        p.inv()[(size_t)(b * SEQ + tid * 8 + i) * 16 + e] = base + slot;
        p.gate()[base + slot] = __uint_as_float(v[i]);
      }
    }
    __syncthreads();
  }
}

struct CfgMoe1 {
  static constexpr bool PERM = true;
  int K; const Params* p; int L; int bid, nb;
  DI bool next(int i, pg8::Unit& u) const {
    const int t = i * nb + bid; if (t >= 16 * 16 * 8) return false;
    const int rnd = t >> 8, w = t & 255, xcd = w & 7, jx = w >> 3, pid = xcd * 4 + (jx >> 3);
    const int mt = jx & 7, nt = pid & 15, e = rnd * 2 + (pid >> 4);
    u.pm = e * 8 + mt; u.pn = e * 16 + nt; return true;
  }
  DI const char* a_base(const pg8::Unit&) const { return (const char*)p->hn8(); }
  DI const char* b_base(const pg8::Unit& u) const { return (const char*)(p->Wgu8() + ((size_t)L * 16 * 4096 + (size_t)u.pn * 256) * DM); }
  DI void a_off(const pg8::Unit& u, int R0, int C0, int R1, int C1, unsigned (&vo)[4]) const {
    const int* tk = p->tok() + u.pm * 256;
    vo[0] = (unsigned)(tk[R0] * 512 + C0) * 2u; vo[1] = (unsigned)(tk[R1] * 512 + C1) * 2u;
    vo[2] = (unsigned)(tk[128 + R0] * 512 + C0) * 2u; vo[3] = (unsigned)(tk[128 + R1] * 512 + C1) * 2u;
  }
  DI void epi(const f32x4 (&acc)[2][2][4][2], const pg8::Unit& u, int wr, int wc, int fr, int fq) const {
    const int row0 = u.pm * 256 + wr * 64 + fr, col0 = (u.pn & 15) * 128 + wc * 32 + 8 * fq;
    const float dq = 1.f / (F8_H_SCALE * F8_W_SCALE);
#pragma unroll
    for (int ai = 0; ai < 2; ++ai)
#pragma unroll
      for (int m = 0; m < 4; ++m) {
        const f32x4 g0 = acc[ai][0][m][0] * dq, g1 = acc[ai][0][m][1] * dq, u0 = acc[ai][1][m][0] * (dq * F8_HID_SCALE), u1 = acc[ai][1][m][1] * (dq * F8_HID_SCALE);
        uint2 w;
        w.x = pk4_f8(fast_silu(g0[0]) * u0[0], fast_silu(g0[1]) * u0[1], fast_silu(g0[2]) * u0[2], fast_silu(g0[3]) * u0[3]);
        w.y = pk4_f8(fast_silu(g1[0]) * u1[0], fast_silu(g1[1]) * u1[1], fast_silu(g1[2]) * u1[2], fast_silu(g1[3]) * u1[3]);
        *reinterpret_cast<uint2*>(p->hid8() + (size_t)(row0 + ai * 128 + m * 16) * 2048 + col0) = w;
      }
  }
};
DI void ph_moe1(const Params& p, int L, char* smem) {
  CfgMoe1 c; c.K = 512; c.p = &p; c.L = L; c.bid = obid(); c.nb = gridDim.x;
  pg8::gemm_phase_f8((pg8::lds_u8*)smem, c);
}
struct CfgMoe2 {
  static constexpr bool PERM = true;
  int K; const Params* p; int L; int bid, nb;
  DI bool next(int i, pg8::Unit& u) const {
    const int t = i * nb + bid; if (t >= 16 * 4 * 8) return false;
    const int rnd = t >> 8, w = t & 255, xcd = w & 7, jx = w >> 3, pid = rnd * 32 + xcd * 4 + (jx >> 3);
    u.pm = (pid >> 2) * 8 + (jx & 7); u.pn = pid; return true;
  }
  DI const char* a_base(const pg8::Unit& u) const { return (const char*)(p->hid8() + (size_t)u.pm * 256 * 2048); }
  DI const char* b_base(const pg8::Unit& u) const { return (const char*)(p->Wd8() + ((size_t)L * 16 * DM + (size_t)u.pn * 256) * 2048); }
  DI void a_off(const pg8::Unit&, int R0, int C0, int R1, int C1, unsigned (&vo)[4]) const {
    vo[0] = (unsigned)(R0 * 1024 + C0) * 2u; vo[1] = (unsigned)(R1 * 1024 + C1) * 2u;
    vo[2] = vo[0] + 128u * 1024u * 2u; vo[3] = vo[1] + 128u * 1024u * 2u;
  }
  DI void epi(const f32x4 (&acc)[2][2][4][2], const pg8::Unit& u, int wr, int wc, int fr, int fq) const {
    u16* eo = p->proj();
    const int row0 = u.pm * 256 + wr * 64 + fr, col0 = (u.pn & 3) * 256 + wc * 32 + 8 * fq;
#pragma unroll
    for (int ai = 0; ai < 2; ++ai)
#pragma unroll
      for (int m = 0; m < 4; ++m) {
        const int row = row0 + ai * 128 + m * 16;
        const float gt = p->gate()[row] * (1.f / (F8_HID_SCALE * F8_W_SCALE));
#pragma unroll
        for (int bj = 0; bj < 2; ++bj) {
          const f32x4 a0 = acc[ai][bj][m][0], a1 = acc[ai][bj][m][1];
          uint4 w;
          w.x = pack2(gt * a0[0], gt * a0[1]); w.y = pack2(gt * a0[2], gt * a0[3]);
          w.z = pack2(gt * a1[0], gt * a1[1]); w.w = pack2(gt * a1[2], gt * a1[3]);
          *reinterpret_cast<uint4*>(eo + (size_t)row * DM + col0 + bj * 128) = w;
        }
      }
  }
};
DI void ph_moe2(const Params& p, int L, char* smem) {
  CfgMoe2 c; c.K = 1024; c.p = &p; c.L = L; c.bid = obid(); c.nb = gridDim.x;
  pg8::gemm_phase_f8((pg8::lds_u8*)smem, c);
}
template <bool FINAL>
DI void ph_combine_norm(const Params& p, const float* __restrict__ xa, float* __restrict__ xnew, const float* __restrict__ w,
                        u16* __restrict__ hn_out, float* __restrict__ f_out) {
  const int tid_ = otid(), lane = tid_ & 63, gw = (obid() * NTHR + tid_) >> 6, nw = gridDim.x * (NTHR / 64);
  const u16* eo = p.proj();
  for (int t = gw; t < T; t += nw) {
    float4 v[4];
#pragma unroll
    for (int i = 0; i < 4; ++i) v[i] = *reinterpret_cast<const float4*>(xa + (size_t)t * DM + (i * 64 + lane) * 4);
    const int myrow = (lane < 16) ? p.inv()[(size_t)t * 16 + lane] : -1;
#pragma unroll 1
    for (int e = 0; e < 16; ++e) {
      const int r = __shfl(myrow, e);
      if (r >= 0) {
#pragma unroll
        for (int i = 0; i < 4; ++i) {
          const uint2 q = *reinterpret_cast<const uint2*>(eo + (size_t)r * DM + (i * 64 + lane) * 4);
          v[i].x += __uint_as_float(q.x << 16); v[i].y += __uint_as_float(q.x & 0xffff0000u);
          v[i].z += __uint_as_float(q.y << 16); v[i].w += __uint_as_float(q.y & 0xffff0000u);
        }
      }
    }
    float ss = 0.f;
#pragma unroll
    for (int i = 0; i < 4; ++i) ss += v[i].x * v[i].x + v[i].y * v[i].y + v[i].z * v[i].z + v[i].w * v[i].w;
    ss = wave_sum(ss);
    const float rstd = rsqrtf(ss * (1.f / DM) + 1e-6f);
#pragma unroll
    for (int i = 0; i < 4; ++i) {
      const int c = (i * 64 + lane) * 4;
      const float4 ww = *reinterpret_cast<const float4*>(w + c);
      if (FINAL) {
        *reinterpret_cast<float4*>(f_out + (size_t)t * DM + c) = make_float4(v[i].x * rstd * ww.x, v[i].y * rstd * ww.y, v[i].z * rstd * ww.z, v[i].w * rstd * ww.w);
      } else {
        *reinterpret_cast<float4*>(xnew + (size_t)t * DM + c) = v[i];
        uint2 o;
        o.x = pack2(v[i].x * rstd * ww.x, v[i].y * rstd * ww.y);
        o.y = pack2(v[i].z * rstd * ww.z, v[i].w * rstd * ww.w);
        *reinterpret_cast<uint2*>(hn_out + (size_t)t * DM + c) = o;
      }
    }
  }
}

__global__ void __launch_bounds__(NTHR) mk(Params p) {
  extern __shared__ __attribute__((aligned(16))) char smem[];
  cg::grid_group grid = cg::this_grid();
  __shared__ uint4 xb_words;
  if (threadIdx.x == 0) xb_words = make_uint4(0u, 0u, 0u, 0u);
  __syncthreads();
  XcdBarrier xb = xcd_barrier_post(p.bar(), (volatile LAS unsigned*)&xb_words);
  for (int rep = 0; rep < p.rep[0]; ++rep) ph_convert(p, smem);
  ph_rmsnorm_bf16(p.x, p.ln1_w, p.hn());
  grid.sync();
  for (int L = 0; L < 2; ++L) {
    const float* xin = (L == 0) ? p.x : p.xres2();
    float* xout = p.xres();
    if (L == 1) {
      for (int rep = 0; rep < p.rep[1]; ++rep) ph_combine_norm<false>(p, p.xres(), p.xres2(), p.ln1_w + DM, p.hn(), nullptr);
      xcd_barrier(xb);
    }
    for (int rp = 0; rp < p.rep[3]; ++rp) {
      for (int rep = 0; rep < p.rep[2]; ++rep) ph_inproj(p, L, smem);
      xcd_barrier(xb);
      ph_post(p, L);
      xcd_barrier(xb);
    }
    for (int rep = 0; rep < p.rep[12]; ++rep) xcd_barrier(xb);
    {
      unsigned* ctr = p.bar() + XCD_BAR_WORDS + 8 + L;
      __shared__ int q1_item;
      for (;;) {
        if (threadIdx.x == 0) q1_item = (int)atomicAdd(ctr, 1u);
        __syncthreads();
        const int it = q1_item;
        __syncthreads();
        if (it >= 1344) break;
        if (it < 256) ph_dil_pass<0>(p, smem, it);
        else if (it < 384) ph_ssd_a(p, L, smem, it - 256);
        else if (it < 576) ph_mla_up_q(p, L, smem, it - 384);
        else if (it < 832) ph_mla_up_kv(p, L, smem, it - 576);
        else ph_ret_a(p, smem, it - 832);
      }
    }
    xcd_barrier(xb);
    for (int rep = 0; rep < p.rep[5]; ++rep) {
      for (int r2 = 0; r2 < p.rep[13]; ++r2) { ph_ret_scan(p); ph_ssd_scan(p); }
      for (int r2 = 0; r2 < p.rep[14]; ++r2) ph_mla_attn(p, smem);
      for (int r2 = 0; r2 < p.rep[15]; ++r2) for (int bi = obid(); bi < 256; bi += gridDim.x) ph_dil_pass<1>(p, smem, bi);
    }
    xcd_barrier(xb);
    {
      unsigned* ctr = p.bar() + XCD_BAR_WORDS + L;
      __shared__ int q_item;
      for (;;) {
        if (threadIdx.x == 0) q_item = (int)atomicAdd(ctr, 1u);
        __syncthreads();
        const int it = q_item;
        __syncthreads();
        if (it >= 640) break;
        if (it < 128) ph_ssd_c(p, L, smem, it);
        else ph_ret_c(p, smem, it - 128);
      }
    }
    xcd_barrier(xb);
    for (int rep = 0; rep < p.rep[7]; ++rep) ph_outproj(p, L, xin, xout, smem);
    xcd_barrier(xb);
    for (int rep = 0; rep < p.rep[8]; ++rep) ph_rms2_router(p, L, xout, smem);
    xcd_barrier(xb);
    for (int rep = 0; rep < p.rep[9]; ++rep) ph_topk(p, smem);
    xcd_barrier(xb);
    for (int rep = 0; rep < p.rep[10]; ++rep) ph_moe1(p, L, smem);
    xcd_barrier(xb);
    for (int rep = 0; rep < p.rep[11]; ++rep) ph_moe2(p, L, smem);
    xcd_barrier(xb);
  }
  ph_combine_norm<true>(p, p.xres(), nullptr, p.final_w, nullptr, p.out);
}

extern "C" void kernel_launch(void* const* d_in, const int* in_sizes, int n_in, void* d_out, int out_size, void* d_ws,
                              size_t ws_size, hipStream_t stream) {
  static int grid_blocks = 0;
  if (!grid_blocks) {
    int dev = 0, cus = 0, per_cu = 0;
    (void)hipGetDevice(&dev);
    (void)hipDeviceGetAttribute(&cus, hipDeviceAttributeMultiprocessorCount, dev);
    (void)hipFuncSetAttribute((const void*)mk, hipFuncAttributeMaxDynamicSharedMemorySize, LDS_BYTES);
    (void)hipOccupancyMaxActiveBlocksPerMultiprocessor(&per_cu, (const void*)mk, NTHR, LDS_BYTES);
    if (per_cu < 1) { fprintf(stderr, "occupancy query says %d blocks/CU\n", per_cu); per_cu = 1; }
    grid_blocks = cus * 1;
  }
  Params p{};
  const float** fp = reinterpret_cast<const float**>(&p);
  for (int i = 0; i < 20; ++i) fp[i] = (const float*)d_in[i];
  p.out = (float*)d_out;
  p.ws = (char*)d_ws;
  const size_t off = WSO.total;
  { const int reps[16] = REPS_INIT; for (int i = 0; i < 16; ++i) p.rep[i] = reps[i]; }
  if (off > ws_size) { fprintf(stderr, "workspace too small: need %zu have %zu\n", off, ws_size); return; }
  (void)hipMemsetAsync(p.bar(), 0, (size_t)(XCD_BAR_WORDS + 64) * 4, stream);
  void* args[] = {&p};
  hipError_t e = hipLaunchCooperativeKernel((void*)mk, dim3(grid_blocks), dim3(NTHR), args, LDS_BYTES, stream);
  if (e != hipSuccess) fprintf(stderr, "cooperative launch failed: %s (grid %d)\n", hipGetErrorString(e), grid_blocks);
}
```

```cpp
#include <hip/hip_runtime.h>
#include <hip/hip_cooperative_groups.h>
#include <cstdio>
#include <cstdint>
namespace cg = cooperative_groups;

#define DI __device__ __forceinline__
typedef unsigned short u16;
typedef __attribute__((ext_vector_type(8))) short bf16x8;
typedef __attribute__((ext_vector_type(4))) float f32x4;

#ifndef REPS_INIT
#define REPS_INIT {1, 1, 1, 1, 1, 1, 1, 1, 1, 1, 1, 1, 0, 1, 1, 1}
#endif
constexpr int NTHR = 512;
constexpr int T = 16384, SEQ = 4096, DM = 1024;
constexpr int PW = 3240, PWP = 3328;
constexpr int C_RQ = 0, C_RK = 256, C_RV = 512, C_RG = 768, C_CQ = 1024, C_CKV = 1280, C_KR = 1408,
              C_Z = 1440, C_XBC = 1696, C_DT = 2464, C_DQ = 2472, C_DK = 2728, C_DV = 2984;
constexpr int LDS_BYTES = 132096;

struct WsOff {
  size_t WinT;
  size_t WuqT;
  size_t WukvT;
  size_t WoutT;
  size_t Wgu8;
  size_t Wd8;
  size_t hn8;
  size_t xres;
  size_t hn;
  size_t proj;
  size_t cqn;
  size_t ckvn;
  size_t mq;
  size_t xbc;
  size_t mixed;
  size_t hid8;
  size_t kfull;
  size_t rS;
  size_t sS;
  size_t rU;
  size_t sU;
  size_t cdec;
  size_t vT;
  size_t rtab;
  size_t dpart;
  size_t dtv;
  size_t cs;
  size_t ybuf;
  size_t aff;
  size_t gate;
  size_t tok;
  size_t inv;
  size_t bar;
  size_t xres2;
  size_t total;
};
constexpr WsOff ws_layout() {
  WsOff o{};
  size_t off = 0;
  o.WinT = off; off += (((size_t)2 * PWP * DM * 2) + 255) & ~(size_t)255;
  o.WuqT = off; off += (((size_t)2 * 384 * 256 * 2) + 255) & ~(size_t)255;
  o.WukvT = off; off += (((size_t)2 * 512 * 128 * 2) + 255) & ~(size_t)255;
  o.WoutT = off; off += (((size_t)2 * DM * DM * 2) + 255) & ~(size_t)255;
  o.Wgu8 = off; off += (((size_t)2 * 16 * 4096 * DM) + 255) & ~(size_t)255;
  o.Wd8 = off; off += (((size_t)2 * 16 * DM * 2048) + 255) & ~(size_t)255;
  o.hn8 = off; off += (((size_t)T * DM) + 255) & ~(size_t)255;
  o.xres = off; off += (((size_t)T * DM * 4) + 255) & ~(size_t)255;
  o.hn = off; off += (((size_t)T * DM * 2) + 255) & ~(size_t)255;
  o.proj = off; off += (((size_t)T * PWP * 2) + 255) & ~(size_t)255;
  o.cqn = off; off += (((size_t)T * 256 * 2) + 255) & ~(size_t)255;
  o.ckvn = off; off += (((size_t)T * 128 * 2) + 255) & ~(size_t)255;
  o.mq = off; off += (((size_t)T * 384 * 2) + 255) & ~(size_t)255;
  o.xbc = off; off += (((size_t)T * 768 * 2) + 255) & ~(size_t)255;
  o.mixed = off; off += (((size_t)T * DM * 2) + 255) & ~(size_t)255;
  o.hid8 = off; off += (((size_t)32768 * 2048) + 255) & ~(size_t)255;
  o.kfull = off; off += (((size_t)T * 4 * 96 * 2) + 255) & ~(size_t)255;
  o.rS = off; off += (((size_t)16 * 32 * 2 * 4096 * 2) + 255) & ~(size_t)255;
  o.sS = off; off += (((size_t)128 * 8 * 8192 * 2) + 255) & ~(size_t)255;
  o.rU = off; off += (((size_t)16 * 32 * 2 * 4096 * 4) + 255) & ~(size_t)255;
  o.sU = off; off += (((size_t)128 * 8 * 8192 * 4) + 255) & ~(size_t)255;
  o.cdec = off; off += (((size_t)128 * 8 * 4) + 255) & ~(size_t)255;
  o.vT = off; off += (((size_t)T * 4 * 64 * 2) + 255) & ~(size_t)255;
  o.rtab = off; off += (((size_t)SEQ * 56 * 2 * 4) + 255) & ~(size_t)255;
  o.dpart = off; off += (((size_t)T * 4 * 68 * 4) + 255) & ~(size_t)255;
  o.dtv = off; off += (((size_t)T * 8 * 4) + 255) & ~(size_t)255;
  o.cs = off; off += (((size_t)T * 8 * 4) + 255) & ~(size_t)255;
  o.ybuf = off; off += (((size_t)T * 256 * 4) + 255) & ~(size_t)255;
  o.aff = off; off += (((size_t)T * 16 * 4) + 255) & ~(size_t)255;
  o.gate = off; off += (((size_t)64 * 512 * 4) + 255) & ~(size_t)255;
  o.tok = off; off += (((size_t)64 * 512 * 4) + 255) & ~(size_t)255;
  o.inv = off; off += (((size_t)T * 16 * 4) + 255) & ~(size_t)255;
  o.bar = off; off += (((size_t)(3456 + 64) * 4) + 255) & ~(size_t)255;
  o.xres2 = off; off += (((size_t)T * DM * 4) + 255) & ~(size_t)255;
  o.total = off;
  return o;
}
constexpr WsOff WSO = ws_layout();
struct Params {
  const float *x, *ln1_w, *w_in, *q_norm_w, *kv_norm_w, *w_uq, *w_ukv, *conv_w, *conv_b, *a_log, *dt_bias,
      *ssm_d, *ssm_norm_w, *w_out, *ln2_w, *router_w, *w_gate, *w_up, *w_down, *final_w;
  float* out;
  char* ws;
  int rep[16];
  __host__ DI u16* WinT() const { return reinterpret_cast<u16*>(ws + WSO.WinT); }
  __host__ DI u16* WuqT() const { return reinterpret_cast<u16*>(ws + WSO.WuqT); }
  __host__ DI u16* WukvT() const { return reinterpret_cast<u16*>(ws + WSO.WukvT); }
  __host__ DI u16* WoutT() const { return reinterpret_cast<u16*>(ws + WSO.WoutT); }
  __host__ DI unsigned char* Wgu8() const { return reinterpret_cast<unsigned char*>(ws + WSO.Wgu8); }
  __host__ DI unsigned char* Wd8() const { return reinterpret_cast<unsigned char*>(ws + WSO.Wd8); }
  __host__ DI unsigned char* hn8() const { return reinterpret_cast<unsigned char*>(ws + WSO.hn8); }
  __host__ DI float* xres() const { return reinterpret_cast<float*>(ws + WSO.xres); }
  __host__ DI u16* hn() const { return reinterpret_cast<u16*>(ws + WSO.hn); }
  __host__ DI u16* proj() const { return reinterpret_cast<u16*>(ws + WSO.proj); }
  __host__ DI u16* cqn() const { return reinterpret_cast<u16*>(ws + WSO.cqn); }
  __host__ DI u16* ckvn() const { return reinterpret_cast<u16*>(ws + WSO.ckvn); }
  __host__ DI u16* mq() const { return reinterpret_cast<u16*>(ws + WSO.mq); }
  __host__ DI u16* xbc() const { return reinterpret_cast<u16*>(ws + WSO.xbc); }
  __host__ DI u16* mixed() const { return reinterpret_cast<u16*>(ws + WSO.mixed); }
  __host__ DI unsigned char* hid8() const { return reinterpret_cast<unsigned char*>(ws + WSO.hid8); }
  __host__ DI u16* kfull() const { return reinterpret_cast<u16*>(ws + WSO.kfull); }
  __host__ DI u16* rS() const { return reinterpret_cast<u16*>(ws + WSO.rS); }
  __host__ DI u16* sS() const { return reinterpret_cast<u16*>(ws + WSO.sS); }
  __host__ DI float* rU() const { return reinterpret_cast<float*>(ws + WSO.rU); }
  __host__ DI float* sU() const { return reinterpret_cast<float*>(ws + WSO.sU); }
  __host__ DI float* cdec() const { return reinterpret_cast<float*>(ws + WSO.cdec); }
  __host__ DI u16* vT() const { return reinterpret_cast<u16*>(ws + WSO.vT); }
  __host__ DI float* rtab() const { return reinterpret_cast<float*>(ws + WSO.rtab); }
  __host__ DI float* dpart() const { return reinterpret_cast<float*>(ws + WSO.dpart); }
  __host__ DI float* dtv() const { return reinterpret_cast<float*>(ws + WSO.dtv); }
  __host__ DI float* cs() const { return reinterpret_cast<float*>(ws + WSO.cs); }
  __host__ DI float* ybuf() const { return reinterpret_cast<float*>(ws + WSO.ybuf); }
  __host__ DI float* aff() const { return reinterpret_cast<float*>(ws + WSO.aff); }
  __host__ DI float* gate() const { return reinterpret_cast<float*>(ws + WSO.gate); }
  __host__ DI int* tok() const { return reinterpret_cast<int*>(ws + WSO.tok); }
  __host__ DI int* inv() const { return reinterpret_cast<int*>(ws + WSO.inv); }
  __host__ DI unsigned* bar() const { return reinterpret_cast<unsigned*>(ws + WSO.bar); }
  __host__ DI float* xres2() const { return reinterpret_cast<float*>(ws + WSO.xres2); }
};


typedef __attribute__((ext_vector_type(2))) __bf16 bf16x2_t;
typedef __attribute__((ext_vector_type(2))) float f32x2_t;
typedef __attribute__((ext_vector_type(16))) float f32x16;
typedef __attribute__((ext_vector_type(4))) short s16x4;
typedef __attribute__((ext_vector_type(8))) int i32x8;
typedef __attribute__((ext_vector_type(4))) int i32x4;
DI unsigned pack2(float a, float b) {
  f32x2_t v = {a, b};
  return __builtin_bit_cast(unsigned, __builtin_convertvector(v, bf16x2_t));
}
DI u16 f2bf(float f) { return (u16)(pack2(f, 0.f) & 0xffffu); }
DI float bf2f(u16 h) { return __uint_as_float(((unsigned)h) << 16); }
DI void unpack8(const uint4& v, float* f) {
  f[0] = __uint_as_float(v.x << 16); f[1] = __uint_as_float(v.x & 0xffff0000u);
  f[2] = __uint_as_float(v.y << 16); f[3] = __uint_as_float(v.y & 0xffff0000u);
  f[4] = __uint_as_float(v.z << 16); f[5] = __uint_as_float(v.z & 0xffff0000u);
  f[6] = __uint_as_float(v.w << 16); f[7] = __uint_as_float(v.w & 0xffff0000u);
}
DI void ld8(const u16* p, float* f) { uint4 v = *reinterpret_cast<const uint4*>(p); unpack8(v, f); }
DI unsigned pk4_f8(float a, float b, float c, float d) {
  a = __builtin_amdgcn_fmed3f(a, -448.f, 448.f); b = __builtin_amdgcn_fmed3f(b, -448.f, 448.f);
  c = __builtin_amdgcn_fmed3f(c, -448.f, 448.f); d = __builtin_amdgcn_fmed3f(d, -448.f, 448.f);
  int w = __builtin_amdgcn_cvt_pk_fp8_f32(a, b, 0, false);
  w = __builtin_amdgcn_cvt_pk_fp8_f32(c, d, w, true);
  return (unsigned)w;
}
constexpr float F8_W_SCALE = 256.f, F8_H_SCALE = 16.f, F8_HID_SCALE = 8.f;
DI float wave_sum(float v) {
#pragma unroll
  for (int o = 32; o > 0; o >>= 1) v += __shfl_xor(v, o);
  return v;
}
DI float dot2acc(unsigned a, unsigned b, float c) {
  return __builtin_amdgcn_fdot2_f32_bf16(__builtin_bit_cast(bf16x2_t, a), __builtin_bit_cast(bf16x2_t, b), c, false);
}
DI float dot8(const uint4& a, const uint4& b, float c) {
  c = dot2acc(a.x, b.x, c); c = dot2acc(a.y, b.y, c); c = dot2acc(a.z, b.z, c); c = dot2acc(a.w, b.w, c);
  return c;
}
DI int otid() { int t = threadIdx.x; asm volatile("" : "+v"(t)); return t; }
DI int obid() { int b = blockIdx.x; asm volatile("" : "+s"(b)); return b; }
DI float silu(float x) { return x / (1.f + __expf(-x)); }
DI float fast_silu(float x) { return x * __builtin_amdgcn_rcpf(1.f + __expf(-x)); }


#define XB_TMO      128
#define XB_XCNT(j)  (256  + 64 * (j))
#define XB_XSUB(j)  (1280 + 64 * (j))
#define XB_XGEN(j)  (2304 + 64 * (j))
#define XB_TOP      3328
#define XB_TOPGEN   3392
#define XCD_BAR_WORDS 3456
#define XB_SPIN_CAP (1u << 20)
#define LAS __attribute__((address_space(3)))
DI unsigned xb_ld(unsigned* p) { return __hip_atomic_load(p, __ATOMIC_RELAXED, __HIP_MEMORY_SCOPE_AGENT); }
DI unsigned xb_add(unsigned* p, unsigned v) { return __hip_atomic_fetch_add(p, v, __ATOMIC_RELAXED, __HIP_MEMORY_SCOPE_AGENT); }
DI unsigned xb_xcc_id() { return (unsigned)__builtin_amdgcn_s_getreg((3 << 11) | 20) & 0xFu; }
#define XB_SPIN(cond, bar) do { unsigned _sp = 0; while (cond) { __builtin_amdgcn_s_sleep(1); \
    if ((++_sp & 255u) == 0u) { if (xb_ld(&(bar)[XB_TMO])) break; if (_sp > XB_SPIN_CAP) { atomicAdd(&(bar)[XB_TMO], 1u); break; } } } } while (0)
struct XcdBarrier { unsigned* bar; unsigned x; volatile LAS unsigned* st; };
DI XcdBarrier xcd_barrier_post(unsigned* bar, volatile LAS unsigned* st) {
  XcdBarrier b; b.bar = bar; b.x = xb_xcc_id(); b.st = st;
  if (threadIdx.x == 0) (void)xb_add(&bar[XB_XCNT(b.x)], 1u);
  return b;
}
DI void xcd_barrier_complete(unsigned* bar, unsigned x, unsigned& nloc, unsigned& nx) {
  const unsigned G = gridDim.x * gridDim.y * gridDim.z;
  unsigned sum, cnt, mine, sp = 0u;
  for (;;) {
    sum = 0u; cnt = 0u; mine = 0u;
#pragma unroll
    for (unsigned j = 0; j < 16; ++j) { const unsigned c = xb_ld(&bar[XB_XCNT(j)]); sum += c; cnt += (c > 0u) ? 1u : 0u; mine = (j == x) ? c : mine; }
    if (sum == G) break;
    __builtin_amdgcn_s_sleep(1);
    if ((++sp & 255u) == 0u) { if (xb_ld(&bar[XB_TMO])) break; if (sp > XB_SPIN_CAP) { atomicAdd(&bar[XB_TMO], 1u); break; } }
  }
  nloc = mine > 0u ? mine : 1u; nx = cnt > 0u ? cnt : 1u;
}
DI void xcd_barrier(const XcdBarrier& b) {
  asm volatile("s_waitcnt vmcnt(0)" ::: "memory");
  __syncthreads();
  if (threadIdx.x == 0) {
    unsigned* bar = b.bar;
    __builtin_amdgcn_s_waitcnt(0);
    unsigned nloc = b.st[0], nx = b.st[1];
    if (nloc == 0u) { xcd_barrier_complete(bar, b.x, nloc, nx); b.st[0] = nloc; b.st[1] = nx; }
    const unsigned old = xb_add(&bar[XB_XSUB(b.x)], 1u);
    const unsigned gen = old / nloc;
    if (old + 1u == (gen + 1u) * nloc) {
      __builtin_amdgcn_fence(__ATOMIC_RELEASE, "agent");
      asm volatile("s_waitcnt vmcnt(0)" ::: "memory");
      const unsigned og = xb_add(&bar[XB_TOP], 1u);
      const unsigned tg = og / nx;
      if (og + 1u == (tg + 1u) * nx) xb_add(&bar[XB_TOPGEN], 1u);
      else XB_SPIN(xb_ld(&bar[XB_TOPGEN]) == tg, bar);
      __builtin_amdgcn_fence(__ATOMIC_ACQUIRE, "agent");
      xb_add(&bar[XB_XGEN(b.x)], 1u);
      asm volatile("s_waitcnt vmcnt(0)" ::: "memory");
    } else {
      XB_SPIN(xb_ld(&bar[XB_XGEN(b.x)]) == gen, bar);
      __builtin_amdgcn_fence(__ATOMIC_ACQUIRE, "agent");
      asm volatile("s_waitcnt vmcnt(0)" ::: "memory");
    }
  }
  __syncthreads();
}

template <class F>
DI void transpose_convert(const float* __restrict__ src, int K, int N, int Npad, u16* __restrict__ dst, F rowmap,
                          int bid, int nb, char* smem) {
  u16* tile = reinterpret_cast<u16*>(smem);
  const int tid = otid();
  const int ntn = Npad / 128, ntk = K / 64;
  for (int t = bid; t < ntn * ntk; t += nb) {
    const int n0 = (t % ntn) * 128, k0 = (t / ntn) * 64;
    f32x4 v[4];
#pragma unroll
    for (int i = 0; i < 4; ++i) {
      const int kk = (tid >> 5) + 16 * i, nn = (tid & 31) * 4;
      v[i] = f32x4{0.f, 0.f, 0.f, 0.f};
      if (n0 + nn < N) v[i] = __builtin_nontemporal_load(reinterpret_cast<const f32x4*>(src + (size_t)(k0 + kk) * N + n0 + nn));
    }
#pragma unroll
    for (int i = 0; i < 4; ++i) {
      const int kk = (tid >> 5) + 16 * i, nn = (tid & 31) * 4;
      tile[(nn + 0) * 72 + kk] = f2bf(v[i][0]); tile[(nn + 1) * 72 + kk] = f2bf(v[i][1]);
      tile[(nn + 2) * 72 + kk] = f2bf(v[i][2]); tile[(nn + 3) * 72 + kk] = f2bf(v[i][3]);
    }
    __syncthreads();
#pragma unroll
    for (int j = 0; j < 2; ++j) {
      const int c = tid + NTHR * j, nn = c >> 3, k8 = (c & 7) * 8;
      const uint4 o = *reinterpret_cast<const uint4*>(tile + nn * 72 + k8);
      *reinterpret_cast<uint4*>(dst + (size_t)rowmap(n0 + nn) * K + k0 + k8) = o;
    }
    __syncthreads();
  }
}

template <class F>
DI void transpose_convert_f8(const float* __restrict__ src, int K, int N, unsigned char* __restrict__ dst, F rowmap,
                             int bid, int nb, char* smem) {
  unsigned char* tile = reinterpret_cast<unsigned char*>(smem);
  const int tid = otid();
  const int ntn = N / 128, ntk = K / 64;
  for (int t = bid; t < ntn * ntk; t += nb) {
    const int n0 = (t % ntn) * 128, k0 = (t / ntn) * 64;
    const int kq = (tid >> 5) * 4, nn = (tid & 31) * 4;
    f32x4 v[4];
#pragma unroll
    for (int r = 0; r < 4; ++r) v[r] = __builtin_nontemporal_load(reinterpret_cast<const f32x4*>(src + (size_t)(k0 + kq + r) * N + n0 + nn));
#pragma unroll
    for (int e = 0; e < 4; ++e)
      *reinterpret_cast<unsigned*>(tile + (nn + e) * 80 + kq) =
          pk4_f8(v[0][e] * F8_W_SCALE, v[1][e] * F8_W_SCALE, v[2][e] * F8_W_SCALE, v[3][e] * F8_W_SCALE);
    __syncthreads();
    {
      const int rn = tid >> 2, kc = (tid & 3) * 16;
      const uint4 o = *reinterpret_cast<const uint4*>(tile + rn * 80 + kc);
      *reinterpret_cast<uint4*>(dst + (size_t)rowmap(n0 + rn) * K + k0 + kc) = o;
    }
    __syncthreads();
  }
}

DI void ph_convert(const Params& p, char* smem) {
  const int nb = gridDim.x;
  int bid = obid();
  for (int idx = bid * NTHR + otid(); idx < SEQ * 56; idx += nb * NTHR) {
    const int pos = idx / 56, f = idx - pos * 56;
    float inv;
    if (f < 32) inv = exp2f(-(float)f * (13.287712379549449f / 32.f));
    else if (f < 40) inv = exp2f(-(float)(f - 32) * (18.931568569324174f / 8.f));
    else inv = exp2f(-(float)(f - 40) * (18.931568569324174f / 16.f));
    float sn, cs;
    sincosf((float)pos * inv, &sn, &cs);
    p.rtab()[(size_t)idx * 2] = cs;
    p.rtab()[(size_t)idx * 2 + 1] = sn;
  }
  auto ident = [](int n) { return n; };
  for (int L = 0; L < 2; ++L) {
    transpose_convert(p.w_in + (size_t)L * DM * PW, DM, PW, PWP, p.WinT() + (size_t)L * PWP * DM, ident, bid, nb, smem);
    transpose_convert(p.w_uq + (size_t)L * 256 * 384, 256, 384, 384, p.WuqT() + (size_t)L * 384 * 256, ident, bid, nb, smem);
    transpose_convert(p.w_ukv + (size_t)L * 128 * 512, 128, 512, 512, p.WukvT() + (size_t)L * 512 * 128, ident, bid, nb, smem);
    transpose_convert(p.w_out + (size_t)L * DM * DM, DM, DM, DM, p.WoutT() + (size_t)L * DM * DM, ident, bid, nb, smem);
    for (int e = 0; e < 16; ++e) {
      const size_t le = (size_t)(L * 16 + e);
      auto gmap = [](int n) { return (n >> 7) * 256 + (n & 127); };
      auto umap = [](int n) { return (n >> 7) * 256 + 128 + (n & 127); };
      transpose_convert_f8(p.w_gate + le * DM * 2048, DM, 2048, p.Wgu8() + le * 4096 * DM, gmap, bid, nb, smem);
      transpose_convert_f8(p.w_up + le * DM * 2048, DM, 2048, p.Wgu8() + le * 4096 * DM, umap, bid, nb, smem);
      transpose_convert_f8(p.w_down + le * 2048 * DM, 2048, DM, p.Wd8() + le * DM * 2048, ident, bid, nb, smem);
    }
  }
}

template <class RowPtr, class Epi>
DI void gemm_tile(RowPtr arow, const u16* __restrict__ bt, int ldb, int K, char* smem, Epi epi) {
  u16* sa = reinterpret_cast<u16*>(smem);
  u16* sb = sa + 2 * 256 * 72;
  const int tid = otid(), wid = tid >> 6, lane = tid & 63, wr = wid >> 1, wc = wid & 1, fr = lane & 15, fq = lane >> 4;
  f32x4 acc[4][4];
#pragma unroll
  for (int m = 0; m < 4; ++m)
#pragma unroll
    for (int n = 0; n < 4; ++n) acc[m][n] = f32x4{0.f, 0.f, 0.f, 0.f};
  const int lr = tid >> 3, lc = (tid & 7) * 8;
  const u16* ap[4];
#pragma unroll
  for (int i = 0; i < 4; ++i) ap[i] = arow(lr + 64 * i) + lc;
  const u16* bp[2];
#pragma unroll
  for (int i = 0; i < 2; ++i) bp[i] = bt + (size_t)(lr + 64 * i) * ldb + lc;
  uint4 ra[4], rb[2];
  const int nk = K / 64;
#pragma unroll
  for (int i = 0; i < 4; ++i) ra[i] = *reinterpret_cast<const uint4*>(ap[i]);
#pragma unroll
  for (int i = 0; i < 2; ++i) rb[i] = *reinterpret_cast<const uint4*>(bp[i]);
#pragma unroll
  for (int i = 0; i < 4; ++i) *reinterpret_cast<uint4*>(sa + (lr + 64 * i) * 72 + lc) = ra[i];
#pragma unroll
  for (int i = 0; i < 2; ++i) *reinterpret_cast<uint4*>(sb + (lr + 64 * i) * 72 + lc) = rb[i];
  __syncthreads();
  for (int kt = 0; kt < nk; ++kt) {
    const int cur = kt & 1;
    if (kt + 1 < nk) {
#pragma unroll
      for (int i = 0; i < 4; ++i) ra[i] = *reinterpret_cast<const uint4*>(ap[i] + (kt + 1) * 64);
#pragma unroll
      for (int i = 0; i < 2; ++i) rb[i] = *reinterpret_cast<const uint4*>(bp[i] + (kt + 1) * 64);
    }
    const u16* ca = sa + cur * 256 * 72;
    const u16* cb = sb + cur * 128 * 72;
#pragma unroll
    for (int kk = 0; kk < 2; ++kk) {
      bf16x8 af[4], bfr[4];
#pragma unroll
      for (int m = 0; m < 4; ++m) af[m] = *reinterpret_cast<const bf16x8*>(ca + (wr * 64 + m * 16 + fr) * 72 + kk * 32 + fq * 8);
#pragma unroll
      for (int n = 0; n < 4; ++n) bfr[n] = *reinterpret_cast<const bf16x8*>(cb + (wc * 64 + n * 16 + fr) * 72 + kk * 32 + fq * 8);
#pragma unroll
      for (int m = 0; m < 4; ++m)
#pragma unroll
        for (int n = 0; n < 4; ++n) acc[m][n] = __builtin_amdgcn_mfma_f32_16x16x32_bf16(af[m], bfr[n], acc[m][n], 0, 0, 0);
    }
    if (kt + 1 < nk) {
      u16* na = sa + (cur ^ 1) * 256 * 72;
      u16* nbp = sb + (cur ^ 1) * 128 * 72;
#pragma unroll
      for (int i = 0; i < 4; ++i) *reinterpret_cast<uint4*>(na + (lr + 64 * i) * 72 + lc) = ra[i];
#pragma unroll
      for (int i = 0; i < 2; ++i) *reinterpret_cast<uint4*>(nbp + (lr + 64 * i) * 72 + lc) = rb[i];
    }
    __syncthreads();
  }
  epi(acc, wr, wc, fr, fq);
}

#define WAIT_V(n) asm volatile("s_waitcnt vmcnt(%0)" ::"n"(n) : "memory")
DI int lds_byte2(int r, int c) {
  const int st = (r >> 4) * 2 + (c >> 5), ob = (r & 15) * 64 + (c & 31) * 2;
  return st * 1024 + (ob ^ (((ob >> 9) & 1) << 5));
}
DI void stage_rc2(int b, int& R, int& C) {
  const int st = b >> 10, sb = b & 1023, swz = sb ^ (((sb >> 9) & 1) << 5);
  R = (st >> 1) * 16 + swz / 64;
  C = (st & 1) * 32 + (swz % 64) / 2;
}
typedef __attribute__((address_space(3))) unsigned lds_u32;
template <class RowPtr, class Epi>
DI void gemm256(RowPtr arow, const u16* __restrict__ bt, int ldb, int K, char* smem, Epi epi) {
  constexpr int TILE_B = 256 * 64 * 2, STAGE_B = 2 * TILE_B;
  const int tid = otid(), wid = tid >> 6, lane = tid & 63, wr = wid >> 2, wc = wid & 3, fr = lane & 15, fq = lane >> 4;
  const u16* ap[4];
  const u16* bp[4];
#pragma unroll
  for (int i = 0; i < 4; ++i) {
    int R, C;
    stage_rc2(wid * 1024 + i * 8192 + lane * 16, R, C);
    ap[i] = arow(R) + C;
    bp[i] = bt + (size_t)R * ldb + C;
  }
  f32x4 acc[8][4];
#pragma unroll
  for (int m = 0; m < 8; ++m)
#pragma unroll
    for (int n = 0; n < 4; ++n) acc[m][n] = f32x4{0.f, 0.f, 0.f, 0.f};
#define G2_STAGE(buf, kt)                                                                                              \
  do {                                                                                                                 \
    _Pragma("unroll") for (int i = 0; i < 4; ++i) {                                                                    \
      __builtin_amdgcn_global_load_lds((const unsigned*)(ap[i] + (kt) * 64),                                           \
                                       (lds_u32*)(smem + (buf) * STAGE_B + wid * 1024 + i * 8192), 16, 0, 0);          \
      __builtin_amdgcn_global_load_lds((const unsigned*)(bp[i] + (kt) * 64),                                           \
                                       (lds_u32*)(smem + (buf) * STAGE_B + TILE_B + wid * 1024 + i * 8192), 16, 0, 0); \
    }                                                                                                                  \
  } while (0)
  const int nt = K / 64;
  G2_STAGE(0, 0);
  WAIT_V(0);
  __syncthreads();
  for (int t = 0; t < nt; ++t) {
    const int cur = t & 1;
    if (t + 1 < nt) G2_STAGE(cur ^ 1, t + 1);
    const char* sA = smem + cur * STAGE_B;
    const char* sB = sA + TILE_B;
#pragma unroll
    for (int ks = 0; ks < 2; ++ks) {
      bf16x8 At[8], Bf[4];
#pragma unroll
      for (int m = 0; m < 8; ++m) At[m] = *reinterpret_cast<const bf16x8*>(sA + lds_byte2(wr * 128 + m * 16 + fr, ks * 32 + fq * 8));
#pragma unroll
      for (int n = 0; n < 4; ++n) Bf[n] = *reinterpret_cast<const bf16x8*>(sB + lds_byte2(wc * 64 + n * 16 + fr, ks * 32 + fq * 8));
#pragma unroll
      for (int m = 0; m < 8; ++m)
#pragma unroll
        for (int n = 0; n < 4; ++n) acc[m][n] = __builtin_amdgcn_mfma_f32_16x16x32_bf16(Bf[n], At[m], acc[m][n], 0, 0, 0);
      __builtin_amdgcn_sched_barrier(0);
    }
    WAIT_V(0);
    __syncthreads();
  }
  epi(acc, wr, wc, fr, fq);
}

namespace pg8 {
constexpr int BM = 256, BK = 64, HALF = 128, HTB = HALF * BK * 2;
DI int lds_byte(int r, int c) { const int st = (r >> 4) * 2 + (c >> 5), rr = r & 15, cc = c & 31, ob = rr * 64 + cc * 2; return st * 1024 + (ob ^ (((ob >> 9) & 1) << 5)); }
DI void stage_rc(int b, int& R, int& C) { const int st = b / 1024, sb = b % 1024, swz = sb ^ (((sb >> 9) & 1) << 5); R = (st >> 1) * 16 + swz / 64; C = (st & 1) * 32 + (swz % 64) / 2; }
DI int perm32(int rho) { const int n = rho >> 4, i = rho & 15; return 8 * (i >> 2) + 4 * n + (i & 3); }
struct Unit { int pm, pn; };
typedef __attribute__((address_space(3))) unsigned char lds_u8;
typedef __attribute__((address_space(3))) unsigned lds_u32;
typedef __attribute__((address_space(3))) bf16x8 lds_bf16x8;
typedef __attribute__((address_space(3))) i32x4 lds_i32x4;

template <class Cfg>
DI void gemm_phase(lds_u8* lds, const Cfg& S) {
  const int tid = otid(), wid = __builtin_amdgcn_readfirstlane(tid >> 6), lane = tid & 63, wr = wid >> 2, wc = wid & 3, fr = lane & 15, fq = lane >> 4;
  const int K = S.K, nt = K / BK;
  int R0, C0, R1, C1;
  stage_rc(tid * 16, R0, C0);
  stage_rc(tid * 16 + 8192, R1, C1);
  unsigned voffB[2];
  {
    const int Rb0 = Cfg::PERM ? ((R0 & ~31) + perm32(R0 & 31)) : R0, Rb1 = Cfg::PERM ? ((R1 & ~31) + perm32(R1 & 31)) : R1;
    voffB[0] = (unsigned)(Rb0 * K + C0) * 2u; voffB[1] = (unsigned)(Rb1 * K + C1) * 2u;
  }
  const size_t kstep = (size_t)(BK * 2);
  const size_t hstep = (size_t)HALF * K * 2;
  const unsigned ldsw = (unsigned)wid * 1024u;
  const int aoff = lds_byte(wr * 64 + fr, fq * 8), boff = lds_byte(wc * 32 + fr, fq * 8);
#define PG8_SA(b, h) (((b) * 2 + (h)) * HTB)
#define PG8_SB(b, h) ((4 + (b) * 2 + (h)) * HTB)
#define PG8_STAGE2(bufoff, gbase, o0, o1) do { \
    __builtin_amdgcn_global_load_lds((const unsigned*)((const char*)(gbase) + (o0)), (lds_u32*)(lds + (bufoff) + ldsw), 16, 0, 0); \
    __builtin_amdgcn_global_load_lds((const unsigned*)((const char*)(gbase) + (o1)), (lds_u32*)(lds + (bufoff) + ldsw + 8192), 16, 0, 0); } while (0)
#define PG8_STAGEB(bufoff, gbase) PG8_STAGE2(bufoff, gbase, voffB[0], voffB[1])
#define PG8_LDA(dst, b, h) do { _Pragma("unroll") for (int m = 0; m < 4; ++m) _Pragma("unroll") for (int k = 0; k < 2; ++k) dst[m][k] = *(const lds_bf16x8*)(lds + PG8_SA(b, h) + aoff + m * 2048 + k * 1024); } while (0)
#define PG8_LDB(dst, b, h) do { _Pragma("unroll") for (int n = 0; n < 2; ++n) _Pragma("unroll") for (int k = 0; k < 2; ++k) dst[n][k] = *(const lds_bf16x8*)(lds + PG8_SB(b, h) + boff + n * 2048 + k * 1024); } while (0)
#define PG8_MMA(ai, bj, At, Bt) do { __builtin_amdgcn_s_setprio(1); _Pragma("unroll") for (int m = 0; m < 4; ++m) _Pragma("unroll") for (int n = 0; n < 2; ++n) _Pragma("unroll") for (int k = 0; k < 2; ++k) \
    acc[ai][bj][m][n] = __builtin_amdgcn_mfma_f32_16x16x32_bf16(Bt[n][k], At[m][k], acc[ai][bj][m][n], 0, 0, 0); __builtin_amdgcn_s_setprio(0); } while (0)
#define PG8_WAIT_V(n) asm volatile("s_waitcnt vmcnt(" #n ")" ::: "memory")
#define PG8_WAIT_L(n) asm volatile("s_waitcnt lgkmcnt(" #n ")" ::: "memory")
#define PG8_BAR __builtin_amdgcn_s_barrier()
#define PG8_SCHED __builtin_amdgcn_sched_barrier(0)
  Unit cur, nxt; int ui = 0;
  if (!S.next(0, cur)) return;
  f32x4 acc[2][2][4][2];
#pragma unroll
  for (int a = 0; a < 2; ++a)
#pragma unroll
    for (int b = 0; b < 2; ++b)
#pragma unroll
      for (int m = 0; m < 4; ++m)
#pragma unroll
        for (int n = 0; n < 2; ++n) acc[a][b][m][n] = f32x4{0.f, 0.f, 0.f, 0.f};
  bf16x8 At[4][2], B0[2][2], B1[2][2];
  const char* cA = S.a_base(cur);
  const char* cB = S.b_base(cur);
  unsigned vc[4], vn[4];
  S.a_off(cur, R0, C0, R1, C1, vc);
  PG8_STAGEB(PG8_SB(0, 0), cB); PG8_STAGE2(PG8_SA(0, 0), cA, vc[0], vc[1]); PG8_STAGEB(PG8_SB(0, 1), cB + hstep); PG8_STAGE2(PG8_SA(0, 1), cA, vc[2], vc[3]);
  if (wr == 1) PG8_BAR;
  PG8_WAIT_V(4); PG8_BAR;
  PG8_STAGEB(PG8_SB(1, 0), cB + kstep); PG8_STAGE2(PG8_SA(1, 0), cA + kstep, vc[0], vc[1]); PG8_STAGEB(PG8_SB(1, 1), cB + hstep + kstep);
  PG8_WAIT_V(6); PG8_BAR;
  for (;;) {
    const bool has_next = S.next(ui + 1, nxt);
    const char* nA = has_next ? S.a_base(nxt) : cA;
    const char* nB = has_next ? S.b_base(nxt) : cB;
    if (has_next) S.a_off(nxt, R0, C0, R1, C1, vn);
    else { vn[0] = vc[0]; vn[1] = vc[1]; vn[2] = vc[2]; vn[3] = vc[3]; }
    for (int t = 0; t < nt; t += 2) {
      const bool last = (t == nt - 2);
      const char* a1 = cA + (size_t)(t + 1) * kstep;
      const char* a2 = last ? nA : cA + (size_t)(t + 2) * kstep;
      const char* b2 = last ? nB : cB + (size_t)(t + 2) * kstep;
      const char* a3 = a2 + kstep;
      const char* b3 = b2 + kstep;
      const unsigned w0 = last ? vn[0] : vc[0], w1 = last ? vn[1] : vc[1], w2 = last ? vn[2] : vc[2], w3 = last ? vn[3] : vc[3];
      PG8_LDB(B0, 0, 0); PG8_SCHED; PG8_LDA(At, 0, 0); PG8_STAGE2(PG8_SA(1, 1), a1, vc[2], vc[3]);
      PG8_WAIT_L(8); PG8_BAR; PG8_WAIT_L(0); PG8_MMA(0, 0, At, B0); PG8_BAR; PG8_SCHED;
      PG8_LDB(B1, 0, 1); PG8_STAGEB(PG8_SB(0, 0), b2);
      PG8_BAR; PG8_WAIT_L(0); PG8_MMA(0, 1, At, B1); PG8_BAR;
      PG8_LDA(At, 0, 1); PG8_STAGE2(PG8_SA(0, 0), a2, w0, w1);
      PG8_BAR; PG8_WAIT_L(0); PG8_MMA(1, 0, At, B0); PG8_BAR; PG8_SCHED;
      PG8_STAGEB(PG8_SB(0, 1), b2 + hstep);
      PG8_WAIT_V(6); PG8_BAR; PG8_MMA(1, 1, At, B1); PG8_BAR;
      PG8_LDB(B0, 1, 0); PG8_SCHED; PG8_LDA(At, 1, 0); PG8_STAGE2(PG8_SA(0, 1), a2, w2, w3);
      PG8_WAIT_L(8); PG8_BAR; PG8_WAIT_L(0); PG8_MMA(0, 0, At, B0); PG8_BAR; PG8_SCHED;
      PG8_LDB(B1, 1, 1); PG8_STAGEB(PG8_SB(1, 0), b3);
      PG8_BAR; PG8_WAIT_L(0); PG8_MMA(0, 1, At, B1); PG8_BAR;
      PG8_LDA(At, 1, 1); PG8_STAGE2(PG8_SA(1, 0), a3, w0, w1);
      PG8_BAR; PG8_WAIT_L(0); PG8_MMA(1, 0, At, B0); PG8_BAR; PG8_SCHED;
      PG8_STAGEB(PG8_SB(1, 1), b3 + hstep);
      PG8_WAIT_V(6); PG8_BAR; PG8_MMA(1, 1, At, B1); PG8_BAR;
    }
    S.epi(acc, cur, wr, wc, fr, fq);
    if (!has_next) break;
#pragma unroll
    for (int a = 0; a < 2; ++a)
#pragma unroll
      for (int b = 0; b < 2; ++b)
#pragma unroll
        for (int m = 0; m < 4; ++m)
#pragma unroll
          for (int n = 0; n < 2; ++n) acc[a][b][m][n] = f32x4{0.f, 0.f, 0.f, 0.f};
    cur = nxt; cA = nA; cB = nB; ++ui;
    vc[0] = vn[0]; vc[1] = vn[1]; vc[2] = vn[2]; vc[3] = vn[3];
  }
  PG8_WAIT_V(0);
  if (wr == 0) PG8_BAR;
  PG8_BAR;
#undef PG8_SA
#undef PG8_SB
#undef PG8_STAGE2
#undef PG8_STAGEB
#undef PG8_LDA
#undef PG8_LDB
#undef PG8_MMA
#undef PG8_WAIT_V
#undef PG8_WAIT_L
#undef PG8_BAR
#undef PG8_SCHED
}
template <class Cfg>
DI void gemm_phase_f8(lds_u8* lds, const Cfg& S) {
  const int tid = otid(), wid = __builtin_amdgcn_readfirstlane(tid >> 6), lane = tid & 63, wr = wid >> 2, wc = wid & 3, fr = lane & 15, fq = lane >> 4;
  const int K = S.K, nt = K / BK;
  int R0, C0, R1, C1;
  stage_rc(tid * 16, R0, C0);
  stage_rc(tid * 16 + 8192, R1, C1);
  unsigned voffB[2];
  {
    const int Rb0 = Cfg::PERM ? ((R0 & ~31) + perm32(R0 & 31)) : R0, Rb1 = Cfg::PERM ? ((R1 & ~31) + perm32(R1 & 31)) : R1;
    voffB[0] = (unsigned)(Rb0 * K + C0) * 2u; voffB[1] = (unsigned)(Rb1 * K + C1) * 2u;
  }
  const size_t kstep = (size_t)(BK * 2);
  const size_t hstep = (size_t)HALF * K * 2;
  const unsigned ldsw = (unsigned)wid * 1024u;
  const int aoffL = lds_byte(wr * 64 + fr, 2 * fq * 8), boffL = lds_byte(wc * 32 + fr, 2 * fq * 8);
#define PG8_SA(b, h) (((b) * 2 + (h)) * HTB)
#define PG8_SB(b, h) ((4 + (b) * 2 + (h)) * HTB)
#define PG8_STAGE2(bufoff, gbase, o0, o1) do { \
    __builtin_amdgcn_global_load_lds((const unsigned*)((const char*)(gbase) + (o0)), (lds_u32*)(lds + (bufoff) + ldsw), 16, 0, 0); \
    __builtin_amdgcn_global_load_lds((const unsigned*)((const char*)(gbase) + (o1)), (lds_u32*)(lds + (bufoff) + ldsw + 8192), 16, 0, 0); } while (0)
#define PG8_STAGEB(bufoff, gbase) PG8_STAGE2(bufoff, gbase, voffB[0], voffB[1])
#define PG8_LDA(dst, b, h) do { _Pragma("unroll") for (int m = 0; m < 4; ++m) { const i32x4 lo_ = *(const lds_i32x4*)(lds + PG8_SA(b, h) + aoffL + m * 2048), hi_ = *(const lds_i32x4*)(lds + PG8_SA(b, h) + aoffL + m * 2048 + 16); dst[m] = __builtin_shufflevector(lo_, hi_, 0, 1, 2, 3, 4, 5, 6, 7); } } while (0)
#define PG8_LDB(dst, b, h) do { _Pragma("unroll") for (int n = 0; n < 2; ++n) { const i32x4 lo_ = *(const lds_i32x4*)(lds + PG8_SB(b, h) + boffL + n * 2048), hi_ = *(const lds_i32x4*)(lds + PG8_SB(b, h) + boffL + n * 2048 + 16); dst[n] = __builtin_shufflevector(lo_, hi_, 0, 1, 2, 3, 4, 5, 6, 7); } } while (0)
#define PG8_MMA(ai, bj, At, Bt) do { __builtin_amdgcn_s_setprio(1); _Pragma("unroll") for (int m = 0; m < 4; ++m) _Pragma("unroll") for (int n = 0; n < 2; ++n) \
    asm volatile("v_mfma_f32_16x16x128_f8f6f4 %0, %1, %2, %0" : "+v"(acc[ai][bj][m][n]) : "v"(Bt[n]), "v"(At[m])); __builtin_amdgcn_s_setprio(0); } while (0)
#define PG8_WAIT_V(n) asm volatile("s_waitcnt vmcnt(" #n ")" ::: "memory")
#define PG8_WAIT_L(n) asm volatile("s_waitcnt lgkmcnt(" #n ")" ::: "memory")
#define PG8_BAR __builtin_amdgcn_s_barrier()
#define PG8_SCHED __builtin_amdgcn_sched_barrier(0)
  Unit cur, nxt; int ui = 0;
  if (!S.next(0, cur)) return;
  f32x4 acc[2][2][4][2];
#pragma unroll
  for (int a = 0; a < 2; ++a)
#pragma unroll
    for (int b = 0; b < 2; ++b)
#pragma unroll
      for (int m = 0; m < 4; ++m)
#pragma unroll
        for (int n = 0; n < 2; ++n) acc[a][b][m][n] = f32x4{0.f, 0.f, 0.f, 0.f};
  i32x8 At[4], B0[2], B1[2];
  const char* cA = S.a_base(cur);
  const char* cB = S.b_base(cur);
  unsigned vc[4], vn[4];
  S.a_off(cur, R0, C0, R1, C1, vc);
  PG8_STAGEB(PG8_SB(0, 0), cB); PG8_STAGE2(PG8_SA(0, 0), cA, vc[0], vc[1]); PG8_STAGEB(PG8_SB(0, 1), cB + hstep); PG8_STAGE2(PG8_SA(0, 1), cA, vc[2], vc[3]);
  if (wr == 1) PG8_BAR;
  PG8_WAIT_V(4); PG8_BAR;
  PG8_STAGEB(PG8_SB(1, 0), cB + kstep); PG8_STAGE2(PG8_SA(1, 0), cA + kstep, vc[0], vc[1]); PG8_STAGEB(PG8_SB(1, 1), cB + hstep + kstep);
  PG8_WAIT_V(6); PG8_BAR;
  for (;;) {
    const bool has_next = S.next(ui + 1, nxt);
    const char* nA = has_next ? S.a_base(nxt) : cA;
    const char* nB = has_next ? S.b_base(nxt) : cB;
    if (has_next) S.a_off(nxt, R0, C0, R1, C1, vn);
    else { vn[0] = vc[0]; vn[1] = vc[1]; vn[2] = vc[2]; vn[3] = vc[3]; }
    for (int t = 0; t < nt; t += 2) {
      const bool last = (t == nt - 2);
      const char* a1 = cA + (size_t)(t + 1) * kstep;
      const char* a2 = last ? nA : cA + (size_t)(t + 2) * kstep;
      const char* b2 = last ? nB : cB + (size_t)(t + 2) * kstep;
      const char* a3 = a2 + kstep;
      const char* b3 = b2 + kstep;
      const unsigned w0 = last ? vn[0] : vc[0], w1 = last ? vn[1] : vc[1], w2 = last ? vn[2] : vc[2], w3 = last ? vn[3] : vc[3];
      PG8_LDB(B0, 0, 0); PG8_SCHED; PG8_LDA(At, 0, 0); PG8_STAGE2(PG8_SA(1, 1), a1, vc[2], vc[3]);
      PG8_WAIT_L(8); PG8_BAR; PG8_WAIT_L(0); PG8_MMA(0, 0, At, B0); PG8_BAR; PG8_SCHED;
      PG8_LDB(B1, 0, 1); PG8_STAGEB(PG8_SB(0, 0), b2);
      PG8_BAR; PG8_WAIT_L(0); PG8_MMA(0, 1, At, B1); PG8_BAR;
      PG8_LDA(At, 0, 1); PG8_STAGE2(PG8_SA(0, 0), a2, w0, w1);
      PG8_BAR; PG8_WAIT_L(0); PG8_MMA(1, 0, At, B0); PG8_BAR; PG8_SCHED;
      PG8_STAGEB(PG8_SB(0, 1), b2 + hstep);
      PG8_WAIT_V(6); PG8_BAR; PG8_MMA(1, 1, At, B1); PG8_BAR;
      PG8_LDB(B0, 1, 0); PG8_SCHED; PG8_LDA(At, 1, 0); PG8_STAGE2(PG8_SA(0, 1), a2, w2, w3);
      PG8_WAIT_L(8); PG8_BAR; PG8_WAIT_L(0); PG8_MMA(0, 0, At, B0); PG8_BAR; PG8_SCHED;
      PG8_LDB(B1, 1, 1); PG8_STAGEB(PG8_SB(1, 0), b3);
      PG8_BAR; PG8_WAIT_L(0); PG8_MMA(0, 1, At, B1); PG8_BAR;
      PG8_LDA(At, 1, 1); PG8_STAGE2(PG8_SA(1, 0), a3, w0, w1);
      PG8_BAR; PG8_WAIT_L(0); PG8_MMA(1, 0, At, B0); PG8_BAR; PG8_SCHED;
      PG8_STAGEB(PG8_SB(1, 1), b3 + hstep);
      PG8_WAIT_V(6); PG8_BAR; PG8_MMA(1, 1, At, B1); PG8_BAR;
    }
    asm volatile("s_nop 15\n\ts_nop 15" ::: "memory");
    S.epi(acc, cur, wr, wc, fr, fq);
    if (!has_next) break;
#pragma unroll
    for (int a = 0; a < 2; ++a)
#pragma unroll
      for (int b = 0; b < 2; ++b)
#pragma unroll
        for (int m = 0; m < 4; ++m)
#pragma unroll
          for (int n = 0; n < 2; ++n) acc[a][b][m][n] = f32x4{0.f, 0.f, 0.f, 0.f};
    cur = nxt; cA = nA; cB = nB; ++ui;
    vc[0] = vn[0]; vc[1] = vn[1]; vc[2] = vn[2]; vc[3] = vn[3];
  }
  PG8_WAIT_V(0);
  if (wr == 0) PG8_BAR;
  PG8_BAR;
#undef PG8_SA
#undef PG8_SB
#undef PG8_STAGE2
#undef PG8_STAGEB
#undef PG8_LDA
#undef PG8_LDB
#undef PG8_MMA
#undef PG8_WAIT_V
#undef PG8_WAIT_L
#undef PG8_BAR
#undef PG8_SCHED
}
}

struct CfgInproj {
  static constexpr bool PERM = true;
  int K; const Params* p; int L; int bid, nb;
  DI bool next(int i, pg8::Unit& u) const { const int t = i * nb + bid; if (t >= 64 * 13) return false; u.pm = t & 63; u.pn = t >> 6; return true; }
  DI const char* a_base(const pg8::Unit& u) const { return (const char*)(p->hn() + (size_t)u.pm * 256 * DM); }
  DI const char* b_base(const pg8::Unit& u) const { return (const char*)(p->WinT() + ((size_t)L * PWP + (size_t)u.pn * 256) * DM); }
  DI void a_off(const pg8::Unit&, int R0, int C0, int R1, int C1, unsigned (&vo)[4]) const {
    vo[0] = (unsigned)(R0 * DM + C0) * 2u; vo[1] = (unsigned)(R1 * DM + C1) * 2u;
    vo[2] = vo[0] + 128u * DM * 2u; vo[3] = vo[1] + 128u * DM * 2u;
  }
  DI void epi(const f32x4 (&acc)[2][2][4][2], const pg8::Unit& u, int wr, int wc, int fr, int fq) const {
    const int row0 = u.pm * 256 + wr * 64 + fr, col0 = u.pn * 256 + wc * 32 + 8 * fq;
#pragma unroll
    for (int ai = 0; ai < 2; ++ai)
#pragma unroll
      for (int m = 0; m < 4; ++m) {
        u16* rowp = p->proj() + (size_t)(row0 + ai * 128 + m * 16) * PWP + col0;
#pragma unroll
        for (int bj = 0; bj < 2; ++bj) {
          uint4 w;
          w.x = pack2(acc[ai][bj][m][0][0], acc[ai][bj][m][0][1]); w.y = pack2(acc[ai][bj][m][0][2], acc[ai][bj][m][0][3]);
          w.z = pack2(acc[ai][bj][m][1][0], acc[ai][bj][m][1][1]); w.w = pack2(acc[ai][bj][m][1][2], acc[ai][bj][m][1][3]);
          *reinterpret_cast<uint4*>(rowp + bj * 128) = w;
        }
      }
  }
};
DI void ph_inproj_tail(const Params& p, int L, char* smem, int t) {
  const int m0 = (t & 63) * 256, n0 = 3072 + (t >> 6) * 128;
  const u16* Bt = p.WinT() + ((size_t)L * PWP + n0) * DM;
  gemm_tile([&](int r) { return p.hn() + (size_t)(m0 + r) * DM; }, Bt, DM, DM, smem,
            [&](f32x4 (&acc)[4][4], int wr, int wc, int fr, int fq) {
#pragma unroll
              for (int m = 0; m < 4; ++m)
#pragma unroll
                for (int n = 0; n < 4; ++n)
#pragma unroll
                  for (int j = 0; j < 4; ++j)
                    p.proj()[(size_t)(m0 + wr * 64 + m * 16 + fq * 4 + j) * PWP + n0 + wc * 64 + n * 16 + fr] = f2bf(acc[m][n][j]);
            });
}
DI void ph_inproj(const Params& p, int L, char* smem) {
  CfgInproj c; c.K = DM; c.p = &p; c.L = L; c.bid = obid(); c.nb = gridDim.x;
  pg8::gemm_phase((pg8::lds_u8*)smem, c);
}

DI void ph_gemm_store_bf16(const u16* A, int lda, const u16* Bt, int K, int M, int N, u16* C, int ldc, char* smem, int rot) {
  const int mt = M / 256, nt = N / 128;
  const int nb = gridDim.x;
  for (int t = (obid() + rot) % nb; t < mt * nt; t += nb) {
    const int m0 = (t % mt) * 256, n0 = (t / mt) * 128;
    gemm_tile([&](int r) { return A + (size_t)(m0 + r) * lda; }, Bt + (size_t)n0 * K, K, K, smem,
              [&](f32x4 (&acc)[4][4], int wr, int wc, int fr, int fq) {
#pragma unroll
                for (int m = 0; m < 4; ++m)
#pragma unroll
                  for (int n = 0; n < 4; ++n)
#pragma unroll
                    for (int j = 0; j < 4; ++j) {
                      const int row = m0 + wr * 64 + m * 16 + fq * 4 + j, col = n0 + wc * 64 + n * 16 + fr;
                      C[(size_t)row * ldc + col] = f2bf(acc[m][n][j]);
                    }
              });
  }
}

DI void ph_rmsnorm_bf16(const float* __restrict__ xin, const float* __restrict__ w, u16* __restrict__ outp) {
  const int tid_ = otid(); const int lane = tid_ & 63, gw = (obid() * NTHR + tid_) >> 6, nw = gridDim.x * (NTHR / 64);
  for (int t = gw; t < T; t += nw) {
    const float* xr = xin + (size_t)t * DM;
    float4 v[4];
    float ss = 0.f;
#pragma unroll
    for (int i = 0; i < 4; ++i) {
      v[i] = *reinterpret_cast<const float4*>(xr + (i * 64 + lane) * 4);
      ss += v[i].x * v[i].x + v[i].y * v[i].y + v[i].z * v[i].z + v[i].w * v[i].w;
    }
    ss = wave_sum(ss);
    const float rstd = rsqrtf(ss * (1.f / DM) + 1e-6f);
#pragma unroll
    for (int i = 0; i < 4; ++i) {
      const int c = (i * 64 + lane) * 4;
      const float4 ww = *reinterpret_cast<const float4*>(w + c);
      uint2 o;
      o.x = pack2(v[i].x * rstd * ww.x, v[i].y * rstd * ww.y);
      o.y = pack2(v[i].z * rstd * ww.z, v[i].w * rstd * ww.w);
      *reinterpret_cast<uint2*>(outp + (size_t)t * DM + c) = o;
    }
  }
}

DI void ph_final_norm(const float* __restrict__ xin, const float* __restrict__ w, float* __restrict__ outp) {
  const int tid_ = otid(); const int lane = tid_ & 63, gw = (obid() * NTHR + tid_) >> 6, nw = gridDim.x * (NTHR / 64);
  for (int t = gw; t < T; t += nw) {
    const float* xr = xin + (size_t)t * DM;
    float4 v[4];
    float ss = 0.f;
#pragma unroll
    for (int i = 0; i < 4; ++i) {
      v[i] = *reinterpret_cast<const float4*>(xr + (i * 64 + lane) * 4);
      ss += v[i].x * v[i].x + v[i].y * v[i].y + v[i].z * v[i].z + v[i].w * v[i].w;
    }
    ss = wave_sum(ss);
    const float rstd = rsqrtf(ss * (1.f / DM) + 1e-6f);
#pragma unroll
    for (int i = 0; i < 4; ++i) {
      const int c = (i * 64 + lane) * 4;
      const float4 ww = *reinterpret_cast<const float4*>(w + c);
      float4 o = make_float4(v[i].x * rstd * ww.x, v[i].y * rstd * ww.y, v[i].z * rstd * ww.z, v[i].w * rstd * ww.w);
      *reinterpret_cast<float4*>(outp + (size_t)t * DM + c) = o;
    }
  }
}

DI void rot8(const u16* x1p, const u16* x2p, const float* tab  , float scale, uint4& o1, uint4& o2) {
  float x1[8], x2[8], y1[8], y2[8];
  ld8(x1p, x1); ld8(x2p, x2);
#pragma unroll
  for (int e = 0; e < 8; e += 2) {
    const float4 cs = *reinterpret_cast<const float4*>(tab + e * 2);
    y1[e] = (x1[e] * cs.x - x2[e] * cs.y) * scale;
    y2[e] = (x2[e] * cs.x + x1[e] * cs.y) * scale;
    y1[e + 1] = (x1[e + 1] * cs.z - x2[e + 1] * cs.w) * scale;
    y2[e + 1] = (x2[e + 1] * cs.z + x1[e + 1] * cs.w) * scale;
  }
  o1.x = pack2(y1[0], y1[1]); o1.y = pack2(y1[2], y1[3]); o1.z = pack2(y1[4], y1[5]); o1.w = pack2(y1[6], y1[7]);
  o2.x = pack2(y2[0], y2[1]); o2.y = pack2(y2[2], y2[3]); o2.z = pack2(y2[4], y2[5]); o2.w = pack2(y2[6], y2[7]);
}
DI void ph_post(const Params& p, int L) {
  const int tid = otid();
  const int gt = obid() * NTHR + tid, gs = gridDim.x * NTHR;
  const int lane = tid & 63, gw = gt >> 6, nw = gs >> 6;
  const float* qnw = p.q_norm_w + L * 256;
  const float* kvnw = p.kv_norm_w + L * 128;
  const float* cw = p.conv_w + L * 5 * 768;
  const float* cb = p.conv_b + L * 768;
  const float* dtb = p.dt_bias + L * 8;
  for (int idx = gt; idx < T * 96; idx += gs) {
    const int t = idx / 96, cg = idx - t * 96, s = t & (SEQ - 1);
    float acc[8];
    {
      const float4 b0 = *reinterpret_cast<const float4*>(cb + cg * 8), b1 = *reinterpret_cast<const float4*>(cb + cg * 8 + 4);
      acc[0] = b0.x; acc[1] = b0.y; acc[2] = b0.z; acc[3] = b0.w; acc[4] = b1.x; acc[5] = b1.y; acc[6] = b1.z; acc[7] = b1.w;
    }
#pragma unroll
    for (int w = 0; w < 5; ++w) {
      const int ss = s + w - 2;
      if (ss >= 0 && ss < SEQ) {
        float xv[8];
        ld8(p.proj() + (size_t)(t + w - 2) * PWP + C_XBC + cg * 8, xv);
        const float4 w0 = *reinterpret_cast<const float4*>(cw + w * 768 + cg * 8), w1 = *reinterpret_cast<const float4*>(cw + w * 768 + cg * 8 + 4);
        acc[0] += xv[0] * w0.x; acc[1] += xv[1] * w0.y; acc[2] += xv[2] * w0.z; acc[3] += xv[3] * w0.w;
        acc[4] += xv[4] * w1.x; acc[5] += xv[5] * w1.y; acc[6] += xv[6] * w1.z; acc[7] += xv[7] * w1.w;
      }
    }
    uint4 o;
    o.x = pack2(fast_silu(acc[0]), fast_silu(acc[1])); o.y = pack2(fast_silu(acc[2]), fast_silu(acc[3]));
    o.z = pack2(fast_silu(acc[4]), fast_silu(acc[5])); o.w = pack2(fast_silu(acc[6]), fast_silu(acc[7]));
    *reinterpret_cast<uint4*>(p.xbc() + (size_t)t * 768 + cg * 8) = o;
  }
  for (int idx = gt; idx < T * 8; idx += gs) {
    const int t = idx >> 3, k = idx & 7;
    const float v = bf2f(p.proj()[(size_t)t * PWP + C_DT + k]) + dtb[k];
    p.dtv()[idx] = (v > 20.f) ? v : log1pf(expf(v));
  }
  {
    const int sub = lane >> 4, l16 = lane & 15;
    for (int t = gw * 4 + sub; t < T; t += nw * 4) {
      const u16* pr = p.proj() + (size_t)t * PWP;
      float v[16], u[8];
      ld8(pr + C_CQ + l16 * 16, v); ld8(pr + C_CQ + l16 * 16 + 8, v + 8);
      ld8(pr + C_CKV + l16 * 8, u);
      float ss = 0.f, s2 = 0.f;
#pragma unroll
      for (int i = 0; i < 16; ++i) ss += v[i] * v[i];
#pragma unroll
      for (int i = 0; i < 8; ++i) s2 += u[i] * u[i];
#pragma unroll
      for (int o = 1; o < 16; o <<= 1) { ss += __shfl_xor(ss, o); s2 += __shfl_xor(s2, o); }
      const float rstd = rsqrtf(ss * (1.f / 256.f) + 1e-6f), r2 = rsqrtf(s2 * (1.f / 128.f) + 1e-6f);
      uint4 o;
      const float* qw = qnw + l16 * 16;
      o.x = pack2(v[0] * rstd * qw[0], v[1] * rstd * qw[1]); o.y = pack2(v[2] * rstd * qw[2], v[3] * rstd * qw[3]);
      o.z = pack2(v[4] * rstd * qw[4], v[5] * rstd * qw[5]); o.w = pack2(v[6] * rstd * qw[6], v[7] * rstd * qw[7]);
      *reinterpret_cast<uint4*>(p.cqn() + (size_t)t * 256 + l16 * 16) = o;
      o.x = pack2(v[8] * rstd * qw[8], v[9] * rstd * qw[9]); o.y = pack2(v[10] * rstd * qw[10], v[11] * rstd * qw[11]);
      o.z = pack2(v[12] * rstd * qw[12], v[13] * rstd * qw[13]); o.w = pack2(v[14] * rstd * qw[14], v[15] * rstd * qw[15]);
      *reinterpret_cast<uint4*>(p.cqn() + (size_t)t * 256 + l16 * 16 + 8) = o;
      const float* kw = kvnw + l16 * 8;
      o.x = pack2(u[0] * r2 * kw[0], u[1] * r2 * kw[1]); o.y = pack2(u[2] * r2 * kw[2], u[3] * r2 * kw[3]);
      o.z = pack2(u[4] * r2 * kw[4], u[5] * r2 * kw[5]); o.w = pack2(u[6] * r2 * kw[6], u[7] * r2 * kw[7]);
      *reinterpret_cast<uint4*>(p.ckvn() + (size_t)t * 128 + l16 * 8) = o;
    }
  }
  for (int idx = gt; idx < T * 42; idx += gs) {
    const int t = idx / 42, ri = idx - t * 42, s = t & (SEQ - 1);
    u16* pr = p.proj() + (size_t)t * PWP;
    uint4 o1, o2;
    if (ri < 32) {
      const int isk = ri >> 4, h = (ri >> 2) & 3, i0 = (ri & 3) * 8;
      u16* a = pr + (isk ? C_RK : C_RQ) + h * 64 + i0;
      rot8(a, a + 32, p.rtab() + ((size_t)s * 56 + i0) * 2, isk ? 1.f : 0.125f, o1, o2);
      *reinterpret_cast<uint4*>(a) = o1;
      *reinterpret_cast<uint4*>(a + 32) = o2;
    } else if (ri < 40) {
      const int j = ri - 32, isk = j >> 2, h = j & 3;
      u16* a = pr + (isk ? C_DK : C_DQ) + h * 64;
      rot8(a, a + 8, p.rtab() + ((size_t)s * 56 + 32) * 2, 1.f, o1, o2);
      *reinterpret_cast<uint4*>(a) = o1;
      *reinterpret_cast<uint4*>(a + 8) = o2;
    } else {
      const int i0 = (ri - 40) * 8;
      u16* a = pr + C_KR + i0;
      rot8(a, a + 16, p.rtab() + ((size_t)s * 56 + 40 + i0) * 2, 1.f, o1, o2);
      *reinterpret_cast<uint4*>(a) = o1;
      *reinterpret_cast<uint4*>(a + 16) = o2;
      const int bb = t >> 12;
#pragma unroll
      for (int hd = 0; hd < 4; ++hd) {
        u16* kf = p.kfull() + ((size_t)(bb * 4 + hd) * SEQ + s) * 96 + 64 + i0;
        *reinterpret_cast<uint4*>(kf) = o1;
        *reinterpret_cast<uint4*>(kf + 16) = o2;
      }
    }
  }
}

DI void ph_mla_up_q(const Params& p, int L, char* smem, int t) {
  const int mt = T / 256;
  const u16* Bq = p.WuqT() + (size_t)L * 384 * 256;
  {
    const int m0 = (t % mt) * 256, n0 = (t / mt) * 128;
    gemm_tile([&](int r) { return p.cqn() + (size_t)(m0 + r) * 256; }, Bq + (size_t)n0 * 256, 256, 256, smem,
              [&](f32x4 (&acc)[4][4], int wr, int wc, int fr, int fq) {
                const float scale = 0.10206207261596575f * 1.4426950408889634f;
#pragma unroll
                for (int m = 0; m < 4; ++m)
#pragma unroll
                  for (int j = 0; j < 4; ++j) {
                    const int row = m0 + wr * 64 + m * 16 + fq * 4 + j;
                    const float2 cssn = *reinterpret_cast<const float2*>(p.rtab() + ((size_t)(row & (SEQ - 1)) * 56 + 40 + fr) * 2);
                    const float cs = cssn.x, sn = cssn.y;
#pragma unroll
                    for (int n2 = 0; n2 < 4; n2 += 2) {
                      const int cb = n0 + wc * 64 + n2 * 16;
                      float x1 = acc[m][n2][j], x2 = acc[m][n2 + 1][j];
                      if (cb % 96 == 64) {
                        const float y1 = x1 * cs - x2 * sn, y2 = x2 * cs + x1 * sn;
                        x1 = y1; x2 = y2;
                      }
                      p.mq()[(size_t)row * 384 + cb + fr] = f2bf(x1 * scale);
                      p.mq()[(size_t)row * 384 + cb + 16 + fr] = f2bf(x2 * scale);
                    }
                  }
              });
  }
}
DI void ph_mla_up_kv(const Params& p, int L, char* smem, int t) {
  const int mt = T / 256;
  const u16* Bkv = p.WukvT() + (size_t)L * 512 * 128;
  {
    const int m0 = (t % mt) * 256, h = t / mt, n0 = h * 128;
    gemm_tile([&](int r) { return p.ckvn() + (size_t)(m0 + r) * 128; }, Bkv + (size_t)n0 * 128, 128, 128, smem,
              [&](f32x4 (&acc)[4][4], int wr, int wc, int fr, int fq) {
#pragma unroll
                for (int m = 0; m < 4; ++m) {
                  const int row = m0 + wr * 64 + m * 16 + fq * 4;
                  const int bb = row >> 12, sq = row & (SEQ - 1);
                  const size_t bh = (size_t)(bb * 4 + h);
#pragma unroll
                  for (int n = 0; n < 4; ++n) {
                    if (wc == 0) {
#pragma unroll
                      for (int j = 0; j < 4; ++j) p.kfull()[(bh * SEQ + sq + j) * 96 + n * 16 + fr] = f2bf(acc[m][n][j]);
                    } else {
                      uint2 v;
                      v.x = pack2(acc[m][n][0], acc[m][n][1]);
                      v.y = pack2(acc[m][n][2], acc[m][n][3]);
                      const int sqp = (sq & ~12) | ((sq & 4) << 1) | ((sq & 8) >> 1);
                      *reinterpret_cast<uint2*>(p.vT() + (bh * 64 + n * 16 + fr) * SEQ + sqp) = v;
                    }
                  }
                }
              });
  }
}

DI void ph_cumsum(const Params& p, int L) {
  const int tid_ = otid(); const int lane = tid_ & 63, gw = (obid() * NTHR + tid_) >> 6, nw = gridDim.x * (NTHR / 64);
  for (int it = gw; it < 32; it += nw) {
    const int h = it & 3, dir = (it >> 2) & 1, b = it >> 3;
    const float a = -expf(p.a_log[L * 8 + dir * 4 + h]);
    float running = 0.f;
    for (int c = 0; c < 64; ++c) {
      const int i = c * 64 + lane;
      const int s = dir ? (SEQ - 1 - i) : i;
      const size_t off = (size_t)(b * SEQ + s) * 8 + dir * 4 + h;
      float v = p.dtv()[off] * a;
#pragma unroll
      for (int o = 1; o < 64; o <<= 1) {
        const float u = __shfl_up(v, o);
        if (lane >= o) v += u;
      }
      v += running;
      p.cs()[off] = v;
      running = __shfl(v, 63);
    }
  }
}

DI void ph_ret_naive(const Params& p) {
  const int gt = obid() * NTHR + otid(), gs = gridDim.x * NTHR;
  for (int it = gt; it < 4 * 4 * SEQ; it += gs) {
    const int n = it & (SEQ - 1), h = (it >> 12) & 3, b = it >> 14;
    const u16* base = p.proj() + (size_t)(b * SEQ) * PWP;
    uint4 qp[8];
    float o[64];
#pragma unroll
    for (int d = 0; d < 8; ++d) qp[d] = *reinterpret_cast<const uint4*>(base + (size_t)n * PWP + C_RQ + h * 64 + d * 8);
#pragma unroll
    for (int d = 0; d < 64; ++d) o[d] = 0.f;
    const float lg0 = log1pf(-exp2f(-5.f - (float)h)), lg1 = log1pf(-exp2f(-5.5f - (float)h));
#pragma unroll 1
    for (int m = 0; m < SEQ; ++m) {
      const u16* kr = base + (size_t)m * PWP + C_RK + h * 64;
      const u16* vr = base + (size_t)m * PWP + C_RV + h * 64;
      float s = 0.f;
#pragma unroll
      for (int d = 0; d < 8; ++d) s = dot8(qp[d], *reinterpret_cast<const uint4*>(kr + d * 8), s);
      const float w = (m <= n) ? expf(lg0 * (float)(n - m)) : expf(lg1 * (float)(m - n));
      s *= w;
#pragma unroll
      for (int d = 0; d < 64; d += 8) {
        float vf[8];
        ld8(vr + d, vf);
#pragma unroll
        for (int j = 0; j < 8; ++j) o[d + j] += s * vf[j];
      }
    }
    float mu = 0.f;
#pragma unroll
    for (int d = 0; d < 64; ++d) mu += o[d];
    mu *= (1.f / 64.f);
    float var = 0.f;
#pragma unroll
    for (int d = 0; d < 64; ++d) var += (o[d] - mu) * (o[d] - mu);
    var *= (1.f / 64.f);
    const float rs = rsqrtf(var + 1e-5f);
    const size_t t = (size_t)b * SEQ + n;
#pragma unroll
    for (int d = 0; d < 64; d += 8) {
      float g[8];
      ld8(p.proj() + t * PWP + C_RG + h * 64 + d, g);
      uint4 ov;
      ov.x = pack2(silu(g[0]) * (o[d + 0] - mu) * rs, silu(g[1]) * (o[d + 1] - mu) * rs);
      ov.y = pack2(silu(g[2]) * (o[d + 2] - mu) * rs, silu(g[3]) * (o[d + 3] - mu) * rs);
      ov.z = pack2(silu(g[4]) * (o[d + 4] - mu) * rs, silu(g[5]) * (o[d + 5] - mu) * rs);
      ov.w = pack2(silu(g[6]) * (o[d + 6] - mu) * rs, silu(g[7]) * (o[d + 7] - mu) * rs);
      *reinterpret_cast<uint4*>(p.mixed() + t * DM + h * 64 + d) = ov;
    }
  }
}

DI void ph_mla_naive(const Params& p) {
  const int gt = obid() * NTHR + otid(), gs = gridDim.x * NTHR;
  for (int it = gt; it < 2 * 4 * 4 * SEQ; it += gs) {
    const int n = it & (SEQ - 1), vh = (it >> 12) & 1, h = (it >> 13) & 3, b = it >> 15;
    const size_t t = (size_t)b * SEQ + n;
    uint4 qp[12];
    float o[32];
#pragma unroll
    for (int d = 0; d < 12; ++d) qp[d] = *reinterpret_cast<const uint4*>(p.mq() + t * 384 + h * 96 + d * 8);
    const size_t tb = (size_t)b * SEQ;
    float mx = -1e30f;
#pragma unroll 1
    for (int m = 0; m < SEQ; ++m) {
      const u16* kn = ((u16*)nullptr) + (tb + m) * 512 + h * 128;
      const u16* kr = p.proj() + (tb + m) * PWP + C_KR;
      float s = 0.f;
#pragma unroll
      for (int d = 0; d < 8; ++d) s = dot8(qp[d], *reinterpret_cast<const uint4*>(kn + d * 8), s);
#pragma unroll
      for (int d = 0; d < 4; ++d) s = dot8(qp[8 + d], *reinterpret_cast<const uint4*>(kr + d * 8), s);
      mx = fmaxf(mx, s);
    }
#pragma unroll
    for (int d = 0; d < 32; ++d) o[d] = 0.f;
    float l = 0.f;
#pragma unroll 1
    for (int m = 0; m < SEQ; ++m) {
      const u16* kn = ((u16*)nullptr) + (tb + m) * 512 + h * 128;
      const u16* kr = p.proj() + (tb + m) * PWP + C_KR;
      float s = 0.f;
#pragma unroll
      for (int d = 0; d < 8; ++d) s = dot8(qp[d], *reinterpret_cast<const uint4*>(kn + d * 8), s);
#pragma unroll
      for (int d = 0; d < 4; ++d) s = dot8(qp[8 + d], *reinterpret_cast<const uint4*>(kr + d * 8), s);
      const float pe = exp2f(s - mx);
      l += pe;
#pragma unroll
      for (int d = 0; d < 32; d += 8) {
        float vf[8];
        ld8(kn + 64 + vh * 32 + d, vf);
#pragma unroll
        for (int j = 0; j < 8; ++j) o[d + j] += pe * vf[j];
      }
    }
    const float il = 1.f / l;
#pragma unroll
    for (int d = 0; d < 32; d += 8) {
      uint4 ov;
      ov.x = pack2(o[d + 0] * il, o[d + 1] * il);
      ov.y = pack2(o[d + 2] * il, o[d + 3] * il);
      ov.z = pack2(o[d + 4] * il, o[d + 5] * il);
      ov.w = pack2(o[d + 6] * il, o[d + 7] * il);
      *reinterpret_cast<uint4*>(p.mixed() + t * DM + 256 + h * 64 + vh * 32 + d) = ov;
    }
  }
}

#define MFMA32(a, b, c) __builtin_amdgcn_mfma_f32_32x32x16_bf16((a), (b), (c), 0, 0, 0)
DI float max16(const f32x16& v) {
  float a = fmaxf(fmaxf(v[0], v[1]), v[2]), b = fmaxf(fmaxf(v[3], v[4]), v[5]), c = fmaxf(fmaxf(v[6], v[7]), v[8]);
  float d = fmaxf(fmaxf(v[9], v[10]), v[11]), e = fmaxf(fmaxf(v[12], v[13]), v[14]);
  return fmaxf(fmaxf(fmaxf(a, b), fmaxf(c, d)), fmaxf(e, v[15]));
}
DI void ph_mla_attn(const Params& p, char* smem) {
  const int tid = otid(), wid = tid >> 6, lane = tid & 63, l32 = lane & 31, hh = lane >> 5;
  u16* sK = reinterpret_cast<u16*>(smem);
  u16* sV = sK + 2 * 128 * 104;
  uint4 konev = make_uint4(hh == 0 ? 0x00003F80u : 0u, 0u, 0u, 0u);
  const bf16x8 kone = __builtin_bit_cast(bf16x8, konev);
  for (int item = obid(); item < 256; item += gridDim.x) {
    const int xcd_ = item & 7, jx_ = item >> 3, bh = xcd_ * 2 + (jx_ >> 4), qt = jx_ & 15, b = bh >> 2, h = bh & 3;
    const size_t t0 = (size_t)b * SEQ + qt * 256 + wid * 32;
    bf16x8 qf[6];
#pragma unroll
    for (int ks = 0; ks < 6; ++ks) qf[ks] = *reinterpret_cast<const bf16x8*>(p.mq() + (t0 + l32) * 384 + h * 96 + ks * 16 + hh * 8);
    const u16* kg = p.kfull() + (size_t)bh * SEQ * 96;
    const u16* vg = p.vT() + (size_t)bh * 64 * SEQ;
    f32x16 o0, o1;
#pragma unroll
    for (int i = 0; i < 16; ++i) { o0[i] = 0.f; o1[i] = 0.f; }
    float m = 0.f, l = 0.f;
    bf16x8 qf6 = __builtin_bit_cast(bf16x8, make_uint4(0u, 0u, 0u, 0u));
    const int kr0 = tid / 12, kc0 = tid % 12, kr1 = (512 + tid) / 12, kc1 = (512 + tid) % 12, kr2 = (1024 + tid) / 12, kc2 = (1024 + tid) % 12;
    const int vd0 = tid >> 4, vd1 = 32 + (tid >> 4), vkc = (tid & 15) * 8;
    uint4 ak0, ak1, ak2, av0, av1;
#define MLA_LD(dst_, ptr_) asm volatile("global_load_dwordx4 %0, %1, off" : "=v"(dst_) : "v"(ptr_) : "memory")
#define MLA_GLOAD(K0, K1, K2, V0, V1, kt_)                                               \
    {                                                                                    \
      const u16* kb_ = kg + (size_t)(kt_) * 128 * 96 + tid * 8;                          \
      MLA_LD(K0, kb_); MLA_LD(K1, kb_ + 512 * 8); MLA_LD(K2, kb_ + 1024 * 8);            \
      const u16* vp_ = vg + (size_t)vd0 * SEQ + (kt_) * 128 + vkc;                       \
      MLA_LD(V0, vp_); MLA_LD(V1, vp_ + (size_t)32 * SEQ);                               \
    }
#define MLA_SSTORE(K0, K1, K2, V0, V1, buf_)                                             \
    {                                                                                    \
      u16* kb_ = sK + (buf_) * 128 * 104;                                                \
      u16* vb_ = sV + (buf_) * 64 * 136;                                                 \
      *reinterpret_cast<uint4*>(kb_ + kr0 * 104 + kc0 * 8) = K0;                         \
      *reinterpret_cast<uint4*>(kb_ + kr1 * 104 + kc1 * 8) = K1;                         \
      *reinterpret_cast<uint4*>(kb_ + kr2 * 104 + kc2 * 8) = K2;                         \
      *reinterpret_cast<uint4*>(vb_ + vd0 * 136 + vkc) = V0;                             \
      *reinterpret_cast<uint4*>(vb_ + vd1 * 136 + vkc) = V1;                             \
    }
    float mxrun = 0.f;
#define SGB(mask, n) __builtin_amdgcn_sched_group_barrier((mask), (n), 0)
#define MLA_KFRAG(kb_, sub_, ks_) (*reinterpret_cast<const bf16x8*>((kb_) + ((sub_) * 32 + l32) * 104 + (ks_) * 16 + hh * 8))
#define MLA_VFRAG(dst_, vb_, sub_, ks2_, dvt_) \
    dst_ = *reinterpret_cast<const bf16x8*>((vb_) + ((dvt_) * 32 + l32) * 136 + (sub_) * 32 + (ks2_) * 16 + hh * 8)
#define MLA_SOFTMAX(sc_, pa_, pb_)                                                                         \
    {                                                                                                      \
      mxrun = fmaxf(mxrun, max16(sc_));                                                                    \
      float ps0_ = 0.f, ps1_ = 0.f;                                                                        \
      _Pragma("unroll") for (int i = 0; i < 16; i += 2) {                                                  \
        sc_[i] = __builtin_amdgcn_exp2f(sc_[i]); sc_[i + 1] = __builtin_amdgcn_exp2f(sc_[i + 1]);          \
        ps0_ += sc_[i]; ps1_ += sc_[i + 1];                                                                \
      }                                                                                                    \
      l += ps0_ + ps1_;                                                                                    \
      uint4 pk_;                                                                                           \
      pk_.x = pack2(sc_[0], sc_[1]); pk_.y = pack2(sc_[2], sc_[3]); pk_.z = pack2(sc_[4], sc_[5]); pk_.w = pack2(sc_[6], sc_[7]); \
      pa_ = __builtin_bit_cast(bf16x8, pk_);                                                               \
      pk_.x = pack2(sc_[8], sc_[9]); pk_.y = pack2(sc_[10], sc_[11]); pk_.z = pack2(sc_[12], sc_[13]); pk_.w = pack2(sc_[14], sc_[15]); \
      pb_ = __builtin_bit_cast(bf16x8, pk_);                                                               \
    }
    auto compute_tile = [&](int cur, int half) {
      const u16* kb = sK + cur * 128 * 104 + half * 64 * 104;
      const u16* vb = sV + cur * 64 * 136 + half * 64;
      bf16x8 k0[6], k1[6];
#pragma unroll
      for (int ks = 0; ks < 6; ++ks) { k0[ks] = MLA_KFRAG(kb, 0, ks); k1[ks] = MLA_KFRAG(kb, 1, ks); }
      f32x16 s0, s1;
#pragma unroll
      for (int i = 0; i < 16; ++i) { s0[i] = 0.f; s1[i] = 0.f; }
#pragma unroll
      for (int ks = 0; ks < 6; ++ks) s0 = MFMA32(k0[ks], qf[ks], s0);
      s0 = MFMA32(kone, qf6, s0);
      bf16x8 v00, v01, v02, v03, v10, v11, v12, v13;
      MLA_VFRAG(v00, vb, 0, 0, 0); MLA_VFRAG(v01, vb, 0, 0, 1); MLA_VFRAG(v02, vb, 0, 1, 0); MLA_VFRAG(v03, vb, 0, 1, 1);
#pragma unroll
      for (int ks = 0; ks < 6; ++ks) s1 = MFMA32(k1[ks], qf[ks], s1);
      s1 = MFMA32(kone, qf6, s1);
      MLA_VFRAG(v10, vb, 1, 0, 0); MLA_VFRAG(v11, vb, 1, 0, 1); MLA_VFRAG(v12, vb, 1, 1, 0); MLA_VFRAG(v13, vb, 1, 1, 1);
      bf16x8 p0a, p0b, p1a, p1b;
      MLA_SOFTMAX(s0, p0a, p0b);
      o0 = MFMA32(v00, p0a, o0); o1 = MFMA32(v01, p0a, o1); o0 = MFMA32(v02, p0b, o0); o1 = MFMA32(v03, p0b, o1);
      MLA_SOFTMAX(s1, p1a, p1b);
      o0 = MFMA32(v10, p1a, o0); o1 = MFMA32(v11, p1a, o1); o0 = MFMA32(v12, p1b, o0); o1 = MFMA32(v13, p1b, o1);
      SGB(0x100, 12);
#pragma unroll
      for (int i = 0; i < 7; ++i) { SGB(0x008, 1); if (i < 4) SGB(0x100, 1); }
#pragma unroll
      for (int i = 0; i < 7; ++i) { SGB(0x008, 1); if (i < 4) SGB(0x100, 1); SGB(0x402, 7); }
#pragma unroll
      for (int i = 0; i < 4; ++i) { SGB(0x008, 1); SGB(0x402, 12); }
#pragma unroll
      for (int i = 0; i < 4; ++i) SGB(0x008, 1);
    };
    auto lazy_update = [&]() {
      const float mxr = fmaxf(mxrun, __shfl_xor(mxrun, 32));
      if (__builtin_amdgcn_ballot_w64(mxr > 8.f) != 0ull) {
        float d = (mxr > 8.f) ? mxr : 0.f;
        const float mnew = bf2f(f2bf(m + d));
        d = mnew - m;
        m = mnew;
        const float alpha = __builtin_amdgcn_exp2f(-d);
        l *= alpha;
        mxrun -= d;
#pragma unroll
        for (int i = 0; i < 16; ++i) { o0[i] *= alpha; o1[i] *= alpha; }
        uint4 qv = make_uint4(0u, 0u, 0u, 0u);
        if (hh == 0) qv.x = (unsigned)f2bf(-m);
        qf6 = __builtin_bit_cast(bf16x8, qv);
      }
    };
    MLA_GLOAD(ak0, ak1, ak2, av0, av1, 0);
    asm volatile("s_waitcnt vmcnt(0)" ::: "memory");
    MLA_SSTORE(ak0, ak1, ak2, av0, av1, 0);
    __syncthreads();
    {
      f32x16 s0, s1;
#pragma unroll
      for (int i = 0; i < 16; ++i) { s0[i] = 0.f; s1[i] = 0.f; }
#pragma unroll
      for (int ks = 0; ks < 6; ++ks) { s0 = MFMA32(MLA_KFRAG(sK, 0, ks), qf[ks], s0); s1 = MFMA32(MLA_KFRAG(sK, 1, ks), qf[ks], s1); }
      float mx = fmaxf(max16(s0), max16(s1));
      mx = fmaxf(mx, __shfl_xor(mx, 32));
      m = bf2f(f2bf(mx));
      uint4 qv = make_uint4(0u, 0u, 0u, 0u);
      if (hh == 0) qv.x = (unsigned)f2bf(-m);
      qf6 = __builtin_bit_cast(bf16x8, qv);
    }
#pragma unroll 1
    for (int kt = 0; kt < 32; kt += 2) {
      MLA_GLOAD(ak0, ak1, ak2, av0, av1, kt + 1);
#pragma unroll 1
      for (int half = 0; half < 2; ++half) compute_tile(0, half);
      asm volatile("s_waitcnt vmcnt(0)" ::: "memory");
      MLA_SSTORE(ak0, ak1, ak2, av0, av1, 1);
      __syncthreads();
      lazy_update();
      if (kt + 2 < 32) MLA_GLOAD(ak0, ak1, ak2, av0, av1, kt + 2);
#pragma unroll 1
      for (int half = 0; half < 2; ++half) compute_tile(1, half);
      if (kt + 2 < 32) {
        asm volatile("s_waitcnt vmcnt(0)" ::: "memory");
        MLA_SSTORE(ak0, ak1, ak2, av0, av1, 0);
      }
      __syncthreads();
      lazy_update();
    }
    l += __shfl_xor(l, 32);
    const float il = 1.f / l;
    u16* orow = p.mixed() + (t0 + l32) * DM + 256 + h * 64 + hh * 4;
#pragma unroll
    for (int g = 0; g < 4; ++g) {
      uint2 v;
      v.x = pack2(o0[4 * g + 0] * il, o0[4 * g + 1] * il);
      v.y = pack2(o0[4 * g + 2] * il, o0[4 * g + 3] * il);
      *reinterpret_cast<uint2*>(orow + g * 8) = v;
      v.x = pack2(o1[4 * g + 0] * il, o1[4 * g + 1] * il);
      v.y = pack2(o1[4 * g + 2] * il, o1[4 * g + 3] * il);
      *reinterpret_cast<uint2*>(orow + 32 + g * 8) = v;
    }
  }
}

typedef __attribute__((address_space(3))) s16x4 lds_s16x4;
template <int MODE>
DI void ph_dil_pass(const Params& p, char* smem, int blk_) {
  const int tid = otid(), wid = tid >> 6, lane = tid & 63, l32 = lane & 31, hh = lane >> 5;
  u16* sV = reinterpret_cast<u16*>(smem) + wid * (2 * 32 * 72);
  const int i16 = lane & 15, tq = i16 >> 2, tp = i16 & 3, tblk = (lane >> 4) & 1;
  {
    constexpr int NT = (MODE == 0) ? 13 : 5;
    const int it = wid, xcd_ = blk_ & 7, jx_ = blk_ >> 3, bh = xcd_ * 2 + (jx_ >> 4), r = jx_ & 15, b = bh >> 2, h = bh & 3;
    const int i0 = it * 32;
    const int q0 = (r * 8 + it) * 32;
    const int qpos = (MODE == 0) ? (r + 16 * (i0 + l32)) : (q0 + l32);
    const size_t tb = (size_t)b * SEQ;
    const u16* kbase = p.proj() + tb * PWP + C_DK + h * 64;
    const u16* vbase = p.proj() + tb * PWP + C_DV + h * 64;
    bf16x8 qf[4];
    {
      const u16* qp = p.proj() + (tb + qpos) * PWP + C_DQ + h * 64 + hh * 8;
#pragma unroll
      for (int ks = 0; ks < 4; ++ks) qf[ks] = *reinterpret_cast<const bf16x8*>(qp + ks * 16);
    }
    f32x16 o0, o1;
#pragma unroll
    for (int i = 0; i < 16; ++i) { o0[i] = 0.f; o1[i] = 0.f; }
    float m = -1e30f, l = 0.f;
    auto tile_params = [&](int tt, int& d, int& rd, int& ub, int& ulim, int& qb, int& qs) {
      if (MODE == 0) {
        if (tt < 5) { d = 16; rd = r; qb = i0; qs = 1; ulim = 256; ub = qb - 64 + 32 * tt; }
        else { d = 4; rd = r & 3; qb = (r >> 2) + 4 * i0; qs = 4; ulim = 1024; ub = qb - 64 + 32 * (tt - 5); }
      } else { d = 1; rd = 0; qb = q0; qs = 1; ulim = 4096; ub = qb - 64 + 32 * tt; }
    };
    bf16x8 ka0, ka1, ka2, ka3, kb0, kb1, kb2, kb3;
    uint4 va0, va1, va2, va3, vb0, vb1, vb2, vb3;
#define DIL_LD(dst_, ptr_) asm volatile("global_load_dwordx4 %0, %1, off" : "=v"(dst_) : "v"(ptr_) : "memory")
#define DIL_GLOAD(K0, K1, K2, K3, V0, V1, V2, V3, tt_)                                                   \
    {                                                                                                    \
      int d_, rd_, ub_, ulim_, qb_, qs_;                                                                 \
      tile_params((tt_), d_, rd_, ub_, ulim_, qb_, qs_);                                                 \
      int u_ = min(max(ub_ + l32, 0), ulim_ - 1);                                                        \
      const u16* kp_ = kbase + (size_t)(rd_ + d_ * u_) * PWP + hh * 8;                                   \
      DIL_LD(K0, kp_); DIL_LD(K1, kp_ + 16); DIL_LD(K2, kp_ + 32); DIL_LD(K3, kp_ + 48);                 \
      const int kr_ = ub_ + (lane >> 3);                                                                 \
      const u16* vp_;                                                                                    \
      u_ = min(max(kr_, 0), ulim_ - 1);      vp_ = vbase + (size_t)(rd_ + d_ * u_) * PWP + (lane & 7) * 8; DIL_LD(V0, vp_); \
      u_ = min(max(kr_ + 8, 0), ulim_ - 1);  vp_ = vbase + (size_t)(rd_ + d_ * u_) * PWP + (lane & 7) * 8; DIL_LD(V1, vp_); \
      u_ = min(max(kr_ + 16, 0), ulim_ - 1); vp_ = vbase + (size_t)(rd_ + d_ * u_) * PWP + (lane & 7) * 8; DIL_LD(V2, vp_); \
      u_ = min(max(kr_ + 24, 0), ulim_ - 1); vp_ = vbase + (size_t)(rd_ + d_ * u_) * PWP + (lane & 7) * 8; DIL_LD(V3, vp_); \
    }
#define DIL_VSTORE(V0, V1, V2, V3, buf_)                                                                 \
    {                                                                                                    \
      u16* vb_ = sV + (buf_) * 32 * 72 + (lane >> 3) * 72 + (lane & 7) * 8;                              \
      *reinterpret_cast<uint4*>(vb_) = V0;                                                               \
      *reinterpret_cast<uint4*>(vb_ + 8 * 72) = V1;                                                      \
      *reinterpret_cast<uint4*>(vb_ + 16 * 72) = V2;                                                     \
      *reinterpret_cast<uint4*>(vb_ + 24 * 72) = V3;                                                     \
    }
    auto tile_rest = [&](int tt, f32x16 sc, int cur) {
      int d, rd, ub, ulim, qb, qs;
      tile_params(tt, d, rd, ub, ulim, qb, qs);
      const int uq = qb + qs * l32;
      const float cs = 0.125f * 1.4426950408889634f;
      float mx = -1e30f;
#pragma unroll
      for (int i = 0; i < 16; ++i) {
        const int u = ub + (i & 3) + 8 * (i >> 2) + 4 * hh;
        const int du = u - uq;
        const bool valid = (u >= 0) && (u < ulim) && (du <= 64) && (du >= -64);
        sc[i] = valid ? sc[i] * cs : -1e30f;
        mx = fmaxf(mx, sc[i]);
      }
      mx = fmaxf(mx, __shfl_xor(mx, 32));
      const float mn = fmaxf(m, mx);
      const float alpha = __builtin_amdgcn_exp2f(m - mn);
      m = mn;
      float ps = 0.f;
#pragma unroll
      for (int i = 0; i < 16; ++i) {
        float pe = __builtin_amdgcn_exp2f(sc[i] - mn);
        pe = (sc[i] > -1e29f) ? pe : 0.f;
        ps += pe;
        sc[i] = pe;
      }
      l = l * alpha + ps;
#pragma unroll
      for (int i = 0; i < 16; ++i) { o0[i] *= alpha; o1[i] *= alpha; }
      const u16* vb = sV + cur * 32 * 72;
#pragma unroll
      for (int ks2 = 0; ks2 < 2; ++ks2) {
        uint4 pk;
        pk.x = pack2(sc[8 * ks2 + 0], sc[8 * ks2 + 1]);
        pk.y = pack2(sc[8 * ks2 + 2], sc[8 * ks2 + 3]);
        pk.z = pack2(sc[8 * ks2 + 4], sc[8 * ks2 + 5]);
        pk.w = pack2(sc[8 * ks2 + 6], sc[8 * ks2 + 7]);
        const bf16x8 pb = __builtin_bit_cast(bf16x8, pk);
#pragma unroll
        for (int dvt = 0; dvt < 2; ++dvt) {
          const u16* a0 = vb + (16 * ks2 + 4 * hh + tq) * 72 + dvt * 32 + tblk * 16 + tp * 4;
          const s16x4 lo = __builtin_amdgcn_ds_read_tr16_b64_v4i16((lds_s16x4*)(a0));
          const s16x4 hi = __builtin_amdgcn_ds_read_tr16_b64_v4i16((lds_s16x4*)(a0 + 8 * 72));
          const bf16x8 a = __builtin_shufflevector(lo, hi, 0, 1, 2, 3, 4, 5, 6, 7);
          if (dvt == 0) o0 = MFMA32(a, pb, o0); else o1 = MFMA32(a, pb, o1);
        }
      }
    };
    DIL_GLOAD(ka0, ka1, ka2, ka3, va0, va1, va2, va3, 0);
    DIL_GLOAD(kb0, kb1, kb2, kb3, vb0, vb1, vb2, vb3, 1);
    asm volatile("s_waitcnt vmcnt(8)" ::: "memory");
    DIL_VSTORE(va0, va1, va2, va3, 0);
#pragma unroll 1
    for (int tt = 0; tt < NT; tt += 2) {
      {
        f32x16 sc;
#pragma unroll
        for (int i = 0; i < 16; ++i) sc[i] = 0.f;
        sc = MFMA32(ka0, qf[0], sc); sc = MFMA32(ka1, qf[1], sc); sc = MFMA32(ka2, qf[2], sc); sc = MFMA32(ka3, qf[3], sc);
        asm volatile("" :: "v"(sc));
        if (tt + 2 < NT) DIL_GLOAD(ka0, ka1, ka2, ka3, va0, va1, va2, va3, tt + 2);
        tile_rest(tt, sc, 0);
        if (tt + 1 < NT) {
          if (tt + 2 < NT) asm volatile("s_waitcnt vmcnt(8)" ::: "memory"); else asm volatile("s_waitcnt vmcnt(0)" ::: "memory");
          DIL_VSTORE(vb0, vb1, vb2, vb3, 1);
        }
      }
      if (tt + 1 < NT) {
        f32x16 sc;
#pragma unroll
        for (int i = 0; i < 16; ++i) sc[i] = 0.f;
        sc = MFMA32(kb0, qf[0], sc); sc = MFMA32(kb1, qf[1], sc); sc = MFMA32(kb2, qf[2], sc); sc = MFMA32(kb3, qf[3], sc);
        asm volatile("" :: "v"(sc));
        if (tt + 3 < NT) DIL_GLOAD(kb0, kb1, kb2, kb3, vb0, vb1, vb2, vb3, tt + 3);
        tile_rest(tt + 1, sc, 1);
        if (tt + 2 < NT) {
          if (tt + 3 < NT) asm volatile("s_waitcnt vmcnt(8)" ::: "memory"); else asm volatile("s_waitcnt vmcnt(0)" ::: "memory");
          DIL_VSTORE(va0, va1, va2, va3, 0);
        }
      }
    }
    l += __shfl_xor(l, 32);
    float* part = p.dpart() + ((tb + qpos) * 4 + h) * 68 + hh * 4;
    if (MODE == 0) {
#pragma unroll
      for (int g = 0; g < 4; ++g) {
        *reinterpret_cast<float4*>(part + g * 8) = make_float4(o0[4 * g + 0], o0[4 * g + 1], o0[4 * g + 2], o0[4 * g + 3]);
        *reinterpret_cast<float4*>(part + 32 + g * 8) = make_float4(o1[4 * g + 0], o1[4 * g + 1], o1[4 * g + 2], o1[4 * g + 3]);
      }
      if (hh == 0) { part[64] = m; part[65] = l; }
    } else {
      const float mA = part[64 - hh * 4], lA = part[65 - hh * 4];
      const float M = fmaxf(m, mA), sa = __builtin_amdgcn_exp2f(m - M), sb = __builtin_amdgcn_exp2f(mA - M);
      const float il = 1.f / (l * sa + lA * sb);
      u16* orow = p.mixed() + (tb + qpos) * DM + 768 + h * 64 + hh * 4;
#pragma unroll
      for (int g = 0; g < 4; ++g) {
        const float4 a0 = *reinterpret_cast<const float4*>(part + g * 8), a1 = *reinterpret_cast<const float4*>(part + 32 + g * 8);
        uint2 v;
        v.x = pack2((o0[4 * g + 0] * sa + a0.x * sb) * il, (o0[4 * g + 1] * sa + a0.y * sb) * il);
        v.y = pack2((o0[4 * g + 2] * sa + a0.z * sb) * il, (o0[4 * g + 3] * sa + a0.w * sb) * il);
        *reinterpret_cast<uint2*>(orow + g * 8) = v;
        v.x = pack2((o1[4 * g + 0] * sa + a1.x * sb) * il, (o1[4 * g + 1] * sa + a1.y * sb) * il);
        v.y = pack2((o1[4 * g + 2] * sa + a1.z * sb) * il, (o1[4 * g + 3] * sa + a1.w * sb) * il);
        *reinterpret_cast<uint2*>(orow + 32 + g * 8) = v;
      }
    }
  }
}

DI void ph_dil_naive(const Params& p) {
  const int gt = obid() * NTHR + otid(), gs = gridDim.x * NTHR;
  for (int it = gt; it < 4 * 4 * SEQ; it += gs) {
    const int n = it & (SEQ - 1), h = (it >> 12) & 3, b = it >> 14;
    const size_t tb = (size_t)b * SEQ;
    uint4 qp[8];
    float o[64];
#pragma unroll
    for (int d = 0; d < 8; ++d) qp[d] = *reinterpret_cast<const uint4*>(p.proj() + (tb + n) * PWP + C_DQ + h * 64 + d * 8);
    float mx = -1e30f;
    for (int pat = 0; pat < 3; ++pat) {
      const int dil = (pat == 0) ? 1 : (pat == 1 ? 4 : 16);
#pragma unroll 1
      for (int j = -64; j <= 64; ++j) {
        const int pos = n + j * dil;
        if (pos < 0 || pos >= SEQ) continue;
        const u16* kr = p.proj() + (tb + pos) * PWP + C_DK + h * 64;
        float s = 0.f;
#pragma unroll
        for (int d = 0; d < 8; ++d) s = dot8(qp[d], *reinterpret_cast<const uint4*>(kr + d * 8), s);
        s *= 0.125f;
        mx = fmaxf(mx, s);
      }
    }
#pragma unroll
    for (int d = 0; d < 64; ++d) o[d] = 0.f;
    float l = 0.f;
    for (int pat = 0; pat < 3; ++pat) {
      const int dil = (pat == 0) ? 1 : (pat == 1 ? 4 : 16);
#pragma unroll 1
      for (int j = -64; j <= 64; ++j) {
        const int pos = n + j * dil;
        if (pos < 0 || pos >= SEQ) continue;
        const u16* kr = p.proj() + (tb + pos) * PWP + C_DK + h * 64;
        const u16* vr = p.proj() + (tb + pos) * PWP + C_DV + h * 64;
        float s = 0.f;
#pragma unroll
        for (int d = 0; d < 8; ++d) s = dot8(qp[d], *reinterpret_cast<const uint4*>(kr + d * 8), s);
        s *= 0.125f;
        const float pe = __expf(s - mx);
        l += pe;
#pragma unroll
        for (int d = 0; d < 64; d += 8) {
          float vf[8];
          ld8(vr + d, vf);
#pragma unroll
          for (int jj = 0; jj < 8; ++jj) o[d + jj] += pe * vf[jj];
        }
      }
    }
    const float il = 1.f / l;
#pragma unroll
    for (int d = 0; d < 64; d += 8) {
      uint4 ov;
      ov.x = pack2(o[d + 0] * il, o[d + 1] * il);
      ov.y = pack2(o[d + 2] * il, o[d + 3] * il);
      ov.z = pack2(o[d + 4] * il, o[d + 5] * il);
      ov.w = pack2(o[d + 6] * il, o[d + 7] * il);
      *reinterpret_cast<uint4*>(p.mixed() + (tb + n) * DM + 768 + h * 64 + d) = ov;
    }
  }
}

DI void ph_ssd_naive(const Params& p, int L) {
  const int gt = obid() * NTHR + otid(), gs = gridDim.x * NTHR;
  for (int it = gt; it < 4 * 4 * 4 * SEQ; it += gs) {
    const int l = it & (SEQ - 1), pq = (it >> 12) & 3, h = (it >> 14) & 3, b = it >> 16;
    const int g = h >> 1;
    const size_t tb = (size_t)b * SEQ;
    uint4 cl[16];
    float acc[16];
#pragma unroll
    for (int d = 0; d < 16; ++d) cl[d] = *reinterpret_cast<const uint4*>(p.xbc() + (tb + l) * 768 + 512 + g * 128 + d * 8);
#pragma unroll
    for (int d = 0; d < 16; ++d) acc[d] = 0.f;
    const float pl = p.cs()[(tb + l) * 8 + h], rl = p.cs()[(tb + l) * 8 + 4 + h];
#pragma unroll 1
    for (int s = 0; s < SEQ; ++s) {
      const u16* br = p.xbc() + (tb + s) * 768 + 256 + g * 128;
      float cbv = 0.f;
#pragma unroll
      for (int d = 0; d < 16; ++d) cbv = dot8(cl[d], *reinterpret_cast<const uint4*>(br + d * 8), cbv);
      float w;
      if (s <= l) w = expf(pl - p.cs()[(tb + s) * 8 + h]) * p.dtv()[(tb + s) * 8 + h];
      else w = expf(rl - p.cs()[(tb + s) * 8 + 4 + h]) * p.dtv()[(tb + s) * 8 + 4 + h];
      cbv *= w;
      const u16* xr = p.xbc() + (tb + s) * 768 + h * 64 + pq * 16;
#pragma unroll
      for (int d = 0; d < 16; d += 8) {
        float xf[8];
        ld8(xr + d, xf);
#pragma unroll
        for (int j = 0; j < 8; ++j) acc[d + j] += cbv * xf[j];
      }
    }
    const float dsk = p.ssm_d[L * 4 + h];
#pragma unroll
    for (int d = 0; d < 16; ++d) {
      const int c = h * 64 + pq * 16 + d;
      const float xv = bf2f(p.xbc()[(tb + l) * 768 + c]);
      const float z = bf2f(p.proj()[(tb + l) * PWP + C_Z + c]);
      p.ybuf()[(tb + l) * 256 + c] = (acc[d] + dsk * xv) * silu(z);
    }
  }
}

DI void ph_ssd_norm(const Params& p, int L) {
  const int tid_ = otid(); const int lane = tid_ & 63, gw = (obid() * NTHR + tid_) >> 6, nw = gridDim.x * (NTHR / 64);
  const float* nwt = p.ssm_norm_w + L * 256;
  for (int t = gw; t < T; t += nw) {
    const float4 v = *reinterpret_cast<const float4*>(p.ybuf() + (size_t)t * 256 + lane * 4);
    float ss = wave_sum(v.x * v.x + v.y * v.y + v.z * v.z + v.w * v.w);
    const float rstd = rsqrtf(ss * (1.f / 256.f) + 1e-6f);
    const float4 ww = *reinterpret_cast<const float4*>(nwt + lane * 4);
    uint2 o;
    o.x = pack2(v.x * rstd * ww.x, v.y * rstd * ww.y);
    o.y = pack2(v.z * rstd * ww.z, v.w * rstd * ww.w);
    *reinterpret_cast<uint2*>(p.mixed() + (size_t)t * DM + 512 + lane * 4) = o;
  }
}

#define MFMA16(a, b, c) __builtin_amdgcn_mfma_f32_16x16x32_bf16((a), (b), (c), 0, 0, 0)
template <int MT, int NT, int KS>
DI void wave_mm(f32x4 (&acc)[MT][NT], const u16* a0, int lda, const u16* b0, int ldb, int fr, int fq) {
#pragma unroll
  for (int ks = 0; ks < KS; ++ks) {
    bf16x8 af[MT], bfv[NT];
#pragma unroll
    for (int m = 0; m < MT; ++m) af[m] = *reinterpret_cast<const bf16x8*>(a0 + (m * 16 + fr) * lda + ks * 32 + fq * 8);
#pragma unroll
    for (int n = 0; n < NT; ++n) bfv[n] = *reinterpret_cast<const bf16x8*>(b0 + (n * 16 + fr) * ldb + ks * 32 + fq * 8);
#pragma unroll
    for (int m = 0; m < MT; ++m)
#pragma unroll
      for (int n = 0; n < NT; ++n) acc[m][n] = MFMA16(af[m], bfv[n], acc[m][n]);
  }
}
template <int MT, int NT>
DI void zero_acc(f32x4 (&acc)[MT][NT]) {
#pragma unroll
  for (int m = 0; m < MT; ++m)
#pragma unroll
    for (int n = 0; n < NT; ++n) acc[m][n] = f32x4{0.f, 0.f, 0.f, 0.f};
}
template <int NROWS, int NCOLS>
DI void stage_rows(u16* dst, int ldd, const u16* src, size_t lsrc, int tid) {
  constexpr int CPR = NCOLS / 8, NCH = NROWS * CPR / NTHR;
  static_assert(NROWS * CPR % NTHR == 0, "tile must be a multiple of 512 chunks");
  uint4 r[NCH];
#pragma unroll
  for (int i = 0; i < NCH; ++i) {
    const int c = tid + i * NTHR, row = c / CPR, cc = c % CPR;
    r[i] = *reinterpret_cast<const uint4*>(src + (size_t)row * lsrc + cc * 8);
  }
#pragma unroll
  for (int i = 0; i < NCH; ++i) {
    const int c = tid + i * NTHR, row = c / CPR, cc = c % CPR;
    *reinterpret_cast<uint4*>(dst + row * ldd + cc * 8) = r[i];
  }
}
template <int NCOLS, class W>
DI void stage_T(u16* dst, int ldd, const u16* src, size_t lsrc, int tid, W w) {
  constexpr int NCH = 128 * (NCOLS / 8) / NTHR;
  uint4 r[NCH];
#pragma unroll
  for (int i = 0; i < NCH; ++i) {
    const int c = tid + i * NTHR, j = c & 127, cc = c >> 7;
    r[i] = *reinterpret_cast<const uint4*>(src + (size_t)j * lsrc + cc * 8);
  }
#pragma unroll
  for (int i = 0; i < NCH; ++i) {
    const int c = tid + i * NTHR, j = c & 127, cc = c >> 7;
    float f[8];
    unpack8(r[i], f);
    const float wj = w(j);
#pragma unroll
    for (int e = 0; e < 8; ++e) dst[(cc * 8 + e) * ldd + j] = f2bf(f[e] * wj);
  }
}

template <int NROWS, int NCOLS>
DI void stage_rows_ld(uint4 (&r)[NROWS * (NCOLS / 8) / NTHR], const u16* src, size_t lsrc, int tid) {
  constexpr int CPR = NCOLS / 8, NCH = NROWS * CPR / NTHR;
#pragma unroll
  for (int i = 0; i < NCH; ++i) {
    const int c = tid + i * NTHR, row = c / CPR, cc = c % CPR;
    r[i] = *reinterpret_cast<const uint4*>(src + (size_t)row * lsrc + cc * 8);
  }
}
template <int NROWS, int NCOLS>
DI void stage_rows_st(u16* dst, int ldd, const uint4 (&r)[NROWS * (NCOLS / 8) / NTHR], int tid) {
  constexpr int CPR = NCOLS / 8, NCH = NROWS * CPR / NTHR;
#pragma unroll
  for (int i = 0; i < NCH; ++i) {
    const int c = tid + i * NTHR, row = c / CPR, cc = c % CPR;
    *reinterpret_cast<uint4*>(dst + row * ldd + cc * 8) = r[i];
  }
}
template <int NCOLS>
DI void stage_T_ld(uint4 (&r)[128 * (NCOLS / 8) / NTHR], const u16* src, size_t lsrc, int tid) {
  constexpr int NCH = 128 * (NCOLS / 8) / NTHR;
#pragma unroll
  for (int i = 0; i < NCH; ++i) {
    const int c = tid + i * NTHR, j = c & 127, cc = c >> 7;
    r[i] = *reinterpret_cast<const uint4*>(src + (size_t)j * lsrc + cc * 8);
  }
}
template <int NCOLS, class W>
DI void stage_T_st(u16* dst, int ldd, const uint4 (&r)[128 * (NCOLS / 8) / NTHR], int tid, W w) {
  constexpr int NCH = 128 * (NCOLS / 8) / NTHR;
#pragma unroll
  for (int i = 0; i < NCH; ++i) {
    const int c = tid + i * NTHR, j = c & 127, cc = c >> 7;
    float f[8];
    unpack8(r[i], f);
    const float wj = w(j);
#pragma unroll
    for (int e = 0; e < 8; ++e) dst[(cc * 8 + e) * ldd + j] = f2bf(f[e] * wj);
  }
}

DI void ph_ret_a(const Params& p, char* smem, int item) {
  const int tid = otid(), wid = tid >> 6, lane = tid & 63, fr = lane & 15, fq = lane >> 4;
  u16* sVt = reinterpret_cast<u16*>(smem);
  u16* sKf = sVt + 64 * 136;
  u16* sKb = sKf + 64 * 136;
  {
    const int c = item & 31, bh = item >> 5, b = bh >> 2, h = bh & 3;
    const float lg0 = log1pf(-exp2f(-5.f - (float)h)), lg1 = log1pf(-exp2f(-5.5f - (float)h));
    const u16* src = p.proj() + ((size_t)b * SEQ + c * 128) * PWP;
    {
      uint4 rv[2], rk[2];
      stage_T_ld<64>(rv, src + C_RV + h * 64, PWP, tid);
      stage_T_ld<64>(rk, src + C_RK + h * 64, PWP, tid);
      stage_T_st<64>(sVt, 136, rv, tid, [](int) { return 1.f; });
      stage_T_st<64>(sKf, 136, rk, tid, [&](int j) { return __expf(lg0 * (float)(127 - j)); });
      stage_T_st<64>(sKb, 136, rk, tid, [&](int j) { return __expf(lg1 * (float)j); });
    }
    __syncthreads();
    const int dir = wid >> 2, q = wid & 3;
    f32x4 acc[1][4];
    zero_acc(acc);
    wave_mm<1, 4, 4>(acc, sVt + q * 16 * 136, 136, dir ? sKb : sKf, 136, fr, fq);
    float* out = p.rU() + ((size_t)(bh * 32 + c) * 2 + dir) * 4096;
#pragma unroll
    for (int n = 0; n < 4; ++n)
#pragma unroll
      for (int j = 0; j < 4; ++j) out[(q * 16 + fq * 4 + j) * 64 + n * 16 + fr] = acc[0][n][j];
    __syncthreads();
  }
}
DI void ph_ret_scan(const Params& p) {
  const int gt = obid() * NTHR + otid(), gs = gridDim.x * NTHR;
  for (int it = gt; it < 16 * 2 * 4096; it += gs) {
    const int e = it & 4095, dir = (it >> 12) & 1, bh = it >> 13, h = bh & 3;
    const float lg = log1pf(-exp2f((dir ? -5.5f : -5.f) - (float)h));
    const float cd = __expf(lg * 128.f);
    float u[32];
#pragma unroll
    for (int c = 0; c < 32; ++c) u[c] = p.rU()[((size_t)(bh * 32 + c) * 2 + dir) * 4096 + e];
    float st = 0.f;
    if (dir == 0) {
#pragma unroll
      for (int c = 0; c < 32; ++c) {
        p.rS()[((size_t)(bh * 32 + c) * 2 + dir) * 4096 + e] = f2bf(st);
        st = st * cd + u[c];
      }
    } else {
#pragma unroll
      for (int c = 31; c >= 0; --c) {
        p.rS()[((size_t)(bh * 32 + c) * 2 + dir) * 4096 + e] = f2bf(st);
        st = st * cd + u[c];
      }
    }
  }
}
DI void ph_ret_c(const Params& p, char* smem, int item) {
  const int tid = otid(), wid = tid >> 6, lane = tid & 63, fr = lane & 15, fq = lane >> 4;
  u16* sQ = reinterpret_cast<u16*>(smem);
  u16* sK = sQ + 128 * 72;
  u16* sVt = sK + 128 * 72;
  u16* sSf = sVt + 64 * 136;
  u16* sSb = sSf + 64 * 72;
  u16* sP = sSb + 64 * 72;
  {
    const int c = item & 31, bh = item >> 5, b = bh >> 2, h = bh & 3;
    const float lg0 = log1pf(-exp2f(-5.f - (float)h)), lg1 = log1pf(-exp2f(-5.5f - (float)h));
    const size_t t0 = (size_t)b * SEQ + c * 128;
    const u16* src = p.proj() + t0 * PWP;
    {
      uint4 rq[2], rk[2], rv[2], rf[1], rb[1];
      stage_rows_ld<128, 64>(rq, src + C_RQ + h * 64, PWP, tid);
      stage_rows_ld<128, 64>(rk, src + C_RK + h * 64, PWP, tid);
      stage_T_ld<64>(rv, src + C_RV + h * 64, PWP, tid);
      stage_rows_ld<64, 64>(rf, p.rS() + ((size_t)(bh * 32 + c) * 2 + 0) * 4096, 64, tid);
      stage_rows_ld<64, 64>(rb, p.rS() + ((size_t)(bh * 32 + c) * 2 + 1) * 4096, 64, tid);
      stage_rows_st<128, 64>(sQ, 72, rq, tid);
      stage_rows_st<128, 64>(sK, 72, rk, tid);
      stage_T_st<64>(sVt, 136, rv, tid, [](int) { return 1.f; });
      stage_rows_st<64, 64>(sSf, 72, rf, tid);
      stage_rows_st<64, 64>(sSb, 72, rb, tid);
    }
    __syncthreads();
    {
      const int wr = wid >> 1, wc = wid & 1;
      f32x4 sacc[2][4];
      zero_acc(sacc);
      wave_mm<2, 4, 2>(sacc, sQ + wr * 32 * 72, 72, sK + wc * 64 * 72, 72, fr, fq);
#pragma unroll
      for (int m = 0; m < 2; ++m)
#pragma unroll
        for (int n = 0; n < 4; ++n)
#pragma unroll
          for (int j = 0; j < 4; ++j) {
            const int i = wr * 32 + m * 16 + fq * 4 + j, jj = wc * 64 + n * 16 + fr;
            const float dcy = (jj <= i) ? __expf(lg0 * (float)(i - jj)) : __expf(lg1 * (float)(jj - i));
            sP[i * 136 + jj] = f2bf(sacc[m][n][j] * dcy);
          }
    }
    __syncthreads();
    {
      f32x4 ai[1][4], af_[1][4], ab_[1][4];
      zero_acc(ai); zero_acc(af_); zero_acc(ab_);
      wave_mm<1, 4, 4>(ai, sP + wid * 16 * 136, 136, sVt, 136, fr, fq);
      wave_mm<1, 4, 2>(af_, sQ + wid * 16 * 72, 72, sSf, 72, fr, fq);
      wave_mm<1, 4, 2>(ab_, sQ + wid * 16 * 72, 72, sSb, 72, fr, fq);
#pragma unroll
      for (int j = 0; j < 4; ++j) {
        const int i = wid * 16 + fq * 4 + j;
        const float xf = __expf(lg0 * (float)(i + 1)), xb = __expf(lg1 * (float)(128 - i));
        float o[4], sum = 0.f;
#pragma unroll
        for (int n = 0; n < 4; ++n) { o[n] = ai[0][n][j] + xf * af_[0][n][j] + xb * ab_[0][n][j]; sum += o[n]; }
#pragma unroll
        for (int sft = 1; sft < 16; sft <<= 1) sum += __shfl_xor(sum, sft);
        const float mu = sum * (1.f / 64.f);
        float var = 0.f;
#pragma unroll
        for (int n = 0; n < 4; ++n) var += (o[n] - mu) * (o[n] - mu);
#pragma unroll
        for (int sft = 1; sft < 16; sft <<= 1) var += __shfl_xor(var, sft);
        const float rs = rsqrtf(var * (1.f / 64.f) + 1e-5f);
#pragma unroll
        for (int n = 0; n < 4; ++n) {
          const float g = bf2f(p.proj()[(t0 + i) * PWP + C_RG + h * 64 + n * 16 + fr]);
          p.mixed()[(t0 + i) * DM + h * 64 + n * 16 + fr] = f2bf(silu(g) * (o[n] - mu) * rs);
        }
      }
    }
    __syncthreads();
  }
}

DI void ssd_local_cumsum(const Params& p, int L, size_t t0, float* cum, float* dtl, int wid, int lane) {
  const int dir = wid >> 2, h = wid & 3;
  const float a = -__expf(p.a_log[L * 8 + dir * 4 + h]);
  float d0, d1;
  if (dir == 0) { d0 = p.dtv()[(t0 + 2 * lane) * 8 + h]; d1 = p.dtv()[(t0 + 2 * lane + 1) * 8 + h]; }
  else { d0 = p.dtv()[(t0 + 127 - 2 * lane) * 8 + 4 + h]; d1 = p.dtv()[(t0 + 126 - 2 * lane) * 8 + 4 + h]; }
  float v0 = d0 * a, v1 = v0 + d1 * a;
  float run = v1;
#pragma unroll
  for (int o = 1; o < 64; o <<= 1) {
    const float u = __shfl_up(run, o);
    if (lane >= o) run += u;
  }
  const float excl = run - v1;
  v0 += excl; v1 += excl;
  float* cr = cum + (dir * 4 + h) * 128;
  float* dr = dtl + (dir * 4 + h) * 128;
  if (dir == 0) { cr[2 * lane] = v0; cr[2 * lane + 1] = v1; dr[2 * lane] = d0; dr[2 * lane + 1] = d1; }
  else { cr[127 - 2 * lane] = v0; cr[126 - 2 * lane] = v1; dr[127 - 2 * lane] = d0; dr[126 - 2 * lane] = d1; }
}

DI void ph_ssd_a(const Params& p, int L, char* smem, int item) {
  const int tid = otid(), wid = tid >> 6, lane = tid & 63, fr = lane & 15, fq = lane >> 4;
  u16* sBt = reinterpret_cast<u16*>(smem);
  u16* sXf = sBt + 2 * 128 * 136;
  u16* sXb = sXf + 64 * 136;
  float* cum = reinterpret_cast<float*>(sXb + 64 * 136);
  float* dtl = cum + 8 * 128;
  {
    const int c = item & 31, b = item >> 5;
    const size_t t0 = (size_t)b * SEQ + c * 128;
    ssd_local_cumsum(p, L, t0, cum, dtl, wid, lane);
    stage_T<256>(sBt, 136, p.xbc() + t0 * 768 + 256, 768, tid, [](int) { return 1.f; });
    __syncthreads();
    if (tid < 8) {
      const int dir = tid >> 2;
      p.cdec()[(size_t)item * 8 + tid] = __expf(dir ? cum[tid * 128 + 0] : cum[tid * 128 + 127]);
    }
    for (int h = 0; h < 4; ++h) {
      const float* cf = cum + h * 128;
      const float* cb = cum + (4 + h) * 128;
      const float* df = dtl + h * 128;
      const float* db = dtl + (4 + h) * 128;
      const float endf = cf[127], endb = cb[0];
      {
        uint4 rx[2];
        stage_T_ld<64>(rx, p.xbc() + t0 * 768 + h * 64, 768, tid);
        stage_T_st<64>(sXf, 136, rx, tid, [&](int l) { return __expf(endf - cf[l]) * df[l]; });
        stage_T_st<64>(sXb, 136, rx, tid, [&](int l) { return __expf(endb - cb[l]) * db[l]; });
      }
      __syncthreads();
      const int dir = wid >> 2, q = wid & 3, g = h >> 1;
      f32x4 acc[4][2];
      zero_acc(acc);
      wave_mm<4, 2, 4>(acc, dir ? sXb : sXf, 136, sBt + (g * 128 + q * 32) * 136, 136, fr, fq);
      float* out = p.sU() + ((size_t)item * 8 + h * 2 + dir) * 8192;
#pragma unroll
      for (int m = 0; m < 4; ++m)
#pragma unroll
        for (int n = 0; n < 2; ++n)
#pragma unroll
          for (int j = 0; j < 4; ++j) out[(m * 16 + fq * 4 + j) * 128 + q * 32 + n * 16 + fr] = acc[m][n][j];
      __syncthreads();
    }
  }
}
DI void ph_ssd_scan(const Params& p) {
  const int gt = obid() * NTHR + otid(), gs = gridDim.x * NTHR;
  for (int it = gt; it < 4 * 8 * 8192; it += gs) {
    const int e = it & 8191, hd = (it >> 13) & 7, b = it >> 16;
    const int dir = hd & 1, h = hd >> 1;
    float u[32];
#pragma unroll
    for (int c = 0; c < 32; ++c) u[c] = p.sU()[((size_t)(b * 32 + c) * 8 + hd) * 8192 + e];
    float st = 0.f;
    if (dir == 0) {
#pragma unroll
      for (int c = 0; c < 32; ++c) {
        p.sS()[((size_t)(b * 32 + c) * 8 + hd) * 8192 + e] = f2bf(st);
        st = st * p.cdec()[(size_t)(b * 32 + c) * 8 + dir * 4 + h] + u[c];
      }
    } else {
#pragma unroll
      for (int c = 31; c >= 0; --c) {
        p.sS()[((size_t)(b * 32 + c) * 8 + hd) * 8192 + e] = f2bf(st);
        st = st * p.cdec()[(size_t)(b * 32 + c) * 8 + dir * 4 + h] + u[c];
      }
    }
  }
}
DI void ph_ssd_c(const Params& p, int L, char* smem, int item) {
  const int tid = otid(), wid = tid >> 6, lane = tid & 63, fr = lane & 15, fq = lane >> 4;
  u16* sC = reinterpret_cast<u16*>(smem);
  u16* sB = sC + 128 * 136;
  u16* sXt = sB + 128 * 136;
  u16* sSf = sXt + 64 * 136;
  u16* sSb = sSf + 64 * 136;
  float* cum = reinterpret_cast<float*>(sSb + 64 * 136);
  float* dtl = cum + 8 * 128;
  {
    const int c = item & 31, b = item >> 5;
    const size_t t0 = (size_t)b * SEQ + c * 128;
    ssd_local_cumsum(p, L, t0, cum, dtl, wid, lane);
    float ssq[4] = {0.f, 0.f, 0.f, 0.f};
#pragma unroll 1
    for (int g = 0; g < 2; ++g) {
      {
        uint4 rc[4], rb4[4];
        stage_rows_ld<128, 128>(rc, p.xbc() + t0 * 768 + 512 + g * 128, 768, tid);
        stage_rows_ld<128, 128>(rb4, p.xbc() + t0 * 768 + 256 + g * 128, 768, tid);
        stage_rows_st<128, 128>(sC, 136, rc, tid);
        stage_rows_st<128, 128>(sB, 136, rb4, tid);
      }
      __syncthreads();
      const int wr = wid >> 1, wc = wid & 1;
      f32x4 G[2][4];
      zero_acc(G);
      wave_mm<2, 4, 4>(G, sC + wr * 32 * 136, 136, sB + wc * 64 * 136, 136, fr, fq);
      __syncthreads();
#pragma unroll 1
      for (int hl = 0; hl < 2; ++hl) {
        const int h = g * 2 + hl;
        const float* cf = cum + h * 128;
        const float* cb = cum + (4 + h) * 128;
        const float* df = dtl + h * 128;
        const float* db = dtl + (4 + h) * 128;
        uint4 rxt[2], rsf[2], rsb[2];
        stage_T_ld<64>(rxt, p.xbc() + t0 * 768 + h * 64, 768, tid);
        stage_rows_ld<64, 128>(rsf, p.sS() + ((size_t)item * 8 + h * 2 + 0) * 8192, 128, tid);
        stage_rows_ld<64, 128>(rsb, p.sS() + ((size_t)item * 8 + h * 2 + 1) * 8192, 128, tid);
#pragma unroll
        for (int m = 0; m < 2; ++m)
#pragma unroll
          for (int n = 0; n < 4; ++n)
#pragma unroll
            for (int j = 0; j < 4; ++j) {
              const int l = wr * 32 + m * 16 + fq * 4 + j, sx = wc * 64 + n * 16 + fr;
              const float w = (sx <= l) ? __expf(cf[l] - cf[sx]) * df[sx] : __expf(cb[l] - cb[sx]) * db[sx];
              sB[l * 136 + sx] = f2bf(G[m][n][j] * w);
            }
        stage_T_st<64>(sXt, 136, rxt, tid, [](int) { return 1.f; });
        stage_rows_st<64, 128>(sSf, 136, rsf, tid);
        stage_rows_st<64, 128>(sSb, 136, rsb, tid);
        __syncthreads();
        f32x4 yd[1][4], yf[1][4], yb[1][4];
        zero_acc(yd); zero_acc(yf); zero_acc(yb);
        wave_mm<1, 4, 4>(yd, sB + wid * 16 * 136, 136, sXt, 136, fr, fq);
        wave_mm<1, 4, 4>(yf, sC + wid * 16 * 136, 136, sSf, 136, fr, fq);
        wave_mm<1, 4, 4>(yb, sC + wid * 16 * 136, 136, sSb, 136, fr, fq);
        const float dsk = p.ssm_d[L * 4 + h];
#pragma unroll
        for (int j = 0; j < 4; ++j) {
          const int l = wid * 16 + fq * 4 + j;
          const float ef = __expf(cf[l]), eb = __expf(cb[l]);
#pragma unroll
          for (int n = 0; n < 4; ++n) {
            const int ch = h * 64 + n * 16 + fr;
            const float xv = bf2f(p.xbc()[(t0 + l) * 768 + ch]);
            const float z = bf2f(p.proj()[(t0 + l) * PWP + C_Z + ch]);
            const float yv = (yd[0][n][j] + ef * yf[0][n][j] + eb * yb[0][n][j] + dsk * xv) * silu(z);
            ssq[j] += yv * yv;
            p.ybuf()[(t0 + l) * 256 + ch] = yv;
          }
        }
        __syncthreads();
      }
    }
    const float* nwt = p.ssm_norm_w + L * 256;
#pragma unroll
    for (int j = 0; j < 4; ++j) {
      float ss = ssq[j];
#pragma unroll
      for (int sft = 1; sft < 16; sft <<= 1) ss += __shfl_xor(ss, sft);
      const float rstd = rsqrtf(ss * (1.f / 256.f) + 1e-6f);
      const int l = wid * 16 + fq * 4 + j;
#pragma unroll
      for (int hn = 0; hn < 16; ++hn) {
        const int ch = hn * 16 + fr;
        p.mixed()[(t0 + l) * DM + 512 + ch] = f2bf(p.ybuf()[(t0 + l) * 256 + ch] * rstd * nwt[ch]);
      }
    }
  }
}

struct CfgOutproj {
  static constexpr bool PERM = false;
  int K; const Params* p; int L; int bid, nb; const float* xin; float* xout;
  DI bool next(int i, pg8::Unit& u) const { const int t = i * nb + bid; if (t >= 64 * 4) return false; u.pm = t & 63; u.pn = t >> 6; return true; }
  DI const char* a_base(const pg8::Unit& u) const { return (const char*)(p->mixed() + (size_t)u.pm * 256 * DM); }
  DI const char* b_base(const pg8::Unit& u) const { return (const char*)(p->WoutT() + ((size_t)L * DM + (size_t)u.pn * 256) * DM); }
  DI void a_off(const pg8::Unit&, int R0, int C0, int R1, int C1, unsigned (&vo)[4]) const {
    vo[0] = (unsigned)(R0 * DM + C0) * 2u; vo[1] = (unsigned)(R1 * DM + C1) * 2u;
    vo[2] = vo[0] + 128u * DM * 2u; vo[3] = vo[1] + 128u * DM * 2u;
  }
  DI void epi(const f32x4 (&acc)[2][2][4][2], const pg8::Unit& u, int wr, int wc, int fr, int fq) const {
    const int row0 = u.pm * 256 + wr * 64 + fr, col0 = u.pn * 256 + wc * 32 + 4 * fq;
#pragma unroll
    for (int ai = 0; ai < 2; ++ai)
#pragma unroll
      for (int m = 0; m < 4; ++m) {
        const size_t ro = (size_t)(row0 + ai * 128 + m * 16) * DM + col0;
#pragma unroll
        for (int bj = 0; bj < 2; ++bj)
#pragma unroll
          for (int n = 0; n < 2; ++n) {
            const size_t o = ro + bj * 128 + n * 16;
            const float4 xi = *reinterpret_cast<const float4*>(xin + o);
            const f32x4 a = acc[ai][bj][m][n];
            *reinterpret_cast<float4*>(xout + o) = make_float4(xi.x + a[0], xi.y + a[1], xi.z + a[2], xi.w + a[3]);
          }
      }
  }
};
DI void ph_outproj(const Params& p, int L, const float* xin, float* xout, char* smem) {
  CfgOutproj c; c.K = DM; c.p = &p; c.L = L; c.bid = obid(); c.nb = gridDim.x; c.xin = xin; c.xout = xout;
  pg8::gemm_phase((pg8::lds_u8*)smem, c);
}

DI void ph_rms2_router(const Params& p, int L, const float* xres, char* smem) {
  const int tid = otid(), lane = tid & 63, gw = (obid() * NTHR + tid) >> 6, nw = gridDim.x * (NTHR / 64);
  const float* w = p.ln2_w + L * DM;
  const float* rw = p.router_w + (size_t)L * DM * 16;
  float4* srw = reinterpret_cast<float4*>(smem);
  for (int i = tid; i < 4096; i += NTHR) {
    const int c = i >> 2, e4 = i & 3;
    srw[(e4 * 4 + (c & 3)) * 256 + (c >> 2)] = *reinterpret_cast<const float4*>(rw + (size_t)i * 4);
  }
  __syncthreads();
  const int b5 = (lane >> 5) & 1, b4 = (lane >> 4) & 1, b3 = (lane >> 3) & 1, b2 = (lane >> 2) & 1;
  const int my_e = 8 * b5 + 4 * b4 + 2 * b3 + b2;
  for (int t = gw; t < T; t += nw) {
    const float* xr = xres + (size_t)t * DM;
    float4 v[4];
    float ss = 0.f;
#pragma unroll
    for (int i = 0; i < 4; ++i) {
      v[i] = *reinterpret_cast<const float4*>(xr + (i * 64 + lane) * 4);
      ss += v[i].x * v[i].x + v[i].y * v[i].y + v[i].z * v[i].z + v[i].w * v[i].w;
    }
    ss = wave_sum(ss);
    const float rstd = rsqrtf(ss * (1.f / DM) + 1e-6f);
    float lg[16];
#pragma unroll
    for (int e = 0; e < 16; ++e) lg[e] = 0.f;
#pragma unroll
    for (int i = 0; i < 4; ++i) {
      const int q = i * 64 + lane;
      const float4 ww = *reinterpret_cast<const float4*>(w + q * 4);
      const float hv[4] = {v[i].x * rstd * ww.x, v[i].y * rstd * ww.y, v[i].z * rstd * ww.z, v[i].w * rstd * ww.w};
      *reinterpret_cast<unsigned*>(p.hn8() + (size_t)t * DM + q * 4) =
          pk4_f8(hv[0] * F8_H_SCALE, hv[1] * F8_H_SCALE, hv[2] * F8_H_SCALE, hv[3] * F8_H_SCALE);
#pragma unroll
      for (int j = 0; j < 4; ++j)
#pragma unroll
        for (int e4 = 0; e4 < 4; ++e4) {
          const float4 r = srw[(e4 * 4 + j) * 256 + q];
          lg[e4 * 4 + 0] += hv[j] * r.x; lg[e4 * 4 + 1] += hv[j] * r.y;
          lg[e4 * 4 + 2] += hv[j] * r.z; lg[e4 * 4 + 3] += hv[j] * r.w;
        }
      __builtin_amdgcn_sched_barrier(0);
    }
#pragma unroll
    for (int k = 0; k < 8; ++k) {
      const float send = b5 ? lg[k] : lg[k + 8], keep = b5 ? lg[k + 8] : lg[k];
      lg[k] = keep + __shfl_xor(send, 32);
    }
#pragma unroll
    for (int k = 0; k < 4; ++k) {
      const float send = b4 ? lg[k] : lg[k + 4], keep = b4 ? lg[k + 4] : lg[k];
      lg[k] = keep + __shfl_xor(send, 16);
    }
#pragma unroll
    for (int k = 0; k < 2; ++k) {
      const float send = b3 ? lg[k] : lg[k + 2], keep = b3 ? lg[k + 2] : lg[k];
      lg[k] = keep + __shfl_xor(send, 8);
    }
    float lv;
    {
      const float send = b2 ? lg[0] : lg[1], keep = b2 ? lg[1] : lg[0];
      lv = keep + __shfl_xor(send, 4);
    }
    lv += __shfl_xor(lv, 2);
    lv += __shfl_xor(lv, 1);
    float mx = lv;
    mx = fmaxf(mx, __shfl_xor(mx, 4)); mx = fmaxf(mx, __shfl_xor(mx, 8));
    mx = fmaxf(mx, __shfl_xor(mx, 16)); mx = fmaxf(mx, __shfl_xor(mx, 32));
    const float ex = expf(lv - mx);
    float den = ex;
    den += __shfl_xor(den, 4); den += __shfl_xor(den, 8); den += __shfl_xor(den, 16); den += __shfl_xor(den, 32);
    if ((lane & 3) == 0) { p.aff()[(size_t)t * 16 + my_e] = ex / den; p.inv()[(size_t)t * 16 + my_e] = -1; }
  }
}

DI int block_sum_i(int v, int* red, int tid) {
#pragma unroll
  for (int o = 32; o > 0; o >>= 1) v += __shfl_xor(v, o);
  __syncthreads();
  if ((tid & 63) == 0) red[tid >> 6] = v;
  __syncthreads();
  int t = 0;
#pragma unroll
  for (int w = 0; w < NTHR / 64; ++w) t += red[w];
  return t;
}
DI void ph_topk(const Params& p, char* smem) {
  int* red = reinterpret_cast<int*>(smem);
  int* wsum = red + 16;
  const int tid = otid(), wid = tid >> 6, lane = tid & 63;
  for (int it = obid(); it < 64; it += gridDim.x) {
    const int e = it & 15, b = it >> 4;
    unsigned v[8];
#pragma unroll
    for (int i = 0; i < 8; ++i) v[i] = __float_as_uint(p.aff()[(size_t)(b * SEQ + tid * 8 + i) * 16 + e]);
    unsigned thr = 0;
#pragma unroll 1
    for (int bit = 30; bit >= 0; --bit) {
      const unsigned cand = thr | (1u << bit);
      int cnt = 0;
#pragma unroll
      for (int i = 0; i < 8; ++i) cnt += (v[i] >= cand) ? 1 : 0;
      if (block_sum_i(cnt, red, tid) >= 512) thr = cand;
    }
    int ngt = 0, ntie = 0;
#pragma unroll
    for (int i = 0; i < 8; ++i) { ngt += (v[i] > thr) ? 1 : 0; ntie += (v[i] == thr) ? 1 : 0; }
    int ig = ngt, itie = ntie;
#pragma unroll
    for (int o = 1; o < 64; o <<= 1) {
      const int a = __shfl_up(ig, o), c = __shfl_up(itie, o);
      if (lane >= o) { ig += a; itie += c; }
    }
    __syncthreads();
    if (lane == 63) { wsum[wid] = ig; wsum[8 + wid] = itie; }
    __syncthreads();
    int og = 0, ot = 0, totg = 0;
#pragma unroll
    for (int w = 0; w < 8; ++w) {
      const int a = wsum[w], c = wsum[8 + w];
      if (w < wid) { og += a; ot += c; }
      totg += a;
    }
    int pg = og + ig - ngt, pt = ot + itie - ntie;
    const int base = (e * 4 + b) * 512;
#pragma unroll
    for (int i = 0; i < 8; ++i) {
      int slot = -1;
      if (v[i] > thr) { slot = pg; ++pg; }
      else if (v[i] == thr) { if (totg + pt < 512) slot = totg + pt; ++pt; }
      if (slot >= 0) {
        p.tok()[base + slot] = b * SEQ + tid * 8 + i;
        p.inv()[(size_t)(b * SEQ + tid * 8 + i) * 16 + e] = base + slot;
        p.gate()[base + slot] = __uint_as_float(v[i]);
      }
    }
    __syncthreads();
  }
}

struct CfgMoe1 {
  static constexpr bool PERM = true;
  int K; const Params* p; int L; int bid, nb;
  DI bool next(int i, pg8::Unit& u) const {
    const int t = i * nb + bid; if (t >= 16 * 16 * 8) return false;
    const int rnd = t >> 8, w = t & 255, xcd = w & 7, jx = w >> 3, pid = xcd * 4 + (jx >> 3);
    const int mt = jx & 7, nt = pid & 15, e = rnd * 2 + (pid >> 4);
    u.pm = e * 8 + mt; u.pn = e * 16 + nt; return true;
  }
  DI const char* a_base(const pg8::Unit&) const { return (const char*)p->hn8(); }
  DI const char* b_base(const pg8::Unit& u) const { return (const char*)(p->Wgu8() + ((size_t)L * 16 * 4096 + (size_t)u.pn * 256) * DM); }
  DI void a_off(const pg8::Unit& u, int R0, int C0, int R1, int C1, unsigned (&vo)[4]) const {
    const int* tk = p->tok() + u.pm * 256;
    vo[0] = (unsigned)(tk[R0] * 512 + C0) * 2u; vo[1] = (unsigned)(tk[R1] * 512 + C1) * 2u;
    vo[2] = (unsigned)(tk[128 + R0] * 512 + C0) * 2u; vo[3] = (unsigned)(tk[128 + R1] * 512 + C1) * 2u;
  }
  DI void epi(const f32x4 (&acc)[2][2][4][2], const pg8::Unit& u, int wr, int wc, int fr, int fq) const {
    const int row0 = u.pm * 256 + wr * 64 + fr, col0 = (u.pn & 15) * 128 + wc * 32 + 8 * fq;
    const float dq = 1.f / (F8_H_SCALE * F8_W_SCALE);
#pragma unroll
    for (int ai = 0; ai < 2; ++ai)
#pragma unroll
      for (int m = 0; m < 4; ++m) {
        const f32x4 g0 = acc[ai][0][m][0] * dq, g1 = acc[ai][0][m][1] * dq, u0 = acc[ai][1][m][0] * (dq * F8_HID_SCALE), u1 = acc[ai][1][m][1] * (dq * F8_HID_SCALE);
        uint2 w;
        w.x = pk4_f8(fast_silu(g0[0]) * u0[0], fast_silu(g0[1]) * u0[1], fast_silu(g0[2]) * u0[2], fast_silu(g0[3]) * u0[3]);
        w.y = pk4_f8(fast_silu(g1[0]) * u1[0], fast_silu(g1[1]) * u1[1], fast_silu(g1[2]) * u1[2], fast_silu(g1[3]) * u1[3]);
        *reinterpret_cast<uint2*>(p->hid8() + (size_t)(row0 + ai * 128 + m * 16) * 2048 + col0) = w;
      }
  }
};
DI void ph_moe1(const Params& p, int L, char* smem) {
  CfgMoe1 c; c.K = 512; c.p = &p; c.L = L; c.bid = obid(); c.nb = gridDim.x;
  pg8::gemm_phase_f8((pg8::lds_u8*)smem, c);
}
struct CfgMoe2 {
  static constexpr bool PERM = true;
  int K; const Params* p; int L; int bid, nb;
  DI bool next(int i, pg8::Unit& u) const {
    const int t = i * nb + bid; if (t >= 16 * 4 * 8) return false;
    const int rnd = t >> 8, w = t & 255, xcd = w & 7, jx = w >> 3, pid = rnd * 32 + xcd * 4 + (jx >> 3);
    u.pm = (pid >> 2) * 8 + (jx & 7); u.pn = pid; return true;
  }
  DI const char* a_base(const pg8::Unit& u) const { return (const char*)(p->hid8() + (size_t)u.pm * 256 * 2048); }
  DI const char* b_base(const pg8::Unit& u) const { return (const char*)(p->Wd8() + ((size_t)L * 16 * DM + (size_t)u.pn * 256) * 2048); }
  DI void a_off(const pg8::Unit&, int R0, int C0, int R1, int C1, unsigned (&vo)[4]) const {
    vo[0] = (unsigned)(R0 * 1024 + C0) * 2u; vo[1] = (unsigned)(R1 * 1024 + C1) * 2u;
    vo[2] = vo[0] + 128u * 1024u * 2u; vo[3] = vo[1] + 128u * 1024u * 2u;
  }
  DI void epi(const f32x4 (&acc)[2][2][4][2], const pg8::Unit& u, int wr, int wc, int fr, int fq) const {
    u16* eo = p->proj();
    const int row0 = u.pm * 256 + wr * 64 + fr, col0 = (u.pn & 3) * 256 + wc * 32 + 8 * fq;
#pragma unroll
    for (int ai = 0; ai < 2; ++ai)
#pragma unroll
      for (int m = 0; m < 4; ++m) {
        const int row = row0 + ai * 128 + m * 16;
        const float gt = p->gate()[row] * (1.f / (F8_HID_SCALE * F8_W_SCALE));
#pragma unroll
        for (int bj = 0; bj < 2; ++bj) {
          const f32x4 a0 = acc[ai][bj][m][0], a1 = acc[ai][bj][m][1];
          uint4 w;
          w.x = pack2(gt * a0[0], gt * a0[1]); w.y = pack2(gt * a0[2], gt * a0[3]);
          w.z = pack2(gt * a1[0], gt * a1[1]); w.w = pack2(gt * a1[2], gt * a1[3]);
          *reinterpret_cast<uint4*>(eo + (size_t)row * DM + col0 + bj * 128) = w;
        }
      }
  }
};
DI void ph_moe2(const Params& p, int L, char* smem) {
  CfgMoe2 c; c.K = 1024; c.p = &p; c.L = L; c.bid = obid(); c.nb = gridDim.x;
  pg8::gemm_phase_f8((pg8::lds_u8*)smem, c);
}
template <bool FINAL>
DI void ph_combine_norm(const Params& p, const float* __restrict__ xa, float* __restrict__ xnew, const float* __restrict__ w,
                        u16* __restrict__ hn_out, float* __restrict__ f_out) {
  const int tid_ = otid(), lane = tid_ & 63, gw = (obid() * NTHR + tid_) >> 6, nw = gridDim.x * (NTHR / 64);
  const u16* eo = p.proj();
  for (int t = gw; t < T; t += nw) {
    float4 v[4];
#pragma unroll
    for (int i = 0; i < 4; ++i) v[i] = *reinterpret_cast<const float4*>(xa + (size_t)t * DM + (i * 64 + lane) * 4);
    const int myrow = (lane < 16) ? p.inv()[(size_t)t * 16 + lane] : -1;
#pragma unroll 1
    for (int e = 0; e < 16; ++e) {
      const int r = __shfl(myrow, e);
      if (r >= 0) {
#pragma unroll
        for (int i = 0; i < 4; ++i) {
          const uint2 q = *reinterpret_cast<const uint2*>(eo + (size_t)r * DM + (i * 64 + lane) * 4);
          v[i].x += __uint_as_float(q.x << 16); v[i].y += __uint_as_float(q.x & 0xffff0000u);
          v[i].z += __uint_as_float(q.y << 16); v[i].w += __uint_as_float(q.y & 0xffff0000u);
        }
      }
    }
    float ss = 0.f;
#pragma unroll
    for (int i = 0; i < 4; ++i) ss += v[i].x * v[i].x + v[i].y * v[i].y + v[i].z * v[i].z + v[i].w * v[i].w;
    ss = wave_sum(ss);
    const float rstd = rsqrtf(ss * (1.f / DM) + 1e-6f);
#pragma unroll
    for (int i = 0; i < 4; ++i) {
      const int c = (i * 64 + lane) * 4;
      const float4 ww = *reinterpret_cast<const float4*>(w + c);
      if (FINAL) {
        *reinterpret_cast<float4*>(f_out + (size_t)t * DM + c) = make_float4(v[i].x * rstd * ww.x, v[i].y * rstd * ww.y, v[i].z * rstd * ww.z, v[i].w * rstd * ww.w);
      } else {
        *reinterpret_cast<float4*>(xnew + (size_t)t * DM + c) = v[i];
        uint2 o;
        o.x = pack2(v[i].x * rstd * ww.x, v[i].y * rstd * ww.y);
        o.y = pack2(v[i].z * rstd * ww.z, v[i].w * rstd * ww.w);
        *reinterpret_cast<uint2*>(hn_out + (size_t)t * DM + c) = o;
      }
    }
  }
}

__global__ void __launch_bounds__(NTHR) mk(Params p) {
  extern __shared__ __attribute__((aligned(16))) char smem[];
  cg::grid_group grid = cg::this_grid();
  __shared__ uint4 xb_words;
  if (threadIdx.x == 0) xb_words = make_uint4(0u, 0u, 0u, 0u);
  __syncthreads();
  XcdBarrier xb = xcd_barrier_post(p.bar(), (volatile LAS unsigned*)&xb_words);
  for (int rep = 0; rep < p.rep[0]; ++rep) ph_convert(p, smem);
  ph_rmsnorm_bf16(p.x, p.ln1_w, p.hn());
  xcd_barrier(xb);
  if (p.rep[12] == 0x7fffffff) grid.sync();
  for (int L = 0; L < 2; ++L) {
    const float* xin = (L == 0) ? p.x : p.xres2();
    float* xout = p.xres();
    if (L == 1) {
      for (int rep = 0; rep < p.rep[1]; ++rep) ph_combine_norm<false>(p, p.xres(), p.xres2(), p.ln1_w + DM, p.hn(), nullptr);
      xcd_barrier(xb);
    }
    for (int rp = 0; rp < p.rep[3]; ++rp) {
      for (int rep = 0; rep < p.rep[2]; ++rep) ph_inproj(p, L, smem);
      xcd_barrier(xb);
      ph_post(p, L);
      xcd_barrier(xb);
    }
    for (int rep = 0; rep < p.rep[12]; ++rep) xcd_barrier(xb);
    {
      unsigned* ctr = p.bar() + XCD_BAR_WORDS + 8 + L;
      __shared__ int q1_item;
      for (;;) {
        if (threadIdx.x == 0) q1_item = (int)atomicAdd(ctr, 1u);
        __syncthreads();
        const int it = q1_item;
        __syncthreads();
        if (it >= 1344) break;
        if (it < 256) ph_dil_pass<0>(p, smem, it);
        else if (it < 384) ph_ssd_a(p, L, smem, it - 256);
        else if (it < 576) ph_mla_up_q(p, L, smem, it - 384);
        else if (it < 832) ph_mla_up_kv(p, L, smem, it - 576);
        else ph_ret_a(p, smem, it - 832);
      }
    }
    xcd_barrier(xb);
    for (int rep = 0; rep < p.rep[5]; ++rep) {
      for (int r2 = 0; r2 < p.rep[13]; ++r2) { ph_ret_scan(p); ph_ssd_scan(p); }
      for (int r2 = 0; r2 < p.rep[14]; ++r2) ph_mla_attn(p, smem);
      for (int r2 = 0; r2 < p.rep[15]; ++r2) for (int bi = obid(); bi < 256; bi += gridDim.x) ph_dil_pass<1>(p, smem, bi);
    }
    xcd_barrier(xb);
    {
      unsigned* ctr = p.bar() + XCD_BAR_WORDS + L;
      __shared__ int q_item;
      for (;;) {
        if (threadIdx.x == 0) q_item = (int)atomicAdd(ctr, 1u);
        __syncthreads();
        const int it = q_item;
        __syncthreads();
        if (it >= 640) break;
        if (it < 128) ph_ssd_c(p, L, smem, it);
        else ph_ret_c(p, smem, it - 128);
      }
    }
    xcd_barrier(xb);
    for (int rep = 0; rep < p.rep[7]; ++rep) ph_outproj(p, L, xin, xout, smem);
    xcd_barrier(xb);
    for (int rep = 0; rep < p.rep[8]; ++rep) ph_rms2_router(p, L, xout, smem);
    xcd_barrier(xb);
    for (int rep = 0; rep < p.rep[9]; ++rep) ph_topk(p, smem);
    xcd_barrier(xb);
    for (int rep = 0; rep < p.rep[10]; ++rep) ph_moe1(p, L, smem);
    xcd_barrier(xb);
    for (int rep = 0; rep < p.rep[11]; ++rep) ph_moe2(p, L, smem);
    xcd_barrier(xb);
  }
  ph_combine_norm<true>(p, p.xres(), nullptr, p.final_w, nullptr, p.out);
}

extern "C" void kernel_launch(void* const* d_in, const int* in_sizes, int n_in, void* d_out, int out_size, void* d_ws,
                              size_t ws_size, hipStream_t stream) {
  static int grid_blocks = 0;
  if (!grid_blocks) {
    int dev = 0, cus = 0, per_cu = 0;
    (void)hipGetDevice(&dev);
    (void)hipDeviceGetAttribute(&cus, hipDeviceAttributeMultiprocessorCount, dev);
    (void)hipFuncSetAttribute((const void*)mk, hipFuncAttributeMaxDynamicSharedMemorySize, LDS_BYTES);
    (void)hipOccupancyMaxActiveBlocksPerMultiprocessor(&per_cu, (const void*)mk, NTHR, LDS_BYTES);
    if (per_cu < 1) { fprintf(stderr, "occupancy query says %d blocks/CU\n", per_cu); per_cu = 1; }
    grid_blocks = cus * 1;
  }
  Params p{};
  const float** fp = reinterpret_cast<const float**>(&p);
  for (int i = 0; i < 20; ++i) fp[i] = (const float*)d_in[i];
  p.out = (float*)d_out;
  p.ws = (char*)d_ws;
  const size_t off = WSO.total;
  { const int reps[16] = REPS_INIT; for (int i = 0; i < 16; ++i) p.rep[i] = reps[i]; }
  if (off > ws_size) { fprintf(stderr, "workspace too small: need %zu have %zu\n", off, ws_size); return; }
  (void)hipMemsetAsync(p.bar(), 0, (size_t)(XCD_BAR_WORDS + 64) * 4, stream);
  void* args[] = {&p};
  hipError_t e = hipLaunchCooperativeKernel((void*)mk, dim3(grid_blocks), dim3(NTHR), args, LDS_BYTES, stream);
  if (e != hipSuccess) fprintf(stderr, "cooperative launch failed: %s (grid %d)\n", hipGetErrorString(e), grid_blocks);
}
```

```cpp
#include <hip/hip_runtime.h>
#include <hip/hip_cooperative_groups.h>
#include <cstdio>
#include <cstdint>
namespace cg = cooperative_groups;

#define DI __device__ __forceinline__
typedef unsigned short u16;
typedef __attribute__((ext_vector_type(8))) short bf16x8;
typedef __attribute__((ext_vector_type(4))) float f32x4;

#ifndef REPS_INIT
#define REPS_INIT {1, 1, 1, 1, 1, 1, 1, 1, 1, 1, 1, 1, 0, 1, 1, 1}
#endif
constexpr int NTHR = 512;
constexpr int T = 16384, SEQ = 4096, DM = 1024;
constexpr int PW = 3240, PWP = 3328;
constexpr int C_RQ = 0, C_RK = 256, C_RV = 512, C_RG = 768, C_CQ = 1024, C_CKV = 1280, C_KR = 1408,
              C_Z = 1440, C_XBC = 1696, C_DT = 2464, C_DQ = 2472, C_DK = 2728, C_DV = 2984;
constexpr int LDS_BYTES = 131072 + 8192;

struct WsOff {
  size_t WinT;
  size_t WuqT;
  size_t WukvT;
  size_t WoutT;
  size_t Wgu8;
  size_t Wd8;
  size_t hn8;
  size_t xres;
  size_t hn;
  size_t proj;
  size_t cqn;
  size_t ckvn;
  size_t mq;
  size_t xbc;
  size_t mixed;
  size_t hid8;
  size_t kfull;
  size_t rS;
  size_t sS;
  size_t rU;
  size_t sU;
  size_t cdec;
  size_t vT;
  size_t rtab;
  size_t dpart;
  size_t dtv;
  size_t cs;
  size_t ybuf;
  size_t aff;
  size_t gate;
  size_t tok;
  size_t inv;
  size_t bar;
  size_t xres2;
  size_t total;
};
constexpr WsOff ws_layout() {
  WsOff o{};
  size_t off = 0;
  o.WinT = off; off += (((size_t)2 * PWP * DM * 2) + 255) & ~(size_t)255;
  o.WuqT = off; off += (((size_t)2 * 384 * 256 * 2) + 255) & ~(size_t)255;
  o.WukvT = off; off += (((size_t)2 * 512 * 128 * 2) + 255) & ~(size_t)255;
  o.WoutT = off; off += (((size_t)2 * DM * DM * 2) + 255) & ~(size_t)255;
  o.Wgu8 = off; off += (((size_t)2 * 16 * 4096 * DM) + 255) & ~(size_t)255;
  o.Wd8 = off; off += (((size_t)2 * 16 * DM * 2048) + 255) & ~(size_t)255;
  o.hn8 = off; off += (((size_t)T * DM) + 255) & ~(size_t)255;
  o.xres = off; off += (((size_t)T * DM * 4) + 255) & ~(size_t)255;
  o.hn = off; off += (((size_t)T * DM * 2) + 255) & ~(size_t)255;
  o.proj = off; off += (((size_t)T * PWP * 2) + 255) & ~(size_t)255;
  o.cqn = off; off += (((size_t)T * 256 * 2) + 255) & ~(size_t)255;
  o.ckvn = off; off += (((size_t)T * 128 * 2) + 255) & ~(size_t)255;
  o.mq = off; off += (((size_t)T * 384 * 2) + 255) & ~(size_t)255;
  o.xbc = off; off += (((size_t)T * 768 * 2) + 255) & ~(size_t)255;
  o.mixed = off; off += (((size_t)T * DM * 2) + 255) & ~(size_t)255;
  o.hid8 = off; off += (((size_t)32768 * 2048) + 255) & ~(size_t)255;
  o.kfull = off; off += (((size_t)T * 4 * 96 * 2) + 255) & ~(size_t)255;
  o.rS = off; off += (((size_t)16 * 32 * 2 * 4096 * 2) + 255) & ~(size_t)255;
  o.sS = off; off += (((size_t)128 * 8 * 8192 * 2) + 255) & ~(size_t)255;
  o.rU = off; off += (((size_t)16 * 32 * 2 * 4096 * 4) + 255) & ~(size_t)255;
  o.sU = off; off += (((size_t)128 * 8 * 8192 * 4) + 255) & ~(size_t)255;
  o.cdec = off; off += (((size_t)128 * 8 * 4) + 255) & ~(size_t)255;
  o.vT = off; off += (((size_t)T * 4 * 64 * 2) + 255) & ~(size_t)255;
  o.rtab = off; off += (((size_t)SEQ * 56 * 2 * 4) + 255) & ~(size_t)255;
  o.dpart = off; off += (((size_t)T * 4 * 68 * 4) + 255) & ~(size_t)255;
  o.dtv = off; off += (((size_t)T * 8 * 4) + 255) & ~(size_t)255;
  o.cs = off; off += (((size_t)T * 8 * 4) + 255) & ~(size_t)255;
  o.ybuf = off; off += (((size_t)T * 256 * 4) + 255) & ~(size_t)255;
  o.aff = off; off += (((size_t)T * 16 * 4) + 255) & ~(size_t)255;
  o.gate = off; off += (((size_t)64 * 512 * 4) + 255) & ~(size_t)255;
  o.tok = off; off += (((size_t)64 * 512 * 4) + 255) & ~(size_t)255;
  o.inv = off; off += (((size_t)T * 16 * 4) + 255) & ~(size_t)255;
  o.bar = off; off += (((size_t)(3456 + 64) * 4) + 255) & ~(size_t)255;
  o.xres2 = off; off += (((size_t)T * DM * 4) + 255) & ~(size_t)255;
  o.total = off;
  return o;
}
constexpr WsOff WSO = ws_layout();
struct Params {
  const float *x, *ln1_w, *w_in, *q_norm_w, *kv_norm_w, *w_uq, *w_ukv, *conv_w, *conv_b, *a_log, *dt_bias,
      *ssm_d, *ssm_norm_w, *w_out, *ln2_w, *router_w, *w_gate, *w_up, *w_down, *final_w;
  float* out;
  char* ws;
  int rep[16];
  __host__ DI u16* WinT() const { return reinterpret_cast<u16*>(ws + WSO.WinT); }
  __host__ DI u16* WuqT() const { return reinterpret_cast<u16*>(ws + WSO.WuqT); }
  __host__ DI u16* WukvT() const { return reinterpret_cast<u16*>(ws + WSO.WukvT); }
  __host__ DI u16* WoutT() const { return reinterpret_cast<u16*>(ws + WSO.WoutT); }
  __host__ DI unsigned char* Wgu8() const { return reinterpret_cast<unsigned char*>(ws + WSO.Wgu8); }
  __host__ DI unsigned char* Wd8() const { return reinterpret_cast<unsigned char*>(ws + WSO.Wd8); }
  __host__ DI unsigned char* hn8() const { return reinterpret_cast<unsigned char*>(ws + WSO.hn8); }
  __host__ DI float* xres() const { return reinterpret_cast<float*>(ws + WSO.xres); }
  __host__ DI u16* hn() const { return reinterpret_cast<u16*>(ws + WSO.hn); }
  __host__ DI u16* proj() const { return reinterpret_cast<u16*>(ws + WSO.proj); }
  __host__ DI u16* cqn() const { return reinterpret_cast<u16*>(ws + WSO.cqn); }
  __host__ DI u16* ckvn() const { return reinterpret_cast<u16*>(ws + WSO.ckvn); }
  __host__ DI u16* mq() const { return reinterpret_cast<u16*>(ws + WSO.mq); }
  __host__ DI u16* xbc() const { return reinterpret_cast<u16*>(ws + WSO.xbc); }
  __host__ DI u16* mixed() const { return reinterpret_cast<u16*>(ws + WSO.mixed); }
  __host__ DI unsigned char* hid8() const { return reinterpret_cast<unsigned char*>(ws + WSO.hid8); }
  __host__ DI u16* kfull() const { return reinterpret_cast<u16*>(ws + WSO.kfull); }
  __host__ DI u16* rS() const { return reinterpret_cast<u16*>(ws + WSO.rS); }
  __host__ DI u16* sS() const { return reinterpret_cast<u16*>(ws + WSO.sS); }
  __host__ DI float* rU() const { return reinterpret_cast<float*>(ws + WSO.rU); }
  __host__ DI float* sU() const { return reinterpret_cast<float*>(ws + WSO.sU); }
  __host__ DI float* cdec() const { return reinterpret_cast<float*>(ws + WSO.cdec); }
  __host__ DI u16* vT() const { return reinterpret_cast<u16*>(ws + WSO.vT); }
  __host__ DI float* rtab() const { return reinterpret_cast<float*>(ws + WSO.rtab); }
  __host__ DI float* dpart() const { return reinterpret_cast<float*>(ws + WSO.dpart); }
  __host__ DI float* dtv() const { return reinterpret_cast<float*>(ws + WSO.dtv); }
  __host__ DI float* cs() const { return reinterpret_cast<float*>(ws + WSO.cs); }
  __host__ DI float* ybuf() const { return reinterpret_cast<float*>(ws + WSO.ybuf); }
  __host__ DI float* aff() const { return reinterpret_cast<float*>(ws + WSO.aff); }
  __host__ DI float* gate() const { return reinterpret_cast<float*>(ws + WSO.gate); }
  __host__ DI int* tok() const { return reinterpret_cast<int*>(ws + WSO.tok); }
  __host__ DI int* inv() const { return reinterpret_cast<int*>(ws + WSO.inv); }
  __host__ DI unsigned* bar() const { return reinterpret_cast<unsigned*>(ws + WSO.bar); }
  __host__ DI float* xres2() const { return reinterpret_cast<float*>(ws + WSO.xres2); }
};


typedef __attribute__((ext_vector_type(2))) __bf16 bf16x2_t;
typedef __attribute__((ext_vector_type(2))) float f32x2_t;
typedef __attribute__((ext_vector_type(16))) float f32x16;
typedef __attribute__((ext_vector_type(4))) short s16x4;
typedef __attribute__((ext_vector_type(8))) int i32x8;
typedef __attribute__((ext_vector_type(4))) int i32x4;
DI unsigned pack2(float a, float b) {
  f32x2_t v = {a, b};
  return __builtin_bit_cast(unsigned, __builtin_convertvector(v, bf16x2_t));
}
DI u16 f2bf(float f) { return (u16)(pack2(f, 0.f) & 0xffffu); }
DI float bf2f(u16 h) { return __uint_as_float(((unsigned)h) << 16); }
DI void unpack8(const uint4& v, float* f) {
  f[0] = __uint_as_float(v.x << 16); f[1] = __uint_as_float(v.x & 0xffff0000u);
  f[2] = __uint_as_float(v.y << 16); f[3] = __uint_as_float(v.y & 0xffff0000u);
  f[4] = __uint_as_float(v.z << 16); f[5] = __uint_as_float(v.z & 0xffff0000u);
  f[6] = __uint_as_float(v.w << 16); f[7] = __uint_as_float(v.w & 0xffff0000u);
}
DI void ld8(const u16* p, float* f) { uint4 v = *reinterpret_cast<const uint4*>(p); unpack8(v, f); }
DI unsigned pk4_f8(float a, float b, float c, float d) {
  a = __builtin_amdgcn_fmed3f(a, -448.f, 448.f); b = __builtin_amdgcn_fmed3f(b, -448.f, 448.f);
  c = __builtin_amdgcn_fmed3f(c, -448.f, 448.f); d = __builtin_amdgcn_fmed3f(d, -448.f, 448.f);
  int w = __builtin_amdgcn_cvt_pk_fp8_f32(a, b, 0, false);
  w = __builtin_amdgcn_cvt_pk_fp8_f32(c, d, w, true);
  return (unsigned)w;
}
constexpr float F8_W_SCALE = 256.f, F8_H_SCALE = 16.f, F8_HID_SCALE = 8.f;
DI float wave_sum(float v) {
#pragma unroll
  for (int o = 32; o > 0; o >>= 1) v += __shfl_xor(v, o);
  return v;
}
DI float dot2acc(unsigned a, unsigned b, float c) {
  return __builtin_amdgcn_fdot2_f32_bf16(__builtin_bit_cast(bf16x2_t, a), __builtin_bit_cast(bf16x2_t, b), c, false);
}
DI float dot8(const uint4& a, const uint4& b, float c) {
  c = dot2acc(a.x, b.x, c); c = dot2acc(a.y, b.y, c); c = dot2acc(a.z, b.z, c); c = dot2acc(a.w, b.w, c);
  return c;
}
DI int otid() { int t = threadIdx.x; asm volatile("" : "+v"(t)); return t; }
DI int obid() { int b = blockIdx.x; asm volatile("" : "+s"(b)); return b; }
DI float silu(float x) { return x / (1.f + __expf(-x)); }
DI float fast_silu(float x) { return x * __builtin_amdgcn_rcpf(1.f + __expf(-x)); }


#define XB_TMO      128
#define XB_XCNT(j)  (256  + 64 * (j))
#define XB_XSUB(j)  (1280 + 64 * (j))
#define XB_XGEN(j)  (2304 + 64 * (j))
#define XB_TOP      3328
#define XB_TOPGEN   3392
#define XCD_BAR_WORDS 3456
#define XB_SPIN_CAP (1u << 20)
#define LAS __attribute__((address_space(3)))
DI unsigned xb_ld(unsigned* p) { return __hip_atomic_load(p, __ATOMIC_RELAXED, __HIP_MEMORY_SCOPE_AGENT); }
DI unsigned xb_add(unsigned* p, unsigned v) { return __hip_atomic_fetch_add(p, v, __ATOMIC_RELAXED, __HIP_MEMORY_SCOPE_AGENT); }
DI unsigned xb_xcc_id() { return (unsigned)__builtin_amdgcn_s_getreg((3 << 11) | 20) & 0xFu; }
#define XB_SPIN(cond, bar) do { unsigned _sp = 0; while (cond) { __builtin_amdgcn_s_sleep(1); \
    if ((++_sp & 255u) == 0u) { if (xb_ld(&(bar)[XB_TMO])) break; if (_sp > XB_SPIN_CAP) { atomicAdd(&(bar)[XB_TMO], 1u); break; } } } } while (0)
struct XcdBarrier { unsigned* bar; unsigned x; volatile LAS unsigned* st; };
DI XcdBarrier xcd_barrier_post(unsigned* bar, volatile LAS unsigned* st) {
  XcdBarrier b; b.bar = bar; b.x = xb_xcc_id(); b.st = st;
  if (threadIdx.x == 0) (void)xb_add(&bar[XB_XCNT(b.x)], 1u);
  return b;
}
DI void xcd_barrier_complete(unsigned* bar, unsigned x, unsigned& nloc, unsigned& nx) {
  const unsigned G = gridDim.x * gridDim.y * gridDim.z;
  unsigned sum, cnt, mine, sp = 0u;
  for (;;) {
    sum = 0u; cnt = 0u; mine = 0u;
#pragma unroll
    for (unsigned j = 0; j < 16; ++j) { const unsigned c = xb_ld(&bar[XB_XCNT(j)]); sum += c; cnt += (c > 0u) ? 1u : 0u; mine = (j == x) ? c : mine; }
    if (sum == G) break;
    __builtin_amdgcn_s_sleep(1);
    if ((++sp & 255u) == 0u) { if (xb_ld(&bar[XB_TMO])) break; if (sp > XB_SPIN_CAP) { atomicAdd(&bar[XB_TMO], 1u); break; } }
  }
  nloc = mine > 0u ? mine : 1u; nx = cnt > 0u ? cnt : 1u;
}
DI void xcd_barrier(const XcdBarrier& b) {
  asm volatile("s_waitcnt vmcnt(0)" ::: "memory");
  __syncthreads();
  if (threadIdx.x == 0) {
    unsigned* bar = b.bar;
    __builtin_amdgcn_s_waitcnt(0);
    unsigned nloc = b.st[0], nx = b.st[1];
    if (nloc == 0u) { xcd_barrier_complete(bar, b.x, nloc, nx); b.st[0] = nloc; b.st[1] = nx; }
    const unsigned old = xb_add(&bar[XB_XSUB(b.x)], 1u);
    const unsigned gen = old / nloc;
    if (old + 1u == (gen + 1u) * nloc) {
      __builtin_amdgcn_fence(__ATOMIC_RELEASE, "agent");
      asm volatile("s_waitcnt vmcnt(0)" ::: "memory");
      const unsigned og = xb_add(&bar[XB_TOP], 1u);
      const unsigned tg = og / nx;
      if (og + 1u == (tg + 1u) * nx) xb_add(&bar[XB_TOPGEN], 1u);
      else XB_SPIN(xb_ld(&bar[XB_TOPGEN]) == tg, bar);
      __builtin_amdgcn_fence(__ATOMIC_ACQUIRE, "agent");
      xb_add(&bar[XB_XGEN(b.x)], 1u);
      asm volatile("s_waitcnt vmcnt(0)" ::: "memory");
    } else {
      XB_SPIN(xb_ld(&bar[XB_XGEN(b.x)]) == gen, bar);
      __builtin_amdgcn_fence(__ATOMIC_ACQUIRE, "agent");
      asm volatile("s_waitcnt vmcnt(0)" ::: "memory");
    }
  }
  __syncthreads();
}

template <class F>
DI void transpose_convert(const float* __restrict__ src, int K, int N, int Npad, u16* __restrict__ dst, F rowmap,
                          int bid, int nb, char* smem) {
  u16* tile = reinterpret_cast<u16*>(smem);
  const int tid = otid();
  const int ntn = Npad / 128, ntk = K / 64;
  for (int t = bid; t < ntn * ntk; t += nb) {
    const int n0 = (t % ntn) * 128, k0 = (t / ntn) * 64;
    f32x4 v[4];
#pragma unroll
    for (int i = 0; i < 4; ++i) {
      const int kk = (tid >> 5) + 16 * i, nn = (tid & 31) * 4;
      v[i] = f32x4{0.f, 0.f, 0.f, 0.f};
      if (n0 + nn < N) v[i] = __builtin_nontemporal_load(reinterpret_cast<const f32x4*>(src + (size_t)(k0 + kk) * N + n0 + nn));
    }
#pragma unroll
    for (int i = 0; i < 4; ++i) {
      const int kk = (tid >> 5) + 16 * i, nn = (tid & 31) * 4;
      tile[(nn + 0) * 72 + kk] = f2bf(v[i][0]); tile[(nn + 1) * 72 + kk] = f2bf(v[i][1]);
      tile[(nn + 2) * 72 + kk] = f2bf(v[i][2]); tile[(nn + 3) * 72 + kk] = f2bf(v[i][3]);
    }
    __syncthreads();
#pragma unroll
    for (int j = 0; j < 2; ++j) {
      const int c = tid + NTHR * j, nn = c >> 3, k8 = (c & 7) * 8;
      const uint4 o = *reinterpret_cast<const uint4*>(tile + nn * 72 + k8);
      *reinterpret_cast<uint4*>(dst + (size_t)rowmap(n0 + nn) * K + k0 + k8) = o;
    }
    __syncthreads();
  }
}

template <class F>
DI void transpose_convert_f8(const float* __restrict__ src, int K, int N, unsigned char* __restrict__ dst, F rowmap,
                             int bid, int nb, char* smem) {
  unsigned char* tile = reinterpret_cast<unsigned char*>(smem);
  const int tid = otid();
  const int ntn = N / 128, ntk = K / 64;
  for (int t = bid; t < ntn * ntk; t += nb) {
    const int n0 = (t % ntn) * 128, k0 = (t / ntn) * 64;
    const int kq = (tid >> 5) * 4, nn = (tid & 31) * 4;
    f32x4 v[4];
#pragma unroll
    for (int r = 0; r < 4; ++r) v[r] = __builtin_nontemporal_load(reinterpret_cast<const f32x4*>(src + (size_t)(k0 + kq + r) * N + n0 + nn));
#pragma unroll
    for (int e = 0; e < 4; ++e)
      *reinterpret_cast<unsigned*>(tile + (nn + e) * 80 + kq) =
          pk4_f8(v[0][e] * F8_W_SCALE, v[1][e] * F8_W_SCALE, v[2][e] * F8_W_SCALE, v[3][e] * F8_W_SCALE);
    __syncthreads();
    {
      const int rn = tid >> 2, kc = (tid & 3) * 16;
      const uint4 o = *reinterpret_cast<const uint4*>(tile + rn * 80 + kc);
      *reinterpret_cast<uint4*>(dst + (size_t)rowmap(n0 + rn) * K + k0 + kc) = o;
    }
    __syncthreads();
  }
}

DI void ph_convert(const Params& p, char* smem) {
  const int nb = gridDim.x;
  int bid = obid();
  for (int idx = bid * NTHR + otid(); idx < SEQ * 56; idx += nb * NTHR) {
    const int pos = idx / 56, f = idx - pos * 56;
    float inv;
    if (f < 32) inv = exp2f(-(float)f * (13.287712379549449f / 32.f));
    else if (f < 40) inv = exp2f(-(float)(f - 32) * (18.931568569324174f / 8.f));
    else inv = exp2f(-(float)(f - 40) * (18.931568569324174f / 16.f));
    float sn, cs;
    sincosf((float)pos * inv, &sn, &cs);
    p.rtab()[(size_t)idx * 2] = cs;
    p.rtab()[(size_t)idx * 2 + 1] = sn;
  }
  auto ident = [](int n) { return n; };
  for (int L = 0; L < 2; ++L) {
    transpose_convert(p.w_in + (size_t)L * DM * PW, DM, PW, PWP, p.WinT() + (size_t)L * PWP * DM, ident, bid, nb, smem);
    transpose_convert(p.w_uq + (size_t)L * 256 * 384, 256, 384, 384, p.WuqT() + (size_t)L * 384 * 256, ident, bid, nb, smem);
    transpose_convert(p.w_ukv + (size_t)L * 128 * 512, 128, 512, 512, p.WukvT() + (size_t)L * 512 * 128, ident, bid, nb, smem);
    transpose_convert(p.w_out + (size_t)L * DM * DM, DM, DM, DM, p.WoutT() + (size_t)L * DM * DM, ident, bid, nb, smem);
    for (int e = 0; e < 16; ++e) {
      const size_t le = (size_t)(L * 16 + e);
      auto gmap = [](int n) { return (n >> 7) * 256 + (n & 127); };
      auto umap = [](int n) { return (n >> 7) * 256 + 128 + (n & 127); };
      transpose_convert_f8(p.w_gate + le * DM * 2048, DM, 2048, p.Wgu8() + le * 4096 * DM, gmap, bid, nb, smem);
      transpose_convert_f8(p.w_up + le * DM * 2048, DM, 2048, p.Wgu8() + le * 4096 * DM, umap, bid, nb, smem);
      transpose_convert_f8(p.w_down + le * 2048 * DM, 2048, DM, p.Wd8() + le * DM * 2048, ident, bid, nb, smem);
    }
  }
}

template <class RowPtr, class Epi>
DI void gemm_tile(RowPtr arow, const u16* __restrict__ bt, int ldb, int K, char* smem, Epi epi) {
  u16* sa = reinterpret_cast<u16*>(smem);
  u16* sb = sa + 2 * 256 * 72;
  const int tid = otid(), wid = tid >> 6, lane = tid & 63, wr = wid >> 1, wc = wid & 1, fr = lane & 15, fq = lane >> 4;
  f32x4 acc[4][4];
#pragma unroll
  for (int m = 0; m < 4; ++m)
#pragma unroll
    for (int n = 0; n < 4; ++n) acc[m][n] = f32x4{0.f, 0.f, 0.f, 0.f};
  const int lr = tid >> 3, lc = (tid & 7) * 8;
  const u16* ap[4];
#pragma unroll
  for (int i = 0; i < 4; ++i) ap[i] = arow(lr + 64 * i) + lc;
  const u16* bp[2];
#pragma unroll
  for (int i = 0; i < 2; ++i) bp[i] = bt + (size_t)(lr + 64 * i) * ldb + lc;
  uint4 ra[4], rb[2];
  const int nk = K / 64;
#pragma unroll
  for (int i = 0; i < 4; ++i) ra[i] = *reinterpret_cast<const uint4*>(ap[i]);
#pragma unroll
  for (int i = 0; i < 2; ++i) rb[i] = *reinterpret_cast<const uint4*>(bp[i]);
#pragma unroll
  for (int i = 0; i < 4; ++i) *reinterpret_cast<uint4*>(sa + (lr + 64 * i) * 72 + lc) = ra[i];
#pragma unroll
  for (int i = 0; i < 2; ++i) *reinterpret_cast<uint4*>(sb + (lr + 64 * i) * 72 + lc) = rb[i];
  __syncthreads();
  for (int kt = 0; kt < nk; ++kt) {
    const int cur = kt & 1;
    if (kt + 1 < nk) {
#pragma unroll
      for (int i = 0; i < 4; ++i) ra[i] = *reinterpret_cast<const uint4*>(ap[i] + (kt + 1) * 64);
#pragma unroll
      for (int i = 0; i < 2; ++i) rb[i] = *reinterpret_cast<const uint4*>(bp[i] + (kt + 1) * 64);
    }
    const u16* ca = sa + cur * 256 * 72;
    const u16* cb = sb + cur * 128 * 72;
#pragma unroll
    for (int kk = 0; kk < 2; ++kk) {
      bf16x8 af[4], bfr[4];
#pragma unroll
      for (int m = 0; m < 4; ++m) af[m] = *reinterpret_cast<const bf16x8*>(ca + (wr * 64 + m * 16 + fr) * 72 + kk * 32 + fq * 8);
#pragma unroll
      for (int n = 0; n < 4; ++n) bfr[n] = *reinterpret_cast<const bf16x8*>(cb + (wc * 64 + n * 16 + fr) * 72 + kk * 32 + fq * 8);
#pragma unroll
      for (int m = 0; m < 4; ++m)
#pragma unroll
        for (int n = 0; n < 4; ++n) acc[m][n] = __builtin_amdgcn_mfma_f32_16x16x32_bf16(af[m], bfr[n], acc[m][n], 0, 0, 0);
    }
    if (kt + 1 < nk) {
      u16* na = sa + (cur ^ 1) * 256 * 72;
      u16* nbp = sb + (cur ^ 1) * 128 * 72;
#pragma unroll
      for (int i = 0; i < 4; ++i) *reinterpret_cast<uint4*>(na + (lr + 64 * i) * 72 + lc) = ra[i];
#pragma unroll
      for (int i = 0; i < 2; ++i) *reinterpret_cast<uint4*>(nbp + (lr + 64 * i) * 72 + lc) = rb[i];
    }
    __syncthreads();
  }
  epi(acc, wr, wc, fr, fq);
}

#define WAIT_V(n) asm volatile("s_waitcnt vmcnt(%0)" ::"n"(n) : "memory")
DI int lds_byte2(int r, int c) {
  const int st = (r >> 4) * 2 + (c >> 5), ob = (r & 15) * 64 + (c & 31) * 2;
  return st * 1024 + (ob ^ (((ob >> 9) & 1) << 5));
}
DI void stage_rc2(int b, int& R, int& C) {
  const int st = b >> 10, sb = b & 1023, swz = sb ^ (((sb >> 9) & 1) << 5);
  R = (st >> 1) * 16 + swz / 64;
  C = (st & 1) * 32 + (swz % 64) / 2;
}
typedef __attribute__((address_space(3))) unsigned lds_u32;
template <class RowPtr, class Epi>
DI void gemm256(RowPtr arow, const u16* __restrict__ bt, int ldb, int K, char* smem, Epi epi) {
  constexpr int TILE_B = 256 * 64 * 2, STAGE_B = 2 * TILE_B;
  const int tid = otid(), wid = tid >> 6, lane = tid & 63, wr = wid >> 2, wc = wid & 3, fr = lane & 15, fq = lane >> 4;
  const u16* ap[4];
  const u16* bp[4];
#pragma unroll
  for (int i = 0; i < 4; ++i) {
    int R, C;
    stage_rc2(wid * 1024 + i * 8192 + lane * 16, R, C);
    ap[i] = arow(R) + C;
    bp[i] = bt + (size_t)R * ldb + C;
  }
  f32x4 acc[8][4];
#pragma unroll
  for (int m = 0; m < 8; ++m)
#pragma unroll
    for (int n = 0; n < 4; ++n) acc[m][n] = f32x4{0.f, 0.f, 0.f, 0.f};
#define G2_STAGE(buf, kt)                                                                                              \
  do {                                                                                                                 \
    _Pragma("unroll") for (int i = 0; i < 4; ++i) {                                                                    \
      __builtin_amdgcn_global_load_lds((const unsigned*)(ap[i] + (kt) * 64),                                           \
                                       (lds_u32*)(smem + (buf) * STAGE_B + wid * 1024 + i * 8192), 16, 0, 0);          \
      __builtin_amdgcn_global_load_lds((const unsigned*)(bp[i] + (kt) * 64),                                           \
                                       (lds_u32*)(smem + (buf) * STAGE_B + TILE_B + wid * 1024 + i * 8192), 16, 0, 0); \
    }                                                                                                                  \
  } while (0)
  const int nt = K / 64;
  G2_STAGE(0, 0);
  WAIT_V(0);
  __syncthreads();
  for (int t = 0; t < nt; ++t) {
    const int cur = t & 1;
    if (t + 1 < nt) G2_STAGE(cur ^ 1, t + 1);
    const char* sA = smem + cur * STAGE_B;
    const char* sB = sA + TILE_B;
#pragma unroll
    for (int ks = 0; ks < 2; ++ks) {
      bf16x8 At[8], Bf[4];
#pragma unroll
      for (int m = 0; m < 8; ++m) At[m] = *reinterpret_cast<const bf16x8*>(sA + lds_byte2(wr * 128 + m * 16 + fr, ks * 32 + fq * 8));
#pragma unroll
      for (int n = 0; n < 4; ++n) Bf[n] = *reinterpret_cast<const bf16x8*>(sB + lds_byte2(wc * 64 + n * 16 + fr, ks * 32 + fq * 8));
#pragma unroll
      for (int m = 0; m < 8; ++m)
#pragma unroll
        for (int n = 0; n < 4; ++n) acc[m][n] = __builtin_amdgcn_mfma_f32_16x16x32_bf16(Bf[n], At[m], acc[m][n], 0, 0, 0);
      __builtin_amdgcn_sched_barrier(0);
    }
    WAIT_V(0);
    __syncthreads();
  }
  epi(acc, wr, wc, fr, fq);
}

namespace pg8 {
constexpr int BM = 256, BK = 64, HALF = 128, HTB = HALF * BK * 2;
DI int lds_byte(int r, int c) { const int st = (r >> 4) * 2 + (c >> 5), rr = r & 15, cc = c & 31, ob = rr * 64 + cc * 2; return st * 1024 + (ob ^ (((ob >> 9) & 1) << 5)); }
DI void stage_rc(int b, int& R, int& C) { const int st = b / 1024, sb = b % 1024, swz = sb ^ (((sb >> 9) & 1) << 5); R = (st >> 1) * 16 + swz / 64; C = (st & 1) * 32 + (swz % 64) / 2; }
DI int perm32(int rho) { const int n = rho >> 4, i = rho & 15; return 8 * (i >> 2) + 4 * n + (i & 3); }
struct Unit { int pm, pn; };
typedef __attribute__((address_space(3))) unsigned char lds_u8;
typedef __attribute__((address_space(3))) unsigned lds_u32;
typedef __attribute__((address_space(3))) bf16x8 lds_bf16x8;
typedef __attribute__((address_space(3))) i32x4 lds_i32x4;

template <class Cfg>
DI void gemm_phase(lds_u8* lds, const Cfg& S) {
  const int tid = otid(), wid = __builtin_amdgcn_readfirstlane(tid >> 6), lane = tid & 63, wr = wid >> 2, wc = wid & 3, fr = lane & 15, fq = lane >> 4;
  const int K = S.K, nt = K / BK;
  int R0, C0, R1, C1;
  stage_rc(tid * 16, R0, C0);
  stage_rc(tid * 16 + 8192, R1, C1);
  unsigned voffB[2];
  {
    const int Rb0 = Cfg::PERM ? ((R0 & ~31) + perm32(R0 & 31)) : R0, Rb1 = Cfg::PERM ? ((R1 & ~31) + perm32(R1 & 31)) : R1;
    voffB[0] = (unsigned)(Rb0 * K + C0) * 2u; voffB[1] = (unsigned)(Rb1 * K + C1) * 2u;
  }
  const size_t kstep = (size_t)(BK * 2);
  const size_t hstep = (size_t)HALF * K * 2;
  const unsigned ldsw = (unsigned)wid * 1024u;
  const int aoff = lds_byte(wr * 64 + fr, fq * 8), boff = lds_byte(wc * 32 + fr, fq * 8);
#define PG8_SA(b, h) (((b) * 2 + (h)) * HTB)
#define PG8_SB(b, h) ((4 + (b) * 2 + (h)) * HTB)
#define PG8_STAGE2(bufoff, gbase, o0, o1) do { \
    __builtin_amdgcn_global_load_lds((const unsigned*)((const char*)(gbase) + (o0)), (lds_u32*)(lds + (bufoff) + ldsw), 16, 0, 0); \
    __builtin_amdgcn_global_load_lds((const unsigned*)((const char*)(gbase) + (o1)), (lds_u32*)(lds + (bufoff) + ldsw + 8192), 16, 0, 0); } while (0)
#define PG8_STAGEB(bufoff, gbase) PG8_STAGE2(bufoff, gbase, voffB[0], voffB[1])
#define PG8_LDA(dst, b, h) do { _Pragma("unroll") for (int m = 0; m < 4; ++m) _Pragma("unroll") for (int k = 0; k < 2; ++k) dst[m][k] = *(const lds_bf16x8*)(lds + PG8_SA(b, h) + aoff + m * 2048 + k * 1024); } while (0)
#define PG8_LDB(dst, b, h) do { _Pragma("unroll") for (int n = 0; n < 2; ++n) _Pragma("unroll") for (int k = 0; k < 2; ++k) dst[n][k] = *(const lds_bf16x8*)(lds + PG8_SB(b, h) + boff + n * 2048 + k * 1024); } while (0)
#define PG8_MMA(ai, bj, At, Bt) do { __builtin_amdgcn_s_setprio(1); _Pragma("unroll") for (int m = 0; m < 4; ++m) _Pragma("unroll") for (int n = 0; n < 2; ++n) _Pragma("unroll") for (int k = 0; k < 2; ++k) \
    acc[ai][bj][m][n] = __builtin_amdgcn_mfma_f32_16x16x32_bf16(Bt[n][k], At[m][k], acc[ai][bj][m][n], 0, 0, 0); __builtin_amdgcn_s_setprio(0); } while (0)
#define PG8_WAIT_V(n) asm volatile("s_waitcnt vmcnt(" #n ")" ::: "memory")
#define PG8_WAIT_L(n) asm volatile("s_waitcnt lgkmcnt(" #n ")" ::: "memory")
#define PG8_BAR __builtin_amdgcn_s_barrier()
#define PG8_SCHED __builtin_amdgcn_sched_barrier(0)
  Unit cur, nxt; int ui = 0;
  if (!S.next(0, cur)) return;
  f32x4 acc[2][2][4][2];
#pragma unroll
  for (int a = 0; a < 2; ++a)
#pragma unroll
    for (int b = 0; b < 2; ++b)
#pragma unroll
      for (int m = 0; m < 4; ++m)
#pragma unroll
        for (int n = 0; n < 2; ++n) acc[a][b][m][n] = f32x4{0.f, 0.f, 0.f, 0.f};
  bf16x8 At[4][2], B0[2][2], B1[2][2];
  const char* cA = S.a_base(cur);
  const char* cB = S.b_base(cur);
  unsigned vc[4], vn[4];
  S.a_off(cur, R0, C0, R1, C1, vc);
  PG8_STAGEB(PG8_SB(0, 0), cB); PG8_STAGE2(PG8_SA(0, 0), cA, vc[0], vc[1]); PG8_STAGEB(PG8_SB(0, 1), cB + hstep); PG8_STAGE2(PG8_SA(0, 1), cA, vc[2], vc[3]);
  if (wr == 1) PG8_BAR;
  PG8_WAIT_V(4); PG8_BAR;
  PG8_STAGEB(PG8_SB(1, 0), cB + kstep); PG8_STAGE2(PG8_SA(1, 0), cA + kstep, vc[0], vc[1]); PG8_STAGEB(PG8_SB(1, 1), cB + hstep + kstep);
  PG8_WAIT_V(6); PG8_BAR;
  for (;;) {
    const bool has_next = S.next(ui + 1, nxt);
    const char* nA = has_next ? S.a_base(nxt) : cA;
    const char* nB = has_next ? S.b_base(nxt) : cB;
    if (has_next) S.a_off(nxt, R0, C0, R1, C1, vn);
    else { vn[0] = vc[0]; vn[1] = vc[1]; vn[2] = vc[2]; vn[3] = vc[3]; }
    for (int t = 0; t < nt; t += 2) {
      const bool last = (t == nt - 2);
      const char* a1 = cA + (size_t)(t + 1) * kstep;
      const char* a2 = last ? nA : cA + (size_t)(t + 2) * kstep;
      const char* b2 = last ? nB : cB + (size_t)(t + 2) * kstep;
      const char* a3 = a2 + kstep;
      const char* b3 = b2 + kstep;
      const unsigned w0 = last ? vn[0] : vc[0], w1 = last ? vn[1] : vc[1], w2 = last ? vn[2] : vc[2], w3 = last ? vn[3] : vc[3];
      PG8_LDB(B0, 0, 0); PG8_SCHED; PG8_LDA(At, 0, 0); PG8_STAGE2(PG8_SA(1, 1), a1, vc[2], vc[3]);
      PG8_WAIT_L(8); PG8_BAR; PG8_WAIT_L(0); PG8_MMA(0, 0, At, B0); PG8_BAR; PG8_SCHED;
      PG8_LDB(B1, 0, 1); PG8_STAGEB(PG8_SB(0, 0), b2);
      PG8_BAR; PG8_WAIT_L(0); PG8_MMA(0, 1, At, B1); PG8_BAR;
      PG8_LDA(At, 0, 1); PG8_STAGE2(PG8_SA(0, 0), a2, w0, w1);
      PG8_BAR; PG8_WAIT_L(0); PG8_MMA(1, 0, At, B0); PG8_BAR; PG8_SCHED;
      PG8_STAGEB(PG8_SB(0, 1), b2 + hstep);
      PG8_WAIT_V(6); PG8_BAR; PG8_MMA(1, 1, At, B1); PG8_BAR;
      PG8_LDB(B0, 1, 0); PG8_SCHED; PG8_LDA(At, 1, 0); PG8_STAGE2(PG8_SA(0, 1), a2, w2, w3);
      PG8_WAIT_L(8); PG8_BAR; PG8_WAIT_L(0); PG8_MMA(0, 0, At, B0); PG8_BAR; PG8_SCHED;
      PG8_LDB(B1, 1, 1); PG8_STAGEB(PG8_SB(1, 0), b3);
      PG8_BAR; PG8_WAIT_L(0); PG8_MMA(0, 1, At, B1); PG8_BAR;
      PG8_LDA(At, 1, 1); PG8_STAGE2(PG8_SA(1, 0), a3, w0, w1);
      PG8_BAR; PG8_WAIT_L(0); PG8_MMA(1, 0, At, B0); PG8_BAR; PG8_SCHED;
      PG8_STAGEB(PG8_SB(1, 1), b3 + hstep);
      PG8_WAIT_V(6); PG8_BAR; PG8_MMA(1, 1, At, B1); PG8_BAR;
    }
    S.epi(acc, cur, wr, wc, fr, fq);
    if (!has_next) break;
#pragma unroll
    for (int a = 0; a < 2; ++a)
#pragma unroll
      for (int b = 0; b < 2; ++b)
#pragma unroll
        for (int m = 0; m < 4; ++m)
#pragma unroll
          for (int n = 0; n < 2; ++n) acc[a][b][m][n] = f32x4{0.f, 0.f, 0.f, 0.f};
    cur = nxt; cA = nA; cB = nB; ++ui;
    vc[0] = vn[0]; vc[1] = vn[1]; vc[2] = vn[2]; vc[3] = vn[3];
  }
  PG8_WAIT_V(0);
  if (wr == 0) PG8_BAR;
  PG8_BAR;
#undef PG8_SA
#undef PG8_SB
#undef PG8_STAGE2
#undef PG8_STAGEB
#undef PG8_LDA
#undef PG8_LDB
#undef PG8_MMA
#undef PG8_WAIT_V
#undef PG8_WAIT_L
#undef PG8_BAR
#undef PG8_SCHED
}
template <class Cfg>
DI void gemm_phase_f8(lds_u8* lds, const Cfg& S) {
  const int tid = otid(), wid = __builtin_amdgcn_readfirstlane(tid >> 6), lane = tid & 63, wr = wid >> 2, wc = wid & 3, fr = lane & 15, fq = lane >> 4;
  const int K = S.K, nt = K / BK;
  int R0, C0, R1, C1;
  stage_rc(tid * 16, R0, C0);
  stage_rc(tid * 16 + 8192, R1, C1);
  unsigned voffB[2];
  {
    const int Rb0 = Cfg::PERM ? ((R0 & ~31) + perm32(R0 & 31)) : R0, Rb1 = Cfg::PERM ? ((R1 & ~31) + perm32(R1 & 31)) : R1;
    voffB[0] = (unsigned)(Rb0 * K + C0) * 2u; voffB[1] = (unsigned)(Rb1 * K + C1) * 2u;
  }
  const size_t kstep = (size_t)(BK * 2);
  const size_t hstep = (size_t)HALF * K * 2;
  const unsigned ldsw = (unsigned)wid * 1024u;
  const int cl = 2 * fq + (fq & 1), ch = 2 * fq + 1 - (fq & 1);
  const int aoffL = lds_byte(wr * 64 + fr, cl * 8), aoffH = lds_byte(wr * 64 + fr, ch * 8);
  const int boffL = lds_byte(wc * 32 + fr, cl * 8), boffH = lds_byte(wc * 32 + fr, ch * 8);
#define PG8_SA(b, h) (((b) * 2 + (h)) * HTB)
#define PG8_SB(b, h) ((4 + (b) * 2 + (h)) * HTB)
#define PG8_STAGE2(bufoff, gbase, o0, o1) do { \
    __builtin_amdgcn_global_load_lds((const unsigned*)((const char*)(gbase) + (o0)), (lds_u32*)(lds + (bufoff) + ldsw), 16, 0, 0); \
    __builtin_amdgcn_global_load_lds((const unsigned*)((const char*)(gbase) + (o1)), (lds_u32*)(lds + (bufoff) + ldsw + 8192), 16, 0, 0); } while (0)
#define PG8_STAGEB(bufoff, gbase) PG8_STAGE2(bufoff, gbase, voffB[0], voffB[1])
#define PG8_LDA(dst, b, h) do { _Pragma("unroll") for (int m = 0; m < 4; ++m) { const i32x4 lo_ = *(const lds_i32x4*)(lds + PG8_SA(b, h) + aoffL + m * 2048), hi_ = *(const lds_i32x4*)(lds + PG8_SA(b, h) + aoffH + m * 2048); dst[m] = __builtin_shufflevector(lo_, hi_, 0, 1, 2, 3, 4, 5, 6, 7); } } while (0)
#define PG8_LDB(dst, b, h) do { _Pragma("unroll") for (int n = 0; n < 2; ++n) { const i32x4 lo_ = *(const lds_i32x4*)(lds + PG8_SB(b, h) + boffL + n * 2048), hi_ = *(const lds_i32x4*)(lds + PG8_SB(b, h) + boffH + n * 2048); dst[n] = __builtin_shufflevector(lo_, hi_, 0, 1, 2, 3, 4, 5, 6, 7); } } while (0)
#define PG8_MMA(ai, bj, At, Bt) do { __builtin_amdgcn_s_setprio(1); _Pragma("unroll") for (int m = 0; m < 4; ++m) _Pragma("unroll") for (int n = 0; n < 2; ++n) \
    asm volatile("v_mfma_f32_16x16x128_f8f6f4 %0, %1, %2, %0" : "+v"(acc[ai][bj][m][n]) : "v"(Bt[n]), "v"(At[m])); __builtin_amdgcn_s_setprio(0); } while (0)
#define PG8_WAIT_V(n) asm volatile("s_waitcnt vmcnt(" #n ")" ::: "memory")
#define PG8_WAIT_L(n) asm volatile("s_waitcnt lgkmcnt(" #n ")" ::: "memory")
#define PG8_BAR __builtin_amdgcn_s_barrier()
#define PG8_SCHED __builtin_amdgcn_sched_barrier(0)
  Unit cur, nxt; int ui = 0;
  if (!S.next(0, cur)) return;
  f32x4 acc[2][2][4][2];
#pragma unroll
  for (int a = 0; a < 2; ++a)
#pragma unroll
    for (int b = 0; b < 2; ++b)
#pragma unroll
      for (int m = 0; m < 4; ++m)
#pragma unroll
        for (int n = 0; n < 2; ++n) acc[a][b][m][n] = f32x4{0.f, 0.f, 0.f, 0.f};
  i32x8 At[4], B0[2], B1[2];
  const char* cA = S.a_base(cur);
  const char* cB = S.b_base(cur);
  unsigned vc[4], vn[4];
  S.a_off(cur, R0, C0, R1, C1, vc, 0);
  PG8_STAGEB(PG8_SB(0, 0), cB); PG8_STAGE2(PG8_SA(0, 0), cA, vc[0], vc[1]); PG8_STAGEB(PG8_SB(0, 1), cB + hstep); PG8_STAGE2(PG8_SA(0, 1), cA, vc[2], vc[3]);
  if (wr == 1) PG8_BAR;
  PG8_WAIT_V(4); PG8_BAR;
  PG8_STAGEB(PG8_SB(1, 0), cB + kstep); PG8_STAGE2(PG8_SA(1, 0), cA + kstep, vc[0], vc[1]); PG8_STAGEB(PG8_SB(1, 1), cB + hstep + kstep);
  PG8_WAIT_V(6); PG8_BAR;
  for (;;) {
    const bool has_next = S.next(ui + 1, nxt);
    const char* nA = has_next ? S.a_base(nxt) : cA;
    const char* nB = has_next ? S.b_base(nxt) : cB;
    if (has_next) S.a_off(nxt, R0, C0, R1, C1, vn, ui + 1);
    else { vn[0] = vc[0]; vn[1] = vc[1]; vn[2] = vc[2]; vn[3] = vc[3]; }
    for (int t = 0; t < nt; t += 2) {
      const bool last = (t == nt - 2);
      const char* a1 = cA + (size_t)(t + 1) * kstep;
      const char* a2 = last ? nA : cA + (size_t)(t + 2) * kstep;
      const char* b2 = last ? nB : cB + (size_t)(t + 2) * kstep;
      const char* a3 = a2 + kstep;
      const char* b3 = b2 + kstep;
      const unsigned w0 = last ? vn[0] : vc[0], w1 = last ? vn[1] : vc[1], w2 = last ? vn[2] : vc[2], w3 = last ? vn[3] : vc[3];
      PG8_LDB(B0, 0, 0); PG8_SCHED; PG8_LDA(At, 0, 0); PG8_STAGE2(PG8_SA(1, 1), a1, vc[2], vc[3]);
      PG8_WAIT_L(8); PG8_BAR; PG8_WAIT_L(0); PG8_MMA(0, 0, At, B0); PG8_BAR; PG8_SCHED;
      PG8_LDB(B1, 0, 1); PG8_STAGEB(PG8_SB(0, 0), b2);
      PG8_BAR; PG8_WAIT_L(0); PG8_MMA(0, 1, At, B1); PG8_BAR;
      PG8_LDA(At, 0, 1); PG8_STAGE2(PG8_SA(0, 0), a2, w0, w1);
      PG8_BAR; PG8_WAIT_L(0); PG8_MMA(1, 0, At, B0); PG8_BAR; PG8_SCHED;
      PG8_STAGEB(PG8_SB(0, 1), b2 + hstep);
      PG8_WAIT_V(6); PG8_BAR; PG8_MMA(1, 1, At, B1); PG8_BAR;
      PG8_LDB(B0, 1, 0); PG8_SCHED; PG8_LDA(At, 1, 0); PG8_STAGE2(PG8_SA(0, 1), a2, w2, w3);
      PG8_WAIT_L(8); PG8_BAR; PG8_WAIT_L(0); PG8_MMA(0, 0, At, B0); PG8_BAR; PG8_SCHED;
      PG8_LDB(B1, 1, 1); PG8_STAGEB(PG8_SB(1, 0), b3);
      PG8_BAR; PG8_WAIT_L(0); PG8_MMA(0, 1, At, B1); PG8_BAR;
      PG8_LDA(At, 1, 1); PG8_STAGE2(PG8_SA(1, 0), a3, w0, w1);
      PG8_BAR; PG8_WAIT_L(0); PG8_MMA(1, 0, At, B0); PG8_BAR; PG8_SCHED;
      PG8_STAGEB(PG8_SB(1, 1), b3 + hstep);
      PG8_WAIT_V(6); PG8_BAR; PG8_MMA(1, 1, At, B1); PG8_BAR;
    }
    asm volatile("s_nop 15\n\ts_nop 15" ::: "memory");
    S.epi(acc, cur, wr, wc, fr, fq);
    if (!has_next) break;
#pragma unroll
    for (int a = 0; a < 2; ++a)
#pragma unroll
      for (int b = 0; b < 2; ++b)
#pragma unroll
        for (int m = 0; m < 4; ++m)
#pragma unroll
          for (int n = 0; n < 2; ++n) acc[a][b][m][n] = f32x4{0.f, 0.f, 0.f, 0.f};
    cur = nxt; cA = nA; cB = nB; ++ui;
    vc[0] = vn[0]; vc[1] = vn[1]; vc[2] = vn[2]; vc[3] = vn[3];
  }
  PG8_WAIT_V(0);
  if (wr == 0) PG8_BAR;
  PG8_BAR;
#undef PG8_SA
#undef PG8_SB
#undef PG8_STAGE2
#undef PG8_STAGEB
#undef PG8_LDA
#undef PG8_LDB
#undef PG8_MMA
#undef PG8_WAIT_V
#undef PG8_WAIT_L
#undef PG8_BAR
#undef PG8_SCHED
}
}

struct CfgInproj {
  static constexpr bool PERM = true;
  int K; const Params* p; int L; int bid, nb;
  DI bool next(int i, pg8::Unit& u) const { const int t = i * nb + bid; if (t >= 64 * 13) return false; u.pm = t & 63; u.pn = t >> 6; return true; }
  DI const char* a_base(const pg8::Unit& u) const { return (const char*)(p->hn() + (size_t)u.pm * 256 * DM); }
  DI const char* b_base(const pg8::Unit& u) const { return (const char*)(p->WinT() + ((size_t)L * PWP + (size_t)u.pn * 256) * DM); }
  DI void a_off(const pg8::Unit&, int R0, int C0, int R1, int C1, unsigned (&vo)[4]) const {
    vo[0] = (unsigned)(R0 * DM + C0) * 2u; vo[1] = (unsigned)(R1 * DM + C1) * 2u;
    vo[2] = vo[0] + 128u * DM * 2u; vo[3] = vo[1] + 128u * DM * 2u;
  }
  DI void epi(const f32x4 (&acc)[2][2][4][2], const pg8::Unit& u, int wr, int wc, int fr, int fq) const {
    const int row0 = u.pm * 256 + wr * 64 + fr, col0 = u.pn * 256 + wc * 32 + 8 * fq;
#pragma unroll
    for (int ai = 0; ai < 2; ++ai)
#pragma unroll
      for (int m = 0; m < 4; ++m) {
        u16* rowp = p->proj() + (size_t)(row0 + ai * 128 + m * 16) * PWP + col0;
#pragma unroll
        for (int bj = 0; bj < 2; ++bj) {
          uint4 w;
          w.x = pack2(acc[ai][bj][m][0][0], acc[ai][bj][m][0][1]); w.y = pack2(acc[ai][bj][m][0][2], acc[ai][bj][m][0][3]);
          w.z = pack2(acc[ai][bj][m][1][0], acc[ai][bj][m][1][1]); w.w = pack2(acc[ai][bj][m][1][2], acc[ai][bj][m][1][3]);
          *reinterpret_cast<uint4*>(rowp + bj * 128) = w;
        }
      }
  }
};
DI void ph_inproj_tail(const Params& p, int L, char* smem, int t) {
  const int m0 = (t & 63) * 256, n0 = 3072 + (t >> 6) * 128;
  const u16* Bt = p.WinT() + ((size_t)L * PWP + n0) * DM;
  gemm_tile([&](int r) { return p.hn() + (size_t)(m0 + r) * DM; }, Bt, DM, DM, smem,
            [&](f32x4 (&acc)[4][4], int wr, int wc, int fr, int fq) {
#pragma unroll
              for (int m = 0; m < 4; ++m)
#pragma unroll
                for (int n = 0; n < 4; ++n)
#pragma unroll
                  for (int j = 0; j < 4; ++j)
                    p.proj()[(size_t)(m0 + wr * 64 + m * 16 + fq * 4 + j) * PWP + n0 + wc * 64 + n * 16 + fr] = f2bf(acc[m][n][j]);
            });
}
DI void ph_inproj(const Params& p, int L, char* smem) {
  CfgInproj c; c.K = DM; c.p = &p; c.L = L; c.bid = obid(); c.nb = gridDim.x;
  pg8::gemm_phase((pg8::lds_u8*)smem, c);
}

DI void ph_gemm_store_bf16(const u16* A, int lda, const u16* Bt, int K, int M, int N, u16* C, int ldc, char* smem, int rot) {
  const int mt = M / 256, nt = N / 128;
  const int nb = gridDim.x;
  for (int t = (obid() + rot) % nb; t < mt * nt; t += nb) {
    const int m0 = (t % mt) * 256, n0 = (t / mt) * 128;
    gemm_tile([&](int r) { return A + (size_t)(m0 + r) * lda; }, Bt + (size_t)n0 * K, K, K, smem,
              [&](f32x4 (&acc)[4][4], int wr, int wc, int fr, int fq) {
#pragma unroll
                for (int m = 0; m < 4; ++m)
#pragma unroll
                  for (int n = 0; n < 4; ++n)
#pragma unroll
                    for (int j = 0; j < 4; ++j) {
                      const int row = m0 + wr * 64 + m * 16 + fq * 4 + j, col = n0 + wc * 64 + n * 16 + fr;
                      C[(size_t)row * ldc + col] = f2bf(acc[m][n][j]);
                    }
              });
  }
}

DI void ph_rmsnorm_bf16(const float* __restrict__ xin, const float* __restrict__ w, u16* __restrict__ outp) {
  const int tid_ = otid(); const int lane = tid_ & 63, gw = (obid() * NTHR + tid_) >> 6, nw = gridDim.x * (NTHR / 64);
  for (int t = gw; t < T; t += nw) {
    const float* xr = xin + (size_t)t * DM;
    float4 v[4];
    float ss = 0.f;
#pragma unroll
    for (int i = 0; i < 4; ++i) {
      v[i] = *reinterpret_cast<const float4*>(xr + (i * 64 + lane) * 4);
      ss += v[i].x * v[i].x + v[i].y * v[i].y + v[i].z * v[i].z + v[i].w * v[i].w;
    }
    ss = wave_sum(ss);
    const float rstd = rsqrtf(ss * (1.f / DM) + 1e-6f);
#pragma unroll
    for (int i = 0; i < 4; ++i) {
      const int c = (i * 64 + lane) * 4;
      const float4 ww = *reinterpret_cast<const float4*>(w + c);
      uint2 o;
      o.x = pack2(v[i].x * rstd * ww.x, v[i].y * rstd * ww.y);
      o.y = pack2(v[i].z * rstd * ww.z, v[i].w * rstd * ww.w);
      *reinterpret_cast<uint2*>(outp + (size_t)t * DM + c) = o;
    }
  }
}

DI void ph_final_norm(const float* __restrict__ xin, const float* __restrict__ w, float* __restrict__ outp) {
  const int tid_ = otid(); const int lane = tid_ & 63, gw = (obid() * NTHR + tid_) >> 6, nw = gridDim.x * (NTHR / 64);
  for (int t = gw; t < T; t += nw) {
    const float* xr = xin + (size_t)t * DM;
    float4 v[4];
    float ss = 0.f;
#pragma unroll
    for (int i = 0; i < 4; ++i) {
      v[i] = *reinterpret_cast<const float4*>(xr + (i * 64 + lane) * 4);
      ss += v[i].x * v[i].x + v[i].y * v[i].y + v[i].z * v[i].z + v[i].w * v[i].w;
    }
    ss = wave_sum(ss);
    const float rstd = rsqrtf(ss * (1.f / DM) + 1e-6f);
#pragma unroll
    for (int i = 0; i < 4; ++i) {
      const int c = (i * 64 + lane) * 4;
      const float4 ww = *reinterpret_cast<const float4*>(w + c);
      float4 o = make_float4(v[i].x * rstd * ww.x, v[i].y * rstd * ww.y, v[i].z * rstd * ww.z, v[i].w * rstd * ww.w);
      *reinterpret_cast<float4*>(outp + (size_t)t * DM + c) = o;
    }
  }
}

DI void rot8(const u16* x1p, const u16* x2p, const float* tab  , float scale, uint4& o1, uint4& o2) {
  float x1[8], x2[8], y1[8], y2[8];
  ld8(x1p, x1); ld8(x2p, x2);
#pragma unroll
  for (int e = 0; e < 8; e += 2) {
    const float4 cs = *reinterpret_cast<const float4*>(tab + e * 2);
    y1[e] = (x1[e] * cs.x - x2[e] * cs.y) * scale;
    y2[e] = (x2[e] * cs.x + x1[e] * cs.y) * scale;
    y1[e + 1] = (x1[e + 1] * cs.z - x2[e + 1] * cs.w) * scale;
    y2[e + 1] = (x2[e + 1] * cs.z + x1[e + 1] * cs.w) * scale;
  }
  o1.x = pack2(y1[0], y1[1]); o1.y = pack2(y1[2], y1[3]); o1.z = pack2(y1[4], y1[5]); o1.w = pack2(y1[6], y1[7]);
  o2.x = pack2(y2[0], y2[1]); o2.y = pack2(y2[2], y2[3]); o2.z = pack2(y2[4], y2[5]); o2.w = pack2(y2[6], y2[7]);
}
DI void ph_post(const Params& p, int L) {
  const int tid = otid();
  const int gt = obid() * NTHR + tid, gs = gridDim.x * NTHR;
  const int lane = tid & 63, gw = gt >> 6, nw = gs >> 6;
  const float* qnw = p.q_norm_w + L * 256;
  const float* kvnw = p.kv_norm_w + L * 128;
  const float* cw = p.conv_w + L * 5 * 768;
  const float* cb = p.conv_b + L * 768;
  const float* dtb = p.dt_bias + L * 8;
  for (int idx = gt; idx < T * 96; idx += gs) {
    const int t = idx / 96, cg = idx - t * 96, s = t & (SEQ - 1);
    float acc[8];
    {
      const float4 b0 = *reinterpret_cast<const float4*>(cb + cg * 8), b1 = *reinterpret_cast<const float4*>(cb + cg * 8 + 4);
      acc[0] = b0.x; acc[1] = b0.y; acc[2] = b0.z; acc[3] = b0.w; acc[4] = b1.x; acc[5] = b1.y; acc[6] = b1.z; acc[7] = b1.w;
    }
#pragma unroll
    for (int w = 0; w < 5; ++w) {
      const int ss = s + w - 2;
      if (ss >= 0 && ss < SEQ) {
        float xv[8];
        ld8(p.proj() + (size_t)(t + w - 2) * PWP + C_XBC + cg * 8, xv);
        const float4 w0 = *reinterpret_cast<const float4*>(cw + w * 768 + cg * 8), w1 = *reinterpret_cast<const float4*>(cw + w * 768 + cg * 8 + 4);
        acc[0] += xv[0] * w0.x; acc[1] += xv[1] * w0.y; acc[2] += xv[2] * w0.z; acc[3] += xv[3] * w0.w;
        acc[4] += xv[4] * w1.x; acc[5] += xv[5] * w1.y; acc[6] += xv[6] * w1.z; acc[7] += xv[7] * w1.w;
      }
    }
    uint4 o;
    o.x = pack2(fast_silu(acc[0]), fast_silu(acc[1])); o.y = pack2(fast_silu(acc[2]), fast_silu(acc[3]));
    o.z = pack2(fast_silu(acc[4]), fast_silu(acc[5])); o.w = pack2(fast_silu(acc[6]), fast_silu(acc[7]));
    *reinterpret_cast<uint4*>(p.xbc() + (size_t)t * 768 + cg * 8) = o;
  }
  for (int idx = gt; idx < T * 8; idx += gs) {
    const int t = idx >> 3, k = idx & 7;
    const float v = bf2f(p.proj()[(size_t)t * PWP + C_DT + k]) + dtb[k];
    p.dtv()[idx] = (v > 20.f) ? v : log1pf(expf(v));
  }
  {
    const int sub = lane >> 4, l16 = lane & 15;
    for (int t = gw * 4 + sub; t < T; t += nw * 4) {
      const u16* pr = p.proj() + (size_t)t * PWP;
      float v[16], u[8];
      ld8(pr + C_CQ + l16 * 16, v); ld8(pr + C_CQ + l16 * 16 + 8, v + 8);
      ld8(pr + C_CKV + l16 * 8, u);
      float ss = 0.f, s2 = 0.f;
#pragma unroll
      for (int i = 0; i < 16; ++i) ss += v[i] * v[i];
#pragma unroll
      for (int i = 0; i < 8; ++i) s2 += u[i] * u[i];
#pragma unroll
      for (int o = 1; o < 16; o <<= 1) { ss += __shfl_xor(ss, o); s2 += __shfl_xor(s2, o); }
      const float rstd = rsqrtf(ss * (1.f / 256.f) + 1e-6f), r2 = rsqrtf(s2 * (1.f / 128.f) + 1e-6f);
      uint4 o;
      const float* qw = qnw + l16 * 16;
      o.x = pack2(v[0] * rstd * qw[0], v[1] * rstd * qw[1]); o.y = pack2(v[2] * rstd * qw[2], v[3] * rstd * qw[3]);
      o.z = pack2(v[4] * rstd * qw[4], v[5] * rstd * qw[5]); o.w = pack2(v[6] * rstd * qw[6], v[7] * rstd * qw[7]);
      *reinterpret_cast<uint4*>(p.cqn() + (size_t)t * 256 + l16 * 16) = o;
      o.x = pack2(v[8] * rstd * qw[8], v[9] * rstd * qw[9]); o.y = pack2(v[10] * rstd * qw[10], v[11] * rstd * qw[11]);
      o.z = pack2(v[12] * rstd * qw[12], v[13] * rstd * qw[13]); o.w = pack2(v[14] * rstd * qw[14], v[15] * rstd * qw[15]);
      *reinterpret_cast<uint4*>(p.cqn() + (size_t)t * 256 + l16 * 16 + 8) = o;
      const float* kw = kvnw + l16 * 8;
      o.x = pack2(u[0] * r2 * kw[0], u[1] * r2 * kw[1]); o.y = pack2(u[2] * r2 * kw[2], u[3] * r2 * kw[3]);
      o.z = pack2(u[4] * r2 * kw[4], u[5] * r2 * kw[5]); o.w = pack2(u[6] * r2 * kw[6], u[7] * r2 * kw[7]);
      *reinterpret_cast<uint4*>(p.ckvn() + (size_t)t * 128 + l16 * 8) = o;
    }
  }
  for (int idx = gt; idx < T * 42; idx += gs) {
    const int t = idx / 42, ri = idx - t * 42, s = t & (SEQ - 1);
    u16* pr = p.proj() + (size_t)t * PWP;
    uint4 o1, o2;
    if (ri < 32) {
      const int isk = ri >> 4, h = (ri >> 2) & 3, i0 = (ri & 3) * 8;
      u16* a = pr + (isk ? C_RK : C_RQ) + h * 64 + i0;
      rot8(a, a + 32, p.rtab() + ((size_t)s * 56 + i0) * 2, isk ? 1.f : 0.125f, o1, o2);
      *reinterpret_cast<uint4*>(a) = o1;
      *reinterpret_cast<uint4*>(a + 32) = o2;
    } else if (ri < 40) {
      const int j = ri - 32, isk = j >> 2, h = j & 3;
      u16* a = pr + (isk ? C_DK : C_DQ) + h * 64;
      rot8(a, a + 8, p.rtab() + ((size_t)s * 56 + 32) * 2, 1.f, o1, o2);
      *reinterpret_cast<uint4*>(a) = o1;
      *reinterpret_cast<uint4*>(a + 8) = o2;
    } else {
      const int i0 = (ri - 40) * 8;
      u16* a = pr + C_KR + i0;
      rot8(a, a + 16, p.rtab() + ((size_t)s * 56 + 40 + i0) * 2, 1.f, o1, o2);
      *reinterpret_cast<uint4*>(a) = o1;
      *reinterpret_cast<uint4*>(a + 16) = o2;
      const int bb = t >> 12;
#pragma unroll
      for (int hd = 0; hd < 4; ++hd) {
        u16* kf = p.kfull() + ((size_t)(bb * 4 + hd) * SEQ + s) * 96 + 64 + i0;
        *reinterpret_cast<uint4*>(kf) = o1;
        *reinterpret_cast<uint4*>(kf + 16) = o2;
      }
    }
  }
}

DI void ph_mla_up_q(const Params& p, int L, char* smem, int t) {
  const int mt = T / 256;
  const u16* Bq = p.WuqT() + (size_t)L * 384 * 256;
  {
    const int m0 = (t % mt) * 256, n0 = (t / mt) * 128;
    gemm_tile([&](int r) { return p.cqn() + (size_t)(m0 + r) * 256; }, Bq + (size_t)n0 * 256, 256, 256, smem,
              [&](f32x4 (&acc)[4][4], int wr, int wc, int fr, int fq) {
                const float scale = 0.10206207261596575f * 1.4426950408889634f;
#pragma unroll
                for (int m = 0; m < 4; ++m)
#pragma unroll
                  for (int j = 0; j < 4; ++j) {
                    const int row = m0 + wr * 64 + m * 16 + fq * 4 + j;
                    const float2 cssn = *reinterpret_cast<const float2*>(p.rtab() + ((size_t)(row & (SEQ - 1)) * 56 + 40 + fr) * 2);
                    const float cs = cssn.x, sn = cssn.y;
#pragma unroll
                    for (int n2 = 0; n2 < 4; n2 += 2) {
                      const int cb = n0 + wc * 64 + n2 * 16;
                      float x1 = acc[m][n2][j], x2 = acc[m][n2 + 1][j];
                      if (cb % 96 == 64) {
                        const float y1 = x1 * cs - x2 * sn, y2 = x2 * cs + x1 * sn;
                        x1 = y1; x2 = y2;
                      }
                      p.mq()[(size_t)row * 384 + cb + fr] = f2bf(x1 * scale);
                      p.mq()[(size_t)row * 384 + cb + 16 + fr] = f2bf(x2 * scale);
                    }
                  }
              });
  }
}
DI void ph_mla_up_kv(const Params& p, int L, char* smem, int t) {
  const int mt = T / 256;
  const u16* Bkv = p.WukvT() + (size_t)L * 512 * 128;
  {
    const int m0 = (t % mt) * 256, h = t / mt, n0 = h * 128;
    gemm_tile([&](int r) { return p.ckvn() + (size_t)(m0 + r) * 128; }, Bkv + (size_t)n0 * 128, 128, 128, smem,
              [&](f32x4 (&acc)[4][4], int wr, int wc, int fr, int fq) {
#pragma unroll
                for (int m = 0; m < 4; ++m) {
                  const int row = m0 + wr * 64 + m * 16 + fq * 4;
                  const int bb = row >> 12, sq = row & (SEQ - 1);
                  const size_t bh = (size_t)(bb * 4 + h);
#pragma unroll
                  for (int n = 0; n < 4; ++n) {
                    if (wc == 0) {
#pragma unroll
                      for (int j = 0; j < 4; ++j) p.kfull()[(bh * SEQ + sq + j) * 96 + n * 16 + fr] = f2bf(acc[m][n][j]);
                    } else {
                      uint2 v;
                      v.x = pack2(acc[m][n][0], acc[m][n][1]);
                      v.y = pack2(acc[m][n][2], acc[m][n][3]);
                      const int sqp = (sq & ~12) | ((sq & 4) << 1) | ((sq & 8) >> 1);
                      *reinterpret_cast<uint2*>(p.vT() + (bh * 64 + n * 16 + fr) * SEQ + sqp) = v;
                    }
                  }
                }
              });
  }
}

DI void ph_cumsum(const Params& p, int L) {
  const int tid_ = otid(); const int lane = tid_ & 63, gw = (obid() * NTHR + tid_) >> 6, nw = gridDim.x * (NTHR / 64);
  for (int it = gw; it < 32; it += nw) {
    const int h = it & 3, dir = (it >> 2) & 1, b = it >> 3;
    const float a = -expf(p.a_log[L * 8 + dir * 4 + h]);
    float running = 0.f;
    for (int c = 0; c < 64; ++c) {
      const int i = c * 64 + lane;
      const int s = dir ? (SEQ - 1 - i) : i;
      const size_t off = (size_t)(b * SEQ + s) * 8 + dir * 4 + h;
      float v = p.dtv()[off] * a;
#pragma unroll
      for (int o = 1; o < 64; o <<= 1) {
        const float u = __shfl_up(v, o);
        if (lane >= o) v += u;
      }
      v += running;
      p.cs()[off] = v;
      running = __shfl(v, 63);
    }
  }
}

DI void ph_ret_naive(const Params& p) {
  const int gt = obid() * NTHR + otid(), gs = gridDim.x * NTHR;
  for (int it = gt; it < 4 * 4 * SEQ; it += gs) {
    const int n = it & (SEQ - 1), h = (it >> 12) & 3, b = it >> 14;
    const u16* base = p.proj() + (size_t)(b * SEQ) * PWP;
    uint4 qp[8];
    float o[64];
#pragma unroll
    for (int d = 0; d < 8; ++d) qp[d] = *reinterpret_cast<const uint4*>(base + (size_t)n * PWP + C_RQ + h * 64 + d * 8);
#pragma unroll
    for (int d = 0; d < 64; ++d) o[d] = 0.f;
    const float lg0 = log1pf(-exp2f(-5.f - (float)h)), lg1 = log1pf(-exp2f(-5.5f - (float)h));
#pragma unroll 1
    for (int m = 0; m < SEQ; ++m) {
      const u16* kr = base + (size_t)m * PWP + C_RK + h * 64;
      const u16* vr = base + (size_t)m * PWP + C_RV + h * 64;
      float s = 0.f;
#pragma unroll
      for (int d = 0; d < 8; ++d) s = dot8(qp[d], *reinterpret_cast<const uint4*>(kr + d * 8), s);
      const float w = (m <= n) ? expf(lg0 * (float)(n - m)) : expf(lg1 * (float)(m - n));
      s *= w;
#pragma unroll
      for (int d = 0; d < 64; d += 8) {
        float vf[8];
        ld8(vr + d, vf);
#pragma unroll
        for (int j = 0; j < 8; ++j) o[d + j] += s * vf[j];
      }
    }
    float mu = 0.f;
#pragma unroll
    for (int d = 0; d < 64; ++d) mu += o[d];
    mu *= (1.f / 64.f);
    float var = 0.f;
#pragma unroll
    for (int d = 0; d < 64; ++d) var += (o[d] - mu) * (o[d] - mu);
    var *= (1.f / 64.f);
    const float rs = rsqrtf(var + 1e-5f);
    const size_t t = (size_t)b * SEQ + n;
#pragma unroll
    for (int d = 0; d < 64; d += 8) {
      float g[8];
      ld8(p.proj() + t * PWP + C_RG + h * 64 + d, g);
      uint4 ov;
      ov.x = pack2(silu(g[0]) * (o[d + 0] - mu) * rs, silu(g[1]) * (o[d + 1] - mu) * rs);
      ov.y = pack2(silu(g[2]) * (o[d + 2] - mu) * rs, silu(g[3]) * (o[d + 3] - mu) * rs);
      ov.z = pack2(silu(g[4]) * (o[d + 4] - mu) * rs, silu(g[5]) * (o[d + 5] - mu) * rs);
      ov.w = pack2(silu(g[6]) * (o[d + 6] - mu) * rs, silu(g[7]) * (o[d + 7] - mu) * rs);
      *reinterpret_cast<uint4*>(p.mixed() + t * DM + h * 64 + d) = ov;
    }
  }
}

DI void ph_mla_naive(const Params& p) {
  const int gt = obid() * NTHR + otid(), gs = gridDim.x * NTHR;
  for (int it = gt; it < 2 * 4 * 4 * SEQ; it += gs) {
    const int n = it & (SEQ - 1), vh = (it >> 12) & 1, h = (it >> 13) & 3, b = it >> 15;
    const size_t t = (size_t)b * SEQ + n;
    uint4 qp[12];
    float o[32];
#pragma unroll
    for (int d = 0; d < 12; ++d) qp[d] = *reinterpret_cast<const uint4*>(p.mq() + t * 384 + h * 96 + d * 8);
    const size_t tb = (size_t)b * SEQ;
    float mx = -1e30f;
#pragma unroll 1
    for (int m = 0; m < SEQ; ++m) {
      const u16* kn = ((u16*)nullptr) + (tb + m) * 512 + h * 128;
      const u16* kr = p.proj() + (tb + m) * PWP + C_KR;
      float s = 0.f;
#pragma unroll
      for (int d = 0; d < 8; ++d) s = dot8(qp[d], *reinterpret_cast<const uint4*>(kn + d * 8), s);
#pragma unroll
      for (int d = 0; d < 4; ++d) s = dot8(qp[8 + d], *reinterpret_cast<const uint4*>(kr + d * 8), s);
      mx = fmaxf(mx, s);
    }
#pragma unroll
    for (int d = 0; d < 32; ++d) o[d] = 0.f;
    float l = 0.f;
#pragma unroll 1
    for (int m = 0; m < SEQ; ++m) {
      const u16* kn = ((u16*)nullptr) + (tb + m) * 512 + h * 128;
      const u16* kr = p.proj() + (tb + m) * PWP + C_KR;
      float s = 0.f;
#pragma unroll
      for (int d = 0; d < 8; ++d) s = dot8(qp[d], *reinterpret_cast<const uint4*>(kn + d * 8), s);
#pragma unroll
      for (int d = 0; d < 4; ++d) s = dot8(qp[8 + d], *reinterpret_cast<const uint4*>(kr + d * 8), s);
      const float pe = exp2f(s - mx);
      l += pe;
#pragma unroll
      for (int d = 0; d < 32; d += 8) {
        float vf[8];
        ld8(kn + 64 + vh * 32 + d, vf);
#pragma unroll
        for (int j = 0; j < 8; ++j) o[d + j] += pe * vf[j];
      }
    }
    const float il = 1.f / l;
#pragma unroll
    for (int d = 0; d < 32; d += 8) {
      uint4 ov;
      ov.x = pack2(o[d + 0] * il, o[d + 1] * il);
      ov.y = pack2(o[d + 2] * il, o[d + 3] * il);
      ov.z = pack2(o[d + 4] * il, o[d + 5] * il);
      ov.w = pack2(o[d + 6] * il, o[d + 7] * il);
      *reinterpret_cast<uint4*>(p.mixed() + t * DM + 256 + h * 64 + vh * 32 + d) = ov;
    }
  }
}

#define MFMA32(a, b, c) __builtin_amdgcn_mfma_f32_32x32x16_bf16((a), (b), (c), 0, 0, 0)
DI float max16(const f32x16& v) {
  float a = fmaxf(fmaxf(v[0], v[1]), v[2]), b = fmaxf(fmaxf(v[3], v[4]), v[5]), c = fmaxf(fmaxf(v[6], v[7]), v[8]);
  float d = fmaxf(fmaxf(v[9], v[10]), v[11]), e = fmaxf(fmaxf(v[12], v[13]), v[14]);
  return fmaxf(fmaxf(fmaxf(a, b), fmaxf(c, d)), fmaxf(e, v[15]));
}
DI void ph_mla_attn(const Params& p, char* smem) {
  const int tid = otid(), wid = tid >> 6, lane = tid & 63, l32 = lane & 31, hh = lane >> 5;
  u16* sK = reinterpret_cast<u16*>(smem);
  u16* sV = sK + 2 * 128 * 104;
  uint4 konev = make_uint4(hh == 0 ? 0x00003F80u : 0u, 0u, 0u, 0u);
  const bf16x8 kone = __builtin_bit_cast(bf16x8, konev);
  for (int item = obid(); item < 256; item += gridDim.x) {
    const int xcd_ = item & 7, jx_ = item >> 3, bh = xcd_ * 2 + (jx_ >> 4), qt = jx_ & 15, b = bh >> 2, h = bh & 3;
    const size_t t0 = (size_t)b * SEQ + qt * 256 + wid * 32;
    bf16x8 qf[6];
#pragma unroll
    for (int ks = 0; ks < 6; ++ks) qf[ks] = *reinterpret_cast<const bf16x8*>(p.mq() + (t0 + l32) * 384 + h * 96 + ks * 16 + hh * 8);
    const u16* kg = p.kfull() + (size_t)bh * SEQ * 96;
    const u16* vg = p.vT() + (size_t)bh * 64 * SEQ;
    f32x16 o0, o1;
#pragma unroll
    for (int i = 0; i < 16; ++i) { o0[i] = 0.f; o1[i] = 0.f; }
    float m = 0.f, l = 0.f;
    bf16x8 qf6 = __builtin_bit_cast(bf16x8, make_uint4(0u, 0u, 0u, 0u));
    const int kr0 = tid / 12, kc0 = tid % 12, kr1 = (512 + tid) / 12, kc1 = (512 + tid) % 12, kr2 = (1024 + tid) / 12, kc2 = (1024 + tid) % 12;
    const int vd0 = tid >> 4, vd1 = 32 + (tid >> 4), vkc = (tid & 15) * 8;
    uint4 ak0, ak1, ak2, av0, av1;
#define MLA_LD(dst_, ptr_) asm volatile("global_load_dwordx4 %0, %1, off" : "=v"(dst_) : "v"(ptr_) : "memory")
#define MLA_GLOAD(K0, K1, K2, V0, V1, kt_)                                               \
    {                                                                                    \
      const u16* kb_ = kg + (size_t)(kt_) * 128 * 96 + tid * 8;                          \
      MLA_LD(K0, kb_); MLA_LD(K1, kb_ + 512 * 8); MLA_LD(K2, kb_ + 1024 * 8);            \
      const u16* vp_ = vg + (size_t)vd0 * SEQ + (kt_) * 128 + vkc;                       \
      MLA_LD(V0, vp_); MLA_LD(V1, vp_ + (size_t)32 * SEQ);                               \
    }
#define MLA_SSTORE(K0, K1, K2, V0, V1, buf_)                                             \
    {                                                                                    \
      u16* kb_ = sK + (buf_) * 128 * 104;                                                \
      u16* vb_ = sV + (buf_) * 64 * 136;                                                 \
      *reinterpret_cast<uint4*>(kb_ + kr0 * 104 + kc0 * 8) = K0;                         \
      *reinterpret_cast<uint4*>(kb_ + kr1 * 104 + kc1 * 8) = K1;                         \
      *reinterpret_cast<uint4*>(kb_ + kr2 * 104 + kc2 * 8) = K2;                         \
      *reinterpret_cast<uint4*>(vb_ + vd0 * 136 + vkc) = V0;                             \
      *reinterpret_cast<uint4*>(vb_ + vd1 * 136 + vkc) = V1;                             \
    }
    float mxrun = 0.f;
#define SGB(mask, n) __builtin_amdgcn_sched_group_barrier((mask), (n), 0)
#define MLA_KFRAG(kb_, sub_, ks_) (*reinterpret_cast<const bf16x8*>((kb_) + ((sub_) * 32 + l32) * 104 + (ks_) * 16 + hh * 8))
#define MLA_VFRAG(dst_, vb_, sub_, ks2_, dvt_) \
    dst_ = *reinterpret_cast<const bf16x8*>((vb_) + ((dvt_) * 32 + l32) * 136 + (sub_) * 32 + (ks2_) * 16 + hh * 8)
#define MLA_SOFTMAX(sc_, pa_, pb_)                                                                         \
    {                                                                                                      \
      mxrun = fmaxf(mxrun, max16(sc_));                                                                    \
      float ps0_ = 0.f, ps1_ = 0.f;                                                                        \
      _Pragma("unroll") for (int i = 0; i < 16; i += 2) {                                                  \
        sc_[i] = __builtin_amdgcn_exp2f(sc_[i]); sc_[i + 1] = __builtin_amdgcn_exp2f(sc_[i + 1]);          \
        ps0_ += sc_[i]; ps1_ += sc_[i + 1];                                                                \
      }                                                                                                    \
      l += ps0_ + ps1_;                                                                                    \
      uint4 pk_;                                                                                           \
      pk_.x = pack2(sc_[0], sc_[1]); pk_.y = pack2(sc_[2], sc_[3]); pk_.z = pack2(sc_[4], sc_[5]); pk_.w = pack2(sc_[6], sc_[7]); \
      pa_ = __builtin_bit_cast(bf16x8, pk_);                                                               \
      pk_.x = pack2(sc_[8], sc_[9]); pk_.y = pack2(sc_[10], sc_[11]); pk_.z = pack2(sc_[12], sc_[13]); pk_.w = pack2(sc_[14], sc_[15]); \
      pb_ = __builtin_bit_cast(bf16x8, pk_);                                                               \
    }
    auto compute_tile = [&](int cur, int half) {
      const u16* kb = sK + cur * 128 * 104 + half * 64 * 104;
      const u16* vb = sV + cur * 64 * 136 + half * 64;
      bf16x8 k0[6], k1[6];
#pragma unroll
      for (int ks = 0; ks < 6; ++ks) { k0[ks] = MLA_KFRAG(kb, 0, ks); k1[ks] = MLA_KFRAG(kb, 1, ks); }
      f32x16 s0, s1;
#pragma unroll
      for (int i = 0; i < 16; ++i) { s0[i] = 0.f; s1[i] = 0.f; }
#pragma unroll
      for (int ks = 0; ks < 6; ++ks) s0 = MFMA32(k0[ks], qf[ks], s0);
      s0 = MFMA32(kone, qf6, s0);
      bf16x8 v00, v01, v02, v03, v10, v11, v12, v13;
      MLA_VFRAG(v00, vb, 0, 0, 0); MLA_VFRAG(v01, vb, 0, 0, 1); MLA_VFRAG(v02, vb, 0, 1, 0); MLA_VFRAG(v03, vb, 0, 1, 1);
#pragma unroll
      for (int ks = 0; ks < 6; ++ks) s1 = MFMA32(k1[ks], qf[ks], s1);
      s1 = MFMA32(kone, qf6, s1);
      MLA_VFRAG(v10, vb, 1, 0, 0); MLA_VFRAG(v11, vb, 1, 0, 1); MLA_VFRAG(v12, vb, 1, 1, 0); MLA_VFRAG(v13, vb, 1, 1, 1);
      bf16x8 p0a, p0b, p1a, p1b;
      MLA_SOFTMAX(s0, p0a, p0b);
      o0 = MFMA32(v00, p0a, o0); o1 = MFMA32(v01, p0a, o1); o0 = MFMA32(v02, p0b, o0); o1 = MFMA32(v03, p0b, o1);
      MLA_SOFTMAX(s1, p1a, p1b);
      o0 = MFMA32(v10, p1a, o0); o1 = MFMA32(v11, p1a, o1); o0 = MFMA32(v12, p1b, o0); o1 = MFMA32(v13, p1b, o1);
      SGB(0x100, 12);
#pragma unroll
      for (int i = 0; i < 7; ++i) { SGB(0x008, 1); if (i < 4) SGB(0x100, 1); }
#pragma unroll
      for (int i = 0; i < 7; ++i) { SGB(0x008, 1); if (i < 4) SGB(0x100, 1); SGB(0x402, 7); }
#pragma unroll
      for (int i = 0; i < 4; ++i) { SGB(0x008, 1); SGB(0x402, 12); }
#pragma unroll
      for (int i = 0; i < 4; ++i) SGB(0x008, 1);
    };
    auto lazy_update = [&]() {
      const float mxr = fmaxf(mxrun, __shfl_xor(mxrun, 32));
      if (__builtin_amdgcn_ballot_w64(mxr > 8.f) != 0ull) {
        float d = (mxr > 8.f) ? mxr : 0.f;
        const float mnew = bf2f(f2bf(m + d));
        d = mnew - m;
        m = mnew;
        const float alpha = __builtin_amdgcn_exp2f(-d);
        l *= alpha;
        mxrun -= d;
#pragma unroll
        for (int i = 0; i < 16; ++i) { o0[i] *= alpha; o1[i] *= alpha; }
        uint4 qv = make_uint4(0u, 0u, 0u, 0u);
        if (hh == 0) qv.x = (unsigned)f2bf(-m);
        qf6 = __builtin_bit_cast(bf16x8, qv);
      }
    };
    MLA_GLOAD(ak0, ak1, ak2, av0, av1, 0);
    asm volatile("s_waitcnt vmcnt(0)" ::: "memory");
    MLA_SSTORE(ak0, ak1, ak2, av0, av1, 0);
    __syncthreads();
    {
      f32x16 s0, s1;
#pragma unroll
      for (int i = 0; i < 16; ++i) { s0[i] = 0.f; s1[i] = 0.f; }
#pragma unroll
      for (int ks = 0; ks < 6; ++ks) { s0 = MFMA32(MLA_KFRAG(sK, 0, ks), qf[ks], s0); s1 = MFMA32(MLA_KFRAG(sK, 1, ks), qf[ks], s1); }
      float mx = fmaxf(max16(s0), max16(s1));
      mx = fmaxf(mx, __shfl_xor(mx, 32));
      m = bf2f(f2bf(mx));
      uint4 qv = make_uint4(0u, 0u, 0u, 0u);
      if (hh == 0) qv.x = (unsigned)f2bf(-m);
      qf6 = __builtin_bit_cast(bf16x8, qv);
    }
#pragma unroll 1
    for (int kt = 0; kt < 32; kt += 2) {
      MLA_GLOAD(ak0, ak1, ak2, av0, av1, kt + 1);
#pragma unroll 1
      for (int half = 0; half < 2; ++half) compute_tile(0, half);
      asm volatile("s_waitcnt vmcnt(0)" ::: "memory");
      MLA_SSTORE(ak0, ak1, ak2, av0, av1, 1);
      __syncthreads();
      lazy_update();
      if (kt + 2 < 32) MLA_GLOAD(ak0, ak1, ak2, av0, av1, kt + 2);
#pragma unroll 1
      for (int half = 0; half < 2; ++half) compute_tile(1, half);
      if (kt + 2 < 32) {
        asm volatile("s_waitcnt vmcnt(0)" ::: "memory");
        MLA_SSTORE(ak0, ak1, ak2, av0, av1, 0);
      }
      __syncthreads();
      lazy_update();
    }
    l += __shfl_xor(l, 32);
    const float il = 1.f / l;
    u16* orow = p.mixed() + (t0 + l32) * DM + 256 + h * 64 + hh * 4;
#pragma unroll
    for (int g = 0; g < 4; ++g) {
      uint2 v;
      v.x = pack2(o0[4 * g + 0] * il, o0[4 * g + 1] * il);
      v.y = pack2(o0[4 * g + 2] * il, o0[4 * g + 3] * il);
      *reinterpret_cast<uint2*>(orow + g * 8) = v;
      v.x = pack2(o1[4 * g + 0] * il, o1[4 * g + 1] * il);
      v.y = pack2(o1[4 * g + 2] * il, o1[4 * g + 3] * il);
      *reinterpret_cast<uint2*>(orow + 32 + g * 8) = v;
    }
  }
}

typedef __attribute__((address_space(3))) s16x4 lds_s16x4;
template <int MODE>
DI void ph_dil_pass(const Params& p, char* smem, int blk_) {
  const int tid = otid(), wid = tid >> 6, lane = tid & 63, l32 = lane & 31, hh = lane >> 5;
  u16* sV = reinterpret_cast<u16*>(smem) + wid * (2 * 32 * 72);
  const int i16 = lane & 15, tq = i16 >> 2, tp = i16 & 3, tblk = (lane >> 4) & 1;
  {
    constexpr int NT = (MODE == 0) ? 13 : 5;
    const int it = wid, xcd_ = blk_ & 7, jx_ = blk_ >> 3, bh = xcd_ * 2 + (jx_ >> 4), r = jx_ & 15, b = bh >> 2, h = bh & 3;
    const int i0 = it * 32;
    const int q0 = (r * 8 + it) * 32;
    const int qpos = (MODE == 0) ? (r + 16 * (i0 + l32)) : (q0 + l32);
    const size_t tb = (size_t)b * SEQ;
    const u16* kbase = p.proj() + tb * PWP + C_DK + h * 64;
    const u16* vbase = p.proj() + tb * PWP + C_DV + h * 64;
    bf16x8 qf[4];
    {
      const u16* qp = p.proj() + (tb + qpos) * PWP + C_DQ + h * 64 + hh * 8;
#pragma unroll
      for (int ks = 0; ks < 4; ++ks) qf[ks] = *reinterpret_cast<const bf16x8*>(qp + ks * 16);
    }
    f32x16 o0, o1;
#pragma unroll
    for (int i = 0; i < 16; ++i) { o0[i] = 0.f; o1[i] = 0.f; }
    float m = -1e30f, l = 0.f;
    auto tile_params = [&](int tt, int& d, int& rd, int& ub, int& ulim, int& qb, int& qs) {
      if (MODE == 0) {
        if (tt < 5) { d = 16; rd = r; qb = i0; qs = 1; ulim = 256; ub = qb - 64 + 32 * tt; }
        else { d = 4; rd = r & 3; qb = (r >> 2) + 4 * i0; qs = 4; ulim = 1024; ub = qb - 64 + 32 * (tt - 5); }
      } else { d = 1; rd = 0; qb = q0; qs = 1; ulim = 4096; ub = qb - 64 + 32 * tt; }
    };
    bf16x8 ka0, ka1, ka2, ka3, kb0, kb1, kb2, kb3;
    uint4 va0, va1, va2, va3, vb0, vb1, vb2, vb3;
#define DIL_LD(dst_, ptr_) asm volatile("global_load_dwordx4 %0, %1, off" : "=v"(dst_) : "v"(ptr_) : "memory")
#define DIL_GLOAD(K0, K1, K2, K3, V0, V1, V2, V3, tt_)                                                   \
    {                                                                                                    \
      int d_, rd_, ub_, ulim_, qb_, qs_;                                                                 \
      tile_params((tt_), d_, rd_, ub_, ulim_, qb_, qs_);                                                 \
      int u_ = min(max(ub_ + l32, 0), ulim_ - 1);                                                        \
      const u16* kp_ = kbase + (size_t)(rd_ + d_ * u_) * PWP + hh * 8;                                   \
      DIL_LD(K0, kp_); DIL_LD(K1, kp_ + 16); DIL_LD(K2, kp_ + 32); DIL_LD(K3, kp_ + 48);                 \
      const int kr_ = ub_ + (lane >> 3);                                                                 \
      const u16* vp_;                                                                                    \
      u_ = min(max(kr_, 0), ulim_ - 1);      vp_ = vbase + (size_t)(rd_ + d_ * u_) * PWP + (lane & 7) * 8; DIL_LD(V0, vp_); \
      u_ = min(max(kr_ + 8, 0), ulim_ - 1);  vp_ = vbase + (size_t)(rd_ + d_ * u_) * PWP + (lane & 7) * 8; DIL_LD(V1, vp_); \
      u_ = min(max(kr_ + 16, 0), ulim_ - 1); vp_ = vbase + (size_t)(rd_ + d_ * u_) * PWP + (lane & 7) * 8; DIL_LD(V2, vp_); \
      u_ = min(max(kr_ + 24, 0), ulim_ - 1); vp_ = vbase + (size_t)(rd_ + d_ * u_) * PWP + (lane & 7) * 8; DIL_LD(V3, vp_); \
    }
#define DIL_VSTORE(V0, V1, V2, V3, buf_)                                                                 \
    {                                                                                                    \
      u16* vb_ = sV + (buf_) * 32 * 72 + (lane >> 3) * 72 + (lane & 7) * 8;                              \
      *reinterpret_cast<uint4*>(vb_) = V0;                                                               \
      *reinterpret_cast<uint4*>(vb_ + 8 * 72) = V1;                                                      \
      *reinterpret_cast<uint4*>(vb_ + 16 * 72) = V2;                                                     \
      *reinterpret_cast<uint4*>(vb_ + 24 * 72) = V3;                                                     \
    }
    auto tile_rest = [&](int tt, f32x16 sc, int cur) {
      int d, rd, ub, ulim, qb, qs;
      tile_params(tt, d, rd, ub, ulim, qb, qs);
      const int uq = qb + qs * l32;
      const float cs = 0.125f * 1.4426950408889634f;
      float mx = -1e30f;
#pragma unroll
      for (int i = 0; i < 16; ++i) {
        const int u = ub + (i & 3) + 8 * (i >> 2) + 4 * hh;
        const int du = u - uq;
        const bool valid = (u >= 0) && (u < ulim) && (du <= 64) && (du >= -64);
        sc[i] = valid ? sc[i] * cs : -1e30f;
        mx = fmaxf(mx, sc[i]);
      }
      mx = fmaxf(mx, __shfl_xor(mx, 32));
      const float mn = fmaxf(m, mx);
      const float alpha = __builtin_amdgcn_exp2f(m - mn);
      m = mn;
      float ps = 0.f;
#pragma unroll
      for (int i = 0; i < 16; ++i) {
        float pe = __builtin_amdgcn_exp2f(sc[i] - mn);
        pe = (sc[i] > -1e29f) ? pe : 0.f;
        ps += pe;
        sc[i] = pe;
      }
      l = l * alpha + ps;
#pragma unroll
      for (int i = 0; i < 16; ++i) { o0[i] *= alpha; o1[i] *= alpha; }
      const u16* vb = sV + cur * 32 * 72;
#pragma unroll
      for (int ks2 = 0; ks2 < 2; ++ks2) {
        uint4 pk;
        pk.x = pack2(sc[8 * ks2 + 0], sc[8 * ks2 + 1]);
        pk.y = pack2(sc[8 * ks2 + 2], sc[8 * ks2 + 3]);
        pk.z = pack2(sc[8 * ks2 + 4], sc[8 * ks2 + 5]);
        pk.w = pack2(sc[8 * ks2 + 6], sc[8 * ks2 + 7]);
        const bf16x8 pb = __builtin_bit_cast(bf16x8, pk);
#pragma unroll
        for (int dvt = 0; dvt < 2; ++dvt) {
          const u16* a0 = vb + (16 * ks2 + 4 * hh + tq) * 72 + dvt * 32 + tblk * 16 + tp * 4;
          const s16x4 lo = __builtin_amdgcn_ds_read_tr16_b64_v4i16((lds_s16x4*)(a0));
          const s16x4 hi = __builtin_amdgcn_ds_read_tr16_b64_v4i16((lds_s16x4*)(a0 + 8 * 72));
          const bf16x8 a = __builtin_shufflevector(lo, hi, 0, 1, 2, 3, 4, 5, 6, 7);
          if (dvt == 0) o0 = MFMA32(a, pb, o0); else o1 = MFMA32(a, pb, o1);
        }
      }
    };
    DIL_GLOAD(ka0, ka1, ka2, ka3, va0, va1, va2, va3, 0);
    DIL_GLOAD(kb0, kb1, kb2, kb3, vb0, vb1, vb2, vb3, 1);
    asm volatile("s_waitcnt vmcnt(8)" ::: "memory");
    DIL_VSTORE(va0, va1, va2, va3, 0);
#pragma unroll 1
    for (int tt = 0; tt < NT; tt += 2) {
      {
        f32x16 sc;
#pragma unroll
        for (int i = 0; i < 16; ++i) sc[i] = 0.f;
        sc = MFMA32(ka0, qf[0], sc); sc = MFMA32(ka1, qf[1], sc); sc = MFMA32(ka2, qf[2], sc); sc = MFMA32(ka3, qf[3], sc);
        asm volatile("" :: "v"(sc));
        if (tt + 2 < NT) DIL_GLOAD(ka0, ka1, ka2, ka3, va0, va1, va2, va3, tt + 2);
        tile_rest(tt, sc, 0);
        if (tt + 1 < NT) {
          if (tt + 2 < NT) asm volatile("s_waitcnt vmcnt(8)" ::: "memory"); else asm volatile("s_waitcnt vmcnt(0)" ::: "memory");
          DIL_VSTORE(vb0, vb1, vb2, vb3, 1);
        }
      }
      if (tt + 1 < NT) {
        f32x16 sc;
#pragma unroll
        for (int i = 0; i < 16; ++i) sc[i] = 0.f;
        sc = MFMA32(kb0, qf[0], sc); sc = MFMA32(kb1, qf[1], sc); sc = MFMA32(kb2, qf[2], sc); sc = MFMA32(kb3, qf[3], sc);
        asm volatile("" :: "v"(sc));
        if (tt + 3 < NT) DIL_GLOAD(kb0, kb1, kb2, kb3, vb0, vb1, vb2, vb3, tt + 3);
        tile_rest(tt + 1, sc, 1);
        if (tt + 2 < NT) {
          if (tt + 3 < NT) asm volatile("s_waitcnt vmcnt(8)" ::: "memory"); else asm volatile("s_waitcnt vmcnt(0)" ::: "memory");
          DIL_VSTORE(va0, va1, va2, va3, 0);
        }
      }
    }
    l += __shfl_xor(l, 32);
    float* part = p.dpart() + ((tb + qpos) * 4 + h) * 68 + hh * 4;
    if (MODE == 0) {
#pragma unroll
      for (int g = 0; g < 4; ++g) {
        *reinterpret_cast<float4*>(part + g * 8) = make_float4(o0[4 * g + 0], o0[4 * g + 1], o0[4 * g + 2], o0[4 * g + 3]);
        *reinterpret_cast<float4*>(part + 32 + g * 8) = make_float4(o1[4 * g + 0], o1[4 * g + 1], o1[4 * g + 2], o1[4 * g + 3]);
      }
      if (hh == 0) { part[64] = m; part[65] = l; }
    } else {
      const float mA = part[64 - hh * 4], lA = part[65 - hh * 4];
      const float M = fmaxf(m, mA), sa = __builtin_amdgcn_exp2f(m - M), sb = __builtin_amdgcn_exp2f(mA - M);
      const float il = 1.f / (l * sa + lA * sb);
      u16* orow = p.mixed() + (tb + qpos) * DM + 768 + h * 64 + hh * 4;
#pragma unroll
      for (int g = 0; g < 4; ++g) {
        const float4 a0 = *reinterpret_cast<const float4*>(part + g * 8), a1 = *reinterpret_cast<const float4*>(part + 32 + g * 8);
        uint2 v;
        v.x = pack2((o0[4 * g + 0] * sa + a0.x * sb) * il, (o0[4 * g + 1] * sa + a0.y * sb) * il);
        v.y = pack2((o0[4 * g + 2] * sa + a0.z * sb) * il, (o0[4 * g + 3] * sa + a0.w * sb) * il);
        *reinterpret_cast<uint2*>(orow + g * 8) = v;
        v.x = pack2((o1[4 * g + 0] * sa + a1.x * sb) * il, (o1[4 * g + 1] * sa + a1.y * sb) * il);
        v.y = pack2((o1[4 * g + 2] * sa + a1.z * sb) * il, (o1[4 * g + 3] * sa + a1.w * sb) * il);
        *reinterpret_cast<uint2*>(orow + 32 + g * 8) = v;
      }
    }
  }
}

DI void ph_dil_naive(const Params& p) {
  const int gt = obid() * NTHR + otid(), gs = gridDim.x * NTHR;
  for (int it = gt; it < 4 * 4 * SEQ; it += gs) {
    const int n = it & (SEQ - 1), h = (it >> 12) & 3, b = it >> 14;
    const size_t tb = (size_t)b * SEQ;
    uint4 qp[8];
    float o[64];
#pragma unroll
    for (int d = 0; d < 8; ++d) qp[d] = *reinterpret_cast<const uint4*>(p.proj() + (tb + n) * PWP + C_DQ + h * 64 + d * 8);
    float mx = -1e30f;
    for (int pat = 0; pat < 3; ++pat) {
      const int dil = (pat == 0) ? 1 : (pat == 1 ? 4 : 16);
#pragma unroll 1
      for (int j = -64; j <= 64; ++j) {
        const int pos = n + j * dil;
        if (pos < 0 || pos >= SEQ) continue;
        const u16* kr = p.proj() + (tb + pos) * PWP + C_DK + h * 64;
        float s = 0.f;
#pragma unroll
        for (int d = 0; d < 8; ++d) s = dot8(qp[d], *reinterpret_cast<const uint4*>(kr + d * 8), s);
        s *= 0.125f;
        mx = fmaxf(mx, s);
      }
    }
#pragma unroll
    for (int d = 0; d < 64; ++d) o[d] = 0.f;
    float l = 0.f;
    for (int pat = 0; pat < 3; ++pat) {
      const int dil = (pat == 0) ? 1 : (pat == 1 ? 4 : 16);
#pragma unroll 1
      for (int j = -64; j <= 64; ++j) {
        const int pos = n + j * dil;
        if (pos < 0 || pos >= SEQ) continue;
        const u16* kr = p.proj() + (tb + pos) * PWP + C_DK + h * 64;
        const u16* vr = p.proj() + (tb + pos) * PWP + C_DV + h * 64;
        float s = 0.f;
#pragma unroll
        for (int d = 0; d < 8; ++d) s = dot8(qp[d], *reinterpret_cast<const uint4*>(kr + d * 8), s);
        s *= 0.125f;
        const float pe = __expf(s - mx);
        l += pe;
#pragma unroll
        for (int d = 0; d < 64; d += 8) {
          float vf[8];
          ld8(vr + d, vf);
#pragma unroll
          for (int jj = 0; jj < 8; ++jj) o[d + jj] += pe * vf[jj];
        }
      }
    }
    const float il = 1.f / l;
#pragma unroll
    for (int d = 0; d < 64; d += 8) {
      uint4 ov;
      ov.x = pack2(o[d + 0] * il, o[d + 1] * il);
      ov.y = pack2(o[d + 2] * il, o[d + 3] * il);
      ov.z = pack2(o[d + 4] * il, o[d + 5] * il);
      ov.w = pack2(o[d + 6] * il, o[d + 7] * il);
      *reinterpret_cast<uint4*>(p.mixed() + (tb + n) * DM + 768 + h * 64 + d) = ov;
    }
  }
}

DI void ph_ssd_naive(const Params& p, int L) {
  const int gt = obid() * NTHR + otid(), gs = gridDim.x * NTHR;
  for (int it = gt; it < 4 * 4 * 4 * SEQ; it += gs) {
    const int l = it & (SEQ - 1), pq = (it >> 12) & 3, h = (it >> 14) & 3, b = it >> 16;
    const int g = h >> 1;
    const size_t tb = (size_t)b * SEQ;
    uint4 cl[16];
    float acc[16];
#pragma unroll
    for (int d = 0; d < 16; ++d) cl[d] = *reinterpret_cast<const uint4*>(p.xbc() + (tb + l) * 768 + 512 + g * 128 + d * 8);
#pragma unroll
    for (int d = 0; d < 16; ++d) acc[d] = 0.f;
    const float pl = p.cs()[(tb + l) * 8 + h], rl = p.cs()[(tb + l) * 8 + 4 + h];
#pragma unroll 1
    for (int s = 0; s < SEQ; ++s) {
      const u16* br = p.xbc() + (tb + s) * 768 + 256 + g * 128;
      float cbv = 0.f;
#pragma unroll
      for (int d = 0; d < 16; ++d) cbv = dot8(cl[d], *reinterpret_cast<const uint4*>(br + d * 8), cbv);
      float w;
      if (s <= l) w = expf(pl - p.cs()[(tb + s) * 8 + h]) * p.dtv()[(tb + s) * 8 + h];
      else w = expf(rl - p.cs()[(tb + s) * 8 + 4 + h]) * p.dtv()[(tb + s) * 8 + 4 + h];
      cbv *= w;
      const u16* xr = p.xbc() + (tb + s) * 768 + h * 64 + pq * 16;
#pragma unroll
      for (int d = 0; d < 16; d += 8) {
        float xf[8];
        ld8(xr + d, xf);
#pragma unroll
        for (int j = 0; j < 8; ++j) acc[d + j] += cbv * xf[j];
      }
    }
    const float dsk = p.ssm_d[L * 4 + h];
#pragma unroll
    for (int d = 0; d < 16; ++d) {
      const int c = h * 64 + pq * 16 + d;
      const float xv = bf2f(p.xbc()[(tb + l) * 768 + c]);
      const float z = bf2f(p.proj()[(tb + l) * PWP + C_Z + c]);
      p.ybuf()[(tb + l) * 256 + c] = (acc[d] + dsk * xv) * silu(z);
    }
  }
}

DI void ph_ssd_norm(const Params& p, int L) {
  const int tid_ = otid(); const int lane = tid_ & 63, gw = (obid() * NTHR + tid_) >> 6, nw = gridDim.x * (NTHR / 64);
  const float* nwt = p.ssm_norm_w + L * 256;
  for (int t = gw; t < T; t += nw) {
    const float4 v = *reinterpret_cast<const float4*>(p.ybuf() + (size_t)t * 256 + lane * 4);
    float ss = wave_sum(v.x * v.x + v.y * v.y + v.z * v.z + v.w * v.w);
    const float rstd = rsqrtf(ss * (1.f / 256.f) + 1e-6f);
    const float4 ww = *reinterpret_cast<const float4*>(nwt + lane * 4);
    uint2 o;
    o.x = pack2(v.x * rstd * ww.x, v.y * rstd * ww.y);
    o.y = pack2(v.z * rstd * ww.z, v.w * rstd * ww.w);
    *reinterpret_cast<uint2*>(p.mixed() + (size_t)t * DM + 512 + lane * 4) = o;
  }
}

#define MFMA16(a, b, c) __builtin_amdgcn_mfma_f32_16x16x32_bf16((a), (b), (c), 0, 0, 0)
template <int MT, int NT, int KS>
DI void wave_mm(f32x4 (&acc)[MT][NT], const u16* a0, int lda, const u16* b0, int ldb, int fr, int fq) {
#pragma unroll
  for (int ks = 0; ks < KS; ++ks) {
    bf16x8 af[MT], bfv[NT];
#pragma unroll
    for (int m = 0; m < MT; ++m) af[m] = *reinterpret_cast<const bf16x8*>(a0 + (m * 16 + fr) * lda + ks * 32 + fq * 8);
#pragma unroll
    for (int n = 0; n < NT; ++n) bfv[n] = *reinterpret_cast<const bf16x8*>(b0 + (n * 16 + fr) * ldb + ks * 32 + fq * 8);
#pragma unroll
    for (int m = 0; m < MT; ++m)
#pragma unroll
      for (int n = 0; n < NT; ++n) acc[m][n] = MFMA16(af[m], bfv[n], acc[m][n]);
  }
}
template <int MT, int NT>
DI void zero_acc(f32x4 (&acc)[MT][NT]) {
#pragma unroll
  for (int m = 0; m < MT; ++m)
#pragma unroll
    for (int n = 0; n < NT; ++n) acc[m][n] = f32x4{0.f, 0.f, 0.f, 0.f};
}
template <int NROWS, int NCOLS>
DI void stage_rows(u16* dst, int ldd, const u16* src, size_t lsrc, int tid) {
  constexpr int CPR = NCOLS / 8, NCH = NROWS * CPR / NTHR;
  static_assert(NROWS * CPR % NTHR == 0, "tile must be a multiple of 512 chunks");
  uint4 r[NCH];
#pragma unroll
  for (int i = 0; i < NCH; ++i) {
    const int c = tid + i * NTHR, row = c / CPR, cc = c % CPR;
    r[i] = *reinterpret_cast<const uint4*>(src + (size_t)row * lsrc + cc * 8);
  }
#pragma unroll
  for (int i = 0; i < NCH; ++i) {
    const int c = tid + i * NTHR, row = c / CPR, cc = c % CPR;
    *reinterpret_cast<uint4*>(dst + row * ldd + cc * 8) = r[i];
  }
}
template <int NCOLS, class W>
DI void stage_T(u16* dst, int ldd, const u16* src, size_t lsrc, int tid, W w) {
  constexpr int NCH = 128 * (NCOLS / 8) / NTHR;
  uint4 r[NCH];
#pragma unroll
  for (int i = 0; i < NCH; ++i) {
    const int c = tid + i * NTHR, j = c & 127, cc = c >> 7;
    r[i] = *reinterpret_cast<const uint4*>(src + (size_t)j * lsrc + cc * 8);
  }
#pragma unroll
  for (int i = 0; i < NCH; ++i) {
    const int c = tid + i * NTHR, j = c & 127, cc = c >> 7;
    float f[8];
    unpack8(r[i], f);
    const float wj = w(j);
#pragma unroll
    for (int e = 0; e < 8; ++e) dst[(cc * 8 + e) * ldd + j] = f2bf(f[e] * wj);
  }
}

template <int NROWS, int NCOLS>
DI void stage_rows_ld(uint4 (&r)[NROWS * (NCOLS / 8) / NTHR], const u16* src, size_t lsrc, int tid) {
  constexpr int CPR = NCOLS / 8, NCH = NROWS * CPR / NTHR;
#pragma unroll
  for (int i = 0; i < NCH; ++i) {
    const int c = tid + i * NTHR, row = c / CPR, cc = c % CPR;
    r[i] = *reinterpret_cast<const uint4*>(src + (size_t)row * lsrc + cc * 8);
  }
}
template <int NROWS, int NCOLS>
DI void stage_rows_st(u16* dst, int ldd, const uint4 (&r)[NROWS * (NCOLS / 8) / NTHR], int tid) {
  constexpr int CPR = NCOLS / 8, NCH = NROWS * CPR / NTHR;
#pragma unroll
  for (int i = 0; i < NCH; ++i) {
    const int c = tid + i * NTHR, row = c / CPR, cc = c % CPR;
    *reinterpret_cast<uint4*>(dst + row * ldd + cc * 8) = r[i];
  }
}
template <int NCOLS>
DI void stage_T_ld(uint4 (&r)[128 * (NCOLS / 8) / NTHR], const u16* src, size_t lsrc, int tid) {
  constexpr int NCH = 128 * (NCOLS / 8) / NTHR;
#pragma unroll
  for (int i = 0; i < NCH; ++i) {
    const int c = tid + i * NTHR, j = c & 127, cc = c >> 7;
    r[i] = *reinterpret_cast<const uint4*>(src + (size_t)j * lsrc + cc * 8);
  }
}
template <int NCOLS, class W>
DI void stage_T_st(u16* dst, int ldd, const uint4 (&r)[128 * (NCOLS / 8) / NTHR], int tid, W w) {
  constexpr int NCH = 128 * (NCOLS / 8) / NTHR;
#pragma unroll
  for (int i = 0; i < NCH; ++i) {
    const int c = tid + i * NTHR, j = c & 127, cc = c >> 7;
    float f[8];
    unpack8(r[i], f);
    const float wj = w(j);
#pragma unroll
    for (int e = 0; e < 8; ++e) dst[(cc * 8 + e) * ldd + j] = f2bf(f[e] * wj);
  }
}

DI void ph_ret_a(const Params& p, char* smem, int item) {
  const int tid = otid(), wid = tid >> 6, lane = tid & 63, fr = lane & 15, fq = lane >> 4;
  u16* sVt = reinterpret_cast<u16*>(smem);
  u16* sKf = sVt + 64 * 136;
  u16* sKb = sKf + 64 * 136;
  {
    const int c = item & 31, bh = item >> 5, b = bh >> 2, h = bh & 3;
    const float lg0 = log1pf(-exp2f(-5.f - (float)h)), lg1 = log1pf(-exp2f(-5.5f - (float)h));
    const u16* src = p.proj() + ((size_t)b * SEQ + c * 128) * PWP;
    {
      uint4 rv[2], rk[2];
      stage_T_ld<64>(rv, src + C_RV + h * 64, PWP, tid);
      stage_T_ld<64>(rk, src + C_RK + h * 64, PWP, tid);
      stage_T_st<64>(sVt, 136, rv, tid, [](int) { return 1.f; });
      stage_T_st<64>(sKf, 136, rk, tid, [&](int j) { return __expf(lg0 * (float)(127 - j)); });
      stage_T_st<64>(sKb, 136, rk, tid, [&](int j) { return __expf(lg1 * (float)j); });
    }
    __syncthreads();
    const int dir = wid >> 2, q = wid & 3;
    f32x4 acc[1][4];
    zero_acc(acc);
    wave_mm<1, 4, 4>(acc, sVt + q * 16 * 136, 136, dir ? sKb : sKf, 136, fr, fq);
    float* out = p.rU() + ((size_t)(bh * 32 + c) * 2 + dir) * 4096;
#pragma unroll
    for (int n = 0; n < 4; ++n)
#pragma unroll
      for (int j = 0; j < 4; ++j) out[(q * 16 + fq * 4 + j) * 64 + n * 16 + fr] = acc[0][n][j];
    __syncthreads();
  }
}
DI void ph_ret_scan(const Params& p) {
  const int gt = obid() * NTHR + otid(), gs = gridDim.x * NTHR;
  for (int it = gt; it < 16 * 2 * 4096; it += gs) {
    const int e = it & 4095, dir = (it >> 12) & 1, bh = it >> 13, h = bh & 3;
    const float lg = log1pf(-exp2f((dir ? -5.5f : -5.f) - (float)h));
    const float cd = __expf(lg * 128.f);
    float u[32];
#pragma unroll
    for (int c = 0; c < 32; ++c) u[c] = p.rU()[((size_t)(bh * 32 + c) * 2 + dir) * 4096 + e];
    float st = 0.f;
    if (dir == 0) {
#pragma unroll
      for (int c = 0; c < 32; ++c) {
        p.rS()[((size_t)(bh * 32 + c) * 2 + dir) * 4096 + e] = f2bf(st);
        st = st * cd + u[c];
      }
    } else {
#pragma unroll
      for (int c = 31; c >= 0; --c) {
        p.rS()[((size_t)(bh * 32 + c) * 2 + dir) * 4096 + e] = f2bf(st);
        st = st * cd + u[c];
      }
    }
  }
}
DI void ph_ret_c(const Params& p, char* smem, int item) {
  const int tid = otid(), wid = tid >> 6, lane = tid & 63, fr = lane & 15, fq = lane >> 4;
  u16* sQ = reinterpret_cast<u16*>(smem);
  u16* sK = sQ + 128 * 72;
  u16* sVt = sK + 128 * 72;
  u16* sSf = sVt + 64 * 136;
  u16* sSb = sSf + 64 * 72;
  u16* sP = sSb + 64 * 72;
  {
    const int c = item & 31, bh = item >> 5, b = bh >> 2, h = bh & 3;
    const float lg0 = log1pf(-exp2f(-5.f - (float)h)), lg1 = log1pf(-exp2f(-5.5f - (float)h));
    const size_t t0 = (size_t)b * SEQ + c * 128;
    const u16* src = p.proj() + t0 * PWP;
    {
      uint4 rq[2], rk[2], rv[2], rf[1], rb[1];
      stage_rows_ld<128, 64>(rq, src + C_RQ + h * 64, PWP, tid);
      stage_rows_ld<128, 64>(rk, src + C_RK + h * 64, PWP, tid);
      stage_T_ld<64>(rv, src + C_RV + h * 64, PWP, tid);
      stage_rows_ld<64, 64>(rf, p.rS() + ((size_t)(bh * 32 + c) * 2 + 0) * 4096, 64, tid);
      stage_rows_ld<64, 64>(rb, p.rS() + ((size_t)(bh * 32 + c) * 2 + 1) * 4096, 64, tid);
      stage_rows_st<128, 64>(sQ, 72, rq, tid);
      stage_rows_st<128, 64>(sK, 72, rk, tid);
      stage_T_st<64>(sVt, 136, rv, tid, [](int) { return 1.f; });
      stage_rows_st<64, 64>(sSf, 72, rf, tid);
      stage_rows_st<64, 64>(sSb, 72, rb, tid);
    }
    __syncthreads();
    {
      const int wr = wid >> 1, wc = wid & 1;
      f32x4 sacc[2][4];
      zero_acc(sacc);
      wave_mm<2, 4, 2>(sacc, sQ + wr * 32 * 72, 72, sK + wc * 64 * 72, 72, fr, fq);
#pragma unroll
      for (int m = 0; m < 2; ++m)
#pragma unroll
        for (int n = 0; n < 4; ++n)
#pragma unroll
          for (int j = 0; j < 4; ++j) {
            const int i = wr * 32 + m * 16 + fq * 4 + j, jj = wc * 64 + n * 16 + fr;
            const float dcy = (jj <= i) ? __expf(lg0 * (float)(i - jj)) : __expf(lg1 * (float)(jj - i));
            sP[i * 136 + jj] = f2bf(sacc[m][n][j] * dcy);
          }
    }
    __syncthreads();
    {
      f32x4 ai[1][4], af_[1][4], ab_[1][4];
      zero_acc(ai); zero_acc(af_); zero_acc(ab_);
      wave_mm<1, 4, 4>(ai, sP + wid * 16 * 136, 136, sVt, 136, fr, fq);
      wave_mm<1, 4, 2>(af_, sQ + wid * 16 * 72, 72, sSf, 72, fr, fq);
      wave_mm<1, 4, 2>(ab_, sQ + wid * 16 * 72, 72, sSb, 72, fr, fq);
#pragma unroll
      for (int j = 0; j < 4; ++j) {
        const int i = wid * 16 + fq * 4 + j;
        const float xf = __expf(lg0 * (float)(i + 1)), xb = __expf(lg1 * (float)(128 - i));
        float o[4], sum = 0.f;
#pragma unroll
        for (int n = 0; n < 4; ++n) { o[n] = ai[0][n][j] + xf * af_[0][n][j] + xb * ab_[0][n][j]; sum += o[n]; }
#pragma unroll
        for (int sft = 1; sft < 16; sft <<= 1) sum += __shfl_xor(sum, sft);
        const float mu = sum * (1.f / 64.f);
        float var = 0.f;
#pragma unroll
        for (int n = 0; n < 4; ++n) var += (o[n] - mu) * (o[n] - mu);
#pragma unroll
        for (int sft = 1; sft < 16; sft <<= 1) var += __shfl_xor(var, sft);
        const float rs = rsqrtf(var * (1.f / 64.f) + 1e-5f);
#pragma unroll
        for (int n = 0; n < 4; ++n) {
          const float g = bf2f(p.proj()[(t0 + i) * PWP + C_RG + h * 64 + n * 16 + fr]);
          p.mixed()[(t0 + i) * DM + h * 64 + n * 16 + fr] = f2bf(silu(g) * (o[n] - mu) * rs);
        }
      }
    }
    __syncthreads();
  }
}

DI void ssd_local_cumsum(const Params& p, int L, size_t t0, float* cum, float* dtl, int wid, int lane) {
  const int dir = wid >> 2, h = wid & 3;
  const float a = -__expf(p.a_log[L * 8 + dir * 4 + h]);
  float d0, d1;
  if (dir == 0) { d0 = p.dtv()[(t0 + 2 * lane) * 8 + h]; d1 = p.dtv()[(t0 + 2 * lane + 1) * 8 + h]; }
  else { d0 = p.dtv()[(t0 + 127 - 2 * lane) * 8 + 4 + h]; d1 = p.dtv()[(t0 + 126 - 2 * lane) * 8 + 4 + h]; }
  float v0 = d0 * a, v1 = v0 + d1 * a;
  float run = v1;
#pragma unroll
  for (int o = 1; o < 64; o <<= 1) {
    const float u = __shfl_up(run, o);
    if (lane >= o) run += u;
  }
  const float excl = run - v1;
  v0 += excl; v1 += excl;
  float* cr = cum + (dir * 4 + h) * 128;
  float* dr = dtl + (dir * 4 + h) * 128;
  if (dir == 0) { cr[2 * lane] = v0; cr[2 * lane + 1] = v1; dr[2 * lane] = d0; dr[2 * lane + 1] = d1; }
  else { cr[127 - 2 * lane] = v0; cr[126 - 2 * lane] = v1; dr[127 - 2 * lane] = d0; dr[126 - 2 * lane] = d1; }
}

DI void ph_ssd_a(const Params& p, int L, char* smem, int item) {
  const int tid = otid(), wid = tid >> 6, lane = tid & 63, fr = lane & 15, fq = lane >> 4;
  u16* sBt = reinterpret_cast<u16*>(smem);
  u16* sXf = sBt + 2 * 128 * 136;
  u16* sXb = sXf + 64 * 136;
  float* cum = reinterpret_cast<float*>(sXb + 64 * 136);
  float* dtl = cum + 8 * 128;
  {
    const int c = item & 31, b = item >> 5;
    const size_t t0 = (size_t)b * SEQ + c * 128;
    ssd_local_cumsum(p, L, t0, cum, dtl, wid, lane);
    stage_T<256>(sBt, 136, p.xbc() + t0 * 768 + 256, 768, tid, [](int) { return 1.f; });
    __syncthreads();
    if (tid < 8) {
      const int dir = tid >> 2;
      p.cdec()[(size_t)item * 8 + tid] = __expf(dir ? cum[tid * 128 + 0] : cum[tid * 128 + 127]);
    }
    for (int h = 0; h < 4; ++h) {
      const float* cf = cum + h * 128;
      const float* cb = cum + (4 + h) * 128;
      const float* df = dtl + h * 128;
      const float* db = dtl + (4 + h) * 128;
      const float endf = cf[127], endb = cb[0];
      {
        uint4 rx[2];
        stage_T_ld<64>(rx, p.xbc() + t0 * 768 + h * 64, 768, tid);
        stage_T_st<64>(sXf, 136, rx, tid, [&](int l) { return __expf(endf - cf[l]) * df[l]; });
        stage_T_st<64>(sXb, 136, rx, tid, [&](int l) { return __expf(endb - cb[l]) * db[l]; });
      }
      __syncthreads();
      const int dir = wid >> 2, q = wid & 3, g = h >> 1;
      f32x4 acc[4][2];
      zero_acc(acc);
      wave_mm<4, 2, 4>(acc, dir ? sXb : sXf, 136, sBt + (g * 128 + q * 32) * 136, 136, fr, fq);
      float* out = p.sU() + ((size_t)item * 8 + h * 2 + dir) * 8192;
#pragma unroll
      for (int m = 0; m < 4; ++m)
#pragma unroll
        for (int n = 0; n < 2; ++n)
#pragma unroll
          for (int j = 0; j < 4; ++j) out[(m * 16 + fq * 4 + j) * 128 + q * 32 + n * 16 + fr] = acc[m][n][j];
      __syncthreads();
    }
  }
}
DI void ph_ssd_scan(const Params& p) {
  const int gt = obid() * NTHR + otid(), gs = gridDim.x * NTHR;
  for (int it = gt; it < 4 * 8 * 8192; it += gs) {
    const int e = it & 8191, hd = (it >> 13) & 7, b = it >> 16;
    const int dir = hd & 1, h = hd >> 1;
    float u[32];
#pragma unroll
    for (int c = 0; c < 32; ++c) u[c] = p.sU()[((size_t)(b * 32 + c) * 8 + hd) * 8192 + e];
    float st = 0.f;
    if (dir == 0) {
#pragma unroll
      for (int c = 0; c < 32; ++c) {
        p.sS()[((size_t)(b * 32 + c) * 8 + hd) * 8192 + e] = f2bf(st);
        st = st * p.cdec()[(size_t)(b * 32 + c) * 8 + dir * 4 + h] + u[c];
      }
    } else {
#pragma unroll
      for (int c = 31; c >= 0; --c) {
        p.sS()[((size_t)(b * 32 + c) * 8 + hd) * 8192 + e] = f2bf(st);
        st = st * p.cdec()[(size_t)(b * 32 + c) * 8 + dir * 4 + h] + u[c];
      }
    }
  }
}
DI void ph_ssd_c(const Params& p, int L, char* smem, int item) {
  const int tid = otid(), wid = tid >> 6, lane = tid & 63, fr = lane & 15, fq = lane >> 4;
  u16* sC = reinterpret_cast<u16*>(smem);
  u16* sB = sC + 128 * 136;
  u16* sXt = sB + 128 * 136;
  u16* sSf = sXt + 64 * 136;
  u16* sSb = sSf + 64 * 136;
  float* cum = reinterpret_cast<float*>(sSb + 64 * 136);
  float* dtl = cum + 8 * 128;
  {
    const int c = item & 31, b = item >> 5;
    const size_t t0 = (size_t)b * SEQ + c * 128;
    ssd_local_cumsum(p, L, t0, cum, dtl, wid, lane);
    float ssq[4] = {0.f, 0.f, 0.f, 0.f};
#pragma unroll 1
    for (int g = 0; g < 2; ++g) {
      {
        uint4 rc[4], rb4[4];
        stage_rows_ld<128, 128>(rc, p.xbc() + t0 * 768 + 512 + g * 128, 768, tid);
        stage_rows_ld<128, 128>(rb4, p.xbc() + t0 * 768 + 256 + g * 128, 768, tid);
        stage_rows_st<128, 128>(sC, 136, rc, tid);
        stage_rows_st<128, 128>(sB, 136, rb4, tid);
      }
      __syncthreads();
      const int wr = wid >> 1, wc = wid & 1;
      f32x4 G[2][4];
      zero_acc(G);
      wave_mm<2, 4, 4>(G, sC + wr * 32 * 136, 136, sB + wc * 64 * 136, 136, fr, fq);
      __syncthreads();
#pragma unroll 1
      for (int hl = 0; hl < 2; ++hl) {
        const int h = g * 2 + hl;
        const float* cf = cum + h * 128;
        const float* cb = cum + (4 + h) * 128;
        const float* df = dtl + h * 128;
        const float* db = dtl + (4 + h) * 128;
        uint4 rxt[2], rsf[2], rsb[2];
        stage_T_ld<64>(rxt, p.xbc() + t0 * 768 + h * 64, 768, tid);
        stage_rows_ld<64, 128>(rsf, p.sS() + ((size_t)item * 8 + h * 2 + 0) * 8192, 128, tid);
        stage_rows_ld<64, 128>(rsb, p.sS() + ((size_t)item * 8 + h * 2 + 1) * 8192, 128, tid);
#pragma unroll
        for (int m = 0; m < 2; ++m)
#pragma unroll
          for (int n = 0; n < 4; ++n)
#pragma unroll
            for (int j = 0; j < 4; ++j) {
              const int l = wr * 32 + m * 16 + fq * 4 + j, sx = wc * 64 + n * 16 + fr;
              const float w = (sx <= l) ? __expf(cf[l] - cf[sx]) * df[sx] : __expf(cb[l] - cb[sx]) * db[sx];
              sB[l * 136 + sx] = f2bf(G[m][n][j] * w);
            }
        stage_T_st<64>(sXt, 136, rxt, tid, [](int) { return 1.f; });
        stage_rows_st<64, 128>(sSf, 136, rsf, tid);
        stage_rows_st<64, 128>(sSb, 136, rsb, tid);
        __syncthreads();
        f32x4 yd[1][4], yf[1][4], yb[1][4];
        zero_acc(yd); zero_acc(yf); zero_acc(yb);
        wave_mm<1, 4, 4>(yd, sB + wid * 16 * 136, 136, sXt, 136, fr, fq);
        wave_mm<1, 4, 4>(yf, sC + wid * 16 * 136, 136, sSf, 136, fr, fq);
        wave_mm<1, 4, 4>(yb, sC + wid * 16 * 136, 136, sSb, 136, fr, fq);
        const float dsk = p.ssm_d[L * 4 + h];
#pragma unroll
        for (int j = 0; j < 4; ++j) {
          const int l = wid * 16 + fq * 4 + j;
          const float ef = __expf(cf[l]), eb = __expf(cb[l]);
#pragma unroll
          for (int n = 0; n < 4; ++n) {
            const int ch = h * 64 + n * 16 + fr;
            const float xv = bf2f(p.xbc()[(t0 + l) * 768 + ch]);
            const float z = bf2f(p.proj()[(t0 + l) * PWP + C_Z + ch]);
            const float yv = (yd[0][n][j] + ef * yf[0][n][j] + eb * yb[0][n][j] + dsk * xv) * silu(z);
            ssq[j] += yv * yv;
            p.ybuf()[(t0 + l) * 256 + ch] = yv;
          }
        }
        __syncthreads();
      }
    }
    const float* nwt = p.ssm_norm_w + L * 256;
#pragma unroll
    for (int j = 0; j < 4; ++j) {
      float ss = ssq[j];
#pragma unroll
      for (int sft = 1; sft < 16; sft <<= 1) ss += __shfl_xor(ss, sft);
      const float rstd = rsqrtf(ss * (1.f / 256.f) + 1e-6f);
      const int l = wid * 16 + fq * 4 + j;
#pragma unroll
      for (int hn = 0; hn < 16; ++hn) {
        const int ch = hn * 16 + fr;
        p.mixed()[(t0 + l) * DM + 512 + ch] = f2bf(p.ybuf()[(t0 + l) * 256 + ch] * rstd * nwt[ch]);
      }
    }
  }
}

struct CfgOutproj {
  static constexpr bool PERM = false;
  int K; const Params* p; int L; int bid, nb; const float* xin; float* xout;
  DI bool next(int i, pg8::Unit& u) const { const int t = i * nb + bid; if (t >= 64 * 4) return false; u.pm = t & 63; u.pn = t >> 6; return true; }
  DI const char* a_base(const pg8::Unit& u) const { return (const char*)(p->mixed() + (size_t)u.pm * 256 * DM); }
  DI const char* b_base(const pg8::Unit& u) const { return (const char*)(p->WoutT() + ((size_t)L * DM + (size_t)u.pn * 256) * DM); }
  DI void a_off(const pg8::Unit&, int R0, int C0, int R1, int C1, unsigned (&vo)[4]) const {
    vo[0] = (unsigned)(R0 * DM + C0) * 2u; vo[1] = (unsigned)(R1 * DM + C1) * 2u;
    vo[2] = vo[0] + 128u * DM * 2u; vo[3] = vo[1] + 128u * DM * 2u;
  }
  DI void epi(const f32x4 (&acc)[2][2][4][2], const pg8::Unit& u, int wr, int wc, int fr, int fq) const {
    const int row0 = u.pm * 256 + wr * 64 + fr, col0 = u.pn * 256 + wc * 32 + 4 * fq;
#pragma unroll
    for (int ai = 0; ai < 2; ++ai)
#pragma unroll
      for (int m = 0; m < 4; ++m) {
        const size_t ro = (size_t)(row0 + ai * 128 + m * 16) * DM + col0;
#pragma unroll
        for (int bj = 0; bj < 2; ++bj)
#pragma unroll
          for (int n = 0; n < 2; ++n) {
            const size_t o = ro + bj * 128 + n * 16;
            const float4 xi = *reinterpret_cast<const float4*>(xin + o);
            const f32x4 a = acc[ai][bj][m][n];
            *reinterpret_cast<float4*>(xout + o) = make_float4(xi.x + a[0], xi.y + a[1], xi.z + a[2], xi.w + a[3]);
          }
      }
  }
};
DI void ph_outproj(const Params& p, int L, const float* xin, float* xout, char* smem) {
  CfgOutproj c; c.K = DM; c.p = &p; c.L = L; c.bid = obid(); c.nb = gridDim.x; c.xin = xin; c.xout = xout;
  pg8::gemm_phase((pg8::lds_u8*)smem, c);
}

DI void ph_rms2_router(const Params& p, int L, const float* xres, char* smem) {
  const int tid = otid(), lane = tid & 63, gw = (obid() * NTHR + tid) >> 6, nw = gridDim.x * (NTHR / 64);
  const float* w = p.ln2_w + L * DM;
  const float* rw = p.router_w + (size_t)L * DM * 16;
  float4* srw = reinterpret_cast<float4*>(smem);
  for (int i = tid; i < 4096; i += NTHR) {
    const int c = i >> 2, e4 = i & 3;
    srw[(e4 * 4 + (c & 3)) * 256 + (c >> 2)] = *reinterpret_cast<const float4*>(rw + (size_t)i * 4);
  }
  __syncthreads();
  const int b5 = (lane >> 5) & 1, b4 = (lane >> 4) & 1, b3 = (lane >> 3) & 1, b2 = (lane >> 2) & 1;
  const int my_e = 8 * b5 + 4 * b4 + 2 * b3 + b2;
  for (int t = gw; t < T; t += nw) {
    const float* xr = xres + (size_t)t * DM;
    float4 v[4];
    float ss = 0.f;
#pragma unroll
    for (int i = 0; i < 4; ++i) {
      v[i] = *reinterpret_cast<const float4*>(xr + (i * 64 + lane) * 4);
      ss += v[i].x * v[i].x + v[i].y * v[i].y + v[i].z * v[i].z + v[i].w * v[i].w;
    }
    ss = wave_sum(ss);
    const float rstd = rsqrtf(ss * (1.f / DM) + 1e-6f);
    float lg[16];
#pragma unroll
    for (int e = 0; e < 16; ++e) lg[e] = 0.f;
#pragma unroll
    for (int i = 0; i < 4; ++i) {
      const int q = i * 64 + lane;
      const float4 ww = *reinterpret_cast<const float4*>(w + q * 4);
      const float hv[4] = {v[i].x * rstd * ww.x, v[i].y * rstd * ww.y, v[i].z * rstd * ww.z, v[i].w * rstd * ww.w};
      *reinterpret_cast<unsigned*>(p.hn8() + (size_t)t * DM + q * 4) =
          pk4_f8(hv[0] * F8_H_SCALE, hv[1] * F8_H_SCALE, hv[2] * F8_H_SCALE, hv[3] * F8_H_SCALE);
#pragma unroll
      for (int j = 0; j < 4; ++j)
#pragma unroll
        for (int e4 = 0; e4 < 4; ++e4) {
          const float4 r = srw[(e4 * 4 + j) * 256 + q];
          lg[e4 * 4 + 0] += hv[j] * r.x; lg[e4 * 4 + 1] += hv[j] * r.y;
          lg[e4 * 4 + 2] += hv[j] * r.z; lg[e4 * 4 + 3] += hv[j] * r.w;
        }
      __builtin_amdgcn_sched_barrier(0);
    }
#pragma unroll
    for (int k = 0; k < 8; ++k) {
      const float send = b5 ? lg[k] : lg[k + 8], keep = b5 ? lg[k + 8] : lg[k];
      lg[k] = keep + __shfl_xor(send, 32);
    }
#pragma unroll
    for (int k = 0; k < 4; ++k) {
      const float send = b4 ? lg[k] : lg[k + 4], keep = b4 ? lg[k + 4] : lg[k];
      lg[k] = keep + __shfl_xor(send, 16);
    }
#pragma unroll
    for (int k = 0; k < 2; ++k) {
      const float send = b3 ? lg[k] : lg[k + 2], keep = b3 ? lg[k + 2] : lg[k];
      lg[k] = keep + __shfl_xor(send, 8);
    }
    float lv;
    {
      const float send = b2 ? lg[0] : lg[1], keep = b2 ? lg[1] : lg[0];
      lv = keep + __shfl_xor(send, 4);
    }
    lv += __shfl_xor(lv, 2);
    lv += __shfl_xor(lv, 1);
    float mx = lv;
    mx = fmaxf(mx, __shfl_xor(mx, 4)); mx = fmaxf(mx, __shfl_xor(mx, 8));
    mx = fmaxf(mx, __shfl_xor(mx, 16)); mx = fmaxf(mx, __shfl_xor(mx, 32));
    const float ex = expf(lv - mx);
    float den = ex;
    den += __shfl_xor(den, 4); den += __shfl_xor(den, 8); den += __shfl_xor(den, 16); den += __shfl_xor(den, 32);
    if ((lane & 3) == 0) { p.aff()[(size_t)t * 16 + my_e] = ex / den; p.inv()[(size_t)t * 16 + my_e] = -1; }
  }
}

DI int block_sum_i(int v, int* red, int tid) {
#pragma unroll
  for (int o = 32; o > 0; o >>= 1) v += __shfl_xor(v, o);
  __syncthreads();
  if ((tid & 63) == 0) red[tid >> 6] = v;
  __syncthreads();
  int t = 0;
#pragma unroll
  for (int w = 0; w < NTHR / 64; ++w) t += red[w];
  return t;
}
DI void ph_topk(const Params& p, char* smem) {
  int* red = reinterpret_cast<int*>(smem);
  int* wsum = red + 16;
  const int tid = otid(), wid = tid >> 6, lane = tid & 63;
  for (int it = obid(); it < 64; it += gridDim.x) {
    const int e = it & 15, b = it >> 4;
    unsigned v[8];
#pragma unroll
    for (int i = 0; i < 8; ++i) v[i] = __float_as_uint(p.aff()[(size_t)(b * SEQ + tid * 8 + i) * 16 + e]);
    unsigned thr = 0;
#pragma unroll 1
    for (int bit = 30; bit >= 0; --bit) {
      const unsigned cand = thr | (1u << bit);
      int cnt = 0;
#pragma unroll
      for (int i = 0; i < 8; ++i) cnt += (v[i] >= cand) ? 1 : 0;
      if (block_sum_i(cnt, red, tid) >= 512) thr = cand;
    }
    int ngt = 0, ntie = 0;
#pragma unroll
    for (int i = 0; i < 8; ++i) { ngt += (v[i] > thr) ? 1 : 0; ntie += (v[i] == thr) ? 1 : 0; }
    int ig = ngt, itie = ntie;
#pragma unroll
    for (int o = 1; o < 64; o <<= 1) {
      const int a = __shfl_up(ig, o), c = __shfl_up(itie, o);
      if (lane >= o) { ig += a; itie += c; }
    }
    __syncthreads();
    if (lane == 63) { wsum[wid] = ig; wsum[8 + wid] = itie; }
    __syncthreads();
    int og = 0, ot = 0, totg = 0;
#pragma unroll
    for (int w = 0; w < 8; ++w) {
      const int a = wsum[w], c = wsum[8 + w];
      if (w < wid) { og += a; ot += c; }
      totg += a;
    }
    int pg = og + ig - ngt, pt = ot + itie - ntie;
    const int base = (e * 4 + b) * 512;
#pragma unroll
    for (int i = 0; i < 8; ++i) {
      int slot = -1;
      if (v[i] > thr) { slot = pg; ++pg; }
      else if (v[i] == thr) { if (totg + pt < 512) slot = totg + pt; ++pt; }
      if (slot >= 0) {
        p.tok()[base + slot] = b * SEQ + tid * 8 + i;
        p.inv()[(size_t)(b * SEQ + tid * 8 + i) * 16 + e] = base + slot;
        p.gate()[base + slot] = __uint_as_float(v[i]);
      }
    }
    __syncthreads();
  }
}

struct CfgMoe1 {
  static constexpr bool PERM = true;
  int K; const Params* p; int L; int bid, nb;
  DI bool next(int i, pg8::Unit& u) const {
    const int t = i * nb + bid; if (t >= 16 * 16 * 8) return false;
    const int rnd = t >> 8, w = t & 255, xcd = w & 7, jx = w >> 3, pid = xcd * 4 + (jx >> 3);
    const int mt = jx & 7, nt = pid & 15, e = rnd * 2 + (pid >> 4);
    u.pm = e * 8 + mt; u.pn = e * 16 + nt; return true;
  }
  DI const char* a_base(const pg8::Unit&) const { return (const char*)p->hn8(); }
  DI const char* b_base(const pg8::Unit& u) const { return (const char*)(p->Wgu8() + ((size_t)L * 16 * 4096 + (size_t)u.pn * 256) * DM); }
  const int* tokl;
  DI void a_off(const pg8::Unit&, int R0, int C0, int R1, int C1, unsigned (&vo)[4], int ui) const {
    const int* tk = tokl + ui * 256;
    vo[0] = (unsigned)(tk[R0] * 512 + C0) * 2u; vo[1] = (unsigned)(tk[R1] * 512 + C1) * 2u;
    vo[2] = (unsigned)(tk[128 + R0] * 512 + C0) * 2u; vo[3] = (unsigned)(tk[128 + R1] * 512 + C1) * 2u;
  }
  DI void epi(const f32x4 (&acc)[2][2][4][2], const pg8::Unit& u, int wr, int wc, int fr, int fq) const {
    const int row0 = u.pm * 256 + wr * 64 + fr, col0 = (u.pn & 15) * 128 + wc * 32 + 8 * fq;
    const float dq = 1.f / (F8_H_SCALE * F8_W_SCALE);
#pragma unroll
    for (int ai = 0; ai < 2; ++ai)
#pragma unroll
      for (int m = 0; m < 4; ++m) {
        const f32x4 g0 = acc[ai][0][m][0] * dq, g1 = acc[ai][0][m][1] * dq, u0 = acc[ai][1][m][0] * (dq * F8_HID_SCALE), u1 = acc[ai][1][m][1] * (dq * F8_HID_SCALE);
        uint2 w;
        w.x = pk4_f8(fast_silu(g0[0]) * u0[0], fast_silu(g0[1]) * u0[1], fast_silu(g0[2]) * u0[2], fast_silu(g0[3]) * u0[3]);
        w.y = pk4_f8(fast_silu(g1[0]) * u1[0], fast_silu(g1[1]) * u1[1], fast_silu(g1[2]) * u1[2], fast_silu(g1[3]) * u1[3]);
        *reinterpret_cast<uint2*>(p->hid8() + (size_t)(row0 + ai * 128 + m * 16) * 2048 + col0) = w;
      }
  }
};
DI void ph_moe1(const Params& p, int L, char* smem) {
  CfgMoe1 c; c.K = 512; c.p = &p; c.L = L; c.bid = obid(); c.nb = gridDim.x;
  int* tokl = reinterpret_cast<int*>(smem + 131072);
  c.tokl = tokl;
  for (int idx = otid(); idx < 8 * 256; idx += NTHR) {
    pg8::Unit u;
    if (c.next(idx >> 8, u)) tokl[idx] = p.tok()[u.pm * 256 + (idx & 255)];
  }
  __syncthreads();
  pg8::gemm_phase_f8((pg8::lds_u8*)smem, c);
}
struct CfgMoe2 {
  static constexpr bool PERM = true;
  int K; const Params* p; int L; int bid, nb;
  DI bool next(int i, pg8::Unit& u) const {
    const int t = i * nb + bid; if (t >= 16 * 4 * 8) return false;
    const int rnd = t >> 8, w = t & 255, xcd = w & 7, jx = w >> 3, pid = rnd * 32 + xcd * 4 + (jx >> 3);
    u.pm = (pid >> 2) * 8 + (jx & 7); u.pn = pid; return true;
  }
  DI const char* a_base(const pg8::Unit& u) const { return (const char*)(p->hid8() + (size_t)u.pm * 256 * 2048); }
  DI const char* b_base(const pg8::Unit& u) const { return (const char*)(p->Wd8() + ((size_t)L * 16 * DM + (size_t)u.pn * 256) * 2048); }
  DI void a_off(const pg8::Unit&, int R0, int C0, int R1, int C1, unsigned (&vo)[4], int) const {
    vo[0] = (unsigned)(R0 * 1024 + C0) * 2u; vo[1] = (unsigned)(R1 * 1024 + C1) * 2u;
    vo[2] = vo[0] + 128u * 1024u * 2u; vo[3] = vo[1] + 128u * 1024u * 2u;
  }
  DI void epi(const f32x4 (&acc)[2][2][4][2], const pg8::Unit& u, int wr, int wc, int fr, int fq) const {
    u16* eo = p->proj();
    const int row0 = u.pm * 256 + wr * 64 + fr, col0 = (u.pn & 3) * 256 + wc * 32 + 8 * fq;
#pragma unroll
    for (int ai = 0; ai < 2; ++ai)
#pragma unroll
      for (int m = 0; m < 4; ++m) {
        const int row = row0 + ai * 128 + m * 16;
        const float gt = p->gate()[row] * (1.f / (F8_HID_SCALE * F8_W_SCALE));
#pragma unroll
        for (int bj = 0; bj < 2; ++bj) {
          const f32x4 a0 = acc[ai][bj][m][0], a1 = acc[ai][bj][m][1];
          uint4 w;
          w.x = pack2(gt * a0[0], gt * a0[1]); w.y = pack2(gt * a0[2], gt * a0[3]);
          w.z = pack2(gt * a1[0], gt * a1[1]); w.w = pack2(gt * a1[2], gt * a1[3]);
          *reinterpret_cast<uint4*>(eo + (size_t)row * DM + col0 + bj * 128) = w;
        }
      }
  }
};
DI void ph_moe2(const Params& p, int L, char* smem) {
  CfgMoe2 c; c.K = 1024; c.p = &p; c.L = L; c.bid = obid(); c.nb = gridDim.x;
  pg8::gemm_phase_f8((pg8::lds_u8*)smem, c);
}
template <bool FINAL>
DI void ph_combine_norm(const Params& p, const float* __restrict__ xa, float* __restrict__ xnew, const float* __restrict__ w,
                        u16* __restrict__ hn_out, float* __restrict__ f_out) {
  const int tid_ = otid(), lane = tid_ & 63, gw = (obid() * NTHR + tid_) >> 6, nw = gridDim.x * (NTHR / 64);
  const u16* eo = p.proj();
  for (int t = gw; t < T; t += nw) {
    float4 v[4];
#pragma unroll
    for (int i = 0; i < 4; ++i) v[i] = *reinterpret_cast<const float4*>(xa + (size_t)t * DM + (i * 64 + lane) * 4);
    const int myrow = (lane < 16) ? p.inv()[(size_t)t * 16 + lane] : -1;
#pragma unroll 1
    for (int e = 0; e < 16; ++e) {
      const int r = __shfl(myrow, e);
      if (r >= 0) {
#pragma unroll
        for (int i = 0; i < 4; ++i) {
          const uint2 q = *reinterpret_cast<const uint2*>(eo + (size_t)r * DM + (i * 64 + lane) * 4);
          v[i].x += __uint_as_float(q.x << 16); v[i].y += __uint_as_float(q.x & 0xffff0000u);
          v[i].z += __uint_as_float(q.y << 16); v[i].w += __uint_as_float(q.y & 0xffff0000u);
        }
      }
    }
    float ss = 0.f;
#pragma unroll
    for (int i = 0; i < 4; ++i) ss += v[i].x * v[i].x + v[i].y * v[i].y + v[i].z * v[i].z + v[i].w * v[i].w;
    ss = wave_sum(ss);
    const float rstd = rsqrtf(ss * (1.f / DM) + 1e-6f);
#pragma unroll
    for (int i = 0; i < 4; ++i) {
      const int c = (i * 64 + lane) * 4;
      const float4 ww = *reinterpret_cast<const float4*>(w + c);
      if (FINAL) {
        *reinterpret_cast<float4*>(f_out + (size_t)t * DM + c) = make_float4(v[i].x * rstd * ww.x, v[i].y * rstd * ww.y, v[i].z * rstd * ww.z, v[i].w * rstd * ww.w);
      } else {
        *reinterpret_cast<float4*>(xnew + (size_t)t * DM + c) = v[i];
        uint2 o;
        o.x = pack2(v[i].x * rstd * ww.x, v[i].y * rstd * ww.y);
        o.y = pack2(v[i].z * rstd * ww.z, v[i].w * rstd * ww.w);
        *reinterpret_cast<uint2*>(hn_out + (size_t)t * DM + c) = o;
      }
    }
  }
}

__global__ void __launch_bounds__(NTHR) mk(Params p) {
  extern __shared__ __attribute__((aligned(16))) char smem[];
  cg::grid_group grid = cg::this_grid();
  __shared__ uint4 xb_words;
  if (threadIdx.x == 0) xb_words = make_uint4(0u, 0u, 0u, 0u);
  __syncthreads();
  XcdBarrier xb = xcd_barrier_post(p.bar(), (volatile LAS unsigned*)&xb_words);
  for (int rep = 0; rep < p.rep[0]; ++rep) ph_convert(p, smem);
  ph_rmsnorm_bf16(p.x, p.ln1_w, p.hn());
  xcd_barrier(xb);
  if (p.rep[12] == 0x7fffffff) grid.sync();
  for (int L = 0; L < 2; ++L) {
    const float* xin = (L == 0) ? p.x : p.xres2();
    float* xout = p.xres();
    if (L == 1) {
      for (int rep = 0; rep < p.rep[1]; ++rep) ph_combine_norm<false>(p, p.xres(), p.xres2(), p.ln1_w + DM, p.hn(), nullptr);
      xcd_barrier(xb);
    }
    for (int rp = 0; rp < p.rep[3]; ++rp) {
      for (int rep = 0; rep < p.rep[2]; ++rep) ph_inproj(p, L, smem);
      xcd_barrier(xb);
      ph_post(p, L);
      xcd_barrier(xb);
    }
    for (int rep = 0; rep < p.rep[12]; ++rep) xcd_barrier(xb);
    {
      unsigned* ctr = p.bar() + XCD_BAR_WORDS + 8 + L;
      __shared__ int q1_item;
      for (;;) {
        if (threadIdx.x == 0) q1_item = (int)atomicAdd(ctr, 1u);
        __syncthreads();
        const int it = q1_item;
        __syncthreads();
        if (it >= 1344) break;
        if (it < 256) ph_dil_pass<0>(p, smem, it);
        else if (it < 384) ph_ssd_a(p, L, smem, it - 256);
        else if (it < 576) ph_mla_up_q(p, L, smem, it - 384);
        else if (it < 832) ph_mla_up_kv(p, L, smem, it - 576);
        else ph_ret_a(p, smem, it - 832);
      }
    }
    xcd_barrier(xb);
    for (int rep = 0; rep < p.rep[5]; ++rep) {
      for (int r2 = 0; r2 < p.rep[13]; ++r2) { ph_ret_scan(p); ph_ssd_scan(p); }
      for (int r2 = 0; r2 < p.rep[14]; ++r2) ph_mla_attn(p, smem);
      for (int r2 = 0; r2 < p.rep[15]; ++r2) for (int bi = obid(); bi < 256; bi += gridDim.x) ph_dil_pass<1>(p, smem, bi);
    }
    xcd_barrier(xb);
    {
      unsigned* ctr = p.bar() + XCD_BAR_WORDS + L;
      __shared__ int q_item;
      for (;;) {
        if (threadIdx.x == 0) q_item = (int)atomicAdd(ctr, 1u);
        __syncthreads();
        const int it = q_item;
        __syncthreads();
        if (it >= 640) break;
        if (it < 128) ph_ssd_c(p, L, smem, it);
        else ph_ret_c(p, smem, it - 128);
      }
    }
    xcd_barrier(xb);
    for (int rep = 0; rep < p.rep[7]; ++rep) ph_outproj(p, L, xin, xout, smem);
    xcd_barrier(xb);
    for (int rep = 0; rep < p.rep[8]; ++rep) ph_rms2_router(p, L, xout, smem);
    xcd_barrier(xb);
    for (int rep = 0; rep < p.rep[9]; ++rep) ph_topk(p, smem);
    xcd_barrier(xb);
    for (int rep = 0; rep < p.rep[10]; ++rep) ph_moe1(p, L, smem);
    xcd_barrier(xb);
    for (int rep = 0; rep < p.rep[11]; ++rep) ph_moe2(p, L, smem);
    xcd_barrier(xb);
  }
  ph_combine_norm<true>(p, p.xres(), nullptr, p.final_w, nullptr, p.out);
}

extern "C" void kernel_launch(void* const* d_in, const int* in_sizes, int n_in, void* d_out, int out_size, void* d_ws,
                              size_t ws_size, hipStream_t stream) {
  static int grid_blocks = 0;
  if (!grid_blocks) {
    int dev = 0, cus = 0, per_cu = 0;
    (void)hipGetDevice(&dev);
    (void)hipDeviceGetAttribute(&cus, hipDeviceAttributeMultiprocessorCount, dev);
    (void)hipFuncSetAttribute((const void*)mk, hipFuncAttributeMaxDynamicSharedMemorySize, LDS_BYTES);
    (void)hipOccupancyMaxActiveBlocksPerMultiprocessor(&per_cu, (const void*)mk, NTHR, LDS_BYTES);
    if (per_cu < 1) { fprintf(stderr, "occupancy query says %d blocks/CU\n", per_cu); per_cu = 1; }
    grid_blocks = cus * 1;
  }
  Params p{};
  const float** fp = reinterpret_cast<const float**>(&p);
  for (int i = 0; i < 20; ++i) fp[i] = (const float*)d_in[i];
  p.out = (float*)d_out;
  p.ws = (char*)d_ws;
  const size_t off = WSO.total;
  { const int reps[16] = REPS_INIT; for (int i = 0; i < 16; ++i) p.rep[i] = reps[i]; }
  if (off > ws_size) { fprintf(stderr, "workspace too small: need %zu have %zu\n", off, ws_size); return; }
  (void)hipMemsetAsync(p.bar(), 0, (size_t)(XCD_BAR_WORDS + 64) * 4, stream);
  void* args[] = {&p};
  hipError_t e = hipLaunchCooperativeKernel((void*)mk, dim3(grid_blocks), dim3(NTHR), args, LDS_BYTES, stream);
  if (e != hipSuccess) fprintf(stderr, "cooperative launch failed: %s (grid %d)\n", hipGetErrorString(e), grid_blocks);
}
```

```cpp
#include <hip/hip_runtime.h>
#include <hip/hip_cooperative_groups.h>
#include <cstdio>
#include <cstdint>
namespace cg = cooperative_groups;

#define DI __device__ __forceinline__
typedef unsigned short u16;
typedef __attribute__((ext_vector_type(8))) short bf16x8;
typedef __attribute__((ext_vector_type(4))) float f32x4;

#ifndef REPS_INIT
#define REPS_INIT {1, 1, 1, 1, 1, 1, 1, 1, 1, 1, 1, 1, 0, 1, 1, 1}
#endif
constexpr int NTHR = 512;
constexpr int T = 16384, SEQ = 4096, DM = 1024;
constexpr int PW = 3240, PWP = 3328;
constexpr int C_RQ = 0, C_RK = 256, C_RV = 512, C_RG = 768, C_CQ = 1024, C_CKV = 1280, C_KR = 1408,
              C_Z = 1440, C_XBC = 1696, C_DT = 2464, C_DQ = 2472, C_DK = 2728, C_DV = 2984;
constexpr int LDS_BYTES = 131072 + 8192;

struct WsOff {
  size_t WinT;
  size_t WuqT;
  size_t WukvT;
  size_t WoutT;
  size_t Wgu8;
  size_t Wd8;
  size_t hn8;
  size_t xres;
  size_t hn;
  size_t proj;
  size_t cqn;
  size_t ckvn;
  size_t mq;
  size_t xbc;
  size_t mixed;
  size_t hid8;
  size_t kfull;
  size_t rS;
  size_t sS;
  size_t rU;
  size_t sU;
  size_t cdec;
  size_t vT;
  size_t rtab;
  size_t dpart;
  size_t dtv;
  size_t cs;
  size_t ybuf;
  size_t aff;
  size_t gate;
  size_t tok;
  size_t inv;
  size_t bar;
  size_t xres2;
  size_t total;
};
constexpr WsOff ws_layout() {
  WsOff o{};
  size_t off = 0;
  o.WinT = off; off += (((size_t)2 * PWP * DM * 2) + 255) & ~(size_t)255;
  o.WuqT = off; off += (((size_t)2 * 384 * 256 * 2) + 255) & ~(size_t)255;
  o.WukvT = off; off += (((size_t)2 * 512 * 128 * 2) + 255) & ~(size_t)255;
  o.WoutT = off; off += (((size_t)2 * DM * DM * 2) + 255) & ~(size_t)255;
  o.Wgu8 = off; off += (((size_t)2 * 16 * 4096 * DM) + 255) & ~(size_t)255;
  o.Wd8 = off; off += (((size_t)2 * 16 * DM * 2048) + 255) & ~(size_t)255;
  o.hn8 = off; off += (((size_t)T * DM) + 255) & ~(size_t)255;
  o.xres = off; off += (((size_t)T * DM * 4) + 255) & ~(size_t)255;
  o.hn = off; off += (((size_t)T * DM * 2) + 255) & ~(size_t)255;
  o.proj = off; off += (((size_t)T * PWP * 2) + 255) & ~(size_t)255;
  o.cqn = off; off += (((size_t)T * 256 * 2) + 255) & ~(size_t)255;
  o.ckvn = off; off += (((size_t)T * 128 * 2) + 255) & ~(size_t)255;
  o.mq = off; off += (((size_t)T * 384 * 2) + 255) & ~(size_t)255;
  o.xbc = off; off += (((size_t)T * 768 * 2) + 255) & ~(size_t)255;
  o.mixed = off; off += (((size_t)T * DM * 2) + 255) & ~(size_t)255;
  o.hid8 = off; off += (((size_t)32768 * 2048) + 255) & ~(size_t)255;
  o.kfull = off; off += (((size_t)T * 4 * 96 * 2) + 255) & ~(size_t)255;
  o.rS = off; off += (((size_t)16 * 32 * 2 * 4096 * 2) + 255) & ~(size_t)255;
  o.sS = off; off += (((size_t)128 * 8 * 8192 * 2) + 255) & ~(size_t)255;
  o.rU = off; off += (((size_t)16 * 32 * 2 * 4096 * 4) + 255) & ~(size_t)255;
  o.sU = off; off += (((size_t)128 * 8 * 8192 * 4) + 255) & ~(size_t)255;
  o.cdec = off; off += (((size_t)128 * 8 * 4) + 255) & ~(size_t)255;
  o.vT = off; off += (((size_t)T * 4 * 64 * 2) + 255) & ~(size_t)255;
  o.rtab = off; off += (((size_t)SEQ * 56 * 2 * 4) + 255) & ~(size_t)255;
  o.dpart = off; off += (((size_t)T * 4 * 68 * 4) + 255) & ~(size_t)255;
  o.dtv = off; off += (((size_t)T * 8 * 4) + 255) & ~(size_t)255;
  o.cs = off; off += (((size_t)T * 8 * 4) + 255) & ~(size_t)255;
  o.ybuf = off; off += (((size_t)T * 256 * 4) + 255) & ~(size_t)255;
  o.aff = off; off += (((size_t)T * 16 * 4) + 255) & ~(size_t)255;
  o.gate = off; off += (((size_t)64 * 512 * 4) + 255) & ~(size_t)255;
  o.tok = off; off += (((size_t)64 * 512 * 4) + 255) & ~(size_t)255;
  o.inv = off; off += (((size_t)T * 16 * 4) + 255) & ~(size_t)255;
  o.bar = off; off += (((size_t)(3456 + 64) * 4) + 255) & ~(size_t)255;
  o.xres2 = off; off += (((size_t)T * DM * 4) + 255) & ~(size_t)255;
  o.total = off;
  return o;
}
constexpr WsOff WSO = ws_layout();
struct Params {
  const float *x, *ln1_w, *w_in, *q_norm_w, *kv_norm_w, *w_uq, *w_ukv, *conv_w, *conv_b, *a_log, *dt_bias,
      *ssm_d, *ssm_norm_w, *w_out, *ln2_w, *router_w, *w_gate, *w_up, *w_down, *final_w;
  float* out;
  char* ws;
  int rep[16];
  __host__ DI u16* WinT() const { return reinterpret_cast<u16*>(ws + WSO.WinT); }
  __host__ DI u16* WuqT() const { return reinterpret_cast<u16*>(ws + WSO.WuqT); }
  __host__ DI u16* WukvT() const { return reinterpret_cast<u16*>(ws + WSO.WukvT); }
  __host__ DI u16* WoutT() const { return reinterpret_cast<u16*>(ws + WSO.WoutT); }
  __host__ DI unsigned char* Wgu8() const { return reinterpret_cast<unsigned char*>(ws + WSO.Wgu8); }
  __host__ DI unsigned char* Wd8() const { return reinterpret_cast<unsigned char*>(ws + WSO.Wd8); }
  __host__ DI unsigned char* hn8() const { return reinterpret_cast<unsigned char*>(ws + WSO.hn8); }
  __host__ DI float* xres() const { return reinterpret_cast<float*>(ws + WSO.xres); }
  __host__ DI u16* hn() const { return reinterpret_cast<u16*>(ws + WSO.hn); }
  __host__ DI u16* proj() const { return reinterpret_cast<u16*>(ws + WSO.proj); }
  __host__ DI u16* cqn() const { return reinterpret_cast<u16*>(ws + WSO.cqn); }
  __host__ DI u16* ckvn() const { return reinterpret_cast<u16*>(ws + WSO.ckvn); }
  __host__ DI u16* mq() const { return reinterpret_cast<u16*>(ws + WSO.mq); }
  __host__ DI u16* xbc() const { return reinterpret_cast<u16*>(ws + WSO.xbc); }
  __host__ DI u16* mixed() const { return reinterpret_cast<u16*>(ws + WSO.mixed); }
  __host__ DI unsigned char* hid8() const { return reinterpret_cast<unsigned char*>(ws + WSO.hid8); }
  __host__ DI u16* kfull() const { return reinterpret_cast<u16*>(ws + WSO.kfull); }
  __host__ DI u16* rS() const { return reinterpret_cast<u16*>(ws + WSO.rS); }
  __host__ DI u16* sS() const { return reinterpret_cast<u16*>(ws + WSO.sS); }
  __host__ DI float* rU() const { return reinterpret_cast<float*>(ws + WSO.rU); }
  __host__ DI float* sU() const { return reinterpret_cast<float*>(ws + WSO.sU); }
  __host__ DI float* cdec() const { return reinterpret_cast<float*>(ws + WSO.cdec); }
  __host__ DI u16* vT() const { return reinterpret_cast<u16*>(ws + WSO.vT); }
  __host__ DI float* rtab() const { return reinterpret_cast<float*>(ws + WSO.rtab); }
  __host__ DI float* dpart() const { return reinterpret_cast<float*>(ws + WSO.dpart); }
  __host__ DI float* dtv() const { return reinterpret_cast<float*>(ws + WSO.dtv); }
  __host__ DI float* cs() const { return reinterpret_cast<float*>(ws + WSO.cs); }
  __host__ DI float* ybuf() const { return reinterpret_cast<float*>(ws + WSO.ybuf); }
  __host__ DI float* aff() const { return reinterpret_cast<float*>(ws + WSO.aff); }
  __host__ DI float* gate() const { return reinterpret_cast<float*>(ws + WSO.gate); }
  __host__ DI int* tok() const { return reinterpret_cast<int*>(ws + WSO.tok); }
  __host__ DI int* inv() const { return reinterpret_cast<int*>(ws + WSO.inv); }
  __host__ DI unsigned* bar() const { return reinterpret_cast<unsigned*>(ws + WSO.bar); }
  __host__ DI float* xres2() const { return reinterpret_cast<float*>(ws + WSO.xres2); }
};


typedef __attribute__((ext_vector_type(2))) __bf16 bf16x2_t;
typedef __attribute__((ext_vector_type(2))) float f32x2_t;
typedef __attribute__((ext_vector_type(16))) float f32x16;
typedef __attribute__((ext_vector_type(4))) short s16x4;
typedef __attribute__((ext_vector_type(8))) int i32x8;
typedef __attribute__((ext_vector_type(4))) int i32x4;
DI unsigned pack2(float a, float b) {
  f32x2_t v = {a, b};
  return __builtin_bit_cast(unsigned, __builtin_convertvector(v, bf16x2_t));
}
DI u16 f2bf(float f) { return (u16)(pack2(f, 0.f) & 0xffffu); }
DI float bf2f(u16 h) { return __uint_as_float(((unsigned)h) << 16); }
DI void unpack8(const uint4& v, float* f) {
  f[0] = __uint_as_float(v.x << 16); f[1] = __uint_as_float(v.x & 0xffff0000u);
  f[2] = __uint_as_float(v.y << 16); f[3] = __uint_as_float(v.y & 0xffff0000u);
  f[4] = __uint_as_float(v.z << 16); f[5] = __uint_as_float(v.z & 0xffff0000u);
  f[6] = __uint_as_float(v.w << 16); f[7] = __uint_as_float(v.w & 0xffff0000u);
}
DI void ld8(const u16* p, float* f) { uint4 v = *reinterpret_cast<const uint4*>(p); unpack8(v, f); }
DI unsigned pk4_f8(float a, float b, float c, float d) {
  a = __builtin_amdgcn_fmed3f(a, -448.f, 448.f); b = __builtin_amdgcn_fmed3f(b, -448.f, 448.f);
  c = __builtin_amdgcn_fmed3f(c, -448.f, 448.f); d = __builtin_amdgcn_fmed3f(d, -448.f, 448.f);
  int w = __builtin_amdgcn_cvt_pk_fp8_f32(a, b, 0, false);
  w = __builtin_amdgcn_cvt_pk_fp8_f32(c, d, w, true);
  return (unsigned)w;
}
constexpr float F8_W_SCALE = 256.f, F8_H_SCALE = 16.f, F8_HID_SCALE = 8.f;
DI float wave_sum(float v) {
#pragma unroll
  for (int o = 32; o > 0; o >>= 1) v += __shfl_xor(v, o);
  return v;
}
DI float dot2acc(unsigned a, unsigned b, float c) {
  return __builtin_amdgcn_fdot2_f32_bf16(__builtin_bit_cast(bf16x2_t, a), __builtin_bit_cast(bf16x2_t, b), c, false);
}
DI float dot8(const uint4& a, const uint4& b, float c) {
  c = dot2acc(a.x, b.x, c); c = dot2acc(a.y, b.y, c); c = dot2acc(a.z, b.z, c); c = dot2acc(a.w, b.w, c);
  return c;
}
DI int otid() { int t = threadIdx.x; asm volatile("" : "+v"(t)); return t; }
DI int obid() { int b = blockIdx.x; asm volatile("" : "+s"(b)); return b; }
DI float silu(float x) { return x / (1.f + __expf(-x)); }
DI float fast_silu(float x) { return x * __builtin_amdgcn_rcpf(1.f + __expf(-x)); }


#define XB_TMO      128
#define XB_XCNT(j)  (256  + 64 * (j))
#define XB_XSUB(j)  (1280 + 64 * (j))
#define XB_XGEN(j)  (2304 + 64 * (j))
#define XB_TOP      3328
#define XB_TOPGEN   3392
#define XCD_BAR_WORDS 3456
#define XB_SPIN_CAP (1u << 20)
#define LAS __attribute__((address_space(3)))
DI unsigned xb_ld(unsigned* p) { return __hip_atomic_load(p, __ATOMIC_RELAXED, __HIP_MEMORY_SCOPE_AGENT); }
DI unsigned xb_add(unsigned* p, unsigned v) { return __hip_atomic_fetch_add(p, v, __ATOMIC_RELAXED, __HIP_MEMORY_SCOPE_AGENT); }
DI unsigned xb_xcc_id() { return (unsigned)__builtin_amdgcn_s_getreg((3 << 11) | 20) & 0xFu; }
#define XB_SPIN(cond, bar) do { unsigned _sp = 0; while (cond) { __builtin_amdgcn_s_sleep(1); \
    if ((++_sp & 255u) == 0u) { if (xb_ld(&(bar)[XB_TMO])) break; if (_sp > XB_SPIN_CAP) { atomicAdd(&(bar)[XB_TMO], 1u); break; } } } } while (0)
struct XcdBarrier { unsigned* bar; unsigned x; volatile LAS unsigned* st; };
DI XcdBarrier xcd_barrier_post(unsigned* bar, volatile LAS unsigned* st) {
  XcdBarrier b; b.bar = bar; b.x = xb_xcc_id(); b.st = st;
  if (threadIdx.x == 0) (void)xb_add(&bar[XB_XCNT(b.x)], 1u);
  return b;
}
DI void xcd_barrier_complete(unsigned* bar, unsigned x, unsigned& nloc, unsigned& nx) {
  const unsigned G = gridDim.x * gridDim.y * gridDim.z;
  unsigned sum, cnt, mine, sp = 0u;
  for (;;) {
    sum = 0u; cnt = 0u; mine = 0u;
#pragma unroll
    for (unsigned j = 0; j < 16; ++j) { const unsigned c = xb_ld(&bar[XB_XCNT(j)]); sum += c; cnt += (c > 0u) ? 1u : 0u; mine = (j == x) ? c : mine; }
    if (sum == G) break;
    __builtin_amdgcn_s_sleep(1);
    if ((++sp & 255u) == 0u) { if (xb_ld(&bar[XB_TMO])) break; if (sp > XB_SPIN_CAP) { atomicAdd(&bar[XB_TMO], 1u); break; } }
  }
  nloc = mine > 0u ? mine : 1u; nx = cnt > 0u ? cnt : 1u;
}
DI void xcd_barrier(const XcdBarrier& b) {
  asm volatile("s_waitcnt vmcnt(0)" ::: "memory");
  __syncthreads();
  if (threadIdx.x == 0) {
    unsigned* bar = b.bar;
    __builtin_amdgcn_s_waitcnt(0);
    unsigned nloc = b.st[0], nx = b.st[1];
    if (nloc == 0u) { xcd_barrier_complete(bar, b.x, nloc, nx); b.st[0] = nloc; b.st[1] = nx; }
    const unsigned old = xb_add(&bar[XB_XSUB(b.x)], 1u);
    const unsigned gen = old / nloc;
    if (old + 1u == (gen + 1u) * nloc) {
      __builtin_amdgcn_fence(__ATOMIC_RELEASE, "agent");
      asm volatile("s_waitcnt vmcnt(0)" ::: "memory");
      const unsigned og = xb_add(&bar[XB_TOP], 1u);
      const unsigned tg = og / nx;
      if (og + 1u == (tg + 1u) * nx) xb_add(&bar[XB_TOPGEN], 1u);
      else XB_SPIN(xb_ld(&bar[XB_TOPGEN]) == tg, bar);
      __builtin_amdgcn_fence(__ATOMIC_ACQUIRE, "agent");
      xb_add(&bar[XB_XGEN(b.x)], 1u);
      asm volatile("s_waitcnt vmcnt(0)" ::: "memory");
    } else {
      XB_SPIN(xb_ld(&bar[XB_XGEN(b.x)]) == gen, bar);
      __builtin_amdgcn_fence(__ATOMIC_ACQUIRE, "agent");
      asm volatile("s_waitcnt vmcnt(0)" ::: "memory");
    }
  }
  __syncthreads();
}

template <class F>
DI void transpose_convert(const float* __restrict__ src, int K, int N, int Npad, u16* __restrict__ dst, F rowmap,
                          int bid, int nb, char* smem) {
  u16* tile = reinterpret_cast<u16*>(smem);
  const int tid = otid();
  const int ntn = Npad / 128, ntk = K / 64;
  for (int t = bid; t < ntn * ntk; t += nb) {
    const int n0 = (t % ntn) * 128, k0 = (t / ntn) * 64;
    f32x4 v[4];
#pragma unroll
    for (int i = 0; i < 4; ++i) {
      const int kk = (tid >> 5) + 16 * i, nn = (tid & 31) * 4;
      v[i] = f32x4{0.f, 0.f, 0.f, 0.f};
      if (n0 + nn < N) v[i] = __builtin_nontemporal_load(reinterpret_cast<const f32x4*>(src + (size_t)(k0 + kk) * N + n0 + nn));
    }
#pragma unroll
    for (int i = 0; i < 4; ++i) {
      const int kk = (tid >> 5) + 16 * i, nn = (tid & 31) * 4;
      tile[(nn + 0) * 72 + kk] = f2bf(v[i][0]); tile[(nn + 1) * 72 + kk] = f2bf(v[i][1]);
      tile[(nn + 2) * 72 + kk] = f2bf(v[i][2]); tile[(nn + 3) * 72 + kk] = f2bf(v[i][3]);
    }
    __syncthreads();
#pragma unroll
    for (int j = 0; j < 2; ++j) {
      const int c = tid + NTHR * j, nn = c >> 3, k8 = (c & 7) * 8;
      const uint4 o = *reinterpret_cast<const uint4*>(tile + nn * 72 + k8);
      *reinterpret_cast<uint4*>(dst + (size_t)rowmap(n0 + nn) * K + k0 + k8) = o;
    }
    __syncthreads();
  }
}

template <class F>
DI void transpose_convert_f8(const float* __restrict__ src, int K, int N, unsigned char* __restrict__ dst, F rowmap,
                             int bid, int nb, char* smem) {
  unsigned char* tile = reinterpret_cast<unsigned char*>(smem);
  const int tid = otid();
  const int ntn = N / 128, ntk = K / 64;
  for (int t = bid; t < ntn * ntk; t += nb) {
    const int n0 = (t % ntn) * 128, k0 = (t / ntn) * 64;
    const int kq = (tid >> 5) * 4, nn = (tid & 31) * 4;
    f32x4 v[4];
#pragma unroll
    for (int r = 0; r < 4; ++r) v[r] = __builtin_nontemporal_load(reinterpret_cast<const f32x4*>(src + (size_t)(k0 + kq + r) * N + n0 + nn));
#pragma unroll
    for (int e = 0; e < 4; ++e)
      *reinterpret_cast<unsigned*>(tile + (nn + e) * 80 + kq) =
          pk4_f8(v[0][e] * F8_W_SCALE, v[1][e] * F8_W_SCALE, v[2][e] * F8_W_SCALE, v[3][e] * F8_W_SCALE);
    __syncthreads();
    {
      const int rn = tid >> 2, kc = (tid & 3) * 16;
      const uint4 o = *reinterpret_cast<const uint4*>(tile + rn * 80 + kc);
      *reinterpret_cast<uint4*>(dst + (size_t)rowmap(n0 + rn) * K + k0 + kc) = o;
    }
    __syncthreads();
  }
}

DI void ph_convert(const Params& p, char* smem) {
  const int nb = gridDim.x;
  int bid = obid();
  for (int idx = bid * NTHR + otid(); idx < SEQ * 56; idx += nb * NTHR) {
    const int pos = idx / 56, f = idx - pos * 56;
    float inv;
    if (f < 32) inv = exp2f(-(float)f * (13.287712379549449f / 32.f));
    else if (f < 40) inv = exp2f(-(float)(f - 32) * (18.931568569324174f / 8.f));
    else inv = exp2f(-(float)(f - 40) * (18.931568569324174f / 16.f));
    float sn, cs;
    sincosf((float)pos * inv, &sn, &cs);
    p.rtab()[(size_t)idx * 2] = cs;
    p.rtab()[(size_t)idx * 2 + 1] = sn;
  }
  auto ident = [](int n) { return n; };
  for (int L = 0; L < 2; ++L) {
    transpose_convert(p.w_in + (size_t)L * DM * PW, DM, PW, PWP, p.WinT() + (size_t)L * PWP * DM, ident, bid, nb, smem);
    transpose_convert(p.w_uq + (size_t)L * 256 * 384, 256, 384, 384, p.WuqT() + (size_t)L * 384 * 256, ident, bid, nb, smem);
    transpose_convert(p.w_ukv + (size_t)L * 128 * 512, 128, 512, 512, p.WukvT() + (size_t)L * 512 * 128, ident, bid, nb, smem);
    transpose_convert(p.w_out + (size_t)L * DM * DM, DM, DM, DM, p.WoutT() + (size_t)L * DM * DM, ident, bid, nb, smem);
    for (int e = 0; e < 16; ++e) {
      const size_t le = (size_t)(L * 16 + e);
      auto gmap = [](int n) { return (n >> 7) * 256 + (n & 127); };
      auto umap = [](int n) { return (n >> 7) * 256 + 128 + (n & 127); };
      transpose_convert_f8(p.w_gate + le * DM * 2048, DM, 2048, p.Wgu8() + le * 4096 * DM, gmap, bid, nb, smem);
      transpose_convert_f8(p.w_up + le * DM * 2048, DM, 2048, p.Wgu8() + le * 4096 * DM, umap, bid, nb, smem);
      transpose_convert_f8(p.w_down + le * 2048 * DM, 2048, DM, p.Wd8() + le * DM * 2048, ident, bid, nb, smem);
    }
  }
}

template <class RowPtr, class Epi>
DI void gemm_tile(RowPtr arow, const u16* __restrict__ bt, int ldb, int K, char* smem, Epi epi) {
  u16* sa = reinterpret_cast<u16*>(smem);
  u16* sb = sa + 2 * 256 * 72;
  const int tid = otid(), wid = tid >> 6, lane = tid & 63, wr = wid >> 1, wc = wid & 1, fr = lane & 15, fq = lane >> 4;
  f32x4 acc[4][4];
#pragma unroll
  for (int m = 0; m < 4; ++m)
#pragma unroll
    for (int n = 0; n < 4; ++n) acc[m][n] = f32x4{0.f, 0.f, 0.f, 0.f};
  const int lr = tid >> 3, lc = (tid & 7) * 8;
  const u16* ap[4];
#pragma unroll
  for (int i = 0; i < 4; ++i) ap[i] = arow(lr + 64 * i) + lc;
  const u16* bp[2];
#pragma unroll
  for (int i = 0; i < 2; ++i) bp[i] = bt + (size_t)(lr + 64 * i) * ldb + lc;
  uint4 ra[4], rb[2];
  const int nk = K / 64;
#pragma unroll
  for (int i = 0; i < 4; ++i) ra[i] = *reinterpret_cast<const uint4*>(ap[i]);
#pragma unroll
  for (int i = 0; i < 2; ++i) rb[i] = *reinterpret_cast<const uint4*>(bp[i]);
#pragma unroll
  for (int i = 0; i < 4; ++i) *reinterpret_cast<uint4*>(sa + (lr + 64 * i) * 72 + lc) = ra[i];
#pragma unroll
  for (int i = 0; i < 2; ++i) *reinterpret_cast<uint4*>(sb + (lr + 64 * i) * 72 + lc) = rb[i];
  __syncthreads();
  for (int kt = 0; kt < nk; ++kt) {
    const int cur = kt & 1;
    if (kt + 1 < nk) {
#pragma unroll
      for (int i = 0; i < 4; ++i) ra[i] = *reinterpret_cast<const uint4*>(ap[i] + (kt + 1) * 64);
#pragma unroll
      for (int i = 0; i < 2; ++i) rb[i] = *reinterpret_cast<const uint4*>(bp[i] + (kt + 1) * 64);
    }
    const u16* ca = sa + cur * 256 * 72;
    const u16* cb = sb + cur * 128 * 72;
#pragma unroll
    for (int kk = 0; kk < 2; ++kk) {
      bf16x8 af[4], bfr[4];
#pragma unroll
      for (int m = 0; m < 4; ++m) af[m] = *reinterpret_cast<const bf16x8*>(ca + (wr * 64 + m * 16 + fr) * 72 + kk * 32 + fq * 8);
#pragma unroll
      for (int n = 0; n < 4; ++n) bfr[n] = *reinterpret_cast<const bf16x8*>(cb + (wc * 64 + n * 16 + fr) * 72 + kk * 32 + fq * 8);
#pragma unroll
      for (int m = 0; m < 4; ++m)
#pragma unroll
        for (int n = 0; n < 4; ++n) acc[m][n] = __builtin_amdgcn_mfma_f32_16x16x32_bf16(af[m], bfr[n], acc[m][n], 0, 0, 0);
    }
    if (kt + 1 < nk) {
      u16* na = sa + (cur ^ 1) * 256 * 72;
      u16* nbp = sb + (cur ^ 1) * 128 * 72;
#pragma unroll
      for (int i = 0; i < 4; ++i) *reinterpret_cast<uint4*>(na + (lr + 64 * i) * 72 + lc) = ra[i];
#pragma unroll
      for (int i = 0; i < 2; ++i) *reinterpret_cast<uint4*>(nbp + (lr + 64 * i) * 72 + lc) = rb[i];
    }
    __syncthreads();
  }
  epi(acc, wr, wc, fr, fq);
}

#define WAIT_V(n) asm volatile("s_waitcnt vmcnt(%0)" ::"n"(n) : "memory")
DI int lds_byte2(int r, int c) {
  const int st = (r >> 4) * 2 + (c >> 5), ob = (r & 15) * 64 + (c & 31) * 2;
  return st * 1024 + (ob ^ (((ob >> 9) & 1) << 5));
}
DI void stage_rc2(int b, int& R, int& C) {
  const int st = b >> 10, sb = b & 1023, swz = sb ^ (((sb >> 9) & 1) << 5);
  R = (st >> 1) * 16 + swz / 64;
  C = (st & 1) * 32 + (swz % 64) / 2;
}
typedef __attribute__((address_space(3))) unsigned lds_u32;
template <class RowPtr, class Epi>
DI void gemm256(RowPtr arow, const u16* __restrict__ bt, int ldb, int K, char* smem, Epi epi) {
  constexpr int TILE_B = 256 * 64 * 2, STAGE_B = 2 * TILE_B;
  const int tid = otid(), wid = tid >> 6, lane = tid & 63, wr = wid >> 2, wc = wid & 3, fr = lane & 15, fq = lane >> 4;
  const u16* ap[4];
  const u16* bp[4];
#pragma unroll
  for (int i = 0; i < 4; ++i) {
    int R, C;
    stage_rc2(wid * 1024 + i * 8192 + lane * 16, R, C);
    ap[i] = arow(R) + C;
    bp[i] = bt + (size_t)R * ldb + C;
  }
  f32x4 acc[8][4];
#pragma unroll
  for (int m = 0; m < 8; ++m)
#pragma unroll
    for (int n = 0; n < 4; ++n) acc[m][n] = f32x4{0.f, 0.f, 0.f, 0.f};
#define G2_STAGE(buf, kt)                                                                                              \
  do {                                                                                                                 \
    _Pragma("unroll") for (int i = 0; i < 4; ++i) {                                                                    \
      __builtin_amdgcn_global_load_lds((const unsigned*)(ap[i] + (kt) * 64),                                           \
                                       (lds_u32*)(smem + (buf) * STAGE_B + wid * 1024 + i * 8192), 16, 0, 0);          \
      __builtin_amdgcn_global_load_lds((const unsigned*)(bp[i] + (kt) * 64),                                           \
                                       (lds_u32*)(smem + (buf) * STAGE_B + TILE_B + wid * 1024 + i * 8192), 16, 0, 0); \
    }                                                                                                                  \
  } while (0)
  const int nt = K / 64;
  G2_STAGE(0, 0);
  WAIT_V(0);
  __syncthreads();
  for (int t = 0; t < nt; ++t) {
    const int cur = t & 1;
    if (t + 1 < nt) G2_STAGE(cur ^ 1, t + 1);
    const char* sA = smem + cur * STAGE_B;
    const char* sB = sA + TILE_B;
#pragma unroll
    for (int ks = 0; ks < 2; ++ks) {
      bf16x8 At[8], Bf[4];
#pragma unroll
      for (int m = 0; m < 8; ++m) At[m] = *reinterpret_cast<const bf16x8*>(sA + lds_byte2(wr * 128 + m * 16 + fr, ks * 32 + fq * 8));
#pragma unroll
      for (int n = 0; n < 4; ++n) Bf[n] = *reinterpret_cast<const bf16x8*>(sB + lds_byte2(wc * 64 + n * 16 + fr, ks * 32 + fq * 8));
#pragma unroll
      for (int m = 0; m < 8; ++m)
#pragma unroll
        for (int n = 0; n < 4; ++n) acc[m][n] = __builtin_amdgcn_mfma_f32_16x16x32_bf16(Bf[n], At[m], acc[m][n], 0, 0, 0);
      __builtin_amdgcn_sched_barrier(0);
    }
    WAIT_V(0);
    __syncthreads();
  }
  epi(acc, wr, wc, fr, fq);
}

namespace pg8 {
constexpr int BM = 256, BK = 64, HALF = 128, HTB = HALF * BK * 2;
DI int lds_byte(int r, int c) { const int st = (r >> 4) * 2 + (c >> 5), rr = r & 15, cc = c & 31, ob = rr * 64 + cc * 2; return st * 1024 + (ob ^ (((ob >> 9) & 1) << 5)); }
DI void stage_rc(int b, int& R, int& C) { const int st = b / 1024, sb = b % 1024, swz = sb ^ (((sb >> 9) & 1) << 5); R = (st >> 1) * 16 + swz / 64; C = (st & 1) * 32 + (swz % 64) / 2; }
DI int perm32(int rho) { const int n = rho >> 4, i = rho & 15; return 8 * (i >> 2) + 4 * n + (i & 3); }
struct Unit { int pm, pn; };
typedef __attribute__((address_space(3))) unsigned char lds_u8;
typedef __attribute__((address_space(3))) unsigned lds_u32;
typedef __attribute__((address_space(3))) bf16x8 lds_bf16x8;
typedef __attribute__((address_space(3))) i32x4 lds_i32x4;

template <class Cfg>
DI void gemm_phase(lds_u8* lds, const Cfg& S) {
  const int tid = otid(), wid = __builtin_amdgcn_readfirstlane(tid >> 6), lane = tid & 63, wr = wid >> 2, wc = wid & 3, fr = lane & 15, fq = lane >> 4;
  const int K = S.K, nt = K / BK;
  int R0, C0, R1, C1;
  stage_rc(tid * 16, R0, C0);
  stage_rc(tid * 16 + 8192, R1, C1);
  unsigned voffB[2];
  {
    const int Rb0 = Cfg::PERM ? ((R0 & ~31) + perm32(R0 & 31)) : R0, Rb1 = Cfg::PERM ? ((R1 & ~31) + perm32(R1 & 31)) : R1;
    voffB[0] = (unsigned)(Rb0 * K + C0) * 2u; voffB[1] = (unsigned)(Rb1 * K + C1) * 2u;
  }
  const size_t kstep = (size_t)(BK * 2);
  const size_t hstep = (size_t)HALF * K * 2;
  const unsigned ldsw = (unsigned)wid * 1024u;
  const int aoff = lds_byte(wr * 64 + fr, fq * 8), boff = lds_byte(wc * 32 + fr, fq * 8);
#define PG8_SA(b, h) (((b) * 2 + (h)) * HTB)
#define PG8_SB(b, h) ((4 + (b) * 2 + (h)) * HTB)
#define PG8_STAGE2(bufoff, gbase, o0, o1) do { \
    __builtin_amdgcn_global_load_lds((const unsigned*)((const char*)(gbase) + (o0)), (lds_u32*)(lds + (bufoff) + ldsw), 16, 0, 0); \
    __builtin_amdgcn_global_load_lds((const unsigned*)((const char*)(gbase) + (o1)), (lds_u32*)(lds + (bufoff) + ldsw + 8192), 16, 0, 0); } while (0)
#define PG8_STAGEB(bufoff, gbase) PG8_STAGE2(bufoff, gbase, voffB[0], voffB[1])
#define PG8_LDA(dst, b, h) do { _Pragma("unroll") for (int m = 0; m < 4; ++m) _Pragma("unroll") for (int k = 0; k < 2; ++k) dst[m][k] = *(const lds_bf16x8*)(lds + PG8_SA(b, h) + aoff + m * 2048 + k * 1024); } while (0)
#define PG8_LDB(dst, b, h) do { _Pragma("unroll") for (int n = 0; n < 2; ++n) _Pragma("unroll") for (int k = 0; k < 2; ++k) dst[n][k] = *(const lds_bf16x8*)(lds + PG8_SB(b, h) + boff + n * 2048 + k * 1024); } while (0)
#define PG8_MMA(ai, bj, At, Bt) do { __builtin_amdgcn_s_setprio(1); _Pragma("unroll") for (int m = 0; m < 4; ++m) _Pragma("unroll") for (int n = 0; n < 2; ++n) _Pragma("unroll") for (int k = 0; k < 2; ++k) \
    acc[ai][bj][m][n] = __builtin_amdgcn_mfma_f32_16x16x32_bf16(Bt[n][k], At[m][k], acc[ai][bj][m][n], 0, 0, 0); __builtin_amdgcn_s_setprio(0); } while (0)
#define PG8_WAIT_V(n) asm volatile("s_waitcnt vmcnt(" #n ")" ::: "memory")
#define PG8_WAIT_L(n) asm volatile("s_waitcnt lgkmcnt(" #n ")" ::: "memory")
#define PG8_BAR __builtin_amdgcn_s_barrier()
#define PG8_SCHED __builtin_amdgcn_sched_barrier(0)
  Unit cur, nxt; int ui = 0;
  if (!S.next(0, cur)) return;
  f32x4 acc[2][2][4][2];
#pragma unroll
  for (int a = 0; a < 2; ++a)
#pragma unroll
    for (int b = 0; b < 2; ++b)
#pragma unroll
      for (int m = 0; m < 4; ++m)
#pragma unroll
        for (int n = 0; n < 2; ++n) acc[a][b][m][n] = f32x4{0.f, 0.f, 0.f, 0.f};
  bf16x8 At[4][2], B0[2][2], B1[2][2];
  const char* cA = S.a_base(cur);
  const char* cB = S.b_base(cur);
  unsigned vc[4], vn[4];
  S.a_off(cur, R0, C0, R1, C1, vc);
  PG8_STAGEB(PG8_SB(0, 0), cB); PG8_STAGE2(PG8_SA(0, 0), cA, vc[0], vc[1]); PG8_STAGEB(PG8_SB(0, 1), cB + hstep); PG8_STAGE2(PG8_SA(0, 1), cA, vc[2], vc[3]);
  if (wr == 1) PG8_BAR;
  PG8_WAIT_V(4); PG8_BAR;
  PG8_STAGEB(PG8_SB(1, 0), cB + kstep); PG8_STAGE2(PG8_SA(1, 0), cA + kstep, vc[0], vc[1]); PG8_STAGEB(PG8_SB(1, 1), cB + hstep + kstep);
  PG8_WAIT_V(6); PG8_BAR;
  for (;;) {
    const bool has_next = S.next(ui + 1, nxt);
    const char* nA = has_next ? S.a_base(nxt) : cA;
    const char* nB = has_next ? S.b_base(nxt) : cB;
    if (has_next) S.a_off(nxt, R0, C0, R1, C1, vn);
    else { vn[0] = vc[0]; vn[1] = vc[1]; vn[2] = vc[2]; vn[3] = vc[3]; }
    for (int t = 0; t < nt; t += 2) {
      const bool last = (t == nt - 2);
      const char* a1 = cA + (size_t)(t + 1) * kstep;
      const char* a2 = last ? nA : cA + (size_t)(t + 2) * kstep;
      const char* b2 = last ? nB : cB + (size_t)(t + 2) * kstep;
      const char* a3 = a2 + kstep;
      const char* b3 = b2 + kstep;
      const unsigned w0 = last ? vn[0] : vc[0], w1 = last ? vn[1] : vc[1], w2 = last ? vn[2] : vc[2], w3 = last ? vn[3] : vc[3];
      PG8_LDB(B0, 0, 0); PG8_SCHED; PG8_LDA(At, 0, 0); PG8_STAGE2(PG8_SA(1, 1), a1, vc[2], vc[3]);
      PG8_WAIT_L(8); PG8_BAR; PG8_WAIT_L(0); PG8_MMA(0, 0, At, B0); PG8_BAR; PG8_SCHED;
      PG8_LDB(B1, 0, 1); PG8_STAGEB(PG8_SB(0, 0), b2);
      PG8_BAR; PG8_WAIT_L(0); PG8_MMA(0, 1, At, B1); PG8_BAR;
      PG8_LDA(At, 0, 1); PG8_STAGE2(PG8_SA(0, 0), a2, w0, w1);
      PG8_BAR; PG8_WAIT_L(0); PG8_MMA(1, 0, At, B0); PG8_BAR; PG8_SCHED;
      PG8_STAGEB(PG8_SB(0, 1), b2 + hstep);
      PG8_WAIT_V(6); PG8_BAR; PG8_MMA(1, 1, At, B1); PG8_BAR;
      PG8_LDB(B0, 1, 0); PG8_SCHED; PG8_LDA(At, 1, 0); PG8_STAGE2(PG8_SA(0, 1), a2, w2, w3);
      PG8_WAIT_L(8); PG8_BAR; PG8_WAIT_L(0); PG8_MMA(0, 0, At, B0); PG8_BAR; PG8_SCHED;
      PG8_LDB(B1, 1, 1); PG8_STAGEB(PG8_SB(1, 0), b3);
      PG8_BAR; PG8_WAIT_L(0); PG8_MMA(0, 1, At, B1); PG8_BAR;
      PG8_LDA(At, 1, 1); PG8_STAGE2(PG8_SA(1, 0), a3, w0, w1);
      PG8_BAR; PG8_WAIT_L(0); PG8_MMA(1, 0, At, B0); PG8_BAR; PG8_SCHED;
      PG8_STAGEB(PG8_SB(1, 1), b3 + hstep);
      PG8_WAIT_V(6); PG8_BAR; PG8_MMA(1, 1, At, B1); PG8_BAR;
    }
    S.epi(acc, cur, wr, wc, fr, fq);
    if (!has_next) break;
#pragma unroll
    for (int a = 0; a < 2; ++a)
#pragma unroll
      for (int b = 0; b < 2; ++b)
#pragma unroll
        for (int m = 0; m < 4; ++m)
#pragma unroll
          for (int n = 0; n < 2; ++n) acc[a][b][m][n] = f32x4{0.f, 0.f, 0.f, 0.f};
    cur = nxt; cA = nA; cB = nB; ++ui;
    vc[0] = vn[0]; vc[1] = vn[1]; vc[2] = vn[2]; vc[3] = vn[3];
  }
  PG8_WAIT_V(0);
  if (wr == 0) PG8_BAR;
  PG8_BAR;
#undef PG8_SA
#undef PG8_SB
#undef PG8_STAGE2
#undef PG8_STAGEB
#undef PG8_LDA
#undef PG8_LDB
#undef PG8_MMA
#undef PG8_WAIT_V
#undef PG8_WAIT_L
#undef PG8_BAR
#undef PG8_SCHED
}
template <class Cfg>
DI void gemm_phase_f8(lds_u8* lds, const Cfg& S) {
  const int tid = otid(), wid = __builtin_amdgcn_readfirstlane(tid >> 6), lane = tid & 63, wr = wid >> 2, wc = wid & 3, fr = lane & 15, fq = lane >> 4;
  const int K = S.K, nt = K / BK;
  int R0, C0, R1, C1;
  stage_rc(tid * 16, R0, C0);
  stage_rc(tid * 16 + 8192, R1, C1);
  unsigned voffB[2];
  {
    const int Rb0 = Cfg::PERM ? ((R0 & ~31) + perm32(R0 & 31)) : R0, Rb1 = Cfg::PERM ? ((R1 & ~31) + perm32(R1 & 31)) : R1;
    voffB[0] = (unsigned)(Rb0 * K + C0) * 2u; voffB[1] = (unsigned)(Rb1 * K + C1) * 2u;
  }
  const size_t kstep = (size_t)(BK * 2);
  const size_t hstep = (size_t)HALF * K * 2;
  const unsigned ldsw = (unsigned)wid * 1024u;
  const int cl = 2 * fq + (fq & 1), ch = 2 * fq + 1 - (fq & 1);
  const int aoffL = lds_byte(wr * 64 + fr, cl * 8), aoffH = lds_byte(wr * 64 + fr, ch * 8);
  const int boffL = lds_byte(wc * 32 + fr, cl * 8), boffH = lds_byte(wc * 32 + fr, ch * 8);
#define PG8_SA(b, h) (((b) * 2 + (h)) * HTB)
#define PG8_SB(b, h) ((4 + (b) * 2 + (h)) * HTB)
#define PG8_STAGE2(bufoff, gbase, o0, o1) do { \
    __builtin_amdgcn_global_load_lds((const unsigned*)((const char*)(gbase) + (o0)), (lds_u32*)(lds + (bufoff) + ldsw), 16, 0, 0); \
    __builtin_amdgcn_global_load_lds((const unsigned*)((const char*)(gbase) + (o1)), (lds_u32*)(lds + (bufoff) + ldsw + 8192), 16, 0, 0); } while (0)
#define PG8_STAGEB(bufoff, gbase) PG8_STAGE2(bufoff, gbase, voffB[0], voffB[1])
#define PG8_LDA(dst, b, h) do { _Pragma("unroll") for (int m = 0; m < 4; ++m) { const i32x4 lo_ = *(const lds_i32x4*)(lds + PG8_SA(b, h) + aoffL + m * 2048), hi_ = *(const lds_i32x4*)(lds + PG8_SA(b, h) + aoffH + m * 2048); dst[m] = __builtin_shufflevector(lo_, hi_, 0, 1, 2, 3, 4, 5, 6, 7); } } while (0)
#define PG8_LDB(dst, b, h) do { _Pragma("unroll") for (int n = 0; n < 2; ++n) { const i32x4 lo_ = *(const lds_i32x4*)(lds + PG8_SB(b, h) + boffL + n * 2048), hi_ = *(const lds_i32x4*)(lds + PG8_SB(b, h) + boffH + n * 2048); dst[n] = __builtin_shufflevector(lo_, hi_, 0, 1, 2, 3, 4, 5, 6, 7); } } while (0)
#define PG8_MMA(ai, bj, At, Bt) do { __builtin_amdgcn_s_setprio(1); _Pragma("unroll") for (int m = 0; m < 4; ++m) _Pragma("unroll") for (int n = 0; n < 2; ++n) \
    asm volatile("v_mfma_f32_16x16x128_f8f6f4 %0, %1, %2, %0" : "+v"(acc[ai][bj][m][n]) : "v"(Bt[n]), "v"(At[m])); __builtin_amdgcn_s_setprio(0); } while (0)
#define PG8_WAIT_V(n) asm volatile("s_waitcnt vmcnt(" #n ")" ::: "memory")
#define PG8_WAIT_L(n) asm volatile("s_waitcnt lgkmcnt(" #n ")" ::: "memory")
#define PG8_BAR __builtin_amdgcn_s_barrier()
#define PG8_SCHED __builtin_amdgcn_sched_barrier(0)
  Unit cur, nxt; int ui = 0;
  if (!S.next(0, cur)) return;
  f32x4 acc[2][2][4][2];
#pragma unroll
  for (int a = 0; a < 2; ++a)
#pragma unroll
    for (int b = 0; b < 2; ++b)
#pragma unroll
      for (int m = 0; m < 4; ++m)
#pragma unroll
        for (int n = 0; n < 2; ++n) acc[a][b][m][n] = f32x4{0.f, 0.f, 0.f, 0.f};
  i32x8 At[4], B0[2], B1[2];
  const char* cA = S.a_base(cur);
  const char* cB = S.b_base(cur);
  unsigned vc[4], vn[4];
  S.a_off(cur, R0, C0, R1, C1, vc, 0);
  PG8_STAGEB(PG8_SB(0, 0), cB); PG8_STAGE2(PG8_SA(0, 0), cA, vc[0], vc[1]); PG8_STAGEB(PG8_SB(0, 1), cB + hstep); PG8_STAGE2(PG8_SA(0, 1), cA, vc[2], vc[3]);
  if (wr == 1) PG8_BAR;
  PG8_WAIT_V(4); PG8_BAR;
  PG8_STAGEB(PG8_SB(1, 0), cB + kstep); PG8_STAGE2(PG8_SA(1, 0), cA + kstep, vc[0], vc[1]); PG8_STAGEB(PG8_SB(1, 1), cB + hstep + kstep);
  PG8_WAIT_V(6); PG8_BAR;
  for (;;) {
    const bool has_next = S.next(ui + 1, nxt);
    const char* nA = has_next ? S.a_base(nxt) : cA;
    const char* nB = has_next ? S.b_base(nxt) : cB;
    if (has_next) S.a_off(nxt, R0, C0, R1, C1, vn, ui + 1);
    else { vn[0] = vc[0]; vn[1] = vc[1]; vn[2] = vc[2]; vn[3] = vc[3]; }
    for (int t = 0; t < nt; t += 2) {
      const bool last = (t == nt - 2);
      const char* a1 = cA + (size_t)(t + 1) * kstep;
      const char* a2 = last ? nA : cA + (size_t)(t + 2) * kstep;
      const char* b2 = last ? nB : cB + (size_t)(t + 2) * kstep;
      const char* a3 = a2 + kstep;
      const char* b3 = b2 + kstep;
      const unsigned w0 = last ? vn[0] : vc[0], w1 = last ? vn[1] : vc[1], w2 = last ? vn[2] : vc[2], w3 = last ? vn[3] : vc[3];
      PG8_LDB(B0, 0, 0); PG8_SCHED; PG8_LDA(At, 0, 0); PG8_STAGE2(PG8_SA(1, 1), a1, vc[2], vc[3]);
      PG8_WAIT_L(8); PG8_BAR; PG8_WAIT_L(0); PG8_MMA(0, 0, At, B0); PG8_BAR; PG8_SCHED;
      PG8_LDB(B1, 0, 1); PG8_STAGEB(PG8_SB(0, 0), b2);
      PG8_BAR; PG8_WAIT_L(0); PG8_MMA(0, 1, At, B1); PG8_BAR;
      PG8_LDA(At, 0, 1); PG8_STAGE2(PG8_SA(0, 0), a2, w0, w1);
      PG8_BAR; PG8_WAIT_L(0); PG8_MMA(1, 0, At, B0); PG8_BAR; PG8_SCHED;
      PG8_STAGEB(PG8_SB(0, 1), b2 + hstep);
      PG8_WAIT_V(6); PG8_BAR; PG8_MMA(1, 1, At, B1); PG8_BAR;
      PG8_LDB(B0, 1, 0); PG8_SCHED; PG8_LDA(At, 1, 0); PG8_STAGE2(PG8_SA(0, 1), a2, w2, w3);
      PG8_WAIT_L(8); PG8_BAR; PG8_WAIT_L(0); PG8_MMA(0, 0, At, B0); PG8_BAR; PG8_SCHED;
      PG8_LDB(B1, 1, 1); PG8_STAGEB(PG8_SB(1, 0), b3);
      PG8_BAR; PG8_WAIT_L(0); PG8_MMA(0, 1, At, B1); PG8_BAR;
      PG8_LDA(At, 1, 1); PG8_STAGE2(PG8_SA(1, 0), a3, w0, w1);
      PG8_BAR; PG8_WAIT_L(0); PG8_MMA(1, 0, At, B0); PG8_BAR; PG8_SCHED;
      PG8_STAGEB(PG8_SB(1, 1), b3 + hstep);
      PG8_WAIT_V(6); PG8_BAR; PG8_MMA(1, 1, At, B1); PG8_BAR;
    }
    asm volatile("s_nop 15\n\ts_nop 15" ::: "memory");
    S.epi(acc, cur, wr, wc, fr, fq);
    if (!has_next) break;
#pragma unroll
    for (int a = 0; a < 2; ++a)
#pragma unroll
      for (int b = 0; b < 2; ++b)
#pragma unroll
        for (int m = 0; m < 4; ++m)
#pragma unroll
          for (int n = 0; n < 2; ++n) acc[a][b][m][n] = f32x4{0.f, 0.f, 0.f, 0.f};
    cur = nxt; cA = nA; cB = nB; ++ui;
    vc[0] = vn[0]; vc[1] = vn[1]; vc[2] = vn[2]; vc[3] = vn[3];
  }
  PG8_WAIT_V(0);
  if (wr == 0) PG8_BAR;
  PG8_BAR;
#undef PG8_SA
#undef PG8_SB
#undef PG8_STAGE2
#undef PG8_STAGEB
#undef PG8_LDA
#undef PG8_LDB
#undef PG8_MMA
#undef PG8_WAIT_V
#undef PG8_WAIT_L
#undef PG8_BAR
#undef PG8_SCHED
}
}

struct CfgInproj {
  static constexpr bool PERM = true;
  int K; const Params* p; int L; int bid, nb;
  DI bool next(int i, pg8::Unit& u) const { const int t = i * nb + bid; if (t >= 64 * 13) return false; u.pm = t & 63; u.pn = t >> 6; return true; }
  DI const char* a_base(const pg8::Unit& u) const { return (const char*)(p->hn() + (size_t)u.pm * 256 * DM); }
  DI const char* b_base(const pg8::Unit& u) const { return (const char*)(p->WinT() + ((size_t)L * PWP + (size_t)u.pn * 256) * DM); }
  DI void a_off(const pg8::Unit&, int R0, int C0, int R1, int C1, unsigned (&vo)[4]) const {
    vo[0] = (unsigned)(R0 * DM + C0) * 2u; vo[1] = (unsigned)(R1 * DM + C1) * 2u;
    vo[2] = vo[0] + 128u * DM * 2u; vo[3] = vo[1] + 128u * DM * 2u;
  }
  DI void epi(const f32x4 (&acc)[2][2][4][2], const pg8::Unit& u, int wr, int wc, int fr, int fq) const {
    const int row0 = u.pm * 256 + wr * 64 + fr, col0 = u.pn * 256 + wc * 32 + 8 * fq;
#pragma unroll
    for (int ai = 0; ai < 2; ++ai)
#pragma unroll
      for (int m = 0; m < 4; ++m) {
        u16* rowp = p->proj() + (size_t)(row0 + ai * 128 + m * 16) * PWP + col0;
#pragma unroll
        for (int bj = 0; bj < 2; ++bj) {
          uint4 w;
          w.x = pack2(acc[ai][bj][m][0][0], acc[ai][bj][m][0][1]); w.y = pack2(acc[ai][bj][m][0][2], acc[ai][bj][m][0][3]);
          w.z = pack2(acc[ai][bj][m][1][0], acc[ai][bj][m][1][1]); w.w = pack2(acc[ai][bj][m][1][2], acc[ai][bj][m][1][3]);
          *reinterpret_cast<uint4*>(rowp + bj * 128) = w;
        }
      }
  }
};
DI void ph_inproj_tail(const Params& p, int L, char* smem, int t) {
  const int m0 = (t & 63) * 256, n0 = 3072 + (t >> 6) * 128;
  const u16* Bt = p.WinT() + ((size_t)L * PWP + n0) * DM;
  gemm_tile([&](int r) { return p.hn() + (size_t)(m0 + r) * DM; }, Bt, DM, DM, smem,
            [&](f32x4 (&acc)[4][4], int wr, int wc, int fr, int fq) {
#pragma unroll
              for (int m = 0; m < 4; ++m)
#pragma unroll
                for (int n = 0; n < 4; ++n)
#pragma unroll
                  for (int j = 0; j < 4; ++j)
                    p.proj()[(size_t)(m0 + wr * 64 + m * 16 + fq * 4 + j) * PWP + n0 + wc * 64 + n * 16 + fr] = f2bf(acc[m][n][j]);
            });
}
DI void ph_inproj(const Params& p, int L, char* smem) {
  CfgInproj c; c.K = DM; c.p = &p; c.L = L; c.bid = obid(); c.nb = gridDim.x;
  pg8::gemm_phase((pg8::lds_u8*)smem, c);
}

DI void ph_gemm_store_bf16(const u16* A, int lda, const u16* Bt, int K, int M, int N, u16* C, int ldc, char* smem, int rot) {
  const int mt = M / 256, nt = N / 128;
  const int nb = gridDim.x;
  for (int t = (obid() + rot) % nb; t < mt * nt; t += nb) {
    const int m0 = (t % mt) * 256, n0 = (t / mt) * 128;
    gemm_tile([&](int r) { return A + (size_t)(m0 + r) * lda; }, Bt + (size_t)n0 * K, K, K, smem,
              [&](f32x4 (&acc)[4][4], int wr, int wc, int fr, int fq) {
#pragma unroll
                for (int m = 0; m < 4; ++m)
#pragma unroll
                  for (int n = 0; n < 4; ++n)
#pragma unroll
                    for (int j = 0; j < 4; ++j) {
                      const int row = m0 + wr * 64 + m * 16 + fq * 4 + j, col = n0 + wc * 64 + n * 16 + fr;
                      C[(size_t)row * ldc + col] = f2bf(acc[m][n][j]);
                    }
              });
  }
}

DI void ph_rmsnorm_bf16(const float* __restrict__ xin, const float* __restrict__ w, u16* __restrict__ outp) {
  const int tid_ = otid(); const int lane = tid_ & 63, gw = (obid() * NTHR + tid_) >> 6, nw = gridDim.x * (NTHR / 64);
  for (int t = gw; t < T; t += nw) {
    const float* xr = xin + (size_t)t * DM;
    float4 v[4];
    float ss = 0.f;
#pragma unroll
    for (int i = 0; i < 4; ++i) {
      v[i] = *reinterpret_cast<const float4*>(xr + (i * 64 + lane) * 4);
      ss += v[i].x * v[i].x + v[i].y * v[i].y + v[i].z * v[i].z + v[i].w * v[i].w;
    }
    ss = wave_sum(ss);
    const float rstd = rsqrtf(ss * (1.f / DM) + 1e-6f);
#pragma unroll
    for (int i = 0; i < 4; ++i) {
      const int c = (i * 64 + lane) * 4;
      const float4 ww = *reinterpret_cast<const float4*>(w + c);
      uint2 o;
      o.x = pack2(v[i].x * rstd * ww.x, v[i].y * rstd * ww.y);
      o.y = pack2(v[i].z * rstd * ww.z, v[i].w * rstd * ww.w);
      *reinterpret_cast<uint2*>(outp + (size_t)t * DM + c) = o;
    }
  }
}

DI void ph_final_norm(const float* __restrict__ xin, const float* __restrict__ w, float* __restrict__ outp) {
  const int tid_ = otid(); const int lane = tid_ & 63, gw = (obid() * NTHR + tid_) >> 6, nw = gridDim.x * (NTHR / 64);
  for (int t = gw; t < T; t += nw) {
    const float* xr = xin + (size_t)t * DM;
    float4 v[4];
    float ss = 0.f;
#pragma unroll
    for (int i = 0; i < 4; ++i) {
      v[i] = *reinterpret_cast<const float4*>(xr + (i * 64 + lane) * 4);
      ss += v[i].x * v[i].x + v[i].y * v[i].y + v[i].z * v[i].z + v[i].w * v[i].w;
    }
    ss = wave_sum(ss);
    const float rstd = rsqrtf(ss * (1.f / DM) + 1e-6f);
#pragma unroll
    for (int i = 0; i < 4; ++i) {
      const int c = (i * 64 + lane) * 4;
      const float4 ww = *reinterpret_cast<const float4*>(w + c);
      float4 o = make_float4(v[i].x * rstd * ww.x, v[i].y * rstd * ww.y, v[i].z * rstd * ww.z, v[i].w * rstd * ww.w);
      *reinterpret_cast<float4*>(outp + (size_t)t * DM + c) = o;
    }
  }
}

DI void rot8(const u16* x1p, const u16* x2p, const float* tab  , float scale, uint4& o1, uint4& o2) {
  float x1[8], x2[8], y1[8], y2[8];
  ld8(x1p, x1); ld8(x2p, x2);
#pragma unroll
  for (int e = 0; e < 8; e += 2) {
    const float4 cs = *reinterpret_cast<const float4*>(tab + e * 2);
    y1[e] = (x1[e] * cs.x - x2[e] * cs.y) * scale;
    y2[e] = (x2[e] * cs.x + x1[e] * cs.y) * scale;
    y1[e + 1] = (x1[e + 1] * cs.z - x2[e + 1] * cs.w) * scale;
    y2[e + 1] = (x2[e + 1] * cs.z + x1[e + 1] * cs.w) * scale;
  }
  o1.x = pack2(y1[0], y1[1]); o1.y = pack2(y1[2], y1[3]); o1.z = pack2(y1[4], y1[5]); o1.w = pack2(y1[6], y1[7]);
  o2.x = pack2(y2[0], y2[1]); o2.y = pack2(y2[2], y2[3]); o2.z = pack2(y2[4], y2[5]); o2.w = pack2(y2[6], y2[7]);
}
DI void ph_post(const Params& p, int L) {
  const int tid = otid();
  const int gt = obid() * NTHR + tid, gs = gridDim.x * NTHR;
  const int lane = tid & 63, gw = gt >> 6, nw = gs >> 6;
  const float* qnw = p.q_norm_w + L * 256;
  const float* kvnw = p.kv_norm_w + L * 128;
  const float* cw = p.conv_w + L * 5 * 768;
  const float* cb = p.conv_b + L * 768;
  const float* dtb = p.dt_bias + L * 8;
  for (int idx = gt; idx < T * 96; idx += gs) {
    const int t = idx / 96, cg = idx - t * 96, s = t & (SEQ - 1);
    float acc[8];
    {
      const float4 b0 = *reinterpret_cast<const float4*>(cb + cg * 8), b1 = *reinterpret_cast<const float4*>(cb + cg * 8 + 4);
      acc[0] = b0.x; acc[1] = b0.y; acc[2] = b0.z; acc[3] = b0.w; acc[4] = b1.x; acc[5] = b1.y; acc[6] = b1.z; acc[7] = b1.w;
    }
#pragma unroll
    for (int w = 0; w < 5; ++w) {
      const int ss = s + w - 2;
      if (ss >= 0 && ss < SEQ) {
        float xv[8];
        ld8(p.proj() + (size_t)(t + w - 2) * PWP + C_XBC + cg * 8, xv);
        const float4 w0 = *reinterpret_cast<const float4*>(cw + w * 768 + cg * 8), w1 = *reinterpret_cast<const float4*>(cw + w * 768 + cg * 8 + 4);
        acc[0] += xv[0] * w0.x; acc[1] += xv[1] * w0.y; acc[2] += xv[2] * w0.z; acc[3] += xv[3] * w0.w;
        acc[4] += xv[4] * w1.x; acc[5] += xv[5] * w1.y; acc[6] += xv[6] * w1.z; acc[7] += xv[7] * w1.w;
      }
    }
    uint4 o;
    o.x = pack2(fast_silu(acc[0]), fast_silu(acc[1])); o.y = pack2(fast_silu(acc[2]), fast_silu(acc[3]));
    o.z = pack2(fast_silu(acc[4]), fast_silu(acc[5])); o.w = pack2(fast_silu(acc[6]), fast_silu(acc[7]));
    *reinterpret_cast<uint4*>(p.xbc() + (size_t)t * 768 + cg * 8) = o;
  }
  for (int idx = gt; idx < T * 8; idx += gs) {
    const int t = idx >> 3, k = idx & 7;
    const float v = bf2f(p.proj()[(size_t)t * PWP + C_DT + k]) + dtb[k];
    p.dtv()[idx] = (v > 20.f) ? v : log1pf(expf(v));
  }
  {
    const int sub = lane >> 4, l16 = lane & 15;
    for (int t = gw * 4 + sub; t < T; t += nw * 4) {
      const u16* pr = p.proj() + (size_t)t * PWP;
      float v[16], u[8];
      ld8(pr + C_CQ + l16 * 16, v); ld8(pr + C_CQ + l16 * 16 + 8, v + 8);
      ld8(pr + C_CKV + l16 * 8, u);
      float ss = 0.f, s2 = 0.f;
#pragma unroll
      for (int i = 0; i < 16; ++i) ss += v[i] * v[i];
#pragma unroll
      for (int i = 0; i < 8; ++i) s2 += u[i] * u[i];
#pragma unroll
      for (int o = 1; o < 16; o <<= 1) { ss += __shfl_xor(ss, o); s2 += __shfl_xor(s2, o); }
      const float rstd = rsqrtf(ss * (1.f / 256.f) + 1e-6f), r2 = rsqrtf(s2 * (1.f / 128.f) + 1e-6f);
      uint4 o;
      const float* qw = qnw + l16 * 16;
      o.x = pack2(v[0] * rstd * qw[0], v[1] * rstd * qw[1]); o.y = pack2(v[2] * rstd * qw[2], v[3] * rstd * qw[3]);
      o.z = pack2(v[4] * rstd * qw[4], v[5] * rstd * qw[5]); o.w = pack2(v[6] * rstd * qw[6], v[7] * rstd * qw[7]);
      *reinterpret_cast<uint4*>(p.cqn() + (size_t)t * 256 + l16 * 16) = o;
      o.x = pack2(v[8] * rstd * qw[8], v[9] * rstd * qw[9]); o.y = pack2(v[10] * rstd * qw[10], v[11] * rstd * qw[11]);
      o.z = pack2(v[12] * rstd * qw[12], v[13] * rstd * qw[13]); o.w = pack2(v[14] * rstd * qw[14], v[15] * rstd * qw[15]);
      *reinterpret_cast<uint4*>(p.cqn() + (size_t)t * 256 + l16 * 16 + 8) = o;
      const float* kw = kvnw + l16 * 8;
      o.x = pack2(u[0] * r2 * kw[0], u[1] * r2 * kw[1]); o.y = pack2(u[2] * r2 * kw[2], u[3] * r2 * kw[3]);
      o.z = pack2(u[4] * r2 * kw[4], u[5] * r2 * kw[5]); o.w = pack2(u[6] * r2 * kw[6], u[7] * r2 * kw[7]);
      *reinterpret_cast<uint4*>(p.ckvn() + (size_t)t * 128 + l16 * 8) = o;
    }
  }
  for (int idx = gt; idx < T * 42; idx += gs) {
    const int t = idx / 42, ri = idx - t * 42, s = t & (SEQ - 1);
    u16* pr = p.proj() + (size_t)t * PWP;
    uint4 o1, o2;
    if (ri < 32) {
      const int isk = ri >> 4, h = (ri >> 2) & 3, i0 = (ri & 3) * 8;
      u16* a = pr + (isk ? C_RK : C_RQ) + h * 64 + i0;
      rot8(a, a + 32, p.rtab() + ((size_t)s * 56 + i0) * 2, isk ? 1.f : 0.125f, o1, o2);
      *reinterpret_cast<uint4*>(a) = o1;
      *reinterpret_cast<uint4*>(a + 32) = o2;
    } else if (ri < 40) {
      const int j = ri - 32, isk = j >> 2, h = j & 3;
      u16* a = pr + (isk ? C_DK : C_DQ) + h * 64;
      rot8(a, a + 8, p.rtab() + ((size_t)s * 56 + 32) * 2, 1.f, o1, o2);
      *reinterpret_cast<uint4*>(a) = o1;
      *reinterpret_cast<uint4*>(a + 8) = o2;
    } else {
      const int i0 = (ri - 40) * 8;
      u16* a = pr + C_KR + i0;
      rot8(a, a + 16, p.rtab() + ((size_t)s * 56 + 40 + i0) * 2, 1.f, o1, o2);
      *reinterpret_cast<uint4*>(a) = o1;
      *reinterpret_cast<uint4*>(a + 16) = o2;
      const int bb = t >> 12;
#pragma unroll
      for (int hd = 0; hd < 4; ++hd) {
        u16* kf = p.kfull() + ((size_t)(bb * 4 + hd) * SEQ + s) * 96 + 64 + i0;
        *reinterpret_cast<uint4*>(kf) = o1;
        *reinterpret_cast<uint4*>(kf + 16) = o2;
      }
    }
  }
}

DI void ph_mla_up_q(const Params& p, int L, char* smem, int t) {
  const int mt = T / 256;
  const u16* Bq = p.WuqT() + (size_t)L * 384 * 256;
  {
    const int m0 = (t % mt) * 256, n0 = (t / mt) * 128;
    gemm_tile([&](int r) { return p.cqn() + (size_t)(m0 + r) * 256; }, Bq + (size_t)n0 * 256, 256, 256, smem,
              [&](f32x4 (&acc)[4][4], int wr, int wc, int fr, int fq) {
                const float scale = 0.10206207261596575f * 1.4426950408889634f;
#pragma unroll
                for (int m = 0; m < 4; ++m)
#pragma unroll
                  for (int j = 0; j < 4; ++j) {
                    const int row = m0 + wr * 64 + m * 16 + fq * 4 + j;
                    const float2 cssn = *reinterpret_cast<const float2*>(p.rtab() + ((size_t)(row & (SEQ - 1)) * 56 + 40 + fr) * 2);
                    const float cs = cssn.x, sn = cssn.y;
#pragma unroll
                    for (int n2 = 0; n2 < 4; n2 += 2) {
                      const int cb = n0 + wc * 64 + n2 * 16;
                      float x1 = acc[m][n2][j], x2 = acc[m][n2 + 1][j];
                      if (cb % 96 == 64) {
                        const float y1 = x1 * cs - x2 * sn, y2 = x2 * cs + x1 * sn;
                        x1 = y1; x2 = y2;
                      }
                      p.mq()[(size_t)row * 384 + cb + fr] = f2bf(x1 * scale);
                      p.mq()[(size_t)row * 384 + cb + 16 + fr] = f2bf(x2 * scale);
                    }
                  }
              });
  }
}
DI void ph_mla_up_kv(const Params& p, int L, char* smem, int t) {
  const int mt = T / 256;
  const u16* Bkv = p.WukvT() + (size_t)L * 512 * 128;
  {
    const int m0 = (t % mt) * 256, h = t / mt, n0 = h * 128;
    gemm_tile([&](int r) { return p.ckvn() + (size_t)(m0 + r) * 128; }, Bkv + (size_t)n0 * 128, 128, 128, smem,
              [&](f32x4 (&acc)[4][4], int wr, int wc, int fr, int fq) {
#pragma unroll
                for (int m = 0; m < 4; ++m) {
                  const int row = m0 + wr * 64 + m * 16 + fq * 4;
                  const int bb = row >> 12, sq = row & (SEQ - 1);
                  const size_t bh = (size_t)(bb * 4 + h);
#pragma unroll
                  for (int n = 0; n < 4; ++n) {
                    if (wc == 0) {
#pragma unroll
                      for (int j = 0; j < 4; ++j) p.kfull()[(bh * SEQ + sq + j) * 96 + n * 16 + fr] = f2bf(acc[m][n][j]);
                    } else {
                      uint2 v;
                      v.x = pack2(acc[m][n][0], acc[m][n][1]);
                      v.y = pack2(acc[m][n][2], acc[m][n][3]);
                      const int sqp = (sq & ~12) | ((sq & 4) << 1) | ((sq & 8) >> 1);
                      *reinterpret_cast<uint2*>(p.vT() + (bh * 64 + n * 16 + fr) * SEQ + sqp) = v;
                    }
                  }
                }
              });
  }
}

DI void ph_cumsum(const Params& p, int L) {
  const int tid_ = otid(); const int lane = tid_ & 63, gw = (obid() * NTHR + tid_) >> 6, nw = gridDim.x * (NTHR / 64);
  for (int it = gw; it < 32; it += nw) {
    const int h = it & 3, dir = (it >> 2) & 1, b = it >> 3;
    const float a = -expf(p.a_log[L * 8 + dir * 4 + h]);
    float running = 0.f;
    for (int c = 0; c < 64; ++c) {
      const int i = c * 64 + lane;
      const int s = dir ? (SEQ - 1 - i) : i;
      const size_t off = (size_t)(b * SEQ + s) * 8 + dir * 4 + h;
      float v = p.dtv()[off] * a;
#pragma unroll
      for (int o = 1; o < 64; o <<= 1) {
        const float u = __shfl_up(v, o);
        if (lane >= o) v += u;
      }
      v += running;
      p.cs()[off] = v;
      running = __shfl(v, 63);
    }
  }
}

DI void ph_ret_naive(const Params& p) {
  const int gt = obid() * NTHR + otid(), gs = gridDim.x * NTHR;
  for (int it = gt; it < 4 * 4 * SEQ; it += gs) {
    const int n = it & (SEQ - 1), h = (it >> 12) & 3, b = it >> 14;
    const u16* base = p.proj() + (size_t)(b * SEQ) * PWP;
    uint4 qp[8];
    float o[64];
#pragma unroll
    for (int d = 0; d < 8; ++d) qp[d] = *reinterpret_cast<const uint4*>(base + (size_t)n * PWP + C_RQ + h * 64 + d * 8);
#pragma unroll
    for (int d = 0; d < 64; ++d) o[d] = 0.f;
    const float lg0 = log1pf(-exp2f(-5.f - (float)h)), lg1 = log1pf(-exp2f(-5.5f - (float)h));
#pragma unroll 1
    for (int m = 0; m < SEQ; ++m) {
      const u16* kr = base + (size_t)m * PWP + C_RK + h * 64;
      const u16* vr = base + (size_t)m * PWP + C_RV + h * 64;
      float s = 0.f;
#pragma unroll
      for (int d = 0; d < 8; ++d) s = dot8(qp[d], *reinterpret_cast<const uint4*>(kr + d * 8), s);
      const float w = (m <= n) ? expf(lg0 * (float)(n - m)) : expf(lg1 * (float)(m - n));
      s *= w;
#pragma unroll
      for (int d = 0; d < 64; d += 8) {
        float vf[8];
        ld8(vr + d, vf);
#pragma unroll
        for (int j = 0; j < 8; ++j) o[d + j] += s * vf[j];
      }
    }
    float mu = 0.f;
#pragma unroll
    for (int d = 0; d < 64; ++d) mu += o[d];
    mu *= (1.f / 64.f);
    float var = 0.f;
#pragma unroll
    for (int d = 0; d < 64; ++d) var += (o[d] - mu) * (o[d] - mu);
    var *= (1.f / 64.f);
    const float rs = rsqrtf(var + 1e-5f);
    const size_t t = (size_t)b * SEQ + n;
#pragma unroll
    for (int d = 0; d < 64; d += 8) {
      float g[8];
      ld8(p.proj() + t * PWP + C_RG + h * 64 + d, g);
      uint4 ov;
      ov.x = pack2(silu(g[0]) * (o[d + 0] - mu) * rs, silu(g[1]) * (o[d + 1] - mu) * rs);
      ov.y = pack2(silu(g[2]) * (o[d + 2] - mu) * rs, silu(g[3]) * (o[d + 3] - mu) * rs);
      ov.z = pack2(silu(g[4]) * (o[d + 4] - mu) * rs, silu(g[5]) * (o[d + 5] - mu) * rs);
      ov.w = pack2(silu(g[6]) * (o[d + 6] - mu) * rs, silu(g[7]) * (o[d + 7] - mu) * rs);
      *reinterpret_cast<uint4*>(p.mixed() + t * DM + h * 64 + d) = ov;
    }
  }
}

DI void ph_mla_naive(const Params& p) {
  const int gt = obid() * NTHR + otid(), gs = gridDim.x * NTHR;
  for (int it = gt; it < 2 * 4 * 4 * SEQ; it += gs) {
    const int n = it & (SEQ - 1), vh = (it >> 12) & 1, h = (it >> 13) & 3, b = it >> 15;
    const size_t t = (size_t)b * SEQ + n;
    uint4 qp[12];
    float o[32];
#pragma unroll
    for (int d = 0; d < 12; ++d) qp[d] = *reinterpret_cast<const uint4*>(p.mq() + t * 384 + h * 96 + d * 8);
    const size_t tb = (size_t)b * SEQ;
    float mx = -1e30f;
#pragma unroll 1
    for (int m = 0; m < SEQ; ++m) {
      const u16* kn = ((u16*)nullptr) + (tb + m) * 512 + h * 128;
      const u16* kr = p.proj() + (tb + m) * PWP + C_KR;
      float s = 0.f;
#pragma unroll
      for (int d = 0; d < 8; ++d) s = dot8(qp[d], *reinterpret_cast<const uint4*>(kn + d * 8), s);
#pragma unroll
      for (int d = 0; d < 4; ++d) s = dot8(qp[8 + d], *reinterpret_cast<const uint4*>(kr + d * 8), s);
      mx = fmaxf(mx, s);
    }
#pragma unroll
    for (int d = 0; d < 32; ++d) o[d] = 0.f;
    float l = 0.f;
#pragma unroll 1
    for (int m = 0; m < SEQ; ++m) {
      const u16* kn = ((u16*)nullptr) + (tb + m) * 512 + h * 128;
      const u16* kr = p.proj() + (tb + m) * PWP + C_KR;
      float s = 0.f;
#pragma unroll
      for (int d = 0; d < 8; ++d) s = dot8(qp[d], *reinterpret_cast<const uint4*>(kn + d * 8), s);
#pragma unroll
      for (int d = 0; d < 4; ++d) s = dot8(qp[8 + d], *reinterpret_cast<const uint4*>(kr + d * 8), s);
      const float pe = exp2f(s - mx);
      l += pe;
#pragma unroll
      for (int d = 0; d < 32; d += 8) {
        float vf[8];
        ld8(kn + 64 + vh * 32 + d, vf);
#pragma unroll
        for (int j = 0; j < 8; ++j) o[d + j] += pe * vf[j];
      }
    }
    const float il = 1.f / l;
#pragma unroll
    for (int d = 0; d < 32; d += 8) {
      uint4 ov;
      ov.x = pack2(o[d + 0] * il, o[d + 1] * il);
      ov.y = pack2(o[d + 2] * il, o[d + 3] * il);
      ov.z = pack2(o[d + 4] * il, o[d + 5] * il);
      ov.w = pack2(o[d + 6] * il, o[d + 7] * il);
      *reinterpret_cast<uint4*>(p.mixed() + t * DM + 256 + h * 64 + vh * 32 + d) = ov;
    }
  }
}

#define MFMA32(a, b, c) __builtin_amdgcn_mfma_f32_32x32x16_bf16((a), (b), (c), 0, 0, 0)
DI float max16(const f32x16& v) {
  float a = fmaxf(fmaxf(v[0], v[1]), v[2]), b = fmaxf(fmaxf(v[3], v[4]), v[5]), c = fmaxf(fmaxf(v[6], v[7]), v[8]);
  float d = fmaxf(fmaxf(v[9], v[10]), v[11]), e = fmaxf(fmaxf(v[12], v[13]), v[14]);
  return fmaxf(fmaxf(fmaxf(a, b), fmaxf(c, d)), fmaxf(e, v[15]));
}
DI void ph_mla_attn(const Params& p, char* smem) {
  const int tid = otid(), wid = tid >> 6, lane = tid & 63, l32 = lane & 31, hh = lane >> 5;
  u16* sK = reinterpret_cast<u16*>(smem);
  u16* sV = sK + 2 * 128 * 104;
  uint4 konev = make_uint4(hh == 0 ? 0x00003F80u : 0u, 0u, 0u, 0u);
  const bf16x8 kone = __builtin_bit_cast(bf16x8, konev);
  for (int item = obid(); item < 256; item += gridDim.x) {
    const int xcd_ = item & 7, jx_ = item >> 3, bh = xcd_ * 2 + (jx_ >> 4), qt = jx_ & 15, b = bh >> 2, h = bh & 3;
    const size_t t0 = (size_t)b * SEQ + qt * 256 + wid * 32;
    bf16x8 qf[6];
#pragma unroll
    for (int ks = 0; ks < 6; ++ks) qf[ks] = *reinterpret_cast<const bf16x8*>(p.mq() + (t0 + l32) * 384 + h * 96 + ks * 16 + hh * 8);
    const u16* kg = p.kfull() + (size_t)bh * SEQ * 96;
    const u16* vg = p.vT() + (size_t)bh * 64 * SEQ;
    f32x16 o0, o1;
#pragma unroll
    for (int i = 0; i < 16; ++i) { o0[i] = 0.f; o1[i] = 0.f; }
    float m = 0.f, l = 0.f;
    bf16x8 qf6 = __builtin_bit_cast(bf16x8, make_uint4(0u, 0u, 0u, 0u));
    const int kr0 = tid / 12, kc0 = tid % 12, kr1 = (512 + tid) / 12, kc1 = (512 + tid) % 12, kr2 = (1024 + tid) / 12, kc2 = (1024 + tid) % 12;
    const int vd0 = tid >> 4, vd1 = 32 + (tid >> 4), vkc = (tid & 15) * 8;
    uint4 ak0, ak1, ak2, av0, av1;
#define MLA_LD(dst_, ptr_) asm volatile("global_load_dwordx4 %0, %1, off" : "=v"(dst_) : "v"(ptr_) : "memory")
#define MLA_GLOAD(K0, K1, K2, V0, V1, kt_)                                               \
    {                                                                                    \
      const u16* kb_ = kg + (size_t)(kt_) * 128 * 96 + tid * 8;                          \
      MLA_LD(K0, kb_); MLA_LD(K1, kb_ + 512 * 8); MLA_LD(K2, kb_ + 1024 * 8);            \
      const u16* vp_ = vg + (size_t)vd0 * SEQ + (kt_) * 128 + vkc;                       \
      MLA_LD(V0, vp_); MLA_LD(V1, vp_ + (size_t)32 * SEQ);                               \
    }
#define MLA_SSTORE(K0, K1, K2, V0, V1, buf_)                                             \
    {                                                                                    \
      u16* kb_ = sK + (buf_) * 128 * 104;                                                \
      u16* vb_ = sV + (buf_) * 64 * 136;                                                 \
      *reinterpret_cast<uint4*>(kb_ + kr0 * 104 + kc0 * 8) = K0;                         \
      *reinterpret_cast<uint4*>(kb_ + kr1 * 104 + kc1 * 8) = K1;                         \
      *reinterpret_cast<uint4*>(kb_ + kr2 * 104 + kc2 * 8) = K2;                         \
      *reinterpret_cast<uint4*>(vb_ + vd0 * 136 + vkc) = V0;                             \
      *reinterpret_cast<uint4*>(vb_ + vd1 * 136 + vkc) = V1;                             \
    }
    float mxrun = 0.f;
#define SGB(mask, n) __builtin_amdgcn_sched_group_barrier((mask), (n), 0)
#define MLA_KFRAG(kb_, sub_, ks_) (*reinterpret_cast<const bf16x8*>((kb_) + ((sub_) * 32 + l32) * 104 + (ks_) * 16 + hh * 8))
#define MLA_VFRAG(dst_, vb_, sub_, ks2_, dvt_) \
    dst_ = *reinterpret_cast<const bf16x8*>((vb_) + ((dvt_) * 32 + l32) * 136 + (sub_) * 32 + (ks2_) * 16 + hh * 8)
#define MLA_SOFTMAX(sc_, pa_, pb_)                                                                         \
    {                                                                                                      \
      mxrun = fmaxf(mxrun, max16(sc_));                                                                    \
      float ps0_ = 0.f, ps1_ = 0.f;                                                                        \
      _Pragma("unroll") for (int i = 0; i < 16; i += 2) {                                                  \
        sc_[i] = __builtin_amdgcn_exp2f(sc_[i]); sc_[i + 1] = __builtin_amdgcn_exp2f(sc_[i + 1]);          \
        ps0_ += sc_[i]; ps1_ += sc_[i + 1];                                                                \
      }                                                                                                    \
      l += ps0_ + ps1_;                                                                                    \
      uint4 pk_;                                                                                           \
      pk_.x = pack2(sc_[0], sc_[1]); pk_.y = pack2(sc_[2], sc_[3]); pk_.z = pack2(sc_[4], sc_[5]); pk_.w = pack2(sc_[6], sc_[7]); \
      pa_ = __builtin_bit_cast(bf16x8, pk_);                                                               \
      pk_.x = pack2(sc_[8], sc_[9]); pk_.y = pack2(sc_[10], sc_[11]); pk_.z = pack2(sc_[12], sc_[13]); pk_.w = pack2(sc_[14], sc_[15]); \
      pb_ = __builtin_bit_cast(bf16x8, pk_);                                                               \
    }
    auto compute_tile = [&](int cur, int half) {
      const u16* kb = sK + cur * 128 * 104 + half * 64 * 104;
      const u16* vb = sV + cur * 64 * 136 + half * 64;
      bf16x8 k0[6], k1[6];
#pragma unroll
      for (int ks = 0; ks < 6; ++ks) { k0[ks] = MLA_KFRAG(kb, 0, ks); k1[ks] = MLA_KFRAG(kb, 1, ks); }
      f32x16 s0, s1;
#pragma unroll
      for (int i = 0; i < 16; ++i) { s0[i] = 0.f; s1[i] = 0.f; }
#pragma unroll
      for (int ks = 0; ks < 6; ++ks) s0 = MFMA32(k0[ks], qf[ks], s0);
      s0 = MFMA32(kone, qf6, s0);
      bf16x8 v00, v01, v02, v03, v10, v11, v12, v13;
      MLA_VFRAG(v00, vb, 0, 0, 0); MLA_VFRAG(v01, vb, 0, 0, 1); MLA_VFRAG(v02, vb, 0, 1, 0); MLA_VFRAG(v03, vb, 0, 1, 1);
#pragma unroll
      for (int ks = 0; ks < 6; ++ks) s1 = MFMA32(k1[ks], qf[ks], s1);
      s1 = MFMA32(kone, qf6, s1);
      MLA_VFRAG(v10, vb, 1, 0, 0); MLA_VFRAG(v11, vb, 1, 0, 1); MLA_VFRAG(v12, vb, 1, 1, 0); MLA_VFRAG(v13, vb, 1, 1, 1);
      bf16x8 p0a, p0b, p1a, p1b;
      MLA_SOFTMAX(s0, p0a, p0b);
      o0 = MFMA32(v00, p0a, o0); o1 = MFMA32(v01, p0a, o1); o0 = MFMA32(v02, p0b, o0); o1 = MFMA32(v03, p0b, o1);
      MLA_SOFTMAX(s1, p1a, p1b);
      o0 = MFMA32(v10, p1a, o0); o1 = MFMA32(v11, p1a, o1); o0 = MFMA32(v12, p1b, o0); o1 = MFMA32(v13, p1b, o1);
      SGB(0x100, 12);
#pragma unroll
      for (int i = 0; i < 7; ++i) { SGB(0x008, 1); if (i < 4) SGB(0x100, 1); }
#pragma unroll
      for (int i = 0; i < 7; ++i) { SGB(0x008, 1); if (i < 4) SGB(0x100, 1); SGB(0x402, 7); }
#pragma unroll
      for (int i = 0; i < 4; ++i) { SGB(0x008, 1); SGB(0x402, 12); }
#pragma unroll
      for (int i = 0; i < 4; ++i) SGB(0x008, 1);
    };
    auto lazy_update = [&]() {
      const float mxr = fmaxf(mxrun, __shfl_xor(mxrun, 32));
      if (__builtin_amdgcn_ballot_w64(mxr > 8.f) != 0ull) {
        float d = (mxr > 8.f) ? mxr : 0.f;
        const float mnew = bf2f(f2bf(m + d));
        d = mnew - m;
        m = mnew;
        const float alpha = __builtin_amdgcn_exp2f(-d);
        l *= alpha;
        mxrun -= d;
#pragma unroll
        for (int i = 0; i < 16; ++i) { o0[i] *= alpha; o1[i] *= alpha; }
        uint4 qv = make_uint4(0u, 0u, 0u, 0u);
        if (hh == 0) qv.x = (unsigned)f2bf(-m);
        qf6 = __builtin_bit_cast(bf16x8, qv);
      }
    };
    MLA_GLOAD(ak0, ak1, ak2, av0, av1, 0);
    asm volatile("s_waitcnt vmcnt(0)" ::: "memory");
    MLA_SSTORE(ak0, ak1, ak2, av0, av1, 0);
    __syncthreads();
    {
      f32x16 s0, s1;
#pragma unroll
      for (int i = 0; i < 16; ++i) { s0[i] = 0.f; s1[i] = 0.f; }
#pragma unroll
      for (int ks = 0; ks < 6; ++ks) { s0 = MFMA32(MLA_KFRAG(sK, 0, ks), qf[ks], s0); s1 = MFMA32(MLA_KFRAG(sK, 1, ks), qf[ks], s1); }
      float mx = fmaxf(max16(s0), max16(s1));
      mx = fmaxf(mx, __shfl_xor(mx, 32));
      m = bf2f(f2bf(mx));
      uint4 qv = make_uint4(0u, 0u, 0u, 0u);
      if (hh == 0) qv.x = (unsigned)f2bf(-m);
      qf6 = __builtin_bit_cast(bf16x8, qv);
    }
#pragma unroll 1
    for (int kt = 0; kt < 32; kt += 2) {
      MLA_GLOAD(ak0, ak1, ak2, av0, av1, kt + 1);
#pragma unroll 1
      for (int half = 0; half < 2; ++half) compute_tile(0, half);
      asm volatile("s_waitcnt vmcnt(0)" ::: "memory");
      MLA_SSTORE(ak0, ak1, ak2, av0, av1, 1);
      __syncthreads();
      lazy_update();
      if (kt + 2 < 32) MLA_GLOAD(ak0, ak1, ak2, av0, av1, kt + 2);
#pragma unroll 1
      for (int half = 0; half < 2; ++half) compute_tile(1, half);
      if (kt + 2 < 32) {
        asm volatile("s_waitcnt vmcnt(0)" ::: "memory");
        MLA_SSTORE(ak0, ak1, ak2, av0, av1, 0);
      }
      __syncthreads();
      lazy_update();
    }
    l += __shfl_xor(l, 32);
    const float il = 1.f / l;
    u16* orow = p.mixed() + (t0 + l32) * DM + 256 + h * 64 + hh * 4;
#pragma unroll
    for (int g = 0; g < 4; ++g) {
      uint2 v;
      v.x = pack2(o0[4 * g + 0] * il, o0[4 * g + 1] * il);
      v.y = pack2(o0[4 * g + 2] * il, o0[4 * g + 3] * il);
      *reinterpret_cast<uint2*>(orow + g * 8) = v;
      v.x = pack2(o1[4 * g + 0] * il, o1[4 * g + 1] * il);
      v.y = pack2(o1[4 * g + 2] * il, o1[4 * g + 3] * il);
      *reinterpret_cast<uint2*>(orow + 32 + g * 8) = v;
    }
  }
}

typedef __attribute__((address_space(3))) s16x4 lds_s16x4;
template <int MODE>
DI void ph_dil_pass(const Params& p, char* smem, int blk_) {
  const int tid = otid(), wid = tid >> 6, lane = tid & 63, l32 = lane & 31, hh = lane >> 5;
  u16* sV = reinterpret_cast<u16*>(smem) + wid * (2 * 32 * 72);
  const int i16 = lane & 15, tq = i16 >> 2, tp = i16 & 3, tblk = (lane >> 4) & 1;
  {
    constexpr int NT = (MODE == 0) ? 13 : 5;
    const int it = wid, xcd_ = blk_ & 7, jx_ = blk_ >> 3, bh = xcd_ * 2 + (jx_ >> 4), r = jx_ & 15, b = bh >> 2, h = bh & 3;
    const int i0 = it * 32;
    const int q0 = (r * 8 + it) * 32;
    const int qpos = (MODE == 0) ? (r + 16 * (i0 + l32)) : (q0 + l32);
    const size_t tb = (size_t)b * SEQ;
    const u16* kbase = p.proj() + tb * PWP + C_DK + h * 64;
    const u16* vbase = p.proj() + tb * PWP + C_DV + h * 64;
    bf16x8 qf[4];
    {
      const u16* qp = p.proj() + (tb + qpos) * PWP + C_DQ + h * 64 + hh * 8;
#pragma unroll
      for (int ks = 0; ks < 4; ++ks) qf[ks] = *reinterpret_cast<const bf16x8*>(qp + ks * 16);
    }
    f32x16 o0, o1;
#pragma unroll
    for (int i = 0; i < 16; ++i) { o0[i] = 0.f; o1[i] = 0.f; }
    float m = -1e30f, l = 0.f;
    auto tile_params = [&](int tt, int& d, int& rd, int& ub, int& ulim, int& qb, int& qs) {
      if (MODE == 0) {
        if (tt < 5) { d = 16; rd = r; qb = i0; qs = 1; ulim = 256; ub = qb - 64 + 32 * tt; }
        else { d = 4; rd = r & 3; qb = (r >> 2) + 4 * i0; qs = 4; ulim = 1024; ub = qb - 64 + 32 * (tt - 5); }
      } else { d = 1; rd = 0; qb = q0; qs = 1; ulim = 4096; ub = qb - 64 + 32 * tt; }
    };
    bf16x8 ka0, ka1, ka2, ka3, kb0, kb1, kb2, kb3;
    uint4 va0, va1, va2, va3, vb0, vb1, vb2, vb3;
#define DIL_LD(dst_, ptr_) asm volatile("global_load_dwordx4 %0, %1, off" : "=v"(dst_) : "v"(ptr_) : "memory")
#define DIL_GLOAD(K0, K1, K2, K3, V0, V1, V2, V3, tt_)                                                   \
    {                                                                                                    \
      int d_, rd_, ub_, ulim_, qb_, qs_;                                                                 \
      tile_params((tt_), d_, rd_, ub_, ulim_, qb_, qs_);                                                 \
      int u_ = min(max(ub_ + l32, 0), ulim_ - 1);                                                        \
      const u16* kp_ = kbase + (size_t)(rd_ + d_ * u_) * PWP + hh * 8;                                   \
      DIL_LD(K0, kp_); DIL_LD(K1, kp_ + 16); DIL_LD(K2, kp_ + 32); DIL_LD(K3, kp_ + 48);                 \
      const int kr_ = ub_ + (lane >> 3);                                                                 \
      const u16* vp_;                                                                                    \
      u_ = min(max(kr_, 0), ulim_ - 1);      vp_ = vbase + (size_t)(rd_ + d_ * u_) * PWP + (lane & 7) * 8; DIL_LD(V0, vp_); \
      u_ = min(max(kr_ + 8, 0), ulim_ - 1);  vp_ = vbase + (size_t)(rd_ + d_ * u_) * PWP + (lane & 7) * 8; DIL_LD(V1, vp_); \
      u_ = min(max(kr_ + 16, 0), ulim_ - 1); vp_ = vbase + (size_t)(rd_ + d_ * u_) * PWP + (lane & 7) * 8; DIL_LD(V2, vp_); \
      u_ = min(max(kr_ + 24, 0), ulim_ - 1); vp_ = vbase + (size_t)(rd_ + d_ * u_) * PWP + (lane & 7) * 8; DIL_LD(V3, vp_); \
    }
#define DIL_VSTORE(V0, V1, V2, V3, buf_)                                                                 \
    {                                                                                                    \
      u16* vb_ = sV + (buf_) * 32 * 72 + (lane >> 3) * 72 + (lane & 7) * 8;                              \
      *reinterpret_cast<uint4*>(vb_) = V0;                                                               \
      *reinterpret_cast<uint4*>(vb_ + 8 * 72) = V1;                                                      \
      *reinterpret_cast<uint4*>(vb_ + 16 * 72) = V2;                                                     \
      *reinterpret_cast<uint4*>(vb_ + 24 * 72) = V3;                                                     \
    }
    auto tile_rest = [&](int tt, f32x16 sc, int cur) {
      int d, rd, ub, ulim, qb, qs;
      tile_params(tt, d, rd, ub, ulim, qb, qs);
      const int uq = qb + qs * l32;
      const float cs = 0.125f * 1.4426950408889634f;
      float mx = -1e30f;
#pragma unroll
      for (int i = 0; i < 16; ++i) {
        const int u = ub + (i & 3) + 8 * (i >> 2) + 4 * hh;
        const int du = u - uq;
        const bool valid = (u >= 0) && (u < ulim) && (du <= 64) && (du >= -64);
        sc[i] = valid ? sc[i] * cs : -1e30f;
        mx = fmaxf(mx, sc[i]);
      }
      mx = fmaxf(mx, __shfl_xor(mx, 32));
      const float mn = fmaxf(m, mx);
      const float alpha = __builtin_amdgcn_exp2f(m - mn);
      m = mn;
      float ps = 0.f;
#pragma unroll
      for (int i = 0; i < 16; ++i) {
        float pe = __builtin_amdgcn_exp2f(sc[i] - mn);
        pe = (sc[i] > -1e29f) ? pe : 0.f;
        ps += pe;
        sc[i] = pe;
      }
      l = l * alpha + ps;
#pragma unroll
      for (int i = 0; i < 16; ++i) { o0[i] *= alpha; o1[i] *= alpha; }
      const u16* vb = sV + cur * 32 * 72;
#pragma unroll
      for (int ks2 = 0; ks2 < 2; ++ks2) {
        uint4 pk;
        pk.x = pack2(sc[8 * ks2 + 0], sc[8 * ks2 + 1]);
        pk.y = pack2(sc[8 * ks2 + 2], sc[8 * ks2 + 3]);
        pk.z = pack2(sc[8 * ks2 + 4], sc[8 * ks2 + 5]);
        pk.w = pack2(sc[8 * ks2 + 6], sc[8 * ks2 + 7]);
        const bf16x8 pb = __builtin_bit_cast(bf16x8, pk);
#pragma unroll
        for (int dvt = 0; dvt < 2; ++dvt) {
          const u16* a0 = vb + (16 * ks2 + 4 * hh + tq) * 72 + dvt * 32 + tblk * 16 + tp * 4;
          const s16x4 lo = __builtin_amdgcn_ds_read_tr16_b64_v4i16((lds_s16x4*)(a0));
          const s16x4 hi = __builtin_amdgcn_ds_read_tr16_b64_v4i16((lds_s16x4*)(a0 + 8 * 72));
          const bf16x8 a = __builtin_shufflevector(lo, hi, 0, 1, 2, 3, 4, 5, 6, 7);
          if (dvt == 0) o0 = MFMA32(a, pb, o0); else o1 = MFMA32(a, pb, o1);
        }
      }
    };
    DIL_GLOAD(ka0, ka1, ka2, ka3, va0, va1, va2, va3, 0);
    DIL_GLOAD(kb0, kb1, kb2, kb3, vb0, vb1, vb2, vb3, 1);
    asm volatile("s_waitcnt vmcnt(8)" ::: "memory");
    DIL_VSTORE(va0, va1, va2, va3, 0);
#pragma unroll 1
    for (int tt = 0; tt < NT; tt += 2) {
      {
        f32x16 sc;
#pragma unroll
        for (int i = 0; i < 16; ++i) sc[i] = 0.f;
        sc = MFMA32(ka0, qf[0], sc); sc = MFMA32(ka1, qf[1], sc); sc = MFMA32(ka2, qf[2], sc); sc = MFMA32(ka3, qf[3], sc);
        asm volatile("" :: "v"(sc));
        if (tt + 2 < NT) DIL_GLOAD(ka0, ka1, ka2, ka3, va0, va1, va2, va3, tt + 2);
        tile_rest(tt, sc, 0);
        if (tt + 1 < NT) {
          if (tt + 2 < NT) asm volatile("s_waitcnt vmcnt(8)" ::: "memory"); else asm volatile("s_waitcnt vmcnt(0)" ::: "memory");
          DIL_VSTORE(vb0, vb1, vb2, vb3, 1);
        }
      }
      if (tt + 1 < NT) {
        f32x16 sc;
#pragma unroll
        for (int i = 0; i < 16; ++i) sc[i] = 0.f;
        sc = MFMA32(kb0, qf[0], sc); sc = MFMA32(kb1, qf[1], sc); sc = MFMA32(kb2, qf[2], sc); sc = MFMA32(kb3, qf[3], sc);
        asm volatile("" :: "v"(sc));
        if (tt + 3 < NT) DIL_GLOAD(kb0, kb1, kb2, kb3, vb0, vb1, vb2, vb3, tt + 3);
        tile_rest(tt + 1, sc, 1);
        if (tt + 2 < NT) {
          if (tt + 3 < NT) asm volatile("s_waitcnt vmcnt(8)" ::: "memory"); else asm volatile("s_waitcnt vmcnt(0)" ::: "memory");
          DIL_VSTORE(va0, va1, va2, va3, 0);
        }
      }
    }
    l += __shfl_xor(l, 32);
    float* part = p.dpart() + ((tb + qpos) * 4 + h) * 68 + hh * 4;
    if (MODE == 0) {
#pragma unroll
      for (int g = 0; g < 4; ++g) {
        *reinterpret_cast<float4*>(part + g * 8) = make_float4(o0[4 * g + 0], o0[4 * g + 1], o0[4 * g + 2], o0[4 * g + 3]);
        *reinterpret_cast<float4*>(part + 32 + g * 8) = make_float4(o1[4 * g + 0], o1[4 * g + 1], o1[4 * g + 2], o1[4 * g + 3]);
      }
      if (hh == 0) { part[64] = m; part[65] = l; }
    } else {
      const float mA = part[64 - hh * 4], lA = part[65 - hh * 4];
      const float M = fmaxf(m, mA), sa = __builtin_amdgcn_exp2f(m - M), sb = __builtin_amdgcn_exp2f(mA - M);
      const float il = 1.f / (l * sa + lA * sb);
      u16* orow = p.mixed() + (tb + qpos) * DM + 768 + h * 64 + hh * 4;
#pragma unroll
      for (int g = 0; g < 4; ++g) {
        const float4 a0 = *reinterpret_cast<const float4*>(part + g * 8), a1 = *reinterpret_cast<const float4*>(part + 32 + g * 8);
        uint2 v;
        v.x = pack2((o0[4 * g + 0] * sa + a0.x * sb) * il, (o0[4 * g + 1] * sa + a0.y * sb) * il);
        v.y = pack2((o0[4 * g + 2] * sa + a0.z * sb) * il, (o0[4 * g + 3] * sa + a0.w * sb) * il);
        *reinterpret_cast<uint2*>(orow + g * 8) = v;
        v.x = pack2((o1[4 * g + 0] * sa + a1.x * sb) * il, (o1[4 * g + 1] * sa + a1.y * sb) * il);
        v.y = pack2((o1[4 * g + 2] * sa + a1.z * sb) * il, (o1[4 * g + 3] * sa + a1.w * sb) * il);
        *reinterpret_cast<uint2*>(orow + 32 + g * 8) = v;
      }
    }
  }
}

DI void ph_dil_naive(const Params& p) {
  const int gt = obid() * NTHR + otid(), gs = gridDim.x * NTHR;
  for (int it = gt; it < 4 * 4 * SEQ; it += gs) {
    const int n = it & (SEQ - 1), h = (it >> 12) & 3, b = it >> 14;
    const size_t tb = (size_t)b * SEQ;
    uint4 qp[8];
    float o[64];
#pragma unroll
    for (int d = 0; d < 8; ++d) qp[d] = *reinterpret_cast<const uint4*>(p.proj() + (tb + n) * PWP + C_DQ + h * 64 + d * 8);
    float mx = -1e30f;
    for (int pat = 0; pat < 3; ++pat) {
      const int dil = (pat == 0) ? 1 : (pat == 1 ? 4 : 16);
#pragma unroll 1
      for (int j = -64; j <= 64; ++j) {
        const int pos = n + j * dil;
        if (pos < 0 || pos >= SEQ) continue;
        const u16* kr = p.proj() + (tb + pos) * PWP + C_DK + h * 64;
        float s = 0.f;
#pragma unroll
        for (int d = 0; d < 8; ++d) s = dot8(qp[d], *reinterpret_cast<const uint4*>(kr + d * 8), s);
        s *= 0.125f;
        mx = fmaxf(mx, s);
      }
    }
#pragma unroll
    for (int d = 0; d < 64; ++d) o[d] = 0.f;
    float l = 0.f;
    for (int pat = 0; pat < 3; ++pat) {
      const int dil = (pat == 0) ? 1 : (pat == 1 ? 4 : 16);
#pragma unroll 1
      for (int j = -64; j <= 64; ++j) {
        const int pos = n + j * dil;
        if (pos < 0 || pos >= SEQ) continue;
        const u16* kr = p.proj() + (tb + pos) * PWP + C_DK + h * 64;
        const u16* vr = p.proj() + (tb + pos) * PWP + C_DV + h * 64;
        float s = 0.f;
#pragma unroll
        for (int d = 0; d < 8; ++d) s = dot8(qp[d], *reinterpret_cast<const uint4*>(kr + d * 8), s);
        s *= 0.125f;
        const float pe = __expf(s - mx);
        l += pe;
#pragma unroll
        for (int d = 0; d < 64; d += 8) {
          float vf[8];
          ld8(vr + d, vf);
#pragma unroll
          for (int jj = 0; jj < 8; ++jj) o[d + jj] += pe * vf[jj];
        }
      }
    }
    const float il = 1.f / l;
#pragma unroll
    for (int d = 0; d < 64; d += 8) {
      uint4 ov;
      ov.x = pack2(o[d + 0] * il, o[d + 1] * il);
      ov.y = pack2(o[d + 2] * il, o[d + 3] * il);
      ov.z = pack2(o[d + 4] * il, o[d + 5] * il);
      ov.w = pack2(o[d + 6] * il, o[d + 7] * il);
      *reinterpret_cast<uint4*>(p.mixed() + (tb + n) * DM + 768 + h * 64 + d) = ov;
    }
  }
}

DI void ph_ssd_naive(const Params& p, int L) {
  const int gt = obid() * NTHR + otid(), gs = gridDim.x * NTHR;
  for (int it = gt; it < 4 * 4 * 4 * SEQ; it += gs) {
    const int l = it & (SEQ - 1), pq = (it >> 12) & 3, h = (it >> 14) & 3, b = it >> 16;
    const int g = h >> 1;
    const size_t tb = (size_t)b * SEQ;
    uint4 cl[16];
    float acc[16];
#pragma unroll
    for (int d = 0; d < 16; ++d) cl[d] = *reinterpret_cast<const uint4*>(p.xbc() + (tb + l) * 768 + 512 + g * 128 + d * 8);
#pragma unroll
    for (int d = 0; d < 16; ++d) acc[d] = 0.f;
    const float pl = p.cs()[(tb + l) * 8 + h], rl = p.cs()[(tb + l) * 8 + 4 + h];
#pragma unroll 1
    for (int s = 0; s < SEQ; ++s) {
      const u16* br = p.xbc() + (tb + s) * 768 + 256 + g * 128;
      float cbv = 0.f;
#pragma unroll
      for (int d = 0; d < 16; ++d) cbv = dot8(cl[d], *reinterpret_cast<const uint4*>(br + d * 8), cbv);
      float w;
      if (s <= l) w = expf(pl - p.cs()[(tb + s) * 8 + h]) * p.dtv()[(tb + s) * 8 + h];
      else w = expf(rl - p.cs()[(tb + s) * 8 + 4 + h]) * p.dtv()[(tb + s) * 8 + 4 + h];
      cbv *= w;
      const u16* xr = p.xbc() + (tb + s) * 768 + h * 64 + pq * 16;
#pragma unroll
      for (int d = 0; d < 16; d += 8) {
        float xf[8];
        ld8(xr + d, xf);
#pragma unroll
        for (int j = 0; j < 8; ++j) acc[d + j] += cbv * xf[j];
      }
    }
    const float dsk = p.ssm_d[L * 4 + h];
#pragma unroll
    for (int d = 0; d < 16; ++d) {
      const int c = h * 64 + pq * 16 + d;
      const float xv = bf2f(p.xbc()[(tb + l) * 768 + c]);
      const float z = bf2f(p.proj()[(tb + l) * PWP + C_Z + c]);
      p.ybuf()[(tb + l) * 256 + c] = (acc[d] + dsk * xv) * silu(z);
    }
  }
}

DI void ph_ssd_norm(const Params& p, int L) {
  const int tid_ = otid(); const int lane = tid_ & 63, gw = (obid() * NTHR + tid_) >> 6, nw = gridDim.x * (NTHR / 64);
  const float* nwt = p.ssm_norm_w + L * 256;
  for (int t = gw; t < T; t += nw) {
    const float4 v = *reinterpret_cast<const float4*>(p.ybuf() + (size_t)t * 256 + lane * 4);
    float ss = wave_sum(v.x * v.x + v.y * v.y + v.z * v.z + v.w * v.w);
    const float rstd = rsqrtf(ss * (1.f / 256.f) + 1e-6f);
    const float4 ww = *reinterpret_cast<const float4*>(nwt + lane * 4);
    uint2 o;
    o.x = pack2(v.x * rstd * ww.x, v.y * rstd * ww.y);
    o.y = pack2(v.z * rstd * ww.z, v.w * rstd * ww.w);
    *reinterpret_cast<uint2*>(p.mixed() + (size_t)t * DM + 512 + lane * 4) = o;
  }
}

#define MFMA16(a, b, c) __builtin_amdgcn_mfma_f32_16x16x32_bf16((a), (b), (c), 0, 0, 0)
template <int MT, int NT, int KS>
DI void wave_mm(f32x4 (&acc)[MT][NT], const u16* a0, int lda, const u16* b0, int ldb, int fr, int fq) {
#pragma unroll
  for (int ks = 0; ks < KS; ++ks) {
    bf16x8 af[MT], bfv[NT];
#pragma unroll
    for (int m = 0; m < MT; ++m) af[m] = *reinterpret_cast<const bf16x8*>(a0 + (m * 16 + fr) * lda + ks * 32 + fq * 8);
#pragma unroll
    for (int n = 0; n < NT; ++n) bfv[n] = *reinterpret_cast<const bf16x8*>(b0 + (n * 16 + fr) * ldb + ks * 32 + fq * 8);
#pragma unroll
    for (int m = 0; m < MT; ++m)
#pragma unroll
      for (int n = 0; n < NT; ++n) acc[m][n] = MFMA16(af[m], bfv[n], acc[m][n]);
  }
}
template <int MT, int NT>
DI void zero_acc(f32x4 (&acc)[MT][NT]) {
#pragma unroll
  for (int m = 0; m < MT; ++m)
#pragma unroll
    for (int n = 0; n < NT; ++n) acc[m][n] = f32x4{0.f, 0.f, 0.f, 0.f};
}
template <int NROWS, int NCOLS>
DI void stage_rows(u16* dst, int ldd, const u16* src, size_t lsrc, int tid) {
  constexpr int CPR = NCOLS / 8, NCH = NROWS * CPR / NTHR;
  static_assert(NROWS * CPR % NTHR == 0, "tile must be a multiple of 512 chunks");
  uint4 r[NCH];
#pragma unroll
  for (int i = 0; i < NCH; ++i) {
    const int c = tid + i * NTHR, row = c / CPR, cc = c % CPR;
    r[i] = *reinterpret_cast<const uint4*>(src + (size_t)row * lsrc + cc * 8);
  }
#pragma unroll
  for (int i = 0; i < NCH; ++i) {
    const int c = tid + i * NTHR, row = c / CPR, cc = c % CPR;
    *reinterpret_cast<uint4*>(dst + row * ldd + cc * 8) = r[i];
  }
}
template <int NCOLS, class W>
DI void stage_T(u16* dst, int ldd, const u16* src, size_t lsrc, int tid, W w) {
  constexpr int NCH = 128 * (NCOLS / 8) / NTHR;
  uint4 r[NCH];
#pragma unroll
  for (int i = 0; i < NCH; ++i) {
    const int c = tid + i * NTHR, j = c & 127, cc = c >> 7;
    r[i] = *reinterpret_cast<const uint4*>(src + (size_t)j * lsrc + cc * 8);
  }
#pragma unroll
  for (int i = 0; i < NCH; ++i) {
    const int c = tid + i * NTHR, j = c & 127, cc = c >> 7;
    float f[8];
    unpack8(r[i], f);
    const float wj = w(j);
#pragma unroll
    for (int e = 0; e < 8; ++e) dst[(cc * 8 + e) * ldd + j] = f2bf(f[e] * wj);
  }
}

template <int NROWS, int NCOLS>
DI void stage_rows_ld(uint4 (&r)[NROWS * (NCOLS / 8) / NTHR], const u16* src, size_t lsrc, int tid) {
  constexpr int CPR = NCOLS / 8, NCH = NROWS * CPR / NTHR;
#pragma unroll
  for (int i = 0; i < NCH; ++i) {
    const int c = tid + i * NTHR, row = c / CPR, cc = c % CPR;
    r[i] = *reinterpret_cast<const uint4*>(src + (size_t)row * lsrc + cc * 8);
  }
}
template <int NROWS, int NCOLS>
DI void stage_rows_st(u16* dst, int ldd, const uint4 (&r)[NROWS * (NCOLS / 8) / NTHR], int tid) {
  constexpr int CPR = NCOLS / 8, NCH = NROWS * CPR / NTHR;
#pragma unroll
  for (int i = 0; i < NCH; ++i) {
    const int c = tid + i * NTHR, row = c / CPR, cc = c % CPR;
    *reinterpret_cast<uint4*>(dst + row * ldd + cc * 8) = r[i];
  }
}
template <int NCOLS>
DI void stage_T_ld(uint4 (&r)[128 * (NCOLS / 8) / NTHR], const u16* src, size_t lsrc, int tid) {
  constexpr int NCH = 128 * (NCOLS / 8) / NTHR;
#pragma unroll
  for (int i = 0; i < NCH; ++i) {
    const int c = tid + i * NTHR, j = c & 127, cc = c >> 7;
    r[i] = *reinterpret_cast<const uint4*>(src + (size_t)j * lsrc + cc * 8);
  }
}
template <int NCOLS, class W>
DI void stage_T_st(u16* dst, int ldd, const uint4 (&r)[128 * (NCOLS / 8) / NTHR], int tid, W w) {
  constexpr int NCH = 128 * (NCOLS / 8) / NTHR;
#pragma unroll
  for (int i = 0; i < NCH; ++i) {
    const int c = tid + i * NTHR, j = c & 127, cc = c >> 7;
    float f[8];
    unpack8(r[i], f);
    const float wj = w(j);
#pragma unroll
    for (int e = 0; e < 8; ++e) dst[(cc * 8 + e) * ldd + j] = f2bf(f[e] * wj);
  }
}

DI void ph_ret_a(const Params& p, char* smem, int item) {
  const int tid = otid(), wid = tid >> 6, lane = tid & 63, fr = lane & 15, fq = lane >> 4;
  u16* sVt = reinterpret_cast<u16*>(smem);
  u16* sKf = sVt + 64 * 136;
  u16* sKb = sKf + 64 * 136;
  {
    const int c = item & 31, bh = item >> 5, b = bh >> 2, h = bh & 3;
    const float lg0 = log1pf(-exp2f(-5.f - (float)h)), lg1 = log1pf(-exp2f(-5.5f - (float)h));
    const u16* src = p.proj() + ((size_t)b * SEQ + c * 128) * PWP;
    {
      uint4 rv[2], rk[2];
      stage_T_ld<64>(rv, src + C_RV + h * 64, PWP, tid);
      stage_T_ld<64>(rk, src + C_RK + h * 64, PWP, tid);
      stage_T_st<64>(sVt, 136, rv, tid, [](int) { return 1.f; });
      stage_T_st<64>(sKf, 136, rk, tid, [&](int j) { return __expf(lg0 * (float)(127 - j)); });
      stage_T_st<64>(sKb, 136, rk, tid, [&](int j) { return __expf(lg1 * (float)j); });
    }
    __syncthreads();
    const int dir = wid >> 2, q = wid & 3;
    f32x4 acc[1][4];
    zero_acc(acc);
    wave_mm<1, 4, 4>(acc, sVt + q * 16 * 136, 136, dir ? sKb : sKf, 136, fr, fq);
    float* out = p.rU() + ((size_t)(bh * 32 + c) * 2 + dir) * 4096;
#pragma unroll
    for (int n = 0; n < 4; ++n)
#pragma unroll
      for (int j = 0; j < 4; ++j) out[(q * 16 + fq * 4 + j) * 64 + n * 16 + fr] = acc[0][n][j];
    __syncthreads();
  }
}
DI void ph_ret_scan(const Params& p) {
  const int gt = obid() * NTHR + otid(), gs = gridDim.x * NTHR;
  for (int it = gt; it < 16 * 2 * 4096; it += gs) {
    const int e = it & 4095, dir = (it >> 12) & 1, bh = it >> 13, h = bh & 3;
    const float lg = log1pf(-exp2f((dir ? -5.5f : -5.f) - (float)h));
    const float cd = __expf(lg * 128.f);
    float u[32];
#pragma unroll
    for (int c = 0; c < 32; ++c) u[c] = p.rU()[((size_t)(bh * 32 + c) * 2 + dir) * 4096 + e];
    float st = 0.f;
    if (dir == 0) {
#pragma unroll
      for (int c = 0; c < 32; ++c) {
        p.rS()[((size_t)(bh * 32 + c) * 2 + dir) * 4096 + e] = f2bf(st);
        st = st * cd + u[c];
      }
    } else {
#pragma unroll
      for (int c = 31; c >= 0; --c) {
        p.rS()[((size_t)(bh * 32 + c) * 2 + dir) * 4096 + e] = f2bf(st);
        st = st * cd + u[c];
      }
    }
  }
}
DI void ph_ret_c(const Params& p, char* smem, int item) {
  const int tid = otid(), wid = tid >> 6, lane = tid & 63, fr = lane & 15, fq = lane >> 4;
  u16* sQ = reinterpret_cast<u16*>(smem);
  u16* sK = sQ + 128 * 72;
  u16* sVt = sK + 128 * 72;
  u16* sSf = sVt + 64 * 136;
  u16* sSb = sSf + 64 * 72;
  u16* sP = sSb + 64 * 72;
  {
    const int c = item & 31, bh = item >> 5, b = bh >> 2, h = bh & 3;
    const float lg0 = log1pf(-exp2f(-5.f - (float)h)), lg1 = log1pf(-exp2f(-5.5f - (float)h));
    const size_t t0 = (size_t)b * SEQ + c * 128;
    const u16* src = p.proj() + t0 * PWP;
    {
      uint4 rq[2], rk[2], rv[2], rf[1], rb[1];
      stage_rows_ld<128, 64>(rq, src + C_RQ + h * 64, PWP, tid);
      stage_rows_ld<128, 64>(rk, src + C_RK + h * 64, PWP, tid);
      stage_T_ld<64>(rv, src + C_RV + h * 64, PWP, tid);
      stage_rows_ld<64, 64>(rf, p.rS() + ((size_t)(bh * 32 + c) * 2 + 0) * 4096, 64, tid);
      stage_rows_ld<64, 64>(rb, p.rS() + ((size_t)(bh * 32 + c) * 2 + 1) * 4096, 64, tid);
      stage_rows_st<128, 64>(sQ, 72, rq, tid);
      stage_rows_st<128, 64>(sK, 72, rk, tid);
      stage_T_st<64>(sVt, 136, rv, tid, [](int) { return 1.f; });
      stage_rows_st<64, 64>(sSf, 72, rf, tid);
      stage_rows_st<64, 64>(sSb, 72, rb, tid);
    }
    __syncthreads();
    {
      const int wr = wid >> 1, wc = wid & 1;
      f32x4 sacc[2][4];
      zero_acc(sacc);
      wave_mm<2, 4, 2>(sacc, sQ + wr * 32 * 72, 72, sK + wc * 64 * 72, 72, fr, fq);
#pragma unroll
      for (int m = 0; m < 2; ++m)
#pragma unroll
        for (int n = 0; n < 4; ++n)
#pragma unroll
          for (int j = 0; j < 4; ++j) {
            const int i = wr * 32 + m * 16 + fq * 4 + j, jj = wc * 64 + n * 16 + fr;
            const float dcy = (jj <= i) ? __expf(lg0 * (float)(i - jj)) : __expf(lg1 * (float)(jj - i));
            sP[i * 136 + jj] = f2bf(sacc[m][n][j] * dcy);
          }
    }
    __syncthreads();
    {
      f32x4 ai[1][4], af_[1][4], ab_[1][4];
      zero_acc(ai); zero_acc(af_); zero_acc(ab_);
      wave_mm<1, 4, 4>(ai, sP + wid * 16 * 136, 136, sVt, 136, fr, fq);
      wave_mm<1, 4, 2>(af_, sQ + wid * 16 * 72, 72, sSf, 72, fr, fq);
      wave_mm<1, 4, 2>(ab_, sQ + wid * 16 * 72, 72, sSb, 72, fr, fq);
#pragma unroll
      for (int j = 0; j < 4; ++j) {
        const int i = wid * 16 + fq * 4 + j;
        const float xf = __expf(lg0 * (float)(i + 1)), xb = __expf(lg1 * (float)(128 - i));
        float o[4], sum = 0.f;
#pragma unroll
        for (int n = 0; n < 4; ++n) { o[n] = ai[0][n][j] + xf * af_[0][n][j] + xb * ab_[0][n][j]; sum += o[n]; }
#pragma unroll
        for (int sft = 1; sft < 16; sft <<= 1) sum += __shfl_xor(sum, sft);
        const float mu = sum * (1.f / 64.f);
        float var = 0.f;
#pragma unroll
        for (int n = 0; n < 4; ++n) var += (o[n] - mu) * (o[n] - mu);
#pragma unroll
        for (int sft = 1; sft < 16; sft <<= 1) var += __shfl_xor(var, sft);
        const float rs = rsqrtf(var * (1.f / 64.f) + 1e-5f);
#pragma unroll
        for (int n = 0; n < 4; ++n) {
          const float g = bf2f(p.proj()[(t0 + i) * PWP + C_RG + h * 64 + n * 16 + fr]);
          p.mixed()[(t0 + i) * DM + h * 64 + n * 16 + fr] = f2bf(silu(g) * (o[n] - mu) * rs);
        }
      }
    }
    __syncthreads();
  }
}

DI void ssd_local_cumsum(const Params& p, int L, size_t t0, float* cum, float* dtl, int wid, int lane) {
  const int dir = wid >> 2, h = wid & 3;
  const float a = -__expf(p.a_log[L * 8 + dir * 4 + h]);
  float d0, d1;
  if (dir == 0) { d0 = p.dtv()[(t0 + 2 * lane) * 8 + h]; d1 = p.dtv()[(t0 + 2 * lane + 1) * 8 + h]; }
  else { d0 = p.dtv()[(t0 + 127 - 2 * lane) * 8 + 4 + h]; d1 = p.dtv()[(t0 + 126 - 2 * lane) * 8 + 4 + h]; }
  float v0 = d0 * a, v1 = v0 + d1 * a;
  float run = v1;
#pragma unroll
  for (int o = 1; o < 64; o <<= 1) {
    const float u = __shfl_up(run, o);
    if (lane >= o) run += u;
  }
  const float excl = run - v1;
  v0 += excl; v1 += excl;
  float* cr = cum + (dir * 4 + h) * 128;
  float* dr = dtl + (dir * 4 + h) * 128;
  if (dir == 0) { cr[2 * lane] = v0; cr[2 * lane + 1] = v1; dr[2 * lane] = d0; dr[2 * lane + 1] = d1; }
  else { cr[127 - 2 * lane] = v0; cr[126 - 2 * lane] = v1; dr[127 - 2 * lane] = d0; dr[126 - 2 * lane] = d1; }
}

DI void ph_ssd_a(const Params& p, int L, char* smem, int item) {
  const int tid = otid(), wid = tid >> 6, lane = tid & 63, fr = lane & 15, fq = lane >> 4;
  u16* sBt = reinterpret_cast<u16*>(smem);
  u16* sXf = sBt + 2 * 128 * 136;
  u16* sXb = sXf + 64 * 136;
  float* cum = reinterpret_cast<float*>(sXb + 64 * 136);
  float* dtl = cum + 8 * 128;
  {
    const int c = item & 31, b = item >> 5;
    const size_t t0 = (size_t)b * SEQ + c * 128;
    ssd_local_cumsum(p, L, t0, cum, dtl, wid, lane);
    stage_T<256>(sBt, 136, p.xbc() + t0 * 768 + 256, 768, tid, [](int) { return 1.f; });
    __syncthreads();
    if (tid < 8) {
      const int dir = tid >> 2;
      p.cdec()[(size_t)item * 8 + tid] = __expf(dir ? cum[tid * 128 + 0] : cum[tid * 128 + 127]);
    }
    for (int h = 0; h < 4; ++h) {
      const float* cf = cum + h * 128;
      const float* cb = cum + (4 + h) * 128;
      const float* df = dtl + h * 128;
      const float* db = dtl + (4 + h) * 128;
      const float endf = cf[127], endb = cb[0];
      {
        uint4 rx[2];
        stage_T_ld<64>(rx, p.xbc() + t0 * 768 + h * 64, 768, tid);
        stage_T_st<64>(sXf, 136, rx, tid, [&](int l) { return __expf(endf - cf[l]) * df[l]; });
        stage_T_st<64>(sXb, 136, rx, tid, [&](int l) { return __expf(endb - cb[l]) * db[l]; });
      }
      __syncthreads();
      const int dir = wid >> 2, q = wid & 3, g = h >> 1;
      f32x4 acc[4][2];
      zero_acc(acc);
      wave_mm<4, 2, 4>(acc, dir ? sXb : sXf, 136, sBt + (g * 128 + q * 32) * 136, 136, fr, fq);
      float* out = p.sU() + ((size_t)item * 8 + h * 2 + dir) * 8192;
#pragma unroll
      for (int m = 0; m < 4; ++m)
#pragma unroll
        for (int n = 0; n < 2; ++n)
#pragma unroll
          for (int j = 0; j < 4; ++j) out[(m * 16 + fq * 4 + j) * 128 + q * 32 + n * 16 + fr] = acc[m][n][j];
      __syncthreads();
    }
  }
}
DI void ph_ssd_scan(const Params& p) {
  const int gt = obid() * NTHR + otid(), gs = gridDim.x * NTHR;
  for (int it = gt; it < 4 * 8 * 8192; it += gs) {
    const int e = it & 8191, hd = (it >> 13) & 7, b = it >> 16;
    const int dir = hd & 1, h = hd >> 1;
    float u[32];
#pragma unroll
    for (int c = 0; c < 32; ++c) u[c] = p.sU()[((size_t)(b * 32 + c) * 8 + hd) * 8192 + e];
    float st = 0.f;
    if (dir == 0) {
#pragma unroll
      for (int c = 0; c < 32; ++c) {
        p.sS()[((size_t)(b * 32 + c) * 8 + hd) * 8192 + e] = f2bf(st);
        st = st * p.cdec()[(size_t)(b * 32 + c) * 8 + dir * 4 + h] + u[c];
      }
    } else {
#pragma unroll
      for (int c = 31; c >= 0; --c) {
        p.sS()[((size_t)(b * 32 + c) * 8 + hd) * 8192 + e] = f2bf(st);
        st = st * p.cdec()[(size_t)(b * 32 + c) * 8 + dir * 4 + h] + u[c];
      }
    }
  }
}
DI void ph_ssd_c(const Params& p, int L, char* smem, int item) {
  const int tid = otid(), wid = tid >> 6, lane = tid & 63, fr = lane & 15, fq = lane >> 4;
  u16* sC = reinterpret_cast<u16*>(smem);
  u16* sB = sC + 128 * 136;
  u16* sXt = sB + 128 * 136;
  u16* sSf = sXt + 64 * 136;
  u16* sSb = sSf + 64 * 136;
  float* cum = reinterpret_cast<float*>(sSb + 64 * 136);
  float* dtl = cum + 8 * 128;
  {
    const int c = item & 31, b = item >> 5;
    const size_t t0 = (size_t)b * SEQ + c * 128;
    ssd_local_cumsum(p, L, t0, cum, dtl, wid, lane);
    float ssq[4] = {0.f, 0.f, 0.f, 0.f};
#pragma unroll 1
    for (int g = 0; g < 2; ++g) {
      {
        uint4 rc[4], rb4[4];
        stage_rows_ld<128, 128>(rc, p.xbc() + t0 * 768 + 512 + g * 128, 768, tid);
        stage_rows_ld<128, 128>(rb4, p.xbc() + t0 * 768 + 256 + g * 128, 768, tid);
        stage_rows_st<128, 128>(sC, 136, rc, tid);
        stage_rows_st<128, 128>(sB, 136, rb4, tid);
      }
      __syncthreads();
      const int wr = wid >> 1, wc = wid & 1;
      f32x4 G[2][4];
      zero_acc(G);
      wave_mm<2, 4, 4>(G, sC + wr * 32 * 136, 136, sB + wc * 64 * 136, 136, fr, fq);
      __syncthreads();
#pragma unroll 1
      for (int hl = 0; hl < 2; ++hl) {
        const int h = g * 2 + hl;
        const float* cf = cum + h * 128;
        const float* cb = cum + (4 + h) * 128;
        const float* df = dtl + h * 128;
        const float* db = dtl + (4 + h) * 128;
        uint4 rxt[2], rsf[2], rsb[2];
        stage_T_ld<64>(rxt, p.xbc() + t0 * 768 + h * 64, 768, tid);
        stage_rows_ld<64, 128>(rsf, p.sS() + ((size_t)item * 8 + h * 2 + 0) * 8192, 128, tid);
        stage_rows_ld<64, 128>(rsb, p.sS() + ((size_t)item * 8 + h * 2 + 1) * 8192, 128, tid);
#pragma unroll
        for (int m = 0; m < 2; ++m)
#pragma unroll
          for (int n = 0; n < 4; ++n)
#pragma unroll
            for (int j = 0; j < 4; ++j) {
              const int l = wr * 32 + m * 16 + fq * 4 + j, sx = wc * 64 + n * 16 + fr;
              const float w = (sx <= l) ? __expf(cf[l] - cf[sx]) * df[sx] : __expf(cb[l] - cb[sx]) * db[sx];
              sB[l * 136 + sx] = f2bf(G[m][n][j] * w);
            }
        stage_T_st<64>(sXt, 136, rxt, tid, [](int) { return 1.f; });
        stage_rows_st<64, 128>(sSf, 136, rsf, tid);
        stage_rows_st<64, 128>(sSb, 136, rsb, tid);
        __syncthreads();
        f32x4 yd[1][4], yf[1][4], yb[1][4];
        zero_acc(yd); zero_acc(yf); zero_acc(yb);
        wave_mm<1, 4, 4>(yd, sB + wid * 16 * 136, 136, sXt, 136, fr, fq);
        wave_mm<1, 4, 4>(yf, sC + wid * 16 * 136, 136, sSf, 136, fr, fq);
        wave_mm<1, 4, 4>(yb, sC + wid * 16 * 136, 136, sSb, 136, fr, fq);
        const float dsk = p.ssm_d[L * 4 + h];
#pragma unroll
        for (int j = 0; j < 4; ++j) {
          const int l = wid * 16 + fq * 4 + j;
          const float ef = __expf(cf[l]), eb = __expf(cb[l]);
#pragma unroll
          for (int n = 0; n < 4; ++n) {
            const int ch = h * 64 + n * 16 + fr;
            const float xv = bf2f(p.xbc()[(t0 + l) * 768 + ch]);
            const float z = bf2f(p.proj()[(t0 + l) * PWP + C_Z + ch]);
            const float yv = (yd[0][n][j] + ef * yf[0][n][j] + eb * yb[0][n][j] + dsk * xv) * silu(z);
            ssq[j] += yv * yv;
            p.ybuf()[(t0 + l) * 256 + ch] = yv;
          }
        }
        __syncthreads();
      }
    }
    const float* nwt = p.ssm_norm_w + L * 256;
#pragma unroll
    for (int j = 0; j < 4; ++j) {
      float ss = ssq[j];
#pragma unroll
      for (int sft = 1; sft < 16; sft <<= 1) ss += __shfl_xor(ss, sft);
      const float rstd = rsqrtf(ss * (1.f / 256.f) + 1e-6f);
      const int l = wid * 16 + fq * 4 + j;
#pragma unroll
      for (int hn = 0; hn < 16; ++hn) {
        const int ch = hn * 16 + fr;
        p.mixed()[(t0 + l) * DM + 512 + ch] = f2bf(p.ybuf()[(t0 + l) * 256 + ch] * rstd * nwt[ch]);
      }
    }
  }
}

struct CfgOutproj {
  static constexpr bool PERM = false;
  int K; const Params* p; int L; int bid, nb; const float* xin; float* xout;
  DI bool next(int i, pg8::Unit& u) const { const int t = i * nb + bid; if (t >= 64 * 4) return false; u.pm = t & 63; u.pn = t >> 6; return true; }
  DI const char* a_base(const pg8::Unit& u) const { return (const char*)(p->mixed() + (size_t)u.pm * 256 * DM); }
  DI const char* b_base(const pg8::Unit& u) const { return (const char*)(p->WoutT() + ((size_t)L * DM + (size_t)u.pn * 256) * DM); }
  DI void a_off(const pg8::Unit&, int R0, int C0, int R1, int C1, unsigned (&vo)[4]) const {
    vo[0] = (unsigned)(R0 * DM + C0) * 2u; vo[1] = (unsigned)(R1 * DM + C1) * 2u;
    vo[2] = vo[0] + 128u * DM * 2u; vo[3] = vo[1] + 128u * DM * 2u;
  }
  DI void epi(const f32x4 (&acc)[2][2][4][2], const pg8::Unit& u, int wr, int wc, int fr, int fq) const {
    const int row0 = u.pm * 256 + wr * 64 + fr, col0 = u.pn * 256 + wc * 32 + 4 * fq;
#pragma unroll
    for (int ai = 0; ai < 2; ++ai)
#pragma unroll
      for (int m = 0; m < 4; ++m) {
        const size_t ro = (size_t)(row0 + ai * 128 + m * 16) * DM + col0;
#pragma unroll
        for (int bj = 0; bj < 2; ++bj)
#pragma unroll
          for (int n = 0; n < 2; ++n) {
            const size_t o = ro + bj * 128 + n * 16;
            const float4 xi = *reinterpret_cast<const float4*>(xin + o);
            const f32x4 a = acc[ai][bj][m][n];
            *reinterpret_cast<float4*>(xout + o) = make_float4(xi.x + a[0], xi.y + a[1], xi.z + a[2], xi.w + a[3]);
          }
      }
  }
};
DI void ph_outproj(const Params& p, int L, const float* xin, float* xout, char* smem) {
  CfgOutproj c; c.K = DM; c.p = &p; c.L = L; c.bid = obid(); c.nb = gridDim.x; c.xin = xin; c.xout = xout;
  pg8::gemm_phase((pg8::lds_u8*)smem, c);
}

DI void ph_rms2_router(const Params& p, int L, const float* xres, char* smem) {
  const int tid = otid(), lane = tid & 63, gw = (obid() * NTHR + tid) >> 6, nw = gridDim.x * (NTHR / 64);
  const float* w = p.ln2_w + L * DM;
  const float* rw = p.router_w + (size_t)L * DM * 16;
  float4* srw = reinterpret_cast<float4*>(smem);
  for (int i = tid; i < 4096; i += NTHR) {
    const int c = i >> 2, e4 = i & 3;
    srw[(e4 * 4 + (c & 3)) * 256 + (c >> 2)] = *reinterpret_cast<const float4*>(rw + (size_t)i * 4);
  }
  __syncthreads();
  const int b5 = (lane >> 5) & 1, b4 = (lane >> 4) & 1, b3 = (lane >> 3) & 1, b2 = (lane >> 2) & 1;
  const int my_e = 8 * b5 + 4 * b4 + 2 * b3 + b2;
  float4 v[4];
  if (gw < T) {
#pragma unroll
    for (int i = 0; i < 4; ++i) v[i] = *reinterpret_cast<const float4*>(xres + (size_t)gw * DM + (i * 64 + lane) * 4);
  }
  for (int t = gw; t < T; t += nw) {
    float4 vnx[4];
    const int tn = (t + nw < T) ? (t + nw) : t;
#pragma unroll
    for (int i = 0; i < 4; ++i) vnx[i] = *reinterpret_cast<const float4*>(xres + (size_t)tn * DM + (i * 64 + lane) * 4);
    float ss = 0.f;
#pragma unroll
    for (int i = 0; i < 4; ++i) ss += v[i].x * v[i].x + v[i].y * v[i].y + v[i].z * v[i].z + v[i].w * v[i].w;
    ss = wave_sum(ss);
    const float rstd = rsqrtf(ss * (1.f / DM) + 1e-6f);
    float lg[16];
#pragma unroll
    for (int e = 0; e < 16; ++e) lg[e] = 0.f;
#pragma unroll
    for (int i = 0; i < 4; ++i) {
      const int q = i * 64 + lane;
      const float4 ww = *reinterpret_cast<const float4*>(w + q * 4);
      const float hv[4] = {v[i].x * rstd * ww.x, v[i].y * rstd * ww.y, v[i].z * rstd * ww.z, v[i].w * rstd * ww.w};
      *reinterpret_cast<unsigned*>(p.hn8() + (size_t)t * DM + q * 4) =
          pk4_f8(hv[0] * F8_H_SCALE, hv[1] * F8_H_SCALE, hv[2] * F8_H_SCALE, hv[3] * F8_H_SCALE);
#pragma unroll
      for (int j = 0; j < 4; ++j)
#pragma unroll
        for (int e4 = 0; e4 < 4; ++e4) {
          const float4 r = srw[(e4 * 4 + j) * 256 + q];
          lg[e4 * 4 + 0] += hv[j] * r.x; lg[e4 * 4 + 1] += hv[j] * r.y;
          lg[e4 * 4 + 2] += hv[j] * r.z; lg[e4 * 4 + 3] += hv[j] * r.w;
        }
      __builtin_amdgcn_sched_barrier(0);
    }
#pragma unroll
    for (int k = 0; k < 8; ++k) {
      const float send = b5 ? lg[k] : lg[k + 8], keep = b5 ? lg[k + 8] : lg[k];
      lg[k] = keep + __shfl_xor(send, 32);
    }
#pragma unroll
    for (int k = 0; k < 4; ++k) {
      const float send = b4 ? lg[k] : lg[k + 4], keep = b4 ? lg[k + 4] : lg[k];
      lg[k] = keep + __shfl_xor(send, 16);
    }
#pragma unroll
    for (int k = 0; k < 2; ++k) {
      const float send = b3 ? lg[k] : lg[k + 2], keep = b3 ? lg[k + 2] : lg[k];
      lg[k] = keep + __shfl_xor(send, 8);
    }
    float lv;
    {
      const float send = b2 ? lg[0] : lg[1], keep = b2 ? lg[1] : lg[0];
      lv = keep + __shfl_xor(send, 4);
    }
    lv += __shfl_xor(lv, 2);
    lv += __shfl_xor(lv, 1);
    float mx = lv;
    mx = fmaxf(mx, __shfl_xor(mx, 4)); mx = fmaxf(mx, __shfl_xor(mx, 8));
    mx = fmaxf(mx, __shfl_xor(mx, 16)); mx = fmaxf(mx, __shfl_xor(mx, 32));
    const float ex = expf(lv - mx);
    float den = ex;
    den += __shfl_xor(den, 4); den += __shfl_xor(den, 8); den += __shfl_xor(den, 16); den += __shfl_xor(den, 32);
    if ((lane & 3) == 0) { p.aff()[(size_t)t * 16 + my_e] = ex / den; p.inv()[(size_t)t * 16 + my_e] = -1; }
#pragma unroll
    for (int i = 0; i < 4; ++i) v[i] = vnx[i];
  }
}

DI int block_sum_i(int v, int* red, int tid) {
#pragma unroll
  for (int o = 32; o > 0; o >>= 1) v += __shfl_xor(v, o);
  __syncthreads();
  if ((tid & 63) == 0) red[tid >> 6] = v;
  __syncthreads();
  int t = 0;
#pragma unroll
  for (int w = 0; w < NTHR / 64; ++w) t += red[w];
  return t;
}
DI void ph_topk(const Params& p, char* smem) {
  int* red = reinterpret_cast<int*>(smem);
  int* wsum = red + 16;
  const int tid = otid(), wid = tid >> 6, lane = tid & 63;
  for (int it = obid(); it < 64; it += gridDim.x) {
    const int e = it & 15, b = it >> 4;
    unsigned v[8];
#pragma unroll
    for (int i = 0; i < 8; ++i) v[i] = __float_as_uint(p.aff()[(size_t)(b * SEQ + tid * 8 + i) * 16 + e]);
    unsigned thr = 0;
#pragma unroll 1
    for (int bit = 30; bit >= 0; --bit) {
      const unsigned cand = thr | (1u << bit);
      int cnt = 0;
#pragma unroll
      for (int i = 0; i < 8; ++i) cnt += (v[i] >= cand) ? 1 : 0;
      if (block_sum_i(cnt, red, tid) >= 512) thr = cand;
    }
    int ngt = 0, ntie = 0;
#pragma unroll
    for (int i = 0; i < 8; ++i) { ngt += (v[i] > thr) ? 1 : 0; ntie += (v[i] == thr) ? 1 : 0; }
    int ig = ngt, itie = ntie;
#pragma unroll
    for (int o = 1; o < 64; o <<= 1) {
      const int a = __shfl_up(ig, o), c = __shfl_up(itie, o);
      if (lane >= o) { ig += a; itie += c; }
    }
    __syncthreads();
    if (lane == 63) { wsum[wid] = ig; wsum[8 + wid] = itie; }
    __syncthreads();
    int og = 0, ot = 0, totg = 0;
#pragma unroll
    for (int w = 0; w < 8; ++w) {
      const int a = wsum[w], c = wsum[8 + w];
      if (w < wid) { og += a; ot += c; }
      totg += a;
    }
    int pg = og + ig - ngt, pt = ot + itie - ntie;
    const int base = (e * 4 + b) * 512;
#pragma unroll
    for (int i = 0; i < 8; ++i) {
      int slot = -1;
      if (v[i] > thr) { slot = pg; ++pg; }
      else if (v[i] == thr) { if (totg + pt < 512) slot = totg + pt; ++pt; }
      if (slot >= 0) {
        p.tok()[base + slot] = b * SEQ + tid * 8 + i;
        p.inv()[(size_t)(b * SEQ + tid * 8 + i) * 16 + e] = base + slot;
        p.gate()[base + slot] = __uint_as_float(v[i]);
      }
    }
    __syncthreads();
  }
}

struct CfgMoe1 {
  static constexpr bool PERM = true;
  int K; const Params* p; int L; int bid, nb;
  DI bool next(int i, pg8::Unit& u) const {
    const int t = i * nb + bid; if (t >= 16 * 16 * 8) return false;
    const int rnd = t >> 8, w = t & 255, xcd = w & 7, jx = w >> 3, pid = xcd * 4 + (jx >> 3);
    const int mt = jx & 7, nt = pid & 15, e = rnd * 2 + (pid >> 4);
    u.pm = e * 8 + mt; u.pn = e * 16 + nt; return true;
  }
  DI const char* a_base(const pg8::Unit&) const { return (const char*)p->hn8(); }
  DI const char* b_base(const pg8::Unit& u) const { return (const char*)(p->Wgu8() + ((size_t)L * 16 * 4096 + (size_t)u.pn * 256) * DM); }
  const int* tokl;
  DI void a_off(const pg8::Unit&, int R0, int C0, int R1, int C1, unsigned (&vo)[4], int ui) const {
    const int* tk = tokl + ui * 256;
    vo[0] = (unsigned)(tk[R0] * 512 + C0) * 2u; vo[1] = (unsigned)(tk[R1] * 512 + C1) * 2u;
    vo[2] = (unsigned)(tk[128 + R0] * 512 + C0) * 2u; vo[3] = (unsigned)(tk[128 + R1] * 512 + C1) * 2u;
  }
  DI void epi(const f32x4 (&acc)[2][2][4][2], const pg8::Unit& u, int wr, int wc, int fr, int fq) const {
    const int row0 = u.pm * 256 + wr * 64 + fr, col0 = (u.pn & 15) * 128 + wc * 32 + 8 * fq;
    const float dq = 1.f / (F8_H_SCALE * F8_W_SCALE);
#pragma unroll
    for (int ai = 0; ai < 2; ++ai)
#pragma unroll
      for (int m = 0; m < 4; ++m) {
        const f32x4 g0 = acc[ai][0][m][0] * dq, g1 = acc[ai][0][m][1] * dq, u0 = acc[ai][1][m][0] * (dq * F8_HID_SCALE), u1 = acc[ai][1][m][1] * (dq * F8_HID_SCALE);
        uint2 w;
        w.x = pk4_f8(fast_silu(g0[0]) * u0[0], fast_silu(g0[1]) * u0[1], fast_silu(g0[2]) * u0[2], fast_silu(g0[3]) * u0[3]);
        w.y = pk4_f8(fast_silu(g1[0]) * u1[0], fast_silu(g1[1]) * u1[1], fast_silu(g1[2]) * u1[2], fast_silu(g1[3]) * u1[3]);
        *reinterpret_cast<uint2*>(p->hid8() + (size_t)(row0 + ai * 128 + m * 16) * 2048 + col0) = w;
      }
  }
};
DI void ph_moe1(const Params& p, int L, char* smem) {
  CfgMoe1 c; c.K = 512; c.p = &p; c.L = L; c.bid = obid(); c.nb = gridDim.x;
  int* tokl = reinterpret_cast<int*>(smem + 131072);
  c.tokl = tokl;
  for (int idx = otid(); idx < 8 * 256; idx += NTHR) {
    pg8::Unit u;
    if (c.next(idx >> 8, u)) tokl[idx] = p.tok()[u.pm * 256 + (idx & 255)];
  }
  __syncthreads();
  pg8::gemm_phase_f8((pg8::lds_u8*)smem, c);
}
struct CfgMoe2 {
  static constexpr bool PERM = true;
  int K; const Params* p; int L; int bid, nb;
  DI bool next(int i, pg8::Unit& u) const {
    const int t = i * nb + bid; if (t >= 16 * 4 * 8) return false;
    const int rnd = t >> 8, w = t & 255, xcd = w & 7, jx = w >> 3, pid = rnd * 32 + xcd * 4 + (jx >> 3);
    u.pm = (pid >> 2) * 8 + (jx & 7); u.pn = pid; return true;
  }
  DI const char* a_base(const pg8::Unit& u) const { return (const char*)(p->hid8() + (size_t)u.pm * 256 * 2048); }
  DI const char* b_base(const pg8::Unit& u) const { return (const char*)(p->Wd8() + ((size_t)L * 16 * DM + (size_t)u.pn * 256) * 2048); }
  DI void a_off(const pg8::Unit&, int R0, int C0, int R1, int C1, unsigned (&vo)[4], int) const {
    vo[0] = (unsigned)(R0 * 1024 + C0) * 2u; vo[1] = (unsigned)(R1 * 1024 + C1) * 2u;
    vo[2] = vo[0] + 128u * 1024u * 2u; vo[3] = vo[1] + 128u * 1024u * 2u;
  }
  DI void epi(const f32x4 (&acc)[2][2][4][2], const pg8::Unit& u, int wr, int wc, int fr, int fq) const {
    u16* eo = p->proj();
    const int row0 = u.pm * 256 + wr * 64 + fr, col0 = (u.pn & 3) * 256 + wc * 32 + 8 * fq;
#pragma unroll
    for (int ai = 0; ai < 2; ++ai)
#pragma unroll
      for (int m = 0; m < 4; ++m) {
        const int row = row0 + ai * 128 + m * 16;
        const float gt = p->gate()[row] * (1.f / (F8_HID_SCALE * F8_W_SCALE));
#pragma unroll
        for (int bj = 0; bj < 2; ++bj) {
          const f32x4 a0 = acc[ai][bj][m][0], a1 = acc[ai][bj][m][1];
          uint4 w;
          w.x = pack2(gt * a0[0], gt * a0[1]); w.y = pack2(gt * a0[2], gt * a0[3]);
          w.z = pack2(gt * a1[0], gt * a1[1]); w.w = pack2(gt * a1[2], gt * a1[3]);
          *reinterpret_cast<uint4*>(eo + (size_t)row * DM + col0 + bj * 128) = w;
        }
      }
  }
};
DI void ph_moe2(const Params& p, int L, char* smem) {
  CfgMoe2 c; c.K = 1024; c.p = &p; c.L = L; c.bid = obid(); c.nb = gridDim.x;
  pg8::gemm_phase_f8((pg8::lds_u8*)smem, c);
}
template <bool FINAL>
DI void ph_combine_norm(const Params& p, const float* __restrict__ xa, float* __restrict__ xnew, const float* __restrict__ w,
                        u16* __restrict__ hn_out, float* __restrict__ f_out) {
  const int tid_ = otid(), lane = tid_ & 63, gw = (obid() * NTHR + tid_) >> 6, nw = gridDim.x * (NTHR / 64);
  const u16* eo = p.proj();
  float4 v[4];
  int myrow = -1;
  if (gw < T) {
#pragma unroll
    for (int i = 0; i < 4; ++i) v[i] = *reinterpret_cast<const float4*>(xa + (size_t)gw * DM + (i * 64 + lane) * 4);
    myrow = (lane < 16) ? p.inv()[(size_t)gw * 16 + lane] : -1;
  }
  for (int t = gw; t < T; t += nw) {
    float4 vnx[4];
    const int tn = (t + nw < T) ? (t + nw) : t;
#pragma unroll
    for (int i = 0; i < 4; ++i) vnx[i] = *reinterpret_cast<const float4*>(xa + (size_t)tn * DM + (i * 64 + lane) * 4);
    const int myrow_nx = (lane < 16) ? p.inv()[(size_t)tn * 16 + lane] : -1;
    unsigned long long mask = __builtin_amdgcn_ballot_w64(myrow >= 0);
#pragma unroll 1
    while (mask != 0ull) {
      const int e0 = __builtin_ctzll(mask);
      mask &= mask - 1ull;
      const int r0 = __builtin_amdgcn_readlane(myrow, e0);
      int r1 = -1;
      if (mask != 0ull) { const int e1 = __builtin_ctzll(mask); mask &= mask - 1ull; r1 = __builtin_amdgcn_readlane(myrow, e1); }
      uint2 q0[4], q1[4];
#pragma unroll
      for (int i = 0; i < 4; ++i) q0[i] = *reinterpret_cast<const uint2*>(eo + (size_t)r0 * DM + (i * 64 + lane) * 4);
      const int r1c = (r1 >= 0) ? r1 : r0;
#pragma unroll
      for (int i = 0; i < 4; ++i) q1[i] = *reinterpret_cast<const uint2*>(eo + (size_t)r1c * DM + (i * 64 + lane) * 4);
      const float s1 = (r1 >= 0) ? 1.f : 0.f;
#pragma unroll
      for (int i = 0; i < 4; ++i) {
        v[i].x += __uint_as_float(q0[i].x << 16); v[i].y += __uint_as_float(q0[i].x & 0xffff0000u);
        v[i].z += __uint_as_float(q0[i].y << 16); v[i].w += __uint_as_float(q0[i].y & 0xffff0000u);
        v[i].x += s1 * __uint_as_float(q1[i].x << 16); v[i].y += s1 * __uint_as_float(q1[i].x & 0xffff0000u);
        v[i].z += s1 * __uint_as_float(q1[i].y << 16); v[i].w += s1 * __uint_as_float(q1[i].y & 0xffff0000u);
      }
    }
    float ss = 0.f;
#pragma unroll
    for (int i = 0; i < 4; ++i) ss += v[i].x * v[i].x + v[i].y * v[i].y + v[i].z * v[i].z + v[i].w * v[i].w;
    ss = wave_sum(ss);
    const float rstd = rsqrtf(ss * (1.f / DM) + 1e-6f);
#pragma unroll
    for (int i = 0; i < 4; ++i) {
      const int c = (i * 64 + lane) * 4;
      const float4 ww = *reinterpret_cast<const float4*>(w + c);
      if (FINAL) {
        *reinterpret_cast<float4*>(f_out + (size_t)t * DM + c) = make_float4(v[i].x * rstd * ww.x, v[i].y * rstd * ww.y, v[i].z * rstd * ww.z, v[i].w * rstd * ww.w);
      } else {
        *reinterpret_cast<float4*>(xnew + (size_t)t * DM + c) = v[i];
        uint2 o;
        o.x = pack2(v[i].x * rstd * ww.x, v[i].y * rstd * ww.y);
        o.y = pack2(v[i].z * rstd * ww.z, v[i].w * rstd * ww.w);
        *reinterpret_cast<uint2*>(hn_out + (size_t)t * DM + c) = o;
      }
    }
#pragma unroll
    for (int i = 0; i < 4; ++i) v[i] = vnx[i];
    myrow = myrow_nx;
  }
}

__global__ void __launch_bounds__(NTHR) mk(Params p) {
  extern __shared__ __attribute__((aligned(16))) char smem[];
  cg::grid_group grid = cg::this_grid();
  __shared__ uint4 xb_words;
  if (threadIdx.x == 0) xb_words = make_uint4(0u, 0u, 0u, 0u);
  __syncthreads();
  XcdBarrier xb = xcd_barrier_post(p.bar(), (volatile LAS unsigned*)&xb_words);
  for (int rep = 0; rep < p.rep[0]; ++rep) ph_convert(p, smem);
  ph_rmsnorm_bf16(p.x, p.ln1_w, p.hn());
  xcd_barrier(xb);
  if (p.rep[12] == 0x7fffffff) grid.sync();
  for (int L = 0; L < 2; ++L) {
    const float* xin = (L == 0) ? p.x : p.xres2();
    float* xout = p.xres();
    if (L == 1) {
      for (int rep = 0; rep < p.rep[1]; ++rep) ph_combine_norm<false>(p, p.xres(), p.xres2(), p.ln1_w + DM, p.hn(), nullptr);
      xcd_barrier(xb);
    }
    for (int rp = 0; rp < p.rep[3]; ++rp) {
      for (int rep = 0; rep < p.rep[2]; ++rep) ph_inproj(p, L, smem);
      xcd_barrier(xb);
      ph_post(p, L);
      xcd_barrier(xb);
    }
    for (int rep = 0; rep < p.rep[12]; ++rep) xcd_barrier(xb);
    {
      unsigned* ctr = p.bar() + XCD_BAR_WORDS + 8 + L;
      __shared__ int q1_item;
      for (;;) {
        if (threadIdx.x == 0) q1_item = (int)atomicAdd(ctr, 1u);
        __syncthreads();
        const int it = q1_item;
        __syncthreads();
        if (it >= 1344) break;
        if (it < 256) ph_dil_pass<0>(p, smem, it);
        else if (it < 384) ph_ssd_a(p, L, smem, it - 256);
        else if (it < 576) ph_mla_up_q(p, L, smem, it - 384);
        else if (it < 832) ph_mla_up_kv(p, L, smem, it - 576);
        else ph_ret_a(p, smem, it - 832);
      }
    }
    xcd_barrier(xb);
    for (int rep = 0; rep < p.rep[5]; ++rep) {
      for (int r2 = 0; r2 < p.rep[13]; ++r2) { ph_ret_scan(p); ph_ssd_scan(p); }
      for (int r2 = 0; r2 < p.rep[14]; ++r2) ph_mla_attn(p, smem);
      for (int r2 = 0; r2 < p.rep[15]; ++r2) for (int bi = obid(); bi < 256; bi += gridDim.x) ph_dil_pass<1>(p, smem, bi);
    }
    xcd_barrier(xb);
    {
      unsigned* ctr = p.bar() + XCD_BAR_WORDS + L;
      __shared__ int q_item;
      for (;;) {
        if (threadIdx.x == 0) q_item = (int)atomicAdd(ctr, 1u);
        __syncthreads();
        const int it = q_item;
        __syncthreads();
        if (it >= 640) break;
        if (it < 128) ph_ssd_c(p, L, smem, it);
        else ph_ret_c(p, smem, it - 128);
      }
    }
    xcd_barrier(xb);
    for (int rep = 0; rep < p.rep[7]; ++rep) ph_outproj(p, L, xin, xout, smem);
    xcd_barrier(xb);
    for (int rep = 0; rep < p.rep[8]; ++rep) ph_rms2_router(p, L, xout, smem);
    xcd_barrier(xb);
    for (int rep = 0; rep < p.rep[9]; ++rep) ph_topk(p, smem);
    xcd_barrier(xb);
    for (int rep = 0; rep < p.rep[10]; ++rep) ph_moe1(p, L, smem);
    xcd_barrier(xb);
    for (int rep = 0; rep < p.rep[11]; ++rep) ph_moe2(p, L, smem);
    xcd_barrier(xb);
  }
  ph_combine_norm<true>(p, p.xres(), nullptr, p.final_w, nullptr, p.out);
}

extern "C" void kernel_launch(void* const* d_in, const int* in_sizes, int n_in, void* d_out, int out_size, void* d_ws,
                              size_t ws_size, hipStream_t stream) {
  static int grid_blocks = 0;
  if (!grid_blocks) {
    int dev = 0, cus = 0, per_cu = 0;
    (void)hipGetDevice(&dev);
    (void)hipDeviceGetAttribute(&cus, hipDeviceAttributeMultiprocessorCount, dev);
    (void)hipFuncSetAttribute((const void*)mk, hipFuncAttributeMaxDynamicSharedMemorySize, LDS_BYTES);
    (void)hipOccupancyMaxActiveBlocksPerMultiprocessor(&per_cu, (const void*)mk, NTHR, LDS_BYTES);
    if (per_cu < 1) { fprintf(stderr, "occupancy query says %d blocks/CU\n", per_cu); per_cu = 1; }
    grid_blocks = cus * 1;
  }
  Params p{};
  const float** fp = reinterpret_cast<const float**>(&p);
  for (int i = 0; i < 20; ++i) fp[i] = (const float*)d_in[i];
  p.out = (float*)d_out;
  p.ws = (char*)d_ws;
  const size_t off = WSO.total;
  { const int reps[16] = REPS_INIT; for (int i = 0; i < 16; ++i) p.rep[i] = reps[i]; }
  if (off > ws_size) { fprintf(stderr, "workspace too small: need %zu have %zu\n", off, ws_size); return; }
  (void)hipMemsetAsync(p.bar(), 0, (size_t)(XCD_BAR_WORDS + 64) * 4, stream);
  void* args[] = {&p};
  hipError_t e = hipLaunchCooperativeKernel((void*)mk, dim3(grid_blocks), dim3(NTHR), args, LDS_BYTES, stream);
  if (e != hipSuccess) fprintf(stderr, "cooperative launch failed: %s (grid %d)\n", hipGetErrorString(e), grid_blocks);
}
```

```cpp
#include <hip/hip_runtime.h>
#include <hip/hip_cooperative_groups.h>
#include <cstdio>
#include <cstdint>
namespace cg = cooperative_groups;

#define DI __device__ __forceinline__
typedef unsigned short u16;
typedef __attribute__((ext_vector_type(8))) short bf16x8;
typedef __attribute__((ext_vector_type(4))) float f32x4;

#ifndef REPS_INIT
#define REPS_INIT {1, 1, 1, 1, 1, 1, 1, 1, 1, 1, 1, 1, 0, 1, 1, 1}
#endif
constexpr int NTHR = 512;
constexpr int T = 16384, SEQ = 4096, DM = 1024;
constexpr int PW = 3240, PWP = 3328;
constexpr int C_RQ = 0, C_RK = 256, C_RV = 512, C_RG = 768, C_CQ = 1024, C_CKV = 1280, C_KR = 1408,
              C_Z = 1440, C_XBC = 1696, C_DT = 2464, C_DQ = 2472, C_DK = 2728, C_DV = 2984;
constexpr int LDS_BYTES = 131072 + 8192;

struct WsOff {
  size_t WinT;
  size_t WuqT;
  size_t WukvT;
  size_t WoutT;
  size_t Wgu8;
  size_t Wd8;
  size_t hn8;
  size_t xres;
  size_t hn;
  size_t proj;
  size_t cqn;
  size_t ckvn;
  size_t mq;
  size_t xbc;
  size_t mixed;
  size_t hid8;
  size_t kfull;
  size_t rS;
  size_t sS;
  size_t rU;
  size_t sU;
  size_t cdec;
  size_t vT;
  size_t rtab;
  size_t dpart;
  size_t dtv;
  size_t cs;
  size_t ybuf;
  size_t aff;
  size_t gate;
  size_t tok;
  size_t inv;
  size_t bar;
  size_t xres2;
  size_t total;
};
constexpr WsOff ws_layout() {
  WsOff o{};
  size_t off = 0;
  o.WinT = off; off += (((size_t)2 * PWP * DM * 2) + 255) & ~(size_t)255;
  o.WuqT = off; off += (((size_t)2 * 384 * 256 * 2) + 255) & ~(size_t)255;
  o.WukvT = off; off += (((size_t)2 * 512 * 128 * 2) + 255) & ~(size_t)255;
  o.WoutT = off; off += (((size_t)2 * DM * DM * 2) + 255) & ~(size_t)255;
  o.Wgu8 = off; off += (((size_t)2 * 16 * 4096 * DM) + 255) & ~(size_t)255;
  o.Wd8 = off; off += (((size_t)2 * 16 * DM * 2048) + 255) & ~(size_t)255;
  o.hn8 = off; off += (((size_t)T * DM) + 255) & ~(size_t)255;
  o.xres = off; off += (((size_t)T * DM * 2) + 255) & ~(size_t)255;
  o.hn = off; off += (((size_t)T * DM * 2) + 255) & ~(size_t)255;
  o.proj = off; off += (((size_t)T * PWP * 2) + 255) & ~(size_t)255;
  o.cqn = off; off += (((size_t)T * 256 * 2) + 255) & ~(size_t)255;
  o.ckvn = off; off += (((size_t)T * 128 * 2) + 255) & ~(size_t)255;
  o.mq = off; off += (((size_t)T * 384 * 2) + 255) & ~(size_t)255;
  o.xbc = off; off += (((size_t)T * 768 * 2) + 255) & ~(size_t)255;
  o.mixed = off; off += (((size_t)T * DM * 2) + 255) & ~(size_t)255;
  o.hid8 = off; off += (((size_t)32768 * 2048) + 255) & ~(size_t)255;
  o.kfull = off; off += (((size_t)T * 4 * 96 * 2) + 255) & ~(size_t)255;
  o.rS = off; off += (((size_t)16 * 32 * 2 * 4096 * 2) + 255) & ~(size_t)255;
  o.sS = off; off += (((size_t)128 * 8 * 8192 * 2) + 255) & ~(size_t)255;
  o.rU = off; off += (((size_t)16 * 32 * 2 * 4096 * 4) + 255) & ~(size_t)255;
  o.sU = off; off += (((size_t)128 * 8 * 8192 * 4) + 255) & ~(size_t)255;
  o.cdec = off; off += (((size_t)128 * 8 * 4) + 255) & ~(size_t)255;
  o.vT = off; off += (((size_t)T * 4 * 64 * 2) + 255) & ~(size_t)255;
  o.rtab = off; off += (((size_t)SEQ * 56 * 2 * 4) + 255) & ~(size_t)255;
  o.dpart = off; off += (((size_t)T * 4 * 68 * 4) + 255) & ~(size_t)255;
  o.dtv = off; off += (((size_t)T * 8 * 4) + 255) & ~(size_t)255;
  o.cs = off; off += (((size_t)T * 8 * 4) + 255) & ~(size_t)255;
  o.ybuf = off; off += (((size_t)T * 256 * 4) + 255) & ~(size_t)255;
  o.aff = off; off += (((size_t)T * 16 * 4) + 255) & ~(size_t)255;
  o.gate = off; off += (((size_t)64 * 512 * 4) + 255) & ~(size_t)255;
  o.tok = off; off += (((size_t)64 * 512 * 4) + 255) & ~(size_t)255;
  o.inv = off; off += (((size_t)T * 16 * 4) + 255) & ~(size_t)255;
  o.bar = off; off += (((size_t)(3456 + 64) * 4) + 255) & ~(size_t)255;
  o.xres2 = off; off += (((size_t)T * DM * 2) + 255) & ~(size_t)255;
  o.total = off;
  return o;
}
constexpr WsOff WSO = ws_layout();
struct Params {
  const float *x, *ln1_w, *w_in, *q_norm_w, *kv_norm_w, *w_uq, *w_ukv, *conv_w, *conv_b, *a_log, *dt_bias,
      *ssm_d, *ssm_norm_w, *w_out, *ln2_w, *router_w, *w_gate, *w_up, *w_down, *final_w;
  float* out;
  char* ws;
  int rep[16];
  __host__ DI u16* WinT() const { return reinterpret_cast<u16*>(ws + WSO.WinT); }
  __host__ DI u16* WuqT() const { return reinterpret_cast<u16*>(ws + WSO.WuqT); }
  __host__ DI u16* WukvT() const { return reinterpret_cast<u16*>(ws + WSO.WukvT); }
  __host__ DI u16* WoutT() const { return reinterpret_cast<u16*>(ws + WSO.WoutT); }
  __host__ DI unsigned char* Wgu8() const { return reinterpret_cast<unsigned char*>(ws + WSO.Wgu8); }
  __host__ DI unsigned char* Wd8() const { return reinterpret_cast<unsigned char*>(ws + WSO.Wd8); }
  __host__ DI unsigned char* hn8() const { return reinterpret_cast<unsigned char*>(ws + WSO.hn8); }
  __host__ DI u16* xres() const { return reinterpret_cast<u16*>(ws + WSO.xres); }
  __host__ DI u16* hn() const { return reinterpret_cast<u16*>(ws + WSO.hn); }
  __host__ DI u16* proj() const { return reinterpret_cast<u16*>(ws + WSO.proj); }
  __host__ DI u16* cqn() const { return reinterpret_cast<u16*>(ws + WSO.cqn); }
  __host__ DI u16* ckvn() const { return reinterpret_cast<u16*>(ws + WSO.ckvn); }
  __host__ DI u16* mq() const { return reinterpret_cast<u16*>(ws + WSO.mq); }
  __host__ DI u16* xbc() const { return reinterpret_cast<u16*>(ws + WSO.xbc); }
  __host__ DI u16* mixed() const { return reinterpret_cast<u16*>(ws + WSO.mixed); }
  __host__ DI unsigned char* hid8() const { return reinterpret_cast<unsigned char*>(ws + WSO.hid8); }
  __host__ DI u16* kfull() const { return reinterpret_cast<u16*>(ws + WSO.kfull); }
  __host__ DI u16* rS() const { return reinterpret_cast<u16*>(ws + WSO.rS); }
  __host__ DI u16* sS() const { return reinterpret_cast<u16*>(ws + WSO.sS); }
  __host__ DI float* rU() const { return reinterpret_cast<float*>(ws + WSO.rU); }
  __host__ DI float* sU() const { return reinterpret_cast<float*>(ws + WSO.sU); }
  __host__ DI float* cdec() const { return reinterpret_cast<float*>(ws + WSO.cdec); }
  __host__ DI u16* vT() const { return reinterpret_cast<u16*>(ws + WSO.vT); }
  __host__ DI float* rtab() const { return reinterpret_cast<float*>(ws + WSO.rtab); }
  __host__ DI float* dpart() const { return reinterpret_cast<float*>(ws + WSO.dpart); }
  __host__ DI float* dtv() const { return reinterpret_cast<float*>(ws + WSO.dtv); }
  __host__ DI float* cs() const { return reinterpret_cast<float*>(ws + WSO.cs); }
  __host__ DI float* ybuf() const { return reinterpret_cast<float*>(ws + WSO.ybuf); }
  __host__ DI float* aff() const { return reinterpret_cast<float*>(ws + WSO.aff); }
  __host__ DI float* gate() const { return reinterpret_cast<float*>(ws + WSO.gate); }
  __host__ DI int* tok() const { return reinterpret_cast<int*>(ws + WSO.tok); }
  __host__ DI int* inv() const { return reinterpret_cast<int*>(ws + WSO.inv); }
  __host__ DI unsigned* bar() const { return reinterpret_cast<unsigned*>(ws + WSO.bar); }
  __host__ DI u16* xres2() const { return reinterpret_cast<u16*>(ws + WSO.xres2); }
};


typedef __attribute__((ext_vector_type(2))) __bf16 bf16x2_t;
typedef __attribute__((ext_vector_type(2))) float f32x2_t;
typedef __attribute__((ext_vector_type(16))) float f32x16;
typedef __attribute__((ext_vector_type(4))) short s16x4;
typedef __attribute__((ext_vector_type(8))) int i32x8;
typedef __attribute__((ext_vector_type(4))) int i32x4;
DI unsigned pack2(float a, float b) {
  f32x2_t v = {a, b};
  return __builtin_bit_cast(unsigned, __builtin_convertvector(v, bf16x2_t));
}
DI u16 f2bf(float f) { return (u16)(pack2(f, 0.f) & 0xffffu); }
DI float bf2f(u16 h) { return __uint_as_float(((unsigned)h) << 16); }
DI void unpack8(const uint4& v, float* f) {
  f[0] = __uint_as_float(v.x << 16); f[1] = __uint_as_float(v.x & 0xffff0000u);
  f[2] = __uint_as_float(v.y << 16); f[3] = __uint_as_float(v.y & 0xffff0000u);
  f[4] = __uint_as_float(v.z << 16); f[5] = __uint_as_float(v.z & 0xffff0000u);
  f[6] = __uint_as_float(v.w << 16); f[7] = __uint_as_float(v.w & 0xffff0000u);
}
DI void ld8(const u16* p, float* f) { uint4 v = *reinterpret_cast<const uint4*>(p); unpack8(v, f); }
DI unsigned pk4_f8(float a, float b, float c, float d) {
  a = __builtin_amdgcn_fmed3f(a, -448.f, 448.f); b = __builtin_amdgcn_fmed3f(b, -448.f, 448.f);
  c = __builtin_amdgcn_fmed3f(c, -448.f, 448.f); d = __builtin_amdgcn_fmed3f(d, -448.f, 448.f);
  int w = __builtin_amdgcn_cvt_pk_fp8_f32(a, b, 0, false);
  w = __builtin_amdgcn_cvt_pk_fp8_f32(c, d, w, true);
  return (unsigned)w;
}
constexpr float F8_W_SCALE = 256.f, F8_H_SCALE = 16.f, F8_HID_SCALE = 8.f;
DI float4 bf4_to_f4(const uint2& q) {
  return make_float4(__uint_as_float(q.x << 16), __uint_as_float(q.x & 0xffff0000u), __uint_as_float(q.y << 16), __uint_as_float(q.y & 0xffff0000u));
}
DI float wave_sum(float v) {
#pragma unroll
  for (int o = 32; o > 0; o >>= 1) v += __shfl_xor(v, o);
  return v;
}
DI float dot2acc(unsigned a, unsigned b, float c) {
  return __builtin_amdgcn_fdot2_f32_bf16(__builtin_bit_cast(bf16x2_t, a), __builtin_bit_cast(bf16x2_t, b), c, false);
}
DI float dot8(const uint4& a, const uint4& b, float c) {
  c = dot2acc(a.x, b.x, c); c = dot2acc(a.y, b.y, c); c = dot2acc(a.z, b.z, c); c = dot2acc(a.w, b.w, c);
  return c;
}
DI int otid() { int t = threadIdx.x; asm volatile("" : "+v"(t)); return t; }
DI int obid() { int b = blockIdx.x; asm volatile("" : "+s"(b)); return b; }
DI float silu(float x) { return x / (1.f + __expf(-x)); }
DI float fast_silu(float x) { return x * __builtin_amdgcn_rcpf(1.f + __expf(-x)); }


#define XB_TMO      128
#define XB_XCNT(j)  (256  + 64 * (j))
#define XB_XSUB(j)  (1280 + 64 * (j))
#define XB_XGEN(j)  (2304 + 64 * (j))
#define XB_TOP      3328
#define XB_TOPGEN   3392
#define XCD_BAR_WORDS 3456
#define XB_SPIN_CAP (1u << 20)
#define LAS __attribute__((address_space(3)))
DI unsigned xb_ld(unsigned* p) { return __hip_atomic_load(p, __ATOMIC_RELAXED, __HIP_MEMORY_SCOPE_AGENT); }
DI unsigned xb_add(unsigned* p, unsigned v) { return __hip_atomic_fetch_add(p, v, __ATOMIC_RELAXED, __HIP_MEMORY_SCOPE_AGENT); }
DI unsigned xb_xcc_id() { return (unsigned)__builtin_amdgcn_s_getreg((3 << 11) | 20) & 0xFu; }
#define XB_SPIN(cond, bar) do { unsigned _sp = 0; while (cond) { __builtin_amdgcn_s_sleep(1); \
    if ((++_sp & 255u) == 0u) { if (xb_ld(&(bar)[XB_TMO])) break; if (_sp > XB_SPIN_CAP) { atomicAdd(&(bar)[XB_TMO], 1u); break; } } } } while (0)
struct XcdBarrier { unsigned* bar; unsigned x; volatile LAS unsigned* st; };
DI XcdBarrier xcd_barrier_post(unsigned* bar, volatile LAS unsigned* st) {
  XcdBarrier b; b.bar = bar; b.x = xb_xcc_id(); b.st = st;
  if (threadIdx.x == 0) (void)xb_add(&bar[XB_XCNT(b.x)], 1u);
  return b;
}
DI void xcd_barrier_complete(unsigned* bar, unsigned x, unsigned& nloc, unsigned& nx) {
  const unsigned G = gridDim.x * gridDim.y * gridDim.z;
  unsigned sum, cnt, mine, sp = 0u;
  for (;;) {
    sum = 0u; cnt = 0u; mine = 0u;
#pragma unroll
    for (unsigned j = 0; j < 16; ++j) { const unsigned c = xb_ld(&bar[XB_XCNT(j)]); sum += c; cnt += (c > 0u) ? 1u : 0u; mine = (j == x) ? c : mine; }
    if (sum == G) break;
    __builtin_amdgcn_s_sleep(1);
    if ((++sp & 255u) == 0u) { if (xb_ld(&bar[XB_TMO])) break; if (sp > XB_SPIN_CAP) { atomicAdd(&bar[XB_TMO], 1u); break; } }
  }
  nloc = mine > 0u ? mine : 1u; nx = cnt > 0u ? cnt : 1u;
}
DI void xcd_barrier(const XcdBarrier& b) {
  asm volatile("s_waitcnt vmcnt(0)" ::: "memory");
  __syncthreads();
  if (threadIdx.x == 0) {
    unsigned* bar = b.bar;
    __builtin_amdgcn_s_waitcnt(0);
    unsigned nloc = b.st[0], nx = b.st[1];
    if (nloc == 0u) { xcd_barrier_complete(bar, b.x, nloc, nx); b.st[0] = nloc; b.st[1] = nx; }
    const unsigned old = xb_add(&bar[XB_XSUB(b.x)], 1u);
    const unsigned gen = old / nloc;
    if (old + 1u == (gen + 1u) * nloc) {
      __builtin_amdgcn_fence(__ATOMIC_RELEASE, "agent");
      asm volatile("s_waitcnt vmcnt(0)" ::: "memory");
      const unsigned og = xb_add(&bar[XB_TOP], 1u);
      const unsigned tg = og / nx;
      if (og + 1u == (tg + 1u) * nx) xb_add(&bar[XB_TOPGEN], 1u);
      else XB_SPIN(xb_ld(&bar[XB_TOPGEN]) == tg, bar);
      __builtin_amdgcn_fence(__ATOMIC_ACQUIRE, "agent");
      xb_add(&bar[XB_XGEN(b.x)], 1u);
      asm volatile("s_waitcnt vmcnt(0)" ::: "memory");
    } else {
      XB_SPIN(xb_ld(&bar[XB_XGEN(b.x)]) == gen, bar);
      __builtin_amdgcn_fence(__ATOMIC_ACQUIRE, "agent");
      asm volatile("s_waitcnt vmcnt(0)" ::: "memory");
    }
  }
  __syncthreads();
}

template <class F>
DI void transpose_convert(const float* __restrict__ src, int K, int N, int Npad, u16* __restrict__ dst, F rowmap,
                          int bid, int nb, char* smem) {
  u16* tile = reinterpret_cast<u16*>(smem);
  const int tid = otid();
  const int ntn = Npad / 128, ntk = K / 64;
  for (int t = bid; t < ntn * ntk; t += nb) {
    const int n0 = (t % ntn) * 128, k0 = (t / ntn) * 64;
    f32x4 v[4];
#pragma unroll
    for (int i = 0; i < 4; ++i) {
      const int kk = (tid >> 5) + 16 * i, nn = (tid & 31) * 4;
      v[i] = f32x4{0.f, 0.f, 0.f, 0.f};
      if (n0 + nn < N) v[i] = __builtin_nontemporal_load(reinterpret_cast<const f32x4*>(src + (size_t)(k0 + kk) * N + n0 + nn));
    }
#pragma unroll
    for (int i = 0; i < 4; ++i) {
      const int kk = (tid >> 5) + 16 * i, nn = (tid & 31) * 4;
      tile[(nn + 0) * 72 + kk] = f2bf(v[i][0]); tile[(nn + 1) * 72 + kk] = f2bf(v[i][1]);
      tile[(nn + 2) * 72 + kk] = f2bf(v[i][2]); tile[(nn + 3) * 72 + kk] = f2bf(v[i][3]);
    }
    __syncthreads();
#pragma unroll
    for (int j = 0; j < 2; ++j) {
      const int c = tid + NTHR * j, nn = c >> 3, k8 = (c & 7) * 8;
      const uint4 o = *reinterpret_cast<const uint4*>(tile + nn * 72 + k8);
      *reinterpret_cast<uint4*>(dst + (size_t)rowmap(n0 + nn) * K + k0 + k8) = o;
    }
    __syncthreads();
  }
}

template <class F>
DI void transpose_convert_f8(const float* __restrict__ src, int K, int N, unsigned char* __restrict__ dst, F rowmap,
                             int bid, int nb, char* smem) {
  unsigned char* tile = reinterpret_cast<unsigned char*>(smem);
  const int tid = otid();
  const int ntn = N / 128, ntk = K / 64;
  for (int t = bid; t < ntn * ntk; t += nb) {
    const int n0 = (t % ntn) * 128, k0 = (t / ntn) * 64;
    const int kq = (tid >> 5) * 4, nn = (tid & 31) * 4;
    f32x4 v[4];
#pragma unroll
    for (int r = 0; r < 4; ++r) v[r] = __builtin_nontemporal_load(reinterpret_cast<const f32x4*>(src + (size_t)(k0 + kq + r) * N + n0 + nn));
#pragma unroll
    for (int e = 0; e < 4; ++e)
      *reinterpret_cast<unsigned*>(tile + (nn + e) * 80 + kq) =
          pk4_f8(v[0][e] * F8_W_SCALE, v[1][e] * F8_W_SCALE, v[2][e] * F8_W_SCALE, v[3][e] * F8_W_SCALE);
    __syncthreads();
    {
      const int rn = tid >> 2, kc = (tid & 3) * 16;
      const uint4 o = *reinterpret_cast<const uint4*>(tile + rn * 80 + kc);
      *reinterpret_cast<uint4*>(dst + (size_t)rowmap(n0 + rn) * K + k0 + kc) = o;
    }
    __syncthreads();
  }
}

DI void ph_convert(const Params& p, char* smem) {
  const int nb = gridDim.x;
  int bid = obid();
  for (int idx = bid * NTHR + otid(); idx < SEQ * 56; idx += nb * NTHR) {
    const int pos = idx / 56, f = idx - pos * 56;
    float inv;
    if (f < 32) inv = exp2f(-(float)f * (13.287712379549449f / 32.f));
    else if (f < 40) inv = exp2f(-(float)(f - 32) * (18.931568569324174f / 8.f));
    else inv = exp2f(-(float)(f - 40) * (18.931568569324174f / 16.f));
    float sn, cs;
    sincosf((float)pos * inv, &sn, &cs);
    p.rtab()[(size_t)idx * 2] = cs;
    p.rtab()[(size_t)idx * 2 + 1] = sn;
  }
  auto ident = [](int n) { return n; };
  for (int L = 0; L < 2; ++L) {
    transpose_convert(p.w_in + (size_t)L * DM * PW, DM, PW, PWP, p.WinT() + (size_t)L * PWP * DM, ident, bid, nb, smem);
    transpose_convert(p.w_uq + (size_t)L * 256 * 384, 256, 384, 384, p.WuqT() + (size_t)L * 384 * 256, ident, bid, nb, smem);
    transpose_convert(p.w_ukv + (size_t)L * 128 * 512, 128, 512, 512, p.WukvT() + (size_t)L * 512 * 128, ident, bid, nb, smem);
    transpose_convert(p.w_out + (size_t)L * DM * DM, DM, DM, DM, p.WoutT() + (size_t)L * DM * DM, ident, bid, nb, smem);
    for (int e = 0; e < 16; ++e) {
      const size_t le = (size_t)(L * 16 + e);
      auto gmap = [](int n) { return (n >> 7) * 256 + (n & 127); };
      auto umap = [](int n) { return (n >> 7) * 256 + 128 + (n & 127); };
      transpose_convert_f8(p.w_gate + le * DM * 2048, DM, 2048, p.Wgu8() + le * 4096 * DM, gmap, bid, nb, smem);
      transpose_convert_f8(p.w_up + le * DM * 2048, DM, 2048, p.Wgu8() + le * 4096 * DM, umap, bid, nb, smem);
      transpose_convert_f8(p.w_down + le * 2048 * DM, 2048, DM, p.Wd8() + le * DM * 2048, ident, bid, nb, smem);
    }
  }
}

template <class RowPtr, class Epi>
DI void gemm_tile(RowPtr arow, const u16* __restrict__ bt, int ldb, int K, char* smem, Epi epi) {
  u16* sa = reinterpret_cast<u16*>(smem);
  u16* sb = sa + 2 * 256 * 72;
  const int tid = otid(), wid = tid >> 6, lane = tid & 63, wr = wid >> 1, wc = wid & 1, fr = lane & 15, fq = lane >> 4;
  f32x4 acc[4][4];
#pragma unroll
  for (int m = 0; m < 4; ++m)
#pragma unroll
    for (int n = 0; n < 4; ++n) acc[m][n] = f32x4{0.f, 0.f, 0.f, 0.f};
  const int lr = tid >> 3, lc = (tid & 7) * 8;
  const u16* ap[4];
#pragma unroll
  for (int i = 0; i < 4; ++i) ap[i] = arow(lr + 64 * i) + lc;
  const u16* bp[2];
#pragma unroll
  for (int i = 0; i < 2; ++i) bp[i] = bt + (size_t)(lr + 64 * i) * ldb + lc;
  uint4 ra[4], rb[2];
  const int nk = K / 64;
#pragma unroll
  for (int i = 0; i < 4; ++i) ra[i] = *reinterpret_cast<const uint4*>(ap[i]);
#pragma unroll
  for (int i = 0; i < 2; ++i) rb[i] = *reinterpret_cast<const uint4*>(bp[i]);
#pragma unroll
  for (int i = 0; i < 4; ++i) *reinterpret_cast<uint4*>(sa + (lr + 64 * i) * 72 + lc) = ra[i];
#pragma unroll
  for (int i = 0; i < 2; ++i) *reinterpret_cast<uint4*>(sb + (lr + 64 * i) * 72 + lc) = rb[i];
  __syncthreads();
  for (int kt = 0; kt < nk; ++kt) {
    const int cur = kt & 1;
    if (kt + 1 < nk) {
#pragma unroll
      for (int i = 0; i < 4; ++i) ra[i] = *reinterpret_cast<const uint4*>(ap[i] + (kt + 1) * 64);
#pragma unroll
      for (int i = 0; i < 2; ++i) rb[i] = *reinterpret_cast<const uint4*>(bp[i] + (kt + 1) * 64);
    }
    const u16* ca = sa + cur * 256 * 72;
    const u16* cb = sb + cur * 128 * 72;
#pragma unroll
    for (int kk = 0; kk < 2; ++kk) {
      bf16x8 af[4], bfr[4];
#pragma unroll
      for (int m = 0; m < 4; ++m) af[m] = *reinterpret_cast<const bf16x8*>(ca + (wr * 64 + m * 16 + fr) * 72 + kk * 32 + fq * 8);
#pragma unroll
      for (int n = 0; n < 4; ++n) bfr[n] = *reinterpret_cast<const bf16x8*>(cb + (wc * 64 + n * 16 + fr) * 72 + kk * 32 + fq * 8);
#pragma unroll
      for (int m = 0; m < 4; ++m)
#pragma unroll
        for (int n = 0; n < 4; ++n) acc[m][n] = __builtin_amdgcn_mfma_f32_16x16x32_bf16(af[m], bfr[n], acc[m][n], 0, 0, 0);
    }
    if (kt + 1 < nk) {
      u16* na = sa + (cur ^ 1) * 256 * 72;
      u16* nbp = sb + (cur ^ 1) * 128 * 72;
#pragma unroll
      for (int i = 0; i < 4; ++i) *reinterpret_cast<uint4*>(na + (lr + 64 * i) * 72 + lc) = ra[i];
#pragma unroll
      for (int i = 0; i < 2; ++i) *reinterpret_cast<uint4*>(nbp + (lr + 64 * i) * 72 + lc) = rb[i];
    }
    __syncthreads();
  }
  epi(acc, wr, wc, fr, fq);
}

#define WAIT_V(n) asm volatile("s_waitcnt vmcnt(%0)" ::"n"(n) : "memory")
DI int lds_byte2(int r, int c) {
  const int st = (r >> 4) * 2 + (c >> 5), ob = (r & 15) * 64 + (c & 31) * 2;
  return st * 1024 + (ob ^ (((ob >> 9) & 1) << 5));
}
DI void stage_rc2(int b, int& R, int& C) {
  const int st = b >> 10, sb = b & 1023, swz = sb ^ (((sb >> 9) & 1) << 5);
  R = (st >> 1) * 16 + swz / 64;
  C = (st & 1) * 32 + (swz % 64) / 2;
}
typedef __attribute__((address_space(3))) unsigned lds_u32;
template <class RowPtr, class Epi>
DI void gemm256(RowPtr arow, const u16* __restrict__ bt, int ldb, int K, char* smem, Epi epi) {
  constexpr int TILE_B = 256 * 64 * 2, STAGE_B = 2 * TILE_B;
  const int tid = otid(), wid = tid >> 6, lane = tid & 63, wr = wid >> 2, wc = wid & 3, fr = lane & 15, fq = lane >> 4;
  const u16* ap[4];
  const u16* bp[4];
#pragma unroll
  for (int i = 0; i < 4; ++i) {
    int R, C;
    stage_rc2(wid * 1024 + i * 8192 + lane * 16, R, C);
    ap[i] = arow(R) + C;
    bp[i] = bt + (size_t)R * ldb + C;
  }
  f32x4 acc[8][4];
#pragma unroll
  for (int m = 0; m < 8; ++m)
#pragma unroll
    for (int n = 0; n < 4; ++n) acc[m][n] = f32x4{0.f, 0.f, 0.f, 0.f};
#define G2_STAGE(buf, kt)                                                                                              \
  do {                                                                                                                 \
    _Pragma("unroll") for (int i = 0; i < 4; ++i) {                                                                    \
      __builtin_amdgcn_global_load_lds((const unsigned*)(ap[i] + (kt) * 64),                                           \
                                       (lds_u32*)(smem + (buf) * STAGE_B + wid * 1024 + i * 8192), 16, 0, 0);          \
      __builtin_amdgcn_global_load_lds((const unsigned*)(bp[i] + (kt) * 64),                                           \
                                       (lds_u32*)(smem + (buf) * STAGE_B + TILE_B + wid * 1024 + i * 8192), 16, 0, 0); \
    }                                                                                                                  \
  } while (0)
  const int nt = K / 64;
  G2_STAGE(0, 0);
  WAIT_V(0);
  __syncthreads();
  for (int t = 0; t < nt; ++t) {
    const int cur = t & 1;
    if (t + 1 < nt) G2_STAGE(cur ^ 1, t + 1);
    const char* sA = smem + cur * STAGE_B;
    const char* sB = sA + TILE_B;
#pragma unroll
    for (int ks = 0; ks < 2; ++ks) {
      bf16x8 At[8], Bf[4];
#pragma unroll
      for (int m = 0; m < 8; ++m) At[m] = *reinterpret_cast<const bf16x8*>(sA + lds_byte2(wr * 128 + m * 16 + fr, ks * 32 + fq * 8));
#pragma unroll
      for (int n = 0; n < 4; ++n) Bf[n] = *reinterpret_cast<const bf16x8*>(sB + lds_byte2(wc * 64 + n * 16 + fr, ks * 32 + fq * 8));
#pragma unroll
      for (int m = 0; m < 8; ++m)
#pragma unroll
        for (int n = 0; n < 4; ++n) acc[m][n] = __builtin_amdgcn_mfma_f32_16x16x32_bf16(Bf[n], At[m], acc[m][n], 0, 0, 0);
      __builtin_amdgcn_sched_barrier(0);
    }
    WAIT_V(0);
    __syncthreads();
  }
  epi(acc, wr, wc, fr, fq);
}

namespace pg8 {
constexpr int BM = 256, BK = 64, HALF = 128, HTB = HALF * BK * 2;
DI int lds_byte(int r, int c) { const int st = (r >> 4) * 2 + (c >> 5), rr = r & 15, cc = c & 31, ob = rr * 64 + cc * 2; return st * 1024 + (ob ^ (((ob >> 9) & 1) << 5)); }
DI void stage_rc(int b, int& R, int& C) { const int st = b / 1024, sb = b % 1024, swz = sb ^ (((sb >> 9) & 1) << 5); R = (st >> 1) * 16 + swz / 64; C = (st & 1) * 32 + (swz % 64) / 2; }
DI int perm32(int rho) { const int n = rho >> 4, i = rho & 15; return 8 * (i >> 2) + 4 * n + (i & 3); }
struct Unit { int pm, pn; };
typedef __attribute__((address_space(3))) unsigned char lds_u8;
typedef __attribute__((address_space(3))) unsigned lds_u32;
typedef __attribute__((address_space(3))) bf16x8 lds_bf16x8;
typedef __attribute__((address_space(3))) i32x4 lds_i32x4;

template <class Cfg>
DI void gemm_phase(lds_u8* lds, const Cfg& S) {
  const int tid = otid(), wid = __builtin_amdgcn_readfirstlane(tid >> 6), lane = tid & 63, wr = wid >> 2, wc = wid & 3, fr = lane & 15, fq = lane >> 4;
  const int K = S.K, nt = K / BK;
  int R0, C0, R1, C1;
  stage_rc(tid * 16, R0, C0);
  stage_rc(tid * 16 + 8192, R1, C1);
  unsigned voffB[2];
  {
    const int Rb0 = Cfg::PERM ? ((R0 & ~31) + perm32(R0 & 31)) : R0, Rb1 = Cfg::PERM ? ((R1 & ~31) + perm32(R1 & 31)) : R1;
    voffB[0] = (unsigned)(Rb0 * K + C0) * 2u; voffB[1] = (unsigned)(Rb1 * K + C1) * 2u;
  }
  const size_t kstep = (size_t)(BK * 2);
  const size_t hstep = (size_t)HALF * K * 2;
  const unsigned ldsw = (unsigned)wid * 1024u;
  const int aoff = lds_byte(wr * 64 + fr, fq * 8), boff = lds_byte(wc * 32 + fr, fq * 8);
#define PG8_SA(b, h) (((b) * 2 + (h)) * HTB)
#define PG8_SB(b, h) ((4 + (b) * 2 + (h)) * HTB)
#define PG8_STAGE2(bufoff, gbase, o0, o1) do { \
    __builtin_amdgcn_global_load_lds((const unsigned*)((const char*)(gbase) + (o0)), (lds_u32*)(lds + (bufoff) + ldsw), 16, 0, 0); \
    __builtin_amdgcn_global_load_lds((const unsigned*)((const char*)(gbase) + (o1)), (lds_u32*)(lds + (bufoff) + ldsw + 8192), 16, 0, 0); } while (0)
#define PG8_STAGEB(bufoff, gbase) PG8_STAGE2(bufoff, gbase, voffB[0], voffB[1])
#define PG8_LDA(dst, b, h) do { _Pragma("unroll") for (int m = 0; m < 4; ++m) _Pragma("unroll") for (int k = 0; k < 2; ++k) dst[m][k] = *(const lds_bf16x8*)(lds + PG8_SA(b, h) + aoff + m * 2048 + k * 1024); } while (0)
#define PG8_LDB(dst, b, h) do { _Pragma("unroll") for (int n = 0; n < 2; ++n) _Pragma("unroll") for (int k = 0; k < 2; ++k) dst[n][k] = *(const lds_bf16x8*)(lds + PG8_SB(b, h) + boff + n * 2048 + k * 1024); } while (0)
#define PG8_MMA(ai, bj, At, Bt) do { __builtin_amdgcn_s_setprio(1); _Pragma("unroll") for (int m = 0; m < 4; ++m) _Pragma("unroll") for (int n = 0; n < 2; ++n) _Pragma("unroll") for (int k = 0; k < 2; ++k) \
    acc[ai][bj][m][n] = __builtin_amdgcn_mfma_f32_16x16x32_bf16(Bt[n][k], At[m][k], acc[ai][bj][m][n], 0, 0, 0); __builtin_amdgcn_s_setprio(0); } while (0)
#define PG8_WAIT_V(n) asm volatile("s_waitcnt vmcnt(" #n ")" ::: "memory")
#define PG8_WAIT_L(n) asm volatile("s_waitcnt lgkmcnt(" #n ")" ::: "memory")
#define PG8_BAR __builtin_amdgcn_s_barrier()
#define PG8_SCHED __builtin_amdgcn_sched_barrier(0)
  Unit cur, nxt; int ui = 0;
  if (!S.next(0, cur)) return;
  f32x4 acc[2][2][4][2];
#pragma unroll
  for (int a = 0; a < 2; ++a)
#pragma unroll
    for (int b = 0; b < 2; ++b)
#pragma unroll
      for (int m = 0; m < 4; ++m)
#pragma unroll
        for (int n = 0; n < 2; ++n) acc[a][b][m][n] = f32x4{0.f, 0.f, 0.f, 0.f};
  bf16x8 At[4][2], B0[2][2], B1[2][2];
  const char* cA = S.a_base(cur);
  const char* cB = S.b_base(cur);
  unsigned vc[4], vn[4];
  S.a_off(cur, R0, C0, R1, C1, vc);
  PG8_STAGEB(PG8_SB(0, 0), cB); PG8_STAGE2(PG8_SA(0, 0), cA, vc[0], vc[1]); PG8_STAGEB(PG8_SB(0, 1), cB + hstep); PG8_STAGE2(PG8_SA(0, 1), cA, vc[2], vc[3]);
  if (wr == 1) PG8_BAR;
  PG8_WAIT_V(4); PG8_BAR;
  PG8_STAGEB(PG8_SB(1, 0), cB + kstep); PG8_STAGE2(PG8_SA(1, 0), cA + kstep, vc[0], vc[1]); PG8_STAGEB(PG8_SB(1, 1), cB + hstep + kstep);
  PG8_WAIT_V(6); PG8_BAR;
  for (;;) {
    const bool has_next = S.next(ui + 1, nxt);
    const char* nA = has_next ? S.a_base(nxt) : cA;
    const char* nB = has_next ? S.b_base(nxt) : cB;
    if (has_next) S.a_off(nxt, R0, C0, R1, C1, vn);
    else { vn[0] = vc[0]; vn[1] = vc[1]; vn[2] = vc[2]; vn[3] = vc[3]; }
    for (int t = 0; t < nt; t += 2) {
      const bool last = (t == nt - 2);
      const char* a1 = cA + (size_t)(t + 1) * kstep;
      const char* a2 = last ? nA : cA + (size_t)(t + 2) * kstep;
      const char* b2 = last ? nB : cB + (size_t)(t + 2) * kstep;
      const char* a3 = a2 + kstep;
      const char* b3 = b2 + kstep;
      const unsigned w0 = last ? vn[0] : vc[0], w1 = last ? vn[1] : vc[1], w2 = last ? vn[2] : vc[2], w3 = last ? vn[3] : vc[3];
      PG8_LDB(B0, 0, 0); PG8_SCHED; PG8_LDA(At, 0, 0); PG8_STAGE2(PG8_SA(1, 1), a1, vc[2], vc[3]);
      PG8_WAIT_L(8); PG8_BAR; PG8_WAIT_L(0); PG8_MMA(0, 0, At, B0); PG8_BAR; PG8_SCHED;
      PG8_LDB(B1, 0, 1); PG8_STAGEB(PG8_SB(0, 0), b2);
      PG8_BAR; PG8_WAIT_L(0); PG8_MMA(0, 1, At, B1); PG8_BAR;
      PG8_LDA(At, 0, 1); PG8_STAGE2(PG8_SA(0, 0), a2, w0, w1);
      PG8_BAR; PG8_WAIT_L(0); PG8_MMA(1, 0, At, B0); PG8_BAR; PG8_SCHED;
      PG8_STAGEB(PG8_SB(0, 1), b2 + hstep);
      PG8_WAIT_V(6); PG8_BAR; PG8_MMA(1, 1, At, B1); PG8_BAR;
      PG8_LDB(B0, 1, 0); PG8_SCHED; PG8_LDA(At, 1, 0); PG8_STAGE2(PG8_SA(0, 1), a2, w2, w3);
      PG8_WAIT_L(8); PG8_BAR; PG8_WAIT_L(0); PG8_MMA(0, 0, At, B0); PG8_BAR; PG8_SCHED;
      PG8_LDB(B1, 1, 1); PG8_STAGEB(PG8_SB(1, 0), b3);
      PG8_BAR; PG8_WAIT_L(0); PG8_MMA(0, 1, At, B1); PG8_BAR;
      PG8_LDA(At, 1, 1); PG8_STAGE2(PG8_SA(1, 0), a3, w0, w1);
      PG8_BAR; PG8_WAIT_L(0); PG8_MMA(1, 0, At, B0); PG8_BAR; PG8_SCHED;
      PG8_STAGEB(PG8_SB(1, 1), b3 + hstep);
      PG8_WAIT_V(6); PG8_BAR; PG8_MMA(1, 1, At, B1); PG8_BAR;
    }
    S.epi(acc, cur, wr, wc, fr, fq);
    if (!has_next) break;
#pragma unroll
    for (int a = 0; a < 2; ++a)
#pragma unroll
      for (int b = 0; b < 2; ++b)
#pragma unroll
        for (int m = 0; m < 4; ++m)
#pragma unroll
          for (int n = 0; n < 2; ++n) acc[a][b][m][n] = f32x4{0.f, 0.f, 0.f, 0.f};
    cur = nxt; cA = nA; cB = nB; ++ui;
    vc[0] = vn[0]; vc[1] = vn[1]; vc[2] = vn[2]; vc[3] = vn[3];
  }
  PG8_WAIT_V(0);
  if (wr == 0) PG8_BAR;
  PG8_BAR;
#undef PG8_SA
#undef PG8_SB
#undef PG8_STAGE2
#undef PG8_STAGEB
#undef PG8_LDA
#undef PG8_LDB
#undef PG8_MMA
#undef PG8_WAIT_V
#undef PG8_WAIT_L
#undef PG8_BAR
#undef PG8_SCHED
}
template <class Cfg>
DI void gemm_phase_f8(lds_u8* lds, const Cfg& S) {
  const int tid = otid(), wid = __builtin_amdgcn_readfirstlane(tid >> 6), lane = tid & 63, wr = wid >> 2, wc = wid & 3, fr = lane & 15, fq = lane >> 4;
  const int K = S.K, nt = K / BK;
  int R0, C0, R1, C1;
  stage_rc(tid * 16, R0, C0);
  stage_rc(tid * 16 + 8192, R1, C1);
  unsigned voffB[2];
  {
    const int Rb0 = Cfg::PERM ? ((R0 & ~31) + perm32(R0 & 31)) : R0, Rb1 = Cfg::PERM ? ((R1 & ~31) + perm32(R1 & 31)) : R1;
    voffB[0] = (unsigned)(Rb0 * K + C0) * 2u; voffB[1] = (unsigned)(Rb1 * K + C1) * 2u;
  }
  const size_t kstep = (size_t)(BK * 2);
  const size_t hstep = (size_t)HALF * K * 2;
  const unsigned ldsw = (unsigned)wid * 1024u;
  const int cl = 2 * fq + (fq & 1), ch = 2 * fq + 1 - (fq & 1);
  const int aoffL = lds_byte(wr * 64 + fr, cl * 8), aoffH = lds_byte(wr * 64 + fr, ch * 8);
  const int boffL = lds_byte(wc * 32 + fr, cl * 8), boffH = lds_byte(wc * 32 + fr, ch * 8);
#define PG8_SA(b, h) (((b) * 2 + (h)) * HTB)
#define PG8_SB(b, h) ((4 + (b) * 2 + (h)) * HTB)
#define PG8_STAGE2(bufoff, gbase, o0, o1) do { \
    __builtin_amdgcn_global_load_lds((const unsigned*)((const char*)(gbase) + (o0)), (lds_u32*)(lds + (bufoff) + ldsw), 16, 0, 0); \
    __builtin_amdgcn_global_load_lds((const unsigned*)((const char*)(gbase) + (o1)), (lds_u32*)(lds + (bufoff) + ldsw + 8192), 16, 0, 0); } while (0)
#define PG8_STAGEB(bufoff, gbase) PG8_STAGE2(bufoff, gbase, voffB[0], voffB[1])
#define PG8_LDA(dst, b, h) do { _Pragma("unroll") for (int m = 0; m < 4; ++m) { const i32x4 lo_ = *(const lds_i32x4*)(lds + PG8_SA(b, h) + aoffL + m * 2048), hi_ = *(const lds_i32x4*)(lds + PG8_SA(b, h) + aoffH + m * 2048); dst[m] = __builtin_shufflevector(lo_, hi_, 0, 1, 2, 3, 4, 5, 6, 7); } } while (0)
#define PG8_LDB(dst, b, h) do { _Pragma("unroll") for (int n = 0; n < 2; ++n) { const i32x4 lo_ = *(const lds_i32x4*)(lds + PG8_SB(b, h) + boffL + n * 2048), hi_ = *(const lds_i32x4*)(lds + PG8_SB(b, h) + boffH + n * 2048); dst[n] = __builtin_shufflevector(lo_, hi_, 0, 1, 2, 3, 4, 5, 6, 7); } } while (0)
#define PG8_MMA(ai, bj, At, Bt) do { __builtin_amdgcn_s_setprio(1); _Pragma("unroll") for (int m = 0; m < 4; ++m) _Pragma("unroll") for (int n = 0; n < 2; ++n) \
    asm volatile("v_mfma_f32_16x16x128_f8f6f4 %0, %1, %2, %0" : "+v"(acc[ai][bj][m][n]) : "v"(Bt[n]), "v"(At[m])); __builtin_amdgcn_s_setprio(0); } while (0)
#define PG8_WAIT_V(n) asm volatile("s_waitcnt vmcnt(" #n ")" ::: "memory")
#define PG8_WAIT_L(n) asm volatile("s_waitcnt lgkmcnt(" #n ")" ::: "memory")
#define PG8_BAR __builtin_amdgcn_s_barrier()
#define PG8_SCHED __builtin_amdgcn_sched_barrier(0)
  Unit cur, nxt; int ui = 0;
  if (!S.next(0, cur)) return;
  f32x4 acc[2][2][4][2];
#pragma unroll
  for (int a = 0; a < 2; ++a)
#pragma unroll
    for (int b = 0; b < 2; ++b)
#pragma unroll
      for (int m = 0; m < 4; ++m)
#pragma unroll
        for (int n = 0; n < 2; ++n) acc[a][b][m][n] = f32x4{0.f, 0.f, 0.f, 0.f};
  i32x8 At[4], B0[2], B1[2];
  const char* cA = S.a_base(cur);
  const char* cB = S.b_base(cur);
  unsigned vc[4], vn[4];
  S.a_off(cur, R0, C0, R1, C1, vc, 0);
  PG8_STAGEB(PG8_SB(0, 0), cB); PG8_STAGE2(PG8_SA(0, 0), cA, vc[0], vc[1]); PG8_STAGEB(PG8_SB(0, 1), cB + hstep); PG8_STAGE2(PG8_SA(0, 1), cA, vc[2], vc[3]);
  if (wr == 1) PG8_BAR;
  PG8_WAIT_V(4); PG8_BAR;
  PG8_STAGEB(PG8_SB(1, 0), cB + kstep); PG8_STAGE2(PG8_SA(1, 0), cA + kstep, vc[0], vc[1]); PG8_STAGEB(PG8_SB(1, 1), cB + hstep + kstep);
  PG8_WAIT_V(6); PG8_BAR;
  for (;;) {
    const bool has_next = S.next(ui + 1, nxt);
    const char* nA = has_next ? S.a_base(nxt) : cA;
    const char* nB = has_next ? S.b_base(nxt) : cB;
    if (has_next) S.a_off(nxt, R0, C0, R1, C1, vn, ui + 1);
    else { vn[0] = vc[0]; vn[1] = vc[1]; vn[2] = vc[2]; vn[3] = vc[3]; }
    for (int t = 0; t < nt; t += 2) {
      const bool last = (t == nt - 2);
      const char* a1 = cA + (size_t)(t + 1) * kstep;
      const char* a2 = last ? nA : cA + (size_t)(t + 2) * kstep;
      const char* b2 = last ? nB : cB + (size_t)(t + 2) * kstep;
      const char* a3 = a2 + kstep;
      const char* b3 = b2 + kstep;
      const unsigned w0 = last ? vn[0] : vc[0], w1 = last ? vn[1] : vc[1], w2 = last ? vn[2] : vc[2], w3 = last ? vn[3] : vc[3];
      PG8_LDB(B0, 0, 0); PG8_SCHED; PG8_LDA(At, 0, 0); PG8_STAGE2(PG8_SA(1, 1), a1, vc[2], vc[3]);
      PG8_WAIT_L(8); PG8_BAR; PG8_WAIT_L(0); PG8_MMA(0, 0, At, B0); PG8_BAR; PG8_SCHED;
      PG8_LDB(B1, 0, 1); PG8_STAGEB(PG8_SB(0, 0), b2);
      PG8_BAR; PG8_WAIT_L(0); PG8_MMA(0, 1, At, B1); PG8_BAR;
      PG8_LDA(At, 0, 1); PG8_STAGE2(PG8_SA(0, 0), a2, w0, w1);
      PG8_BAR; PG8_WAIT_L(0); PG8_MMA(1, 0, At, B0); PG8_BAR; PG8_SCHED;
      PG8_STAGEB(PG8_SB(0, 1), b2 + hstep);
      PG8_WAIT_V(6); PG8_BAR; PG8_MMA(1, 1, At, B1); PG8_BAR;
      PG8_LDB(B0, 1, 0); PG8_SCHED; PG8_LDA(At, 1, 0); PG8_STAGE2(PG8_SA(0, 1), a2, w2, w3);
      PG8_WAIT_L(8); PG8_BAR; PG8_WAIT_L(0); PG8_MMA(0, 0, At, B0); PG8_BAR; PG8_SCHED;
      PG8_LDB(B1, 1, 1); PG8_STAGEB(PG8_SB(1, 0), b3);
      PG8_BAR; PG8_WAIT_L(0); PG8_MMA(0, 1, At, B1); PG8_BAR;
      PG8_LDA(At, 1, 1); PG8_STAGE2(PG8_SA(1, 0), a3, w0, w1);
      PG8_BAR; PG8_WAIT_L(0); PG8_MMA(1, 0, At, B0); PG8_BAR; PG8_SCHED;
      PG8_STAGEB(PG8_SB(1, 1), b3 + hstep);
      PG8_WAIT_V(6); PG8_BAR; PG8_MMA(1, 1, At, B1); PG8_BAR;
    }
    asm volatile("s_nop 15\n\ts_nop 15" ::: "memory");
    S.epi(acc, cur, wr, wc, fr, fq);
    if (!has_next) break;
#pragma unroll
    for (int a = 0; a < 2; ++a)
#pragma unroll
      for (int b = 0; b < 2; ++b)
#pragma unroll
        for (int m = 0; m < 4; ++m)
#pragma unroll
          for (int n = 0; n < 2; ++n) acc[a][b][m][n] = f32x4{0.f, 0.f, 0.f, 0.f};
    cur = nxt; cA = nA; cB = nB; ++ui;
    vc[0] = vn[0]; vc[1] = vn[1]; vc[2] = vn[2]; vc[3] = vn[3];
  }
  PG8_WAIT_V(0);
  if (wr == 0) PG8_BAR;
  PG8_BAR;
#undef PG8_SA
#undef PG8_SB
#undef PG8_STAGE2
#undef PG8_STAGEB
#undef PG8_LDA
#undef PG8_LDB
#undef PG8_MMA
#undef PG8_WAIT_V
#undef PG8_WAIT_L
#undef PG8_BAR
#undef PG8_SCHED
}
}

struct CfgInproj {
  static constexpr bool PERM = true;
  int K; const Params* p; int L; int bid, nb;
  DI bool next(int i, pg8::Unit& u) const { const int t = i * nb + bid; if (t >= 64 * 13) return false; u.pm = t & 63; u.pn = t >> 6; return true; }
  DI const char* a_base(const pg8::Unit& u) const { return (const char*)(p->hn() + (size_t)u.pm * 256 * DM); }
  DI const char* b_base(const pg8::Unit& u) const { return (const char*)(p->WinT() + ((size_t)L * PWP + (size_t)u.pn * 256) * DM); }
  DI void a_off(const pg8::Unit&, int R0, int C0, int R1, int C1, unsigned (&vo)[4]) const {
    vo[0] = (unsigned)(R0 * DM + C0) * 2u; vo[1] = (unsigned)(R1 * DM + C1) * 2u;
    vo[2] = vo[0] + 128u * DM * 2u; vo[3] = vo[1] + 128u * DM * 2u;
  }
  DI void epi(const f32x4 (&acc)[2][2][4][2], const pg8::Unit& u, int wr, int wc, int fr, int fq) const {
    const int row0 = u.pm * 256 + wr * 64 + fr, col0 = u.pn * 256 + wc * 32 + 8 * fq;
#pragma unroll
    for (int ai = 0; ai < 2; ++ai)
#pragma unroll
      for (int m = 0; m < 4; ++m) {
        u16* rowp = p->proj() + (size_t)(row0 + ai * 128 + m * 16) * PWP + col0;
#pragma unroll
        for (int bj = 0; bj < 2; ++bj) {
          uint4 w;
          w.x = pack2(acc[ai][bj][m][0][0], acc[ai][bj][m][0][1]); w.y = pack2(acc[ai][bj][m][0][2], acc[ai][bj][m][0][3]);
          w.z = pack2(acc[ai][bj][m][1][0], acc[ai][bj][m][1][1]); w.w = pack2(acc[ai][bj][m][1][2], acc[ai][bj][m][1][3]);
          *reinterpret_cast<uint4*>(rowp + bj * 128) = w;
        }
      }
  }
};
DI void ph_inproj_tail(const Params& p, int L, char* smem, int t) {
  const int m0 = (t & 63) * 256, n0 = 3072 + (t >> 6) * 128;
  const u16* Bt = p.WinT() + ((size_t)L * PWP + n0) * DM;
  gemm_tile([&](int r) { return p.hn() + (size_t)(m0 + r) * DM; }, Bt, DM, DM, smem,
            [&](f32x4 (&acc)[4][4], int wr, int wc, int fr, int fq) {
#pragma unroll
              for (int m = 0; m < 4; ++m)
#pragma unroll
                for (int n = 0; n < 4; ++n)
#pragma unroll
                  for (int j = 0; j < 4; ++j)
                    p.proj()[(size_t)(m0 + wr * 64 + m * 16 + fq * 4 + j) * PWP + n0 + wc * 64 + n * 16 + fr] = f2bf(acc[m][n][j]);
            });
}
DI void ph_inproj(const Params& p, int L, char* smem) {
  CfgInproj c; c.K = DM; c.p = &p; c.L = L; c.bid = obid(); c.nb = gridDim.x;
  pg8::gemm_phase((pg8::lds_u8*)smem, c);
}

DI void ph_gemm_store_bf16(const u16* A, int lda, const u16* Bt, int K, int M, int N, u16* C, int ldc, char* smem, int rot) {
  const int mt = M / 256, nt = N / 128;
  const int nb = gridDim.x;
  for (int t = (obid() + rot) % nb; t < mt * nt; t += nb) {
    const int m0 = (t % mt) * 256, n0 = (t / mt) * 128;
    gemm_tile([&](int r) { return A + (size_t)(m0 + r) * lda; }, Bt + (size_t)n0 * K, K, K, smem,
              [&](f32x4 (&acc)[4][4], int wr, int wc, int fr, int fq) {
#pragma unroll
                for (int m = 0; m < 4; ++m)
#pragma unroll
                  for (int n = 0; n < 4; ++n)
#pragma unroll
                    for (int j = 0; j < 4; ++j) {
                      const int row = m0 + wr * 64 + m * 16 + fq * 4 + j, col = n0 + wc * 64 + n * 16 + fr;
                      C[(size_t)row * ldc + col] = f2bf(acc[m][n][j]);
                    }
              });
  }
}

DI void ph_rmsnorm_bf16(const float* __restrict__ xin, const float* __restrict__ w, u16* __restrict__ outp) {
  const int tid_ = otid(); const int lane = tid_ & 63, gw = (obid() * NTHR + tid_) >> 6, nw = gridDim.x * (NTHR / 64);
  for (int t = gw; t < T; t += nw) {
    const float* xr = xin + (size_t)t * DM;
    float4 v[4];
    float ss = 0.f;
#pragma unroll
    for (int i = 0; i < 4; ++i) {
      v[i] = *reinterpret_cast<const float4*>(xr + (i * 64 + lane) * 4);
      ss += v[i].x * v[i].x + v[i].y * v[i].y + v[i].z * v[i].z + v[i].w * v[i].w;
    }
    ss = wave_sum(ss);
    const float rstd = rsqrtf(ss * (1.f / DM) + 1e-6f);
#pragma unroll
    for (int i = 0; i < 4; ++i) {
      const int c = (i * 64 + lane) * 4;
      const float4 ww = *reinterpret_cast<const float4*>(w + c);
      uint2 o;
      o.x = pack2(v[i].x * rstd * ww.x, v[i].y * rstd * ww.y);
      o.y = pack2(v[i].z * rstd * ww.z, v[i].w * rstd * ww.w);
      *reinterpret_cast<uint2*>(outp + (size_t)t * DM + c) = o;
    }
  }
}

DI void ph_final_norm(const float* __restrict__ xin, const float* __restrict__ w, float* __restrict__ outp) {
  const int tid_ = otid(); const int lane = tid_ & 63, gw = (obid() * NTHR + tid_) >> 6, nw = gridDim.x * (NTHR / 64);
  for (int t = gw; t < T; t += nw) {
    const float* xr = xin + (size_t)t * DM;
    float4 v[4];
    float ss = 0.f;
#pragma unroll
    for (int i = 0; i < 4; ++i) {
      v[i] = *reinterpret_cast<const float4*>(xr + (i * 64 + lane) * 4);
      ss += v[i].x * v[i].x + v[i].y * v[i].y + v[i].z * v[i].z + v[i].w * v[i].w;
    }
    ss = wave_sum(ss);
    const float rstd = rsqrtf(ss * (1.f / DM) + 1e-6f);
#pragma unroll
    for (int i = 0; i < 4; ++i) {
      const int c = (i * 64 + lane) * 4;
      const float4 ww = *reinterpret_cast<const float4*>(w + c);
      float4 o = make_float4(v[i].x * rstd * ww.x, v[i].y * rstd * ww.y, v[i].z * rstd * ww.z, v[i].w * rstd * ww.w);
      *reinterpret_cast<float4*>(outp + (size_t)t * DM + c) = o;
    }
  }
}

DI void rot8(const u16* x1p, const u16* x2p, const float* tab  , float scale, uint4& o1, uint4& o2) {
  float x1[8], x2[8], y1[8], y2[8];
  ld8(x1p, x1); ld8(x2p, x2);
#pragma unroll
  for (int e = 0; e < 8; e += 2) {
    const float4 cs = *reinterpret_cast<const float4*>(tab + e * 2);
    y1[e] = (x1[e] * cs.x - x2[e] * cs.y) * scale;
    y2[e] = (x2[e] * cs.x + x1[e] * cs.y) * scale;
    y1[e + 1] = (x1[e + 1] * cs.z - x2[e + 1] * cs.w) * scale;
    y2[e + 1] = (x2[e + 1] * cs.z + x1[e + 1] * cs.w) * scale;
  }
  o1.x = pack2(y1[0], y1[1]); o1.y = pack2(y1[2], y1[3]); o1.z = pack2(y1[4], y1[5]); o1.w = pack2(y1[6], y1[7]);
  o2.x = pack2(y2[0], y2[1]); o2.y = pack2(y2[2], y2[3]); o2.z = pack2(y2[4], y2[5]); o2.w = pack2(y2[6], y2[7]);
}
DI void ph_post(const Params& p, int L) {
  const int tid = otid();
  const int gt = obid() * NTHR + tid, gs = gridDim.x * NTHR;
  const int lane = tid & 63, gw = gt >> 6, nw = gs >> 6;
  const float* qnw = p.q_norm_w + L * 256;
  const float* kvnw = p.kv_norm_w + L * 128;
  const float* cw = p.conv_w + L * 5 * 768;
  const float* cb = p.conv_b + L * 768;
  const float* dtb = p.dt_bias + L * 8;
  for (int idx = gt; idx < T * 96; idx += gs) {
    const int t = idx / 96, cg = idx - t * 96, s = t & (SEQ - 1);
    float acc[8];
    {
      const float4 b0 = *reinterpret_cast<const float4*>(cb + cg * 8), b1 = *reinterpret_cast<const float4*>(cb + cg * 8 + 4);
      acc[0] = b0.x; acc[1] = b0.y; acc[2] = b0.z; acc[3] = b0.w; acc[4] = b1.x; acc[5] = b1.y; acc[6] = b1.z; acc[7] = b1.w;
    }
#pragma unroll
    for (int w = 0; w < 5; ++w) {
      const int ss = s + w - 2;
      if (ss >= 0 && ss < SEQ) {
        float xv[8];
        ld8(p.proj() + (size_t)(t + w - 2) * PWP + C_XBC + cg * 8, xv);
        const float4 w0 = *reinterpret_cast<const float4*>(cw + w * 768 + cg * 8), w1 = *reinterpret_cast<const float4*>(cw + w * 768 + cg * 8 + 4);
        acc[0] += xv[0] * w0.x; acc[1] += xv[1] * w0.y; acc[2] += xv[2] * w0.z; acc[3] += xv[3] * w0.w;
        acc[4] += xv[4] * w1.x; acc[5] += xv[5] * w1.y; acc[6] += xv[6] * w1.z; acc[7] += xv[7] * w1.w;
      }
    }
    uint4 o;
    o.x = pack2(fast_silu(acc[0]), fast_silu(acc[1])); o.y = pack2(fast_silu(acc[2]), fast_silu(acc[3]));
    o.z = pack2(fast_silu(acc[4]), fast_silu(acc[5])); o.w = pack2(fast_silu(acc[6]), fast_silu(acc[7]));
    *reinterpret_cast<uint4*>(p.xbc() + (size_t)t * 768 + cg * 8) = o;
  }
  for (int idx = gt; idx < T * 8; idx += gs) {
    const int t = idx >> 3, k = idx & 7;
    const float v = bf2f(p.proj()[(size_t)t * PWP + C_DT + k]) + dtb[k];
    p.dtv()[idx] = (v > 20.f) ? v : log1pf(expf(v));
  }
  {
    const int sub = lane >> 4, l16 = lane & 15;
    for (int t = gw * 4 + sub; t < T; t += nw * 4) {
      const u16* pr = p.proj() + (size_t)t * PWP;
      float v[16], u[8];
      ld8(pr + C_CQ + l16 * 16, v); ld8(pr + C_CQ + l16 * 16 + 8, v + 8);
      ld8(pr + C_CKV + l16 * 8, u);
      float ss = 0.f, s2 = 0.f;
#pragma unroll
      for (int i = 0; i < 16; ++i) ss += v[i] * v[i];
#pragma unroll
      for (int i = 0; i < 8; ++i) s2 += u[i] * u[i];
#pragma unroll
      for (int o = 1; o < 16; o <<= 1) { ss += __shfl_xor(ss, o); s2 += __shfl_xor(s2, o); }
      const float rstd = rsqrtf(ss * (1.f / 256.f) + 1e-6f), r2 = rsqrtf(s2 * (1.f / 128.f) + 1e-6f);
      uint4 o;
      const float* qw = qnw + l16 * 16;
      o.x = pack2(v[0] * rstd * qw[0], v[1] * rstd * qw[1]); o.y = pack2(v[2] * rstd * qw[2], v[3] * rstd * qw[3]);
      o.z = pack2(v[4] * rstd * qw[4], v[5] * rstd * qw[5]); o.w = pack2(v[6] * rstd * qw[6], v[7] * rstd * qw[7]);
      *reinterpret_cast<uint4*>(p.cqn() + (size_t)t * 256 + l16 * 16) = o;
      o.x = pack2(v[8] * rstd * qw[8], v[9] * rstd * qw[9]); o.y = pack2(v[10] * rstd * qw[10], v[11] * rstd * qw[11]);
      o.z = pack2(v[12] * rstd * qw[12], v[13] * rstd * qw[13]); o.w = pack2(v[14] * rstd * qw[14], v[15] * rstd * qw[15]);
      *reinterpret_cast<uint4*>(p.cqn() + (size_t)t * 256 + l16 * 16 + 8) = o;
      const float* kw = kvnw + l16 * 8;
      o.x = pack2(u[0] * r2 * kw[0], u[1] * r2 * kw[1]); o.y = pack2(u[2] * r2 * kw[2], u[3] * r2 * kw[3]);
      o.z = pack2(u[4] * r2 * kw[4], u[5] * r2 * kw[5]); o.w = pack2(u[6] * r2 * kw[6], u[7] * r2 * kw[7]);
      *reinterpret_cast<uint4*>(p.ckvn() + (size_t)t * 128 + l16 * 8) = o;
    }
  }
  for (int idx = gt; idx < T * 42; idx += gs) {
    const int t = idx / 42, ri = idx - t * 42, s = t & (SEQ - 1);
    u16* pr = p.proj() + (size_t)t * PWP;
    uint4 o1, o2;
    if (ri < 32) {
      const int isk = ri >> 4, h = (ri >> 2) & 3, i0 = (ri & 3) * 8;
      u16* a = pr + (isk ? C_RK : C_RQ) + h * 64 + i0;
      rot8(a, a + 32, p.rtab() + ((size_t)s * 56 + i0) * 2, isk ? 1.f : 0.125f, o1, o2);
      *reinterpret_cast<uint4*>(a) = o1;
      *reinterpret_cast<uint4*>(a + 32) = o2;
    } else if (ri < 40) {
      const int j = ri - 32, isk = j >> 2, h = j & 3;
      u16* a = pr + (isk ? C_DK : C_DQ) + h * 64;
      rot8(a, a + 8, p.rtab() + ((size_t)s * 56 + 32) * 2, 1.f, o1, o2);
      *reinterpret_cast<uint4*>(a) = o1;
      *reinterpret_cast<uint4*>(a + 8) = o2;
    } else {
      const int i0 = (ri - 40) * 8;
      u16* a = pr + C_KR + i0;
      rot8(a, a + 16, p.rtab() + ((size_t)s * 56 + 40 + i0) * 2, 1.f, o1, o2);
      *reinterpret_cast<uint4*>(a) = o1;
      *reinterpret_cast<uint4*>(a + 16) = o2;
      const int bb = t >> 12;
#pragma unroll
      for (int hd = 0; hd < 4; ++hd) {
        u16* kf = p.kfull() + ((size_t)(bb * 4 + hd) * SEQ + s) * 96 + 64 + i0;
        *reinterpret_cast<uint4*>(kf) = o1;
        *reinterpret_cast<uint4*>(kf + 16) = o2;
      }
    }
  }
}

DI void ph_mla_up_q(const Params& p, int L, char* smem, int t) {
  const int mt = T / 256;
  const u16* Bq = p.WuqT() + (size_t)L * 384 * 256;
  {
    const int m0 = (t % mt) * 256, n0 = (t / mt) * 128;
    gemm_tile([&](int r) { return p.cqn() + (size_t)(m0 + r) * 256; }, Bq + (size_t)n0 * 256, 256, 256, smem,
              [&](f32x4 (&acc)[4][4], int wr, int wc, int fr, int fq) {
                const float scale = 0.10206207261596575f * 1.4426950408889634f;
#pragma unroll
                for (int m = 0; m < 4; ++m)
#pragma unroll
                  for (int j = 0; j < 4; ++j) {
                    const int row = m0 + wr * 64 + m * 16 + fq * 4 + j;
                    const float2 cssn = *reinterpret_cast<const float2*>(p.rtab() + ((size_t)(row & (SEQ - 1)) * 56 + 40 + fr) * 2);
                    const float cs = cssn.x, sn = cssn.y;
#pragma unroll
                    for (int n2 = 0; n2 < 4; n2 += 2) {
                      const int cb = n0 + wc * 64 + n2 * 16;
                      float x1 = acc[m][n2][j], x2 = acc[m][n2 + 1][j];
                      if (cb % 96 == 64) {
                        const float y1 = x1 * cs - x2 * sn, y2 = x2 * cs + x1 * sn;
                        x1 = y1; x2 = y2;
                      }
                      p.mq()[(size_t)row * 384 + cb + fr] = f2bf(x1 * scale);
                      p.mq()[(size_t)row * 384 + cb + 16 + fr] = f2bf(x2 * scale);
                    }
                  }
              });
  }
}
DI void ph_mla_up_kv(const Params& p, int L, char* smem, int t) {
  const int mt = T / 256;
  const u16* Bkv = p.WukvT() + (size_t)L * 512 * 128;
  {
    const int m0 = (t % mt) * 256, h = t / mt, n0 = h * 128;
    gemm_tile([&](int r) { return p.ckvn() + (size_t)(m0 + r) * 128; }, Bkv + (size_t)n0 * 128, 128, 128, smem,
              [&](f32x4 (&acc)[4][4], int wr, int wc, int fr, int fq) {
#pragma unroll
                for (int m = 0; m < 4; ++m) {
                  const int row = m0 + wr * 64 + m * 16 + fq * 4;
                  const int bb = row >> 12, sq = row & (SEQ - 1);
                  const size_t bh = (size_t)(bb * 4 + h);
#pragma unroll
                  for (int n = 0; n < 4; ++n) {
                    if (wc == 0) {
#pragma unroll
                      for (int j = 0; j < 4; ++j) p.kfull()[(bh * SEQ + sq + j) * 96 + n * 16 + fr] = f2bf(acc[m][n][j]);
                    } else {
                      uint2 v;
                      v.x = pack2(acc[m][n][0], acc[m][n][1]);
                      v.y = pack2(acc[m][n][2], acc[m][n][3]);
                      const int sqp = (sq & ~12) | ((sq & 4) << 1) | ((sq & 8) >> 1);
                      *reinterpret_cast<uint2*>(p.vT() + (bh * 64 + n * 16 + fr) * SEQ + sqp) = v;
                    }
                  }
                }
              });
  }
}

DI void ph_cumsum(const Params& p, int L) {
  const int tid_ = otid(); const int lane = tid_ & 63, gw = (obid() * NTHR + tid_) >> 6, nw = gridDim.x * (NTHR / 64);
  for (int it = gw; it < 32; it += nw) {
    const int h = it & 3, dir = (it >> 2) & 1, b = it >> 3;
    const float a = -expf(p.a_log[L * 8 + dir * 4 + h]);
    float running = 0.f;
    for (int c = 0; c < 64; ++c) {
      const int i = c * 64 + lane;
      const int s = dir ? (SEQ - 1 - i) : i;
      const size_t off = (size_t)(b * SEQ + s) * 8 + dir * 4 + h;
      float v = p.dtv()[off] * a;
#pragma unroll
      for (int o = 1; o < 64; o <<= 1) {
        const float u = __shfl_up(v, o);
        if (lane >= o) v += u;
      }
      v += running;
      p.cs()[off] = v;
      running = __shfl(v, 63);
    }
  }
}

DI void ph_ret_naive(const Params& p) {
  const int gt = obid() * NTHR + otid(), gs = gridDim.x * NTHR;
  for (int it = gt; it < 4 * 4 * SEQ; it += gs) {
    const int n = it & (SEQ - 1), h = (it >> 12) & 3, b = it >> 14;
    const u16* base = p.proj() + (size_t)(b * SEQ) * PWP;
    uint4 qp[8];
    float o[64];
#pragma unroll
    for (int d = 0; d < 8; ++d) qp[d] = *reinterpret_cast<const uint4*>(base + (size_t)n * PWP + C_RQ + h * 64 + d * 8);
#pragma unroll
    for (int d = 0; d < 64; ++d) o[d] = 0.f;
    const float lg0 = log1pf(-exp2f(-5.f - (float)h)), lg1 = log1pf(-exp2f(-5.5f - (float)h));
#pragma unroll 1
    for (int m = 0; m < SEQ; ++m) {
      const u16* kr = base + (size_t)m * PWP + C_RK + h * 64;
      const u16* vr = base + (size_t)m * PWP + C_RV + h * 64;
      float s = 0.f;
#pragma unroll
      for (int d = 0; d < 8; ++d) s = dot8(qp[d], *reinterpret_cast<const uint4*>(kr + d * 8), s);
      const float w = (m <= n) ? expf(lg0 * (float)(n - m)) : expf(lg1 * (float)(m - n));
      s *= w;
#pragma unroll
      for (int d = 0; d < 64; d += 8) {
        float vf[8];
        ld8(vr + d, vf);
#pragma unroll
        for (int j = 0; j < 8; ++j) o[d + j] += s * vf[j];
      }
    }
    float mu = 0.f;
#pragma unroll
    for (int d = 0; d < 64; ++d) mu += o[d];
    mu *= (1.f / 64.f);
    float var = 0.f;
#pragma unroll
    for (int d = 0; d < 64; ++d) var += (o[d] - mu) * (o[d] - mu);
    var *= (1.f / 64.f);
    const float rs = rsqrtf(var + 1e-5f);
    const size_t t = (size_t)b * SEQ + n;
#pragma unroll
    for (int d = 0; d < 64; d += 8) {
      float g[8];
      ld8(p.proj() + t * PWP + C_RG + h * 64 + d, g);
      uint4 ov;
      ov.x = pack2(silu(g[0]) * (o[d + 0] - mu) * rs, silu(g[1]) * (o[d + 1] - mu) * rs);
      ov.y = pack2(silu(g[2]) * (o[d + 2] - mu) * rs, silu(g[3]) * (o[d + 3] - mu) * rs);
      ov.z = pack2(silu(g[4]) * (o[d + 4] - mu) * rs, silu(g[5]) * (o[d + 5] - mu) * rs);
      ov.w = pack2(silu(g[6]) * (o[d + 6] - mu) * rs, silu(g[7]) * (o[d + 7] - mu) * rs);
      *reinterpret_cast<uint4*>(p.mixed() + t * DM + h * 64 + d) = ov;
    }
  }
}

DI void ph_mla_naive(const Params& p) {
  const int gt = obid() * NTHR + otid(), gs = gridDim.x * NTHR;
  for (int it = gt; it < 2 * 4 * 4 * SEQ; it += gs) {
    const int n = it & (SEQ - 1), vh = (it >> 12) & 1, h = (it >> 13) & 3, b = it >> 15;
    const size_t t = (size_t)b * SEQ + n;
    uint4 qp[12];
    float o[32];
#pragma unroll
    for (int d = 0; d < 12; ++d) qp[d] = *reinterpret_cast<const uint4*>(p.mq() + t * 384 + h * 96 + d * 8);
    const size_t tb = (size_t)b * SEQ;
    float mx = -1e30f;
#pragma unroll 1
    for (int m = 0; m < SEQ; ++m) {
      const u16* kn = ((u16*)nullptr) + (tb + m) * 512 + h * 128;
      const u16* kr = p.proj() + (tb + m) * PWP + C_KR;
      float s = 0.f;
#pragma unroll
      for (int d = 0; d < 8; ++d) s = dot8(qp[d], *reinterpret_cast<const uint4*>(kn + d * 8), s);
#pragma unroll
      for (int d = 0; d < 4; ++d) s = dot8(qp[8 + d], *reinterpret_cast<const uint4*>(kr + d * 8), s);
      mx = fmaxf(mx, s);
    }
#pragma unroll
    for (int d = 0; d < 32; ++d) o[d] = 0.f;
    float l = 0.f;
#pragma unroll 1
    for (int m = 0; m < SEQ; ++m) {
      const u16* kn = ((u16*)nullptr) + (tb + m) * 512 + h * 128;
      const u16* kr = p.proj() + (tb + m) * PWP + C_KR;
      float s = 0.f;
#pragma unroll
      for (int d = 0; d < 8; ++d) s = dot8(qp[d], *reinterpret_cast<const uint4*>(kn + d * 8), s);
#pragma unroll
      for (int d = 0; d < 4; ++d) s = dot8(qp[8 + d], *reinterpret_cast<const uint4*>(kr + d * 8), s);
      const float pe = exp2f(s - mx);
      l += pe;
#pragma unroll
      for (int d = 0; d < 32; d += 8) {
        float vf[8];
        ld8(kn + 64 + vh * 32 + d, vf);
#pragma unroll
        for (int j = 0; j < 8; ++j) o[d + j] += pe * vf[j];
      }
    }
    const float il = 1.f / l;
#pragma unroll
    for (int d = 0; d < 32; d += 8) {
      uint4 ov;
      ov.x = pack2(o[d + 0] * il, o[d + 1] * il);
      ov.y = pack2(o[d + 2] * il, o[d + 3] * il);
      ov.z = pack2(o[d + 4] * il, o[d + 5] * il);
      ov.w = pack2(o[d + 6] * il, o[d + 7] * il);
      *reinterpret_cast<uint4*>(p.mixed() + t * DM + 256 + h * 64 + vh * 32 + d) = ov;
    }
  }
}

#define MFMA32(a, b, c) __builtin_amdgcn_mfma_f32_32x32x16_bf16((a), (b), (c), 0, 0, 0)
DI float max16(const f32x16& v) {
  float a = fmaxf(fmaxf(v[0], v[1]), v[2]), b = fmaxf(fmaxf(v[3], v[4]), v[5]), c = fmaxf(fmaxf(v[6], v[7]), v[8]);
  float d = fmaxf(fmaxf(v[9], v[10]), v[11]), e = fmaxf(fmaxf(v[12], v[13]), v[14]);
  return fmaxf(fmaxf(fmaxf(a, b), fmaxf(c, d)), fmaxf(e, v[15]));
}
DI void ph_mla_attn(const Params& p, char* smem) {
  const int tid = otid(), wid = tid >> 6, lane = tid & 63, l32 = lane & 31, hh = lane >> 5;
  u16* sK = reinterpret_cast<u16*>(smem);
  u16* sV = sK + 2 * 128 * 104;
  uint4 konev = make_uint4(hh == 0 ? 0x00003F80u : 0u, 0u, 0u, 0u);
  const bf16x8 kone = __builtin_bit_cast(bf16x8, konev);
  for (int item = obid(); item < 256; item += gridDim.x) {
    const int xcd_ = item & 7, jx_ = item >> 3, bh = xcd_ * 2 + (jx_ >> 4), qt = jx_ & 15, b = bh >> 2, h = bh & 3;
    const size_t t0 = (size_t)b * SEQ + qt * 256 + wid * 32;
    bf16x8 qf[6];
#pragma unroll
    for (int ks = 0; ks < 6; ++ks) qf[ks] = *reinterpret_cast<const bf16x8*>(p.mq() + (t0 + l32) * 384 + h * 96 + ks * 16 + hh * 8);
    const u16* kg = p.kfull() + (size_t)bh * SEQ * 96;
    const u16* vg = p.vT() + (size_t)bh * 64 * SEQ;
    f32x16 o0, o1;
#pragma unroll
    for (int i = 0; i < 16; ++i) { o0[i] = 0.f; o1[i] = 0.f; }
    float m = 0.f, l = 0.f;
    bf16x8 qf6 = __builtin_bit_cast(bf16x8, make_uint4(0u, 0u, 0u, 0u));
    const int kr0 = tid / 12, kc0 = tid % 12, kr1 = (512 + tid) / 12, kc1 = (512 + tid) % 12, kr2 = (1024 + tid) / 12, kc2 = (1024 + tid) % 12;
    const int vd0 = tid >> 4, vd1 = 32 + (tid >> 4), vkc = (tid & 15) * 8;
    uint4 ak0, ak1, ak2, av0, av1;
#define MLA_LD(dst_, ptr_) asm volatile("global_load_dwordx4 %0, %1, off" : "=v"(dst_) : "v"(ptr_) : "memory")
#define MLA_GLOAD(K0, K1, K2, V0, V1, kt_)                                               \
    {                                                                                    \
      const u16* kb_ = kg + (size_t)(kt_) * 128 * 96 + tid * 8;                          \
      MLA_LD(K0, kb_); MLA_LD(K1, kb_ + 512 * 8); MLA_LD(K2, kb_ + 1024 * 8);            \
      const u16* vp_ = vg + (size_t)vd0 * SEQ + (kt_) * 128 + vkc;                       \
      MLA_LD(V0, vp_); MLA_LD(V1, vp_ + (size_t)32 * SEQ);                               \
    }
#define MLA_SSTORE(K0, K1, K2, V0, V1, buf_)                                             \
    {                                                                                    \
      u16* kb_ = sK + (buf_) * 128 * 104;                                                \
      u16* vb_ = sV + (buf_) * 64 * 136;                                                 \
      *reinterpret_cast<uint4*>(kb_ + kr0 * 104 + kc0 * 8) = K0;                         \
      *reinterpret_cast<uint4*>(kb_ + kr1 * 104 + kc1 * 8) = K1;                         \
      *reinterpret_cast<uint4*>(kb_ + kr2 * 104 + kc2 * 8) = K2;                         \
      *reinterpret_cast<uint4*>(vb_ + vd0 * 136 + vkc) = V0;                             \
      *reinterpret_cast<uint4*>(vb_ + vd1 * 136 + vkc) = V1;                             \
    }
    float mxrun = 0.f;
#define SGB(mask, n) __builtin_amdgcn_sched_group_barrier((mask), (n), 0)
#define MLA_KFRAG(kb_, sub_, ks_) (*reinterpret_cast<const bf16x8*>((kb_) + ((sub_) * 32 + l32) * 104 + (ks_) * 16 + hh * 8))
#define MLA_VFRAG(dst_, vb_, sub_, ks2_, dvt_) \
    dst_ = *reinterpret_cast<const bf16x8*>((vb_) + ((dvt_) * 32 + l32) * 136 + (sub_) * 32 + (ks2_) * 16 + hh * 8)
#define MLA_SOFTMAX(sc_, pa_, pb_)                                                                         \
    {                                                                                                      \
      mxrun = fmaxf(mxrun, max16(sc_));                                                                    \
      float ps0_ = 0.f, ps1_ = 0.f;                                                                        \
      _Pragma("unroll") for (int i = 0; i < 16; i += 2) {                                                  \
        sc_[i] = __builtin_amdgcn_exp2f(sc_[i]); sc_[i + 1] = __builtin_amdgcn_exp2f(sc_[i + 1]);          \
        ps0_ += sc_[i]; ps1_ += sc_[i + 1];                                                                \
      }                                                                                                    \
      l += ps0_ + ps1_;                                                                                    \
      uint4 pk_;                                                                                           \
      pk_.x = pack2(sc_[0], sc_[1]); pk_.y = pack2(sc_[2], sc_[3]); pk_.z = pack2(sc_[4], sc_[5]); pk_.w = pack2(sc_[6], sc_[7]); \
      pa_ = __builtin_bit_cast(bf16x8, pk_);                                                               \
      pk_.x = pack2(sc_[8], sc_[9]); pk_.y = pack2(sc_[10], sc_[11]); pk_.z = pack2(sc_[12], sc_[13]); pk_.w = pack2(sc_[14], sc_[15]); \
      pb_ = __builtin_bit_cast(bf16x8, pk_);                                                               \
    }
    auto compute_tile = [&](int cur, int half) {
      const u16* kb = sK + cur * 128 * 104 + half * 64 * 104;
      const u16* vb = sV + cur * 64 * 136 + half * 64;
      bf16x8 k0[6], k1[6];
#pragma unroll
      for (int ks = 0; ks < 6; ++ks) { k0[ks] = MLA_KFRAG(kb, 0, ks); k1[ks] = MLA_KFRAG(kb, 1, ks); }
      f32x16 s0, s1;
#pragma unroll
      for (int i = 0; i < 16; ++i) { s0[i] = 0.f; s1[i] = 0.f; }
#pragma unroll
      for (int ks = 0; ks < 6; ++ks) s0 = MFMA32(k0[ks], qf[ks], s0);
      s0 = MFMA32(kone, qf6, s0);
      bf16x8 v00, v01, v02, v03, v10, v11, v12, v13;
      MLA_VFRAG(v00, vb, 0, 0, 0); MLA_VFRAG(v01, vb, 0, 0, 1); MLA_VFRAG(v02, vb, 0, 1, 0); MLA_VFRAG(v03, vb, 0, 1, 1);
#pragma unroll
      for (int ks = 0; ks < 6; ++ks) s1 = MFMA32(k1[ks], qf[ks], s1);
      s1 = MFMA32(kone, qf6, s1);
      MLA_VFRAG(v10, vb, 1, 0, 0); MLA_VFRAG(v11, vb, 1, 0, 1); MLA_VFRAG(v12, vb, 1, 1, 0); MLA_VFRAG(v13, vb, 1, 1, 1);
      bf16x8 p0a, p0b, p1a, p1b;
      MLA_SOFTMAX(s0, p0a, p0b);
      o0 = MFMA32(v00, p0a, o0); o1 = MFMA32(v01, p0a, o1); o0 = MFMA32(v02, p0b, o0); o1 = MFMA32(v03, p0b, o1);
      MLA_SOFTMAX(s1, p1a, p1b);
      o0 = MFMA32(v10, p1a, o0); o1 = MFMA32(v11, p1a, o1); o0 = MFMA32(v12, p1b, o0); o1 = MFMA32(v13, p1b, o1);
      SGB(0x100, 12);
#pragma unroll
      for (int i = 0; i < 7; ++i) { SGB(0x008, 1); if (i < 4) SGB(0x100, 1); }
#pragma unroll
      for (int i = 0; i < 7; ++i) { SGB(0x008, 1); if (i < 4) SGB(0x100, 1); SGB(0x402, 7); }
#pragma unroll
      for (int i = 0; i < 4; ++i) { SGB(0x008, 1); SGB(0x402, 12); }
#pragma unroll
      for (int i = 0; i < 4; ++i) SGB(0x008, 1);
    };
    auto lazy_update = [&]() {
      const float mxr = fmaxf(mxrun, __shfl_xor(mxrun, 32));
      if (__builtin_amdgcn_ballot_w64(mxr > 8.f) != 0ull) {
        float d = (mxr > 8.f) ? mxr : 0.f;
        const float mnew = bf2f(f2bf(m + d));
        d = mnew - m;
        m = mnew;
        const float alpha = __builtin_amdgcn_exp2f(-d);
        l *= alpha;
        mxrun -= d;
#pragma unroll
        for (int i = 0; i < 16; ++i) { o0[i] *= alpha; o1[i] *= alpha; }
        uint4 qv = make_uint4(0u, 0u, 0u, 0u);
        if (hh == 0) qv.x = (unsigned)f2bf(-m);
        qf6 = __builtin_bit_cast(bf16x8, qv);
      }
    };
    MLA_GLOAD(ak0, ak1, ak2, av0, av1, 0);
    asm volatile("s_waitcnt vmcnt(0)" ::: "memory");
    MLA_SSTORE(ak0, ak1, ak2, av0, av1, 0);
    __syncthreads();
    {
      f32x16 s0, s1;
#pragma unroll
      for (int i = 0; i < 16; ++i) { s0[i] = 0.f; s1[i] = 0.f; }
#pragma unroll
      for (int ks = 0; ks < 6; ++ks) { s0 = MFMA32(MLA_KFRAG(sK, 0, ks), qf[ks], s0); s1 = MFMA32(MLA_KFRAG(sK, 1, ks), qf[ks], s1); }
      float mx = fmaxf(max16(s0), max16(s1));
      mx = fmaxf(mx, __shfl_xor(mx, 32));
      m = bf2f(f2bf(mx));
      uint4 qv = make_uint4(0u, 0u, 0u, 0u);
      if (hh == 0) qv.x = (unsigned)f2bf(-m);
      qf6 = __builtin_bit_cast(bf16x8, qv);
    }
#pragma unroll 1
    for (int kt = 0; kt < 32; kt += 2) {
      MLA_GLOAD(ak0, ak1, ak2, av0, av1, kt + 1);
#pragma unroll 1
      for (int half = 0; half < 2; ++half) compute_tile(0, half);
      asm volatile("s_waitcnt vmcnt(0)" ::: "memory");
      MLA_SSTORE(ak0, ak1, ak2, av0, av1, 1);
      __syncthreads();
      lazy_update();
      if (kt + 2 < 32) MLA_GLOAD(ak0, ak1, ak2, av0, av1, kt + 2);
#pragma unroll 1
      for (int half = 0; half < 2; ++half) compute_tile(1, half);
      if (kt + 2 < 32) {
        asm volatile("s_waitcnt vmcnt(0)" ::: "memory");
        MLA_SSTORE(ak0, ak1, ak2, av0, av1, 0);
      }
      __syncthreads();
      lazy_update();
    }
    l += __shfl_xor(l, 32);
    const float il = 1.f / l;
    u16* orow = p.mixed() + (t0 + l32) * DM + 256 + h * 64 + hh * 4;
#pragma unroll
    for (int g = 0; g < 4; ++g) {
      uint2 v;
      v.x = pack2(o0[4 * g + 0] * il, o0[4 * g + 1] * il);
      v.y = pack2(o0[4 * g + 2] * il, o0[4 * g + 3] * il);
      *reinterpret_cast<uint2*>(orow + g * 8) = v;
      v.x = pack2(o1[4 * g + 0] * il, o1[4 * g + 1] * il);
      v.y = pack2(o1[4 * g + 2] * il, o1[4 * g + 3] * il);
      *reinterpret_cast<uint2*>(orow + 32 + g * 8) = v;
    }
  }
}

typedef __attribute__((address_space(3))) s16x4 lds_s16x4;
template <int MODE>
DI void ph_dil_pass(const Params& p, char* smem, int blk_) {
  const int tid = otid(), wid = tid >> 6, lane = tid & 63, l32 = lane & 31, hh = lane >> 5;
  u16* sV = reinterpret_cast<u16*>(smem) + wid * (2 * 32 * 72);
  const int i16 = lane & 15, tq = i16 >> 2, tp = i16 & 3, tblk = (lane >> 4) & 1;
  {
    constexpr int NT = (MODE == 0) ? 13 : 5;
    const int it = wid, xcd_ = blk_ & 7, jx_ = blk_ >> 3, bh = xcd_ * 2 + (jx_ >> 4), r = jx_ & 15, b = bh >> 2, h = bh & 3;
    const int i0 = it * 32;
    const int q0 = (r * 8 + it) * 32;
    const int qpos = (MODE == 0) ? (r + 16 * (i0 + l32)) : (q0 + l32);
    const size_t tb = (size_t)b * SEQ;
    const u16* kbase = p.proj() + tb * PWP + C_DK + h * 64;
    const u16* vbase = p.proj() + tb * PWP + C_DV + h * 64;
    bf16x8 qf[4];
    {
      const u16* qp = p.proj() + (tb + qpos) * PWP + C_DQ + h * 64 + hh * 8;
#pragma unroll
      for (int ks = 0; ks < 4; ++ks) qf[ks] = *reinterpret_cast<const bf16x8*>(qp + ks * 16);
    }
    f32x16 o0, o1;
#pragma unroll
    for (int i = 0; i < 16; ++i) { o0[i] = 0.f; o1[i] = 0.f; }
    float m = -1e30f, l = 0.f;
    auto tile_params = [&](int tt, int& d, int& rd, int& ub, int& ulim, int& qb, int& qs) {
      if (MODE == 0) {
        if (tt < 5) { d = 16; rd = r; qb = i0; qs = 1; ulim = 256; ub = qb - 64 + 32 * tt; }
        else { d = 4; rd = r & 3; qb = (r >> 2) + 4 * i0; qs = 4; ulim = 1024; ub = qb - 64 + 32 * (tt - 5); }
      } else { d = 1; rd = 0; qb = q0; qs = 1; ulim = 4096; ub = qb - 64 + 32 * tt; }
    };
    bf16x8 ka0, ka1, ka2, ka3, kb0, kb1, kb2, kb3;
    uint4 va0, va1, va2, va3, vb0, vb1, vb2, vb3;
#define DIL_LD(dst_, ptr_) asm volatile("global_load_dwordx4 %0, %1, off" : "=v"(dst_) : "v"(ptr_) : "memory")
#define DIL_GLOAD(K0, K1, K2, K3, V0, V1, V2, V3, tt_)                                                   \
    {                                                                                                    \
      int d_, rd_, ub_, ulim_, qb_, qs_;                                                                 \
      tile_params((tt_), d_, rd_, ub_, ulim_, qb_, qs_);                                                 \
      int u_ = min(max(ub_ + l32, 0), ulim_ - 1);                                                        \
      const u16* kp_ = kbase + (size_t)(rd_ + d_ * u_) * PWP + hh * 8;                                   \
      DIL_LD(K0, kp_); DIL_LD(K1, kp_ + 16); DIL_LD(K2, kp_ + 32); DIL_LD(K3, kp_ + 48);                 \
      const int kr_ = ub_ + (lane >> 3);                                                                 \
      const u16* vp_;                                                                                    \
      u_ = min(max(kr_, 0), ulim_ - 1);      vp_ = vbase + (size_t)(rd_ + d_ * u_) * PWP + (lane & 7) * 8; DIL_LD(V0, vp_); \
      u_ = min(max(kr_ + 8, 0), ulim_ - 1);  vp_ = vbase + (size_t)(rd_ + d_ * u_) * PWP + (lane & 7) * 8; DIL_LD(V1, vp_); \
      u_ = min(max(kr_ + 16, 0), ulim_ - 1); vp_ = vbase + (size_t)(rd_ + d_ * u_) * PWP + (lane & 7) * 8; DIL_LD(V2, vp_); \
      u_ = min(max(kr_ + 24, 0), ulim_ - 1); vp_ = vbase + (size_t)(rd_ + d_ * u_) * PWP + (lane & 7) * 8; DIL_LD(V3, vp_); \
    }
#define DIL_VSTORE(V0, V1, V2, V3, buf_)                                                                 \
    {                                                                                                    \
      u16* vb_ = sV + (buf_) * 32 * 72 + (lane >> 3) * 72 + (lane & 7) * 8;                              \
      *reinterpret_cast<uint4*>(vb_) = V0;                                                               \
      *reinterpret_cast<uint4*>(vb_ + 8 * 72) = V1;                                                      \
      *reinterpret_cast<uint4*>(vb_ + 16 * 72) = V2;                                                     \
      *reinterpret_cast<uint4*>(vb_ + 24 * 72) = V3;                                                     \
    }
    auto tile_rest = [&](int tt, f32x16 sc, int cur) {
      int d, rd, ub, ulim, qb, qs;
      tile_params(tt, d, rd, ub, ulim, qb, qs);
      const int uq = qb + qs * l32;
      const float cs = 0.125f * 1.4426950408889634f;
      float mx = -1e30f;
#pragma unroll
      for (int i = 0; i < 16; ++i) {
        const int u = ub + (i & 3) + 8 * (i >> 2) + 4 * hh;
        const int du = u - uq;
        const bool valid = (u >= 0) && (u < ulim) && (du <= 64) && (du >= -64);
        sc[i] = valid ? sc[i] * cs : -1e30f;
        mx = fmaxf(mx, sc[i]);
      }
      mx = fmaxf(mx, __shfl_xor(mx, 32));
      const float mn = fmaxf(m, mx);
      const float alpha = __builtin_amdgcn_exp2f(m - mn);
      m = mn;
      float ps = 0.f;
#pragma unroll
      for (int i = 0; i < 16; ++i) {
        float pe = __builtin_amdgcn_exp2f(sc[i] - mn);
        pe = (sc[i] > -1e29f) ? pe : 0.f;
        ps += pe;
        sc[i] = pe;
      }
      l = l * alpha + ps;
#pragma unroll
      for (int i = 0; i < 16; ++i) { o0[i] *= alpha; o1[i] *= alpha; }
      const u16* vb = sV + cur * 32 * 72;
#pragma unroll
      for (int ks2 = 0; ks2 < 2; ++ks2) {
        uint4 pk;
        pk.x = pack2(sc[8 * ks2 + 0], sc[8 * ks2 + 1]);
        pk.y = pack2(sc[8 * ks2 + 2], sc[8 * ks2 + 3]);
        pk.z = pack2(sc[8 * ks2 + 4], sc[8 * ks2 + 5]);
        pk.w = pack2(sc[8 * ks2 + 6], sc[8 * ks2 + 7]);
        const bf16x8 pb = __builtin_bit_cast(bf16x8, pk);
#pragma unroll
        for (int dvt = 0; dvt < 2; ++dvt) {
          const u16* a0 = vb + (16 * ks2 + 4 * hh + tq) * 72 + dvt * 32 + tblk * 16 + tp * 4;
          const s16x4 lo = __builtin_amdgcn_ds_read_tr16_b64_v4i16((lds_s16x4*)(a0));
          const s16x4 hi = __builtin_amdgcn_ds_read_tr16_b64_v4i16((lds_s16x4*)(a0 + 8 * 72));
          const bf16x8 a = __builtin_shufflevector(lo, hi, 0, 1, 2, 3, 4, 5, 6, 7);
          if (dvt == 0) o0 = MFMA32(a, pb, o0); else o1 = MFMA32(a, pb, o1);
        }
      }
    };
    DIL_GLOAD(ka0, ka1, ka2, ka3, va0, va1, va2, va3, 0);
    DIL_GLOAD(kb0, kb1, kb2, kb3, vb0, vb1, vb2, vb3, 1);
    asm volatile("s_waitcnt vmcnt(8)" ::: "memory");
    DIL_VSTORE(va0, va1, va2, va3, 0);
#pragma unroll 1
    for (int tt = 0; tt < NT; tt += 2) {
      {
        f32x16 sc;
#pragma unroll
        for (int i = 0; i < 16; ++i) sc[i] = 0.f;
        sc = MFMA32(ka0, qf[0], sc); sc = MFMA32(ka1, qf[1], sc); sc = MFMA32(ka2, qf[2], sc); sc = MFMA32(ka3, qf[3], sc);
        asm volatile("" :: "v"(sc));
        if (tt + 2 < NT) DIL_GLOAD(ka0, ka1, ka2, ka3, va0, va1, va2, va3, tt + 2);
        tile_rest(tt, sc, 0);
        if (tt + 1 < NT) {
          if (tt + 2 < NT) asm volatile("s_waitcnt vmcnt(8)" ::: "memory"); else asm volatile("s_waitcnt vmcnt(0)" ::: "memory");
          DIL_VSTORE(vb0, vb1, vb2, vb3, 1);
        }
      }
      if (tt + 1 < NT) {
        f32x16 sc;
#pragma unroll
        for (int i = 0; i < 16; ++i) sc[i] = 0.f;
        sc = MFMA32(kb0, qf[0], sc); sc = MFMA32(kb1, qf[1], sc); sc = MFMA32(kb2, qf[2], sc); sc = MFMA32(kb3, qf[3], sc);
        asm volatile("" :: "v"(sc));
        if (tt + 3 < NT) DIL_GLOAD(kb0, kb1, kb2, kb3, vb0, vb1, vb2, vb3, tt + 3);
        tile_rest(tt + 1, sc, 1);
        if (tt + 2 < NT) {
          if (tt + 3 < NT) asm volatile("s_waitcnt vmcnt(8)" ::: "memory"); else asm volatile("s_waitcnt vmcnt(0)" ::: "memory");
          DIL_VSTORE(va0, va1, va2, va3, 0);
        }
      }
    }
    l += __shfl_xor(l, 32);
    float* part = p.dpart() + ((tb + qpos) * 4 + h) * 68 + hh * 4;
    if (MODE == 0) {
#pragma unroll
      for (int g = 0; g < 4; ++g) {
        *reinterpret_cast<float4*>(part + g * 8) = make_float4(o0[4 * g + 0], o0[4 * g + 1], o0[4 * g + 2], o0[4 * g + 3]);
        *reinterpret_cast<float4*>(part + 32 + g * 8) = make_float4(o1[4 * g + 0], o1[4 * g + 1], o1[4 * g + 2], o1[4 * g + 3]);
      }
      if (hh == 0) { part[64] = m; part[65] = l; }
    } else {
      const float mA = part[64 - hh * 4], lA = part[65 - hh * 4];
      const float M = fmaxf(m, mA), sa = __builtin_amdgcn_exp2f(m - M), sb = __builtin_amdgcn_exp2f(mA - M);
      const float il = 1.f / (l * sa + lA * sb);
      u16* orow = p.mixed() + (tb + qpos) * DM + 768 + h * 64 + hh * 4;
#pragma unroll
      for (int g = 0; g < 4; ++g) {
        const float4 a0 = *reinterpret_cast<const float4*>(part + g * 8), a1 = *reinterpret_cast<const float4*>(part + 32 + g * 8);
        uint2 v;
        v.x = pack2((o0[4 * g + 0] * sa + a0.x * sb) * il, (o0[4 * g + 1] * sa + a0.y * sb) * il);
        v.y = pack2((o0[4 * g + 2] * sa + a0.z * sb) * il, (o0[4 * g + 3] * sa + a0.w * sb) * il);
        *reinterpret_cast<uint2*>(orow + g * 8) = v;
        v.x = pack2((o1[4 * g + 0] * sa + a1.x * sb) * il, (o1[4 * g + 1] * sa + a1.y * sb) * il);
        v.y = pack2((o1[4 * g + 2] * sa + a1.z * sb) * il, (o1[4 * g + 3] * sa + a1.w * sb) * il);
        *reinterpret_cast<uint2*>(orow + 32 + g * 8) = v;
      }
    }
  }
}

DI void ph_dil_naive(const Params& p) {
  const int gt = obid() * NTHR + otid(), gs = gridDim.x * NTHR;
  for (int it = gt; it < 4 * 4 * SEQ; it += gs) {
    const int n = it & (SEQ - 1), h = (it >> 12) & 3, b = it >> 14;
    const size_t tb = (size_t)b * SEQ;
    uint4 qp[8];
    float o[64];
#pragma unroll
    for (int d = 0; d < 8; ++d) qp[d] = *reinterpret_cast<const uint4*>(p.proj() + (tb + n) * PWP + C_DQ + h * 64 + d * 8);
    float mx = -1e30f;
    for (int pat = 0; pat < 3; ++pat) {
      const int dil = (pat == 0) ? 1 : (pat == 1 ? 4 : 16);
#pragma unroll 1
      for (int j = -64; j <= 64; ++j) {
        const int pos = n + j * dil;
        if (pos < 0 || pos >= SEQ) continue;
        const u16* kr = p.proj() + (tb + pos) * PWP + C_DK + h * 64;
        float s = 0.f;
#pragma unroll
        for (int d = 0; d < 8; ++d) s = dot8(qp[d], *reinterpret_cast<const uint4*>(kr + d * 8), s);
        s *= 0.125f;
        mx = fmaxf(mx, s);
      }
    }
#pragma unroll
    for (int d = 0; d < 64; ++d) o[d] = 0.f;
    float l = 0.f;
    for (int pat = 0; pat < 3; ++pat) {
      const int dil = (pat == 0) ? 1 : (pat == 1 ? 4 : 16);
#pragma unroll 1
      for (int j = -64; j <= 64; ++j) {
        const int pos = n + j * dil;
        if (pos < 0 || pos >= SEQ) continue;
        const u16* kr = p.proj() + (tb + pos) * PWP + C_DK + h * 64;
        const u16* vr = p.proj() + (tb + pos) * PWP + C_DV + h * 64;
        float s = 0.f;
#pragma unroll
        for (int d = 0; d < 8; ++d) s = dot8(qp[d], *reinterpret_cast<const uint4*>(kr + d * 8), s);
        s *= 0.125f;
        const float pe = __expf(s - mx);
        l += pe;
#pragma unroll
        for (int d = 0; d < 64; d += 8) {
          float vf[8];
          ld8(vr + d, vf);
#pragma unroll
          for (int jj = 0; jj < 8; ++jj) o[d + jj] += pe * vf[jj];
        }
      }
    }
    const float il = 1.f / l;
#pragma unroll
    for (int d = 0; d < 64; d += 8) {
      uint4 ov;
      ov.x = pack2(o[d + 0] * il, o[d + 1] * il);
      ov.y = pack2(o[d + 2] * il, o[d + 3] * il);
      ov.z = pack2(o[d + 4] * il, o[d + 5] * il);
      ov.w = pack2(o[d + 6] * il, o[d + 7] * il);
      *reinterpret_cast<uint4*>(p.mixed() + (tb + n) * DM + 768 + h * 64 + d) = ov;
    }
  }
}

DI void ph_ssd_naive(const Params& p, int L) {
  const int gt = obid() * NTHR + otid(), gs = gridDim.x * NTHR;
  for (int it = gt; it < 4 * 4 * 4 * SEQ; it += gs) {
    const int l = it & (SEQ - 1), pq = (it >> 12) & 3, h = (it >> 14) & 3, b = it >> 16;
    const int g = h >> 1;
    const size_t tb = (size_t)b * SEQ;
    uint4 cl[16];
    float acc[16];
#pragma unroll
    for (int d = 0; d < 16; ++d) cl[d] = *reinterpret_cast<const uint4*>(p.xbc() + (tb + l) * 768 + 512 + g * 128 + d * 8);
#pragma unroll
    for (int d = 0; d < 16; ++d) acc[d] = 0.f;
    const float pl = p.cs()[(tb + l) * 8 + h], rl = p.cs()[(tb + l) * 8 + 4 + h];
#pragma unroll 1
    for (int s = 0; s < SEQ; ++s) {
      const u16* br = p.xbc() + (tb + s) * 768 + 256 + g * 128;
      float cbv = 0.f;
#pragma unroll
      for (int d = 0; d < 16; ++d) cbv = dot8(cl[d], *reinterpret_cast<const uint4*>(br + d * 8), cbv);
      float w;
      if (s <= l) w = expf(pl - p.cs()[(tb + s) * 8 + h]) * p.dtv()[(tb + s) * 8 + h];
      else w = expf(rl - p.cs()[(tb + s) * 8 + 4 + h]) * p.dtv()[(tb + s) * 8 + 4 + h];
      cbv *= w;
      const u16* xr = p.xbc() + (tb + s) * 768 + h * 64 + pq * 16;
#pragma unroll
      for (int d = 0; d < 16; d += 8) {
        float xf[8];
        ld8(xr + d, xf);
#pragma unroll
        for (int j = 0; j < 8; ++j) acc[d + j] += cbv * xf[j];
      }
    }
    const float dsk = p.ssm_d[L * 4 + h];
#pragma unroll
    for (int d = 0; d < 16; ++d) {
      const int c = h * 64 + pq * 16 + d;
      const float xv = bf2f(p.xbc()[(tb + l) * 768 + c]);
      const float z = bf2f(p.proj()[(tb + l) * PWP + C_Z + c]);
      p.ybuf()[(tb + l) * 256 + c] = (acc[d] + dsk * xv) * silu(z);
    }
  }
}

DI void ph_ssd_norm(const Params& p, int L) {
  const int tid_ = otid(); const int lane = tid_ & 63, gw = (obid() * NTHR + tid_) >> 6, nw = gridDim.x * (NTHR / 64);
  const float* nwt = p.ssm_norm_w + L * 256;
  for (int t = gw; t < T; t += nw) {
    const float4 v = *reinterpret_cast<const float4*>(p.ybuf() + (size_t)t * 256 + lane * 4);
    float ss = wave_sum(v.x * v.x + v.y * v.y + v.z * v.z + v.w * v.w);
    const float rstd = rsqrtf(ss * (1.f / 256.f) + 1e-6f);
    const float4 ww = *reinterpret_cast<const float4*>(nwt + lane * 4);
    uint2 o;
    o.x = pack2(v.x * rstd * ww.x, v.y * rstd * ww.y);
    o.y = pack2(v.z * rstd * ww.z, v.w * rstd * ww.w);
    *reinterpret_cast<uint2*>(p.mixed() + (size_t)t * DM + 512 + lane * 4) = o;
  }
}

#define MFMA16(a, b, c) __builtin_amdgcn_mfma_f32_16x16x32_bf16((a), (b), (c), 0, 0, 0)
template <int MT, int NT, int KS>
DI void wave_mm(f32x4 (&acc)[MT][NT], const u16* a0, int lda, const u16* b0, int ldb, int fr, int fq) {
#pragma unroll
  for (int ks = 0; ks < KS; ++ks) {
    bf16x8 af[MT], bfv[NT];
#pragma unroll
    for (int m = 0; m < MT; ++m) af[m] = *reinterpret_cast<const bf16x8*>(a0 + (m * 16 + fr) * lda + ks * 32 + fq * 8);
#pragma unroll
    for (int n = 0; n < NT; ++n) bfv[n] = *reinterpret_cast<const bf16x8*>(b0 + (n * 16 + fr) * ldb + ks * 32 + fq * 8);
#pragma unroll
    for (int m = 0; m < MT; ++m)
#pragma unroll
      for (int n = 0; n < NT; ++n) acc[m][n] = MFMA16(af[m], bfv[n], acc[m][n]);
  }
}
template <int MT, int NT>
DI void zero_acc(f32x4 (&acc)[MT][NT]) {
#pragma unroll
  for (int m = 0; m < MT; ++m)
#pragma unroll
    for (int n = 0; n < NT; ++n) acc[m][n] = f32x4{0.f, 0.f, 0.f, 0.f};
}
template <int NROWS, int NCOLS>
DI void stage_rows(u16* dst, int ldd, const u16* src, size_t lsrc, int tid) {
  constexpr int CPR = NCOLS / 8, NCH = NROWS * CPR / NTHR;
  static_assert(NROWS * CPR % NTHR == 0, "tile must be a multiple of 512 chunks");
  uint4 r[NCH];
#pragma unroll
  for (int i = 0; i < NCH; ++i) {
    const int c = tid + i * NTHR, row = c / CPR, cc = c % CPR;
    r[i] = *reinterpret_cast<const uint4*>(src + (size_t)row * lsrc + cc * 8);
  }
#pragma unroll
  for (int i = 0; i < NCH; ++i) {
    const int c = tid + i * NTHR, row = c / CPR, cc = c % CPR;
    *reinterpret_cast<uint4*>(dst + row * ldd + cc * 8) = r[i];
  }
}
template <int NCOLS, class W>
DI void stage_T(u16* dst, int ldd, const u16* src, size_t lsrc, int tid, W w) {
  constexpr int NCH = 128 * (NCOLS / 8) / NTHR;
  uint4 r[NCH];
#pragma unroll
  for (int i = 0; i < NCH; ++i) {
    const int c = tid + i * NTHR, j = c & 127, cc = c >> 7;
    r[i] = *reinterpret_cast<const uint4*>(src + (size_t)j * lsrc + cc * 8);
  }
#pragma unroll
  for (int i = 0; i < NCH; ++i) {
    const int c = tid + i * NTHR, j = c & 127, cc = c >> 7;
    float f[8];
    unpack8(r[i], f);
    const float wj = w(j);
#pragma unroll
    for (int e = 0; e < 8; ++e) dst[(cc * 8 + e) * ldd + j] = f2bf(f[e] * wj);
  }
}

template <int NROWS, int NCOLS>
DI void stage_rows_ld(uint4 (&r)[NROWS * (NCOLS / 8) / NTHR], const u16* src, size_t lsrc, int tid) {
  constexpr int CPR = NCOLS / 8, NCH = NROWS * CPR / NTHR;
#pragma unroll
  for (int i = 0; i < NCH; ++i) {
    const int c = tid + i * NTHR, row = c / CPR, cc = c % CPR;
    r[i] = *reinterpret_cast<const uint4*>(src + (size_t)row * lsrc + cc * 8);
  }
}
template <int NROWS, int NCOLS>
DI void stage_rows_st(u16* dst, int ldd, const uint4 (&r)[NROWS * (NCOLS / 8) / NTHR], int tid) {
  constexpr int CPR = NCOLS / 8, NCH = NROWS * CPR / NTHR;
#pragma unroll
  for (int i = 0; i < NCH; ++i) {
    const int c = tid + i * NTHR, row = c / CPR, cc = c % CPR;
    *reinterpret_cast<uint4*>(dst + row * ldd + cc * 8) = r[i];
  }
}
template <int NCOLS>
DI void stage_T_ld(uint4 (&r)[128 * (NCOLS / 8) / NTHR], const u16* src, size_t lsrc, int tid) {
  constexpr int NCH = 128 * (NCOLS / 8) / NTHR;
#pragma unroll
  for (int i = 0; i < NCH; ++i) {
    const int c = tid + i * NTHR, j = c & 127, cc = c >> 7;
    r[i] = *reinterpret_cast<const uint4*>(src + (size_t)j * lsrc + cc * 8);
  }
}
template <int NCOLS, class W>
DI void stage_T_st(u16* dst, int ldd, const uint4 (&r)[128 * (NCOLS / 8) / NTHR], int tid, W w) {
  constexpr int NCH = 128 * (NCOLS / 8) / NTHR;
#pragma unroll
  for (int i = 0; i < NCH; ++i) {
    const int c = tid + i * NTHR, j = c & 127, cc = c >> 7;
    float f[8];
    unpack8(r[i], f);
    const float wj = w(j);
#pragma unroll
    for (int e = 0; e < 8; ++e) dst[(cc * 8 + e) * ldd + j] = f2bf(f[e] * wj);
  }
}

DI void ph_ret_a(const Params& p, char* smem, int item) {
  const int tid = otid(), wid = tid >> 6, lane = tid & 63, fr = lane & 15, fq = lane >> 4;
  u16* sVt = reinterpret_cast<u16*>(smem);
  u16* sKf = sVt + 64 * 136;
  u16* sKb = sKf + 64 * 136;
  {
    const int c = item & 31, bh = item >> 5, b = bh >> 2, h = bh & 3;
    const float lg0 = log1pf(-exp2f(-5.f - (float)h)), lg1 = log1pf(-exp2f(-5.5f - (float)h));
    const u16* src = p.proj() + ((size_t)b * SEQ + c * 128) * PWP;
    {
      uint4 rv[2], rk[2];
      stage_T_ld<64>(rv, src + C_RV + h * 64, PWP, tid);
      stage_T_ld<64>(rk, src + C_RK + h * 64, PWP, tid);
      stage_T_st<64>(sVt, 136, rv, tid, [](int) { return 1.f; });
      stage_T_st<64>(sKf, 136, rk, tid, [&](int j) { return __expf(lg0 * (float)(127 - j)); });
      stage_T_st<64>(sKb, 136, rk, tid, [&](int j) { return __expf(lg1 * (float)j); });
    }
    __syncthreads();
    const int dir = wid >> 2, q = wid & 3;
    f32x4 acc[1][4];
    zero_acc(acc);
    wave_mm<1, 4, 4>(acc, sVt + q * 16 * 136, 136, dir ? sKb : sKf, 136, fr, fq);
    float* out = p.rU() + ((size_t)(bh * 32 + c) * 2 + dir) * 4096;
#pragma unroll
    for (int n = 0; n < 4; ++n)
#pragma unroll
      for (int j = 0; j < 4; ++j) out[(q * 16 + fq * 4 + j) * 64 + n * 16 + fr] = acc[0][n][j];
    __syncthreads();
  }
}
DI void ph_ret_scan(const Params& p) {
  const int gt = obid() * NTHR + otid(), gs = gridDim.x * NTHR;
  for (int it = gt; it < 16 * 2 * 4096; it += gs) {
    const int e = it & 4095, dir = (it >> 12) & 1, bh = it >> 13, h = bh & 3;
    const float lg = log1pf(-exp2f((dir ? -5.5f : -5.f) - (float)h));
    const float cd = __expf(lg * 128.f);
    float u[32];
#pragma unroll
    for (int c = 0; c < 32; ++c) u[c] = p.rU()[((size_t)(bh * 32 + c) * 2 + dir) * 4096 + e];
    float st = 0.f;
    if (dir == 0) {
#pragma unroll
      for (int c = 0; c < 32; ++c) {
        p.rS()[((size_t)(bh * 32 + c) * 2 + dir) * 4096 + e] = f2bf(st);
        st = st * cd + u[c];
      }
    } else {
#pragma unroll
      for (int c = 31; c >= 0; --c) {
        p.rS()[((size_t)(bh * 32 + c) * 2 + dir) * 4096 + e] = f2bf(st);
        st = st * cd + u[c];
      }
    }
  }
}
DI void ph_ret_c(const Params& p, char* smem, int item) {
  const int tid = otid(), wid = tid >> 6, lane = tid & 63, fr = lane & 15, fq = lane >> 4;
  u16* sQ = reinterpret_cast<u16*>(smem);
  u16* sK = sQ + 128 * 72;
  u16* sVt = sK + 128 * 72;
  u16* sSf = sVt + 64 * 136;
  u16* sSb = sSf + 64 * 72;
  u16* sP = sSb + 64 * 72;
  {
    const int c = item & 31, bh = item >> 5, b = bh >> 2, h = bh & 3;
    const float lg0 = log1pf(-exp2f(-5.f - (float)h)), lg1 = log1pf(-exp2f(-5.5f - (float)h));
    const size_t t0 = (size_t)b * SEQ + c * 128;
    const u16* src = p.proj() + t0 * PWP;
    {
      uint4 rq[2], rk[2], rv[2], rf[1], rb[1];
      stage_rows_ld<128, 64>(rq, src + C_RQ + h * 64, PWP, tid);
      stage_rows_ld<128, 64>(rk, src + C_RK + h * 64, PWP, tid);
      stage_T_ld<64>(rv, src + C_RV + h * 64, PWP, tid);
      stage_rows_ld<64, 64>(rf, p.rS() + ((size_t)(bh * 32 + c) * 2 + 0) * 4096, 64, tid);
      stage_rows_ld<64, 64>(rb, p.rS() + ((size_t)(bh * 32 + c) * 2 + 1) * 4096, 64, tid);
      stage_rows_st<128, 64>(sQ, 72, rq, tid);
      stage_rows_st<128, 64>(sK, 72, rk, tid);
      stage_T_st<64>(sVt, 136, rv, tid, [](int) { return 1.f; });
      stage_rows_st<64, 64>(sSf, 72, rf, tid);
      stage_rows_st<64, 64>(sSb, 72, rb, tid);
    }
    __syncthreads();
    {
      const int wr = wid >> 1, wc = wid & 1;
      f32x4 sacc[2][4];
      zero_acc(sacc);
      wave_mm<2, 4, 2>(sacc, sQ + wr * 32 * 72, 72, sK + wc * 64 * 72, 72, fr, fq);
#pragma unroll
      for (int m = 0; m < 2; ++m)
#pragma unroll
        for (int n = 0; n < 4; ++n)
#pragma unroll
          for (int j = 0; j < 4; ++j) {
            const int i = wr * 32 + m * 16 + fq * 4 + j, jj = wc * 64 + n * 16 + fr;
            const float dcy = (jj <= i) ? __expf(lg0 * (float)(i - jj)) : __expf(lg1 * (float)(jj - i));
            sP[i * 136 + jj] = f2bf(sacc[m][n][j] * dcy);
          }
    }
    __syncthreads();
    {
      f32x4 ai[1][4], af_[1][4], ab_[1][4];
      zero_acc(ai); zero_acc(af_); zero_acc(ab_);
      wave_mm<1, 4, 4>(ai, sP + wid * 16 * 136, 136, sVt, 136, fr, fq);
      wave_mm<1, 4, 2>(af_, sQ + wid * 16 * 72, 72, sSf, 72, fr, fq);
      wave_mm<1, 4, 2>(ab_, sQ + wid * 16 * 72, 72, sSb, 72, fr, fq);
#pragma unroll
      for (int j = 0; j < 4; ++j) {
        const int i = wid * 16 + fq * 4 + j;
        const float xf = __expf(lg0 * (float)(i + 1)), xb = __expf(lg1 * (float)(128 - i));
        float o[4], sum = 0.f;
#pragma unroll
        for (int n = 0; n < 4; ++n) { o[n] = ai[0][n][j] + xf * af_[0][n][j] + xb * ab_[0][n][j]; sum += o[n]; }
#pragma unroll
        for (int sft = 1; sft < 16; sft <<= 1) sum += __shfl_xor(sum, sft);
        const float mu = sum * (1.f / 64.f);
        float var = 0.f;
#pragma unroll
        for (int n = 0; n < 4; ++n) var += (o[n] - mu) * (o[n] - mu);
#pragma unroll
        for (int sft = 1; sft < 16; sft <<= 1) var += __shfl_xor(var, sft);
        const float rs = rsqrtf(var * (1.f / 64.f) + 1e-5f);
#pragma unroll
        for (int n = 0; n < 4; ++n) {
          const float g = bf2f(p.proj()[(t0 + i) * PWP + C_RG + h * 64 + n * 16 + fr]);
          p.mixed()[(t0 + i) * DM + h * 64 + n * 16 + fr] = f2bf(silu(g) * (o[n] - mu) * rs);
        }
      }
    }
    __syncthreads();
  }
}

DI void ssd_local_cumsum(const Params& p, int L, size_t t0, float* cum, float* dtl, int wid, int lane) {
  const int dir = wid >> 2, h = wid & 3;
  const float a = -__expf(p.a_log[L * 8 + dir * 4 + h]);
  float d0, d1;
  if (dir == 0) { d0 = p.dtv()[(t0 + 2 * lane) * 8 + h]; d1 = p.dtv()[(t0 + 2 * lane + 1) * 8 + h]; }
  else { d0 = p.dtv()[(t0 + 127 - 2 * lane) * 8 + 4 + h]; d1 = p.dtv()[(t0 + 126 - 2 * lane) * 8 + 4 + h]; }
  float v0 = d0 * a, v1 = v0 + d1 * a;
  float run = v1;
#pragma unroll
  for (int o = 1; o < 64; o <<= 1) {
    const float u = __shfl_up(run, o);
    if (lane >= o) run += u;
  }
  const float excl = run - v1;
  v0 += excl; v1 += excl;
  float* cr = cum + (dir * 4 + h) * 128;
  float* dr = dtl + (dir * 4 + h) * 128;
  if (dir == 0) { cr[2 * lane] = v0; cr[2 * lane + 1] = v1; dr[2 * lane] = d0; dr[2 * lane + 1] = d1; }
  else { cr[127 - 2 * lane] = v0; cr[126 - 2 * lane] = v1; dr[127 - 2 * lane] = d0; dr[126 - 2 * lane] = d1; }
}

DI void ph_ssd_a(const Params& p, int L, char* smem, int item) {
  const int tid = otid(), wid = tid >> 6, lane = tid & 63, fr = lane & 15, fq = lane >> 4;
  u16* sBt = reinterpret_cast<u16*>(smem);
  u16* sXf = sBt + 2 * 128 * 136;
  u16* sXb = sXf + 64 * 136;
  float* cum = reinterpret_cast<float*>(sXb + 64 * 136);
  float* dtl = cum + 8 * 128;
  {
    const int c = item & 31, b = item >> 5;
    const size_t t0 = (size_t)b * SEQ + c * 128;
    ssd_local_cumsum(p, L, t0, cum, dtl, wid, lane);
    stage_T<256>(sBt, 136, p.xbc() + t0 * 768 + 256, 768, tid, [](int) { return 1.f; });
    __syncthreads();
    if (tid < 8) {
      const int dir = tid >> 2;
      p.cdec()[(size_t)item * 8 + tid] = __expf(dir ? cum[tid * 128 + 0] : cum[tid * 128 + 127]);
    }
    for (int h = 0; h < 4; ++h) {
      const float* cf = cum + h * 128;
      const float* cb = cum + (4 + h) * 128;
      const float* df = dtl + h * 128;
      const float* db = dtl + (4 + h) * 128;
      const float endf = cf[127], endb = cb[0];
      {
        uint4 rx[2];
        stage_T_ld<64>(rx, p.xbc() + t0 * 768 + h * 64, 768, tid);
        stage_T_st<64>(sXf, 136, rx, tid, [&](int l) { return __expf(endf - cf[l]) * df[l]; });
        stage_T_st<64>(sXb, 136, rx, tid, [&](int l) { return __expf(endb - cb[l]) * db[l]; });
      }
      __syncthreads();
      const int dir = wid >> 2, q = wid & 3, g = h >> 1;
      f32x4 acc[4][2];
      zero_acc(acc);
      wave_mm<4, 2, 4>(acc, dir ? sXb : sXf, 136, sBt + (g * 128 + q * 32) * 136, 136, fr, fq);
      float* out = p.sU() + ((size_t)item * 8 + h * 2 + dir) * 8192;
#pragma unroll
      for (int m = 0; m < 4; ++m)
#pragma unroll
        for (int n = 0; n < 2; ++n)
#pragma unroll
          for (int j = 0; j < 4; ++j) out[(m * 16 + fq * 4 + j) * 128 + q * 32 + n * 16 + fr] = acc[m][n][j];
      __syncthreads();
    }
  }
}
DI void ph_ssd_scan(const Params& p) {
  const int gt = obid() * NTHR + otid(), gs = gridDim.x * NTHR;
  for (int it = gt; it < 4 * 8 * 8192; it += gs) {
    const int e = it & 8191, hd = (it >> 13) & 7, b = it >> 16;
    const int dir = hd & 1, h = hd >> 1;
    float u[32];
#pragma unroll
    for (int c = 0; c < 32; ++c) u[c] = p.sU()[((size_t)(b * 32 + c) * 8 + hd) * 8192 + e];
    float st = 0.f;
    if (dir == 0) {
#pragma unroll
      for (int c = 0; c < 32; ++c) {
        p.sS()[((size_t)(b * 32 + c) * 8 + hd) * 8192 + e] = f2bf(st);
        st = st * p.cdec()[(size_t)(b * 32 + c) * 8 + dir * 4 + h] + u[c];
      }
    } else {
#pragma unroll
      for (int c = 31; c >= 0; --c) {
        p.sS()[((size_t)(b * 32 + c) * 8 + hd) * 8192 + e] = f2bf(st);
        st = st * p.cdec()[(size_t)(b * 32 + c) * 8 + dir * 4 + h] + u[c];
      }
    }
  }
}
DI void ph_ssd_c(const Params& p, int L, char* smem, int item) {
  const int tid = otid(), wid = tid >> 6, lane = tid & 63, fr = lane & 15, fq = lane >> 4;
  u16* sC = reinterpret_cast<u16*>(smem);
  u16* sB = sC + 128 * 136;
  u16* sXt = sB + 128 * 136;
  u16* sSf = sXt + 64 * 136;
  u16* sSb = sSf + 64 * 136;
  float* cum = reinterpret_cast<float*>(sSb + 64 * 136);
  float* dtl = cum + 8 * 128;
  {
    const int c = item & 31, b = item >> 5;
    const size_t t0 = (size_t)b * SEQ + c * 128;
    ssd_local_cumsum(p, L, t0, cum, dtl, wid, lane);
    float ssq[4] = {0.f, 0.f, 0.f, 0.f};
#pragma unroll 1
    for (int g = 0; g < 2; ++g) {
      {
        uint4 rc[4], rb4[4];
        stage_rows_ld<128, 128>(rc, p.xbc() + t0 * 768 + 512 + g * 128, 768, tid);
        stage_rows_ld<128, 128>(rb4, p.xbc() + t0 * 768 + 256 + g * 128, 768, tid);
        stage_rows_st<128, 128>(sC, 136, rc, tid);
        stage_rows_st<128, 128>(sB, 136, rb4, tid);
      }
      __syncthreads();
      const int wr = wid >> 1, wc = wid & 1;
      f32x4 G[2][4];
      zero_acc(G);
      wave_mm<2, 4, 4>(G, sC + wr * 32 * 136, 136, sB + wc * 64 * 136, 136, fr, fq);
      __syncthreads();
#pragma unroll 1
      for (int hl = 0; hl < 2; ++hl) {
        const int h = g * 2 + hl;
        const float* cf = cum + h * 128;
        const float* cb = cum + (4 + h) * 128;
        const float* df = dtl + h * 128;
        const float* db = dtl + (4 + h) * 128;
        uint4 rxt[2], rsf[2], rsb[2];
        stage_T_ld<64>(rxt, p.xbc() + t0 * 768 + h * 64, 768, tid);
        stage_rows_ld<64, 128>(rsf, p.sS() + ((size_t)item * 8 + h * 2 + 0) * 8192, 128, tid);
        stage_rows_ld<64, 128>(rsb, p.sS() + ((size_t)item * 8 + h * 2 + 1) * 8192, 128, tid);
#pragma unroll
        for (int m = 0; m < 2; ++m)
#pragma unroll
          for (int n = 0; n < 4; ++n)
#pragma unroll
            for (int j = 0; j < 4; ++j) {
              const int l = wr * 32 + m * 16 + fq * 4 + j, sx = wc * 64 + n * 16 + fr;
              const float w = (sx <= l) ? __expf(cf[l] - cf[sx]) * df[sx] : __expf(cb[l] - cb[sx]) * db[sx];
              sB[l * 136 + sx] = f2bf(G[m][n][j] * w);
            }
        stage_T_st<64>(sXt, 136, rxt, tid, [](int) { return 1.f; });
        stage_rows_st<64, 128>(sSf, 136, rsf, tid);
        stage_rows_st<64, 128>(sSb, 136, rsb, tid);
        __syncthreads();
        f32x4 yd[1][4], yf[1][4], yb[1][4];
        zero_acc(yd); zero_acc(yf); zero_acc(yb);
        wave_mm<1, 4, 4>(yd, sB + wid * 16 * 136, 136, sXt, 136, fr, fq);
        wave_mm<1, 4, 4>(yf, sC + wid * 16 * 136, 136, sSf, 136, fr, fq);
        wave_mm<1, 4, 4>(yb, sC + wid * 16 * 136, 136, sSb, 136, fr, fq);
        const float dsk = p.ssm_d[L * 4 + h];
#pragma unroll
        for (int j = 0; j < 4; ++j) {
          const int l = wid * 16 + fq * 4 + j;
          const float ef = __expf(cf[l]), eb = __expf(cb[l]);
#pragma unroll
          for (int n = 0; n < 4; ++n) {
            const int ch = h * 64 + n * 16 + fr;
            const float xv = bf2f(p.xbc()[(t0 + l) * 768 + ch]);
            const float z = bf2f(p.proj()[(t0 + l) * PWP + C_Z + ch]);
            const float yv = (yd[0][n][j] + ef * yf[0][n][j] + eb * yb[0][n][j] + dsk * xv) * silu(z);
            ssq[j] += yv * yv;
            p.ybuf()[(t0 + l) * 256 + ch] = yv;
          }
        }
        __syncthreads();
      }
    }
    const float* nwt = p.ssm_norm_w + L * 256;
#pragma unroll
    for (int j = 0; j < 4; ++j) {
      float ss = ssq[j];
#pragma unroll
      for (int sft = 1; sft < 16; sft <<= 1) ss += __shfl_xor(ss, sft);
      const float rstd = rsqrtf(ss * (1.f / 256.f) + 1e-6f);
      const int l = wid * 16 + fq * 4 + j;
#pragma unroll
      for (int hn = 0; hn < 16; ++hn) {
        const int ch = hn * 16 + fr;
        p.mixed()[(t0 + l) * DM + 512 + ch] = f2bf(p.ybuf()[(t0 + l) * 256 + ch] * rstd * nwt[ch]);
      }
    }
  }
}

template <bool XIN_F32>
struct CfgOutproj {
  static constexpr bool PERM = true;
  int K; const Params* p; int L; int bid, nb; const void* xin; u16* xout;
  DI bool next(int i, pg8::Unit& u) const { const int t = i * nb + bid; if (t >= 64 * 4) return false; u.pm = t & 63; u.pn = t >> 6; return true; }
  DI const char* a_base(const pg8::Unit& u) const { return (const char*)(p->mixed() + (size_t)u.pm * 256 * DM); }
  DI const char* b_base(const pg8::Unit& u) const { return (const char*)(p->WoutT() + ((size_t)L * DM + (size_t)u.pn * 256) * DM); }
  DI void a_off(const pg8::Unit&, int R0, int C0, int R1, int C1, unsigned (&vo)[4]) const {
    vo[0] = (unsigned)(R0 * DM + C0) * 2u; vo[1] = (unsigned)(R1 * DM + C1) * 2u;
    vo[2] = vo[0] + 128u * DM * 2u; vo[3] = vo[1] + 128u * DM * 2u;
  }
  DI void epi(const f32x4 (&acc)[2][2][4][2], const pg8::Unit& u, int wr, int wc, int fr, int fq) const {
    const int row0 = u.pm * 256 + wr * 64 + fr, col0 = u.pn * 256 + wc * 32 + 8 * fq;
#pragma unroll
    for (int ai = 0; ai < 2; ++ai)
#pragma unroll
      for (int m = 0; m < 4; ++m) {
        const size_t ro = (size_t)(row0 + ai * 128 + m * 16) * DM + col0;
#pragma unroll
        for (int bj = 0; bj < 2; ++bj) {
          const size_t o = ro + bj * 128;
          float4 x0, x1;
          if (XIN_F32) {
            x0 = *reinterpret_cast<const float4*>(static_cast<const float*>(xin) + o);
            x1 = *reinterpret_cast<const float4*>(static_cast<const float*>(xin) + o + 4);
          } else {
            const uint4 q = *reinterpret_cast<const uint4*>(static_cast<const u16*>(xin) + o);
            x0 = bf4_to_f4(make_uint2(q.x, q.y)); x1 = bf4_to_f4(make_uint2(q.z, q.w));
          }
          const f32x4 a0 = acc[ai][bj][m][0], a1 = acc[ai][bj][m][1];
          uint4 w;
          w.x = pack2(x0.x + a0[0], x0.y + a0[1]); w.y = pack2(x0.z + a0[2], x0.w + a0[3]);
          w.z = pack2(x1.x + a1[0], x1.y + a1[1]); w.w = pack2(x1.z + a1[2], x1.w + a1[3]);
          *reinterpret_cast<uint4*>(xout + o) = w;
        }
      }
  }
};
DI void ph_outproj(const Params& p, int L, char* smem) {
  if (L == 0) {
    CfgOutproj<true> c; c.K = DM; c.p = &p; c.L = L; c.bid = obid(); c.nb = gridDim.x; c.xin = p.x; c.xout = p.xres();
    pg8::gemm_phase((pg8::lds_u8*)smem, c);
  } else {
    CfgOutproj<false> c; c.K = DM; c.p = &p; c.L = L; c.bid = obid(); c.nb = gridDim.x; c.xin = p.xres2(); c.xout = p.xres();
    pg8::gemm_phase((pg8::lds_u8*)smem, c);
  }
}

DI void ph_rms2_router(const Params& p, int L, const u16* xres, char* smem) {
  const int tid = otid(), lane = tid & 63, gw = (obid() * NTHR + tid) >> 6, nw = gridDim.x * (NTHR / 64);
  const float* w = p.ln2_w + L * DM;
  const float* rw = p.router_w + (size_t)L * DM * 16;
  float4* srw = reinterpret_cast<float4*>(smem);
  for (int i = tid; i < 4096; i += NTHR) {
    const int c = i >> 2, e4 = i & 3;
    srw[(e4 * 4 + (c & 3)) * 256 + (c >> 2)] = *reinterpret_cast<const float4*>(rw + (size_t)i * 4);
  }
  __syncthreads();
  const int b5 = (lane >> 5) & 1, b4 = (lane >> 4) & 1, b3 = (lane >> 3) & 1, b2 = (lane >> 2) & 1;
  const int my_e = 8 * b5 + 4 * b4 + 2 * b3 + b2;
  float4 v[4];
  if (gw < T) {
#pragma unroll
    for (int i = 0; i < 4; ++i) v[i] = bf4_to_f4(*reinterpret_cast<const uint2*>(xres + (size_t)gw * DM + (i * 64 + lane) * 4));
  }
  for (int t = gw; t < T; t += nw) {
    uint2 vnx[4];
    const int tn = (t + nw < T) ? (t + nw) : t;
#pragma unroll
    for (int i = 0; i < 4; ++i) vnx[i] = *reinterpret_cast<const uint2*>(xres + (size_t)tn * DM + (i * 64 + lane) * 4);
    float ss = 0.f;
#pragma unroll
    for (int i = 0; i < 4; ++i) ss += v[i].x * v[i].x + v[i].y * v[i].y + v[i].z * v[i].z + v[i].w * v[i].w;
    ss = wave_sum(ss);
    const float rstd = rsqrtf(ss * (1.f / DM) + 1e-6f);
    float lg[16];
#pragma unroll
    for (int e = 0; e < 16; ++e) lg[e] = 0.f;
#pragma unroll
    for (int i = 0; i < 4; ++i) {
      const int q = i * 64 + lane;
      const float4 ww = *reinterpret_cast<const float4*>(w + q * 4);
      const float hv[4] = {v[i].x * rstd * ww.x, v[i].y * rstd * ww.y, v[i].z * rstd * ww.z, v[i].w * rstd * ww.w};
      *reinterpret_cast<unsigned*>(p.hn8() + (size_t)t * DM + q * 4) =
          pk4_f8(hv[0] * F8_H_SCALE, hv[1] * F8_H_SCALE, hv[2] * F8_H_SCALE, hv[3] * F8_H_SCALE);
#pragma unroll
      for (int j = 0; j < 4; ++j)
#pragma unroll
        for (int e4 = 0; e4 < 4; ++e4) {
          const float4 r = srw[(e4 * 4 + j) * 256 + q];
          lg[e4 * 4 + 0] += hv[j] * r.x; lg[e4 * 4 + 1] += hv[j] * r.y;
          lg[e4 * 4 + 2] += hv[j] * r.z; lg[e4 * 4 + 3] += hv[j] * r.w;
        }
      __builtin_amdgcn_sched_barrier(0);
    }
#pragma unroll
    for (int k = 0; k < 8; ++k) {
      const float send = b5 ? lg[k] : lg[k + 8], keep = b5 ? lg[k + 8] : lg[k];
      lg[k] = keep + __shfl_xor(send, 32);
    }
#pragma unroll
    for (int k = 0; k < 4; ++k) {
      const float send = b4 ? lg[k] : lg[k + 4], keep = b4 ? lg[k + 4] : lg[k];
      lg[k] = keep + __shfl_xor(send, 16);
    }
#pragma unroll
    for (int k = 0; k < 2; ++k) {
      const float send = b3 ? lg[k] : lg[k + 2], keep = b3 ? lg[k + 2] : lg[k];
      lg[k] = keep + __shfl_xor(send, 8);
    }
    float lv;
    {
      const float send = b2 ? lg[0] : lg[1], keep = b2 ? lg[1] : lg[0];
      lv = keep + __shfl_xor(send, 4);
    }
    lv += __shfl_xor(lv, 2);
    lv += __shfl_xor(lv, 1);
    float mx = lv;
    mx = fmaxf(mx, __shfl_xor(mx, 4)); mx = fmaxf(mx, __shfl_xor(mx, 8));
    mx = fmaxf(mx, __shfl_xor(mx, 16)); mx = fmaxf(mx, __shfl_xor(mx, 32));
    const float ex = expf(lv - mx);
    float den = ex;
    den += __shfl_xor(den, 4); den += __shfl_xor(den, 8); den += __shfl_xor(den, 16); den += __shfl_xor(den, 32);
    if ((lane & 3) == 0) { p.aff()[(size_t)t * 16 + my_e] = ex / den; p.inv()[(size_t)t * 16 + my_e] = -1; }
#pragma unroll
    for (int i = 0; i < 4; ++i) v[i] = bf4_to_f4(vnx[i]);
  }
}

DI int block_sum_i(int v, int* red, int tid) {
#pragma unroll
  for (int o = 32; o > 0; o >>= 1) v += __shfl_xor(v, o);
  __syncthreads();
  if ((tid & 63) == 0) red[tid >> 6] = v;
  __syncthreads();
  int t = 0;
#pragma unroll
  for (int w = 0; w < NTHR / 64; ++w) t += red[w];
  return t;
}
DI void ph_topk(const Params& p, char* smem) {
  int* red = reinterpret_cast<int*>(smem);
  int* wsum = red + 16;
  const int tid = otid(), wid = tid >> 6, lane = tid & 63;
  for (int it = obid(); it < 64; it += gridDim.x) {
    const int e = it & 15, b = it >> 4;
    unsigned v[8];
#pragma unroll
    for (int i = 0; i < 8; ++i) v[i] = __float_as_uint(p.aff()[(size_t)(b * SEQ + tid * 8 + i) * 16 + e]);
    unsigned thr = 0;
#pragma unroll 1
    for (int bit = 30; bit >= 0; --bit) {
      const unsigned cand = thr | (1u << bit);
      int cnt = 0;
#pragma unroll
      for (int i = 0; i < 8; ++i) cnt += (v[i] >= cand) ? 1 : 0;
      if (block_sum_i(cnt, red, tid) >= 512) thr = cand;
    }
    int ngt = 0, ntie = 0;
#pragma unroll
    for (int i = 0; i < 8; ++i) { ngt += (v[i] > thr) ? 1 : 0; ntie += (v[i] == thr) ? 1 : 0; }
    int ig = ngt, itie = ntie;
#pragma unroll
    for (int o = 1; o < 64; o <<= 1) {
      const int a = __shfl_up(ig, o), c = __shfl_up(itie, o);
      if (lane >= o) { ig += a; itie += c; }
    }
    __syncthreads();
    if (lane == 63) { wsum[wid] = ig; wsum[8 + wid] = itie; }
    __syncthreads();
    int og = 0, ot = 0, totg = 0;
#pragma unroll
    for (int w = 0; w < 8; ++w) {
      const int a = wsum[w], c = wsum[8 + w];
      if (w < wid) { og += a; ot += c; }
      totg += a;
    }
    int pg = og + ig - ngt, pt = ot + itie - ntie;
    const int base = (e * 4 + b) * 512;
#pragma unroll
    for (int i = 0; i < 8; ++i) {
      int slot = -1;
      if (v[i] > thr) { slot = pg; ++pg; }
      else if (v[i] == thr) { if (totg + pt < 512) slot = totg + pt; ++pt; }
      if (slot >= 0) {
        p.tok()[base + slot] = b * SEQ + tid * 8 + i;
        p.inv()[(size_t)(b * SEQ + tid * 8 + i) * 16 + e] = base + slot;
        p.gate()[base + slot] = __uint_as_float(v[i]);
      }
    }
    __syncthreads();
  }
}

struct CfgMoe1 {
  static constexpr bool PERM = true;
  int K; const Params* p; int L; int bid, nb;
  DI bool next(int i, pg8::Unit& u) const {
    const int t = i * nb + bid; if (t >= 16 * 16 * 8) return false;
    const int rnd = t >> 8, w = t & 255, xcd = w & 7, jx = w >> 3, pid = xcd * 4 + (jx >> 3);
    const int mt = jx & 7, nt = pid & 15, e = rnd * 2 + (pid >> 4);
    u.pm = e * 8 + mt; u.pn = e * 16 + nt; return true;
  }
  DI const char* a_base(const pg8::Unit&) const { return (const char*)p->hn8(); }
  DI const char* b_base(const pg8::Unit& u) const { return (const char*)(p->Wgu8() + ((size_t)L * 16 * 4096 + (size_t)u.pn * 256) * DM); }
  const int* tokl;
  DI void a_off(const pg8::Unit&, int R0, int C0, int R1, int C1, unsigned (&vo)[4], int ui) const {
    const int* tk = tokl + ui * 256;
    vo[0] = (unsigned)(tk[R0] * 512 + C0) * 2u; vo[1] = (unsigned)(tk[R1] * 512 + C1) * 2u;
    vo[2] = (unsigned)(tk[128 + R0] * 512 + C0) * 2u; vo[3] = (unsigned)(tk[128 + R1] * 512 + C1) * 2u;
  }
  DI void epi(const f32x4 (&acc)[2][2][4][2], const pg8::Unit& u, int wr, int wc, int fr, int fq) const {
    const int row0 = u.pm * 256 + wr * 64 + fr, col0 = (u.pn & 15) * 128 + wc * 32 + 8 * fq;
    const float dq = 1.f / (F8_H_SCALE * F8_W_SCALE);
#pragma unroll
    for (int ai = 0; ai < 2; ++ai)
#pragma unroll
      for (int m = 0; m < 4; ++m) {
        const f32x4 g0 = acc[ai][0][m][0] * dq, g1 = acc[ai][0][m][1] * dq, u0 = acc[ai][1][m][0] * (dq * F8_HID_SCALE), u1 = acc[ai][1][m][1] * (dq * F8_HID_SCALE);
        uint2 w;
        w.x = pk4_f8(fast_silu(g0[0]) * u0[0], fast_silu(g0[1]) * u0[1], fast_silu(g0[2]) * u0[2], fast_silu(g0[3]) * u0[3]);
        w.y = pk4_f8(fast_silu(g1[0]) * u1[0], fast_silu(g1[1]) * u1[1], fast_silu(g1[2]) * u1[2], fast_silu(g1[3]) * u1[3]);
        *reinterpret_cast<uint2*>(p->hid8() + (size_t)(row0 + ai * 128 + m * 16) * 2048 + col0) = w;
      }
  }
};
DI void ph_moe1(const Params& p, int L, char* smem) {
  CfgMoe1 c; c.K = 512; c.p = &p; c.L = L; c.bid = obid(); c.nb = gridDim.x;
  int* tokl = reinterpret_cast<int*>(smem + 131072);
  c.tokl = tokl;
  for (int idx = otid(); idx < 8 * 256; idx += NTHR) {
    pg8::Unit u;
    if (c.next(idx >> 8, u)) tokl[idx] = p.tok()[u.pm * 256 + (idx & 255)];
  }
  __syncthreads();
  pg8::gemm_phase_f8((pg8::lds_u8*)smem, c);
}
struct CfgMoe2 {
  static constexpr bool PERM = true;
  int K; const Params* p; int L; int bid, nb;
  DI bool next(int i, pg8::Unit& u) const {
    const int t = i * nb + bid; if (t >= 16 * 4 * 8) return false;
    const int rnd = t >> 8, w = t & 255, xcd = w & 7, jx = w >> 3, pid = rnd * 32 + xcd * 4 + (jx >> 3);
    u.pm = (pid >> 2) * 8 + (jx & 7); u.pn = pid; return true;
  }
  DI const char* a_base(const pg8::Unit& u) const { return (const char*)(p->hid8() + (size_t)u.pm * 256 * 2048); }
  DI const char* b_base(const pg8::Unit& u) const { return (const char*)(p->Wd8() + ((size_t)L * 16 * DM + (size_t)u.pn * 256) * 2048); }
  DI void a_off(const pg8::Unit&, int R0, int C0, int R1, int C1, unsigned (&vo)[4], int) const {
    vo[0] = (unsigned)(R0 * 1024 + C0) * 2u; vo[1] = (unsigned)(R1 * 1024 + C1) * 2u;
    vo[2] = vo[0] + 128u * 1024u * 2u; vo[3] = vo[1] + 128u * 1024u * 2u;
  }
  DI void epi(const f32x4 (&acc)[2][2][4][2], const pg8::Unit& u, int wr, int wc, int fr, int fq) const {
    u16* eo = p->proj();
    const int row0 = u.pm * 256 + wr * 64 + fr, col0 = (u.pn & 3) * 256 + wc * 32 + 8 * fq;
#pragma unroll
    for (int ai = 0; ai < 2; ++ai)
#pragma unroll
      for (int m = 0; m < 4; ++m) {
        const int row = row0 + ai * 128 + m * 16;
        const float gt = p->gate()[row] * (1.f / (F8_HID_SCALE * F8_W_SCALE));
#pragma unroll
        for (int bj = 0; bj < 2; ++bj) {
          const f32x4 a0 = acc[ai][bj][m][0], a1 = acc[ai][bj][m][1];
          uint4 w;
          w.x = pack2(gt * a0[0], gt * a0[1]); w.y = pack2(gt * a0[2], gt * a0[3]);
          w.z = pack2(gt * a1[0], gt * a1[1]); w.w = pack2(gt * a1[2], gt * a1[3]);
          *reinterpret_cast<uint4*>(eo + (size_t)row * DM + col0 + bj * 128) = w;
        }
      }
  }
};
DI void ph_moe2(const Params& p, int L, char* smem) {
  CfgMoe2 c; c.K = 1024; c.p = &p; c.L = L; c.bid = obid(); c.nb = gridDim.x;
  pg8::gemm_phase_f8((pg8::lds_u8*)smem, c);
}
template <bool FINAL>
DI void ph_combine_norm(const Params& p, const u16* __restrict__ xa, u16* __restrict__ xnew, const float* __restrict__ w,
                        u16* __restrict__ hn_out, float* __restrict__ f_out) {
  const int tid_ = otid(), lane = tid_ & 63, gw = (obid() * NTHR + tid_) >> 6, nw = gridDim.x * (NTHR / 64);
  const u16* eo = p.proj();
  float4 v[4];
  int myrow = -1;
  if (gw < T) {
#pragma unroll
    for (int i = 0; i < 4; ++i) v[i] = bf4_to_f4(*reinterpret_cast<const uint2*>(xa + (size_t)gw * DM + (i * 64 + lane) * 4));
    myrow = (lane < 16) ? p.inv()[(size_t)gw * 16 + lane] : -1;
  }
  for (int t = gw; t < T; t += nw) {
    uint2 vnx[4];
    const int tn = (t + nw < T) ? (t + nw) : t;
#pragma unroll
    for (int i = 0; i < 4; ++i) vnx[i] = *reinterpret_cast<const uint2*>(xa + (size_t)tn * DM + (i * 64 + lane) * 4);
    const int myrow_nx = (lane < 16) ? p.inv()[(size_t)tn * 16 + lane] : -1;
    unsigned long long mask = __builtin_amdgcn_ballot_w64(myrow >= 0);
#pragma unroll 1
    while (mask != 0ull) {
      const int e0 = __builtin_ctzll(mask);
      mask &= mask - 1ull;
      const int r0 = __builtin_amdgcn_readlane(myrow, e0);
      int r1 = -1;
      if (mask != 0ull) { const int e1 = __builtin_ctzll(mask); mask &= mask - 1ull; r1 = __builtin_amdgcn_readlane(myrow, e1); }
      uint2 q0[4], q1[4];
#pragma unroll
      for (int i = 0; i < 4; ++i) q0[i] = *reinterpret_cast<const uint2*>(eo + (size_t)r0 * DM + (i * 64 + lane) * 4);
      const int r1c = (r1 >= 0) ? r1 : r0;
#pragma unroll
      for (int i = 0; i < 4; ++i) q1[i] = *reinterpret_cast<const uint2*>(eo + (size_t)r1c * DM + (i * 64 + lane) * 4);
      const float s1 = (r1 >= 0) ? 1.f : 0.f;
#pragma unroll
      for (int i = 0; i < 4; ++i) {
        v[i].x += __uint_as_float(q0[i].x << 16); v[i].y += __uint_as_float(q0[i].x & 0xffff0000u);
        v[i].z += __uint_as_float(q0[i].y << 16); v[i].w += __uint_as_float(q0[i].y & 0xffff0000u);
        v[i].x += s1 * __uint_as_float(q1[i].x << 16); v[i].y += s1 * __uint_as_float(q1[i].x & 0xffff0000u);
        v[i].z += s1 * __uint_as_float(q1[i].y << 16); v[i].w += s1 * __uint_as_float(q1[i].y & 0xffff0000u);
      }
    }
    float ss = 0.f;
#pragma unroll
    for (int i = 0; i < 4; ++i) ss += v[i].x * v[i].x + v[i].y * v[i].y + v[i].z * v[i].z + v[i].w * v[i].w;
    ss = wave_sum(ss);
    const float rstd = rsqrtf(ss * (1.f / DM) + 1e-6f);
#pragma unroll
    for (int i = 0; i < 4; ++i) {
      const int c = (i * 64 + lane) * 4;
      const float4 ww = *reinterpret_cast<const float4*>(w + c);
      if (FINAL) {
        *reinterpret_cast<float4*>(f_out + (size_t)t * DM + c) = make_float4(v[i].x * rstd * ww.x, v[i].y * rstd * ww.y, v[i].z * rstd * ww.z, v[i].w * rstd * ww.w);
      } else {
        uint2 xo;
        xo.x = pack2(v[i].x, v[i].y); xo.y = pack2(v[i].z, v[i].w);
        *reinterpret_cast<uint2*>(xnew + (size_t)t * DM + c) = xo;
        uint2 o;
        o.x = pack2(v[i].x * rstd * ww.x, v[i].y * rstd * ww.y);
        o.y = pack2(v[i].z * rstd * ww.z, v[i].w * rstd * ww.w);
        *reinterpret_cast<uint2*>(hn_out + (size_t)t * DM + c) = o;
      }
    }
#pragma unroll
    for (int i = 0; i < 4; ++i) v[i] = bf4_to_f4(vnx[i]);
    myrow = myrow_nx;
  }
}

__global__ void __launch_bounds__(NTHR) mk(Params p) {
  extern __shared__ __attribute__((aligned(16))) char smem[];
  cg::grid_group grid = cg::this_grid();
  __shared__ uint4 xb_words;
  if (threadIdx.x == 0) xb_words = make_uint4(0u, 0u, 0u, 0u);
  __syncthreads();
  XcdBarrier xb = xcd_barrier_post(p.bar(), (volatile LAS unsigned*)&xb_words);
  for (int rep = 0; rep < p.rep[0]; ++rep) ph_convert(p, smem);
  ph_rmsnorm_bf16(p.x, p.ln1_w, p.hn());
  xcd_barrier(xb);
  if (p.rep[12] == 0x7fffffff) grid.sync();
  for (int L = 0; L < 2; ++L) {
    u16* xout = p.xres();
    if (L == 1) {
      for (int rep = 0; rep < p.rep[1]; ++rep) ph_combine_norm<false>(p, p.xres(), p.xres2(), p.ln1_w + DM, p.hn(), nullptr);
      xcd_barrier(xb);
    }
    for (int rp = 0; rp < p.rep[3]; ++rp) {
      for (int rep = 0; rep < p.rep[2]; ++rep) ph_inproj(p, L, smem);
      xcd_barrier(xb);
      ph_post(p, L);
      xcd_barrier(xb);
    }
    for (int rep = 0; rep < p.rep[12]; ++rep) xcd_barrier(xb);
    {
      unsigned* ctr = p.bar() + XCD_BAR_WORDS + 8 + L;
      __shared__ int q1_item;
      for (;;) {
        if (threadIdx.x == 0) q1_item = (int)atomicAdd(ctr, 1u);
        __syncthreads();
        const int it = q1_item;
        __syncthreads();
        if (it >= 1344) break;
        if (it < 256) ph_dil_pass<0>(p, smem, it);
        else if (it < 384) ph_ssd_a(p, L, smem, it - 256);
        else if (it < 576) ph_mla_up_q(p, L, smem, it - 384);
        else if (it < 832) ph_mla_up_kv(p, L, smem, it - 576);
        else ph_ret_a(p, smem, it - 832);
      }
    }
    xcd_barrier(xb);
    for (int rep = 0; rep < p.rep[5]; ++rep) {
      for (int r2 = 0; r2 < p.rep[13]; ++r2) { ph_ret_scan(p); ph_ssd_scan(p); }
      for (int r2 = 0; r2 < p.rep[14]; ++r2) ph_mla_attn(p, smem);
      for (int r2 = 0; r2 < p.rep[15]; ++r2) for (int bi = obid(); bi < 256; bi += gridDim.x) ph_dil_pass<1>(p, smem, bi);
    }
    xcd_barrier(xb);
    {
      unsigned* ctr = p.bar() + XCD_BAR_WORDS + L;
      __shared__ int q_item;
      for (;;) {
        if (threadIdx.x == 0) q_item = (int)atomicAdd(ctr, 1u);
        __syncthreads();
        const int it = q_item;
        __syncthreads();
        if (it >= 640) break;
        if (it < 128) ph_ssd_c(p, L, smem, it);
        else ph_ret_c(p, smem, it - 128);
      }
    }
    xcd_barrier(xb);
    for (int rep = 0; rep < p.rep[7]; ++rep) ph_outproj(p, L, smem);
    xcd_barrier(xb);
    for (int rep = 0; rep < p.rep[8]; ++rep) ph_rms2_router(p, L, xout, smem);
    xcd_barrier(xb);
    for (int rep = 0; rep < p.rep[9]; ++rep) ph_topk(p, smem);
    xcd_barrier(xb);
    for (int rep = 0; rep < p.rep[10]; ++rep) ph_moe1(p, L, smem);
    xcd_barrier(xb);
    for (int rep = 0; rep < p.rep[11]; ++rep) ph_moe2(p, L, smem);
    xcd_barrier(xb);
  }
  ph_combine_norm<true>(p, p.xres(), nullptr, p.final_w, nullptr, p.out);
}

extern "C" void kernel_launch(void* const* d_in, const int* in_sizes, int n_in, void* d_out, int out_size, void* d_ws,
                              size_t ws_size, hipStream_t stream) {
  static int grid_blocks = 0;
  if (!grid_blocks) {
    int dev = 0, cus = 0, per_cu = 0;
    (void)hipGetDevice(&dev);
    (void)hipDeviceGetAttribute(&cus, hipDeviceAttributeMultiprocessorCount, dev);
    (void)hipFuncSetAttribute((const void*)mk, hipFuncAttributeMaxDynamicSharedMemorySize, LDS_BYTES);
    (void)hipOccupancyMaxActiveBlocksPerMultiprocessor(&per_cu, (const void*)mk, NTHR, LDS_BYTES);
    if (per_cu < 1) { fprintf(stderr, "occupancy query says %d blocks/CU\n", per_cu); per_cu = 1; }
    grid_blocks = cus * 1;
  }
  Params p{};
  const float** fp = reinterpret_cast<const float**>(&p);
  for (int i = 0; i < 20; ++i) fp[i] = (const float*)d_in[i];
  p.out = (float*)d_out;
  p.ws = (char*)d_ws;
  const size_t off = WSO.total;
  { const int reps[16] = REPS_INIT; for (int i = 0; i < 16; ++i) p.rep[i] = reps[i]; }
  if (off > ws_size) { fprintf(stderr, "workspace too small: need %zu have %zu\n", off, ws_size); return; }
  (void)hipMemsetAsync(p.bar(), 0, (size_t)(XCD_BAR_WORDS + 64) * 4, stream);
  void* args[] = {&p};
  hipError_t e = hipLaunchCooperativeKernel((void*)mk, dim3(grid_blocks), dim3(NTHR), args, LDS_BYTES, stream);
  if (e != hipSuccess) fprintf(stderr, "cooperative launch failed: %s (grid %d)\n", hipGetErrorString(e), grid_blocks);
}
```

```cpp
#include <hip/hip_runtime.h>
#include <hip/hip_cooperative_groups.h>
#include <cstdio>
#include <cstdint>
namespace cg = cooperative_groups;

#define DI __device__ __forceinline__
typedef unsigned short u16;
typedef __attribute__((ext_vector_type(8))) short bf16x8;
typedef __attribute__((ext_vector_type(4))) float f32x4;

#ifndef REPS_INIT
#define REPS_INIT {1, 1, 1, 1, 1, 1, 1, 1, 1, 1, 1, 1, 0, 1, 1, 1}
#endif
constexpr int NTHR = 512;
constexpr int T = 16384, SEQ = 4096, DM = 1024;
constexpr int PW = 3240, PWP = 3328;
constexpr int C_RQ = 0, C_RK = 256, C_RV = 512, C_RG = 768, C_CQ = 1024, C_CKV = 1280, C_KR = 1408,
              C_Z = 1440, C_XBC = 1696, C_DT = 2464, C_DQ = 2472, C_DK = 2728, C_DV = 2984;
constexpr int LDS_BYTES = 131072 + 8192;

struct WsOff {
  size_t WinT;
  size_t WuqT;
  size_t WukvT;
  size_t WoutT;
  size_t Wgu8;
  size_t Wd8;
  size_t hn8;
  size_t xres;
  size_t hn;
  size_t proj;
  size_t cqn;
  size_t ckvn;
  size_t mq;
  size_t xbc;
  size_t mixed;
  size_t hid8;
  size_t kfull;
  size_t rS;
  size_t sS;
  size_t rU;
  size_t sU;
  size_t cdec;
  size_t vT;
  size_t rtab;
  size_t dpart;
  size_t dtv;
  size_t cs;
  size_t ybuf;
  size_t aff;
  size_t gate;
  size_t tok;
  size_t inv;
  size_t bar;
  size_t xres2;
  size_t total;
};
constexpr WsOff ws_layout() {
  WsOff o{};
  size_t off = 0;
  o.WinT = off; off += (((size_t)2 * PWP * DM * 2) + 255) & ~(size_t)255;
  o.WuqT = off; off += (((size_t)2 * 384 * 256 * 2) + 255) & ~(size_t)255;
  o.WukvT = off; off += (((size_t)2 * 512 * 128 * 2) + 255) & ~(size_t)255;
  o.WoutT = off; off += (((size_t)2 * DM * DM * 2) + 255) & ~(size_t)255;
  o.Wgu8 = off; off += (((size_t)2 * 16 * 4096 * DM) + 255) & ~(size_t)255;
  o.Wd8 = off; off += (((size_t)2 * 16 * DM * 2048) + 255) & ~(size_t)255;
  o.hn8 = off; off += (((size_t)T * DM) + 255) & ~(size_t)255;
  o.xres = off; off += (((size_t)T * DM * 2) + 255) & ~(size_t)255;
  o.hn = off; off += (((size_t)T * DM * 2) + 255) & ~(size_t)255;
  o.proj = off; off += (((size_t)T * PWP * 2) + 255) & ~(size_t)255;
  o.cqn = off; off += (((size_t)T * 256 * 2) + 255) & ~(size_t)255;
  o.ckvn = off; off += (((size_t)T * 128 * 2) + 255) & ~(size_t)255;
  o.mq = off; off += (((size_t)T * 384 * 2) + 255) & ~(size_t)255;
  o.xbc = off; off += (((size_t)T * 768 * 2) + 255) & ~(size_t)255;
  o.mixed = off; off += (((size_t)T * DM * 2) + 255) & ~(size_t)255;
  o.hid8 = off; off += (((size_t)32768 * 2048) + 255) & ~(size_t)255;
  o.kfull = off; off += (((size_t)T * 4 * 96 * 2) + 255) & ~(size_t)255;
  o.rS = off; off += (((size_t)16 * 32 * 2 * 4096 * 2) + 255) & ~(size_t)255;
  o.sS = off; off += (((size_t)128 * 8 * 8192 * 2) + 255) & ~(size_t)255;
  o.rU = off; off += (((size_t)16 * 32 * 2 * 4096 * 4) + 255) & ~(size_t)255;
  o.sU = off; off += (((size_t)128 * 8 * 8192 * 4) + 255) & ~(size_t)255;
  o.cdec = off; off += (((size_t)128 * 8 * 4) + 255) & ~(size_t)255;
  o.vT = off; off += (((size_t)T * 4 * 64 * 2) + 255) & ~(size_t)255;
  o.rtab = off; off += (((size_t)SEQ * 56 * 2 * 4) + 255) & ~(size_t)255;
  o.dpart = off; off += (((size_t)T * 4 * 68 * 4) + 255) & ~(size_t)255;
  o.dtv = off; off += (((size_t)T * 8 * 4) + 255) & ~(size_t)255;
  o.cs = off; off += (((size_t)T * 8 * 4) + 255) & ~(size_t)255;
  o.ybuf = off; off += (((size_t)T * 256 * 4) + 255) & ~(size_t)255;
  o.aff = off; off += (((size_t)T * 16 * 4) + 255) & ~(size_t)255;
  o.gate = off; off += (((size_t)64 * 512 * 4) + 255) & ~(size_t)255;
  o.tok = off; off += (((size_t)64 * 512 * 4) + 255) & ~(size_t)255;
  o.inv = off; off += (((size_t)T * 16 * 4) + 255) & ~(size_t)255;
  o.bar = off; off += (((size_t)(3456 + 64) * 4) + 255) & ~(size_t)255;
  o.xres2 = off; off += (((size_t)T * DM * 2) + 255) & ~(size_t)255;
  o.total = off;
  return o;
}
constexpr WsOff WSO = ws_layout();
struct Params {
  const float *x, *ln1_w, *w_in, *q_norm_w, *kv_norm_w, *w_uq, *w_ukv, *conv_w, *conv_b, *a_log, *dt_bias,
      *ssm_d, *ssm_norm_w, *w_out, *ln2_w, *router_w, *w_gate, *w_up, *w_down, *final_w;
  float* out;
  char* ws;
  int rep[16];
  __host__ DI u16* WinT() const { return reinterpret_cast<u16*>(ws + WSO.WinT); }
  __host__ DI u16* WuqT() const { return reinterpret_cast<u16*>(ws + WSO.WuqT); }
  __host__ DI u16* WukvT() const { return reinterpret_cast<u16*>(ws + WSO.WukvT); }
  __host__ DI u16* WoutT() const { return reinterpret_cast<u16*>(ws + WSO.WoutT); }
  __host__ DI unsigned char* Wgu8() const { return reinterpret_cast<unsigned char*>(ws + WSO.Wgu8); }
  __host__ DI unsigned char* Wd8() const { return reinterpret_cast<unsigned char*>(ws + WSO.Wd8); }
  __host__ DI unsigned char* hn8() const { return reinterpret_cast<unsigned char*>(ws + WSO.hn8); }
  __host__ DI u16* xres() const { return reinterpret_cast<u16*>(ws + WSO.xres); }
  __host__ DI u16* hn() const { return reinterpret_cast<u16*>(ws + WSO.hn); }
  __host__ DI u16* proj() const { return reinterpret_cast<u16*>(ws + WSO.proj); }
  __host__ DI u16* cqn() const { return reinterpret_cast<u16*>(ws + WSO.cqn); }
  __host__ DI u16* ckvn() const { return reinterpret_cast<u16*>(ws + WSO.ckvn); }
  __host__ DI u16* mq() const { return reinterpret_cast<u16*>(ws + WSO.mq); }
  __host__ DI u16* xbc() const { return reinterpret_cast<u16*>(ws + WSO.xbc); }
  __host__ DI u16* mixed() const { return reinterpret_cast<u16*>(ws + WSO.mixed); }
  __host__ DI unsigned char* hid8() const { return reinterpret_cast<unsigned char*>(ws + WSO.hid8); }
  __host__ DI u16* kfull() const { return reinterpret_cast<u16*>(ws + WSO.kfull); }
  __host__ DI u16* rS() const { return reinterpret_cast<u16*>(ws + WSO.rS); }
  __host__ DI u16* sS() const { return reinterpret_cast<u16*>(ws + WSO.sS); }
  __host__ DI float* rU() const { return reinterpret_cast<float*>(ws + WSO.rU); }
  __host__ DI float* sU() const { return reinterpret_cast<float*>(ws + WSO.sU); }
  __host__ DI float* cdec() const { return reinterpret_cast<float*>(ws + WSO.cdec); }
  __host__ DI u16* vT() const { return reinterpret_cast<u16*>(ws + WSO.vT); }
  __host__ DI float* rtab() const { return reinterpret_cast<float*>(ws + WSO.rtab); }
  __host__ DI float* dpart() const { return reinterpret_cast<float*>(ws + WSO.dpart); }
  __host__ DI float* dtv() const { return reinterpret_cast<float*>(ws + WSO.dtv); }
  __host__ DI float* cs() const { return reinterpret_cast<float*>(ws + WSO.cs); }
  __host__ DI float* ybuf() const { return reinterpret_cast<float*>(ws + WSO.ybuf); }
  __host__ DI float* aff() const { return reinterpret_cast<float*>(ws + WSO.aff); }
  __host__ DI float* gate() const { return reinterpret_cast<float*>(ws + WSO.gate); }
  __host__ DI int* tok() const { return reinterpret_cast<int*>(ws + WSO.tok); }
  __host__ DI int* inv() const { return reinterpret_cast<int*>(ws + WSO.inv); }
  __host__ DI unsigned* bar() const { return reinterpret_cast<unsigned*>(ws + WSO.bar); }
  __host__ DI u16* xres2() const { return reinterpret_cast<u16*>(ws + WSO.xres2); }
};


typedef __attribute__((ext_vector_type(2))) __bf16 bf16x2_t;
typedef __attribute__((ext_vector_type(2))) float f32x2_t;
typedef __attribute__((ext_vector_type(16))) float f32x16;
typedef __attribute__((ext_vector_type(4))) short s16x4;
typedef __attribute__((ext_vector_type(8))) int i32x8;
typedef __attribute__((ext_vector_type(4))) int i32x4;
DI unsigned pack2(float a, float b) {
  f32x2_t v = {a, b};
  return __builtin_bit_cast(unsigned, __builtin_convertvector(v, bf16x2_t));
}
DI u16 f2bf(float f) { return (u16)(pack2(f, 0.f) & 0xffffu); }
DI float bf2f(u16 h) { return __uint_as_float(((unsigned)h) << 16); }
DI void unpack8(const uint4& v, float* f) {
  f[0] = __uint_as_float(v.x << 16); f[1] = __uint_as_float(v.x & 0xffff0000u);
  f[2] = __uint_as_float(v.y << 16); f[3] = __uint_as_float(v.y & 0xffff0000u);
  f[4] = __uint_as_float(v.z << 16); f[5] = __uint_as_float(v.z & 0xffff0000u);
  f[6] = __uint_as_float(v.w << 16); f[7] = __uint_as_float(v.w & 0xffff0000u);
}
DI void ld8(const u16* p, float* f) { uint4 v = *reinterpret_cast<const uint4*>(p); unpack8(v, f); }
DI unsigned pk4_f8(float a, float b, float c, float d) {
  a = __builtin_amdgcn_fmed3f(a, -448.f, 448.f); b = __builtin_amdgcn_fmed3f(b, -448.f, 448.f);
  c = __builtin_amdgcn_fmed3f(c, -448.f, 448.f); d = __builtin_amdgcn_fmed3f(d, -448.f, 448.f);
  int w = __builtin_amdgcn_cvt_pk_fp8_f32(a, b, 0, false);
  w = __builtin_amdgcn_cvt_pk_fp8_f32(c, d, w, true);
  return (unsigned)w;
}
constexpr float F8_W_SCALE = 256.f, F8_H_SCALE = 16.f, F8_HID_SCALE = 8.f;
DI float4 bf4_to_f4(const uint2& q) {
  return make_float4(__uint_as_float(q.x << 16), __uint_as_float(q.x & 0xffff0000u), __uint_as_float(q.y << 16), __uint_as_float(q.y & 0xffff0000u));
}
DI float wave_sum(float v) {
#pragma unroll
  for (int o = 32; o > 0; o >>= 1) v += __shfl_xor(v, o);
  return v;
}
DI float dot2acc(unsigned a, unsigned b, float c) {
  return __builtin_amdgcn_fdot2_f32_bf16(__builtin_bit_cast(bf16x2_t, a), __builtin_bit_cast(bf16x2_t, b), c, false);
}
DI float dot8(const uint4& a, const uint4& b, float c) {
  c = dot2acc(a.x, b.x, c); c = dot2acc(a.y, b.y, c); c = dot2acc(a.z, b.z, c); c = dot2acc(a.w, b.w, c);
  return c;
}
DI int otid() { int t = threadIdx.x; asm volatile("" : "+v"(t)); return t; }
DI int obid() { int b = blockIdx.x; asm volatile("" : "+s"(b)); return b; }
DI float silu(float x) { return x / (1.f + __expf(-x)); }
DI float fast_silu(float x) { return x * __builtin_amdgcn_rcpf(1.f + __expf(-x)); }


#define XB_TMO      128
#define XB_XCNT(j)  (256  + 64 * (j))
#define XB_XSUB(j)  (1280 + 64 * (j))
#define XB_XGEN(j)  (2304 + 64 * (j))
#define XB_TOP      3328
#define XB_TOPGEN   3392
#define XCD_BAR_WORDS 3456
#define XB_SPIN_CAP (1u << 20)
#define LAS __attribute__((address_space(3)))
DI unsigned xb_ld(unsigned* p) { return __hip_atomic_load(p, __ATOMIC_RELAXED, __HIP_MEMORY_SCOPE_AGENT); }
DI unsigned xb_add(unsigned* p, unsigned v) { return __hip_atomic_fetch_add(p, v, __ATOMIC_RELAXED, __HIP_MEMORY_SCOPE_AGENT); }
DI unsigned xb_xcc_id() { return (unsigned)__builtin_amdgcn_s_getreg((3 << 11) | 20) & 0xFu; }
#define XB_SPIN(cond, bar) do { unsigned _sp = 0; while (cond) { __builtin_amdgcn_s_sleep(1); \
    if ((++_sp & 255u) == 0u) { if (xb_ld(&(bar)[XB_TMO])) break; if (_sp > XB_SPIN_CAP) { atomicAdd(&(bar)[XB_TMO], 1u); break; } } } } while (0)
struct XcdBarrier { unsigned* bar; unsigned x; volatile LAS unsigned* st; };
DI XcdBarrier xcd_barrier_post(unsigned* bar, volatile LAS unsigned* st) {
  XcdBarrier b; b.bar = bar; b.x = xb_xcc_id(); b.st = st;
  if (threadIdx.x == 0) (void)xb_add(&bar[XB_XCNT(b.x)], 1u);
  return b;
}
DI void xcd_barrier_complete(unsigned* bar, unsigned x, unsigned& nloc, unsigned& nx) {
  const unsigned G = gridDim.x * gridDim.y * gridDim.z;
  unsigned sum, cnt, mine, sp = 0u;
  for (;;) {
    sum = 0u; cnt = 0u; mine = 0u;
#pragma unroll
    for (unsigned j = 0; j < 16; ++j) { const unsigned c = xb_ld(&bar[XB_XCNT(j)]); sum += c; cnt += (c > 0u) ? 1u : 0u; mine = (j == x) ? c : mine; }
    if (sum == G) break;
    __builtin_amdgcn_s_sleep(1);
    if ((++sp & 255u) == 0u) { if (xb_ld(&bar[XB_TMO])) break; if (sp > XB_SPIN_CAP) { atomicAdd(&bar[XB_TMO], 1u); break; } }
  }
  nloc = mine > 0u ? mine : 1u; nx = cnt > 0u ? cnt : 1u;
}
DI void xcd_barrier(const XcdBarrier& b) {
  asm volatile("s_waitcnt vmcnt(0)" ::: "memory");
  __syncthreads();
  if (threadIdx.x == 0) {
    unsigned* bar = b.bar;
    __builtin_amdgcn_s_waitcnt(0);
    unsigned nloc = b.st[0], nx = b.st[1];
    if (nloc == 0u) { xcd_barrier_complete(bar, b.x, nloc, nx); b.st[0] = nloc; b.st[1] = nx; }
    const unsigned old = xb_add(&bar[XB_XSUB(b.x)], 1u);
    const unsigned gen = old / nloc;
    if (old + 1u == (gen + 1u) * nloc) {
      __builtin_amdgcn_fence(__ATOMIC_RELEASE, "agent");
      asm volatile("s_waitcnt vmcnt(0)" ::: "memory");
      const unsigned og = xb_add(&bar[XB_TOP], 1u);
      const unsigned tg = og / nx;
      if (og + 1u == (tg + 1u) * nx) xb_add(&bar[XB_TOPGEN], 1u);
      else XB_SPIN(xb_ld(&bar[XB_TOPGEN]) == tg, bar);
      __builtin_amdgcn_fence(__ATOMIC_ACQUIRE, "agent");
      xb_add(&bar[XB_XGEN(b.x)], 1u);
      asm volatile("s_waitcnt vmcnt(0)" ::: "memory");
    } else {
      XB_SPIN(xb_ld(&bar[XB_XGEN(b.x)]) == gen, bar);
      __builtin_amdgcn_fence(__ATOMIC_ACQUIRE, "agent");
      asm volatile("s_waitcnt vmcnt(0)" ::: "memory");
    }
  }
  __syncthreads();
}

template <class F>
DI void transpose_convert(const float* __restrict__ src, int K, int N, int Npad, u16* __restrict__ dst, F rowmap,
                          int bid, int nb, char* smem) {
  u16* tile = reinterpret_cast<u16*>(smem);
  const int tid = otid();
  const int ntn = Npad / 128, ntk = K / 64;
  for (int t = bid; t < ntn * ntk; t += nb) {
    const int n0 = (t % ntn) * 128, k0 = (t / ntn) * 64;
    f32x4 v[4];
#pragma unroll
    for (int i = 0; i < 4; ++i) {
      const int kk = (tid >> 5) + 16 * i, nn = (tid & 31) * 4;
      v[i] = f32x4{0.f, 0.f, 0.f, 0.f};
      if (n0 + nn < N) v[i] = __builtin_nontemporal_load(reinterpret_cast<const f32x4*>(src + (size_t)(k0 + kk) * N + n0 + nn));
    }
#pragma unroll
    for (int i = 0; i < 4; ++i) {
      const int kk = (tid >> 5) + 16 * i, nn = (tid & 31) * 4;
      tile[(nn + 0) * 72 + kk] = f2bf(v[i][0]); tile[(nn + 1) * 72 + kk] = f2bf(v[i][1]);
      tile[(nn + 2) * 72 + kk] = f2bf(v[i][2]); tile[(nn + 3) * 72 + kk] = f2bf(v[i][3]);
    }
    __syncthreads();
#pragma unroll
    for (int j = 0; j < 2; ++j) {
      const int c = tid + NTHR * j, nn = c >> 3, k8 = (c & 7) * 8;
      const uint4 o = *reinterpret_cast<const uint4*>(tile + nn * 72 + k8);
      *reinterpret_cast<uint4*>(dst + (size_t)rowmap(n0 + nn) * K + k0 + k8) = o;
    }
    __syncthreads();
  }
}

template <class F>
DI void transpose_convert_f8(const float* __restrict__ src, int K, int N, unsigned char* __restrict__ dst, F rowmap,
                             int bid, int nb, char* smem) {
  unsigned char* tile = reinterpret_cast<unsigned char*>(smem);
  const int tid = otid();
  const int ntn = N / 128, ntk = K / 64;
  for (int t = bid; t < ntn * ntk; t += nb) {
    const int n0 = (t % ntn) * 128, k0 = (t / ntn) * 64;
    const int kq = (tid >> 5) * 4, nn = (tid & 31) * 4;
    f32x4 v[4];
#pragma unroll
    for (int r = 0; r < 4; ++r) v[r] = __builtin_nontemporal_load(reinterpret_cast<const f32x4*>(src + (size_t)(k0 + kq + r) * N + n0 + nn));
#pragma unroll
    for (int e = 0; e < 4; ++e)
      *reinterpret_cast<unsigned*>(tile + (nn + e) * 80 + kq) =
          pk4_f8(v[0][e] * F8_W_SCALE, v[1][e] * F8_W_SCALE, v[2][e] * F8_W_SCALE, v[3][e] * F8_W_SCALE);
    __syncthreads();
    {
      const int rn = tid >> 2, kc = (tid & 3) * 16;
      const uint4 o = *reinterpret_cast<const uint4*>(tile + rn * 80 + kc);
      *reinterpret_cast<uint4*>(dst + (size_t)rowmap(n0 + rn) * K + k0 + kc) = o;
    }
    __syncthreads();
  }
}

DI void ph_convert(const Params& p, char* smem) {
  const int nb = gridDim.x;
  int bid = obid();
  for (int idx = bid * NTHR + otid(); idx < SEQ * 56; idx += nb * NTHR) {
    const int pos = idx / 56, f = idx - pos * 56;
    float inv;
    if (f < 32) inv = exp2f(-(float)f * (13.287712379549449f / 32.f));
    else if (f < 40) inv = exp2f(-(float)(f - 32) * (18.931568569324174f / 8.f));
    else inv = exp2f(-(float)(f - 40) * (18.931568569324174f / 16.f));
    float sn, cs;
    sincosf((float)pos * inv, &sn, &cs);
    p.rtab()[(size_t)idx * 2] = cs;
    p.rtab()[(size_t)idx * 2 + 1] = sn;
  }
  auto ident = [](int n) { return n; };
  for (int L = 0; L < 2; ++L) {
    transpose_convert(p.w_in + (size_t)L * DM * PW, DM, PW, PWP, p.WinT() + (size_t)L * PWP * DM, ident, bid, nb, smem);
    transpose_convert(p.w_uq + (size_t)L * 256 * 384, 256, 384, 384, p.WuqT() + (size_t)L * 384 * 256, ident, bid, nb, smem);
    transpose_convert(p.w_ukv + (size_t)L * 128 * 512, 128, 512, 512, p.WukvT() + (size_t)L * 512 * 128, ident, bid, nb, smem);
    transpose_convert(p.w_out + (size_t)L * DM * DM, DM, DM, DM, p.WoutT() + (size_t)L * DM * DM, ident, bid, nb, smem);
    for (int e = 0; e < 16; ++e) {
      const size_t le = (size_t)(L * 16 + e);
      auto gmap = [](int n) { return (n >> 7) * 256 + (n & 127); };
      auto umap = [](int n) { return (n >> 7) * 256 + 128 + (n & 127); };
      transpose_convert_f8(p.w_gate + le * DM * 2048, DM, 2048, p.Wgu8() + le * 4096 * DM, gmap, bid, nb, smem);
      transpose_convert_f8(p.w_up + le * DM * 2048, DM, 2048, p.Wgu8() + le * 4096 * DM, umap, bid, nb, smem);
      transpose_convert_f8(p.w_down + le * 2048 * DM, 2048, DM, p.Wd8() + le * DM * 2048, ident, bid, nb, smem);
    }
  }
}

template <class RowPtr, class Epi>
DI void gemm_tile(RowPtr arow, const u16* __restrict__ bt, int ldb, int K, char* smem, Epi epi) {
  u16* sa = reinterpret_cast<u16*>(smem);
  u16* sb = sa + 2 * 256 * 72;
  const int tid = otid(), wid = tid >> 6, lane = tid & 63, wr = wid >> 1, wc = wid & 1, fr = lane & 15, fq = lane >> 4;
  f32x4 acc[4][4];
#pragma unroll
  for (int m = 0; m < 4; ++m)
#pragma unroll
    for (int n = 0; n < 4; ++n) acc[m][n] = f32x4{0.f, 0.f, 0.f, 0.f};
  const int lr = tid >> 3, lc = (tid & 7) * 8;
  const u16* ap[4];
#pragma unroll
  for (int i = 0; i < 4; ++i) ap[i] = arow(lr + 64 * i) + lc;
  const u16* bp[2];
#pragma unroll
  for (int i = 0; i < 2; ++i) bp[i] = bt + (size_t)(lr + 64 * i) * ldb + lc;
  uint4 ra[4], rb[2];
  const int nk = K / 64;
#pragma unroll
  for (int i = 0; i < 4; ++i) ra[i] = *reinterpret_cast<const uint4*>(ap[i]);
#pragma unroll
  for (int i = 0; i < 2; ++i) rb[i] = *reinterpret_cast<const uint4*>(bp[i]);
#pragma unroll
  for (int i = 0; i < 4; ++i) *reinterpret_cast<uint4*>(sa + (lr + 64 * i) * 72 + lc) = ra[i];
#pragma unroll
  for (int i = 0; i < 2; ++i) *reinterpret_cast<uint4*>(sb + (lr + 64 * i) * 72 + lc) = rb[i];
  __syncthreads();
  for (int kt = 0; kt < nk; ++kt) {
    const int cur = kt & 1;
    if (kt + 1 < nk) {
#pragma unroll
      for (int i = 0; i < 4; ++i) ra[i] = *reinterpret_cast<const uint4*>(ap[i] + (kt + 1) * 64);
#pragma unroll
      for (int i = 0; i < 2; ++i) rb[i] = *reinterpret_cast<const uint4*>(bp[i] + (kt + 1) * 64);
    }
    const u16* ca = sa + cur * 256 * 72;
    const u16* cb = sb + cur * 128 * 72;
#pragma unroll
    for (int kk = 0; kk < 2; ++kk) {
      bf16x8 af[4], bfr[4];
#pragma unroll
      for (int m = 0; m < 4; ++m) af[m] = *reinterpret_cast<const bf16x8*>(ca + (wr * 64 + m * 16 + fr) * 72 + kk * 32 + fq * 8);
#pragma unroll
      for (int n = 0; n < 4; ++n) bfr[n] = *reinterpret_cast<const bf16x8*>(cb + (wc * 64 + n * 16 + fr) * 72 + kk * 32 + fq * 8);
#pragma unroll
      for (int m = 0; m < 4; ++m)
#pragma unroll
        for (int n = 0; n < 4; ++n) acc[m][n] = __builtin_amdgcn_mfma_f32_16x16x32_bf16(af[m], bfr[n], acc[m][n], 0, 0, 0);
    }
    if (kt + 1 < nk) {
      u16* na = sa + (cur ^ 1) * 256 * 72;
      u16* nbp = sb + (cur ^ 1) * 128 * 72;
#pragma unroll
      for (int i = 0; i < 4; ++i) *reinterpret_cast<uint4*>(na + (lr + 64 * i) * 72 + lc) = ra[i];
#pragma unroll
      for (int i = 0; i < 2; ++i) *reinterpret_cast<uint4*>(nbp + (lr + 64 * i) * 72 + lc) = rb[i];
    }
    __syncthreads();
  }
  epi(acc, wr, wc, fr, fq);
}

#define WAIT_V(n) asm volatile("s_waitcnt vmcnt(%0)" ::"n"(n) : "memory")
DI int lds_byte2(int r, int c) {
  const int st = (r >> 4) * 2 + (c >> 5), ob = (r & 15) * 64 + (c & 31) * 2;
  return st * 1024 + (ob ^ (((ob >> 9) & 1) << 5));
}
DI void stage_rc2(int b, int& R, int& C) {
  const int st = b >> 10, sb = b & 1023, swz = sb ^ (((sb >> 9) & 1) << 5);
  R = (st >> 1) * 16 + swz / 64;
  C = (st & 1) * 32 + (swz % 64) / 2;
}
typedef __attribute__((address_space(3))) unsigned lds_u32;
template <class RowPtr, class Epi>
DI void gemm256(RowPtr arow, const u16* __restrict__ bt, int ldb, int K, char* smem, Epi epi) {
  constexpr int TILE_B = 256 * 64 * 2, STAGE_B = 2 * TILE_B;
  const int tid = otid(), wid = tid >> 6, lane = tid & 63, wr = wid >> 2, wc = wid & 3, fr = lane & 15, fq = lane >> 4;
  const u16* ap[4];
  const u16* bp[4];
#pragma unroll
  for (int i = 0; i < 4; ++i) {
    int R, C;
    stage_rc2(wid * 1024 + i * 8192 + lane * 16, R, C);
    ap[i] = arow(R) + C;
    bp[i] = bt + (size_t)R * ldb + C;
  }
  f32x4 acc[8][4];
#pragma unroll
  for (int m = 0; m < 8; ++m)
#pragma unroll
    for (int n = 0; n < 4; ++n) acc[m][n] = f32x4{0.f, 0.f, 0.f, 0.f};
#define G2_STAGE(buf, kt)                                                                                              \
  do {                                                                                                                 \
    _Pragma("unroll") for (int i = 0; i < 4; ++i) {                                                                    \
      __builtin_amdgcn_global_load_lds((const unsigned*)(ap[i] + (kt) * 64),                                           \
                                       (lds_u32*)(smem + (buf) * STAGE_B + wid * 1024 + i * 8192), 16, 0, 0);          \
      __builtin_amdgcn_global_load_lds((const unsigned*)(bp[i] + (kt) * 64),                                           \
                                       (lds_u32*)(smem + (buf) * STAGE_B + TILE_B + wid * 1024 + i * 8192), 16, 0, 0); \
    }                                                                                                                  \
  } while (0)
  const int nt = K / 64;
  G2_STAGE(0, 0);
  WAIT_V(0);
  __syncthreads();
  for (int t = 0; t < nt; ++t) {
    const int cur = t & 1;
    if (t + 1 < nt) G2_STAGE(cur ^ 1, t + 1);
    const char* sA = smem + cur * STAGE_B;
    const char* sB = sA + TILE_B;
#pragma unroll
    for (int ks = 0; ks < 2; ++ks) {
      bf16x8 At[8], Bf[4];
#pragma unroll
      for (int m = 0; m < 8; ++m) At[m] = *reinterpret_cast<const bf16x8*>(sA + lds_byte2(wr * 128 + m * 16 + fr, ks * 32 + fq * 8));
#pragma unroll
      for (int n = 0; n < 4; ++n) Bf[n] = *reinterpret_cast<const bf16x8*>(sB + lds_byte2(wc * 64 + n * 16 + fr, ks * 32 + fq * 8));
#pragma unroll
      for (int m = 0; m < 8; ++m)
#pragma unroll
        for (int n = 0; n < 4; ++n) acc[m][n] = __builtin_amdgcn_mfma_f32_16x16x32_bf16(Bf[n], At[m], acc[m][n], 0, 0, 0);
      __builtin_amdgcn_sched_barrier(0);
    }
    WAIT_V(0);
    __syncthreads();
  }
  epi(acc, wr, wc, fr, fq);
}

namespace pg8 {
constexpr int BM = 256, BK = 64, HALF = 128, HTB = HALF * BK * 2;
DI int lds_byte(int r, int c) { const int st = (r >> 4) * 2 + (c >> 5), rr = r & 15, cc = c & 31, ob = rr * 64 + cc * 2; return st * 1024 + (ob ^ (((ob >> 9) & 1) << 5)); }
DI void stage_rc(int b, int& R, int& C) { const int st = b / 1024, sb = b % 1024, swz = sb ^ (((sb >> 9) & 1) << 5); R = (st >> 1) * 16 + swz / 64; C = (st & 1) * 32 + (swz % 64) / 2; }
DI int perm32(int rho) { const int n = rho >> 4, i = rho & 15; return 8 * (i >> 2) + 4 * n + (i & 3); }
struct Unit { int pm, pn; };
typedef __attribute__((address_space(3))) unsigned char lds_u8;
typedef __attribute__((address_space(3))) unsigned lds_u32;
typedef __attribute__((address_space(3))) bf16x8 lds_bf16x8;
typedef __attribute__((address_space(3))) i32x4 lds_i32x4;

template <class Cfg>
DI void gemm_phase(lds_u8* lds, const Cfg& S) {
  const int tid = otid(), wid = __builtin_amdgcn_readfirstlane(tid >> 6), lane = tid & 63, wr = wid >> 2, wc = wid & 3, fr = lane & 15, fq = lane >> 4;
  const int K = S.K, nt = K / BK;
  int R0, C0, R1, C1;
  stage_rc(tid * 16, R0, C0);
  stage_rc(tid * 16 + 8192, R1, C1);
  unsigned voffB[2];
  {
    const int Rb0 = Cfg::PERM ? ((R0 & ~31) + perm32(R0 & 31)) : R0, Rb1 = Cfg::PERM ? ((R1 & ~31) + perm32(R1 & 31)) : R1;
    voffB[0] = (unsigned)(Rb0 * K + C0) * 2u; voffB[1] = (unsigned)(Rb1 * K + C1) * 2u;
  }
  const size_t kstep = (size_t)(BK * 2);
  const size_t hstep = (size_t)HALF * K * 2;
  const unsigned ldsw = (unsigned)wid * 1024u;
  const int aoff = lds_byte(wr * 64 + fr, fq * 8), boff = lds_byte(wc * 32 + fr, fq * 8);
#define PG8_SA(b, h) (((b) * 2 + (h)) * HTB)
#define PG8_SB(b, h) ((4 + (b) * 2 + (h)) * HTB)
#define PG8_STAGE2(bufoff, gbase, o0, o1) do { \
    __builtin_amdgcn_global_load_lds((const unsigned*)((const char*)(gbase) + (o0)), (lds_u32*)(lds + (bufoff) + ldsw), 16, 0, 0); \
    __builtin_amdgcn_global_load_lds((const unsigned*)((const char*)(gbase) + (o1)), (lds_u32*)(lds + (bufoff) + ldsw + 8192), 16, 0, 0); } while (0)
#define PG8_STAGEB(bufoff, gbase) PG8_STAGE2(bufoff, gbase, voffB[0], voffB[1])
#define PG8_LDA(dst, b, h) do { _Pragma("unroll") for (int m = 0; m < 4; ++m) _Pragma("unroll") for (int k = 0; k < 2; ++k) dst[m][k] = *(const lds_bf16x8*)(lds + PG8_SA(b, h) + aoff + m * 2048 + k * 1024); } while (0)
#define PG8_LDB(dst, b, h) do { _Pragma("unroll") for (int n = 0; n < 2; ++n) _Pragma("unroll") for (int k = 0; k < 2; ++k) dst[n][k] = *(const lds_bf16x8*)(lds + PG8_SB(b, h) + boff + n * 2048 + k * 1024); } while (0)
#define PG8_MMA(ai, bj, At, Bt) do { __builtin_amdgcn_s_setprio(1); _Pragma("unroll") for (int m = 0; m < 4; ++m) _Pragma("unroll") for (int n = 0; n < 2; ++n) _Pragma("unroll") for (int k = 0; k < 2; ++k) \
    acc[ai][bj][m][n] = __builtin_amdgcn_mfma_f32_16x16x32_bf16(Bt[n][k], At[m][k], acc[ai][bj][m][n], 0, 0, 0); __builtin_amdgcn_s_setprio(0); } while (0)
#define PG8_WAIT_V(n) asm volatile("s_waitcnt vmcnt(" #n ")" ::: "memory")
#define PG8_WAIT_L(n) asm volatile("s_waitcnt lgkmcnt(" #n ")" ::: "memory")
#define PG8_BAR __builtin_amdgcn_s_barrier()
#define PG8_SCHED __builtin_amdgcn_sched_barrier(0)
  Unit cur, nxt; int ui = 0;
  if (!S.next(0, cur)) return;
  f32x4 acc[2][2][4][2];
#pragma unroll
  for (int a = 0; a < 2; ++a)
#pragma unroll
    for (int b = 0; b < 2; ++b)
#pragma unroll
      for (int m = 0; m < 4; ++m)
#pragma unroll
        for (int n = 0; n < 2; ++n) acc[a][b][m][n] = f32x4{0.f, 0.f, 0.f, 0.f};
  bf16x8 At[4][2], B0[2][2], B1[2][2];
  const char* cA = S.a_base(cur);
  const char* cB = S.b_base(cur);
  unsigned vc[4], vn[4];
  S.a_off(cur, R0, C0, R1, C1, vc);
  PG8_STAGEB(PG8_SB(0, 0), cB); PG8_STAGE2(PG8_SA(0, 0), cA, vc[0], vc[1]); PG8_STAGEB(PG8_SB(0, 1), cB + hstep); PG8_STAGE2(PG8_SA(0, 1), cA, vc[2], vc[3]);
  if (wr == 1) PG8_BAR;
  PG8_WAIT_V(4); PG8_BAR;
  PG8_STAGEB(PG8_SB(1, 0), cB + kstep); PG8_STAGE2(PG8_SA(1, 0), cA + kstep, vc[0], vc[1]); PG8_STAGEB(PG8_SB(1, 1), cB + hstep + kstep);
  PG8_WAIT_V(6); PG8_BAR;
  for (;;) {
    const bool has_next = S.next(ui + 1, nxt);
    const char* nA = has_next ? S.a_base(nxt) : cA;
    const char* nB = has_next ? S.b_base(nxt) : cB;
    if (has_next) S.a_off(nxt, R0, C0, R1, C1, vn);
    else { vn[0] = vc[0]; vn[1] = vc[1]; vn[2] = vc[2]; vn[3] = vc[3]; }
    for (int t = 0; t < nt; t += 2) {
      const bool last = (t == nt - 2);
      const char* a1 = cA + (size_t)(t + 1) * kstep;
      const char* a2 = last ? nA : cA + (size_t)(t + 2) * kstep;
      const char* b2 = last ? nB : cB + (size_t)(t + 2) * kstep;
      const char* a3 = a2 + kstep;
      const char* b3 = b2 + kstep;
      const unsigned w0 = last ? vn[0] : vc[0], w1 = last ? vn[1] : vc[1], w2 = last ? vn[2] : vc[2], w3 = last ? vn[3] : vc[3];
      PG8_LDB(B0, 0, 0); PG8_SCHED; PG8_LDA(At, 0, 0); PG8_STAGE2(PG8_SA(1, 1), a1, vc[2], vc[3]);
      PG8_WAIT_L(8); PG8_BAR; PG8_WAIT_L(0); PG8_MMA(0, 0, At, B0); PG8_BAR; PG8_SCHED;
      PG8_LDB(B1, 0, 1); PG8_STAGEB(PG8_SB(0, 0), b2);
      PG8_BAR; PG8_WAIT_L(0); PG8_MMA(0, 1, At, B1); PG8_BAR;
      PG8_LDA(At, 0, 1); PG8_STAGE2(PG8_SA(0, 0), a2, w0, w1);
      PG8_BAR; PG8_WAIT_L(0); PG8_MMA(1, 0, At, B0); PG8_BAR; PG8_SCHED;
      PG8_STAGEB(PG8_SB(0, 1), b2 + hstep);
      PG8_WAIT_V(6); PG8_BAR; PG8_MMA(1, 1, At, B1); PG8_BAR;
      PG8_LDB(B0, 1, 0); PG8_SCHED; PG8_LDA(At, 1, 0); PG8_STAGE2(PG8_SA(0, 1), a2, w2, w3);
      PG8_WAIT_L(8); PG8_BAR; PG8_WAIT_L(0); PG8_MMA(0, 0, At, B0); PG8_BAR; PG8_SCHED;
      PG8_LDB(B1, 1, 1); PG8_STAGEB(PG8_SB(1, 0), b3);
      PG8_BAR; PG8_WAIT_L(0); PG8_MMA(0, 1, At, B1); PG8_BAR;
      PG8_LDA(At, 1, 1); PG8_STAGE2(PG8_SA(1, 0), a3, w0, w1);
      PG8_BAR; PG8_WAIT_L(0); PG8_MMA(1, 0, At, B0); PG8_BAR; PG8_SCHED;
      PG8_STAGEB(PG8_SB(1, 1), b3 + hstep);
      PG8_WAIT_V(6); PG8_BAR; PG8_MMA(1, 1, At, B1); PG8_BAR;
    }
    S.epi(acc, cur, wr, wc, fr, fq);
    if (!has_next) break;
#pragma unroll
    for (int a = 0; a < 2; ++a)
#pragma unroll
      for (int b = 0; b < 2; ++b)
#pragma unroll
        for (int m = 0; m < 4; ++m)
#pragma unroll
          for (int n = 0; n < 2; ++n) acc[a][b][m][n] = f32x4{0.f, 0.f, 0.f, 0.f};
    cur = nxt; cA = nA; cB = nB; ++ui;
    vc[0] = vn[0]; vc[1] = vn[1]; vc[2] = vn[2]; vc[3] = vn[3];
  }
  PG8_WAIT_V(0);
  if (wr == 0) PG8_BAR;
  PG8_BAR;
#undef PG8_SA
#undef PG8_SB
#undef PG8_STAGE2
#undef PG8_STAGEB
#undef PG8_LDA
#undef PG8_LDB
#undef PG8_MMA
#undef PG8_WAIT_V
#undef PG8_WAIT_L
#undef PG8_BAR
#undef PG8_SCHED
}
template <class Cfg>
DI void gemm_phase_f8(lds_u8* lds, const Cfg& S) {
  const int tid = otid(), wid = __builtin_amdgcn_readfirstlane(tid >> 6), lane = tid & 63, wr = wid >> 2, wc = wid & 3, fr = lane & 15, fq = lane >> 4;
  const int K = S.K, nt = K / BK;
  int R0, C0, R1, C1;
  stage_rc(tid * 16, R0, C0);
  stage_rc(tid * 16 + 8192, R1, C1);
  unsigned voffB[2];
  {
    const int Rb0 = Cfg::PERM ? ((R0 & ~31) + perm32(R0 & 31)) : R0, Rb1 = Cfg::PERM ? ((R1 & ~31) + perm32(R1 & 31)) : R1;
    voffB[0] = (unsigned)(Rb0 * K + C0) * 2u; voffB[1] = (unsigned)(Rb1 * K + C1) * 2u;
  }
  const size_t kstep = (size_t)(BK * 2);
  const size_t hstep = (size_t)HALF * K * 2;
  const unsigned ldsw = (unsigned)wid * 1024u;
  const int cl = 2 * fq + (fq & 1), ch = 2 * fq + 1 - (fq & 1);
  const int aoffL = lds_byte(wr * 64 + fr, cl * 8), aoffH = lds_byte(wr * 64 + fr, ch * 8);
  const int boffL = lds_byte(wc * 32 + fr, cl * 8), boffH = lds_byte(wc * 32 + fr, ch * 8);
#define PG8_SA(b, h) (((b) * 2 + (h)) * HTB)
#define PG8_SB(b, h) ((4 + (b) * 2 + (h)) * HTB)
#define PG8_STAGE2(bufoff, gbase, o0, o1) do { \
    __builtin_amdgcn_global_load_lds((const unsigned*)((const char*)(gbase) + (o0)), (lds_u32*)(lds + (bufoff) + ldsw), 16, 0, 0); \
    __builtin_amdgcn_global_load_lds((const unsigned*)((const char*)(gbase) + (o1)), (lds_u32*)(lds + (bufoff) + ldsw + 8192), 16, 0, 0); } while (0)
#define PG8_STAGEB(bufoff, gbase) PG8_STAGE2(bufoff, gbase, voffB[0], voffB[1])
#define PG8_LDA(dst, b, h) do { _Pragma("unroll") for (int m = 0; m < 4; ++m) { const i32x4 lo_ = *(const lds_i32x4*)(lds + PG8_SA(b, h) + aoffL + m * 2048), hi_ = *(const lds_i32x4*)(lds + PG8_SA(b, h) + aoffH + m * 2048); dst[m] = __builtin_shufflevector(lo_, hi_, 0, 1, 2, 3, 4, 5, 6, 7); } } while (0)
#define PG8_LDB(dst, b, h) do { _Pragma("unroll") for (int n = 0; n < 2; ++n) { const i32x4 lo_ = *(const lds_i32x4*)(lds + PG8_SB(b, h) + boffL + n * 2048), hi_ = *(const lds_i32x4*)(lds + PG8_SB(b, h) + boffH + n * 2048); dst[n] = __builtin_shufflevector(lo_, hi_, 0, 1, 2, 3, 4, 5, 6, 7); } } while (0)
#define PG8_MMA(ai, bj, At, Bt) do { __builtin_amdgcn_s_setprio(1); _Pragma("unroll") for (int m = 0; m < 4; ++m) _Pragma("unroll") for (int n = 0; n < 2; ++n) \
    asm volatile("v_mfma_f32_16x16x128_f8f6f4 %0, %1, %2, %0" : "+v"(acc[ai][bj][m][n]) : "v"(Bt[n]), "v"(At[m])); __builtin_amdgcn_s_setprio(0); } while (0)
#define PG8_WAIT_V(n) asm volatile("s_waitcnt vmcnt(" #n ")" ::: "memory")
#define PG8_WAIT_L(n) asm volatile("s_waitcnt lgkmcnt(" #n ")" ::: "memory")
#define PG8_BAR __builtin_amdgcn_s_barrier()
#define PG8_SCHED __builtin_amdgcn_sched_barrier(0)
  Unit cur, nxt; int ui = 0;
  if (!S.next(0, cur)) return;
  f32x4 acc[2][2][4][2];
#pragma unroll
  for (int a = 0; a < 2; ++a)
#pragma unroll
    for (int b = 0; b < 2; ++b)
#pragma unroll
      for (int m = 0; m < 4; ++m)
#pragma unroll
        for (int n = 0; n < 2; ++n) acc[a][b][m][n] = f32x4{0.f, 0.f, 0.f, 0.f};
  i32x8 At[4], B0[2], B1[2];
  const char* cA = S.a_base(cur);
  const char* cB = S.b_base(cur);
  unsigned vc[4], vn[4];
  S.a_off(cur, R0, C0, R1, C1, vc, 0);
  PG8_STAGEB(PG8_SB(0, 0), cB); PG8_STAGE2(PG8_SA(0, 0), cA, vc[0], vc[1]); PG8_STAGEB(PG8_SB(0, 1), cB + hstep); PG8_STAGE2(PG8_SA(0, 1), cA, vc[2], vc[3]);
  if (wr == 1) PG8_BAR;
  PG8_WAIT_V(4); PG8_BAR;
  PG8_STAGEB(PG8_SB(1, 0), cB + kstep); PG8_STAGE2(PG8_SA(1, 0), cA + kstep, vc[0], vc[1]); PG8_STAGEB(PG8_SB(1, 1), cB + hstep + kstep);
  PG8_WAIT_V(6); PG8_BAR;
  for (;;) {
    const bool has_next = S.next(ui + 1, nxt);
    const char* nA = has_next ? S.a_base(nxt) : cA;
    const char* nB = has_next ? S.b_base(nxt) : cB;
    if (has_next) S.a_off(nxt, R0, C0, R1, C1, vn, ui + 1);
    else { vn[0] = vc[0]; vn[1] = vc[1]; vn[2] = vc[2]; vn[3] = vc[3]; }
    for (int t = 0; t < nt; t += 2) {
      const bool last = (t == nt - 2);
      const char* a1 = cA + (size_t)(t + 1) * kstep;
      const char* a2 = last ? nA : cA + (size_t)(t + 2) * kstep;
      const char* b2 = last ? nB : cB + (size_t)(t + 2) * kstep;
      const char* a3 = a2 + kstep;
      const char* b3 = b2 + kstep;
      const unsigned w0 = last ? vn[0] : vc[0], w1 = last ? vn[1] : vc[1], w2 = last ? vn[2] : vc[2], w3 = last ? vn[3] : vc[3];
      PG8_LDB(B0, 0, 0); PG8_SCHED; PG8_LDA(At, 0, 0); PG8_STAGE2(PG8_SA(1, 1), a1, vc[2], vc[3]);
      PG8_WAIT_L(8); PG8_BAR; PG8_WAIT_L(0); PG8_MMA(0, 0, At, B0); PG8_BAR; PG8_SCHED;
      PG8_LDB(B1, 0, 1); PG8_STAGEB(PG8_SB(0, 0), b2);
      PG8_BAR; PG8_WAIT_L(0); PG8_MMA(0, 1, At, B1); PG8_BAR;
      PG8_LDA(At, 0, 1); PG8_STAGE2(PG8_SA(0, 0), a2, w0, w1);
      PG8_BAR; PG8_WAIT_L(0); PG8_MMA(1, 0, At, B0); PG8_BAR; PG8_SCHED;
      PG8_STAGEB(PG8_SB(0, 1), b2 + hstep);
      PG8_WAIT_V(6); PG8_BAR; PG8_MMA(1, 1, At, B1); PG8_BAR;
      PG8_LDB(B0, 1, 0); PG8_SCHED; PG8_LDA(At, 1, 0); PG8_STAGE2(PG8_SA(0, 1), a2, w2, w3);
      PG8_WAIT_L(8); PG8_BAR; PG8_WAIT_L(0); PG8_MMA(0, 0, At, B0); PG8_BAR; PG8_SCHED;
      PG8_LDB(B1, 1, 1); PG8_STAGEB(PG8_SB(1, 0), b3);
      PG8_BAR; PG8_WAIT_L(0); PG8_MMA(0, 1, At, B1); PG8_BAR;
      PG8_LDA(At, 1, 1); PG8_STAGE2(PG8_SA(1, 0), a3, w0, w1);
      PG8_BAR; PG8_WAIT_L(0); PG8_MMA(1, 0, At, B0); PG8_BAR; PG8_SCHED;
      PG8_STAGEB(PG8_SB(1, 1), b3 + hstep);
      PG8_WAIT_V(6); PG8_BAR; PG8_MMA(1, 1, At, B1); PG8_BAR;
    }
    asm volatile("s_nop 15\n\ts_nop 15" ::: "memory");
    S.epi(acc, cur, wr, wc, fr, fq);
    if (!has_next) break;
#pragma unroll
    for (int a = 0; a < 2; ++a)
#pragma unroll
      for (int b = 0; b < 2; ++b)
#pragma unroll
        for (int m = 0; m < 4; ++m)
#pragma unroll
          for (int n = 0; n < 2; ++n) acc[a][b][m][n] = f32x4{0.f, 0.f, 0.f, 0.f};
    cur = nxt; cA = nA; cB = nB; ++ui;
    vc[0] = vn[0]; vc[1] = vn[1]; vc[2] = vn[2]; vc[3] = vn[3];
  }
  PG8_WAIT_V(0);
  if (wr == 0) PG8_BAR;
  PG8_BAR;
#undef PG8_SA
#undef PG8_SB
#undef PG8_STAGE2
#undef PG8_STAGEB
#undef PG8_LDA
#undef PG8_LDB
#undef PG8_MMA
#undef PG8_WAIT_V
#undef PG8_WAIT_L
#undef PG8_BAR
#undef PG8_SCHED
}
}

struct CfgInproj {
  static constexpr bool PERM = true;
  int K; const Params* p; int L; int bid, nb;
  DI bool next(int i, pg8::Unit& u) const { const int t = i * nb + bid; if (t >= 64 * 13) return false; u.pm = t & 63; u.pn = t >> 6; return true; }
  DI const char* a_base(const pg8::Unit& u) const { return (const char*)(p->hn() + (size_t)u.pm * 256 * DM); }
  DI const char* b_base(const pg8::Unit& u) const { return (const char*)(p->WinT() + ((size_t)L * PWP + (size_t)u.pn * 256) * DM); }
  DI void a_off(const pg8::Unit&, int R0, int C0, int R1, int C1, unsigned (&vo)[4]) const {
    vo[0] = (unsigned)(R0 * DM + C0) * 2u; vo[1] = (unsigned)(R1 * DM + C1) * 2u;
    vo[2] = vo[0] + 128u * DM * 2u; vo[3] = vo[1] + 128u * DM * 2u;
  }
  DI void epi(const f32x4 (&acc)[2][2][4][2], const pg8::Unit& u, int wr, int wc, int fr, int fq) const {
    const int row0 = u.pm * 256 + wr * 64 + fr, col0 = u.pn * 256 + wc * 32 + 8 * fq;
#pragma unroll
    for (int ai = 0; ai < 2; ++ai)
#pragma unroll
      for (int m = 0; m < 4; ++m) {
        u16* rowp = p->proj() + (size_t)(row0 + ai * 128 + m * 16) * PWP + col0;
#pragma unroll
        for (int bj = 0; bj < 2; ++bj) {
          uint4 w;
          w.x = pack2(acc[ai][bj][m][0][0], acc[ai][bj][m][0][1]); w.y = pack2(acc[ai][bj][m][0][2], acc[ai][bj][m][0][3]);
          w.z = pack2(acc[ai][bj][m][1][0], acc[ai][bj][m][1][1]); w.w = pack2(acc[ai][bj][m][1][2], acc[ai][bj][m][1][3]);
          *reinterpret_cast<uint4*>(rowp + bj * 128) = w;
        }
      }
  }
};
DI void ph_inproj_tail(const Params& p, int L, char* smem, int t) {
  const int m0 = (t & 63) * 256, n0 = 3072 + (t >> 6) * 128;
  const u16* Bt = p.WinT() + ((size_t)L * PWP + n0) * DM;
  gemm_tile([&](int r) { return p.hn() + (size_t)(m0 + r) * DM; }, Bt, DM, DM, smem,
            [&](f32x4 (&acc)[4][4], int wr, int wc, int fr, int fq) {
#pragma unroll
              for (int m = 0; m < 4; ++m)
#pragma unroll
                for (int n = 0; n < 4; ++n)
#pragma unroll
                  for (int j = 0; j < 4; ++j)
                    p.proj()[(size_t)(m0 + wr * 64 + m * 16 + fq * 4 + j) * PWP + n0 + wc * 64 + n * 16 + fr] = f2bf(acc[m][n][j]);
            });
}
DI void ph_inproj(const Params& p, int L, char* smem) {
  CfgInproj c; c.K = DM; c.p = &p; c.L = L; c.bid = obid(); c.nb = gridDim.x;
  pg8::gemm_phase((pg8::lds_u8*)smem, c);
}

DI void ph_gemm_store_bf16(const u16* A, int lda, const u16* Bt, int K, int M, int N, u16* C, int ldc, char* smem, int rot) {
  const int mt = M / 256, nt = N / 128;
  const int nb = gridDim.x;
  for (int t = (obid() + rot) % nb; t < mt * nt; t += nb) {
    const int m0 = (t % mt) * 256, n0 = (t / mt) * 128;
    gemm_tile([&](int r) { return A + (size_t)(m0 + r) * lda; }, Bt + (size_t)n0 * K, K, K, smem,
              [&](f32x4 (&acc)[4][4], int wr, int wc, int fr, int fq) {
#pragma unroll
                for (int m = 0; m < 4; ++m)
#pragma unroll
                  for (int n = 0; n < 4; ++n)
#pragma unroll
                    for (int j = 0; j < 4; ++j) {
                      const int row = m0 + wr * 64 + m * 16 + fq * 4 + j, col = n0 + wc * 64 + n * 16 + fr;
                      C[(size_t)row * ldc + col] = f2bf(acc[m][n][j]);
                    }
              });
  }
}

DI void ph_rmsnorm_bf16(const float* __restrict__ xin, const float* __restrict__ w, u16* __restrict__ outp) {
  const int tid_ = otid(); const int lane = tid_ & 63, gw = (obid() * NTHR + tid_) >> 6, nw = gridDim.x * (NTHR / 64);
  for (int t = gw; t < T; t += nw) {
    const float* xr = xin + (size_t)t * DM;
    float4 v[4];
    float ss = 0.f;
#pragma unroll
    for (int i = 0; i < 4; ++i) {
      v[i] = *reinterpret_cast<const float4*>(xr + (i * 64 + lane) * 4);
      ss += v[i].x * v[i].x + v[i].y * v[i].y + v[i].z * v[i].z + v[i].w * v[i].w;
    }
    ss = wave_sum(ss);
    const float rstd = rsqrtf(ss * (1.f / DM) + 1e-6f);
#pragma unroll
    for (int i = 0; i < 4; ++i) {
      const int c = (i * 64 + lane) * 4;
      const float4 ww = *reinterpret_cast<const float4*>(w + c);
      uint2 o;
      o.x = pack2(v[i].x * rstd * ww.x, v[i].y * rstd * ww.y);
      o.y = pack2(v[i].z * rstd * ww.z, v[i].w * rstd * ww.w);
      *reinterpret_cast<uint2*>(outp + (size_t)t * DM + c) = o;
    }
  }
}

DI void ph_final_norm(const float* __restrict__ xin, const float* __restrict__ w, float* __restrict__ outp) {
  const int tid_ = otid(); const int lane = tid_ & 63, gw = (obid() * NTHR + tid_) >> 6, nw = gridDim.x * (NTHR / 64);
  for (int t = gw; t < T; t += nw) {
    const float* xr = xin + (size_t)t * DM;
    float4 v[4];
    float ss = 0.f;
#pragma unroll
    for (int i = 0; i < 4; ++i) {
      v[i] = *reinterpret_cast<const float4*>(xr + (i * 64 + lane) * 4);
      ss += v[i].x * v[i].x + v[i].y * v[i].y + v[i].z * v[i].z + v[i].w * v[i].w;
    }
    ss = wave_sum(ss);
    const float rstd = rsqrtf(ss * (1.f / DM) + 1e-6f);
#pragma unroll
    for (int i = 0; i < 4; ++i) {
      const int c = (i * 64 + lane) * 4;
      const float4 ww = *reinterpret_cast<const float4*>(w + c);
      float4 o = make_float4(v[i].x * rstd * ww.x, v[i].y * rstd * ww.y, v[i].z * rstd * ww.z, v[i].w * rstd * ww.w);
      *reinterpret_cast<float4*>(outp + (size_t)t * DM + c) = o;
    }
  }
}

DI void rot8(const u16* x1p, const u16* x2p, const float* tab  , float scale, uint4& o1, uint4& o2) {
  float x1[8], x2[8], y1[8], y2[8];
  ld8(x1p, x1); ld8(x2p, x2);
#pragma unroll
  for (int e = 0; e < 8; e += 2) {
    const float4 cs = *reinterpret_cast<const float4*>(tab + e * 2);
    y1[e] = (x1[e] * cs.x - x2[e] * cs.y) * scale;
    y2[e] = (x2[e] * cs.x + x1[e] * cs.y) * scale;
    y1[e + 1] = (x1[e + 1] * cs.z - x2[e + 1] * cs.w) * scale;
    y2[e + 1] = (x2[e + 1] * cs.z + x1[e + 1] * cs.w) * scale;
  }
  o1.x = pack2(y1[0], y1[1]); o1.y = pack2(y1[2], y1[3]); o1.z = pack2(y1[4], y1[5]); o1.w = pack2(y1[6], y1[7]);
  o2.x = pack2(y2[0], y2[1]); o2.y = pack2(y2[2], y2[3]); o2.z = pack2(y2[4], y2[5]); o2.w = pack2(y2[6], y2[7]);
}
DI void ph_post(const Params& p, int L) {
  const int tid = otid();
  const int gt = obid() * NTHR + tid, gs = gridDim.x * NTHR;
  const int lane = tid & 63, gw = gt >> 6, nw = gs >> 6;
  const float* qnw = p.q_norm_w + L * 256;
  const float* kvnw = p.kv_norm_w + L * 128;
  const float* cw = p.conv_w + L * 5 * 768;
  const float* cb = p.conv_b + L * 768;
  const float* dtb = p.dt_bias + L * 8;
  {
    uint4 xr[5];
    auto load_taps = [&](int idx, uint4 (&r)[5]) {
      const int t = idx / 96, cg = idx - t * 96, s = t & (SEQ - 1);
#pragma unroll
      for (int w = 0; w < 5; ++w) {
        const int ss = s + w - 2;
        const int tt = (ss >= 0 && ss < SEQ) ? (t + w - 2) : t;
        r[w] = *reinterpret_cast<const uint4*>(p.proj() + (size_t)tt * PWP + C_XBC + cg * 8);
      }
    };
    if (gt < T * 96) load_taps(gt, xr);
    for (int idx = gt; idx < T * 96; idx += gs) {
      const int t = idx / 96, cg = idx - t * 96, s = t & (SEQ - 1);
      uint4 xn[5];
      const int idn = (idx + gs < T * 96) ? (idx + gs) : idx;
      load_taps(idn, xn);
      float acc[8];
      {
        const float4 b0 = *reinterpret_cast<const float4*>(cb + cg * 8), b1 = *reinterpret_cast<const float4*>(cb + cg * 8 + 4);
        acc[0] = b0.x; acc[1] = b0.y; acc[2] = b0.z; acc[3] = b0.w; acc[4] = b1.x; acc[5] = b1.y; acc[6] = b1.z; acc[7] = b1.w;
      }
#pragma unroll
      for (int w = 0; w < 5; ++w) {
        const int ss = s + w - 2;
        const float msk = (ss >= 0 && ss < SEQ) ? 1.f : 0.f;
        float xv[8];
        unpack8(xr[w], xv);
        const float4 w0 = *reinterpret_cast<const float4*>(cw + w * 768 + cg * 8), w1 = *reinterpret_cast<const float4*>(cw + w * 768 + cg * 8 + 4);
        acc[0] += msk * xv[0] * w0.x; acc[1] += msk * xv[1] * w0.y; acc[2] += msk * xv[2] * w0.z; acc[3] += msk * xv[3] * w0.w;
        acc[4] += msk * xv[4] * w1.x; acc[5] += msk * xv[5] * w1.y; acc[6] += msk * xv[6] * w1.z; acc[7] += msk * xv[7] * w1.w;
      }
      uint4 o;
      o.x = pack2(fast_silu(acc[0]), fast_silu(acc[1])); o.y = pack2(fast_silu(acc[2]), fast_silu(acc[3]));
      o.z = pack2(fast_silu(acc[4]), fast_silu(acc[5])); o.w = pack2(fast_silu(acc[6]), fast_silu(acc[7]));
      *reinterpret_cast<uint4*>(p.xbc() + (size_t)t * 768 + cg * 8) = o;
#pragma unroll
      for (int w = 0; w < 5; ++w) xr[w] = xn[w];
    }
  }
  for (int idx = gt; idx < T * 8; idx += gs) {
    const int t = idx >> 3, k = idx & 7;
    const float v = bf2f(p.proj()[(size_t)t * PWP + C_DT + k]) + dtb[k];
    p.dtv()[idx] = (v > 20.f) ? v : log1pf(expf(v));
  }
  {
    const int sub = lane >> 4, l16 = lane & 15;
    for (int t = gw * 4 + sub; t < T; t += nw * 4) {
      const u16* pr = p.proj() + (size_t)t * PWP;
      float v[16], u[8];
      ld8(pr + C_CQ + l16 * 16, v); ld8(pr + C_CQ + l16 * 16 + 8, v + 8);
      ld8(pr + C_CKV + l16 * 8, u);
      float ss = 0.f, s2 = 0.f;
#pragma unroll
      for (int i = 0; i < 16; ++i) ss += v[i] * v[i];
#pragma unroll
      for (int i = 0; i < 8; ++i) s2 += u[i] * u[i];
#pragma unroll
      for (int o = 1; o < 16; o <<= 1) { ss += __shfl_xor(ss, o); s2 += __shfl_xor(s2, o); }
      const float rstd = rsqrtf(ss * (1.f / 256.f) + 1e-6f), r2 = rsqrtf(s2 * (1.f / 128.f) + 1e-6f);
      uint4 o;
      const float* qw = qnw + l16 * 16;
      o.x = pack2(v[0] * rstd * qw[0], v[1] * rstd * qw[1]); o.y = pack2(v[2] * rstd * qw[2], v[3] * rstd * qw[3]);
      o.z = pack2(v[4] * rstd * qw[4], v[5] * rstd * qw[5]); o.w = pack2(v[6] * rstd * qw[6], v[7] * rstd * qw[7]);
      *reinterpret_cast<uint4*>(p.cqn() + (size_t)t * 256 + l16 * 16) = o;
      o.x = pack2(v[8] * rstd * qw[8], v[9] * rstd * qw[9]); o.y = pack2(v[10] * rstd * qw[10], v[11] * rstd * qw[11]);
      o.z = pack2(v[12] * rstd * qw[12], v[13] * rstd * qw[13]); o.w = pack2(v[14] * rstd * qw[14], v[15] * rstd * qw[15]);
      *reinterpret_cast<uint4*>(p.cqn() + (size_t)t * 256 + l16 * 16 + 8) = o;
      const float* kw = kvnw + l16 * 8;
      o.x = pack2(u[0] * r2 * kw[0], u[1] * r2 * kw[1]); o.y = pack2(u[2] * r2 * kw[2], u[3] * r2 * kw[3]);
      o.z = pack2(u[4] * r2 * kw[4], u[5] * r2 * kw[5]); o.w = pack2(u[6] * r2 * kw[6], u[7] * r2 * kw[7]);
      *reinterpret_cast<uint4*>(p.ckvn() + (size_t)t * 128 + l16 * 8) = o;
    }
  }
  {
    auto item_of = [&](int idx, u16*& a, int& off2, int& tabo, float& scale, int& krope_i0) {
      const int t = idx / 42, ri = idx - t * 42, s = t & (SEQ - 1);
      u16* pr = p.proj() + (size_t)t * PWP;
      krope_i0 = -1;
      if (ri < 32) {
        const int isk = ri >> 4, h = (ri >> 2) & 3, i0 = (ri & 3) * 8;
        a = pr + (isk ? C_RK : C_RQ) + h * 64 + i0; off2 = 32; tabo = (s * 56 + i0) * 2; scale = isk ? 1.f : 0.125f;
      } else if (ri < 40) {
        const int j = ri - 32, isk = j >> 2, h = j & 3;
        a = pr + (isk ? C_DK : C_DQ) + h * 64; off2 = 8; tabo = (s * 56 + 32) * 2; scale = 1.f;
      } else {
        const int i0 = (ri - 40) * 8;
        a = pr + C_KR + i0; off2 = 16; tabo = (s * 56 + 40 + i0) * 2; scale = 1.f; krope_i0 = i0;
      }
    };
    uint4 x1c = make_uint4(0, 0, 0, 0), x2c = make_uint4(0, 0, 0, 0);
    if (gt < T * 42) {
      u16* a; int off2, tabo, ki; float sc;
      item_of(gt, a, off2, tabo, sc, ki);
      x1c = *reinterpret_cast<const uint4*>(a); x2c = *reinterpret_cast<const uint4*>(a + off2);
    }
    for (int idx = gt; idx < T * 42; idx += gs) {
      u16* a; int off2, tabo, ki; float scale;
      item_of(idx, a, off2, tabo, scale, ki);
      uint4 x1n, x2n;
      {
        const int idn = (idx + gs < T * 42) ? (idx + gs) : idx;
        u16* an; int o2n, tn_, kn; float scn;
        item_of(idn, an, o2n, tn_, scn, kn);
        x1n = *reinterpret_cast<const uint4*>(an); x2n = *reinterpret_cast<const uint4*>(an + o2n);
      }
      float x1[8], x2[8], y1[8], y2[8];
      unpack8(x1c, x1); unpack8(x2c, x2);
      const float* tab = p.rtab() + tabo;
#pragma unroll
      for (int e = 0; e < 8; e += 2) {
        const float4 cs = *reinterpret_cast<const float4*>(tab + e * 2);
        y1[e] = (x1[e] * cs.x - x2[e] * cs.y) * scale;
        y2[e] = (x2[e] * cs.x + x1[e] * cs.y) * scale;
        y1[e + 1] = (x1[e + 1] * cs.z - x2[e + 1] * cs.w) * scale;
        y2[e + 1] = (x2[e + 1] * cs.z + x1[e + 1] * cs.w) * scale;
      }
      uint4 o1, o2;
      o1.x = pack2(y1[0], y1[1]); o1.y = pack2(y1[2], y1[3]); o1.z = pack2(y1[4], y1[5]); o1.w = pack2(y1[6], y1[7]);
      o2.x = pack2(y2[0], y2[1]); o2.y = pack2(y2[2], y2[3]); o2.z = pack2(y2[4], y2[5]); o2.w = pack2(y2[6], y2[7]);
      *reinterpret_cast<uint4*>(a) = o1;
      *reinterpret_cast<uint4*>(a + off2) = o2;
      if (ki >= 0) {
        const int t = idx / 42, s = t & (SEQ - 1), bb = t >> 12;
#pragma unroll
        for (int hd = 0; hd < 4; ++hd) {
          u16* kf = p.kfull() + ((size_t)(bb * 4 + hd) * SEQ + s) * 96 + 64 + ki;
          *reinterpret_cast<uint4*>(kf) = o1;
          *reinterpret_cast<uint4*>(kf + 16) = o2;
        }
      }
      x1c = x1n; x2c = x2n;
    }
  }
}

DI void ph_mla_up_q(const Params& p, int L, char* smem, int t) {
  const int mt = T / 256;
  const u16* Bq = p.WuqT() + (size_t)L * 384 * 256;
  {
    const int m0 = (t % mt) * 256, n0 = (t / mt) * 128;
    gemm_tile([&](int r) { return p.cqn() + (size_t)(m0 + r) * 256; }, Bq + (size_t)n0 * 256, 256, 256, smem,
              [&](f32x4 (&acc)[4][4], int wr, int wc, int fr, int fq) {
                const float scale = 0.10206207261596575f * 1.4426950408889634f;
#pragma unroll
                for (int m = 0; m < 4; ++m)
#pragma unroll
                  for (int j = 0; j < 4; ++j) {
                    const int row = m0 + wr * 64 + m * 16 + fq * 4 + j;
                    const float2 cssn = *reinterpret_cast<const float2*>(p.rtab() + ((size_t)(row & (SEQ - 1)) * 56 + 40 + fr) * 2);
                    const float cs = cssn.x, sn = cssn.y;
#pragma unroll
                    for (int n2 = 0; n2 < 4; n2 += 2) {
                      const int cb = n0 + wc * 64 + n2 * 16;
                      float x1 = acc[m][n2][j], x2 = acc[m][n2 + 1][j];
                      if (cb % 96 == 64) {
                        const float y1 = x1 * cs - x2 * sn, y2 = x2 * cs + x1 * sn;
                        x1 = y1; x2 = y2;
                      }
                      p.mq()[(size_t)row * 384 + cb + fr] = f2bf(x1 * scale);
                      p.mq()[(size_t)row * 384 + cb + 16 + fr] = f2bf(x2 * scale);
                    }
                  }
              });
  }
}
DI void ph_mla_up_kv(const Params& p, int L, char* smem, int t) {
  const int mt = T / 256;
  const u16* Bkv = p.WukvT() + (size_t)L * 512 * 128;
  {
    const int m0 = (t % mt) * 256, h = t / mt, n0 = h * 128;
    gemm_tile([&](int r) { return p.ckvn() + (size_t)(m0 + r) * 128; }, Bkv + (size_t)n0 * 128, 128, 128, smem,
              [&](f32x4 (&acc)[4][4], int wr, int wc, int fr, int fq) {
#pragma unroll
                for (int m = 0; m < 4; ++m) {
                  const int row = m0 + wr * 64 + m * 16 + fq * 4;
                  const int bb = row >> 12, sq = row & (SEQ - 1);
                  const size_t bh = (size_t)(bb * 4 + h);
#pragma unroll
                  for (int n = 0; n < 4; ++n) {
                    if (wc == 0) {
#pragma unroll
                      for (int j = 0; j < 4; ++j) p.kfull()[(bh * SEQ + sq + j) * 96 + n * 16 + fr] = f2bf(acc[m][n][j]);
                    } else {
                      uint2 v;
                      v.x = pack2(acc[m][n][0], acc[m][n][1]);
                      v.y = pack2(acc[m][n][2], acc[m][n][3]);
                      const int sqp = (sq & ~12) | ((sq & 4) << 1) | ((sq & 8) >> 1);
                      *reinterpret_cast<uint2*>(p.vT() + (bh * 64 + n * 16 + fr) * SEQ + sqp) = v;
                    }
                  }
                }
              });
  }
}

DI void ph_cumsum(const Params& p, int L) {
  const int tid_ = otid(); const int lane = tid_ & 63, gw = (obid() * NTHR + tid_) >> 6, nw = gridDim.x * (NTHR / 64);
  for (int it = gw; it < 32; it += nw) {
    const int h = it & 3, dir = (it >> 2) & 1, b = it >> 3;
    const float a = -expf(p.a_log[L * 8 + dir * 4 + h]);
    float running = 0.f;
    for (int c = 0; c < 64; ++c) {
      const int i = c * 64 + lane;
      const int s = dir ? (SEQ - 1 - i) : i;
      const size_t off = (size_t)(b * SEQ + s) * 8 + dir * 4 + h;
      float v = p.dtv()[off] * a;
#pragma unroll
      for (int o = 1; o < 64; o <<= 1) {
        const float u = __shfl_up(v, o);
        if (lane >= o) v += u;
      }
      v += running;
      p.cs()[off] = v;
      running = __shfl(v, 63);
    }
  }
}

DI void ph_ret_naive(const Params& p) {
  const int gt = obid() * NTHR + otid(), gs = gridDim.x * NTHR;
  for (int it = gt; it < 4 * 4 * SEQ; it += gs) {
    const int n = it & (SEQ - 1), h = (it >> 12) & 3, b = it >> 14;
    const u16* base = p.proj() + (size_t)(b * SEQ) * PWP;
    uint4 qp[8];
    float o[64];
#pragma unroll
    for (int d = 0; d < 8; ++d) qp[d] = *reinterpret_cast<const uint4*>(base + (size_t)n * PWP + C_RQ + h * 64 + d * 8);
#pragma unroll
    for (int d = 0; d < 64; ++d) o[d] = 0.f;
    const float lg0 = log1pf(-exp2f(-5.f - (float)h)), lg1 = log1pf(-exp2f(-5.5f - (float)h));
#pragma unroll 1
    for (int m = 0; m < SEQ; ++m) {
      const u16* kr = base + (size_t)m * PWP + C_RK + h * 64;
      const u16* vr = base + (size_t)m * PWP + C_RV + h * 64;
      float s = 0.f;
#pragma unroll
      for (int d = 0; d < 8; ++d) s = dot8(qp[d], *reinterpret_cast<const uint4*>(kr + d * 8), s);
      const float w = (m <= n) ? expf(lg0 * (float)(n - m)) : expf(lg1 * (float)(m - n));
      s *= w;
#pragma unroll
      for (int d = 0; d < 64; d += 8) {
        float vf[8];
        ld8(vr + d, vf);
#pragma unroll
        for (int j = 0; j < 8; ++j) o[d + j] += s * vf[j];
      }
    }
    float mu = 0.f;
#pragma unroll
    for (int d = 0; d < 64; ++d) mu += o[d];
    mu *= (1.f / 64.f);
    float var = 0.f;
#pragma unroll
    for (int d = 0; d < 64; ++d) var += (o[d] - mu) * (o[d] - mu);
    var *= (1.f / 64.f);
    const float rs = rsqrtf(var + 1e-5f);
    const size_t t = (size_t)b * SEQ + n;
#pragma unroll
    for (int d = 0; d < 64; d += 8) {
      float g[8];
      ld8(p.proj() + t * PWP + C_RG + h * 64 + d, g);
      uint4 ov;
      ov.x = pack2(silu(g[0]) * (o[d + 0] - mu) * rs, silu(g[1]) * (o[d + 1] - mu) * rs);
      ov.y = pack2(silu(g[2]) * (o[d + 2] - mu) * rs, silu(g[3]) * (o[d + 3] - mu) * rs);
      ov.z = pack2(silu(g[4]) * (o[d + 4] - mu) * rs, silu(g[5]) * (o[d + 5] - mu) * rs);
      ov.w = pack2(silu(g[6]) * (o[d + 6] - mu) * rs, silu(g[7]) * (o[d + 7] - mu) * rs);
      *reinterpret_cast<uint4*>(p.mixed() + t * DM + h * 64 + d) = ov;
    }
  }
}

DI void ph_mla_naive(const Params& p) {
  const int gt = obid() * NTHR + otid(), gs = gridDim.x * NTHR;
  for (int it = gt; it < 2 * 4 * 4 * SEQ; it += gs) {
    const int n = it & (SEQ - 1), vh = (it >> 12) & 1, h = (it >> 13) & 3, b = it >> 15;
    const size_t t = (size_t)b * SEQ + n;
    uint4 qp[12];
    float o[32];
#pragma unroll
    for (int d = 0; d < 12; ++d) qp[d] = *reinterpret_cast<const uint4*>(p.mq() + t * 384 + h * 96 + d * 8);
    const size_t tb = (size_t)b * SEQ;
    float mx = -1e30f;
#pragma unroll 1
    for (int m = 0; m < SEQ; ++m) {
      const u16* kn = ((u16*)nullptr) + (tb + m) * 512 + h * 128;
      const u16* kr = p.proj() + (tb + m) * PWP + C_KR;
      float s = 0.f;
#pragma unroll
      for (int d = 0; d < 8; ++d) s = dot8(qp[d], *reinterpret_cast<const uint4*>(kn + d * 8), s);
#pragma unroll
      for (int d = 0; d < 4; ++d) s = dot8(qp[8 + d], *reinterpret_cast<const uint4*>(kr + d * 8), s);
      mx = fmaxf(mx, s);
    }
#pragma unroll
    for (int d = 0; d < 32; ++d) o[d] = 0.f;
    float l = 0.f;
#pragma unroll 1
    for (int m = 0; m < SEQ; ++m) {
      const u16* kn = ((u16*)nullptr) + (tb + m) * 512 + h * 128;
      const u16* kr = p.proj() + (tb + m) * PWP + C_KR;
      float s = 0.f;
#pragma unroll
      for (int d = 0; d < 8; ++d) s = dot8(qp[d], *reinterpret_cast<const uint4*>(kn + d * 8), s);
#pragma unroll
      for (int d = 0; d < 4; ++d) s = dot8(qp[8 + d], *reinterpret_cast<const uint4*>(kr + d * 8), s);
      const float pe = exp2f(s - mx);
      l += pe;
#pragma unroll
      for (int d = 0; d < 32; d += 8) {
        float vf[8];
        ld8(kn + 64 + vh * 32 + d, vf);
#pragma unroll
        for (int j = 0; j < 8; ++j) o[d + j] += pe * vf[j];
      }
    }
    const float il = 1.f / l;
#pragma unroll
    for (int d = 0; d < 32; d += 8) {
      uint4 ov;
      ov.x = pack2(o[d + 0] * il, o[d + 1] * il);
      ov.y = pack2(o[d + 2] * il, o[d + 3] * il);
      ov.z = pack2(o[d + 4] * il, o[d + 5] * il);
      ov.w = pack2(o[d + 6] * il, o[d + 7] * il);
      *reinterpret_cast<uint4*>(p.mixed() + t * DM + 256 + h * 64 + vh * 32 + d) = ov;
    }
  }
}

#define MFMA32(a, b, c) __builtin_amdgcn_mfma_f32_32x32x16_bf16((a), (b), (c), 0, 0, 0)
DI float max16(const f32x16& v) {
  float a = fmaxf(fmaxf(v[0], v[1]), v[2]), b = fmaxf(fmaxf(v[3], v[4]), v[5]), c = fmaxf(fmaxf(v[6], v[7]), v[8]);
  float d = fmaxf(fmaxf(v[9], v[10]), v[11]), e = fmaxf(fmaxf(v[12], v[13]), v[14]);
  return fmaxf(fmaxf(fmaxf(a, b), fmaxf(c, d)), fmaxf(e, v[15]));
}
DI void ph_mla_attn(const Params& p, char* smem) {
  const int tid = otid(), wid = tid >> 6, lane = tid & 63, l32 = lane & 31, hh = lane >> 5;
  u16* sK = reinterpret_cast<u16*>(smem);
  u16* sV = sK + 2 * 128 * 104;
  uint4 konev = make_uint4(hh == 0 ? 0x00003F80u : 0u, 0u, 0u, 0u);
  const bf16x8 kone = __builtin_bit_cast(bf16x8, konev);
  for (int item = obid(); item < 256; item += gridDim.x) {
    const int xcd_ = item & 7, jx_ = item >> 3, bh = xcd_ * 2 + (jx_ >> 4), qt = jx_ & 15, b = bh >> 2, h = bh & 3;
    const size_t t0 = (size_t)b * SEQ + qt * 256 + wid * 32;
    bf16x8 qf[6];
#pragma unroll
    for (int ks = 0; ks < 6; ++ks) qf[ks] = *reinterpret_cast<const bf16x8*>(p.mq() + (t0 + l32) * 384 + h * 96 + ks * 16 + hh * 8);
    const u16* kg = p.kfull() + (size_t)bh * SEQ * 96;
    const u16* vg = p.vT() + (size_t)bh * 64 * SEQ;
    f32x16 o0, o1;
#pragma unroll
    for (int i = 0; i < 16; ++i) { o0[i] = 0.f; o1[i] = 0.f; }
    float m = 0.f, l = 0.f;
    bf16x8 qf6 = __builtin_bit_cast(bf16x8, make_uint4(0u, 0u, 0u, 0u));
    const int kr0 = tid / 12, kc0 = tid % 12, kr1 = (512 + tid) / 12, kc1 = (512 + tid) % 12, kr2 = (1024 + tid) / 12, kc2 = (1024 + tid) % 12;
    const int vd0 = tid >> 4, vd1 = 32 + (tid >> 4), vkc = (tid & 15) * 8;
    uint4 ak0, ak1, ak2, av0, av1;
#define MLA_LD(dst_, ptr_) asm volatile("global_load_dwordx4 %0, %1, off" : "=v"(dst_) : "v"(ptr_) : "memory")
#define MLA_GLOAD(K0, K1, K2, V0, V1, kt_)                                               \
    {                                                                                    \
      const u16* kb_ = kg + (size_t)(kt_) * 128 * 96 + tid * 8;                          \
      MLA_LD(K0, kb_); MLA_LD(K1, kb_ + 512 * 8); MLA_LD(K2, kb_ + 1024 * 8);            \
      const u16* vp_ = vg + (size_t)vd0 * SEQ + (kt_) * 128 + vkc;                       \
      MLA_LD(V0, vp_); MLA_LD(V1, vp_ + (size_t)32 * SEQ);                               \
    }
#define MLA_SSTORE(K0, K1, K2, V0, V1, buf_)                                             \
    {                                                                                    \
      u16* kb_ = sK + (buf_) * 128 * 104;                                                \
      u16* vb_ = sV + (buf_) * 64 * 136;                                                 \
      *reinterpret_cast<uint4*>(kb_ + kr0 * 104 + kc0 * 8) = K0;                         \
      *reinterpret_cast<uint4*>(kb_ + kr1 * 104 + kc1 * 8) = K1;                         \
      *reinterpret_cast<uint4*>(kb_ + kr2 * 104 + kc2 * 8) = K2;                         \
      *reinterpret_cast<uint4*>(vb_ + vd0 * 136 + vkc) = V0;                             \
      *reinterpret_cast<uint4*>(vb_ + vd1 * 136 + vkc) = V1;                             \
    }
    float mxrun = 0.f;
#define SGB(mask, n) __builtin_amdgcn_sched_group_barrier((mask), (n), 0)
#define MLA_KFRAG(kb_, sub_, ks_) (*reinterpret_cast<const bf16x8*>((kb_) + ((sub_) * 32 + l32) * 104 + (ks_) * 16 + hh * 8))
#define MLA_VFRAG(dst_, vb_, sub_, ks2_, dvt_) \
    dst_ = *reinterpret_cast<const bf16x8*>((vb_) + ((dvt_) * 32 + l32) * 136 + (sub_) * 32 + (ks2_) * 16 + hh * 8)
#define MLA_SOFTMAX(sc_, pa_, pb_)                                                                         \
    {                                                                                                      \
      mxrun = fmaxf(mxrun, max16(sc_));                                                                    \
      float ps0_ = 0.f, ps1_ = 0.f;                                                                        \
      _Pragma("unroll") for (int i = 0; i < 16; i += 2) {                                                  \
        sc_[i] = __builtin_amdgcn_exp2f(sc_[i]); sc_[i + 1] = __builtin_amdgcn_exp2f(sc_[i + 1]);          \
        ps0_ += sc_[i]; ps1_ += sc_[i + 1];                                                                \
      }                                                                                                    \
      l += ps0_ + ps1_;                                                                                    \
      uint4 pk_;                                                                                           \
      pk_.x = pack2(sc_[0], sc_[1]); pk_.y = pack2(sc_[2], sc_[3]); pk_.z = pack2(sc_[4], sc_[5]); pk_.w = pack2(sc_[6], sc_[7]); \
      pa_ = __builtin_bit_cast(bf16x8, pk_);                                                               \
      pk_.x = pack2(sc_[8], sc_[9]); pk_.y = pack2(sc_[10], sc_[11]); pk_.z = pack2(sc_[12], sc_[13]); pk_.w = pack2(sc_[14], sc_[15]); \
      pb_ = __builtin_bit_cast(bf16x8, pk_);                                                               \
    }
    auto compute_tile = [&](int cur, int half) {
      const u16* kb = sK + cur * 128 * 104 + half * 64 * 104;
      const u16* vb = sV + cur * 64 * 136 + half * 64;
      bf16x8 k0[6], k1[6];
#pragma unroll
      for (int ks = 0; ks < 6; ++ks) { k0[ks] = MLA_KFRAG(kb, 0, ks); k1[ks] = MLA_KFRAG(kb, 1, ks); }
      f32x16 s0, s1;
#pragma unroll
      for (int i = 0; i < 16; ++i) { s0[i] = 0.f; s1[i] = 0.f; }
#pragma unroll
      for (int ks = 0; ks < 6; ++ks) s0 = MFMA32(k0[ks], qf[ks], s0);
      s0 = MFMA32(kone, qf6, s0);
      bf16x8 v00, v01, v02, v03, v10, v11, v12, v13;
      MLA_VFRAG(v00, vb, 0, 0, 0); MLA_VFRAG(v01, vb, 0, 0, 1); MLA_VFRAG(v02, vb, 0, 1, 0); MLA_VFRAG(v03, vb, 0, 1, 1);
#pragma unroll
      for (int ks = 0; ks < 6; ++ks) s1 = MFMA32(k1[ks], qf[ks], s1);
      s1 = MFMA32(kone, qf6, s1);
      MLA_VFRAG(v10, vb, 1, 0, 0); MLA_VFRAG(v11, vb, 1, 0, 1); MLA_VFRAG(v12, vb, 1, 1, 0); MLA_VFRAG(v13, vb, 1, 1, 1);
      bf16x8 p0a, p0b, p1a, p1b;
      MLA_SOFTMAX(s0, p0a, p0b);
      o0 = MFMA32(v00, p0a, o0); o1 = MFMA32(v01, p0a, o1); o0 = MFMA32(v02, p0b, o0); o1 = MFMA32(v03, p0b, o1);
      MLA_SOFTMAX(s1, p1a, p1b);
      o0 = MFMA32(v10, p1a, o0); o1 = MFMA32(v11, p1a, o1); o0 = MFMA32(v12, p1b, o0); o1 = MFMA32(v13, p1b, o1);
      SGB(0x100, 12);
#pragma unroll
      for (int i = 0; i < 7; ++i) { SGB(0x008, 1); if (i < 4) SGB(0x100, 1); }
#pragma unroll
      for (int i = 0; i < 7; ++i) { SGB(0x008, 1); if (i < 4) SGB(0x100, 1); SGB(0x402, 7); }
#pragma unroll
      for (int i = 0; i < 4; ++i) { SGB(0x008, 1); SGB(0x402, 12); }
#pragma unroll
      for (int i = 0; i < 4; ++i) SGB(0x008, 1);
    };
    auto lazy_update = [&]() {
      const float mxr = fmaxf(mxrun, __shfl_xor(mxrun, 32));
      if (__builtin_amdgcn_ballot_w64(mxr > 8.f) != 0ull) {
        float d = (mxr > 8.f) ? mxr : 0.f;
        const float mnew = bf2f(f2bf(m + d));
        d = mnew - m;
        m = mnew;
        const float alpha = __builtin_amdgcn_exp2f(-d);
        l *= alpha;
        mxrun -= d;
#pragma unroll
        for (int i = 0; i < 16; ++i) { o0[i] *= alpha; o1[i] *= alpha; }
        uint4 qv = make_uint4(0u, 0u, 0u, 0u);
        if (hh == 0) qv.x = (unsigned)f2bf(-m);
        qf6 = __builtin_bit_cast(bf16x8, qv);
      }
    };
    MLA_GLOAD(ak0, ak1, ak2, av0, av1, 0);
    asm volatile("s_waitcnt vmcnt(0)" ::: "memory");
    MLA_SSTORE(ak0, ak1, ak2, av0, av1, 0);
    __syncthreads();
    {
      f32x16 s0, s1;
#pragma unroll
      for (int i = 0; i < 16; ++i) { s0[i] = 0.f; s1[i] = 0.f; }
#pragma unroll
      for (int ks = 0; ks < 6; ++ks) { s0 = MFMA32(MLA_KFRAG(sK, 0, ks), qf[ks], s0); s1 = MFMA32(MLA_KFRAG(sK, 1, ks), qf[ks], s1); }
      float mx = fmaxf(max16(s0), max16(s1));
      mx = fmaxf(mx, __shfl_xor(mx, 32));
      m = bf2f(f2bf(mx));
      uint4 qv = make_uint4(0u, 0u, 0u, 0u);
      if (hh == 0) qv.x = (unsigned)f2bf(-m);
      qf6 = __builtin_bit_cast(bf16x8, qv);
    }
#pragma unroll 1
    for (int kt = 0; kt < 32; kt += 2) {
      MLA_GLOAD(ak0, ak1, ak2, av0, av1, kt + 1);
#pragma unroll 1
      for (int half = 0; half < 2; ++half) compute_tile(0, half);
      asm volatile("s_waitcnt vmcnt(0)" ::: "memory");
      MLA_SSTORE(ak0, ak1, ak2, av0, av1, 1);
      __syncthreads();
      lazy_update();
      if (kt + 2 < 32) MLA_GLOAD(ak0, ak1, ak2, av0, av1, kt + 2);
#pragma unroll 1
      for (int half = 0; half < 2; ++half) compute_tile(1, half);
      if (kt + 2 < 32) {
        asm volatile("s_waitcnt vmcnt(0)" ::: "memory");
        MLA_SSTORE(ak0, ak1, ak2, av0, av1, 0);
      }
      __syncthreads();
      lazy_update();
    }
    l += __shfl_xor(l, 32);
    const float il = 1.f / l;
    u16* orow = p.mixed() + (t0 + l32) * DM + 256 + h * 64 + hh * 4;
#pragma unroll
    for (int g = 0; g < 4; ++g) {
      uint2 v;
      v.x = pack2(o0[4 * g + 0] * il, o0[4 * g + 1] * il);
      v.y = pack2(o0[4 * g + 2] * il, o0[4 * g + 3] * il);
      *reinterpret_cast<uint2*>(orow + g * 8) = v;
      v.x = pack2(o1[4 * g + 0] * il, o1[4 * g + 1] * il);
      v.y = pack2(o1[4 * g + 2] * il, o1[4 * g + 3] * il);
      *reinterpret_cast<uint2*>(orow + 32 + g * 8) = v;
    }
  }
}

typedef __attribute__((address_space(3))) s16x4 lds_s16x4;
template <int MODE>
DI void ph_dil_pass(const Params& p, char* smem, int blk_) {
  const int tid = otid(), wid = tid >> 6, lane = tid & 63, l32 = lane & 31, hh = lane >> 5;
  u16* sV = reinterpret_cast<u16*>(smem) + wid * (2 * 32 * 72);
  const int i16 = lane & 15, tq = i16 >> 2, tp = i16 & 3, tblk = (lane >> 4) & 1;
  {
    constexpr int NT = (MODE == 0) ? 13 : 5;
    const int it = wid, xcd_ = blk_ & 7, jx_ = blk_ >> 3, bh = xcd_ * 2 + (jx_ >> 4), r = jx_ & 15, b = bh >> 2, h = bh & 3;
    const int i0 = it * 32;
    const int q0 = (r * 8 + it) * 32;
    const int qpos = (MODE == 0) ? (r + 16 * (i0 + l32)) : (q0 + l32);
    const size_t tb = (size_t)b * SEQ;
    const u16* kbase = p.proj() + tb * PWP + C_DK + h * 64;
    const u16* vbase = p.proj() + tb * PWP + C_DV + h * 64;
    bf16x8 qf[4];
    {
      const u16* qp = p.proj() + (tb + qpos) * PWP + C_DQ + h * 64 + hh * 8;
#pragma unroll
      for (int ks = 0; ks < 4; ++ks) qf[ks] = *reinterpret_cast<const bf16x8*>(qp + ks * 16);
    }
    f32x16 o0, o1;
#pragma unroll
    for (int i = 0; i < 16; ++i) { o0[i] = 0.f; o1[i] = 0.f; }
    float m = -1e30f, l = 0.f;
    auto tile_params = [&](int tt, int& d, int& rd, int& ub, int& ulim, int& qb, int& qs) {
      if (MODE == 0) {
        if (tt < 5) { d = 16; rd = r; qb = i0; qs = 1; ulim = 256; ub = qb - 64 + 32 * tt; }
        else { d = 4; rd = r & 3; qb = (r >> 2) + 4 * i0; qs = 4; ulim = 1024; ub = qb - 64 + 32 * (tt - 5); }
      } else { d = 1; rd = 0; qb = q0; qs = 1; ulim = 4096; ub = qb - 64 + 32 * tt; }
    };
    bf16x8 ka0, ka1, ka2, ka3, kb0, kb1, kb2, kb3;
    uint4 va0, va1, va2, va3, vb0, vb1, vb2, vb3;
#define DIL_LD(dst_, ptr_) asm volatile("global_load_dwordx4 %0, %1, off" : "=v"(dst_) : "v"(ptr_) : "memory")
#define DIL_GLOAD(K0, K1, K2, K3, V0, V1, V2, V3, tt_)                                                   \
    {                                                                                                    \
      int d_, rd_, ub_, ulim_, qb_, qs_;                                                                 \
      tile_params((tt_), d_, rd_, ub_, ulim_, qb_, qs_);                                                 \
      int u_ = min(max(ub_ + l32, 0), ulim_ - 1);                                                        \
      const u16* kp_ = kbase + (size_t)(rd_ + d_ * u_) * PWP + hh * 8;                                   \
      DIL_LD(K0, kp_); DIL_LD(K1, kp_ + 16); DIL_LD(K2, kp_ + 32); DIL_LD(K3, kp_ + 48);                 \
      const int kr_ = ub_ + (lane >> 3);                                                                 \
      const u16* vp_;                                                                                    \
      u_ = min(max(kr_, 0), ulim_ - 1);      vp_ = vbase + (size_t)(rd_ + d_ * u_) * PWP + (lane & 7) * 8; DIL_LD(V0, vp_); \
      u_ = min(max(kr_ + 8, 0), ulim_ - 1);  vp_ = vbase + (size_t)(rd_ + d_ * u_) * PWP + (lane & 7) * 8; DIL_LD(V1, vp_); \
      u_ = min(max(kr_ + 16, 0), ulim_ - 1); vp_ = vbase + (size_t)(rd_ + d_ * u_) * PWP + (lane & 7) * 8; DIL_LD(V2, vp_); \
      u_ = min(max(kr_ + 24, 0), ulim_ - 1); vp_ = vbase + (size_t)(rd_ + d_ * u_) * PWP + (lane & 7) * 8; DIL_LD(V3, vp_); \
    }
#define DIL_VSTORE(V0, V1, V2, V3, buf_)                                                                 \
    {                                                                                                    \
      u16* vb_ = sV + (buf_) * 32 * 72 + (lane >> 3) * 72 + (lane & 7) * 8;                              \
      *reinterpret_cast<uint4*>(vb_) = V0;                                                               \
      *reinterpret_cast<uint4*>(vb_ + 8 * 72) = V1;                                                      \
      *reinterpret_cast<uint4*>(vb_ + 16 * 72) = V2;                                                     \
      *reinterpret_cast<uint4*>(vb_ + 24 * 72) = V3;                                                     \
    }
    auto tile_rest = [&](int tt, f32x16 sc, int cur) {
      int d, rd, ub, ulim, qb, qs;
      tile_params(tt, d, rd, ub, ulim, qb, qs);
      const int uq = qb + qs * l32;
      const float cs = 0.125f * 1.4426950408889634f;
      float mx = -1e30f;
#pragma unroll
      for (int i = 0; i < 16; ++i) {
        const int u = ub + (i & 3) + 8 * (i >> 2) + 4 * hh;
        const int du = u - uq;
        const bool valid = (u >= 0) && (u < ulim) && (du <= 64) && (du >= -64);
        sc[i] = valid ? sc[i] * cs : -1e30f;
        mx = fmaxf(mx, sc[i]);
      }
      mx = fmaxf(mx, __shfl_xor(mx, 32));
      const float mn = fmaxf(m, mx);
      const float alpha = __builtin_amdgcn_exp2f(m - mn);
      m = mn;
      float ps = 0.f;
#pragma unroll
      for (int i = 0; i < 16; ++i) {
        float pe = __builtin_amdgcn_exp2f(sc[i] - mn);
        pe = (sc[i] > -1e29f) ? pe : 0.f;
        ps += pe;
        sc[i] = pe;
      }
      l = l * alpha + ps;
#pragma unroll
      for (int i = 0; i < 16; ++i) { o0[i] *= alpha; o1[i] *= alpha; }
      const u16* vb = sV + cur * 32 * 72;
#pragma unroll
      for (int ks2 = 0; ks2 < 2; ++ks2) {
        uint4 pk;
        pk.x = pack2(sc[8 * ks2 + 0], sc[8 * ks2 + 1]);
        pk.y = pack2(sc[8 * ks2 + 2], sc[8 * ks2 + 3]);
        pk.z = pack2(sc[8 * ks2 + 4], sc[8 * ks2 + 5]);
        pk.w = pack2(sc[8 * ks2 + 6], sc[8 * ks2 + 7]);
        const bf16x8 pb = __builtin_bit_cast(bf16x8, pk);
#pragma unroll
        for (int dvt = 0; dvt < 2; ++dvt) {
          const u16* a0 = vb + (16 * ks2 + 4 * hh + tq) * 72 + dvt * 32 + tblk * 16 + tp * 4;
          const s16x4 lo = __builtin_amdgcn_ds_read_tr16_b64_v4i16((lds_s16x4*)(a0));
          const s16x4 hi = __builtin_amdgcn_ds_read_tr16_b64_v4i16((lds_s16x4*)(a0 + 8 * 72));
          const bf16x8 a = __builtin_shufflevector(lo, hi, 0, 1, 2, 3, 4, 5, 6, 7);
          if (dvt == 0) o0 = MFMA32(a, pb, o0); else o1 = MFMA32(a, pb, o1);
        }
      }
    };
    DIL_GLOAD(ka0, ka1, ka2, ka3, va0, va1, va2, va3, 0);
    DIL_GLOAD(kb0, kb1, kb2, kb3, vb0, vb1, vb2, vb3, 1);
    asm volatile("s_waitcnt vmcnt(8)" ::: "memory");
    DIL_VSTORE(va0, va1, va2, va3, 0);
#pragma unroll 1
    for (int tt = 0; tt < NT; tt += 2) {
      {
        f32x16 sc;
#pragma unroll
        for (int i = 0; i < 16; ++i) sc[i] = 0.f;
        sc = MFMA32(ka0, qf[0], sc); sc = MFMA32(ka1, qf[1], sc); sc = MFMA32(ka2, qf[2], sc); sc = MFMA32(ka3, qf[3], sc);
        asm volatile("" :: "v"(sc));
        if (tt + 2 < NT) DIL_GLOAD(ka0, ka1, ka2, ka3, va0, va1, va2, va3, tt + 2);
        tile_rest(tt, sc, 0);
        if (tt + 1 < NT) {
          if (tt + 2 < NT) asm volatile("s_waitcnt vmcnt(8)" ::: "memory"); else asm volatile("s_waitcnt vmcnt(0)" ::: "memory");
          DIL_VSTORE(vb0, vb1, vb2, vb3, 1);
        }
      }
      if (tt + 1 < NT) {
        f32x16 sc;
#pragma unroll
        for (int i = 0; i < 16; ++i) sc[i] = 0.f;
        sc = MFMA32(kb0, qf[0], sc); sc = MFMA32(kb1, qf[1], sc); sc = MFMA32(kb2, qf[2], sc); sc = MFMA32(kb3, qf[3], sc);
        asm volatile("" :: "v"(sc));
        if (tt + 3 < NT) DIL_GLOAD(kb0, kb1, kb2, kb3, vb0, vb1, vb2, vb3, tt + 3);
        tile_rest(tt + 1, sc, 1);
        if (tt + 2 < NT) {
          if (tt + 3 < NT) asm volatile("s_waitcnt vmcnt(8)" ::: "memory"); else asm volatile("s_waitcnt vmcnt(0)" ::: "memory");
          DIL_VSTORE(va0, va1, va2, va3, 0);
        }
      }
    }
    l += __shfl_xor(l, 32);
    float* part = p.dpart() + ((tb + qpos) * 4 + h) * 68 + hh * 4;
    if (MODE == 0) {
#pragma unroll
      for (int g = 0; g < 4; ++g) {
        *reinterpret_cast<float4*>(part + g * 8) = make_float4(o0[4 * g + 0], o0[4 * g + 1], o0[4 * g + 2], o0[4 * g + 3]);
        *reinterpret_cast<float4*>(part + 32 + g * 8) = make_float4(o1[4 * g + 0], o1[4 * g + 1], o1[4 * g + 2], o1[4 * g + 3]);
      }
      if (hh == 0) { part[64] = m; part[65] = l; }
    } else {
      const float mA = part[64 - hh * 4], lA = part[65 - hh * 4];
      const float M = fmaxf(m, mA), sa = __builtin_amdgcn_exp2f(m - M), sb = __builtin_amdgcn_exp2f(mA - M);
      const float il = 1.f / (l * sa + lA * sb);
      u16* orow = p.mixed() + (tb + qpos) * DM + 768 + h * 64 + hh * 4;
#pragma unroll
      for (int g = 0; g < 4; ++g) {
        const float4 a0 = *reinterpret_cast<const float4*>(part + g * 8), a1 = *reinterpret_cast<const float4*>(part + 32 + g * 8);
        uint2 v;
        v.x = pack2((o0[4 * g + 0] * sa + a0.x * sb) * il, (o0[4 * g + 1] * sa + a0.y * sb) * il);
        v.y = pack2((o0[4 * g + 2] * sa + a0.z * sb) * il, (o0[4 * g + 3] * sa + a0.w * sb) * il);
        *reinterpret_cast<uint2*>(orow + g * 8) = v;
        v.x = pack2((o1[4 * g + 0] * sa + a1.x * sb) * il, (o1[4 * g + 1] * sa + a1.y * sb) * il);
        v.y = pack2((o1[4 * g + 2] * sa + a1.z * sb) * il, (o1[4 * g + 3] * sa + a1.w * sb) * il);
        *reinterpret_cast<uint2*>(orow + 32 + g * 8) = v;
      }
    }
  }
}

DI void ph_dil_naive(const Params& p) {
  const int gt = obid() * NTHR + otid(), gs = gridDim.x * NTHR;
  for (int it = gt; it < 4 * 4 * SEQ; it += gs) {
    const int n = it & (SEQ - 1), h = (it >> 12) & 3, b = it >> 14;
    const size_t tb = (size_t)b * SEQ;
    uint4 qp[8];
    float o[64];
#pragma unroll
    for (int d = 0; d < 8; ++d) qp[d] = *reinterpret_cast<const uint4*>(p.proj() + (tb + n) * PWP + C_DQ + h * 64 + d * 8);
    float mx = -1e30f;
    for (int pat = 0; pat < 3; ++pat) {
      const int dil = (pat == 0) ? 1 : (pat == 1 ? 4 : 16);
#pragma unroll 1
      for (int j = -64; j <= 64; ++j) {
        const int pos = n + j * dil;
        if (pos < 0 || pos >= SEQ) continue;
        const u16* kr = p.proj() + (tb + pos) * PWP + C_DK + h * 64;
        float s = 0.f;
#pragma unroll
        for (int d = 0; d < 8; ++d) s = dot8(qp[d], *reinterpret_cast<const uint4*>(kr + d * 8), s);
        s *= 0.125f;
        mx = fmaxf(mx, s);
      }
    }
#pragma unroll
    for (int d = 0; d < 64; ++d) o[d] = 0.f;
    float l = 0.f;
    for (int pat = 0; pat < 3; ++pat) {
      const int dil = (pat == 0) ? 1 : (pat == 1 ? 4 : 16);
#pragma unroll 1
      for (int j = -64; j <= 64; ++j) {
        const int pos = n + j * dil;
        if (pos < 0 || pos >= SEQ) continue;
        const u16* kr = p.proj() + (tb + pos) * PWP + C_DK + h * 64;
        const u16* vr = p.proj() + (tb + pos) * PWP + C_DV + h * 64;
        float s = 0.f;
#pragma unroll
        for (int d = 0; d < 8; ++d) s = dot8(qp[d], *reinterpret_cast<const uint4*>(kr + d * 8), s);
        s *= 0.125f;
        const float pe = __expf(s - mx);
        l += pe;
#pragma unroll
        for (int d = 0; d < 64; d += 8) {
          float vf[8];
          ld8(vr + d, vf);
#pragma unroll
          for (int jj = 0; jj < 8; ++jj) o[d + jj] += pe * vf[jj];
        }
      }
    }
    const float il = 1.f / l;
#pragma unroll
    for (int d = 0; d < 64; d += 8) {
      uint4 ov;
      ov.x = pack2(o[d + 0] * il, o[d + 1] * il);
      ov.y = pack2(o[d + 2] * il, o[d + 3] * il);
      ov.z = pack2(o[d + 4] * il, o[d + 5] * il);
      ov.w = pack2(o[d + 6] * il, o[d + 7] * il);
      *reinterpret_cast<uint4*>(p.mixed() + (tb + n) * DM + 768 + h * 64 + d) = ov;
    }
  }
}

DI void ph_ssd_naive(const Params& p, int L) {
  const int gt = obid() * NTHR + otid(), gs = gridDim.x * NTHR;
  for (int it = gt; it < 4 * 4 * 4 * SEQ; it += gs) {
    const int l = it & (SEQ - 1), pq = (it >> 12) & 3, h = (it >> 14) & 3, b = it >> 16;
    const int g = h >> 1;
    const size_t tb = (size_t)b * SEQ;
    uint4 cl[16];
    float acc[16];
#pragma unroll
    for (int d = 0; d < 16; ++d) cl[d] = *reinterpret_cast<const uint4*>(p.xbc() + (tb + l) * 768 + 512 + g * 128 + d * 8);
#pragma unroll
    for (int d = 0; d < 16; ++d) acc[d] = 0.f;
    const float pl = p.cs()[(tb + l) * 8 + h], rl = p.cs()[(tb + l) * 8 + 4 + h];
#pragma unroll 1
    for (int s = 0; s < SEQ; ++s) {
      const u16* br = p.xbc() + (tb + s) * 768 + 256 + g * 128;
      float cbv = 0.f;
#pragma unroll
      for (int d = 0; d < 16; ++d) cbv = dot8(cl[d], *reinterpret_cast<const uint4*>(br + d * 8), cbv);
      float w;
      if (s <= l) w = expf(pl - p.cs()[(tb + s) * 8 + h]) * p.dtv()[(tb + s) * 8 + h];
      else w = expf(rl - p.cs()[(tb + s) * 8 + 4 + h]) * p.dtv()[(tb + s) * 8 + 4 + h];
      cbv *= w;
      const u16* xr = p.xbc() + (tb + s) * 768 + h * 64 + pq * 16;
#pragma unroll
      for (int d = 0; d < 16; d += 8) {
        float xf[8];
        ld8(xr + d, xf);
#pragma unroll
        for (int j = 0; j < 8; ++j) acc[d + j] += cbv * xf[j];
      }
    }
    const float dsk = p.ssm_d[L * 4 + h];
#pragma unroll
    for (int d = 0; d < 16; ++d) {
      const int c = h * 64 + pq * 16 + d;
      const float xv = bf2f(p.xbc()[(tb + l) * 768 + c]);
      const float z = bf2f(p.proj()[(tb + l) * PWP + C_Z + c]);
      p.ybuf()[(tb + l) * 256 + c] = (acc[d] + dsk * xv) * silu(z);
    }
  }
}

DI void ph_ssd_norm(const Params& p, int L) {
  const int tid_ = otid(); const int lane = tid_ & 63, gw = (obid() * NTHR + tid_) >> 6, nw = gridDim.x * (NTHR / 64);
  const float* nwt = p.ssm_norm_w + L * 256;
  for (int t = gw; t < T; t += nw) {
    const float4 v = *reinterpret_cast<const float4*>(p.ybuf() + (size_t)t * 256 + lane * 4);
    float ss = wave_sum(v.x * v.x + v.y * v.y + v.z * v.z + v.w * v.w);
    const float rstd = rsqrtf(ss * (1.f / 256.f) + 1e-6f);
    const float4 ww = *reinterpret_cast<const float4*>(nwt + lane * 4);
    uint2 o;
    o.x = pack2(v.x * rstd * ww.x, v.y * rstd * ww.y);
    o.y = pack2(v.z * rstd * ww.z, v.w * rstd * ww.w);
    *reinterpret_cast<uint2*>(p.mixed() + (size_t)t * DM + 512 + lane * 4) = o;
  }
}

#define MFMA16(a, b, c) __builtin_amdgcn_mfma_f32_16x16x32_bf16((a), (b), (c), 0, 0, 0)
template <int MT, int NT, int KS>
DI void wave_mm(f32x4 (&acc)[MT][NT], const u16* a0, int lda, const u16* b0, int ldb, int fr, int fq) {
#pragma unroll
  for (int ks = 0; ks < KS; ++ks) {
    bf16x8 af[MT], bfv[NT];
#pragma unroll
    for (int m = 0; m < MT; ++m) af[m] = *reinterpret_cast<const bf16x8*>(a0 + (m * 16 + fr) * lda + ks * 32 + fq * 8);
#pragma unroll
    for (int n = 0; n < NT; ++n) bfv[n] = *reinterpret_cast<const bf16x8*>(b0 + (n * 16 + fr) * ldb + ks * 32 + fq * 8);
#pragma unroll
    for (int m = 0; m < MT; ++m)
#pragma unroll
      for (int n = 0; n < NT; ++n) acc[m][n] = MFMA16(af[m], bfv[n], acc[m][n]);
  }
}
template <int MT, int NT>
DI void zero_acc(f32x4 (&acc)[MT][NT]) {
#pragma unroll
  for (int m = 0; m < MT; ++m)
#pragma unroll
    for (int n = 0; n < NT; ++n) acc[m][n] = f32x4{0.f, 0.f, 0.f, 0.f};
}
template <int NROWS, int NCOLS>
DI void stage_rows(u16* dst, int ldd, const u16* src, size_t lsrc, int tid) {
  constexpr int CPR = NCOLS / 8, NCH = NROWS * CPR / NTHR;
  static_assert(NROWS * CPR % NTHR == 0, "tile must be a multiple of 512 chunks");
  uint4 r[NCH];
#pragma unroll
  for (int i = 0; i < NCH; ++i) {
    const int c = tid + i * NTHR, row = c / CPR, cc = c % CPR;
    r[i] = *reinterpret_cast<const uint4*>(src + (size_t)row * lsrc + cc * 8);
  }
#pragma unroll
  for (int i = 0; i < NCH; ++i) {
    const int c = tid + i * NTHR, row = c / CPR, cc = c % CPR;
    *reinterpret_cast<uint4*>(dst + row * ldd + cc * 8) = r[i];
  }
}
template <int NCOLS, class W>
DI void stage_T(u16* dst, int ldd, const u16* src, size_t lsrc, int tid, W w) {
  constexpr int NCH = 128 * (NCOLS / 8) / NTHR;
  uint4 r[NCH];
#pragma unroll
  for (int i = 0; i < NCH; ++i) {
    const int c = tid + i * NTHR, j = c & 127, cc = c >> 7;
    r[i] = *reinterpret_cast<const uint4*>(src + (size_t)j * lsrc + cc * 8);
  }
#pragma unroll
  for (int i = 0; i < NCH; ++i) {
    const int c = tid + i * NTHR, j = c & 127, cc = c >> 7;
    float f[8];
    unpack8(r[i], f);
    const float wj = w(j);
#pragma unroll
    for (int e = 0; e < 8; ++e) dst[(cc * 8 + e) * ldd + j] = f2bf(f[e] * wj);
  }
}

template <int NROWS, int NCOLS>
DI void stage_rows_ld(uint4 (&r)[NROWS * (NCOLS / 8) / NTHR], const u16* src, size_t lsrc, int tid) {
  constexpr int CPR = NCOLS / 8, NCH = NROWS * CPR / NTHR;
#pragma unroll
  for (int i = 0; i < NCH; ++i) {
    const int c = tid + i * NTHR, row = c / CPR, cc = c % CPR;
    r[i] = *reinterpret_cast<const uint4*>(src + (size_t)row * lsrc + cc * 8);
  }
}
template <int NROWS, int NCOLS>
DI void stage_rows_st(u16* dst, int ldd, const uint4 (&r)[NROWS * (NCOLS / 8) / NTHR], int tid) {
  constexpr int CPR = NCOLS / 8, NCH = NROWS * CPR / NTHR;
#pragma unroll
  for (int i = 0; i < NCH; ++i) {
    const int c = tid + i * NTHR, row = c / CPR, cc = c % CPR;
    *reinterpret_cast<uint4*>(dst + row * ldd + cc * 8) = r[i];
  }
}
template <int NCOLS>
DI void stage_T_ld(uint4 (&r)[128 * (NCOLS / 8) / NTHR], const u16* src, size_t lsrc, int tid) {
  constexpr int NCH = 128 * (NCOLS / 8) / NTHR;
#pragma unroll
  for (int i = 0; i < NCH; ++i) {
    const int c = tid + i * NTHR, j = c & 127, cc = c >> 7;
    r[i] = *reinterpret_cast<const uint4*>(src + (size_t)j * lsrc + cc * 8);
  }
}
template <int NCOLS, class W>
DI void stage_T_st(u16* dst, int ldd, const uint4 (&r)[128 * (NCOLS / 8) / NTHR], int tid, W w) {
  constexpr int NCH = 128 * (NCOLS / 8) / NTHR;
#pragma unroll
  for (int i = 0; i < NCH; ++i) {
    const int c = tid + i * NTHR, j = c & 127, cc = c >> 7;
    float f[8];
    unpack8(r[i], f);
    const float wj = w(j);
#pragma unroll
    for (int e = 0; e < 8; ++e) dst[(cc * 8 + e) * ldd + j] = f2bf(f[e] * wj);
  }
}

DI void ph_ret_a(const Params& p, char* smem, int item) {
  const int tid = otid(), wid = tid >> 6, lane = tid & 63, fr = lane & 15, fq = lane >> 4;
  u16* sVt = reinterpret_cast<u16*>(smem);
  u16* sKf = sVt + 64 * 136;
  u16* sKb = sKf + 64 * 136;
  {
    const int c = item & 31, bh = item >> 5, b = bh >> 2, h = bh & 3;
    const float lg0 = log1pf(-exp2f(-5.f - (float)h)), lg1 = log1pf(-exp2f(-5.5f - (float)h));
    const u16* src = p.proj() + ((size_t)b * SEQ + c * 128) * PWP;
    {
      uint4 rv[2], rk[2];
      stage_T_ld<64>(rv, src + C_RV + h * 64, PWP, tid);
      stage_T_ld<64>(rk, src + C_RK + h * 64, PWP, tid);
      stage_T_st<64>(sVt, 136, rv, tid, [](int) { return 1.f; });
      stage_T_st<64>(sKf, 136, rk, tid, [&](int j) { return __expf(lg0 * (float)(127 - j)); });
      stage_T_st<64>(sKb, 136, rk, tid, [&](int j) { return __expf(lg1 * (float)j); });
    }
    __syncthreads();
    const int dir = wid >> 2, q = wid & 3;
    f32x4 acc[1][4];
    zero_acc(acc);
    wave_mm<1, 4, 4>(acc, sVt + q * 16 * 136, 136, dir ? sKb : sKf, 136, fr, fq);
    float* out = p.rU() + ((size_t)(bh * 32 + c) * 2 + dir) * 4096;
#pragma unroll
    for (int n = 0; n < 4; ++n)
#pragma unroll
      for (int j = 0; j < 4; ++j) out[(q * 16 + fq * 4 + j) * 64 + n * 16 + fr] = acc[0][n][j];
    __syncthreads();
  }
}
DI void ph_ret_scan(const Params& p) {
  const int gt = obid() * NTHR + otid(), gs = gridDim.x * NTHR;
  for (int it = gt; it < 16 * 2 * 4096; it += gs) {
    const int e = it & 4095, dir = (it >> 12) & 1, bh = it >> 13, h = bh & 3;
    const float lg = log1pf(-exp2f((dir ? -5.5f : -5.f) - (float)h));
    const float cd = __expf(lg * 128.f);
    float u[32];
#pragma unroll
    for (int c = 0; c < 32; ++c) u[c] = p.rU()[((size_t)(bh * 32 + c) * 2 + dir) * 4096 + e];
    float st = 0.f;
    if (dir == 0) {
#pragma unroll
      for (int c = 0; c < 32; ++c) {
        p.rS()[((size_t)(bh * 32 + c) * 2 + dir) * 4096 + e] = f2bf(st);
        st = st * cd + u[c];
      }
    } else {
#pragma unroll
      for (int c = 31; c >= 0; --c) {
        p.rS()[((size_t)(bh * 32 + c) * 2 + dir) * 4096 + e] = f2bf(st);
        st = st * cd + u[c];
      }
    }
  }
}
DI void ph_ret_c(const Params& p, char* smem, int item) {
  const int tid = otid(), wid = tid >> 6, lane = tid & 63, fr = lane & 15, fq = lane >> 4;
  u16* sQ = reinterpret_cast<u16*>(smem);
  u16* sK = sQ + 128 * 72;
  u16* sVt = sK + 128 * 72;
  u16* sSf = sVt + 64 * 136;
  u16* sSb = sSf + 64 * 72;
  u16* sP = sSb + 64 * 72;
  {
    const int c = item & 31, bh = item >> 5, b = bh >> 2, h = bh & 3;
    const float lg0 = log1pf(-exp2f(-5.f - (float)h)), lg1 = log1pf(-exp2f(-5.5f - (float)h));
    const size_t t0 = (size_t)b * SEQ + c * 128;
    const u16* src = p.proj() + t0 * PWP;
    {
      uint4 rq[2], rk[2], rv[2], rf[1], rb[1];
      stage_rows_ld<128, 64>(rq, src + C_RQ + h * 64, PWP, tid);
      stage_rows_ld<128, 64>(rk, src + C_RK + h * 64, PWP, tid);
      stage_T_ld<64>(rv, src + C_RV + h * 64, PWP, tid);
      stage_rows_ld<64, 64>(rf, p.rS() + ((size_t)(bh * 32 + c) * 2 + 0) * 4096, 64, tid);
      stage_rows_ld<64, 64>(rb, p.rS() + ((size_t)(bh * 32 + c) * 2 + 1) * 4096, 64, tid);
      stage_rows_st<128, 64>(sQ, 72, rq, tid);
      stage_rows_st<128, 64>(sK, 72, rk, tid);
      stage_T_st<64>(sVt, 136, rv, tid, [](int) { return 1.f; });
      stage_rows_st<64, 64>(sSf, 72, rf, tid);
      stage_rows_st<64, 64>(sSb, 72, rb, tid);
    }
    __syncthreads();
    {
      const int wr = wid >> 1, wc = wid & 1;
      f32x4 sacc[2][4];
      zero_acc(sacc);
      wave_mm<2, 4, 2>(sacc, sQ + wr * 32 * 72, 72, sK + wc * 64 * 72, 72, fr, fq);
#pragma unroll
      for (int m = 0; m < 2; ++m)
#pragma unroll
        for (int n = 0; n < 4; ++n)
#pragma unroll
          for (int j = 0; j < 4; ++j) {
            const int i = wr * 32 + m * 16 + fq * 4 + j, jj = wc * 64 + n * 16 + fr;
            const float dcy = (jj <= i) ? __expf(lg0 * (float)(i - jj)) : __expf(lg1 * (float)(jj - i));
            sP[i * 136 + jj] = f2bf(sacc[m][n][j] * dcy);
          }
    }
    __syncthreads();
    {
      f32x4 ai[1][4], af_[1][4], ab_[1][4];
      zero_acc(ai); zero_acc(af_); zero_acc(ab_);
      wave_mm<1, 4, 4>(ai, sP + wid * 16 * 136, 136, sVt, 136, fr, fq);
      wave_mm<1, 4, 2>(af_, sQ + wid * 16 * 72, 72, sSf, 72, fr, fq);
      wave_mm<1, 4, 2>(ab_, sQ + wid * 16 * 72, 72, sSb, 72, fr, fq);
#pragma unroll
      for (int j = 0; j < 4; ++j) {
        const int i = wid * 16 + fq * 4 + j;
        const float xf = __expf(lg0 * (float)(i + 1)), xb = __expf(lg1 * (float)(128 - i));
        float o[4], sum = 0.f;
#pragma unroll
        for (int n = 0; n < 4; ++n) { o[n] = ai[0][n][j] + xf * af_[0][n][j] + xb * ab_[0][n][j]; sum += o[n]; }
#pragma unroll
        for (int sft = 1; sft < 16; sft <<= 1) sum += __shfl_xor(sum, sft);
        const float mu = sum * (1.f / 64.f);
        float var = 0.f;
#pragma unroll
        for (int n = 0; n < 4; ++n) var += (o[n] - mu) * (o[n] - mu);
#pragma unroll
        for (int sft = 1; sft < 16; sft <<= 1) var += __shfl_xor(var, sft);
        const float rs = rsqrtf(var * (1.f / 64.f) + 1e-5f);
#pragma unroll
        for (int n = 0; n < 4; ++n) {
          const float g = bf2f(p.proj()[(t0 + i) * PWP + C_RG + h * 64 + n * 16 + fr]);
          p.mixed()[(t0 + i) * DM + h * 64 + n * 16 + fr] = f2bf(silu(g) * (o[n] - mu) * rs);
        }
      }
    }
    __syncthreads();
  }
}

DI void ssd_local_cumsum(const Params& p, int L, size_t t0, float* cum, float* dtl, int wid, int lane) {
  const int dir = wid >> 2, h = wid & 3;
  const float a = -__expf(p.a_log[L * 8 + dir * 4 + h]);
  float d0, d1;
  if (dir == 0) { d0 = p.dtv()[(t0 + 2 * lane) * 8 + h]; d1 = p.dtv()[(t0 + 2 * lane + 1) * 8 + h]; }
  else { d0 = p.dtv()[(t0 + 127 - 2 * lane) * 8 + 4 + h]; d1 = p.dtv()[(t0 + 126 - 2 * lane) * 8 + 4 + h]; }
  float v0 = d0 * a, v1 = v0 + d1 * a;
  float run = v1;
#pragma unroll
  for (int o = 1; o < 64; o <<= 1) {
    const float u = __shfl_up(run, o);
    if (lane >= o) run += u;
  }
  const float excl = run - v1;
  v0 += excl; v1 += excl;
  float* cr = cum + (dir * 4 + h) * 128;
  float* dr = dtl + (dir * 4 + h) * 128;
  if (dir == 0) { cr[2 * lane] = v0; cr[2 * lane + 1] = v1; dr[2 * lane] = d0; dr[2 * lane + 1] = d1; }
  else { cr[127 - 2 * lane] = v0; cr[126 - 2 * lane] = v1; dr[127 - 2 * lane] = d0; dr[126 - 2 * lane] = d1; }
}

DI void ph_ssd_a(const Params& p, int L, char* smem, int item) {
  const int tid = otid(), wid = tid >> 6, lane = tid & 63, fr = lane & 15, fq = lane >> 4;
  u16* sBt = reinterpret_cast<u16*>(smem);
  u16* sXf = sBt + 2 * 128 * 136;
  u16* sXb = sXf + 64 * 136;
  float* cum = reinterpret_cast<float*>(sXb + 64 * 136);
  float* dtl = cum + 8 * 128;
  {
    const int c = item & 31, b = item >> 5;
    const size_t t0 = (size_t)b * SEQ + c * 128;
    ssd_local_cumsum(p, L, t0, cum, dtl, wid, lane);
    stage_T<256>(sBt, 136, p.xbc() + t0 * 768 + 256, 768, tid, [](int) { return 1.f; });
    __syncthreads();
    if (tid < 8) {
      const int dir = tid >> 2;
      p.cdec()[(size_t)item * 8 + tid] = __expf(dir ? cum[tid * 128 + 0] : cum[tid * 128 + 127]);
    }
    for (int h = 0; h < 4; ++h) {
      const float* cf = cum + h * 128;
      const float* cb = cum + (4 + h) * 128;
      const float* df = dtl + h * 128;
      const float* db = dtl + (4 + h) * 128;
      const float endf = cf[127], endb = cb[0];
      {
        uint4 rx[2];
        stage_T_ld<64>(rx, p.xbc() + t0 * 768 + h * 64, 768, tid);
        stage_T_st<64>(sXf, 136, rx, tid, [&](int l) { return __expf(endf - cf[l]) * df[l]; });
        stage_T_st<64>(sXb, 136, rx, tid, [&](int l) { return __expf(endb - cb[l]) * db[l]; });
      }
      __syncthreads();
      const int dir = wid >> 2, q = wid & 3, g = h >> 1;
      f32x4 acc[4][2];
      zero_acc(acc);
      wave_mm<4, 2, 4>(acc, dir ? sXb : sXf, 136, sBt + (g * 128 + q * 32) * 136, 136, fr, fq);
      float* out = p.sU() + ((size_t)item * 8 + h * 2 + dir) * 8192;
#pragma unroll
      for (int m = 0; m < 4; ++m)
#pragma unroll
        for (int n = 0; n < 2; ++n)
#pragma unroll
          for (int j = 0; j < 4; ++j) out[(m * 16 + fq * 4 + j) * 128 + q * 32 + n * 16 + fr] = acc[m][n][j];
      __syncthreads();
    }
  }
}
DI void ph_ssd_scan(const Params& p) {
  const int gt = obid() * NTHR + otid(), gs = gridDim.x * NTHR;
  for (int it = gt; it < 4 * 8 * 8192; it += gs) {
    const int e = it & 8191, hd = (it >> 13) & 7, b = it >> 16;
    const int dir = hd & 1, h = hd >> 1;
    float u[32];
#pragma unroll
    for (int c = 0; c < 32; ++c) u[c] = p.sU()[((size_t)(b * 32 + c) * 8 + hd) * 8192 + e];
    float st = 0.f;
    if (dir == 0) {
#pragma unroll
      for (int c = 0; c < 32; ++c) {
        p.sS()[((size_t)(b * 32 + c) * 8 + hd) * 8192 + e] = f2bf(st);
        st = st * p.cdec()[(size_t)(b * 32 + c) * 8 + dir * 4 + h] + u[c];
      }
    } else {
#pragma unroll
      for (int c = 31; c >= 0; --c) {
        p.sS()[((size_t)(b * 32 + c) * 8 + hd) * 8192 + e] = f2bf(st);
        st = st * p.cdec()[(size_t)(b * 32 + c) * 8 + dir * 4 + h] + u[c];
      }
    }
  }
}
DI void ph_ssd_c(const Params& p, int L, char* smem, int item) {
  const int tid = otid(), wid = tid >> 6, lane = tid & 63, fr = lane & 15, fq = lane >> 4;
  u16* sC = reinterpret_cast<u16*>(smem);
  u16* sB = sC + 128 * 136;
  u16* sXt = sB + 128 * 136;
  u16* sSf = sXt + 64 * 136;
  u16* sSb = sSf + 64 * 136;
  float* cum = reinterpret_cast<float*>(sSb + 64 * 136);
  float* dtl = cum + 8 * 128;
  {
    const int c = item & 31, b = item >> 5;
    const size_t t0 = (size_t)b * SEQ + c * 128;
    ssd_local_cumsum(p, L, t0, cum, dtl, wid, lane);
    float ssq[4] = {0.f, 0.f, 0.f, 0.f};
#pragma unroll 1
    for (int g = 0; g < 2; ++g) {
      {
        uint4 rc[4], rb4[4];
        stage_rows_ld<128, 128>(rc, p.xbc() + t0 * 768 + 512 + g * 128, 768, tid);
        stage_rows_ld<128, 128>(rb4, p.xbc() + t0 * 768 + 256 + g * 128, 768, tid);
        stage_rows_st<128, 128>(sC, 136, rc, tid);
        stage_rows_st<128, 128>(sB, 136, rb4, tid);
      }
      __syncthreads();
      const int wr = wid >> 1, wc = wid & 1;
      f32x4 G[2][4];
      zero_acc(G);
      wave_mm<2, 4, 4>(G, sC + wr * 32 * 136, 136, sB + wc * 64 * 136, 136, fr, fq);
      __syncthreads();
#pragma unroll 1
      for (int hl = 0; hl < 2; ++hl) {
        const int h = g * 2 + hl;
        const float* cf = cum + h * 128;
        const float* cb = cum + (4 + h) * 128;
        const float* df = dtl + h * 128;
        const float* db = dtl + (4 + h) * 128;
        uint4 rxt[2], rsf[2], rsb[2];
        stage_T_ld<64>(rxt, p.xbc() + t0 * 768 + h * 64, 768, tid);
        stage_rows_ld<64, 128>(rsf, p.sS() + ((size_t)item * 8 + h * 2 + 0) * 8192, 128, tid);
        stage_rows_ld<64, 128>(rsb, p.sS() + ((size_t)item * 8 + h * 2 + 1) * 8192, 128, tid);
#pragma unroll
        for (int m = 0; m < 2; ++m)
#pragma unroll
          for (int n = 0; n < 4; ++n)
#pragma unroll
            for (int j = 0; j < 4; ++j) {
              const int l = wr * 32 + m * 16 + fq * 4 + j, sx = wc * 64 + n * 16 + fr;
              const float w = (sx <= l) ? __expf(cf[l] - cf[sx]) * df[sx] : __expf(cb[l] - cb[sx]) * db[sx];
              sB[l * 136 + sx] = f2bf(G[m][n][j] * w);
            }
        stage_T_st<64>(sXt, 136, rxt, tid, [](int) { return 1.f; });
        stage_rows_st<64, 128>(sSf, 136, rsf, tid);
        stage_rows_st<64, 128>(sSb, 136, rsb, tid);
        __syncthreads();
        f32x4 yd[1][4], yf[1][4], yb[1][4];
        zero_acc(yd); zero_acc(yf); zero_acc(yb);
        wave_mm<1, 4, 4>(yd, sB + wid * 16 * 136, 136, sXt, 136, fr, fq);
        wave_mm<1, 4, 4>(yf, sC + wid * 16 * 136, 136, sSf, 136, fr, fq);
        wave_mm<1, 4, 4>(yb, sC + wid * 16 * 136, 136, sSb, 136, fr, fq);
        const float dsk = p.ssm_d[L * 4 + h];
#pragma unroll
        for (int j = 0; j < 4; ++j) {
          const int l = wid * 16 + fq * 4 + j;
          const float ef = __expf(cf[l]), eb = __expf(cb[l]);
#pragma unroll
          for (int n = 0; n < 4; ++n) {
            const int ch = h * 64 + n * 16 + fr;
            const float xv = bf2f(p.xbc()[(t0 + l) * 768 + ch]);
            const float z = bf2f(p.proj()[(t0 + l) * PWP + C_Z + ch]);
            const float yv = (yd[0][n][j] + ef * yf[0][n][j] + eb * yb[0][n][j] + dsk * xv) * silu(z);
            ssq[j] += yv * yv;
            p.ybuf()[(t0 + l) * 256 + ch] = yv;
          }
        }
        __syncthreads();
      }
    }
    const float* nwt = p.ssm_norm_w + L * 256;
#pragma unroll
    for (int j = 0; j < 4; ++j) {
      float ss = ssq[j];
#pragma unroll
      for (int sft = 1; sft < 16; sft <<= 1) ss += __shfl_xor(ss, sft);
      const float rstd = rsqrtf(ss * (1.f / 256.f) + 1e-6f);
      const int l = wid * 16 + fq * 4 + j;
#pragma unroll
      for (int hn = 0; hn < 16; ++hn) {
        const int ch = hn * 16 + fr;
        p.mixed()[(t0 + l) * DM + 512 + ch] = f2bf(p.ybuf()[(t0 + l) * 256 + ch] * rstd * nwt[ch]);
      }
    }
  }
}

template <bool XIN_F32>
struct CfgOutproj {
  static constexpr bool PERM = true;
  int K; const Params* p; int L; int bid, nb; const void* xin; u16* xout;
  DI bool next(int i, pg8::Unit& u) const { const int t = i * nb + bid; if (t >= 64 * 4) return false; u.pm = t & 63; u.pn = t >> 6; return true; }
  DI const char* a_base(const pg8::Unit& u) const { return (const char*)(p->mixed() + (size_t)u.pm * 256 * DM); }
  DI const char* b_base(const pg8::Unit& u) const { return (const char*)(p->WoutT() + ((size_t)L * DM + (size_t)u.pn * 256) * DM); }
  DI void a_off(const pg8::Unit&, int R0, int C0, int R1, int C1, unsigned (&vo)[4]) const {
    vo[0] = (unsigned)(R0 * DM + C0) * 2u; vo[1] = (unsigned)(R1 * DM + C1) * 2u;
    vo[2] = vo[0] + 128u * DM * 2u; vo[3] = vo[1] + 128u * DM * 2u;
  }
  DI void epi(const f32x4 (&acc)[2][2][4][2], const pg8::Unit& u, int wr, int wc, int fr, int fq) const {
    const int row0 = u.pm * 256 + wr * 64 + fr, col0 = u.pn * 256 + wc * 32 + 8 * fq;
#pragma unroll
    for (int ai = 0; ai < 2; ++ai)
#pragma unroll
      for (int m = 0; m < 4; ++m) {
        const size_t ro = (size_t)(row0 + ai * 128 + m * 16) * DM + col0;
#pragma unroll
        for (int bj = 0; bj < 2; ++bj) {
          const size_t o = ro + bj * 128;
          float4 x0, x1;
          if (XIN_F32) {
            x0 = *reinterpret_cast<const float4*>(static_cast<const float*>(xin) + o);
            x1 = *reinterpret_cast<const float4*>(static_cast<const float*>(xin) + o + 4);
          } else {
            const uint4 q = *reinterpret_cast<const uint4*>(static_cast<const u16*>(xin) + o);
            x0 = bf4_to_f4(make_uint2(q.x, q.y)); x1 = bf4_to_f4(make_uint2(q.z, q.w));
          }
          const f32x4 a0 = acc[ai][bj][m][0], a1 = acc[ai][bj][m][1];
          uint4 w;
          w.x = pack2(x0.x + a0[0], x0.y + a0[1]); w.y = pack2(x0.z + a0[2], x0.w + a0[3]);
          w.z = pack2(x1.x + a1[0], x1.y + a1[1]); w.w = pack2(x1.z + a1[2], x1.w + a1[3]);
          *reinterpret_cast<uint4*>(xout + o) = w;
        }
      }
  }
};
DI void ph_outproj(const Params& p, int L, char* smem) {
  if (L == 0) {
    CfgOutproj<true> c; c.K = DM; c.p = &p; c.L = L; c.bid = obid(); c.nb = gridDim.x; c.xin = p.x; c.xout = p.xres();
    pg8::gemm_phase((pg8::lds_u8*)smem, c);
  } else {
    CfgOutproj<false> c; c.K = DM; c.p = &p; c.L = L; c.bid = obid(); c.nb = gridDim.x; c.xin = p.xres2(); c.xout = p.xres();
    pg8::gemm_phase((pg8::lds_u8*)smem, c);
  }
}

DI void ph_rms2_router(const Params& p, int L, const u16* xres, char* smem) {
  const int tid = otid(), lane = tid & 63, gw = (obid() * NTHR + tid) >> 6, nw = gridDim.x * (NTHR / 64);
  const float* w = p.ln2_w + L * DM;
  const float* rw = p.router_w + (size_t)L * DM * 16;
  float4* srw = reinterpret_cast<float4*>(smem);
  for (int i = tid; i < 4096; i += NTHR) {
    const int c = i >> 2, e4 = i & 3;
    srw[(e4 * 4 + (c & 3)) * 256 + (c >> 2)] = *reinterpret_cast<const float4*>(rw + (size_t)i * 4);
  }
  __syncthreads();
  const int b5 = (lane >> 5) & 1, b4 = (lane >> 4) & 1, b3 = (lane >> 3) & 1, b2 = (lane >> 2) & 1;
  const int my_e = 8 * b5 + 4 * b4 + 2 * b3 + b2;
  float4 v[4];
  if (gw < T) {
#pragma unroll
    for (int i = 0; i < 4; ++i) v[i] = bf4_to_f4(*reinterpret_cast<const uint2*>(xres + (size_t)gw * DM + (i * 64 + lane) * 4));
  }
  for (int t = gw; t < T; t += nw) {
    uint2 vnx[4];
    const int tn = (t + nw < T) ? (t + nw) : t;
#pragma unroll
    for (int i = 0; i < 4; ++i) vnx[i] = *reinterpret_cast<const uint2*>(xres + (size_t)tn * DM + (i * 64 + lane) * 4);
    float ss = 0.f;
#pragma unroll
    for (int i = 0; i < 4; ++i) ss += v[i].x * v[i].x + v[i].y * v[i].y + v[i].z * v[i].z + v[i].w * v[i].w;
    ss = wave_sum(ss);
    const float rstd = rsqrtf(ss * (1.f / DM) + 1e-6f);
    float lg[16];
#pragma unroll
    for (int e = 0; e < 16; ++e) lg[e] = 0.f;
#pragma unroll
    for (int i = 0; i < 4; ++i) {
      const int q = i * 64 + lane;
      const float4 ww = *reinterpret_cast<const float4*>(w + q * 4);
      const float hv[4] = {v[i].x * rstd * ww.x, v[i].y * rstd * ww.y, v[i].z * rstd * ww.z, v[i].w * rstd * ww.w};
      *reinterpret_cast<unsigned*>(p.hn8() + (size_t)t * DM + q * 4) =
          pk4_f8(hv[0] * F8_H_SCALE, hv[1] * F8_H_SCALE, hv[2] * F8_H_SCALE, hv[3] * F8_H_SCALE);
#pragma unroll
      for (int j = 0; j < 4; ++j)
#pragma unroll
        for (int e4 = 0; e4 < 4; ++e4) {
          const float4 r = srw[(e4 * 4 + j) * 256 + q];
          lg[e4 * 4 + 0] += hv[j] * r.x; lg[e4 * 4 + 1] += hv[j] * r.y;
          lg[e4 * 4 + 2] += hv[j] * r.z; lg[e4 * 4 + 3] += hv[j] * r.w;
        }
      __builtin_amdgcn_sched_barrier(0);
    }
#pragma unroll
    for (int k = 0; k < 8; ++k) {
      const float send = b5 ? lg[k] : lg[k + 8], keep = b5 ? lg[k + 8] : lg[k];
      lg[k] = keep + __shfl_xor(send, 32);
    }
#pragma unroll
    for (int k = 0; k < 4; ++k) {
      const float send = b4 ? lg[k] : lg[k + 4], keep = b4 ? lg[k + 4] : lg[k];
      lg[k] = keep + __shfl_xor(send, 16);
    }
#pragma unroll
    for (int k = 0; k < 2; ++k) {
      const float send = b3 ? lg[k] : lg[k + 2], keep = b3 ? lg[k + 2] : lg[k];
      lg[k] = keep + __shfl_xor(send, 8);
    }
    float lv;
    {
      const float send = b2 ? lg[0] : lg[1], keep = b2 ? lg[1] : lg[0];
      lv = keep + __shfl_xor(send, 4);
    }
    lv += __shfl_xor(lv, 2);
    lv += __shfl_xor(lv, 1);
    float mx = lv;
    mx = fmaxf(mx, __shfl_xor(mx, 4)); mx = fmaxf(mx, __shfl_xor(mx, 8));
    mx = fmaxf(mx, __shfl_xor(mx, 16)); mx = fmaxf(mx, __shfl_xor(mx, 32));
    const float ex = expf(lv - mx);
    float den = ex;
    den += __shfl_xor(den, 4); den += __shfl_xor(den, 8); den += __shfl_xor(den, 16); den += __shfl_xor(den, 32);
    if ((lane & 3) == 0) { p.aff()[(size_t)t * 16 + my_e] = ex / den; p.inv()[(size_t)t * 16 + my_e] = -1; }
#pragma unroll
    for (int i = 0; i < 4; ++i) v[i] = bf4_to_f4(vnx[i]);
  }
}

DI int block_sum_i(int v, int* red, int tid) {
#pragma unroll
  for (int o = 32; o > 0; o >>= 1) v += __shfl_xor(v, o);
  __syncthreads();
  if ((tid & 63) == 0) red[tid >> 6] = v;
  __syncthreads();
  int t = 0;
#pragma unroll
  for (int w = 0; w < NTHR / 64; ++w) t += red[w];
  return t;
}
DI void ph_topk(const Params& p, char* smem) {
  int* red = reinterpret_cast<int*>(smem);
  int* wsum = red + 16;
  const int tid = otid(), wid = tid >> 6, lane = tid & 63;
  for (int it = obid(); it < 64; it += gridDim.x) {
    const int e = it & 15, b = it >> 4;
    unsigned v[8];
#pragma unroll
    for (int i = 0; i < 8; ++i) v[i] = __float_as_uint(p.aff()[(size_t)(b * SEQ + tid * 8 + i) * 16 + e]);
    unsigned thr = 0;
#pragma unroll 1
    for (int bit = 30; bit >= 0; --bit) {
      const unsigned cand = thr | (1u << bit);
      int cnt = 0;
#pragma unroll
      for (int i = 0; i < 8; ++i) cnt += (v[i] >= cand) ? 1 : 0;
      if (block_sum_i(cnt, red, tid) >= 512) thr = cand;
    }
    int ngt = 0, ntie = 0;
#pragma unroll
    for (int i = 0; i < 8; ++i) { ngt += (v[i] > thr) ? 1 : 0; ntie += (v[i] == thr) ? 1 : 0; }
    int ig = ngt, itie = ntie;
#pragma unroll
    for (int o = 1; o < 64; o <<= 1) {
      const int a = __shfl_up(ig, o), c = __shfl_up(itie, o);
      if (lane >= o) { ig += a; itie += c; }
    }
    __syncthreads();
    if (lane == 63) { wsum[wid] = ig; wsum[8 + wid] = itie; }
    __syncthreads();
    int og = 0, ot = 0, totg = 0;
#pragma unroll
    for (int w = 0; w < 8; ++w) {
      const int a = wsum[w], c = wsum[8 + w];
      if (w < wid) { og += a; ot += c; }
      totg += a;
    }
    int pg = og + ig - ngt, pt = ot + itie - ntie;
    const int base = (e * 4 + b) * 512;
#pragma unroll
    for (int i = 0; i < 8; ++i) {
      int slot = -1;
      if (v[i] > thr) { slot = pg; ++pg; }
      else if (v[i] == thr) { if (totg + pt < 512) slot = totg + pt; ++pt; }
      if (slot >= 0) {
        p.tok()[base + slot] = b * SEQ + tid * 8 + i;
        p.inv()[(size_t)(b * SEQ + tid * 8 + i) * 16 + e] = base + slot;
        p.gate()[base + slot] = __uint_as_float(v[i]);
      }
    }
    __syncthreads();
  }
}

struct CfgMoe1 {
  static constexpr bool PERM = true;
  int K; const Params* p; int L; int bid, nb;
  DI bool next(int i, pg8::Unit& u) const {
    const int t = i * nb + bid; if (t >= 16 * 16 * 8) return false;
    const int rnd = t >> 8, w = t & 255, xcd = w & 7, jx = w >> 3, pid = xcd * 4 + (jx >> 3);
    const int mt = jx & 7, nt = pid & 15, e = rnd * 2 + (pid >> 4);
    u.pm = e * 8 + mt; u.pn = e * 16 + nt; return true;
  }
  DI const char* a_base(const pg8::Unit&) const { return (const char*)p->hn8(); }
  DI const char* b_base(const pg8::Unit& u) const { return (const char*)(p->Wgu8() + ((size_t)L * 16 * 4096 + (size_t)u.pn * 256) * DM); }
  const int* tokl;
  DI void a_off(const pg8::Unit&, int R0, int C0, int R1, int C1, unsigned (&vo)[4], int ui) const {
    const int* tk = tokl + ui * 256;
    vo[0] = (unsigned)(tk[R0] * 512 + C0) * 2u; vo[1] = (unsigned)(tk[R1] * 512 + C1) * 2u;
    vo[2] = (unsigned)(tk[128 + R0] * 512 + C0) * 2u; vo[3] = (unsigned)(tk[128 + R1] * 512 + C1) * 2u;
  }
  DI void epi(const f32x4 (&acc)[2][2][4][2], const pg8::Unit& u, int wr, int wc, int fr, int fq) const {
    const int row0 = u.pm * 256 + wr * 64 + fr, col0 = (u.pn & 15) * 128 + wc * 32 + 8 * fq;
    const float dq = 1.f / (F8_H_SCALE * F8_W_SCALE);
#pragma unroll
    for (int ai = 0; ai < 2; ++ai)
#pragma unroll
      for (int m = 0; m < 4; ++m) {
        const f32x4 g0 = acc[ai][0][m][0] * dq, g1 = acc[ai][0][m][1] * dq, u0 = acc[ai][1][m][0] * (dq * F8_HID_SCALE), u1 = acc[ai][1][m][1] * (dq * F8_HID_SCALE);
        uint2 w;
        w.x = pk4_f8(fast_silu(g0[0]) * u0[0], fast_silu(g0[1]) * u0[1], fast_silu(g0[2]) * u0[2], fast_silu(g0[3]) * u0[3]);
        w.y = pk4_f8(fast_silu(g1[0]) * u1[0], fast_silu(g1[1]) * u1[1], fast_silu(g1[2]) * u1[2], fast_silu(g1[3]) * u1[3]);
        *reinterpret_cast<uint2*>(p->hid8() + (size_t)(row0 + ai * 128 + m * 16) * 2048 + col0) = w;
      }
  }
};
DI void ph_moe1(const Params& p, int L, char* smem) {
  CfgMoe1 c; c.K = 512; c.p = &p; c.L = L; c.bid = obid(); c.nb = gridDim.x;
  int* tokl = reinterpret_cast<int*>(smem + 131072);
  c.tokl = tokl;
  for (int idx = otid(); idx < 8 * 256; idx += NTHR) {
    pg8::Unit u;
    if (c.next(idx >> 8, u)) tokl[idx] = p.tok()[u.pm * 256 + (idx & 255)];
  }
  __syncthreads();
  pg8::gemm_phase_f8((pg8::lds_u8*)smem, c);
}
struct CfgMoe2 {
  static constexpr bool PERM = true;
  int K; const Params* p; int L; int bid, nb;
  DI bool next(int i, pg8::Unit& u) const {
    const int t = i * nb + bid; if (t >= 16 * 4 * 8) return false;
    const int rnd = t >> 8, w = t & 255, xcd = w & 7, jx = w >> 3, pid = rnd * 32 + xcd * 4 + (jx >> 3);
    u.pm = (pid >> 2) * 8 + (jx & 7); u.pn = pid; return true;
  }
  DI const char* a_base(const pg8::Unit& u) const { return (const char*)(p->hid8() + (size_t)u.pm * 256 * 2048); }
  DI const char* b_base(const pg8::Unit& u) const { return (const char*)(p->Wd8() + ((size_t)L * 16 * DM + (size_t)u.pn * 256) * 2048); }
  DI void a_off(const pg8::Unit&, int R0, int C0, int R1, int C1, unsigned (&vo)[4], int) const {
    vo[0] = (unsigned)(R0 * 1024 + C0) * 2u; vo[1] = (unsigned)(R1 * 1024 + C1) * 2u;
    vo[2] = vo[0] + 128u * 1024u * 2u; vo[3] = vo[1] + 128u * 1024u * 2u;
  }
  DI void epi(const f32x4 (&acc)[2][2][4][2], const pg8::Unit& u, int wr, int wc, int fr, int fq) const {
    u16* eo = p->proj();
    const int row0 = u.pm * 256 + wr * 64 + fr, col0 = (u.pn & 3) * 256 + wc * 32 + 8 * fq;
#pragma unroll
    for (int ai = 0; ai < 2; ++ai)
#pragma unroll
      for (int m = 0; m < 4; ++m) {
        const int row = row0 + ai * 128 + m * 16;
        const float gt = p->gate()[row] * (1.f / (F8_HID_SCALE * F8_W_SCALE));
#pragma unroll
        for (int bj = 0; bj < 2; ++bj) {
          const f32x4 a0 = acc[ai][bj][m][0], a1 = acc[ai][bj][m][1];
          uint4 w;
          w.x = pack2(gt * a0[0], gt * a0[1]); w.y = pack2(gt * a0[2], gt * a0[3]);
          w.z = pack2(gt * a1[0], gt * a1[1]); w.w = pack2(gt * a1[2], gt * a1[3]);
          *reinterpret_cast<uint4*>(eo + (size_t)row * DM + col0 + bj * 128) = w;
        }
      }
  }
};
DI void ph_moe2(const Params& p, int L, char* smem) {
  CfgMoe2 c; c.K = 1024; c.p = &p; c.L = L; c.bid = obid(); c.nb = gridDim.x;
  pg8::gemm_phase_f8((pg8::lds_u8*)smem, c);
}
template <bool FINAL>
DI void ph_combine_norm(const Params& p, const u16* __restrict__ xa, u16* __restrict__ xnew, const float* __restrict__ w,
                        u16* __restrict__ hn_out, float* __restrict__ f_out) {
  const int tid_ = otid(), lane = tid_ & 63, gw = (obid() * NTHR + tid_) >> 6, nw = gridDim.x * (NTHR / 64);
  const u16* eo = p.proj();
  float4 v[4];
  int myrow = -1;
  if (gw < T) {
#pragma unroll
    for (int i = 0; i < 4; ++i) v[i] = bf4_to_f4(*reinterpret_cast<const uint2*>(xa + (size_t)gw * DM + (i * 64 + lane) * 4));
    myrow = (lane < 16) ? p.inv()[(size_t)gw * 16 + lane] : -1;
  }
  for (int t = gw; t < T; t += nw) {
    uint2 vnx[4];
    const int tn = (t + nw < T) ? (t + nw) : t;
#pragma unroll
    for (int i = 0; i < 4; ++i) vnx[i] = *reinterpret_cast<const uint2*>(xa + (size_t)tn * DM + (i * 64 + lane) * 4);
    const int myrow_nx = (lane < 16) ? p.inv()[(size_t)tn * 16 + lane] : -1;
    unsigned long long mask = __builtin_amdgcn_ballot_w64(myrow >= 0);
#pragma unroll 1
    while (mask != 0ull) {
      const int e0 = __builtin_ctzll(mask);
      mask &= mask - 1ull;
      const int r0 = __builtin_amdgcn_readlane(myrow, e0);
      int r1 = -1;
      if (mask != 0ull) { const int e1 = __builtin_ctzll(mask); mask &= mask - 1ull; r1 = __builtin_amdgcn_readlane(myrow, e1); }
      uint2 q0[4], q1[4];
#pragma unroll
      for (int i = 0; i < 4; ++i) q0[i] = *reinterpret_cast<const uint2*>(eo + (size_t)r0 * DM + (i * 64 + lane) * 4);
      const int r1c = (r1 >= 0) ? r1 : r0;
#pragma unroll
      for (int i = 0; i < 4; ++i) q1[i] = *reinterpret_cast<const uint2*>(eo + (size_t)r1c * DM + (i * 64 + lane) * 4);
      const float s1 = (r1 >= 0) ? 1.f : 0.f;
#pragma unroll
      for (int i = 0; i < 4; ++i) {
        v[i].x += __uint_as_float(q0[i].x << 16); v[i].y += __uint_as_float(q0[i].x & 0xffff0000u);
        v[i].z += __uint_as_float(q0[i].y << 16); v[i].w += __uint_as_float(q0[i].y & 0xffff0000u);
        v[i].x += s1 * __uint_as_float(q1[i].x << 16); v[i].y += s1 * __uint_as_float(q1[i].x & 0xffff0000u);
        v[i].z += s1 * __uint_as_float(q1[i].y << 16); v[i].w += s1 * __uint_as_float(q1[i].y & 0xffff0000u);
      }
    }
    float ss = 0.f;
#pragma unroll
    for (int i = 0; i < 4; ++i) ss += v[i].x * v[i].x + v[i].y * v[i].y + v[i].z * v[i].z + v[i].w * v[i].w;
    ss = wave_sum(ss);
    const float rstd = rsqrtf(ss * (1.f / DM) + 1e-6f);
#pragma unroll
    for (int i = 0; i < 4; ++i) {
      const int c = (i * 64 + lane) * 4;
      const float4 ww = *reinterpret_cast<const float4*>(w + c);
      if (FINAL) {
        *reinterpret_cast<float4*>(f_out + (size_t)t * DM + c) = make_float4(v[i].x * rstd * ww.x, v[i].y * rstd * ww.y, v[i].z * rstd * ww.z, v[i].w * rstd * ww.w);
      } else {
        uint2 xo;
        xo.x = pack2(v[i].x, v[i].y); xo.y = pack2(v[i].z, v[i].w);
        *reinterpret_cast<uint2*>(xnew + (size_t)t * DM + c) = xo;
        uint2 o;
        o.x = pack2(v[i].x * rstd * ww.x, v[i].y * rstd * ww.y);
        o.y = pack2(v[i].z * rstd * ww.z, v[i].w * rstd * ww.w);
        *reinterpret_cast<uint2*>(hn_out + (size_t)t * DM + c) = o;
      }
    }
#pragma unroll
    for (int i = 0; i < 4; ++i) v[i] = bf4_to_f4(vnx[i]);
    myrow = myrow_nx;
  }
}

__global__ void __launch_bounds__(NTHR) mk(Params p) {
  extern __shared__ __attribute__((aligned(16))) char smem[];
  cg::grid_group grid = cg::this_grid();
  __shared__ uint4 xb_words;
  if (threadIdx.x == 0) xb_words = make_uint4(0u, 0u, 0u, 0u);
  __syncthreads();
  XcdBarrier xb = xcd_barrier_post(p.bar(), (volatile LAS unsigned*)&xb_words);
  for (int rep = 0; rep < p.rep[0]; ++rep) ph_convert(p, smem);
  ph_rmsnorm_bf16(p.x, p.ln1_w, p.hn());
  xcd_barrier(xb);
  if (p.rep[12] == 0x7fffffff) grid.sync();
  for (int L = 0; L < 2; ++L) {
    u16* xout = p.xres();
    if (L == 1) {
      for (int rep = 0; rep < p.rep[1]; ++rep) ph_combine_norm<false>(p, p.xres(), p.xres2(), p.ln1_w + DM, p.hn(), nullptr);
      xcd_barrier(xb);
    }
    for (int rp = 0; rp < p.rep[3]; ++rp) {
      for (int rep = 0; rep < p.rep[2]; ++rep) ph_inproj(p, L, smem);
      xcd_barrier(xb);
      ph_post(p, L);
      xcd_barrier(xb);
    }
    for (int rep = 0; rep < p.rep[12]; ++rep) xcd_barrier(xb);
    {
      unsigned* ctr = p.bar() + XCD_BAR_WORDS + 8 + L;
      __shared__ int q1_item;
      for (;;) {
        if (threadIdx.x == 0) q1_item = (int)atomicAdd(ctr, 1u);
        __syncthreads();
        const int it = q1_item;
        __syncthreads();
        if (it >= 1344) break;
        if (it < 256) ph_dil_pass<0>(p, smem, it);
        else if (it < 384) ph_ssd_a(p, L, smem, it - 256);
        else if (it < 576) ph_mla_up_q(p, L, smem, it - 384);
        else if (it < 832) ph_mla_up_kv(p, L, smem, it - 576);
        else ph_ret_a(p, smem, it - 832);
      }
    }
    xcd_barrier(xb);
    for (int rep = 0; rep < p.rep[5]; ++rep) {
      for (int r2 = 0; r2 < p.rep[13]; ++r2) { ph_ret_scan(p); ph_ssd_scan(p); }
      for (int r2 = 0; r2 < p.rep[14]; ++r2) ph_mla_attn(p, smem);
      for (int r2 = 0; r2 < p.rep[15]; ++r2) for (int bi = obid(); bi < 256; bi += gridDim.x) ph_dil_pass<1>(p, smem, bi);
    }
    xcd_barrier(xb);
    {
      unsigned* ctr = p.bar() + XCD_BAR_WORDS + L;
      __shared__ int q_item;
      for (;;) {
        if (threadIdx.x == 0) q_item = (int)atomicAdd(ctr, 1u);
        __syncthreads();
        const int it = q_item;
        __syncthreads();
        if (it >= 640) break;
        if (it < 128) ph_ssd_c(p, L, smem, it);
        else ph_ret_c(p, smem, it - 128);
      }
    }
    xcd_barrier(xb);
    for (int rep = 0; rep < p.rep[7]; ++rep) ph_outproj(p, L, smem);
    xcd_barrier(xb);
    for (int rep = 0; rep < p.rep[8]; ++rep) ph_rms2_router(p, L, xout, smem);
    xcd_barrier(xb);
    for (int rep = 0; rep < p.rep[9]; ++rep) ph_topk(p, smem);
    xcd_barrier(xb);
    for (int rep = 0; rep < p.rep[10]; ++rep) ph_moe1(p, L, smem);
    xcd_barrier(xb);
    for (int rep = 0; rep < p.rep[11]; ++rep) ph_moe2(p, L, smem);
    xcd_barrier(xb);
  }
  ph_combine_norm<true>(p, p.xres(), nullptr, p.final_w, nullptr, p.out);
}

extern "C" void kernel_launch(void* const* d_in, const int* in_sizes, int n_in, void* d_out, int out_size, void* d_ws,
                              size_t ws_size, hipStream_t stream) {
  static int grid_blocks = 0;
  if (!grid_blocks) {
    int dev = 0, cus = 0, per_cu = 0;
    (void)hipGetDevice(&dev);
    (void)hipDeviceGetAttribute(&cus, hipDeviceAttributeMultiprocessorCount, dev);
    (void)hipFuncSetAttribute((const void*)mk, hipFuncAttributeMaxDynamicSharedMemorySize, LDS_BYTES);
    (void)hipOccupancyMaxActiveBlocksPerMultiprocessor(&per_cu, (const void*)mk, NTHR, LDS_BYTES);
    if (per_cu < 1) { fprintf(stderr, "occupancy query says %d blocks/CU\n", per_cu); per_cu = 1; }
    grid_blocks = cus * 1;
  }
  Params p{};
  const float** fp = reinterpret_cast<const float**>(&p);
  for (int i = 0; i < 20; ++i) fp[i] = (const float*)d_in[i];
  p.out = (float*)d_out;
  p.ws = (char*)d_ws;
  const size_t off = WSO.total;
  { const int reps[16] = REPS_INIT; for (int i = 0; i < 16; ++i) p.rep[i] = reps[i]; }
  if (off > ws_size) { fprintf(stderr, "workspace too small: need %zu have %zu\n", off, ws_size); return; }
  (void)hipMemsetAsync(p.bar(), 0, (size_t)(XCD_BAR_WORDS + 64) * 4, stream);
  void* args[] = {&p};
  hipError_t e = hipLaunchCooperativeKernel((void*)mk, dim3(grid_blocks), dim3(NTHR), args, LDS_BYTES, stream);
  if (e != hipSuccess) fprintf(stderr, "cooperative launch failed: %s (grid %d)\n", hipGetErrorString(e), grid_blocks);
}
```

```cpp
#include <hip/hip_runtime.h>
#include <hip/hip_cooperative_groups.h>
#include <cstdio>
#include <cstdint>
namespace cg = cooperative_groups;

#define DI __device__ __forceinline__
typedef unsigned short u16;
typedef __attribute__((ext_vector_type(8))) short bf16x8;
typedef __attribute__((ext_vector_type(4))) float f32x4;

#ifndef REPS_INIT
#define REPS_INIT {1, 1, 1, 1, 1, 1, 1, 1, 1, 1, 1, 1, 0, 1, 1, 1}
#endif
constexpr int NTHR = 512;
constexpr int T = 16384, SEQ = 4096, DM = 1024;
constexpr int PW = 3240, PWP = 3328;
constexpr int C_RQ = 0, C_RK = 256, C_RV = 512, C_RG = 768, C_CQ = 1024, C_CKV = 1280, C_KR = 1408,
              C_Z = 1440, C_XBC = 1696, C_DT = 2464, C_DQ = 2472, C_DK = 2728, C_DV = 2984;
constexpr int LDS_BYTES = 131072 + 8192;

struct WsOff {
  size_t WinT;
  size_t WuqT;
  size_t WukvT;
  size_t WoutT;
  size_t Wgu8;
  size_t Wd8;
  size_t hn8;
  size_t xres;
  size_t hn;
  size_t proj;
  size_t cqn;
  size_t ckvn;
  size_t mq;
  size_t xbc;
  size_t mixed;
  size_t hid8;
  size_t kfull;
  size_t rS;
  size_t sS;
  size_t rU;
  size_t sU;
  size_t cdec;
  size_t vT;
  size_t rtab;
  size_t dpart;
  size_t dtv;
  size_t cs;
  size_t ybuf;
  size_t aff;
  size_t gate;
  size_t tok;
  size_t inv;
  size_t bar;
  size_t xres2;
  size_t total;
};
constexpr WsOff ws_layout() {
  WsOff o{};
  size_t off = 0;
  o.WinT = off; off += (((size_t)2 * PWP * DM * 2) + 255) & ~(size_t)255;
  o.WuqT = off; off += (((size_t)2 * 384 * 256 * 2) + 255) & ~(size_t)255;
  o.WukvT = off; off += (((size_t)2 * 512 * 128 * 2) + 255) & ~(size_t)255;
  o.WoutT = off; off += (((size_t)2 * DM * DM * 2) + 255) & ~(size_t)255;
  o.Wgu8 = off; off += (((size_t)2 * 16 * 4096 * DM) + 255) & ~(size_t)255;
  o.Wd8 = off; off += (((size_t)2 * 16 * DM * 2048) + 255) & ~(size_t)255;
  o.hn8 = off; off += (((size_t)T * DM) + 255) & ~(size_t)255;
  o.xres = off; off += (((size_t)T * DM * 2) + 255) & ~(size_t)255;
  o.hn = off; off += (((size_t)T * DM * 2) + 255) & ~(size_t)255;
  o.proj = off; off += (((size_t)T * PWP * 2) + 255) & ~(size_t)255;
  o.cqn = off; off += (((size_t)T * 256 * 2) + 255) & ~(size_t)255;
  o.ckvn = off; off += (((size_t)T * 128 * 2) + 255) & ~(size_t)255;
  o.mq = off; off += (((size_t)T * 384 * 2) + 255) & ~(size_t)255;
  o.xbc = off; off += (((size_t)T * 768 * 2) + 255) & ~(size_t)255;
  o.mixed = off; off += (((size_t)T * DM * 2) + 255) & ~(size_t)255;
  o.hid8 = off; off += (((size_t)32768 * 2048) + 255) & ~(size_t)255;
  o.kfull = off; off += (((size_t)T * 4 * 96 * 2) + 255) & ~(size_t)255;
  o.rS = off; off += (((size_t)16 * 32 * 2 * 4096 * 2) + 255) & ~(size_t)255;
  o.sS = off; off += (((size_t)128 * 8 * 8192 * 2) + 255) & ~(size_t)255;
  o.rU = off; off += (((size_t)16 * 32 * 2 * 4096 * 4) + 255) & ~(size_t)255;
  o.sU = off; off += (((size_t)128 * 8 * 8192 * 4) + 255) & ~(size_t)255;
  o.cdec = off; off += (((size_t)128 * 8 * 4) + 255) & ~(size_t)255;
  o.vT = off; off += (((size_t)T * 4 * 64 * 2) + 255) & ~(size_t)255;
  o.rtab = off; off += (((size_t)SEQ * 56 * 2 * 4) + 255) & ~(size_t)255;
  o.dpart = off; off += (((size_t)T * 4 * 68 * 4) + 255) & ~(size_t)255;
  o.dtv = off; off += (((size_t)T * 8 * 4) + 255) & ~(size_t)255;
  o.cs = off; off += (((size_t)T * 8 * 4) + 255) & ~(size_t)255;
  o.ybuf = off; off += (((size_t)T * 256 * 4) + 255) & ~(size_t)255;
  o.aff = off; off += (((size_t)T * 16 * 4) + 255) & ~(size_t)255;
  o.gate = off; off += (((size_t)64 * 512 * 4) + 255) & ~(size_t)255;
  o.tok = off; off += (((size_t)64 * 512 * 4) + 255) & ~(size_t)255;
  o.inv = off; off += (((size_t)T * 16 * 4) + 255) & ~(size_t)255;
  o.bar = off; off += (((size_t)(3456 + 64) * 4) + 255) & ~(size_t)255;
  o.xres2 = off; off += (((size_t)T * DM * 2) + 255) & ~(size_t)255;
  o.total = off;
  return o;
}
constexpr WsOff WSO = ws_layout();
struct Params {
  const float *x, *ln1_w, *w_in, *q_norm_w, *kv_norm_w, *w_uq, *w_ukv, *conv_w, *conv_b, *a_log, *dt_bias,
      *ssm_d, *ssm_norm_w, *w_out, *ln2_w, *router_w, *w_gate, *w_up, *w_down, *final_w;
  float* out;
  char* ws;
  int rep[16];
  __host__ DI u16* WinT() const { return reinterpret_cast<u16*>(ws + WSO.WinT); }
  __host__ DI u16* WuqT() const { return reinterpret_cast<u16*>(ws + WSO.WuqT); }
  __host__ DI u16* WukvT() const { return reinterpret_cast<u16*>(ws + WSO.WukvT); }
  __host__ DI u16* WoutT() const { return reinterpret_cast<u16*>(ws + WSO.WoutT); }
  __host__ DI unsigned char* Wgu8() const { return reinterpret_cast<unsigned char*>(ws + WSO.Wgu8); }
  __host__ DI unsigned char* Wd8() const { return reinterpret_cast<unsigned char*>(ws + WSO.Wd8); }
  __host__ DI unsigned char* hn8() const { return reinterpret_cast<unsigned char*>(ws + WSO.hn8); }
  __host__ DI u16* xres() const { return reinterpret_cast<u16*>(ws + WSO.xres); }
  __host__ DI u16* hn() const { return reinterpret_cast<u16*>(ws + WSO.hn); }
  __host__ DI u16* proj() const { return reinterpret_cast<u16*>(ws + WSO.proj); }
  __host__ DI u16* cqn() const { return reinterpret_cast<u16*>(ws + WSO.cqn); }
  __host__ DI u16* ckvn() const { return reinterpret_cast<u16*>(ws + WSO.ckvn); }
  __host__ DI u16* mq() const { return reinterpret_cast<u16*>(ws + WSO.mq); }
  __host__ DI u16* xbc() const { return reinterpret_cast<u16*>(ws + WSO.xbc); }
  __host__ DI u16* mixed() const { return reinterpret_cast<u16*>(ws + WSO.mixed); }
  __host__ DI unsigned char* hid8() const { return reinterpret_cast<unsigned char*>(ws + WSO.hid8); }
  __host__ DI u16* kfull() const { return reinterpret_cast<u16*>(ws + WSO.kfull); }
  __host__ DI u16* rS() const { return reinterpret_cast<u16*>(ws + WSO.rS); }
  __host__ DI u16* sS() const { return reinterpret_cast<u16*>(ws + WSO.sS); }
  __host__ DI float* rU() const { return reinterpret_cast<float*>(ws + WSO.rU); }
  __host__ DI float* sU() const { return reinterpret_cast<float*>(ws + WSO.sU); }
  __host__ DI float* cdec() const { return reinterpret_cast<float*>(ws + WSO.cdec); }
  __host__ DI u16* vT() const { return reinterpret_cast<u16*>(ws + WSO.vT); }
  __host__ DI float* rtab() const { return reinterpret_cast<float*>(ws + WSO.rtab); }
  __host__ DI float* dpart() const { return reinterpret_cast<float*>(ws + WSO.dpart); }
  __host__ DI float* dtv() const { return reinterpret_cast<float*>(ws + WSO.dtv); }
  __host__ DI float* cs() const { return reinterpret_cast<float*>(ws + WSO.cs); }
  __host__ DI float* ybuf() const { return reinterpret_cast<float*>(ws + WSO.ybuf); }
  __host__ DI float* aff() const { return reinterpret_cast<float*>(ws + WSO.aff); }
  __host__ DI float* gate() const { return reinterpret_cast<float*>(ws + WSO.gate); }
  __host__ DI int* tok() const { return reinterpret_cast<int*>(ws + WSO.tok); }
  __host__ DI int* inv() const { return reinterpret_cast<int*>(ws + WSO.inv); }
  __host__ DI unsigned* bar() const { return reinterpret_cast<unsigned*>(ws + WSO.bar); }
  __host__ DI u16* xres2() const { return reinterpret_cast<u16*>(ws + WSO.xres2); }
};


typedef __attribute__((ext_vector_type(2))) __bf16 bf16x2_t;
typedef __attribute__((ext_vector_type(2))) float f32x2_t;
typedef __attribute__((ext_vector_type(16))) float f32x16;
typedef __attribute__((ext_vector_type(4))) short s16x4;
typedef __attribute__((ext_vector_type(8))) int i32x8;
typedef __attribute__((ext_vector_type(4))) int i32x4;
DI unsigned pack2(float a, float b) {
  f32x2_t v = {a, b};
  return __builtin_bit_cast(unsigned, __builtin_convertvector(v, bf16x2_t));
}
DI u16 f2bf(float f) { return (u16)(pack2(f, 0.f) & 0xffffu); }
DI float bf2f(u16 h) { return __uint_as_float(((unsigned)h) << 16); }
DI void unpack8(const uint4& v, float* f) {
  f[0] = __uint_as_float(v.x << 16); f[1] = __uint_as_float(v.x & 0xffff0000u);
  f[2] = __uint_as_float(v.y << 16); f[3] = __uint_as_float(v.y & 0xffff0000u);
  f[4] = __uint_as_float(v.z << 16); f[5] = __uint_as_float(v.z & 0xffff0000u);
  f[6] = __uint_as_float(v.w << 16); f[7] = __uint_as_float(v.w & 0xffff0000u);
}
DI void ld8(const u16* p, float* f) { uint4 v = *reinterpret_cast<const uint4*>(p); unpack8(v, f); }
DI unsigned pk4_f8(float a, float b, float c, float d) {
  a = __builtin_amdgcn_fmed3f(a, -448.f, 448.f); b = __builtin_amdgcn_fmed3f(b, -448.f, 448.f);
  c = __builtin_amdgcn_fmed3f(c, -448.f, 448.f); d = __builtin_amdgcn_fmed3f(d, -448.f, 448.f);
  int w = __builtin_amdgcn_cvt_pk_fp8_f32(a, b, 0, false);
  w = __builtin_amdgcn_cvt_pk_fp8_f32(c, d, w, true);
  return (unsigned)w;
}
constexpr float F8_W_SCALE = 256.f, F8_H_SCALE = 16.f, F8_HID_SCALE = 8.f;
DI float4 bf4_to_f4(const uint2& q) {
  return make_float4(__uint_as_float(q.x << 16), __uint_as_float(q.x & 0xffff0000u), __uint_as_float(q.y << 16), __uint_as_float(q.y & 0xffff0000u));
}
DI float wave_sum(float v) {
#pragma unroll
  for (int o = 32; o > 0; o >>= 1) v += __shfl_xor(v, o);
  return v;
}
DI float dot2acc(unsigned a, unsigned b, float c) {
  return __builtin_amdgcn_fdot2_f32_bf16(__builtin_bit_cast(bf16x2_t, a), __builtin_bit_cast(bf16x2_t, b), c, false);
}
DI float dot8(const uint4& a, const uint4& b, float c) {
  c = dot2acc(a.x, b.x, c); c = dot2acc(a.y, b.y, c); c = dot2acc(a.z, b.z, c); c = dot2acc(a.w, b.w, c);
  return c;
}
DI int otid() { int t = threadIdx.x; asm volatile("" : "+v"(t)); return t; }
DI int obid() { int b = blockIdx.x; asm volatile("" : "+s"(b)); return b; }
DI float silu(float x) { return x / (1.f + __expf(-x)); }
DI float fast_silu(float x) { return x * __builtin_amdgcn_rcpf(1.f + __expf(-x)); }


#define XB_TMO      128
#define XB_XCNT(j)  (256  + 64 * (j))
#define XB_XSUB(j)  (1280 + 64 * (j))
#define XB_XGEN(j)  (2304 + 64 * (j))
#define XB_TOP      3328
#define XB_TOPGEN   3392
#define XCD_BAR_WORDS 3456
#define XB_SPIN_CAP (1u << 20)
#define LAS __attribute__((address_space(3)))
DI unsigned xb_ld(unsigned* p) { return __hip_atomic_load(p, __ATOMIC_RELAXED, __HIP_MEMORY_SCOPE_AGENT); }
DI unsigned xb_add(unsigned* p, unsigned v) { return __hip_atomic_fetch_add(p, v, __ATOMIC_RELAXED, __HIP_MEMORY_SCOPE_AGENT); }
DI unsigned xb_xcc_id() { return (unsigned)__builtin_amdgcn_s_getreg((3 << 11) | 20) & 0xFu; }
#define XB_SPIN(cond, bar) do { unsigned _sp = 0; while (cond) { __builtin_amdgcn_s_sleep(1); \
    if ((++_sp & 255u) == 0u) { if (xb_ld(&(bar)[XB_TMO])) break; if (_sp > XB_SPIN_CAP) { atomicAdd(&(bar)[XB_TMO], 1u); break; } } } } while (0)
struct XcdBarrier { unsigned* bar; unsigned x; volatile LAS unsigned* st; };
DI XcdBarrier xcd_barrier_post(unsigned* bar, volatile LAS unsigned* st) {
  XcdBarrier b; b.bar = bar; b.x = xb_xcc_id(); b.st = st;
  if (threadIdx.x == 0) (void)xb_add(&bar[XB_XCNT(b.x)], 1u);
  return b;
}
DI void xcd_barrier_complete(unsigned* bar, unsigned x, unsigned& nloc, unsigned& nx) {
  const unsigned G = gridDim.x * gridDim.y * gridDim.z;
  unsigned sum, cnt, mine, sp = 0u;
  for (;;) {
    sum = 0u; cnt = 0u; mine = 0u;
#pragma unroll
    for (unsigned j = 0; j < 16; ++j) { const unsigned c = xb_ld(&bar[XB_XCNT(j)]); sum += c; cnt += (c > 0u) ? 1u : 0u; mine = (j == x) ? c : mine; }
    if (sum == G) break;
    __builtin_amdgcn_s_sleep(1);
    if ((++sp & 255u) == 0u) { if (xb_ld(&bar[XB_TMO])) break; if (sp > XB_SPIN_CAP) { atomicAdd(&bar[XB_TMO], 1u); break; } }
  }
  nloc = mine > 0u ? mine : 1u; nx = cnt > 0u ? cnt : 1u;
}
DI void xcd_barrier(const XcdBarrier& b) {
  asm volatile("s_waitcnt vmcnt(0)" ::: "memory");
  __syncthreads();
  if (threadIdx.x == 0) {
    unsigned* bar = b.bar;
    __builtin_amdgcn_s_waitcnt(0);
    unsigned nloc = b.st[0], nx = b.st[1];
    if (nloc == 0u) { xcd_barrier_complete(bar, b.x, nloc, nx); b.st[0] = nloc; b.st[1] = nx; }
    const unsigned old = xb_add(&bar[XB_XSUB(b.x)], 1u);
    const unsigned gen = old / nloc;
    if (old + 1u == (gen + 1u) * nloc) {
      __builtin_amdgcn_fence(__ATOMIC_RELEASE, "agent");
      asm volatile("s_waitcnt vmcnt(0)" ::: "memory");
      const unsigned og = xb_add(&bar[XB_TOP], 1u);
      const unsigned tg = og / nx;
      if (og + 1u == (tg + 1u) * nx) xb_add(&bar[XB_TOPGEN], 1u);
      else XB_SPIN(xb_ld(&bar[XB_TOPGEN]) == tg, bar);
      __builtin_amdgcn_fence(__ATOMIC_ACQUIRE, "agent");
      xb_add(&bar[XB_XGEN(b.x)], 1u);
      asm volatile("s_waitcnt vmcnt(0)" ::: "memory");
    } else {
      XB_SPIN(xb_ld(&bar[XB_XGEN(b.x)]) == gen, bar);
      __builtin_amdgcn_fence(__ATOMIC_ACQUIRE, "agent");
      asm volatile("s_waitcnt vmcnt(0)" ::: "memory");
    }
  }
  __syncthreads();
}

template <class F>
DI void transpose_convert(const float* __restrict__ src, int K, int N, int Npad, u16* __restrict__ dst, F rowmap,
                          int bid, int nb, char* smem) {
  u16* tile = reinterpret_cast<u16*>(smem);
  const int tid = otid();
  const int ntn = Npad / 128, ntk = K / 64;
  for (int t = bid; t < ntn * ntk; t += nb) {
    const int n0 = (t % ntn) * 128, k0 = (t / ntn) * 64;
    f32x4 v[4];
#pragma unroll
    for (int i = 0; i < 4; ++i) {
      const int kk = (tid >> 5) + 16 * i, nn = (tid & 31) * 4;
      v[i] = f32x4{0.f, 0.f, 0.f, 0.f};
      if (n0 + nn < N) v[i] = __builtin_nontemporal_load(reinterpret_cast<const f32x4*>(src + (size_t)(k0 + kk) * N + n0 + nn));
    }
#pragma unroll
    for (int i = 0; i < 4; ++i) {
      const int kk = (tid >> 5) + 16 * i, nn = (tid & 31) * 4;
      tile[(nn + 0) * 72 + kk] = f2bf(v[i][0]); tile[(nn + 1) * 72 + kk] = f2bf(v[i][1]);
      tile[(nn + 2) * 72 + kk] = f2bf(v[i][2]); tile[(nn + 3) * 72 + kk] = f2bf(v[i][3]);
    }
    __syncthreads();
#pragma unroll
    for (int j = 0; j < 2; ++j) {
      const int c = tid + NTHR * j, nn = c >> 3, k8 = (c & 7) * 8;
      const uint4 o = *reinterpret_cast<const uint4*>(tile + nn * 72 + k8);
      *reinterpret_cast<uint4*>(dst + (size_t)rowmap(n0 + nn) * K + k0 + k8) = o;
    }
    __syncthreads();
  }
}

template <class F>
DI void transpose_convert_f8(const float* __restrict__ src, int K, int N, unsigned char* __restrict__ dst, F rowmap,
                             int bid, int nb, char* smem) {
  unsigned char* tile = reinterpret_cast<unsigned char*>(smem);
  const int tid = otid();
  const int ntn = N / 128, ntk = K / 64;
  for (int t = bid; t < ntn * ntk; t += nb) {
    const int n0 = (t % ntn) * 128, k0 = (t / ntn) * 64;
    const int kq = (tid >> 5) * 4, nn = (tid & 31) * 4;
    f32x4 v[4];
#pragma unroll
    for (int r = 0; r < 4; ++r) v[r] = __builtin_nontemporal_load(reinterpret_cast<const f32x4*>(src + (size_t)(k0 + kq + r) * N + n0 + nn));
#pragma unroll
    for (int e = 0; e < 4; ++e)
      *reinterpret_cast<unsigned*>(tile + (nn + e) * 80 + kq) =
          pk4_f8(v[0][e] * F8_W_SCALE, v[1][e] * F8_W_SCALE, v[2][e] * F8_W_SCALE, v[3][e] * F8_W_SCALE);
    __syncthreads();
    {
      const int rn = tid >> 2, kc = (tid & 3) * 16;
      const uint4 o = *reinterpret_cast<const uint4*>(tile + rn * 80 + kc);
      *reinterpret_cast<uint4*>(dst + (size_t)rowmap(n0 + rn) * K + k0 + kc) = o;
    }
    __syncthreads();
  }
}

constexpr int CVT_IN_MLA_E = 10;
struct CvtTile { const float* src; unsigned char* dst; int N, K, n0, k0, mat; };
DI CvtTile cvt_tile(const Params& p, int L, int g) {
  const int e = g / 768, r = g - e * 768, mat = r >> 8, tt = r & 255;
  const size_t le = (size_t)(L * 16 + e);
  CvtTile c;
  c.mat = mat;
  if (mat < 2) { c.src = ((mat == 0) ? p.w_gate : p.w_up) + le * DM * 2048; c.N = 2048; c.dst = p.Wgu8() + le * 4096 * DM; c.K = 1024; c.n0 = (tt & 15) * 128; c.k0 = (tt >> 4) * 64; }
  else { c.src = p.w_down + le * 2048 * DM; c.N = 1024; c.dst = p.Wd8() + le * DM * 2048; c.K = 2048; c.n0 = (tt & 7) * 128; c.k0 = (tt >> 3) * 64; }
  return c;
}
DI int cvt_rowmap(int mat, int n) { return (mat == 2) ? n : ((n >> 7) * 256 + (mat == 1 ? 128 : 0) + (n & 127)); }

DI void ph_convert(const Params& p, char* smem) {
  const int nb = gridDim.x;
  int bid = obid();
  for (int idx = bid * NTHR + otid(); idx < SEQ * 56; idx += nb * NTHR) {
    const int pos = idx / 56, f = idx - pos * 56;
    float inv;
    if (f < 32) inv = exp2f(-(float)f * (13.287712379549449f / 32.f));
    else if (f < 40) inv = exp2f(-(float)(f - 32) * (18.931568569324174f / 8.f));
    else inv = exp2f(-(float)(f - 40) * (18.931568569324174f / 16.f));
    float sn, cs;
    sincosf((float)pos * inv, &sn, &cs);
    p.rtab()[(size_t)idx * 2] = cs;
    p.rtab()[(size_t)idx * 2 + 1] = sn;
  }
  auto ident = [](int n) { return n; };
  for (int L = 0; L < 2; ++L) {
    transpose_convert(p.w_in + (size_t)L * DM * PW, DM, PW, PWP, p.WinT() + (size_t)L * PWP * DM, ident, bid, nb, smem);
    transpose_convert(p.w_uq + (size_t)L * 256 * 384, 256, 384, 384, p.WuqT() + (size_t)L * 384 * 256, ident, bid, nb, smem);
    transpose_convert(p.w_ukv + (size_t)L * 128 * 512, 128, 512, 512, p.WukvT() + (size_t)L * 512 * 128, ident, bid, nb, smem);
    transpose_convert(p.w_out + (size_t)L * DM * DM, DM, DM, DM, p.WoutT() + (size_t)L * DM * DM, ident, bid, nb, smem);
    for (int e = ((nb == 256) ? CVT_IN_MLA_E : 0); e < 16; ++e) {
      const size_t le = (size_t)(L * 16 + e);
      auto gmap = [](int n) { return (n >> 7) * 256 + (n & 127); };
      auto umap = [](int n) { return (n >> 7) * 256 + 128 + (n & 127); };
      transpose_convert_f8(p.w_gate + le * DM * 2048, DM, 2048, p.Wgu8() + le * 4096 * DM, gmap, bid, nb, smem);
      transpose_convert_f8(p.w_up + le * DM * 2048, DM, 2048, p.Wgu8() + le * 4096 * DM, umap, bid, nb, smem);
      transpose_convert_f8(p.w_down + le * 2048 * DM, 2048, DM, p.Wd8() + le * DM * 2048, ident, bid, nb, smem);
    }
  }
}

template <class RowPtr, class Epi>
DI void gemm_tile(RowPtr arow, const u16* __restrict__ bt, int ldb, int K, char* smem, Epi epi) {
  u16* sa = reinterpret_cast<u16*>(smem);
  u16* sb = sa + 2 * 256 * 72;
  const int tid = otid(), wid = tid >> 6, lane = tid & 63, wr = wid >> 1, wc = wid & 1, fr = lane & 15, fq = lane >> 4;
  f32x4 acc[4][4];
#pragma unroll
  for (int m = 0; m < 4; ++m)
#pragma unroll
    for (int n = 0; n < 4; ++n) acc[m][n] = f32x4{0.f, 0.f, 0.f, 0.f};
  const int lr = tid >> 3, lc = (tid & 7) * 8;
  const u16* ap[4];
#pragma unroll
  for (int i = 0; i < 4; ++i) ap[i] = arow(lr + 64 * i) + lc;
  const u16* bp[2];
#pragma unroll
  for (int i = 0; i < 2; ++i) bp[i] = bt + (size_t)(lr + 64 * i) * ldb + lc;
  uint4 ra[4], rb[2];
  const int nk = K / 64;
#pragma unroll
  for (int i = 0; i < 4; ++i) ra[i] = *reinterpret_cast<const uint4*>(ap[i]);
#pragma unroll
  for (int i = 0; i < 2; ++i) rb[i] = *reinterpret_cast<const uint4*>(bp[i]);
#pragma unroll
  for (int i = 0; i < 4; ++i) *reinterpret_cast<uint4*>(sa + (lr + 64 * i) * 72 + lc) = ra[i];
#pragma unroll
  for (int i = 0; i < 2; ++i) *reinterpret_cast<uint4*>(sb + (lr + 64 * i) * 72 + lc) = rb[i];
  __syncthreads();
  for (int kt = 0; kt < nk; ++kt) {
    const int cur = kt & 1;
    if (kt + 1 < nk) {
#pragma unroll
      for (int i = 0; i < 4; ++i) ra[i] = *reinterpret_cast<const uint4*>(ap[i] + (kt + 1) * 64);
#pragma unroll
      for (int i = 0; i < 2; ++i) rb[i] = *reinterpret_cast<const uint4*>(bp[i] + (kt + 1) * 64);
    }
    const u16* ca = sa + cur * 256 * 72;
    const u16* cb = sb + cur * 128 * 72;
#pragma unroll
    for (int kk = 0; kk < 2; ++kk) {
      bf16x8 af[4], bfr[4];
#pragma unroll
      for (int m = 0; m < 4; ++m) af[m] = *reinterpret_cast<const bf16x8*>(ca + (wr * 64 + m * 16 + fr) * 72 + kk * 32 + fq * 8);
#pragma unroll
      for (int n = 0; n < 4; ++n) bfr[n] = *reinterpret_cast<const bf16x8*>(cb + (wc * 64 + n * 16 + fr) * 72 + kk * 32 + fq * 8);
#pragma unroll
      for (int m = 0; m < 4; ++m)
#pragma unroll
        for (int n = 0; n < 4; ++n) acc[m][n] = __builtin_amdgcn_mfma_f32_16x16x32_bf16(af[m], bfr[n], acc[m][n], 0, 0, 0);
    }
    if (kt + 1 < nk) {
      u16* na = sa + (cur ^ 1) * 256 * 72;
      u16* nbp = sb + (cur ^ 1) * 128 * 72;
#pragma unroll
      for (int i = 0; i < 4; ++i) *reinterpret_cast<uint4*>(na + (lr + 64 * i) * 72 + lc) = ra[i];
#pragma unroll
      for (int i = 0; i < 2; ++i) *reinterpret_cast<uint4*>(nbp + (lr + 64 * i) * 72 + lc) = rb[i];
    }
    __syncthreads();
  }
  epi(acc, wr, wc, fr, fq);
}

#define WAIT_V(n) asm volatile("s_waitcnt vmcnt(%0)" ::"n"(n) : "memory")
DI int lds_byte2(int r, int c) {
  const int st = (r >> 4) * 2 + (c >> 5), ob = (r & 15) * 64 + (c & 31) * 2;
  return st * 1024 + (ob ^ (((ob >> 9) & 1) << 5));
}
DI void stage_rc2(int b, int& R, int& C) {
  const int st = b >> 10, sb = b & 1023, swz = sb ^ (((sb >> 9) & 1) << 5);
  R = (st >> 1) * 16 + swz / 64;
  C = (st & 1) * 32 + (swz % 64) / 2;
}
typedef __attribute__((address_space(3))) unsigned lds_u32;
template <class RowPtr, class Epi>
DI void gemm256(RowPtr arow, const u16* __restrict__ bt, int ldb, int K, char* smem, Epi epi) {
  constexpr int TILE_B = 256 * 64 * 2, STAGE_B = 2 * TILE_B;
  const int tid = otid(), wid = tid >> 6, lane = tid & 63, wr = wid >> 2, wc = wid & 3, fr = lane & 15, fq = lane >> 4;
  const u16* ap[4];
  const u16* bp[4];
#pragma unroll
  for (int i = 0; i < 4; ++i) {
    int R, C;
    stage_rc2(wid * 1024 + i * 8192 + lane * 16, R, C);
    ap[i] = arow(R) + C;
    bp[i] = bt + (size_t)R * ldb + C;
  }
  f32x4 acc[8][4];
#pragma unroll
  for (int m = 0; m < 8; ++m)
#pragma unroll
    for (int n = 0; n < 4; ++n) acc[m][n] = f32x4{0.f, 0.f, 0.f, 0.f};
#define G2_STAGE(buf, kt)                                                                                              \
  do {                                                                                                                 \
    _Pragma("unroll") for (int i = 0; i < 4; ++i) {                                                                    \
      __builtin_amdgcn_global_load_lds((const unsigned*)(ap[i] + (kt) * 64),                                           \
                                       (lds_u32*)(smem + (buf) * STAGE_B + wid * 1024 + i * 8192), 16, 0, 0);          \
      __builtin_amdgcn_global_load_lds((const unsigned*)(bp[i] + (kt) * 64),                                           \
                                       (lds_u32*)(smem + (buf) * STAGE_B + TILE_B + wid * 1024 + i * 8192), 16, 0, 0); \
    }                                                                                                                  \
  } while (0)
  const int nt = K / 64;
  G2_STAGE(0, 0);
  WAIT_V(0);
  __syncthreads();
  for (int t = 0; t < nt; ++t) {
    const int cur = t & 1;
    if (t + 1 < nt) G2_STAGE(cur ^ 1, t + 1);
    const char* sA = smem + cur * STAGE_B;
    const char* sB = sA + TILE_B;
#pragma unroll
    for (int ks = 0; ks < 2; ++ks) {
      bf16x8 At[8], Bf[4];
#pragma unroll
      for (int m = 0; m < 8; ++m) At[m] = *reinterpret_cast<const bf16x8*>(sA + lds_byte2(wr * 128 + m * 16 + fr, ks * 32 + fq * 8));
#pragma unroll
      for (int n = 0; n < 4; ++n) Bf[n] = *reinterpret_cast<const bf16x8*>(sB + lds_byte2(wc * 64 + n * 16 + fr, ks * 32 + fq * 8));
#pragma unroll
      for (int m = 0; m < 8; ++m)
#pragma unroll
        for (int n = 0; n < 4; ++n) acc[m][n] = __builtin_amdgcn_mfma_f32_16x16x32_bf16(Bf[n], At[m], acc[m][n], 0, 0, 0);
      __builtin_amdgcn_sched_barrier(0);
    }
    WAIT_V(0);
    __syncthreads();
  }
  epi(acc, wr, wc, fr, fq);
}

namespace pg8 {
constexpr int BM = 256, BK = 64, HALF = 128, HTB = HALF * BK * 2;
DI int lds_byte(int r, int c) { const int st = (r >> 4) * 2 + (c >> 5), rr = r & 15, cc = c & 31, ob = rr * 64 + cc * 2; return st * 1024 + (ob ^ (((ob >> 9) & 1) << 5)); }
DI void stage_rc(int b, int& R, int& C) { const int st = b / 1024, sb = b % 1024, swz = sb ^ (((sb >> 9) & 1) << 5); R = (st >> 1) * 16 + swz / 64; C = (st & 1) * 32 + (swz % 64) / 2; }
DI int perm32(int rho) { const int n = rho >> 4, i = rho & 15; return 8 * (i >> 2) + 4 * n + (i & 3); }
struct Unit { int pm, pn; };
typedef __attribute__((address_space(3))) unsigned char lds_u8;
typedef __attribute__((address_space(3))) unsigned lds_u32;
typedef __attribute__((address_space(3))) bf16x8 lds_bf16x8;
typedef __attribute__((address_space(3))) i32x4 lds_i32x4;

template <class Cfg>
DI void gemm_phase(lds_u8* lds, const Cfg& S) {
  const int tid = otid(), wid = __builtin_amdgcn_readfirstlane(tid >> 6), lane = tid & 63, wr = wid >> 2, wc = wid & 3, fr = lane & 15, fq = lane >> 4;
  const int K = S.K, nt = K / BK;
  int R0, C0, R1, C1;
  stage_rc(tid * 16, R0, C0);
  stage_rc(tid * 16 + 8192, R1, C1);
  unsigned voffB[2];
  {
    const int Rb0 = Cfg::PERM ? ((R0 & ~31) + perm32(R0 & 31)) : R0, Rb1 = Cfg::PERM ? ((R1 & ~31) + perm32(R1 & 31)) : R1;
    voffB[0] = (unsigned)(Rb0 * K + C0) * 2u; voffB[1] = (unsigned)(Rb1 * K + C1) * 2u;
  }
  const size_t kstep = (size_t)(BK * 2);
  const size_t hstep = (size_t)HALF * K * 2;
  const unsigned ldsw = (unsigned)wid * 1024u;
  const int aoff = lds_byte(wr * 64 + fr, fq * 8), boff = lds_byte(wc * 32 + fr, fq * 8);
#define PG8_SA(b, h) (((b) * 2 + (h)) * HTB)
#define PG8_SB(b, h) ((4 + (b) * 2 + (h)) * HTB)
#define PG8_STAGE2(bufoff, gbase, o0, o1) do { \
    __builtin_amdgcn_global_load_lds((const unsigned*)((const char*)(gbase) + (o0)), (lds_u32*)(lds + (bufoff) + ldsw), 16, 0, 0); \
    __builtin_amdgcn_global_load_lds((const unsigned*)((const char*)(gbase) + (o1)), (lds_u32*)(lds + (bufoff) + ldsw + 8192), 16, 0, 0); } while (0)
#define PG8_STAGEB(bufoff, gbase) PG8_STAGE2(bufoff, gbase, voffB[0], voffB[1])
#define PG8_LDA(dst, b, h) do { _Pragma("unroll") for (int m = 0; m < 4; ++m) _Pragma("unroll") for (int k = 0; k < 2; ++k) dst[m][k] = *(const lds_bf16x8*)(lds + PG8_SA(b, h) + aoff + m * 2048 + k * 1024); } while (0)
#define PG8_LDB(dst, b, h) do { _Pragma("unroll") for (int n = 0; n < 2; ++n) _Pragma("unroll") for (int k = 0; k < 2; ++k) dst[n][k] = *(const lds_bf16x8*)(lds + PG8_SB(b, h) + boff + n * 2048 + k * 1024); } while (0)
#define PG8_MMA(ai, bj, At, Bt) do { __builtin_amdgcn_s_setprio(1); _Pragma("unroll") for (int m = 0; m < 4; ++m) _Pragma("unroll") for (int n = 0; n < 2; ++n) _Pragma("unroll") for (int k = 0; k < 2; ++k) \
    acc[ai][bj][m][n] = __builtin_amdgcn_mfma_f32_16x16x32_bf16(Bt[n][k], At[m][k], acc[ai][bj][m][n], 0, 0, 0); __builtin_amdgcn_s_setprio(0); } while (0)
#define PG8_WAIT_V(n) asm volatile("s_waitcnt vmcnt(" #n ")" ::: "memory")
#define PG8_WAIT_L(n) asm volatile("s_waitcnt lgkmcnt(" #n ")" ::: "memory")
#define PG8_BAR __builtin_amdgcn_s_barrier()
#define PG8_SCHED __builtin_amdgcn_sched_barrier(0)
  Unit cur, nxt; int ui = 0;
  if (!S.next(0, cur)) return;
  f32x4 acc[2][2][4][2];
#pragma unroll
  for (int a = 0; a < 2; ++a)
#pragma unroll
    for (int b = 0; b < 2; ++b)
#pragma unroll
      for (int m = 0; m < 4; ++m)
#pragma unroll
        for (int n = 0; n < 2; ++n) acc[a][b][m][n] = f32x4{0.f, 0.f, 0.f, 0.f};
  bf16x8 At[4][2], B0[2][2], B1[2][2];
  const char* cA = S.a_base(cur);
  const char* cB = S.b_base(cur);
  unsigned vc[4], vn[4];
  S.a_off(cur, R0, C0, R1, C1, vc);
  PG8_STAGEB(PG8_SB(0, 0), cB); PG8_STAGE2(PG8_SA(0, 0), cA, vc[0], vc[1]); PG8_STAGEB(PG8_SB(0, 1), cB + hstep); PG8_STAGE2(PG8_SA(0, 1), cA, vc[2], vc[3]);
  if (wr == 1) PG8_BAR;
  PG8_WAIT_V(4); PG8_BAR;
  PG8_STAGEB(PG8_SB(1, 0), cB + kstep); PG8_STAGE2(PG8_SA(1, 0), cA + kstep, vc[0], vc[1]); PG8_STAGEB(PG8_SB(1, 1), cB + hstep + kstep);
  PG8_WAIT_V(6); PG8_BAR;
  for (;;) {
    const bool has_next = S.next(ui + 1, nxt);
    const char* nA = has_next ? S.a_base(nxt) : cA;
    const char* nB = has_next ? S.b_base(nxt) : cB;
    if (has_next) S.a_off(nxt, R0, C0, R1, C1, vn);
    else { vn[0] = vc[0]; vn[1] = vc[1]; vn[2] = vc[2]; vn[3] = vc[3]; }
    for (int t = 0; t < nt; t += 2) {
      const bool last = (t == nt - 2);
      const char* a1 = cA + (size_t)(t + 1) * kstep;
      const char* a2 = last ? nA : cA + (size_t)(t + 2) * kstep;
      const char* b2 = last ? nB : cB + (size_t)(t + 2) * kstep;
      const char* a3 = a2 + kstep;
      const char* b3 = b2 + kstep;
      const unsigned w0 = last ? vn[0] : vc[0], w1 = last ? vn[1] : vc[1], w2 = last ? vn[2] : vc[2], w3 = last ? vn[3] : vc[3];
      PG8_LDB(B0, 0, 0); PG8_SCHED; PG8_LDA(At, 0, 0); PG8_STAGE2(PG8_SA(1, 1), a1, vc[2], vc[3]);
      PG8_WAIT_L(8); PG8_BAR; PG8_WAIT_L(0); PG8_MMA(0, 0, At, B0); PG8_BAR; PG8_SCHED;
      PG8_LDB(B1, 0, 1); PG8_STAGEB(PG8_SB(0, 0), b2);
      PG8_BAR; PG8_WAIT_L(0); PG8_MMA(0, 1, At, B1); PG8_BAR;
      PG8_LDA(At, 0, 1); PG8_STAGE2(PG8_SA(0, 0), a2, w0, w1);
      PG8_BAR; PG8_WAIT_L(0); PG8_MMA(1, 0, At, B0); PG8_BAR; PG8_SCHED;
      PG8_STAGEB(PG8_SB(0, 1), b2 + hstep);
      PG8_WAIT_V(6); PG8_BAR; PG8_MMA(1, 1, At, B1); PG8_BAR;
      PG8_LDB(B0, 1, 0); PG8_SCHED; PG8_LDA(At, 1, 0); PG8_STAGE2(PG8_SA(0, 1), a2, w2, w3);
      PG8_WAIT_L(8); PG8_BAR; PG8_WAIT_L(0); PG8_MMA(0, 0, At, B0); PG8_BAR; PG8_SCHED;
      PG8_LDB(B1, 1, 1); PG8_STAGEB(PG8_SB(1, 0), b3);
      PG8_BAR; PG8_WAIT_L(0); PG8_MMA(0, 1, At, B1); PG8_BAR;
      PG8_LDA(At, 1, 1); PG8_STAGE2(PG8_SA(1, 0), a3, w0, w1);
      PG8_BAR; PG8_WAIT_L(0); PG8_MMA(1, 0, At, B0); PG8_BAR; PG8_SCHED;
      PG8_STAGEB(PG8_SB(1, 1), b3 + hstep);
      PG8_WAIT_V(6); PG8_BAR; PG8_MMA(1, 1, At, B1); PG8_BAR;
    }
    S.epi(acc, cur, wr, wc, fr, fq);
    if (!has_next) break;
#pragma unroll
    for (int a = 0; a < 2; ++a)
#pragma unroll
      for (int b = 0; b < 2; ++b)
#pragma unroll
        for (int m = 0; m < 4; ++m)
#pragma unroll
          for (int n = 0; n < 2; ++n) acc[a][b][m][n] = f32x4{0.f, 0.f, 0.f, 0.f};
    cur = nxt; cA = nA; cB = nB; ++ui;
    vc[0] = vn[0]; vc[1] = vn[1]; vc[2] = vn[2]; vc[3] = vn[3];
  }
  PG8_WAIT_V(0);
  if (wr == 0) PG8_BAR;
  PG8_BAR;
#undef PG8_SA
#undef PG8_SB
#undef PG8_STAGE2
#undef PG8_STAGEB
#undef PG8_LDA
#undef PG8_LDB
#undef PG8_MMA
#undef PG8_WAIT_V
#undef PG8_WAIT_L
#undef PG8_BAR
#undef PG8_SCHED
}
template <class Cfg>
DI void gemm_phase_f8(lds_u8* lds, const Cfg& S) {
  const int tid = otid(), wid = __builtin_amdgcn_readfirstlane(tid >> 6), lane = tid & 63, wr = wid >> 2, wc = wid & 3, fr = lane & 15, fq = lane >> 4;
  const int K = S.K, nt = K / BK;
  int R0, C0, R1, C1;
  stage_rc(tid * 16, R0, C0);
  stage_rc(tid * 16 + 8192, R1, C1);
  unsigned voffB[2];
  {
    const int Rb0 = Cfg::PERM ? ((R0 & ~31) + perm32(R0 & 31)) : R0, Rb1 = Cfg::PERM ? ((R1 & ~31) + perm32(R1 & 31)) : R1;
    voffB[0] = (unsigned)(Rb0 * K + C0) * 2u; voffB[1] = (unsigned)(Rb1 * K + C1) * 2u;
  }
  const size_t kstep = (size_t)(BK * 2);
  const size_t hstep = (size_t)HALF * K * 2;
  const unsigned ldsw = (unsigned)wid * 1024u;
  const int cl = 2 * fq + (fq & 1), ch = 2 * fq + 1 - (fq & 1);
  const int aoffL = lds_byte(wr * 64 + fr, cl * 8), aoffH = lds_byte(wr * 64 + fr, ch * 8);
  const int boffL = lds_byte(wc * 32 + fr, cl * 8), boffH = lds_byte(wc * 32 + fr, ch * 8);
#define PG8_SA(b, h) (((b) * 2 + (h)) * HTB)
#define PG8_SB(b, h) ((4 + (b) * 2 + (h)) * HTB)
#define PG8_STAGE2(bufoff, gbase, o0, o1) do { \
    __builtin_amdgcn_global_load_lds((const unsigned*)((const char*)(gbase) + (o0)), (lds_u32*)(lds + (bufoff) + ldsw), 16, 0, 0); \
    __builtin_amdgcn_global_load_lds((const unsigned*)((const char*)(gbase) + (o1)), (lds_u32*)(lds + (bufoff) + ldsw + 8192), 16, 0, 0); } while (0)
#define PG8_STAGEB(bufoff, gbase) PG8_STAGE2(bufoff, gbase, voffB[0], voffB[1])
#define PG8_LDA(dst, b, h) do { _Pragma("unroll") for (int m = 0; m < 4; ++m) { const i32x4 lo_ = *(const lds_i32x4*)(lds + PG8_SA(b, h) + aoffL + m * 2048), hi_ = *(const lds_i32x4*)(lds + PG8_SA(b, h) + aoffH + m * 2048); dst[m] = __builtin_shufflevector(lo_, hi_, 0, 1, 2, 3, 4, 5, 6, 7); } } while (0)
#define PG8_LDB(dst, b, h) do { _Pragma("unroll") for (int n = 0; n < 2; ++n) { const i32x4 lo_ = *(const lds_i32x4*)(lds + PG8_SB(b, h) + boffL + n * 2048), hi_ = *(const lds_i32x4*)(lds + PG8_SB(b, h) + boffH + n * 2048); dst[n] = __builtin_shufflevector(lo_, hi_, 0, 1, 2, 3, 4, 5, 6, 7); } } while (0)
#define PG8_MMA(ai, bj, At, Bt) do { __builtin_amdgcn_s_setprio(1); _Pragma("unroll") for (int m = 0; m < 4; ++m) _Pragma("unroll") for (int n = 0; n < 2; ++n) \
    asm volatile("v_mfma_f32_16x16x128_f8f6f4 %0, %1, %2, %0" : "+v"(acc[ai][bj][m][n]) : "v"(Bt[n]), "v"(At[m])); __builtin_amdgcn_s_setprio(0); } while (0)
#define PG8_WAIT_V(n) asm volatile("s_waitcnt vmcnt(" #n ")" ::: "memory")
#define PG8_WAIT_L(n) asm volatile("s_waitcnt lgkmcnt(" #n ")" ::: "memory")
#define PG8_BAR __builtin_amdgcn_s_barrier()
#define PG8_SCHED __builtin_amdgcn_sched_barrier(0)
  Unit cur, nxt; int ui = 0;
  if (!S.next(0, cur)) return;
  f32x4 acc[2][2][4][2];
#pragma unroll
  for (int a = 0; a < 2; ++a)
#pragma unroll
    for (int b = 0; b < 2; ++b)
#pragma unroll
      for (int m = 0; m < 4; ++m)
#pragma unroll
        for (int n = 0; n < 2; ++n) acc[a][b][m][n] = f32x4{0.f, 0.f, 0.f, 0.f};
  i32x8 At[4], B0[2], B1[2];
  const char* cA = S.a_base(cur);
  const char* cB = S.b_base(cur);
  unsigned vc[4], vn[4];
  S.a_off(cur, R0, C0, R1, C1, vc, 0);
  PG8_STAGEB(PG8_SB(0, 0), cB); PG8_STAGE2(PG8_SA(0, 0), cA, vc[0], vc[1]); PG8_STAGEB(PG8_SB(0, 1), cB + hstep); PG8_STAGE2(PG8_SA(0, 1), cA, vc[2], vc[3]);
  if (wr == 1) PG8_BAR;
  PG8_WAIT_V(4); PG8_BAR;
  PG8_STAGEB(PG8_SB(1, 0), cB + kstep); PG8_STAGE2(PG8_SA(1, 0), cA + kstep, vc[0], vc[1]); PG8_STAGEB(PG8_SB(1, 1), cB + hstep + kstep);
  PG8_WAIT_V(6); PG8_BAR;
  for (;;) {
    const bool has_next = S.next(ui + 1, nxt);
    const char* nA = has_next ? S.a_base(nxt) : cA;
    const char* nB = has_next ? S.b_base(nxt) : cB;
    if (has_next) S.a_off(nxt, R0, C0, R1, C1, vn, ui + 1);
    else { vn[0] = vc[0]; vn[1] = vc[1]; vn[2] = vc[2]; vn[3] = vc[3]; }
    for (int t = 0; t < nt; t += 2) {
      const bool last = (t == nt - 2);
      const char* a1 = cA + (size_t)(t + 1) * kstep;
      const char* a2 = last ? nA : cA + (size_t)(t + 2) * kstep;
      const char* b2 = last ? nB : cB + (size_t)(t + 2) * kstep;
      const char* a3 = a2 + kstep;
      const char* b3 = b2 + kstep;
      const unsigned w0 = last ? vn[0] : vc[0], w1 = last ? vn[1] : vc[1], w2 = last ? vn[2] : vc[2], w3 = last ? vn[3] : vc[3];
      PG8_LDB(B0, 0, 0); PG8_SCHED; PG8_LDA(At, 0, 0); PG8_STAGE2(PG8_SA(1, 1), a1, vc[2], vc[3]);
      PG8_WAIT_L(8); PG8_BAR; PG8_WAIT_L(0); PG8_MMA(0, 0, At, B0); PG8_BAR; PG8_SCHED;
      PG8_LDB(B1, 0, 1); PG8_STAGEB(PG8_SB(0, 0), b2);
      PG8_BAR; PG8_WAIT_L(0); PG8_MMA(0, 1, At, B1); PG8_BAR;
      PG8_LDA(At, 0, 1); PG8_STAGE2(PG8_SA(0, 0), a2, w0, w1);
      PG8_BAR; PG8_WAIT_L(0); PG8_MMA(1, 0, At, B0); PG8_BAR; PG8_SCHED;
      PG8_STAGEB(PG8_SB(0, 1), b2 + hstep);
      PG8_WAIT_V(6); PG8_BAR; PG8_MMA(1, 1, At, B1); PG8_BAR;
      PG8_LDB(B0, 1, 0); PG8_SCHED; PG8_LDA(At, 1, 0); PG8_STAGE2(PG8_SA(0, 1), a2, w2, w3);
      PG8_WAIT_L(8); PG8_BAR; PG8_WAIT_L(0); PG8_MMA(0, 0, At, B0); PG8_BAR; PG8_SCHED;
      PG8_LDB(B1, 1, 1); PG8_STAGEB(PG8_SB(1, 0), b3);
      PG8_BAR; PG8_WAIT_L(0); PG8_MMA(0, 1, At, B1); PG8_BAR;
      PG8_LDA(At, 1, 1); PG8_STAGE2(PG8_SA(1, 0), a3, w0, w1);
      PG8_BAR; PG8_WAIT_L(0); PG8_MMA(1, 0, At, B0); PG8_BAR; PG8_SCHED;
      PG8_STAGEB(PG8_SB(1, 1), b3 + hstep);
      PG8_WAIT_V(6); PG8_BAR; PG8_MMA(1, 1, At, B1); PG8_BAR;
    }
    asm volatile("s_nop 15\n\ts_nop 15" ::: "memory");
    S.epi(acc, cur, wr, wc, fr, fq);
    if (!has_next) break;
#pragma unroll
    for (int a = 0; a < 2; ++a)
#pragma unroll
      for (int b = 0; b < 2; ++b)
#pragma unroll
        for (int m = 0; m < 4; ++m)
#pragma unroll
          for (int n = 0; n < 2; ++n) acc[a][b][m][n] = f32x4{0.f, 0.f, 0.f, 0.f};
    cur = nxt; cA = nA; cB = nB; ++ui;
    vc[0] = vn[0]; vc[1] = vn[1]; vc[2] = vn[2]; vc[3] = vn[3];
  }
  PG8_WAIT_V(0);
  if (wr == 0) PG8_BAR;
  PG8_BAR;
#undef PG8_SA
#undef PG8_SB
#undef PG8_STAGE2
#undef PG8_STAGEB
#undef PG8_LDA
#undef PG8_LDB
#undef PG8_MMA
#undef PG8_WAIT_V
#undef PG8_WAIT_L
#undef PG8_BAR
#undef PG8_SCHED
}
}

struct CfgInproj {
  static constexpr bool PERM = true;
  int K; const Params* p; int L; int bid, nb;
  DI bool next(int i, pg8::Unit& u) const { const int t = i * nb + bid; if (t >= 64 * 13) return false; u.pm = t & 63; u.pn = t >> 6; return true; }
  DI const char* a_base(const pg8::Unit& u) const { return (const char*)(p->hn() + (size_t)u.pm * 256 * DM); }
  DI const char* b_base(const pg8::Unit& u) const { return (const char*)(p->WinT() + ((size_t)L * PWP + (size_t)u.pn * 256) * DM); }
  DI void a_off(const pg8::Unit&, int R0, int C0, int R1, int C1, unsigned (&vo)[4]) const {
    vo[0] = (unsigned)(R0 * DM + C0) * 2u; vo[1] = (unsigned)(R1 * DM + C1) * 2u;
    vo[2] = vo[0] + 128u * DM * 2u; vo[3] = vo[1] + 128u * DM * 2u;
  }
  DI void epi(const f32x4 (&acc)[2][2][4][2], const pg8::Unit& u, int wr, int wc, int fr, int fq) const {
    const int row0 = u.pm * 256 + wr * 64 + fr, col0 = u.pn * 256 + wc * 32 + 8 * fq;
#pragma unroll
    for (int ai = 0; ai < 2; ++ai)
#pragma unroll
      for (int m = 0; m < 4; ++m) {
        u16* rowp = p->proj() + (size_t)(row0 + ai * 128 + m * 16) * PWP + col0;
#pragma unroll
        for (int bj = 0; bj < 2; ++bj) {
          uint4 w;
          w.x = pack2(acc[ai][bj][m][0][0], acc[ai][bj][m][0][1]); w.y = pack2(acc[ai][bj][m][0][2], acc[ai][bj][m][0][3]);
          w.z = pack2(acc[ai][bj][m][1][0], acc[ai][bj][m][1][1]); w.w = pack2(acc[ai][bj][m][1][2], acc[ai][bj][m][1][3]);
          *reinterpret_cast<uint4*>(rowp + bj * 128) = w;
        }
      }
  }
};
DI void ph_inproj_tail(const Params& p, int L, char* smem, int t) {
  const int m0 = (t & 63) * 256, n0 = 3072 + (t >> 6) * 128;
  const u16* Bt = p.WinT() + ((size_t)L * PWP + n0) * DM;
  gemm_tile([&](int r) { return p.hn() + (size_t)(m0 + r) * DM; }, Bt, DM, DM, smem,
            [&](f32x4 (&acc)[4][4], int wr, int wc, int fr, int fq) {
#pragma unroll
              for (int m = 0; m < 4; ++m)
#pragma unroll
                for (int n = 0; n < 4; ++n)
#pragma unroll
                  for (int j = 0; j < 4; ++j)
                    p.proj()[(size_t)(m0 + wr * 64 + m * 16 + fq * 4 + j) * PWP + n0 + wc * 64 + n * 16 + fr] = f2bf(acc[m][n][j]);
            });
}
DI void ph_inproj(const Params& p, int L, char* smem) {
  CfgInproj c; c.K = DM; c.p = &p; c.L = L; c.bid = obid(); c.nb = gridDim.x;
  pg8::gemm_phase((pg8::lds_u8*)smem, c);
}

DI void ph_gemm_store_bf16(const u16* A, int lda, const u16* Bt, int K, int M, int N, u16* C, int ldc, char* smem, int rot) {
  const int mt = M / 256, nt = N / 128;
  const int nb = gridDim.x;
  for (int t = (obid() + rot) % nb; t < mt * nt; t += nb) {
    const int m0 = (t % mt) * 256, n0 = (t / mt) * 128;
    gemm_tile([&](int r) { return A + (size_t)(m0 + r) * lda; }, Bt + (size_t)n0 * K, K, K, smem,
              [&](f32x4 (&acc)[4][4], int wr, int wc, int fr, int fq) {
#pragma unroll
                for (int m = 0; m < 4; ++m)
#pragma unroll
                  for (int n = 0; n < 4; ++n)
#pragma unroll
                    for (int j = 0; j < 4; ++j) {
                      const int row = m0 + wr * 64 + m * 16 + fq * 4 + j, col = n0 + wc * 64 + n * 16 + fr;
                      C[(size_t)row * ldc + col] = f2bf(acc[m][n][j]);
                    }
              });
  }
}

DI void ph_rmsnorm_bf16(const float* __restrict__ xin, const float* __restrict__ w, u16* __restrict__ outp) {
  const int tid_ = otid(); const int lane = tid_ & 63, gw = (obid() * NTHR + tid_) >> 6, nw = gridDim.x * (NTHR / 64);
  for (int t = gw; t < T; t += nw) {
    const float* xr = xin + (size_t)t * DM;
    float4 v[4];
    float ss = 0.f;
#pragma unroll
    for (int i = 0; i < 4; ++i) {
      v[i] = *reinterpret_cast<const float4*>(xr + (i * 64 + lane) * 4);
      ss += v[i].x * v[i].x + v[i].y * v[i].y + v[i].z * v[i].z + v[i].w * v[i].w;
    }
    ss = wave_sum(ss);
    const float rstd = rsqrtf(ss * (1.f / DM) + 1e-6f);
#pragma unroll
    for (int i = 0; i < 4; ++i) {
      const int c = (i * 64 + lane) * 4;
      const float4 ww = *reinterpret_cast<const float4*>(w + c);
      uint2 o;
      o.x = pack2(v[i].x * rstd * ww.x, v[i].y * rstd * ww.y);
      o.y = pack2(v[i].z * rstd * ww.z, v[i].w * rstd * ww.w);
      *reinterpret_cast<uint2*>(outp + (size_t)t * DM + c) = o;
    }
  }
}

DI void ph_final_norm(const float* __restrict__ xin, const float* __restrict__ w, float* __restrict__ outp) {
  const int tid_ = otid(); const int lane = tid_ & 63, gw = (obid() * NTHR + tid_) >> 6, nw = gridDim.x * (NTHR / 64);
  for (int t = gw; t < T; t += nw) {
    const float* xr = xin + (size_t)t * DM;
    float4 v[4];
    float ss = 0.f;
#pragma unroll
    for (int i = 0; i < 4; ++i) {
      v[i] = *reinterpret_cast<const float4*>(xr + (i * 64 + lane) * 4);
      ss += v[i].x * v[i].x + v[i].y * v[i].y + v[i].z * v[i].z + v[i].w * v[i].w;
    }
    ss = wave_sum(ss);
    const float rstd = rsqrtf(ss * (1.f / DM) + 1e-6f);
#pragma unroll
    for (int i = 0; i < 4; ++i) {
      const int c = (i * 64 + lane) * 4;
      const float4 ww = *reinterpret_cast<const float4*>(w + c);
      float4 o = make_float4(v[i].x * rstd * ww.x, v[i].y * rstd * ww.y, v[i].z * rstd * ww.z, v[i].w * rstd * ww.w);
      *reinterpret_cast<float4*>(outp + (size_t)t * DM + c) = o;
    }
  }
}

DI void rot8(const u16* x1p, const u16* x2p, const float* tab  , float scale, uint4& o1, uint4& o2) {
  float x1[8], x2[8], y1[8], y2[8];
  ld8(x1p, x1); ld8(x2p, x2);
#pragma unroll
  for (int e = 0; e < 8; e += 2) {
    const float4 cs = *reinterpret_cast<const float4*>(tab + e * 2);
    y1[e] = (x1[e] * cs.x - x2[e] * cs.y) * scale;
    y2[e] = (x2[e] * cs.x + x1[e] * cs.y) * scale;
    y1[e + 1] = (x1[e + 1] * cs.z - x2[e + 1] * cs.w) * scale;
    y2[e + 1] = (x2[e + 1] * cs.z + x1[e + 1] * cs.w) * scale;
  }
  o1.x = pack2(y1[0], y1[1]); o1.y = pack2(y1[2], y1[3]); o1.z = pack2(y1[4], y1[5]); o1.w = pack2(y1[6], y1[7]);
  o2.x = pack2(y2[0], y2[1]); o2.y = pack2(y2[2], y2[3]); o2.z = pack2(y2[4], y2[5]); o2.w = pack2(y2[6], y2[7]);
}
DI void ph_post(const Params& p, int L) {
  const int tid = otid();
  const int gt = obid() * NTHR + tid, gs = gridDim.x * NTHR;
  const int lane = tid & 63, gw = gt >> 6, nw = gs >> 6;
  const float* qnw = p.q_norm_w + L * 256;
  const float* kvnw = p.kv_norm_w + L * 128;
  const float* cw = p.conv_w + L * 5 * 768;
  const float* cb = p.conv_b + L * 768;
  const float* dtb = p.dt_bias + L * 8;
  {
    uint4 xr[5];
    auto load_taps = [&](int idx, uint4 (&r)[5]) {
      const int t = idx / 96, cg = idx - t * 96, s = t & (SEQ - 1);
#pragma unroll
      for (int w = 0; w < 5; ++w) {
        const int ss = s + w - 2;
        const int tt = (ss >= 0 && ss < SEQ) ? (t + w - 2) : t;
        r[w] = *reinterpret_cast<const uint4*>(p.proj() + (size_t)tt * PWP + C_XBC + cg * 8);
      }
    };
    if (gt < T * 96) load_taps(gt, xr);
    for (int idx = gt; idx < T * 96; idx += gs) {
      const int t = idx / 96, cg = idx - t * 96, s = t & (SEQ - 1);
      uint4 xn[5];
      const int idn = (idx + gs < T * 96) ? (idx + gs) : idx;
      load_taps(idn, xn);
      float acc[8];
      {
        const float4 b0 = *reinterpret_cast<const float4*>(cb + cg * 8), b1 = *reinterpret_cast<const float4*>(cb + cg * 8 + 4);
        acc[0] = b0.x; acc[1] = b0.y; acc[2] = b0.z; acc[3] = b0.w; acc[4] = b1.x; acc[5] = b1.y; acc[6] = b1.z; acc[7] = b1.w;
      }
#pragma unroll
      for (int w = 0; w < 5; ++w) {
        const int ss = s + w - 2;
        const float msk = (ss >= 0 && ss < SEQ) ? 1.f : 0.f;
        float xv[8];
        unpack8(xr[w], xv);
        const float4 w0 = *reinterpret_cast<const float4*>(cw + w * 768 + cg * 8), w1 = *reinterpret_cast<const float4*>(cw + w * 768 + cg * 8 + 4);
        acc[0] += msk * xv[0] * w0.x; acc[1] += msk * xv[1] * w0.y; acc[2] += msk * xv[2] * w0.z; acc[3] += msk * xv[3] * w0.w;
        acc[4] += msk * xv[4] * w1.x; acc[5] += msk * xv[5] * w1.y; acc[6] += msk * xv[6] * w1.z; acc[7] += msk * xv[7] * w1.w;
      }
      uint4 o;
      o.x = pack2(fast_silu(acc[0]), fast_silu(acc[1])); o.y = pack2(fast_silu(acc[2]), fast_silu(acc[3]));
      o.z = pack2(fast_silu(acc[4]), fast_silu(acc[5])); o.w = pack2(fast_silu(acc[6]), fast_silu(acc[7]));
      *reinterpret_cast<uint4*>(p.xbc() + (size_t)t * 768 + cg * 8) = o;
#pragma unroll
      for (int w = 0; w < 5; ++w) xr[w] = xn[w];
    }
  }
  for (int idx = gt; idx < T * 8; idx += gs) {
    const int t = idx >> 3, k = idx & 7;
    const float v = bf2f(p.proj()[(size_t)t * PWP + C_DT + k]) + dtb[k];
    p.dtv()[idx] = (v > 20.f) ? v : log1pf(expf(v));
  }
  {
    const int sub = lane >> 4, l16 = lane & 15;
    for (int t = gw * 4 + sub; t < T; t += nw * 4) {
      const u16* pr = p.proj() + (size_t)t * PWP;
      float v[16], u[8];
      ld8(pr + C_CQ + l16 * 16, v); ld8(pr + C_CQ + l16 * 16 + 8, v + 8);
      ld8(pr + C_CKV + l16 * 8, u);
      float ss = 0.f, s2 = 0.f;
#pragma unroll
      for (int i = 0; i < 16; ++i) ss += v[i] * v[i];
#pragma unroll
      for (int i = 0; i < 8; ++i) s2 += u[i] * u[i];
#pragma unroll
      for (int o = 1; o < 16; o <<= 1) { ss += __shfl_xor(ss, o); s2 += __shfl_xor(s2, o); }
      const float rstd = rsqrtf(ss * (1.f / 256.f) + 1e-6f), r2 = rsqrtf(s2 * (1.f / 128.f) + 1e-6f);
      uint4 o;
      const float* qw = qnw + l16 * 16;
      o.x = pack2(v[0] * rstd * qw[0], v[1] * rstd * qw[1]); o.y = pack2(v[2] * rstd * qw[2], v[3] * rstd * qw[3]);
      o.z = pack2(v[4] * rstd * qw[4], v[5] * rstd * qw[5]); o.w = pack2(v[6] * rstd * qw[6], v[7] * rstd * qw[7]);
      *reinterpret_cast<uint4*>(p.cqn() + (size_t)t * 256 + l16 * 16) = o;
      o.x = pack2(v[8] * rstd * qw[8], v[9] * rstd * qw[9]); o.y = pack2(v[10] * rstd * qw[10], v[11] * rstd * qw[11]);
      o.z = pack2(v[12] * rstd * qw[12], v[13] * rstd * qw[13]); o.w = pack2(v[14] * rstd * qw[14], v[15] * rstd * qw[15]);
      *reinterpret_cast<uint4*>(p.cqn() + (size_t)t * 256 + l16 * 16 + 8) = o;
      const float* kw = kvnw + l16 * 8;
      o.x = pack2(u[0] * r2 * kw[0], u[1] * r2 * kw[1]); o.y = pack2(u[2] * r2 * kw[2], u[3] * r2 * kw[3]);
      o.z = pack2(u[4] * r2 * kw[4], u[5] * r2 * kw[5]); o.w = pack2(u[6] * r2 * kw[6], u[7] * r2 * kw[7]);
      *reinterpret_cast<uint4*>(p.ckvn() + (size_t)t * 128 + l16 * 8) = o;
    }
  }
  {
    auto item_of = [&](int idx, u16*& a, int& off2, int& tabo, float& scale, int& krope_i0) {
      const int t = idx / 42, ri = idx - t * 42, s = t & (SEQ - 1);
      u16* pr = p.proj() + (size_t)t * PWP;
      krope_i0 = -1;
      if (ri < 32) {
        const int isk = ri >> 4, h = (ri >> 2) & 3, i0 = (ri & 3) * 8;
        a = pr + (isk ? C_RK : C_RQ) + h * 64 + i0; off2 = 32; tabo = (s * 56 + i0) * 2; scale = isk ? 1.f : 0.125f;
      } else if (ri < 40) {
        const int j = ri - 32, isk = j >> 2, h = j & 3;
        a = pr + (isk ? C_DK : C_DQ) + h * 64; off2 = 8; tabo = (s * 56 + 32) * 2; scale = 1.f;
      } else {
        const int i0 = (ri - 40) * 8;
        a = pr + C_KR + i0; off2 = 16; tabo = (s * 56 + 40 + i0) * 2; scale = 1.f; krope_i0 = i0;
      }
    };
    uint4 x1c = make_uint4(0, 0, 0, 0), x2c = make_uint4(0, 0, 0, 0);
    if (gt < T * 42) {
      u16* a; int off2, tabo, ki; float sc;
      item_of(gt, a, off2, tabo, sc, ki);
      x1c = *reinterpret_cast<const uint4*>(a); x2c = *reinterpret_cast<const uint4*>(a + off2);
    }
    for (int idx = gt; idx < T * 42; idx += gs) {
      u16* a; int off2, tabo, ki; float scale;
      item_of(idx, a, off2, tabo, scale, ki);
      uint4 x1n, x2n;
      {
        const int idn = (idx + gs < T * 42) ? (idx + gs) : idx;
        u16* an; int o2n, tn_, kn; float scn;
        item_of(idn, an, o2n, tn_, scn, kn);
        x1n = *reinterpret_cast<const uint4*>(an); x2n = *reinterpret_cast<const uint4*>(an + o2n);
      }
      float x1[8], x2[8], y1[8], y2[8];
      unpack8(x1c, x1); unpack8(x2c, x2);
      const float* tab = p.rtab() + tabo;
#pragma unroll
      for (int e = 0; e < 8; e += 2) {
        const float4 cs = *reinterpret_cast<const float4*>(tab + e * 2);
        y1[e] = (x1[e] * cs.x - x2[e] * cs.y) * scale;
        y2[e] = (x2[e] * cs.x + x1[e] * cs.y) * scale;
        y1[e + 1] = (x1[e + 1] * cs.z - x2[e + 1] * cs.w) * scale;
        y2[e + 1] = (x2[e + 1] * cs.z + x1[e + 1] * cs.w) * scale;
      }
      uint4 o1, o2;
      o1.x = pack2(y1[0], y1[1]); o1.y = pack2(y1[2], y1[3]); o1.z = pack2(y1[4], y1[5]); o1.w = pack2(y1[6], y1[7]);
      o2.x = pack2(y2[0], y2[1]); o2.y = pack2(y2[2], y2[3]); o2.z = pack2(y2[4], y2[5]); o2.w = pack2(y2[6], y2[7]);
      *reinterpret_cast<uint4*>(a) = o1;
      *reinterpret_cast<uint4*>(a + off2) = o2;
      if (ki >= 0) {
        const int t = idx / 42, s = t & (SEQ - 1), bb = t >> 12;
#pragma unroll
        for (int hd = 0; hd < 4; ++hd) {
          u16* kf = p.kfull() + ((size_t)(bb * 4 + hd) * SEQ + s) * 96 + 64 + ki;
          *reinterpret_cast<uint4*>(kf) = o1;
          *reinterpret_cast<uint4*>(kf + 16) = o2;
        }
      }
      x1c = x1n; x2c = x2n;
    }
  }
}

DI void ph_mla_up_q(const Params& p, int L, char* smem, int t) {
  const int mt = T / 256;
  const u16* Bq = p.WuqT() + (size_t)L * 384 * 256;
  {
    const int m0 = (t % mt) * 256, n0 = (t / mt) * 128;
    gemm_tile([&](int r) { return p.cqn() + (size_t)(m0 + r) * 256; }, Bq + (size_t)n0 * 256, 256, 256, smem,
              [&](f32x4 (&acc)[4][4], int wr, int wc, int fr, int fq) {
                const float scale = 0.10206207261596575f * 1.4426950408889634f;
#pragma unroll
                for (int m = 0; m < 4; ++m)
#pragma unroll
                  for (int j = 0; j < 4; ++j) {
                    const int row = m0 + wr * 64 + m * 16 + fq * 4 + j;
                    const float2 cssn = *reinterpret_cast<const float2*>(p.rtab() + ((size_t)(row & (SEQ - 1)) * 56 + 40 + fr) * 2);
                    const float cs = cssn.x, sn = cssn.y;
#pragma unroll
                    for (int n2 = 0; n2 < 4; n2 += 2) {
                      const int cb = n0 + wc * 64 + n2 * 16;
                      float x1 = acc[m][n2][j], x2 = acc[m][n2 + 1][j];
                      if (cb % 96 == 64) {
                        const float y1 = x1 * cs - x2 * sn, y2 = x2 * cs + x1 * sn;
                        x1 = y1; x2 = y2;
                      }
                      p.mq()[(size_t)row * 384 + cb + fr] = f2bf(x1 * scale);
                      p.mq()[(size_t)row * 384 + cb + 16 + fr] = f2bf(x2 * scale);
                    }
                  }
              });
  }
}
DI void ph_mla_up_kv(const Params& p, int L, char* smem, int t) {
  const int mt = T / 256;
  const u16* Bkv = p.WukvT() + (size_t)L * 512 * 128;
  {
    const int m0 = (t % mt) * 256, h = t / mt, n0 = h * 128;
    gemm_tile([&](int r) { return p.ckvn() + (size_t)(m0 + r) * 128; }, Bkv + (size_t)n0 * 128, 128, 128, smem,
              [&](f32x4 (&acc)[4][4], int wr, int wc, int fr, int fq) {
#pragma unroll
                for (int m = 0; m < 4; ++m) {
                  const int row = m0 + wr * 64 + m * 16 + fq * 4;
                  const int bb = row >> 12, sq = row & (SEQ - 1);
                  const size_t bh = (size_t)(bb * 4 + h);
#pragma unroll
                  for (int n = 0; n < 4; ++n) {
                    if (wc == 0) {
#pragma unroll
                      for (int j = 0; j < 4; ++j) p.kfull()[(bh * SEQ + sq + j) * 96 + n * 16 + fr] = f2bf(acc[m][n][j]);
                    } else {
                      uint2 v;
                      v.x = pack2(acc[m][n][0], acc[m][n][1]);
                      v.y = pack2(acc[m][n][2], acc[m][n][3]);
                      const int sqp = (sq & ~12) | ((sq & 4) << 1) | ((sq & 8) >> 1);
                      *reinterpret_cast<uint2*>(p.vT() + (bh * 64 + n * 16 + fr) * SEQ + sqp) = v;
                    }
                  }
                }
              });
  }
}

DI void ph_cumsum(const Params& p, int L) {
  const int tid_ = otid(); const int lane = tid_ & 63, gw = (obid() * NTHR + tid_) >> 6, nw = gridDim.x * (NTHR / 64);
  for (int it = gw; it < 32; it += nw) {
    const int h = it & 3, dir = (it >> 2) & 1, b = it >> 3;
    const float a = -expf(p.a_log[L * 8 + dir * 4 + h]);
    float running = 0.f;
    for (int c = 0; c < 64; ++c) {
      const int i = c * 64 + lane;
      const int s = dir ? (SEQ - 1 - i) : i;
      const size_t off = (size_t)(b * SEQ + s) * 8 + dir * 4 + h;
      float v = p.dtv()[off] * a;
#pragma unroll
      for (int o = 1; o < 64; o <<= 1) {
        const float u = __shfl_up(v, o);
        if (lane >= o) v += u;
      }
      v += running;
      p.cs()[off] = v;
      running = __shfl(v, 63);
    }
  }
}

DI void ph_ret_naive(const Params& p) {
  const int gt = obid() * NTHR + otid(), gs = gridDim.x * NTHR;
  for (int it = gt; it < 4 * 4 * SEQ; it += gs) {
    const int n = it & (SEQ - 1), h = (it >> 12) & 3, b = it >> 14;
    const u16* base = p.proj() + (size_t)(b * SEQ) * PWP;
    uint4 qp[8];
    float o[64];
#pragma unroll
    for (int d = 0; d < 8; ++d) qp[d] = *reinterpret_cast<const uint4*>(base + (size_t)n * PWP + C_RQ + h * 64 + d * 8);
#pragma unroll
    for (int d = 0; d < 64; ++d) o[d] = 0.f;
    const float lg0 = log1pf(-exp2f(-5.f - (float)h)), lg1 = log1pf(-exp2f(-5.5f - (float)h));
#pragma unroll 1
    for (int m = 0; m < SEQ; ++m) {
      const u16* kr = base + (size_t)m * PWP + C_RK + h * 64;
      const u16* vr = base + (size_t)m * PWP + C_RV + h * 64;
      float s = 0.f;
#pragma unroll
      for (int d = 0; d < 8; ++d) s = dot8(qp[d], *reinterpret_cast<const uint4*>(kr + d * 8), s);
      const float w = (m <= n) ? expf(lg0 * (float)(n - m)) : expf(lg1 * (float)(m - n));
      s *= w;
#pragma unroll
      for (int d = 0; d < 64; d += 8) {
        float vf[8];
        ld8(vr + d, vf);
#pragma unroll
        for (int j = 0; j < 8; ++j) o[d + j] += s * vf[j];
      }
    }
    float mu = 0.f;
#pragma unroll
    for (int d = 0; d < 64; ++d) mu += o[d];
    mu *= (1.f / 64.f);
    float var = 0.f;
#pragma unroll
    for (int d = 0; d < 64; ++d) var += (o[d] - mu) * (o[d] - mu);
    var *= (1.f / 64.f);
    const float rs = rsqrtf(var + 1e-5f);
    const size_t t = (size_t)b * SEQ + n;
#pragma unroll
    for (int d = 0; d < 64; d += 8) {
      float g[8];
      ld8(p.proj() + t * PWP + C_RG + h * 64 + d, g);
      uint4 ov;
      ov.x = pack2(silu(g[0]) * (o[d + 0] - mu) * rs, silu(g[1]) * (o[d + 1] - mu) * rs);
      ov.y = pack2(silu(g[2]) * (o[d + 2] - mu) * rs, silu(g[3]) * (o[d + 3] - mu) * rs);
      ov.z = pack2(silu(g[4]) * (o[d + 4] - mu) * rs, silu(g[5]) * (o[d + 5] - mu) * rs);
      ov.w = pack2(silu(g[6]) * (o[d + 6] - mu) * rs, silu(g[7]) * (o[d + 7] - mu) * rs);
      *reinterpret_cast<uint4*>(p.mixed() + t * DM + h * 64 + d) = ov;
    }
  }
}

DI void ph_mla_naive(const Params& p) {
  const int gt = obid() * NTHR + otid(), gs = gridDim.x * NTHR;
  for (int it = gt; it < 2 * 4 * 4 * SEQ; it += gs) {
    const int n = it & (SEQ - 1), vh = (it >> 12) & 1, h = (it >> 13) & 3, b = it >> 15;
    const size_t t = (size_t)b * SEQ + n;
    uint4 qp[12];
    float o[32];
#pragma unroll
    for (int d = 0; d < 12; ++d) qp[d] = *reinterpret_cast<const uint4*>(p.mq() + t * 384 + h * 96 + d * 8);
    const size_t tb = (size_t)b * SEQ;
    float mx = -1e30f;
#pragma unroll 1
    for (int m = 0; m < SEQ; ++m) {
      const u16* kn = ((u16*)nullptr) + (tb + m) * 512 + h * 128;
      const u16* kr = p.proj() + (tb + m) * PWP + C_KR;
      float s = 0.f;
#pragma unroll
      for (int d = 0; d < 8; ++d) s = dot8(qp[d], *reinterpret_cast<const uint4*>(kn + d * 8), s);
#pragma unroll
      for (int d = 0; d < 4; ++d) s = dot8(qp[8 + d], *reinterpret_cast<const uint4*>(kr + d * 8), s);
      mx = fmaxf(mx, s);
    }
#pragma unroll
    for (int d = 0; d < 32; ++d) o[d] = 0.f;
    float l = 0.f;
#pragma unroll 1
    for (int m = 0; m < SEQ; ++m) {
      const u16* kn = ((u16*)nullptr) + (tb + m) * 512 + h * 128;
      const u16* kr = p.proj() + (tb + m) * PWP + C_KR;
      float s = 0.f;
#pragma unroll
      for (int d = 0; d < 8; ++d) s = dot8(qp[d], *reinterpret_cast<const uint4*>(kn + d * 8), s);
#pragma unroll
      for (int d = 0; d < 4; ++d) s = dot8(qp[8 + d], *reinterpret_cast<const uint4*>(kr + d * 8), s);
      const float pe = exp2f(s - mx);
      l += pe;
#pragma unroll
      for (int d = 0; d < 32; d += 8) {
        float vf[8];
        ld8(kn + 64 + vh * 32 + d, vf);
#pragma unroll
        for (int j = 0; j < 8; ++j) o[d + j] += pe * vf[j];
      }
    }
    const float il = 1.f / l;
#pragma unroll
    for (int d = 0; d < 32; d += 8) {
      uint4 ov;
      ov.x = pack2(o[d + 0] * il, o[d + 1] * il);
      ov.y = pack2(o[d + 2] * il, o[d + 3] * il);
      ov.z = pack2(o[d + 4] * il, o[d + 5] * il);
      ov.w = pack2(o[d + 6] * il, o[d + 7] * il);
      *reinterpret_cast<uint4*>(p.mixed() + t * DM + 256 + h * 64 + vh * 32 + d) = ov;
    }
  }
}

#define MFMA32(a, b, c) __builtin_amdgcn_mfma_f32_32x32x16_bf16((a), (b), (c), 0, 0, 0)
DI float max16(const f32x16& v) {
  float a = fmaxf(fmaxf(v[0], v[1]), v[2]), b = fmaxf(fmaxf(v[3], v[4]), v[5]), c = fmaxf(fmaxf(v[6], v[7]), v[8]);
  float d = fmaxf(fmaxf(v[9], v[10]), v[11]), e = fmaxf(fmaxf(v[12], v[13]), v[14]);
  return fmaxf(fmaxf(fmaxf(a, b), fmaxf(c, d)), fmaxf(e, v[15]));
}
DI void ph_mla_attn(const Params& p, char* smem, int L) {
  const int tid = otid(), wid = tid >> 6, lane = tid & 63, l32 = lane & 31, hh = lane >> 5;
  u16* sK = reinterpret_cast<u16*>(smem);
  u16* sV = sK + 2 * 128 * 104;
  uint4 konev = make_uint4(hh == 0 ? 0x00003F80u : 0u, 0u, 0u, 0u);
  const bf16x8 kone = __builtin_bit_cast(bf16x8, konev);
  for (int item = obid(); item < 256; item += gridDim.x) {
    const int xcd_ = item & 7, jx_ = item >> 3, bh = xcd_ * 2 + (jx_ >> 4), qt = jx_ & 15, b = bh >> 2, h = bh & 3;
    const size_t t0 = (size_t)b * SEQ + qt * 256 + wid * 32;
    bf16x8 qf[6];
#pragma unroll
    for (int ks = 0; ks < 6; ++ks) qf[ks] = *reinterpret_cast<const bf16x8*>(p.mq() + (t0 + l32) * 384 + h * 96 + ks * 16 + hh * 8);
    const u16* kg = p.kfull() + (size_t)bh * SEQ * 96;
    const u16* vg = p.vT() + (size_t)bh * 64 * SEQ;
    f32x16 o0, o1;
#pragma unroll
    for (int i = 0; i < 16; ++i) { o0[i] = 0.f; o1[i] = 0.f; }
    float m = 0.f, l = 0.f;
    bf16x8 qf6 = __builtin_bit_cast(bf16x8, make_uint4(0u, 0u, 0u, 0u));
    const int kr0 = tid / 12, kc0 = tid % 12, kr1 = (512 + tid) / 12, kc1 = (512 + tid) % 12, kr2 = (1024 + tid) / 12, kc2 = (1024 + tid) % 12;
    const int vd0 = tid >> 4, vd1 = 32 + (tid >> 4), vkc = (tid & 15) * 8;
    uint4 ak0, ak1, ak2, av0, av1;
#define MLA_LD(dst_, ptr_) asm volatile("global_load_dwordx4 %0, %1, off" : "=v"(dst_) : "v"(ptr_) : "memory")
#define MLA_GLOAD(K0, K1, K2, V0, V1, kt_)                                               \
    {                                                                                    \
      const u16* kb_ = kg + (size_t)(kt_) * 128 * 96 + tid * 8;                          \
      MLA_LD(K0, kb_); MLA_LD(K1, kb_ + 512 * 8); MLA_LD(K2, kb_ + 1024 * 8);            \
      const u16* vp_ = vg + (size_t)vd0 * SEQ + (kt_) * 128 + vkc;                       \
      MLA_LD(V0, vp_); MLA_LD(V1, vp_ + (size_t)32 * SEQ);                               \
    }
#define MLA_SSTORE(K0, K1, K2, V0, V1, buf_)                                             \
    {                                                                                    \
      u16* kb_ = sK + (buf_) * 128 * 104;                                                \
      u16* vb_ = sV + (buf_) * 64 * 136;                                                 \
      *reinterpret_cast<uint4*>(kb_ + kr0 * 104 + kc0 * 8) = K0;                         \
      *reinterpret_cast<uint4*>(kb_ + kr1 * 104 + kc1 * 8) = K1;                         \
      *reinterpret_cast<uint4*>(kb_ + kr2 * 104 + kc2 * 8) = K2;                         \
      *reinterpret_cast<uint4*>(vb_ + vd0 * 136 + vkc) = V0;                             \
      *reinterpret_cast<uint4*>(vb_ + vd1 * 136 + vkc) = V1;                             \
    }
    float mxrun = 0.f;
#define SGB(mask, n) __builtin_amdgcn_sched_group_barrier((mask), (n), 0)
#define MLA_KFRAG(kb_, sub_, ks_) (*reinterpret_cast<const bf16x8*>((kb_) + ((sub_) * 32 + l32) * 104 + (ks_) * 16 + hh * 8))
#define MLA_VFRAG(dst_, vb_, sub_, ks2_, dvt_) \
    dst_ = *reinterpret_cast<const bf16x8*>((vb_) + ((dvt_) * 32 + l32) * 136 + (sub_) * 32 + (ks2_) * 16 + hh * 8)
#define MLA_SOFTMAX(sc_, pa_, pb_)                                                                         \
    {                                                                                                      \
      mxrun = fmaxf(mxrun, max16(sc_));                                                                    \
      float ps0_ = 0.f, ps1_ = 0.f;                                                                        \
      _Pragma("unroll") for (int i = 0; i < 16; i += 2) {                                                  \
        sc_[i] = __builtin_amdgcn_exp2f(sc_[i]); sc_[i + 1] = __builtin_amdgcn_exp2f(sc_[i + 1]);          \
        ps0_ += sc_[i]; ps1_ += sc_[i + 1];                                                                \
      }                                                                                                    \
      l += ps0_ + ps1_;                                                                                    \
      uint4 pk_;                                                                                           \
      pk_.x = pack2(sc_[0], sc_[1]); pk_.y = pack2(sc_[2], sc_[3]); pk_.z = pack2(sc_[4], sc_[5]); pk_.w = pack2(sc_[6], sc_[7]); \
      pa_ = __builtin_bit_cast(bf16x8, pk_);                                                               \
      pk_.x = pack2(sc_[8], sc_[9]); pk_.y = pack2(sc_[10], sc_[11]); pk_.z = pack2(sc_[12], sc_[13]); pk_.w = pack2(sc_[14], sc_[15]); \
      pb_ = __builtin_bit_cast(bf16x8, pk_);                                                               \
    }
    auto compute_tile = [&](int cur, int half) {
      const u16* kb = sK + cur * 128 * 104 + half * 64 * 104;
      const u16* vb = sV + cur * 64 * 136 + half * 64;
      bf16x8 k0[6], k1[6];
#pragma unroll
      for (int ks = 0; ks < 6; ++ks) { k0[ks] = MLA_KFRAG(kb, 0, ks); k1[ks] = MLA_KFRAG(kb, 1, ks); }
      f32x16 s0, s1;
#pragma unroll
      for (int i = 0; i < 16; ++i) { s0[i] = 0.f; s1[i] = 0.f; }
#pragma unroll
      for (int ks = 0; ks < 6; ++ks) s0 = MFMA32(k0[ks], qf[ks], s0);
      s0 = MFMA32(kone, qf6, s0);
      bf16x8 v00, v01, v02, v03, v10, v11, v12, v13;
      MLA_VFRAG(v00, vb, 0, 0, 0); MLA_VFRAG(v01, vb, 0, 0, 1); MLA_VFRAG(v02, vb, 0, 1, 0); MLA_VFRAG(v03, vb, 0, 1, 1);
#pragma unroll
      for (int ks = 0; ks < 6; ++ks) s1 = MFMA32(k1[ks], qf[ks], s1);
      s1 = MFMA32(kone, qf6, s1);
      MLA_VFRAG(v10, vb, 1, 0, 0); MLA_VFRAG(v11, vb, 1, 0, 1); MLA_VFRAG(v12, vb, 1, 1, 0); MLA_VFRAG(v13, vb, 1, 1, 1);
      bf16x8 p0a, p0b, p1a, p1b;
      MLA_SOFTMAX(s0, p0a, p0b);
      o0 = MFMA32(v00, p0a, o0); o1 = MFMA32(v01, p0a, o1); o0 = MFMA32(v02, p0b, o0); o1 = MFMA32(v03, p0b, o1);
      MLA_SOFTMAX(s1, p1a, p1b);
      o0 = MFMA32(v10, p1a, o0); o1 = MFMA32(v11, p1a, o1); o0 = MFMA32(v12, p1b, o0); o1 = MFMA32(v13, p1b, o1);
      SGB(0x100, 12);
#pragma unroll
      for (int i = 0; i < 7; ++i) { SGB(0x008, 1); if (i < 4) SGB(0x100, 1); }
#pragma unroll
      for (int i = 0; i < 7; ++i) { SGB(0x008, 1); if (i < 4) SGB(0x100, 1); SGB(0x402, 7); }
#pragma unroll
      for (int i = 0; i < 4; ++i) { SGB(0x008, 1); SGB(0x402, 12); }
#pragma unroll
      for (int i = 0; i < 4; ++i) SGB(0x008, 1);
    };
    auto lazy_update = [&]() {
      const float mxr = fmaxf(mxrun, __shfl_xor(mxrun, 32));
      if (__builtin_amdgcn_ballot_w64(mxr > 8.f) != 0ull) {
        float d = (mxr > 8.f) ? mxr : 0.f;
        const float mnew = bf2f(f2bf(m + d));
        d = mnew - m;
        m = mnew;
        const float alpha = __builtin_amdgcn_exp2f(-d);
        l *= alpha;
        mxrun -= d;
#pragma unroll
        for (int i = 0; i < 16; ++i) { o0[i] *= alpha; o1[i] *= alpha; }
        uint4 qv = make_uint4(0u, 0u, 0u, 0u);
        if (hh == 0) qv.x = (unsigned)f2bf(-m);
        qf6 = __builtin_bit_cast(bf16x8, qv);
      }
    };
    unsigned char* cbuf = reinterpret_cast<unsigned char*>(sV + 2 * 64 * 136);
    const bool cvt_on = (gridDim.x == 256);
    f32x4 cv0, cv1, cv2, cv3;
    bool cvalid = false;
#define CVT_ISSUE(j_)                                                                                                   \
    {                                                                                                                   \
      const int g_ = obid() + 256 * (j_);                                                                               \
      cvalid = cvt_on && (g_ < CVT_IN_MLA_E * 768);                                                                     \
      if (cvalid) {                                                                                                     \
        const CvtTile ct_ = cvt_tile(p, L, g_);                                                                         \
        const float* sp_ = ct_.src + (size_t)(ct_.k0 + (tid >> 5) * 4) * ct_.N + ct_.n0 + (tid & 31) * 4;              \
        cv0 = __builtin_nontemporal_load(reinterpret_cast<const f32x4*>(sp_));                                          \
        cv1 = __builtin_nontemporal_load(reinterpret_cast<const f32x4*>(sp_ + ct_.N));                                  \
        cv2 = __builtin_nontemporal_load(reinterpret_cast<const f32x4*>(sp_ + 2 * ct_.N));                              \
        cv3 = __builtin_nontemporal_load(reinterpret_cast<const f32x4*>(sp_ + 3 * ct_.N));                              \
      }                                                                                                                 \
    }
#define CVT_TO_LDS(par_)                                                                                                \
    if (cvalid) {                                                                                                       \
      unsigned char* cb_ = cbuf + (par_) * 10240 + (tid & 31) * 4 * 80 + (tid >> 5) * 4;                                \
      *reinterpret_cast<unsigned*>(cb_) = pk4_f8(cv0[0] * F8_W_SCALE, cv1[0] * F8_W_SCALE, cv2[0] * F8_W_SCALE, cv3[0] * F8_W_SCALE);       \
      *reinterpret_cast<unsigned*>(cb_ + 80) = pk4_f8(cv0[1] * F8_W_SCALE, cv1[1] * F8_W_SCALE, cv2[1] * F8_W_SCALE, cv3[1] * F8_W_SCALE);  \
      *reinterpret_cast<unsigned*>(cb_ + 160) = pk4_f8(cv0[2] * F8_W_SCALE, cv1[2] * F8_W_SCALE, cv2[2] * F8_W_SCALE, cv3[2] * F8_W_SCALE); \
      *reinterpret_cast<unsigned*>(cb_ + 240) = pk4_f8(cv0[3] * F8_W_SCALE, cv1[3] * F8_W_SCALE, cv2[3] * F8_W_SCALE, cv3[3] * F8_W_SCALE); \
    }
#define CVT_TO_GLOBAL(par_, j_)                                                                                         \
    if (cvalid) {                                                                                                       \
      const CvtTile ct_ = cvt_tile(p, L, obid() + 256 * (j_));        \
      unsigned char* cd_ = ct_.dst + (size_t)cvt_rowmap(ct_.mat, ct_.n0 + (tid >> 2)) * ct_.K + ct_.k0 + (tid & 3) * 16;  \
      *reinterpret_cast<uint4*>(cd_) = *reinterpret_cast<const uint4*>(cbuf + (par_) * 10240 + (tid >> 2) * 80 + (tid & 3) * 16); \
    }
    MLA_GLOAD(ak0, ak1, ak2, av0, av1, 0);
    asm volatile("s_waitcnt vmcnt(0)" ::: "memory");
    MLA_SSTORE(ak0, ak1, ak2, av0, av1, 0);
    __syncthreads();
    {
      f32x16 s0, s1;
#pragma unroll
      for (int i = 0; i < 16; ++i) { s0[i] = 0.f; s1[i] = 0.f; }
#pragma unroll
      for (int ks = 0; ks < 6; ++ks) { s0 = MFMA32(MLA_KFRAG(sK, 0, ks), qf[ks], s0); s1 = MFMA32(MLA_KFRAG(sK, 1, ks), qf[ks], s1); }
      float mx = fmaxf(max16(s0), max16(s1));
      mx = fmaxf(mx, __shfl_xor(mx, 32));
      m = bf2f(f2bf(mx));
      uint4 qv = make_uint4(0u, 0u, 0u, 0u);
      if (hh == 0) qv.x = (unsigned)f2bf(-m);
      qf6 = __builtin_bit_cast(bf16x8, qv);
    }
#pragma unroll 1
    for (int kt = 0; kt < 32; kt += 2) {
      MLA_GLOAD(ak0, ak1, ak2, av0, av1, kt + 1);
      CVT_ISSUE(kt);
#pragma unroll 1
      for (int half = 0; half < 2; ++half) compute_tile(0, half);
      asm volatile("s_waitcnt vmcnt(0)" ::: "memory");
      MLA_SSTORE(ak0, ak1, ak2, av0, av1, 1);
      CVT_TO_LDS(0);
      __syncthreads();
      CVT_TO_GLOBAL(0, kt);
      lazy_update();
      if (kt + 2 < 32) MLA_GLOAD(ak0, ak1, ak2, av0, av1, kt + 2);
      CVT_ISSUE(kt + 1);
#pragma unroll 1
      for (int half = 0; half < 2; ++half) compute_tile(1, half);
      asm volatile("s_waitcnt vmcnt(0)" ::: "memory");
      if (kt + 2 < 32) MLA_SSTORE(ak0, ak1, ak2, av0, av1, 0);
      CVT_TO_LDS(1);
      __syncthreads();
      CVT_TO_GLOBAL(1, kt + 1);
      lazy_update();
    }
    l += __shfl_xor(l, 32);
    const float il = 1.f / l;
    u16* orow = p.mixed() + (t0 + l32) * DM + 256 + h * 64 + hh * 4;
#pragma unroll
    for (int g = 0; g < 4; ++g) {
      uint2 v;
      v.x = pack2(o0[4 * g + 0] * il, o0[4 * g + 1] * il);
      v.y = pack2(o0[4 * g + 2] * il, o0[4 * g + 3] * il);
      *reinterpret_cast<uint2*>(orow + g * 8) = v;
      v.x = pack2(o1[4 * g + 0] * il, o1[4 * g + 1] * il);
      v.y = pack2(o1[4 * g + 2] * il, o1[4 * g + 3] * il);
      *reinterpret_cast<uint2*>(orow + 32 + g * 8) = v;
    }
  }
}

typedef __attribute__((address_space(3))) s16x4 lds_s16x4;
template <int MODE>
DI void ph_dil_pass(const Params& p, char* smem, int blk_) {
  const int tid = otid(), wid = tid >> 6, lane = tid & 63, l32 = lane & 31, hh = lane >> 5;
  u16* sV = reinterpret_cast<u16*>(smem) + wid * (2 * 32 * 72);
  const int i16 = lane & 15, tq = i16 >> 2, tp = i16 & 3, tblk = (lane >> 4) & 1;
  {
    constexpr int NT = (MODE == 0) ? 13 : 5;
    const int it = wid, xcd_ = blk_ & 7, jx_ = blk_ >> 3, bh = xcd_ * 2 + (jx_ >> 4), r = jx_ & 15, b = bh >> 2, h = bh & 3;
    const int i0 = it * 32;
    const int q0 = (r * 8 + it) * 32;
    const int qpos = (MODE == 0) ? (r + 16 * (i0 + l32)) : (q0 + l32);
    const size_t tb = (size_t)b * SEQ;
    const u16* kbase = p.proj() + tb * PWP + C_DK + h * 64;
    const u16* vbase = p.proj() + tb * PWP + C_DV + h * 64;
    bf16x8 qf[4];
    {
      const u16* qp = p.proj() + (tb + qpos) * PWP + C_DQ + h * 64 + hh * 8;
#pragma unroll
      for (int ks = 0; ks < 4; ++ks) qf[ks] = *reinterpret_cast<const bf16x8*>(qp + ks * 16);
    }
    f32x16 o0, o1;
#pragma unroll
    for (int i = 0; i < 16; ++i) { o0[i] = 0.f; o1[i] = 0.f; }
    float m = -1e30f, l = 0.f;
    auto tile_params = [&](int tt, int& d, int& rd, int& ub, int& ulim, int& qb, int& qs) {
      if (MODE == 0) {
        if (tt < 5) { d = 16; rd = r; qb = i0; qs = 1; ulim = 256; ub = qb - 64 + 32 * tt; }
        else { d = 4; rd = r & 3; qb = (r >> 2) + 4 * i0; qs = 4; ulim = 1024; ub = qb - 64 + 32 * (tt - 5); }
      } else { d = 1; rd = 0; qb = q0; qs = 1; ulim = 4096; ub = qb - 64 + 32 * tt; }
    };
    bf16x8 ka0, ka1, ka2, ka3, kb0, kb1, kb2, kb3;
    uint4 va0, va1, va2, va3, vb0, vb1, vb2, vb3;
#define DIL_LD(dst_, ptr_) asm volatile("global_load_dwordx4 %0, %1, off" : "=v"(dst_) : "v"(ptr_) : "memory")
#define DIL_GLOAD(K0, K1, K2, K3, V0, V1, V2, V3, tt_)                                                   \
    {                                                                                                    \
      int d_, rd_, ub_, ulim_, qb_, qs_;                                                                 \
      tile_params((tt_), d_, rd_, ub_, ulim_, qb_, qs_);                                                 \
      int u_ = min(max(ub_ + l32, 0), ulim_ - 1);                                                        \
      const u16* kp_ = kbase + (size_t)(rd_ + d_ * u_) * PWP + hh * 8;                                   \
      DIL_LD(K0, kp_); DIL_LD(K1, kp_ + 16); DIL_LD(K2, kp_ + 32); DIL_LD(K3, kp_ + 48);                 \
      const int kr_ = ub_ + (lane >> 3);                                                                 \
      const u16* vp_;                                                                                    \
      u_ = min(max(kr_, 0), ulim_ - 1);      vp_ = vbase + (size_t)(rd_ + d_ * u_) * PWP + (lane & 7) * 8; DIL_LD(V0, vp_); \
      u_ = min(max(kr_ + 8, 0), ulim_ - 1);  vp_ = vbase + (size_t)(rd_ + d_ * u_) * PWP + (lane & 7) * 8; DIL_LD(V1, vp_); \
      u_ = min(max(kr_ + 16, 0), ulim_ - 1); vp_ = vbase + (size_t)(rd_ + d_ * u_) * PWP + (lane & 7) * 8; DIL_LD(V2, vp_); \
      u_ = min(max(kr_ + 24, 0), ulim_ - 1); vp_ = vbase + (size_t)(rd_ + d_ * u_) * PWP + (lane & 7) * 8; DIL_LD(V3, vp_); \
    }
#define DIL_VSTORE(V0, V1, V2, V3, buf_)                                                                 \
    {                                                                                                    \
      u16* vb_ = sV + (buf_) * 32 * 72 + (lane >> 3) * 72 + (lane & 7) * 8;                              \
      *reinterpret_cast<uint4*>(vb_) = V0;                                                               \
      *reinterpret_cast<uint4*>(vb_ + 8 * 72) = V1;                                                      \
      *reinterpret_cast<uint4*>(vb_ + 16 * 72) = V2;                                                     \
      *reinterpret_cast<uint4*>(vb_ + 24 * 72) = V3;                                                     \
    }
    auto tile_rest = [&](int tt, f32x16 sc, int cur) {
      int d, rd, ub, ulim, qb, qs;
      tile_params(tt, d, rd, ub, ulim, qb, qs);
      const int uq = qb + qs * l32;
      const float cs = 0.125f * 1.4426950408889634f;
      float mx = -1e30f;
#pragma unroll
      for (int i = 0; i < 16; ++i) {
        const int u = ub + (i & 3) + 8 * (i >> 2) + 4 * hh;
        const int du = u - uq;
        const bool valid = (u >= 0) && (u < ulim) && (du <= 64) && (du >= -64);
        sc[i] = valid ? sc[i] * cs : -1e30f;
        mx = fmaxf(mx, sc[i]);
      }
      mx = fmaxf(mx, __shfl_xor(mx, 32));
      const float mn = fmaxf(m, mx);
      const float alpha = __builtin_amdgcn_exp2f(m - mn);
      m = mn;
      float ps = 0.f;
#pragma unroll
      for (int i = 0; i < 16; ++i) {
        float pe = __builtin_amdgcn_exp2f(sc[i] - mn);
        pe = (sc[i] > -1e29f) ? pe : 0.f;
        ps += pe;
        sc[i] = pe;
      }
      l = l * alpha + ps;
#pragma unroll
      for (int i = 0; i < 16; ++i) { o0[i] *= alpha; o1[i] *= alpha; }
      const u16* vb = sV + cur * 32 * 72;
#pragma unroll
      for (int ks2 = 0; ks2 < 2; ++ks2) {
        uint4 pk;
        pk.x = pack2(sc[8 * ks2 + 0], sc[8 * ks2 + 1]);
        pk.y = pack2(sc[8 * ks2 + 2], sc[8 * ks2 + 3]);
        pk.z = pack2(sc[8 * ks2 + 4], sc[8 * ks2 + 5]);
        pk.w = pack2(sc[8 * ks2 + 6], sc[8 * ks2 + 7]);
        const bf16x8 pb = __builtin_bit_cast(bf16x8, pk);
#pragma unroll
        for (int dvt = 0; dvt < 2; ++dvt) {
          const u16* a0 = vb + (16 * ks2 + 4 * hh + tq) * 72 + dvt * 32 + tblk * 16 + tp * 4;
          const s16x4 lo = __builtin_amdgcn_ds_read_tr16_b64_v4i16((lds_s16x4*)(a0));
          const s16x4 hi = __builtin_amdgcn_ds_read_tr16_b64_v4i16((lds_s16x4*)(a0 + 8 * 72));
          const bf16x8 a = __builtin_shufflevector(lo, hi, 0, 1, 2, 3, 4, 5, 6, 7);
          if (dvt == 0) o0 = MFMA32(a, pb, o0); else o1 = MFMA32(a, pb, o1);
        }
      }
    };
    DIL_GLOAD(ka0, ka1, ka2, ka3, va0, va1, va2, va3, 0);
    DIL_GLOAD(kb0, kb1, kb2, kb3, vb0, vb1, vb2, vb3, 1);
    asm volatile("s_waitcnt vmcnt(8)" ::: "memory");
    DIL_VSTORE(va0, va1, va2, va3, 0);
#pragma unroll 1
    for (int tt = 0; tt < NT; tt += 2) {
      {
        f32x16 sc;
#pragma unroll
        for (int i = 0; i < 16; ++i) sc[i] = 0.f;
        sc = MFMA32(ka0, qf[0], sc); sc = MFMA32(ka1, qf[1], sc); sc = MFMA32(ka2, qf[2], sc); sc = MFMA32(ka3, qf[3], sc);
        asm volatile("" :: "v"(sc));
        if (tt + 2 < NT) DIL_GLOAD(ka0, ka1, ka2, ka3, va0, va1, va2, va3, tt + 2);
        tile_rest(tt, sc, 0);
        if (tt + 1 < NT) {
          if (tt + 2 < NT) asm volatile("s_waitcnt vmcnt(8)" ::: "memory"); else asm volatile("s_waitcnt vmcnt(0)" ::: "memory");
          DIL_VSTORE(vb0, vb1, vb2, vb3, 1);
        }
      }
      if (tt + 1 < NT) {
        f32x16 sc;
#pragma unroll
        for (int i = 0; i < 16; ++i) sc[i] = 0.f;
        sc = MFMA32(kb0, qf[0], sc); sc = MFMA32(kb1, qf[1], sc); sc = MFMA32(kb2, qf[2], sc); sc = MFMA32(kb3, qf[3], sc);
        asm volatile("" :: "v"(sc));
        if (tt + 3 < NT) DIL_GLOAD(kb0, kb1, kb2, kb3, vb0, vb1, vb2, vb3, tt + 3);
        tile_rest(tt + 1, sc, 1);
        if (tt + 2 < NT) {
          if (tt + 3 < NT) asm volatile("s_waitcnt vmcnt(8)" ::: "memory"); else asm volatile("s_waitcnt vmcnt(0)" ::: "memory");
          DIL_VSTORE(va0, va1, va2, va3, 0);
        }
      }
    }
    l += __shfl_xor(l, 32);
    float* part = p.dpart() + ((tb + qpos) * 4 + h) * 68 + hh * 4;
    if (MODE == 0) {
#pragma unroll
      for (int g = 0; g < 4; ++g) {
        *reinterpret_cast<float4*>(part + g * 8) = make_float4(o0[4 * g + 0], o0[4 * g + 1], o0[4 * g + 2], o0[4 * g + 3]);
        *reinterpret_cast<float4*>(part + 32 + g * 8) = make_float4(o1[4 * g + 0], o1[4 * g + 1], o1[4 * g + 2], o1[4 * g + 3]);
      }
      if (hh == 0) { part[64] = m; part[65] = l; }
    } else {
      const float mA = part[64 - hh * 4], lA = part[65 - hh * 4];
      const float M = fmaxf(m, mA), sa = __builtin_amdgcn_exp2f(m - M), sb = __builtin_amdgcn_exp2f(mA - M);
      const float il = 1.f / (l * sa + lA * sb);
      u16* orow = p.mixed() + (tb + qpos) * DM + 768 + h * 64 + hh * 4;
#pragma unroll
      for (int g = 0; g < 4; ++g) {
        const float4 a0 = *reinterpret_cast<const float4*>(part + g * 8), a1 = *reinterpret_cast<const float4*>(part + 32 + g * 8);
        uint2 v;
        v.x = pack2((o0[4 * g + 0] * sa + a0.x * sb) * il, (o0[4 * g + 1] * sa + a0.y * sb) * il);
        v.y = pack2((o0[4 * g + 2] * sa + a0.z * sb) * il, (o0[4 * g + 3] * sa + a0.w * sb) * il);
        *reinterpret_cast<uint2*>(orow + g * 8) = v;
        v.x = pack2((o1[4 * g + 0] * sa + a1.x * sb) * il, (o1[4 * g + 1] * sa + a1.y * sb) * il);
        v.y = pack2((o1[4 * g + 2] * sa + a1.z * sb) * il, (o1[4 * g + 3] * sa + a1.w * sb) * il);
        *reinterpret_cast<uint2*>(orow + 32 + g * 8) = v;
      }
    }
  }
}

DI void ph_dil_naive(const Params& p) {
  const int gt = obid() * NTHR + otid(), gs = gridDim.x * NTHR;
  for (int it = gt; it < 4 * 4 * SEQ; it += gs) {
    const int n = it & (SEQ - 1), h = (it >> 12) & 3, b = it >> 14;
    const size_t tb = (size_t)b * SEQ;
    uint4 qp[8];
    float o[64];
#pragma unroll
    for (int d = 0; d < 8; ++d) qp[d] = *reinterpret_cast<const uint4*>(p.proj() + (tb + n) * PWP + C_DQ + h * 64 + d * 8);
    float mx = -1e30f;
    for (int pat = 0; pat < 3; ++pat) {
      const int dil = (pat == 0) ? 1 : (pat == 1 ? 4 : 16);
#pragma unroll 1
      for (int j = -64; j <= 64; ++j) {
        const int pos = n + j * dil;
        if (pos < 0 || pos >= SEQ) continue;
        const u16* kr = p.proj() + (tb + pos) * PWP + C_DK + h * 64;
        float s = 0.f;
#pragma unroll
        for (int d = 0; d < 8; ++d) s = dot8(qp[d], *reinterpret_cast<const uint4*>(kr + d * 8), s);
        s *= 0.125f;
        mx = fmaxf(mx, s);
      }
    }
#pragma unroll
    for (int d = 0; d < 64; ++d) o[d] = 0.f;
    float l = 0.f;
    for (int pat = 0; pat < 3; ++pat) {
      const int dil = (pat == 0) ? 1 : (pat == 1 ? 4 : 16);
#pragma unroll 1
      for (int j = -64; j <= 64; ++j) {
        const int pos = n + j * dil;
        if (pos < 0 || pos >= SEQ) continue;
        const u16* kr = p.proj() + (tb + pos) * PWP + C_DK + h * 64;
        const u16* vr = p.proj() + (tb + pos) * PWP + C_DV + h * 64;
        float s = 0.f;
#pragma unroll
        for (int d = 0; d < 8; ++d) s = dot8(qp[d], *reinterpret_cast<const uint4*>(kr + d * 8), s);
        s *= 0.125f;
        const float pe = __expf(s - mx);
        l += pe;
#pragma unroll
        for (int d = 0; d < 64; d += 8) {
          float vf[8];
          ld8(vr + d, vf);
#pragma unroll
          for (int jj = 0; jj < 8; ++jj) o[d + jj] += pe * vf[jj];
        }
      }
    }
    const float il = 1.f / l;
#pragma unroll
    for (int d = 0; d < 64; d += 8) {
      uint4 ov;
      ov.x = pack2(o[d + 0] * il, o[d + 1] * il);
      ov.y = pack2(o[d + 2] * il, o[d + 3] * il);
      ov.z = pack2(o[d + 4] * il, o[d + 5] * il);
      ov.w = pack2(o[d + 6] * il, o[d + 7] * il);
      *reinterpret_cast<uint4*>(p.mixed() + (tb + n) * DM + 768 + h * 64 + d) = ov;
    }
  }
}

DI void ph_ssd_naive(const Params& p, int L) {
  const int gt = obid() * NTHR + otid(), gs = gridDim.x * NTHR;
  for (int it = gt; it < 4 * 4 * 4 * SEQ; it += gs) {
    const int l = it & (SEQ - 1), pq = (it >> 12) & 3, h = (it >> 14) & 3, b = it >> 16;
    const int g = h >> 1;
    const size_t tb = (size_t)b * SEQ;
    uint4 cl[16];
    float acc[16];
#pragma unroll
    for (int d = 0; d < 16; ++d) cl[d] = *reinterpret_cast<const uint4*>(p.xbc() + (tb + l) * 768 + 512 + g * 128 + d * 8);
#pragma unroll
    for (int d = 0; d < 16; ++d) acc[d] = 0.f;
    const float pl = p.cs()[(tb + l) * 8 + h], rl = p.cs()[(tb + l) * 8 + 4 + h];
#pragma unroll 1
    for (int s = 0; s < SEQ; ++s) {
      const u16* br = p.xbc() + (tb + s) * 768 + 256 + g * 128;
      float cbv = 0.f;
#pragma unroll
      for (int d = 0; d < 16; ++d) cbv = dot8(cl[d], *reinterpret_cast<const uint4*>(br + d * 8), cbv);
      float w;
      if (s <= l) w = expf(pl - p.cs()[(tb + s) * 8 + h]) * p.dtv()[(tb + s) * 8 + h];
      else w = expf(rl - p.cs()[(tb + s) * 8 + 4 + h]) * p.dtv()[(tb + s) * 8 + 4 + h];
      cbv *= w;
      const u16* xr = p.xbc() + (tb + s) * 768 + h * 64 + pq * 16;
#pragma unroll
      for (int d = 0; d < 16; d += 8) {
        float xf[8];
        ld8(xr + d, xf);
#pragma unroll
        for (int j = 0; j < 8; ++j) acc[d + j] += cbv * xf[j];
      }
    }
    const float dsk = p.ssm_d[L * 4 + h];
#pragma unroll
    for (int d = 0; d < 16; ++d) {
      const int c = h * 64 + pq * 16 + d;
      const float xv = bf2f(p.xbc()[(tb + l) * 768 + c]);
      const float z = bf2f(p.proj()[(tb + l) * PWP + C_Z + c]);
      p.ybuf()[(tb + l) * 256 + c] = (acc[d] + dsk * xv) * silu(z);
    }
  }
}

DI void ph_ssd_norm(const Params& p, int L) {
  const int tid_ = otid(); const int lane = tid_ & 63, gw = (obid() * NTHR + tid_) >> 6, nw = gridDim.x * (NTHR / 64);
  const float* nwt = p.ssm_norm_w + L * 256;
  for (int t = gw; t < T; t += nw) {
    const float4 v = *reinterpret_cast<const float4*>(p.ybuf() + (size_t)t * 256 + lane * 4);
    float ss = wave_sum(v.x * v.x + v.y * v.y + v.z * v.z + v.w * v.w);
    const float rstd = rsqrtf(ss * (1.f / 256.f) + 1e-6f);
    const float4 ww = *reinterpret_cast<const float4*>(nwt + lane * 4);
    uint2 o;
    o.x = pack2(v.x * rstd * ww.x, v.y * rstd * ww.y);
    o.y = pack2(v.z * rstd * ww.z, v.w * rstd * ww.w);
    *reinterpret_cast<uint2*>(p.mixed() + (size_t)t * DM + 512 + lane * 4) = o;
  }
}

#define MFMA16(a, b, c) __builtin_amdgcn_mfma_f32_16x16x32_bf16((a), (b), (c), 0, 0, 0)
template <int MT, int NT, int KS>
DI void wave_mm(f32x4 (&acc)[MT][NT], const u16* a0, int lda, const u16* b0, int ldb, int fr, int fq) {
#pragma unroll
  for (int ks = 0; ks < KS; ++ks) {
    bf16x8 af[MT], bfv[NT];
#pragma unroll
    for (int m = 0; m < MT; ++m) af[m] = *reinterpret_cast<const bf16x8*>(a0 + (m * 16 + fr) * lda + ks * 32 + fq * 8);
#pragma unroll
    for (int n = 0; n < NT; ++n) bfv[n] = *reinterpret_cast<const bf16x8*>(b0 + (n * 16 + fr) * ldb + ks * 32 + fq * 8);
#pragma unroll
    for (int m = 0; m < MT; ++m)
#pragma unroll
      for (int n = 0; n < NT; ++n) acc[m][n] = MFMA16(af[m], bfv[n], acc[m][n]);
  }
}
template <int MT, int NT>
DI void zero_acc(f32x4 (&acc)[MT][NT]) {
#pragma unroll
  for (int m = 0; m < MT; ++m)
#pragma unroll
    for (int n = 0; n < NT; ++n) acc[m][n] = f32x4{0.f, 0.f, 0.f, 0.f};
}
template <int NROWS, int NCOLS>
DI void stage_rows(u16* dst, int ldd, const u16* src, size_t lsrc, int tid) {
  constexpr int CPR = NCOLS / 8, NCH = NROWS * CPR / NTHR;
  static_assert(NROWS * CPR % NTHR == 0, "tile must be a multiple of 512 chunks");
  uint4 r[NCH];
#pragma unroll
  for (int i = 0; i < NCH; ++i) {
    const int c = tid + i * NTHR, row = c / CPR, cc = c % CPR;
    r[i] = *reinterpret_cast<const uint4*>(src + (size_t)row * lsrc + cc * 8);
  }
#pragma unroll
  for (int i = 0; i < NCH; ++i) {
    const int c = tid + i * NTHR, row = c / CPR, cc = c % CPR;
    *reinterpret_cast<uint4*>(dst + row * ldd + cc * 8) = r[i];
  }
}
template <int NCOLS, class W>
DI void stage_T(u16* dst, int ldd, const u16* src, size_t lsrc, int tid, W w) {
  constexpr int NCH = 128 * (NCOLS / 8) / NTHR;
  uint4 r[NCH];
#pragma unroll
  for (int i = 0; i < NCH; ++i) {
    const int c = tid + i * NTHR, j = c & 127, cc = c >> 7;
    r[i] = *reinterpret_cast<const uint4*>(src + (size_t)j * lsrc + cc * 8);
  }
#pragma unroll
  for (int i = 0; i < NCH; ++i) {
    const int c = tid + i * NTHR, j = c & 127, cc = c >> 7;
    float f[8];
    unpack8(r[i], f);
    const float wj = w(j);
#pragma unroll
    for (int e = 0; e < 8; ++e) dst[(cc * 8 + e) * ldd + j] = f2bf(f[e] * wj);
  }
}

template <int NROWS, int NCOLS>
DI void stage_rows_ld(uint4 (&r)[NROWS * (NCOLS / 8) / NTHR], const u16* src, size_t lsrc, int tid) {
  constexpr int CPR = NCOLS / 8, NCH = NROWS * CPR / NTHR;
#pragma unroll
  for (int i = 0; i < NCH; ++i) {
    const int c = tid + i * NTHR, row = c / CPR, cc = c % CPR;
    r[i] = *reinterpret_cast<const uint4*>(src + (size_t)row * lsrc + cc * 8);
  }
}
template <int NROWS, int NCOLS>
DI void stage_rows_st(u16* dst, int ldd, const uint4 (&r)[NROWS * (NCOLS / 8) / NTHR], int tid) {
  constexpr int CPR = NCOLS / 8, NCH = NROWS * CPR / NTHR;
#pragma unroll
  for (int i = 0; i < NCH; ++i) {
    const int c = tid + i * NTHR, row = c / CPR, cc = c % CPR;
    *reinterpret_cast<uint4*>(dst + row * ldd + cc * 8) = r[i];
  }
}
template <int NCOLS>
DI void stage_T_ld(uint4 (&r)[128 * (NCOLS / 8) / NTHR], const u16* src, size_t lsrc, int tid) {
  constexpr int NCH = 128 * (NCOLS / 8) / NTHR;
#pragma unroll
  for (int i = 0; i < NCH; ++i) {
    const int c = tid + i * NTHR, j = c & 127, cc = c >> 7;
    r[i] = *reinterpret_cast<const uint4*>(src + (size_t)j * lsrc + cc * 8);
  }
}
template <int NCOLS, class W>
DI void stage_T_st(u16* dst, int ldd, const uint4 (&r)[128 * (NCOLS / 8) / NTHR], int tid, W w) {
  constexpr int NCH = 128 * (NCOLS / 8) / NTHR;
#pragma unroll
  for (int i = 0; i < NCH; ++i) {
    const int c = tid + i * NTHR, j = c & 127, cc = c >> 7;
    float f[8];
    unpack8(r[i], f);
    const float wj = w(j);
#pragma unroll
    for (int e = 0; e < 8; ++e) dst[(cc * 8 + e) * ldd + j] = f2bf(f[e] * wj);
  }
}

DI void ph_ret_a(const Params& p, char* smem, int item) {
  const int tid = otid(), wid = tid >> 6, lane = tid & 63, fr = lane & 15, fq = lane >> 4;
  u16* sVt = reinterpret_cast<u16*>(smem);
  u16* sKf = sVt + 64 * 136;
  u16* sKb = sKf + 64 * 136;
  {
    const int c = item & 31, bh = item >> 5, b = bh >> 2, h = bh & 3;
    const float lg0 = log1pf(-exp2f(-5.f - (float)h)), lg1 = log1pf(-exp2f(-5.5f - (float)h));
    const u16* src = p.proj() + ((size_t)b * SEQ + c * 128) * PWP;
    {
      uint4 rv[2], rk[2];
      stage_T_ld<64>(rv, src + C_RV + h * 64, PWP, tid);
      stage_T_ld<64>(rk, src + C_RK + h * 64, PWP, tid);
      stage_T_st<64>(sVt, 136, rv, tid, [](int) { return 1.f; });
      stage_T_st<64>(sKf, 136, rk, tid, [&](int j) { return __expf(lg0 * (float)(127 - j)); });
      stage_T_st<64>(sKb, 136, rk, tid, [&](int j) { return __expf(lg1 * (float)j); });
    }
    __syncthreads();
    const int dir = wid >> 2, q = wid & 3;
    f32x4 acc[1][4];
    zero_acc(acc);
    wave_mm<1, 4, 4>(acc, sVt + q * 16 * 136, 136, dir ? sKb : sKf, 136, fr, fq);
    float* out = p.rU() + ((size_t)(bh * 32 + c) * 2 + dir) * 4096;
#pragma unroll
    for (int n = 0; n < 4; ++n)
#pragma unroll
      for (int j = 0; j < 4; ++j) out[(q * 16 + fq * 4 + j) * 64 + n * 16 + fr] = acc[0][n][j];
    __syncthreads();
  }
}
DI void ph_ret_scan(const Params& p) {
  const int gt = obid() * NTHR + otid(), gs = gridDim.x * NTHR;
  for (int it = gt; it < 16 * 2 * 4096; it += gs) {
    const int e = it & 4095, dir = (it >> 12) & 1, bh = it >> 13, h = bh & 3;
    const float lg = log1pf(-exp2f((dir ? -5.5f : -5.f) - (float)h));
    const float cd = __expf(lg * 128.f);
    float u[32];
#pragma unroll
    for (int c = 0; c < 32; ++c) u[c] = p.rU()[((size_t)(bh * 32 + c) * 2 + dir) * 4096 + e];
    float st = 0.f;
    if (dir == 0) {
#pragma unroll
      for (int c = 0; c < 32; ++c) {
        p.rS()[((size_t)(bh * 32 + c) * 2 + dir) * 4096 + e] = f2bf(st);
        st = st * cd + u[c];
      }
    } else {
#pragma unroll
      for (int c = 31; c >= 0; --c) {
        p.rS()[((size_t)(bh * 32 + c) * 2 + dir) * 4096 + e] = f2bf(st);
        st = st * cd + u[c];
      }
    }
  }
}
DI void ph_ret_c(const Params& p, char* smem, int item) {
  const int tid = otid(), wid = tid >> 6, lane = tid & 63, fr = lane & 15, fq = lane >> 4;
  u16* sQ = reinterpret_cast<u16*>(smem);
  u16* sK = sQ + 128 * 72;
  u16* sVt = sK + 128 * 72;
  u16* sSf = sVt + 64 * 136;
  u16* sSb = sSf + 64 * 72;
  u16* sP = sSb + 64 * 72;
  {
    const int c = item & 31, bh = item >> 5, b = bh >> 2, h = bh & 3;
    const float lg0 = log1pf(-exp2f(-5.f - (float)h)), lg1 = log1pf(-exp2f(-5.5f - (float)h));
    const size_t t0 = (size_t)b * SEQ + c * 128;
    const u16* src = p.proj() + t0 * PWP;
    {
      uint4 rq[2], rk[2], rv[2], rf[1], rb[1];
      stage_rows_ld<128, 64>(rq, src + C_RQ + h * 64, PWP, tid);
      stage_rows_ld<128, 64>(rk, src + C_RK + h * 64, PWP, tid);
      stage_T_ld<64>(rv, src + C_RV + h * 64, PWP, tid);
      stage_rows_ld<64, 64>(rf, p.rS() + ((size_t)(bh * 32 + c) * 2 + 0) * 4096, 64, tid);
      stage_rows_ld<64, 64>(rb, p.rS() + ((size_t)(bh * 32 + c) * 2 + 1) * 4096, 64, tid);
      stage_rows_st<128, 64>(sQ, 72, rq, tid);
      stage_rows_st<128, 64>(sK, 72, rk, tid);
      stage_T_st<64>(sVt, 136, rv, tid, [](int) { return 1.f; });
      stage_rows_st<64, 64>(sSf, 72, rf, tid);
      stage_rows_st<64, 64>(sSb, 72, rb, tid);
    }
    __syncthreads();
    {
      const int wr = wid >> 1, wc = wid & 1;
      f32x4 sacc[2][4];
      zero_acc(sacc);
      wave_mm<2, 4, 2>(sacc, sQ + wr * 32 * 72, 72, sK + wc * 64 * 72, 72, fr, fq);
#pragma unroll
      for (int m = 0; m < 2; ++m)
#pragma unroll
        for (int n = 0; n < 4; ++n)
#pragma unroll
          for (int j = 0; j < 4; ++j) {
            const int i = wr * 32 + m * 16 + fq * 4 + j, jj = wc * 64 + n * 16 + fr;
            const float dcy = (jj <= i) ? __expf(lg0 * (float)(i - jj)) : __expf(lg1 * (float)(jj - i));
            sP[i * 136 + jj] = f2bf(sacc[m][n][j] * dcy);
          }
    }
    __syncthreads();
    {
      f32x4 ai[1][4], af_[1][4], ab_[1][4];
      zero_acc(ai); zero_acc(af_); zero_acc(ab_);
      wave_mm<1, 4, 4>(ai, sP + wid * 16 * 136, 136, sVt, 136, fr, fq);
      wave_mm<1, 4, 2>(af_, sQ + wid * 16 * 72, 72, sSf, 72, fr, fq);
      wave_mm<1, 4, 2>(ab_, sQ + wid * 16 * 72, 72, sSb, 72, fr, fq);
#pragma unroll
      for (int j = 0; j < 4; ++j) {
        const int i = wid * 16 + fq * 4 + j;
        const float xf = __expf(lg0 * (float)(i + 1)), xb = __expf(lg1 * (float)(128 - i));
        float o[4], sum = 0.f;
#pragma unroll
        for (int n = 0; n < 4; ++n) { o[n] = ai[0][n][j] + xf * af_[0][n][j] + xb * ab_[0][n][j]; sum += o[n]; }
#pragma unroll
        for (int sft = 1; sft < 16; sft <<= 1) sum += __shfl_xor(sum, sft);
        const float mu = sum * (1.f / 64.f);
        float var = 0.f;
#pragma unroll
        for (int n = 0; n < 4; ++n) var += (o[n] - mu) * (o[n] - mu);
#pragma unroll
        for (int sft = 1; sft < 16; sft <<= 1) var += __shfl_xor(var, sft);
        const float rs = rsqrtf(var * (1.f / 64.f) + 1e-5f);
#pragma unroll
        for (int n = 0; n < 4; ++n) {
          const float g = bf2f(p.proj()[(t0 + i) * PWP + C_RG + h * 64 + n * 16 + fr]);
          p.mixed()[(t0 + i) * DM + h * 64 + n * 16 + fr] = f2bf(silu(g) * (o[n] - mu) * rs);
        }
      }
    }
    __syncthreads();
  }
}

DI void ssd_local_cumsum(const Params& p, int L, size_t t0, float* cum, float* dtl, int wid, int lane) {
  const int dir = wid >> 2, h = wid & 3;
  const float a = -__expf(p.a_log[L * 8 + dir * 4 + h]);
  float d0, d1;
  if (dir == 0) { d0 = p.dtv()[(t0 + 2 * lane) * 8 + h]; d1 = p.dtv()[(t0 + 2 * lane + 1) * 8 + h]; }
  else { d0 = p.dtv()[(t0 + 127 - 2 * lane) * 8 + 4 + h]; d1 = p.dtv()[(t0 + 126 - 2 * lane) * 8 + 4 + h]; }
  float v0 = d0 * a, v1 = v0 + d1 * a;
  float run = v1;
#pragma unroll
  for (int o = 1; o < 64; o <<= 1) {
    const float u = __shfl_up(run, o);
    if (lane >= o) run += u;
  }
  const float excl = run - v1;
  v0 += excl; v1 += excl;
  float* cr = cum + (dir * 4 + h) * 128;
  float* dr = dtl + (dir * 4 + h) * 128;
  if (dir == 0) { cr[2 * lane] = v0; cr[2 * lane + 1] = v1; dr[2 * lane] = d0; dr[2 * lane + 1] = d1; }
  else { cr[127 - 2 * lane] = v0; cr[126 - 2 * lane] = v1; dr[127 - 2 * lane] = d0; dr[126 - 2 * lane] = d1; }
}

DI void ph_ssd_a(const Params& p, int L, char* smem, int item) {
  const int tid = otid(), wid = tid >> 6, lane = tid & 63, fr = lane & 15, fq = lane >> 4;
  u16* sBt = reinterpret_cast<u16*>(smem);
  u16* sXf = sBt + 2 * 128 * 136;
  u16* sXb = sXf + 64 * 136;
  float* cum = reinterpret_cast<float*>(sXb + 64 * 136);
  float* dtl = cum + 8 * 128;
  {
    const int c = item & 31, b = item >> 5;
    const size_t t0 = (size_t)b * SEQ + c * 128;
    ssd_local_cumsum(p, L, t0, cum, dtl, wid, lane);
    stage_T<256>(sBt, 136, p.xbc() + t0 * 768 + 256, 768, tid, [](int) { return 1.f; });
    __syncthreads();
    if (tid < 8) {
      const int dir = tid >> 2;
      p.cdec()[(size_t)item * 8 + tid] = __expf(dir ? cum[tid * 128 + 0] : cum[tid * 128 + 127]);
    }
    for (int h = 0; h < 4; ++h) {
      const float* cf = cum + h * 128;
      const float* cb = cum + (4 + h) * 128;
      const float* df = dtl + h * 128;
      const float* db = dtl + (4 + h) * 128;
      const float endf = cf[127], endb = cb[0];
      {
        uint4 rx[2];
        stage_T_ld<64>(rx, p.xbc() + t0 * 768 + h * 64, 768, tid);
        stage_T_st<64>(sXf, 136, rx, tid, [&](int l) { return __expf(endf - cf[l]) * df[l]; });
        stage_T_st<64>(sXb, 136, rx, tid, [&](int l) { return __expf(endb - cb[l]) * db[l]; });
      }
      __syncthreads();
      const int dir = wid >> 2, q = wid & 3, g = h >> 1;
      f32x4 acc[4][2];
      zero_acc(acc);
      wave_mm<4, 2, 4>(acc, dir ? sXb : sXf, 136, sBt + (g * 128 + q * 32) * 136, 136, fr, fq);
      float* out = p.sU() + ((size_t)item * 8 + h * 2 + dir) * 8192;
#pragma unroll
      for (int m = 0; m < 4; ++m)
#pragma unroll
        for (int n = 0; n < 2; ++n)
#pragma unroll
          for (int j = 0; j < 4; ++j) out[(m * 16 + fq * 4 + j) * 128 + q * 32 + n * 16 + fr] = acc[m][n][j];
      __syncthreads();
    }
  }
}
DI void ph_ssd_scan(const Params& p) {
  const int gt = obid() * NTHR + otid(), gs = gridDim.x * NTHR;
  for (int it = gt; it < 4 * 8 * 8192; it += gs) {
    const int e = it & 8191, hd = (it >> 13) & 7, b = it >> 16;
    const int dir = hd & 1, h = hd >> 1;
    float u[32];
#pragma unroll
    for (int c = 0; c < 32; ++c) u[c] = p.sU()[((size_t)(b * 32 + c) * 8 + hd) * 8192 + e];
    float st = 0.f;
    if (dir == 0) {
#pragma unroll
      for (int c = 0; c < 32; ++c) {
        p.sS()[((size_t)(b * 32 + c) * 8 + hd) * 8192 + e] = f2bf(st);
        st = st * p.cdec()[(size_t)(b * 32 + c) * 8 + dir * 4 + h] + u[c];
      }
    } else {
#pragma unroll
      for (int c = 31; c >= 0; --c) {
        p.sS()[((size_t)(b * 32 + c) * 8 + hd) * 8192 + e] = f2bf(st);
        st = st * p.cdec()[(size_t)(b * 32 + c) * 8 + dir * 4 + h] + u[c];
      }
    }
  }
}
DI void ph_ssd_c(const Params& p, int L, char* smem, int item) {
  const int tid = otid(), wid = tid >> 6, lane = tid & 63, fr = lane & 15, fq = lane >> 4;
  u16* sC = reinterpret_cast<u16*>(smem);
  u16* sB = sC + 128 * 136;
  u16* sXt = sB + 128 * 136;
  u16* sSf = sXt + 64 * 136;
  u16* sSb = sSf + 64 * 136;
  float* cum = reinterpret_cast<float*>(sSb + 64 * 136);
  float* dtl = cum + 8 * 128;
  {
    const int c = item & 31, b = item >> 5;
    const size_t t0 = (size_t)b * SEQ + c * 128;
    ssd_local_cumsum(p, L, t0, cum, dtl, wid, lane);
    float ssq[4] = {0.f, 0.f, 0.f, 0.f};
#pragma unroll 1
    for (int g = 0; g < 2; ++g) {
      {
        uint4 rc[4], rb4[4];
        stage_rows_ld<128, 128>(rc, p.xbc() + t0 * 768 + 512 + g * 128, 768, tid);
        stage_rows_ld<128, 128>(rb4, p.xbc() + t0 * 768 + 256 + g * 128, 768, tid);
        stage_rows_st<128, 128>(sC, 136, rc, tid);
        stage_rows_st<128, 128>(sB, 136, rb4, tid);
      }
      __syncthreads();
      const int wr = wid >> 1, wc = wid & 1;
      f32x4 G[2][4];
      zero_acc(G);
      wave_mm<2, 4, 4>(G, sC + wr * 32 * 136, 136, sB + wc * 64 * 136, 136, fr, fq);
      __syncthreads();
#pragma unroll 1
      for (int hl = 0; hl < 2; ++hl) {
        const int h = g * 2 + hl;
        const float* cf = cum + h * 128;
        const float* cb = cum + (4 + h) * 128;
        const float* df = dtl + h * 128;
        const float* db = dtl + (4 + h) * 128;
        uint4 rxt[2], rsf[2], rsb[2];
        stage_T_ld<64>(rxt, p.xbc() + t0 * 768 + h * 64, 768, tid);
        stage_rows_ld<64, 128>(rsf, p.sS() + ((size_t)item * 8 + h * 2 + 0) * 8192, 128, tid);
        stage_rows_ld<64, 128>(rsb, p.sS() + ((size_t)item * 8 + h * 2 + 1) * 8192, 128, tid);
#pragma unroll
        for (int m = 0; m < 2; ++m)
#pragma unroll
          for (int n = 0; n < 4; ++n)
#pragma unroll
            for (int j = 0; j < 4; ++j) {
              const int l = wr * 32 + m * 16 + fq * 4 + j, sx = wc * 64 + n * 16 + fr;
              const float w = (sx <= l) ? __expf(cf[l] - cf[sx]) * df[sx] : __expf(cb[l] - cb[sx]) * db[sx];
              sB[l * 136 + sx] = f2bf(G[m][n][j] * w);
            }
        stage_T_st<64>(sXt, 136, rxt, tid, [](int) { return 1.f; });
        stage_rows_st<64, 128>(sSf, 136, rsf, tid);
        stage_rows_st<64, 128>(sSb, 136, rsb, tid);
        __syncthreads();
        f32x4 yd[1][4], yf[1][4], yb[1][4];
        zero_acc(yd); zero_acc(yf); zero_acc(yb);
        wave_mm<1, 4, 4>(yd, sB + wid * 16 * 136, 136, sXt, 136, fr, fq);
        wave_mm<1, 4, 4>(yf, sC + wid * 16 * 136, 136, sSf, 136, fr, fq);
        wave_mm<1, 4, 4>(yb, sC + wid * 16 * 136, 136, sSb, 136, fr, fq);
        const float dsk = p.ssm_d[L * 4 + h];
#pragma unroll
        for (int j = 0; j < 4; ++j) {
          const int l = wid * 16 + fq * 4 + j;
          const float ef = __expf(cf[l]), eb = __expf(cb[l]);
#pragma unroll
          for (int n = 0; n < 4; ++n) {
            const int ch = h * 64 + n * 16 + fr;
            const float xv = bf2f(p.xbc()[(t0 + l) * 768 + ch]);
            const float z = bf2f(p.proj()[(t0 + l) * PWP + C_Z + ch]);
            const float yv = (yd[0][n][j] + ef * yf[0][n][j] + eb * yb[0][n][j] + dsk * xv) * silu(z);
            ssq[j] += yv * yv;
            p.ybuf()[(t0 + l) * 256 + ch] = yv;
          }
        }
        __syncthreads();
      }
    }
    const float* nwt = p.ssm_norm_w + L * 256;
#pragma unroll
    for (int j = 0; j < 4; ++j) {
      float ss = ssq[j];
#pragma unroll
      for (int sft = 1; sft < 16; sft <<= 1) ss += __shfl_xor(ss, sft);
      const float rstd = rsqrtf(ss * (1.f / 256.f) + 1e-6f);
      const int l = wid * 16 + fq * 4 + j;
#pragma unroll
      for (int hn = 0; hn < 16; ++hn) {
        const int ch = hn * 16 + fr;
        p.mixed()[(t0 + l) * DM + 512 + ch] = f2bf(p.ybuf()[(t0 + l) * 256 + ch] * rstd * nwt[ch]);
      }
    }
  }
}

template <bool XIN_F32>
struct CfgOutproj {
  static constexpr bool PERM = true;
  int K; const Params* p; int L; int bid, nb; const void* xin; u16* xout;
  DI bool next(int i, pg8::Unit& u) const { const int t = i * nb + bid; if (t >= 64 * 4) return false; u.pm = t & 63; u.pn = t >> 6; return true; }
  DI const char* a_base(const pg8::Unit& u) const { return (const char*)(p->mixed() + (size_t)u.pm * 256 * DM); }
  DI const char* b_base(const pg8::Unit& u) const { return (const char*)(p->WoutT() + ((size_t)L * DM + (size_t)u.pn * 256) * DM); }
  DI void a_off(const pg8::Unit&, int R0, int C0, int R1, int C1, unsigned (&vo)[4]) const {
    vo[0] = (unsigned)(R0 * DM + C0) * 2u; vo[1] = (unsigned)(R1 * DM + C1) * 2u;
    vo[2] = vo[0] + 128u * DM * 2u; vo[3] = vo[1] + 128u * DM * 2u;
  }
  DI void epi(const f32x4 (&acc)[2][2][4][2], const pg8::Unit& u, int wr, int wc, int fr, int fq) const {
    const int row0 = u.pm * 256 + wr * 64 + fr, col0 = u.pn * 256 + wc * 32 + 8 * fq;
#pragma unroll
    for (int ai = 0; ai < 2; ++ai)
#pragma unroll
      for (int m = 0; m < 4; ++m) {
        const size_t ro = (size_t)(row0 + ai * 128 + m * 16) * DM + col0;
#pragma unroll
        for (int bj = 0; bj < 2; ++bj) {
          const size_t o = ro + bj * 128;
          float4 x0, x1;
          if (XIN_F32) {
            x0 = *reinterpret_cast<const float4*>(static_cast<const float*>(xin) + o);
            x1 = *reinterpret_cast<const float4*>(static_cast<const float*>(xin) + o + 4);
          } else {
            const uint4 q = *reinterpret_cast<const uint4*>(static_cast<const u16*>(xin) + o);
            x0 = bf4_to_f4(make_uint2(q.x, q.y)); x1 = bf4_to_f4(make_uint2(q.z, q.w));
          }
          const f32x4 a0 = acc[ai][bj][m][0], a1 = acc[ai][bj][m][1];
          uint4 w;
          w.x = pack2(x0.x + a0[0], x0.y + a0[1]); w.y = pack2(x0.z + a0[2], x0.w + a0[3]);
          w.z = pack2(x1.x + a1[0], x1.y + a1[1]); w.w = pack2(x1.z + a1[2], x1.w + a1[3]);
          *reinterpret_cast<uint4*>(xout + o) = w;
        }
      }
  }
};
DI void ph_outproj(const Params& p, int L, char* smem) {
  if (L == 0) {
    CfgOutproj<true> c; c.K = DM; c.p = &p; c.L = L; c.bid = obid(); c.nb = gridDim.x; c.xin = p.x; c.xout = p.xres();
    pg8::gemm_phase((pg8::lds_u8*)smem, c);
  } else {
    CfgOutproj<false> c; c.K = DM; c.p = &p; c.L = L; c.bid = obid(); c.nb = gridDim.x; c.xin = p.xres2(); c.xout = p.xres();
    pg8::gemm_phase((pg8::lds_u8*)smem, c);
  }
}

DI void ph_rms2_router(const Params& p, int L, const u16* xres, char* smem) {
  const int tid = otid(), lane = tid & 63, gw = (obid() * NTHR + tid) >> 6, nw = gridDim.x * (NTHR / 64);
  const float* w = p.ln2_w + L * DM;
  const float* rw = p.router_w + (size_t)L * DM * 16;
  float4* srw = reinterpret_cast<float4*>(smem);
  for (int i = tid; i < 4096; i += NTHR) {
    const int c = i >> 2, e4 = i & 3;
    srw[(e4 * 4 + (c & 3)) * 256 + (c >> 2)] = *reinterpret_cast<const float4*>(rw + (size_t)i * 4);
  }
  __syncthreads();
  const int b5 = (lane >> 5) & 1, b4 = (lane >> 4) & 1, b3 = (lane >> 3) & 1, b2 = (lane >> 2) & 1;
  const int my_e = 8 * b5 + 4 * b4 + 2 * b3 + b2;
  float4 v[4];
  if (gw < T) {
#pragma unroll
    for (int i = 0; i < 4; ++i) v[i] = bf4_to_f4(*reinterpret_cast<const uint2*>(xres + (size_t)gw * DM + (i * 64 + lane) * 4));
  }
  for (int t = gw; t < T; t += nw) {
    uint2 vnx[4];
    const int tn = (t + nw < T) ? (t + nw) : t;
#pragma unroll
    for (int i = 0; i < 4; ++i) vnx[i] = *reinterpret_cast<const uint2*>(xres + (size_t)tn * DM + (i * 64 + lane) * 4);
    float ss = 0.f;
#pragma unroll
    for (int i = 0; i < 4; ++i) ss += v[i].x * v[i].x + v[i].y * v[i].y + v[i].z * v[i].z + v[i].w * v[i].w;
    ss = wave_sum(ss);
    const float rstd = rsqrtf(ss * (1.f / DM) + 1e-6f);
    float lg[16];
#pragma unroll
    for (int e = 0; e < 16; ++e) lg[e] = 0.f;
#pragma unroll
    for (int i = 0; i < 4; ++i) {
      const int q = i * 64 + lane;
      const float4 ww = *reinterpret_cast<const float4*>(w + q * 4);
      const float hv[4] = {v[i].x * rstd * ww.x, v[i].y * rstd * ww.y, v[i].z * rstd * ww.z, v[i].w * rstd * ww.w};
      *reinterpret_cast<unsigned*>(p.hn8() + (size_t)t * DM + q * 4) =
          pk4_f8(hv[0] * F8_H_SCALE, hv[1] * F8_H_SCALE, hv[2] * F8_H_SCALE, hv[3] * F8_H_SCALE);
#pragma unroll
      for (int j = 0; j < 4; ++j)
#pragma unroll
        for (int e4 = 0; e4 < 4; ++e4) {
          const float4 r = srw[(e4 * 4 + j) * 256 + q];
          lg[e4 * 4 + 0] += hv[j] * r.x; lg[e4 * 4 + 1] += hv[j] * r.y;
          lg[e4 * 4 + 2] += hv[j] * r.z; lg[e4 * 4 + 3] += hv[j] * r.w;
        }
      __builtin_amdgcn_sched_barrier(0);
    }
#pragma unroll
    for (int k = 0; k < 8; ++k) {
      const float send = b5 ? lg[k] : lg[k + 8], keep = b5 ? lg[k + 8] : lg[k];
      lg[k] = keep + __shfl_xor(send, 32);
    }
#pragma unroll
    for (int k = 0; k < 4; ++k) {
      const float send = b4 ? lg[k] : lg[k + 4], keep = b4 ? lg[k + 4] : lg[k];
      lg[k] = keep + __shfl_xor(send, 16);
    }
#pragma unroll
    for (int k = 0; k < 2; ++k) {
      const float send = b3 ? lg[k] : lg[k + 2], keep = b3 ? lg[k + 2] : lg[k];
      lg[k] = keep + __shfl_xor(send, 8);
    }
    float lv;
    {
      const float send = b2 ? lg[0] : lg[1], keep = b2 ? lg[1] : lg[0];
      lv = keep + __shfl_xor(send, 4);
    }
    lv += __shfl_xor(lv, 2);
    lv += __shfl_xor(lv, 1);
    float mx = lv;
    mx = fmaxf(mx, __shfl_xor(mx, 4)); mx = fmaxf(mx, __shfl_xor(mx, 8));
    mx = fmaxf(mx, __shfl_xor(mx, 16)); mx = fmaxf(mx, __shfl_xor(mx, 32));
    const float ex = expf(lv - mx);
    float den = ex;
    den += __shfl_xor(den, 4); den += __shfl_xor(den, 8); den += __shfl_xor(den, 16); den += __shfl_xor(den, 32);
    if ((lane & 3) == 0) { p.aff()[(size_t)t * 16 + my_e] = ex / den; p.inv()[(size_t)t * 16 + my_e] = -1; }
#pragma unroll
    for (int i = 0; i < 4; ++i) v[i] = bf4_to_f4(vnx[i]);
  }
}

DI int block_sum_i(int v, int* red, int tid) {
#pragma unroll
  for (int o = 32; o > 0; o >>= 1) v += __shfl_xor(v, o);
  __syncthreads();
  if ((tid & 63) == 0) red[tid >> 6] = v;
  __syncthreads();
  int t = 0;
#pragma unroll
  for (int w = 0; w < NTHR / 64; ++w) t += red[w];
  return t;
}
DI void ph_topk(const Params& p, char* smem) {
  int* red = reinterpret_cast<int*>(smem);
  int* wsum = red + 16;
  const int tid = otid(), wid = tid >> 6, lane = tid & 63;
  for (int it = obid(); it < 64; it += gridDim.x) {
    const int e = it & 15, b = it >> 4;
    unsigned v[8];
#pragma unroll
    for (int i = 0; i < 8; ++i) v[i] = __float_as_uint(p.aff()[(size_t)(b * SEQ + tid * 8 + i) * 16 + e]);
    unsigned thr = 0;
#pragma unroll 1
    for (int bit = 30; bit >= 0; --bit) {
      const unsigned cand = thr | (1u << bit);
      int cnt = 0;
#pragma unroll
      for (int i = 0; i < 8; ++i) cnt += (v[i] >= cand) ? 1 : 0;
      if (block_sum_i(cnt, red, tid) >= 512) thr = cand;
    }
    int ngt = 0, ntie = 0;
#pragma unroll
    for (int i = 0; i < 8; ++i) { ngt += (v[i] > thr) ? 1 : 0; ntie += (v[i] == thr) ? 1 : 0; }
    int ig = ngt, itie = ntie;
#pragma unroll
    for (int o = 1; o < 64; o <<= 1) {
      const int a = __shfl_up(ig, o), c = __shfl_up(itie, o);
      if (lane >= o) { ig += a; itie += c; }
    }
    __syncthreads();
    if (lane == 63) { wsum[wid] = ig; wsum[8 + wid] = itie; }
    __syncthreads();
    int og = 0, ot = 0, totg = 0;
#pragma unroll
    for (int w = 0; w < 8; ++w) {
      const int a = wsum[w], c = wsum[8 + w];
      if (w < wid) { og += a; ot += c; }
      totg += a;
    }
    int pg = og + ig - ngt, pt = ot + itie - ntie;
    const int base = (e * 4 + b) * 512;
#pragma unroll
    for (int i = 0; i < 8; ++i) {
      int slot = -1;
      if (v[i] > thr) { slot = pg; ++pg; }
      else if (v[i] == thr) { if (totg + pt < 512) slot = totg + pt; ++pt; }
      if (slot >= 0) {
        p.tok()[base + slot] = b * SEQ + tid * 8 + i;
        p.inv()[(size_t)(b * SEQ + tid * 8 + i) * 16 + e] = base + slot;
        p.gate()[base + slot] = __uint_as_float(v[i]);
      }
    }
    __syncthreads();
  }
}

struct CfgMoe1 {
  static constexpr bool PERM = true;
  int K; const Params* p; int L; int bid, nb;
  DI bool next(int i, pg8::Unit& u) const {
    const int t = i * nb + bid; if (t >= 16 * 16 * 8) return false;
    const int rnd = t >> 8, w = t & 255, xcd = w & 7, jx = w >> 3, pid = xcd * 4 + (jx >> 3);
    const int mt = jx & 7, nt = pid & 15, e = rnd * 2 + (pid >> 4);
    u.pm = e * 8 + mt; u.pn = e * 16 + nt; return true;
  }
  DI const char* a_base(const pg8::Unit&) const { return (const char*)p->hn8(); }
  DI const char* b_base(const pg8::Unit& u) const { return (const char*)(p->Wgu8() + ((size_t)L * 16 * 4096 + (size_t)u.pn * 256) * DM); }
  const int* tokl;
  DI void a_off(const pg8::Unit&, int R0, int C0, int R1, int C1, unsigned (&vo)[4], int ui) const {
    const int* tk = tokl + ui * 256;
    vo[0] = (unsigned)(tk[R0] * 512 + C0) * 2u; vo[1] = (unsigned)(tk[R1] * 512 + C1) * 2u;
    vo[2] = (unsigned)(tk[128 + R0] * 512 + C0) * 2u; vo[3] = (unsigned)(tk[128 + R1] * 512 + C1) * 2u;
  }
  DI void epi(const f32x4 (&acc)[2][2][4][2], const pg8::Unit& u, int wr, int wc, int fr, int fq) const {
    const int row0 = u.pm * 256 + wr * 64 + fr, col0 = (u.pn & 15) * 128 + wc * 32 + 8 * fq;
    const float dq = 1.f / (F8_H_SCALE * F8_W_SCALE);
#pragma unroll
    for (int ai = 0; ai < 2; ++ai)
#pragma unroll
      for (int m = 0; m < 4; ++m) {
        const f32x4 g0 = acc[ai][0][m][0] * dq, g1 = acc[ai][0][m][1] * dq, u0 = acc[ai][1][m][0] * (dq * F8_HID_SCALE), u1 = acc[ai][1][m][1] * (dq * F8_HID_SCALE);
        uint2 w;
        w.x = pk4_f8(fast_silu(g0[0]) * u0[0], fast_silu(g0[1]) * u0[1], fast_silu(g0[2]) * u0[2], fast_silu(g0[3]) * u0[3]);
        w.y = pk4_f8(fast_silu(g1[0]) * u1[0], fast_silu(g1[1]) * u1[1], fast_silu(g1[2]) * u1[2], fast_silu(g1[3]) * u1[3]);
        *reinterpret_cast<uint2*>(p->hid8() + (size_t)(row0 + ai * 128 + m * 16) * 2048 + col0) = w;
      }
  }
};
DI void ph_moe1(const Params& p, int L, char* smem) {
  CfgMoe1 c; c.K = 512; c.p = &p; c.L = L; c.bid = obid(); c.nb = gridDim.x;
  int* tokl = reinterpret_cast<int*>(smem + 131072);
  c.tokl = tokl;
  for (int idx = otid(); idx < 8 * 256; idx += NTHR) {
    pg8::Unit u;
    if (c.next(idx >> 8, u)) tokl[idx] = p.tok()[u.pm * 256 + (idx & 255)];
  }
  __syncthreads();
  pg8::gemm_phase_f8((pg8::lds_u8*)smem, c);
}
struct CfgMoe2 {
  static constexpr bool PERM = true;
  int K; const Params* p; int L; int bid, nb;
  DI bool next(int i, pg8::Unit& u) const {
    const int t = i * nb + bid; if (t >= 16 * 4 * 8) return false;
    const int rnd = t >> 8, w = t & 255, xcd = w & 7, jx = w >> 3, pid = rnd * 32 + xcd * 4 + (jx >> 3);
    u.pm = (pid >> 2) * 8 + (jx & 7); u.pn = pid; return true;
  }
  DI const char* a_base(const pg8::Unit& u) const { return (const char*)(p->hid8() + (size_t)u.pm * 256 * 2048); }
  DI const char* b_base(const pg8::Unit& u) const { return (const char*)(p->Wd8() + ((size_t)L * 16 * DM + (size_t)u.pn * 256) * 2048); }
  DI void a_off(const pg8::Unit&, int R0, int C0, int R1, int C1, unsigned (&vo)[4], int) const {
    vo[0] = (unsigned)(R0 * 1024 + C0) * 2u; vo[1] = (unsigned)(R1 * 1024 + C1) * 2u;
    vo[2] = vo[0] + 128u * 1024u * 2u; vo[3] = vo[1] + 128u * 1024u * 2u;
  }
  DI void epi(const f32x4 (&acc)[2][2][4][2], const pg8::Unit& u, int wr, int wc, int fr, int fq) const {
    u16* eo = p->proj();
    const int row0 = u.pm * 256 + wr * 64 + fr, col0 = (u.pn & 3) * 256 + wc * 32 + 8 * fq;
#pragma unroll
    for (int ai = 0; ai < 2; ++ai)
#pragma unroll
      for (int m = 0; m < 4; ++m) {
        const int row = row0 + ai * 128 + m * 16;
        const float gt = p->gate()[row] * (1.f / (F8_HID_SCALE * F8_W_SCALE));
#pragma unroll
        for (int bj = 0; bj < 2; ++bj) {
          const f32x4 a0 = acc[ai][bj][m][0], a1 = acc[ai][bj][m][1];
          uint4 w;
          w.x = pack2(gt * a0[0], gt * a0[1]); w.y = pack2(gt * a0[2], gt * a0[3]);
          w.z = pack2(gt * a1[0], gt * a1[1]); w.w = pack2(gt * a1[2], gt * a1[3]);
          *reinterpret_cast<uint4*>(eo + (size_t)row * DM + col0 + bj * 128) = w;
        }
      }
  }
};
DI void ph_moe2(const Params& p, int L, char* smem) {
  CfgMoe2 c; c.K = 1024; c.p = &p; c.L = L; c.bid = obid(); c.nb = gridDim.x;
  pg8::gemm_phase_f8((pg8::lds_u8*)smem, c);
}
template <bool FINAL>
DI void ph_combine_norm(const Params& p, const u16* __restrict__ xa, u16* __restrict__ xnew, const float* __restrict__ w,
                        u16* __restrict__ hn_out, float* __restrict__ f_out) {
  const int tid_ = otid(), lane = tid_ & 63, gw = (obid() * NTHR + tid_) >> 6, nw = gridDim.x * (NTHR / 64);
  const u16* eo = p.proj();
  float4 v[4];
  int myrow = -1;
  if (gw < T) {
#pragma unroll
    for (int i = 0; i < 4; ++i) v[i] = bf4_to_f4(*reinterpret_cast<const uint2*>(xa + (size_t)gw * DM + (i * 64 + lane) * 4));
    myrow = (lane < 16) ? p.inv()[(size_t)gw * 16 + lane] : -1;
  }
  for (int t = gw; t < T; t += nw) {
    uint2 vnx[4];
    const int tn = (t + nw < T) ? (t + nw) : t;
#pragma unroll
    for (int i = 0; i < 4; ++i) vnx[i] = *reinterpret_cast<const uint2*>(xa + (size_t)tn * DM + (i * 64 + lane) * 4);
    const int myrow_nx = (lane < 16) ? p.inv()[(size_t)tn * 16 + lane] : -1;
    unsigned long long mask = __builtin_amdgcn_ballot_w64(myrow >= 0);
#pragma unroll 1
    while (mask != 0ull) {
      const int e0 = __builtin_ctzll(mask);
      mask &= mask - 1ull;
      const int r0 = __builtin_amdgcn_readlane(myrow, e0);
      int r1 = -1;
      if (mask != 0ull) { const int e1 = __builtin_ctzll(mask); mask &= mask - 1ull; r1 = __builtin_amdgcn_readlane(myrow, e1); }
      uint2 q0[4], q1[4];
#pragma unroll
      for (int i = 0; i < 4; ++i) q0[i] = *reinterpret_cast<const uint2*>(eo + (size_t)r0 * DM + (i * 64 + lane) * 4);
      const int r1c = (r1 >= 0) ? r1 : r0;
#pragma unroll
      for (int i = 0; i < 4; ++i) q1[i] = *reinterpret_cast<const uint2*>(eo + (size_t)r1c * DM + (i * 64 + lane) * 4);
      const float s1 = (r1 >= 0) ? 1.f : 0.f;
#pragma unroll
      for (int i = 0; i < 4; ++i) {
        v[i].x += __uint_as_float(q0[i].x << 16); v[i].y += __uint_as_float(q0[i].x & 0xffff0000u);
        v[i].z += __uint_as_float(q0[i].y << 16); v[i].w += __uint_as_float(q0[i].y & 0xffff0000u);
        v[i].x += s1 * __uint_as_float(q1[i].x << 16); v[i].y += s1 * __uint_as_float(q1[i].x & 0xffff0000u);
        v[i].z += s1 * __uint_as_float(q1[i].y << 16); v[i].w += s1 * __uint_as_float(q1[i].y & 0xffff0000u);
      }
    }
    float ss = 0.f;
#pragma unroll
    for (int i = 0; i < 4; ++i) ss += v[i].x * v[i].x + v[i].y * v[i].y + v[i].z * v[i].z + v[i].w * v[i].w;
    ss = wave_sum(ss);
    const float rstd = rsqrtf(ss * (1.f / DM) + 1e-6f);
#pragma unroll
    for (int i = 0; i < 4; ++i) {
      const int c = (i * 64 + lane) * 4;
      const float4 ww = *reinterpret_cast<const float4*>(w + c);
      if (FINAL) {
        *reinterpret_cast<float4*>(f_out + (size_t)t * DM + c) = make_float4(v[i].x * rstd * ww.x, v[i].y * rstd * ww.y, v[i].z * rstd * ww.z, v[i].w * rstd * ww.w);
      } else {
        uint2 xo;
        xo.x = pack2(v[i].x, v[i].y); xo.y = pack2(v[i].z, v[i].w);
        *reinterpret_cast<uint2*>(xnew + (size_t)t * DM + c) = xo;
        uint2 o;
        o.x = pack2(v[i].x * rstd * ww.x, v[i].y * rstd * ww.y);
        o.y = pack2(v[i].z * rstd * ww.z, v[i].w * rstd * ww.w);
        *reinterpret_cast<uint2*>(hn_out + (size_t)t * DM + c) = o;
      }
    }
#pragma unroll
    for (int i = 0; i < 4; ++i) v[i] = bf4_to_f4(vnx[i]);
    myrow = myrow_nx;
  }
}

__global__ void __launch_bounds__(NTHR) mk(Params p) {
  extern __shared__ __attribute__((aligned(16))) char smem[];
  cg::grid_group grid = cg::this_grid();
  __shared__ uint4 xb_words;
  if (threadIdx.x == 0) xb_words = make_uint4(0u, 0u, 0u, 0u);
  __syncthreads();
  XcdBarrier xb = xcd_barrier_post(p.bar(), (volatile LAS unsigned*)&xb_words);
  ph_convert(p, smem);
  ph_rmsnorm_bf16(p.x, p.ln1_w, p.hn());
  xcd_barrier(xb);
  if (p.rep[12] == 0x7fffffff) grid.sync();
  for (int L = 0; L < 2; ++L) {
    u16* xout = p.xres();
    if (L == 1) {
      ph_combine_norm<false>(p, p.xres(), p.xres2(), p.ln1_w + DM, p.hn(), nullptr);
      xcd_barrier(xb);
    }
    ph_inproj(p, L, smem);
    xcd_barrier(xb);
    ph_post(p, L);
    xcd_barrier(xb);
    {
      unsigned* ctr = p.bar() + XCD_BAR_WORDS + 8 + L;
      __shared__ int q1_item;
      for (;;) {
        if (threadIdx.x == 0) q1_item = (int)atomicAdd(ctr, 1u);
        __syncthreads();
        const int it = q1_item;
        __syncthreads();
        if (it >= 1344) break;
        if (it < 256) ph_dil_pass<0>(p, smem, it);
        else if (it < 384) ph_ssd_a(p, L, smem, it - 256);
        else if (it < 576) ph_mla_up_q(p, L, smem, it - 384);
        else if (it < 832) ph_mla_up_kv(p, L, smem, it - 576);
        else ph_ret_a(p, smem, it - 832);
      }
    }
    xcd_barrier(xb);
    {
      { ph_ret_scan(p); ph_ssd_scan(p); }
      ph_mla_attn(p, smem, L);
      for (int bi = obid(); bi < 256; bi += gridDim.x) ph_dil_pass<1>(p, smem, bi);
    }
    xcd_barrier(xb);
    {
      unsigned* ctr = p.bar() + XCD_BAR_WORDS + L;
      __shared__ int q_item;
      for (;;) {
        if (threadIdx.x == 0) q_item = (int)atomicAdd(ctr, 1u);
        __syncthreads();
        const int it = q_item;
        __syncthreads();
        if (it >= 640) break;
        if (it < 128) ph_ssd_c(p, L, smem, it);
        else ph_ret_c(p, smem, it - 128);
      }
    }
    xcd_barrier(xb);
    ph_outproj(p, L, smem);
    xcd_barrier(xb);
    ph_rms2_router(p, L, xout, smem);
    xcd_barrier(xb);
    ph_topk(p, smem);
    xcd_barrier(xb);
    ph_moe1(p, L, smem);
    xcd_barrier(xb);
    ph_moe2(p, L, smem);
    xcd_barrier(xb);
  }
  ph_combine_norm<true>(p, p.xres(), nullptr, p.final_w, nullptr, p.out);
}

extern "C" void kernel_launch(void* const* d_in, const int* in_sizes, int n_in, void* d_out, int out_size, void* d_ws,
                              size_t ws_size, hipStream_t stream) {
  static int grid_blocks = 0;
  if (!grid_blocks) {
    int dev = 0, cus = 0, per_cu = 0;
    (void)hipGetDevice(&dev);
    (void)hipDeviceGetAttribute(&cus, hipDeviceAttributeMultiprocessorCount, dev);
    (void)hipFuncSetAttribute((const void*)mk, hipFuncAttributeMaxDynamicSharedMemorySize, LDS_BYTES);
    (void)hipOccupancyMaxActiveBlocksPerMultiprocessor(&per_cu, (const void*)mk, NTHR, LDS_BYTES);
    if (per_cu < 1) { fprintf(stderr, "occupancy query says %d blocks/CU\n", per_cu); per_cu = 1; }
    grid_blocks = cus * 1;
  }
  Params p{};
  const float** fp = reinterpret_cast<const float**>(&p);
  for (int i = 0; i < 20; ++i) fp[i] = (const float*)d_in[i];
  p.out = (float*)d_out;
  p.ws = (char*)d_ws;
  const size_t off = WSO.total;
  { const int reps[16] = REPS_INIT; for (int i = 0; i < 16; ++i) p.rep[i] = reps[i]; }
  if (off > ws_size) { fprintf(stderr, "workspace too small: need %zu have %zu\n", off, ws_size); return; }
  (void)hipMemsetAsync(p.bar(), 0, (size_t)(XCD_BAR_WORDS + 64) * 4, stream);
  void* args[] = {&p};
  hipError_t e = hipLaunchCooperativeKernel((void*)mk, dim3(grid_blocks), dim3(NTHR), args, LDS_BYTES, stream);
  if (e != hipSuccess) fprintf(stderr, "cooperative launch failed: %s (grid %d)\n", hipGetErrorString(e), grid_blocks);
}
```

```cpp
#include <hip/hip_runtime.h>
#include <hip/hip_cooperative_groups.h>
#include <cstdio>
#include <cstdint>
namespace cg = cooperative_groups;

#define DI __device__ __forceinline__
typedef unsigned short u16;
typedef __attribute__((ext_vector_type(8))) short bf16x8;
typedef __attribute__((ext_vector_type(4))) float f32x4;

#ifndef REPS_INIT
#define REPS_INIT {1, 1, 1, 1, 1, 1, 1, 1, 1, 1, 1, 1, 0, 1, 1, 1}
#endif
constexpr int NTHR = 512;
constexpr int T = 16384, SEQ = 4096, DM = 1024;
constexpr int PW = 3240, PWP = 3328;
constexpr int C_RQ = 0, C_RK = 256, C_RV = 512, C_RG = 768, C_CQ = 1024, C_CKV = 1280, C_KR = 1408,
              C_Z = 1440, C_XBC = 1696, C_DT = 2464, C_DQ = 2472, C_DK = 2728, C_DV = 2984;
constexpr int LDS_BYTES = 131072 + 8192;

struct WsOff {
  size_t WinT;
  size_t WuqT;
  size_t WukvT;
  size_t WoutT;
  size_t Wgu8;
  size_t Wd8;
  size_t hn8;
  size_t xres;
  size_t hn;
  size_t proj;
  size_t cqn;
  size_t ckvn;
  size_t mq;
  size_t xbc;
  size_t mixed;
  size_t hid8;
  size_t kfull;
  size_t rS;
  size_t sS;
  size_t rU;
  size_t sU;
  size_t cdec;
  size_t vT;
  size_t rtab;
  size_t dpart;
  size_t dtv;
  size_t cs;
  size_t ybuf;
  size_t aff;
  size_t gate;
  size_t tok;
  size_t inv;
  size_t bar;
  size_t xres2;
  size_t total;
};
constexpr WsOff ws_layout() {
  WsOff o{};
  size_t off = 0;
  o.WinT = off; off += (((size_t)2 * PWP * DM * 2) + 255) & ~(size_t)255;
  o.WuqT = off; off += (((size_t)2 * 384 * 256 * 2) + 255) & ~(size_t)255;
  o.WukvT = off; off += (((size_t)2 * 512 * 128 * 2) + 255) & ~(size_t)255;
  o.WoutT = off; off += (((size_t)2 * DM * DM * 2) + 255) & ~(size_t)255;
  o.Wgu8 = off; off += (((size_t)2 * 16 * 4096 * DM) + 255) & ~(size_t)255;
  o.Wd8 = off; off += (((size_t)2 * 16 * DM * 2048) + 255) & ~(size_t)255;
  o.hn8 = off; off += (((size_t)T * DM) + 255) & ~(size_t)255;
  o.xres = off; off += (((size_t)T * DM * 2) + 255) & ~(size_t)255;
  o.hn = off; off += (((size_t)T * DM * 2) + 255) & ~(size_t)255;
  o.proj = off; off += (((size_t)T * PWP * 2) + 255) & ~(size_t)255;
  o.cqn = off; off += (((size_t)T * 256 * 2) + 255) & ~(size_t)255;
  o.ckvn = off; off += (((size_t)T * 128 * 2) + 255) & ~(size_t)255;
  o.mq = off; off += (((size_t)T * 384 * 2) + 255) & ~(size_t)255;
  o.xbc = off; off += (((size_t)T * 768 * 2) + 255) & ~(size_t)255;
  o.mixed = off; off += (((size_t)T * DM * 2) + 255) & ~(size_t)255;
  o.hid8 = off; off += (((size_t)32768 * 2048) + 255) & ~(size_t)255;
  o.kfull = off; off += (((size_t)T * 4 * 96 * 2) + 255) & ~(size_t)255;
  o.rS = off; off += (((size_t)16 * 32 * 2 * 4096 * 2) + 255) & ~(size_t)255;
  o.sS = off; off += (((size_t)128 * 8 * 8192 * 2) + 255) & ~(size_t)255;
  o.rU = off; off += (((size_t)16 * 32 * 2 * 4096 * 4) + 255) & ~(size_t)255;
  o.sU = off; off += (((size_t)128 * 8 * 8192 * 4) + 255) & ~(size_t)255;
  o.cdec = off; off += (((size_t)128 * 8 * 4) + 255) & ~(size_t)255;
  o.vT = off; off += (((size_t)T * 4 * 64 * 2) + 255) & ~(size_t)255;
  o.rtab = off; off += (((size_t)SEQ * 56 * 2 * 4) + 255) & ~(size_t)255;
  o.dpart = off; off += (((size_t)T * 4 * 68 * 4) + 255) & ~(size_t)255;
  o.dtv = off; off += (((size_t)T * 8 * 4) + 255) & ~(size_t)255;
  o.cs = off; off += (((size_t)T * 8 * 4) + 255) & ~(size_t)255;
  o.ybuf = off; off += (((size_t)T * 256 * 4) + 255) & ~(size_t)255;
  o.aff = off; off += (((size_t)T * 16 * 4) + 255) & ~(size_t)255;
  o.gate = off; off += (((size_t)64 * 512 * 4) + 255) & ~(size_t)255;
  o.tok = off; off += (((size_t)64 * 512 * 4) + 255) & ~(size_t)255;
  o.inv = off; off += (((size_t)T * 16 * 4) + 255) & ~(size_t)255;
  o.bar = off; off += (((size_t)(3456 + 64) * 4) + 255) & ~(size_t)255;
  o.xres2 = off; off += (((size_t)T * DM * 2) + 255) & ~(size_t)255;
  o.total = off;
  return o;
}
constexpr WsOff WSO = ws_layout();
struct Params {
  const float *x, *ln1_w, *w_in, *q_norm_w, *kv_norm_w, *w_uq, *w_ukv, *conv_w, *conv_b, *a_log, *dt_bias,
      *ssm_d, *ssm_norm_w, *w_out, *ln2_w, *router_w, *w_gate, *w_up, *w_down, *final_w;
  float* out;
  char* ws;
  int rep[16];
  __host__ DI u16* WinT() const { return reinterpret_cast<u16*>(ws + WSO.WinT); }
  __host__ DI u16* WuqT() const { return reinterpret_cast<u16*>(ws + WSO.WuqT); }
  __host__ DI u16* WukvT() const { return reinterpret_cast<u16*>(ws + WSO.WukvT); }
  __host__ DI u16* WoutT() const { return reinterpret_cast<u16*>(ws + WSO.WoutT); }
  __host__ DI unsigned char* Wgu8() const { return reinterpret_cast<unsigned char*>(ws + WSO.Wgu8); }
  __host__ DI unsigned char* Wd8() const { return reinterpret_cast<unsigned char*>(ws + WSO.Wd8); }
  __host__ DI unsigned char* hn8() const { return reinterpret_cast<unsigned char*>(ws + WSO.hn8); }
  __host__ DI u16* xres() const { return reinterpret_cast<u16*>(ws + WSO.xres); }
  __host__ DI u16* hn() const { return reinterpret_cast<u16*>(ws + WSO.hn); }
  __host__ DI u16* proj() const { return reinterpret_cast<u16*>(ws + WSO.proj); }
  __host__ DI u16* cqn() const { return reinterpret_cast<u16*>(ws + WSO.cqn); }
  __host__ DI u16* ckvn() const { return reinterpret_cast<u16*>(ws + WSO.ckvn); }
  __host__ DI u16* mq() const { return reinterpret_cast<u16*>(ws + WSO.mq); }
  __host__ DI u16* xbc() const { return reinterpret_cast<u16*>(ws + WSO.xbc); }
  __host__ DI u16* mixed() const { return reinterpret_cast<u16*>(ws + WSO.mixed); }
  __host__ DI unsigned char* hid8() const { return reinterpret_cast<unsigned char*>(ws + WSO.hid8); }
  __host__ DI u16* kfull() const { return reinterpret_cast<u16*>(ws + WSO.kfull); }
  __host__ DI u16* rS() const { return reinterpret_cast<u16*>(ws + WSO.rS); }
  __host__ DI u16* sS() const { return reinterpret_cast<u16*>(ws + WSO.sS); }
  __host__ DI float* rU() const { return reinterpret_cast<float*>(ws + WSO.rU); }
  __host__ DI float* sU() const { return reinterpret_cast<float*>(ws + WSO.sU); }
  __host__ DI float* cdec() const { return reinterpret_cast<float*>(ws + WSO.cdec); }
  __host__ DI u16* vT() const { return reinterpret_cast<u16*>(ws + WSO.vT); }
  __host__ DI float* rtab() const { return reinterpret_cast<float*>(ws + WSO.rtab); }
  __host__ DI float* dpart() const { return reinterpret_cast<float*>(ws + WSO.dpart); }
  __host__ DI float* dtv() const { return reinterpret_cast<float*>(ws + WSO.dtv); }
  __host__ DI float* cs() const { return reinterpret_cast<float*>(ws + WSO.cs); }
  __host__ DI float* ybuf() const { return reinterpret_cast<float*>(ws + WSO.ybuf); }
  __host__ DI float* aff() const { return reinterpret_cast<float*>(ws + WSO.aff); }
  __host__ DI float* gate() const { return reinterpret_cast<float*>(ws + WSO.gate); }
  __host__ DI int* tok() const { return reinterpret_cast<int*>(ws + WSO.tok); }
  __host__ DI int* inv() const { return reinterpret_cast<int*>(ws + WSO.inv); }
  __host__ DI unsigned* bar() const { return reinterpret_cast<unsigned*>(ws + WSO.bar); }
  __host__ DI u16* xres2() const { return reinterpret_cast<u16*>(ws + WSO.xres2); }
};


typedef __attribute__((ext_vector_type(2))) __bf16 bf16x2_t;
typedef __attribute__((ext_vector_type(2))) float f32x2_t;
typedef __attribute__((ext_vector_type(16))) float f32x16;
typedef __attribute__((ext_vector_type(4))) short s16x4;
typedef __attribute__((ext_vector_type(8))) int i32x8;
typedef __attribute__((ext_vector_type(4))) int i32x4;
DI unsigned pack2(float a, float b) {
  f32x2_t v = {a, b};
  return __builtin_bit_cast(unsigned, __builtin_convertvector(v, bf16x2_t));
}
DI u16 f2bf(float f) { return (u16)(pack2(f, 0.f) & 0xffffu); }
DI float bf2f(u16 h) { return __uint_as_float(((unsigned)h) << 16); }
DI void unpack8(const uint4& v, float* f) {
  f[0] = __uint_as_float(v.x << 16); f[1] = __uint_as_float(v.x & 0xffff0000u);
  f[2] = __uint_as_float(v.y << 16); f[3] = __uint_as_float(v.y & 0xffff0000u);
  f[4] = __uint_as_float(v.z << 16); f[5] = __uint_as_float(v.z & 0xffff0000u);
  f[6] = __uint_as_float(v.w << 16); f[7] = __uint_as_float(v.w & 0xffff0000u);
}
DI void ld8(const u16* p, float* f) { uint4 v = *reinterpret_cast<const uint4*>(p); unpack8(v, f); }
DI unsigned pk4_f8(float a, float b, float c, float d) {
  a = __builtin_amdgcn_fmed3f(a, -448.f, 448.f); b = __builtin_amdgcn_fmed3f(b, -448.f, 448.f);
  c = __builtin_amdgcn_fmed3f(c, -448.f, 448.f); d = __builtin_amdgcn_fmed3f(d, -448.f, 448.f);
  int w = __builtin_amdgcn_cvt_pk_fp8_f32(a, b, 0, false);
  w = __builtin_amdgcn_cvt_pk_fp8_f32(c, d, w, true);
  return (unsigned)w;
}
constexpr float F8_W_SCALE = 256.f, F8_H_SCALE = 16.f, F8_HID_SCALE = 8.f;
DI float4 bf4_to_f4(const uint2& q) {
  return make_float4(__uint_as_float(q.x << 16), __uint_as_float(q.x & 0xffff0000u), __uint_as_float(q.y << 16), __uint_as_float(q.y & 0xffff0000u));
}
DI float wave_sum(float v) {
#pragma unroll
  for (int o = 32; o > 0; o >>= 1) v += __shfl_xor(v, o);
  return v;
}
DI float dot2acc(unsigned a, unsigned b, float c) {
  return __builtin_amdgcn_fdot2_f32_bf16(__builtin_bit_cast(bf16x2_t, a), __builtin_bit_cast(bf16x2_t, b), c, false);
}
DI float dot8(const uint4& a, const uint4& b, float c) {
  c = dot2acc(a.x, b.x, c); c = dot2acc(a.y, b.y, c); c = dot2acc(a.z, b.z, c); c = dot2acc(a.w, b.w, c);
  return c;
}
DI int otid() { int t = threadIdx.x; asm volatile("" : "+v"(t)); return t; }
DI int obid() { int b = blockIdx.x; asm volatile("" : "+s"(b)); return b; }
DI float silu(float x) { return x / (1.f + __expf(-x)); }
DI float fast_silu(float x) { return x * __builtin_amdgcn_rcpf(1.f + __expf(-x)); }


#define XB_TMO      128
#define XB_XCNT(j)  (256  + 64 * (j))
#define XB_XSUB(j)  (1280 + 64 * (j))
#define XB_XGEN(j)  (2304 + 64 * (j))
#define XB_TOP      3328
#define XB_TOPGEN   3392
#define XCD_BAR_WORDS 3456
#define XB_SPIN_CAP (1u << 20)
#define LAS __attribute__((address_space(3)))
DI unsigned xb_ld(unsigned* p) { return __hip_atomic_load(p, __ATOMIC_RELAXED, __HIP_MEMORY_SCOPE_AGENT); }
DI unsigned xb_add(unsigned* p, unsigned v) { return __hip_atomic_fetch_add(p, v, __ATOMIC_RELAXED, __HIP_MEMORY_SCOPE_AGENT); }
DI unsigned xb_xcc_id() { return (unsigned)__builtin_amdgcn_s_getreg((3 << 11) | 20) & 0xFu; }
#define XB_SPIN(cond, bar) do { unsigned _sp = 0; while (cond) { __builtin_amdgcn_s_sleep(1); \
    if ((++_sp & 255u) == 0u) { if (xb_ld(&(bar)[XB_TMO])) break; if (_sp > XB_SPIN_CAP) { atomicAdd(&(bar)[XB_TMO], 1u); break; } } } } while (0)
struct XcdBarrier { unsigned* bar; unsigned x; volatile LAS unsigned* st; };
DI XcdBarrier xcd_barrier_post(unsigned* bar, volatile LAS unsigned* st) {
  XcdBarrier b; b.bar = bar; b.x = xb_xcc_id(); b.st = st;
  if (threadIdx.x == 0) (void)xb_add(&bar[XB_XCNT(b.x)], 1u);
  return b;
}
DI void xcd_barrier_complete(unsigned* bar, unsigned x, unsigned& nloc, unsigned& nx) {
  const unsigned G = gridDim.x * gridDim.y * gridDim.z;
  unsigned sum, cnt, mine, sp = 0u;
  for (;;) {
    sum = 0u; cnt = 0u; mine = 0u;
#pragma unroll
    for (unsigned j = 0; j < 16; ++j) { const unsigned c = xb_ld(&bar[XB_XCNT(j)]); sum += c; cnt += (c > 0u) ? 1u : 0u; mine = (j == x) ? c : mine; }
    if (sum == G) break;
    __builtin_amdgcn_s_sleep(1);
    if ((++sp & 255u) == 0u) { if (xb_ld(&bar[XB_TMO])) break; if (sp > XB_SPIN_CAP) { atomicAdd(&bar[XB_TMO], 1u); break; } }
  }
  nloc = mine > 0u ? mine : 1u; nx = cnt > 0u ? cnt : 1u;
}
DI void xcd_barrier(const XcdBarrier& b) {
  asm volatile("s_waitcnt vmcnt(0)" ::: "memory");
  __syncthreads();
  if (threadIdx.x == 0) {
    unsigned* bar = b.bar;
    __builtin_amdgcn_s_waitcnt(0);
    unsigned nloc = b.st[0], nx = b.st[1];
    if (nloc == 0u) { xcd_barrier_complete(bar, b.x, nloc, nx); b.st[0] = nloc; b.st[1] = nx; }
    const unsigned old = xb_add(&bar[XB_XSUB(b.x)], 1u);
    const unsigned gen = old / nloc;
    if (old + 1u == (gen + 1u) * nloc) {
      __builtin_amdgcn_fence(__ATOMIC_RELEASE, "agent");
      asm volatile("s_waitcnt vmcnt(0)" ::: "memory");
      const unsigned og = xb_add(&bar[XB_TOP], 1u);
      const unsigned tg = og / nx;
      if (og + 1u == (tg + 1u) * nx) xb_add(&bar[XB_TOPGEN], 1u);
      else XB_SPIN(xb_ld(&bar[XB_TOPGEN]) == tg, bar);
      __builtin_amdgcn_fence(__ATOMIC_ACQUIRE, "agent");
      xb_add(&bar[XB_XGEN(b.x)], 1u);
      asm volatile("s_waitcnt vmcnt(0)" ::: "memory");
    } else {
      XB_SPIN(xb_ld(&bar[XB_XGEN(b.x)]) == gen, bar);
      __builtin_amdgcn_fence(__ATOMIC_ACQUIRE, "agent");
      asm volatile("s_waitcnt vmcnt(0)" ::: "memory");
    }
  }
  __syncthreads();
}

template <class F>
DI void transpose_convert(const float* __restrict__ src, int K, int N, int Npad, u16* __restrict__ dst, F rowmap,
                          int bid, int nb, char* smem) {
  u16* tile = reinterpret_cast<u16*>(smem);
  const int tid = otid();
  const int ntn = Npad / 128, ntk = K / 64;
  for (int t = bid; t < ntn * ntk; t += nb) {
    const int n0 = (t % ntn) * 128, k0 = (t / ntn) * 64;
    f32x4 v[4];
#pragma unroll
    for (int i = 0; i < 4; ++i) {
      const int kk = (tid >> 5) + 16 * i, nn = (tid & 31) * 4;
      v[i] = f32x4{0.f, 0.f, 0.f, 0.f};
      if (n0 + nn < N) v[i] = __builtin_nontemporal_load(reinterpret_cast<const f32x4*>(src + (size_t)(k0 + kk) * N + n0 + nn));
    }
#pragma unroll
    for (int i = 0; i < 4; ++i) {
      const int kk = (tid >> 5) + 16 * i, nn = (tid & 31) * 4;
      tile[(nn + 0) * 72 + kk] = f2bf(v[i][0]); tile[(nn + 1) * 72 + kk] = f2bf(v[i][1]);
      tile[(nn + 2) * 72 + kk] = f2bf(v[i][2]); tile[(nn + 3) * 72 + kk] = f2bf(v[i][3]);
    }
    __syncthreads();
#pragma unroll
    for (int j = 0; j < 2; ++j) {
      const int c = tid + NTHR * j, nn = c >> 3, k8 = (c & 7) * 8;
      const uint4 o = *reinterpret_cast<const uint4*>(tile + nn * 72 + k8);
      *reinterpret_cast<uint4*>(dst + (size_t)rowmap(n0 + nn) * K + k0 + k8) = o;
    }
    __syncthreads();
  }
}

template <class F>
DI void transpose_convert_f8(const float* __restrict__ src, int K, int N, unsigned char* __restrict__ dst, F rowmap,
                             int bid, int nb, char* smem) {
  unsigned char* tile = reinterpret_cast<unsigned char*>(smem);
  const int tid = otid();
  const int ntn = N / 128, ntk = K / 64;
  for (int t = bid; t < ntn * ntk; t += nb) {
    const int n0 = (t % ntn) * 128, k0 = (t / ntn) * 64;
    const int kq = (tid >> 5) * 4, nn = (tid & 31) * 4;
    f32x4 v[4];
#pragma unroll
    for (int r = 0; r < 4; ++r) v[r] = __builtin_nontemporal_load(reinterpret_cast<const f32x4*>(src + (size_t)(k0 + kq + r) * N + n0 + nn));
#pragma unroll
    for (int e = 0; e < 4; ++e)
      *reinterpret_cast<unsigned*>(tile + (nn + e) * 80 + kq) =
          pk4_f8(v[0][e] * F8_W_SCALE, v[1][e] * F8_W_SCALE, v[2][e] * F8_W_SCALE, v[3][e] * F8_W_SCALE);
    __syncthreads();
    {
      const int rn = tid >> 2, kc = (tid & 3) * 16;
      const uint4 o = *reinterpret_cast<const uint4*>(tile + rn * 80 + kc);
      *reinterpret_cast<uint4*>(dst + (size_t)rowmap(n0 + rn) * K + k0 + kc) = o;
    }
    __syncthreads();
  }
}

constexpr int CVT_IN_MLA_E = 16;
struct CvtTile { const float* src; unsigned char* dst; int N, K, n0, k0, mat; };
DI CvtTile cvt_tile(const Params& p, int L, int g) {
  const int e = g / 768, r = g - e * 768, mat = r >> 8, tt = r & 255;
  const size_t le = (size_t)(L * 16 + e);
  CvtTile c;
  c.mat = mat;
  if (mat < 2) { c.src = ((mat == 0) ? p.w_gate : p.w_up) + le * DM * 2048; c.N = 2048; c.dst = p.Wgu8() + le * 4096 * DM; c.K = 1024; c.n0 = (tt & 15) * 128; c.k0 = (tt >> 4) * 64; }
  else { c.src = p.w_down + le * 2048 * DM; c.N = 1024; c.dst = p.Wd8() + le * DM * 2048; c.K = 2048; c.n0 = (tt & 7) * 128; c.k0 = (tt >> 3) * 64; }
  return c;
}
DI int cvt_rowmap(int mat, int n) { return (mat == 2) ? n : ((n >> 7) * 256 + (mat == 1 ? 128 : 0) + (n & 127)); }

DI void ph_convert(const Params& p, char* smem) {
  const int nb = gridDim.x;
  int bid = obid();
  for (int idx = bid * NTHR + otid(); idx < SEQ * 56; idx += nb * NTHR) {
    const int pos = idx / 56, f = idx - pos * 56;
    float inv;
    if (f < 32) inv = exp2f(-(float)f * (13.287712379549449f / 32.f));
    else if (f < 40) inv = exp2f(-(float)(f - 32) * (18.931568569324174f / 8.f));
    else inv = exp2f(-(float)(f - 40) * (18.931568569324174f / 16.f));
    float sn, cs;
    sincosf((float)pos * inv, &sn, &cs);
    p.rtab()[(size_t)idx * 2] = cs;
    p.rtab()[(size_t)idx * 2 + 1] = sn;
  }
  auto ident = [](int n) { return n; };
  for (int L = 0; L < 2; ++L) {
    transpose_convert(p.w_in + (size_t)L * DM * PW, DM, PW, PWP, p.WinT() + (size_t)L * PWP * DM, ident, bid, nb, smem);
    transpose_convert(p.w_uq + (size_t)L * 256 * 384, 256, 384, 384, p.WuqT() + (size_t)L * 384 * 256, ident, bid, nb, smem);
    transpose_convert(p.w_ukv + (size_t)L * 128 * 512, 128, 512, 512, p.WukvT() + (size_t)L * 512 * 128, ident, bid, nb, smem);
    transpose_convert(p.w_out + (size_t)L * DM * DM, DM, DM, DM, p.WoutT() + (size_t)L * DM * DM, ident, bid, nb, smem);
    for (int e = ((nb == 256) ? CVT_IN_MLA_E : 0); e < 16; ++e) {
      const size_t le = (size_t)(L * 16 + e);
      auto gmap = [](int n) { return (n >> 7) * 256 + (n & 127); };
      auto umap = [](int n) { return (n >> 7) * 256 + 128 + (n & 127); };
      transpose_convert_f8(p.w_gate + le * DM * 2048, DM, 2048, p.Wgu8() + le * 4096 * DM, gmap, bid, nb, smem);
      transpose_convert_f8(p.w_up + le * DM * 2048, DM, 2048, p.Wgu8() + le * 4096 * DM, umap, bid, nb, smem);
      transpose_convert_f8(p.w_down + le * 2048 * DM, 2048, DM, p.Wd8() + le * DM * 2048, ident, bid, nb, smem);
    }
  }
}

template <class RowPtr, class Epi>
DI void gemm_tile(RowPtr arow, const u16* __restrict__ bt, int ldb, int K, char* smem, Epi epi) {
  u16* sa = reinterpret_cast<u16*>(smem);
  u16* sb = sa + 2 * 256 * 72;
  const int tid = otid(), wid = tid >> 6, lane = tid & 63, wr = wid >> 1, wc = wid & 1, fr = lane & 15, fq = lane >> 4;
  f32x4 acc[4][4];
#pragma unroll
  for (int m = 0; m < 4; ++m)
#pragma unroll
    for (int n = 0; n < 4; ++n) acc[m][n] = f32x4{0.f, 0.f, 0.f, 0.f};
  const int lr = tid >> 3, lc = (tid & 7) * 8;
  const u16* ap[4];
#pragma unroll
  for (int i = 0; i < 4; ++i) ap[i] = arow(lr + 64 * i) + lc;
  const u16* bp[2];
#pragma unroll
  for (int i = 0; i < 2; ++i) bp[i] = bt + (size_t)(lr + 64 * i) * ldb + lc;
  uint4 ra[4], rb[2];
  const int nk = K / 64;
#pragma unroll
  for (int i = 0; i < 4; ++i) ra[i] = *reinterpret_cast<const uint4*>(ap[i]);
#pragma unroll
  for (int i = 0; i < 2; ++i) rb[i] = *reinterpret_cast<const uint4*>(bp[i]);
#pragma unroll
  for (int i = 0; i < 4; ++i) *reinterpret_cast<uint4*>(sa + (lr + 64 * i) * 72 + lc) = ra[i];
#pragma unroll
  for (int i = 0; i < 2; ++i) *reinterpret_cast<uint4*>(sb + (lr + 64 * i) * 72 + lc) = rb[i];
  __syncthreads();
  for (int kt = 0; kt < nk; ++kt) {
    const int cur = kt & 1;
    if (kt + 1 < nk) {
#pragma unroll
      for (int i = 0; i < 4; ++i) ra[i] = *reinterpret_cast<const uint4*>(ap[i] + (kt + 1) * 64);
#pragma unroll
      for (int i = 0; i < 2; ++i) rb[i] = *reinterpret_cast<const uint4*>(bp[i] + (kt + 1) * 64);
    }
    const u16* ca = sa + cur * 256 * 72;
    const u16* cb = sb + cur * 128 * 72;
#pragma unroll
    for (int kk = 0; kk < 2; ++kk) {
      bf16x8 af[4], bfr[4];
#pragma unroll
      for (int m = 0; m < 4; ++m) af[m] = *reinterpret_cast<const bf16x8*>(ca + (wr * 64 + m * 16 + fr) * 72 + kk * 32 + fq * 8);
#pragma unroll
      for (int n = 0; n < 4; ++n) bfr[n] = *reinterpret_cast<const bf16x8*>(cb + (wc * 64 + n * 16 + fr) * 72 + kk * 32 + fq * 8);
#pragma unroll
      for (int m = 0; m < 4; ++m)
#pragma unroll
        for (int n = 0; n < 4; ++n) acc[m][n] = __builtin_amdgcn_mfma_f32_16x16x32_bf16(af[m], bfr[n], acc[m][n], 0, 0, 0);
    }
    if (kt + 1 < nk) {
      u16* na = sa + (cur ^ 1) * 256 * 72;
      u16* nbp = sb + (cur ^ 1) * 128 * 72;
#pragma unroll
      for (int i = 0; i < 4; ++i) *reinterpret_cast<uint4*>(na + (lr + 64 * i) * 72 + lc) = ra[i];
#pragma unroll
      for (int i = 0; i < 2; ++i) *reinterpret_cast<uint4*>(nbp + (lr + 64 * i) * 72 + lc) = rb[i];
    }
    __syncthreads();
  }
  epi(acc, wr, wc, fr, fq);
}

#define WAIT_V(n) asm volatile("s_waitcnt vmcnt(%0)" ::"n"(n) : "memory")
DI int lds_byte2(int r, int c) {
  const int st = (r >> 4) * 2 + (c >> 5), ob = (r & 15) * 64 + (c & 31) * 2;
  return st * 1024 + (ob ^ (((ob >> 9) & 1) << 5));
}
DI void stage_rc2(int b, int& R, int& C) {
  const int st = b >> 10, sb = b & 1023, swz = sb ^ (((sb >> 9) & 1) << 5);
  R = (st >> 1) * 16 + swz / 64;
  C = (st & 1) * 32 + (swz % 64) / 2;
}
typedef __attribute__((address_space(3))) unsigned lds_u32;
template <class RowPtr, class Epi>
DI void gemm256(RowPtr arow, const u16* __restrict__ bt, int ldb, int K, char* smem, Epi epi) {
  constexpr int TILE_B = 256 * 64 * 2, STAGE_B = 2 * TILE_B;
  const int tid = otid(), wid = tid >> 6, lane = tid & 63, wr = wid >> 2, wc = wid & 3, fr = lane & 15, fq = lane >> 4;
  const u16* ap[4];
  const u16* bp[4];
#pragma unroll
  for (int i = 0; i < 4; ++i) {
    int R, C;
    stage_rc2(wid * 1024 + i * 8192 + lane * 16, R, C);
    ap[i] = arow(R) + C;
    bp[i] = bt + (size_t)R * ldb + C;
  }
  f32x4 acc[8][4];
#pragma unroll
  for (int m = 0; m < 8; ++m)
#pragma unroll
    for (int n = 0; n < 4; ++n) acc[m][n] = f32x4{0.f, 0.f, 0.f, 0.f};
#define G2_STAGE(buf, kt)                                                                                              \
  do {                                                                                                                 \
    _Pragma("unroll") for (int i = 0; i < 4; ++i) {                                                                    \
      __builtin_amdgcn_global_load_lds((const unsigned*)(ap[i] + (kt) * 64),                                           \
                                       (lds_u32*)(smem + (buf) * STAGE_B + wid * 1024 + i * 8192), 16, 0, 0);          \
      __builtin_amdgcn_global_load_lds((const unsigned*)(bp[i] + (kt) * 64),                                           \
                                       (lds_u32*)(smem + (buf) * STAGE_B + TILE_B + wid * 1024 + i * 8192), 16, 0, 0); \
    }                                                                                                                  \
  } while (0)
  const int nt = K / 64;
  G2_STAGE(0, 0);
  WAIT_V(0);
  __syncthreads();
  for (int t = 0; t < nt; ++t) {
    const int cur = t & 1;
    if (t + 1 < nt) G2_STAGE(cur ^ 1, t + 1);
    const char* sA = smem + cur * STAGE_B;
    const char* sB = sA + TILE_B;
#pragma unroll
    for (int ks = 0; ks < 2; ++ks) {
      bf16x8 At[8], Bf[4];
#pragma unroll
      for (int m = 0; m < 8; ++m) At[m] = *reinterpret_cast<const bf16x8*>(sA + lds_byte2(wr * 128 + m * 16 + fr, ks * 32 + fq * 8));
#pragma unroll
      for (int n = 0; n < 4; ++n) Bf[n] = *reinterpret_cast<const bf16x8*>(sB + lds_byte2(wc * 64 + n * 16 + fr, ks * 32 + fq * 8));
#pragma unroll
      for (int m = 0; m < 8; ++m)
#pragma unroll
        for (int n = 0; n < 4; ++n) acc[m][n] = __builtin_amdgcn_mfma_f32_16x16x32_bf16(Bf[n], At[m], acc[m][n], 0, 0, 0);
      __builtin_amdgcn_sched_barrier(0);
    }
    WAIT_V(0);
    __syncthreads();
  }
  epi(acc, wr, wc, fr, fq);
}

namespace pg8 {
constexpr int BM = 256, BK = 64, HALF = 128, HTB = HALF * BK * 2;
DI int lds_byte(int r, int c) { const int st = (r >> 4) * 2 + (c >> 5), rr = r & 15, cc = c & 31, ob = rr * 64 + cc * 2; return st * 1024 + (ob ^ (((ob >> 9) & 1) << 5)); }
DI void stage_rc(int b, int& R, int& C) { const int st = b / 1024, sb = b % 1024, swz = sb ^ (((sb >> 9) & 1) << 5); R = (st >> 1) * 16 + swz / 64; C = (st & 1) * 32 + (swz % 64) / 2; }
DI int perm32(int rho) { const int n = rho >> 4, i = rho & 15; return 8 * (i >> 2) + 4 * n + (i & 3); }
struct Unit { int pm, pn; };
typedef __attribute__((address_space(3))) unsigned char lds_u8;
typedef __attribute__((address_space(3))) unsigned lds_u32;
typedef __attribute__((address_space(3))) bf16x8 lds_bf16x8;
typedef __attribute__((address_space(3))) i32x4 lds_i32x4;

template <class Cfg>
DI void gemm_phase(lds_u8* lds, const Cfg& S) {
  const int tid = otid(), wid = __builtin_amdgcn_readfirstlane(tid >> 6), lane = tid & 63, wr = wid >> 2, wc = wid & 3, fr = lane & 15, fq = lane >> 4;
  const int K = S.K, nt = K / BK;
  int R0, C0, R1, C1;
  stage_rc(tid * 16, R0, C0);
  stage_rc(tid * 16 + 8192, R1, C1);
  unsigned voffB[2];
  {
    const int Rb0 = Cfg::PERM ? ((R0 & ~31) + perm32(R0 & 31)) : R0, Rb1 = Cfg::PERM ? ((R1 & ~31) + perm32(R1 & 31)) : R1;
    voffB[0] = (unsigned)(Rb0 * K + C0) * 2u; voffB[1] = (unsigned)(Rb1 * K + C1) * 2u;
  }
  const size_t kstep = (size_t)(BK * 2);
  const size_t hstep = (size_t)HALF * K * 2;
  const unsigned ldsw = (unsigned)wid * 1024u;
  const int aoff = lds_byte(wr * 64 + fr, fq * 8), boff = lds_byte(wc * 32 + fr, fq * 8);
#define PG8_SA(b, h) (((b) * 2 + (h)) * HTB)
#define PG8_SB(b, h) ((4 + (b) * 2 + (h)) * HTB)
#define PG8_STAGE2(bufoff, gbase, o0, o1) do { \
    __builtin_amdgcn_global_load_lds((const unsigned*)((const char*)(gbase) + (o0)), (lds_u32*)(lds + (bufoff) + ldsw), 16, 0, 0); \
    __builtin_amdgcn_global_load_lds((const unsigned*)((const char*)(gbase) + (o1)), (lds_u32*)(lds + (bufoff) + ldsw + 8192), 16, 0, 0); } while (0)
#define PG8_STAGEB(bufoff, gbase) PG8_STAGE2(bufoff, gbase, voffB[0], voffB[1])
#define PG8_LDA(dst, b, h) do { _Pragma("unroll") for (int m = 0; m < 4; ++m) _Pragma("unroll") for (int k = 0; k < 2; ++k) dst[m][k] = *(const lds_bf16x8*)(lds + PG8_SA(b, h) + aoff + m * 2048 + k * 1024); } while (0)
#define PG8_LDB(dst, b, h) do { _Pragma("unroll") for (int n = 0; n < 2; ++n) _Pragma("unroll") for (int k = 0; k < 2; ++k) dst[n][k] = *(const lds_bf16x8*)(lds + PG8_SB(b, h) + boff + n * 2048 + k * 1024); } while (0)
#define PG8_MMA(ai, bj, At, Bt) do { __builtin_amdgcn_s_setprio(1); _Pragma("unroll") for (int m = 0; m < 4; ++m) _Pragma("unroll") for (int n = 0; n < 2; ++n) _Pragma("unroll") for (int k = 0; k < 2; ++k) \
    acc[ai][bj][m][n] = __builtin_amdgcn_mfma_f32_16x16x32_bf16(Bt[n][k], At[m][k], acc[ai][bj][m][n], 0, 0, 0); __builtin_amdgcn_s_setprio(0); } while (0)
#define PG8_WAIT_V(n) asm volatile("s_waitcnt vmcnt(" #n ")" ::: "memory")
#define PG8_WAIT_L(n) asm volatile("s_waitcnt lgkmcnt(" #n ")" ::: "memory")
#define PG8_BAR __builtin_amdgcn_s_barrier()
#define PG8_SCHED __builtin_amdgcn_sched_barrier(0)
  Unit cur, nxt; int ui = 0;
  if (!S.next(0, cur)) return;
  f32x4 acc[2][2][4][2];
#pragma unroll
  for (int a = 0; a < 2; ++a)
#pragma unroll
    for (int b = 0; b < 2; ++b)
#pragma unroll
      for (int m = 0; m < 4; ++m)
#pragma unroll
        for (int n = 0; n < 2; ++n) acc[a][b][m][n] = f32x4{0.f, 0.f, 0.f, 0.f};
  bf16x8 At[4][2], B0[2][2], B1[2][2];
  const char* cA = S.a_base(cur);
  const char* cB = S.b_base(cur);
  unsigned vc[4], vn[4];
  S.a_off(cur, R0, C0, R1, C1, vc);
  PG8_STAGEB(PG8_SB(0, 0), cB); PG8_STAGE2(PG8_SA(0, 0), cA, vc[0], vc[1]); PG8_STAGEB(PG8_SB(0, 1), cB + hstep); PG8_STAGE2(PG8_SA(0, 1), cA, vc[2], vc[3]);
  if (wr == 1) PG8_BAR;
  PG8_WAIT_V(4); PG8_BAR;
  PG8_STAGEB(PG8_SB(1, 0), cB + kstep); PG8_STAGE2(PG8_SA(1, 0), cA + kstep, vc[0], vc[1]); PG8_STAGEB(PG8_SB(1, 1), cB + hstep + kstep);
  PG8_WAIT_V(6); PG8_BAR;
  for (;;) {
    const bool has_next = S.next(ui + 1, nxt);
    const char* nA = has_next ? S.a_base(nxt) : cA;
    const char* nB = has_next ? S.b_base(nxt) : cB;
    if (has_next) S.a_off(nxt, R0, C0, R1, C1, vn);
    else { vn[0] = vc[0]; vn[1] = vc[1]; vn[2] = vc[2]; vn[3] = vc[3]; }
    for (int t = 0; t < nt; t += 2) {
      const bool last = (t == nt - 2);
      const char* a1 = cA + (size_t)(t + 1) * kstep;
      const char* a2 = last ? nA : cA + (size_t)(t + 2) * kstep;
      const char* b2 = last ? nB : cB + (size_t)(t + 2) * kstep;
      const char* a3 = a2 + kstep;
      const char* b3 = b2 + kstep;
      const unsigned w0 = last ? vn[0] : vc[0], w1 = last ? vn[1] : vc[1], w2 = last ? vn[2] : vc[2], w3 = last ? vn[3] : vc[3];
      PG8_LDB(B0, 0, 0); PG8_SCHED; PG8_LDA(At, 0, 0); PG8_STAGE2(PG8_SA(1, 1), a1, vc[2], vc[3]);
      PG8_WAIT_L(8); PG8_BAR; PG8_WAIT_L(0); PG8_MMA(0, 0, At, B0); PG8_BAR; PG8_SCHED;
      PG8_LDB(B1, 0, 1); PG8_STAGEB(PG8_SB(0, 0), b2);
      PG8_BAR; PG8_WAIT_L(0); PG8_MMA(0, 1, At, B1); PG8_BAR;
      PG8_LDA(At, 0, 1); PG8_STAGE2(PG8_SA(0, 0), a2, w0, w1);
      PG8_BAR; PG8_WAIT_L(0); PG8_MMA(1, 0, At, B0); PG8_BAR; PG8_SCHED;
      PG8_STAGEB(PG8_SB(0, 1), b2 + hstep);
      PG8_WAIT_V(6); PG8_BAR; PG8_MMA(1, 1, At, B1); PG8_BAR;
      PG8_LDB(B0, 1, 0); PG8_SCHED; PG8_LDA(At, 1, 0); PG8_STAGE2(PG8_SA(0, 1), a2, w2, w3);
      PG8_WAIT_L(8); PG8_BAR; PG8_WAIT_L(0); PG8_MMA(0, 0, At, B0); PG8_BAR; PG8_SCHED;
      PG8_LDB(B1, 1, 1); PG8_STAGEB(PG8_SB(1, 0), b3);
      PG8_BAR; PG8_WAIT_L(0); PG8_MMA(0, 1, At, B1); PG8_BAR;
      PG8_LDA(At, 1, 1); PG8_STAGE2(PG8_SA(1, 0), a3, w0, w1);
      PG8_BAR; PG8_WAIT_L(0); PG8_MMA(1, 0, At, B0); PG8_BAR; PG8_SCHED;
      PG8_STAGEB(PG8_SB(1, 1), b3 + hstep);
      PG8_WAIT_V(6); PG8_BAR; PG8_MMA(1, 1, At, B1); PG8_BAR;
    }
    S.epi(acc, cur, wr, wc, fr, fq);
    if (!has_next) break;
#pragma unroll
    for (int a = 0; a < 2; ++a)
#pragma unroll
      for (int b = 0; b < 2; ++b)
#pragma unroll
        for (int m = 0; m < 4; ++m)
#pragma unroll
          for (int n = 0; n < 2; ++n) acc[a][b][m][n] = f32x4{0.f, 0.f, 0.f, 0.f};
    cur = nxt; cA = nA; cB = nB; ++ui;
    vc[0] = vn[0]; vc[1] = vn[1]; vc[2] = vn[2]; vc[3] = vn[3];
  }
  PG8_WAIT_V(0);
  if (wr == 0) PG8_BAR;
  PG8_BAR;
#undef PG8_SA
#undef PG8_SB
#undef PG8_STAGE2
#undef PG8_STAGEB
#undef PG8_LDA
#undef PG8_LDB
#undef PG8_MMA
#undef PG8_WAIT_V
#undef PG8_WAIT_L
#undef PG8_BAR
#undef PG8_SCHED
}
template <class Cfg>
DI void gemm_phase_f8(lds_u8* lds, const Cfg& S) {
  const int tid = otid(), wid = __builtin_amdgcn_readfirstlane(tid >> 6), lane = tid & 63, wr = wid >> 2, wc = wid & 3, fr = lane & 15, fq = lane >> 4;
  const int K = S.K, nt = K / BK;
  int R0, C0, R1, C1;
  stage_rc(tid * 16, R0, C0);
  stage_rc(tid * 16 + 8192, R1, C1);
  unsigned voffB[2];
  {
    const int Rb0 = Cfg::PERM ? ((R0 & ~31) + perm32(R0 & 31)) : R0, Rb1 = Cfg::PERM ? ((R1 & ~31) + perm32(R1 & 31)) : R1;
    voffB[0] = (unsigned)(Rb0 * K + C0) * 2u; voffB[1] = (unsigned)(Rb1 * K + C1) * 2u;
  }
  const size_t kstep = (size_t)(BK * 2);
  const size_t hstep = (size_t)HALF * K * 2;
  const unsigned ldsw = (unsigned)wid * 1024u;
  const int cl = 2 * fq + (fq & 1), ch = 2 * fq + 1 - (fq & 1);
  const int aoffL = lds_byte(wr * 64 + fr, cl * 8), aoffH = lds_byte(wr * 64 + fr, ch * 8);
  const int boffL = lds_byte(wc * 32 + fr, cl * 8), boffH = lds_byte(wc * 32 + fr, ch * 8);
#define PG8_SA(b, h) (((b) * 2 + (h)) * HTB)
#define PG8_SB(b, h) ((4 + (b) * 2 + (h)) * HTB)
#define PG8_STAGE2(bufoff, gbase, o0, o1) do { \
    __builtin_amdgcn_global_load_lds((const unsigned*)((const char*)(gbase) + (o0)), (lds_u32*)(lds + (bufoff) + ldsw), 16, 0, 0); \
    __builtin_amdgcn_global_load_lds((const unsigned*)((const char*)(gbase) + (o1)), (lds_u32*)(lds + (bufoff) + ldsw + 8192), 16, 0, 0); } while (0)
#define PG8_STAGEB(bufoff, gbase) PG8_STAGE2(bufoff, gbase, voffB[0], voffB[1])
#define PG8_LDA(dst, b, h) do { _Pragma("unroll") for (int m = 0; m < 4; ++m) { const i32x4 lo_ = *(const lds_i32x4*)(lds + PG8_SA(b, h) + aoffL + m * 2048), hi_ = *(const lds_i32x4*)(lds + PG8_SA(b, h) + aoffH + m * 2048); dst[m] = __builtin_shufflevector(lo_, hi_, 0, 1, 2, 3, 4, 5, 6, 7); } } while (0)
#define PG8_LDB(dst, b, h) do { _Pragma("unroll") for (int n = 0; n < 2; ++n) { const i32x4 lo_ = *(const lds_i32x4*)(lds + PG8_SB(b, h) + boffL + n * 2048), hi_ = *(const lds_i32x4*)(lds + PG8_SB(b, h) + boffH + n * 2048); dst[n] = __builtin_shufflevector(lo_, hi_, 0, 1, 2, 3, 4, 5, 6, 7); } } while (0)
#define PG8_MMA(ai, bj, At, Bt) do { __builtin_amdgcn_s_setprio(1); _Pragma("unroll") for (int m = 0; m < 4; ++m) _Pragma("unroll") for (int n = 0; n < 2; ++n) \
    asm volatile("v_mfma_f32_16x16x128_f8f6f4 %0, %1, %2, %0" : "+v"(acc[ai][bj][m][n]) : "v"(Bt[n]), "v"(At[m])); __builtin_amdgcn_s_setprio(0); } while (0)
#define PG8_WAIT_V(n) asm volatile("s_waitcnt vmcnt(" #n ")" ::: "memory")
#define PG8_WAIT_L(n) asm volatile("s_waitcnt lgkmcnt(" #n ")" ::: "memory")
#define PG8_BAR __builtin_amdgcn_s_barrier()
#define PG8_SCHED __builtin_amdgcn_sched_barrier(0)
  Unit cur, nxt; int ui = 0;
  if (!S.next(0, cur)) return;
  f32x4 acc[2][2][4][2];
#pragma unroll
  for (int a = 0; a < 2; ++a)
#pragma unroll
    for (int b = 0; b < 2; ++b)
#pragma unroll
      for (int m = 0; m < 4; ++m)
#pragma unroll
        for (int n = 0; n < 2; ++n) acc[a][b][m][n] = f32x4{0.f, 0.f, 0.f, 0.f};
  i32x8 At[4], B0[2], B1[2];
  const char* cA = S.a_base(cur);
  const char* cB = S.b_base(cur);
  unsigned vc[4], vn[4];
  S.a_off(cur, R0, C0, R1, C1, vc, 0);
  PG8_STAGEB(PG8_SB(0, 0), cB); PG8_STAGE2(PG8_SA(0, 0), cA, vc[0], vc[1]); PG8_STAGEB(PG8_SB(0, 1), cB + hstep); PG8_STAGE2(PG8_SA(0, 1), cA, vc[2], vc[3]);
  if (wr == 1) PG8_BAR;
  PG8_WAIT_V(4); PG8_BAR;
  PG8_STAGEB(PG8_SB(1, 0), cB + kstep); PG8_STAGE2(PG8_SA(1, 0), cA + kstep, vc[0], vc[1]); PG8_STAGEB(PG8_SB(1, 1), cB + hstep + kstep);
  PG8_WAIT_V(6); PG8_BAR;
  for (;;) {
    const bool has_next = S.next(ui + 1, nxt);
    const char* nA = has_next ? S.a_base(nxt) : cA;
    const char* nB = has_next ? S.b_base(nxt) : cB;
    if (has_next) S.a_off(nxt, R0, C0, R1, C1, vn, ui + 1);
    else { vn[0] = vc[0]; vn[1] = vc[1]; vn[2] = vc[2]; vn[3] = vc[3]; }
    for (int t = 0; t < nt; t += 2) {
      const bool last = (t == nt - 2);
      const char* a1 = cA + (size_t)(t + 1) * kstep;
      const char* a2 = last ? nA : cA + (size_t)(t + 2) * kstep;
      const char* b2 = last ? nB : cB + (size_t)(t + 2) * kstep;
      const char* a3 = a2 + kstep;
      const char* b3 = b2 + kstep;
      const unsigned w0 = last ? vn[0] : vc[0], w1 = last ? vn[1] : vc[1], w2 = last ? vn[2] : vc[2], w3 = last ? vn[3] : vc[3];
      PG8_LDB(B0, 0, 0); PG8_SCHED; PG8_LDA(At, 0, 0); PG8_STAGE2(PG8_SA(1, 1), a1, vc[2], vc[3]);
      PG8_WAIT_L(8); PG8_BAR; PG8_WAIT_L(0); PG8_MMA(0, 0, At, B0); PG8_BAR; PG8_SCHED;
      PG8_LDB(B1, 0, 1); PG8_STAGEB(PG8_SB(0, 0), b2);
      PG8_BAR; PG8_WAIT_L(0); PG8_MMA(0, 1, At, B1); PG8_BAR;
      PG8_LDA(At, 0, 1); PG8_STAGE2(PG8_SA(0, 0), a2, w0, w1);
      PG8_BAR; PG8_WAIT_L(0); PG8_MMA(1, 0, At, B0); PG8_BAR; PG8_SCHED;
      PG8_STAGEB(PG8_SB(0, 1), b2 + hstep);
      PG8_WAIT_V(6); PG8_BAR; PG8_MMA(1, 1, At, B1); PG8_BAR;
      PG8_LDB(B0, 1, 0); PG8_SCHED; PG8_LDA(At, 1, 0); PG8_STAGE2(PG8_SA(0, 1), a2, w2, w3);
      PG8_WAIT_L(8); PG8_BAR; PG8_WAIT_L(0); PG8_MMA(0, 0, At, B0); PG8_BAR; PG8_SCHED;
      PG8_LDB(B1, 1, 1); PG8_STAGEB(PG8_SB(1, 0), b3);
      PG8_BAR; PG8_WAIT_L(0); PG8_MMA(0, 1, At, B1); PG8_BAR;
      PG8_LDA(At, 1, 1); PG8_STAGE2(PG8_SA(1, 0), a3, w0, w1);
      PG8_BAR; PG8_WAIT_L(0); PG8_MMA(1, 0, At, B0); PG8_BAR; PG8_SCHED;
      PG8_STAGEB(PG8_SB(1, 1), b3 + hstep);
      PG8_WAIT_V(6); PG8_BAR; PG8_MMA(1, 1, At, B1); PG8_BAR;
    }
    asm volatile("s_nop 15\n\ts_nop 15" ::: "memory");
    S.epi(acc, cur, wr, wc, fr, fq);
    if (!has_next) break;
#pragma unroll
    for (int a = 0; a < 2; ++a)
#pragma unroll
      for (int b = 0; b < 2; ++b)
#pragma unroll
        for (int m = 0; m < 4; ++m)
#pragma unroll
          for (int n = 0; n < 2; ++n) acc[a][b][m][n] = f32x4{0.f, 0.f, 0.f, 0.f};
    cur = nxt; cA = nA; cB = nB; ++ui;
    vc[0] = vn[0]; vc[1] = vn[1]; vc[2] = vn[2]; vc[3] = vn[3];
  }
  PG8_WAIT_V(0);
  if (wr == 0) PG8_BAR;
  PG8_BAR;
#undef PG8_SA
#undef PG8_SB
#undef PG8_STAGE2
#undef PG8_STAGEB
#undef PG8_LDA
#undef PG8_LDB
#undef PG8_MMA
#undef PG8_WAIT_V
#undef PG8_WAIT_L
#undef PG8_BAR
#undef PG8_SCHED
}
}

struct CfgInproj {
  static constexpr bool PERM = true;
  int K; const Params* p; int L; int bid, nb;
  DI bool next(int i, pg8::Unit& u) const { const int t = i * nb + bid; if (t >= 64 * 13) return false; u.pm = t & 63; u.pn = t >> 6; return true; }
  DI const char* a_base(const pg8::Unit& u) const { return (const char*)(p->hn() + (size_t)u.pm * 256 * DM); }
  DI const char* b_base(const pg8::Unit& u) const { return (const char*)(p->WinT() + ((size_t)L * PWP + (size_t)u.pn * 256) * DM); }
  DI void a_off(const pg8::Unit&, int R0, int C0, int R1, int C1, unsigned (&vo)[4]) const {
    vo[0] = (unsigned)(R0 * DM + C0) * 2u; vo[1] = (unsigned)(R1 * DM + C1) * 2u;
    vo[2] = vo[0] + 128u * DM * 2u; vo[3] = vo[1] + 128u * DM * 2u;
  }
  DI void epi(const f32x4 (&acc)[2][2][4][2], const pg8::Unit& u, int wr, int wc, int fr, int fq) const {
    const int row0 = u.pm * 256 + wr * 64 + fr, col0 = u.pn * 256 + wc * 32 + 8 * fq;
#pragma unroll
    for (int ai = 0; ai < 2; ++ai)
#pragma unroll
      for (int m = 0; m < 4; ++m) {
        u16* rowp = p->proj() + (size_t)(row0 + ai * 128 + m * 16) * PWP + col0;
#pragma unroll
        for (int bj = 0; bj < 2; ++bj) {
          uint4 w;
          w.x = pack2(acc[ai][bj][m][0][0], acc[ai][bj][m][0][1]); w.y = pack2(acc[ai][bj][m][0][2], acc[ai][bj][m][0][3]);
          w.z = pack2(acc[ai][bj][m][1][0], acc[ai][bj][m][1][1]); w.w = pack2(acc[ai][bj][m][1][2], acc[ai][bj][m][1][3]);
          *reinterpret_cast<uint4*>(rowp + bj * 128) = w;
        }
      }
  }
};
DI void ph_inproj_tail(const Params& p, int L, char* smem, int t) {
  const int m0 = (t & 63) * 256, n0 = 3072 + (t >> 6) * 128;
  const u16* Bt = p.WinT() + ((size_t)L * PWP + n0) * DM;
  gemm_tile([&](int r) { return p.hn() + (size_t)(m0 + r) * DM; }, Bt, DM, DM, smem,
            [&](f32x4 (&acc)[4][4], int wr, int wc, int fr, int fq) {
#pragma unroll
              for (int m = 0; m < 4; ++m)
#pragma unroll
                for (int n = 0; n < 4; ++n)
#pragma unroll
                  for (int j = 0; j < 4; ++j)
                    p.proj()[(size_t)(m0 + wr * 64 + m * 16 + fq * 4 + j) * PWP + n0 + wc * 64 + n * 16 + fr] = f2bf(acc[m][n][j]);
            });
}
DI void ph_inproj(const Params& p, int L, char* smem) {
  CfgInproj c; c.K = DM; c.p = &p; c.L = L; c.bid = obid(); c.nb = gridDim.x;
  pg8::gemm_phase((pg8::lds_u8*)smem, c);
}

DI void ph_gemm_store_bf16(const u16* A, int lda, const u16* Bt, int K, int M, int N, u16* C, int ldc, char* smem, int rot) {
  const int mt = M / 256, nt = N / 128;
  const int nb = gridDim.x;
  for (int t = (obid() + rot) % nb; t < mt * nt; t += nb) {
    const int m0 = (t % mt) * 256, n0 = (t / mt) * 128;
    gemm_tile([&](int r) { return A + (size_t)(m0 + r) * lda; }, Bt + (size_t)n0 * K, K, K, smem,
              [&](f32x4 (&acc)[4][4], int wr, int wc, int fr, int fq) {
#pragma unroll
                for (int m = 0; m < 4; ++m)
#pragma unroll
                  for (int n = 0; n < 4; ++n)
#pragma unroll
                    for (int j = 0; j < 4; ++j) {
                      const int row = m0 + wr * 64 + m * 16 + fq * 4 + j, col = n0 + wc * 64 + n * 16 + fr;
                      C[(size_t)row * ldc + col] = f2bf(acc[m][n][j]);
                    }
              });
  }
}

DI void ph_rmsnorm_bf16(const float* __restrict__ xin, const float* __restrict__ w, u16* __restrict__ outp) {
  const int tid_ = otid(); const int lane = tid_ & 63, gw = (obid() * NTHR + tid_) >> 6, nw = gridDim.x * (NTHR / 64);
  for (int t = gw; t < T; t += nw) {
    const float* xr = xin + (size_t)t * DM;
    float4 v[4];
    float ss = 0.f;
#pragma unroll
    for (int i = 0; i < 4; ++i) {
      v[i] = *reinterpret_cast<const float4*>(xr + (i * 64 + lane) * 4);
      ss += v[i].x * v[i].x + v[i].y * v[i].y + v[i].z * v[i].z + v[i].w * v[i].w;
    }
    ss = wave_sum(ss);
    const float rstd = rsqrtf(ss * (1.f / DM) + 1e-6f);
#pragma unroll
    for (int i = 0; i < 4; ++i) {
      const int c = (i * 64 + lane) * 4;
      const float4 ww = *reinterpret_cast<const float4*>(w + c);
      uint2 o;
      o.x = pack2(v[i].x * rstd * ww.x, v[i].y * rstd * ww.y);
      o.y = pack2(v[i].z * rstd * ww.z, v[i].w * rstd * ww.w);
      *reinterpret_cast<uint2*>(outp + (size_t)t * DM + c) = o;
    }
  }
}

DI void ph_final_norm(const float* __restrict__ xin, const float* __restrict__ w, float* __restrict__ outp) {
  const int tid_ = otid(); const int lane = tid_ & 63, gw = (obid() * NTHR + tid_) >> 6, nw = gridDim.x * (NTHR / 64);
  for (int t = gw; t < T; t += nw) {
    const float* xr = xin + (size_t)t * DM;
    float4 v[4];
    float ss = 0.f;
#pragma unroll
    for (int i = 0; i < 4; ++i) {
      v[i] = *reinterpret_cast<const float4*>(xr + (i * 64 + lane) * 4);
      ss += v[i].x * v[i].x + v[i].y * v[i].y + v[i].z * v[i].z + v[i].w * v[i].w;
    }
    ss = wave_sum(ss);
    const float rstd = rsqrtf(ss * (1.f / DM) + 1e-6f);
#pragma unroll
    for (int i = 0; i < 4; ++i) {
      const int c = (i * 64 + lane) * 4;
      const float4 ww = *reinterpret_cast<const float4*>(w + c);
      float4 o = make_float4(v[i].x * rstd * ww.x, v[i].y * rstd * ww.y, v[i].z * rstd * ww.z, v[i].w * rstd * ww.w);
      *reinterpret_cast<float4*>(outp + (size_t)t * DM + c) = o;
    }
  }
}

DI void rot8(const u16* x1p, const u16* x2p, const float* tab  , float scale, uint4& o1, uint4& o2) {
  float x1[8], x2[8], y1[8], y2[8];
  ld8(x1p, x1); ld8(x2p, x2);
#pragma unroll
  for (int e = 0; e < 8; e += 2) {
    const float4 cs = *reinterpret_cast<const float4*>(tab + e * 2);
    y1[e] = (x1[e] * cs.x - x2[e] * cs.y) * scale;
    y2[e] = (x2[e] * cs.x + x1[e] * cs.y) * scale;
    y1[e + 1] = (x1[e + 1] * cs.z - x2[e + 1] * cs.w) * scale;
    y2[e + 1] = (x2[e + 1] * cs.z + x1[e + 1] * cs.w) * scale;
  }
  o1.x = pack2(y1[0], y1[1]); o1.y = pack2(y1[2], y1[3]); o1.z = pack2(y1[4], y1[5]); o1.w = pack2(y1[6], y1[7]);
  o2.x = pack2(y2[0], y2[1]); o2.y = pack2(y2[2], y2[3]); o2.z = pack2(y2[4], y2[5]); o2.w = pack2(y2[6], y2[7]);
}
DI void ph_post(const Params& p, int L) {
  const int tid = otid();
  const int gt = obid() * NTHR + tid, gs = gridDim.x * NTHR;
  const int lane = tid & 63, gw = gt >> 6, nw = gs >> 6;
  const float* qnw = p.q_norm_w + L * 256;
  const float* kvnw = p.kv_norm_w + L * 128;
  const float* cw = p.conv_w + L * 5 * 768;
  const float* cb = p.conv_b + L * 768;
  const float* dtb = p.dt_bias + L * 8;
  {
    uint4 xr[5];
    auto load_taps = [&](int idx, uint4 (&r)[5]) {
      const int t = idx / 96, cg = idx - t * 96, s = t & (SEQ - 1);
#pragma unroll
      for (int w = 0; w < 5; ++w) {
        const int ss = s + w - 2;
        const int tt = (ss >= 0 && ss < SEQ) ? (t + w - 2) : t;
        r[w] = *reinterpret_cast<const uint4*>(p.proj() + (size_t)tt * PWP + C_XBC + cg * 8);
      }
    };
    if (gt < T * 96) load_taps(gt, xr);
    for (int idx = gt; idx < T * 96; idx += gs) {
      const int t = idx / 96, cg = idx - t * 96, s = t & (SEQ - 1);
      uint4 xn[5];
      const int idn = (idx + gs < T * 96) ? (idx + gs) : idx;
      load_taps(idn, xn);
      float acc[8];
      {
        const float4 b0 = *reinterpret_cast<const float4*>(cb + cg * 8), b1 = *reinterpret_cast<const float4*>(cb + cg * 8 + 4);
        acc[0] = b0.x; acc[1] = b0.y; acc[2] = b0.z; acc[3] = b0.w; acc[4] = b1.x; acc[5] = b1.y; acc[6] = b1.z; acc[7] = b1.w;
      }
#pragma unroll
      for (int w = 0; w < 5; ++w) {
        const int ss = s + w - 2;
        const float msk = (ss >= 0 && ss < SEQ) ? 1.f : 0.f;
        float xv[8];
        unpack8(xr[w], xv);
        const float4 w0 = *reinterpret_cast<const float4*>(cw + w * 768 + cg * 8), w1 = *reinterpret_cast<const float4*>(cw + w * 768 + cg * 8 + 4);
        acc[0] += msk * xv[0] * w0.x; acc[1] += msk * xv[1] * w0.y; acc[2] += msk * xv[2] * w0.z; acc[3] += msk * xv[3] * w0.w;
        acc[4] += msk * xv[4] * w1.x; acc[5] += msk * xv[5] * w1.y; acc[6] += msk * xv[6] * w1.z; acc[7] += msk * xv[7] * w1.w;
      }
      uint4 o;
      o.x = pack2(fast_silu(acc[0]), fast_silu(acc[1])); o.y = pack2(fast_silu(acc[2]), fast_silu(acc[3]));
      o.z = pack2(fast_silu(acc[4]), fast_silu(acc[5])); o.w = pack2(fast_silu(acc[6]), fast_silu(acc[7]));
      *reinterpret_cast<uint4*>(p.xbc() + (size_t)t * 768 + cg * 8) = o;
#pragma unroll
      for (int w = 0; w < 5; ++w) xr[w] = xn[w];
    }
  }
  for (int idx = gt; idx < T * 8; idx += gs) {
    const int t = idx >> 3, k = idx & 7;
    const float v = bf2f(p.proj()[(size_t)t * PWP + C_DT + k]) + dtb[k];
    p.dtv()[idx] = (v > 20.f) ? v : log1pf(expf(v));
  }
  {
    const int sub = lane >> 4, l16 = lane & 15;
    for (int t = gw * 4 + sub; t < T; t += nw * 4) {
      const u16* pr = p.proj() + (size_t)t * PWP;
      float v[16], u[8];
      ld8(pr + C_CQ + l16 * 16, v); ld8(pr + C_CQ + l16 * 16 + 8, v + 8);
      ld8(pr + C_CKV + l16 * 8, u);
      float ss = 0.f, s2 = 0.f;
#pragma unroll
      for (int i = 0; i < 16; ++i) ss += v[i] * v[i];
#pragma unroll
      for (int i = 0; i < 8; ++i) s2 += u[i] * u[i];
#pragma unroll
      for (int o = 1; o < 16; o <<= 1) { ss += __shfl_xor(ss, o); s2 += __shfl_xor(s2, o); }
      const float rstd = rsqrtf(ss * (1.f / 256.f) + 1e-6f), r2 = rsqrtf(s2 * (1.f / 128.f) + 1e-6f);
      uint4 o;
      const float* qw = qnw + l16 * 16;
      o.x = pack2(v[0] * rstd * qw[0], v[1] * rstd * qw[1]); o.y = pack2(v[2] * rstd * qw[2], v[3] * rstd * qw[3]);
      o.z = pack2(v[4] * rstd * qw[4], v[5] * rstd * qw[5]); o.w = pack2(v[6] * rstd * qw[6], v[7] * rstd * qw[7]);
      *reinterpret_cast<uint4*>(p.cqn() + (size_t)t * 256 + l16 * 16) = o;
      o.x = pack2(v[8] * rstd * qw[8], v[9] * rstd * qw[9]); o.y = pack2(v[10] * rstd * qw[10], v[11] * rstd * qw[11]);
      o.z = pack2(v[12] * rstd * qw[12], v[13] * rstd * qw[13]); o.w = pack2(v[14] * rstd * qw[14], v[15] * rstd * qw[15]);
      *reinterpret_cast<uint4*>(p.cqn() + (size_t)t * 256 + l16 * 16 + 8) = o;
      const float* kw = kvnw + l16 * 8;
      o.x = pack2(u[0] * r2 * kw[0], u[1] * r2 * kw[1]); o.y = pack2(u[2] * r2 * kw[2], u[3] * r2 * kw[3]);
      o.z = pack2(u[4] * r2 * kw[4], u[5] * r2 * kw[5]); o.w = pack2(u[6] * r2 * kw[6], u[7] * r2 * kw[7]);
      *reinterpret_cast<uint4*>(p.ckvn() + (size_t)t * 128 + l16 * 8) = o;
    }
  }
  {
    auto item_of = [&](int idx, u16*& a, int& off2, int& tabo, float& scale, int& krope_i0) {
      const int t = idx / 42, ri = idx - t * 42, s = t & (SEQ - 1);
      u16* pr = p.proj() + (size_t)t * PWP;
      krope_i0 = -1;
      if (ri < 32) {
        const int isk = ri >> 4, h = (ri >> 2) & 3, i0 = (ri & 3) * 8;
        a = pr + (isk ? C_RK : C_RQ) + h * 64 + i0; off2 = 32; tabo = (s * 56 + i0) * 2; scale = isk ? 1.f : 0.125f;
      } else if (ri < 40) {
        const int j = ri - 32, isk = j >> 2, h = j & 3;
        a = pr + (isk ? C_DK : C_DQ) + h * 64; off2 = 8; tabo = (s * 56 + 32) * 2; scale = 1.f;
      } else {
        const int i0 = (ri - 40) * 8;
        a = pr + C_KR + i0; off2 = 16; tabo = (s * 56 + 40 + i0) * 2; scale = 1.f; krope_i0 = i0;
      }
    };
    uint4 x1c = make_uint4(0, 0, 0, 0), x2c = make_uint4(0, 0, 0, 0);
    if (gt < T * 42) {
      u16* a; int off2, tabo, ki; float sc;
      item_of(gt, a, off2, tabo, sc, ki);
      x1c = *reinterpret_cast<const uint4*>(a); x2c = *reinterpret_cast<const uint4*>(a + off2);
    }
    for (int idx = gt; idx < T * 42; idx += gs) {
      u16* a; int off2, tabo, ki; float scale;
      item_of(idx, a, off2, tabo, scale, ki);
      uint4 x1n, x2n;
      {
        const int idn = (idx + gs < T * 42) ? (idx + gs) : idx;
        u16* an; int o2n, tn_, kn; float scn;
        item_of(idn, an, o2n, tn_, scn, kn);
        x1n = *reinterpret_cast<const uint4*>(an); x2n = *reinterpret_cast<const uint4*>(an + o2n);
      }
      float x1[8], x2[8], y1[8], y2[8];
      unpack8(x1c, x1); unpack8(x2c, x2);
      const float* tab = p.rtab() + tabo;
#pragma unroll
      for (int e = 0; e < 8; e += 2) {
        const float4 cs = *reinterpret_cast<const float4*>(tab + e * 2);
        y1[e] = (x1[e] * cs.x - x2[e] * cs.y) * scale;
        y2[e] = (x2[e] * cs.x + x1[e] * cs.y) * scale;
        y1[e + 1] = (x1[e + 1] * cs.z - x2[e + 1] * cs.w) * scale;
        y2[e + 1] = (x2[e + 1] * cs.z + x1[e + 1] * cs.w) * scale;
      }
      uint4 o1, o2;
      o1.x = pack2(y1[0], y1[1]); o1.y = pack2(y1[2], y1[3]); o1.z = pack2(y1[4], y1[5]); o1.w = pack2(y1[6], y1[7]);
      o2.x = pack2(y2[0], y2[1]); o2.y = pack2(y2[2], y2[3]); o2.z = pack2(y2[4], y2[5]); o2.w = pack2(y2[6], y2[7]);
      *reinterpret_cast<uint4*>(a) = o1;
      *reinterpret_cast<uint4*>(a + off2) = o2;
      if (ki >= 0) {
        const int t = idx / 42, s = t & (SEQ - 1), bb = t >> 12;
#pragma unroll
        for (int hd = 0; hd < 4; ++hd) {
          u16* kf = p.kfull() + ((size_t)(bb * 4 + hd) * SEQ + s) * 96 + 64 + ki;
          *reinterpret_cast<uint4*>(kf) = o1;
          *reinterpret_cast<uint4*>(kf + 16) = o2;
        }
      }
      x1c = x1n; x2c = x2n;
    }
  }
}

DI void ph_mla_up_q(const Params& p, int L, char* smem, int t) {
  const int mt = T / 256;
  const u16* Bq = p.WuqT() + (size_t)L * 384 * 256;
  {
    const int m0 = (t % mt) * 256, n0 = (t / mt) * 128;
    gemm_tile([&](int r) { return p.cqn() + (size_t)(m0 + r) * 256; }, Bq + (size_t)n0 * 256, 256, 256, smem,
              [&](f32x4 (&acc)[4][4], int wr, int wc, int fr, int fq) {
                const float scale = 0.10206207261596575f * 1.4426950408889634f;
#pragma unroll
                for (int m = 0; m < 4; ++m)
#pragma unroll
                  for (int j = 0; j < 4; ++j) {
                    const int row = m0 + wr * 64 + m * 16 + fq * 4 + j;
                    const float2 cssn = *reinterpret_cast<const float2*>(p.rtab() + ((size_t)(row & (SEQ - 1)) * 56 + 40 + fr) * 2);
                    const float cs = cssn.x, sn = cssn.y;
#pragma unroll
                    for (int n2 = 0; n2 < 4; n2 += 2) {
                      const int cb = n0 + wc * 64 + n2 * 16;
                      float x1 = acc[m][n2][j], x2 = acc[m][n2 + 1][j];
                      if (cb % 96 == 64) {
                        const float y1 = x1 * cs - x2 * sn, y2 = x2 * cs + x1 * sn;
                        x1 = y1; x2 = y2;
                      }
                      p.mq()[(size_t)row * 384 + cb + fr] = f2bf(x1 * scale);
                      p.mq()[(size_t)row * 384 + cb + 16 + fr] = f2bf(x2 * scale);
                    }
                  }
              });
  }
}
DI void ph_mla_up_kv(const Params& p, int L, char* smem, int t) {
  const int mt = T / 256;
  const u16* Bkv = p.WukvT() + (size_t)L * 512 * 128;
  {
    const int m0 = (t % mt) * 256, h = t / mt, n0 = h * 128;
    gemm_tile([&](int r) { return p.ckvn() + (size_t)(m0 + r) * 128; }, Bkv + (size_t)n0 * 128, 128, 128, smem,
              [&](f32x4 (&acc)[4][4], int wr, int wc, int fr, int fq) {
#pragma unroll
                for (int m = 0; m < 4; ++m) {
                  const int row = m0 + wr * 64 + m * 16 + fq * 4;
                  const int bb = row >> 12, sq = row & (SEQ - 1);
                  const size_t bh = (size_t)(bb * 4 + h);
#pragma unroll
                  for (int n = 0; n < 4; ++n) {
                    if (wc == 0) {
#pragma unroll
                      for (int j = 0; j < 4; ++j) p.kfull()[(bh * SEQ + sq + j) * 96 + n * 16 + fr] = f2bf(acc[m][n][j]);
                    } else {
                      uint2 v;
                      v.x = pack2(acc[m][n][0], acc[m][n][1]);
                      v.y = pack2(acc[m][n][2], acc[m][n][3]);
                      const int sqp = (sq & ~12) | ((sq & 4) << 1) | ((sq & 8) >> 1);
                      *reinterpret_cast<uint2*>(p.vT() + (bh * 64 + n * 16 + fr) * SEQ + sqp) = v;
                    }
                  }
                }
              });
  }
}

DI void ph_cumsum(const Params& p, int L) {
  const int tid_ = otid(); const int lane = tid_ & 63, gw = (obid() * NTHR + tid_) >> 6, nw = gridDim.x * (NTHR / 64);
  for (int it = gw; it < 32; it += nw) {
    const int h = it & 3, dir = (it >> 2) & 1, b = it >> 3;
    const float a = -expf(p.a_log[L * 8 + dir * 4 + h]);
    float running = 0.f;
    for (int c = 0; c < 64; ++c) {
      const int i = c * 64 + lane;
      const int s = dir ? (SEQ - 1 - i) : i;
      const size_t off = (size_t)(b * SEQ + s) * 8 + dir * 4 + h;
      float v = p.dtv()[off] * a;
#pragma unroll
      for (int o = 1; o < 64; o <<= 1) {
        const float u = __shfl_up(v, o);
        if (lane >= o) v += u;
      }
      v += running;
      p.cs()[off] = v;
      running = __shfl(v, 63);
    }
  }
}

DI void ph_ret_naive(const Params& p) {
  const int gt = obid() * NTHR + otid(), gs = gridDim.x * NTHR;
  for (int it = gt; it < 4 * 4 * SEQ; it += gs) {
    const int n = it & (SEQ - 1), h = (it >> 12) & 3, b = it >> 14;
    const u16* base = p.proj() + (size_t)(b * SEQ) * PWP;
    uint4 qp[8];
    float o[64];
#pragma unroll
    for (int d = 0; d < 8; ++d) qp[d] = *reinterpret_cast<const uint4*>(base + (size_t)n * PWP + C_RQ + h * 64 + d * 8);
#pragma unroll
    for (int d = 0; d < 64; ++d) o[d] = 0.f;
    const float lg0 = log1pf(-exp2f(-5.f - (float)h)), lg1 = log1pf(-exp2f(-5.5f - (float)h));
#pragma unroll 1
    for (int m = 0; m < SEQ; ++m) {
      const u16* kr = base + (size_t)m * PWP + C_RK + h * 64;
      const u16* vr = base + (size_t)m * PWP + C_RV + h * 64;
      float s = 0.f;
#pragma unroll
      for (int d = 0; d < 8; ++d) s = dot8(qp[d], *reinterpret_cast<const uint4*>(kr + d * 8), s);
      const float w = (m <= n) ? expf(lg0 * (float)(n - m)) : expf(lg1 * (float)(m - n));
      s *= w;
#pragma unroll
      for (int d = 0; d < 64; d += 8) {
        float vf[8];
        ld8(vr + d, vf);
#pragma unroll
        for (int j = 0; j < 8; ++j) o[d + j] += s * vf[j];
      }
    }
    float mu = 0.f;
#pragma unroll
    for (int d = 0; d < 64; ++d) mu += o[d];
    mu *= (1.f / 64.f);
    float var = 0.f;
#pragma unroll
    for (int d = 0; d < 64; ++d) var += (o[d] - mu) * (o[d] - mu);
    var *= (1.f / 64.f);
    const float rs = rsqrtf(var + 1e-5f);
    const size_t t = (size_t)b * SEQ + n;
#pragma unroll
    for (int d = 0; d < 64; d += 8) {
      float g[8];
      ld8(p.proj() + t * PWP + C_RG + h * 64 + d, g);
      uint4 ov;
      ov.x = pack2(silu(g[0]) * (o[d + 0] - mu) * rs, silu(g[1]) * (o[d + 1] - mu) * rs);
      ov.y = pack2(silu(g[2]) * (o[d + 2] - mu) * rs, silu(g[3]) * (o[d + 3] - mu) * rs);
      ov.z = pack2(silu(g[4]) * (o[d + 4] - mu) * rs, silu(g[5]) * (o[d + 5] - mu) * rs);
      ov.w = pack2(silu(g[6]) * (o[d + 6] - mu) * rs, silu(g[7]) * (o[d + 7] - mu) * rs);
      *reinterpret_cast<uint4*>(p.mixed() + t * DM + h * 64 + d) = ov;
    }
  }
}

DI void ph_mla_naive(const Params& p) {
  const int gt = obid() * NTHR + otid(), gs = gridDim.x * NTHR;
  for (int it = gt; it < 2 * 4 * 4 * SEQ; it += gs) {
    const int n = it & (SEQ - 1), vh = (it >> 12) & 1, h = (it >> 13) & 3, b = it >> 15;
    const size_t t = (size_t)b * SEQ + n;
    uint4 qp[12];
    float o[32];
#pragma unroll
    for (int d = 0; d < 12; ++d) qp[d] = *reinterpret_cast<const uint4*>(p.mq() + t * 384 + h * 96 + d * 8);
    const size_t tb = (size_t)b * SEQ;
    float mx = -1e30f;
#pragma unroll 1
    for (int m = 0; m < SEQ; ++m) {
      const u16* kn = ((u16*)nullptr) + (tb + m) * 512 + h * 128;
      const u16* kr = p.proj() + (tb + m) * PWP + C_KR;
      float s = 0.f;
#pragma unroll
      for (int d = 0; d < 8; ++d) s = dot8(qp[d], *reinterpret_cast<const uint4*>(kn + d * 8), s);
#pragma unroll
      for (int d = 0; d < 4; ++d) s = dot8(qp[8 + d], *reinterpret_cast<const uint4*>(kr + d * 8), s);
      mx = fmaxf(mx, s);
    }
#pragma unroll
    for (int d = 0; d < 32; ++d) o[d] = 0.f;
    float l = 0.f;
#pragma unroll 1
    for (int m = 0; m < SEQ; ++m) {
      const u16* kn = ((u16*)nullptr) + (tb + m) * 512 + h * 128;
      const u16* kr = p.proj() + (tb + m) * PWP + C_KR;
      float s = 0.f;
#pragma unroll
      for (int d = 0; d < 8; ++d) s = dot8(qp[d], *reinterpret_cast<const uint4*>(kn + d * 8), s);
#pragma unroll
      for (int d = 0; d < 4; ++d) s = dot8(qp[8 + d], *reinterpret_cast<const uint4*>(kr + d * 8), s);
      const float pe = exp2f(s - mx);
      l += pe;
#pragma unroll
      for (int d = 0; d < 32; d += 8) {
        float vf[8];
        ld8(kn + 64 + vh * 32 + d, vf);
#pragma unroll
        for (int j = 0; j < 8; ++j) o[d + j] += pe * vf[j];
      }
    }
    const float il = 1.f / l;
#pragma unroll
    for (int d = 0; d < 32; d += 8) {
      uint4 ov;
      ov.x = pack2(o[d + 0] * il, o[d + 1] * il);
      ov.y = pack2(o[d + 2] * il, o[d + 3] * il);
      ov.z = pack2(o[d + 4] * il, o[d + 5] * il);
      ov.w = pack2(o[d + 6] * il, o[d + 7] * il);
      *reinterpret_cast<uint4*>(p.mixed() + t * DM + 256 + h * 64 + vh * 32 + d) = ov;
    }
  }
}

#define MFMA32(a, b, c) __builtin_amdgcn_mfma_f32_32x32x16_bf16((a), (b), (c), 0, 0, 0)
DI float max16(const f32x16& v) {
  float a = fmaxf(fmaxf(v[0], v[1]), v[2]), b = fmaxf(fmaxf(v[3], v[4]), v[5]), c = fmaxf(fmaxf(v[6], v[7]), v[8]);
  float d = fmaxf(fmaxf(v[9], v[10]), v[11]), e = fmaxf(fmaxf(v[12], v[13]), v[14]);
  return fmaxf(fmaxf(fmaxf(a, b), fmaxf(c, d)), fmaxf(e, v[15]));
}
DI void ph_mla_attn(const Params& p, char* smem, int L) {
  const int tid = otid(), wid = tid >> 6, lane = tid & 63, l32 = lane & 31, hh = lane >> 5;
  u16* sK = reinterpret_cast<u16*>(smem);
  u16* sV = sK + 2 * 128 * 104;
  uint4 konev = make_uint4(hh == 0 ? 0x00003F80u : 0u, 0u, 0u, 0u);
  const bf16x8 kone = __builtin_bit_cast(bf16x8, konev);
  for (int item = obid(); item < 256; item += gridDim.x) {
    const int xcd_ = item & 7, jx_ = item >> 3, bh = xcd_ * 2 + (jx_ >> 4), qt = jx_ & 15, b = bh >> 2, h = bh & 3;
    const size_t t0 = (size_t)b * SEQ + qt * 256 + wid * 32;
    bf16x8 qf[6];
#pragma unroll
    for (int ks = 0; ks < 6; ++ks) qf[ks] = *reinterpret_cast<const bf16x8*>(p.mq() + (t0 + l32) * 384 + h * 96 + ks * 16 + hh * 8);
    const u16* kg = p.kfull() + (size_t)bh * SEQ * 96;
    const u16* vg = p.vT() + (size_t)bh * 64 * SEQ;
    f32x16 o0, o1;
#pragma unroll
    for (int i = 0; i < 16; ++i) { o0[i] = 0.f; o1[i] = 0.f; }
    float m = 0.f, l = 0.f;
    bf16x8 qf6 = __builtin_bit_cast(bf16x8, make_uint4(0u, 0u, 0u, 0u));
    const int kr0 = tid / 12, kc0 = tid % 12, kr1 = (512 + tid) / 12, kc1 = (512 + tid) % 12, kr2 = (1024 + tid) / 12, kc2 = (1024 + tid) % 12;
    const int vd0 = tid >> 4, vd1 = 32 + (tid >> 4), vkc = (tid & 15) * 8;
    uint4 ak0, ak1, ak2, av0, av1;
#define MLA_LD(dst_, ptr_) asm volatile("global_load_dwordx4 %0, %1, off" : "=v"(dst_) : "v"(ptr_) : "memory")
#define MLA_GLOAD(K0, K1, K2, V0, V1, kt_)                                               \
    {                                                                                    \
      const u16* kb_ = kg + (size_t)(kt_) * 128 * 96 + tid * 8;                          \
      MLA_LD(K0, kb_); MLA_LD(K1, kb_ + 512 * 8); MLA_LD(K2, kb_ + 1024 * 8);            \
      const u16* vp_ = vg + (size_t)vd0 * SEQ + (kt_) * 128 + vkc;                       \
      MLA_LD(V0, vp_); MLA_LD(V1, vp_ + (size_t)32 * SEQ);                               \
    }
#define MLA_SSTORE(K0, K1, K2, V0, V1, buf_)                                             \
    {                                                                                    \
      u16* kb_ = sK + (buf_) * 128 * 104;                                                \
      u16* vb_ = sV + (buf_) * 64 * 136;                                                 \
      *reinterpret_cast<uint4*>(kb_ + kr0 * 104 + kc0 * 8) = K0;                         \
      *reinterpret_cast<uint4*>(kb_ + kr1 * 104 + kc1 * 8) = K1;                         \
      *reinterpret_cast<uint4*>(kb_ + kr2 * 104 + kc2 * 8) = K2;                         \
      *reinterpret_cast<uint4*>(vb_ + vd0 * 136 + vkc) = V0;                             \
      *reinterpret_cast<uint4*>(vb_ + vd1 * 136 + vkc) = V1;                             \
    }
    float mxrun = 0.f;
#define SGB(mask, n) __builtin_amdgcn_sched_group_barrier((mask), (n), 0)
#define MLA_KFRAG(kb_, sub_, ks_) (*reinterpret_cast<const bf16x8*>((kb_) + ((sub_) * 32 + l32) * 104 + (ks_) * 16 + hh * 8))
#define MLA_VFRAG(dst_, vb_, sub_, ks2_, dvt_) \
    dst_ = *reinterpret_cast<const bf16x8*>((vb_) + ((dvt_) * 32 + l32) * 136 + (sub_) * 32 + (ks2_) * 16 + hh * 8)
#define MLA_SOFTMAX(sc_, pa_, pb_)                                                                         \
    {                                                                                                      \
      mxrun = fmaxf(mxrun, max16(sc_));                                                                    \
      float ps0_ = 0.f, ps1_ = 0.f;                                                                        \
      _Pragma("unroll") for (int i = 0; i < 16; i += 2) {                                                  \
        sc_[i] = __builtin_amdgcn_exp2f(sc_[i]); sc_[i + 1] = __builtin_amdgcn_exp2f(sc_[i + 1]);          \
        ps0_ += sc_[i]; ps1_ += sc_[i + 1];                                                                \
      }                                                                                                    \
      l += ps0_ + ps1_;                                                                                    \
      uint4 pk_;                                                                                           \
      pk_.x = pack2(sc_[0], sc_[1]); pk_.y = pack2(sc_[2], sc_[3]); pk_.z = pack2(sc_[4], sc_[5]); pk_.w = pack2(sc_[6], sc_[7]); \
      pa_ = __builtin_bit_cast(bf16x8, pk_);                                                               \
      pk_.x = pack2(sc_[8], sc_[9]); pk_.y = pack2(sc_[10], sc_[11]); pk_.z = pack2(sc_[12], sc_[13]); pk_.w = pack2(sc_[14], sc_[15]); \
      pb_ = __builtin_bit_cast(bf16x8, pk_);                                                               \
    }
    auto compute_tile = [&](int cur, int half) {
      const u16* kb = sK + cur * 128 * 104 + half * 64 * 104;
      const u16* vb = sV + cur * 64 * 136 + half * 64;
      bf16x8 k0[6], k1[6];
#pragma unroll
      for (int ks = 0; ks < 6; ++ks) { k0[ks] = MLA_KFRAG(kb, 0, ks); k1[ks] = MLA_KFRAG(kb, 1, ks); }
      f32x16 s0, s1;
#pragma unroll
      for (int i = 0; i < 16; ++i) { s0[i] = 0.f; s1[i] = 0.f; }
#pragma unroll
      for (int ks = 0; ks < 6; ++ks) s0 = MFMA32(k0[ks], qf[ks], s0);
      s0 = MFMA32(kone, qf6, s0);
      bf16x8 v00, v01, v02, v03, v10, v11, v12, v13;
      MLA_VFRAG(v00, vb, 0, 0, 0); MLA_VFRAG(v01, vb, 0, 0, 1); MLA_VFRAG(v02, vb, 0, 1, 0); MLA_VFRAG(v03, vb, 0, 1, 1);
#pragma unroll
      for (int ks = 0; ks < 6; ++ks) s1 = MFMA32(k1[ks], qf[ks], s1);
      s1 = MFMA32(kone, qf6, s1);
      MLA_VFRAG(v10, vb, 1, 0, 0); MLA_VFRAG(v11, vb, 1, 0, 1); MLA_VFRAG(v12, vb, 1, 1, 0); MLA_VFRAG(v13, vb, 1, 1, 1);
      bf16x8 p0a, p0b, p1a, p1b;
      MLA_SOFTMAX(s0, p0a, p0b);
      o0 = MFMA32(v00, p0a, o0); o1 = MFMA32(v01, p0a, o1); o0 = MFMA32(v02, p0b, o0); o1 = MFMA32(v03, p0b, o1);
      MLA_SOFTMAX(s1, p1a, p1b);
      o0 = MFMA32(v10, p1a, o0); o1 = MFMA32(v11, p1a, o1); o0 = MFMA32(v12, p1b, o0); o1 = MFMA32(v13, p1b, o1);
      SGB(0x100, 12);
#pragma unroll
      for (int i = 0; i < 7; ++i) { SGB(0x008, 1); if (i < 4) SGB(0x100, 1); }
#pragma unroll
      for (int i = 0; i < 7; ++i) { SGB(0x008, 1); if (i < 4) SGB(0x100, 1); SGB(0x402, 7); }
#pragma unroll
      for (int i = 0; i < 4; ++i) { SGB(0x008, 1); SGB(0x402, 12); }
#pragma unroll
      for (int i = 0; i < 4; ++i) SGB(0x008, 1);
    };
    auto lazy_update = [&]() {
      const float mxr = fmaxf(mxrun, __shfl_xor(mxrun, 32));
      if (__builtin_amdgcn_ballot_w64(mxr > 8.f) != 0ull) {
        float d = (mxr > 8.f) ? mxr : 0.f;
        const float mnew = bf2f(f2bf(m + d));
        d = mnew - m;
        m = mnew;
        const float alpha = __builtin_amdgcn_exp2f(-d);
        l *= alpha;
        mxrun -= d;
#pragma unroll
        for (int i = 0; i < 16; ++i) { o0[i] *= alpha; o1[i] *= alpha; }
        uint4 qv = make_uint4(0u, 0u, 0u, 0u);
        if (hh == 0) qv.x = (unsigned)f2bf(-m);
        qf6 = __builtin_bit_cast(bf16x8, qv);
      }
    };
    unsigned char* cbuf = reinterpret_cast<unsigned char*>(sV + 2 * 64 * 136);
    const bool cvt_on = (gridDim.x == 256);
    f32x4 cv0, cv1, cv2, cv3;
    bool cvalid = false;
#define CVT_ISSUE(j_)                                                                                                   \
    {                                                                                                                   \
      const int g_ = obid() + 256 * (j_);                                                                               \
      cvalid = cvt_on && (g_ < CVT_IN_MLA_E * 768);                                                                     \
      if (cvalid) {                                                                                                     \
        const CvtTile ct_ = cvt_tile(p, L, g_);                                                                         \
        const float* sp_ = ct_.src + (size_t)(ct_.k0 + (tid >> 5) * 4) * ct_.N + ct_.n0 + (tid & 31) * 4;              \
        asm volatile("global_load_dwordx4 %0, %1, off nt" : "=v"(cv0) : "v"(sp_) : "memory");                           \
        asm volatile("global_load_dwordx4 %0, %1, off nt" : "=v"(cv1) : "v"(sp_ + ct_.N) : "memory");                   \
        asm volatile("global_load_dwordx4 %0, %1, off nt" : "=v"(cv2) : "v"(sp_ + 2 * ct_.N) : "memory");               \
        asm volatile("global_load_dwordx4 %0, %1, off nt" : "=v"(cv3) : "v"(sp_ + 3 * ct_.N) : "memory");               \
      }                                                                                                                 \
    }
#define CVT_TO_LDS(par_)                                                                                                \
    if (cvalid) {                                                                                                       \
      unsigned char* cb_ = cbuf + (par_) * 10240 + (tid & 31) * 4 * 80 + (tid >> 5) * 4;                                \
      *reinterpret_cast<unsigned*>(cb_) = pk4_f8(cv0[0] * F8_W_SCALE, cv1[0] * F8_W_SCALE, cv2[0] * F8_W_SCALE, cv3[0] * F8_W_SCALE);       \
      *reinterpret_cast<unsigned*>(cb_ + 80) = pk4_f8(cv0[1] * F8_W_SCALE, cv1[1] * F8_W_SCALE, cv2[1] * F8_W_SCALE, cv3[1] * F8_W_SCALE);  \
      *reinterpret_cast<unsigned*>(cb_ + 160) = pk4_f8(cv0[2] * F8_W_SCALE, cv1[2] * F8_W_SCALE, cv2[2] * F8_W_SCALE, cv3[2] * F8_W_SCALE); \
      *reinterpret_cast<unsigned*>(cb_ + 240) = pk4_f8(cv0[3] * F8_W_SCALE, cv1[3] * F8_W_SCALE, cv2[3] * F8_W_SCALE, cv3[3] * F8_W_SCALE); \
    }
#define CVT_TO_GLOBAL(par_, j_)                                                                                         \
    if (cvalid) {                                                                                                       \
      const CvtTile ct_ = cvt_tile(p, L, obid() + 256 * (j_));        \
      unsigned char* cd_ = ct_.dst + (size_t)cvt_rowmap(ct_.mat, ct_.n0 + (tid >> 2)) * ct_.K + ct_.k0 + (tid & 3) * 16;  \
      *reinterpret_cast<uint4*>(cd_) = *reinterpret_cast<const uint4*>(cbuf + (par_) * 10240 + (tid >> 2) * 80 + (tid & 3) * 16); \
    }
    MLA_GLOAD(ak0, ak1, ak2, av0, av1, 0);
    asm volatile("s_waitcnt vmcnt(0)" ::: "memory");
    MLA_SSTORE(ak0, ak1, ak2, av0, av1, 0);
    __syncthreads();
    {
      f32x16 s0, s1;
#pragma unroll
      for (int i = 0; i < 16; ++i) { s0[i] = 0.f; s1[i] = 0.f; }
#pragma unroll
      for (int ks = 0; ks < 6; ++ks) { s0 = MFMA32(MLA_KFRAG(sK, 0, ks), qf[ks], s0); s1 = MFMA32(MLA_KFRAG(sK, 1, ks), qf[ks], s1); }
      float mx = fmaxf(max16(s0), max16(s1));
      mx = fmaxf(mx, __shfl_xor(mx, 32));
      m = bf2f(f2bf(mx));
      uint4 qv = make_uint4(0u, 0u, 0u, 0u);
      if (hh == 0) qv.x = (unsigned)f2bf(-m);
      qf6 = __builtin_bit_cast(bf16x8, qv);
    }
#pragma unroll 1
    for (int kt = 0; kt < 32; kt += 2) {
#pragma unroll 1
      for (int half = 0; half < 2; ++half) {
        CVT_ISSUE(2 * kt + half);
        if (half == 0) MLA_GLOAD(ak0, ak1, ak2, av0, av1, kt + 1);
        compute_tile(0, half);
        if (half == 0) {
          asm volatile("s_waitcnt vmcnt(5)" ::: "memory");
        } else {
          asm volatile("s_waitcnt vmcnt(0)" ::: "memory");
          MLA_SSTORE(ak0, ak1, ak2, av0, av1, 1);
        }
        asm volatile("" : "+v"(cv0), "+v"(cv1), "+v"(cv2), "+v"(cv3) :: "memory");
        CVT_TO_LDS(half);
        __syncthreads();
        CVT_TO_GLOBAL(half, 2 * kt + half);
      }
      lazy_update();
      const bool more = kt + 2 < 32;
#pragma unroll 1
      for (int half = 0; half < 2; ++half) {
        CVT_ISSUE(2 * kt + 2 + half);
        if (half == 0 && more) MLA_GLOAD(ak0, ak1, ak2, av0, av1, kt + 2);
        compute_tile(1, half);
        if (half == 0 && more) {
          asm volatile("s_waitcnt vmcnt(5)" ::: "memory");
        } else {
          asm volatile("s_waitcnt vmcnt(0)" ::: "memory");
          if (half == 1 && more) MLA_SSTORE(ak0, ak1, ak2, av0, av1, 0);
        }
        asm volatile("" : "+v"(cv0), "+v"(cv1), "+v"(cv2), "+v"(cv3) :: "memory");
        CVT_TO_LDS(half);
        __syncthreads();
        CVT_TO_GLOBAL(half, 2 * kt + 2 + half);
      }
      lazy_update();
    }
    l += __shfl_xor(l, 32);
    const float il = 1.f / l;
    u16* orow = p.mixed() + (t0 + l32) * DM + 256 + h * 64 + hh * 4;
#pragma unroll
    for (int g = 0; g < 4; ++g) {
      uint2 v;
      v.x = pack2(o0[4 * g + 0] * il, o0[4 * g + 1] * il);
      v.y = pack2(o0[4 * g + 2] * il, o0[4 * g + 3] * il);
      *reinterpret_cast<uint2*>(orow + g * 8) = v;
      v.x = pack2(o1[4 * g + 0] * il, o1[4 * g + 1] * il);
      v.y = pack2(o1[4 * g + 2] * il, o1[4 * g + 3] * il);
      *reinterpret_cast<uint2*>(orow + 32 + g * 8) = v;
    }
  }
}

typedef __attribute__((address_space(3))) s16x4 lds_s16x4;
template <int MODE>
DI void ph_dil_pass(const Params& p, char* smem, int blk_) {
  const int tid = otid(), wid = tid >> 6, lane = tid & 63, l32 = lane & 31, hh = lane >> 5;
  u16* sV = reinterpret_cast<u16*>(smem) + wid * (2 * 32 * 72);
  const int i16 = lane & 15, tq = i16 >> 2, tp = i16 & 3, tblk = (lane >> 4) & 1;
  {
    constexpr int NT = (MODE == 0) ? 13 : 5;
    const int it = wid, xcd_ = blk_ & 7, jx_ = blk_ >> 3, bh = xcd_ * 2 + (jx_ >> 4), r = jx_ & 15, b = bh >> 2, h = bh & 3;
    const int i0 = it * 32;
    const int q0 = (r * 8 + it) * 32;
    const int qpos = (MODE == 0) ? (r + 16 * (i0 + l32)) : (q0 + l32);
    const size_t tb = (size_t)b * SEQ;
    const u16* kbase = p.proj() + tb * PWP + C_DK + h * 64;
    const u16* vbase = p.proj() + tb * PWP + C_DV + h * 64;
    bf16x8 qf[4];
    {
      const u16* qp = p.proj() + (tb + qpos) * PWP + C_DQ + h * 64 + hh * 8;
#pragma unroll
      for (int ks = 0; ks < 4; ++ks) qf[ks] = *reinterpret_cast<const bf16x8*>(qp + ks * 16);
    }
    f32x16 o0, o1;
#pragma unroll
    for (int i = 0; i < 16; ++i) { o0[i] = 0.f; o1[i] = 0.f; }
    float m = -1e30f, l = 0.f;
    auto tile_params = [&](int tt, int& d, int& rd, int& ub, int& ulim, int& qb, int& qs) {
      if (MODE == 0) {
        if (tt < 5) { d = 16; rd = r; qb = i0; qs = 1; ulim = 256; ub = qb - 64 + 32 * tt; }
        else { d = 4; rd = r & 3; qb = (r >> 2) + 4 * i0; qs = 4; ulim = 1024; ub = qb - 64 + 32 * (tt - 5); }
      } else { d = 1; rd = 0; qb = q0; qs = 1; ulim = 4096; ub = qb - 64 + 32 * tt; }
    };
    bf16x8 ka0, ka1, ka2, ka3, kb0, kb1, kb2, kb3;
    uint4 va0, va1, va2, va3, vb0, vb1, vb2, vb3;
#define DIL_LD(dst_, ptr_) asm volatile("global_load_dwordx4 %0, %1, off" : "=v"(dst_) : "v"(ptr_) : "memory")
#define DIL_GLOAD(K0, K1, K2, K3, V0, V1, V2, V3, tt_)                                                   \
    {                                                                                                    \
      int d_, rd_, ub_, ulim_, qb_, qs_;                                                                 \
      tile_params((tt_), d_, rd_, ub_, ulim_, qb_, qs_);                                                 \
      int u_ = min(max(ub_ + l32, 0), ulim_ - 1);                                                        \
      const u16* kp_ = kbase + (size_t)(rd_ + d_ * u_) * PWP + hh * 8;                                   \
      DIL_LD(K0, kp_); DIL_LD(K1, kp_ + 16); DIL_LD(K2, kp_ + 32); DIL_LD(K3, kp_ + 48);                 \
      const int kr_ = ub_ + (lane >> 3);                                                                 \
      const u16* vp_;                                                                                    \
      u_ = min(max(kr_, 0), ulim_ - 1);      vp_ = vbase + (size_t)(rd_ + d_ * u_) * PWP + (lane & 7) * 8; DIL_LD(V0, vp_); \
      u_ = min(max(kr_ + 8, 0), ulim_ - 1);  vp_ = vbase + (size_t)(rd_ + d_ * u_) * PWP + (lane & 7) * 8; DIL_LD(V1, vp_); \
      u_ = min(max(kr_ + 16, 0), ulim_ - 1); vp_ = vbase + (size_t)(rd_ + d_ * u_) * PWP + (lane & 7) * 8; DIL_LD(V2, vp_); \
      u_ = min(max(kr_ + 24, 0), ulim_ - 1); vp_ = vbase + (size_t)(rd_ + d_ * u_) * PWP + (lane & 7) * 8; DIL_LD(V3, vp_); \
    }
#define DIL_VSTORE(V0, V1, V2, V3, buf_)                                                                 \
    {                                                                                                    \
      u16* vb_ = sV + (buf_) * 32 * 72 + (lane >> 3) * 72 + (lane & 7) * 8;                              \
      *reinterpret_cast<uint4*>(vb_) = V0;                                                               \
      *reinterpret_cast<uint4*>(vb_ + 8 * 72) = V1;                                                      \
      *reinterpret_cast<uint4*>(vb_ + 16 * 72) = V2;                                                     \
      *reinterpret_cast<uint4*>(vb_ + 24 * 72) = V3;                                                     \
    }
    auto tile_rest = [&](int tt, f32x16 sc, int cur) {
      int d, rd, ub, ulim, qb, qs;
      tile_params(tt, d, rd, ub, ulim, qb, qs);
      const int uq = qb + qs * l32;
      const float cs = 0.125f * 1.4426950408889634f;
      float mx = -1e30f;
#pragma unroll
      for (int i = 0; i < 16; ++i) {
        const int u = ub + (i & 3) + 8 * (i >> 2) + 4 * hh;
        const int du = u - uq;
        const bool valid = (u >= 0) && (u < ulim) && (du <= 64) && (du >= -64);
        sc[i] = valid ? sc[i] * cs : -1e30f;
        mx = fmaxf(mx, sc[i]);
      }
      mx = fmaxf(mx, __shfl_xor(mx, 32));
      const float mn = fmaxf(m, mx);
      const float alpha = __builtin_amdgcn_exp2f(m - mn);
      m = mn;
      float ps = 0.f;
#pragma unroll
      for (int i = 0; i < 16; ++i) {
        float pe = __builtin_amdgcn_exp2f(sc[i] - mn);
        pe = (sc[i] > -1e29f) ? pe : 0.f;
        ps += pe;
        sc[i] = pe;
      }
      l = l * alpha + ps;
#pragma unroll
      for (int i = 0; i < 16; ++i) { o0[i] *= alpha; o1[i] *= alpha; }
      const u16* vb = sV + cur * 32 * 72;
#pragma unroll
      for (int ks2 = 0; ks2 < 2; ++ks2) {
        uint4 pk;
        pk.x = pack2(sc[8 * ks2 + 0], sc[8 * ks2 + 1]);
        pk.y = pack2(sc[8 * ks2 + 2], sc[8 * ks2 + 3]);
        pk.z = pack2(sc[8 * ks2 + 4], sc[8 * ks2 + 5]);
        pk.w = pack2(sc[8 * ks2 + 6], sc[8 * ks2 + 7]);
        const bf16x8 pb = __builtin_bit_cast(bf16x8, pk);
#pragma unroll
        for (int dvt = 0; dvt < 2; ++dvt) {
          const u16* a0 = vb + (16 * ks2 + 4 * hh + tq) * 72 + dvt * 32 + tblk * 16 + tp * 4;
          const s16x4 lo = __builtin_amdgcn_ds_read_tr16_b64_v4i16((lds_s16x4*)(a0));
          const s16x4 hi = __builtin_amdgcn_ds_read_tr16_b64_v4i16((lds_s16x4*)(a0 + 8 * 72));
          const bf16x8 a = __builtin_shufflevector(lo, hi, 0, 1, 2, 3, 4, 5, 6, 7);
          if (dvt == 0) o0 = MFMA32(a, pb, o0); else o1 = MFMA32(a, pb, o1);
        }
      }
    };
    DIL_GLOAD(ka0, ka1, ka2, ka3, va0, va1, va2, va3, 0);
    DIL_GLOAD(kb0, kb1, kb2, kb3, vb0, vb1, vb2, vb3, 1);
    asm volatile("s_waitcnt vmcnt(8)" ::: "memory");
    DIL_VSTORE(va0, va1, va2, va3, 0);
#pragma unroll 1
    for (int tt = 0; tt < NT; tt += 2) {
      {
        f32x16 sc;
#pragma unroll
        for (int i = 0; i < 16; ++i) sc[i] = 0.f;
        sc = MFMA32(ka0, qf[0], sc); sc = MFMA32(ka1, qf[1], sc); sc = MFMA32(ka2, qf[2], sc); sc = MFMA32(ka3, qf[3], sc);
        asm volatile("" :: "v"(sc));
        if (tt + 2 < NT) DIL_GLOAD(ka0, ka1, ka2, ka3, va0, va1, va2, va3, tt + 2);
        tile_rest(tt, sc, 0);
        if (tt + 1 < NT) {
          if (tt + 2 < NT) asm volatile("s_waitcnt vmcnt(8)" ::: "memory"); else asm volatile("s_waitcnt vmcnt(0)" ::: "memory");
          DIL_VSTORE(vb0, vb1, vb2, vb3, 1);
        }
      }
      if (tt + 1 < NT) {
        f32x16 sc;
#pragma unroll
        for (int i = 0; i < 16; ++i) sc[i] = 0.f;
        sc = MFMA32(kb0, qf[0], sc); sc = MFMA32(kb1, qf[1], sc); sc = MFMA32(kb2, qf[2], sc); sc = MFMA32(kb3, qf[3], sc);
        asm volatile("" :: "v"(sc));
        if (tt + 3 < NT) DIL_GLOAD(kb0, kb1, kb2, kb3, vb0, vb1, vb2, vb3, tt + 3);
        tile_rest(tt + 1, sc, 1);
        if (tt + 2 < NT) {
          if (tt + 3 < NT) asm volatile("s_waitcnt vmcnt(8)" ::: "memory"); else asm volatile("s_waitcnt vmcnt(0)" ::: "memory");
          DIL_VSTORE(va0, va1, va2, va3, 0);
        }
      }
    }
    l += __shfl_xor(l, 32);
    float* part = p.dpart() + ((tb + qpos) * 4 + h) * 68 + hh * 4;
    if (MODE == 0) {
#pragma unroll
      for (int g = 0; g < 4; ++g) {
        *reinterpret_cast<float4*>(part + g * 8) = make_float4(o0[4 * g + 0], o0[4 * g + 1], o0[4 * g + 2], o0[4 * g + 3]);
        *reinterpret_cast<float4*>(part + 32 + g * 8) = make_float4(o1[4 * g + 0], o1[4 * g + 1], o1[4 * g + 2], o1[4 * g + 3]);
      }
      if (hh == 0) { part[64] = m; part[65] = l; }
    } else {
      const float mA = part[64 - hh * 4], lA = part[65 - hh * 4];
      const float M = fmaxf(m, mA), sa = __builtin_amdgcn_exp2f(m - M), sb = __builtin_amdgcn_exp2f(mA - M);
      const float il = 1.f / (l * sa + lA * sb);
      u16* orow = p.mixed() + (tb + qpos) * DM + 768 + h * 64 + hh * 4;
#pragma unroll
      for (int g = 0; g < 4; ++g) {
        const float4 a0 = *reinterpret_cast<const float4*>(part + g * 8), a1 = *reinterpret_cast<const float4*>(part + 32 + g * 8);
        uint2 v;
        v.x = pack2((o0[4 * g + 0] * sa + a0.x * sb) * il, (o0[4 * g + 1] * sa + a0.y * sb) * il);
        v.y = pack2((o0[4 * g + 2] * sa + a0.z * sb) * il, (o0[4 * g + 3] * sa + a0.w * sb) * il);
        *reinterpret_cast<uint2*>(orow + g * 8) = v;
        v.x = pack2((o1[4 * g + 0] * sa + a1.x * sb) * il, (o1[4 * g + 1] * sa + a1.y * sb) * il);
        v.y = pack2((o1[4 * g + 2] * sa + a1.z * sb) * il, (o1[4 * g + 3] * sa + a1.w * sb) * il);
        *reinterpret_cast<uint2*>(orow + 32 + g * 8) = v;
      }
    }
  }
}

DI void ph_dil_naive(const Params& p) {
  const int gt = obid() * NTHR + otid(), gs = gridDim.x * NTHR;
  for (int it = gt; it < 4 * 4 * SEQ; it += gs) {
    const int n = it & (SEQ - 1), h = (it >> 12) & 3, b = it >> 14;
    const size_t tb = (size_t)b * SEQ;
    uint4 qp[8];
    float o[64];
#pragma unroll
    for (int d = 0; d < 8; ++d) qp[d] = *reinterpret_cast<const uint4*>(p.proj() + (tb + n) * PWP + C_DQ + h * 64 + d * 8);
    float mx = -1e30f;
    for (int pat = 0; pat < 3; ++pat) {
      const int dil = (pat == 0) ? 1 : (pat == 1 ? 4 : 16);
#pragma unroll 1
      for (int j = -64; j <= 64; ++j) {
        const int pos = n + j * dil;
        if (pos < 0 || pos >= SEQ) continue;
        const u16* kr = p.proj() + (tb + pos) * PWP + C_DK + h * 64;
        float s = 0.f;
#pragma unroll
        for (int d = 0; d < 8; ++d) s = dot8(qp[d], *reinterpret_cast<const uint4*>(kr + d * 8), s);
        s *= 0.125f;
        mx = fmaxf(mx, s);
      }
    }
#pragma unroll
    for (int d = 0; d < 64; ++d) o[d] = 0.f;
    float l = 0.f;
    for (int pat = 0; pat < 3; ++pat) {
      const int dil = (pat == 0) ? 1 : (pat == 1 ? 4 : 16);
#pragma unroll 1
      for (int j = -64; j <= 64; ++j) {
        const int pos = n + j * dil;
        if (pos < 0 || pos >= SEQ) continue;
        const u16* kr = p.proj() + (tb + pos) * PWP + C_DK + h * 64;
        const u16* vr = p.proj() + (tb + pos) * PWP + C_DV + h * 64;
        float s = 0.f;
#pragma unroll
        for (int d = 0; d < 8; ++d) s = dot8(qp[d], *reinterpret_cast<const uint4*>(kr + d * 8), s);
        s *= 0.125f;
        const float pe = __expf(s - mx);
        l += pe;
#pragma unroll
        for (int d = 0; d < 64; d += 8) {
          float vf[8];
          ld8(vr + d, vf);
#pragma unroll
          for (int jj = 0; jj < 8; ++jj) o[d + jj] += pe * vf[jj];
        }
      }
    }
    const float il = 1.f / l;
#pragma unroll
    for (int d = 0; d < 64; d += 8) {
      uint4 ov;
      ov.x = pack2(o[d + 0] * il, o[d + 1] * il);
      ov.y = pack2(o[d + 2] * il, o[d + 3] * il);
      ov.z = pack2(o[d + 4] * il, o[d + 5] * il);
      ov.w = pack2(o[d + 6] * il, o[d + 7] * il);
      *reinterpret_cast<uint4*>(p.mixed() + (tb + n) * DM + 768 + h * 64 + d) = ov;
    }
  }
}

DI void ph_ssd_naive(const Params& p, int L) {
  const int gt = obid() * NTHR + otid(), gs = gridDim.x * NTHR;
  for (int it = gt; it < 4 * 4 * 4 * SEQ; it += gs) {
    const int l = it & (SEQ - 1), pq = (it >> 12) & 3, h = (it >> 14) & 3, b = it >> 16;
    const int g = h >> 1;
    const size_t tb = (size_t)b * SEQ;
    uint4 cl[16];
    float acc[16];
#pragma unroll
    for (int d = 0; d < 16; ++d) cl[d] = *reinterpret_cast<const uint4*>(p.xbc() + (tb + l) * 768 + 512 + g * 128 + d * 8);
#pragma unroll
    for (int d = 0; d < 16; ++d) acc[d] = 0.f;
    const float pl = p.cs()[(tb + l) * 8 + h], rl = p.cs()[(tb + l) * 8 + 4 + h];
#pragma unroll 1
    for (int s = 0; s < SEQ; ++s) {
      const u16* br = p.xbc() + (tb + s) * 768 + 256 + g * 128;
      float cbv = 0.f;
#pragma unroll
      for (int d = 0; d < 16; ++d) cbv = dot8(cl[d], *reinterpret_cast<const uint4*>(br + d * 8), cbv);
      float w;
      if (s <= l) w = expf(pl - p.cs()[(tb + s) * 8 + h]) * p.dtv()[(tb + s) * 8 + h];
      else w = expf(rl - p.cs()[(tb + s) * 8 + 4 + h]) * p.dtv()[(tb + s) * 8 + 4 + h];
      cbv *= w;
      const u16* xr = p.xbc() + (tb + s) * 768 + h * 64 + pq * 16;
#pragma unroll
      for (int d = 0; d < 16; d += 8) {
        float xf[8];
        ld8(xr + d, xf);
#pragma unroll
        for (int j = 0; j < 8; ++j) acc[d + j] += cbv * xf[j];
      }
    }
    const float dsk = p.ssm_d[L * 4 + h];
#pragma unroll
    for (int d = 0; d < 16; ++d) {
      const int c = h * 64 + pq * 16 + d;
      const float xv = bf2f(p.xbc()[(tb + l) * 768 + c]);
      const float z = bf2f(p.proj()[(tb + l) * PWP + C_Z + c]);
      p.ybuf()[(tb + l) * 256 + c] = (acc[d] + dsk * xv) * silu(z);
    }
  }
}

DI void ph_ssd_norm(const Params& p, int L) {
  const int tid_ = otid(); const int lane = tid_ & 63, gw = (obid() * NTHR + tid_) >> 6, nw = gridDim.x * (NTHR / 64);
  const float* nwt = p.ssm_norm_w + L * 256;
  for (int t = gw; t < T; t += nw) {
    const float4 v = *reinterpret_cast<const float4*>(p.ybuf() + (size_t)t * 256 + lane * 4);
    float ss = wave_sum(v.x * v.x + v.y * v.y + v.z * v.z + v.w * v.w);
    const float rstd = rsqrtf(ss * (1.f / 256.f) + 1e-6f);
    const float4 ww = *reinterpret_cast<const float4*>(nwt + lane * 4);
    uint2 o;
    o.x = pack2(v.x * rstd * ww.x, v.y * rstd * ww.y);
    o.y = pack2(v.z * rstd * ww.z, v.w * rstd * ww.w);
    *reinterpret_cast<uint2*>(p.mixed() + (size_t)t * DM + 512 + lane * 4) = o;
  }
}

#define MFMA16(a, b, c) __builtin_amdgcn_mfma_f32_16x16x32_bf16((a), (b), (c), 0, 0, 0)
template <int MT, int NT, int KS>
DI void wave_mm(f32x4 (&acc)[MT][NT], const u16* a0, int lda, const u16* b0, int ldb, int fr, int fq) {
#pragma unroll
  for (int ks = 0; ks < KS; ++ks) {
    bf16x8 af[MT], bfv[NT];
#pragma unroll
    for (int m = 0; m < MT; ++m) af[m] = *reinterpret_cast<const bf16x8*>(a0 + (m * 16 + fr) * lda + ks * 32 + fq * 8);
#pragma unroll
    for (int n = 0; n < NT; ++n) bfv[n] = *reinterpret_cast<const bf16x8*>(b0 + (n * 16 + fr) * ldb + ks * 32 + fq * 8);
#pragma unroll
    for (int m = 0; m < MT; ++m)
#pragma unroll
      for (int n = 0; n < NT; ++n) acc[m][n] = MFMA16(af[m], bfv[n], acc[m][n]);
  }
}
template <int MT, int NT>
DI void zero_acc(f32x4 (&acc)[MT][NT]) {
#pragma unroll
  for (int m = 0; m < MT; ++m)
#pragma unroll
    for (int n = 0; n < NT; ++n) acc[m][n] = f32x4{0.f, 0.f, 0.f, 0.f};
}
template <int NROWS, int NCOLS>
DI void stage_rows(u16* dst, int ldd, const u16* src, size_t lsrc, int tid) {
  constexpr int CPR = NCOLS / 8, NCH = NROWS * CPR / NTHR;
  static_assert(NROWS * CPR % NTHR == 0, "tile must be a multiple of 512 chunks");
  uint4 r[NCH];
#pragma unroll
  for (int i = 0; i < NCH; ++i) {
    const int c = tid + i * NTHR, row = c / CPR, cc = c % CPR;
    r[i] = *reinterpret_cast<const uint4*>(src + (size_t)row * lsrc + cc * 8);
  }
#pragma unroll
  for (int i = 0; i < NCH; ++i) {
    const int c = tid + i * NTHR, row = c / CPR, cc = c % CPR;
    *reinterpret_cast<uint4*>(dst + row * ldd + cc * 8) = r[i];
  }
}
template <int NCOLS, class W>
DI void stage_T(u16* dst, int ldd, const u16* src, size_t lsrc, int tid, W w) {
  constexpr int NCH = 128 * (NCOLS / 8) / NTHR;
  uint4 r[NCH];
#pragma unroll
  for (int i = 0; i < NCH; ++i) {
    const int c = tid + i * NTHR, j = c & 127, cc = c >> 7;
    r[i] = *reinterpret_cast<const uint4*>(src + (size_t)j * lsrc + cc * 8);
  }
#pragma unroll
  for (int i = 0; i < NCH; ++i) {
    const int c = tid + i * NTHR, j = c & 127, cc = c >> 7;
    float f[8];
    unpack8(r[i], f);
    const float wj = w(j);
#pragma unroll
    for (int e = 0; e < 8; ++e) dst[(cc * 8 + e) * ldd + j] = f2bf(f[e] * wj);
  }
}

template <int NROWS, int NCOLS>
DI void stage_rows_ld(uint4 (&r)[NROWS * (NCOLS / 8) / NTHR], const u16* src, size_t lsrc, int tid) {
  constexpr int CPR = NCOLS / 8, NCH = NROWS * CPR / NTHR;
#pragma unroll
  for (int i = 0; i < NCH; ++i) {
    const int c = tid + i * NTHR, row = c / CPR, cc = c % CPR;
    r[i] = *reinterpret_cast<const uint4*>(src + (size_t)row * lsrc + cc * 8);
  }
}
template <int NROWS, int NCOLS>
DI void stage_rows_st(u16* dst, int ldd, const uint4 (&r)[NROWS * (NCOLS / 8) / NTHR], int tid) {
  constexpr int CPR = NCOLS / 8, NCH = NROWS * CPR / NTHR;
#pragma unroll
  for (int i = 0; i < NCH; ++i) {
    const int c = tid + i * NTHR, row = c / CPR, cc = c % CPR;
    *reinterpret_cast<uint4*>(dst + row * ldd + cc * 8) = r[i];
  }
}
template <int NCOLS>
DI void stage_T_ld(uint4 (&r)[128 * (NCOLS / 8) / NTHR], const u16* src, size_t lsrc, int tid) {
  constexpr int NCH = 128 * (NCOLS / 8) / NTHR;
#pragma unroll
  for (int i = 0; i < NCH; ++i) {
    const int c = tid + i * NTHR, j = c & 127, cc = c >> 7;
    r[i] = *reinterpret_cast<const uint4*>(src + (size_t)j * lsrc + cc * 8);
  }
}
template <int NCOLS, class W>
DI void stage_T_st(u16* dst, int ldd, const uint4 (&r)[128 * (NCOLS / 8) / NTHR], int tid, W w) {
  constexpr int NCH = 128 * (NCOLS / 8) / NTHR;
#pragma unroll
  for (int i = 0; i < NCH; ++i) {
    const int c = tid + i * NTHR, j = c & 127, cc = c >> 7;
    float f[8];
    unpack8(r[i], f);
    const float wj = w(j);
#pragma unroll
    for (int e = 0; e < 8; ++e) dst[(cc * 8 + e) * ldd + j] = f2bf(f[e] * wj);
  }
}

DI void ph_ret_a(const Params& p, char* smem, int item) {
  const int tid = otid(), wid = tid >> 6, lane = tid & 63, fr = lane & 15, fq = lane >> 4;
  u16* sVt = reinterpret_cast<u16*>(smem);
  u16* sKf = sVt + 64 * 136;
  u16* sKb = sKf + 64 * 136;
  {
    const int c = item & 31, bh = item >> 5, b = bh >> 2, h = bh & 3;
    const float lg0 = log1pf(-exp2f(-5.f - (float)h)), lg1 = log1pf(-exp2f(-5.5f - (float)h));
    const u16* src = p.proj() + ((size_t)b * SEQ + c * 128) * PWP;
    {
      uint4 rv[2], rk[2];
      stage_T_ld<64>(rv, src + C_RV + h * 64, PWP, tid);
      stage_T_ld<64>(rk, src + C_RK + h * 64, PWP, tid);
      stage_T_st<64>(sVt, 136, rv, tid, [](int) { return 1.f; });
      stage_T_st<64>(sKf, 136, rk, tid, [&](int j) { return __expf(lg0 * (float)(127 - j)); });
      stage_T_st<64>(sKb, 136, rk, tid, [&](int j) { return __expf(lg1 * (float)j); });
    }
    __syncthreads();
    const int dir = wid >> 2, q = wid & 3;
    f32x4 acc[1][4];
    zero_acc(acc);
    wave_mm<1, 4, 4>(acc, sVt + q * 16 * 136, 136, dir ? sKb : sKf, 136, fr, fq);
    float* out = p.rU() + ((size_t)(bh * 32 + c) * 2 + dir) * 4096;
#pragma unroll
    for (int n = 0; n < 4; ++n)
#pragma unroll
      for (int j = 0; j < 4; ++j) out[(q * 16 + fq * 4 + j) * 64 + n * 16 + fr] = acc[0][n][j];
    __syncthreads();
  }
}
DI void ph_ret_scan(const Params& p) {
  const int gt = obid() * NTHR + otid(), gs = gridDim.x * NTHR;
  for (int it = gt; it < 16 * 2 * 4096; it += gs) {
    const int e = it & 4095, dir = (it >> 12) & 1, bh = it >> 13, h = bh & 3;
    const float lg = log1pf(-exp2f((dir ? -5.5f : -5.f) - (float)h));
    const float cd = __expf(lg * 128.f);
    float u[32];
#pragma unroll
    for (int c = 0; c < 32; ++c) u[c] = p.rU()[((size_t)(bh * 32 + c) * 2 + dir) * 4096 + e];
    float st = 0.f;
    if (dir == 0) {
#pragma unroll
      for (int c = 0; c < 32; ++c) {
        p.rS()[((size_t)(bh * 32 + c) * 2 + dir) * 4096 + e] = f2bf(st);
        st = st * cd + u[c];
      }
    } else {
#pragma unroll
      for (int c = 31; c >= 0; --c) {
        p.rS()[((size_t)(bh * 32 + c) * 2 + dir) * 4096 + e] = f2bf(st);
        st = st * cd + u[c];
      }
    }
  }
}
DI void ph_ret_c(const Params& p, char* smem, int item) {
  const int tid = otid(), wid = tid >> 6, lane = tid & 63, fr = lane & 15, fq = lane >> 4;
  u16* sQ = reinterpret_cast<u16*>(smem);
  u16* sK = sQ + 128 * 72;
  u16* sVt = sK + 128 * 72;
  u16* sSf = sVt + 64 * 136;
  u16* sSb = sSf + 64 * 72;
  u16* sP = sSb + 64 * 72;
  {
    const int c = item & 31, bh = item >> 5, b = bh >> 2, h = bh & 3;
    const float lg0 = log1pf(-exp2f(-5.f - (float)h)), lg1 = log1pf(-exp2f(-5.5f - (float)h));
    const size_t t0 = (size_t)b * SEQ + c * 128;
    const u16* src = p.proj() + t0 * PWP;
    {
      uint4 rq[2], rk[2], rv[2], rf[1], rb[1];
      stage_rows_ld<128, 64>(rq, src + C_RQ + h * 64, PWP, tid);
      stage_rows_ld<128, 64>(rk, src + C_RK + h * 64, PWP, tid);
      stage_T_ld<64>(rv, src + C_RV + h * 64, PWP, tid);
      stage_rows_ld<64, 64>(rf, p.rS() + ((size_t)(bh * 32 + c) * 2 + 0) * 4096, 64, tid);
      stage_rows_ld<64, 64>(rb, p.rS() + ((size_t)(bh * 32 + c) * 2 + 1) * 4096, 64, tid);
      stage_rows_st<128, 64>(sQ, 72, rq, tid);
      stage_rows_st<128, 64>(sK, 72, rk, tid);
      stage_T_st<64>(sVt, 136, rv, tid, [](int) { return 1.f; });
      stage_rows_st<64, 64>(sSf, 72, rf, tid);
      stage_rows_st<64, 64>(sSb, 72, rb, tid);
    }
    __syncthreads();
    {
      const int wr = wid >> 1, wc = wid & 1;
      f32x4 sacc[2][4];
      zero_acc(sacc);
      wave_mm<2, 4, 2>(sacc, sQ + wr * 32 * 72, 72, sK + wc * 64 * 72, 72, fr, fq);
#pragma unroll
      for (int m = 0; m < 2; ++m)
#pragma unroll
        for (int n = 0; n < 4; ++n)
#pragma unroll
          for (int j = 0; j < 4; ++j) {
            const int i = wr * 32 + m * 16 + fq * 4 + j, jj = wc * 64 + n * 16 + fr;
            const float dcy = (jj <= i) ? __expf(lg0 * (float)(i - jj)) : __expf(lg1 * (float)(jj - i));
            sP[i * 136 + jj] = f2bf(sacc[m][n][j] * dcy);
          }
    }
    __syncthreads();
    {
      f32x4 ai[1][4], af_[1][4], ab_[1][4];
      zero_acc(ai); zero_acc(af_); zero_acc(ab_);
      wave_mm<1, 4, 4>(ai, sP + wid * 16 * 136, 136, sVt, 136, fr, fq);
      wave_mm<1, 4, 2>(af_, sQ + wid * 16 * 72, 72, sSf, 72, fr, fq);
      wave_mm<1, 4, 2>(ab_, sQ + wid * 16 * 72, 72, sSb, 72, fr, fq);
#pragma unroll
      for (int j = 0; j < 4; ++j) {
        const int i = wid * 16 + fq * 4 + j;
        const float xf = __expf(lg0 * (float)(i + 1)), xb = __expf(lg1 * (float)(128 - i));
        float o[4], sum = 0.f;
#pragma unroll
        for (int n = 0; n < 4; ++n) { o[n] = ai[0][n][j] + xf * af_[0][n][j] + xb * ab_[0][n][j]; sum += o[n]; }
#pragma unroll
        for (int sft = 1; sft < 16; sft <<= 1) sum += __shfl_xor(sum, sft);
        const float mu = sum * (1.f / 64.f);
        float var = 0.f;
#pragma unroll
        for (int n = 0; n < 4; ++n) var += (o[n] - mu) * (o[n] - mu);
#pragma unroll
        for (int sft = 1; sft < 16; sft <<= 1) var += __shfl_xor(var, sft);
        const float rs = rsqrtf(var * (1.f / 64.f) + 1e-5f);
#pragma unroll
        for (int n = 0; n < 4; ++n) {
          const float g = bf2f(p.proj()[(t0 + i) * PWP + C_RG + h * 64 + n * 16 + fr]);
          p.mixed()[(t0 + i) * DM + h * 64 + n * 16 + fr] = f2bf(silu(g) * (o[n] - mu) * rs);
        }
      }
    }
    __syncthreads();
  }
}

DI void ssd_local_cumsum(const Params& p, int L, size_t t0, float* cum, float* dtl, int wid, int lane) {
  const int dir = wid >> 2, h = wid & 3;
  const float a = -__expf(p.a_log[L * 8 + dir * 4 + h]);
  float d0, d1;
  if (dir == 0) { d0 = p.dtv()[(t0 + 2 * lane) * 8 + h]; d1 = p.dtv()[(t0 + 2 * lane + 1) * 8 + h]; }
  else { d0 = p.dtv()[(t0 + 127 - 2 * lane) * 8 + 4 + h]; d1 = p.dtv()[(t0 + 126 - 2 * lane) * 8 + 4 + h]; }
  float v0 = d0 * a, v1 = v0 + d1 * a;
  float run = v1;
#pragma unroll
  for (int o = 1; o < 64; o <<= 1) {
    const float u = __shfl_up(run, o);
    if (lane >= o) run += u;
  }
  const float excl = run - v1;
  v0 += excl; v1 += excl;
  float* cr = cum + (dir * 4 + h) * 128;
  float* dr = dtl + (dir * 4 + h) * 128;
  if (dir == 0) { cr[2 * lane] = v0; cr[2 * lane + 1] = v1; dr[2 * lane] = d0; dr[2 * lane + 1] = d1; }
  else { cr[127 - 2 * lane] = v0; cr[126 - 2 * lane] = v1; dr[127 - 2 * lane] = d0; dr[126 - 2 * lane] = d1; }
}

DI void ph_ssd_a(const Params& p, int L, char* smem, int item) {
  const int tid = otid(), wid = tid >> 6, lane = tid & 63, fr = lane & 15, fq = lane >> 4;
  u16* sBt = reinterpret_cast<u16*>(smem);
  u16* sXf = sBt + 2 * 128 * 136;
  u16* sXb = sXf + 64 * 136;
  float* cum = reinterpret_cast<float*>(sXb + 64 * 136);
  float* dtl = cum + 8 * 128;
  {
    const int c = item & 31, b = item >> 5;
    const size_t t0 = (size_t)b * SEQ + c * 128;
    ssd_local_cumsum(p, L, t0, cum, dtl, wid, lane);
    stage_T<256>(sBt, 136, p.xbc() + t0 * 768 + 256, 768, tid, [](int) { return 1.f; });
    __syncthreads();
    if (tid < 8) {
      const int dir = tid >> 2;
      p.cdec()[(size_t)item * 8 + tid] = __expf(dir ? cum[tid * 128 + 0] : cum[tid * 128 + 127]);
    }
    for (int h = 0; h < 4; ++h) {
      const float* cf = cum + h * 128;
      const float* cb = cum + (4 + h) * 128;
      const float* df = dtl + h * 128;
      const float* db = dtl + (4 + h) * 128;
      const float endf = cf[127], endb = cb[0];
      {
        uint4 rx[2];
        stage_T_ld<64>(rx, p.xbc() + t0 * 768 + h * 64, 768, tid);
        stage_T_st<64>(sXf, 136, rx, tid, [&](int l) { return __expf(endf - cf[l]) * df[l]; });
        stage_T_st<64>(sXb, 136, rx, tid, [&](int l) { return __expf(endb - cb[l]) * db[l]; });
      }
      __syncthreads();
      const int dir = wid >> 2, q = wid & 3, g = h >> 1;
      f32x4 acc[4][2];
      zero_acc(acc);
      wave_mm<4, 2, 4>(acc, dir ? sXb : sXf, 136, sBt + (g * 128 + q * 32) * 136, 136, fr, fq);
      float* out = p.sU() + ((size_t)item * 8 + h * 2 + dir) * 8192;
#pragma unroll
      for (int m = 0; m < 4; ++m)
#pragma unroll
        for (int n = 0; n < 2; ++n)
#pragma unroll
          for (int j = 0; j < 4; ++j) out[(m * 16 + fq * 4 + j) * 128 + q * 32 + n * 16 + fr] = acc[m][n][j];
      __syncthreads();
    }
  }
}
DI void ph_ssd_scan(const Params& p) {
  const int gt = obid() * NTHR + otid(), gs = gridDim.x * NTHR;
  for (int it = gt; it < 4 * 8 * 8192; it += gs) {
    const int e = it & 8191, hd = (it >> 13) & 7, b = it >> 16;
    const int dir = hd & 1, h = hd >> 1;
    float u[32];
#pragma unroll
    for (int c = 0; c < 32; ++c) u[c] = p.sU()[((size_t)(b * 32 + c) * 8 + hd) * 8192 + e];
    float st = 0.f;
    if (dir == 0) {
#pragma unroll
      for (int c = 0; c < 32; ++c) {
        p.sS()[((size_t)(b * 32 + c) * 8 + hd) * 8192 + e] = f2bf(st);
        st = st * p.cdec()[(size_t)(b * 32 + c) * 8 + dir * 4 + h] + u[c];
      }
    } else {
#pragma unroll
      for (int c = 31; c >= 0; --c) {
        p.sS()[((size_t)(b * 32 + c) * 8 + hd) * 8192 + e] = f2bf(st);
        st = st * p.cdec()[(size_t)(b * 32 + c) * 8 + dir * 4 + h] + u[c];
      }
    }
  }
}
DI void ph_ssd_c(const Params& p, int L, char* smem, int item) {
  const int tid = otid(), wid = tid >> 6, lane = tid & 63, fr = lane & 15, fq = lane >> 4;
  u16* sC = reinterpret_cast<u16*>(smem);
  u16* sB = sC + 128 * 136;
  u16* sXt = sB + 128 * 136;
  u16* sSf = sXt + 64 * 136;
  u16* sSb = sSf + 64 * 136;
  float* cum = reinterpret_cast<float*>(sSb + 64 * 136);
  float* dtl = cum + 8 * 128;
  {
    const int c = item & 31, b = item >> 5;
    const size_t t0 = (size_t)b * SEQ + c * 128;
    ssd_local_cumsum(p, L, t0, cum, dtl, wid, lane);
    float ssq[4] = {0.f, 0.f, 0.f, 0.f};
#pragma unroll 1
    for (int g = 0; g < 2; ++g) {
      {
        uint4 rc[4], rb4[4];
        stage_rows_ld<128, 128>(rc, p.xbc() + t0 * 768 + 512 + g * 128, 768, tid);
        stage_rows_ld<128, 128>(rb4, p.xbc() + t0 * 768 + 256 + g * 128, 768, tid);
        stage_rows_st<128, 128>(sC, 136, rc, tid);
        stage_rows_st<128, 128>(sB, 136, rb4, tid);
      }
      __syncthreads();
      const int wr = wid >> 1, wc = wid & 1;
      f32x4 G[2][4];
      zero_acc(G);
      wave_mm<2, 4, 4>(G, sC + wr * 32 * 136, 136, sB + wc * 64 * 136, 136, fr, fq);
      __syncthreads();
#pragma unroll 1
      for (int hl = 0; hl < 2; ++hl) {
        const int h = g * 2 + hl;
        const float* cf = cum + h * 128;
        const float* cb = cum + (4 + h) * 128;
        const float* df = dtl + h * 128;
        const float* db = dtl + (4 + h) * 128;
        uint4 rxt[2], rsf[2], rsb[2];
        stage_T_ld<64>(rxt, p.xbc() + t0 * 768 + h * 64, 768, tid);
        stage_rows_ld<64, 128>(rsf, p.sS() + ((size_t)item * 8 + h * 2 + 0) * 8192, 128, tid);
        stage_rows_ld<64, 128>(rsb, p.sS() + ((size_t)item * 8 + h * 2 + 1) * 8192, 128, tid);
#pragma unroll
        for (int m = 0; m < 2; ++m)
#pragma unroll
          for (int n = 0; n < 4; ++n)
#pragma unroll
            for (int j = 0; j < 4; ++j) {
              const int l = wr * 32 + m * 16 + fq * 4 + j, sx = wc * 64 + n * 16 + fr;
              const float w = (sx <= l) ? __expf(cf[l] - cf[sx]) * df[sx] : __expf(cb[l] - cb[sx]) * db[sx];
              sB[l * 136 + sx] = f2bf(G[m][n][j] * w);
            }
        stage_T_st<64>(sXt, 136, rxt, tid, [](int) { return 1.f; });
        stage_rows_st<64, 128>(sSf, 136, rsf, tid);
        stage_rows_st<64, 128>(sSb, 136, rsb, tid);
        __syncthreads();
        f32x4 yd[1][4], yf[1][4], yb[1][4];
        zero_acc(yd); zero_acc(yf); zero_acc(yb);
        wave_mm<1, 4, 4>(yd, sB + wid * 16 * 136, 136, sXt, 136, fr, fq);
        wave_mm<1, 4, 4>(yf, sC + wid * 16 * 136, 136, sSf, 136, fr, fq);
        wave_mm<1, 4, 4>(yb, sC + wid * 16 * 136, 136, sSb, 136, fr, fq);
        const float dsk = p.ssm_d[L * 4 + h];
#pragma unroll
        for (int j = 0; j < 4; ++j) {
          const int l = wid * 16 + fq * 4 + j;
          const float ef = __expf(cf[l]), eb = __expf(cb[l]);
#pragma unroll
          for (int n = 0; n < 4; ++n) {
            const int ch = h * 64 + n * 16 + fr;
            const float xv = bf2f(p.xbc()[(t0 + l) * 768 + ch]);
            const float z = bf2f(p.proj()[(t0 + l) * PWP + C_Z + ch]);
            const float yv = (yd[0][n][j] + ef * yf[0][n][j] + eb * yb[0][n][j] + dsk * xv) * silu(z);
            ssq[j] += yv * yv;
            p.ybuf()[(t0 + l) * 256 + ch] = yv;
          }
        }
        __syncthreads();
      }
    }
    const float* nwt = p.ssm_norm_w + L * 256;
#pragma unroll
    for (int j = 0; j < 4; ++j) {
      float ss = ssq[j];
#pragma unroll
      for (int sft = 1; sft < 16; sft <<= 1) ss += __shfl_xor(ss, sft);
      const float rstd = rsqrtf(ss * (1.f / 256.f) + 1e-6f);
      const int l = wid * 16 + fq * 4 + j;
#pragma unroll
      for (int hn = 0; hn < 16; ++hn) {
        const int ch = hn * 16 + fr;
        p.mixed()[(t0 + l) * DM + 512 + ch] = f2bf(p.ybuf()[(t0 + l) * 256 + ch] * rstd * nwt[ch]);
      }
    }
  }
}

template <bool XIN_F32>
struct CfgOutproj {
  static constexpr bool PERM = true;
  int K; const Params* p; int L; int bid, nb; const void* xin; u16* xout;
  DI bool next(int i, pg8::Unit& u) const { const int t = i * nb + bid; if (t >= 64 * 4) return false; u.pm = t & 63; u.pn = t >> 6; return true; }
  DI const char* a_base(const pg8::Unit& u) const { return (const char*)(p->mixed() + (size_t)u.pm * 256 * DM); }
  DI const char* b_base(const pg8::Unit& u) const { return (const char*)(p->WoutT() + ((size_t)L * DM + (size_t)u.pn * 256) * DM); }
  DI void a_off(const pg8::Unit&, int R0, int C0, int R1, int C1, unsigned (&vo)[4]) const {
    vo[0] = (unsigned)(R0 * DM + C0) * 2u; vo[1] = (unsigned)(R1 * DM + C1) * 2u;
    vo[2] = vo[0] + 128u * DM * 2u; vo[3] = vo[1] + 128u * DM * 2u;
  }
  DI void epi(const f32x4 (&acc)[2][2][4][2], const pg8::Unit& u, int wr, int wc, int fr, int fq) const {
    const int row0 = u.pm * 256 + wr * 64 + fr, col0 = u.pn * 256 + wc * 32 + 8 * fq;
#pragma unroll
    for (int ai = 0; ai < 2; ++ai)
#pragma unroll
      for (int m = 0; m < 4; ++m) {
        const size_t ro = (size_t)(row0 + ai * 128 + m * 16) * DM + col0;
#pragma unroll
        for (int bj = 0; bj < 2; ++bj) {
          const size_t o = ro + bj * 128;
          float4 x0, x1;
          if (XIN_F32) {
            x0 = *reinterpret_cast<const float4*>(static_cast<const float*>(xin) + o);
            x1 = *reinterpret_cast<const float4*>(static_cast<const float*>(xin) + o + 4);
          } else {
            const uint4 q = *reinterpret_cast<const uint4*>(static_cast<const u16*>(xin) + o);
            x0 = bf4_to_f4(make_uint2(q.x, q.y)); x1 = bf4_to_f4(make_uint2(q.z, q.w));
          }
          const f32x4 a0 = acc[ai][bj][m][0], a1 = acc[ai][bj][m][1];
          uint4 w;
          w.x = pack2(x0.x + a0[0], x0.y + a0[1]); w.y = pack2(x0.z + a0[2], x0.w + a0[3]);
          w.z = pack2(x1.x + a1[0], x1.y + a1[1]); w.w = pack2(x1.z + a1[2], x1.w + a1[3]);
          *reinterpret_cast<uint4*>(xout + o) = w;
        }
      }
  }
};
DI void ph_outproj(const Params& p, int L, char* smem) {
  if (L == 0) {
    CfgOutproj<true> c; c.K = DM; c.p = &p; c.L = L; c.bid = obid(); c.nb = gridDim.x; c.xin = p.x; c.xout = p.xres();
    pg8::gemm_phase((pg8::lds_u8*)smem, c);
  } else {
    CfgOutproj<false> c; c.K = DM; c.p = &p; c.L = L; c.bid = obid(); c.nb = gridDim.x; c.xin = p.xres2(); c.xout = p.xres();
    pg8::gemm_phase((pg8::lds_u8*)smem, c);
  }
}

DI void ph_rms2_router(const Params& p, int L, const u16* xres, char* smem) {
  const int tid = otid(), lane = tid & 63, gw = (obid() * NTHR + tid) >> 6, nw = gridDim.x * (NTHR / 64);
  const float* w = p.ln2_w + L * DM;
  const float* rw = p.router_w + (size_t)L * DM * 16;
  float4* srw = reinterpret_cast<float4*>(smem);
  for (int i = tid; i < 4096; i += NTHR) {
    const int c = i >> 2, e4 = i & 3;
    srw[(e4 * 4 + (c & 3)) * 256 + (c >> 2)] = *reinterpret_cast<const float4*>(rw + (size_t)i * 4);
  }
  __syncthreads();
  const int b5 = (lane >> 5) & 1, b4 = (lane >> 4) & 1, b3 = (lane >> 3) & 1, b2 = (lane >> 2) & 1;
  const int my_e = 8 * b5 + 4 * b4 + 2 * b3 + b2;
  float4 v[4];
  if (gw < T) {
#pragma unroll
    for (int i = 0; i < 4; ++i) v[i] = bf4_to_f4(*reinterpret_cast<const uint2*>(xres + (size_t)gw * DM + (i * 64 + lane) * 4));
  }
  for (int t = gw; t < T; t += nw) {
    uint2 vnx[4];
    const int tn = (t + nw < T) ? (t + nw) : t;
#pragma unroll
    for (int i = 0; i < 4; ++i) vnx[i] = *reinterpret_cast<const uint2*>(xres + (size_t)tn * DM + (i * 64 + lane) * 4);
    float ss = 0.f;
#pragma unroll
    for (int i = 0; i < 4; ++i) ss += v[i].x * v[i].x + v[i].y * v[i].y + v[i].z * v[i].z + v[i].w * v[i].w;
    ss = wave_sum(ss);
    const float rstd = rsqrtf(ss * (1.f / DM) + 1e-6f);
    float lg[16];
#pragma unroll
    for (int e = 0; e < 16; ++e) lg[e] = 0.f;
#pragma unroll
    for (int i = 0; i < 4; ++i) {
      const int q = i * 64 + lane;
      const float4 ww = *reinterpret_cast<const float4*>(w + q * 4);
      const float hv[4] = {v[i].x * rstd * ww.x, v[i].y * rstd * ww.y, v[i].z * rstd * ww.z, v[i].w * rstd * ww.w};
      *reinterpret_cast<unsigned*>(p.hn8() + (size_t)t * DM + q * 4) =
          pk4_f8(hv[0] * F8_H_SCALE, hv[1] * F8_H_SCALE, hv[2] * F8_H_SCALE, hv[3] * F8_H_SCALE);
#pragma unroll
      for (int j = 0; j < 4; ++j)
#pragma unroll
        for (int e4 = 0; e4 < 4; ++e4) {
          const float4 r = srw[(e4 * 4 + j) * 256 + q];
          lg[e4 * 4 + 0] += hv[j] * r.x; lg[e4 * 4 + 1] += hv[j] * r.y;
          lg[e4 * 4 + 2] += hv[j] * r.z; lg[e4 * 4 + 3] += hv[j] * r.w;
        }
      __builtin_amdgcn_sched_barrier(0);
    }
#pragma unroll
    for (int k = 0; k < 8; ++k) {
      const float send = b5 ? lg[k] : lg[k + 8], keep = b5 ? lg[k + 8] : lg[k];
      lg[k] = keep + __shfl_xor(send, 32);
    }
#pragma unroll
    for (int k = 0; k < 4; ++k) {
      const float send = b4 ? lg[k] : lg[k + 4], keep = b4 ? lg[k + 4] : lg[k];
      lg[k] = keep + __shfl_xor(send, 16);
    }
#pragma unroll
    for (int k = 0; k < 2; ++k) {
      const float send = b3 ? lg[k] : lg[k + 2], keep = b3 ? lg[k + 2] : lg[k];
      lg[k] = keep + __shfl_xor(send, 8);
    }
    float lv;
    {
      const float send = b2 ? lg[0] : lg[1], keep = b2 ? lg[1] : lg[0];
      lv = keep + __shfl_xor(send, 4);
    }
    lv += __shfl_xor(lv, 2);
    lv += __shfl_xor(lv, 1);
    float mx = lv;
    mx = fmaxf(mx, __shfl_xor(mx, 4)); mx = fmaxf(mx, __shfl_xor(mx, 8));
    mx = fmaxf(mx, __shfl_xor(mx, 16)); mx = fmaxf(mx, __shfl_xor(mx, 32));
    const float ex = expf(lv - mx);
    float den = ex;
    den += __shfl_xor(den, 4); den += __shfl_xor(den, 8); den += __shfl_xor(den, 16); den += __shfl_xor(den, 32);
    if ((lane & 3) == 0) { p.aff()[(size_t)t * 16 + my_e] = ex / den; p.inv()[(size_t)t * 16 + my_e] = -1; }
#pragma unroll
    for (int i = 0; i < 4; ++i) v[i] = bf4_to_f4(vnx[i]);
  }
}

DI int block_sum_i(int v, int* red, int tid) {
#pragma unroll
  for (int o = 32; o > 0; o >>= 1) v += __shfl_xor(v, o);
  __syncthreads();
  if ((tid & 63) == 0) red[tid >> 6] = v;
  __syncthreads();
  int t = 0;
#pragma unroll
  for (int w = 0; w < NTHR / 64; ++w) t += red[w];
  return t;
}
DI void ph_topk(const Params& p, char* smem) {
  int* red = reinterpret_cast<int*>(smem);
  int* wsum = red + 16;
  const int tid = otid(), wid = tid >> 6, lane = tid & 63;
  for (int it = obid(); it < 64; it += gridDim.x) {
    const int e = it & 15, b = it >> 4;
    unsigned v[8];
#pragma unroll
    for (int i = 0; i < 8; ++i) v[i] = __float_as_uint(p.aff()[(size_t)(b * SEQ + tid * 8 + i) * 16 + e]);
    unsigned thr = 0;
#pragma unroll 1
    for (int bit = 30; bit >= 0; --bit) {
      const unsigned cand = thr | (1u << bit);
      int cnt = 0;
#pragma unroll
      for (int i = 0; i < 8; ++i) cnt += (v[i] >= cand) ? 1 : 0;
      if (block_sum_i(cnt, red, tid) >= 512) thr = cand;
    }
    int ngt = 0, ntie = 0;
#pragma unroll
    for (int i = 0; i < 8; ++i) { ngt += (v[i] > thr) ? 1 : 0; ntie += (v[i] == thr) ? 1 : 0; }
    int ig = ngt, itie = ntie;
#pragma unroll
    for (int o = 1; o < 64; o <<= 1) {
      const int a = __shfl_up(ig, o), c = __shfl_up(itie, o);
      if (lane >= o) { ig += a; itie += c; }
    }
    __syncthreads();
    if (lane == 63) { wsum[wid] = ig; wsum[8 + wid] = itie; }
    __syncthreads();
    int og = 0, ot = 0, totg = 0;
#pragma unroll
    for (int w = 0; w < 8; ++w) {
      const int a = wsum[w], c = wsum[8 + w];
      if (w < wid) { og += a; ot += c; }
      totg += a;
    }
    int pg = og + ig - ngt, pt = ot + itie - ntie;
    const int base = (e * 4 + b) * 512;
#pragma unroll
    for (int i = 0; i < 8; ++i) {
      int slot = -1;
      if (v[i] > thr) { slot = pg; ++pg; }
      else if (v[i] == thr) { if (totg + pt < 512) slot = totg + pt; ++pt; }
      if (slot >= 0) {
        p.tok()[base + slot] = b * SEQ + tid * 8 + i;
        p.inv()[(size_t)(b * SEQ + tid * 8 + i) * 16 + e] = base + slot;
        p.gate()[base + slot] = __uint_as_float(v[i]);
      }
    }
    __syncthreads();
  }
}

struct CfgMoe1 {
  static constexpr bool PERM = true;
  int K; const Params* p; int L; int bid, nb;
  DI bool next(int i, pg8::Unit& u) const {
    const int t = i * nb + bid; if (t >= 16 * 16 * 8) return false;
    const int rnd = t >> 8, w = t & 255, xcd = w & 7, jx = w >> 3, pid = xcd * 4 + (jx >> 3);
    const int mt = jx & 7, nt = pid & 15, e = rnd * 2 + (pid >> 4);
    u.pm = e * 8 + mt; u.pn = e * 16 + nt; return true;
  }
  DI const char* a_base(const pg8::Unit&) const { return (const char*)p->hn8(); }
  DI const char* b_base(const pg8::Unit& u) const { return (const char*)(p->Wgu8() + ((size_t)L * 16 * 4096 + (size_t)u.pn * 256) * DM); }
  const int* tokl;
  DI void a_off(const pg8::Unit&, int R0, int C0, int R1, int C1, unsigned (&vo)[4], int ui) const {
    const int* tk = tokl + ui * 256;
    vo[0] = (unsigned)(tk[R0] * 512 + C0) * 2u; vo[1] = (unsigned)(tk[R1] * 512 + C1) * 2u;
    vo[2] = (unsigned)(tk[128 + R0] * 512 + C0) * 2u; vo[3] = (unsigned)(tk[128 + R1] * 512 + C1) * 2u;
  }
  DI void epi(const f32x4 (&acc)[2][2][4][2], const pg8::Unit& u, int wr, int wc, int fr, int fq) const {
    const int row0 = u.pm * 256 + wr * 64 + fr, col0 = (u.pn & 15) * 128 + wc * 32 + 8 * fq;
    const float dq = 1.f / (F8_H_SCALE * F8_W_SCALE);
#pragma unroll
    for (int ai = 0; ai < 2; ++ai)
#pragma unroll
      for (int m = 0; m < 4; ++m) {
        const f32x4 g0 = acc[ai][0][m][0] * dq, g1 = acc[ai][0][m][1] * dq, u0 = acc[ai][1][m][0] * (dq * F8_HID_SCALE), u1 = acc[ai][1][m][1] * (dq * F8_HID_SCALE);
        uint2 w;
        w.x = pk4_f8(fast_silu(g0[0]) * u0[0], fast_silu(g0[1]) * u0[1], fast_silu(g0[2]) * u0[2], fast_silu(g0[3]) * u0[3]);
        w.y = pk4_f8(fast_silu(g1[0]) * u1[0], fast_silu(g1[1]) * u1[1], fast_silu(g1[2]) * u1[2], fast_silu(g1[3]) * u1[3]);
        *reinterpret_cast<uint2*>(p->hid8() + (size_t)(row0 + ai * 128 + m * 16) * 2048 + col0) = w;
      }
  }
};
DI void ph_moe1(const Params& p, int L, char* smem) {
  CfgMoe1 c; c.K = 512; c.p = &p; c.L = L; c.bid = obid(); c.nb = gridDim.x;
  int* tokl = reinterpret_cast<int*>(smem + 131072);
  c.tokl = tokl;
  for (int idx = otid(); idx < 8 * 256; idx += NTHR) {
    pg8::Unit u;
    if (c.next(idx >> 8, u)) tokl[idx] = p.tok()[u.pm * 256 + (idx & 255)];
  }
  __syncthreads();
  pg8::gemm_phase_f8((pg8::lds_u8*)smem, c);
}
struct CfgMoe2 {
  static constexpr bool PERM = true;
  int K; const Params* p; int L; int bid, nb;
  DI bool next(int i, pg8::Unit& u) const {
    const int t = i * nb + bid; if (t >= 16 * 4 * 8) return false;
    const int rnd = t >> 8, w = t & 255, xcd = w & 7, jx = w >> 3, pid = rnd * 32 + xcd * 4 + (jx >> 3);
    u.pm = (pid >> 2) * 8 + (jx & 7); u.pn = pid; return true;
  }
  DI const char* a_base(const pg8::Unit& u) const { return (const char*)(p->hid8() + (size_t)u.pm * 256 * 2048); }
  DI const char* b_base(const pg8::Unit& u) const { return (const char*)(p->Wd8() + ((size_t)L * 16 * DM + (size_t)u.pn * 256) * 2048); }
  DI void a_off(const pg8::Unit&, int R0, int C0, int R1, int C1, unsigned (&vo)[4], int) const {
    vo[0] = (unsigned)(R0 * 1024 + C0) * 2u; vo[1] = (unsigned)(R1 * 1024 + C1) * 2u;
    vo[2] = vo[0] + 128u * 1024u * 2u; vo[3] = vo[1] + 128u * 1024u * 2u;
  }
  DI void epi(const f32x4 (&acc)[2][2][4][2], const pg8::Unit& u, int wr, int wc, int fr, int fq) const {
    u16* eo = p->proj();
    const int row0 = u.pm * 256 + wr * 64 + fr, col0 = (u.pn & 3) * 256 + wc * 32 + 8 * fq;
#pragma unroll
    for (int ai = 0; ai < 2; ++ai)
#pragma unroll
      for (int m = 0; m < 4; ++m) {
        const int row = row0 + ai * 128 + m * 16;
        const float gt = p->gate()[row] * (1.f / (F8_HID_SCALE * F8_W_SCALE));
#pragma unroll
        for (int bj = 0; bj < 2; ++bj) {
          const f32x4 a0 = acc[ai][bj][m][0], a1 = acc[ai][bj][m][1];
          uint4 w;
          w.x = pack2(gt * a0[0], gt * a0[1]); w.y = pack2(gt * a0[2], gt * a0[3]);
          w.z = pack2(gt * a1[0], gt * a1[1]); w.w = pack2(gt * a1[2], gt * a1[3]);
          *reinterpret_cast<uint4*>(eo + (size_t)row * DM + col0 + bj * 128) = w;
        }
      }
  }
};
DI void ph_moe2(const Params& p, int L, char* smem) {
  CfgMoe2 c; c.K = 1024; c.p = &p; c.L = L; c.bid = obid(); c.nb = gridDim.x;
  pg8::gemm_phase_f8((pg8::lds_u8*)smem, c);
}
template <bool FINAL>
DI void ph_combine_norm(const Params& p, const u16* __restrict__ xa, u16* __restrict__ xnew, const float* __restrict__ w,
                        u16* __restrict__ hn_out, float* __restrict__ f_out) {
  const int tid_ = otid(), lane = tid_ & 63, gw = (obid() * NTHR + tid_) >> 6, nw = gridDim.x * (NTHR / 64);
  const u16* eo = p.proj();
  float4 v[4];
  int myrow = -1;
  if (gw < T) {
#pragma unroll
    for (int i = 0; i < 4; ++i) v[i] = bf4_to_f4(*reinterpret_cast<const uint2*>(xa + (size_t)gw * DM + (i * 64 + lane) * 4));
    myrow = (lane < 16) ? p.inv()[(size_t)gw * 16 + lane] : -1;
  }
  for (int t = gw; t < T; t += nw) {
    uint2 vnx[4];
    const int tn = (t + nw < T) ? (t + nw) : t;
#pragma unroll
    for (int i = 0; i < 4; ++i) vnx[i] = *reinterpret_cast<const uint2*>(xa + (size_t)tn * DM + (i * 64 + lane) * 4);
    const int myrow_nx = (lane < 16) ? p.inv()[(size_t)tn * 16 + lane] : -1;
    unsigned long long mask = __builtin_amdgcn_ballot_w64(myrow >= 0);
#pragma unroll 1
    while (mask != 0ull) {
      const int e0 = __builtin_ctzll(mask);
      mask &= mask - 1ull;
      const int r0 = __builtin_amdgcn_readlane(myrow, e0);
      int r1 = -1;
      if (mask != 0ull) { const int e1 = __builtin_ctzll(mask); mask &= mask - 1ull; r1 = __builtin_amdgcn_readlane(myrow, e1); }
      uint2 q0[4], q1[4];
#pragma unroll
      for (int i = 0; i < 4; ++i) q0[i] = *reinterpret_cast<const uint2*>(eo + (size_t)r0 * DM + (i * 64 + lane) * 4);
      const int r1c = (r1 >= 0) ? r1 : r0;
#pragma unroll
      for (int i = 0; i < 4; ++i) q1[i] = *reinterpret_cast<const uint2*>(eo + (size_t)r1c * DM + (i * 64 + lane) * 4);
      const float s1 = (r1 >= 0) ? 1.f : 0.f;
#pragma unroll
      for (int i = 0; i < 4; ++i) {
        v[i].x += __uint_as_float(q0[i].x << 16); v[i].y += __uint_as_float(q0[i].x & 0xffff0000u);
        v[i].z += __uint_as_float(q0[i].y << 16); v[i].w += __uint_as_float(q0[i].y & 0xffff0000u);
        v[i].x += s1 * __uint_as_float(q1[i].x << 16); v[i].y += s1 * __uint_as_float(q1[i].x & 0xffff0000u);
        v[i].z += s1 * __uint_as_float(q1[i].y << 16); v[i].w += s1 * __uint_as_float(q1[i].y & 0xffff0000u);
      }
    }
    float ss = 0.f;
#pragma unroll
    for (int i = 0; i < 4; ++i) ss += v[i].x * v[i].x + v[i].y * v[i].y + v[i].z * v[i].z + v[i].w * v[i].w;
    ss = wave_sum(ss);
    const float rstd = rsqrtf(ss * (1.f / DM) + 1e-6f);
#pragma unroll
    for (int i = 0; i < 4; ++i) {
      const int c = (i * 64 + lane) * 4;
      const float4 ww = *reinterpret_cast<const float4*>(w + c);
      if (FINAL) {
        *reinterpret_cast<float4*>(f_out + (size_t)t * DM + c) = make_float4(v[i].x * rstd * ww.x, v[i].y * rstd * ww.y, v[i].z * rstd * ww.z, v[i].w * rstd * ww.w);
      } else {
        uint2 xo;
        xo.x = pack2(v[i].x, v[i].y); xo.y = pack2(v[i].z, v[i].w);
        *reinterpret_cast<uint2*>(xnew + (size_t)t * DM + c) = xo;
        uint2 o;
        o.x = pack2(v[i].x * rstd * ww.x, v[i].y * rstd * ww.y);
        o.y = pack2(v[i].z * rstd * ww.z, v[i].w * rstd * ww.w);
        *reinterpret_cast<uint2*>(hn_out + (size_t)t * DM + c) = o;
      }
    }
#pragma unroll
    for (int i = 0; i < 4; ++i) v[i] = bf4_to_f4(vnx[i]);
    myrow = myrow_nx;
  }
}

__global__ void __launch_bounds__(NTHR) mk(Params p) {
  extern __shared__ __attribute__((aligned(16))) char smem[];
  cg::grid_group grid = cg::this_grid();
  __shared__ uint4 xb_words;
  if (threadIdx.x == 0) xb_words = make_uint4(0u, 0u, 0u, 0u);
  __syncthreads();
  XcdBarrier xb = xcd_barrier_post(p.bar(), (volatile LAS unsigned*)&xb_words);
  ph_convert(p, smem);
  ph_rmsnorm_bf16(p.x, p.ln1_w, p.hn());
  xcd_barrier(xb);
  if (p.rep[12] == 0x7fffffff) grid.sync();
  for (int L = 0; L < 2; ++L) {
    u16* xout = p.xres();
    if (L == 1) {
      ph_combine_norm<false>(p, p.xres(), p.xres2(), p.ln1_w + DM, p.hn(), nullptr);
      xcd_barrier(xb);
    }
    ph_inproj(p, L, smem);
    xcd_barrier(xb);
    ph_post(p, L);
    xcd_barrier(xb);
    {
      unsigned* ctr = p.bar() + XCD_BAR_WORDS + 8 + L;
      __shared__ int q1_item;
      for (;;) {
        if (threadIdx.x == 0) q1_item = (int)atomicAdd(ctr, 1u);
        __syncthreads();
        const int it = q1_item;
        __syncthreads();
        if (it >= 1344) break;
        if (it < 256) ph_dil_pass<0>(p, smem, it);
        else if (it < 384) ph_ssd_a(p, L, smem, it - 256);
        else if (it < 576) ph_mla_up_q(p, L, smem, it - 384);
        else if (it < 832) ph_mla_up_kv(p, L, smem, it - 576);
        else ph_ret_a(p, smem, it - 832);
      }
    }
    xcd_barrier(xb);
    {
      { ph_ret_scan(p); ph_ssd_scan(p); }
      ph_mla_attn(p, smem, L);
      for (int bi = obid(); bi < 256; bi += gridDim.x) ph_dil_pass<1>(p, smem, bi);
    }
    xcd_barrier(xb);
    {
      unsigned* ctr = p.bar() + XCD_BAR_WORDS + L;
      __shared__ int q_item;
      for (;;) {
        if (threadIdx.x == 0) q_item = (int)atomicAdd(ctr, 1u);
        __syncthreads();
        const int it = q_item;
        __syncthreads();
        if (it >= 640) break;
        if (it < 128) ph_ssd_c(p, L, smem, it);
        else ph_ret_c(p, smem, it - 128);
      }
    }
    xcd_barrier(xb);
    ph_outproj(p, L, smem);
    xcd_barrier(xb);
    ph_rms2_router(p, L, xout, smem);
    xcd_barrier(xb);
    ph_topk(p, smem);
    xcd_barrier(xb);
    ph_moe1(p, L, smem);
    xcd_barrier(xb);
    ph_moe2(p, L, smem);
    xcd_barrier(xb);
  }
  ph_combine_norm<true>(p, p.xres(), nullptr, p.final_w, nullptr, p.out);
}

extern "C" void kernel_launch(void* const* d_in, const int* in_sizes, int n_in, void* d_out, int out_size, void* d_ws,
                              size_t ws_size, hipStream_t stream) {
  static int grid_blocks = 0;
  if (!grid_blocks) {
    int dev = 0, cus = 0, per_cu = 0;
    (void)hipGetDevice(&dev);
    (void)hipDeviceGetAttribute(&cus, hipDeviceAttributeMultiprocessorCount, dev);
    (void)hipFuncSetAttribute((const void*)mk, hipFuncAttributeMaxDynamicSharedMemorySize, LDS_BYTES);
    (void)hipOccupancyMaxActiveBlocksPerMultiprocessor(&per_cu, (const void*)mk, NTHR, LDS_BYTES);
    if (per_cu < 1) { fprintf(stderr, "occupancy query says %d blocks/CU\n", per_cu); per_cu = 1; }
    grid_blocks = cus * 1;
  }
  Params p{};
  const float** fp = reinterpret_cast<const float**>(&p);
  for (int i = 0; i < 20; ++i) fp[i] = (const float*)d_in[i];
  p.out = (float*)d_out;
  p.ws = (char*)d_ws;
  const size_t off = WSO.total;
  { const int reps[16] = REPS_INIT; for (int i = 0; i < 16; ++i) p.rep[i] = reps[i]; }
  if (off > ws_size) { fprintf(stderr, "workspace too small: need %zu have %zu\n", off, ws_size); return; }
  (void)hipMemsetAsync(p.bar(), 0, (size_t)(XCD_BAR_WORDS + 64) * 4, stream);
  void* args[] = {&p};
  hipError_t e = hipLaunchCooperativeKernel((void*)mk, dim3(grid_blocks), dim3(NTHR), args, LDS_BYTES, stream);
  if (e != hipSuccess) fprintf(stderr, "cooperative launch failed: %s (grid %d)\n", hipGetErrorString(e), grid_blocks);
}
```

```cpp
#include <hip/hip_runtime.h>
#include <hip/hip_cooperative_groups.h>
#include <cstdio>
#include <cstdint>
namespace cg = cooperative_groups;

#define DI __device__ __forceinline__
typedef unsigned short u16;
typedef __attribute__((ext_vector_type(8))) short bf16x8;
typedef __attribute__((ext_vector_type(4))) float f32x4;

#ifndef REPS_INIT
#define REPS_INIT {1, 1, 1, 1, 1, 1, 1, 1, 1, 1, 1, 1, 0, 1, 1, 1}
#endif
constexpr int NTHR = 512;
constexpr int T = 16384, SEQ = 4096, DM = 1024;
constexpr int PW = 3240, PWP = 3328;
constexpr int C_RQ = 0, C_RK = 256, C_RV = 512, C_RG = 768, C_CQ = 1024, C_CKV = 1280, C_KR = 1408,
              C_Z = 1440, C_XBC = 1696, C_DT = 2464, C_DQ = 2472, C_DK = 2728, C_DV = 2984;
constexpr int LDS_BYTES = 131072 + 8192;

struct WsOff {
  size_t WinT;
  size_t WuqT;
  size_t WukvT;
  size_t WoutT;
  size_t Wgu8;
  size_t Wd8;
  size_t hn8;
  size_t xres;
  size_t hn;
  size_t proj;
  size_t cqn;
  size_t ckvn;
  size_t mq;
  size_t xbc;
  size_t mixed;
  size_t hid8;
  size_t kfull;
  size_t rS;
  size_t sS;
  size_t rU;
  size_t sU;
  size_t cdec;
  size_t vT;
  size_t rtab;
  size_t dpart;
  size_t dtv;
  size_t cs;
  size_t ybuf;
  size_t aff;
  size_t gate;
  size_t tok;
  size_t inv;
  size_t bar;
  size_t xres2;
  size_t total;
};
constexpr WsOff ws_layout() {
  WsOff o{};
  size_t off = 0;
  o.WinT = off; off += (((size_t)2 * PWP * DM * 2) + 255) & ~(size_t)255;
  o.WuqT = off; off += (((size_t)2 * 384 * 256 * 2) + 255) & ~(size_t)255;
  o.WukvT = off; off += (((size_t)2 * 512 * 128 * 2) + 255) & ~(size_t)255;
  o.WoutT = off; off += (((size_t)2 * DM * DM * 2) + 255) & ~(size_t)255;
  o.Wgu8 = off; off += (((size_t)2 * 16 * 4096 * DM) + 255) & ~(size_t)255;
  o.Wd8 = off; off += (((size_t)2 * 16 * DM * 2048) + 255) & ~(size_t)255;
  o.hn8 = off; off += (((size_t)T * DM) + 255) & ~(size_t)255;
  o.xres = off; off += (((size_t)T * DM * 2) + 255) & ~(size_t)255;
  o.hn = off; off += (((size_t)T * DM * 2) + 255) & ~(size_t)255;
  o.proj = off; off += (((size_t)T * PWP * 2) + 255) & ~(size_t)255;
  o.cqn = off; off += (((size_t)T * 256 * 2) + 255) & ~(size_t)255;
  o.ckvn = off; off += (((size_t)T * 128 * 2) + 255) & ~(size_t)255;
  o.mq = off; off += (((size_t)T * 384 * 2) + 255) & ~(size_t)255;
  o.xbc = off; off += (((size_t)T * 768 * 2) + 255) & ~(size_t)255;
  o.mixed = off; off += (((size_t)T * DM * 2) + 255) & ~(size_t)255;
  o.hid8 = off; off += (((size_t)32768 * 2048) + 255) & ~(size_t)255;
  o.kfull = off; off += (((size_t)T * 4 * 96 * 2) + 255) & ~(size_t)255;
  o.rS = off; off += (((size_t)16 * 32 * 2 * 4096 * 2) + 255) & ~(size_t)255;
  o.sS = off; off += (((size_t)128 * 8 * 8192 * 2) + 255) & ~(size_t)255;
  o.rU = off; off += (((size_t)16 * 32 * 2 * 4096 * 4) + 255) & ~(size_t)255;
  o.sU = off; off += (((size_t)128 * 8 * 8192 * 4) + 255) & ~(size_t)255;
  o.cdec = off; off += (((size_t)128 * 8 * 4) + 255) & ~(size_t)255;
  o.vT = off; off += (((size_t)T * 4 * 64 * 2) + 255) & ~(size_t)255;
  o.rtab = off; off += (((size_t)SEQ * 56 * 2 * 4) + 255) & ~(size_t)255;
  o.dpart = off; off += (((size_t)T * 4 * 68 * 4) + 255) & ~(size_t)255;
  o.dtv = off; off += (((size_t)T * 8 * 4) + 255) & ~(size_t)255;
  o.cs = off; off += (((size_t)T * 8 * 4) + 255) & ~(size_t)255;
  o.ybuf = off; off += (((size_t)T * 256 * 4) + 255) & ~(size_t)255;
  o.aff = off; off += (((size_t)T * 16 * 4) + 255) & ~(size_t)255;
  o.gate = off; off += (((size_t)64 * 512 * 4) + 255) & ~(size_t)255;
  o.tok = off; off += (((size_t)64 * 512 * 4) + 255) & ~(size_t)255;
  o.inv = off; off += (((size_t)T * 16 * 4) + 255) & ~(size_t)255;
  o.bar = off; off += (((size_t)(3456 + 64) * 4) + 255) & ~(size_t)255;
  o.xres2 = off; off += (((size_t)T * DM * 2) + 255) & ~(size_t)255;
  o.total = off;
  return o;
}
constexpr WsOff WSO = ws_layout();
struct Params {
  const float *x, *ln1_w, *w_in, *q_norm_w, *kv_norm_w, *w_uq, *w_ukv, *conv_w, *conv_b, *a_log, *dt_bias,
      *ssm_d, *ssm_norm_w, *w_out, *ln2_w, *router_w, *w_gate, *w_up, *w_down, *final_w;
  float* out;
  char* ws;
  int rep[16];
  __host__ DI u16* WinT() const { return reinterpret_cast<u16*>(ws + WSO.WinT); }
  __host__ DI u16* WuqT() const { return reinterpret_cast<u16*>(ws + WSO.WuqT); }
  __host__ DI u16* WukvT() const { return reinterpret_cast<u16*>(ws + WSO.WukvT); }
  __host__ DI u16* WoutT() const { return reinterpret_cast<u16*>(ws + WSO.WoutT); }
  __host__ DI unsigned char* Wgu8() const { return reinterpret_cast<unsigned char*>(ws + WSO.Wgu8); }
  __host__ DI unsigned char* Wd8() const { return reinterpret_cast<unsigned char*>(ws + WSO.Wd8); }
  __host__ DI unsigned char* hn8() const { return reinterpret_cast<unsigned char*>(ws + WSO.hn8); }
  __host__ DI u16* xres() const { return reinterpret_cast<u16*>(ws + WSO.xres); }
  __host__ DI u16* hn() const { return reinterpret_cast<u16*>(ws + WSO.hn); }
  __host__ DI u16* proj() const { return reinterpret_cast<u16*>(ws + WSO.proj); }
  __host__ DI u16* cqn() const { return reinterpret_cast<u16*>(ws + WSO.cqn); }
  __host__ DI u16* ckvn() const { return reinterpret_cast<u16*>(ws + WSO.ckvn); }
  __host__ DI u16* mq() const { return reinterpret_cast<u16*>(ws + WSO.mq); }
  __host__ DI u16* xbc() const { return reinterpret_cast<u16*>(ws + WSO.xbc); }
  __host__ DI u16* mixed() const { return reinterpret_cast<u16*>(ws + WSO.mixed); }
  __host__ DI unsigned char* hid8() const { return reinterpret_cast<unsigned char*>(ws + WSO.hid8); }
  __host__ DI u16* kfull() const { return reinterpret_cast<u16*>(ws + WSO.kfull); }
  __host__ DI u16* rS() const { return reinterpret_cast<u16*>(ws + WSO.rS); }
  __host__ DI u16* sS() const { return reinterpret_cast<u16*>(ws + WSO.sS); }
  __host__ DI float* rU() const { return reinterpret_cast<float*>(ws + WSO.rU); }
  __host__ DI float* sU() const { return reinterpret_cast<float*>(ws + WSO.sU); }
  __host__ DI float* cdec() const { return reinterpret_cast<float*>(ws + WSO.cdec); }
  __host__ DI u16* vT() const { return reinterpret_cast<u16*>(ws + WSO.vT); }
  __host__ DI float* rtab() const { return reinterpret_cast<float*>(ws + WSO.rtab); }
  __host__ DI float* dpart() const { return reinterpret_cast<float*>(ws + WSO.dpart); }
  __host__ DI float* dtv() const { return reinterpret_cast<float*>(ws + WSO.dtv); }
  __host__ DI float* cs() const { return reinterpret_cast<float*>(ws + WSO.cs); }
  __host__ DI float* ybuf() const { return reinterpret_cast<float*>(ws + WSO.ybuf); }
  __host__ DI float* aff() const { return reinterpret_cast<float*>(ws + WSO.aff); }
  __host__ DI float* gate() const { return reinterpret_cast<float*>(ws + WSO.gate); }
  __host__ DI int* tok() const { return reinterpret_cast<int*>(ws + WSO.tok); }
  __host__ DI int* inv() const { return reinterpret_cast<int*>(ws + WSO.inv); }
  __host__ DI unsigned* bar() const { return reinterpret_cast<unsigned*>(ws + WSO.bar); }
  __host__ DI u16* xres2() const { return reinterpret_cast<u16*>(ws + WSO.xres2); }
};


typedef __attribute__((ext_vector_type(2))) __bf16 bf16x2_t;
typedef __attribute__((ext_vector_type(2))) float f32x2_t;
typedef __attribute__((ext_vector_type(16))) float f32x16;
typedef __attribute__((ext_vector_type(4))) short s16x4;
typedef __attribute__((ext_vector_type(8))) int i32x8;
typedef __attribute__((ext_vector_type(4))) int i32x4;
DI unsigned pack2(float a, float b) {
  f32x2_t v = {a, b};
  return __builtin_bit_cast(unsigned, __builtin_convertvector(v, bf16x2_t));
}
DI u16 f2bf(float f) { return (u16)(pack2(f, 0.f) & 0xffffu); }
DI float bf2f(u16 h) { return __uint_as_float(((unsigned)h) << 16); }
DI void unpack8(const uint4& v, float* f) {
  f[0] = __uint_as_float(v.x << 16); f[1] = __uint_as_float(v.x & 0xffff0000u);
  f[2] = __uint_as_float(v.y << 16); f[3] = __uint_as_float(v.y & 0xffff0000u);
  f[4] = __uint_as_float(v.z << 16); f[5] = __uint_as_float(v.z & 0xffff0000u);
  f[6] = __uint_as_float(v.w << 16); f[7] = __uint_as_float(v.w & 0xffff0000u);
}
DI void ld8(const u16* p, float* f) { uint4 v = *reinterpret_cast<const uint4*>(p); unpack8(v, f); }
DI unsigned pk4_f8(float a, float b, float c, float d) {
  a = __builtin_amdgcn_fmed3f(a, -448.f, 448.f); b = __builtin_amdgcn_fmed3f(b, -448.f, 448.f);
  c = __builtin_amdgcn_fmed3f(c, -448.f, 448.f); d = __builtin_amdgcn_fmed3f(d, -448.f, 448.f);
  int w = __builtin_amdgcn_cvt_pk_fp8_f32(a, b, 0, false);
  w = __builtin_amdgcn_cvt_pk_fp8_f32(c, d, w, true);
  return (unsigned)w;
}
constexpr float F8_W_SCALE = 256.f, F8_H_SCALE = 16.f, F8_HID_SCALE = 8.f;
typedef short s16x2_t __attribute__((ext_vector_type(2)));
template <int SCALE> DI unsigned pk4_f8_scaled(float a, float b, float c, float d) {
  constexpr float inv = 1.f / (float)SCALE;
  s16x2_t r = {0, 0};
  r = __builtin_amdgcn_cvt_scalef32_pk_fp8_f32(r, a, b, inv, false);
  r = __builtin_amdgcn_cvt_scalef32_pk_fp8_f32(r, c, d, inv, true);
  return __builtin_bit_cast(unsigned, r);
}
DI float4 bf4_to_f4(const uint2& q) {
  return make_float4(__uint_as_float(q.x << 16), __uint_as_float(q.x & 0xffff0000u), __uint_as_float(q.y << 16), __uint_as_float(q.y & 0xffff0000u));
}
DI float wave_sum(float v) {
#pragma unroll
  for (int o = 32; o > 0; o >>= 1) v += __shfl_xor(v, o);
  return v;
}
DI float dot2acc(unsigned a, unsigned b, float c) {
  return __builtin_amdgcn_fdot2_f32_bf16(__builtin_bit_cast(bf16x2_t, a), __builtin_bit_cast(bf16x2_t, b), c, false);
}
DI float dot8(const uint4& a, const uint4& b, float c) {
  c = dot2acc(a.x, b.x, c); c = dot2acc(a.y, b.y, c); c = dot2acc(a.z, b.z, c); c = dot2acc(a.w, b.w, c);
  return c;
}
DI int otid() { int t = threadIdx.x; asm volatile("" : "+v"(t)); return t; }
DI int obid() { int b = blockIdx.x; asm volatile("" : "+s"(b)); return b; }
DI float silu(float x) { return x / (1.f + __expf(-x)); }
DI float fast_silu(float x) { return x * __builtin_amdgcn_rcpf(1.f + __expf(-x)); }


#define XB_TMO      128
#define XB_XCNT(j)  (256  + 64 * (j))
#define XB_XSUB(j)  (1280 + 64 * (j))
#define XB_XGEN(j)  (2304 + 64 * (j))
#define XB_TOP      3328
#define XB_TOPGEN   3392
#define XCD_BAR_WORDS 3456
#define XB_SPIN_CAP (1u << 20)
#define LAS __attribute__((address_space(3)))
DI unsigned xb_ld(unsigned* p) { return __hip_atomic_load(p, __ATOMIC_RELAXED, __HIP_MEMORY_SCOPE_AGENT); }
DI unsigned xb_add(unsigned* p, unsigned v) { return __hip_atomic_fetch_add(p, v, __ATOMIC_RELAXED, __HIP_MEMORY_SCOPE_AGENT); }
DI unsigned xb_xcc_id() { return (unsigned)__builtin_amdgcn_s_getreg((3 << 11) | 20) & 0xFu; }
#define XB_SPIN(cond, bar) do { unsigned _sp = 0; while (cond) { __builtin_amdgcn_s_sleep(1); \
    if ((++_sp & 255u) == 0u) { if (xb_ld(&(bar)[XB_TMO])) break; if (_sp > XB_SPIN_CAP) { atomicAdd(&(bar)[XB_TMO], 1u); break; } } } } while (0)
struct XcdBarrier { unsigned* bar; unsigned x; volatile LAS unsigned* st; };
DI XcdBarrier xcd_barrier_post(unsigned* bar, volatile LAS unsigned* st) {
  XcdBarrier b; b.bar = bar; b.x = xb_xcc_id(); b.st = st;
  if (threadIdx.x == 0) (void)xb_add(&bar[XB_XCNT(b.x)], 1u);
  return b;
}
DI void xcd_barrier_complete(unsigned* bar, unsigned x, unsigned& nloc, unsigned& nx) {
  const unsigned G = gridDim.x * gridDim.y * gridDim.z;
  unsigned sum, cnt, mine, sp = 0u;
  for (;;) {
    sum = 0u; cnt = 0u; mine = 0u;
#pragma unroll
    for (unsigned j = 0; j < 16; ++j) { const unsigned c = xb_ld(&bar[XB_XCNT(j)]); sum += c; cnt += (c > 0u) ? 1u : 0u; mine = (j == x) ? c : mine; }
    if (sum == G) break;
    __builtin_amdgcn_s_sleep(1);
    if ((++sp & 255u) == 0u) { if (xb_ld(&bar[XB_TMO])) break; if (sp > XB_SPIN_CAP) { atomicAdd(&bar[XB_TMO], 1u); break; } }
  }
  nloc = mine > 0u ? mine : 1u; nx = cnt > 0u ? cnt : 1u;
}
DI void xcd_barrier(const XcdBarrier& b) {
  asm volatile("s_waitcnt vmcnt(0)" ::: "memory");
  __syncthreads();
  if (threadIdx.x == 0) {
    unsigned* bar = b.bar;
    __builtin_amdgcn_s_waitcnt(0);
    unsigned nloc = b.st[0], nx = b.st[1];
    if (nloc == 0u) { xcd_barrier_complete(bar, b.x, nloc, nx); b.st[0] = nloc; b.st[1] = nx; }
    const unsigned old = xb_add(&bar[XB_XSUB(b.x)], 1u);
    const unsigned gen = old / nloc;
    if (old + 1u == (gen + 1u) * nloc) {
      __builtin_amdgcn_fence(__ATOMIC_RELEASE, "agent");
      asm volatile("s_waitcnt vmcnt(0)" ::: "memory");
      const unsigned og = xb_add(&bar[XB_TOP], 1u);
      const unsigned tg = og / nx;
      if (og + 1u == (tg + 1u) * nx) xb_add(&bar[XB_TOPGEN], 1u);
      else XB_SPIN(xb_ld(&bar[XB_TOPGEN]) == tg, bar);
      __builtin_amdgcn_fence(__ATOMIC_ACQUIRE, "agent");
      xb_add(&bar[XB_XGEN(b.x)], 1u);
      asm volatile("s_waitcnt vmcnt(0)" ::: "memory");
    } else {
      XB_SPIN(xb_ld(&bar[XB_XGEN(b.x)]) == gen, bar);
      __builtin_amdgcn_fence(__ATOMIC_ACQUIRE, "agent");
      asm volatile("s_waitcnt vmcnt(0)" ::: "memory");
    }
  }
  __syncthreads();
}

template <class F>
DI void transpose_convert(const float* __restrict__ src, int K, int N, int Npad, u16* __restrict__ dst, F rowmap,
                          int bid, int nb, char* smem) {
  u16* tile = reinterpret_cast<u16*>(smem);
  const int tid = otid();
  const int ntn = Npad / 128, ntk = K / 64;
  for (int t = bid; t < ntn * ntk; t += nb) {
    const int n0 = (t % ntn) * 128, k0 = (t / ntn) * 64;
    f32x4 v[4];
#pragma unroll
    for (int i = 0; i < 4; ++i) {
      const int kk = (tid >> 5) + 16 * i, nn = (tid & 31) * 4;
      v[i] = f32x4{0.f, 0.f, 0.f, 0.f};
      if (n0 + nn < N) v[i] = __builtin_nontemporal_load(reinterpret_cast<const f32x4*>(src + (size_t)(k0 + kk) * N + n0 + nn));
    }
#pragma unroll
    for (int i = 0; i < 4; ++i) {
      const int kk = (tid >> 5) + 16 * i, nn = (tid & 31) * 4;
      tile[(nn + 0) * 72 + kk] = f2bf(v[i][0]); tile[(nn + 1) * 72 + kk] = f2bf(v[i][1]);
      tile[(nn + 2) * 72 + kk] = f2bf(v[i][2]); tile[(nn + 3) * 72 + kk] = f2bf(v[i][3]);
    }
    __syncthreads();
#pragma unroll
    for (int j = 0; j < 2; ++j) {
      const int c = tid + NTHR * j, nn = c >> 3, k8 = (c & 7) * 8;
      const uint4 o = *reinterpret_cast<const uint4*>(tile + nn * 72 + k8);
      *reinterpret_cast<uint4*>(dst + (size_t)rowmap(n0 + nn) * K + k0 + k8) = o;
    }
    __syncthreads();
  }
}

template <class F>
DI void transpose_convert_f8(const float* __restrict__ src, int K, int N, unsigned char* __restrict__ dst, F rowmap,
                             int bid, int nb, char* smem) {
  unsigned char* tile = reinterpret_cast<unsigned char*>(smem);
  const int tid = otid();
  const int ntn = N / 128, ntk = K / 64;
  for (int t = bid; t < ntn * ntk; t += nb) {
    const int n0 = (t % ntn) * 128, k0 = (t / ntn) * 64;
    const int kq = (tid >> 5) * 4, nn = (tid & 31) * 4;
    f32x4 v[4];
#pragma unroll
    for (int r = 0; r < 4; ++r) v[r] = __builtin_nontemporal_load(reinterpret_cast<const f32x4*>(src + (size_t)(k0 + kq + r) * N + n0 + nn));
#pragma unroll
    for (int e = 0; e < 4; ++e)
      *reinterpret_cast<unsigned*>(tile + (nn + e) * 80 + kq) =
          pk4_f8(v[0][e] * F8_W_SCALE, v[1][e] * F8_W_SCALE, v[2][e] * F8_W_SCALE, v[3][e] * F8_W_SCALE);
    __syncthreads();
    {
      const int rn = tid >> 2, kc = (tid & 3) * 16;
      const uint4 o = *reinterpret_cast<const uint4*>(tile + rn * 80 + kc);
      *reinterpret_cast<uint4*>(dst + (size_t)rowmap(n0 + rn) * K + k0 + kc) = o;
    }
    __syncthreads();
  }
}

constexpr int CVT_IN_MLA_E = 16;
struct CvtTile { const float* src; unsigned char* dst; int N, K, n0, k0, mat; };
DI CvtTile cvt_tile(const Params& p, int L, int g) {
  const int e = g / 768, r = g - e * 768, mat = r >> 8, tt = r & 255;
  const size_t le = (size_t)(L * 16 + e);
  CvtTile c;
  c.mat = mat;
  if (mat < 2) { c.src = ((mat == 0) ? p.w_gate : p.w_up) + le * DM * 2048; c.N = 2048; c.dst = p.Wgu8() + le * 4096 * DM; c.K = 1024; c.n0 = (tt & 15) * 128; c.k0 = (tt >> 4) * 64; }
  else { c.src = p.w_down + le * 2048 * DM; c.N = 1024; c.dst = p.Wd8() + le * DM * 2048; c.K = 2048; c.n0 = (tt & 7) * 128; c.k0 = (tt >> 3) * 64; }
  return c;
}
DI int cvt_rowmap(int mat, int n) { return (mat == 2) ? n : ((n >> 7) * 256 + (mat == 1 ? 128 : 0) + (n & 127)); }

constexpr int CVT_IDLE_FIRST_BLK = 64, CVT_IDLE_BLKS = 192;
constexpr int CVT_A = CVT_IDLE_BLKS * 12, CVT_B = CVT_A + CVT_IDLE_BLKS * 8;
static_assert(CVT_B + 33 * 256 >= 12288, "MLA loop must cover the rest");
DI void cvt_tiles_idle(const Params& p, int L, char* smem, int first, int per_blk) {
  const int tid = otid(), ib = obid() - CVT_IDLE_FIRST_BLK;
  unsigned char* tile = reinterpret_cast<unsigned char*>(smem);
  __syncthreads();
#pragma unroll 1
  for (int i = 0; i < per_blk; i += 2) {
    f32x4 v[2][4];
#pragma unroll
    for (int u = 0; u < 2; ++u) {
      const CvtTile ct = cvt_tile(p, L, first + ib + CVT_IDLE_BLKS * (i + u));
      const float* sp = ct.src + (size_t)(ct.k0 + (tid >> 5) * 4) * ct.N + ct.n0 + (tid & 31) * 4;
#pragma unroll
      for (int r = 0; r < 4; ++r) v[u][r] = __builtin_nontemporal_load(reinterpret_cast<const f32x4*>(sp + (size_t)r * ct.N));
    }
#pragma unroll
    for (int u = 0; u < 2; ++u) {
      unsigned char* cb = tile + u * 10240 + (tid & 31) * 4 * 80 + (tid >> 5) * 4;
#pragma unroll
      for (int c = 0; c < 4; ++c) *reinterpret_cast<unsigned*>(cb + c * 80) = pk4_f8_scaled<256>(v[u][0][c], v[u][1][c], v[u][2][c], v[u][3][c]);
    }
    __syncthreads();
#pragma unroll
    for (int u = 0; u < 2; ++u) {
      const CvtTile ct = cvt_tile(p, L, first + ib + CVT_IDLE_BLKS * (i + u));
      unsigned char* cd = ct.dst + (size_t)cvt_rowmap(ct.mat, ct.n0 + (tid >> 2)) * ct.K + ct.k0 + (tid & 3) * 16;
      *reinterpret_cast<uint4*>(cd) = *reinterpret_cast<const uint4*>(tile + u * 10240 + (tid >> 2) * 80 + (tid & 3) * 16);
    }
    __syncthreads();
  }
}

DI void ph_convert(const Params& p, char* smem) {
  const int nb = gridDim.x;
  int bid = obid();
  for (int idx = bid * NTHR + otid(); idx < SEQ * 56; idx += nb * NTHR) {
    const int pos = idx / 56, f = idx - pos * 56;
    float inv;
    if (f < 32) inv = exp2f(-(float)f * (13.287712379549449f / 32.f));
    else if (f < 40) inv = exp2f(-(float)(f - 32) * (18.931568569324174f / 8.f));
    else inv = exp2f(-(float)(f - 40) * (18.931568569324174f / 16.f));
    float sn, cs;
    sincosf((float)pos * inv, &sn, &cs);
    p.rtab()[(size_t)idx * 2] = cs;
    p.rtab()[(size_t)idx * 2 + 1] = sn;
  }
  auto ident = [](int n) { return n; };
  for (int L = 0; L < 2; ++L) {
    transpose_convert(p.w_in + (size_t)L * DM * PW, DM, PW, PWP, p.WinT() + (size_t)L * PWP * DM, ident, bid, nb, smem);
    transpose_convert(p.w_uq + (size_t)L * 256 * 384, 256, 384, 384, p.WuqT() + (size_t)L * 384 * 256, ident, bid, nb, smem);
    transpose_convert(p.w_ukv + (size_t)L * 128 * 512, 128, 512, 512, p.WukvT() + (size_t)L * 512 * 128, ident, bid, nb, smem);
    transpose_convert(p.w_out + (size_t)L * DM * DM, DM, DM, DM, p.WoutT() + (size_t)L * DM * DM, ident, bid, nb, smem);
    for (int e = ((nb == 256) ? CVT_IN_MLA_E : 0); e < 16; ++e) {
      const size_t le = (size_t)(L * 16 + e);
      auto gmap = [](int n) { return (n >> 7) * 256 + (n & 127); };
      auto umap = [](int n) { return (n >> 7) * 256 + 128 + (n & 127); };
      transpose_convert_f8(p.w_gate + le * DM * 2048, DM, 2048, p.Wgu8() + le * 4096 * DM, gmap, bid, nb, smem);
      transpose_convert_f8(p.w_up + le * DM * 2048, DM, 2048, p.Wgu8() + le * 4096 * DM, umap, bid, nb, smem);
      transpose_convert_f8(p.w_down + le * 2048 * DM, 2048, DM, p.Wd8() + le * DM * 2048, ident, bid, nb, smem);
    }
  }
}

template <class RowPtr, class Epi>
DI void gemm_tile(RowPtr arow, const u16* __restrict__ bt, int ldb, int K, char* smem, Epi epi) {
  u16* sa = reinterpret_cast<u16*>(smem);
  u16* sb = sa + 2 * 256 * 72;
  const int tid = otid(), wid = tid >> 6, lane = tid & 63, wr = wid >> 1, wc = wid & 1, fr = lane & 15, fq = lane >> 4;
  f32x4 acc[4][4];
#pragma unroll
  for (int m = 0; m < 4; ++m)
#pragma unroll
    for (int n = 0; n < 4; ++n) acc[m][n] = f32x4{0.f, 0.f, 0.f, 0.f};
  const int lr = tid >> 3, lc = (tid & 7) * 8;
  const u16* ap[4];
#pragma unroll
  for (int i = 0; i < 4; ++i) ap[i] = arow(lr + 64 * i) + lc;
  const u16* bp[2];
#pragma unroll
  for (int i = 0; i < 2; ++i) bp[i] = bt + (size_t)(lr + 64 * i) * ldb + lc;
  uint4 ra[4], rb[2];
  const int nk = K / 64;
#pragma unroll
  for (int i = 0; i < 4; ++i) ra[i] = *reinterpret_cast<const uint4*>(ap[i]);
#pragma unroll
  for (int i = 0; i < 2; ++i) rb[i] = *reinterpret_cast<const uint4*>(bp[i]);
#pragma unroll
  for (int i = 0; i < 4; ++i) *reinterpret_cast<uint4*>(sa + (lr + 64 * i) * 72 + lc) = ra[i];
#pragma unroll
  for (int i = 0; i < 2; ++i) *reinterpret_cast<uint4*>(sb + (lr + 64 * i) * 72 + lc) = rb[i];
  __syncthreads();
  for (int kt = 0; kt < nk; ++kt) {
    const int cur = kt & 1;
    if (kt + 1 < nk) {
#pragma unroll
      for (int i = 0; i < 4; ++i) ra[i] = *reinterpret_cast<const uint4*>(ap[i] + (kt + 1) * 64);
#pragma unroll
      for (int i = 0; i < 2; ++i) rb[i] = *reinterpret_cast<const uint4*>(bp[i] + (kt + 1) * 64);
    }
    const u16* ca = sa + cur * 256 * 72;
    const u16* cb = sb + cur * 128 * 72;
#pragma unroll
    for (int kk = 0; kk < 2; ++kk) {
      bf16x8 af[4], bfr[4];
#pragma unroll
      for (int m = 0; m < 4; ++m) af[m] = *reinterpret_cast<const bf16x8*>(ca + (wr * 64 + m * 16 + fr) * 72 + kk * 32 + fq * 8);
#pragma unroll
      for (int n = 0; n < 4; ++n) bfr[n] = *reinterpret_cast<const bf16x8*>(cb + (wc * 64 + n * 16 + fr) * 72 + kk * 32 + fq * 8);
#pragma unroll
      for (int m = 0; m < 4; ++m)
#pragma unroll
        for (int n = 0; n < 4; ++n) acc[m][n] = __builtin_amdgcn_mfma_f32_16x16x32_bf16(af[m], bfr[n], acc[m][n], 0, 0, 0);
    }
    if (kt + 1 < nk) {
      u16* na = sa + (cur ^ 1) * 256 * 72;
      u16* nbp = sb + (cur ^ 1) * 128 * 72;
#pragma unroll
      for (int i = 0; i < 4; ++i) *reinterpret_cast<uint4*>(na + (lr + 64 * i) * 72 + lc) = ra[i];
#pragma unroll
      for (int i = 0; i < 2; ++i) *reinterpret_cast<uint4*>(nbp + (lr + 64 * i) * 72 + lc) = rb[i];
    }
    __syncthreads();
  }
  epi(acc, wr, wc, fr, fq);
}

#define WAIT_V(n) asm volatile("s_waitcnt vmcnt(%0)" ::"n"(n) : "memory")
DI int lds_byte2(int r, int c) {
  const int st = (r >> 4) * 2 + (c >> 5), ob = (r & 15) * 64 + (c & 31) * 2;
  return st * 1024 + (ob ^ (((ob >> 9) & 1) << 5));
}
DI void stage_rc2(int b, int& R, int& C) {
  const int st = b >> 10, sb = b & 1023, swz = sb ^ (((sb >> 9) & 1) << 5);
  R = (st >> 1) * 16 + swz / 64;
  C = (st & 1) * 32 + (swz % 64) / 2;
}
typedef __attribute__((address_space(3))) unsigned lds_u32;
template <class RowPtr, class Epi>
DI void gemm256(RowPtr arow, const u16* __restrict__ bt, int ldb, int K, char* smem, Epi epi) {
  constexpr int TILE_B = 256 * 64 * 2, STAGE_B = 2 * TILE_B;
  const int tid = otid(), wid = tid >> 6, lane = tid & 63, wr = wid >> 2, wc = wid & 3, fr = lane & 15, fq = lane >> 4;
  const u16* ap[4];
  const u16* bp[4];
#pragma unroll
  for (int i = 0; i < 4; ++i) {
    int R, C;
    stage_rc2(wid * 1024 + i * 8192 + lane * 16, R, C);
    ap[i] = arow(R) + C;
    bp[i] = bt + (size_t)R * ldb + C;
  }
  f32x4 acc[8][4];
#pragma unroll
  for (int m = 0; m < 8; ++m)
#pragma unroll
    for (int n = 0; n < 4; ++n) acc[m][n] = f32x4{0.f, 0.f, 0.f, 0.f};
#define G2_STAGE(buf, kt)                                                                                              \
  do {                                                                                                                 \
    _Pragma("unroll") for (int i = 0; i < 4; ++i) {                                                                    \
      __builtin_amdgcn_global_load_lds((const unsigned*)(ap[i] + (kt) * 64),                                           \
                                       (lds_u32*)(smem + (buf) * STAGE_B + wid * 1024 + i * 8192), 16, 0, 0);          \
      __builtin_amdgcn_global_load_lds((const unsigned*)(bp[i] + (kt) * 64),                                           \
                                       (lds_u32*)(smem + (buf) * STAGE_B + TILE_B + wid * 1024 + i * 8192), 16, 0, 0); \
    }                                                                                                                  \
  } while (0)
  const int nt = K / 64;
  G2_STAGE(0, 0);
  WAIT_V(0);
  __syncthreads();
  for (int t = 0; t < nt; ++t) {
    const int cur = t & 1;
    if (t + 1 < nt) G2_STAGE(cur ^ 1, t + 1);
    const char* sA = smem + cur * STAGE_B;
    const char* sB = sA + TILE_B;
#pragma unroll
    for (int ks = 0; ks < 2; ++ks) {
      bf16x8 At[8], Bf[4];
#pragma unroll
      for (int m = 0; m < 8; ++m) At[m] = *reinterpret_cast<const bf16x8*>(sA + lds_byte2(wr * 128 + m * 16 + fr, ks * 32 + fq * 8));
#pragma unroll
      for (int n = 0; n < 4; ++n) Bf[n] = *reinterpret_cast<const bf16x8*>(sB + lds_byte2(wc * 64 + n * 16 + fr, ks * 32 + fq * 8));
#pragma unroll
      for (int m = 0; m < 8; ++m)
#pragma unroll
        for (int n = 0; n < 4; ++n) acc[m][n] = __builtin_amdgcn_mfma_f32_16x16x32_bf16(Bf[n], At[m], acc[m][n], 0, 0, 0);
      __builtin_amdgcn_sched_barrier(0);
    }
    WAIT_V(0);
    __syncthreads();
  }
  epi(acc, wr, wc, fr, fq);
}

namespace pg8 {
constexpr int BM = 256, BK = 64, HALF = 128, HTB = HALF * BK * 2;
DI int lds_byte(int r, int c) { const int st = (r >> 4) * 2 + (c >> 5), rr = r & 15, cc = c & 31, ob = rr * 64 + cc * 2; return st * 1024 + (ob ^ (((ob >> 9) & 1) << 5)); }
DI void stage_rc(int b, int& R, int& C) { const int st = b / 1024, sb = b % 1024, swz = sb ^ (((sb >> 9) & 1) << 5); R = (st >> 1) * 16 + swz / 64; C = (st & 1) * 32 + (swz % 64) / 2; }
DI int perm32(int rho) { const int n = rho >> 4, i = rho & 15; return 8 * (i >> 2) + 4 * n + (i & 3); }
struct Unit { int pm, pn; };
typedef __attribute__((address_space(3))) unsigned char lds_u8;
typedef __attribute__((address_space(3))) unsigned lds_u32;
typedef __attribute__((address_space(3))) bf16x8 lds_bf16x8;
typedef __attribute__((address_space(3))) i32x4 lds_i32x4;

template <class Cfg>
DI void gemm_phase(lds_u8* lds, const Cfg& S) {
  const int tid = otid(), wid = __builtin_amdgcn_readfirstlane(tid >> 6), lane = tid & 63, wr = wid >> 2, wc = wid & 3, fr = lane & 15, fq = lane >> 4;
  const int K = S.K, nt = K / BK;
  int R0, C0, R1, C1;
  stage_rc(tid * 16, R0, C0);
  stage_rc(tid * 16 + 8192, R1, C1);
  unsigned voffB[2];
  {
    const int Rb0 = Cfg::PERM ? ((R0 & ~31) + perm32(R0 & 31)) : R0, Rb1 = Cfg::PERM ? ((R1 & ~31) + perm32(R1 & 31)) : R1;
    voffB[0] = (unsigned)(Rb0 * K + C0) * 2u; voffB[1] = (unsigned)(Rb1 * K + C1) * 2u;
  }
  const size_t kstep = (size_t)(BK * 2);
  const size_t hstep = (size_t)HALF * K * 2;
  const unsigned ldsw = (unsigned)wid * 1024u;
  const int aoff = lds_byte(wr * 64 + fr, fq * 8), boff = lds_byte(wc * 32 + fr, fq * 8);
#define PG8_SA(b, h) (((b) * 2 + (h)) * HTB)
#define PG8_SB(b, h) ((4 + (b) * 2 + (h)) * HTB)
#define PG8_STAGE2(bufoff, gbase, o0, o1) do { \
    __builtin_amdgcn_global_load_lds((const unsigned*)((const char*)(gbase) + (o0)), (lds_u32*)(lds + (bufoff) + ldsw), 16, 0, 0); \
    __builtin_amdgcn_global_load_lds((const unsigned*)((const char*)(gbase) + (o1)), (lds_u32*)(lds + (bufoff) + ldsw + 8192), 16, 0, 0); } while (0)
#define PG8_STAGEB(bufoff, gbase) PG8_STAGE2(bufoff, gbase, voffB[0], voffB[1])
#define PG8_LDA(dst, b, h) do { _Pragma("unroll") for (int m = 0; m < 4; ++m) _Pragma("unroll") for (int k = 0; k < 2; ++k) dst[m][k] = *(const lds_bf16x8*)(lds + PG8_SA(b, h) + aoff + m * 2048 + k * 1024); } while (0)
#define PG8_LDB(dst, b, h) do { _Pragma("unroll") for (int n = 0; n < 2; ++n) _Pragma("unroll") for (int k = 0; k < 2; ++k) dst[n][k] = *(const lds_bf16x8*)(lds + PG8_SB(b, h) + boff + n * 2048 + k * 1024); } while (0)
#define PG8_MMA(ai, bj, At, Bt) do { __builtin_amdgcn_s_setprio(1); _Pragma("unroll") for (int m = 0; m < 4; ++m) _Pragma("unroll") for (int n = 0; n < 2; ++n) _Pragma("unroll") for (int k = 0; k < 2; ++k) \
    acc[ai][bj][m][n] = __builtin_amdgcn_mfma_f32_16x16x32_bf16(Bt[n][k], At[m][k], acc[ai][bj][m][n], 0, 0, 0); __builtin_amdgcn_s_setprio(0); } while (0)
#define PG8_WAIT_V(n) asm volatile("s_waitcnt vmcnt(" #n ")" ::: "memory")
#define PG8_WAIT_L(n) asm volatile("s_waitcnt lgkmcnt(" #n ")" ::: "memory")
#define PG8_BAR __builtin_amdgcn_s_barrier()
#define PG8_SCHED __builtin_amdgcn_sched_barrier(0)
  Unit cur, nxt; int ui = 0;
  if (!S.next(0, cur)) return;
  f32x4 acc[2][2][4][2];
#pragma unroll
  for (int a = 0; a < 2; ++a)
#pragma unroll
    for (int b = 0; b < 2; ++b)
#pragma unroll
      for (int m = 0; m < 4; ++m)
#pragma unroll
        for (int n = 0; n < 2; ++n) acc[a][b][m][n] = f32x4{0.f, 0.f, 0.f, 0.f};
  bf16x8 At[4][2], B0[2][2], B1[2][2];
  const char* cA = S.a_base(cur);
  const char* cB = S.b_base(cur);
  unsigned vc[4], vn[4];
  S.a_off(cur, R0, C0, R1, C1, vc);
  PG8_STAGEB(PG8_SB(0, 0), cB); PG8_STAGE2(PG8_SA(0, 0), cA, vc[0], vc[1]); PG8_STAGEB(PG8_SB(0, 1), cB + hstep); PG8_STAGE2(PG8_SA(0, 1), cA, vc[2], vc[3]);
  if (wr == 1) PG8_BAR;
  PG8_WAIT_V(4); PG8_BAR;
  PG8_STAGEB(PG8_SB(1, 0), cB + kstep); PG8_STAGE2(PG8_SA(1, 0), cA + kstep, vc[0], vc[1]); PG8_STAGEB(PG8_SB(1, 1), cB + hstep + kstep);
  PG8_WAIT_V(6); PG8_BAR;
  for (;;) {
    const bool has_next = S.next(ui + 1, nxt);
    const char* nA = has_next ? S.a_base(nxt) : cA;
    const char* nB = has_next ? S.b_base(nxt) : cB;
    if (has_next) S.a_off(nxt, R0, C0, R1, C1, vn);
    else { vn[0] = vc[0]; vn[1] = vc[1]; vn[2] = vc[2]; vn[3] = vc[3]; }
    for (int t = 0; t < nt; t += 2) {
      const bool last = (t == nt - 2);
      const char* a1 = cA + (size_t)(t + 1) * kstep;
      const char* a2 = last ? nA : cA + (size_t)(t + 2) * kstep;
      const char* b2 = last ? nB : cB + (size_t)(t + 2) * kstep;
      const char* a3 = a2 + kstep;
      const char* b3 = b2 + kstep;
      const unsigned w0 = last ? vn[0] : vc[0], w1 = last ? vn[1] : vc[1], w2 = last ? vn[2] : vc[2], w3 = last ? vn[3] : vc[3];
      PG8_LDB(B0, 0, 0); PG8_SCHED; PG8_LDA(At, 0, 0); PG8_STAGE2(PG8_SA(1, 1), a1, vc[2], vc[3]);
      PG8_WAIT_L(8); PG8_BAR; PG8_WAIT_L(0); PG8_MMA(0, 0, At, B0); PG8_BAR; PG8_SCHED;
      PG8_LDB(B1, 0, 1); PG8_STAGEB(PG8_SB(0, 0), b2);
      PG8_BAR; PG8_WAIT_L(0); PG8_MMA(0, 1, At, B1); PG8_BAR;
      PG8_LDA(At, 0, 1); PG8_STAGE2(PG8_SA(0, 0), a2, w0, w1);
      PG8_BAR; PG8_WAIT_L(0); PG8_MMA(1, 0, At, B0); PG8_BAR; PG8_SCHED;
      PG8_STAGEB(PG8_SB(0, 1), b2 + hstep);
      PG8_WAIT_V(6); PG8_BAR; PG8_MMA(1, 1, At, B1); PG8_BAR;
      PG8_LDB(B0, 1, 0); PG8_SCHED; PG8_LDA(At, 1, 0); PG8_STAGE2(PG8_SA(0, 1), a2, w2, w3);
      PG8_WAIT_L(8); PG8_BAR; PG8_WAIT_L(0); PG8_MMA(0, 0, At, B0); PG8_BAR; PG8_SCHED;
      PG8_LDB(B1, 1, 1); PG8_STAGEB(PG8_SB(1, 0), b3);
      PG8_BAR; PG8_WAIT_L(0); PG8_MMA(0, 1, At, B1); PG8_BAR;
      PG8_LDA(At, 1, 1); PG8_STAGE2(PG8_SA(1, 0), a3, w0, w1);
      PG8_BAR; PG8_WAIT_L(0); PG8_MMA(1, 0, At, B0); PG8_BAR; PG8_SCHED;
      PG8_STAGEB(PG8_SB(1, 1), b3 + hstep);
      PG8_WAIT_V(6); PG8_BAR; PG8_MMA(1, 1, At, B1); PG8_BAR;
    }
    S.epi(acc, cur, wr, wc, fr, fq);
    if (!has_next) break;
#pragma unroll
    for (int a = 0; a < 2; ++a)
#pragma unroll
      for (int b = 0; b < 2; ++b)
#pragma unroll
        for (int m = 0; m < 4; ++m)
#pragma unroll
          for (int n = 0; n < 2; ++n) acc[a][b][m][n] = f32x4{0.f, 0.f, 0.f, 0.f};
    cur = nxt; cA = nA; cB = nB; ++ui;
    vc[0] = vn[0]; vc[1] = vn[1]; vc[2] = vn[2]; vc[3] = vn[3];
  }
  PG8_WAIT_V(0);
  if (wr == 0) PG8_BAR;
  PG8_BAR;
#undef PG8_SA
#undef PG8_SB
#undef PG8_STAGE2
#undef PG8_STAGEB
#undef PG8_LDA
#undef PG8_LDB
#undef PG8_MMA
#undef PG8_WAIT_V
#undef PG8_WAIT_L
#undef PG8_BAR
#undef PG8_SCHED
}
template <class Cfg>
DI void gemm_phase_f8(lds_u8* lds, const Cfg& S) {
  const int tid = otid(), wid = __builtin_amdgcn_readfirstlane(tid >> 6), lane = tid & 63, wr = wid >> 2, wc = wid & 3, fr = lane & 15, fq = lane >> 4;
  const int K = S.K, nt = K / BK;
  int R0, C0, R1, C1;
  stage_rc(tid * 16, R0, C0);
  stage_rc(tid * 16 + 8192, R1, C1);
  unsigned voffB[2];
  {
    const int Rb0 = Cfg::PERM ? ((R0 & ~31) + perm32(R0 & 31)) : R0, Rb1 = Cfg::PERM ? ((R1 & ~31) + perm32(R1 & 31)) : R1;
    voffB[0] = (unsigned)(Rb0 * K + C0) * 2u; voffB[1] = (unsigned)(Rb1 * K + C1) * 2u;
  }
  const size_t kstep = (size_t)(BK * 2);
  const size_t hstep = (size_t)HALF * K * 2;
  const unsigned ldsw = (unsigned)wid * 1024u;
  const int cl = 2 * fq + (fq & 1), ch = 2 * fq + 1 - (fq & 1);
  const int aoffL = lds_byte(wr * 64 + fr, cl * 8), aoffH = lds_byte(wr * 64 + fr, ch * 8);
  const int boffL = lds_byte(wc * 32 + fr, cl * 8), boffH = lds_byte(wc * 32 + fr, ch * 8);
#define PG8_SA(b, h) (((b) * 2 + (h)) * HTB)
#define PG8_SB(b, h) ((4 + (b) * 2 + (h)) * HTB)
#define PG8_STAGE2(bufoff, gbase, o0, o1) do { \
    __builtin_amdgcn_global_load_lds((const unsigned*)((const char*)(gbase) + (o0)), (lds_u32*)(lds + (bufoff) + ldsw), 16, 0, 0); \
    __builtin_amdgcn_global_load_lds((const unsigned*)((const char*)(gbase) + (o1)), (lds_u32*)(lds + (bufoff) + ldsw + 8192), 16, 0, 0); } while (0)
#define PG8_STAGEB(bufoff, gbase) PG8_STAGE2(bufoff, gbase, voffB[0], voffB[1])
#define PG8_LDA(dst, b, h) do { _Pragma("unroll") for (int m = 0; m < 4; ++m) { const i32x4 lo_ = *(const lds_i32x4*)(lds + PG8_SA(b, h) + aoffL + m * 2048), hi_ = *(const lds_i32x4*)(lds + PG8_SA(b, h) + aoffH + m * 2048); dst[m] = __builtin_shufflevector(lo_, hi_, 0, 1, 2, 3, 4, 5, 6, 7); } } while (0)
#define PG8_LDB(dst, b, h) do { _Pragma("unroll") for (int n = 0; n < 2; ++n) { const i32x4 lo_ = *(const lds_i32x4*)(lds + PG8_SB(b, h) + boffL + n * 2048), hi_ = *(const lds_i32x4*)(lds + PG8_SB(b, h) + boffH + n * 2048); dst[n] = __builtin_shufflevector(lo_, hi_, 0, 1, 2, 3, 4, 5, 6, 7); } } while (0)
#define PG8_MMA(ai, bj, At, Bt) do { __builtin_amdgcn_s_setprio(1); _Pragma("unroll") for (int m = 0; m < 4; ++m) _Pragma("unroll") for (int n = 0; n < 2; ++n) \
    asm volatile("v_mfma_f32_16x16x128_f8f6f4 %0, %1, %2, %0" : "+v"(acc[ai][bj][m][n]) : "v"(Bt[n]), "v"(At[m])); __builtin_amdgcn_s_setprio(0); } while (0)
#define PG8_WAIT_V(n) asm volatile("s_waitcnt vmcnt(" #n ")" ::: "memory")
#define PG8_WAIT_L(n) asm volatile("s_waitcnt lgkmcnt(" #n ")" ::: "memory")
#define PG8_BAR __builtin_amdgcn_s_barrier()
#define PG8_SCHED __builtin_amdgcn_sched_barrier(0)
  Unit cur, nxt; int ui = 0;
  if (!S.next(0, cur)) return;
  f32x4 acc[2][2][4][2];
#pragma unroll
  for (int a = 0; a < 2; ++a)
#pragma unroll
    for (int b = 0; b < 2; ++b)
#pragma unroll
      for (int m = 0; m < 4; ++m)
#pragma unroll
        for (int n = 0; n < 2; ++n) acc[a][b][m][n] = f32x4{0.f, 0.f, 0.f, 0.f};
  i32x8 At[4], B0[2], B1[2];
  const char* cA = S.a_base(cur);
  const char* cB = S.b_base(cur);
  unsigned vc[4], vn[4];
  S.a_off(cur, R0, C0, R1, C1, vc, 0);
  PG8_STAGEB(PG8_SB(0, 0), cB); PG8_STAGE2(PG8_SA(0, 0), cA, vc[0], vc[1]); PG8_STAGEB(PG8_SB(0, 1), cB + hstep); PG8_STAGE2(PG8_SA(0, 1), cA, vc[2], vc[3]);
  if (wr == 1) PG8_BAR;
  PG8_WAIT_V(4); PG8_BAR;
  PG8_STAGEB(PG8_SB(1, 0), cB + kstep); PG8_STAGE2(PG8_SA(1, 0), cA + kstep, vc[0], vc[1]); PG8_STAGEB(PG8_SB(1, 1), cB + hstep + kstep);
  PG8_WAIT_V(6); PG8_BAR;
  for (;;) {
    const bool has_next = S.next(ui + 1, nxt);
    const char* nA = has_next ? S.a_base(nxt) : cA;
    const char* nB = has_next ? S.b_base(nxt) : cB;
    if (has_next) S.a_off(nxt, R0, C0, R1, C1, vn, ui + 1);
    else { vn[0] = vc[0]; vn[1] = vc[1]; vn[2] = vc[2]; vn[3] = vc[3]; }
    for (int t = 0; t < nt; t += 2) {
      const bool last = (t == nt - 2);
      const char* a1 = cA + (size_t)(t + 1) * kstep;
      const char* a2 = last ? nA : cA + (size_t)(t + 2) * kstep;
      const char* b2 = last ? nB : cB + (size_t)(t + 2) * kstep;
      const char* a3 = a2 + kstep;
      const char* b3 = b2 + kstep;
      const unsigned w0 = last ? vn[0] : vc[0], w1 = last ? vn[1] : vc[1], w2 = last ? vn[2] : vc[2], w3 = last ? vn[3] : vc[3];
      PG8_LDB(B0, 0, 0); PG8_SCHED; PG8_LDA(At, 0, 0); PG8_STAGE2(PG8_SA(1, 1), a1, vc[2], vc[3]);
      PG8_WAIT_L(8); PG8_BAR; PG8_WAIT_L(0); PG8_MMA(0, 0, At, B0); PG8_BAR; PG8_SCHED;
      PG8_LDB(B1, 0, 1); PG8_STAGEB(PG8_SB(0, 0), b2);
      PG8_BAR; PG8_WAIT_L(0); PG8_MMA(0, 1, At, B1); PG8_BAR;
      PG8_LDA(At, 0, 1); PG8_STAGE2(PG8_SA(0, 0), a2, w0, w1);
      PG8_BAR; PG8_WAIT_L(0); PG8_MMA(1, 0, At, B0); PG8_BAR; PG8_SCHED;
      PG8_STAGEB(PG8_SB(0, 1), b2 + hstep);
      PG8_WAIT_V(6); PG8_BAR; PG8_MMA(1, 1, At, B1); PG8_BAR;
      PG8_LDB(B0, 1, 0); PG8_SCHED; PG8_LDA(At, 1, 0); PG8_STAGE2(PG8_SA(0, 1), a2, w2, w3);
      PG8_WAIT_L(8); PG8_BAR; PG8_WAIT_L(0); PG8_MMA(0, 0, At, B0); PG8_BAR; PG8_SCHED;
      PG8_LDB(B1, 1, 1); PG8_STAGEB(PG8_SB(1, 0), b3);
      PG8_BAR; PG8_WAIT_L(0); PG8_MMA(0, 1, At, B1); PG8_BAR;
      PG8_LDA(At, 1, 1); PG8_STAGE2(PG8_SA(1, 0), a3, w0, w1);
      PG8_BAR; PG8_WAIT_L(0); PG8_MMA(1, 0, At, B0); PG8_BAR; PG8_SCHED;
      PG8_STAGEB(PG8_SB(1, 1), b3 + hstep);
      PG8_WAIT_V(6); PG8_BAR; PG8_MMA(1, 1, At, B1); PG8_BAR;
    }
    asm volatile("s_nop 15\n\ts_nop 15" ::: "memory");
    S.epi(acc, cur, wr, wc, fr, fq);
    if (!has_next) break;
#pragma unroll
    for (int a = 0; a < 2; ++a)
#pragma unroll
      for (int b = 0; b < 2; ++b)
#pragma unroll
        for (int m = 0; m < 4; ++m)
#pragma unroll
          for (int n = 0; n < 2; ++n) acc[a][b][m][n] = f32x4{0.f, 0.f, 0.f, 0.f};
    cur = nxt; cA = nA; cB = nB; ++ui;
    vc[0] = vn[0]; vc[1] = vn[1]; vc[2] = vn[2]; vc[3] = vn[3];
  }
  PG8_WAIT_V(0);
  if (wr == 0) PG8_BAR;
  PG8_BAR;
#undef PG8_SA
#undef PG8_SB
#undef PG8_STAGE2
#undef PG8_STAGEB
#undef PG8_LDA
#undef PG8_LDB
#undef PG8_MMA
#undef PG8_WAIT_V
#undef PG8_WAIT_L
#undef PG8_BAR
#undef PG8_SCHED
}
}

struct CfgInproj {
  static constexpr bool PERM = true;
  int K; const Params* p; int L; int bid, nb;
  DI bool next(int i, pg8::Unit& u) const { const int t = i * nb + bid; if (t >= 64 * 13) return false; u.pm = t & 63; u.pn = t >> 6; return true; }
  DI const char* a_base(const pg8::Unit& u) const { return (const char*)(p->hn() + (size_t)u.pm * 256 * DM); }
  DI const char* b_base(const pg8::Unit& u) const { return (const char*)(p->WinT() + ((size_t)L * PWP + (size_t)u.pn * 256) * DM); }
  DI void a_off(const pg8::Unit&, int R0, int C0, int R1, int C1, unsigned (&vo)[4]) const {
    vo[0] = (unsigned)(R0 * DM + C0) * 2u; vo[1] = (unsigned)(R1 * DM + C1) * 2u;
    vo[2] = vo[0] + 128u * DM * 2u; vo[3] = vo[1] + 128u * DM * 2u;
  }
  DI void epi(const f32x4 (&acc)[2][2][4][2], const pg8::Unit& u, int wr, int wc, int fr, int fq) const {
    const int row0 = u.pm * 256 + wr * 64 + fr, col0 = u.pn * 256 + wc * 32 + 8 * fq;
#pragma unroll
    for (int ai = 0; ai < 2; ++ai)
#pragma unroll
      for (int m = 0; m < 4; ++m) {
        u16* rowp = p->proj() + (size_t)(row0 + ai * 128 + m * 16) * PWP + col0;
#pragma unroll
        for (int bj = 0; bj < 2; ++bj) {
          uint4 w;
          w.x = pack2(acc[ai][bj][m][0][0], acc[ai][bj][m][0][1]); w.y = pack2(acc[ai][bj][m][0][2], acc[ai][bj][m][0][3]);
          w.z = pack2(acc[ai][bj][m][1][0], acc[ai][bj][m][1][1]); w.w = pack2(acc[ai][bj][m][1][2], acc[ai][bj][m][1][3]);
          *reinterpret_cast<uint4*>(rowp + bj * 128) = w;
        }
      }
  }
};
DI void ph_inproj_tail(const Params& p, int L, char* smem, int t) {
  const int m0 = (t & 63) * 256, n0 = 3072 + (t >> 6) * 128;
  const u16* Bt = p.WinT() + ((size_t)L * PWP + n0) * DM;
  gemm_tile([&](int r) { return p.hn() + (size_t)(m0 + r) * DM; }, Bt, DM, DM, smem,
            [&](f32x4 (&acc)[4][4], int wr, int wc, int fr, int fq) {
#pragma unroll
              for (int m = 0; m < 4; ++m)
#pragma unroll
                for (int n = 0; n < 4; ++n)
#pragma unroll
                  for (int j = 0; j < 4; ++j)
                    p.proj()[(size_t)(m0 + wr * 64 + m * 16 + fq * 4 + j) * PWP + n0 + wc * 64 + n * 16 + fr] = f2bf(acc[m][n][j]);
            });
}
DI void ph_inproj(const Params& p, int L, char* smem) {
  CfgInproj c; c.K = DM; c.p = &p; c.L = L; c.bid = obid(); c.nb = gridDim.x;
  pg8::gemm_phase((pg8::lds_u8*)smem, c);
  if (gridDim.x == 256 && obid() >= CVT_IDLE_FIRST_BLK) cvt_tiles_idle(p, L, smem, 0, 12);
}

DI void ph_gemm_store_bf16(const u16* A, int lda, const u16* Bt, int K, int M, int N, u16* C, int ldc, char* smem, int rot) {
  const int mt = M / 256, nt = N / 128;
  const int nb = gridDim.x;
  for (int t = (obid() + rot) % nb; t < mt * nt; t += nb) {
    const int m0 = (t % mt) * 256, n0 = (t / mt) * 128;
    gemm_tile([&](int r) { return A + (size_t)(m0 + r) * lda; }, Bt + (size_t)n0 * K, K, K, smem,
              [&](f32x4 (&acc)[4][4], int wr, int wc, int fr, int fq) {
#pragma unroll
                for (int m = 0; m < 4; ++m)
#pragma unroll
                  for (int n = 0; n < 4; ++n)
#pragma unroll
                    for (int j = 0; j < 4; ++j) {
                      const int row = m0 + wr * 64 + m * 16 + fq * 4 + j, col = n0 + wc * 64 + n * 16 + fr;
                      C[(size_t)row * ldc + col] = f2bf(acc[m][n][j]);
                    }
              });
  }
}

DI void ph_rmsnorm_bf16(const float* __restrict__ xin, const float* __restrict__ w, u16* __restrict__ outp) {
  const int tid_ = otid(); const int lane = tid_ & 63, gw = (obid() * NTHR + tid_) >> 6, nw = gridDim.x * (NTHR / 64);
  for (int t = gw; t < T; t += nw) {
    const float* xr = xin + (size_t)t * DM;
    float4 v[4];
    float ss = 0.f;
#pragma unroll
    for (int i = 0; i < 4; ++i) {
      v[i] = *reinterpret_cast<const float4*>(xr + (i * 64 + lane) * 4);
      ss += v[i].x * v[i].x + v[i].y * v[i].y + v[i].z * v[i].z + v[i].w * v[i].w;
    }
    ss = wave_sum(ss);
    const float rstd = rsqrtf(ss * (1.f / DM) + 1e-6f);
#pragma unroll
    for (int i = 0; i < 4; ++i) {
      const int c = (i * 64 + lane) * 4;
      const float4 ww = *reinterpret_cast<const float4*>(w + c);
      uint2 o;
      o.x = pack2(v[i].x * rstd * ww.x, v[i].y * rstd * ww.y);
      o.y = pack2(v[i].z * rstd * ww.z, v[i].w * rstd * ww.w);
      *reinterpret_cast<uint2*>(outp + (size_t)t * DM + c) = o;
    }
  }
}

DI void ph_final_norm(const float* __restrict__ xin, const float* __restrict__ w, float* __restrict__ outp) {
  const int tid_ = otid(); const int lane = tid_ & 63, gw = (obid() * NTHR + tid_) >> 6, nw = gridDim.x * (NTHR / 64);
  for (int t = gw; t < T; t += nw) {
    const float* xr = xin + (size_t)t * DM;
    float4 v[4];
    float ss = 0.f;
#pragma unroll
    for (int i = 0; i < 4; ++i) {
      v[i] = *reinterpret_cast<const float4*>(xr + (i * 64 + lane) * 4);
      ss += v[i].x * v[i].x + v[i].y * v[i].y + v[i].z * v[i].z + v[i].w * v[i].w;
    }
    ss = wave_sum(ss);
    const float rstd = rsqrtf(ss * (1.f / DM) + 1e-6f);
#pragma unroll
    for (int i = 0; i < 4; ++i) {
      const int c = (i * 64 + lane) * 4;
      const float4 ww = *reinterpret_cast<const float4*>(w + c);
      float4 o = make_float4(v[i].x * rstd * ww.x, v[i].y * rstd * ww.y, v[i].z * rstd * ww.z, v[i].w * rstd * ww.w);
      *reinterpret_cast<float4*>(outp + (size_t)t * DM + c) = o;
    }
  }
}

DI void rot8(const u16* x1p, const u16* x2p, const float* tab  , float scale, uint4& o1, uint4& o2) {
  float x1[8], x2[8], y1[8], y2[8];
  ld8(x1p, x1); ld8(x2p, x2);
#pragma unroll
  for (int e = 0; e < 8; e += 2) {
    const float4 cs = *reinterpret_cast<const float4*>(tab + e * 2);
    y1[e] = (x1[e] * cs.x - x2[e] * cs.y) * scale;
    y2[e] = (x2[e] * cs.x + x1[e] * cs.y) * scale;
    y1[e + 1] = (x1[e + 1] * cs.z - x2[e + 1] * cs.w) * scale;
    y2[e + 1] = (x2[e + 1] * cs.z + x1[e + 1] * cs.w) * scale;
  }
  o1.x = pack2(y1[0], y1[1]); o1.y = pack2(y1[2], y1[3]); o1.z = pack2(y1[4], y1[5]); o1.w = pack2(y1[6], y1[7]);
  o2.x = pack2(y2[0], y2[1]); o2.y = pack2(y2[2], y2[3]); o2.z = pack2(y2[4], y2[5]); o2.w = pack2(y2[6], y2[7]);
}
DI void ph_post(const Params& p, int L) {
  const int tid = otid();
  const int gt = obid() * NTHR + tid, gs = gridDim.x * NTHR;
  const int lane = tid & 63, gw = gt >> 6, nw = gs >> 6;
  const float* qnw = p.q_norm_w + L * 256;
  const float* kvnw = p.kv_norm_w + L * 128;
  const float* cw = p.conv_w + L * 5 * 768;
  const float* cb = p.conv_b + L * 768;
  const float* dtb = p.dt_bias + L * 8;
  {
    uint4 xr[5];
    auto load_taps = [&](int idx, uint4 (&r)[5]) {
      const int t = idx / 96, cg = idx - t * 96, s = t & (SEQ - 1);
#pragma unroll
      for (int w = 0; w < 5; ++w) {
        const int ss = s + w - 2;
        const int tt = (ss >= 0 && ss < SEQ) ? (t + w - 2) : t;
        r[w] = *reinterpret_cast<const uint4*>(p.proj() + (size_t)tt * PWP + C_XBC + cg * 8);
      }
    };
    if (gt < T * 96) load_taps(gt, xr);
    for (int idx = gt; idx < T * 96; idx += gs) {
      const int t = idx / 96, cg = idx - t * 96, s = t & (SEQ - 1);
      uint4 xn[5];
      const int idn = (idx + gs < T * 96) ? (idx + gs) : idx;
      load_taps(idn, xn);
      float acc[8];
      {
        const float4 b0 = *reinterpret_cast<const float4*>(cb + cg * 8), b1 = *reinterpret_cast<const float4*>(cb + cg * 8 + 4);
        acc[0] = b0.x; acc[1] = b0.y; acc[2] = b0.z; acc[3] = b0.w; acc[4] = b1.x; acc[5] = b1.y; acc[6] = b1.z; acc[7] = b1.w;
      }
#pragma unroll
      for (int w = 0; w < 5; ++w) {
        const int ss = s + w - 2;
        const float msk = (ss >= 0 && ss < SEQ) ? 1.f : 0.f;
        float xv[8];
        unpack8(xr[w], xv);
        const float4 w0 = *reinterpret_cast<const float4*>(cw + w * 768 + cg * 8), w1 = *reinterpret_cast<const float4*>(cw + w * 768 + cg * 8 + 4);
        acc[0] += msk * xv[0] * w0.x; acc[1] += msk * xv[1] * w0.y; acc[2] += msk * xv[2] * w0.z; acc[3] += msk * xv[3] * w0.w;
        acc[4] += msk * xv[4] * w1.x; acc[5] += msk * xv[5] * w1.y; acc[6] += msk * xv[6] * w1.z; acc[7] += msk * xv[7] * w1.w;
      }
      uint4 o;
      o.x = pack2(fast_silu(acc[0]), fast_silu(acc[1])); o.y = pack2(fast_silu(acc[2]), fast_silu(acc[3]));
      o.z = pack2(fast_silu(acc[4]), fast_silu(acc[5])); o.w = pack2(fast_silu(acc[6]), fast_silu(acc[7]));
      *reinterpret_cast<uint4*>(p.xbc() + (size_t)t * 768 + cg * 8) = o;
#pragma unroll
      for (int w = 0; w < 5; ++w) xr[w] = xn[w];
    }
  }
  for (int idx = gt; idx < T * 8; idx += gs) {
    const int t = idx >> 3, k = idx & 7;
    const float v = bf2f(p.proj()[(size_t)t * PWP + C_DT + k]) + dtb[k];
    p.dtv()[idx] = (v > 20.f) ? v : log1pf(expf(v));
  }
  {
    const int sub = lane >> 4, l16 = lane & 15;
    for (int t = gw * 4 + sub; t < T; t += nw * 4) {
      const u16* pr = p.proj() + (size_t)t * PWP;
      float v[16], u[8];
      ld8(pr + C_CQ + l16 * 16, v); ld8(pr + C_CQ + l16 * 16 + 8, v + 8);
      ld8(pr + C_CKV + l16 * 8, u);
      float ss = 0.f, s2 = 0.f;
#pragma unroll
      for (int i = 0; i < 16; ++i) ss += v[i] * v[i];
#pragma unroll
      for (int i = 0; i < 8; ++i) s2 += u[i] * u[i];
#pragma unroll
      for (int o = 1; o < 16; o <<= 1) { ss += __shfl_xor(ss, o); s2 += __shfl_xor(s2, o); }
      const float rstd = rsqrtf(ss * (1.f / 256.f) + 1e-6f), r2 = rsqrtf(s2 * (1.f / 128.f) + 1e-6f);
      uint4 o;
      const float* qw = qnw + l16 * 16;
      o.x = pack2(v[0] * rstd * qw[0], v[1] * rstd * qw[1]); o.y = pack2(v[2] * rstd * qw[2], v[3] * rstd * qw[3]);
      o.z = pack2(v[4] * rstd * qw[4], v[5] * rstd * qw[5]); o.w = pack2(v[6] * rstd * qw[6], v[7] * rstd * qw[7]);
      *reinterpret_cast<uint4*>(p.cqn() + (size_t)t * 256 + l16 * 16) = o;
      o.x = pack2(v[8] * rstd * qw[8], v[9] * rstd * qw[9]); o.y = pack2(v[10] * rstd * qw[10], v[11] * rstd * qw[11]);
      o.z = pack2(v[12] * rstd * qw[12], v[13] * rstd * qw[13]); o.w = pack2(v[14] * rstd * qw[14], v[15] * rstd * qw[15]);
      *reinterpret_cast<uint4*>(p.cqn() + (size_t)t * 256 + l16 * 16 + 8) = o;
      const float* kw = kvnw + l16 * 8;
      o.x = pack2(u[0] * r2 * kw[0], u[1] * r2 * kw[1]); o.y = pack2(u[2] * r2 * kw[2], u[3] * r2 * kw[3]);
      o.z = pack2(u[4] * r2 * kw[4], u[5] * r2 * kw[5]); o.w = pack2(u[6] * r2 * kw[6], u[7] * r2 * kw[7]);
      *reinterpret_cast<uint4*>(p.ckvn() + (size_t)t * 128 + l16 * 8) = o;
    }
  }
  {
    auto item_of = [&](int idx, u16*& a, int& off2, int& tabo, float& scale, int& krope_i0) {
      const int t = idx / 42, ri = idx - t * 42, s = t & (SEQ - 1);
      u16* pr = p.proj() + (size_t)t * PWP;
      krope_i0 = -1;
      if (ri < 32) {
        const int isk = ri >> 4, h = (ri >> 2) & 3, i0 = (ri & 3) * 8;
        a = pr + (isk ? C_RK : C_RQ) + h * 64 + i0; off2 = 32; tabo = (s * 56 + i0) * 2; scale = isk ? 1.f : 0.125f;
      } else if (ri < 40) {
        const int j = ri - 32, isk = j >> 2, h = j & 3;
        a = pr + (isk ? C_DK : C_DQ) + h * 64; off2 = 8; tabo = (s * 56 + 32) * 2; scale = 1.f;
      } else {
        const int i0 = (ri - 40) * 8;
        a = pr + C_KR + i0; off2 = 16; tabo = (s * 56 + 40 + i0) * 2; scale = 1.f; krope_i0 = i0;
      }
    };
    uint4 x1c = make_uint4(0, 0, 0, 0), x2c = make_uint4(0, 0, 0, 0);
    if (gt < T * 42) {
      u16* a; int off2, tabo, ki; float sc;
      item_of(gt, a, off2, tabo, sc, ki);
      x1c = *reinterpret_cast<const uint4*>(a); x2c = *reinterpret_cast<const uint4*>(a + off2);
    }
    for (int idx = gt; idx < T * 42; idx += gs) {
      u16* a; int off2, tabo, ki; float scale;
      item_of(idx, a, off2, tabo, scale, ki);
      uint4 x1n, x2n;
      {
        const int idn = (idx + gs < T * 42) ? (idx + gs) : idx;
        u16* an; int o2n, tn_, kn; float scn;
        item_of(idn, an, o2n, tn_, scn, kn);
        x1n = *reinterpret_cast<const uint4*>(an); x2n = *reinterpret_cast<const uint4*>(an + o2n);
      }
      float x1[8], x2[8], y1[8], y2[8];
      unpack8(x1c, x1); unpack8(x2c, x2);
      const float* tab = p.rtab() + tabo;
#pragma unroll
      for (int e = 0; e < 8; e += 2) {
        const float4 cs = *reinterpret_cast<const float4*>(tab + e * 2);
        y1[e] = (x1[e] * cs.x - x2[e] * cs.y) * scale;
        y2[e] = (x2[e] * cs.x + x1[e] * cs.y) * scale;
        y1[e + 1] = (x1[e + 1] * cs.z - x2[e + 1] * cs.w) * scale;
        y2[e + 1] = (x2[e + 1] * cs.z + x1[e + 1] * cs.w) * scale;
      }
      uint4 o1, o2;
      o1.x = pack2(y1[0], y1[1]); o1.y = pack2(y1[2], y1[3]); o1.z = pack2(y1[4], y1[5]); o1.w = pack2(y1[6], y1[7]);
      o2.x = pack2(y2[0], y2[1]); o2.y = pack2(y2[2], y2[3]); o2.z = pack2(y2[4], y2[5]); o2.w = pack2(y2[6], y2[7]);
      *reinterpret_cast<uint4*>(a) = o1;
      *reinterpret_cast<uint4*>(a + off2) = o2;
      if (ki >= 0) {
        const int t = idx / 42, s = t & (SEQ - 1), bb = t >> 12;
#pragma unroll
        for (int hd = 0; hd < 4; ++hd) {
          u16* kf = p.kfull() + ((size_t)(bb * 4 + hd) * SEQ + s) * 96 + 64 + ki;
          *reinterpret_cast<uint4*>(kf) = o1;
          *reinterpret_cast<uint4*>(kf + 16) = o2;
        }
      }
      x1c = x1n; x2c = x2n;
    }
  }
}

DI void ph_mla_up_q(const Params& p, int L, char* smem, int t) {
  const int mt = T / 256;
  const u16* Bq = p.WuqT() + (size_t)L * 384 * 256;
  {
    const int m0 = (t % mt) * 256, n0 = (t / mt) * 128;
    gemm_tile([&](int r) { return p.cqn() + (size_t)(m0 + r) * 256; }, Bq + (size_t)n0 * 256, 256, 256, smem,
              [&](f32x4 (&acc)[4][4], int wr, int wc, int fr, int fq) {
                const float scale = 0.10206207261596575f * 1.4426950408889634f;
#pragma unroll
                for (int m = 0; m < 4; ++m)
#pragma unroll
                  for (int j = 0; j < 4; ++j) {
                    const int row = m0 + wr * 64 + m * 16 + fq * 4 + j;
                    const float2 cssn = *reinterpret_cast<const float2*>(p.rtab() + ((size_t)(row & (SEQ - 1)) * 56 + 40 + fr) * 2);
                    const float cs = cssn.x, sn = cssn.y;
#pragma unroll
                    for (int n2 = 0; n2 < 4; n2 += 2) {
                      const int cb = n0 + wc * 64 + n2 * 16;
                      float x1 = acc[m][n2][j], x2 = acc[m][n2 + 1][j];
                      if (cb % 96 == 64) {
                        const float y1 = x1 * cs - x2 * sn, y2 = x2 * cs + x1 * sn;
                        x1 = y1; x2 = y2;
                      }
                      p.mq()[(size_t)row * 384 + cb + fr] = f2bf(x1 * scale);
                      p.mq()[(size_t)row * 384 + cb + 16 + fr] = f2bf(x2 * scale);
                    }
                  }
              });
  }
}
DI void ph_mla_up_kv(const Params& p, int L, char* smem, int t) {
  const int mt = T / 256;
  const u16* Bkv = p.WukvT() + (size_t)L * 512 * 128;
  {
    const int m0 = (t % mt) * 256, h = t / mt, n0 = h * 128;
    gemm_tile([&](int r) { return p.ckvn() + (size_t)(m0 + r) * 128; }, Bkv + (size_t)n0 * 128, 128, 128, smem,
              [&](f32x4 (&acc)[4][4], int wr, int wc, int fr, int fq) {
#pragma unroll
                for (int m = 0; m < 4; ++m) {
                  const int row = m0 + wr * 64 + m * 16 + fq * 4;
                  const int bb = row >> 12, sq = row & (SEQ - 1);
                  const size_t bh = (size_t)(bb * 4 + h);
#pragma unroll
                  for (int n = 0; n < 4; ++n) {
                    if (wc == 0) {
#pragma unroll
                      for (int j = 0; j < 4; ++j) p.kfull()[(bh * SEQ + sq + j) * 96 + n * 16 + fr] = f2bf(acc[m][n][j]);
                    } else {
                      uint2 v;
                      v.x = pack2(acc[m][n][0], acc[m][n][1]);
                      v.y = pack2(acc[m][n][2], acc[m][n][3]);
                      const int sqp = (sq & ~12) | ((sq & 4) << 1) | ((sq & 8) >> 1);
                      *reinterpret_cast<uint2*>(p.vT() + (bh * 64 + n * 16 + fr) * SEQ + sqp) = v;
                    }
                  }
                }
              });
  }
}

DI void ph_cumsum(const Params& p, int L) {
  const int tid_ = otid(); const int lane = tid_ & 63, gw = (obid() * NTHR + tid_) >> 6, nw = gridDim.x * (NTHR / 64);
  for (int it = gw; it < 32; it += nw) {
    const int h = it & 3, dir = (it >> 2) & 1, b = it >> 3;
    const float a = -expf(p.a_log[L * 8 + dir * 4 + h]);
    float running = 0.f;
    for (int c = 0; c < 64; ++c) {
      const int i = c * 64 + lane;
      const int s = dir ? (SEQ - 1 - i) : i;
      const size_t off = (size_t)(b * SEQ + s) * 8 + dir * 4 + h;
      float v = p.dtv()[off] * a;
#pragma unroll
      for (int o = 1; o < 64; o <<= 1) {
        const float u = __shfl_up(v, o);
        if (lane >= o) v += u;
      }
      v += running;
      p.cs()[off] = v;
      running = __shfl(v, 63);
    }
  }
}

DI void ph_ret_naive(const Params& p) {
  const int gt = obid() * NTHR + otid(), gs = gridDim.x * NTHR;
  for (int it = gt; it < 4 * 4 * SEQ; it += gs) {
    const int n = it & (SEQ - 1), h = (it >> 12) & 3, b = it >> 14;
    const u16* base = p.proj() + (size_t)(b * SEQ) * PWP;
    uint4 qp[8];
    float o[64];
#pragma unroll
    for (int d = 0; d < 8; ++d) qp[d] = *reinterpret_cast<const uint4*>(base + (size_t)n * PWP + C_RQ + h * 64 + d * 8);
#pragma unroll
    for (int d = 0; d < 64; ++d) o[d] = 0.f;
    const float lg0 = log1pf(-exp2f(-5.f - (float)h)), lg1 = log1pf(-exp2f(-5.5f - (float)h));
#pragma unroll 1
    for (int m = 0; m < SEQ; ++m) {
      const u16* kr = base + (size_t)m * PWP + C_RK + h * 64;
      const u16* vr = base + (size_t)m * PWP + C_RV + h * 64;
      float s = 0.f;
#pragma unroll
      for (int d = 0; d < 8; ++d) s = dot8(qp[d], *reinterpret_cast<const uint4*>(kr + d * 8), s);
      const float w = (m <= n) ? expf(lg0 * (float)(n - m)) : expf(lg1 * (float)(m - n));
      s *= w;
#pragma unroll
      for (int d = 0; d < 64; d += 8) {
        float vf[8];
        ld8(vr + d, vf);
#pragma unroll
        for (int j = 0; j < 8; ++j) o[d + j] += s * vf[j];
      }
    }
    float mu = 0.f;
#pragma unroll
    for (int d = 0; d < 64; ++d) mu += o[d];
    mu *= (1.f / 64.f);
    float var = 0.f;
#pragma unroll
    for (int d = 0; d < 64; ++d) var += (o[d] - mu) * (o[d] - mu);
    var *= (1.f / 64.f);
    const float rs = rsqrtf(var + 1e-5f);
    const size_t t = (size_t)b * SEQ + n;
#pragma unroll
    for (int d = 0; d < 64; d += 8) {
      float g[8];
      ld8(p.proj() + t * PWP + C_RG + h * 64 + d, g);
      uint4 ov;
      ov.x = pack2(silu(g[0]) * (o[d + 0] - mu) * rs, silu(g[1]) * (o[d + 1] - mu) * rs);
      ov.y = pack2(silu(g[2]) * (o[d + 2] - mu) * rs, silu(g[3]) * (o[d + 3] - mu) * rs);
      ov.z = pack2(silu(g[4]) * (o[d + 4] - mu) * rs, silu(g[5]) * (o[d + 5] - mu) * rs);
      ov.w = pack2(silu(g[6]) * (o[d + 6] - mu) * rs, silu(g[7]) * (o[d + 7] - mu) * rs);
      *reinterpret_cast<uint4*>(p.mixed() + t * DM + h * 64 + d) = ov;
    }
  }
}

DI void ph_mla_naive(const Params& p) {
  const int gt = obid() * NTHR + otid(), gs = gridDim.x * NTHR;
  for (int it = gt; it < 2 * 4 * 4 * SEQ; it += gs) {
    const int n = it & (SEQ - 1), vh = (it >> 12) & 1, h = (it >> 13) & 3, b = it >> 15;
    const size_t t = (size_t)b * SEQ + n;
    uint4 qp[12];
    float o[32];
#pragma unroll
    for (int d = 0; d < 12; ++d) qp[d] = *reinterpret_cast<const uint4*>(p.mq() + t * 384 + h * 96 + d * 8);
    const size_t tb = (size_t)b * SEQ;
    float mx = -1e30f;
#pragma unroll 1
    for (int m = 0; m < SEQ; ++m) {
      const u16* kn = ((u16*)nullptr) + (tb + m) * 512 + h * 128;
      const u16* kr = p.proj() + (tb + m) * PWP + C_KR;
      float s = 0.f;
#pragma unroll
      for (int d = 0; d < 8; ++d) s = dot8(qp[d], *reinterpret_cast<const uint4*>(kn + d * 8), s);
#pragma unroll
      for (int d = 0; d < 4; ++d) s = dot8(qp[8 + d], *reinterpret_cast<const uint4*>(kr + d * 8), s);
      mx = fmaxf(mx, s);
    }
#pragma unroll
    for (int d = 0; d < 32; ++d) o[d] = 0.f;
    float l = 0.f;
#pragma unroll 1
    for (int m = 0; m < SEQ; ++m) {
      const u16* kn = ((u16*)nullptr) + (tb + m) * 512 + h * 128;
      const u16* kr = p.proj() + (tb + m) * PWP + C_KR;
      float s = 0.f;
#pragma unroll
      for (int d = 0; d < 8; ++d) s = dot8(qp[d], *reinterpret_cast<const uint4*>(kn + d * 8), s);
#pragma unroll
      for (int d = 0; d < 4; ++d) s = dot8(qp[8 + d], *reinterpret_cast<const uint4*>(kr + d * 8), s);
      const float pe = exp2f(s - mx);
      l += pe;
#pragma unroll
      for (int d = 0; d < 32; d += 8) {
        float vf[8];
        ld8(kn + 64 + vh * 32 + d, vf);
#pragma unroll
        for (int j = 0; j < 8; ++j) o[d + j] += pe * vf[j];
      }
    }
    const float il = 1.f / l;
#pragma unroll
    for (int d = 0; d < 32; d += 8) {
      uint4 ov;
      ov.x = pack2(o[d + 0] * il, o[d + 1] * il);
      ov.y = pack2(o[d + 2] * il, o[d + 3] * il);
      ov.z = pack2(o[d + 4] * il, o[d + 5] * il);
      ov.w = pack2(o[d + 6] * il, o[d + 7] * il);
      *reinterpret_cast<uint4*>(p.mixed() + t * DM + 256 + h * 64 + vh * 32 + d) = ov;
    }
  }
}

#define MFMA32(a, b, c) __builtin_amdgcn_mfma_f32_32x32x16_bf16((a), (b), (c), 0, 0, 0)
DI float max16(const f32x16& v) {
  float a = fmaxf(fmaxf(v[0], v[1]), v[2]), b = fmaxf(fmaxf(v[3], v[4]), v[5]), c = fmaxf(fmaxf(v[6], v[7]), v[8]);
  float d = fmaxf(fmaxf(v[9], v[10]), v[11]), e = fmaxf(fmaxf(v[12], v[13]), v[14]);
  return fmaxf(fmaxf(fmaxf(a, b), fmaxf(c, d)), fmaxf(e, v[15]));
}
DI void ph_mla_attn(const Params& p, char* smem, int L) {
  const int tid = otid(), wid = tid >> 6, lane = tid & 63, l32 = lane & 31, hh = lane >> 5;
  u16* sK = reinterpret_cast<u16*>(smem);
  u16* sV = sK + 2 * 128 * 104;
  uint4 konev = make_uint4(hh == 0 ? 0x00003F80u : 0u, 0u, 0u, 0u);
  const bf16x8 kone = __builtin_bit_cast(bf16x8, konev);
  for (int item = obid(); item < 256; item += gridDim.x) {
    const int xcd_ = item & 7, jx_ = item >> 3, bh = xcd_ * 2 + (jx_ >> 4), qt = jx_ & 15, b = bh >> 2, h = bh & 3;
    const size_t t0 = (size_t)b * SEQ + qt * 256 + wid * 32;
    bf16x8 qf[6];
#pragma unroll
    for (int ks = 0; ks < 6; ++ks) qf[ks] = *reinterpret_cast<const bf16x8*>(p.mq() + (t0 + l32) * 384 + h * 96 + ks * 16 + hh * 8);
    const u16* kg = p.kfull() + (size_t)bh * SEQ * 96;
    const u16* vg = p.vT() + (size_t)bh * 64 * SEQ;
    f32x16 o0, o1;
#pragma unroll
    for (int i = 0; i < 16; ++i) { o0[i] = 0.f; o1[i] = 0.f; }
    float m = 0.f, l = 0.f;
    bf16x8 qf6 = __builtin_bit_cast(bf16x8, make_uint4(0u, 0u, 0u, 0u));
    const int kr0 = tid / 12, kc0 = tid % 12, kr1 = (512 + tid) / 12, kc1 = (512 + tid) % 12, kr2 = (1024 + tid) / 12, kc2 = (1024 + tid) % 12;
    const int vd0 = tid >> 4, vd1 = 32 + (tid >> 4), vkc = (tid & 15) * 8;
    uint4 ak0, ak1, ak2, av0, av1;
#define MLA_LD(dst_, ptr_) asm volatile("global_load_dwordx4 %0, %1, off" : "=v"(dst_) : "v"(ptr_) : "memory")
#define MLA_GLOAD(K0, K1, K2, V0, V1, kt_)                                               \
    {                                                                                    \
      const u16* kb_ = kg + (size_t)(kt_) * 128 * 96 + tid * 8;                          \
      MLA_LD(K0, kb_); MLA_LD(K1, kb_ + 512 * 8); MLA_LD(K2, kb_ + 1024 * 8);            \
      const u16* vp_ = vg + (size_t)vd0 * SEQ + (kt_) * 128 + vkc;                       \
      MLA_LD(V0, vp_); MLA_LD(V1, vp_ + (size_t)32 * SEQ);                               \
    }
#define MLA_SSTORE(K0, K1, K2, V0, V1, buf_)                                             \
    {                                                                                    \
      u16* kb_ = sK + (buf_) * 128 * 104;                                                \
      u16* vb_ = sV + (buf_) * 64 * 136;                                                 \
      *reinterpret_cast<uint4*>(kb_ + kr0 * 104 + kc0 * 8) = K0;                         \
      *reinterpret_cast<uint4*>(kb_ + kr1 * 104 + kc1 * 8) = K1;                         \
      *reinterpret_cast<uint4*>(kb_ + kr2 * 104 + kc2 * 8) = K2;                         \
      *reinterpret_cast<uint4*>(vb_ + vd0 * 136 + vkc) = V0;                             \
      *reinterpret_cast<uint4*>(vb_ + vd1 * 136 + vkc) = V1;                             \
    }
    float mxrun = 0.f;
#define SGB(mask, n) __builtin_amdgcn_sched_group_barrier((mask), (n), 0)
#define MLA_KFRAG(kb_, sub_, ks_) (*reinterpret_cast<const bf16x8*>((kb_) + ((sub_) * 32 + l32) * 104 + (ks_) * 16 + hh * 8))
#define MLA_VFRAG(dst_, vb_, sub_, ks2_, dvt_) \
    dst_ = *reinterpret_cast<const bf16x8*>((vb_) + ((dvt_) * 32 + l32) * 136 + (sub_) * 32 + (ks2_) * 16 + hh * 8)
#define MLA_SOFTMAX(sc_, pa_, pb_)                                                                         \
    {                                                                                                      \
      mxrun = fmaxf(mxrun, max16(sc_));                                                                    \
      float ps0_ = 0.f, ps1_ = 0.f;                                                                        \
      _Pragma("unroll") for (int i = 0; i < 16; i += 2) {                                                  \
        sc_[i] = __builtin_amdgcn_exp2f(sc_[i]); sc_[i + 1] = __builtin_amdgcn_exp2f(sc_[i + 1]);          \
        ps0_ += sc_[i]; ps1_ += sc_[i + 1];                                                                \
      }                                                                                                    \
      l += ps0_ + ps1_;                                                                                    \
      uint4 pk_;                                                                                           \
      pk_.x = pack2(sc_[0], sc_[1]); pk_.y = pack2(sc_[2], sc_[3]); pk_.z = pack2(sc_[4], sc_[5]); pk_.w = pack2(sc_[6], sc_[7]); \
      pa_ = __builtin_bit_cast(bf16x8, pk_);                                                               \
      pk_.x = pack2(sc_[8], sc_[9]); pk_.y = pack2(sc_[10], sc_[11]); pk_.z = pack2(sc_[12], sc_[13]); pk_.w = pack2(sc_[14], sc_[15]); \
      pb_ = __builtin_bit_cast(bf16x8, pk_);                                                               \
    }
    auto compute_tile = [&](int cur, int half) {
      const u16* kb = sK + cur * 128 * 104 + half * 64 * 104;
      const u16* vb = sV + cur * 64 * 136 + half * 64;
      bf16x8 k0[6], k1[6];
#pragma unroll
      for (int ks = 0; ks < 6; ++ks) { k0[ks] = MLA_KFRAG(kb, 0, ks); k1[ks] = MLA_KFRAG(kb, 1, ks); }
      f32x16 s0, s1;
#pragma unroll
      for (int i = 0; i < 16; ++i) { s0[i] = 0.f; s1[i] = 0.f; }
#pragma unroll
      for (int ks = 0; ks < 6; ++ks) s0 = MFMA32(k0[ks], qf[ks], s0);
      s0 = MFMA32(kone, qf6, s0);
      bf16x8 v00, v01, v02, v03, v10, v11, v12, v13;
      MLA_VFRAG(v00, vb, 0, 0, 0); MLA_VFRAG(v01, vb, 0, 0, 1); MLA_VFRAG(v02, vb, 0, 1, 0); MLA_VFRAG(v03, vb, 0, 1, 1);
#pragma unroll
      for (int ks = 0; ks < 6; ++ks) s1 = MFMA32(k1[ks], qf[ks], s1);
      s1 = MFMA32(kone, qf6, s1);
      MLA_VFRAG(v10, vb, 1, 0, 0); MLA_VFRAG(v11, vb, 1, 0, 1); MLA_VFRAG(v12, vb, 1, 1, 0); MLA_VFRAG(v13, vb, 1, 1, 1);
      bf16x8 p0a, p0b, p1a, p1b;
      MLA_SOFTMAX(s0, p0a, p0b);
      o0 = MFMA32(v00, p0a, o0); o1 = MFMA32(v01, p0a, o1); o0 = MFMA32(v02, p0b, o0); o1 = MFMA32(v03, p0b, o1);
      MLA_SOFTMAX(s1, p1a, p1b);
      o0 = MFMA32(v10, p1a, o0); o1 = MFMA32(v11, p1a, o1); o0 = MFMA32(v12, p1b, o0); o1 = MFMA32(v13, p1b, o1);
      SGB(0x100, 12);
#pragma unroll
      for (int i = 0; i < 7; ++i) { SGB(0x008, 1); if (i < 4) SGB(0x100, 1); }
#pragma unroll
      for (int i = 0; i < 7; ++i) { SGB(0x008, 1); if (i < 4) SGB(0x100, 1); SGB(0x402, 7); }
#pragma unroll
      for (int i = 0; i < 4; ++i) { SGB(0x008, 1); SGB(0x402, 12); }
#pragma unroll
      for (int i = 0; i < 4; ++i) SGB(0x008, 1);
    };
    auto lazy_update = [&]() {
      const float mxr = fmaxf(mxrun, __shfl_xor(mxrun, 32));
      if (__builtin_amdgcn_ballot_w64(mxr > 8.f) != 0ull) {
        float d = (mxr > 8.f) ? mxr : 0.f;
        const float mnew = bf2f(f2bf(m + d));
        d = mnew - m;
        m = mnew;
        const float alpha = __builtin_amdgcn_exp2f(-d);
        l *= alpha;
        mxrun -= d;
#pragma unroll
        for (int i = 0; i < 16; ++i) { o0[i] *= alpha; o1[i] *= alpha; }
        uint4 qv = make_uint4(0u, 0u, 0u, 0u);
        if (hh == 0) qv.x = (unsigned)f2bf(-m);
        qf6 = __builtin_bit_cast(bf16x8, qv);
      }
    };
    unsigned char* cbuf = reinterpret_cast<unsigned char*>(sV + 2 * 64 * 136);
    const bool cvt_on = (gridDim.x == 256);
    f32x4 cv0, cv1, cv2, cv3;
    bool cvalid = false;
#define CVT_ISSUE(j_)                                                                                                   \
    {                                                                                                                   \
      const int g_ = CVT_B + obid() + 256 * (j_);                                                                       \
      cvalid = cvt_on && (g_ < 12288);                                                                                  \
      if (cvalid) {                                                                                                     \
        const CvtTile ct_ = cvt_tile(p, L, g_);                                                                         \
        const float* sp_ = ct_.src + (size_t)(ct_.k0 + (tid >> 5) * 4) * ct_.N + ct_.n0 + (tid & 31) * 4;              \
        asm volatile("global_load_dwordx4 %0, %1, off nt" : "=v"(cv0) : "v"(sp_) : "memory");                           \
        asm volatile("global_load_dwordx4 %0, %1, off nt" : "=v"(cv1) : "v"(sp_ + ct_.N) : "memory");                   \
        asm volatile("global_load_dwordx4 %0, %1, off nt" : "=v"(cv2) : "v"(sp_ + 2 * ct_.N) : "memory");               \
        asm volatile("global_load_dwordx4 %0, %1, off nt" : "=v"(cv3) : "v"(sp_ + 3 * ct_.N) : "memory");               \
      }                                                                                                                 \
    }
#define CVT_TO_LDS(par_)                                                                                                \
    if (cvalid) {                                                                                                       \
      unsigned char* cb_ = cbuf + (par_) * 10240 + (tid & 31) * 4 * 80 + (tid >> 5) * 4;                                \
      *reinterpret_cast<unsigned*>(cb_) = pk4_f8_scaled<256>(cv0[0], cv1[0], cv2[0], cv3[0]);       \
      *reinterpret_cast<unsigned*>(cb_ + 80) = pk4_f8_scaled<256>(cv0[1], cv1[1], cv2[1], cv3[1]);  \
      *reinterpret_cast<unsigned*>(cb_ + 160) = pk4_f8_scaled<256>(cv0[2], cv1[2], cv2[2], cv3[2]); \
      *reinterpret_cast<unsigned*>(cb_ + 240) = pk4_f8_scaled<256>(cv0[3], cv1[3], cv2[3], cv3[3]); \
    }
#define CVT_TO_GLOBAL(par_, j_)                                                                                         \
    if (cvalid) {                                                                                                       \
      const CvtTile ct_ = cvt_tile(p, L, CVT_B + obid() + 256 * (j_));        \
      unsigned char* cd_ = ct_.dst + (size_t)cvt_rowmap(ct_.mat, ct_.n0 + (tid >> 2)) * ct_.K + ct_.k0 + (tid & 3) * 16;  \
      *reinterpret_cast<uint4*>(cd_) = *reinterpret_cast<const uint4*>(cbuf + (par_) * 10240 + (tid >> 2) * 80 + (tid & 3) * 16); \
    }
    MLA_GLOAD(ak0, ak1, ak2, av0, av1, 0);
    asm volatile("s_waitcnt vmcnt(0)" ::: "memory");
    MLA_SSTORE(ak0, ak1, ak2, av0, av1, 0);
    __syncthreads();
    {
      f32x16 s0, s1;
#pragma unroll
      for (int i = 0; i < 16; ++i) { s0[i] = 0.f; s1[i] = 0.f; }
#pragma unroll
      for (int ks = 0; ks < 6; ++ks) { s0 = MFMA32(MLA_KFRAG(sK, 0, ks), qf[ks], s0); s1 = MFMA32(MLA_KFRAG(sK, 1, ks), qf[ks], s1); }
      float mx = fmaxf(max16(s0), max16(s1));
      mx = fmaxf(mx, __shfl_xor(mx, 32));
      m = bf2f(f2bf(mx));
      uint4 qv = make_uint4(0u, 0u, 0u, 0u);
      if (hh == 0) qv.x = (unsigned)f2bf(-m);
      qf6 = __builtin_bit_cast(bf16x8, qv);
    }
#pragma unroll 1
    for (int kt = 0; kt < 32; kt += 2) {
#pragma unroll 1
      for (int half = 0; half < 2; ++half) {
        CVT_ISSUE(2 * kt + half);
        if (half == 0) MLA_GLOAD(ak0, ak1, ak2, av0, av1, kt + 1);
        compute_tile(0, half);
        if (half == 0) {
          asm volatile("s_waitcnt vmcnt(5)" ::: "memory");
        } else {
          asm volatile("s_waitcnt vmcnt(0)" ::: "memory");
          MLA_SSTORE(ak0, ak1, ak2, av0, av1, 1);
        }
        asm volatile("" : "+v"(cv0), "+v"(cv1), "+v"(cv2), "+v"(cv3) :: "memory");
        CVT_TO_LDS(half);
        __syncthreads();
        CVT_TO_GLOBAL(half, 2 * kt + half);
      }
      lazy_update();
      const bool more = kt + 2 < 32;
#pragma unroll 1
      for (int half = 0; half < 2; ++half) {
        CVT_ISSUE(2 * kt + 2 + half);
        if (half == 0 && more) MLA_GLOAD(ak0, ak1, ak2, av0, av1, kt + 2);
        compute_tile(1, half);
        if (half == 0 && more) {
          asm volatile("s_waitcnt vmcnt(5)" ::: "memory");
        } else {
          asm volatile("s_waitcnt vmcnt(0)" ::: "memory");
          if (half == 1 && more) MLA_SSTORE(ak0, ak1, ak2, av0, av1, 0);
        }
        asm volatile("" : "+v"(cv0), "+v"(cv1), "+v"(cv2), "+v"(cv3) :: "memory");
        CVT_TO_LDS(half);
        __syncthreads();
        CVT_TO_GLOBAL(half, 2 * kt + 2 + half);
      }
      lazy_update();
    }
    l += __shfl_xor(l, 32);
    const float il = 1.f / l;
    u16* orow = p.mixed() + (t0 + l32) * DM + 256 + h * 64 + hh * 4;
#pragma unroll
    for (int g = 0; g < 4; ++g) {
      uint2 v;
      v.x = pack2(o0[4 * g + 0] * il, o0[4 * g + 1] * il);
      v.y = pack2(o0[4 * g + 2] * il, o0[4 * g + 3] * il);
      *reinterpret_cast<uint2*>(orow + g * 8) = v;
      v.x = pack2(o1[4 * g + 0] * il, o1[4 * g + 1] * il);
      v.y = pack2(o1[4 * g + 2] * il, o1[4 * g + 3] * il);
      *reinterpret_cast<uint2*>(orow + 32 + g * 8) = v;
    }
  }
}

typedef __attribute__((address_space(3))) s16x4 lds_s16x4;
template <int MODE>
DI void ph_dil_pass(const Params& p, char* smem, int blk_) {
  const int tid = otid(), wid = tid >> 6, lane = tid & 63, l32 = lane & 31, hh = lane >> 5;
  u16* sV = reinterpret_cast<u16*>(smem) + wid * (2 * 32 * 72);
  const int i16 = lane & 15, tq = i16 >> 2, tp = i16 & 3, tblk = (lane >> 4) & 1;
  {
    constexpr int NT = (MODE == 0) ? 13 : 5;
    const int it = wid, xcd_ = blk_ & 7, jx_ = blk_ >> 3, bh = xcd_ * 2 + (jx_ >> 4), r = jx_ & 15, b = bh >> 2, h = bh & 3;
    const int i0 = it * 32;
    const int q0 = (r * 8 + it) * 32;
    const int qpos = (MODE == 0) ? (r + 16 * (i0 + l32)) : (q0 + l32);
    const size_t tb = (size_t)b * SEQ;
    const u16* kbase = p.proj() + tb * PWP + C_DK + h * 64;
    const u16* vbase = p.proj() + tb * PWP + C_DV + h * 64;
    bf16x8 qf[4];
    {
      const u16* qp = p.proj() + (tb + qpos) * PWP + C_DQ + h * 64 + hh * 8;
#pragma unroll
      for (int ks = 0; ks < 4; ++ks) qf[ks] = *reinterpret_cast<const bf16x8*>(qp + ks * 16);
    }
    f32x16 o0, o1;
#pragma unroll
    for (int i = 0; i < 16; ++i) { o0[i] = 0.f; o1[i] = 0.f; }
    float m = -1e30f, l = 0.f;
    auto tile_params = [&](int tt, int& d, int& rd, int& ub, int& ulim, int& qb, int& qs) {
      if (MODE == 0) {
        if (tt < 5) { d = 16; rd = r; qb = i0; qs = 1; ulim = 256; ub = qb - 64 + 32 * tt; }
        else { d = 4; rd = r & 3; qb = (r >> 2) + 4 * i0; qs = 4; ulim = 1024; ub = qb - 64 + 32 * (tt - 5); }
      } else { d = 1; rd = 0; qb = q0; qs = 1; ulim = 4096; ub = qb - 64 + 32 * tt; }
    };
    bf16x8 ka0, ka1, ka2, ka3, kb0, kb1, kb2, kb3;
    uint4 va0, va1, va2, va3, vb0, vb1, vb2, vb3;
#define DIL_LD(dst_, ptr_) asm volatile("global_load_dwordx4 %0, %1, off" : "=v"(dst_) : "v"(ptr_) : "memory")
#define DIL_GLOAD(K0, K1, K2, K3, V0, V1, V2, V3, tt_)                                                   \
    {                                                                                                    \
      int d_, rd_, ub_, ulim_, qb_, qs_;                                                                 \
      tile_params((tt_), d_, rd_, ub_, ulim_, qb_, qs_);                                                 \
      int u_ = min(max(ub_ + l32, 0), ulim_ - 1);                                                        \
      const u16* kp_ = kbase + (size_t)(rd_ + d_ * u_) * PWP + hh * 8;                                   \
      DIL_LD(K0, kp_); DIL_LD(K1, kp_ + 16); DIL_LD(K2, kp_ + 32); DIL_LD(K3, kp_ + 48);                 \
      const int kr_ = ub_ + (lane >> 3);                                                                 \
      const u16* vp_;                                                                                    \
      u_ = min(max(kr_, 0), ulim_ - 1);      vp_ = vbase + (size_t)(rd_ + d_ * u_) * PWP + (lane & 7) * 8; DIL_LD(V0, vp_); \
      u_ = min(max(kr_ + 8, 0), ulim_ - 1);  vp_ = vbase + (size_t)(rd_ + d_ * u_) * PWP + (lane & 7) * 8; DIL_LD(V1, vp_); \
      u_ = min(max(kr_ + 16, 0), ulim_ - 1); vp_ = vbase + (size_t)(rd_ + d_ * u_) * PWP + (lane & 7) * 8; DIL_LD(V2, vp_); \
      u_ = min(max(kr_ + 24, 0), ulim_ - 1); vp_ = vbase + (size_t)(rd_ + d_ * u_) * PWP + (lane & 7) * 8; DIL_LD(V3, vp_); \
    }
#define DIL_VSTORE(V0, V1, V2, V3, buf_)                                                                 \
    {                                                                                                    \
      u16* vb_ = sV + (buf_) * 32 * 72 + (lane >> 3) * 72 + (lane & 7) * 8;                              \
      *reinterpret_cast<uint4*>(vb_) = V0;                                                               \
      *reinterpret_cast<uint4*>(vb_ + 8 * 72) = V1;                                                      \
      *reinterpret_cast<uint4*>(vb_ + 16 * 72) = V2;                                                     \
      *reinterpret_cast<uint4*>(vb_ + 24 * 72) = V3;                                                     \
    }
    auto tile_rest = [&](int tt, f32x16 sc, int cur) {
      int d, rd, ub, ulim, qb, qs;
      tile_params(tt, d, rd, ub, ulim, qb, qs);
      const int uq = qb + qs * l32;
      const float cs = 0.125f * 1.4426950408889634f;
      float mx = -1e30f;
#pragma unroll
      for (int i = 0; i < 16; ++i) {
        const int u = ub + (i & 3) + 8 * (i >> 2) + 4 * hh;
        const int du = u - uq;
        const bool valid = (u >= 0) && (u < ulim) && (du <= 64) && (du >= -64);
        sc[i] = valid ? sc[i] * cs : -1e30f;
        mx = fmaxf(mx, sc[i]);
      }
      mx = fmaxf(mx, __shfl_xor(mx, 32));
      const float mn = fmaxf(m, mx);
      const float alpha = __builtin_amdgcn_exp2f(m - mn);
      m = mn;
      float ps = 0.f;
#pragma unroll
      for (int i = 0; i < 16; ++i) {
        float pe = __builtin_amdgcn_exp2f(sc[i] - mn);
        pe = (sc[i] > -1e29f) ? pe : 0.f;
        ps += pe;
        sc[i] = pe;
      }
      l = l * alpha + ps;
#pragma unroll
      for (int i = 0; i < 16; ++i) { o0[i] *= alpha; o1[i] *= alpha; }
      const u16* vb = sV + cur * 32 * 72;
#pragma unroll
      for (int ks2 = 0; ks2 < 2; ++ks2) {
        uint4 pk;
        pk.x = pack2(sc[8 * ks2 + 0], sc[8 * ks2 + 1]);
        pk.y = pack2(sc[8 * ks2 + 2], sc[8 * ks2 + 3]);
        pk.z = pack2(sc[8 * ks2 + 4], sc[8 * ks2 + 5]);
        pk.w = pack2(sc[8 * ks2 + 6], sc[8 * ks2 + 7]);
        const bf16x8 pb = __builtin_bit_cast(bf16x8, pk);
#pragma unroll
        for (int dvt = 0; dvt < 2; ++dvt) {
          const u16* a0 = vb + (16 * ks2 + 4 * hh + tq) * 72 + dvt * 32 + tblk * 16 + tp * 4;
          const s16x4 lo = __builtin_amdgcn_ds_read_tr16_b64_v4i16((lds_s16x4*)(a0));
          const s16x4 hi = __builtin_amdgcn_ds_read_tr16_b64_v4i16((lds_s16x4*)(a0 + 8 * 72));
          const bf16x8 a = __builtin_shufflevector(lo, hi, 0, 1, 2, 3, 4, 5, 6, 7);
          if (dvt == 0) o0 = MFMA32(a, pb, o0); else o1 = MFMA32(a, pb, o1);
        }
      }
    };
    DIL_GLOAD(ka0, ka1, ka2, ka3, va0, va1, va2, va3, 0);
    DIL_GLOAD(kb0, kb1, kb2, kb3, vb0, vb1, vb2, vb3, 1);
    asm volatile("s_waitcnt vmcnt(8)" ::: "memory");
    DIL_VSTORE(va0, va1, va2, va3, 0);
#pragma unroll 1
    for (int tt = 0; tt < NT; tt += 2) {
      {
        f32x16 sc;
#pragma unroll
        for (int i = 0; i < 16; ++i) sc[i] = 0.f;
        sc = MFMA32(ka0, qf[0], sc); sc = MFMA32(ka1, qf[1], sc); sc = MFMA32(ka2, qf[2], sc); sc = MFMA32(ka3, qf[3], sc);
        asm volatile("" :: "v"(sc));
        if (tt + 2 < NT) DIL_GLOAD(ka0, ka1, ka2, ka3, va0, va1, va2, va3, tt + 2);
        tile_rest(tt, sc, 0);
        if (tt + 1 < NT) {
          if (tt + 2 < NT) asm volatile("s_waitcnt vmcnt(8)" ::: "memory"); else asm volatile("s_waitcnt vmcnt(0)" ::: "memory");
          DIL_VSTORE(vb0, vb1, vb2, vb3, 1);
        }
      }
      if (tt + 1 < NT) {
        f32x16 sc;
#pragma unroll
        for (int i = 0; i < 16; ++i) sc[i] = 0.f;
        sc = MFMA32(kb0, qf[0], sc); sc = MFMA32(kb1, qf[1], sc); sc = MFMA32(kb2, qf[2], sc); sc = MFMA32(kb3, qf[3], sc);
        asm volatile("" :: "v"(sc));
        if (tt + 3 < NT) DIL_GLOAD(kb0, kb1, kb2, kb3, vb0, vb1, vb2, vb3, tt + 3);
        tile_rest(tt + 1, sc, 1);
        if (tt + 2 < NT) {
          if (tt + 3 < NT) asm volatile("s_waitcnt vmcnt(8)" ::: "memory"); else asm volatile("s_waitcnt vmcnt(0)" ::: "memory");
          DIL_VSTORE(va0, va1, va2, va3, 0);
        }
      }
    }
    l += __shfl_xor(l, 32);
    float* part = p.dpart() + ((tb + qpos) * 4 + h) * 68 + hh * 4;
    if (MODE == 0) {
#pragma unroll
      for (int g = 0; g < 4; ++g) {
        *reinterpret_cast<float4*>(part + g * 8) = make_float4(o0[4 * g + 0], o0[4 * g + 1], o0[4 * g + 2], o0[4 * g + 3]);
        *reinterpret_cast<float4*>(part + 32 + g * 8) = make_float4(o1[4 * g + 0], o1[4 * g + 1], o1[4 * g + 2], o1[4 * g + 3]);
      }
      if (hh == 0) { part[64] = m; part[65] = l; }
    } else {
      const float mA = part[64 - hh * 4], lA = part[65 - hh * 4];
      const float M = fmaxf(m, mA), sa = __builtin_amdgcn_exp2f(m - M), sb = __builtin_amdgcn_exp2f(mA - M);
      const float il = 1.f / (l * sa + lA * sb);
      u16* orow = p.mixed() + (tb + qpos) * DM + 768 + h * 64 + hh * 4;
#pragma unroll
      for (int g = 0; g < 4; ++g) {
        const float4 a0 = *reinterpret_cast<const float4*>(part + g * 8), a1 = *reinterpret_cast<const float4*>(part + 32 + g * 8);
        uint2 v;
        v.x = pack2((o0[4 * g + 0] * sa + a0.x * sb) * il, (o0[4 * g + 1] * sa + a0.y * sb) * il);
        v.y = pack2((o0[4 * g + 2] * sa + a0.z * sb) * il, (o0[4 * g + 3] * sa + a0.w * sb) * il);
        *reinterpret_cast<uint2*>(orow + g * 8) = v;
        v.x = pack2((o1[4 * g + 0] * sa + a1.x * sb) * il, (o1[4 * g + 1] * sa + a1.y * sb) * il);
        v.y = pack2((o1[4 * g + 2] * sa + a1.z * sb) * il, (o1[4 * g + 3] * sa + a1.w * sb) * il);
        *reinterpret_cast<uint2*>(orow + 32 + g * 8) = v;
      }
    }
  }
}

DI void ph_dil_naive(const Params& p) {
  const int gt = obid() * NTHR + otid(), gs = gridDim.x * NTHR;
  for (int it = gt; it < 4 * 4 * SEQ; it += gs) {
    const int n = it & (SEQ - 1), h = (it >> 12) & 3, b = it >> 14;
    const size_t tb = (size_t)b * SEQ;
    uint4 qp[8];
    float o[64];
#pragma unroll
    for (int d = 0; d < 8; ++d) qp[d] = *reinterpret_cast<const uint4*>(p.proj() + (tb + n) * PWP + C_DQ + h * 64 + d * 8);
    float mx = -1e30f;
    for (int pat = 0; pat < 3; ++pat) {
      const int dil = (pat == 0) ? 1 : (pat == 1 ? 4 : 16);
#pragma unroll 1
      for (int j = -64; j <= 64; ++j) {
        const int pos = n + j * dil;
        if (pos < 0 || pos >= SEQ) continue;
        const u16* kr = p.proj() + (tb + pos) * PWP + C_DK + h * 64;
        float s = 0.f;
#pragma unroll
        for (int d = 0; d < 8; ++d) s = dot8(qp[d], *reinterpret_cast<const uint4*>(kr + d * 8), s);
        s *= 0.125f;
        mx = fmaxf(mx, s);
      }
    }
#pragma unroll
    for (int d = 0; d < 64; ++d) o[d] = 0.f;
    float l = 0.f;
    for (int pat = 0; pat < 3; ++pat) {
      const int dil = (pat == 0) ? 1 : (pat == 1 ? 4 : 16);
#pragma unroll 1
      for (int j = -64; j <= 64; ++j) {
        const int pos = n + j * dil;
        if (pos < 0 || pos >= SEQ) continue;
        const u16* kr = p.proj() + (tb + pos) * PWP + C_DK + h * 64;
        const u16* vr = p.proj() + (tb + pos) * PWP + C_DV + h * 64;
        float s = 0.f;
#pragma unroll
        for (int d = 0; d < 8; ++d) s = dot8(qp[d], *reinterpret_cast<const uint4*>(kr + d * 8), s);
        s *= 0.125f;
        const float pe = __expf(s - mx);
        l += pe;
#pragma unroll
        for (int d = 0; d < 64; d += 8) {
          float vf[8];
          ld8(vr + d, vf);
#pragma unroll
          for (int jj = 0; jj < 8; ++jj) o[d + jj] += pe * vf[jj];
        }
      }
    }
    const float il = 1.f / l;
#pragma unroll
    for (int d = 0; d < 64; d += 8) {
      uint4 ov;
      ov.x = pack2(o[d + 0] * il, o[d + 1] * il);
      ov.y = pack2(o[d + 2] * il, o[d + 3] * il);
      ov.z = pack2(o[d + 4] * il, o[d + 5] * il);
      ov.w = pack2(o[d + 6] * il, o[d + 7] * il);
      *reinterpret_cast<uint4*>(p.mixed() + (tb + n) * DM + 768 + h * 64 + d) = ov;
    }
  }
}

DI void ph_ssd_naive(const Params& p, int L) {
  const int gt = obid() * NTHR + otid(), gs = gridDim.x * NTHR;
  for (int it = gt; it < 4 * 4 * 4 * SEQ; it += gs) {
    const int l = it & (SEQ - 1), pq = (it >> 12) & 3, h = (it >> 14) & 3, b = it >> 16;
    const int g = h >> 1;
    const size_t tb = (size_t)b * SEQ;
    uint4 cl[16];
    float acc[16];
#pragma unroll
    for (int d = 0; d < 16; ++d) cl[d] = *reinterpret_cast<const uint4*>(p.xbc() + (tb + l) * 768 + 512 + g * 128 + d * 8);
#pragma unroll
    for (int d = 0; d < 16; ++d) acc[d] = 0.f;
    const float pl = p.cs()[(tb + l) * 8 + h], rl = p.cs()[(tb + l) * 8 + 4 + h];
#pragma unroll 1
    for (int s = 0; s < SEQ; ++s) {
      const u16* br = p.xbc() + (tb + s) * 768 + 256 + g * 128;
      float cbv = 0.f;
#pragma unroll
      for (int d = 0; d < 16; ++d) cbv = dot8(cl[d], *reinterpret_cast<const uint4*>(br + d * 8), cbv);
      float w;
      if (s <= l) w = expf(pl - p.cs()[(tb + s) * 8 + h]) * p.dtv()[(tb + s) * 8 + h];
      else w = expf(rl - p.cs()[(tb + s) * 8 + 4 + h]) * p.dtv()[(tb + s) * 8 + 4 + h];
      cbv *= w;
      const u16* xr = p.xbc() + (tb + s) * 768 + h * 64 + pq * 16;
#pragma unroll
      for (int d = 0; d < 16; d += 8) {
        float xf[8];
        ld8(xr + d, xf);
#pragma unroll
        for (int j = 0; j < 8; ++j) acc[d + j] += cbv * xf[j];
      }
    }
    const float dsk = p.ssm_d[L * 4 + h];
#pragma unroll
    for (int d = 0; d < 16; ++d) {
      const int c = h * 64 + pq * 16 + d;
      const float xv = bf2f(p.xbc()[(tb + l) * 768 + c]);
      const float z = bf2f(p.proj()[(tb + l) * PWP + C_Z + c]);
      p.ybuf()[(tb + l) * 256 + c] = (acc[d] + dsk * xv) * silu(z);
    }
  }
}

DI void ph_ssd_norm(const Params& p, int L) {
  const int tid_ = otid(); const int lane = tid_ & 63, gw = (obid() * NTHR + tid_) >> 6, nw = gridDim.x * (NTHR / 64);
  const float* nwt = p.ssm_norm_w + L * 256;
  for (int t = gw; t < T; t += nw) {
    const float4 v = *reinterpret_cast<const float4*>(p.ybuf() + (size_t)t * 256 + lane * 4);
    float ss = wave_sum(v.x * v.x + v.y * v.y + v.z * v.z + v.w * v.w);
    const float rstd = rsqrtf(ss * (1.f / 256.f) + 1e-6f);
    const float4 ww = *reinterpret_cast<const float4*>(nwt + lane * 4);
    uint2 o;
    o.x = pack2(v.x * rstd * ww.x, v.y * rstd * ww.y);
    o.y = pack2(v.z * rstd * ww.z, v.w * rstd * ww.w);
    *reinterpret_cast<uint2*>(p.mixed() + (size_t)t * DM + 512 + lane * 4) = o;
  }
}

#define MFMA16(a, b, c) __builtin_amdgcn_mfma_f32_16x16x32_bf16((a), (b), (c), 0, 0, 0)
template <int MT, int NT, int KS>
DI void wave_mm(f32x4 (&acc)[MT][NT], const u16* a0, int lda, const u16* b0, int ldb, int fr, int fq) {
#pragma unroll
  for (int ks = 0; ks < KS; ++ks) {
    bf16x8 af[MT], bfv[NT];
#pragma unroll
    for (int m = 0; m < MT; ++m) af[m] = *reinterpret_cast<const bf16x8*>(a0 + (m * 16 + fr) * lda + ks * 32 + fq * 8);
#pragma unroll
    for (int n = 0; n < NT; ++n) bfv[n] = *reinterpret_cast<const bf16x8*>(b0 + (n * 16 + fr) * ldb + ks * 32 + fq * 8);
#pragma unroll
    for (int m = 0; m < MT; ++m)
#pragma unroll
      for (int n = 0; n < NT; ++n) acc[m][n] = MFMA16(af[m], bfv[n], acc[m][n]);
  }
}
template <int MT, int NT>
DI void zero_acc(f32x4 (&acc)[MT][NT]) {
#pragma unroll
  for (int m = 0; m < MT; ++m)
#pragma unroll
    for (int n = 0; n < NT; ++n) acc[m][n] = f32x4{0.f, 0.f, 0.f, 0.f};
}
template <int NROWS, int NCOLS>
DI void stage_rows(u16* dst, int ldd, const u16* src, size_t lsrc, int tid) {
  constexpr int CPR = NCOLS / 8, NCH = NROWS * CPR / NTHR;
  static_assert(NROWS * CPR % NTHR == 0, "tile must be a multiple of 512 chunks");
  uint4 r[NCH];
#pragma unroll
  for (int i = 0; i < NCH; ++i) {
    const int c = tid + i * NTHR, row = c / CPR, cc = c % CPR;
    r[i] = *reinterpret_cast<const uint4*>(src + (size_t)row * lsrc + cc * 8);
  }
#pragma unroll
  for (int i = 0; i < NCH; ++i) {
    const int c = tid + i * NTHR, row = c / CPR, cc = c % CPR;
    *reinterpret_cast<uint4*>(dst + row * ldd + cc * 8) = r[i];
  }
}
template <int NCOLS, class W>
DI void stage_T(u16* dst, int ldd, const u16* src, size_t lsrc, int tid, W w) {
  constexpr int NCH = 128 * (NCOLS / 8) / NTHR;
  uint4 r[NCH];
#pragma unroll
  for (int i = 0; i < NCH; ++i) {
    const int c = tid + i * NTHR, j = c & 127, cc = c >> 7;
    r[i] = *reinterpret_cast<const uint4*>(src + (size_t)j * lsrc + cc * 8);
  }
#pragma unroll
  for (int i = 0; i < NCH; ++i) {
    const int c = tid + i * NTHR, j = c & 127, cc = c >> 7;
    float f[8];
    unpack8(r[i], f);
    const float wj = w(j);
#pragma unroll
    for (int e = 0; e < 8; ++e) dst[(cc * 8 + e) * ldd + j] = f2bf(f[e] * wj);
  }
}

template <int NROWS, int NCOLS>
DI void stage_rows_ld(uint4 (&r)[NROWS * (NCOLS / 8) / NTHR], const u16* src, size_t lsrc, int tid) {
  constexpr int CPR = NCOLS / 8, NCH = NROWS * CPR / NTHR;
#pragma unroll
  for (int i = 0; i < NCH; ++i) {
    const int c = tid + i * NTHR, row = c / CPR, cc = c % CPR;
    r[i] = *reinterpret_cast<const uint4*>(src + (size_t)row * lsrc + cc * 8);
  }
}
template <int NROWS, int NCOLS>
DI void stage_rows_st(u16* dst, int ldd, const uint4 (&r)[NROWS * (NCOLS / 8) / NTHR], int tid) {
  constexpr int CPR = NCOLS / 8, NCH = NROWS * CPR / NTHR;
#pragma unroll
  for (int i = 0; i < NCH; ++i) {
    const int c = tid + i * NTHR, row = c / CPR, cc = c % CPR;
    *reinterpret_cast<uint4*>(dst + row * ldd + cc * 8) = r[i];
  }
}
template <int NCOLS>
DI void stage_T_ld(uint4 (&r)[128 * (NCOLS / 8) / NTHR], const u16* src, size_t lsrc, int tid) {
  constexpr int NCH = 128 * (NCOLS / 8) / NTHR;
#pragma unroll
  for (int i = 0; i < NCH; ++i) {
    const int c = tid + i * NTHR, j = c & 127, cc = c >> 7;
    r[i] = *reinterpret_cast<const uint4*>(src + (size_t)j * lsrc + cc * 8);
  }
}
template <int NCOLS, class W>
DI void stage_T_st(u16* dst, int ldd, const uint4 (&r)[128 * (NCOLS / 8) / NTHR], int tid, W w) {
  constexpr int NCH = 128 * (NCOLS / 8) / NTHR;
#pragma unroll
  for (int i = 0; i < NCH; ++i) {
    const int c = tid + i * NTHR, j = c & 127, cc = c >> 7;
    float f[8];
    unpack8(r[i], f);
    const float wj = w(j);
#pragma unroll
    for (int e = 0; e < 8; ++e) dst[(cc * 8 + e) * ldd + j] = f2bf(f[e] * wj);
  }
}

DI void ph_ret_a(const Params& p, char* smem, int item) {
  const int tid = otid(), wid = tid >> 6, lane = tid & 63, fr = lane & 15, fq = lane >> 4;
  u16* sVt = reinterpret_cast<u16*>(smem);
  u16* sKf = sVt + 64 * 136;
  u16* sKb = sKf + 64 * 136;
  {
    const int c = item & 31, bh = item >> 5, b = bh >> 2, h = bh & 3;
    const float lg0 = log1pf(-exp2f(-5.f - (float)h)), lg1 = log1pf(-exp2f(-5.5f - (float)h));
    const u16* src = p.proj() + ((size_t)b * SEQ + c * 128) * PWP;
    {
      uint4 rv[2], rk[2];
      stage_T_ld<64>(rv, src + C_RV + h * 64, PWP, tid);
      stage_T_ld<64>(rk, src + C_RK + h * 64, PWP, tid);
      stage_T_st<64>(sVt, 136, rv, tid, [](int) { return 1.f; });
      stage_T_st<64>(sKf, 136, rk, tid, [&](int j) { return __expf(lg0 * (float)(127 - j)); });
      stage_T_st<64>(sKb, 136, rk, tid, [&](int j) { return __expf(lg1 * (float)j); });
    }
    __syncthreads();
    const int dir = wid >> 2, q = wid & 3;
    f32x4 acc[1][4];
    zero_acc(acc);
    wave_mm<1, 4, 4>(acc, sVt + q * 16 * 136, 136, dir ? sKb : sKf, 136, fr, fq);
    float* out = p.rU() + ((size_t)(bh * 32 + c) * 2 + dir) * 4096;
#pragma unroll
    for (int n = 0; n < 4; ++n)
#pragma unroll
      for (int j = 0; j < 4; ++j) out[(q * 16 + fq * 4 + j) * 64 + n * 16 + fr] = acc[0][n][j];
    __syncthreads();
  }
}
DI void ph_ret_scan(const Params& p) {
  const int gt = obid() * NTHR + otid(), gs = gridDim.x * NTHR;
  for (int it = gt; it < 16 * 2 * 4096; it += gs) {
    const int e = it & 4095, dir = (it >> 12) & 1, bh = it >> 13, h = bh & 3;
    const float lg = log1pf(-exp2f((dir ? -5.5f : -5.f) - (float)h));
    const float cd = __expf(lg * 128.f);
    float u[32];
#pragma unroll
    for (int c = 0; c < 32; ++c) u[c] = p.rU()[((size_t)(bh * 32 + c) * 2 + dir) * 4096 + e];
    float st = 0.f;
    if (dir == 0) {
#pragma unroll
      for (int c = 0; c < 32; ++c) {
        p.rS()[((size_t)(bh * 32 + c) * 2 + dir) * 4096 + e] = f2bf(st);
        st = st * cd + u[c];
      }
    } else {
#pragma unroll
      for (int c = 31; c >= 0; --c) {
        p.rS()[((size_t)(bh * 32 + c) * 2 + dir) * 4096 + e] = f2bf(st);
        st = st * cd + u[c];
      }
    }
  }
}
DI void ph_ret_c(const Params& p, char* smem, int item) {
  const int tid = otid(), wid = tid >> 6, lane = tid & 63, fr = lane & 15, fq = lane >> 4;
  u16* sQ = reinterpret_cast<u16*>(smem);
  u16* sK = sQ + 128 * 72;
  u16* sVt = sK + 128 * 72;
  u16* sSf = sVt + 64 * 136;
  u16* sSb = sSf + 64 * 72;
  u16* sP = sSb + 64 * 72;
  {
    const int c = item & 31, bh = item >> 5, b = bh >> 2, h = bh & 3;
    const float lg0 = log1pf(-exp2f(-5.f - (float)h)), lg1 = log1pf(-exp2f(-5.5f - (float)h));
    const size_t t0 = (size_t)b * SEQ + c * 128;
    const u16* src = p.proj() + t0 * PWP;
    {
      uint4 rq[2], rk[2], rv[2], rf[1], rb[1];
      stage_rows_ld<128, 64>(rq, src + C_RQ + h * 64, PWP, tid);
      stage_rows_ld<128, 64>(rk, src + C_RK + h * 64, PWP, tid);
      stage_T_ld<64>(rv, src + C_RV + h * 64, PWP, tid);
      stage_rows_ld<64, 64>(rf, p.rS() + ((size_t)(bh * 32 + c) * 2 + 0) * 4096, 64, tid);
      stage_rows_ld<64, 64>(rb, p.rS() + ((size_t)(bh * 32 + c) * 2 + 1) * 4096, 64, tid);
      stage_rows_st<128, 64>(sQ, 72, rq, tid);
      stage_rows_st<128, 64>(sK, 72, rk, tid);
      stage_T_st<64>(sVt, 136, rv, tid, [](int) { return 1.f; });
      stage_rows_st<64, 64>(sSf, 72, rf, tid);
      stage_rows_st<64, 64>(sSb, 72, rb, tid);
    }
    __syncthreads();
    {
      const int wr = wid >> 1, wc = wid & 1;
      f32x4 sacc[2][4];
      zero_acc(sacc);
      wave_mm<2, 4, 2>(sacc, sQ + wr * 32 * 72, 72, sK + wc * 64 * 72, 72, fr, fq);
#pragma unroll
      for (int m = 0; m < 2; ++m)
#pragma unroll
        for (int n = 0; n < 4; ++n)
#pragma unroll
          for (int j = 0; j < 4; ++j) {
            const int i = wr * 32 + m * 16 + fq * 4 + j, jj = wc * 64 + n * 16 + fr;
            const float dcy = (jj <= i) ? __expf(lg0 * (float)(i - jj)) : __expf(lg1 * (float)(jj - i));
            sP[i * 136 + jj] = f2bf(sacc[m][n][j] * dcy);
          }
    }
    __syncthreads();
    {
      f32x4 ai[1][4], af_[1][4], ab_[1][4];
      zero_acc(ai); zero_acc(af_); zero_acc(ab_);
      wave_mm<1, 4, 4>(ai, sP + wid * 16 * 136, 136, sVt, 136, fr, fq);
      wave_mm<1, 4, 2>(af_, sQ + wid * 16 * 72, 72, sSf, 72, fr, fq);
      wave_mm<1, 4, 2>(ab_, sQ + wid * 16 * 72, 72, sSb, 72, fr, fq);
#pragma unroll
      for (int j = 0; j < 4; ++j) {
        const int i = wid * 16 + fq * 4 + j;
        const float xf = __expf(lg0 * (float)(i + 1)), xb = __expf(lg1 * (float)(128 - i));
        float o[4], sum = 0.f;
#pragma unroll
        for (int n = 0; n < 4; ++n) { o[n] = ai[0][n][j] + xf * af_[0][n][j] + xb * ab_[0][n][j]; sum += o[n]; }
#pragma unroll
        for (int sft = 1; sft < 16; sft <<= 1) sum += __shfl_xor(sum, sft);
        const float mu = sum * (1.f / 64.f);
        float var = 0.f;
#pragma unroll
        for (int n = 0; n < 4; ++n) var += (o[n] - mu) * (o[n] - mu);
#pragma unroll
        for (int sft = 1; sft < 16; sft <<= 1) var += __shfl_xor(var, sft);
        const float rs = rsqrtf(var * (1.f / 64.f) + 1e-5f);
#pragma unroll
        for (int n = 0; n < 4; ++n) {
          const float g = bf2f(p.proj()[(t0 + i) * PWP + C_RG + h * 64 + n * 16 + fr]);
          p.mixed()[(t0 + i) * DM + h * 64 + n * 16 + fr] = f2bf(silu(g) * (o[n] - mu) * rs);
        }
      }
    }
    __syncthreads();
  }
}

DI void ssd_local_cumsum(const Params& p, int L, size_t t0, float* cum, float* dtl, int wid, int lane) {
  const int dir = wid >> 2, h = wid & 3;
  const float a = -__expf(p.a_log[L * 8 + dir * 4 + h]);
  float d0, d1;
  if (dir == 0) { d0 = p.dtv()[(t0 + 2 * lane) * 8 + h]; d1 = p.dtv()[(t0 + 2 * lane + 1) * 8 + h]; }
  else { d0 = p.dtv()[(t0 + 127 - 2 * lane) * 8 + 4 + h]; d1 = p.dtv()[(t0 + 126 - 2 * lane) * 8 + 4 + h]; }
  float v0 = d0 * a, v1 = v0 + d1 * a;
  float run = v1;
#pragma unroll
  for (int o = 1; o < 64; o <<= 1) {
    const float u = __shfl_up(run, o);
    if (lane >= o) run += u;
  }
  const float excl = run - v1;
  v0 += excl; v1 += excl;
  float* cr = cum + (dir * 4 + h) * 128;
  float* dr = dtl + (dir * 4 + h) * 128;
  if (dir == 0) { cr[2 * lane] = v0; cr[2 * lane + 1] = v1; dr[2 * lane] = d0; dr[2 * lane + 1] = d1; }
  else { cr[127 - 2 * lane] = v0; cr[126 - 2 * lane] = v1; dr[127 - 2 * lane] = d0; dr[126 - 2 * lane] = d1; }
}

DI void ph_ssd_a(const Params& p, int L, char* smem, int item) {
  const int tid = otid(), wid = tid >> 6, lane = tid & 63, fr = lane & 15, fq = lane >> 4;
  u16* sBt = reinterpret_cast<u16*>(smem);
  u16* sXf = sBt + 2 * 128 * 136;
  u16* sXb = sXf + 64 * 136;
  float* cum = reinterpret_cast<float*>(sXb + 64 * 136);
  float* dtl = cum + 8 * 128;
  {
    const int c = item & 31, b = item >> 5;
    const size_t t0 = (size_t)b * SEQ + c * 128;
    ssd_local_cumsum(p, L, t0, cum, dtl, wid, lane);
    stage_T<256>(sBt, 136, p.xbc() + t0 * 768 + 256, 768, tid, [](int) { return 1.f; });
    __syncthreads();
    if (tid < 8) {
      const int dir = tid >> 2;
      p.cdec()[(size_t)item * 8 + tid] = __expf(dir ? cum[tid * 128 + 0] : cum[tid * 128 + 127]);
    }
    for (int h = 0; h < 4; ++h) {
      const float* cf = cum + h * 128;
      const float* cb = cum + (4 + h) * 128;
      const float* df = dtl + h * 128;
      const float* db = dtl + (4 + h) * 128;
      const float endf = cf[127], endb = cb[0];
      {
        uint4 rx[2];
        stage_T_ld<64>(rx, p.xbc() + t0 * 768 + h * 64, 768, tid);
        stage_T_st<64>(sXf, 136, rx, tid, [&](int l) { return __expf(endf - cf[l]) * df[l]; });
        stage_T_st<64>(sXb, 136, rx, tid, [&](int l) { return __expf(endb - cb[l]) * db[l]; });
      }
      __syncthreads();
      const int dir = wid >> 2, q = wid & 3, g = h >> 1;
      f32x4 acc[4][2];
      zero_acc(acc);
      wave_mm<4, 2, 4>(acc, dir ? sXb : sXf, 136, sBt + (g * 128 + q * 32) * 136, 136, fr, fq);
      float* out = p.sU() + ((size_t)item * 8 + h * 2 + dir) * 8192;
#pragma unroll
      for (int m = 0; m < 4; ++m)
#pragma unroll
        for (int n = 0; n < 2; ++n)
#pragma unroll
          for (int j = 0; j < 4; ++j) out[(m * 16 + fq * 4 + j) * 128 + q * 32 + n * 16 + fr] = acc[m][n][j];
      __syncthreads();
    }
  }
}
DI void ph_ssd_scan(const Params& p) {
  const int gt = obid() * NTHR + otid(), gs = gridDim.x * NTHR;
  for (int it = gt; it < 4 * 8 * 8192; it += gs) {
    const int e = it & 8191, hd = (it >> 13) & 7, b = it >> 16;
    const int dir = hd & 1, h = hd >> 1;
    float u[32];
#pragma unroll
    for (int c = 0; c < 32; ++c) u[c] = p.sU()[((size_t)(b * 32 + c) * 8 + hd) * 8192 + e];
    float st = 0.f;
    if (dir == 0) {
#pragma unroll
      for (int c = 0; c < 32; ++c) {
        p.sS()[((size_t)(b * 32 + c) * 8 + hd) * 8192 + e] = f2bf(st);
        st = st * p.cdec()[(size_t)(b * 32 + c) * 8 + dir * 4 + h] + u[c];
      }
    } else {
#pragma unroll
      for (int c = 31; c >= 0; --c) {
        p.sS()[((size_t)(b * 32 + c) * 8 + hd) * 8192 + e] = f2bf(st);
        st = st * p.cdec()[(size_t)(b * 32 + c) * 8 + dir * 4 + h] + u[c];
      }
    }
  }
}
DI void ph_ssd_c(const Params& p, int L, char* smem, int item) {
  const int tid = otid(), wid = tid >> 6, lane = tid & 63, fr = lane & 15, fq = lane >> 4;
  u16* sC = reinterpret_cast<u16*>(smem);
  u16* sB = sC + 128 * 136;
  u16* sXt = sB + 128 * 136;
  u16* sSf = sXt + 64 * 136;
  u16* sSb = sSf + 64 * 136;
  float* cum = reinterpret_cast<float*>(sSb + 64 * 136);
  float* dtl = cum + 8 * 128;
  {
    const int c = item & 31, b = item >> 5;
    const size_t t0 = (size_t)b * SEQ + c * 128;
    ssd_local_cumsum(p, L, t0, cum, dtl, wid, lane);
    float ssq[4] = {0.f, 0.f, 0.f, 0.f};
#pragma unroll 1
    for (int g = 0; g < 2; ++g) {
      {
        uint4 rc[4], rb4[4];
        stage_rows_ld<128, 128>(rc, p.xbc() + t0 * 768 + 512 + g * 128, 768, tid);
        stage_rows_ld<128, 128>(rb4, p.xbc() + t0 * 768 + 256 + g * 128, 768, tid);
        stage_rows_st<128, 128>(sC, 136, rc, tid);
        stage_rows_st<128, 128>(sB, 136, rb4, tid);
      }
      __syncthreads();
      const int wr = wid >> 1, wc = wid & 1;
      f32x4 G[2][4];
      zero_acc(G);
      wave_mm<2, 4, 4>(G, sC + wr * 32 * 136, 136, sB + wc * 64 * 136, 136, fr, fq);
      __syncthreads();
#pragma unroll 1
      for (int hl = 0; hl < 2; ++hl) {
        const int h = g * 2 + hl;
        const float* cf = cum + h * 128;
        const float* cb = cum + (4 + h) * 128;
        const float* df = dtl + h * 128;
        const float* db = dtl + (4 + h) * 128;
        uint4 rxt[2], rsf[2], rsb[2];
        stage_T_ld<64>(rxt, p.xbc() + t0 * 768 + h * 64, 768, tid);
        stage_rows_ld<64, 128>(rsf, p.sS() + ((size_t)item * 8 + h * 2 + 0) * 8192, 128, tid);
        stage_rows_ld<64, 128>(rsb, p.sS() + ((size_t)item * 8 + h * 2 + 1) * 8192, 128, tid);
#pragma unroll
        for (int m = 0; m < 2; ++m)
#pragma unroll
          for (int n = 0; n < 4; ++n)
#pragma unroll
            for (int j = 0; j < 4; ++j) {
              const int l = wr * 32 + m * 16 + fq * 4 + j, sx = wc * 64 + n * 16 + fr;
              const float w = (sx <= l) ? __expf(cf[l] - cf[sx]) * df[sx] : __expf(cb[l] - cb[sx]) * db[sx];
              sB[l * 136 + sx] = f2bf(G[m][n][j] * w);
            }
        stage_T_st<64>(sXt, 136, rxt, tid, [](int) { return 1.f; });
        stage_rows_st<64, 128>(sSf, 136, rsf, tid);
        stage_rows_st<64, 128>(sSb, 136, rsb, tid);
        __syncthreads();
        f32x4 yd[1][4], yf[1][4], yb[1][4];
        zero_acc(yd); zero_acc(yf); zero_acc(yb);
        wave_mm<1, 4, 4>(yd, sB + wid * 16 * 136, 136, sXt, 136, fr, fq);
        wave_mm<1, 4, 4>(yf, sC + wid * 16 * 136, 136, sSf, 136, fr, fq);
        wave_mm<1, 4, 4>(yb, sC + wid * 16 * 136, 136, sSb, 136, fr, fq);
        const float dsk = p.ssm_d[L * 4 + h];
#pragma unroll
        for (int j = 0; j < 4; ++j) {
          const int l = wid * 16 + fq * 4 + j;
          const float ef = __expf(cf[l]), eb = __expf(cb[l]);
#pragma unroll
          for (int n = 0; n < 4; ++n) {
            const int ch = h * 64 + n * 16 + fr;
            const float xv = bf2f(p.xbc()[(t0 + l) * 768 + ch]);
            const float z = bf2f(p.proj()[(t0 + l) * PWP + C_Z + ch]);
            const float yv = (yd[0][n][j] + ef * yf[0][n][j] + eb * yb[0][n][j] + dsk * xv) * silu(z);
            ssq[j] += yv * yv;
            p.ybuf()[(t0 + l) * 256 + ch] = yv;
          }
        }
        __syncthreads();
      }
    }
    const float* nwt = p.ssm_norm_w + L * 256;
#pragma unroll
    for (int j = 0; j < 4; ++j) {
      float ss = ssq[j];
#pragma unroll
      for (int sft = 1; sft < 16; sft <<= 1) ss += __shfl_xor(ss, sft);
      const float rstd = rsqrtf(ss * (1.f / 256.f) + 1e-6f);
      const int l = wid * 16 + fq * 4 + j;
#pragma unroll
      for (int hn = 0; hn < 16; ++hn) {
        const int ch = hn * 16 + fr;
        p.mixed()[(t0 + l) * DM + 512 + ch] = f2bf(p.ybuf()[(t0 + l) * 256 + ch] * rstd * nwt[ch]);
      }
    }
  }
}

template <bool XIN_F32>
struct CfgOutproj {
  static constexpr bool PERM = true;
  int K; const Params* p; int L; int bid, nb; const void* xin; u16* xout;
  DI bool next(int i, pg8::Unit& u) const { const int t = i * nb + bid; if (t >= 64 * 4) return false; u.pm = t & 63; u.pn = t >> 6; return true; }
  DI const char* a_base(const pg8::Unit& u) const { return (const char*)(p->mixed() + (size_t)u.pm * 256 * DM); }
  DI const char* b_base(const pg8::Unit& u) const { return (const char*)(p->WoutT() + ((size_t)L * DM + (size_t)u.pn * 256) * DM); }
  DI void a_off(const pg8::Unit&, int R0, int C0, int R1, int C1, unsigned (&vo)[4]) const {
    vo[0] = (unsigned)(R0 * DM + C0) * 2u; vo[1] = (unsigned)(R1 * DM + C1) * 2u;
    vo[2] = vo[0] + 128u * DM * 2u; vo[3] = vo[1] + 128u * DM * 2u;
  }
  DI void epi(const f32x4 (&acc)[2][2][4][2], const pg8::Unit& u, int wr, int wc, int fr, int fq) const {
    const int row0 = u.pm * 256 + wr * 64 + fr, col0 = u.pn * 256 + wc * 32 + 8 * fq;
#pragma unroll
    for (int ai = 0; ai < 2; ++ai)
#pragma unroll
      for (int m = 0; m < 4; ++m) {
        const size_t ro = (size_t)(row0 + ai * 128 + m * 16) * DM + col0;
#pragma unroll
        for (int bj = 0; bj < 2; ++bj) {
          const size_t o = ro + bj * 128;
          float4 x0, x1;
          if (XIN_F32) {
            x0 = *reinterpret_cast<const float4*>(static_cast<const float*>(xin) + o);
            x1 = *reinterpret_cast<const float4*>(static_cast<const float*>(xin) + o + 4);
          } else {
            const uint4 q = *reinterpret_cast<const uint4*>(static_cast<const u16*>(xin) + o);
            x0 = bf4_to_f4(make_uint2(q.x, q.y)); x1 = bf4_to_f4(make_uint2(q.z, q.w));
          }
          const f32x4 a0 = acc[ai][bj][m][0], a1 = acc[ai][bj][m][1];
          uint4 w;
          w.x = pack2(x0.x + a0[0], x0.y + a0[1]); w.y = pack2(x0.z + a0[2], x0.w + a0[3]);
          w.z = pack2(x1.x + a1[0], x1.y + a1[1]); w.w = pack2(x1.z + a1[2], x1.w + a1[3]);
          *reinterpret_cast<uint4*>(xout + o) = w;
        }
      }
  }
};
DI void ph_outproj(const Params& p, int L, char* smem) {
  if (L == 0) {
    CfgOutproj<true> c; c.K = DM; c.p = &p; c.L = L; c.bid = obid(); c.nb = gridDim.x; c.xin = p.x; c.xout = p.xres();
    pg8::gemm_phase((pg8::lds_u8*)smem, c);
  } else {
    CfgOutproj<false> c; c.K = DM; c.p = &p; c.L = L; c.bid = obid(); c.nb = gridDim.x; c.xin = p.xres2(); c.xout = p.xres();
    pg8::gemm_phase((pg8::lds_u8*)smem, c);
  }
}

DI void ph_rms2_router(const Params& p, int L, const u16* xres, char* smem) {
  const int tid = otid(), lane = tid & 63, gw = (obid() * NTHR + tid) >> 6, nw = gridDim.x * (NTHR / 64);
  const float* w = p.ln2_w + L * DM;
  const float* rw = p.router_w + (size_t)L * DM * 16;
  float4* srw = reinterpret_cast<float4*>(smem);
  for (int i = tid; i < 4096; i += NTHR) {
    const int c = i >> 2, e4 = i & 3;
    srw[(e4 * 4 + (c & 3)) * 256 + (c >> 2)] = *reinterpret_cast<const float4*>(rw + (size_t)i * 4);
  }
  __syncthreads();
  const int b5 = (lane >> 5) & 1, b4 = (lane >> 4) & 1, b3 = (lane >> 3) & 1, b2 = (lane >> 2) & 1;
  const int my_e = 8 * b5 + 4 * b4 + 2 * b3 + b2;
  float4 v[4];
  if (gw < T) {
#pragma unroll
    for (int i = 0; i < 4; ++i) v[i] = bf4_to_f4(*reinterpret_cast<const uint2*>(xres + (size_t)gw * DM + (i * 64 + lane) * 4));
  }
  for (int t = gw; t < T; t += nw) {
    uint2 vnx[4];
    const int tn = (t + nw < T) ? (t + nw) : t;
#pragma unroll
    for (int i = 0; i < 4; ++i) vnx[i] = *reinterpret_cast<const uint2*>(xres + (size_t)tn * DM + (i * 64 + lane) * 4);
    float ss = 0.f;
#pragma unroll
    for (int i = 0; i < 4; ++i) ss += v[i].x * v[i].x + v[i].y * v[i].y + v[i].z * v[i].z + v[i].w * v[i].w;
    ss = wave_sum(ss);
    const float rstd = rsqrtf(ss * (1.f / DM) + 1e-6f);
    float lg[16];
#pragma unroll
    for (int e = 0; e < 16; ++e) lg[e] = 0.f;
#pragma unroll
    for (int i = 0; i < 4; ++i) {
      const int q = i * 64 + lane;
      const float4 ww = *reinterpret_cast<const float4*>(w + q * 4);
      const float hv[4] = {v[i].x * rstd * ww.x, v[i].y * rstd * ww.y, v[i].z * rstd * ww.z, v[i].w * rstd * ww.w};
      *reinterpret_cast<unsigned*>(p.hn8() + (size_t)t * DM + q * 4) =
          pk4_f8(hv[0] * F8_H_SCALE, hv[1] * F8_H_SCALE, hv[2] * F8_H_SCALE, hv[3] * F8_H_SCALE);
#pragma unroll
      for (int j = 0; j < 4; ++j)
#pragma unroll
        for (int e4 = 0; e4 < 4; ++e4) {
          const float4 r = srw[(e4 * 4 + j) * 256 + q];
          lg[e4 * 4 + 0] += hv[j] * r.x; lg[e4 * 4 + 1] += hv[j] * r.y;
          lg[e4 * 4 + 2] += hv[j] * r.z; lg[e4 * 4 + 3] += hv[j] * r.w;
        }
      __builtin_amdgcn_sched_barrier(0);
    }
#pragma unroll
    for (int k = 0; k < 8; ++k) {
      const float send = b5 ? lg[k] : lg[k + 8], keep = b5 ? lg[k + 8] : lg[k];
      lg[k] = keep + __shfl_xor(send, 32);
    }
#pragma unroll
    for (int k = 0; k < 4; ++k) {
      const float send = b4 ? lg[k] : lg[k + 4], keep = b4 ? lg[k + 4] : lg[k];
      lg[k] = keep + __shfl_xor(send, 16);
    }
#pragma unroll
    for (int k = 0; k < 2; ++k) {
      const float send = b3 ? lg[k] : lg[k + 2], keep = b3 ? lg[k + 2] : lg[k];
      lg[k] = keep + __shfl_xor(send, 8);
    }
    float lv;
    {
      const float send = b2 ? lg[0] : lg[1], keep = b2 ? lg[1] : lg[0];
      lv = keep + __shfl_xor(send, 4);
    }
    lv += __shfl_xor(lv, 2);
    lv += __shfl_xor(lv, 1);
    float mx = lv;
    mx = fmaxf(mx, __shfl_xor(mx, 4)); mx = fmaxf(mx, __shfl_xor(mx, 8));
    mx = fmaxf(mx, __shfl_xor(mx, 16)); mx = fmaxf(mx, __shfl_xor(mx, 32));
    const float ex = expf(lv - mx);
    float den = ex;
    den += __shfl_xor(den, 4); den += __shfl_xor(den, 8); den += __shfl_xor(den, 16); den += __shfl_xor(den, 32);
    if ((lane & 3) == 0) { p.aff()[(size_t)t * 16 + my_e] = ex / den; p.inv()[(size_t)t * 16 + my_e] = -1; }
#pragma unroll
    for (int i = 0; i < 4; ++i) v[i] = bf4_to_f4(vnx[i]);
  }
}

DI int block_sum_i(int v, int* red, int tid) {
#pragma unroll
  for (int o = 32; o > 0; o >>= 1) v += __shfl_xor(v, o);
  __syncthreads();
  if ((tid & 63) == 0) red[tid >> 6] = v;
  __syncthreads();
  int t = 0;
#pragma unroll
  for (int w = 0; w < NTHR / 64; ++w) t += red[w];
  return t;
}
DI void ph_topk(const Params& p, char* smem) {
  int* red = reinterpret_cast<int*>(smem);
  int* wsum = red + 16;
  const int tid = otid(), wid = tid >> 6, lane = tid & 63;
  for (int it = obid(); it < 64; it += gridDim.x) {
    const int e = it & 15, b = it >> 4;
    unsigned v[8];
#pragma unroll
    for (int i = 0; i < 8; ++i) v[i] = __float_as_uint(p.aff()[(size_t)(b * SEQ + tid * 8 + i) * 16 + e]);
    unsigned thr = 0;
#pragma unroll 1
    for (int bit = 30; bit >= 0; --bit) {
      const unsigned cand = thr | (1u << bit);
      int cnt = 0;
#pragma unroll
      for (int i = 0; i < 8; ++i) cnt += (v[i] >= cand) ? 1 : 0;
      if (block_sum_i(cnt, red, tid) >= 512) thr = cand;
    }
    int ngt = 0, ntie = 0;
#pragma unroll
    for (int i = 0; i < 8; ++i) { ngt += (v[i] > thr) ? 1 : 0; ntie += (v[i] == thr) ? 1 : 0; }
    int ig = ngt, itie = ntie;
#pragma unroll
    for (int o = 1; o < 64; o <<= 1) {
      const int a = __shfl_up(ig, o), c = __shfl_up(itie, o);
      if (lane >= o) { ig += a; itie += c; }
    }
    __syncthreads();
    if (lane == 63) { wsum[wid] = ig; wsum[8 + wid] = itie; }
    __syncthreads();
    int og = 0, ot = 0, totg = 0;
#pragma unroll
    for (int w = 0; w < 8; ++w) {
      const int a = wsum[w], c = wsum[8 + w];
      if (w < wid) { og += a; ot += c; }
      totg += a;
    }
    int pg = og + ig - ngt, pt = ot + itie - ntie;
    const int base = (e * 4 + b) * 512;
#pragma unroll
    for (int i = 0; i < 8; ++i) {
      int slot = -1;
      if (v[i] > thr) { slot = pg; ++pg; }
      else if (v[i] == thr) { if (totg + pt < 512) slot = totg + pt; ++pt; }
      if (slot >= 0) {
        p.tok()[base + slot] = b * SEQ + tid * 8 + i;
        p.inv()[(size_t)(b * SEQ + tid * 8 + i) * 16 + e] = base + slot;
        p.gate()[base + slot] = __uint_as_float(v[i]);
      }
    }
    __syncthreads();
  }
}

struct CfgMoe1 {
  static constexpr bool PERM = true;
  int K; const Params* p; int L; int bid, nb;
  DI bool next(int i, pg8::Unit& u) const {
    const int t = i * nb + bid; if (t >= 16 * 16 * 8) return false;
    const int rnd = t >> 8, w = t & 255, xcd = w & 7, jx = w >> 3, pid = xcd * 4 + (jx >> 3);
    const int mt = jx & 7, nt = pid & 15, e = rnd * 2 + (pid >> 4);
    u.pm = e * 8 + mt; u.pn = e * 16 + nt; return true;
  }
  DI const char* a_base(const pg8::Unit&) const { return (const char*)p->hn8(); }
  DI const char* b_base(const pg8::Unit& u) const { return (const char*)(p->Wgu8() + ((size_t)L * 16 * 4096 + (size_t)u.pn * 256) * DM); }
  const int* tokl;
  DI void a_off(const pg8::Unit&, int R0, int C0, int R1, int C1, unsigned (&vo)[4], int ui) const {
    const int* tk = tokl + ui * 256;
    vo[0] = (unsigned)(tk[R0] * 512 + C0) * 2u; vo[1] = (unsigned)(tk[R1] * 512 + C1) * 2u;
    vo[2] = (unsigned)(tk[128 + R0] * 512 + C0) * 2u; vo[3] = (unsigned)(tk[128 + R1] * 512 + C1) * 2u;
  }
  DI void epi(const f32x4 (&acc)[2][2][4][2], const pg8::Unit& u, int wr, int wc, int fr, int fq) const {
    const int row0 = u.pm * 256 + wr * 64 + fr, col0 = (u.pn & 15) * 128 + wc * 32 + 8 * fq;
    const float dq = 1.f / (F8_H_SCALE * F8_W_SCALE);
#pragma unroll
    for (int ai = 0; ai < 2; ++ai)
#pragma unroll
      for (int m = 0; m < 4; ++m) {
        const f32x4 g0 = acc[ai][0][m][0] * dq, g1 = acc[ai][0][m][1] * dq, u0 = acc[ai][1][m][0] * (dq * F8_HID_SCALE), u1 = acc[ai][1][m][1] * (dq * F8_HID_SCALE);
        uint2 w;
        w.x = pk4_f8(fast_silu(g0[0]) * u0[0], fast_silu(g0[1]) * u0[1], fast_silu(g0[2]) * u0[2], fast_silu(g0[3]) * u0[3]);
        w.y = pk4_f8(fast_silu(g1[0]) * u1[0], fast_silu(g1[1]) * u1[1], fast_silu(g1[2]) * u1[2], fast_silu(g1[3]) * u1[3]);
        *reinterpret_cast<uint2*>(p->hid8() + (size_t)(row0 + ai * 128 + m * 16) * 2048 + col0) = w;
      }
  }
};
DI void ph_moe1(const Params& p, int L, char* smem) {
  CfgMoe1 c; c.K = 512; c.p = &p; c.L = L; c.bid = obid(); c.nb = gridDim.x;
  int* tokl = reinterpret_cast<int*>(smem + 131072);
  c.tokl = tokl;
  for (int idx = otid(); idx < 8 * 256; idx += NTHR) {
    pg8::Unit u;
    if (c.next(idx >> 8, u)) tokl[idx] = p.tok()[u.pm * 256 + (idx & 255)];
  }
  __syncthreads();
  pg8::gemm_phase_f8((pg8::lds_u8*)smem, c);
}
struct CfgMoe2 {
  static constexpr bool PERM = true;
  int K; const Params* p; int L; int bid, nb;
  DI bool next(int i, pg8::Unit& u) const {
    const int t = i * nb + bid; if (t >= 16 * 4 * 8) return false;
    const int rnd = t >> 8, w = t & 255, xcd = w & 7, jx = w >> 3, pid = rnd * 32 + xcd * 4 + (jx >> 3);
    u.pm = (pid >> 2) * 8 + (jx & 7); u.pn = pid; return true;
  }
  DI const char* a_base(const pg8::Unit& u) const { return (const char*)(p->hid8() + (size_t)u.pm * 256 * 2048); }
  DI const char* b_base(const pg8::Unit& u) const { return (const char*)(p->Wd8() + ((size_t)L * 16 * DM + (size_t)u.pn * 256) * 2048); }
  DI void a_off(const pg8::Unit&, int R0, int C0, int R1, int C1, unsigned (&vo)[4], int) const {
    vo[0] = (unsigned)(R0 * 1024 + C0) * 2u; vo[1] = (unsigned)(R1 * 1024 + C1) * 2u;
    vo[2] = vo[0] + 128u * 1024u * 2u; vo[3] = vo[1] + 128u * 1024u * 2u;
  }
  DI void epi(const f32x4 (&acc)[2][2][4][2], const pg8::Unit& u, int wr, int wc, int fr, int fq) const {
    u16* eo = p->proj();
    const int row0 = u.pm * 256 + wr * 64 + fr, col0 = (u.pn & 3) * 256 + wc * 32 + 8 * fq;
#pragma unroll
    for (int ai = 0; ai < 2; ++ai)
#pragma unroll
      for (int m = 0; m < 4; ++m) {
        const int row = row0 + ai * 128 + m * 16;
        const float gt = p->gate()[row] * (1.f / (F8_HID_SCALE * F8_W_SCALE));
#pragma unroll
        for (int bj = 0; bj < 2; ++bj) {
          const f32x4 a0 = acc[ai][bj][m][0], a1 = acc[ai][bj][m][1];
          uint4 w;
          w.x = pack2(gt * a0[0], gt * a0[1]); w.y = pack2(gt * a0[2], gt * a0[3]);
          w.z = pack2(gt * a1[0], gt * a1[1]); w.w = pack2(gt * a1[2], gt * a1[3]);
          *reinterpret_cast<uint4*>(eo + (size_t)row * DM + col0 + bj * 128) = w;
        }
      }
  }
};
DI void ph_moe2(const Params& p, int L, char* smem) {
  CfgMoe2 c; c.K = 1024; c.p = &p; c.L = L; c.bid = obid(); c.nb = gridDim.x;
  pg8::gemm_phase_f8((pg8::lds_u8*)smem, c);
}
template <bool FINAL>
DI void ph_combine_norm(const Params& p, const u16* __restrict__ xa, u16* __restrict__ xnew, const float* __restrict__ w,
                        u16* __restrict__ hn_out, float* __restrict__ f_out) {
  const int tid_ = otid(), lane = tid_ & 63, gw = (obid() * NTHR + tid_) >> 6, nw = gridDim.x * (NTHR / 64);
  const u16* eo = p.proj();
  float4 v[4];
  int myrow = -1;
  if (gw < T) {
#pragma unroll
    for (int i = 0; i < 4; ++i) v[i] = bf4_to_f4(*reinterpret_cast<const uint2*>(xa + (size_t)gw * DM + (i * 64 + lane) * 4));
    myrow = (lane < 16) ? p.inv()[(size_t)gw * 16 + lane] : -1;
  }
  for (int t = gw; t < T; t += nw) {
    uint2 vnx[4];
    const int tn = (t + nw < T) ? (t + nw) : t;
#pragma unroll
    for (int i = 0; i < 4; ++i) vnx[i] = *reinterpret_cast<const uint2*>(xa + (size_t)tn * DM + (i * 64 + lane) * 4);
    const int myrow_nx = (lane < 16) ? p.inv()[(size_t)tn * 16 + lane] : -1;
    unsigned long long mask = __builtin_amdgcn_ballot_w64(myrow >= 0);
#pragma unroll 1
    while (mask != 0ull) {
      const int e0 = __builtin_ctzll(mask);
      mask &= mask - 1ull;
      const int r0 = __builtin_amdgcn_readlane(myrow, e0);
      int r1 = -1;
      if (mask != 0ull) { const int e1 = __builtin_ctzll(mask); mask &= mask - 1ull; r1 = __builtin_amdgcn_readlane(myrow, e1); }
      uint2 q0[4], q1[4];
#pragma unroll
      for (int i = 0; i < 4; ++i) q0[i] = *reinterpret_cast<const uint2*>(eo + (size_t)r0 * DM + (i * 64 + lane) * 4);
      const int r1c = (r1 >= 0) ? r1 : r0;
#pragma unroll
      for (int i = 0; i < 4; ++i) q1[i] = *reinterpret_cast<const uint2*>(eo + (size_t)r1c * DM + (i * 64 + lane) * 4);
      const float s1 = (r1 >= 0) ? 1.f : 0.f;
#pragma unroll
      for (int i = 0; i < 4; ++i) {
        v[i].x += __uint_as_float(q0[i].x << 16); v[i].y += __uint_as_float(q0[i].x & 0xffff0000u);
        v[i].z += __uint_as_float(q0[i].y << 16); v[i].w += __uint_as_float(q0[i].y & 0xffff0000u);
        v[i].x += s1 * __uint_as_float(q1[i].x << 16); v[i].y += s1 * __uint_as_float(q1[i].x & 0xffff0000u);
        v[i].z += s1 * __uint_as_float(q1[i].y << 16); v[i].w += s1 * __uint_as_float(q1[i].y & 0xffff0000u);
      }
    }
    float ss = 0.f;
#pragma unroll
    for (int i = 0; i < 4; ++i) ss += v[i].x * v[i].x + v[i].y * v[i].y + v[i].z * v[i].z + v[i].w * v[i].w;
    ss = wave_sum(ss);
    const float rstd = rsqrtf(ss * (1.f / DM) + 1e-6f);
#pragma unroll
    for (int i = 0; i < 4; ++i) {
      const int c = (i * 64 + lane) * 4;
      const float4 ww = *reinterpret_cast<const float4*>(w + c);
      if (FINAL) {
        *reinterpret_cast<float4*>(f_out + (size_t)t * DM + c) = make_float4(v[i].x * rstd * ww.x, v[i].y * rstd * ww.y, v[i].z * rstd * ww.z, v[i].w * rstd * ww.w);
      } else {
        uint2 xo;
        xo.x = pack2(v[i].x, v[i].y); xo.y = pack2(v[i].z, v[i].w);
        *reinterpret_cast<uint2*>(xnew + (size_t)t * DM + c) = xo;
        uint2 o;
        o.x = pack2(v[i].x * rstd * ww.x, v[i].y * rstd * ww.y);
        o.y = pack2(v[i].z * rstd * ww.z, v[i].w * rstd * ww.w);
        *reinterpret_cast<uint2*>(hn_out + (size_t)t * DM + c) = o;
      }
    }
#pragma unroll
    for (int i = 0; i < 4; ++i) v[i] = bf4_to_f4(vnx[i]);
    myrow = myrow_nx;
  }
}

__global__ void __launch_bounds__(NTHR) mk(Params p) {
  extern __shared__ __attribute__((aligned(16))) char smem[];
  cg::grid_group grid = cg::this_grid();
  __shared__ uint4 xb_words;
  if (threadIdx.x == 0) xb_words = make_uint4(0u, 0u, 0u, 0u);
  __syncthreads();
  XcdBarrier xb = xcd_barrier_post(p.bar(), (volatile LAS unsigned*)&xb_words);
  ph_convert(p, smem);
  ph_rmsnorm_bf16(p.x, p.ln1_w, p.hn());
  xcd_barrier(xb);
  if (p.rep[12] == 0x7fffffff) grid.sync();
  for (int L = 0; L < 2; ++L) {
    u16* xout = p.xres();
    if (L == 1) {
      ph_combine_norm<false>(p, p.xres(), p.xres2(), p.ln1_w + DM, p.hn(), nullptr);
      xcd_barrier(xb);
    }
    ph_inproj(p, L, smem);
    xcd_barrier(xb);
    ph_post(p, L);
    xcd_barrier(xb);
    {
      unsigned* ctr = p.bar() + XCD_BAR_WORDS + 8 + L;
      __shared__ int q1_item;
      for (;;) {
        if (threadIdx.x == 0) q1_item = (int)atomicAdd(ctr, 1u);
        __syncthreads();
        const int it = q1_item;
        __syncthreads();
        if (it >= 1344) break;
        if (it < 256) ph_dil_pass<0>(p, smem, it);
        else if (it < 384) ph_ssd_a(p, L, smem, it - 256);
        else if (it < 576) ph_mla_up_q(p, L, smem, it - 384);
        else if (it < 832) ph_mla_up_kv(p, L, smem, it - 576);
        else ph_ret_a(p, smem, it - 832);
      }
    }
    xcd_barrier(xb);
    {
      { ph_ret_scan(p); ph_ssd_scan(p); }
      ph_mla_attn(p, smem, L);
      for (int bi = obid(); bi < 256; bi += gridDim.x) ph_dil_pass<1>(p, smem, bi);
    }
    xcd_barrier(xb);
    {
      unsigned* ctr = p.bar() + XCD_BAR_WORDS + L;
      __shared__ int q_item;
      for (;;) {
        if (threadIdx.x == 0) q_item = (int)atomicAdd(ctr, 1u);
        __syncthreads();
        const int it = q_item;
        __syncthreads();
        if (it >= 640) break;
        if (it < 128) ph_ssd_c(p, L, smem, it);
        else ph_ret_c(p, smem, it - 128);
      }
    }
    xcd_barrier(xb);
    ph_outproj(p, L, smem);
    xcd_barrier(xb);
    ph_rms2_router(p, L, xout, smem);
    xcd_barrier(xb);
    ph_topk(p, smem);
    if (gridDim.x == 256 && obid() >= CVT_IDLE_FIRST_BLK) cvt_tiles_idle(p, L, smem, CVT_A, 8);
    xcd_barrier(xb);
    ph_moe1(p, L, smem);
    xcd_barrier(xb);
    ph_moe2(p, L, smem);
    xcd_barrier(xb);
  }
  ph_combine_norm<true>(p, p.xres(), nullptr, p.final_w, nullptr, p.out);
}

extern "C" void kernel_launch(void* const* d_in, const int* in_sizes, int n_in, void* d_out, int out_size, void* d_ws,
                              size_t ws_size, hipStream_t stream) {
  static int grid_blocks = 0;
  if (!grid_blocks) {
    int dev = 0, cus = 0, per_cu = 0;
    (void)hipGetDevice(&dev);
    (void)hipDeviceGetAttribute(&cus, hipDeviceAttributeMultiprocessorCount, dev);
    (void)hipFuncSetAttribute((const void*)mk, hipFuncAttributeMaxDynamicSharedMemorySize, LDS_BYTES);
    (void)hipOccupancyMaxActiveBlocksPerMultiprocessor(&per_cu, (const void*)mk, NTHR, LDS_BYTES);
    if (per_cu < 1) { fprintf(stderr, "occupancy query says %d blocks/CU\n", per_cu); per_cu = 1; }
    grid_blocks = cus * 1;
  }
  Params p{};
  const float** fp = reinterpret_cast<const float**>(&p);
  for (int i = 0; i < 20; ++i) fp[i] = (const float*)d_in[i];
  p.out = (float*)d_out;
  p.ws = (char*)d_ws;
  const size_t off = WSO.total;
  { const int reps[16] = REPS_INIT; for (int i = 0; i < 16; ++i) p.rep[i] = reps[i]; }
  if (off > ws_size) { fprintf(stderr, "workspace too small: need %zu have %zu\n", off, ws_size); return; }
  (void)hipMemsetAsync(p.bar(), 0, (size_t)(XCD_BAR_WORDS + 64) * 4, stream);
  void* args[] = {&p};
  hipError_t e = hipLaunchCooperativeKernel((void*)mk, dim3(grid_blocks), dim3(NTHR), args, LDS_BYTES, stream);
  if (e != hipSuccess) fprintf(stderr, "cooperative launch failed: %s (grid %d)\n", hipGetErrorString(e), grid_blocks);
}
```

```cpp
#include <hip/hip_runtime.h>
#include <hip/hip_cooperative_groups.h>
#include <cstdio>
#include <cstdint>
namespace cg = cooperative_groups;

#define DI __device__ __forceinline__
typedef unsigned short u16;
typedef __attribute__((ext_vector_type(8))) short bf16x8;
typedef __attribute__((ext_vector_type(4))) float f32x4;

#ifndef REPS_INIT
#define REPS_INIT {1, 1, 1, 1, 1, 1, 1, 1, 1, 1, 1, 1, 0, 1, 1, 1}
#endif
constexpr int NTHR = 512;
constexpr int T = 16384, SEQ = 4096, DM = 1024;
constexpr int PW = 3240, PWP = 3328;
constexpr int C_RQ = 0, C_RK = 256, C_RV = 512, C_RG = 768, C_CQ = 1024, C_CKV = 1280, C_KR = 1408,
              C_Z = 1440, C_XBC = 1696, C_DT = 2464, C_DQ = 2472, C_DK = 2728, C_DV = 2984;
constexpr int LDS_BYTES = 131072 + 8192;

struct WsOff {
  size_t WinT;
  size_t WuqT;
  size_t WukvT;
  size_t WoutT;
  size_t Wgu8;
  size_t Wd8;
  size_t hn8;
  size_t xres;
  size_t hn;
  size_t proj;
  size_t cqn;
  size_t ckvn;
  size_t mq;
  size_t xbc;
  size_t mixed;
  size_t hid8;
  size_t kfull;
  size_t rS;
  size_t sS;
  size_t rU;
  size_t sU;
  size_t cdec;
  size_t vT;
  size_t rtab;
  size_t dpart;
  size_t dtv;
  size_t cs;
  size_t ybuf;
  size_t aff;
  size_t gate;
  size_t tok;
  size_t inv;
  size_t bar;
  size_t xres2;
  size_t total;
};
constexpr WsOff ws_layout() {
  WsOff o{};
  size_t off = 0;
  o.WinT = off; off += (((size_t)2 * PWP * DM * 2) + 255) & ~(size_t)255;
  o.WuqT = off; off += (((size_t)2 * 384 * 256 * 2) + 255) & ~(size_t)255;
  o.WukvT = off; off += (((size_t)2 * 512 * 128 * 2) + 255) & ~(size_t)255;
  o.WoutT = off; off += (((size_t)2 * DM * DM * 2) + 255) & ~(size_t)255;
  o.Wgu8 = off; off += (((size_t)2 * 16 * 4096 * DM) + 255) & ~(size_t)255;
  o.Wd8 = off; off += (((size_t)2 * 16 * DM * 2048) + 255) & ~(size_t)255;
  o.hn8 = off; off += (((size_t)T * DM) + 255) & ~(size_t)255;
  o.xres = off; off += (((size_t)T * DM * 2) + 255) & ~(size_t)255;
  o.hn = off; off += (((size_t)T * DM * 2) + 255) & ~(size_t)255;
  o.proj = off; off += (((size_t)T * PWP * 2) + 255) & ~(size_t)255;
  o.cqn = off; off += (((size_t)T * 256 * 2) + 255) & ~(size_t)255;
  o.ckvn = off; off += (((size_t)T * 128 * 2) + 255) & ~(size_t)255;
  o.mq = off; off += (((size_t)T * 384 * 2) + 255) & ~(size_t)255;
  o.xbc = off; off += (((size_t)T * 768 * 2) + 255) & ~(size_t)255;
  o.mixed = off; off += (((size_t)T * DM * 2) + 255) & ~(size_t)255;
  o.hid8 = off; off += (((size_t)32768 * 2048) + 255) & ~(size_t)255;
  o.kfull = off; off += (((size_t)T * 4 * 96 * 2) + 255) & ~(size_t)255;
  o.rS = off; off += (((size_t)16 * 32 * 2 * 4096 * 2) + 255) & ~(size_t)255;
  o.sS = off; off += (((size_t)128 * 8 * 8192 * 2) + 255) & ~(size_t)255;
  o.rU = off; off += (((size_t)16 * 32 * 2 * 4096 * 4) + 255) & ~(size_t)255;
  o.sU = off; off += (((size_t)128 * 8 * 8192 * 4) + 255) & ~(size_t)255;
  o.cdec = off; off += (((size_t)128 * 8 * 4) + 255) & ~(size_t)255;
  o.vT = off; off += (((size_t)T * 4 * 64 * 2) + 255) & ~(size_t)255;
  o.rtab = off; off += (((size_t)SEQ * 56 * 2 * 4) + 255) & ~(size_t)255;
  o.dpart = off; off += (((size_t)T * 4 * 68 * 4) + 255) & ~(size_t)255;
  o.dtv = off; off += (((size_t)T * 8 * 4) + 255) & ~(size_t)255;
  o.cs = off; off += (((size_t)T * 8 * 4) + 255) & ~(size_t)255;
  o.ybuf = off; off += (((size_t)T * 256 * 4) + 255) & ~(size_t)255;
  o.aff = off; off += (((size_t)T * 16 * 4) + 255) & ~(size_t)255;
  o.gate = off; off += (((size_t)64 * 512 * 4) + 255) & ~(size_t)255;
  o.tok = off; off += (((size_t)64 * 512 * 4) + 255) & ~(size_t)255;
  o.inv = off; off += (((size_t)T * 16 * 4) + 255) & ~(size_t)255;
  o.bar = off; off += (((size_t)(3456 + 64) * 4) + 255) & ~(size_t)255;
  o.xres2 = off; off += (((size_t)T * DM * 2) + 255) & ~(size_t)255;
  o.total = off;
  return o;
}
constexpr WsOff WSO = ws_layout();
struct Params {
  const float *x, *ln1_w, *w_in, *q_norm_w, *kv_norm_w, *w_uq, *w_ukv, *conv_w, *conv_b, *a_log, *dt_bias,
      *ssm_d, *ssm_norm_w, *w_out, *ln2_w, *router_w, *w_gate, *w_up, *w_down, *final_w;
  float* out;
  char* ws;
  int rep[16];
  __host__ DI u16* WinT() const { return reinterpret_cast<u16*>(ws + WSO.WinT); }
  __host__ DI u16* WuqT() const { return reinterpret_cast<u16*>(ws + WSO.WuqT); }
  __host__ DI u16* WukvT() const { return reinterpret_cast<u16*>(ws + WSO.WukvT); }
  __host__ DI u16* WoutT() const { return reinterpret_cast<u16*>(ws + WSO.WoutT); }
  __host__ DI unsigned char* Wgu8() const { return reinterpret_cast<unsigned char*>(ws + WSO.Wgu8); }
  __host__ DI unsigned char* Wd8() const { return reinterpret_cast<unsigned char*>(ws + WSO.Wd8); }
  __host__ DI unsigned char* hn8() const { return reinterpret_cast<unsigned char*>(ws + WSO.hn8); }
  __host__ DI u16* xres() const { return reinterpret_cast<u16*>(ws + WSO.xres); }
  __host__ DI u16* hn() const { return reinterpret_cast<u16*>(ws + WSO.hn); }
  __host__ DI u16* proj() const { return reinterpret_cast<u16*>(ws + WSO.proj); }
  __host__ DI u16* cqn() const { return reinterpret_cast<u16*>(ws + WSO.cqn); }
  __host__ DI u16* ckvn() const { return reinterpret_cast<u16*>(ws + WSO.ckvn); }
  __host__ DI u16* mq() const { return reinterpret_cast<u16*>(ws + WSO.mq); }
  __host__ DI u16* xbc() const { return reinterpret_cast<u16*>(ws + WSO.xbc); }
  __host__ DI u16* mixed() const { return reinterpret_cast<u16*>(ws + WSO.mixed); }
  __host__ DI unsigned char* hid8() const { return reinterpret_cast<unsigned char*>(ws + WSO.hid8); }
  __host__ DI u16* kfull() const { return reinterpret_cast<u16*>(ws + WSO.kfull); }
  __host__ DI u16* rS() const { return reinterpret_cast<u16*>(ws + WSO.rS); }
  __host__ DI u16* sS() const { return reinterpret_cast<u16*>(ws + WSO.sS); }
  __host__ DI float* rU() const { return reinterpret_cast<float*>(ws + WSO.rU); }
  __host__ DI float* sU() const { return reinterpret_cast<float*>(ws + WSO.sU); }
  __host__ DI float* cdec() const { return reinterpret_cast<float*>(ws + WSO.cdec); }
  __host__ DI u16* vT() const { return reinterpret_cast<u16*>(ws + WSO.vT); }
  __host__ DI float* rtab() const { return reinterpret_cast<float*>(ws + WSO.rtab); }
  __host__ DI float* dpart() const { return reinterpret_cast<float*>(ws + WSO.dpart); }
  __host__ DI float* dtv() const { return reinterpret_cast<float*>(ws + WSO.dtv); }
  __host__ DI float* cs() const { return reinterpret_cast<float*>(ws + WSO.cs); }
  __host__ DI float* ybuf() const { return reinterpret_cast<float*>(ws + WSO.ybuf); }
  __host__ DI float* aff() const { return reinterpret_cast<float*>(ws + WSO.aff); }
  __host__ DI float* gate() const { return reinterpret_cast<float*>(ws + WSO.gate); }
  __host__ DI int* tok() const { return reinterpret_cast<int*>(ws + WSO.tok); }
  __host__ DI int* inv() const { return reinterpret_cast<int*>(ws + WSO.inv); }
  __host__ DI unsigned* bar() const { return reinterpret_cast<unsigned*>(ws + WSO.bar); }
  __host__ DI u16* xres2() const { return reinterpret_cast<u16*>(ws + WSO.xres2); }
};


typedef __attribute__((ext_vector_type(2))) __bf16 bf16x2_t;
typedef __attribute__((ext_vector_type(2))) float f32x2_t;
typedef __attribute__((ext_vector_type(16))) float f32x16;
typedef __attribute__((ext_vector_type(4))) short s16x4;
typedef __attribute__((ext_vector_type(8))) int i32x8;
typedef __attribute__((ext_vector_type(4))) int i32x4;
DI unsigned pack2(float a, float b) {
  f32x2_t v = {a, b};
  return __builtin_bit_cast(unsigned, __builtin_convertvector(v, bf16x2_t));
}
DI u16 f2bf(float f) { return (u16)(pack2(f, 0.f) & 0xffffu); }
DI float bf2f(u16 h) { return __uint_as_float(((unsigned)h) << 16); }
DI void unpack8(const uint4& v, float* f) {
  f[0] = __uint_as_float(v.x << 16); f[1] = __uint_as_float(v.x & 0xffff0000u);
  f[2] = __uint_as_float(v.y << 16); f[3] = __uint_as_float(v.y & 0xffff0000u);
  f[4] = __uint_as_float(v.z << 16); f[5] = __uint_as_float(v.z & 0xffff0000u);
  f[6] = __uint_as_float(v.w << 16); f[7] = __uint_as_float(v.w & 0xffff0000u);
}
DI void ld8(const u16* p, float* f) { uint4 v = *reinterpret_cast<const uint4*>(p); unpack8(v, f); }
DI unsigned pk4_f8(float a, float b, float c, float d) {
  a = __builtin_amdgcn_fmed3f(a, -448.f, 448.f); b = __builtin_amdgcn_fmed3f(b, -448.f, 448.f);
  c = __builtin_amdgcn_fmed3f(c, -448.f, 448.f); d = __builtin_amdgcn_fmed3f(d, -448.f, 448.f);
  int w = __builtin_amdgcn_cvt_pk_fp8_f32(a, b, 0, false);
  w = __builtin_amdgcn_cvt_pk_fp8_f32(c, d, w, true);
  return (unsigned)w;
}
constexpr float F8_W_SCALE = 256.f, F8_H_SCALE = 16.f, F8_HID_SCALE = 8.f;
typedef short s16x2_t __attribute__((ext_vector_type(2)));
template <int SCALE> DI unsigned pk4_f8_scaled(float a, float b, float c, float d) {
  constexpr float inv = 1.f / (float)SCALE;
  s16x2_t r = {0, 0};
  r = __builtin_amdgcn_cvt_scalef32_pk_fp8_f32(r, a, b, inv, false);
  r = __builtin_amdgcn_cvt_scalef32_pk_fp8_f32(r, c, d, inv, true);
  return __builtin_bit_cast(unsigned, r);
}
DI float4 bf4_to_f4(const uint2& q) {
  return make_float4(__uint_as_float(q.x << 16), __uint_as_float(q.x & 0xffff0000u), __uint_as_float(q.y << 16), __uint_as_float(q.y & 0xffff0000u));
}
DI float wave_sum(float v) {
#pragma unroll
  for (int o = 32; o > 0; o >>= 1) v += __shfl_xor(v, o);
  return v;
}
DI float dot2acc(unsigned a, unsigned b, float c) {
  return __builtin_amdgcn_fdot2_f32_bf16(__builtin_bit_cast(bf16x2_t, a), __builtin_bit_cast(bf16x2_t, b), c, false);
}
DI float dot8(const uint4& a, const uint4& b, float c) {
  c = dot2acc(a.x, b.x, c); c = dot2acc(a.y, b.y, c); c = dot2acc(a.z, b.z, c); c = dot2acc(a.w, b.w, c);
  return c;
}
DI int otid() { int t = threadIdx.x; asm volatile("" : "+v"(t)); return t; }
DI int obid() { int b = blockIdx.x; asm volatile("" : "+s"(b)); return b; }
DI float silu(float x) { return x / (1.f + __expf(-x)); }
DI float fast_silu(float x) { return x * __builtin_amdgcn_rcpf(1.f + __expf(-x)); }


#define XB_TMO      128
#define XB_XCNT(j)  (256  + 64 * (j))
#define XB_XSUB(j)  (1280 + 64 * (j))
#define XB_XGEN(j)  (2304 + 64 * (j))
#define XB_TOP      3328
#define XB_TOPGEN   3392
#define XCD_BAR_WORDS 3456
#define XB_SPIN_CAP (1u << 20)
#define LAS __attribute__((address_space(3)))
DI unsigned xb_ld(unsigned* p) { return __hip_atomic_load(p, __ATOMIC_RELAXED, __HIP_MEMORY_SCOPE_AGENT); }
DI unsigned xb_add(unsigned* p, unsigned v) { return __hip_atomic_fetch_add(p, v, __ATOMIC_RELAXED, __HIP_MEMORY_SCOPE_AGENT); }
DI unsigned xb_xcc_id() { return (unsigned)__builtin_amdgcn_s_getreg((3 << 11) | 20) & 0xFu; }
#define XB_SPIN(cond, bar) do { unsigned _sp = 0; while (cond) { __builtin_amdgcn_s_sleep(1); \
    if ((++_sp & 255u) == 0u) { if (xb_ld(&(bar)[XB_TMO])) break; if (_sp > XB_SPIN_CAP) { atomicAdd(&(bar)[XB_TMO], 1u); break; } } } } while (0)
struct XcdBarrier { unsigned* bar; unsigned x; volatile LAS unsigned* st; };
DI XcdBarrier xcd_barrier_post(unsigned* bar, volatile LAS unsigned* st) {
  XcdBarrier b; b.bar = bar; b.x = xb_xcc_id(); b.st = st;
  if (threadIdx.x == 0) (void)xb_add(&bar[XB_XCNT(b.x)], 1u);
  return b;
}
DI void xcd_barrier_complete(unsigned* bar, unsigned x, unsigned& nloc, unsigned& nx) {
  const unsigned G = gridDim.x * gridDim.y * gridDim.z;
  unsigned sum, cnt, mine, sp = 0u;
  for (;;) {
    sum = 0u; cnt = 0u; mine = 0u;
#pragma unroll
    for (unsigned j = 0; j < 16; ++j) { const unsigned c = xb_ld(&bar[XB_XCNT(j)]); sum += c; cnt += (c > 0u) ? 1u : 0u; mine = (j == x) ? c : mine; }
    if (sum == G) break;
    __builtin_amdgcn_s_sleep(1);
    if ((++sp & 255u) == 0u) { if (xb_ld(&bar[XB_TMO])) break; if (sp > XB_SPIN_CAP) { atomicAdd(&bar[XB_TMO], 1u); break; } }
  }
  nloc = mine > 0u ? mine : 1u; nx = cnt > 0u ? cnt : 1u;
}
DI void xcd_barrier(const XcdBarrier& b) {
  asm volatile("s_waitcnt vmcnt(0)" ::: "memory");
  __syncthreads();
  if (threadIdx.x == 0) {
    unsigned* bar = b.bar;
    __builtin_amdgcn_s_waitcnt(0);
    unsigned nloc = b.st[0], nx = b.st[1];
    if (nloc == 0u) { xcd_barrier_complete(bar, b.x, nloc, nx); b.st[0] = nloc; b.st[1] = nx; }
    const unsigned old = xb_add(&bar[XB_XSUB(b.x)], 1u);
    const unsigned gen = old / nloc;
    if (old + 1u == (gen + 1u) * nloc) {
      __builtin_amdgcn_fence(__ATOMIC_RELEASE, "agent");
      asm volatile("s_waitcnt vmcnt(0)" ::: "memory");
      const unsigned og = xb_add(&bar[XB_TOP], 1u);
      const unsigned tg = og / nx;
      if (og + 1u == (tg + 1u) * nx) xb_add(&bar[XB_TOPGEN], 1u);
      else XB_SPIN(xb_ld(&bar[XB_TOPGEN]) == tg, bar);
      __builtin_amdgcn_fence(__ATOMIC_ACQUIRE, "agent");
      xb_add(&bar[XB_XGEN(b.x)], 1u);
      asm volatile("s_waitcnt vmcnt(0)" ::: "memory");
    } else {
      XB_SPIN(xb_ld(&bar[XB_XGEN(b.x)]) == gen, bar);
      __builtin_amdgcn_fence(__ATOMIC_ACQUIRE, "agent");
      asm volatile("s_waitcnt vmcnt(0)" ::: "memory");
    }
  }
  __syncthreads();
}

template <class F>
DI void transpose_convert(const float* __restrict__ src, int K, int N, int Npad, u16* __restrict__ dst, F rowmap,
                          int bid, int nb, char* smem) {
  u16* tile = reinterpret_cast<u16*>(smem);
  const int tid = otid();
  const int ntn = Npad / 128, ntk = K / 64;
  for (int t = bid; t < ntn * ntk; t += nb) {
    const int n0 = (t % ntn) * 128, k0 = (t / ntn) * 64;
    f32x4 v[4];
#pragma unroll
    for (int i = 0; i < 4; ++i) {
      const int kk = (tid >> 5) + 16 * i, nn = (tid & 31) * 4;
      v[i] = f32x4{0.f, 0.f, 0.f, 0.f};
      if (n0 + nn < N) v[i] = __builtin_nontemporal_load(reinterpret_cast<const f32x4*>(src + (size_t)(k0 + kk) * N + n0 + nn));
    }
#pragma unroll
    for (int i = 0; i < 4; ++i) {
      const int kk = (tid >> 5) + 16 * i, nn = (tid & 31) * 4;
      tile[(nn + 0) * 72 + kk] = f2bf(v[i][0]); tile[(nn + 1) * 72 + kk] = f2bf(v[i][1]);
      tile[(nn + 2) * 72 + kk] = f2bf(v[i][2]); tile[(nn + 3) * 72 + kk] = f2bf(v[i][3]);
    }
    __syncthreads();
#pragma unroll
    for (int j = 0; j < 2; ++j) {
      const int c = tid + NTHR * j, nn = c >> 3, k8 = (c & 7) * 8;
      const uint4 o = *reinterpret_cast<const uint4*>(tile + nn * 72 + k8);
      *reinterpret_cast<uint4*>(dst + (size_t)rowmap(n0 + nn) * K + k0 + k8) = o;
    }
    __syncthreads();
  }
}

template <class F>
DI void transpose_convert_f8(const float* __restrict__ src, int K, int N, unsigned char* __restrict__ dst, F rowmap,
                             int bid, int nb, char* smem) {
  unsigned char* tile = reinterpret_cast<unsigned char*>(smem);
  const int tid = otid();
  const int ntn = N / 128, ntk = K / 64;
  for (int t = bid; t < ntn * ntk; t += nb) {
    const int n0 = (t % ntn) * 128, k0 = (t / ntn) * 64;
    const int kq = (tid >> 5) * 4, nn = (tid & 31) * 4;
    f32x4 v[4];
#pragma unroll
    for (int r = 0; r < 4; ++r) v[r] = __builtin_nontemporal_load(reinterpret_cast<const f32x4*>(src + (size_t)(k0 + kq + r) * N + n0 + nn));
#pragma unroll
    for (int e = 0; e < 4; ++e)
      *reinterpret_cast<unsigned*>(tile + (nn + e) * 80 + kq) =
          pk4_f8(v[0][e] * F8_W_SCALE, v[1][e] * F8_W_SCALE, v[2][e] * F8_W_SCALE, v[3][e] * F8_W_SCALE);
    __syncthreads();
    {
      const int rn = tid >> 2, kc = (tid & 3) * 16;
      const uint4 o = *reinterpret_cast<const uint4*>(tile + rn * 80 + kc);
      *reinterpret_cast<uint4*>(dst + (size_t)rowmap(n0 + rn) * K + k0 + kc) = o;
    }
    __syncthreads();
  }
}

constexpr int CVT_IN_MLA_E = 16;
struct CvtTile { const float* src; unsigned char* dst; int N, K, n0, k0, mat; };
DI CvtTile cvt_tile(const Params& p, int L, int g) {
  const int e = g / 768, r = g - e * 768, mat = r >> 8, tt = r & 255;
  const size_t le = (size_t)(L * 16 + e);
  CvtTile c;
  c.mat = mat;
  if (mat < 2) { c.src = ((mat == 0) ? p.w_gate : p.w_up) + le * DM * 2048; c.N = 2048; c.dst = p.Wgu8() + le * 4096 * DM; c.K = 1024; c.n0 = (tt & 15) * 128; c.k0 = (tt >> 4) * 64; }
  else { c.src = p.w_down + le * 2048 * DM; c.N = 1024; c.dst = p.Wd8() + le * DM * 2048; c.K = 2048; c.n0 = (tt & 7) * 128; c.k0 = (tt >> 3) * 64; }
  return c;
}
DI int cvt_rowmap(int mat, int n) { return (mat == 2) ? n : ((n >> 7) * 256 + (mat == 1 ? 128 : 0) + (n & 127)); }

constexpr int CVT_IDLE_FIRST_BLK = 64, CVT_IDLE_BLKS = 192;
constexpr int CVT_NA = 16, CVT_NB = 12;
constexpr int CVT_A = CVT_IDLE_BLKS * CVT_NA, CVT_B = CVT_A + CVT_IDLE_BLKS * CVT_NB;
static_assert(CVT_B + 64 * 256 >= 12288 && CVT_B <= 12288, "MLA loop must cover the rest");
DI void cvt_tiles_idle(const Params& p, int L, char* smem, int first, int per_blk) {
  const int tid = otid(), ib = obid() - CVT_IDLE_FIRST_BLK;
  unsigned char* tile = reinterpret_cast<unsigned char*>(smem);
  __syncthreads();
#pragma unroll 1
  for (int i = 0; i < per_blk; i += 2) {
    f32x4 v[2][4];
#pragma unroll
    for (int u = 0; u < 2; ++u) {
      const CvtTile ct = cvt_tile(p, L, first + ib + CVT_IDLE_BLKS * (i + u));
      const float* sp = ct.src + (size_t)(ct.k0 + (tid >> 5) * 4) * ct.N + ct.n0 + (tid & 31) * 4;
#pragma unroll
      for (int r = 0; r < 4; ++r) v[u][r] = __builtin_nontemporal_load(reinterpret_cast<const f32x4*>(sp + (size_t)r * ct.N));
    }
#pragma unroll
    for (int u = 0; u < 2; ++u) {
      unsigned char* cb = tile + u * 10240 + (tid & 31) * 4 * 80 + (tid >> 5) * 4;
#pragma unroll
      for (int c = 0; c < 4; ++c) *reinterpret_cast<unsigned*>(cb + c * 80) = pk4_f8_scaled<256>(v[u][0][c], v[u][1][c], v[u][2][c], v[u][3][c]);
    }
    __syncthreads();
#pragma unroll
    for (int u = 0; u < 2; ++u) {
      const CvtTile ct = cvt_tile(p, L, first + ib + CVT_IDLE_BLKS * (i + u));
      unsigned char* cd = ct.dst + (size_t)cvt_rowmap(ct.mat, ct.n0 + (tid >> 2)) * ct.K + ct.k0 + (tid & 3) * 16;
      *reinterpret_cast<uint4*>(cd) = *reinterpret_cast<const uint4*>(tile + u * 10240 + (tid >> 2) * 80 + (tid & 3) * 16);
    }
    __syncthreads();
  }
}

DI void ph_convert(const Params& p, char* smem) {
  const int nb = gridDim.x;
  int bid = obid();
  for (int idx = bid * NTHR + otid(); idx < SEQ * 56; idx += nb * NTHR) {
    const int pos = idx / 56, f = idx - pos * 56;
    float inv;
    if (f < 32) inv = exp2f(-(float)f * (13.287712379549449f / 32.f));
    else if (f < 40) inv = exp2f(-(float)(f - 32) * (18.931568569324174f / 8.f));
    else inv = exp2f(-(float)(f - 40) * (18.931568569324174f / 16.f));
    float sn, cs;
    sincosf((float)pos * inv, &sn, &cs);
    p.rtab()[(size_t)idx * 2] = cs;
    p.rtab()[(size_t)idx * 2 + 1] = sn;
  }
  auto ident = [](int n) { return n; };
  for (int L = 0; L < 2; ++L) {
    transpose_convert(p.w_in + (size_t)L * DM * PW, DM, PW, PWP, p.WinT() + (size_t)L * PWP * DM, ident, bid, nb, smem);
    transpose_convert(p.w_uq + (size_t)L * 256 * 384, 256, 384, 384, p.WuqT() + (size_t)L * 384 * 256, ident, bid, nb, smem);
    transpose_convert(p.w_ukv + (size_t)L * 128 * 512, 128, 512, 512, p.WukvT() + (size_t)L * 512 * 128, ident, bid, nb, smem);
    transpose_convert(p.w_out + (size_t)L * DM * DM, DM, DM, DM, p.WoutT() + (size_t)L * DM * DM, ident, bid, nb, smem);
    for (int e = ((nb == 256) ? CVT_IN_MLA_E : 0); e < 16; ++e) {
      const size_t le = (size_t)(L * 16 + e);
      auto gmap = [](int n) { return (n >> 7) * 256 + (n & 127); };
      auto umap = [](int n) { return (n >> 7) * 256 + 128 + (n & 127); };
      transpose_convert_f8(p.w_gate + le * DM * 2048, DM, 2048, p.Wgu8() + le * 4096 * DM, gmap, bid, nb, smem);
      transpose_convert_f8(p.w_up + le * DM * 2048, DM, 2048, p.Wgu8() + le * 4096 * DM, umap, bid, nb, smem);
      transpose_convert_f8(p.w_down + le * 2048 * DM, 2048, DM, p.Wd8() + le * DM * 2048, ident, bid, nb, smem);
    }
  }
}

template <class RowPtr, class Epi>
DI void gemm_tile(RowPtr arow, const u16* __restrict__ bt, int ldb, int K, char* smem, Epi epi) {
  u16* sa = reinterpret_cast<u16*>(smem);
  u16* sb = sa + 2 * 256 * 72;
  const int tid = otid(), wid = tid >> 6, lane = tid & 63, wr = wid >> 1, wc = wid & 1, fr = lane & 15, fq = lane >> 4;
  f32x4 acc[4][4];
#pragma unroll
  for (int m = 0; m < 4; ++m)
#pragma unroll
    for (int n = 0; n < 4; ++n) acc[m][n] = f32x4{0.f, 0.f, 0.f, 0.f};
  const int lr = tid >> 3, lc = (tid & 7) * 8;
  const u16* ap[4];
#pragma unroll
  for (int i = 0; i < 4; ++i) ap[i] = arow(lr + 64 * i) + lc;
  const u16* bp[2];
#pragma unroll
  for (int i = 0; i < 2; ++i) bp[i] = bt + (size_t)(lr + 64 * i) * ldb + lc;
  uint4 ra[4], rb[2];
  const int nk = K / 64;
#pragma unroll
  for (int i = 0; i < 4; ++i) ra[i] = *reinterpret_cast<const uint4*>(ap[i]);
#pragma unroll
  for (int i = 0; i < 2; ++i) rb[i] = *reinterpret_cast<const uint4*>(bp[i]);
#pragma unroll
  for (int i = 0; i < 4; ++i) *reinterpret_cast<uint4*>(sa + (lr + 64 * i) * 72 + lc) = ra[i];
#pragma unroll
  for (int i = 0; i < 2; ++i) *reinterpret_cast<uint4*>(sb + (lr + 64 * i) * 72 + lc) = rb[i];
  __syncthreads();
  for (int kt = 0; kt < nk; ++kt) {
    const int cur = kt & 1;
    if (kt + 1 < nk) {
#pragma unroll
      for (int i = 0; i < 4; ++i) ra[i] = *reinterpret_cast<const uint4*>(ap[i] + (kt + 1) * 64);
#pragma unroll
      for (int i = 0; i < 2; ++i) rb[i] = *reinterpret_cast<const uint4*>(bp[i] + (kt + 1) * 64);
    }
    const u16* ca = sa + cur * 256 * 72;
    const u16* cb = sb + cur * 128 * 72;
#pragma unroll
    for (int kk = 0; kk < 2; ++kk) {
      bf16x8 af[4], bfr[4];
#pragma unroll
      for (int m = 0; m < 4; ++m) af[m] = *reinterpret_cast<const bf16x8*>(ca + (wr * 64 + m * 16 + fr) * 72 + kk * 32 + fq * 8);
#pragma unroll
      for (int n = 0; n < 4; ++n) bfr[n] = *reinterpret_cast<const bf16x8*>(cb + (wc * 64 + n * 16 + fr) * 72 + kk * 32 + fq * 8);
#pragma unroll
      for (int m = 0; m < 4; ++m)
#pragma unroll
        for (int n = 0; n < 4; ++n) acc[m][n] = __builtin_amdgcn_mfma_f32_16x16x32_bf16(af[m], bfr[n], acc[m][n], 0, 0, 0);
    }
    if (kt + 1 < nk) {
      u16* na = sa + (cur ^ 1) * 256 * 72;
      u16* nbp = sb + (cur ^ 1) * 128 * 72;
#pragma unroll
      for (int i = 0; i < 4; ++i) *reinterpret_cast<uint4*>(na + (lr + 64 * i) * 72 + lc) = ra[i];
#pragma unroll
      for (int i = 0; i < 2; ++i) *reinterpret_cast<uint4*>(nbp + (lr + 64 * i) * 72 + lc) = rb[i];
    }
    __syncthreads();
  }
  epi(acc, wr, wc, fr, fq);
}

#define WAIT_V(n) asm volatile("s_waitcnt vmcnt(%0)" ::"n"(n) : "memory")
DI int lds_byte2(int r, int c) {
  const int st = (r >> 4) * 2 + (c >> 5), ob = (r & 15) * 64 + (c & 31) * 2;
  return st * 1024 + (ob ^ (((ob >> 9) & 1) << 5));
}
DI void stage_rc2(int b, int& R, int& C) {
  const int st = b >> 10, sb = b & 1023, swz = sb ^ (((sb >> 9) & 1) << 5);
  R = (st >> 1) * 16 + swz / 64;
  C = (st & 1) * 32 + (swz % 64) / 2;
}
typedef __attribute__((address_space(3))) unsigned lds_u32;
template <class RowPtr, class Epi>
DI void gemm256(RowPtr arow, const u16* __restrict__ bt, int ldb, int K, char* smem, Epi epi) {
  constexpr int TILE_B = 256 * 64 * 2, STAGE_B = 2 * TILE_B;
  const int tid = otid(), wid = tid >> 6, lane = tid & 63, wr = wid >> 2, wc = wid & 3, fr = lane & 15, fq = lane >> 4;
  const u16* ap[4];
  const u16* bp[4];
#pragma unroll
  for (int i = 0; i < 4; ++i) {
    int R, C;
    stage_rc2(wid * 1024 + i * 8192 + lane * 16, R, C);
    ap[i] = arow(R) + C;
    bp[i] = bt + (size_t)R * ldb + C;
  }
  f32x4 acc[8][4];
#pragma unroll
  for (int m = 0; m < 8; ++m)
#pragma unroll
    for (int n = 0; n < 4; ++n) acc[m][n] = f32x4{0.f, 0.f, 0.f, 0.f};
#define G2_STAGE(buf, kt)                                                                                              \
  do {                                                                                                                 \
    _Pragma("unroll") for (int i = 0; i < 4; ++i) {                                                                    \
      __builtin_amdgcn_global_load_lds((const unsigned*)(ap[i] + (kt) * 64),                                           \
                                       (lds_u32*)(smem + (buf) * STAGE_B + wid * 1024 + i * 8192), 16, 0, 0);          \
      __builtin_amdgcn_global_load_lds((const unsigned*)(bp[i] + (kt) * 64),                                           \
                                       (lds_u32*)(smem + (buf) * STAGE_B + TILE_B + wid * 1024 + i * 8192), 16, 0, 0); \
    }                                                                                                                  \
  } while (0)
  const int nt = K / 64;
  G2_STAGE(0, 0);
  WAIT_V(0);
  __syncthreads();
  for (int t = 0; t < nt; ++t) {
    const int cur = t & 1;
    if (t + 1 < nt) G2_STAGE(cur ^ 1, t + 1);
    const char* sA = smem + cur * STAGE_B;
    const char* sB = sA + TILE_B;
#pragma unroll
    for (int ks = 0; ks < 2; ++ks) {
      bf16x8 At[8], Bf[4];
#pragma unroll
      for (int m = 0; m < 8; ++m) At[m] = *reinterpret_cast<const bf16x8*>(sA + lds_byte2(wr * 128 + m * 16 + fr, ks * 32 + fq * 8));
#pragma unroll
      for (int n = 0; n < 4; ++n) Bf[n] = *reinterpret_cast<const bf16x8*>(sB + lds_byte2(wc * 64 + n * 16 + fr, ks * 32 + fq * 8));
#pragma unroll
      for (int m = 0; m < 8; ++m)
#pragma unroll
        for (int n = 0; n < 4; ++n) acc[m][n] = __builtin_amdgcn_mfma_f32_16x16x32_bf16(Bf[n], At[m], acc[m][n], 0, 0, 0);
      __builtin_amdgcn_sched_barrier(0);
    }
    WAIT_V(0);
    __syncthreads();
  }
  epi(acc, wr, wc, fr, fq);
}

namespace pg8 {
constexpr int BM = 256, BK = 64, HALF = 128, HTB = HALF * BK * 2;
DI int lds_byte(int r, int c) { const int st = (r >> 4) * 2 + (c >> 5), rr = r & 15, cc = c & 31, ob = rr * 64 + cc * 2; return st * 1024 + (ob ^ (((ob >> 9) & 1) << 5)); }
DI void stage_rc(int b, int& R, int& C) { const int st = b / 1024, sb = b % 1024, swz = sb ^ (((sb >> 9) & 1) << 5); R = (st >> 1) * 16 + swz / 64; C = (st & 1) * 32 + (swz % 64) / 2; }
DI int perm32(int rho) { const int n = rho >> 4, i = rho & 15; return 8 * (i >> 2) + 4 * n + (i & 3); }
struct Unit { int pm, pn; };
typedef __attribute__((address_space(3))) unsigned char lds_u8;
typedef __attribute__((address_space(3))) unsigned lds_u32;
typedef __attribute__((address_space(3))) bf16x8 lds_bf16x8;
typedef __attribute__((address_space(3))) i32x4 lds_i32x4;

template <class Cfg>
DI void gemm_phase(lds_u8* lds, const Cfg& S) {
  const int tid = otid(), wid = __builtin_amdgcn_readfirstlane(tid >> 6), lane = tid & 63, wr = wid >> 2, wc = wid & 3, fr = lane & 15, fq = lane >> 4;
  const int K = S.K, nt = K / BK;
  int R0, C0, R1, C1;
  stage_rc(tid * 16, R0, C0);
  stage_rc(tid * 16 + 8192, R1, C1);
  unsigned voffB[2];
  {
    const int Rb0 = Cfg::PERM ? ((R0 & ~31) + perm32(R0 & 31)) : R0, Rb1 = Cfg::PERM ? ((R1 & ~31) + perm32(R1 & 31)) : R1;
    voffB[0] = (unsigned)(Rb0 * K + C0) * 2u; voffB[1] = (unsigned)(Rb1 * K + C1) * 2u;
  }
  const size_t kstep = (size_t)(BK * 2);
  const size_t hstep = (size_t)HALF * K * 2;
  const unsigned ldsw = (unsigned)wid * 1024u;
  const int aoff = lds_byte(wr * 64 + fr, fq * 8), boff = lds_byte(wc * 32 + fr, fq * 8);
#define PG8_SA(b, h) (((b) * 2 + (h)) * HTB)
#define PG8_SB(b, h) ((4 + (b) * 2 + (h)) * HTB)
#define PG8_STAGE2(bufoff, gbase, o0, o1) do { \
    __builtin_amdgcn_global_load_lds((const unsigned*)((const char*)(gbase) + (o0)), (lds_u32*)(lds + (bufoff) + ldsw), 16, 0, 0); \
    __builtin_amdgcn_global_load_lds((const unsigned*)((const char*)(gbase) + (o1)), (lds_u32*)(lds + (bufoff) + ldsw + 8192), 16, 0, 0); } while (0)
#define PG8_STAGEB(bufoff, gbase) PG8_STAGE2(bufoff, gbase, voffB[0], voffB[1])
#define PG8_LDA(dst, b, h) do { _Pragma("unroll") for (int m = 0; m < 4; ++m) _Pragma("unroll") for (int k = 0; k < 2; ++k) dst[m][k] = *(const lds_bf16x8*)(lds + PG8_SA(b, h) + aoff + m * 2048 + k * 1024); } while (0)
#define PG8_LDB(dst, b, h) do { _Pragma("unroll") for (int n = 0; n < 2; ++n) _Pragma("unroll") for (int k = 0; k < 2; ++k) dst[n][k] = *(const lds_bf16x8*)(lds + PG8_SB(b, h) + boff + n * 2048 + k * 1024); } while (0)
#define PG8_MMA(ai, bj, At, Bt) do { __builtin_amdgcn_s_setprio(1); _Pragma("unroll") for (int m = 0; m < 4; ++m) _Pragma("unroll") for (int n = 0; n < 2; ++n) _Pragma("unroll") for (int k = 0; k < 2; ++k) \
    acc[ai][bj][m][n] = __builtin_amdgcn_mfma_f32_16x16x32_bf16(Bt[n][k], At[m][k], acc[ai][bj][m][n], 0, 0, 0); __builtin_amdgcn_s_setprio(0); } while (0)
#define PG8_WAIT_V(n) asm volatile("s_waitcnt vmcnt(" #n ")" ::: "memory")
#define PG8_WAIT_L(n) asm volatile("s_waitcnt lgkmcnt(" #n ")" ::: "memory")
#define PG8_BAR __builtin_amdgcn_s_barrier()
#define PG8_SCHED __builtin_amdgcn_sched_barrier(0)
  Unit cur, nxt; int ui = 0;
  if (!S.next(0, cur)) return;
  f32x4 acc[2][2][4][2];
#pragma unroll
  for (int a = 0; a < 2; ++a)
#pragma unroll
    for (int b = 0; b < 2; ++b)
#pragma unroll
      for (int m = 0; m < 4; ++m)
#pragma unroll
        for (int n = 0; n < 2; ++n) acc[a][b][m][n] = f32x4{0.f, 0.f, 0.f, 0.f};
  bf16x8 At[4][2], B0[2][2], B1[2][2];
  const char* cA = S.a_base(cur);
  const char* cB = S.b_base(cur);
  unsigned vc[4], vn[4];
  S.a_off(cur, R0, C0, R1, C1, vc);
  PG8_STAGEB(PG8_SB(0, 0), cB); PG8_STAGE2(PG8_SA(0, 0), cA, vc[0], vc[1]); PG8_STAGEB(PG8_SB(0, 1), cB + hstep); PG8_STAGE2(PG8_SA(0, 1), cA, vc[2], vc[3]);
  if (wr == 1) PG8_BAR;
  PG8_WAIT_V(4); PG8_BAR;
  PG8_STAGEB(PG8_SB(1, 0), cB + kstep); PG8_STAGE2(PG8_SA(1, 0), cA + kstep, vc[0], vc[1]); PG8_STAGEB(PG8_SB(1, 1), cB + hstep + kstep);
  PG8_WAIT_V(6); PG8_BAR;
  for (;;) {
    const bool has_next = S.next(ui + 1, nxt);
    const char* nA = has_next ? S.a_base(nxt) : cA;
    const char* nB = has_next ? S.b_base(nxt) : cB;
    if (has_next) S.a_off(nxt, R0, C0, R1, C1, vn);
    else { vn[0] = vc[0]; vn[1] = vc[1]; vn[2] = vc[2]; vn[3] = vc[3]; }
    for (int t = 0; t < nt; t += 2) {
      const bool last = (t == nt - 2);
      const char* a1 = cA + (size_t)(t + 1) * kstep;
      const char* a2 = last ? nA : cA + (size_t)(t + 2) * kstep;
      const char* b2 = last ? nB : cB + (size_t)(t + 2) * kstep;
      const char* a3 = a2 + kstep;
      const char* b3 = b2 + kstep;
      const unsigned w0 = last ? vn[0] : vc[0], w1 = last ? vn[1] : vc[1], w2 = last ? vn[2] : vc[2], w3 = last ? vn[3] : vc[3];
      PG8_LDB(B0, 0, 0); PG8_SCHED; PG8_LDA(At, 0, 0); PG8_STAGE2(PG8_SA(1, 1), a1, vc[2], vc[3]);
      PG8_WAIT_L(8); PG8_BAR; PG8_WAIT_L(0); PG8_MMA(0, 0, At, B0); PG8_BAR; PG8_SCHED;
      PG8_LDB(B1, 0, 1); PG8_STAGEB(PG8_SB(0, 0), b2);
      PG8_BAR; PG8_WAIT_L(0); PG8_MMA(0, 1, At, B1); PG8_BAR;
      PG8_LDA(At, 0, 1); PG8_STAGE2(PG8_SA(0, 0), a2, w0, w1);
      PG8_BAR; PG8_WAIT_L(0); PG8_MMA(1, 0, At, B0); PG8_BAR; PG8_SCHED;
      PG8_STAGEB(PG8_SB(0, 1), b2 + hstep);
      PG8_WAIT_V(6); PG8_BAR; PG8_MMA(1, 1, At, B1); PG8_BAR;
      PG8_LDB(B0, 1, 0); PG8_SCHED; PG8_LDA(At, 1, 0); PG8_STAGE2(PG8_SA(0, 1), a2, w2, w3);
      PG8_WAIT_L(8); PG8_BAR; PG8_WAIT_L(0); PG8_MMA(0, 0, At, B0); PG8_BAR; PG8_SCHED;
      PG8_LDB(B1, 1, 1); PG8_STAGEB(PG8_SB(1, 0), b3);
      PG8_BAR; PG8_WAIT_L(0); PG8_MMA(0, 1, At, B1); PG8_BAR;
      PG8_LDA(At, 1, 1); PG8_STAGE2(PG8_SA(1, 0), a3, w0, w1);
      PG8_BAR; PG8_WAIT_L(0); PG8_MMA(1, 0, At, B0); PG8_BAR; PG8_SCHED;
      PG8_STAGEB(PG8_SB(1, 1), b3 + hstep);
      PG8_WAIT_V(6); PG8_BAR; PG8_MMA(1, 1, At, B1); PG8_BAR;
    }
    S.epi(acc, cur, wr, wc, fr, fq);
    if (!has_next) break;
#pragma unroll
    for (int a = 0; a < 2; ++a)
#pragma unroll
      for (int b = 0; b < 2; ++b)
#pragma unroll
        for (int m = 0; m < 4; ++m)
#pragma unroll
          for (int n = 0; n < 2; ++n) acc[a][b][m][n] = f32x4{0.f, 0.f, 0.f, 0.f};
    cur = nxt; cA = nA; cB = nB; ++ui;
    vc[0] = vn[0]; vc[1] = vn[1]; vc[2] = vn[2]; vc[3] = vn[3];
  }
  PG8_WAIT_V(0);
  if (wr == 0) PG8_BAR;
  PG8_BAR;
#undef PG8_SA
#undef PG8_SB
#undef PG8_STAGE2
#undef PG8_STAGEB
#undef PG8_LDA
#undef PG8_LDB
#undef PG8_MMA
#undef PG8_WAIT_V
#undef PG8_WAIT_L
#undef PG8_BAR
#undef PG8_SCHED
}
template <class Cfg>
DI void gemm_phase_f8(lds_u8* lds, const Cfg& S) {
  const int tid = otid(), wid = __builtin_amdgcn_readfirstlane(tid >> 6), lane = tid & 63, wr = wid >> 2, wc = wid & 3, fr = lane & 15, fq = lane >> 4;
  const int K = S.K, nt = K / BK;
  int R0, C0, R1, C1;
  stage_rc(tid * 16, R0, C0);
  stage_rc(tid * 16 + 8192, R1, C1);
  unsigned voffB[2];
  {
    const int Rb0 = Cfg::PERM ? ((R0 & ~31) + perm32(R0 & 31)) : R0, Rb1 = Cfg::PERM ? ((R1 & ~31) + perm32(R1 & 31)) : R1;
    voffB[0] = (unsigned)(Rb0 * K + C0) * 2u; voffB[1] = (unsigned)(Rb1 * K + C1) * 2u;
  }
  const size_t kstep = (size_t)(BK * 2);
  const size_t hstep = (size_t)HALF * K * 2;
  const unsigned ldsw = (unsigned)wid * 1024u;
  const int cl = 2 * fq + (fq & 1), ch = 2 * fq + 1 - (fq & 1);
  const int aoffL = lds_byte(wr * 64 + fr, cl * 8), aoffH = lds_byte(wr * 64 + fr, ch * 8);
  const int boffL = lds_byte(wc * 32 + fr, cl * 8), boffH = lds_byte(wc * 32 + fr, ch * 8);
#define PG8_SA(b, h) (((b) * 2 + (h)) * HTB)
#define PG8_SB(b, h) ((4 + (b) * 2 + (h)) * HTB)
#define PG8_STAGE2(bufoff, gbase, o0, o1) do { \
    __builtin_amdgcn_global_load_lds((const unsigned*)((const char*)(gbase) + (o0)), (lds_u32*)(lds + (bufoff) + ldsw), 16, 0, 0); \
    __builtin_amdgcn_global_load_lds((const unsigned*)((const char*)(gbase) + (o1)), (lds_u32*)(lds + (bufoff) + ldsw + 8192), 16, 0, 0); } while (0)
#define PG8_STAGEB(bufoff, gbase) PG8_STAGE2(bufoff, gbase, voffB[0], voffB[1])
#define PG8_LDA(dst, b, h) do { _Pragma("unroll") for (int m = 0; m < 4; ++m) { const i32x4 lo_ = *(const lds_i32x4*)(lds + PG8_SA(b, h) + aoffL + m * 2048), hi_ = *(const lds_i32x4*)(lds + PG8_SA(b, h) + aoffH + m * 2048); dst[m] = __builtin_shufflevector(lo_, hi_, 0, 1, 2, 3, 4, 5, 6, 7); } } while (0)
#define PG8_LDB(dst, b, h) do { _Pragma("unroll") for (int n = 0; n < 2; ++n) { const i32x4 lo_ = *(const lds_i32x4*)(lds + PG8_SB(b, h) + boffL + n * 2048), hi_ = *(const lds_i32x4*)(lds + PG8_SB(b, h) + boffH + n * 2048); dst[n] = __builtin_shufflevector(lo_, hi_, 0, 1, 2, 3, 4, 5, 6, 7); } } while (0)
#define PG8_MMA(ai, bj, At, Bt) do { __builtin_amdgcn_s_setprio(1); _Pragma("unroll") for (int m = 0; m < 4; ++m) _Pragma("unroll") for (int n = 0; n < 2; ++n) \
    asm volatile("v_mfma_f32_16x16x128_f8f6f4 %0, %1, %2, %0" : "+v"(acc[ai][bj][m][n]) : "v"(Bt[n]), "v"(At[m])); __builtin_amdgcn_s_setprio(0); } while (0)
#define PG8_WAIT_V(n) asm volatile("s_waitcnt vmcnt(" #n ")" ::: "memory")
#define PG8_WAIT_L(n) asm volatile("s_waitcnt lgkmcnt(" #n ")" ::: "memory")
#define PG8_BAR __builtin_amdgcn_s_barrier()
#define PG8_SCHED __builtin_amdgcn_sched_barrier(0)
  Unit cur, nxt; int ui = 0;
  if (!S.next(0, cur)) return;
  f32x4 acc[2][2][4][2];
#pragma unroll
  for (int a = 0; a < 2; ++a)
#pragma unroll
    for (int b = 0; b < 2; ++b)
#pragma unroll
      for (int m = 0; m < 4; ++m)
#pragma unroll
        for (int n = 0; n < 2; ++n) acc[a][b][m][n] = f32x4{0.f, 0.f, 0.f, 0.f};
  i32x8 At[4], B0[2], B1[2];
  const char* cA = S.a_base(cur);
  const char* cB = S.b_base(cur);
  unsigned vc[4], vn[4];
  S.a_off(cur, R0, C0, R1, C1, vc, 0);
  PG8_STAGEB(PG8_SB(0, 0), cB); PG8_STAGE2(PG8_SA(0, 0), cA, vc[0], vc[1]); PG8_STAGEB(PG8_SB(0, 1), cB + hstep); PG8_STAGE2(PG8_SA(0, 1), cA, vc[2], vc[3]);
  if (wr == 1) PG8_BAR;
  PG8_WAIT_V(4); PG8_BAR;
  PG8_STAGEB(PG8_SB(1, 0), cB + kstep); PG8_STAGE2(PG8_SA(1, 0), cA + kstep, vc[0], vc[1]); PG8_STAGEB(PG8_SB(1, 1), cB + hstep + kstep);
  PG8_WAIT_V(6); PG8_BAR;
  for (;;) {
    const bool has_next = S.next(ui + 1, nxt);
    const char* nA = has_next ? S.a_base(nxt) : cA;
    const char* nB = has_next ? S.b_base(nxt) : cB;
    if (has_next) S.a_off(nxt, R0, C0, R1, C1, vn, ui + 1);
    else { vn[0] = vc[0]; vn[1] = vc[1]; vn[2] = vc[2]; vn[3] = vc[3]; }
    for (int t = 0; t < nt; t += 2) {
      const bool last = (t == nt - 2);
      const char* a1 = cA + (size_t)(t + 1) * kstep;
      const char* a2 = last ? nA : cA + (size_t)(t + 2) * kstep;
      const char* b2 = last ? nB : cB + (size_t)(t + 2) * kstep;
      const char* a3 = a2 + kstep;
      const char* b3 = b2 + kstep;
      const unsigned w0 = last ? vn[0] : vc[0], w1 = last ? vn[1] : vc[1], w2 = last ? vn[2] : vc[2], w3 = last ? vn[3] : vc[3];
      PG8_LDB(B0, 0, 0); PG8_SCHED; PG8_LDA(At, 0, 0); PG8_STAGE2(PG8_SA(1, 1), a1, vc[2], vc[3]);
      PG8_WAIT_L(8); PG8_BAR; PG8_WAIT_L(0); PG8_MMA(0, 0, At, B0); PG8_BAR; PG8_SCHED;
      PG8_LDB(B1, 0, 1); PG8_STAGEB(PG8_SB(0, 0), b2);
      PG8_BAR; PG8_WAIT_L(0); PG8_MMA(0, 1, At, B1); PG8_BAR;
      PG8_LDA(At, 0, 1); PG8_STAGE2(PG8_SA(0, 0), a2, w0, w1);
      PG8_BAR; PG8_WAIT_L(0); PG8_MMA(1, 0, At, B0); PG8_BAR; PG8_SCHED;
      PG8_STAGEB(PG8_SB(0, 1), b2 + hstep);
      PG8_WAIT_V(6); PG8_BAR; PG8_MMA(1, 1, At, B1); PG8_BAR;
      PG8_LDB(B0, 1, 0); PG8_SCHED; PG8_LDA(At, 1, 0); PG8_STAGE2(PG8_SA(0, 1), a2, w2, w3);
      PG8_WAIT_L(8); PG8_BAR; PG8_WAIT_L(0); PG8_MMA(0, 0, At, B0); PG8_BAR; PG8_SCHED;
      PG8_LDB(B1, 1, 1); PG8_STAGEB(PG8_SB(1, 0), b3);
      PG8_BAR; PG8_WAIT_L(0); PG8_MMA(0, 1, At, B1); PG8_BAR;
      PG8_LDA(At, 1, 1); PG8_STAGE2(PG8_SA(1, 0), a3, w0, w1);
      PG8_BAR; PG8_WAIT_L(0); PG8_MMA(1, 0, At, B0); PG8_BAR; PG8_SCHED;
      PG8_STAGEB(PG8_SB(1, 1), b3 + hstep);
      PG8_WAIT_V(6); PG8_BAR; PG8_MMA(1, 1, At, B1); PG8_BAR;
    }
    asm volatile("s_nop 15\n\ts_nop 15" ::: "memory");
    S.epi(acc, cur, wr, wc, fr, fq);
    if (!has_next) break;
#pragma unroll
    for (int a = 0; a < 2; ++a)
#pragma unroll
      for (int b = 0; b < 2; ++b)
#pragma unroll
        for (int m = 0; m < 4; ++m)
#pragma unroll
          for (int n = 0; n < 2; ++n) acc[a][b][m][n] = f32x4{0.f, 0.f, 0.f, 0.f};
    cur = nxt; cA = nA; cB = nB; ++ui;
    vc[0] = vn[0]; vc[1] = vn[1]; vc[2] = vn[2]; vc[3] = vn[3];
  }
  PG8_WAIT_V(0);
  if (wr == 0) PG8_BAR;
  PG8_BAR;
#undef PG8_SA
#undef PG8_SB
#undef PG8_STAGE2
#undef PG8_STAGEB
#undef PG8_LDA
#undef PG8_LDB
#undef PG8_MMA
#undef PG8_WAIT_V
#undef PG8_WAIT_L
#undef PG8_BAR
#undef PG8_SCHED
}
}

struct CfgInproj {
  static constexpr bool PERM = true;
  int K; const Params* p; int L; int bid, nb;
  DI bool next(int i, pg8::Unit& u) const { const int t = i * nb + bid; if (t >= 64 * 13) return false; u.pm = t & 63; u.pn = t >> 6; return true; }
  DI const char* a_base(const pg8::Unit& u) const { return (const char*)(p->hn() + (size_t)u.pm * 256 * DM); }
  DI const char* b_base(const pg8::Unit& u) const { return (const char*)(p->WinT() + ((size_t)L * PWP + (size_t)u.pn * 256) * DM); }
  DI void a_off(const pg8::Unit&, int R0, int C0, int R1, int C1, unsigned (&vo)[4]) const {
    vo[0] = (unsigned)(R0 * DM + C0) * 2u; vo[1] = (unsigned)(R1 * DM + C1) * 2u;
    vo[2] = vo[0] + 128u * DM * 2u; vo[3] = vo[1] + 128u * DM * 2u;
  }
  DI void epi(const f32x4 (&acc)[2][2][4][2], const pg8::Unit& u, int wr, int wc, int fr, int fq) const {
    const int row0 = u.pm * 256 + wr * 64 + fr, col0 = u.pn * 256 + wc * 32 + 8 * fq;
#pragma unroll
    for (int ai = 0; ai < 2; ++ai)
#pragma unroll
      for (int m = 0; m < 4; ++m) {
        u16* rowp = p->proj() + (size_t)(row0 + ai * 128 + m * 16) * PWP + col0;
#pragma unroll
        for (int bj = 0; bj < 2; ++bj) {
          uint4 w;
          w.x = pack2(acc[ai][bj][m][0][0], acc[ai][bj][m][0][1]); w.y = pack2(acc[ai][bj][m][0][2], acc[ai][bj][m][0][3]);
          w.z = pack2(acc[ai][bj][m][1][0], acc[ai][bj][m][1][1]); w.w = pack2(acc[ai][bj][m][1][2], acc[ai][bj][m][1][3]);
          *reinterpret_cast<uint4*>(rowp + bj * 128) = w;
        }
      }
  }
};
DI void ph_inproj_tail(const Params& p, int L, char* smem, int t) {
  const int m0 = (t & 63) * 256, n0 = 3072 + (t >> 6) * 128;
  const u16* Bt = p.WinT() + ((size_t)L * PWP + n0) * DM;
  gemm_tile([&](int r) { return p.hn() + (size_t)(m0 + r) * DM; }, Bt, DM, DM, smem,
            [&](f32x4 (&acc)[4][4], int wr, int wc, int fr, int fq) {
#pragma unroll
              for (int m = 0; m < 4; ++m)
#pragma unroll
                for (int n = 0; n < 4; ++n)
#pragma unroll
                  for (int j = 0; j < 4; ++j)
                    p.proj()[(size_t)(m0 + wr * 64 + m * 16 + fq * 4 + j) * PWP + n0 + wc * 64 + n * 16 + fr] = f2bf(acc[m][n][j]);
            });
}
DI void ph_inproj(const Params& p, int L, char* smem) {
  CfgInproj c; c.K = DM; c.p = &p; c.L = L; c.bid = obid(); c.nb = gridDim.x;
  pg8::gemm_phase((pg8::lds_u8*)smem, c);
  if (gridDim.x == 256 && obid() >= CVT_IDLE_FIRST_BLK) cvt_tiles_idle(p, L, smem, 0, CVT_NA);
}

DI void ph_gemm_store_bf16(const u16* A, int lda, const u16* Bt, int K, int M, int N, u16* C, int ldc, char* smem, int rot) {
  const int mt = M / 256, nt = N / 128;
  const int nb = gridDim.x;
  for (int t = (obid() + rot) % nb; t < mt * nt; t += nb) {
    const int m0 = (t % mt) * 256, n0 = (t / mt) * 128;
    gemm_tile([&](int r) { return A + (size_t)(m0 + r) * lda; }, Bt + (size_t)n0 * K, K, K, smem,
              [&](f32x4 (&acc)[4][4], int wr, int wc, int fr, int fq) {
#pragma unroll
                for (int m = 0; m < 4; ++m)
#pragma unroll
                  for (int n = 0; n < 4; ++n)
#pragma unroll
                    for (int j = 0; j < 4; ++j) {
                      const int row = m0 + wr * 64 + m * 16 + fq * 4 + j, col = n0 + wc * 64 + n * 16 + fr;
                      C[(size_t)row * ldc + col] = f2bf(acc[m][n][j]);
                    }
              });
  }
}

DI void ph_rmsnorm_bf16(const float* __restrict__ xin, const float* __restrict__ w, u16* __restrict__ outp) {
  const int tid_ = otid(); const int lane = tid_ & 63, gw = (obid() * NTHR + tid_) >> 6, nw = gridDim.x * (NTHR / 64);
  for (int t = gw; t < T; t += nw) {
    const float* xr = xin + (size_t)t * DM;
    float4 v[4];
    float ss = 0.f;
#pragma unroll
    for (int i = 0; i < 4; ++i) {
      v[i] = *reinterpret_cast<const float4*>(xr + (i * 64 + lane) * 4);
      ss += v[i].x * v[i].x + v[i].y * v[i].y + v[i].z * v[i].z + v[i].w * v[i].w;
    }
    ss = wave_sum(ss);
    const float rstd = rsqrtf(ss * (1.f / DM) + 1e-6f);
#pragma unroll
    for (int i = 0; i < 4; ++i) {
      const int c = (i * 64 + lane) * 4;
      const float4 ww = *reinterpret_cast<const float4*>(w + c);
      uint2 o;
      o.x = pack2(v[i].x * rstd * ww.x, v[i].y * rstd * ww.y);
      o.y = pack2(v[i].z * rstd * ww.z, v[i].w * rstd * ww.w);
      *reinterpret_cast<uint2*>(outp + (size_t)t * DM + c) = o;
    }
  }
}

DI void ph_final_norm(const float* __restrict__ xin, const float* __restrict__ w, float* __restrict__ outp) {
  const int tid_ = otid(); const int lane = tid_ & 63, gw = (obid() * NTHR + tid_) >> 6, nw = gridDim.x * (NTHR / 64);
  for (int t = gw; t < T; t += nw) {
    const float* xr = xin + (size_t)t * DM;
    float4 v[4];
    float ss = 0.f;
#pragma unroll
    for (int i = 0; i < 4; ++i) {
      v[i] = *reinterpret_cast<const float4*>(xr + (i * 64 + lane) * 4);
      ss += v[i].x * v[i].x + v[i].y * v[i].y + v[i].z * v[i].z + v[i].w * v[i].w;
    }
    ss = wave_sum(ss);
    const float rstd = rsqrtf(ss * (1.f / DM) + 1e-6f);
#pragma unroll
    for (int i = 0; i < 4; ++i) {
      const int c = (i * 64 + lane) * 4;
      const float4 ww = *reinterpret_cast<const float4*>(w + c);
      float4 o = make_float4(v[i].x * rstd * ww.x, v[i].y * rstd * ww.y, v[i].z * rstd * ww.z, v[i].w * rstd * ww.w);
      *reinterpret_cast<float4*>(outp + (size_t)t * DM + c) = o;
    }
  }
}

DI void rot8(const u16* x1p, const u16* x2p, const float* tab  , float scale, uint4& o1, uint4& o2) {
  float x1[8], x2[8], y1[8], y2[8];
  ld8(x1p, x1); ld8(x2p, x2);
#pragma unroll
  for (int e = 0; e < 8; e += 2) {
    const float4 cs = *reinterpret_cast<const float4*>(tab + e * 2);
    y1[e] = (x1[e] * cs.x - x2[e] * cs.y) * scale;
    y2[e] = (x2[e] * cs.x + x1[e] * cs.y) * scale;
    y1[e + 1] = (x1[e + 1] * cs.z - x2[e + 1] * cs.w) * scale;
    y2[e + 1] = (x2[e + 1] * cs.z + x1[e + 1] * cs.w) * scale;
  }
  o1.x = pack2(y1[0], y1[1]); o1.y = pack2(y1[2], y1[3]); o1.z = pack2(y1[4], y1[5]); o1.w = pack2(y1[6], y1[7]);
  o2.x = pack2(y2[0], y2[1]); o2.y = pack2(y2[2], y2[3]); o2.z = pack2(y2[4], y2[5]); o2.w = pack2(y2[6], y2[7]);
}
DI void ph_post(const Params& p, int L) {
  const int tid = otid();
  const int gt = obid() * NTHR + tid, gs = gridDim.x * NTHR;
  const int lane = tid & 63, gw = gt >> 6, nw = gs >> 6;
  const float* qnw = p.q_norm_w + L * 256;
  const float* kvnw = p.kv_norm_w + L * 128;
  const float* cw = p.conv_w + L * 5 * 768;
  const float* cb = p.conv_b + L * 768;
  const float* dtb = p.dt_bias + L * 8;
  {
    uint4 xr[5];
    auto load_taps = [&](int idx, uint4 (&r)[5]) {
      const int t = idx / 96, cg = idx - t * 96, s = t & (SEQ - 1);
#pragma unroll
      for (int w = 0; w < 5; ++w) {
        const int ss = s + w - 2;
        const int tt = (ss >= 0 && ss < SEQ) ? (t + w - 2) : t;
        r[w] = *reinterpret_cast<const uint4*>(p.proj() + (size_t)tt * PWP + C_XBC + cg * 8);
      }
    };
    if (gt < T * 96) load_taps(gt, xr);
    for (int idx = gt; idx < T * 96; idx += gs) {
      const int t = idx / 96, cg = idx - t * 96, s = t & (SEQ - 1);
      uint4 xn[5];
      const int idn = (idx + gs < T * 96) ? (idx + gs) : idx;
      load_taps(idn, xn);
      float acc[8];
      {
        const float4 b0 = *reinterpret_cast<const float4*>(cb + cg * 8), b1 = *reinterpret_cast<const float4*>(cb + cg * 8 + 4);
        acc[0] = b0.x; acc[1] = b0.y; acc[2] = b0.z; acc[3] = b0.w; acc[4] = b1.x; acc[5] = b1.y; acc[6] = b1.z; acc[7] = b1.w;
      }
#pragma unroll
      for (int w = 0; w < 5; ++w) {
        const int ss = s + w - 2;
        const float msk = (ss >= 0 && ss < SEQ) ? 1.f : 0.f;
        float xv[8];
        unpack8(xr[w], xv);
        const float4 w0 = *reinterpret_cast<const float4*>(cw + w * 768 + cg * 8), w1 = *reinterpret_cast<const float4*>(cw + w * 768 + cg * 8 + 4);
        acc[0] += msk * xv[0] * w0.x; acc[1] += msk * xv[1] * w0.y; acc[2] += msk * xv[2] * w0.z; acc[3] += msk * xv[3] * w0.w;
        acc[4] += msk * xv[4] * w1.x; acc[5] += msk * xv[5] * w1.y; acc[6] += msk * xv[6] * w1.z; acc[7] += msk * xv[7] * w1.w;
      }
      uint4 o;
      o.x = pack2(fast_silu(acc[0]), fast_silu(acc[1])); o.y = pack2(fast_silu(acc[2]), fast_silu(acc[3]));
      o.z = pack2(fast_silu(acc[4]), fast_silu(acc[5])); o.w = pack2(fast_silu(acc[6]), fast_silu(acc[7]));
      *reinterpret_cast<uint4*>(p.xbc() + (size_t)t * 768 + cg * 8) = o;
#pragma unroll
      for (int w = 0; w < 5; ++w) xr[w] = xn[w];
    }
  }
  for (int idx = gt; idx < T * 8; idx += gs) {
    const int t = idx >> 3, k = idx & 7;
    const float v = bf2f(p.proj()[(size_t)t * PWP + C_DT + k]) + dtb[k];
    p.dtv()[idx] = (v > 20.f) ? v : log1pf(expf(v));
  }
  {
    const int sub = lane >> 4, l16 = lane & 15;
    for (int t = gw * 4 + sub; t < T; t += nw * 4) {
      const u16* pr = p.proj() + (size_t)t * PWP;
      float v[16], u[8];
      ld8(pr + C_CQ + l16 * 16, v); ld8(pr + C_CQ + l16 * 16 + 8, v + 8);
      ld8(pr + C_CKV + l16 * 8, u);
      float ss = 0.f, s2 = 0.f;
#pragma unroll
      for (int i = 0; i < 16; ++i) ss += v[i] * v[i];
#pragma unroll
      for (int i = 0; i < 8; ++i) s2 += u[i] * u[i];
#pragma unroll
      for (int o = 1; o < 16; o <<= 1) { ss += __shfl_xor(ss, o); s2 += __shfl_xor(s2, o); }
      const float rstd = rsqrtf(ss * (1.f / 256.f) + 1e-6f), r2 = rsqrtf(s2 * (1.f / 128.f) + 1e-6f);
      uint4 o;
      const float* qw = qnw + l16 * 16;
      o.x = pack2(v[0] * rstd * qw[0], v[1] * rstd * qw[1]); o.y = pack2(v[2] * rstd * qw[2], v[3] * rstd * qw[3]);
      o.z = pack2(v[4] * rstd * qw[4], v[5] * rstd * qw[5]); o.w = pack2(v[6] * rstd * qw[6], v[7] * rstd * qw[7]);
      *reinterpret_cast<uint4*>(p.cqn() + (size_t)t * 256 + l16 * 16) = o;
      o.x = pack2(v[8] * rstd * qw[8], v[9] * rstd * qw[9]); o.y = pack2(v[10] * rstd * qw[10], v[11] * rstd * qw[11]);
      o.z = pack2(v[12] * rstd * qw[12], v[13] * rstd * qw[13]); o.w = pack2(v[14] * rstd * qw[14], v[15] * rstd * qw[15]);
      *reinterpret_cast<uint4*>(p.cqn() + (size_t)t * 256 + l16 * 16 + 8) = o;
      const float* kw = kvnw + l16 * 8;
      o.x = pack2(u[0] * r2 * kw[0], u[1] * r2 * kw[1]); o.y = pack2(u[2] * r2 * kw[2], u[3] * r2 * kw[3]);
      o.z = pack2(u[4] * r2 * kw[4], u[5] * r2 * kw[5]); o.w = pack2(u[6] * r2 * kw[6], u[7] * r2 * kw[7]);
      *reinterpret_cast<uint4*>(p.ckvn() + (size_t)t * 128 + l16 * 8) = o;
    }
  }
  {
    auto item_of = [&](int idx, u16*& a, int& off2, int& tabo, float& scale, int& krope_i0) {
      const int t = idx / 42, ri = idx - t * 42, s = t & (SEQ - 1);
      u16* pr = p.proj() + (size_t)t * PWP;
      krope_i0 = -1;
      if (ri < 32) {
        const int isk = ri >> 4, h = (ri >> 2) & 3, i0 = (ri & 3) * 8;
        a = pr + (isk ? C_RK : C_RQ) + h * 64 + i0; off2 = 32; tabo = (s * 56 + i0) * 2; scale = isk ? 1.f : 0.125f;
      } else if (ri < 40) {
        const int j = ri - 32, isk = j >> 2, h = j & 3;
        a = pr + (isk ? C_DK : C_DQ) + h * 64; off2 = 8; tabo = (s * 56 + 32) * 2; scale = 1.f;
      } else {
        const int i0 = (ri - 40) * 8;
        a = pr + C_KR + i0; off2 = 16; tabo = (s * 56 + 40 + i0) * 2; scale = 1.f; krope_i0 = i0;
      }
    };
    uint4 x1c = make_uint4(0, 0, 0, 0), x2c = make_uint4(0, 0, 0, 0);
    if (gt < T * 42) {
      u16* a; int off2, tabo, ki; float sc;
      item_of(gt, a, off2, tabo, sc, ki);
      x1c = *reinterpret_cast<const uint4*>(a); x2c = *reinterpret_cast<const uint4*>(a + off2);
    }
    for (int idx = gt; idx < T * 42; idx += gs) {
      u16* a; int off2, tabo, ki; float scale;
      item_of(idx, a, off2, tabo, scale, ki);
      uint4 x1n, x2n;
      {
        const int idn = (idx + gs < T * 42) ? (idx + gs) : idx;
        u16* an; int o2n, tn_, kn; float scn;
        item_of(idn, an, o2n, tn_, scn, kn);
        x1n = *reinterpret_cast<const uint4*>(an); x2n = *reinterpret_cast<const uint4*>(an + o2n);
      }
      float x1[8], x2[8], y1[8], y2[8];
      unpack8(x1c, x1); unpack8(x2c, x2);
      const float* tab = p.rtab() + tabo;
#pragma unroll
      for (int e = 0; e < 8; e += 2) {
        const float4 cs = *reinterpret_cast<const float4*>(tab + e * 2);
        y1[e] = (x1[e] * cs.x - x2[e] * cs.y) * scale;
        y2[e] = (x2[e] * cs.x + x1[e] * cs.y) * scale;
        y1[e + 1] = (x1[e + 1] * cs.z - x2[e + 1] * cs.w) * scale;
        y2[e + 1] = (x2[e + 1] * cs.z + x1[e + 1] * cs.w) * scale;
      }
      uint4 o1, o2;
      o1.x = pack2(y1[0], y1[1]); o1.y = pack2(y1[2], y1[3]); o1.z = pack2(y1[4], y1[5]); o1.w = pack2(y1[6], y1[7]);
      o2.x = pack2(y2[0], y2[1]); o2.y = pack2(y2[2], y2[3]); o2.z = pack2(y2[4], y2[5]); o2.w = pack2(y2[6], y2[7]);
      *reinterpret_cast<uint4*>(a) = o1;
      *reinterpret_cast<uint4*>(a + off2) = o2;
      if (ki >= 0) {
        const int t = idx / 42, s = t & (SEQ - 1), bb = t >> 12;
#pragma unroll
        for (int hd = 0; hd < 4; ++hd) {
          u16* kf = p.kfull() + ((size_t)(bb * 4 + hd) * SEQ + s) * 96 + 64 + ki;
          *reinterpret_cast<uint4*>(kf) = o1;
          *reinterpret_cast<uint4*>(kf + 16) = o2;
        }
      }
      x1c = x1n; x2c = x2n;
    }
  }
}

DI void ph_mla_up_q(const Params& p, int L, char* smem, int t) {
  const int mt = T / 256;
  const u16* Bq = p.WuqT() + (size_t)L * 384 * 256;
  {
    const int m0 = (t % mt) * 256, n0 = (t / mt) * 128;
    gemm_tile([&](int r) { return p.cqn() + (size_t)(m0 + r) * 256; }, Bq + (size_t)n0 * 256, 256, 256, smem,
              [&](f32x4 (&acc)[4][4], int wr, int wc, int fr, int fq) {
                const float scale = 0.10206207261596575f * 1.4426950408889634f;
#pragma unroll
                for (int m = 0; m < 4; ++m)
#pragma unroll
                  for (int j = 0; j < 4; ++j) {
                    const int row = m0 + wr * 64 + m * 16 + fq * 4 + j;
                    const float2 cssn = *reinterpret_cast<const float2*>(p.rtab() + ((size_t)(row & (SEQ - 1)) * 56 + 40 + fr) * 2);
                    const float cs = cssn.x, sn = cssn.y;
#pragma unroll
                    for (int n2 = 0; n2 < 4; n2 += 2) {
                      const int cb = n0 + wc * 64 + n2 * 16;
                      float x1 = acc[m][n2][j], x2 = acc[m][n2 + 1][j];
                      if (cb % 96 == 64) {
                        const float y1 = x1 * cs - x2 * sn, y2 = x2 * cs + x1 * sn;
                        x1 = y1; x2 = y2;
                      }
                      p.mq()[(size_t)row * 384 + cb + fr] = f2bf(x1 * scale);
                      p.mq()[(size_t)row * 384 + cb + 16 + fr] = f2bf(x2 * scale);
                    }
                  }
              });
  }
}
DI void ph_mla_up_kv(const Params& p, int L, char* smem, int t) {
  const int mt = T / 256;
  const u16* Bkv = p.WukvT() + (size_t)L * 512 * 128;
  {
    const int m0 = (t % mt) * 256, h = t / mt, n0 = h * 128;
    gemm_tile([&](int r) { return p.ckvn() + (size_t)(m0 + r) * 128; }, Bkv + (size_t)n0 * 128, 128, 128, smem,
              [&](f32x4 (&acc)[4][4], int wr, int wc, int fr, int fq) {
#pragma unroll
                for (int m = 0; m < 4; ++m) {
                  const int row = m0 + wr * 64 + m * 16 + fq * 4;
                  const int bb = row >> 12, sq = row & (SEQ - 1);
                  const size_t bh = (size_t)(bb * 4 + h);
#pragma unroll
                  for (int n = 0; n < 4; ++n) {
                    if (wc == 0) {
#pragma unroll
                      for (int j = 0; j < 4; ++j) p.kfull()[(bh * SEQ + sq + j) * 96 + n * 16 + fr] = f2bf(acc[m][n][j]);
                    } else {
                      uint2 v;
                      v.x = pack2(acc[m][n][0], acc[m][n][1]);
                      v.y = pack2(acc[m][n][2], acc[m][n][3]);
                      const int sqp = (sq & ~12) | ((sq & 4) << 1) | ((sq & 8) >> 1);
                      *reinterpret_cast<uint2*>(p.vT() + (bh * 64 + n * 16 + fr) * SEQ + sqp) = v;
                    }
                  }
                }
              });
  }
}

DI void ph_cumsum(const Params& p, int L) {
  const int tid_ = otid(); const int lane = tid_ & 63, gw = (obid() * NTHR + tid_) >> 6, nw = gridDim.x * (NTHR / 64);
  for (int it = gw; it < 32; it += nw) {
    const int h = it & 3, dir = (it >> 2) & 1, b = it >> 3;
    const float a = -expf(p.a_log[L * 8 + dir * 4 + h]);
    float running = 0.f;
    for (int c = 0; c < 64; ++c) {
      const int i = c * 64 + lane;
      const int s = dir ? (SEQ - 1 - i) : i;
      const size_t off = (size_t)(b * SEQ + s) * 8 + dir * 4 + h;
      float v = p.dtv()[off] * a;
#pragma unroll
      for (int o = 1; o < 64; o <<= 1) {
        const float u = __shfl_up(v, o);
        if (lane >= o) v += u;
      }
      v += running;
      p.cs()[off] = v;
      running = __shfl(v, 63);
    }
  }
}

DI void ph_ret_naive(const Params& p) {
  const int gt = obid() * NTHR + otid(), gs = gridDim.x * NTHR;
  for (int it = gt; it < 4 * 4 * SEQ; it += gs) {
    const int n = it & (SEQ - 1), h = (it >> 12) & 3, b = it >> 14;
    const u16* base = p.proj() + (size_t)(b * SEQ) * PWP;
    uint4 qp[8];
    float o[64];
#pragma unroll
    for (int d = 0; d < 8; ++d) qp[d] = *reinterpret_cast<const uint4*>(base + (size_t)n * PWP + C_RQ + h * 64 + d * 8);
#pragma unroll
    for (int d = 0; d < 64; ++d) o[d] = 0.f;
    const float lg0 = log1pf(-exp2f(-5.f - (float)h)), lg1 = log1pf(-exp2f(-5.5f - (float)h));
#pragma unroll 1
    for (int m = 0; m < SEQ; ++m) {
      const u16* kr = base + (size_t)m * PWP + C_RK + h * 64;
      const u16* vr = base + (size_t)m * PWP + C_RV + h * 64;
      float s = 0.f;
#pragma unroll
      for (int d = 0; d < 8; ++d) s = dot8(qp[d], *reinterpret_cast<const uint4*>(kr + d * 8), s);
      const float w = (m <= n) ? expf(lg0 * (float)(n - m)) : expf(lg1 * (float)(m - n));
      s *= w;
#pragma unroll
      for (int d = 0; d < 64; d += 8) {
        float vf[8];
        ld8(vr + d, vf);
#pragma unroll
        for (int j = 0; j < 8; ++j) o[d + j] += s * vf[j];
      }
    }
    float mu = 0.f;
#pragma unroll
    for (int d = 0; d < 64; ++d) mu += o[d];
    mu *= (1.f / 64.f);
    float var = 0.f;
#pragma unroll
    for (int d = 0; d < 64; ++d) var += (o[d] - mu) * (o[d] - mu);
    var *= (1.f / 64.f);
    const float rs = rsqrtf(var + 1e-5f);
    const size_t t = (size_t)b * SEQ + n;
#pragma unroll
    for (int d = 0; d < 64; d += 8) {
      float g[8];
      ld8(p.proj() + t * PWP + C_RG + h * 64 + d, g);
      uint4 ov;
      ov.x = pack2(silu(g[0]) * (o[d + 0] - mu) * rs, silu(g[1]) * (o[d + 1] - mu) * rs);
      ov.y = pack2(silu(g[2]) * (o[d + 2] - mu) * rs, silu(g[3]) * (o[d + 3] - mu) * rs);
      ov.z = pack2(silu(g[4]) * (o[d + 4] - mu) * rs, silu(g[5]) * (o[d + 5] - mu) * rs);
      ov.w = pack2(silu(g[6]) * (o[d + 6] - mu) * rs, silu(g[7]) * (o[d + 7] - mu) * rs);
      *reinterpret_cast<uint4*>(p.mixed() + t * DM + h * 64 + d) = ov;
    }
  }
}

DI void ph_mla_naive(const Params& p) {
  const int gt = obid() * NTHR + otid(), gs = gridDim.x * NTHR;
  for (int it = gt; it < 2 * 4 * 4 * SEQ; it += gs) {
    const int n = it & (SEQ - 1), vh = (it >> 12) & 1, h = (it >> 13) & 3, b = it >> 15;
    const size_t t = (size_t)b * SEQ + n;
    uint4 qp[12];
    float o[32];
#pragma unroll
    for (int d = 0; d < 12; ++d) qp[d] = *reinterpret_cast<const uint4*>(p.mq() + t * 384 + h * 96 + d * 8);
    const size_t tb = (size_t)b * SEQ;
    float mx = -1e30f;
#pragma unroll 1
    for (int m = 0; m < SEQ; ++m) {
      const u16* kn = ((u16*)nullptr) + (tb + m) * 512 + h * 128;
      const u16* kr = p.proj() + (tb + m) * PWP + C_KR;
      float s = 0.f;
#pragma unroll
      for (int d = 0; d < 8; ++d) s = dot8(qp[d], *reinterpret_cast<const uint4*>(kn + d * 8), s);
#pragma unroll
      for (int d = 0; d < 4; ++d) s = dot8(qp[8 + d], *reinterpret_cast<const uint4*>(kr + d * 8), s);
      mx = fmaxf(mx, s);
    }
#pragma unroll
    for (int d = 0; d < 32; ++d) o[d] = 0.f;
    float l = 0.f;
#pragma unroll 1
    for (int m = 0; m < SEQ; ++m) {
      const u16* kn = ((u16*)nullptr) + (tb + m) * 512 + h * 128;
      const u16* kr = p.proj() + (tb + m) * PWP + C_KR;
      float s = 0.f;
#pragma unroll
      for (int d = 0; d < 8; ++d) s = dot8(qp[d], *reinterpret_cast<const uint4*>(kn + d * 8), s);
#pragma unroll
      for (int d = 0; d < 4; ++d) s = dot8(qp[8 + d], *reinterpret_cast<const uint4*>(kr + d * 8), s);
      const float pe = exp2f(s - mx);
      l += pe;
#pragma unroll
      for (int d = 0; d < 32; d += 8) {
        float vf[8];
        ld8(kn + 64 + vh * 32 + d, vf);
#pragma unroll
        for (int j = 0; j < 8; ++j) o[d + j] += pe * vf[j];
      }
    }
    const float il = 1.f / l;
#pragma unroll
    for (int d = 0; d < 32; d += 8) {
      uint4 ov;
      ov.x = pack2(o[d + 0] * il, o[d + 1] * il);
      ov.y = pack2(o[d + 2] * il, o[d + 3] * il);
      ov.z = pack2(o[d + 4] * il, o[d + 5] * il);
      ov.w = pack2(o[d + 6] * il, o[d + 7] * il);
      *reinterpret_cast<uint4*>(p.mixed() + t * DM + 256 + h * 64 + vh * 32 + d) = ov;
    }
  }
}

#define MFMA32(a, b, c) __builtin_amdgcn_mfma_f32_32x32x16_bf16((a), (b), (c), 0, 0, 0)
DI float max16(const f32x16& v) {
  float a = fmaxf(fmaxf(v[0], v[1]), v[2]), b = fmaxf(fmaxf(v[3], v[4]), v[5]), c = fmaxf(fmaxf(v[6], v[7]), v[8]);
  float d = fmaxf(fmaxf(v[9], v[10]), v[11]), e = fmaxf(fmaxf(v[12], v[13]), v[14]);
  return fmaxf(fmaxf(fmaxf(a, b), fmaxf(c, d)), fmaxf(e, v[15]));
}
DI void ph_mla_attn(const Params& p, char* smem, int L) {
  const int tid = otid(), wid = tid >> 6, lane = tid & 63, l32 = lane & 31, hh = lane >> 5;
  u16* sK = reinterpret_cast<u16*>(smem);
  u16* sV = sK + 2 * 128 * 104;
  uint4 konev = make_uint4(hh == 0 ? 0x00003F80u : 0u, 0u, 0u, 0u);
  const bf16x8 kone = __builtin_bit_cast(bf16x8, konev);
  for (int item = obid(); item < 256; item += gridDim.x) {
    const int xcd_ = item & 7, jx_ = item >> 3, bh = xcd_ * 2 + (jx_ >> 4), qt = jx_ & 15, b = bh >> 2, h = bh & 3;
    const size_t t0 = (size_t)b * SEQ + qt * 256 + wid * 32;
    bf16x8 qf[6];
#pragma unroll
    for (int ks = 0; ks < 6; ++ks) qf[ks] = *reinterpret_cast<const bf16x8*>(p.mq() + (t0 + l32) * 384 + h * 96 + ks * 16 + hh * 8);
    const u16* kg = p.kfull() + (size_t)bh * SEQ * 96;
    const u16* vg = p.vT() + (size_t)bh * 64 * SEQ;
    f32x16 o0, o1;
#pragma unroll
    for (int i = 0; i < 16; ++i) { o0[i] = 0.f; o1[i] = 0.f; }
    float m = 0.f, l = 0.f;
    bf16x8 qf6 = __builtin_bit_cast(bf16x8, make_uint4(0u, 0u, 0u, 0u));
    const int kr0 = tid / 12, kc0 = tid % 12, kr1 = (512 + tid) / 12, kc1 = (512 + tid) % 12, kr2 = (1024 + tid) / 12, kc2 = (1024 + tid) % 12;
    const int vd0 = tid >> 4, vd1 = 32 + (tid >> 4), vkc = (tid & 15) * 8;
    uint4 ak0, ak1, ak2, av0, av1;
#define MLA_LD(dst_, ptr_) asm volatile("global_load_dwordx4 %0, %1, off" : "=v"(dst_) : "v"(ptr_) : "memory")
#define MLA_GLOAD(K0, K1, K2, V0, V1, kt_)                                               \
    {                                                                                    \
      const u16* kb_ = kg + (size_t)(kt_) * 128 * 96 + tid * 8;                          \
      MLA_LD(K0, kb_); MLA_LD(K1, kb_ + 512 * 8); MLA_LD(K2, kb_ + 1024 * 8);            \
      const u16* vp_ = vg + (size_t)vd0 * SEQ + (kt_) * 128 + vkc;                       \
      MLA_LD(V0, vp_); MLA_LD(V1, vp_ + (size_t)32 * SEQ);                               \
    }
#define MLA_SSTORE(K0, K1, K2, V0, V1, buf_)                                             \
    {                                                                                    \
      u16* kb_ = sK + (buf_) * 128 * 104;                                                \
      u16* vb_ = sV + (buf_) * 64 * 136;                                                 \
      *reinterpret_cast<uint4*>(kb_ + kr0 * 104 + kc0 * 8) = K0;                         \
      *reinterpret_cast<uint4*>(kb_ + kr1 * 104 + kc1 * 8) = K1;                         \
      *reinterpret_cast<uint4*>(kb_ + kr2 * 104 + kc2 * 8) = K2;                         \
      *reinterpret_cast<uint4*>(vb_ + vd0 * 136 + vkc) = V0;                             \
      *reinterpret_cast<uint4*>(vb_ + vd1 * 136 + vkc) = V1;                             \
    }
    float mxrun = 0.f;
#define SGB(mask, n) __builtin_amdgcn_sched_group_barrier((mask), (n), 0)
#define MLA_KFRAG(kb_, sub_, ks_) (*reinterpret_cast<const bf16x8*>((kb_) + ((sub_) * 32 + l32) * 104 + (ks_) * 16 + hh * 8))
#define MLA_VFRAG(dst_, vb_, sub_, ks2_, dvt_) \
    dst_ = *reinterpret_cast<const bf16x8*>((vb_) + ((dvt_) * 32 + l32) * 136 + (sub_) * 32 + (ks2_) * 16 + hh * 8)
#define MLA_SOFTMAX(sc_, pa_, pb_)                                                                         \
    {                                                                                                      \
      mxrun = fmaxf(mxrun, max16(sc_));                                                                    \
      float ps0_ = 0.f, ps1_ = 0.f;                                                                        \
      _Pragma("unroll") for (int i = 0; i < 16; i += 2) {                                                  \
        sc_[i] = __builtin_amdgcn_exp2f(sc_[i]); sc_[i + 1] = __builtin_amdgcn_exp2f(sc_[i + 1]);          \
        ps0_ += sc_[i]; ps1_ += sc_[i + 1];                                                                \
      }                                                                                                    \
      l += ps0_ + ps1_;                                                                                    \
      uint4 pk_;                                                                                           \
      pk_.x = pack2(sc_[0], sc_[1]); pk_.y = pack2(sc_[2], sc_[3]); pk_.z = pack2(sc_[4], sc_[5]); pk_.w = pack2(sc_[6], sc_[7]); \
      pa_ = __builtin_bit_cast(bf16x8, pk_);                                                               \
      pk_.x = pack2(sc_[8], sc_[9]); pk_.y = pack2(sc_[10], sc_[11]); pk_.z = pack2(sc_[12], sc_[13]); pk_.w = pack2(sc_[14], sc_[15]); \
      pb_ = __builtin_bit_cast(bf16x8, pk_);                                                               \
    }
    auto compute_tile = [&](int cur, int half) {
      const u16* kb = sK + cur * 128 * 104 + half * 64 * 104;
      const u16* vb = sV + cur * 64 * 136 + half * 64;
      bf16x8 k0[6], k1[6];
#pragma unroll
      for (int ks = 0; ks < 6; ++ks) { k0[ks] = MLA_KFRAG(kb, 0, ks); k1[ks] = MLA_KFRAG(kb, 1, ks); }
      f32x16 s0, s1;
#pragma unroll
      for (int i = 0; i < 16; ++i) { s0[i] = 0.f; s1[i] = 0.f; }
#pragma unroll
      for (int ks = 0; ks < 6; ++ks) s0 = MFMA32(k0[ks], qf[ks], s0);
      s0 = MFMA32(kone, qf6, s0);
      bf16x8 v00, v01, v02, v03, v10, v11, v12, v13;
      MLA_VFRAG(v00, vb, 0, 0, 0); MLA_VFRAG(v01, vb, 0, 0, 1); MLA_VFRAG(v02, vb, 0, 1, 0); MLA_VFRAG(v03, vb, 0, 1, 1);
#pragma unroll
      for (int ks = 0; ks < 6; ++ks) s1 = MFMA32(k1[ks], qf[ks], s1);
      s1 = MFMA32(kone, qf6, s1);
      MLA_VFRAG(v10, vb, 1, 0, 0); MLA_VFRAG(v11, vb, 1, 0, 1); MLA_VFRAG(v12, vb, 1, 1, 0); MLA_VFRAG(v13, vb, 1, 1, 1);
      bf16x8 p0a, p0b, p1a, p1b;
      MLA_SOFTMAX(s0, p0a, p0b);
      o0 = MFMA32(v00, p0a, o0); o1 = MFMA32(v01, p0a, o1); o0 = MFMA32(v02, p0b, o0); o1 = MFMA32(v03, p0b, o1);
      MLA_SOFTMAX(s1, p1a, p1b);
      o0 = MFMA32(v10, p1a, o0); o1 = MFMA32(v11, p1a, o1); o0 = MFMA32(v12, p1b, o0); o1 = MFMA32(v13, p1b, o1);
      SGB(0x100, 12);
#pragma unroll
      for (int i = 0; i < 7; ++i) { SGB(0x008, 1); if (i < 4) SGB(0x100, 1); }
#pragma unroll
      for (int i = 0; i < 7; ++i) { SGB(0x008, 1); if (i < 4) SGB(0x100, 1); SGB(0x402, 7); }
#pragma unroll
      for (int i = 0; i < 4; ++i) { SGB(0x008, 1); SGB(0x402, 12); }
#pragma unroll
      for (int i = 0; i < 4; ++i) SGB(0x008, 1);
    };
    auto lazy_update = [&]() {
      const float mxr = fmaxf(mxrun, __shfl_xor(mxrun, 32));
      if (__builtin_amdgcn_ballot_w64(mxr > 8.f) != 0ull) {
        float d = (mxr > 8.f) ? mxr : 0.f;
        const float mnew = bf2f(f2bf(m + d));
        d = mnew - m;
        m = mnew;
        const float alpha = __builtin_amdgcn_exp2f(-d);
        l *= alpha;
        mxrun -= d;
#pragma unroll
        for (int i = 0; i < 16; ++i) { o0[i] *= alpha; o1[i] *= alpha; }
        uint4 qv = make_uint4(0u, 0u, 0u, 0u);
        if (hh == 0) qv.x = (unsigned)f2bf(-m);
        qf6 = __builtin_bit_cast(bf16x8, qv);
      }
    };
    unsigned char* cbuf = reinterpret_cast<unsigned char*>(sV + 2 * 64 * 136);
    const bool cvt_on = (gridDim.x == 256);
    f32x4 cv0, cv1, cv2, cv3;
    bool cvalid = false;
#define CVT_ISSUE(j_)                                                                                                   \
    {                                                                                                                   \
      const int g_ = CVT_B + obid() + 256 * (j_);                                                                       \
      cvalid = cvt_on && (g_ < 12288);                                                                                  \
      if (cvalid) {                                                                                                     \
        const CvtTile ct_ = cvt_tile(p, L, g_);                                                                         \
        const float* sp_ = ct_.src + (size_t)(ct_.k0 + (tid >> 5) * 4) * ct_.N + ct_.n0 + (tid & 31) * 4;              \
        asm volatile("global_load_dwordx4 %0, %1, off nt" : "=v"(cv0) : "v"(sp_) : "memory");                           \
        asm volatile("global_load_dwordx4 %0, %1, off nt" : "=v"(cv1) : "v"(sp_ + ct_.N) : "memory");                   \
        asm volatile("global_load_dwordx4 %0, %1, off nt" : "=v"(cv2) : "v"(sp_ + 2 * ct_.N) : "memory");               \
        asm volatile("global_load_dwordx4 %0, %1, off nt" : "=v"(cv3) : "v"(sp_ + 3 * ct_.N) : "memory");               \
      }                                                                                                                 \
    }
#define CVT_TO_LDS(par_)                                                                                                \
    if (cvalid) {                                                                                                       \
      unsigned char* cb_ = cbuf + (par_) * 10240 + (tid & 31) * 4 * 80 + (tid >> 5) * 4;                                \
      *reinterpret_cast<unsigned*>(cb_) = pk4_f8_scaled<256>(cv0[0], cv1[0], cv2[0], cv3[0]);       \
      *reinterpret_cast<unsigned*>(cb_ + 80) = pk4_f8_scaled<256>(cv0[1], cv1[1], cv2[1], cv3[1]);  \
      *reinterpret_cast<unsigned*>(cb_ + 160) = pk4_f8_scaled<256>(cv0[2], cv1[2], cv2[2], cv3[2]); \
      *reinterpret_cast<unsigned*>(cb_ + 240) = pk4_f8_scaled<256>(cv0[3], cv1[3], cv2[3], cv3[3]); \
    }
#define CVT_TO_GLOBAL(par_, j_)                                                                                         \
    if (cvalid) {                                                                                                       \
      const CvtTile ct_ = cvt_tile(p, L, CVT_B + obid() + 256 * (j_));        \
      unsigned char* cd_ = ct_.dst + (size_t)cvt_rowmap(ct_.mat, ct_.n0 + (tid >> 2)) * ct_.K + ct_.k0 + (tid & 3) * 16;  \
      *reinterpret_cast<uint4*>(cd_) = *reinterpret_cast<const uint4*>(cbuf + (par_) * 10240 + (tid >> 2) * 80 + (tid & 3) * 16); \
    }
    MLA_GLOAD(ak0, ak1, ak2, av0, av1, 0);
    asm volatile("s_waitcnt vmcnt(0)" ::: "memory");
    MLA_SSTORE(ak0, ak1, ak2, av0, av1, 0);
    __syncthreads();
    {
      f32x16 s0, s1;
#pragma unroll
      for (int i = 0; i < 16; ++i) { s0[i] = 0.f; s1[i] = 0.f; }
#pragma unroll
      for (int ks = 0; ks < 6; ++ks) { s0 = MFMA32(MLA_KFRAG(sK, 0, ks), qf[ks], s0); s1 = MFMA32(MLA_KFRAG(sK, 1, ks), qf[ks], s1); }
      float mx = fmaxf(max16(s0), max16(s1));
      mx = fmaxf(mx, __shfl_xor(mx, 32));
      m = bf2f(f2bf(mx));
      uint4 qv = make_uint4(0u, 0u, 0u, 0u);
      if (hh == 0) qv.x = (unsigned)f2bf(-m);
      qf6 = __builtin_bit_cast(bf16x8, qv);
    }
#pragma unroll 1
    for (int kt = 0; kt < 32; kt += 2) {
#pragma unroll 1
      for (int half = 0; half < 2; ++half) {
        CVT_ISSUE(2 * kt + half);
        if (half == 0) MLA_GLOAD(ak0, ak1, ak2, av0, av1, kt + 1);
        compute_tile(0, half);
        if (half == 0) {
          asm volatile("s_waitcnt vmcnt(5)" ::: "memory");
        } else {
          asm volatile("s_waitcnt vmcnt(0)" ::: "memory");
          MLA_SSTORE(ak0, ak1, ak2, av0, av1, 1);
        }
        asm volatile("" : "+v"(cv0), "+v"(cv1), "+v"(cv2), "+v"(cv3) :: "memory");
        CVT_TO_LDS(half);
        __syncthreads();
        CVT_TO_GLOBAL(half, 2 * kt + half);
      }
      lazy_update();
      const bool more = kt + 2 < 32;
#pragma unroll 1
      for (int half = 0; half < 2; ++half) {
        CVT_ISSUE(2 * kt + 2 + half);
        if (half == 0 && more) MLA_GLOAD(ak0, ak1, ak2, av0, av1, kt + 2);
        compute_tile(1, half);
        if (half == 0 && more) {
          asm volatile("s_waitcnt vmcnt(5)" ::: "memory");
        } else {
          asm volatile("s_waitcnt vmcnt(0)" ::: "memory");
          if (half == 1 && more) MLA_SSTORE(ak0, ak1, ak2, av0, av1, 0);
        }
        asm volatile("" : "+v"(cv0), "+v"(cv1), "+v"(cv2), "+v"(cv3) :: "memory");
        CVT_TO_LDS(half);
        __syncthreads();
        CVT_TO_GLOBAL(half, 2 * kt + 2 + half);
      }
      lazy_update();
    }
    l += __shfl_xor(l, 32);
    const float il = 1.f / l;
    u16* orow = p.mixed() + (t0 + l32) * DM + 256 + h * 64 + hh * 4;
#pragma unroll
    for (int g = 0; g < 4; ++g) {
      uint2 v;
      v.x = pack2(o0[4 * g + 0] * il, o0[4 * g + 1] * il);
      v.y = pack2(o0[4 * g + 2] * il, o0[4 * g + 3] * il);
      *reinterpret_cast<uint2*>(orow + g * 8) = v;
      v.x = pack2(o1[4 * g + 0] * il, o1[4 * g + 1] * il);
      v.y = pack2(o1[4 * g + 2] * il, o1[4 * g + 3] * il);
      *reinterpret_cast<uint2*>(orow + 32 + g * 8) = v;
    }
  }
}

typedef __attribute__((address_space(3))) s16x4 lds_s16x4;
template <int MODE>
DI void ph_dil_pass(const Params& p, char* smem, int blk_) {
  const int tid = otid(), wid = tid >> 6, lane = tid & 63, l32 = lane & 31, hh = lane >> 5;
  u16* sV = reinterpret_cast<u16*>(smem) + wid * (2 * 32 * 72);
  const int i16 = lane & 15, tq = i16 >> 2, tp = i16 & 3, tblk = (lane >> 4) & 1;
  {
    constexpr int NT = (MODE == 0) ? 13 : 5;
    const int it = wid, xcd_ = blk_ & 7, jx_ = blk_ >> 3, bh = xcd_ * 2 + (jx_ >> 4), r = jx_ & 15, b = bh >> 2, h = bh & 3;
    const int i0 = it * 32;
    const int q0 = (r * 8 + it) * 32;
    const int qpos = (MODE == 0) ? (r + 16 * (i0 + l32)) : (q0 + l32);
    const size_t tb = (size_t)b * SEQ;
    const u16* kbase = p.proj() + tb * PWP + C_DK + h * 64;
    const u16* vbase = p.proj() + tb * PWP + C_DV + h * 64;
    bf16x8 qf[4];
    {
      const u16* qp = p.proj() + (tb + qpos) * PWP + C_DQ + h * 64 + hh * 8;
#pragma unroll
      for (int ks = 0; ks < 4; ++ks) qf[ks] = *reinterpret_cast<const bf16x8*>(qp + ks * 16);
    }
    f32x16 o0, o1;
#pragma unroll
    for (int i = 0; i < 16; ++i) { o0[i] = 0.f; o1[i] = 0.f; }
    float m = -1e30f, l = 0.f;
    auto tile_params = [&](int tt, int& d, int& rd, int& ub, int& ulim, int& qb, int& qs) {
      if (MODE == 0) {
        if (tt < 5) { d = 16; rd = r; qb = i0; qs = 1; ulim = 256; ub = qb - 64 + 32 * tt; }
        else { d = 4; rd = r & 3; qb = (r >> 2) + 4 * i0; qs = 4; ulim = 1024; ub = qb - 64 + 32 * (tt - 5); }
      } else { d = 1; rd = 0; qb = q0; qs = 1; ulim = 4096; ub = qb - 64 + 32 * tt; }
    };
    bf16x8 ka0, ka1, ka2, ka3, kb0, kb1, kb2, kb3;
    uint4 va0, va1, va2, va3, vb0, vb1, vb2, vb3;
#define DIL_LD(dst_, ptr_) asm volatile("global_load_dwordx4 %0, %1, off" : "=v"(dst_) : "v"(ptr_) : "memory")
#define DIL_GLOAD(K0, K1, K2, K3, V0, V1, V2, V3, tt_)                                                   \
    {                                                                                                    \
      int d_, rd_, ub_, ulim_, qb_, qs_;                                                                 \
      tile_params((tt_), d_, rd_, ub_, ulim_, qb_, qs_);                                                 \
      int u_ = min(max(ub_ + l32, 0), ulim_ - 1);                                                        \
      const u16* kp_ = kbase + (size_t)(rd_ + d_ * u_) * PWP + hh * 8;                                   \
      DIL_LD(K0, kp_); DIL_LD(K1, kp_ + 16); DIL_LD(K2, kp_ + 32); DIL_LD(K3, kp_ + 48);                 \
      const int kr_ = ub_ + (lane >> 3);                                                                 \
      const u16* vp_;                                                                                    \
      u_ = min(max(kr_, 0), ulim_ - 1);      vp_ = vbase + (size_t)(rd_ + d_ * u_) * PWP + (lane & 7) * 8; DIL_LD(V0, vp_); \
      u_ = min(max(kr_ + 8, 0), ulim_ - 1);  vp_ = vbase + (size_t)(rd_ + d_ * u_) * PWP + (lane & 7) * 8; DIL_LD(V1, vp_); \
      u_ = min(max(kr_ + 16, 0), ulim_ - 1); vp_ = vbase + (size_t)(rd_ + d_ * u_) * PWP + (lane & 7) * 8; DIL_LD(V2, vp_); \
      u_ = min(max(kr_ + 24, 0), ulim_ - 1); vp_ = vbase + (size_t)(rd_ + d_ * u_) * PWP + (lane & 7) * 8; DIL_LD(V3, vp_); \
    }
#define DIL_VSTORE(V0, V1, V2, V3, buf_)                                                                 \
    {                                                                                                    \
      u16* vb_ = sV + (buf_) * 32 * 72 + (lane >> 3) * 72 + (lane & 7) * 8;                              \
      *reinterpret_cast<uint4*>(vb_) = V0;                                                               \
      *reinterpret_cast<uint4*>(vb_ + 8 * 72) = V1;                                                      \
      *reinterpret_cast<uint4*>(vb_ + 16 * 72) = V2;                                                     \
      *reinterpret_cast<uint4*>(vb_ + 24 * 72) = V3;                                                     \
    }
    auto tile_rest = [&](int tt, f32x16 sc, int cur) {
      int d, rd, ub, ulim, qb, qs;
      tile_params(tt, d, rd, ub, ulim, qb, qs);
      const int uq = qb + qs * l32;
      const float cs = 0.125f * 1.4426950408889634f;
      float mx = -1e30f;
#pragma unroll
      for (int i = 0; i < 16; ++i) {
        const int u = ub + (i & 3) + 8 * (i >> 2) + 4 * hh;
        const int du = u - uq;
        const bool valid = (u >= 0) && (u < ulim) && (du <= 64) && (du >= -64);
        sc[i] = valid ? sc[i] * cs : -1e30f;
        mx = fmaxf(mx, sc[i]);
      }
      mx = fmaxf(mx, __shfl_xor(mx, 32));
      const float mn = fmaxf(m, mx);
      const float alpha = __builtin_amdgcn_exp2f(m - mn);
      m = mn;
      float ps = 0.f;
#pragma unroll
      for (int i = 0; i < 16; ++i) {
        float pe = __builtin_amdgcn_exp2f(sc[i] - mn);
        pe = (sc[i] > -1e29f) ? pe : 0.f;
        ps += pe;
        sc[i] = pe;
      }
      l = l * alpha + ps;
#pragma unroll
      for (int i = 0; i < 16; ++i) { o0[i] *= alpha; o1[i] *= alpha; }
      const u16* vb = sV + cur * 32 * 72;
#pragma unroll
      for (int ks2 = 0; ks2 < 2; ++ks2) {
        uint4 pk;
        pk.x = pack2(sc[8 * ks2 + 0], sc[8 * ks2 + 1]);
        pk.y = pack2(sc[8 * ks2 + 2], sc[8 * ks2 + 3]);
        pk.z = pack2(sc[8 * ks2 + 4], sc[8 * ks2 + 5]);
        pk.w = pack2(sc[8 * ks2 + 6], sc[8 * ks2 + 7]);
        const bf16x8 pb = __builtin_bit_cast(bf16x8, pk);
#pragma unroll
        for (int dvt = 0; dvt < 2; ++dvt) {
          const u16* a0 = vb + (16 * ks2 + 4 * hh + tq) * 72 + dvt * 32 + tblk * 16 + tp * 4;
          const s16x4 lo = __builtin_amdgcn_ds_read_tr16_b64_v4i16((lds_s16x4*)(a0));
          const s16x4 hi = __builtin_amdgcn_ds_read_tr16_b64_v4i16((lds_s16x4*)(a0 + 8 * 72));
          const bf16x8 a = __builtin_shufflevector(lo, hi, 0, 1, 2, 3, 4, 5, 6, 7);
          if (dvt == 0) o0 = MFMA32(a, pb, o0); else o1 = MFMA32(a, pb, o1);
        }
      }
    };
    DIL_GLOAD(ka0, ka1, ka2, ka3, va0, va1, va2, va3, 0);
    DIL_GLOAD(kb0, kb1, kb2, kb3, vb0, vb1, vb2, vb3, 1);
    asm volatile("s_waitcnt vmcnt(8)" ::: "memory");
    DIL_VSTORE(va0, va1, va2, va3, 0);
#pragma unroll 1
    for (int tt = 0; tt < NT; tt += 2) {
      {
        f32x16 sc;
#pragma unroll
        for (int i = 0; i < 16; ++i) sc[i] = 0.f;
        sc = MFMA32(ka0, qf[0], sc); sc = MFMA32(ka1, qf[1], sc); sc = MFMA32(ka2, qf[2], sc); sc = MFMA32(ka3, qf[3], sc);
        asm volatile("" :: "v"(sc));
        if (tt + 2 < NT) DIL_GLOAD(ka0, ka1, ka2, ka3, va0, va1, va2, va3, tt + 2);
        tile_rest(tt, sc, 0);
        if (tt + 1 < NT) {
          if (tt + 2 < NT) asm volatile("s_waitcnt vmcnt(8)" ::: "memory"); else asm volatile("s_waitcnt vmcnt(0)" ::: "memory");
          DIL_VSTORE(vb0, vb1, vb2, vb3, 1);
        }
      }
      if (tt + 1 < NT) {
        f32x16 sc;
#pragma unroll
        for (int i = 0; i < 16; ++i) sc[i] = 0.f;
        sc = MFMA32(kb0, qf[0], sc); sc = MFMA32(kb1, qf[1], sc); sc = MFMA32(kb2, qf[2], sc); sc = MFMA32(kb3, qf[3], sc);
        asm volatile("" :: "v"(sc));
        if (tt + 3 < NT) DIL_GLOAD(kb0, kb1, kb2, kb3, vb0, vb1, vb2, vb3, tt + 3);
        tile_rest(tt + 1, sc, 1);
        if (tt + 2 < NT) {
          if (tt + 3 < NT) asm volatile("s_waitcnt vmcnt(8)" ::: "memory"); else asm volatile("s_waitcnt vmcnt(0)" ::: "memory");
          DIL_VSTORE(va0, va1, va2, va3, 0);
        }
      }
    }
    l += __shfl_xor(l, 32);
    float* part = p.dpart() + ((tb + qpos) * 4 + h) * 68 + hh * 4;
    if (MODE == 0) {
#pragma unroll
      for (int g = 0; g < 4; ++g) {
        *reinterpret_cast<float4*>(part + g * 8) = make_float4(o0[4 * g + 0], o0[4 * g + 1], o0[4 * g + 2], o0[4 * g + 3]);
        *reinterpret_cast<float4*>(part + 32 + g * 8) = make_float4(o1[4 * g + 0], o1[4 * g + 1], o1[4 * g + 2], o1[4 * g + 3]);
      }
      if (hh == 0) { part[64] = m; part[65] = l; }
    } else {
      const float mA = part[64 - hh * 4], lA = part[65 - hh * 4];
      const float M = fmaxf(m, mA), sa = __builtin_amdgcn_exp2f(m - M), sb = __builtin_amdgcn_exp2f(mA - M);
      const float il = 1.f / (l * sa + lA * sb);
      u16* orow = p.mixed() + (tb + qpos) * DM + 768 + h * 64 + hh * 4;
#pragma unroll
      for (int g = 0; g < 4; ++g) {
        const float4 a0 = *reinterpret_cast<const float4*>(part + g * 8), a1 = *reinterpret_cast<const float4*>(part + 32 + g * 8);
        uint2 v;
        v.x = pack2((o0[4 * g + 0] * sa + a0.x * sb) * il, (o0[4 * g + 1] * sa + a0.y * sb) * il);
        v.y = pack2((o0[4 * g + 2] * sa + a0.z * sb) * il, (o0[4 * g + 3] * sa + a0.w * sb) * il);
        *reinterpret_cast<uint2*>(orow + g * 8) = v;
        v.x = pack2((o1[4 * g + 0] * sa + a1.x * sb) * il, (o1[4 * g + 1] * sa + a1.y * sb) * il);
        v.y = pack2((o1[4 * g + 2] * sa + a1.z * sb) * il, (o1[4 * g + 3] * sa + a1.w * sb) * il);
        *reinterpret_cast<uint2*>(orow + 32 + g * 8) = v;
      }
    }
  }
}

DI void ph_dil_naive(const Params& p) {
  const int gt = obid() * NTHR + otid(), gs = gridDim.x * NTHR;
  for (int it = gt; it < 4 * 4 * SEQ; it += gs) {
    const int n = it & (SEQ - 1), h = (it >> 12) & 3, b = it >> 14;
    const size_t tb = (size_t)b * SEQ;
    uint4 qp[8];
    float o[64];
#pragma unroll
    for (int d = 0; d < 8; ++d) qp[d] = *reinterpret_cast<const uint4*>(p.proj() + (tb + n) * PWP + C_DQ + h * 64 + d * 8);
    float mx = -1e30f;
    for (int pat = 0; pat < 3; ++pat) {
      const int dil = (pat == 0) ? 1 : (pat == 1 ? 4 : 16);
#pragma unroll 1
      for (int j = -64; j <= 64; ++j) {
        const int pos = n + j * dil;
        if (pos < 0 || pos >= SEQ) continue;
        const u16* kr = p.proj() + (tb + pos) * PWP + C_DK + h * 64;
        float s = 0.f;
#pragma unroll
        for (int d = 0; d < 8; ++d) s = dot8(qp[d], *reinterpret_cast<const uint4*>(kr + d * 8), s);
        s *= 0.125f;
        mx = fmaxf(mx, s);
      }
    }
#pragma unroll
    for (int d = 0; d < 64; ++d) o[d] = 0.f;
    float l = 0.f;
    for (int pat = 0; pat < 3; ++pat) {
      const int dil = (pat == 0) ? 1 : (pat == 1 ? 4 : 16);
#pragma unroll 1
      for (int j = -64; j <= 64; ++j) {
        const int pos = n + j * dil;
        if (pos < 0 || pos >= SEQ) continue;
        const u16* kr = p.proj() + (tb + pos) * PWP + C_DK + h * 64;
        const u16* vr = p.proj() + (tb + pos) * PWP + C_DV + h * 64;
        float s = 0.f;
#pragma unroll
        for (int d = 0; d < 8; ++d) s = dot8(qp[d], *reinterpret_cast<const uint4*>(kr + d * 8), s);
        s *= 0.125f;
        const float pe = __expf(s - mx);
        l += pe;
#pragma unroll
        for (int d = 0; d < 64; d += 8) {
          float vf[8];
          ld8(vr + d, vf);
#pragma unroll
          for (int jj = 0; jj < 8; ++jj) o[d + jj] += pe * vf[jj];
        }
      }
    }
    const float il = 1.f / l;
#pragma unroll
    for (int d = 0; d < 64; d += 8) {
      uint4 ov;
      ov.x = pack2(o[d + 0] * il, o[d + 1] * il);
      ov.y = pack2(o[d + 2] * il, o[d + 3] * il);
      ov.z = pack2(o[d + 4] * il, o[d + 5] * il);
      ov.w = pack2(o[d + 6] * il, o[d + 7] * il);
      *reinterpret_cast<uint4*>(p.mixed() + (tb + n) * DM + 768 + h * 64 + d) = ov;
    }
  }
}

DI void ph_ssd_naive(const Params& p, int L) {
  const int gt = obid() * NTHR + otid(), gs = gridDim.x * NTHR;
  for (int it = gt; it < 4 * 4 * 4 * SEQ; it += gs) {
    const int l = it & (SEQ - 1), pq = (it >> 12) & 3, h = (it >> 14) & 3, b = it >> 16;
    const int g = h >> 1;
    const size_t tb = (size_t)b * SEQ;
    uint4 cl[16];
    float acc[16];
#pragma unroll
    for (int d = 0; d < 16; ++d) cl[d] = *reinterpret_cast<const uint4*>(p.xbc() + (tb + l) * 768 + 512 + g * 128 + d * 8);
#pragma unroll
    for (int d = 0; d < 16; ++d) acc[d] = 0.f;
    const float pl = p.cs()[(tb + l) * 8 + h], rl = p.cs()[(tb + l) * 8 + 4 + h];
#pragma unroll 1
    for (int s = 0; s < SEQ; ++s) {
      const u16* br = p.xbc() + (tb + s) * 768 + 256 + g * 128;
      float cbv = 0.f;
#pragma unroll
      for (int d = 0; d < 16; ++d) cbv = dot8(cl[d], *reinterpret_cast<const uint4*>(br + d * 8), cbv);
      float w;
      if (s <= l) w = expf(pl - p.cs()[(tb + s) * 8 + h]) * p.dtv()[(tb + s) * 8 + h];
      else w = expf(rl - p.cs()[(tb + s) * 8 + 4 + h]) * p.dtv()[(tb + s) * 8 + 4 + h];
      cbv *= w;
      const u16* xr = p.xbc() + (tb + s) * 768 + h * 64 + pq * 16;
#pragma unroll
      for (int d = 0; d < 16; d += 8) {
        float xf[8];
        ld8(xr + d, xf);
#pragma unroll
        for (int j = 0; j < 8; ++j) acc[d + j] += cbv * xf[j];
      }
    }
    const float dsk = p.ssm_d[L * 4 + h];
#pragma unroll
    for (int d = 0; d < 16; ++d) {
      const int c = h * 64 + pq * 16 + d;
      const float xv = bf2f(p.xbc()[(tb + l) * 768 + c]);
      const float z = bf2f(p.proj()[(tb + l) * PWP + C_Z + c]);
      p.ybuf()[(tb + l) * 256 + c] = (acc[d] + dsk * xv) * silu(z);
    }
  }
}

DI void ph_ssd_norm(const Params& p, int L) {
  const int tid_ = otid(); const int lane = tid_ & 63, gw = (obid() * NTHR + tid_) >> 6, nw = gridDim.x * (NTHR / 64);
  const float* nwt = p.ssm_norm_w + L * 256;
  for (int t = gw; t < T; t += nw) {
    const float4 v = *reinterpret_cast<const float4*>(p.ybuf() + (size_t)t * 256 + lane * 4);
    float ss = wave_sum(v.x * v.x + v.y * v.y + v.z * v.z + v.w * v.w);
    const float rstd = rsqrtf(ss * (1.f / 256.f) + 1e-6f);
    const float4 ww = *reinterpret_cast<const float4*>(nwt + lane * 4);
    uint2 o;
    o.x = pack2(v.x * rstd * ww.x, v.y * rstd * ww.y);
    o.y = pack2(v.z * rstd * ww.z, v.w * rstd * ww.w);
    *reinterpret_cast<uint2*>(p.mixed() + (size_t)t * DM + 512 + lane * 4) = o;
  }
}

#define MFMA16(a, b, c) __builtin_amdgcn_mfma_f32_16x16x32_bf16((a), (b), (c), 0, 0, 0)
template <int MT, int NT, int KS>
DI void wave_mm(f32x4 (&acc)[MT][NT], const u16* a0, int lda, const u16* b0, int ldb, int fr, int fq) {
#pragma unroll
  for (int ks = 0; ks < KS; ++ks) {
    bf16x8 af[MT], bfv[NT];
#pragma unroll
    for (int m = 0; m < MT; ++m) af[m] = *reinterpret_cast<const bf16x8*>(a0 + (m * 16 + fr) * lda + ks * 32 + fq * 8);
#pragma unroll
    for (int n = 0; n < NT; ++n) bfv[n] = *reinterpret_cast<const bf16x8*>(b0 + (n * 16 + fr) * ldb + ks * 32 + fq * 8);
#pragma unroll
    for (int m = 0; m < MT; ++m)
#pragma unroll
      for (int n = 0; n < NT; ++n) acc[m][n] = MFMA16(af[m], bfv[n], acc[m][n]);
  }
}
template <int MT, int NT>
DI void zero_acc(f32x4 (&acc)[MT][NT]) {
#pragma unroll
  for (int m = 0; m < MT; ++m)
#pragma unroll
    for (int n = 0; n < NT; ++n) acc[m][n] = f32x4{0.f, 0.f, 0.f, 0.f};
}
template <int NROWS, int NCOLS>
DI void stage_rows(u16* dst, int ldd, const u16* src, size_t lsrc, int tid) {
  constexpr int CPR = NCOLS / 8, NCH = NROWS * CPR / NTHR;
  static_assert(NROWS * CPR % NTHR == 0, "tile must be a multiple of 512 chunks");
  uint4 r[NCH];
#pragma unroll
  for (int i = 0; i < NCH; ++i) {
    const int c = tid + i * NTHR, row = c / CPR, cc = c % CPR;
    r[i] = *reinterpret_cast<const uint4*>(src + (size_t)row * lsrc + cc * 8);
  }
#pragma unroll
  for (int i = 0; i < NCH; ++i) {
    const int c = tid + i * NTHR, row = c / CPR, cc = c % CPR;
    *reinterpret_cast<uint4*>(dst + row * ldd + cc * 8) = r[i];
  }
}
template <int NCOLS, class W>
DI void stage_T(u16* dst, int ldd, const u16* src, size_t lsrc, int tid, W w) {
  constexpr int NCH = 128 * (NCOLS / 8) / NTHR;
  uint4 r[NCH];
#pragma unroll
  for (int i = 0; i < NCH; ++i) {
    const int c = tid + i * NTHR, j = c & 127, cc = c >> 7;
    r[i] = *reinterpret_cast<const uint4*>(src + (size_t)j * lsrc + cc * 8);
  }
#pragma unroll
  for (int i = 0; i < NCH; ++i) {
    const int c = tid + i * NTHR, j = c & 127, cc = c >> 7;
    float f[8];
    unpack8(r[i], f);
    const float wj = w(j);
#pragma unroll
    for (int e = 0; e < 8; ++e) dst[(cc * 8 + e) * ldd + j] = f2bf(f[e] * wj);
  }
}

template <int NROWS, int NCOLS>
DI void stage_rows_ld(uint4 (&r)[NROWS * (NCOLS / 8) / NTHR], const u16* src, size_t lsrc, int tid) {
  constexpr int CPR = NCOLS / 8, NCH = NROWS * CPR / NTHR;
#pragma unroll
  for (int i = 0; i < NCH; ++i) {
    const int c = tid + i * NTHR, row = c / CPR, cc = c % CPR;
    r[i] = *reinterpret_cast<const uint4*>(src + (size_t)row * lsrc + cc * 8);
  }
}
template <int NROWS, int NCOLS>
DI void stage_rows_st(u16* dst, int ldd, const uint4 (&r)[NROWS * (NCOLS / 8) / NTHR], int tid) {
  constexpr int CPR = NCOLS / 8, NCH = NROWS * CPR / NTHR;
#pragma unroll
  for (int i = 0; i < NCH; ++i) {
    const int c = tid + i * NTHR, row = c / CPR, cc = c % CPR;
    *reinterpret_cast<uint4*>(dst + row * ldd + cc * 8) = r[i];
  }
}
template <int NCOLS>
DI void stage_T_ld(uint4 (&r)[128 * (NCOLS / 8) / NTHR], const u16* src, size_t lsrc, int tid) {
  constexpr int NCH = 128 * (NCOLS / 8) / NTHR;
#pragma unroll
  for (int i = 0; i < NCH; ++i) {
    const int c = tid + i * NTHR, j = c & 127, cc = c >> 7;
    r[i] = *reinterpret_cast<const uint4*>(src + (size_t)j * lsrc + cc * 8);
  }
}
template <int NCOLS, class W>
DI void stage_T_st(u16* dst, int ldd, const uint4 (&r)[128 * (NCOLS / 8) / NTHR], int tid, W w) {
  constexpr int NCH = 128 * (NCOLS / 8) / NTHR;
#pragma unroll
  for (int i = 0; i < NCH; ++i) {
    const int c = tid + i * NTHR, j = c & 127, cc = c >> 7;
    float f[8];
    unpack8(r[i], f);
    const float wj = w(j);
#pragma unroll
    for (int e = 0; e < 8; ++e) dst[(cc * 8 + e) * ldd + j] = f2bf(f[e] * wj);
  }
}

DI void ph_ret_a(const Params& p, char* smem, int item) {
  const int tid = otid(), wid = tid >> 6, lane = tid & 63, fr = lane & 15, fq = lane >> 4;
  u16* sVt = reinterpret_cast<u16*>(smem);
  u16* sKf = sVt + 64 * 136;
  u16* sKb = sKf + 64 * 136;
  {
    const int c = item & 31, bh = item >> 5, b = bh >> 2, h = bh & 3;
    const float lg0 = log1pf(-exp2f(-5.f - (float)h)), lg1 = log1pf(-exp2f(-5.5f - (float)h));
    const u16* src = p.proj() + ((size_t)b * SEQ + c * 128) * PWP;
    {
      uint4 rv[2], rk[2];
      stage_T_ld<64>(rv, src + C_RV + h * 64, PWP, tid);
      stage_T_ld<64>(rk, src + C_RK + h * 64, PWP, tid);
      stage_T_st<64>(sVt, 136, rv, tid, [](int) { return 1.f; });
      stage_T_st<64>(sKf, 136, rk, tid, [&](int j) { return __expf(lg0 * (float)(127 - j)); });
      stage_T_st<64>(sKb, 136, rk, tid, [&](int j) { return __expf(lg1 * (float)j); });
    }
    __syncthreads();
    const int dir = wid >> 2, q = wid & 3;
    f32x4 acc[1][4];
    zero_acc(acc);
    wave_mm<1, 4, 4>(acc, sVt + q * 16 * 136, 136, dir ? sKb : sKf, 136, fr, fq);
    float* out = p.rU() + ((size_t)(bh * 32 + c) * 2 + dir) * 4096;
#pragma unroll
    for (int n = 0; n < 4; ++n)
#pragma unroll
      for (int j = 0; j < 4; ++j) out[(q * 16 + fq * 4 + j) * 64 + n * 16 + fr] = acc[0][n][j];
    __syncthreads();
  }
}
DI void ph_ret_scan(const Params& p) {
  const int gt = obid() * NTHR + otid(), gs = gridDim.x * NTHR;
  for (int it = gt; it < 16 * 2 * 4096; it += gs) {
    const int e = it & 4095, dir = (it >> 12) & 1, bh = it >> 13, h = bh & 3;
    const float lg = log1pf(-exp2f((dir ? -5.5f : -5.f) - (float)h));
    const float cd = __expf(lg * 128.f);
    float u[32];
#pragma unroll
    for (int c = 0; c < 32; ++c) u[c] = p.rU()[((size_t)(bh * 32 + c) * 2 + dir) * 4096 + e];
    float st = 0.f;
    if (dir == 0) {
#pragma unroll
      for (int c = 0; c < 32; ++c) {
        p.rS()[((size_t)(bh * 32 + c) * 2 + dir) * 4096 + e] = f2bf(st);
        st = st * cd + u[c];
      }
    } else {
#pragma unroll
      for (int c = 31; c >= 0; --c) {
        p.rS()[((size_t)(bh * 32 + c) * 2 + dir) * 4096 + e] = f2bf(st);
        st = st * cd + u[c];
      }
    }
  }
}
DI void ph_ret_c(const Params& p, char* smem, int item) {
  const int tid = otid(), wid = tid >> 6, lane = tid & 63, fr = lane & 15, fq = lane >> 4;
  u16* sQ = reinterpret_cast<u16*>(smem);
  u16* sK = sQ + 128 * 72;
  u16* sVt = sK + 128 * 72;
  u16* sSf = sVt + 64 * 136;
  u16* sSb = sSf + 64 * 72;
  u16* sP = sSb + 64 * 72;
  {
    const int c = item & 31, bh = item >> 5, b = bh >> 2, h = bh & 3;
    const float lg0 = log1pf(-exp2f(-5.f - (float)h)), lg1 = log1pf(-exp2f(-5.5f - (float)h));
    const size_t t0 = (size_t)b * SEQ + c * 128;
    const u16* src = p.proj() + t0 * PWP;
    {
      uint4 rq[2], rk[2], rv[2], rf[1], rb[1];
      stage_rows_ld<128, 64>(rq, src + C_RQ + h * 64, PWP, tid);
      stage_rows_ld<128, 64>(rk, src + C_RK + h * 64, PWP, tid);
      stage_T_ld<64>(rv, src + C_RV + h * 64, PWP, tid);
      stage_rows_ld<64, 64>(rf, p.rS() + ((size_t)(bh * 32 + c) * 2 + 0) * 4096, 64, tid);
      stage_rows_ld<64, 64>(rb, p.rS() + ((size_t)(bh * 32 + c) * 2 + 1) * 4096, 64, tid);
      stage_rows_st<128, 64>(sQ, 72, rq, tid);
      stage_rows_st<128, 64>(sK, 72, rk, tid);
      stage_T_st<64>(sVt, 136, rv, tid, [](int) { return 1.f; });
      stage_rows_st<64, 64>(sSf, 72, rf, tid);
      stage_rows_st<64, 64>(sSb, 72, rb, tid);
    }
    __syncthreads();
    {
      const int wr = wid >> 1, wc = wid & 1;
      f32x4 sacc[2][4];
      zero_acc(sacc);
      wave_mm<2, 4, 2>(sacc, sQ + wr * 32 * 72, 72, sK + wc * 64 * 72, 72, fr, fq);
#pragma unroll
      for (int m = 0; m < 2; ++m)
#pragma unroll
        for (int n = 0; n < 4; ++n)
#pragma unroll
          for (int j = 0; j < 4; ++j) {
            const int i = wr * 32 + m * 16 + fq * 4 + j, jj = wc * 64 + n * 16 + fr;
            const float dcy = (jj <= i) ? __expf(lg0 * (float)(i - jj)) : __expf(lg1 * (float)(jj - i));
            sP[i * 136 + jj] = f2bf(sacc[m][n][j] * dcy);
          }
    }
    __syncthreads();
    {
      f32x4 ai[1][4], af_[1][4], ab_[1][4];
      zero_acc(ai); zero_acc(af_); zero_acc(ab_);
      wave_mm<1, 4, 4>(ai, sP + wid * 16 * 136, 136, sVt, 136, fr, fq);
      wave_mm<1, 4, 2>(af_, sQ + wid * 16 * 72, 72, sSf, 72, fr, fq);
      wave_mm<1, 4, 2>(ab_, sQ + wid * 16 * 72, 72, sSb, 72, fr, fq);
#pragma unroll
      for (int j = 0; j < 4; ++j) {
        const int i = wid * 16 + fq * 4 + j;
        const float xf = __expf(lg0 * (float)(i + 1)), xb = __expf(lg1 * (float)(128 - i));
        float o[4], sum = 0.f;
#pragma unroll
        for (int n = 0; n < 4; ++n) { o[n] = ai[0][n][j] + xf * af_[0][n][j] + xb * ab_[0][n][j]; sum += o[n]; }
#pragma unroll
        for (int sft = 1; sft < 16; sft <<= 1) sum += __shfl_xor(sum, sft);
        const float mu = sum * (1.f / 64.f);
        float var = 0.f;
#pragma unroll
        for (int n = 0; n < 4; ++n) var += (o[n] - mu) * (o[n] - mu);
#pragma unroll
        for (int sft = 1; sft < 16; sft <<= 1) var += __shfl_xor(var, sft);
        const float rs = rsqrtf(var * (1.f / 64.f) + 1e-5f);
#pragma unroll
        for (int n = 0; n < 4; ++n) {
          const float g = bf2f(p.proj()[(t0 + i) * PWP + C_RG + h * 64 + n * 16 + fr]);
          p.mixed()[(t0 + i) * DM + h * 64 + n * 16 + fr] = f2bf(silu(g) * (o[n] - mu) * rs);
        }
      }
    }
    __syncthreads();
  }
}

DI void ssd_local_cumsum(const Params& p, int L, size_t t0, float* cum, float* dtl, int wid, int lane) {
  const int dir = wid >> 2, h = wid & 3;
  const float a = -__expf(p.a_log[L * 8 + dir * 4 + h]);
  float d0, d1;
  if (dir == 0) { d0 = p.dtv()[(t0 + 2 * lane) * 8 + h]; d1 = p.dtv()[(t0 + 2 * lane + 1) * 8 + h]; }
  else { d0 = p.dtv()[(t0 + 127 - 2 * lane) * 8 + 4 + h]; d1 = p.dtv()[(t0 + 126 - 2 * lane) * 8 + 4 + h]; }
  float v0 = d0 * a, v1 = v0 + d1 * a;
  float run = v1;
#pragma unroll
  for (int o = 1; o < 64; o <<= 1) {
    const float u = __shfl_up(run, o);
    if (lane >= o) run += u;
  }
  const float excl = run - v1;
  v0 += excl; v1 += excl;
  float* cr = cum + (dir * 4 + h) * 128;
  float* dr = dtl + (dir * 4 + h) * 128;
  if (dir == 0) { cr[2 * lane] = v0; cr[2 * lane + 1] = v1; dr[2 * lane] = d0; dr[2 * lane + 1] = d1; }
  else { cr[127 - 2 * lane] = v0; cr[126 - 2 * lane] = v1; dr[127 - 2 * lane] = d0; dr[126 - 2 * lane] = d1; }
}

DI void ph_ssd_a(const Params& p, int L, char* smem, int item) {
  const int tid = otid(), wid = tid >> 6, lane = tid & 63, fr = lane & 15, fq = lane >> 4;
  u16* sBt = reinterpret_cast<u16*>(smem);
  u16* sXf = sBt + 2 * 128 * 136;
  u16* sXb = sXf + 64 * 136;
  float* cum = reinterpret_cast<float*>(sXb + 64 * 136);
  float* dtl = cum + 8 * 128;
  {
    const int c = item & 31, b = item >> 5;
    const size_t t0 = (size_t)b * SEQ + c * 128;
    ssd_local_cumsum(p, L, t0, cum, dtl, wid, lane);
    stage_T<256>(sBt, 136, p.xbc() + t0 * 768 + 256, 768, tid, [](int) { return 1.f; });
    __syncthreads();
    if (tid < 8) {
      const int dir = tid >> 2;
      p.cdec()[(size_t)item * 8 + tid] = __expf(dir ? cum[tid * 128 + 0] : cum[tid * 128 + 127]);
    }
    for (int h = 0; h < 4; ++h) {
      const float* cf = cum + h * 128;
      const float* cb = cum + (4 + h) * 128;
      const float* df = dtl + h * 128;
      const float* db = dtl + (4 + h) * 128;
      const float endf = cf[127], endb = cb[0];
      {
        uint4 rx[2];
        stage_T_ld<64>(rx, p.xbc() + t0 * 768 + h * 64, 768, tid);
        stage_T_st<64>(sXf, 136, rx, tid, [&](int l) { return __expf(endf - cf[l]) * df[l]; });
        stage_T_st<64>(sXb, 136, rx, tid, [&](int l) { return __expf(endb - cb[l]) * db[l]; });
      }
      __syncthreads();
      const int dir = wid >> 2, q = wid & 3, g = h >> 1;
      f32x4 acc[4][2];
      zero_acc(acc);
      wave_mm<4, 2, 4>(acc, dir ? sXb : sXf, 136, sBt + (g * 128 + q * 32) * 136, 136, fr, fq);
      float* out = p.sU() + ((size_t)item * 8 + h * 2 + dir) * 8192;
#pragma unroll
      for (int m = 0; m < 4; ++m)
#pragma unroll
        for (int n = 0; n < 2; ++n)
#pragma unroll
          for (int j = 0; j < 4; ++j) out[(m * 16 + fq * 4 + j) * 128 + q * 32 + n * 16 + fr] = acc[m][n][j];
      __syncthreads();
    }
  }
}
DI void ph_ssd_scan(const Params& p) {
  const int gt = obid() * NTHR + otid(), gs = gridDim.x * NTHR;
  for (int it = gt; it < 4 * 8 * 8192; it += gs) {
    const int e = it & 8191, hd = (it >> 13) & 7, b = it >> 16;
    const int dir = hd & 1, h = hd >> 1;
    float u[32];
#pragma unroll
    for (int c = 0; c < 32; ++c) u[c] = p.sU()[((size_t)(b * 32 + c) * 8 + hd) * 8192 + e];
    float st = 0.f;
    if (dir == 0) {
#pragma unroll
      for (int c = 0; c < 32; ++c) {
        p.sS()[((size_t)(b * 32 + c) * 8 + hd) * 8192 + e] = f2bf(st);
        st = st * p.cdec()[(size_t)(b * 32 + c) * 8 + dir * 4 + h] + u[c];
      }
    } else {
#pragma unroll
      for (int c = 31; c >= 0; --c) {
        p.sS()[((size_t)(b * 32 + c) * 8 + hd) * 8192 + e] = f2bf(st);
        st = st * p.cdec()[(size_t)(b * 32 + c) * 8 + dir * 4 + h] + u[c];
      }
    }
  }
}
DI void ph_ssd_c(const Params& p, int L, char* smem, int item) {
  const int tid = otid(), wid = tid >> 6, lane = tid & 63, fr = lane & 15, fq = lane >> 4;
  u16* sC = reinterpret_cast<u16*>(smem);
  u16* sB = sC + 128 * 136;
  u16* sXt = sB + 128 * 136;
  u16* sSf = sXt + 64 * 136;
  u16* sSb = sSf + 64 * 136;
  float* cum = reinterpret_cast<float*>(sSb + 64 * 136);
  float* dtl = cum + 8 * 128;
  {
    const int c = item & 31, b = item >> 5;
    const size_t t0 = (size_t)b * SEQ + c * 128;
    ssd_local_cumsum(p, L, t0, cum, dtl, wid, lane);
    float ssq[4] = {0.f, 0.f, 0.f, 0.f};
#pragma unroll 1
    for (int g = 0; g < 2; ++g) {
      {
        uint4 rc[4], rb4[4];
        stage_rows_ld<128, 128>(rc, p.xbc() + t0 * 768 + 512 + g * 128, 768, tid);
        stage_rows_ld<128, 128>(rb4, p.xbc() + t0 * 768 + 256 + g * 128, 768, tid);
        stage_rows_st<128, 128>(sC, 136, rc, tid);
        stage_rows_st<128, 128>(sB, 136, rb4, tid);
      }
      __syncthreads();
      const int wr = wid >> 1, wc = wid & 1;
      f32x4 G[2][4];
      zero_acc(G);
      wave_mm<2, 4, 4>(G, sC + wr * 32 * 136, 136, sB + wc * 64 * 136, 136, fr, fq);
      __syncthreads();
#pragma unroll 1
      for (int hl = 0; hl < 2; ++hl) {
        const int h = g * 2 + hl;
        const float* cf = cum + h * 128;
        const float* cb = cum + (4 + h) * 128;
        const float* df = dtl + h * 128;
        const float* db = dtl + (4 + h) * 128;
        uint4 rxt[2], rsf[2], rsb[2];
        stage_T_ld<64>(rxt, p.xbc() + t0 * 768 + h * 64, 768, tid);
        stage_rows_ld<64, 128>(rsf, p.sS() + ((size_t)item * 8 + h * 2 + 0) * 8192, 128, tid);
        stage_rows_ld<64, 128>(rsb, p.sS() + ((size_t)item * 8 + h * 2 + 1) * 8192, 128, tid);
#pragma unroll
        for (int m = 0; m < 2; ++m)
#pragma unroll
          for (int n = 0; n < 4; ++n)
#pragma unroll
            for (int j = 0; j < 4; ++j) {
              const int l = wr * 32 + m * 16 + fq * 4 + j, sx = wc * 64 + n * 16 + fr;
              const float w = (sx <= l) ? __expf(cf[l] - cf[sx]) * df[sx] : __expf(cb[l] - cb[sx]) * db[sx];
              sB[l * 136 + sx] = f2bf(G[m][n][j] * w);
            }
        stage_T_st<64>(sXt, 136, rxt, tid, [](int) { return 1.f; });
        stage_rows_st<64, 128>(sSf, 136, rsf, tid);
        stage_rows_st<64, 128>(sSb, 136, rsb, tid);
        __syncthreads();
        f32x4 yd[1][4], yf[1][4], yb[1][4];
        zero_acc(yd); zero_acc(yf); zero_acc(yb);
        wave_mm<1, 4, 4>(yd, sB + wid * 16 * 136, 136, sXt, 136, fr, fq);
        wave_mm<1, 4, 4>(yf, sC + wid * 16 * 136, 136, sSf, 136, fr, fq);
        wave_mm<1, 4, 4>(yb, sC + wid * 16 * 136, 136, sSb, 136, fr, fq);
        const float dsk = p.ssm_d[L * 4 + h];
#pragma unroll
        for (int j = 0; j < 4; ++j) {
          const int l = wid * 16 + fq * 4 + j;
          const float ef = __expf(cf[l]), eb = __expf(cb[l]);
#pragma unroll
          for (int n = 0; n < 4; ++n) {
            const int ch = h * 64 + n * 16 + fr;
            const float xv = bf2f(p.xbc()[(t0 + l) * 768 + ch]);
            const float z = bf2f(p.proj()[(t0 + l) * PWP + C_Z + ch]);
            const float yv = (yd[0][n][j] + ef * yf[0][n][j] + eb * yb[0][n][j] + dsk * xv) * silu(z);
            ssq[j] += yv * yv;
            p.ybuf()[(t0 + l) * 256 + ch] = yv;
          }
        }
        __syncthreads();
      }
    }
    const float* nwt = p.ssm_norm_w + L * 256;
#pragma unroll
    for (int j = 0; j < 4; ++j) {
      float ss = ssq[j];
#pragma unroll
      for (int sft = 1; sft < 16; sft <<= 1) ss += __shfl_xor(ss, sft);
      const float rstd = rsqrtf(ss * (1.f / 256.f) + 1e-6f);
      const int l = wid * 16 + fq * 4 + j;
#pragma unroll
      for (int hn = 0; hn < 16; ++hn) {
        const int ch = hn * 16 + fr;
        p.mixed()[(t0 + l) * DM + 512 + ch] = f2bf(p.ybuf()[(t0 + l) * 256 + ch] * rstd * nwt[ch]);
      }
    }
  }
}

template <bool XIN_F32>
struct CfgOutproj {
  static constexpr bool PERM = true;
  int K; const Params* p; int L; int bid, nb; const void* xin; u16* xout;
  DI bool next(int i, pg8::Unit& u) const { const int t = i * nb + bid; if (t >= 64 * 4) return false; u.pm = t & 63; u.pn = t >> 6; return true; }
  DI const char* a_base(const pg8::Unit& u) const { return (const char*)(p->mixed() + (size_t)u.pm * 256 * DM); }
  DI const char* b_base(const pg8::Unit& u) const { return (const char*)(p->WoutT() + ((size_t)L * DM + (size_t)u.pn * 256) * DM); }
  DI void a_off(const pg8::Unit&, int R0, int C0, int R1, int C1, unsigned (&vo)[4]) const {
    vo[0] = (unsigned)(R0 * DM + C0) * 2u; vo[1] = (unsigned)(R1 * DM + C1) * 2u;
    vo[2] = vo[0] + 128u * DM * 2u; vo[3] = vo[1] + 128u * DM * 2u;
  }
  DI void epi(const f32x4 (&acc)[2][2][4][2], const pg8::Unit& u, int wr, int wc, int fr, int fq) const {
    const int row0 = u.pm * 256 + wr * 64 + fr, col0 = u.pn * 256 + wc * 32 + 8 * fq;
#pragma unroll
    for (int ai = 0; ai < 2; ++ai)
#pragma unroll
      for (int m = 0; m < 4; ++m) {
        const size_t ro = (size_t)(row0 + ai * 128 + m * 16) * DM + col0;
#pragma unroll
        for (int bj = 0; bj < 2; ++bj) {
          const size_t o = ro + bj * 128;
          float4 x0, x1;
          if (XIN_F32) {
            x0 = *reinterpret_cast<const float4*>(static_cast<const float*>(xin) + o);
            x1 = *reinterpret_cast<const float4*>(static_cast<const float*>(xin) + o + 4);
          } else {
            const uint4 q = *reinterpret_cast<const uint4*>(static_cast<const u16*>(xin) + o);
            x0 = bf4_to_f4(make_uint2(q.x, q.y)); x1 = bf4_to_f4(make_uint2(q.z, q.w));
          }
          const f32x4 a0 = acc[ai][bj][m][0], a1 = acc[ai][bj][m][1];
          uint4 w;
          w.x = pack2(x0.x + a0[0], x0.y + a0[1]); w.y = pack2(x0.z + a0[2], x0.w + a0[3]);
          w.z = pack2(x1.x + a1[0], x1.y + a1[1]); w.w = pack2(x1.z + a1[2], x1.w + a1[3]);
          *reinterpret_cast<uint4*>(xout + o) = w;
        }
      }
  }
};
DI void ph_outproj(const Params& p, int L, char* smem) {
  if (L == 0) {
    CfgOutproj<true> c; c.K = DM; c.p = &p; c.L = L; c.bid = obid(); c.nb = gridDim.x; c.xin = p.x; c.xout = p.xres();
    pg8::gemm_phase((pg8::lds_u8*)smem, c);
  } else {
    CfgOutproj<false> c; c.K = DM; c.p = &p; c.L = L; c.bid = obid(); c.nb = gridDim.x; c.xin = p.xres2(); c.xout = p.xres();
    pg8::gemm_phase((pg8::lds_u8*)smem, c);
  }
}

DI void ph_rms2_router(const Params& p, int L, const u16* xres, char* smem) {
  const int tid = otid(), lane = tid & 63, gw = (obid() * NTHR + tid) >> 6, nw = gridDim.x * (NTHR / 64);
  const float* w = p.ln2_w + L * DM;
  const float* rw = p.router_w + (size_t)L * DM * 16;
  float4* srw = reinterpret_cast<float4*>(smem);
  for (int i = tid; i < 4096; i += NTHR) {
    const int c = i >> 2, e4 = i & 3;
    srw[(e4 * 4 + (c & 3)) * 256 + (c >> 2)] = *reinterpret_cast<const float4*>(rw + (size_t)i * 4);
  }
  __syncthreads();
  const int b5 = (lane >> 5) & 1, b4 = (lane >> 4) & 1, b3 = (lane >> 3) & 1, b2 = (lane >> 2) & 1;
  const int my_e = 8 * b5 + 4 * b4 + 2 * b3 + b2;
  float4 v[4];
  if (gw < T) {
#pragma unroll
    for (int i = 0; i < 4; ++i) v[i] = bf4_to_f4(*reinterpret_cast<const uint2*>(xres + (size_t)gw * DM + (i * 64 + lane) * 4));
  }
  for (int t = gw; t < T; t += nw) {
    uint2 vnx[4];
    const int tn = (t + nw < T) ? (t + nw) : t;
#pragma unroll
    for (int i = 0; i < 4; ++i) vnx[i] = *reinterpret_cast<const uint2*>(xres + (size_t)tn * DM + (i * 64 + lane) * 4);
    float ss = 0.f;
#pragma unroll
    for (int i = 0; i < 4; ++i) ss += v[i].x * v[i].x + v[i].y * v[i].y + v[i].z * v[i].z + v[i].w * v[i].w;
    ss = wave_sum(ss);
    const float rstd = rsqrtf(ss * (1.f / DM) + 1e-6f);
    float lg[16];
#pragma unroll
    for (int e = 0; e < 16; ++e) lg[e] = 0.f;
#pragma unroll
    for (int i = 0; i < 4; ++i) {
      const int q = i * 64 + lane;
      const float4 ww = *reinterpret_cast<const float4*>(w + q * 4);
      const float hv[4] = {v[i].x * rstd * ww.x, v[i].y * rstd * ww.y, v[i].z * rstd * ww.z, v[i].w * rstd * ww.w};
      *reinterpret_cast<unsigned*>(p.hn8() + (size_t)t * DM + q * 4) =
          pk4_f8(hv[0] * F8_H_SCALE, hv[1] * F8_H_SCALE, hv[2] * F8_H_SCALE, hv[3] * F8_H_SCALE);
#pragma unroll
      for (int j = 0; j < 4; ++j)
#pragma unroll
        for (int e4 = 0; e4 < 4; ++e4) {
          const float4 r = srw[(e4 * 4 + j) * 256 + q];
          lg[e4 * 4 + 0] += hv[j] * r.x; lg[e4 * 4 + 1] += hv[j] * r.y;
          lg[e4 * 4 + 2] += hv[j] * r.z; lg[e4 * 4 + 3] += hv[j] * r.w;
        }
      __builtin_amdgcn_sched_barrier(0);
    }
#pragma unroll
    for (int k = 0; k < 8; ++k) {
      const float send = b5 ? lg[k] : lg[k + 8], keep = b5 ? lg[k + 8] : lg[k];
      lg[k] = keep + __shfl_xor(send, 32);
    }
#pragma unroll
    for (int k = 0; k < 4; ++k) {
      const float send = b4 ? lg[k] : lg[k + 4], keep = b4 ? lg[k + 4] : lg[k];
      lg[k] = keep + __shfl_xor(send, 16);
    }
#pragma unroll
    for (int k = 0; k < 2; ++k) {
      const float send = b3 ? lg[k] : lg[k + 2], keep = b3 ? lg[k + 2] : lg[k];
      lg[k] = keep + __shfl_xor(send, 8);
    }
    float lv;
    {
      const float send = b2 ? lg[0] : lg[1], keep = b2 ? lg[1] : lg[0];
      lv = keep + __shfl_xor(send, 4);
    }
    lv += __shfl_xor(lv, 2);
    lv += __shfl_xor(lv, 1);
    float mx = lv;
    mx = fmaxf(mx, __shfl_xor(mx, 4)); mx = fmaxf(mx, __shfl_xor(mx, 8));
    mx = fmaxf(mx, __shfl_xor(mx, 16)); mx = fmaxf(mx, __shfl_xor(mx, 32));
    const float ex = expf(lv - mx);
    float den = ex;
    den += __shfl_xor(den, 4); den += __shfl_xor(den, 8); den += __shfl_xor(den, 16); den += __shfl_xor(den, 32);
    if ((lane & 3) == 0) { p.aff()[(size_t)t * 16 + my_e] = ex / den; p.inv()[(size_t)t * 16 + my_e] = -1; }
#pragma unroll
    for (int i = 0; i < 4; ++i) v[i] = bf4_to_f4(vnx[i]);
  }
}

DI int block_sum_i(int v, int* red, int tid) {
#pragma unroll
  for (int o = 32; o > 0; o >>= 1) v += __shfl_xor(v, o);
  __syncthreads();
  if ((tid & 63) == 0) red[tid >> 6] = v;
  __syncthreads();
  int t = 0;
#pragma unroll
  for (int w = 0; w < NTHR / 64; ++w) t += red[w];
  return t;
}
DI void ph_topk(const Params& p, char* smem) {
  int* red = reinterpret_cast<int*>(smem);
  int* wsum = red + 16;
  const int tid = otid(), wid = tid >> 6, lane = tid & 63;
  for (int it = obid(); it < 64; it += gridDim.x) {
    const int e = it & 15, b = it >> 4;
    unsigned v[8];
#pragma unroll
    for (int i = 0; i < 8; ++i) v[i] = __float_as_uint(p.aff()[(size_t)(b * SEQ + tid * 8 + i) * 16 + e]);
    unsigned thr = 0;
#pragma unroll 1
    for (int bit = 30; bit >= 0; --bit) {
      const unsigned cand = thr | (1u << bit);
      int cnt = 0;
#pragma unroll
      for (int i = 0; i < 8; ++i) cnt += (v[i] >= cand) ? 1 : 0;
      if (block_sum_i(cnt, red, tid) >= 512) thr = cand;
    }
    int ngt = 0, ntie = 0;
#pragma unroll
    for (int i = 0; i < 8; ++i) { ngt += (v[i] > thr) ? 1 : 0; ntie += (v[i] == thr) ? 1 : 0; }
    int ig = ngt, itie = ntie;
#pragma unroll
    for (int o = 1; o < 64; o <<= 1) {
      const int a = __shfl_up(ig, o), c = __shfl_up(itie, o);
      if (lane >= o) { ig += a; itie += c; }
    }
    __syncthreads();
    if (lane == 63) { wsum[wid] = ig; wsum[8 + wid] = itie; }
    __syncthreads();
    int og = 0, ot = 0, totg = 0;
#pragma unroll
    for (int w = 0; w < 8; ++w) {
      const int a = wsum[w], c = wsum[8 + w];
      if (w < wid) { og += a; ot += c; }
      totg += a;
    }
    int pg = og + ig - ngt, pt = ot + itie - ntie;
    const int base = (e * 4 + b) * 512;
#pragma unroll
    for (int i = 0; i < 8; ++i) {
      int slot = -1;
      if (v[i] > thr) { slot = pg; ++pg; }
      else if (v[i] == thr) { if (totg + pt < 512) slot = totg + pt; ++pt; }
      if (slot >= 0) {
        p.tok()[base + slot] = b * SEQ + tid * 8 + i;
        p.inv()[(size_t)(b * SEQ + tid * 8 + i) * 16 + e] = base + slot;
        p.gate()[base + slot] = __uint_as_float(v[i]);
      }
    }
    __syncthreads();
  }
}

struct CfgMoe1 {
  static constexpr bool PERM = true;
  int K; const Params* p; int L; int bid, nb;
  DI bool next(int i, pg8::Unit& u) const {
    const int t = i * nb + bid; if (t >= 16 * 16 * 8) return false;
    const int rnd = t >> 8, w = t & 255, xcd = w & 7, jx = w >> 3, pid = xcd * 4 + (jx >> 3);
    const int mt = jx & 7, nt = pid & 15, e = rnd * 2 + (pid >> 4);
    u.pm = e * 8 + mt; u.pn = e * 16 + nt; return true;
  }
  DI const char* a_base(const pg8::Unit&) const { return (const char*)p->hn8(); }
  DI const char* b_base(const pg8::Unit& u) const { return (const char*)(p->Wgu8() + ((size_t)L * 16 * 4096 + (size_t)u.pn * 256) * DM); }
  const int* tokl;
  DI void a_off(const pg8::Unit&, int R0, int C0, int R1, int C1, unsigned (&vo)[4], int ui) const {
    const int* tk = tokl + ui * 256;
    vo[0] = (unsigned)(tk[R0] * 512 + C0) * 2u; vo[1] = (unsigned)(tk[R1] * 512 + C1) * 2u;
    vo[2] = (unsigned)(tk[128 + R0] * 512 + C0) * 2u; vo[3] = (unsigned)(tk[128 + R1] * 512 + C1) * 2u;
  }
  DI void epi(const f32x4 (&acc)[2][2][4][2], const pg8::Unit& u, int wr, int wc, int fr, int fq) const {
    const int row0 = u.pm * 256 + wr * 64 + fr, col0 = (u.pn & 15) * 128 + wc * 32 + 8 * fq;
    const float dq = 1.f / (F8_H_SCALE * F8_W_SCALE);
#pragma unroll
    for (int ai = 0; ai < 2; ++ai)
#pragma unroll
      for (int m = 0; m < 4; ++m) {
        const f32x4 g0 = acc[ai][0][m][0] * dq, g1 = acc[ai][0][m][1] * dq, u0 = acc[ai][1][m][0] * (dq * F8_HID_SCALE), u1 = acc[ai][1][m][1] * (dq * F8_HID_SCALE);
        uint2 w;
        w.x = pk4_f8(fast_silu(g0[0]) * u0[0], fast_silu(g0[1]) * u0[1], fast_silu(g0[2]) * u0[2], fast_silu(g0[3]) * u0[3]);
        w.y = pk4_f8(fast_silu(g1[0]) * u1[0], fast_silu(g1[1]) * u1[1], fast_silu(g1[2]) * u1[2], fast_silu(g1[3]) * u1[3]);
        *reinterpret_cast<uint2*>(p->hid8() + (size_t)(row0 + ai * 128 + m * 16) * 2048 + col0) = w;
      }
  }
};
DI void ph_moe1(const Params& p, int L, char* smem) {
  CfgMoe1 c; c.K = 512; c.p = &p; c.L = L; c.bid = obid(); c.nb = gridDim.x;
  int* tokl = reinterpret_cast<int*>(smem + 131072);
  c.tokl = tokl;
  for (int idx = otid(); idx < 8 * 256; idx += NTHR) {
    pg8::Unit u;
    if (c.next(idx >> 8, u)) tokl[idx] = p.tok()[u.pm * 256 + (idx & 255)];
  }
  __syncthreads();
  pg8::gemm_phase_f8((pg8::lds_u8*)smem, c);
}
struct CfgMoe2 {
  static constexpr bool PERM = true;
  int K; const Params* p; int L; int bid, nb;
  DI bool next(int i, pg8::Unit& u) const {
    const int t = i * nb + bid; if (t >= 16 * 4 * 8) return false;
    const int rnd = t >> 8, w = t & 255, xcd = w & 7, jx = w >> 3, pid = rnd * 32 + xcd * 4 + (jx >> 3);
    u.pm = (pid >> 2) * 8 + (jx & 7); u.pn = pid; return true;
  }
  DI const char* a_base(const pg8::Unit& u) const { return (const char*)(p->hid8() + (size_t)u.pm * 256 * 2048); }
  DI const char* b_base(const pg8::Unit& u) const { return (const char*)(p->Wd8() + ((size_t)L * 16 * DM + (size_t)u.pn * 256) * 2048); }
  DI void a_off(const pg8::Unit&, int R0, int C0, int R1, int C1, unsigned (&vo)[4], int) const {
    vo[0] = (unsigned)(R0 * 1024 + C0) * 2u; vo[1] = (unsigned)(R1 * 1024 + C1) * 2u;
    vo[2] = vo[0] + 128u * 1024u * 2u; vo[3] = vo[1] + 128u * 1024u * 2u;
  }
  DI void epi(const f32x4 (&acc)[2][2][4][2], const pg8::Unit& u, int wr, int wc, int fr, int fq) const {
    u16* eo = p->proj();
    const int row0 = u.pm * 256 + wr * 64 + fr, col0 = (u.pn & 3) * 256 + wc * 32 + 8 * fq;
#pragma unroll
    for (int ai = 0; ai < 2; ++ai)
#pragma unroll
      for (int m = 0; m < 4; ++m) {
        const int row = row0 + ai * 128 + m * 16;
        const float gt = p->gate()[row] * (1.f / (F8_HID_SCALE * F8_W_SCALE));
#pragma unroll
        for (int bj = 0; bj < 2; ++bj) {
          const f32x4 a0 = acc[ai][bj][m][0], a1 = acc[ai][bj][m][1];
          uint4 w;
          w.x = pack2(gt * a0[0], gt * a0[1]); w.y = pack2(gt * a0[2], gt * a0[3]);
          w.z = pack2(gt * a1[0], gt * a1[1]); w.w = pack2(gt * a1[2], gt * a1[3]);
          *reinterpret_cast<uint4*>(eo + (size_t)row * DM + col0 + bj * 128) = w;
        }
      }
  }
};
DI void ph_moe2(const Params& p, int L, char* smem) {
  CfgMoe2 c; c.K = 1024; c.p = &p; c.L = L; c.bid = obid(); c.nb = gridDim.x;
  pg8::gemm_phase_f8((pg8::lds_u8*)smem, c);
}
template <bool FINAL>
DI void ph_combine_norm(const Params& p, const u16* __restrict__ xa, u16* __restrict__ xnew, const float* __restrict__ w,
                        u16* __restrict__ hn_out, float* __restrict__ f_out) {
  const int tid_ = otid(), lane = tid_ & 63, gw = (obid() * NTHR + tid_) >> 6, nw = gridDim.x * (NTHR / 64);
  const u16* eo = p.proj();
  float4 v[4];
  int myrow = -1;
  if (gw < T) {
#pragma unroll
    for (int i = 0; i < 4; ++i) v[i] = bf4_to_f4(*reinterpret_cast<const uint2*>(xa + (size_t)gw * DM + (i * 64 + lane) * 4));
    myrow = (lane < 16) ? p.inv()[(size_t)gw * 16 + lane] : -1;
  }
  for (int t = gw; t < T; t += nw) {
    uint2 vnx[4];
    const int tn = (t + nw < T) ? (t + nw) : t;
#pragma unroll
    for (int i = 0; i < 4; ++i) vnx[i] = *reinterpret_cast<const uint2*>(xa + (size_t)tn * DM + (i * 64 + lane) * 4);
    const int myrow_nx = (lane < 16) ? p.inv()[(size_t)tn * 16 + lane] : -1;
    unsigned long long mask = __builtin_amdgcn_ballot_w64(myrow >= 0);
#pragma unroll 1
    while (mask != 0ull) {
      const int e0 = __builtin_ctzll(mask);
      mask &= mask - 1ull;
      const int r0 = __builtin_amdgcn_readlane(myrow, e0);
      int r1 = -1;
      if (mask != 0ull) { const int e1 = __builtin_ctzll(mask); mask &= mask - 1ull; r1 = __builtin_amdgcn_readlane(myrow, e1); }
      uint2 q0[4], q1[4];
#pragma unroll
      for (int i = 0; i < 4; ++i) q0[i] = *reinterpret_cast<const uint2*>(eo + (size_t)r0 * DM + (i * 64 + lane) * 4);
      const int r1c = (r1 >= 0) ? r1 : r0;
#pragma unroll
      for (int i = 0; i < 4; ++i) q1[i] = *reinterpret_cast<const uint2*>(eo + (size_t)r1c * DM + (i * 64 + lane) * 4);
      const float s1 = (r1 >= 0) ? 1.f : 0.f;
#pragma unroll
      for (int i = 0; i < 4; ++i) {
        v[i].x += __uint_as_float(q0[i].x << 16); v[i].y += __uint_as_float(q0[i].x & 0xffff0000u);
        v[i].z += __uint_as_float(q0[i].y << 16); v[i].w += __uint_as_float(q0[i].y & 0xffff0000u);
        v[i].x += s1 * __uint_as_float(q1[i].x << 16); v[i].y += s1 * __uint_as_float(q1[i].x & 0xffff0000u);
        v[i].z += s1 * __uint_as_float(q1[i].y << 16); v[i].w += s1 * __uint_as_float(q1[i].y & 0xffff0000u);
      }
    }
    float ss = 0.f;
#pragma unroll
    for (int i = 0; i < 4; ++i) ss += v[i].x * v[i].x + v[i].y * v[i].y + v[i].z * v[i].z + v[i].w * v[i].w;
    ss = wave_sum(ss);
    const float rstd = rsqrtf(ss * (1.f / DM) + 1e-6f);
#pragma unroll
    for (int i = 0; i < 4; ++i) {
      const int c = (i * 64 + lane) * 4;
      const float4 ww = *reinterpret_cast<const float4*>(w + c);
      if (FINAL) {
        *reinterpret_cast<float4*>(f_out + (size_t)t * DM + c) = make_float4(v[i].x * rstd * ww.x, v[i].y * rstd * ww.y, v[i].z * rstd * ww.z, v[i].w * rstd * ww.w);
      } else {
        uint2 xo;
        xo.x = pack2(v[i].x, v[i].y); xo.y = pack2(v[i].z, v[i].w);
        *reinterpret_cast<uint2*>(xnew + (size_t)t * DM + c) = xo;
        uint2 o;
        o.x = pack2(v[i].x * rstd * ww.x, v[i].y * rstd * ww.y);
        o.y = pack2(v[i].z * rstd * ww.z, v[i].w * rstd * ww.w);
        *reinterpret_cast<uint2*>(hn_out + (size_t)t * DM + c) = o;
      }
    }
#pragma unroll
    for (int i = 0; i < 4; ++i) v[i] = bf4_to_f4(vnx[i]);
    myrow = myrow_nx;
  }
}

__global__ void __launch_bounds__(NTHR) mk(Params p) {
  extern __shared__ __attribute__((aligned(16))) char smem[];
  cg::grid_group grid = cg::this_grid();
  __shared__ uint4 xb_words;
  if (threadIdx.x == 0) xb_words = make_uint4(0u, 0u, 0u, 0u);
  __syncthreads();
  XcdBarrier xb = xcd_barrier_post(p.bar(), (volatile LAS unsigned*)&xb_words);
  ph_convert(p, smem);
  ph_rmsnorm_bf16(p.x, p.ln1_w, p.hn());
  xcd_barrier(xb);
  if (p.rep[12] == 0x7fffffff) grid.sync();
  for (int L = 0; L < 2; ++L) {
    u16* xout = p.xres();
    if (L == 1) {
      ph_combine_norm<false>(p, p.xres(), p.xres2(), p.ln1_w + DM, p.hn(), nullptr);
      xcd_barrier(xb);
    }
    ph_inproj(p, L, smem);
    xcd_barrier(xb);
    ph_post(p, L);
    xcd_barrier(xb);
    {
      unsigned* ctr = p.bar() + XCD_BAR_WORDS + 8 + L;
      __shared__ int q1_item;
      for (;;) {
        if (threadIdx.x == 0) q1_item = (int)atomicAdd(ctr, 1u);
        __syncthreads();
        const int it = q1_item;
        __syncthreads();
        if (it >= 1344) break;
        if (it < 256) ph_dil_pass<0>(p, smem, it);
        else if (it < 384) ph_ssd_a(p, L, smem, it - 256);
        else if (it < 576) ph_mla_up_q(p, L, smem, it - 384);
        else if (it < 832) ph_mla_up_kv(p, L, smem, it - 576);
        else ph_ret_a(p, smem, it - 832);
      }
    }
    xcd_barrier(xb);
    {
      { ph_ret_scan(p); ph_ssd_scan(p); }
      ph_mla_attn(p, smem, L);
      for (int bi = obid(); bi < 256; bi += gridDim.x) ph_dil_pass<1>(p, smem, bi);
    }
    xcd_barrier(xb);
    {
      unsigned* ctr = p.bar() + XCD_BAR_WORDS + L;
      __shared__ int q_item;
      for (;;) {
        if (threadIdx.x == 0) q_item = (int)atomicAdd(ctr, 1u);
        __syncthreads();
        const int it = q_item;
        __syncthreads();
        if (it >= 640) break;
        if (it < 128) ph_ssd_c(p, L, smem, it);
        else ph_ret_c(p, smem, it - 128);
      }
    }
    xcd_barrier(xb);
    ph_outproj(p, L, smem);
    xcd_barrier(xb);
    ph_rms2_router(p, L, xout, smem);
    xcd_barrier(xb);
    ph_topk(p, smem);
    if (gridDim.x == 256 && obid() >= CVT_IDLE_FIRST_BLK) cvt_tiles_idle(p, L, smem, CVT_A, CVT_NB);
    xcd_barrier(xb);
    ph_moe1(p, L, smem);
    xcd_barrier(xb);
    ph_moe2(p, L, smem);
    xcd_barrier(xb);
  }
  ph_combine_norm<true>(p, p.xres(), nullptr, p.final_w, nullptr, p.out);
}

extern "C" void kernel_launch(void* const* d_in, const int* in_sizes, int n_in, void* d_out, int out_size, void* d_ws,
                              size_t ws_size, hipStream_t stream) {
  static int grid_blocks = 0;
  if (!grid_blocks) {
    int dev = 0, cus = 0, per_cu = 0;
    (void)hipGetDevice(&dev);
    (void)hipDeviceGetAttribute(&cus, hipDeviceAttributeMultiprocessorCount, dev);
    (void)hipFuncSetAttribute((const void*)mk, hipFuncAttributeMaxDynamicSharedMemorySize, LDS_BYTES);
    (void)hipOccupancyMaxActiveBlocksPerMultiprocessor(&per_cu, (const void*)mk, NTHR, LDS_BYTES);
    if (per_cu < 1) { fprintf(stderr, "occupancy query says %d blocks/CU\n", per_cu); per_cu = 1; }
    grid_blocks = cus * 1;
  }
  Params p{};
  const float** fp = reinterpret_cast<const float**>(&p);
  for (int i = 0; i < 20; ++i) fp[i] = (const float*)d_in[i];
  p.out = (float*)d_out;
  p.ws = (char*)d_ws;
  const size_t off = WSO.total;
  { const int reps[16] = REPS_INIT; for (int i = 0; i < 16; ++i) p.rep[i] = reps[i]; }
  if (off > ws_size) { fprintf(stderr, "workspace too small: need %zu have %zu\n", off, ws_size); return; }
  (void)hipMemsetAsync(p.bar(), 0, (size_t)(XCD_BAR_WORDS + 64) * 4, stream);
  void* args[] = {&p};
  hipError_t e = hipLaunchCooperativeKernel((void*)mk, dim3(grid_blocks), dim3(NTHR), args, LDS_BYTES, stream);
  if (e != hipSuccess) fprintf(stderr, "cooperative launch failed: %s (grid %d)\n", hipGetErrorString(e), grid_blocks);
}
```

```cpp
#include <hip/hip_runtime.h>
#include <hip/hip_cooperative_groups.h>
#include <cstdio>
#include <cstdint>
namespace cg = cooperative_groups;

#define DI __device__ __forceinline__
typedef unsigned short u16;
typedef __attribute__((ext_vector_type(8))) short bf16x8;
typedef __attribute__((ext_vector_type(4))) float f32x4;

#ifndef REPS_INIT
#define REPS_INIT {1, 1, 1, 1, 1, 1, 1, 1, 1, 1, 1, 1, 0, 1, 1, 1}
#endif
constexpr int NTHR = 512;
constexpr int T = 16384, SEQ = 4096, DM = 1024;
constexpr int PW = 3240, PWP = 3328;
constexpr int C_RQ = 0, C_RK = 256, C_RV = 512, C_RG = 768, C_CQ = 1024, C_CKV = 1280, C_KR = 1408,
              C_Z = 1440, C_XBC = 1696, C_DT = 2464, C_DQ = 2472, C_DK = 2728, C_DV = 2984;
constexpr int LDS_BYTES = 131072 + 8192;

struct WsOff {
  size_t WinT;
  size_t WuqT;
  size_t WukvT;
  size_t WoutT;
  size_t Wgu8;
  size_t Wd8;
  size_t hn8;
  size_t xres;
  size_t hn;
  size_t proj;
  size_t cqn;
  size_t ckvn;
  size_t mq;
  size_t xbc;
  size_t mixed;
  size_t hid8;
  size_t kfull;
  size_t rS;
  size_t sS;
  size_t rU;
  size_t sU;
  size_t cdec;
  size_t vT;
  size_t rtab;
  size_t dpart;
  size_t dtv;
  size_t cs;
  size_t ybuf;
  size_t aff;
  size_t gate;
  size_t tok;
  size_t inv;
  size_t bar;
  size_t xres2;
  size_t total;
};
constexpr WsOff ws_layout() {
  WsOff o{};
  size_t off = 0;
  o.WinT = off; off += (((size_t)2 * PWP * DM * 2) + 255) & ~(size_t)255;
  o.WuqT = off; off += (((size_t)2 * 384 * 256 * 2) + 255) & ~(size_t)255;
  o.WukvT = off; off += (((size_t)2 * 512 * 128 * 2) + 255) & ~(size_t)255;
  o.WoutT = off; off += (((size_t)2 * DM * DM * 2) + 255) & ~(size_t)255;
  o.Wgu8 = off; off += (((size_t)2 * 16 * 4096 * DM) + 255) & ~(size_t)255;
  o.Wd8 = off; off += (((size_t)2 * 16 * DM * 2048) + 255) & ~(size_t)255;
  o.hn8 = off; off += (((size_t)T * DM) + 255) & ~(size_t)255;
  o.xres = off; off += (((size_t)T * DM * 2) + 255) & ~(size_t)255;
  o.hn = off; off += (((size_t)T * DM * 2) + 255) & ~(size_t)255;
  o.proj = off; off += (((size_t)T * PWP * 2) + 255) & ~(size_t)255;
  o.cqn = off; off += (((size_t)T * 256 * 2) + 255) & ~(size_t)255;
  o.ckvn = off; off += (((size_t)T * 128 * 2) + 255) & ~(size_t)255;
  o.mq = off; off += (((size_t)T * 384 * 2) + 255) & ~(size_t)255;
  o.xbc = off; off += (((size_t)T * 768 * 2) + 255) & ~(size_t)255;
  o.mixed = off; off += (((size_t)T * DM * 2) + 255) & ~(size_t)255;
  o.hid8 = off; off += (((size_t)32768 * 2048) + 255) & ~(size_t)255;
  o.kfull = off; off += (((size_t)T * 4 * 96 * 2) + 255) & ~(size_t)255;
  o.rS = off; off += (((size_t)16 * 32 * 2 * 4096 * 2) + 255) & ~(size_t)255;
  o.sS = off; off += (((size_t)128 * 8 * 8192 * 2) + 255) & ~(size_t)255;
  o.rU = off; off += (((size_t)16 * 32 * 2 * 4096 * 4) + 255) & ~(size_t)255;
  o.sU = off; off += (((size_t)128 * 8 * 8192 * 4) + 255) & ~(size_t)255;
  o.cdec = off; off += (((size_t)128 * 8 * 4) + 255) & ~(size_t)255;
  o.vT = off; off += (((size_t)T * 4 * 64 * 2) + 255) & ~(size_t)255;
  o.rtab = off; off += (((size_t)SEQ * 56 * 2 * 4) + 255) & ~(size_t)255;
  o.dpart = off; off += (((size_t)T * 4 * 68 * 4) + 255) & ~(size_t)255;
  o.dtv = off; off += (((size_t)T * 8 * 4) + 255) & ~(size_t)255;
  o.cs = off; off += (((size_t)T * 8 * 4) + 255) & ~(size_t)255;
  o.ybuf = off; off += (((size_t)T * 256 * 4) + 255) & ~(size_t)255;
  o.aff = off; off += (((size_t)T * 16 * 4) + 255) & ~(size_t)255;
  o.gate = off; off += (((size_t)64 * 512 * 4) + 255) & ~(size_t)255;
  o.tok = off; off += (((size_t)64 * 512 * 4) + 255) & ~(size_t)255;
  o.inv = off; off += (((size_t)T * 16 * 4) + 255) & ~(size_t)255;
  o.bar = off; off += (((size_t)(3456 + 64) * 4) + 255) & ~(size_t)255;
  o.xres2 = off; off += (((size_t)T * DM * 2) + 255) & ~(size_t)255;
  o.total = off;
  return o;
}
constexpr WsOff WSO = ws_layout();
struct Params {
  const float *x, *ln1_w, *w_in, *q_norm_w, *kv_norm_w, *w_uq, *w_ukv, *conv_w, *conv_b, *a_log, *dt_bias,
      *ssm_d, *ssm_norm_w, *w_out, *ln2_w, *router_w, *w_gate, *w_up, *w_down, *final_w;
  float* out;
  char* ws;
  int rep[16];
  __host__ DI u16* WinT() const { return reinterpret_cast<u16*>(ws + WSO.WinT); }
  __host__ DI u16* WuqT() const { return reinterpret_cast<u16*>(ws + WSO.WuqT); }
  __host__ DI u16* WukvT() const { return reinterpret_cast<u16*>(ws + WSO.WukvT); }
  __host__ DI u16* WoutT() const { return reinterpret_cast<u16*>(ws + WSO.WoutT); }
  __host__ DI unsigned char* Wgu8() const { return reinterpret_cast<unsigned char*>(ws + WSO.Wgu8); }
  __host__ DI unsigned char* Wd8() const { return reinterpret_cast<unsigned char*>(ws + WSO.Wd8); }
  __host__ DI unsigned char* hn8() const { return reinterpret_cast<unsigned char*>(ws + WSO.hn8); }
  __host__ DI u16* xres() const { return reinterpret_cast<u16*>(ws + WSO.xres); }
  __host__ DI u16* hn() const { return reinterpret_cast<u16*>(ws + WSO.hn); }
  __host__ DI u16* proj() const { return reinterpret_cast<u16*>(ws + WSO.proj); }
  __host__ DI u16* cqn() const { return reinterpret_cast<u16*>(ws + WSO.cqn); }
  __host__ DI u16* ckvn() const { return reinterpret_cast<u16*>(ws + WSO.ckvn); }
  __host__ DI u16* mq() const { return reinterpret_cast<u16*>(ws + WSO.mq); }
  __host__ DI u16* xbc() const { return reinterpret_cast<u16*>(ws + WSO.xbc); }
  __host__ DI u16* mixed() const { return reinterpret_cast<u16*>(ws + WSO.mixed); }
  __host__ DI unsigned char* hid8() const { return reinterpret_cast<unsigned char*>(ws + WSO.hid8); }
  __host__ DI u16* kfull() const { return reinterpret_cast<u16*>(ws + WSO.kfull); }
  __host__ DI u16* rS() const { return reinterpret_cast<u16*>(ws + WSO.rS); }
  __host__ DI u16* sS() const { return reinterpret_cast<u16*>(ws + WSO.sS); }
  __host__ DI float* rU() const { return reinterpret_cast<float*>(ws + WSO.rU); }
  __host__ DI float* sU() const { return reinterpret_cast<float*>(ws + WSO.sU); }
  __host__ DI float* cdec() const { return reinterpret_cast<float*>(ws + WSO.cdec); }
  __host__ DI u16* vT() const { return reinterpret_cast<u16*>(ws + WSO.vT); }
  __host__ DI float* rtab() const { return reinterpret_cast<float*>(ws + WSO.rtab); }
  __host__ DI float* dpart() const { return reinterpret_cast<float*>(ws + WSO.dpart); }
  __host__ DI float* dtv() const { return reinterpret_cast<float*>(ws + WSO.dtv); }
  __host__ DI float* cs() const { return reinterpret_cast<float*>(ws + WSO.cs); }
  __host__ DI float* ybuf() const { return reinterpret_cast<float*>(ws + WSO.ybuf); }
  __host__ DI float* aff() const { return reinterpret_cast<float*>(ws + WSO.aff); }
  __host__ DI float* gate() const { return reinterpret_cast<float*>(ws + WSO.gate); }
  __host__ DI int* tok() const { return reinterpret_cast<int*>(ws + WSO.tok); }
  __host__ DI int* inv() const { return reinterpret_cast<int*>(ws + WSO.inv); }
  __host__ DI unsigned* bar() const { return reinterpret_cast<unsigned*>(ws + WSO.bar); }
  __host__ DI u16* xres2() const { return reinterpret_cast<u16*>(ws + WSO.xres2); }
};


typedef __attribute__((ext_vector_type(2))) __bf16 bf16x2_t;
typedef __attribute__((ext_vector_type(2))) float f32x2_t;
typedef __attribute__((ext_vector_type(16))) float f32x16;
typedef __attribute__((ext_vector_type(4))) short s16x4;
typedef __attribute__((ext_vector_type(8))) int i32x8;
typedef __attribute__((ext_vector_type(4))) int i32x4;
DI unsigned pack2(float a, float b) {
  f32x2_t v = {a, b};
  return __builtin_bit_cast(unsigned, __builtin_convertvector(v, bf16x2_t));
}
DI u16 f2bf(float f) { return (u16)(pack2(f, 0.f) & 0xffffu); }
DI float bf2f(u16 h) { return __uint_as_float(((unsigned)h) << 16); }
DI void unpack8(const uint4& v, float* f) {
  f[0] = __uint_as_float(v.x << 16); f[1] = __uint_as_float(v.x & 0xffff0000u);
  f[2] = __uint_as_float(v.y << 16); f[3] = __uint_as_float(v.y & 0xffff0000u);
  f[4] = __uint_as_float(v.z << 16); f[5] = __uint_as_float(v.z & 0xffff0000u);
  f[6] = __uint_as_float(v.w << 16); f[7] = __uint_as_float(v.w & 0xffff0000u);
}
DI void ld8(const u16* p, float* f) { uint4 v = *reinterpret_cast<const uint4*>(p); unpack8(v, f); }
DI unsigned pk4_f8(float a, float b, float c, float d) {
  a = __builtin_amdgcn_fmed3f(a, -448.f, 448.f); b = __builtin_amdgcn_fmed3f(b, -448.f, 448.f);
  c = __builtin_amdgcn_fmed3f(c, -448.f, 448.f); d = __builtin_amdgcn_fmed3f(d, -448.f, 448.f);
  int w = __builtin_amdgcn_cvt_pk_fp8_f32(a, b, 0, false);
  w = __builtin_amdgcn_cvt_pk_fp8_f32(c, d, w, true);
  return (unsigned)w;
}
constexpr float F8_W_SCALE = 256.f, F8_H_SCALE = 16.f, F8_HID_SCALE = 8.f;
typedef short s16x2_t __attribute__((ext_vector_type(2)));
template <int SCALE> DI unsigned pk4_f8_scaled(float a, float b, float c, float d) {
  constexpr float inv = 1.f / (float)SCALE;
  s16x2_t r = {0, 0};
  r = __builtin_amdgcn_cvt_scalef32_pk_fp8_f32(r, a, b, inv, false);
  r = __builtin_amdgcn_cvt_scalef32_pk_fp8_f32(r, c, d, inv, true);
  return __builtin_bit_cast(unsigned, r);
}
DI float4 bf4_to_f4(const uint2& q) {
  return make_float4(__uint_as_float(q.x << 16), __uint_as_float(q.x & 0xffff0000u), __uint_as_float(q.y << 16), __uint_as_float(q.y & 0xffff0000u));
}
DI float wave_sum(float v) {
#pragma unroll
  for (int o = 32; o > 0; o >>= 1) v += __shfl_xor(v, o);
  return v;
}
DI float dot2acc(unsigned a, unsigned b, float c) {
  return __builtin_amdgcn_fdot2_f32_bf16(__builtin_bit_cast(bf16x2_t, a), __builtin_bit_cast(bf16x2_t, b), c, false);
}
DI float dot8(const uint4& a, const uint4& b, float c) {
  c = dot2acc(a.x, b.x, c); c = dot2acc(a.y, b.y, c); c = dot2acc(a.z, b.z, c); c = dot2acc(a.w, b.w, c);
  return c;
}
DI int otid() { int t = threadIdx.x; asm volatile("" : "+v"(t)); return t; }
DI int obid() { int b = blockIdx.x; asm volatile("" : "+s"(b)); return b; }
DI float silu(float x) { return x / (1.f + __expf(-x)); }
DI float fast_silu(float x) { return x * __builtin_amdgcn_rcpf(1.f + __expf(-x)); }


#define XB_TMO      128
#define XB_XCNT(j)  (256  + 64 * (j))
#define XB_XSUB(j)  (1280 + 64 * (j))
#define XB_XGEN(j)  (2304 + 64 * (j))
#define XB_TOP      3328
#define XB_TOPGEN   3392
#define XCD_BAR_WORDS 3456
#define XB_SPIN_CAP (1u << 20)
#define LAS __attribute__((address_space(3)))
DI unsigned xb_ld(unsigned* p) { return __hip_atomic_load(p, __ATOMIC_RELAXED, __HIP_MEMORY_SCOPE_AGENT); }
DI unsigned xb_add(unsigned* p, unsigned v) { return __hip_atomic_fetch_add(p, v, __ATOMIC_RELAXED, __HIP_MEMORY_SCOPE_AGENT); }
DI unsigned xb_xcc_id() { return (unsigned)__builtin_amdgcn_s_getreg((3 << 11) | 20) & 0xFu; }
#define XB_SPIN(cond, bar) do { unsigned _sp = 0; while (cond) { __builtin_amdgcn_s_sleep(1); \
    if ((++_sp & 255u) == 0u) { if (xb_ld(&(bar)[XB_TMO])) break; if (_sp > XB_SPIN_CAP) { atomicAdd(&(bar)[XB_TMO], 1u); break; } } } } while (0)
struct XcdBarrier { unsigned* bar; unsigned x; volatile LAS unsigned* st; };
DI XcdBarrier xcd_barrier_post(unsigned* bar, volatile LAS unsigned* st) {
  XcdBarrier b; b.bar = bar; b.x = xb_xcc_id(); b.st = st;
  if (threadIdx.x == 0) (void)xb_add(&bar[XB_XCNT(b.x)], 1u);
  return b;
}
DI void xcd_barrier_complete(unsigned* bar, unsigned x, unsigned& nloc, unsigned& nx) {
  const unsigned G = gridDim.x * gridDim.y * gridDim.z;
  unsigned sum, cnt, mine, sp = 0u;
  for (;;) {
    sum = 0u; cnt = 0u; mine = 0u;
#pragma unroll
    for (unsigned j = 0; j < 16; ++j) { const unsigned c = xb_ld(&bar[XB_XCNT(j)]); sum += c; cnt += (c > 0u) ? 1u : 0u; mine = (j == x) ? c : mine; }
    if (sum == G) break;
    __builtin_amdgcn_s_sleep(1);
    if ((++sp & 255u) == 0u) { if (xb_ld(&bar[XB_TMO])) break; if (sp > XB_SPIN_CAP) { atomicAdd(&bar[XB_TMO], 1u); break; } }
  }
  nloc = mine > 0u ? mine : 1u; nx = cnt > 0u ? cnt : 1u;
}
DI void xcd_barrier(const XcdBarrier& b) {
  asm volatile("s_waitcnt vmcnt(0)" ::: "memory");
  __syncthreads();
  if (threadIdx.x == 0) {
    unsigned* bar = b.bar;
    __builtin_amdgcn_s_waitcnt(0);
    unsigned nloc = b.st[0], nx = b.st[1];
    if (nloc == 0u) { xcd_barrier_complete(bar, b.x, nloc, nx); b.st[0] = nloc; b.st[1] = nx; }
    const unsigned old = xb_add(&bar[XB_XSUB(b.x)], 1u);
    const unsigned gen = old / nloc;
    if (old + 1u == (gen + 1u) * nloc) {
      __builtin_amdgcn_fence(__ATOMIC_RELEASE, "agent");
      asm volatile("s_waitcnt vmcnt(0)" ::: "memory");
      const unsigned og = xb_add(&bar[XB_TOP], 1u);
      const unsigned tg = og / nx;
      if (og + 1u == (tg + 1u) * nx) xb_add(&bar[XB_TOPGEN], 1u);
      else XB_SPIN(xb_ld(&bar[XB_TOPGEN]) == tg, bar);
      __builtin_amdgcn_fence(__ATOMIC_ACQUIRE, "agent");
      xb_add(&bar[XB_XGEN(b.x)], 1u);
      asm volatile("s_waitcnt vmcnt(0)" ::: "memory");
    } else {
      XB_SPIN(xb_ld(&bar[XB_XGEN(b.x)]) == gen, bar);
      __builtin_amdgcn_fence(__ATOMIC_ACQUIRE, "agent");
      asm volatile("s_waitcnt vmcnt(0)" ::: "memory");
    }
  }
  __syncthreads();
}

template <class F>
DI void transpose_convert(const float* __restrict__ src, int K, int N, int Npad, u16* __restrict__ dst, F rowmap,
                          int bid, int nb, char* smem) {
  u16* tile = reinterpret_cast<u16*>(smem);
  const int tid = otid();
  const int ntn = Npad / 128, ntk = K / 64;
  for (int t = bid; t < ntn * ntk; t += nb) {
    const int n0 = (t % ntn) * 128, k0 = (t / ntn) * 64;
    f32x4 v[4];
#pragma unroll
    for (int i = 0; i < 4; ++i) {
      const int kk = (tid >> 5) + 16 * i, nn = (tid & 31) * 4;
      v[i] = f32x4{0.f, 0.f, 0.f, 0.f};
      if (n0 + nn < N) v[i] = __builtin_nontemporal_load(reinterpret_cast<const f32x4*>(src + (size_t)(k0 + kk) * N + n0 + nn));
    }
#pragma unroll
    for (int i = 0; i < 4; ++i) {
      const int kk = (tid >> 5) + 16 * i, nn = (tid & 31) * 4;
      tile[(nn + 0) * 72 + kk] = f2bf(v[i][0]); tile[(nn + 1) * 72 + kk] = f2bf(v[i][1]);
      tile[(nn + 2) * 72 + kk] = f2bf(v[i][2]); tile[(nn + 3) * 72 + kk] = f2bf(v[i][3]);
    }
    __syncthreads();
#pragma unroll
    for (int j = 0; j < 2; ++j) {
      const int c = tid + NTHR * j, nn = c >> 3, k8 = (c & 7) * 8;
      const uint4 o = *reinterpret_cast<const uint4*>(tile + nn * 72 + k8);
      *reinterpret_cast<uint4*>(dst + (size_t)rowmap(n0 + nn) * K + k0 + k8) = o;
    }
    __syncthreads();
  }
}

template <class F>
DI void transpose_convert_f8(const float* __restrict__ src, int K, int N, unsigned char* __restrict__ dst, F rowmap,
                             int bid, int nb, char* smem) {
  unsigned char* tile = reinterpret_cast<unsigned char*>(smem);
  const int tid = otid();
  const int ntn = N / 128, ntk = K / 64;
  for (int t = bid; t < ntn * ntk; t += nb) {
    const int n0 = (t % ntn) * 128, k0 = (t / ntn) * 64;
    const int kq = (tid >> 5) * 4, nn = (tid & 31) * 4;
    f32x4 v[4];
#pragma unroll
    for (int r = 0; r < 4; ++r) v[r] = __builtin_nontemporal_load(reinterpret_cast<const f32x4*>(src + (size_t)(k0 + kq + r) * N + n0 + nn));
#pragma unroll
    for (int e = 0; e < 4; ++e)
      *reinterpret_cast<unsigned*>(tile + (nn + e) * 80 + kq) =
          pk4_f8(v[0][e] * F8_W_SCALE, v[1][e] * F8_W_SCALE, v[2][e] * F8_W_SCALE, v[3][e] * F8_W_SCALE);
    __syncthreads();
    {
      const int rn = tid >> 2, kc = (tid & 3) * 16;
      const uint4 o = *reinterpret_cast<const uint4*>(tile + rn * 80 + kc);
      *reinterpret_cast<uint4*>(dst + (size_t)rowmap(n0 + rn) * K + k0 + kc) = o;
    }
    __syncthreads();
  }
}

constexpr int CVT_IN_MLA_E = 16;
struct CvtTile { const float* src; unsigned char* dst; int N, K, n0, k0, mat; };
DI CvtTile cvt_tile(const Params& p, int L, int g) {
  const int e = g / 768, r = g - e * 768, mat = r >> 8, tt = r & 255;
  const size_t le = (size_t)(L * 16 + e);
  CvtTile c;
  c.mat = mat;
  if (mat < 2) { c.src = ((mat == 0) ? p.w_gate : p.w_up) + le * DM * 2048; c.N = 2048; c.dst = p.Wgu8() + le * 4096 * DM; c.K = 1024; c.n0 = (tt & 15) * 128; c.k0 = (tt >> 4) * 64; }
  else { c.src = p.w_down + le * 2048 * DM; c.N = 1024; c.dst = p.Wd8() + le * DM * 2048; c.K = 2048; c.n0 = (tt & 7) * 128; c.k0 = (tt >> 3) * 64; }
  return c;
}
DI int cvt_rowmap(int mat, int n) { return (mat == 2) ? n : ((n >> 7) * 256 + (mat == 1 ? 128 : 0) + (n & 127)); }

constexpr int CVT_IDLE_FIRST_BLK = 64, CVT_IDLE_BLKS = 192;
constexpr int CVT_NA = 16, CVT_NB = 12;
constexpr int CVT_A = CVT_IDLE_BLKS * CVT_NA, CVT_B = CVT_A + CVT_IDLE_BLKS * CVT_NB;
static_assert(CVT_B + 32 * 256 >= 12288 && CVT_B <= 12288, "the MLA loop (one tile per 128-key iteration, 32 iterations) must cover the rest");
DI void cvt_tiles_idle(const Params& p, int L, char* smem, int first, int per_blk) {
  const int tid = otid(), ib = obid() - CVT_IDLE_FIRST_BLK;
  unsigned char* tile = reinterpret_cast<unsigned char*>(smem);
  __syncthreads();
#pragma unroll 1
  for (int i = 0; i < per_blk; i += 2) {
    f32x4 v[2][4];
#pragma unroll
    for (int u = 0; u < 2; ++u) {
      const CvtTile ct = cvt_tile(p, L, first + ib + CVT_IDLE_BLKS * (i + u));
      const float* sp = ct.src + (size_t)(ct.k0 + (tid >> 5) * 4) * ct.N + ct.n0 + (tid & 31) * 4;
#pragma unroll
      for (int r = 0; r < 4; ++r) v[u][r] = __builtin_nontemporal_load(reinterpret_cast<const f32x4*>(sp + (size_t)r * ct.N));
    }
#pragma unroll
    for (int u = 0; u < 2; ++u) {
      unsigned char* cb = tile + u * 10240 + (tid & 31) * 4 * 80 + (tid >> 5) * 4;
#pragma unroll
      for (int c = 0; c < 4; ++c) *reinterpret_cast<unsigned*>(cb + c * 80) = pk4_f8_scaled<256>(v[u][0][c], v[u][1][c], v[u][2][c], v[u][3][c]);
    }
    __syncthreads();
#pragma unroll
    for (int u = 0; u < 2; ++u) {
      const CvtTile ct = cvt_tile(p, L, first + ib + CVT_IDLE_BLKS * (i + u));
      unsigned char* cd = ct.dst + (size_t)cvt_rowmap(ct.mat, ct.n0 + (tid >> 2)) * ct.K + ct.k0 + (tid & 3) * 16;
      *reinterpret_cast<uint4*>(cd) = *reinterpret_cast<const uint4*>(tile + u * 10240 + (tid >> 2) * 80 + (tid & 3) * 16);
    }
    __syncthreads();
  }
}

DI void ph_convert(const Params& p, char* smem) {
  const int nb = gridDim.x;
  int bid = obid();
  for (int idx = bid * NTHR + otid(); idx < SEQ * 56; idx += nb * NTHR) {
    const int pos = idx / 56, f = idx - pos * 56;
    float inv;
    if (f < 32) inv = exp2f(-(float)f * (13.287712379549449f / 32.f));
    else if (f < 40) inv = exp2f(-(float)(f - 32) * (18.931568569324174f / 8.f));
    else inv = exp2f(-(float)(f - 40) * (18.931568569324174f / 16.f));
    float sn, cs;
    sincosf((float)pos * inv, &sn, &cs);
    p.rtab()[(size_t)idx * 2] = cs;
    p.rtab()[(size_t)idx * 2 + 1] = sn;
  }
  auto ident = [](int n) { return n; };
  for (int L = 0; L < 2; ++L) {
    transpose_convert(p.w_in + (size_t)L * DM * PW, DM, PW, PWP, p.WinT() + (size_t)L * PWP * DM, ident, bid, nb, smem);
    transpose_convert(p.w_uq + (size_t)L * 256 * 384, 256, 384, 384, p.WuqT() + (size_t)L * 384 * 256, ident, bid, nb, smem);
    transpose_convert(p.w_ukv + (size_t)L * 128 * 512, 128, 512, 512, p.WukvT() + (size_t)L * 512 * 128, ident, bid, nb, smem);
    transpose_convert(p.w_out + (size_t)L * DM * DM, DM, DM, DM, p.WoutT() + (size_t)L * DM * DM, ident, bid, nb, smem);
    for (int e = ((nb == 256) ? CVT_IN_MLA_E : 0); e < 16; ++e) {
      const size_t le = (size_t)(L * 16 + e);
      auto gmap = [](int n) { return (n >> 7) * 256 + (n & 127); };
      auto umap = [](int n) { return (n >> 7) * 256 + 128 + (n & 127); };
      transpose_convert_f8(p.w_gate + le * DM * 2048, DM, 2048, p.Wgu8() + le * 4096 * DM, gmap, bid, nb, smem);
      transpose_convert_f8(p.w_up + le * DM * 2048, DM, 2048, p.Wgu8() + le * 4096 * DM, umap, bid, nb, smem);
      transpose_convert_f8(p.w_down + le * 2048 * DM, 2048, DM, p.Wd8() + le * DM * 2048, ident, bid, nb, smem);
    }
  }
}

template <class RowPtr, class Epi>
DI void gemm_tile(RowPtr arow, const u16* __restrict__ bt, int ldb, int K, char* smem, Epi epi) {
  u16* sa = reinterpret_cast<u16*>(smem);
  u16* sb = sa + 2 * 256 * 72;
  const int tid = otid(), wid = tid >> 6, lane = tid & 63, wr = wid >> 1, wc = wid & 1, fr = lane & 15, fq = lane >> 4;
  f32x4 acc[4][4];
#pragma unroll
  for (int m = 0; m < 4; ++m)
#pragma unroll
    for (int n = 0; n < 4; ++n) acc[m][n] = f32x4{0.f, 0.f, 0.f, 0.f};
  const int lr = tid >> 3, lc = (tid & 7) * 8;
  const u16* ap[4];
#pragma unroll
  for (int i = 0; i < 4; ++i) ap[i] = arow(lr + 64 * i) + lc;
  const u16* bp[2];
#pragma unroll
  for (int i = 0; i < 2; ++i) bp[i] = bt + (size_t)(lr + 64 * i) * ldb + lc;
  uint4 ra[4], rb[2];
  const int nk = K / 64;
#pragma unroll
  for (int i = 0; i < 4; ++i) ra[i] = *reinterpret_cast<const uint4*>(ap[i]);
#pragma unroll
  for (int i = 0; i < 2; ++i) rb[i] = *reinterpret_cast<const uint4*>(bp[i]);
#pragma unroll
  for (int i = 0; i < 4; ++i) *reinterpret_cast<uint4*>(sa + (lr + 64 * i) * 72 + lc) = ra[i];
#pragma unroll
  for (int i = 0; i < 2; ++i) *reinterpret_cast<uint4*>(sb + (lr + 64 * i) * 72 + lc) = rb[i];
  __syncthreads();
  for (int kt = 0; kt < nk; ++kt) {
    const int cur = kt & 1;
    if (kt + 1 < nk) {
#pragma unroll
      for (int i = 0; i < 4; ++i) ra[i] = *reinterpret_cast<const uint4*>(ap[i] + (kt + 1) * 64);
#pragma unroll
      for (int i = 0; i < 2; ++i) rb[i] = *reinterpret_cast<const uint4*>(bp[i] + (kt + 1) * 64);
    }
    const u16* ca = sa + cur * 256 * 72;
    const u16* cb = sb + cur * 128 * 72;
#pragma unroll
    for (int kk = 0; kk < 2; ++kk) {
      bf16x8 af[4], bfr[4];
#pragma unroll
      for (int m = 0; m < 4; ++m) af[m] = *reinterpret_cast<const bf16x8*>(ca + (wr * 64 + m * 16 + fr) * 72 + kk * 32 + fq * 8);
#pragma unroll
      for (int n = 0; n < 4; ++n) bfr[n] = *reinterpret_cast<const bf16x8*>(cb + (wc * 64 + n * 16 + fr) * 72 + kk * 32 + fq * 8);
#pragma unroll
      for (int m = 0; m < 4; ++m)
#pragma unroll
        for (int n = 0; n < 4; ++n) acc[m][n] = __builtin_amdgcn_mfma_f32_16x16x32_bf16(af[m], bfr[n], acc[m][n], 0, 0, 0);
    }
    if (kt + 1 < nk) {
      u16* na = sa + (cur ^ 1) * 256 * 72;
      u16* nbp = sb + (cur ^ 1) * 128 * 72;
#pragma unroll
      for (int i = 0; i < 4; ++i) *reinterpret_cast<uint4*>(na + (lr + 64 * i) * 72 + lc) = ra[i];
#pragma unroll
      for (int i = 0; i < 2; ++i) *reinterpret_cast<uint4*>(nbp + (lr + 64 * i) * 72 + lc) = rb[i];
    }
    __syncthreads();
  }
  epi(acc, wr, wc, fr, fq);
}

#define WAIT_V(n) asm volatile("s_waitcnt vmcnt(%0)" ::"n"(n) : "memory")
DI int lds_byte2(int r, int c) {
  const int st = (r >> 4) * 2 + (c >> 5), ob = (r & 15) * 64 + (c & 31) * 2;
  return st * 1024 + (ob ^ (((ob >> 9) & 1) << 5));
}
DI void stage_rc2(int b, int& R, int& C) {
  const int st = b >> 10, sb = b & 1023, swz = sb ^ (((sb >> 9) & 1) << 5);
  R = (st >> 1) * 16 + swz / 64;
  C = (st & 1) * 32 + (swz % 64) / 2;
}
typedef __attribute__((address_space(3))) unsigned lds_u32;
template <class RowPtr, class Epi>
DI void gemm256(RowPtr arow, const u16* __restrict__ bt, int ldb, int K, char* smem, Epi epi) {
  constexpr int TILE_B = 256 * 64 * 2, STAGE_B = 2 * TILE_B;
  const int tid = otid(), wid = tid >> 6, lane = tid & 63, wr = wid >> 2, wc = wid & 3, fr = lane & 15, fq = lane >> 4;
  const u16* ap[4];
  const u16* bp[4];
#pragma unroll
  for (int i = 0; i < 4; ++i) {
    int R, C;
    stage_rc2(wid * 1024 + i * 8192 + lane * 16, R, C);
    ap[i] = arow(R) + C;
    bp[i] = bt + (size_t)R * ldb + C;
  }
  f32x4 acc[8][4];
#pragma unroll
  for (int m = 0; m < 8; ++m)
#pragma unroll
    for (int n = 0; n < 4; ++n) acc[m][n] = f32x4{0.f, 0.f, 0.f, 0.f};
#define G2_STAGE(buf, kt)                                                                                              \
  do {                                                                                                                 \
    _Pragma("unroll") for (int i = 0; i < 4; ++i) {                                                                    \
      __builtin_amdgcn_global_load_lds((const unsigned*)(ap[i] + (kt) * 64),                                           \
                                       (lds_u32*)(smem + (buf) * STAGE_B + wid * 1024 + i * 8192), 16, 0, 0);          \
      __builtin_amdgcn_global_load_lds((const unsigned*)(bp[i] + (kt) * 64),                                           \
                                       (lds_u32*)(smem + (buf) * STAGE_B + TILE_B + wid * 1024 + i * 8192), 16, 0, 0); \
    }                                                                                                                  \
  } while (0)
  const int nt = K / 64;
  G2_STAGE(0, 0);
  WAIT_V(0);
  __syncthreads();
  for (int t = 0; t < nt; ++t) {
    const int cur = t & 1;
    if (t + 1 < nt) G2_STAGE(cur ^ 1, t + 1);
    const char* sA = smem + cur * STAGE_B;
    const char* sB = sA + TILE_B;
#pragma unroll
    for (int ks = 0; ks < 2; ++ks) {
      bf16x8 At[8], Bf[4];
#pragma unroll
      for (int m = 0; m < 8; ++m) At[m] = *reinterpret_cast<const bf16x8*>(sA + lds_byte2(wr * 128 + m * 16 + fr, ks * 32 + fq * 8));
#pragma unroll
      for (int n = 0; n < 4; ++n) Bf[n] = *reinterpret_cast<const bf16x8*>(sB + lds_byte2(wc * 64 + n * 16 + fr, ks * 32 + fq * 8));
#pragma unroll
      for (int m = 0; m < 8; ++m)
#pragma unroll
        for (int n = 0; n < 4; ++n) acc[m][n] = __builtin_amdgcn_mfma_f32_16x16x32_bf16(Bf[n], At[m], acc[m][n], 0, 0, 0);
      __builtin_amdgcn_sched_barrier(0);
    }
    WAIT_V(0);
    __syncthreads();
  }
  epi(acc, wr, wc, fr, fq);
}

namespace pg8 {
constexpr int BM = 256, BK = 64, HALF = 128, HTB = HALF * BK * 2;
DI int lds_byte(int r, int c) { const int st = (r >> 4) * 2 + (c >> 5), rr = r & 15, cc = c & 31, ob = rr * 64 + cc * 2; return st * 1024 + (ob ^ (((ob >> 9) & 1) << 5)); }
DI void stage_rc(int b, int& R, int& C) { const int st = b / 1024, sb = b % 1024, swz = sb ^ (((sb >> 9) & 1) << 5); R = (st >> 1) * 16 + swz / 64; C = (st & 1) * 32 + (swz % 64) / 2; }
DI int perm32(int rho) { const int n = rho >> 4, i = rho & 15; return 8 * (i >> 2) + 4 * n + (i & 3); }
struct Unit { int pm, pn; };
typedef __attribute__((address_space(3))) unsigned char lds_u8;
typedef __attribute__((address_space(3))) unsigned lds_u32;
typedef __attribute__((address_space(3))) bf16x8 lds_bf16x8;
typedef __attribute__((address_space(3))) i32x4 lds_i32x4;

template <class Cfg>
DI void gemm_phase(lds_u8* lds, const Cfg& S) {
  const int tid = otid(), wid = __builtin_amdgcn_readfirstlane(tid >> 6), lane = tid & 63, wr = wid >> 2, wc = wid & 3, fr = lane & 15, fq = lane >> 4;
  const int K = S.K, nt = K / BK;
  int R0, C0, R1, C1;
  stage_rc(tid * 16, R0, C0);
  stage_rc(tid * 16 + 8192, R1, C1);
  unsigned voffB[2];
  {
    const int Rb0 = Cfg::PERM ? ((R0 & ~31) + perm32(R0 & 31)) : R0, Rb1 = Cfg::PERM ? ((R1 & ~31) + perm32(R1 & 31)) : R1;
    voffB[0] = (unsigned)(Rb0 * K + C0) * 2u; voffB[1] = (unsigned)(Rb1 * K + C1) * 2u;
  }
  const size_t kstep = (size_t)(BK * 2);
  const size_t hstep = (size_t)HALF * K * 2;
  const unsigned ldsw = (unsigned)wid * 1024u;
  const int aoff = lds_byte(wr * 64 + fr, fq * 8), boff = lds_byte(wc * 32 + fr, fq * 8);
#define PG8_SA(b, h) (((b) * 2 + (h)) * HTB)
#define PG8_SB(b, h) ((4 + (b) * 2 + (h)) * HTB)
#define PG8_STAGE2(bufoff, gbase, o0, o1) do { \
    __builtin_amdgcn_global_load_lds((const unsigned*)((const char*)(gbase) + (o0)), (lds_u32*)(lds + (bufoff) + ldsw), 16, 0, 0); \
    __builtin_amdgcn_global_load_lds((const unsigned*)((const char*)(gbase) + (o1)), (lds_u32*)(lds + (bufoff) + ldsw + 8192), 16, 0, 0); } while (0)
#define PG8_STAGEB(bufoff, gbase) PG8_STAGE2(bufoff, gbase, voffB[0], voffB[1])
#define PG8_LDA(dst, b, h) do { _Pragma("unroll") for (int m = 0; m < 4; ++m) _Pragma("unroll") for (int k = 0; k < 2; ++k) dst[m][k] = *(const lds_bf16x8*)(lds + PG8_SA(b, h) + aoff + m * 2048 + k * 1024); } while (0)
#define PG8_LDB(dst, b, h) do { _Pragma("unroll") for (int n = 0; n < 2; ++n) _Pragma("unroll") for (int k = 0; k < 2; ++k) dst[n][k] = *(const lds_bf16x8*)(lds + PG8_SB(b, h) + boff + n * 2048 + k * 1024); } while (0)
#define PG8_MMA(ai, bj, At, Bt) do { __builtin_amdgcn_s_setprio(1); _Pragma("unroll") for (int m = 0; m < 4; ++m) _Pragma("unroll") for (int n = 0; n < 2; ++n) _Pragma("unroll") for (int k = 0; k < 2; ++k) \
    acc[ai][bj][m][n] = __builtin_amdgcn_mfma_f32_16x16x32_bf16(Bt[n][k], At[m][k], acc[ai][bj][m][n], 0, 0, 0); __builtin_amdgcn_s_setprio(0); } while (0)
#define PG8_WAIT_V(n) asm volatile("s_waitcnt vmcnt(" #n ")" ::: "memory")
#define PG8_WAIT_L(n) asm volatile("s_waitcnt lgkmcnt(" #n ")" ::: "memory")
#define PG8_BAR __builtin_amdgcn_s_barrier()
#define PG8_SCHED __builtin_amdgcn_sched_barrier(0)
  Unit cur, nxt; int ui = 0;
  if (!S.next(0, cur)) return;
  f32x4 acc[2][2][4][2];
#pragma unroll
  for (int a = 0; a < 2; ++a)
#pragma unroll
    for (int b = 0; b < 2; ++b)
#pragma unroll
      for (int m = 0; m < 4; ++m)
#pragma unroll
        for (int n = 0; n < 2; ++n) acc[a][b][m][n] = f32x4{0.f, 0.f, 0.f, 0.f};
  bf16x8 At[4][2], B0[2][2], B1[2][2];
  const char* cA = S.a_base(cur);
  const char* cB = S.b_base(cur);
  unsigned vc[4], vn[4];
  S.a_off(cur, R0, C0, R1, C1, vc);
  PG8_STAGEB(PG8_SB(0, 0), cB); PG8_STAGE2(PG8_SA(0, 0), cA, vc[0], vc[1]); PG8_STAGEB(PG8_SB(0, 1), cB + hstep); PG8_STAGE2(PG8_SA(0, 1), cA, vc[2], vc[3]);
  if (wr == 1) PG8_BAR;
  PG8_WAIT_V(4); PG8_BAR;
  PG8_STAGEB(PG8_SB(1, 0), cB + kstep); PG8_STAGE2(PG8_SA(1, 0), cA + kstep, vc[0], vc[1]); PG8_STAGEB(PG8_SB(1, 1), cB + hstep + kstep);
  PG8_WAIT_V(6); PG8_BAR;
  for (;;) {
    const bool has_next = S.next(ui + 1, nxt);
    const char* nA = has_next ? S.a_base(nxt) : cA;
    const char* nB = has_next ? S.b_base(nxt) : cB;
    if (has_next) S.a_off(nxt, R0, C0, R1, C1, vn);
    else { vn[0] = vc[0]; vn[1] = vc[1]; vn[2] = vc[2]; vn[3] = vc[3]; }
    for (int t = 0; t < nt; t += 2) {
      const bool last = (t == nt - 2);
      const char* a1 = cA + (size_t)(t + 1) * kstep;
      const char* a2 = last ? nA : cA + (size_t)(t + 2) * kstep;
      const char* b2 = last ? nB : cB + (size_t)(t + 2) * kstep;
      const char* a3 = a2 + kstep;
      const char* b3 = b2 + kstep;
      const unsigned w0 = last ? vn[0] : vc[0], w1 = last ? vn[1] : vc[1], w2 = last ? vn[2] : vc[2], w3 = last ? vn[3] : vc[3];
      PG8_LDB(B0, 0, 0); PG8_SCHED; PG8_LDA(At, 0, 0); PG8_STAGE2(PG8_SA(1, 1), a1, vc[2], vc[3]);
      PG8_WAIT_L(8); PG8_BAR; PG8_WAIT_L(0); PG8_MMA(0, 0, At, B0); PG8_BAR; PG8_SCHED;
      PG8_LDB(B1, 0, 1); PG8_STAGEB(PG8_SB(0, 0), b2);
      PG8_BAR; PG8_WAIT_L(0); PG8_MMA(0, 1, At, B1); PG8_BAR;
      PG8_LDA(At, 0, 1); PG8_STAGE2(PG8_SA(0, 0), a2, w0, w1);
      PG8_BAR; PG8_WAIT_L(0); PG8_MMA(1, 0, At, B0); PG8_BAR; PG8_SCHED;
      PG8_STAGEB(PG8_SB(0, 1), b2 + hstep);
      PG8_WAIT_V(6); PG8_BAR; PG8_MMA(1, 1, At, B1); PG8_BAR;
      PG8_LDB(B0, 1, 0); PG8_SCHED; PG8_LDA(At, 1, 0); PG8_STAGE2(PG8_SA(0, 1), a2, w2, w3);
      PG8_WAIT_L(8); PG8_BAR; PG8_WAIT_L(0); PG8_MMA(0, 0, At, B0); PG8_BAR; PG8_SCHED;
      PG8_LDB(B1, 1, 1); PG8_STAGEB(PG8_SB(1, 0), b3);
      PG8_BAR; PG8_WAIT_L(0); PG8_MMA(0, 1, At, B1); PG8_BAR;
      PG8_LDA(At, 1, 1); PG8_STAGE2(PG8_SA(1, 0), a3, w0, w1);
      PG8_BAR; PG8_WAIT_L(0); PG8_MMA(1, 0, At, B0); PG8_BAR; PG8_SCHED;
      PG8_STAGEB(PG8_SB(1, 1), b3 + hstep);
      PG8_WAIT_V(6); PG8_BAR; PG8_MMA(1, 1, At, B1); PG8_BAR;
    }
    S.epi(acc, cur, wr, wc, fr, fq);
    if (!has_next) break;
#pragma unroll
    for (int a = 0; a < 2; ++a)
#pragma unroll
      for (int b = 0; b < 2; ++b)
#pragma unroll
        for (int m = 0; m < 4; ++m)
#pragma unroll
          for (int n = 0; n < 2; ++n) acc[a][b][m][n] = f32x4{0.f, 0.f, 0.f, 0.f};
    cur = nxt; cA = nA; cB = nB; ++ui;
    vc[0] = vn[0]; vc[1] = vn[1]; vc[2] = vn[2]; vc[3] = vn[3];
  }
  PG8_WAIT_V(0);
  if (wr == 0) PG8_BAR;
  PG8_BAR;
#undef PG8_SA
#undef PG8_SB
#undef PG8_STAGE2
#undef PG8_STAGEB
#undef PG8_LDA
#undef PG8_LDB
#undef PG8_MMA
#undef PG8_WAIT_V
#undef PG8_WAIT_L
#undef PG8_BAR
#undef PG8_SCHED
}
template <class Cfg>
DI void gemm_phase_f8(lds_u8* lds, const Cfg& S) {
  const int tid = otid(), wid = __builtin_amdgcn_readfirstlane(tid >> 6), lane = tid & 63, wr = wid >> 2, wc = wid & 3, fr = lane & 15, fq = lane >> 4;
  const int K = S.K, nt = K / BK;
  int R0, C0, R1, C1;
  stage_rc(tid * 16, R0, C0);
  stage_rc(tid * 16 + 8192, R1, C1);
  unsigned voffB[2];
  {
    const int Rb0 = Cfg::PERM ? ((R0 & ~31) + perm32(R0 & 31)) : R0, Rb1 = Cfg::PERM ? ((R1 & ~31) + perm32(R1 & 31)) : R1;
    voffB[0] = (unsigned)(Rb0 * K + C0) * 2u; voffB[1] = (unsigned)(Rb1 * K + C1) * 2u;
  }
  const size_t kstep = (size_t)(BK * 2);
  const size_t hstep = (size_t)HALF * K * 2;
  const unsigned ldsw = (unsigned)wid * 1024u;
  const int cl = 2 * fq + (fq & 1), ch = 2 * fq + 1 - (fq & 1);
  const int aoffL = lds_byte(wr * 64 + fr, cl * 8), aoffH = lds_byte(wr * 64 + fr, ch * 8);
  const int boffL = lds_byte(wc * 32 + fr, cl * 8), boffH = lds_byte(wc * 32 + fr, ch * 8);
#define PG8_SA(b, h) (((b) * 2 + (h)) * HTB)
#define PG8_SB(b, h) ((4 + (b) * 2 + (h)) * HTB)
#define PG8_STAGE2(bufoff, gbase, o0, o1) do { \
    __builtin_amdgcn_global_load_lds((const unsigned*)((const char*)(gbase) + (o0)), (lds_u32*)(lds + (bufoff) + ldsw), 16, 0, 0); \
    __builtin_amdgcn_global_load_lds((const unsigned*)((const char*)(gbase) + (o1)), (lds_u32*)(lds + (bufoff) + ldsw + 8192), 16, 0, 0); } while (0)
#define PG8_STAGEB(bufoff, gbase) PG8_STAGE2(bufoff, gbase, voffB[0], voffB[1])
#define PG8_LDA(dst, b, h) do { _Pragma("unroll") for (int m = 0; m < 4; ++m) { const i32x4 lo_ = *(const lds_i32x4*)(lds + PG8_SA(b, h) + aoffL + m * 2048), hi_ = *(const lds_i32x4*)(lds + PG8_SA(b, h) + aoffH + m * 2048); dst[m] = __builtin_shufflevector(lo_, hi_, 0, 1, 2, 3, 4, 5, 6, 7); } } while (0)
#define PG8_LDB(dst, b, h) do { _Pragma("unroll") for (int n = 0; n < 2; ++n) { const i32x4 lo_ = *(const lds_i32x4*)(lds + PG8_SB(b, h) + boffL + n * 2048), hi_ = *(const lds_i32x4*)(lds + PG8_SB(b, h) + boffH + n * 2048); dst[n] = __builtin_shufflevector(lo_, hi_, 0, 1, 2, 3, 4, 5, 6, 7); } } while (0)
#define PG8_MMA(ai, bj, At, Bt) do { __builtin_amdgcn_s_setprio(1); _Pragma("unroll") for (int m = 0; m < 4; ++m) _Pragma("unroll") for (int n = 0; n < 2; ++n) \
    asm volatile("v_mfma_f32_16x16x128_f8f6f4 %0, %1, %2, %0" : "+v"(acc[ai][bj][m][n]) : "v"(Bt[n]), "v"(At[m])); __builtin_amdgcn_s_setprio(0); } while (0)
#define PG8_WAIT_V(n) asm volatile("s_waitcnt vmcnt(" #n ")" ::: "memory")
#define PG8_WAIT_L(n) asm volatile("s_waitcnt lgkmcnt(" #n ")" ::: "memory")
#define PG8_BAR __builtin_amdgcn_s_barrier()
#define PG8_SCHED __builtin_amdgcn_sched_barrier(0)
  Unit cur, nxt; int ui = 0;
  if (!S.next(0, cur)) return;
  f32x4 acc[2][2][4][2];
#pragma unroll
  for (int a = 0; a < 2; ++a)
#pragma unroll
    for (int b = 0; b < 2; ++b)
#pragma unroll
      for (int m = 0; m < 4; ++m)
#pragma unroll
        for (int n = 0; n < 2; ++n) acc[a][b][m][n] = f32x4{0.f, 0.f, 0.f, 0.f};
  i32x8 At[4], B0[2], B1[2];
  const char* cA = S.a_base(cur);
  const char* cB = S.b_base(cur);
  unsigned vc[4], vn[4];
  S.a_off(cur, R0, C0, R1, C1, vc, 0);
  PG8_STAGEB(PG8_SB(0, 0), cB); PG8_STAGE2(PG8_SA(0, 0), cA, vc[0], vc[1]); PG8_STAGEB(PG8_SB(0, 1), cB + hstep); PG8_STAGE2(PG8_SA(0, 1), cA, vc[2], vc[3]);
  if (wr == 1) PG8_BAR;
  PG8_WAIT_V(4); PG8_BAR;
  PG8_STAGEB(PG8_SB(1, 0), cB + kstep); PG8_STAGE2(PG8_SA(1, 0), cA + kstep, vc[0], vc[1]); PG8_STAGEB(PG8_SB(1, 1), cB + hstep + kstep);
  PG8_WAIT_V(6); PG8_BAR;
  for (;;) {
    const bool has_next = S.next(ui + 1, nxt);
    const char* nA = has_next ? S.a_base(nxt) : cA;
    const char* nB = has_next ? S.b_base(nxt) : cB;
    if (has_next) S.a_off(nxt, R0, C0, R1, C1, vn, ui + 1);
    else { vn[0] = vc[0]; vn[1] = vc[1]; vn[2] = vc[2]; vn[3] = vc[3]; }
    for (int t = 0; t < nt; t += 2) {
      const bool last = (t == nt - 2);
      const char* a1 = cA + (size_t)(t + 1) * kstep;
      const char* a2 = last ? nA : cA + (size_t)(t + 2) * kstep;
      const char* b2 = last ? nB : cB + (size_t)(t + 2) * kstep;
      const char* a3 = a2 + kstep;
      const char* b3 = b2 + kstep;
      const unsigned w0 = last ? vn[0] : vc[0], w1 = last ? vn[1] : vc[1], w2 = last ? vn[2] : vc[2], w3 = last ? vn[3] : vc[3];
      PG8_LDB(B0, 0, 0); PG8_SCHED; PG8_LDA(At, 0, 0); PG8_STAGE2(PG8_SA(1, 1), a1, vc[2], vc[3]);
      PG8_WAIT_L(8); PG8_BAR; PG8_WAIT_L(0); PG8_MMA(0, 0, At, B0); PG8_BAR; PG8_SCHED;
      PG8_LDB(B1, 0, 1); PG8_STAGEB(PG8_SB(0, 0), b2);
      PG8_BAR; PG8_WAIT_L(0); PG8_MMA(0, 1, At, B1); PG8_BAR;
      PG8_LDA(At, 0, 1); PG8_STAGE2(PG8_SA(0, 0), a2, w0, w1);
      PG8_BAR; PG8_WAIT_L(0); PG8_MMA(1, 0, At, B0); PG8_BAR; PG8_SCHED;
      PG8_STAGEB(PG8_SB(0, 1), b2 + hstep);
      PG8_WAIT_V(6); PG8_BAR; PG8_MMA(1, 1, At, B1); PG8_BAR;
      PG8_LDB(B0, 1, 0); PG8_SCHED; PG8_LDA(At, 1, 0); PG8_STAGE2(PG8_SA(0, 1), a2, w2, w3);
      PG8_WAIT_L(8); PG8_BAR; PG8_WAIT_L(0); PG8_MMA(0, 0, At, B0); PG8_BAR; PG8_SCHED;
      PG8_LDB(B1, 1, 1); PG8_STAGEB(PG8_SB(1, 0), b3);
      PG8_BAR; PG8_WAIT_L(0); PG8_MMA(0, 1, At, B1); PG8_BAR;
      PG8_LDA(At, 1, 1); PG8_STAGE2(PG8_SA(1, 0), a3, w0, w1);
      PG8_BAR; PG8_WAIT_L(0); PG8_MMA(1, 0, At, B0); PG8_BAR; PG8_SCHED;
      PG8_STAGEB(PG8_SB(1, 1), b3 + hstep);
      PG8_WAIT_V(6); PG8_BAR; PG8_MMA(1, 1, At, B1); PG8_BAR;
    }
    asm volatile("s_nop 15\n\ts_nop 15" ::: "memory");
    S.epi(acc, cur, wr, wc, fr, fq);
    if (!has_next) break;
#pragma unroll
    for (int a = 0; a < 2; ++a)
#pragma unroll
      for (int b = 0; b < 2; ++b)
#pragma unroll
        for (int m = 0; m < 4; ++m)
#pragma unroll
          for (int n = 0; n < 2; ++n) acc[a][b][m][n] = f32x4{0.f, 0.f, 0.f, 0.f};
    cur = nxt; cA = nA; cB = nB; ++ui;
    vc[0] = vn[0]; vc[1] = vn[1]; vc[2] = vn[2]; vc[3] = vn[3];
  }
  PG8_WAIT_V(0);
  if (wr == 0) PG8_BAR;
  PG8_BAR;
#undef PG8_SA
#undef PG8_SB
#undef PG8_STAGE2
#undef PG8_STAGEB
#undef PG8_LDA
#undef PG8_LDB
#undef PG8_MMA
#undef PG8_WAIT_V
#undef PG8_WAIT_L
#undef PG8_BAR
#undef PG8_SCHED
}
}

struct CfgInproj {
  static constexpr bool PERM = true;
  int K; const Params* p; int L; int bid, nb;
  DI bool next(int i, pg8::Unit& u) const { const int t = i * nb + bid; if (t >= 64 * 13) return false; u.pm = t & 63; u.pn = t >> 6; return true; }
  DI const char* a_base(const pg8::Unit& u) const { return (const char*)(p->hn() + (size_t)u.pm * 256 * DM); }
  DI const char* b_base(const pg8::Unit& u) const { return (const char*)(p->WinT() + ((size_t)L * PWP + (size_t)u.pn * 256) * DM); }
  DI void a_off(const pg8::Unit&, int R0, int C0, int R1, int C1, unsigned (&vo)[4]) const {
    vo[0] = (unsigned)(R0 * DM + C0) * 2u; vo[1] = (unsigned)(R1 * DM + C1) * 2u;
    vo[2] = vo[0] + 128u * DM * 2u; vo[3] = vo[1] + 128u * DM * 2u;
  }
  DI void epi(const f32x4 (&acc)[2][2][4][2], const pg8::Unit& u, int wr, int wc, int fr, int fq) const {
    const int row0 = u.pm * 256 + wr * 64 + fr, col0 = u.pn * 256 + wc * 32 + 8 * fq;
#pragma unroll
    for (int ai = 0; ai < 2; ++ai)
#pragma unroll
      for (int m = 0; m < 4; ++m) {
        u16* rowp = p->proj() + (size_t)(row0 + ai * 128 + m * 16) * PWP + col0;
#pragma unroll
        for (int bj = 0; bj < 2; ++bj) {
          uint4 w;
          w.x = pack2(acc[ai][bj][m][0][0], acc[ai][bj][m][0][1]); w.y = pack2(acc[ai][bj][m][0][2], acc[ai][bj][m][0][3]);
          w.z = pack2(acc[ai][bj][m][1][0], acc[ai][bj][m][1][1]); w.w = pack2(acc[ai][bj][m][1][2], acc[ai][bj][m][1][3]);
          *reinterpret_cast<uint4*>(rowp + bj * 128) = w;
        }
      }
  }
};
DI void ph_inproj_tail(const Params& p, int L, char* smem, int t) {
  const int m0 = (t & 63) * 256, n0 = 3072 + (t >> 6) * 128;
  const u16* Bt = p.WinT() + ((size_t)L * PWP + n0) * DM;
  gemm_tile([&](int r) { return p.hn() + (size_t)(m0 + r) * DM; }, Bt, DM, DM, smem,
            [&](f32x4 (&acc)[4][4], int wr, int wc, int fr, int fq) {
#pragma unroll
              for (int m = 0; m < 4; ++m)
#pragma unroll
                for (int n = 0; n < 4; ++n)
#pragma unroll
                  for (int j = 0; j < 4; ++j)
                    p.proj()[(size_t)(m0 + wr * 64 + m * 16 + fq * 4 + j) * PWP + n0 + wc * 64 + n * 16 + fr] = f2bf(acc[m][n][j]);
            });
}
DI void ph_inproj(const Params& p, int L, char* smem) {
  CfgInproj c; c.K = DM; c.p = &p; c.L = L; c.bid = obid(); c.nb = gridDim.x;
  pg8::gemm_phase((pg8::lds_u8*)smem, c);
  if (gridDim.x == 256 && obid() >= CVT_IDLE_FIRST_BLK) cvt_tiles_idle(p, L, smem, 0, CVT_NA);
}

DI void ph_gemm_store_bf16(const u16* A, int lda, const u16* Bt, int K, int M, int N, u16* C, int ldc, char* smem, int rot) {
  const int mt = M / 256, nt = N / 128;
  const int nb = gridDim.x;
  for (int t = (obid() + rot) % nb; t < mt * nt; t += nb) {
    const int m0 = (t % mt) * 256, n0 = (t / mt) * 128;
    gemm_tile([&](int r) { return A + (size_t)(m0 + r) * lda; }, Bt + (size_t)n0 * K, K, K, smem,
              [&](f32x4 (&acc)[4][4], int wr, int wc, int fr, int fq) {
#pragma unroll
                for (int m = 0; m < 4; ++m)
#pragma unroll
                  for (int n = 0; n < 4; ++n)
#pragma unroll
                    for (int j = 0; j < 4; ++j) {
                      const int row = m0 + wr * 64 + m * 16 + fq * 4 + j, col = n0 + wc * 64 + n * 16 + fr;
                      C[(size_t)row * ldc + col] = f2bf(acc[m][n][j]);
                    }
              });
  }
}

DI void ph_rmsnorm_bf16(const float* __restrict__ xin, const float* __restrict__ w, u16* __restrict__ outp) {
  const int tid_ = otid(); const int lane = tid_ & 63, gw = (obid() * NTHR + tid_) >> 6, nw = gridDim.x * (NTHR / 64);
  for (int t = gw; t < T; t += nw) {
    const float* xr = xin + (size_t)t * DM;
    float4 v[4];
    float ss = 0.f;
#pragma unroll
    for (int i = 0; i < 4; ++i) {
      v[i] = *reinterpret_cast<const float4*>(xr + (i * 64 + lane) * 4);
      ss += v[i].x * v[i].x + v[i].y * v[i].y + v[i].z * v[i].z + v[i].w * v[i].w;
    }
    ss = wave_sum(ss);
    const float rstd = rsqrtf(ss * (1.f / DM) + 1e-6f);
#pragma unroll
    for (int i = 0; i < 4; ++i) {
      const int c = (i * 64 + lane) * 4;
      const float4 ww = *reinterpret_cast<const float4*>(w + c);
      uint2 o;
      o.x = pack2(v[i].x * rstd * ww.x, v[i].y * rstd * ww.y);
      o.y = pack2(v[i].z * rstd * ww.z, v[i].w * rstd * ww.w);
      *reinterpret_cast<uint2*>(outp + (size_t)t * DM + c) = o;
    }
  }
}

DI void ph_final_norm(const float* __restrict__ xin, const float* __restrict__ w, float* __restrict__ outp) {
  const int tid_ = otid(); const int lane = tid_ & 63, gw = (obid() * NTHR + tid_) >> 6, nw = gridDim.x * (NTHR / 64);
  for (int t = gw; t < T; t += nw) {
    const float* xr = xin + (size_t)t * DM;
    float4 v[4];
    float ss = 0.f;
#pragma unroll
    for (int i = 0; i < 4; ++i) {
      v[i] = *reinterpret_cast<const float4*>(xr + (i * 64 + lane) * 4);
      ss += v[i].x * v[i].x + v[i].y * v[i].y + v[i].z * v[i].z + v[i].w * v[i].w;
    }
    ss = wave_sum(ss);
    const float rstd = rsqrtf(ss * (1.f / DM) + 1e-6f);
#pragma unroll
    for (int i = 0; i < 4; ++i) {
      const int c = (i * 64 + lane) * 4;
      const float4 ww = *reinterpret_cast<const float4*>(w + c);
      float4 o = make_float4(v[i].x * rstd * ww.x, v[i].y * rstd * ww.y, v[i].z * rstd * ww.z, v[i].w * rstd * ww.w);
      *reinterpret_cast<float4*>(outp + (size_t)t * DM + c) = o;
    }
  }
}

DI void rot8(const u16* x1p, const u16* x2p, const float* tab  , float scale, uint4& o1, uint4& o2) {
  float x1[8], x2[8], y1[8], y2[8];
  ld8(x1p, x1); ld8(x2p, x2);
#pragma unroll
  for (int e = 0; e < 8; e += 2) {
    const float4 cs = *reinterpret_cast<const float4*>(tab + e * 2);
    y1[e] = (x1[e] * cs.x - x2[e] * cs.y) * scale;
    y2[e] = (x2[e] * cs.x + x1[e] * cs.y) * scale;
    y1[e + 1] = (x1[e + 1] * cs.z - x2[e + 1] * cs.w) * scale;
    y2[e + 1] = (x2[e + 1] * cs.z + x1[e + 1] * cs.w) * scale;
  }
  o1.x = pack2(y1[0], y1[1]); o1.y = pack2(y1[2], y1[3]); o1.z = pack2(y1[4], y1[5]); o1.w = pack2(y1[6], y1[7]);
  o2.x = pack2(y2[0], y2[1]); o2.y = pack2(y2[2], y2[3]); o2.z = pack2(y2[4], y2[5]); o2.w = pack2(y2[6], y2[7]);
}
DI void ph_post(const Params& p, int L) {
  const int tid = otid();
  const int gt = obid() * NTHR + tid, gs = gridDim.x * NTHR;
  const int lane = tid & 63, gw = gt >> 6, nw = gs >> 6;
  const float* qnw = p.q_norm_w + L * 256;
  const float* kvnw = p.kv_norm_w + L * 128;
  const float* cw = p.conv_w + L * 5 * 768;
  const float* cb = p.conv_b + L * 768;
  const float* dtb = p.dt_bias + L * 8;
  {
    uint4 xr[5];
    auto load_taps = [&](int idx, uint4 (&r)[5]) {
      const int t = idx / 96, cg = idx - t * 96, s = t & (SEQ - 1);
#pragma unroll
      for (int w = 0; w < 5; ++w) {
        const int ss = s + w - 2;
        const int tt = (ss >= 0 && ss < SEQ) ? (t + w - 2) : t;
        r[w] = *reinterpret_cast<const uint4*>(p.proj() + (size_t)tt * PWP + C_XBC + cg * 8);
      }
    };
    if (gt < T * 96) load_taps(gt, xr);
    for (int idx = gt; idx < T * 96; idx += gs) {
      const int t = idx / 96, cg = idx - t * 96, s = t & (SEQ - 1);
      uint4 xn[5];
      const int idn = (idx + gs < T * 96) ? (idx + gs) : idx;
      load_taps(idn, xn);
      float acc[8];
      {
        const float4 b0 = *reinterpret_cast<const float4*>(cb + cg * 8), b1 = *reinterpret_cast<const float4*>(cb + cg * 8 + 4);
        acc[0] = b0.x; acc[1] = b0.y; acc[2] = b0.z; acc[3] = b0.w; acc[4] = b1.x; acc[5] = b1.y; acc[6] = b1.z; acc[7] = b1.w;
      }
#pragma unroll
      for (int w = 0; w < 5; ++w) {
        const int ss = s + w - 2;
        const float msk = (ss >= 0 && ss < SEQ) ? 1.f : 0.f;
        float xv[8];
        unpack8(xr[w], xv);
        const float4 w0 = *reinterpret_cast<const float4*>(cw + w * 768 + cg * 8), w1 = *reinterpret_cast<const float4*>(cw + w * 768 + cg * 8 + 4);
        acc[0] += msk * xv[0] * w0.x; acc[1] += msk * xv[1] * w0.y; acc[2] += msk * xv[2] * w0.z; acc[3] += msk * xv[3] * w0.w;
        acc[4] += msk * xv[4] * w1.x; acc[5] += msk * xv[5] * w1.y; acc[6] += msk * xv[6] * w1.z; acc[7] += msk * xv[7] * w1.w;
      }
      uint4 o;
      o.x = pack2(fast_silu(acc[0]), fast_silu(acc[1])); o.y = pack2(fast_silu(acc[2]), fast_silu(acc[3]));
      o.z = pack2(fast_silu(acc[4]), fast_silu(acc[5])); o.w = pack2(fast_silu(acc[6]), fast_silu(acc[7]));
      *reinterpret_cast<uint4*>(p.xbc() + (size_t)t * 768 + cg * 8) = o;
#pragma unroll
      for (int w = 0; w < 5; ++w) xr[w] = xn[w];
    }
  }
  for (int idx = gt; idx < T * 8; idx += gs) {
    const int t = idx >> 3, k = idx & 7;
    const float v = bf2f(p.proj()[(size_t)t * PWP + C_DT + k]) + dtb[k];
    p.dtv()[idx] = (v > 20.f) ? v : log1pf(expf(v));
  }
  {
    const int sub = lane >> 4, l16 = lane & 15;
    for (int t = gw * 4 + sub; t < T; t += nw * 4) {
      const u16* pr = p.proj() + (size_t)t * PWP;
      float v[16], u[8];
      ld8(pr + C_CQ + l16 * 16, v); ld8(pr + C_CQ + l16 * 16 + 8, v + 8);
      ld8(pr + C_CKV + l16 * 8, u);
      float ss = 0.f, s2 = 0.f;
#pragma unroll
      for (int i = 0; i < 16; ++i) ss += v[i] * v[i];
#pragma unroll
      for (int i = 0; i < 8; ++i) s2 += u[i] * u[i];
#pragma unroll
      for (int o = 1; o < 16; o <<= 1) { ss += __shfl_xor(ss, o); s2 += __shfl_xor(s2, o); }
      const float rstd = rsqrtf(ss * (1.f / 256.f) + 1e-6f), r2 = rsqrtf(s2 * (1.f / 128.f) + 1e-6f);
      uint4 o;
      const float* qw = qnw + l16 * 16;
      o.x = pack2(v[0] * rstd * qw[0], v[1] * rstd * qw[1]); o.y = pack2(v[2] * rstd * qw[2], v[3] * rstd * qw[3]);
      o.z = pack2(v[4] * rstd * qw[4], v[5] * rstd * qw[5]); o.w = pack2(v[6] * rstd * qw[6], v[7] * rstd * qw[7]);
      *reinterpret_cast<uint4*>(p.cqn() + (size_t)t * 256 + l16 * 16) = o;
      o.x = pack2(v[8] * rstd * qw[8], v[9] * rstd * qw[9]); o.y = pack2(v[10] * rstd * qw[10], v[11] * rstd * qw[11]);
      o.z = pack2(v[12] * rstd * qw[12], v[13] * rstd * qw[13]); o.w = pack2(v[14] * rstd * qw[14], v[15] * rstd * qw[15]);
      *reinterpret_cast<uint4*>(p.cqn() + (size_t)t * 256 + l16 * 16 + 8) = o;
      const float* kw = kvnw + l16 * 8;
      o.x = pack2(u[0] * r2 * kw[0], u[1] * r2 * kw[1]); o.y = pack2(u[2] * r2 * kw[2], u[3] * r2 * kw[3]);
      o.z = pack2(u[4] * r2 * kw[4], u[5] * r2 * kw[5]); o.w = pack2(u[6] * r2 * kw[6], u[7] * r2 * kw[7]);
      *reinterpret_cast<uint4*>(p.ckvn() + (size_t)t * 128 + l16 * 8) = o;
    }
  }
  {
    auto item_of = [&](int idx, u16*& a, int& off2, int& tabo, float& scale, int& krope_i0) {
      const int t = idx / 42, ri = idx - t * 42, s = t & (SEQ - 1);
      u16* pr = p.proj() + (size_t)t * PWP;
      krope_i0 = -1;
      if (ri < 32) {
        const int isk = ri >> 4, h = (ri >> 2) & 3, i0 = (ri & 3) * 8;
        a = pr + (isk ? C_RK : C_RQ) + h * 64 + i0; off2 = 32; tabo = (s * 56 + i0) * 2; scale = isk ? 1.f : 0.125f;
      } else if (ri < 40) {
        const int j = ri - 32, isk = j >> 2, h = j & 3;
        a = pr + (isk ? C_DK : C_DQ) + h * 64; off2 = 8; tabo = (s * 56 + 32) * 2; scale = 1.f;
      } else {
        const int i0 = (ri - 40) * 8;
        a = pr + C_KR + i0; off2 = 16; tabo = (s * 56 + 40 + i0) * 2; scale = 1.f; krope_i0 = i0;
      }
    };
    uint4 x1c = make_uint4(0, 0, 0, 0), x2c = make_uint4(0, 0, 0, 0);
    if (gt < T * 42) {
      u16* a; int off2, tabo, ki; float sc;
      item_of(gt, a, off2, tabo, sc, ki);
      x1c = *reinterpret_cast<const uint4*>(a); x2c = *reinterpret_cast<const uint4*>(a + off2);
    }
    for (int idx = gt; idx < T * 42; idx += gs) {
      u16* a; int off2, tabo, ki; float scale;
      item_of(idx, a, off2, tabo, scale, ki);
      uint4 x1n, x2n;
      {
        const int idn = (idx + gs < T * 42) ? (idx + gs) : idx;
        u16* an; int o2n, tn_, kn; float scn;
        item_of(idn, an, o2n, tn_, scn, kn);
        x1n = *reinterpret_cast<const uint4*>(an); x2n = *reinterpret_cast<const uint4*>(an + o2n);
      }
      float x1[8], x2[8], y1[8], y2[8];
      unpack8(x1c, x1); unpack8(x2c, x2);
      const float* tab = p.rtab() + tabo;
#pragma unroll
      for (int e = 0; e < 8; e += 2) {
        const float4 cs = *reinterpret_cast<const float4*>(tab + e * 2);
        y1[e] = (x1[e] * cs.x - x2[e] * cs.y) * scale;
        y2[e] = (x2[e] * cs.x + x1[e] * cs.y) * scale;
        y1[e + 1] = (x1[e + 1] * cs.z - x2[e + 1] * cs.w) * scale;
        y2[e + 1] = (x2[e + 1] * cs.z + x1[e + 1] * cs.w) * scale;
      }
      uint4 o1, o2;
      o1.x = pack2(y1[0], y1[1]); o1.y = pack2(y1[2], y1[3]); o1.z = pack2(y1[4], y1[5]); o1.w = pack2(y1[6], y1[7]);
      o2.x = pack2(y2[0], y2[1]); o2.y = pack2(y2[2], y2[3]); o2.z = pack2(y2[4], y2[5]); o2.w = pack2(y2[6], y2[7]);
      *reinterpret_cast<uint4*>(a) = o1;
      *reinterpret_cast<uint4*>(a + off2) = o2;
      if (ki >= 0) {
        const int t = idx / 42, s = t & (SEQ - 1), bb = t >> 12;
#pragma unroll
        for (int hd = 0; hd < 4; ++hd) {
          u16* kf = p.kfull() + ((size_t)(bb * 4 + hd) * SEQ + s) * 96 + 64 + ki;
          *reinterpret_cast<uint4*>(kf) = o1;
          *reinterpret_cast<uint4*>(kf + 16) = o2;
        }
      }
      x1c = x1n; x2c = x2n;
    }
  }
}

DI void ph_mla_up_q(const Params& p, int L, char* smem, int t) {
  const int mt = T / 256;
  const u16* Bq = p.WuqT() + (size_t)L * 384 * 256;
  {
    const int m0 = (t % mt) * 256, n0 = (t / mt) * 128;
    gemm_tile([&](int r) { return p.cqn() + (size_t)(m0 + r) * 256; }, Bq + (size_t)n0 * 256, 256, 256, smem,
              [&](f32x4 (&acc)[4][4], int wr, int wc, int fr, int fq) {
                const float scale = 0.10206207261596575f * 1.4426950408889634f;
#pragma unroll
                for (int m = 0; m < 4; ++m)
#pragma unroll
                  for (int j = 0; j < 4; ++j) {
                    const int row = m0 + wr * 64 + m * 16 + fq * 4 + j;
                    const float2 cssn = *reinterpret_cast<const float2*>(p.rtab() + ((size_t)(row & (SEQ - 1)) * 56 + 40 + fr) * 2);
                    const float cs = cssn.x, sn = cssn.y;
#pragma unroll
                    for (int n2 = 0; n2 < 4; n2 += 2) {
                      const int cb = n0 + wc * 64 + n2 * 16;
                      float x1 = acc[m][n2][j], x2 = acc[m][n2 + 1][j];
                      if (cb % 96 == 64) {
                        const float y1 = x1 * cs - x2 * sn, y2 = x2 * cs + x1 * sn;
                        x1 = y1; x2 = y2;
                      }
                      p.mq()[(size_t)row * 384 + cb + fr] = f2bf(x1 * scale);
                      p.mq()[(size_t)row * 384 + cb + 16 + fr] = f2bf(x2 * scale);
                    }
                  }
              });
  }
}
DI void ph_mla_up_kv(const Params& p, int L, char* smem, int t) {
  const int mt = T / 256;
  const u16* Bkv = p.WukvT() + (size_t)L * 512 * 128;
  {
    const int m0 = (t % mt) * 256, h = t / mt, n0 = h * 128;
    gemm_tile([&](int r) { return p.ckvn() + (size_t)(m0 + r) * 128; }, Bkv + (size_t)n0 * 128, 128, 128, smem,
              [&](f32x4 (&acc)[4][4], int wr, int wc, int fr, int fq) {
#pragma unroll
                for (int m = 0; m < 4; ++m) {
                  const int row = m0 + wr * 64 + m * 16 + fq * 4;
                  const int bb = row >> 12, sq = row & (SEQ - 1);
                  const size_t bh = (size_t)(bb * 4 + h);
#pragma unroll
                  for (int n = 0; n < 4; ++n) {
                    if (wc == 0) {
#pragma unroll
                      for (int j = 0; j < 4; ++j) p.kfull()[(bh * SEQ + sq + j) * 96 + n * 16 + fr] = f2bf(acc[m][n][j]);
                    } else {
                      uint2 v;
                      v.x = pack2(acc[m][n][0], acc[m][n][1]);
                      v.y = pack2(acc[m][n][2], acc[m][n][3]);
                      const int sqp = (sq & ~12) | ((sq & 4) << 1) | ((sq & 8) >> 1);
                      *reinterpret_cast<uint2*>(p.vT() + (bh * 64 + n * 16 + fr) * SEQ + sqp) = v;
                    }
                  }
                }
              });
  }
}

DI void ph_cumsum(const Params& p, int L) {
  const int tid_ = otid(); const int lane = tid_ & 63, gw = (obid() * NTHR + tid_) >> 6, nw = gridDim.x * (NTHR / 64);
  for (int it = gw; it < 32; it += nw) {
    const int h = it & 3, dir = (it >> 2) & 1, b = it >> 3;
    const float a = -expf(p.a_log[L * 8 + dir * 4 + h]);
    float running = 0.f;
    for (int c = 0; c < 64; ++c) {
      const int i = c * 64 + lane;
      const int s = dir ? (SEQ - 1 - i) : i;
      const size_t off = (size_t)(b * SEQ + s) * 8 + dir * 4 + h;
      float v = p.dtv()[off] * a;
#pragma unroll
      for (int o = 1; o < 64; o <<= 1) {
        const float u = __shfl_up(v, o);
        if (lane >= o) v += u;
      }
      v += running;
      p.cs()[off] = v;
      running = __shfl(v, 63);
    }
  }
}

DI void ph_ret_naive(const Params& p) {
  const int gt = obid() * NTHR + otid(), gs = gridDim.x * NTHR;
  for (int it = gt; it < 4 * 4 * SEQ; it += gs) {
    const int n = it & (SEQ - 1), h = (it >> 12) & 3, b = it >> 14;
    const u16* base = p.proj() + (size_t)(b * SEQ) * PWP;
    uint4 qp[8];
    float o[64];
#pragma unroll
    for (int d = 0; d < 8; ++d) qp[d] = *reinterpret_cast<const uint4*>(base + (size_t)n * PWP + C_RQ + h * 64 + d * 8);
#pragma unroll
    for (int d = 0; d < 64; ++d) o[d] = 0.f;
    const float lg0 = log1pf(-exp2f(-5.f - (float)h)), lg1 = log1pf(-exp2f(-5.5f - (float)h));
#pragma unroll 1
    for (int m = 0; m < SEQ; ++m) {
      const u16* kr = base + (size_t)m * PWP + C_RK + h * 64;
      const u16* vr = base + (size_t)m * PWP + C_RV + h * 64;
      float s = 0.f;
#pragma unroll
      for (int d = 0; d < 8; ++d) s = dot8(qp[d], *reinterpret_cast<const uint4*>(kr + d * 8), s);
      const float w = (m <= n) ? expf(lg0 * (float)(n - m)) : expf(lg1 * (float)(m - n));
      s *= w;
#pragma unroll
      for (int d = 0; d < 64; d += 8) {
        float vf[8];
        ld8(vr + d, vf);
#pragma unroll
        for (int j = 0; j < 8; ++j) o[d + j] += s * vf[j];
      }
    }
    float mu = 0.f;
#pragma unroll
    for (int d = 0; d < 64; ++d) mu += o[d];
    mu *= (1.f / 64.f);
    float var = 0.f;
#pragma unroll
    for (int d = 0; d < 64; ++d) var += (o[d] - mu) * (o[d] - mu);
    var *= (1.f / 64.f);
    const float rs = rsqrtf(var + 1e-5f);
    const size_t t = (size_t)b * SEQ + n;
#pragma unroll
    for (int d = 0; d < 64; d += 8) {
      float g[8];
      ld8(p.proj() + t * PWP + C_RG + h * 64 + d, g);
      uint4 ov;
      ov.x = pack2(silu(g[0]) * (o[d + 0] - mu) * rs, silu(g[1]) * (o[d + 1] - mu) * rs);
      ov.y = pack2(silu(g[2]) * (o[d + 2] - mu) * rs, silu(g[3]) * (o[d + 3] - mu) * rs);
      ov.z = pack2(silu(g[4]) * (o[d + 4] - mu) * rs, silu(g[5]) * (o[d + 5] - mu) * rs);
      ov.w = pack2(silu(g[6]) * (o[d + 6] - mu) * rs, silu(g[7]) * (o[d + 7] - mu) * rs);
      *reinterpret_cast<uint4*>(p.mixed() + t * DM + h * 64 + d) = ov;
    }
  }
}

DI void ph_mla_naive(const Params& p) {
  const int gt = obid() * NTHR + otid(), gs = gridDim.x * NTHR;
  for (int it = gt; it < 2 * 4 * 4 * SEQ; it += gs) {
    const int n = it & (SEQ - 1), vh = (it >> 12) & 1, h = (it >> 13) & 3, b = it >> 15;
    const size_t t = (size_t)b * SEQ + n;
    uint4 qp[12];
    float o[32];
#pragma unroll
    for (int d = 0; d < 12; ++d) qp[d] = *reinterpret_cast<const uint4*>(p.mq() + t * 384 + h * 96 + d * 8);
    const size_t tb = (size_t)b * SEQ;
    float mx = -1e30f;
#pragma unroll 1
    for (int m = 0; m < SEQ; ++m) {
      const u16* kn = ((u16*)nullptr) + (tb + m) * 512 + h * 128;
      const u16* kr = p.proj() + (tb + m) * PWP + C_KR;
      float s = 0.f;
#pragma unroll
      for (int d = 0; d < 8; ++d) s = dot8(qp[d], *reinterpret_cast<const uint4*>(kn + d * 8), s);
#pragma unroll
      for (int d = 0; d < 4; ++d) s = dot8(qp[8 + d], *reinterpret_cast<const uint4*>(kr + d * 8), s);
      mx = fmaxf(mx, s);
    }
#pragma unroll
    for (int d = 0; d < 32; ++d) o[d] = 0.f;
    float l = 0.f;
#pragma unroll 1
    for (int m = 0; m < SEQ; ++m) {
      const u16* kn = ((u16*)nullptr) + (tb + m) * 512 + h * 128;
      const u16* kr = p.proj() + (tb + m) * PWP + C_KR;
      float s = 0.f;
#pragma unroll
      for (int d = 0; d < 8; ++d) s = dot8(qp[d], *reinterpret_cast<const uint4*>(kn + d * 8), s);
#pragma unroll
      for (int d = 0; d < 4; ++d) s = dot8(qp[8 + d], *reinterpret_cast<const uint4*>(kr + d * 8), s);
      const float pe = exp2f(s - mx);
      l += pe;
#pragma unroll
      for (int d = 0; d < 32; d += 8) {
        float vf[8];
        ld8(kn + 64 + vh * 32 + d, vf);
#pragma unroll
        for (int j = 0; j < 8; ++j) o[d + j] += pe * vf[j];
      }
    }
    const float il = 1.f / l;
#pragma unroll
    for (int d = 0; d < 32; d += 8) {
      uint4 ov;
      ov.x = pack2(o[d + 0] * il, o[d + 1] * il);
      ov.y = pack2(o[d + 2] * il, o[d + 3] * il);
      ov.z = pack2(o[d + 4] * il, o[d + 5] * il);
      ov.w = pack2(o[d + 6] * il, o[d + 7] * il);
      *reinterpret_cast<uint4*>(p.mixed() + t * DM + 256 + h * 64 + vh * 32 + d) = ov;
    }
  }
}

#define MFMA32(a, b, c) __builtin_amdgcn_mfma_f32_32x32x16_bf16((a), (b), (c), 0, 0, 0)
DI float max16(const f32x16& v) {
  float a = fmaxf(fmaxf(v[0], v[1]), v[2]), b = fmaxf(fmaxf(v[3], v[4]), v[5]), c = fmaxf(fmaxf(v[6], v[7]), v[8]);
  float d = fmaxf(fmaxf(v[9], v[10]), v[11]), e = fmaxf(fmaxf(v[12], v[13]), v[14]);
  return fmaxf(fmaxf(fmaxf(a, b), fmaxf(c, d)), fmaxf(e, v[15]));
}
DI void ph_mla_attn(const Params& p, char* smem, int L) {
  const int tid = otid(), wid = tid >> 6, lane = tid & 63, l32 = lane & 31, hh = lane >> 5;
  u16* sK = reinterpret_cast<u16*>(smem);
  u16* sV = sK + 2 * 128 * 104;
  uint4 konev = make_uint4(hh == 0 ? 0x00003F80u : 0u, 0u, 0u, 0u);
  const bf16x8 kone = __builtin_bit_cast(bf16x8, konev);
  for (int item = obid(); item < 256; item += gridDim.x) {
    const int xcd_ = item & 7, jx_ = item >> 3, bh = xcd_ * 2 + (jx_ >> 4), qt = jx_ & 15, b = bh >> 2, h = bh & 3;
    const size_t t0 = (size_t)b * SEQ + qt * 256 + wid * 32;
    bf16x8 qf[6];
#pragma unroll
    for (int ks = 0; ks < 6; ++ks) qf[ks] = *reinterpret_cast<const bf16x8*>(p.mq() + (t0 + l32) * 384 + h * 96 + ks * 16 + hh * 8);
    const u16* kg = p.kfull() + (size_t)bh * SEQ * 96;
    const u16* vg = p.vT() + (size_t)bh * 64 * SEQ;
    f32x16 o0, o1;
#pragma unroll
    for (int i = 0; i < 16; ++i) { o0[i] = 0.f; o1[i] = 0.f; }
    float m = 0.f, l = 0.f;
    bf16x8 qf6 = __builtin_bit_cast(bf16x8, make_uint4(0u, 0u, 0u, 0u));
    const int kr0 = tid / 12, kc0 = tid % 12, kr1 = (512 + tid) / 12, kc1 = (512 + tid) % 12, kr2 = (1024 + tid) / 12, kc2 = (1024 + tid) % 12;
    const int vd0 = tid >> 4, vd1 = 32 + (tid >> 4), vkc = (tid & 15) * 8;
    uint4 ak0, ak1, ak2, av0, av1;
#define MLA_LD(dst_, ptr_) asm volatile("global_load_dwordx4 %0, %1, off" : "=v"(dst_) : "v"(ptr_) : "memory")
#define MLA_GLOAD(K0, K1, K2, V0, V1, kt_)                                               \
    {                                                                                    \
      const u16* kb_ = kg + (size_t)(kt_) * 128 * 96 + tid * 8;                          \
      MLA_LD(K0, kb_); MLA_LD(K1, kb_ + 512 * 8); MLA_LD(K2, kb_ + 1024 * 8);            \
      const u16* vp_ = vg + (size_t)vd0 * SEQ + (kt_) * 128 + vkc;                       \
      MLA_LD(V0, vp_); MLA_LD(V1, vp_ + (size_t)32 * SEQ);                               \
    }
#define MLA_SSTORE(K0, K1, K2, V0, V1, buf_)                                             \
    {                                                                                    \
      u16* kb_ = sK + (buf_) * 128 * 104;                                                \
      u16* vb_ = sV + (buf_) * 64 * 136;                                                 \
      *reinterpret_cast<uint4*>(kb_ + kr0 * 104 + kc0 * 8) = K0;                         \
      *reinterpret_cast<uint4*>(kb_ + kr1 * 104 + kc1 * 8) = K1;                         \
      *reinterpret_cast<uint4*>(kb_ + kr2 * 104 + kc2 * 8) = K2;                         \
      *reinterpret_cast<uint4*>(vb_ + vd0 * 136 + vkc) = V0;                             \
      *reinterpret_cast<uint4*>(vb_ + vd1 * 136 + vkc) = V1;                             \
    }
    float mxrun = 0.f;
#define SGB(mask, n) __builtin_amdgcn_sched_group_barrier((mask), (n), 0)
#define MLA_KFRAG(kb_, sub_, ks_) (*reinterpret_cast<const bf16x8*>((kb_) + ((sub_) * 32 + l32) * 104 + (ks_) * 16 + hh * 8))
#define MLA_VFRAG(dst_, vb_, sub_, ks2_, dvt_) \
    dst_ = *reinterpret_cast<const bf16x8*>((vb_) + ((dvt_) * 32 + l32) * 136 + (sub_) * 32 + (ks2_) * 16 + hh * 8)
#define MLA_SOFTMAX(sc_, pa_, pb_)                                                                         \
    {                                                                                                      \
      mxrun = fmaxf(mxrun, max16(sc_));                                                                    \
      float ps0_ = 0.f, ps1_ = 0.f;                                                                        \
      _Pragma("unroll") for (int i = 0; i < 16; i += 2) {                                                  \
        sc_[i] = __builtin_amdgcn_exp2f(sc_[i]); sc_[i + 1] = __builtin_amdgcn_exp2f(sc_[i + 1]);          \
        ps0_ += sc_[i]; ps1_ += sc_[i + 1];                                                                \
      }                                                                                                    \
      l += ps0_ + ps1_;                                                                                    \
      uint4 pk_;                                                                                           \
      pk_.x = pack2(sc_[0], sc_[1]); pk_.y = pack2(sc_[2], sc_[3]); pk_.z = pack2(sc_[4], sc_[5]); pk_.w = pack2(sc_[6], sc_[7]); \
      pa_ = __builtin_bit_cast(bf16x8, pk_);                                                               \
      pk_.x = pack2(sc_[8], sc_[9]); pk_.y = pack2(sc_[10], sc_[11]); pk_.z = pack2(sc_[12], sc_[13]); pk_.w = pack2(sc_[14], sc_[15]); \
      pb_ = __builtin_bit_cast(bf16x8, pk_);                                                               \
    }
    auto compute_tile = [&](int cur, int half) {
      const u16* kb = sK + cur * 128 * 104 + half * 64 * 104;
      const u16* vb = sV + cur * 64 * 136 + half * 64;
      bf16x8 k0[6], k1[6];
#pragma unroll
      for (int ks = 0; ks < 6; ++ks) { k0[ks] = MLA_KFRAG(kb, 0, ks); k1[ks] = MLA_KFRAG(kb, 1, ks); }
      f32x16 s0, s1;
#pragma unroll
      for (int i = 0; i < 16; ++i) { s0[i] = 0.f; s1[i] = 0.f; }
#pragma unroll
      for (int ks = 0; ks < 6; ++ks) s0 = MFMA32(k0[ks], qf[ks], s0);
      s0 = MFMA32(kone, qf6, s0);
      bf16x8 v00, v01, v02, v03, v10, v11, v12, v13;
      MLA_VFRAG(v00, vb, 0, 0, 0); MLA_VFRAG(v01, vb, 0, 0, 1); MLA_VFRAG(v02, vb, 0, 1, 0); MLA_VFRAG(v03, vb, 0, 1, 1);
#pragma unroll
      for (int ks = 0; ks < 6; ++ks) s1 = MFMA32(k1[ks], qf[ks], s1);
      s1 = MFMA32(kone, qf6, s1);
      MLA_VFRAG(v10, vb, 1, 0, 0); MLA_VFRAG(v11, vb, 1, 0, 1); MLA_VFRAG(v12, vb, 1, 1, 0); MLA_VFRAG(v13, vb, 1, 1, 1);
      bf16x8 p0a, p0b, p1a, p1b;
      MLA_SOFTMAX(s0, p0a, p0b);
      o0 = MFMA32(v00, p0a, o0); o1 = MFMA32(v01, p0a, o1); o0 = MFMA32(v02, p0b, o0); o1 = MFMA32(v03, p0b, o1);
      MLA_SOFTMAX(s1, p1a, p1b);
      o0 = MFMA32(v10, p1a, o0); o1 = MFMA32(v11, p1a, o1); o0 = MFMA32(v12, p1b, o0); o1 = MFMA32(v13, p1b, o1);
      SGB(0x100, 12);
#pragma unroll
      for (int i = 0; i < 7; ++i) { SGB(0x008, 1); if (i < 4) SGB(0x100, 1); }
#pragma unroll
      for (int i = 0; i < 7; ++i) { SGB(0x008, 1); if (i < 4) SGB(0x100, 1); SGB(0x402, 7); }
#pragma unroll
      for (int i = 0; i < 4; ++i) { SGB(0x008, 1); SGB(0x402, 12); }
#pragma unroll
      for (int i = 0; i < 4; ++i) SGB(0x008, 1);
    };
    auto lazy_update = [&]() {
      const float mxr = fmaxf(mxrun, __shfl_xor(mxrun, 32));
      if (__builtin_amdgcn_ballot_w64(mxr > 8.f) != 0ull) {
        float d = (mxr > 8.f) ? mxr : 0.f;
        const float mnew = bf2f(f2bf(m + d));
        d = mnew - m;
        m = mnew;
        const float alpha = __builtin_amdgcn_exp2f(-d);
        l *= alpha;
        mxrun -= d;
#pragma unroll
        for (int i = 0; i < 16; ++i) { o0[i] *= alpha; o1[i] *= alpha; }
        uint4 qv = make_uint4(0u, 0u, 0u, 0u);
        if (hh == 0) qv.x = (unsigned)f2bf(-m);
        qf6 = __builtin_bit_cast(bf16x8, qv);
      }
    };
    unsigned char* cbuf = reinterpret_cast<unsigned char*>(sV + 2 * 64 * 136);
    const bool cvt_on = (gridDim.x == 256);
    f32x4 cv0, cv1, cv2, cv3;
    bool cvalid = false;
#define CVT_ISSUE(j_)                                                                                                   \
    {                                                                                                                   \
      const int g_ = CVT_B + obid() + 256 * (j_);                                                                       \
      cvalid = cvt_on && (g_ < 12288);                                                                                  \
      if (cvalid) {                                                                                                     \
        const CvtTile ct_ = cvt_tile(p, L, g_);                                                                         \
        const float* sp_ = ct_.src + (size_t)(ct_.k0 + (tid >> 5) * 4) * ct_.N + ct_.n0 + (tid & 31) * 4;              \
        cv0 = __builtin_nontemporal_load(reinterpret_cast<const f32x4*>(sp_));                                          \
        cv1 = __builtin_nontemporal_load(reinterpret_cast<const f32x4*>(sp_ + ct_.N));                                  \
        cv2 = __builtin_nontemporal_load(reinterpret_cast<const f32x4*>(sp_ + 2 * ct_.N));                              \
        cv3 = __builtin_nontemporal_load(reinterpret_cast<const f32x4*>(sp_ + 3 * ct_.N));                              \
      }                                                                                                                 \
    }
#define CVT_TO_LDS(par_)                                                                                                \
    if (cvalid) {                                                                                                       \
      unsigned char* cb_ = cbuf + (par_) * 10240 + (tid & 31) * 4 * 80 + (tid >> 5) * 4;                                \
      *reinterpret_cast<unsigned*>(cb_) = pk4_f8_scaled<256>(cv0[0], cv1[0], cv2[0], cv3[0]);       \
      *reinterpret_cast<unsigned*>(cb_ + 80) = pk4_f8_scaled<256>(cv0[1], cv1[1], cv2[1], cv3[1]);  \
      *reinterpret_cast<unsigned*>(cb_ + 160) = pk4_f8_scaled<256>(cv0[2], cv1[2], cv2[2], cv3[2]); \
      *reinterpret_cast<unsigned*>(cb_ + 240) = pk4_f8_scaled<256>(cv0[3], cv1[3], cv2[3], cv3[3]); \
    }
#define CVT_TO_GLOBAL(par_, j_)                                                                                         \
    if (cvalid) {                                                                                                       \
      const CvtTile ct_ = cvt_tile(p, L, CVT_B + obid() + 256 * (j_));        \
      unsigned char* cd_ = ct_.dst + (size_t)cvt_rowmap(ct_.mat, ct_.n0 + (tid >> 2)) * ct_.K + ct_.k0 + (tid & 3) * 16;  \
      *reinterpret_cast<uint4*>(cd_) = *reinterpret_cast<const uint4*>(cbuf + (par_) * 10240 + (tid >> 2) * 80 + (tid & 3) * 16); \
    }
    MLA_GLOAD(ak0, ak1, ak2, av0, av1, 0);
    asm volatile("s_waitcnt vmcnt(0)" ::: "memory");
    MLA_SSTORE(ak0, ak1, ak2, av0, av1, 0);
    __syncthreads();
    {
      f32x16 s0, s1;
#pragma unroll
      for (int i = 0; i < 16; ++i) { s0[i] = 0.f; s1[i] = 0.f; }
#pragma unroll
      for (int ks = 0; ks < 6; ++ks) { s0 = MFMA32(MLA_KFRAG(sK, 0, ks), qf[ks], s0); s1 = MFMA32(MLA_KFRAG(sK, 1, ks), qf[ks], s1); }
      float mx = fmaxf(max16(s0), max16(s1));
      mx = fmaxf(mx, __shfl_xor(mx, 32));
      m = bf2f(f2bf(mx));
      uint4 qv = make_uint4(0u, 0u, 0u, 0u);
      if (hh == 0) qv.x = (unsigned)f2bf(-m);
      qf6 = __builtin_bit_cast(bf16x8, qv);
    }
#pragma unroll 1
    for (int kt = 0; kt < 32; kt += 2) {
      MLA_GLOAD(ak0, ak1, ak2, av0, av1, kt + 1);
      CVT_ISSUE(kt);
#pragma unroll 1
      for (int half = 0; half < 2; ++half) compute_tile(0, half);
      asm volatile("s_waitcnt vmcnt(0)" ::: "memory");
      MLA_SSTORE(ak0, ak1, ak2, av0, av1, 1);
      CVT_TO_LDS(0);
      __syncthreads();
      CVT_TO_GLOBAL(0, kt);
      lazy_update();
      if (kt + 2 < 32) MLA_GLOAD(ak0, ak1, ak2, av0, av1, kt + 2);
      CVT_ISSUE(kt + 1);
#pragma unroll 1
      for (int half = 0; half < 2; ++half) compute_tile(1, half);
      asm volatile("s_waitcnt vmcnt(0)" ::: "memory");
      if (kt + 2 < 32) MLA_SSTORE(ak0, ak1, ak2, av0, av1, 0);
      CVT_TO_LDS(1);
      __syncthreads();
      CVT_TO_GLOBAL(1, kt + 1);
      lazy_update();
    }
    l += __shfl_xor(l, 32);
    const float il = 1.f / l;
    u16* orow = p.mixed() + (t0 + l32) * DM + 256 + h * 64 + hh * 4;
#pragma unroll
    for (int g = 0; g < 4; ++g) {
      uint2 v;
      v.x = pack2(o0[4 * g + 0] * il, o0[4 * g + 1] * il);
      v.y = pack2(o0[4 * g + 2] * il, o0[4 * g + 3] * il);
      *reinterpret_cast<uint2*>(orow + g * 8) = v;
      v.x = pack2(o1[4 * g + 0] * il, o1[4 * g + 1] * il);
      v.y = pack2(o1[4 * g + 2] * il, o1[4 * g + 3] * il);
      *reinterpret_cast<uint2*>(orow + 32 + g * 8) = v;
    }
  }
}

typedef __attribute__((address_space(3))) s16x4 lds_s16x4;
template <int MODE>
DI void ph_dil_pass(const Params& p, char* smem, int blk_) {
  const int tid = otid(), wid = tid >> 6, lane = tid & 63, l32 = lane & 31, hh = lane >> 5;
  u16* sV = reinterpret_cast<u16*>(smem) + wid * (2 * 32 * 72);
  const int i16 = lane & 15, tq = i16 >> 2, tp = i16 & 3, tblk = (lane >> 4) & 1;
  {
    constexpr int NT = (MODE == 0) ? 13 : 5;
    const int it = wid, xcd_ = blk_ & 7, jx_ = blk_ >> 3, bh = xcd_ * 2 + (jx_ >> 4), r = jx_ & 15, b = bh >> 2, h = bh & 3;
    const int i0 = it * 32;
    const int q0 = (r * 8 + it) * 32;
    const int qpos = (MODE == 0) ? (r + 16 * (i0 + l32)) : (q0 + l32);
    const size_t tb = (size_t)b * SEQ;
    const u16* kbase = p.proj() + tb * PWP + C_DK + h * 64;
    const u16* vbase = p.proj() + tb * PWP + C_DV + h * 64;
    bf16x8 qf[4];
    {
      const u16* qp = p.proj() + (tb + qpos) * PWP + C_DQ + h * 64 + hh * 8;
#pragma unroll
      for (int ks = 0; ks < 4; ++ks) qf[ks] = *reinterpret_cast<const bf16x8*>(qp + ks * 16);
    }
    f32x16 o0, o1;
#pragma unroll
    for (int i = 0; i < 16; ++i) { o0[i] = 0.f; o1[i] = 0.f; }
    float m = -1e30f, l = 0.f;
    auto tile_params = [&](int tt, int& d, int& rd, int& ub, int& ulim, int& qb, int& qs) {
      if (MODE == 0) {
        if (tt < 5) { d = 16; rd = r; qb = i0; qs = 1; ulim = 256; ub = qb - 64 + 32 * tt; }
        else { d = 4; rd = r & 3; qb = (r >> 2) + 4 * i0; qs = 4; ulim = 1024; ub = qb - 64 + 32 * (tt - 5); }
      } else { d = 1; rd = 0; qb = q0; qs = 1; ulim = 4096; ub = qb - 64 + 32 * tt; }
    };
    bf16x8 ka0, ka1, ka2, ka3, kb0, kb1, kb2, kb3;
    uint4 va0, va1, va2, va3, vb0, vb1, vb2, vb3;
#define DIL_LD(dst_, ptr_) asm volatile("global_load_dwordx4 %0, %1, off" : "=v"(dst_) : "v"(ptr_) : "memory")
#define DIL_GLOAD(K0, K1, K2, K3, V0, V1, V2, V3, tt_)                                                   \
    {                                                                                                    \
      int d_, rd_, ub_, ulim_, qb_, qs_;                                                                 \
      tile_params((tt_), d_, rd_, ub_, ulim_, qb_, qs_);                                                 \
      int u_ = min(max(ub_ + l32, 0), ulim_ - 1);                                                        \
      const u16* kp_ = kbase + (size_t)(rd_ + d_ * u_) * PWP + hh * 8;                                   \
      DIL_LD(K0, kp_); DIL_LD(K1, kp_ + 16); DIL_LD(K2, kp_ + 32); DIL_LD(K3, kp_ + 48);                 \
      const int kr_ = ub_ + (lane >> 3);                                                                 \
      const u16* vp_;                                                                                    \
      u_ = min(max(kr_, 0), ulim_ - 1);      vp_ = vbase + (size_t)(rd_ + d_ * u_) * PWP + (lane & 7) * 8; DIL_LD(V0, vp_); \
      u_ = min(max(kr_ + 8, 0), ulim_ - 1);  vp_ = vbase + (size_t)(rd_ + d_ * u_) * PWP + (lane & 7) * 8; DIL_LD(V1, vp_); \
      u_ = min(max(kr_ + 16, 0), ulim_ - 1); vp_ = vbase + (size_t)(rd_ + d_ * u_) * PWP + (lane & 7) * 8; DIL_LD(V2, vp_); \
      u_ = min(max(kr_ + 24, 0), ulim_ - 1); vp_ = vbase + (size_t)(rd_ + d_ * u_) * PWP + (lane & 7) * 8; DIL_LD(V3, vp_); \
    }
#define DIL_VSTORE(V0, V1, V2, V3, buf_)                                                                 \
    {                                                                                                    \
      u16* vb_ = sV + (buf_) * 32 * 72 + (lane >> 3) * 72 + (lane & 7) * 8;                              \
      *reinterpret_cast<uint4*>(vb_) = V0;                                                               \
      *reinterpret_cast<uint4*>(vb_ + 8 * 72) = V1;                                                      \
      *reinterpret_cast<uint4*>(vb_ + 16 * 72) = V2;                                                     \
      *reinterpret_cast<uint4*>(vb_ + 24 * 72) = V3;                                                     \
    }
    auto tile_rest = [&](int tt, f32x16 sc, int cur) {
      int d, rd, ub, ulim, qb, qs;
      tile_params(tt, d, rd, ub, ulim, qb, qs);
      const int uq = qb + qs * l32;
      const float cs = 0.125f * 1.4426950408889634f;
      float mx = -1e30f;
#pragma unroll
      for (int i = 0; i < 16; ++i) {
        const int u = ub + (i & 3) + 8 * (i >> 2) + 4 * hh;
        const int du = u - uq;
        const bool valid = (u >= 0) && (u < ulim) && (du <= 64) && (du >= -64);
        sc[i] = valid ? sc[i] * cs : -1e30f;
        mx = fmaxf(mx, sc[i]);
      }
      mx = fmaxf(mx, __shfl_xor(mx, 32));
      const float mn = fmaxf(m, mx);
      const float alpha = __builtin_amdgcn_exp2f(m - mn);
      m = mn;
      float ps = 0.f;
#pragma unroll
      for (int i = 0; i < 16; ++i) {
        float pe = __builtin_amdgcn_exp2f(sc[i] - mn);
        pe = (sc[i] > -1e29f) ? pe : 0.f;
        ps += pe;
        sc[i] = pe;
      }
      l = l * alpha + ps;
#pragma unroll
      for (int i = 0; i < 16; ++i) { o0[i] *= alpha; o1[i] *= alpha; }
      const u16* vb = sV + cur * 32 * 72;
#pragma unroll
      for (int ks2 = 0; ks2 < 2; ++ks2) {
        uint4 pk;
        pk.x = pack2(sc[8 * ks2 + 0], sc[8 * ks2 + 1]);
        pk.y = pack2(sc[8 * ks2 + 2], sc[8 * ks2 + 3]);
        pk.z = pack2(sc[8 * ks2 + 4], sc[8 * ks2 + 5]);
        pk.w = pack2(sc[8 * ks2 + 6], sc[8 * ks2 + 7]);
        const bf16x8 pb = __builtin_bit_cast(bf16x8, pk);
#pragma unroll
        for (int dvt = 0; dvt < 2; ++dvt) {
          const u16* a0 = vb + (16 * ks2 + 4 * hh + tq) * 72 + dvt * 32 + tblk * 16 + tp * 4;
          const s16x4 lo = __builtin_amdgcn_ds_read_tr16_b64_v4i16((lds_s16x4*)(a0));
          const s16x4 hi = __builtin_amdgcn_ds_read_tr16_b64_v4i16((lds_s16x4*)(a0 + 8 * 72));
          const bf16x8 a = __builtin_shufflevector(lo, hi, 0, 1, 2, 3, 4, 5, 6, 7);
          if (dvt == 0) o0 = MFMA32(a, pb, o0); else o1 = MFMA32(a, pb, o1);
        }
      }
    };
    DIL_GLOAD(ka0, ka1, ka2, ka3, va0, va1, va2, va3, 0);
    DIL_GLOAD(kb0, kb1, kb2, kb3, vb0, vb1, vb2, vb3, 1);
    asm volatile("s_waitcnt vmcnt(8)" ::: "memory");
    DIL_VSTORE(va0, va1, va2, va3, 0);
#pragma unroll 1
    for (int tt = 0; tt < NT; tt += 2) {
      {
        f32x16 sc;
#pragma unroll
        for (int i = 0; i < 16; ++i) sc[i] = 0.f;
        sc = MFMA32(ka0, qf[0], sc); sc = MFMA32(ka1, qf[1], sc); sc = MFMA32(ka2, qf[2], sc); sc = MFMA32(ka3, qf[3], sc);
        asm volatile("" :: "v"(sc));
        if (tt + 2 < NT) DIL_GLOAD(ka0, ka1, ka2, ka3, va0, va1, va2, va3, tt + 2);
        tile_rest(tt, sc, 0);
        if (tt + 1 < NT) {
          if (tt + 2 < NT) asm volatile("s_waitcnt vmcnt(8)" ::: "memory"); else asm volatile("s_waitcnt vmcnt(0)" ::: "memory");
          DIL_VSTORE(vb0, vb1, vb2, vb3, 1);
        }
      }
      if (tt + 1 < NT) {
        f32x16 sc;
#pragma unroll
        for (int i = 0; i < 16; ++i) sc[i] = 0.f;
        sc = MFMA32(kb0, qf[0], sc); sc = MFMA32(kb1, qf[1], sc); sc = MFMA32(kb2, qf[2], sc); sc = MFMA32(kb3, qf[3], sc);
        asm volatile("" :: "v"(sc));
        if (tt + 3 < NT) DIL_GLOAD(kb0, kb1, kb2, kb3, vb0, vb1, vb2, vb3, tt + 3);
        tile_rest(tt + 1, sc, 1);
        if (tt + 2 < NT) {
          if (tt + 3 < NT) asm volatile("s_waitcnt vmcnt(8)" ::: "memory"); else asm volatile("s_waitcnt vmcnt(0)" ::: "memory");
          DIL_VSTORE(va0, va1, va2, va3, 0);
        }
      }
    }
    l += __shfl_xor(l, 32);
    float* part = p.dpart() + ((tb + qpos) * 4 + h) * 68 + hh * 4;
    if (MODE == 0) {
#pragma unroll
      for (int g = 0; g < 4; ++g) {
        *reinterpret_cast<float4*>(part + g * 8) = make_float4(o0[4 * g + 0], o0[4 * g + 1], o0[4 * g + 2], o0[4 * g + 3]);
        *reinterpret_cast<float4*>(part + 32 + g * 8) = make_float4(o1[4 * g + 0], o1[4 * g + 1], o1[4 * g + 2], o1[4 * g + 3]);
      }
      if (hh == 0) { part[64] = m; part[65] = l; }
    } else {
      const float mA = part[64 - hh * 4], lA = part[65 - hh * 4];
      const float M = fmaxf(m, mA), sa = __builtin_amdgcn_exp2f(m - M), sb = __builtin_amdgcn_exp2f(mA - M);
      const float il = 1.f / (l * sa + lA * sb);
      u16* orow = p.mixed() + (tb + qpos) * DM + 768 + h * 64 + hh * 4;
#pragma unroll
      for (int g = 0; g < 4; ++g) {
        const float4 a0 = *reinterpret_cast<const float4*>(part + g * 8), a1 = *reinterpret_cast<const float4*>(part + 32 + g * 8);
        uint2 v;
        v.x = pack2((o0[4 * g + 0] * sa + a0.x * sb) * il, (o0[4 * g + 1] * sa + a0.y * sb) * il);
        v.y = pack2((o0[4 * g + 2] * sa + a0.z * sb) * il, (o0[4 * g + 3] * sa + a0.w * sb) * il);
        *reinterpret_cast<uint2*>(orow + g * 8) = v;
        v.x = pack2((o1[4 * g + 0] * sa + a1.x * sb) * il, (o1[4 * g + 1] * sa + a1.y * sb) * il);
        v.y = pack2((o1[4 * g + 2] * sa + a1.z * sb) * il, (o1[4 * g + 3] * sa + a1.w * sb) * il);
        *reinterpret_cast<uint2*>(orow + 32 + g * 8) = v;
      }
    }
  }
}

DI void ph_dil_naive(const Params& p) {
  const int gt = obid() * NTHR + otid(), gs = gridDim.x * NTHR;
  for (int it = gt; it < 4 * 4 * SEQ; it += gs) {
    const int n = it & (SEQ - 1), h = (it >> 12) & 3, b = it >> 14;
    const size_t tb = (size_t)b * SEQ;
    uint4 qp[8];
    float o[64];
#pragma unroll
    for (int d = 0; d < 8; ++d) qp[d] = *reinterpret_cast<const uint4*>(p.proj() + (tb + n) * PWP + C_DQ + h * 64 + d * 8);
    float mx = -1e30f;
    for (int pat = 0; pat < 3; ++pat) {
      const int dil = (pat == 0) ? 1 : (pat == 1 ? 4 : 16);
#pragma unroll 1
      for (int j = -64; j <= 64; ++j) {
        const int pos = n + j * dil;
        if (pos < 0 || pos >= SEQ) continue;
        const u16* kr = p.proj() + (tb + pos) * PWP + C_DK + h * 64;
        float s = 0.f;
#pragma unroll
        for (int d = 0; d < 8; ++d) s = dot8(qp[d], *reinterpret_cast<const uint4*>(kr + d * 8), s);
        s *= 0.125f;
        mx = fmaxf(mx, s);
      }
    }
#pragma unroll
    for (int d = 0; d < 64; ++d) o[d] = 0.f;
    float l = 0.f;
    for (int pat = 0; pat < 3; ++pat) {
      const int dil = (pat == 0) ? 1 : (pat == 1 ? 4 : 16);
#pragma unroll 1
      for (int j = -64; j <= 64; ++j) {
        const int pos = n + j * dil;
        if (pos < 0 || pos >= SEQ) continue;
        const u16* kr = p.proj() + (tb + pos) * PWP + C_DK + h * 64;
        const u16* vr = p.proj() + (tb + pos) * PWP + C_DV + h * 64;
        float s = 0.f;
#pragma unroll
        for (int d = 0; d < 8; ++d) s = dot8(qp[d], *reinterpret_cast<const uint4*>(kr + d * 8), s);
        s *= 0.125f;
        const float pe = __expf(s - mx);
        l += pe;
#pragma unroll
        for (int d = 0; d < 64; d += 8) {
          float vf[8];
          ld8(vr + d, vf);
#pragma unroll
          for (int jj = 0; jj < 8; ++jj) o[d + jj] += pe * vf[jj];
        }
      }
    }
    const float il = 1.f / l;
#pragma unroll
    for (int d = 0; d < 64; d += 8) {
      uint4 ov;
      ov.x = pack2(o[d + 0] * il, o[d + 1] * il);
      ov.y = pack2(o[d + 2] * il, o[d + 3] * il);
      ov.z = pack2(o[d + 4] * il, o[d + 5] * il);
      ov.w = pack2(o[d + 6] * il, o[d + 7] * il);
      *reinterpret_cast<uint4*>(p.mixed() + (tb + n) * DM + 768 + h * 64 + d) = ov;
    }
  }
}

DI void ph_ssd_naive(const Params& p, int L) {
  const int gt = obid() * NTHR + otid(), gs = gridDim.x * NTHR;
  for (int it = gt; it < 4 * 4 * 4 * SEQ; it += gs) {
    const int l = it & (SEQ - 1), pq = (it >> 12) & 3, h = (it >> 14) & 3, b = it >> 16;
    const int g = h >> 1;
    const size_t tb = (size_t)b * SEQ;
    uint4 cl[16];
    float acc[16];
#pragma unroll
    for (int d = 0; d < 16; ++d) cl[d] = *reinterpret_cast<const uint4*>(p.xbc() + (tb + l) * 768 + 512 + g * 128 + d * 8);
#pragma unroll
    for (int d = 0; d < 16; ++d) acc[d] = 0.f;
    const float pl = p.cs()[(tb + l) * 8 + h], rl = p.cs()[(tb + l) * 8 + 4 + h];
#pragma unroll 1
    for (int s = 0; s < SEQ; ++s) {
      const u16* br = p.xbc() + (tb + s) * 768 + 256 + g * 128;
      float cbv = 0.f;
#pragma unroll
      for (int d = 0; d < 16; ++d) cbv = dot8(cl[d], *reinterpret_cast<const uint4*>(br + d * 8), cbv);
      float w;
      if (s <= l) w = expf(pl - p.cs()[(tb + s) * 8 + h]) * p.dtv()[(tb + s) * 8 + h];
      else w = expf(rl - p.cs()[(tb + s) * 8 + 4 + h]) * p.dtv()[(tb + s) * 8 + 4 + h];
      cbv *= w;
      const u16* xr = p.xbc() + (tb + s) * 768 + h * 64 + pq * 16;
#pragma unroll
      for (int d = 0; d < 16; d += 8) {
        float xf[8];
        ld8(xr + d, xf);
#pragma unroll
        for (int j = 0; j < 8; ++j) acc[d + j] += cbv * xf[j];
      }
    }
    const float dsk = p.ssm_d[L * 4 + h];
#pragma unroll
    for (int d = 0; d < 16; ++d) {
      const int c = h * 64 + pq * 16 + d;
      const float xv = bf2f(p.xbc()[(tb + l) * 768 + c]);
      const float z = bf2f(p.proj()[(tb + l) * PWP + C_Z + c]);
      p.ybuf()[(tb + l) * 256 + c] = (acc[d] + dsk * xv) * silu(z);
    }
  }
}

DI void ph_ssd_norm(const Params& p, int L) {
  const int tid_ = otid(); const int lane = tid_ & 63, gw = (obid() * NTHR + tid_) >> 6, nw = gridDim.x * (NTHR / 64);
  const float* nwt = p.ssm_norm_w + L * 256;
  for (int t = gw; t < T; t += nw) {
    const float4 v = *reinterpret_cast<const float4*>(p.ybuf() + (size_t)t * 256 + lane * 4);
    float ss = wave_sum(v.x * v.x + v.y * v.y + v.z * v.z + v.w * v.w);
    const float rstd = rsqrtf(ss * (1.f / 256.f) + 1e-6f);
    const float4 ww = *reinterpret_cast<const float4*>(nwt + lane * 4);
    uint2 o;
    o.x = pack2(v.x * rstd * ww.x, v.y * rstd * ww.y);
    o.y = pack2(v.z * rstd * ww.z, v.w * rstd * ww.w);
    *reinterpret_cast<uint2*>(p.mixed() + (size_t)t * DM + 512 + lane * 4) = o;
  }
}

#define MFMA16(a, b, c) __builtin_amdgcn_mfma_f32_16x16x32_bf16((a), (b), (c), 0, 0, 0)
template <int MT, int NT, int KS>
DI void wave_mm(f32x4 (&acc)[MT][NT], const u16* a0, int lda, const u16* b0, int ldb, int fr, int fq) {
#pragma unroll
  for (int ks = 0; ks < KS; ++ks) {
    bf16x8 af[MT], bfv[NT];
#pragma unroll
    for (int m = 0; m < MT; ++m) af[m] = *reinterpret_cast<const bf16x8*>(a0 + (m * 16 + fr) * lda + ks * 32 + fq * 8);
#pragma unroll
    for (int n = 0; n < NT; ++n) bfv[n] = *reinterpret_cast<const bf16x8*>(b0 + (n * 16 + fr) * ldb + ks * 32 + fq * 8);
#pragma unroll
    for (int m = 0; m < MT; ++m)
#pragma unroll
      for (int n = 0; n < NT; ++n) acc[m][n] = MFMA16(af[m], bfv[n], acc[m][n]);
  }
}
template <int MT, int NT>
DI void zero_acc(f32x4 (&acc)[MT][NT]) {
#pragma unroll
  for (int m = 0; m < MT; ++m)
#pragma unroll
    for (int n = 0; n < NT; ++n) acc[m][n] = f32x4{0.f, 0.f, 0.f, 0.f};
}
template <int NROWS, int NCOLS>
DI void stage_rows(u16* dst, int ldd, const u16* src, size_t lsrc, int tid) {
  constexpr int CPR = NCOLS / 8, NCH = NROWS * CPR / NTHR;
  static_assert(NROWS * CPR % NTHR == 0, "tile must be a multiple of 512 chunks");
  uint4 r[NCH];
#pragma unroll
  for (int i = 0; i < NCH; ++i) {
    const int c = tid + i * NTHR, row = c / CPR, cc = c % CPR;
    r[i] = *reinterpret_cast<const uint4*>(src + (size_t)row * lsrc + cc * 8);
  }
#pragma unroll
  for (int i = 0; i < NCH; ++i) {
    const int c = tid + i * NTHR, row = c / CPR, cc = c % CPR;
    *reinterpret_cast<uint4*>(dst + row * ldd + cc * 8) = r[i];
  }
}
template <int NCOLS, class W>
DI void stage_T(u16* dst, int ldd, const u16* src, size_t lsrc, int tid, W w) {
  constexpr int NCH = 128 * (NCOLS / 8) / NTHR;
  uint4 r[NCH];
#pragma unroll
  for (int i = 0; i < NCH; ++i) {
    const int c = tid + i * NTHR, j = c & 127, cc = c >> 7;
    r[i] = *reinterpret_cast<const uint4*>(src + (size_t)j * lsrc + cc * 8);
  }
#pragma unroll
  for (int i = 0; i < NCH; ++i) {
    const int c = tid + i * NTHR, j = c & 127, cc = c >> 7;
    float f[8];
    unpack8(r[i], f);
    const float wj = w(j);
#pragma unroll
    for (int e = 0; e < 8; ++e) dst[(cc * 8 + e) * ldd + j] = f2bf(f[e] * wj);
  }
}

template <int NROWS, int NCOLS>
DI void stage_rows_ld(uint4 (&r)[NROWS * (NCOLS / 8) / NTHR], const u16* src, size_t lsrc, int tid) {
  constexpr int CPR = NCOLS / 8, NCH = NROWS * CPR / NTHR;
#pragma unroll
  for (int i = 0; i < NCH; ++i) {
    const int c = tid + i * NTHR, row = c / CPR, cc = c % CPR;
    r[i] = *reinterpret_cast<const uint4*>(src + (size_t)row * lsrc + cc * 8);
  }
}
template <int NROWS, int NCOLS>
DI void stage_rows_st(u16* dst, int ldd, const uint4 (&r)[NROWS * (NCOLS / 8) / NTHR], int tid) {
  constexpr int CPR = NCOLS / 8, NCH = NROWS * CPR / NTHR;
#pragma unroll
  for (int i = 0; i < NCH; ++i) {
    const int c = tid + i * NTHR, row = c / CPR, cc = c % CPR;
    *reinterpret_cast<uint4*>(dst + row * ldd + cc * 8) = r[i];
  }
}
template <int NCOLS>
DI void stage_T_ld(uint4 (&r)[128 * (NCOLS / 8) / NTHR], const u16* src, size_t lsrc, int tid) {
  constexpr int NCH = 128 * (NCOLS / 8) / NTHR;
#pragma unroll
  for (int i = 0; i < NCH; ++i) {
    const int c = tid + i * NTHR, j = c & 127, cc = c >> 7;
    r[i] = *reinterpret_cast<const uint4*>(src + (size_t)j * lsrc + cc * 8);
  }
}
template <int NCOLS, class W>
DI void stage_T_st(u16* dst, int ldd, const uint4 (&r)[128 * (NCOLS / 8) / NTHR], int tid, W w) {
  constexpr int NCH = 128 * (NCOLS / 8) / NTHR;
#pragma unroll
  for (int i = 0; i < NCH; ++i) {
    const int c = tid + i * NTHR, j = c & 127, cc = c >> 7;
    float f[8];
    unpack8(r[i], f);
    const float wj = w(j);
#pragma unroll
    for (int e = 0; e < 8; ++e) dst[(cc * 8 + e) * ldd + j] = f2bf(f[e] * wj);
  }
}

DI void ph_ret_a(const Params& p, char* smem, int item) {
  const int tid = otid(), wid = tid >> 6, lane = tid & 63, fr = lane & 15, fq = lane >> 4;
  u16* sVt = reinterpret_cast<u16*>(smem);
  u16* sKf = sVt + 64 * 136;
  u16* sKb = sKf + 64 * 136;
  {
    const int c = item & 31, bh = item >> 5, b = bh >> 2, h = bh & 3;
    const float lg0 = log1pf(-exp2f(-5.f - (float)h)), lg1 = log1pf(-exp2f(-5.5f - (float)h));
    const u16* src = p.proj() + ((size_t)b * SEQ + c * 128) * PWP;
    {
      uint4 rv[2], rk[2];
      stage_T_ld<64>(rv, src + C_RV + h * 64, PWP, tid);
      stage_T_ld<64>(rk, src + C_RK + h * 64, PWP, tid);
      stage_T_st<64>(sVt, 136, rv, tid, [](int) { return 1.f; });
      stage_T_st<64>(sKf, 136, rk, tid, [&](int j) { return __expf(lg0 * (float)(127 - j)); });
      stage_T_st<64>(sKb, 136, rk, tid, [&](int j) { return __expf(lg1 * (float)j); });
    }
    __syncthreads();
    const int dir = wid >> 2, q = wid & 3;
    f32x4 acc[1][4];
    zero_acc(acc);
    wave_mm<1, 4, 4>(acc, sVt + q * 16 * 136, 136, dir ? sKb : sKf, 136, fr, fq);
    float* out = p.rU() + ((size_t)(bh * 32 + c) * 2 + dir) * 4096;
#pragma unroll
    for (int n = 0; n < 4; ++n)
#pragma unroll
      for (int j = 0; j < 4; ++j) out[(q * 16 + fq * 4 + j) * 64 + n * 16 + fr] = acc[0][n][j];
    __syncthreads();
  }
}
DI void ph_ret_scan(const Params& p) {
  const int gt = obid() * NTHR + otid(), gs = gridDim.x * NTHR;
  for (int it = gt; it < 16 * 2 * 4096; it += gs) {
    const int e = it & 4095, dir = (it >> 12) & 1, bh = it >> 13, h = bh & 3;
    const float lg = log1pf(-exp2f((dir ? -5.5f : -5.f) - (float)h));
    const float cd = __expf(lg * 128.f);
    float u[32];
#pragma unroll
    for (int c = 0; c < 32; ++c) u[c] = p.rU()[((size_t)(bh * 32 + c) * 2 + dir) * 4096 + e];
    float st = 0.f;
    if (dir == 0) {
#pragma unroll
      for (int c = 0; c < 32; ++c) {
        p.rS()[((size_t)(bh * 32 + c) * 2 + dir) * 4096 + e] = f2bf(st);
        st = st * cd + u[c];
      }
    } else {
#pragma unroll
      for (int c = 31; c >= 0; --c) {
        p.rS()[((size_t)(bh * 32 + c) * 2 + dir) * 4096 + e] = f2bf(st);
        st = st * cd + u[c];
      }
    }
  }
}
DI void ph_ret_c(const Params& p, char* smem, int item) {
  const int tid = otid(), wid = tid >> 6, lane = tid & 63, fr = lane & 15, fq = lane >> 4;
  u16* sQ = reinterpret_cast<u16*>(smem);
  u16* sK = sQ + 128 * 72;
  u16* sVt = sK + 128 * 72;
  u16* sSf = sVt + 64 * 136;
  u16* sSb = sSf + 64 * 72;
  u16* sP = sSb + 64 * 72;
  {
    const int c = item & 31, bh = item >> 5, b = bh >> 2, h = bh & 3;
    const float lg0 = log1pf(-exp2f(-5.f - (float)h)), lg1 = log1pf(-exp2f(-5.5f - (float)h));
    const size_t t0 = (size_t)b * SEQ + c * 128;
    const u16* src = p.proj() + t0 * PWP;
    {
      uint4 rq[2], rk[2], rv[2], rf[1], rb[1];
      stage_rows_ld<128, 64>(rq, src + C_RQ + h * 64, PWP, tid);
      stage_rows_ld<128, 64>(rk, src + C_RK + h * 64, PWP, tid);
      stage_T_ld<64>(rv, src + C_RV + h * 64, PWP, tid);
      stage_rows_ld<64, 64>(rf, p.rS() + ((size_t)(bh * 32 + c) * 2 + 0) * 4096, 64, tid);
      stage_rows_ld<64, 64>(rb, p.rS() + ((size_t)(bh * 32 + c) * 2 + 1) * 4096, 64, tid);
      stage_rows_st<128, 64>(sQ, 72, rq, tid);
      stage_rows_st<128, 64>(sK, 72, rk, tid);
      stage_T_st<64>(sVt, 136, rv, tid, [](int) { return 1.f; });
      stage_rows_st<64, 64>(sSf, 72, rf, tid);
      stage_rows_st<64, 64>(sSb, 72, rb, tid);
    }
    __syncthreads();
    {
      const int wr = wid >> 1, wc = wid & 1;
      f32x4 sacc[2][4];
      zero_acc(sacc);
      wave_mm<2, 4, 2>(sacc, sQ + wr * 32 * 72, 72, sK + wc * 64 * 72, 72, fr, fq);
#pragma unroll
      for (int m = 0; m < 2; ++m)
#pragma unroll
        for (int n = 0; n < 4; ++n)
#pragma unroll
          for (int j = 0; j < 4; ++j) {
            const int i = wr * 32 + m * 16 + fq * 4 + j, jj = wc * 64 + n * 16 + fr;
            const float dcy = (jj <= i) ? __expf(lg0 * (float)(i - jj)) : __expf(lg1 * (float)(jj - i));
            sP[i * 136 + jj] = f2bf(sacc[m][n][j] * dcy);
          }
    }
    __syncthreads();
    {
      f32x4 ai[1][4], af_[1][4], ab_[1][4];
      zero_acc(ai); zero_acc(af_); zero_acc(ab_);
      wave_mm<1, 4, 4>(ai, sP + wid * 16 * 136, 136, sVt, 136, fr, fq);
      wave_mm<1, 4, 2>(af_, sQ + wid * 16 * 72, 72, sSf, 72, fr, fq);
      wave_mm<1, 4, 2>(ab_, sQ + wid * 16 * 72, 72, sSb, 72, fr, fq);
#pragma unroll
      for (int j = 0; j < 4; ++j) {
        const int i = wid * 16 + fq * 4 + j;
        const float xf = __expf(lg0 * (float)(i + 1)), xb = __expf(lg1 * (float)(128 - i));
        float o[4], sum = 0.f;
#pragma unroll
        for (int n = 0; n < 4; ++n) { o[n] = ai[0][n][j] + xf * af_[0][n][j] + xb * ab_[0][n][j]; sum += o[n]; }
#pragma unroll
        for (int sft = 1; sft < 16; sft <<= 1) sum += __shfl_xor(sum, sft);
        const float mu = sum * (1.f / 64.f);
        float var = 0.f;
#pragma unroll
        for (int n = 0; n < 4; ++n) var += (o[n] - mu) * (o[n] - mu);
#pragma unroll
        for (int sft = 1; sft < 16; sft <<= 1) var += __shfl_xor(var, sft);
        const float rs = rsqrtf(var * (1.f / 64.f) + 1e-5f);
#pragma unroll
        for (int n = 0; n < 4; ++n) {
          const float g = bf2f(p.proj()[(t0 + i) * PWP + C_RG + h * 64 + n * 16 + fr]);
          p.mixed()[(t0 + i) * DM + h * 64 + n * 16 + fr] = f2bf(silu(g) * (o[n] - mu) * rs);
        }
      }
    }
    __syncthreads();
  }
}

DI void ssd_local_cumsum(const Params& p, int L, size_t t0, float* cum, float* dtl, int wid, int lane) {
  const int dir = wid >> 2, h = wid & 3;
  const float a = -__expf(p.a_log[L * 8 + dir * 4 + h]);
  float d0, d1;
  if (dir == 0) { d0 = p.dtv()[(t0 + 2 * lane) * 8 + h]; d1 = p.dtv()[(t0 + 2 * lane + 1) * 8 + h]; }
  else { d0 = p.dtv()[(t0 + 127 - 2 * lane) * 8 + 4 + h]; d1 = p.dtv()[(t0 + 126 - 2 * lane) * 8 + 4 + h]; }
  float v0 = d0 * a, v1 = v0 + d1 * a;
  float run = v1;
#pragma unroll
  for (int o = 1; o < 64; o <<= 1) {
    const float u = __shfl_up(run, o);
    if (lane >= o) run += u;
  }
  const float excl = run - v1;
  v0 += excl; v1 += excl;
  float* cr = cum + (dir * 4 + h) * 128;
  float* dr = dtl + (dir * 4 + h) * 128;
  if (dir == 0) { cr[2 * lane] = v0; cr[2 * lane + 1] = v1; dr[2 * lane] = d0; dr[2 * lane + 1] = d1; }
  else { cr[127 - 2 * lane] = v0; cr[126 - 2 * lane] = v1; dr[127 - 2 * lane] = d0; dr[126 - 2 * lane] = d1; }
}

DI void ph_ssd_a(const Params& p, int L, char* smem, int item) {
  const int tid = otid(), wid = tid >> 6, lane = tid & 63, fr = lane & 15, fq = lane >> 4;
  u16* sBt = reinterpret_cast<u16*>(smem);
  u16* sXf = sBt + 2 * 128 * 136;
  u16* sXb = sXf + 64 * 136;
  float* cum = reinterpret_cast<float*>(sXb + 64 * 136);
  float* dtl = cum + 8 * 128;
  {
    const int c = item & 31, b = item >> 5;
    const size_t t0 = (size_t)b * SEQ + c * 128;
    ssd_local_cumsum(p, L, t0, cum, dtl, wid, lane);
    stage_T<256>(sBt, 136, p.xbc() + t0 * 768 + 256, 768, tid, [](int) { return 1.f; });
    __syncthreads();
    if (tid < 8) {
      const int dir = tid >> 2;
      p.cdec()[(size_t)item * 8 + tid] = __expf(dir ? cum[tid * 128 + 0] : cum[tid * 128 + 127]);
    }
    for (int h = 0; h < 4; ++h) {
      const float* cf = cum + h * 128;
      const float* cb = cum + (4 + h) * 128;
      const float* df = dtl + h * 128;
      const float* db = dtl + (4 + h) * 128;
      const float endf = cf[127], endb = cb[0];
      {
        uint4 rx[2];
        stage_T_ld<64>(rx, p.xbc() + t0 * 768 + h * 64, 768, tid);
        stage_T_st<64>(sXf, 136, rx, tid, [&](int l) { return __expf(endf - cf[l]) * df[l]; });
        stage_T_st<64>(sXb, 136, rx, tid, [&](int l) { return __expf(endb - cb[l]) * db[l]; });
      }
      __syncthreads();
      const int dir = wid >> 2, q = wid & 3, g = h >> 1;
      f32x4 acc[4][2];
      zero_acc(acc);
      wave_mm<4, 2, 4>(acc, dir ? sXb : sXf, 136, sBt + (g * 128 + q * 32) * 136, 136, fr, fq);
      float* out = p.sU() + ((size_t)item * 8 + h * 2 + dir) * 8192;
#pragma unroll
      for (int m = 0; m < 4; ++m)
#pragma unroll
        for (int n = 0; n < 2; ++n)
#pragma unroll
          for (int j = 0; j < 4; ++j) out[(m * 16 + fq * 4 + j) * 128 + q * 32 + n * 16 + fr] = acc[m][n][j];
      __syncthreads();
    }
  }
}
DI void ph_ssd_scan(const Params& p) {
  const int gt = obid() * NTHR + otid(), gs = gridDim.x * NTHR;
  for (int it = gt; it < 4 * 8 * 8192; it += gs) {
    const int e = it & 8191, hd = (it >> 13) & 7, b = it >> 16;
    const int dir = hd & 1, h = hd >> 1;
    float u[32];
#pragma unroll
    for (int c = 0; c < 32; ++c) u[c] = p.sU()[((size_t)(b * 32 + c) * 8 + hd) * 8192 + e];
    float st = 0.f;
    if (dir == 0) {
#pragma unroll
      for (int c = 0; c < 32; ++c) {
        p.sS()[((size_t)(b * 32 + c) * 8 + hd) * 8192 + e] = f2bf(st);
        st = st * p.cdec()[(size_t)(b * 32 + c) * 8 + dir * 4 + h] + u[c];
      }
    } else {
#pragma unroll
      for (int c = 31; c >= 0; --c) {
        p.sS()[((size_t)(b * 32 + c) * 8 + hd) * 8192 + e] = f2bf(st);
        st = st * p.cdec()[(size_t)(b * 32 + c) * 8 + dir * 4 + h] + u[c];
      }
    }
  }
}
DI void ph_ssd_c(const Params& p, int L, char* smem, int item) {
  const int tid = otid(), wid = tid >> 6, lane = tid & 63, fr = lane & 15, fq = lane >> 4;
  u16* sC = reinterpret_cast<u16*>(smem);
  u16* sB = sC + 128 * 136;
  u16* sXt = sB + 128 * 136;
  u16* sSf = sXt + 64 * 136;
  u16* sSb = sSf + 64 * 136;
  float* cum = reinterpret_cast<float*>(sSb + 64 * 136);
  float* dtl = cum + 8 * 128;
  {
    const int c = item & 31, b = item >> 5;
    const size_t t0 = (size_t)b * SEQ + c * 128;
    ssd_local_cumsum(p, L, t0, cum, dtl, wid, lane);
    float ssq[4] = {0.f, 0.f, 0.f, 0.f};
#pragma unroll 1
    for (int g = 0; g < 2; ++g) {
      {
        uint4 rc[4], rb4[4];
        stage_rows_ld<128, 128>(rc, p.xbc() + t0 * 768 + 512 + g * 128, 768, tid);
        stage_rows_ld<128, 128>(rb4, p.xbc() + t0 * 768 + 256 + g * 128, 768, tid);
        stage_rows_st<128, 128>(sC, 136, rc, tid);
        stage_rows_st<128, 128>(sB, 136, rb4, tid);
      }
      __syncthreads();
      const int wr = wid >> 1, wc = wid & 1;
      f32x4 G[2][4];
      zero_acc(G);
      wave_mm<2, 4, 4>(G, sC + wr * 32 * 136, 136, sB + wc * 64 * 136, 136, fr, fq);
      __syncthreads();
#pragma unroll 1
      for (int hl = 0; hl < 2; ++hl) {
        const int h = g * 2 + hl;
        const float* cf = cum + h * 128;
        const float* cb = cum + (4 + h) * 128;
        const float* df = dtl + h * 128;
        const float* db = dtl + (4 + h) * 128;
        uint4 rxt[2], rsf[2], rsb[2];
        stage_T_ld<64>(rxt, p.xbc() + t0 * 768 + h * 64, 768, tid);
        stage_rows_ld<64, 128>(rsf, p.sS() + ((size_t)item * 8 + h * 2 + 0) * 8192, 128, tid);
        stage_rows_ld<64, 128>(rsb, p.sS() + ((size_t)item * 8 + h * 2 + 1) * 8192, 128, tid);
#pragma unroll
        for (int m = 0; m < 2; ++m)
#pragma unroll
          for (int n = 0; n < 4; ++n)
#pragma unroll
            for (int j = 0; j < 4; ++j) {
              const int l = wr * 32 + m * 16 + fq * 4 + j, sx = wc * 64 + n * 16 + fr;
              const float w = (sx <= l) ? __expf(cf[l] - cf[sx]) * df[sx] : __expf(cb[l] - cb[sx]) * db[sx];
              sB[l * 136 + sx] = f2bf(G[m][n][j] * w);
            }
        stage_T_st<64>(sXt, 136, rxt, tid, [](int) { return 1.f; });
        stage_rows_st<64, 128>(sSf, 136, rsf, tid);
        stage_rows_st<64, 128>(sSb, 136, rsb, tid);
        __syncthreads();
        f32x4 yd[1][4], yf[1][4], yb[1][4];
        zero_acc(yd); zero_acc(yf); zero_acc(yb);
        wave_mm<1, 4, 4>(yd, sB + wid * 16 * 136, 136, sXt, 136, fr, fq);
        wave_mm<1, 4, 4>(yf, sC + wid * 16 * 136, 136, sSf, 136, fr, fq);
        wave_mm<1, 4, 4>(yb, sC + wid * 16 * 136, 136, sSb, 136, fr, fq);
        const float dsk = p.ssm_d[L * 4 + h];
#pragma unroll
        for (int j = 0; j < 4; ++j) {
          const int l = wid * 16 + fq * 4 + j;
          const float ef = __expf(cf[l]), eb = __expf(cb[l]);
#pragma unroll
          for (int n = 0; n < 4; ++n) {
            const int ch = h * 64 + n * 16 + fr;
            const float xv = bf2f(p.xbc()[(t0 + l) * 768 + ch]);
            const float z = bf2f(p.proj()[(t0 + l) * PWP + C_Z + ch]);
            const float yv = (yd[0][n][j] + ef * yf[0][n][j] + eb * yb[0][n][j] + dsk * xv) * silu(z);
            ssq[j] += yv * yv;
            p.ybuf()[(t0 + l) * 256 + ch] = yv;
          }
        }
        __syncthreads();
      }
    }
    const float* nwt = p.ssm_norm_w + L * 256;
#pragma unroll
    for (int j = 0; j < 4; ++j) {
      float ss = ssq[j];
#pragma unroll
      for (int sft = 1; sft < 16; sft <<= 1) ss += __shfl_xor(ss, sft);
      const float rstd = rsqrtf(ss * (1.f / 256.f) + 1e-6f);
      const int l = wid * 16 + fq * 4 + j;
#pragma unroll
      for (int hn = 0; hn < 16; ++hn) {
        const int ch = hn * 16 + fr;
        p.mixed()[(t0 + l) * DM + 512 + ch] = f2bf(p.ybuf()[(t0 + l) * 256 + ch] * rstd * nwt[ch]);
      }
    }
  }
}

template <bool XIN_F32>
struct CfgOutproj {
  static constexpr bool PERM = true;
  int K; const Params* p; int L; int bid, nb; const void* xin; u16* xout;
  DI bool next(int i, pg8::Unit& u) const { const int t = i * nb + bid; if (t >= 64 * 4) return false; u.pm = t & 63; u.pn = t >> 6; return true; }
  DI const char* a_base(const pg8::Unit& u) const { return (const char*)(p->mixed() + (size_t)u.pm * 256 * DM); }
  DI const char* b_base(const pg8::Unit& u) const { return (const char*)(p->WoutT() + ((size_t)L * DM + (size_t)u.pn * 256) * DM); }
  DI void a_off(const pg8::Unit&, int R0, int C0, int R1, int C1, unsigned (&vo)[4]) const {
    vo[0] = (unsigned)(R0 * DM + C0) * 2u; vo[1] = (unsigned)(R1 * DM + C1) * 2u;
    vo[2] = vo[0] + 128u * DM * 2u; vo[3] = vo[1] + 128u * DM * 2u;
  }
  DI void epi(const f32x4 (&acc)[2][2][4][2], const pg8::Unit& u, int wr, int wc, int fr, int fq) const {
    const int row0 = u.pm * 256 + wr * 64 + fr, col0 = u.pn * 256 + wc * 32 + 8 * fq;
#pragma unroll
    for (int ai = 0; ai < 2; ++ai)
#pragma unroll
      for (int m = 0; m < 4; ++m) {
        const size_t ro = (size_t)(row0 + ai * 128 + m * 16) * DM + col0;
#pragma unroll
        for (int bj = 0; bj < 2; ++bj) {
          const size_t o = ro + bj * 128;
          float4 x0, x1;
          if (XIN_F32) {
            x0 = *reinterpret_cast<const float4*>(static_cast<const float*>(xin) + o);
            x1 = *reinterpret_cast<const float4*>(static_cast<const float*>(xin) + o + 4);
          } else {
            const uint4 q = *reinterpret_cast<const uint4*>(static_cast<const u16*>(xin) + o);
            x0 = bf4_to_f4(make_uint2(q.x, q.y)); x1 = bf4_to_f4(make_uint2(q.z, q.w));
          }
          const f32x4 a0 = acc[ai][bj][m][0], a1 = acc[ai][bj][m][1];
          uint4 w;
          w.x = pack2(x0.x + a0[0], x0.y + a0[1]); w.y = pack2(x0.z + a0[2], x0.w + a0[3]);
          w.z = pack2(x1.x + a1[0], x1.y + a1[1]); w.w = pack2(x1.z + a1[2], x1.w + a1[3]);
          *reinterpret_cast<uint4*>(xout + o) = w;
        }
      }
  }
};
DI void ph_outproj(const Params& p, int L, char* smem) {
  if (L == 0) {
    CfgOutproj<true> c; c.K = DM; c.p = &p; c.L = L; c.bid = obid(); c.nb = gridDim.x; c.xin = p.x; c.xout = p.xres();
    pg8::gemm_phase((pg8::lds_u8*)smem, c);
  } else {
    CfgOutproj<false> c; c.K = DM; c.p = &p; c.L = L; c.bid = obid(); c.nb = gridDim.x; c.xin = p.xres2(); c.xout = p.xres();
    pg8::gemm_phase((pg8::lds_u8*)smem, c);
  }
}

DI void ph_rms2_router(const Params& p, int L, const u16* xres, char* smem) {
  const int tid = otid(), lane = tid & 63, gw = (obid() * NTHR + tid) >> 6, nw = gridDim.x * (NTHR / 64);
  const float* w = p.ln2_w + L * DM;
  const float* rw = p.router_w + (size_t)L * DM * 16;
  float4* srw = reinterpret_cast<float4*>(smem);
  for (int i = tid; i < 4096; i += NTHR) {
    const int c = i >> 2, e4 = i & 3;
    srw[(e4 * 4 + (c & 3)) * 256 + (c >> 2)] = *reinterpret_cast<const float4*>(rw + (size_t)i * 4);
  }
  __syncthreads();
  const int b5 = (lane >> 5) & 1, b4 = (lane >> 4) & 1, b3 = (lane >> 3) & 1, b2 = (lane >> 2) & 1;
  const int my_e = 8 * b5 + 4 * b4 + 2 * b3 + b2;
  float4 v[4];
  if (gw < T) {
#pragma unroll
    for (int i = 0; i < 4; ++i) v[i] = bf4_to_f4(*reinterpret_cast<const uint2*>(xres + (size_t)gw * DM + (i * 64 + lane) * 4));
  }
  for (int t = gw; t < T; t += nw) {
    uint2 vnx[4];
    const int tn = (t + nw < T) ? (t + nw) : t;
#pragma unroll
    for (int i = 0; i < 4; ++i) vnx[i] = *reinterpret_cast<const uint2*>(xres + (size_t)tn * DM + (i * 64 + lane) * 4);
    float ss = 0.f;
#pragma unroll
    for (int i = 0; i < 4; ++i) ss += v[i].x * v[i].x + v[i].y * v[i].y + v[i].z * v[i].z + v[i].w * v[i].w;
    ss = wave_sum(ss);
    const float rstd = rsqrtf(ss * (1.f / DM) + 1e-6f);
    float lg[16];
#pragma unroll
    for (int e = 0; e < 16; ++e) lg[e] = 0.f;
#pragma unroll
    for (int i = 0; i < 4; ++i) {
      const int q = i * 64 + lane;
      const float4 ww = *reinterpret_cast<const float4*>(w + q * 4);
      const float hv[4] = {v[i].x * rstd * ww.x, v[i].y * rstd * ww.y, v[i].z * rstd * ww.z, v[i].w * rstd * ww.w};
      *reinterpret_cast<unsigned*>(p.hn8() + (size_t)t * DM + q * 4) =
          pk4_f8(hv[0] * F8_H_SCALE, hv[1] * F8_H_SCALE, hv[2] * F8_H_SCALE, hv[3] * F8_H_SCALE);
#pragma unroll
      for (int j = 0; j < 4; ++j)
#pragma unroll
        for (int e4 = 0; e4 < 4; ++e4) {
          const float4 r = srw[(e4 * 4 + j) * 256 + q];
          lg[e4 * 4 + 0] += hv[j] * r.x; lg[e4 * 4 + 1] += hv[j] * r.y;
          lg[e4 * 4 + 2] += hv[j] * r.z; lg[e4 * 4 + 3] += hv[j] * r.w;
        }
      __builtin_amdgcn_sched_barrier(0);
    }
#pragma unroll
    for (int k = 0; k < 8; ++k) {
      const float send = b5 ? lg[k] : lg[k + 8], keep = b5 ? lg[k + 8] : lg[k];
      lg[k] = keep + __shfl_xor(send, 32);
    }
#pragma unroll
    for (int k = 0; k < 4; ++k) {
      const float send = b4 ? lg[k] : lg[k + 4], keep = b4 ? lg[k + 4] : lg[k];
      lg[k] = keep + __shfl_xor(send, 16);
    }
#pragma unroll
    for (int k = 0; k < 2; ++k) {
      const float send = b3 ? lg[k] : lg[k + 2], keep = b3 ? lg[k + 2] : lg[k];
      lg[k] = keep + __shfl_xor(send, 8);
    }
    float lv;
    {
      const float send = b2 ? lg[0] : lg[1], keep = b2 ? lg[1] : lg[0];
      lv = keep + __shfl_xor(send, 4);
    }
    lv += __shfl_xor(lv, 2);
    lv += __shfl_xor(lv, 1);
    float mx = lv;
    mx = fmaxf(mx, __shfl_xor(mx, 4)); mx = fmaxf(mx, __shfl_xor(mx, 8));
    mx = fmaxf(mx, __shfl_xor(mx, 16)); mx = fmaxf(mx, __shfl_xor(mx, 32));
    const float ex = expf(lv - mx);
    float den = ex;
    den += __shfl_xor(den, 4); den += __shfl_xor(den, 8); den += __shfl_xor(den, 16); den += __shfl_xor(den, 32);
    if ((lane & 3) == 0) { p.aff()[(size_t)t * 16 + my_e] = ex / den; p.inv()[(size_t)t * 16 + my_e] = -1; }
#pragma unroll
    for (int i = 0; i < 4; ++i) v[i] = bf4_to_f4(vnx[i]);
  }
}

DI int block_sum_i(int v, int* red, int tid) {
#pragma unroll
  for (int o = 32; o > 0; o >>= 1) v += __shfl_xor(v, o);
  __syncthreads();
  if ((tid & 63) == 0) red[tid >> 6] = v;
  __syncthreads();
  int t = 0;
#pragma unroll
  for (int w = 0; w < NTHR / 64; ++w) t += red[w];
  return t;
}
DI void ph_topk(const Params& p, char* smem) {
  int* red = reinterpret_cast<int*>(smem);
  int* wsum = red + 16;
  const int tid = otid(), wid = tid >> 6, lane = tid & 63;
  for (int it = obid(); it < 64; it += gridDim.x) {
    const int e = it & 15, b = it >> 4;
    unsigned v[8];
#pragma unroll
    for (int i = 0; i < 8; ++i) v[i] = __float_as_uint(p.aff()[(size_t)(b * SEQ + tid * 8 + i) * 16 + e]);
    unsigned thr = 0;
#pragma unroll 1
    for (int bit = 30; bit >= 0; --bit) {
      const unsigned cand = thr | (1u << bit);
      int cnt = 0;
#pragma unroll
      for (int i = 0; i < 8; ++i) cnt += (v[i] >= cand) ? 1 : 0;
      if (block_sum_i(cnt, red, tid) >= 512) thr = cand;
    }
    int ngt = 0, ntie = 0;
#pragma unroll
    for (int i = 0; i < 8; ++i) { ngt += (v[i] > thr) ? 1 : 0; ntie += (v[i] == thr) ? 1 : 0; }
    int ig = ngt, itie = ntie;
#pragma unroll
    for (int o = 1; o < 64; o <<= 1) {
      const int a = __shfl_up(ig, o), c = __shfl_up(itie, o);
      if (lane >= o) { ig += a; itie += c; }
    }
    __syncthreads();
    if (lane == 63) { wsum[wid] = ig; wsum[8 + wid] = itie; }
    __syncthreads();
    int og = 0, ot = 0, totg = 0;
#pragma unroll
    for (int w = 0; w < 8; ++w) {
      const int a = wsum[w], c = wsum[8 + w];
      if (w < wid) { og += a; ot += c; }
      totg += a;
    }
    int pg = og + ig - ngt, pt = ot + itie - ntie;
    const int base = (e * 4 + b) * 512;
#pragma unroll
    for (int i = 0; i < 8; ++i) {
      int slot = -1;
      if (v[i] > thr) { slot = pg; ++pg; }
      else if (v[i] == thr) { if (totg + pt < 512) slot = totg + pt; ++pt; }
      if (slot >= 0) {
        p.tok()[base + slot] = b * SEQ + tid * 8 + i;
        p.inv()[(size_t)(b * SEQ + tid * 8 + i) * 16 + e] = base + slot;
        p.gate()[base + slot] = __uint_as_float(v[i]);
      }
    }
    __syncthreads();
  }
}

struct CfgMoe1 {
  static constexpr bool PERM = true;
  int K; const Params* p; int L; int bid, nb;
  DI bool next(int i, pg8::Unit& u) const {
    const int t = i * nb + bid; if (t >= 16 * 16 * 8) return false;
    const int rnd = t >> 8, w = t & 255, xcd = w & 7, jx = w >> 3, pid = xcd * 4 + (jx >> 3);
    const int mt = jx & 7, nt = pid & 15, e = rnd * 2 + (pid >> 4);
    u.pm = e * 8 + mt; u.pn = e * 16 + nt; return true;
  }
  DI const char* a_base(const pg8::Unit&) const { return (const char*)p->hn8(); }
  DI const char* b_base(const pg8::Unit& u) const { return (const char*)(p->Wgu8() + ((size_t)L * 16 * 4096 + (size_t)u.pn * 256) * DM); }
  const int* tokl;
  DI void a_off(const pg8::Unit&, int R0, int C0, int R1, int C1, unsigned (&vo)[4], int ui) const {
    const int* tk = tokl + ui * 256;
    vo[0] = (unsigned)(tk[R0] * 512 + C0) * 2u; vo[1] = (unsigned)(tk[R1] * 512 + C1) * 2u;
    vo[2] = (unsigned)(tk[128 + R0] * 512 + C0) * 2u; vo[3] = (unsigned)(tk[128 + R1] * 512 + C1) * 2u;
  }
  DI void epi(const f32x4 (&acc)[2][2][4][2], const pg8::Unit& u, int wr, int wc, int fr, int fq) const {
    const int row0 = u.pm * 256 + wr * 64 + fr, col0 = (u.pn & 15) * 128 + wc * 32 + 8 * fq;
    const float dq = 1.f / (F8_H_SCALE * F8_W_SCALE);
#pragma unroll
    for (int ai = 0; ai < 2; ++ai)
#pragma unroll
      for (int m = 0; m < 4; ++m) {
        const f32x4 g0 = acc[ai][0][m][0] * dq, g1 = acc[ai][0][m][1] * dq, u0 = acc[ai][1][m][0] * (dq * F8_HID_SCALE), u1 = acc[ai][1][m][1] * (dq * F8_HID_SCALE);
        uint2 w;
        w.x = pk4_f8(fast_silu(g0[0]) * u0[0], fast_silu(g0[1]) * u0[1], fast_silu(g0[2]) * u0[2], fast_silu(g0[3]) * u0[3]);
        w.y = pk4_f8(fast_silu(g1[0]) * u1[0], fast_silu(g1[1]) * u1[1], fast_silu(g1[2]) * u1[2], fast_silu(g1[3]) * u1[3]);
        *reinterpret_cast<uint2*>(p->hid8() + (size_t)(row0 + ai * 128 + m * 16) * 2048 + col0) = w;
      }
  }
};
DI void ph_moe1(const Params& p, int L, char* smem) {
  CfgMoe1 c; c.K = 512; c.p = &p; c.L = L; c.bid = obid(); c.nb = gridDim.x;
  int* tokl = reinterpret_cast<int*>(smem + 131072);
  c.tokl = tokl;
  for (int idx = otid(); idx < 8 * 256; idx += NTHR) {
    pg8::Unit u;
    if (c.next(idx >> 8, u)) tokl[idx] = p.tok()[u.pm * 256 + (idx & 255)];
  }
  __syncthreads();
  pg8::gemm_phase_f8((pg8::lds_u8*)smem, c);
}
struct CfgMoe2 {
  static constexpr bool PERM = true;
  int K; const Params* p; int L; int bid, nb;
  DI bool next(int i, pg8::Unit& u) const {
    const int t = i * nb + bid; if (t >= 16 * 4 * 8) return false;
    const int rnd = t >> 8, w = t & 255, xcd = w & 7, jx = w >> 3, pid = rnd * 32 + xcd * 4 + (jx >> 3);
    u.pm = (pid >> 2) * 8 + (jx & 7); u.pn = pid; return true;
  }
  DI const char* a_base(const pg8::Unit& u) const { return (const char*)(p->hid8() + (size_t)u.pm * 256 * 2048); }
  DI const char* b_base(const pg8::Unit& u) const { return (const char*)(p->Wd8() + ((size_t)L * 16 * DM + (size_t)u.pn * 256) * 2048); }
  DI void a_off(const pg8::Unit&, int R0, int C0, int R1, int C1, unsigned (&vo)[4], int) const {
    vo[0] = (unsigned)(R0 * 1024 + C0) * 2u; vo[1] = (unsigned)(R1 * 1024 + C1) * 2u;
    vo[2] = vo[0] + 128u * 1024u * 2u; vo[3] = vo[1] + 128u * 1024u * 2u;
  }
  DI void epi(const f32x4 (&acc)[2][2][4][2], const pg8::Unit& u, int wr, int wc, int fr, int fq) const {
    u16* eo = p->proj();
    const int row0 = u.pm * 256 + wr * 64 + fr, col0 = (u.pn & 3) * 256 + wc * 32 + 8 * fq;
#pragma unroll
    for (int ai = 0; ai < 2; ++ai)
#pragma unroll
      for (int m = 0; m < 4; ++m) {
        const int row = row0 + ai * 128 + m * 16;
        const float gt = p->gate()[row] * (1.f / (F8_HID_SCALE * F8_W_SCALE));
#pragma unroll
        for (int bj = 0; bj < 2; ++bj) {
          const f32x4 a0 = acc[ai][bj][m][0], a1 = acc[ai][bj][m][1];
          uint4 w;
          w.x = pack2(gt * a0[0], gt * a0[1]); w.y = pack2(gt * a0[2], gt * a0[3]);
          w.z = pack2(gt * a1[0], gt * a1[1]); w.w = pack2(gt * a1[2], gt * a1[3]);
          *reinterpret_cast<uint4*>(eo + (size_t)row * DM + col0 + bj * 128) = w;
        }
      }
  }
};
DI void ph_moe2(const Params& p, int L, char* smem) {
  CfgMoe2 c; c.K = 1024; c.p = &p; c.L = L; c.bid = obid(); c.nb = gridDim.x;
  pg8::gemm_phase_f8((pg8::lds_u8*)smem, c);
}
template <bool FINAL>
DI void ph_combine_norm(const Params& p, const u16* __restrict__ xa, u16* __restrict__ xnew, const float* __restrict__ w,
                        u16* __restrict__ hn_out, float* __restrict__ f_out) {
  const int tid_ = otid(), lane = tid_ & 63, gw = (obid() * NTHR + tid_) >> 6, nw = gridDim.x * (NTHR / 64);
  const u16* eo = p.proj();
  float4 v[4];
  int myrow = -1;
  if (gw < T) {
#pragma unroll
    for (int i = 0; i < 4; ++i) v[i] = bf4_to_f4(*reinterpret_cast<const uint2*>(xa + (size_t)gw * DM + (i * 64 + lane) * 4));
    myrow = (lane < 16) ? p.inv()[(size_t)gw * 16 + lane] : -1;
  }
  for (int t = gw; t < T; t += nw) {
    uint2 vnx[4];
    const int tn = (t + nw < T) ? (t + nw) : t;
#pragma unroll
    for (int i = 0; i < 4; ++i) vnx[i] = *reinterpret_cast<const uint2*>(xa + (size_t)tn * DM + (i * 64 + lane) * 4);
    const int myrow_nx = (lane < 16) ? p.inv()[(size_t)tn * 16 + lane] : -1;
    unsigned long long mask = __builtin_amdgcn_ballot_w64(myrow >= 0);
#pragma unroll 1
    while (mask != 0ull) {
      const int e0 = __builtin_ctzll(mask);
      mask &= mask - 1ull;
      const int r0 = __builtin_amdgcn_readlane(myrow, e0);
      int r1 = -1;
      if (mask != 0ull) { const int e1 = __builtin_ctzll(mask); mask &= mask - 1ull; r1 = __builtin_amdgcn_readlane(myrow, e1); }
      uint2 q0[4], q1[4];
#pragma unroll
      for (int i = 0; i < 4; ++i) q0[i] = *reinterpret_cast<const uint2*>(eo + (size_t)r0 * DM + (i * 64 + lane) * 4);
      const int r1c = (r1 >= 0) ? r1 : r0;
#pragma unroll
      for (int i = 0; i < 4; ++i) q1[i] = *reinterpret_cast<const uint2*>(eo + (size_t)r1c * DM + (i * 64 + lane) * 4);
      const float s1 = (r1 >= 0) ? 1.f : 0.f;
#pragma unroll
      for (int i = 0; i < 4; ++i) {
        v[i].x += __uint_as_float(q0[i].x << 16); v[i].y += __uint_as_float(q0[i].x & 0xffff0000u);
        v[i].z += __uint_as_float(q0[i].y << 16); v[i].w += __uint_as_float(q0[i].y & 0xffff0000u);
        v[i].x += s1 * __uint_as_float(q1[i].x << 16); v[i].y += s1 * __uint_as_float(q1[i].x & 0xffff0000u);
        v[i].z += s1 * __uint_as_float(q1[i].y << 16); v[i].w += s1 * __uint_as_float(q1[i].y & 0xffff0000u);
      }
    }
    float ss = 0.f;
#pragma unroll
    for (int i = 0; i < 4; ++i) ss += v[i].x * v[i].x + v[i].y * v[i].y + v[i].z * v[i].z + v[i].w * v[i].w;
    ss = wave_sum(ss);
    const float rstd = rsqrtf(ss * (1.f / DM) + 1e-6f);
#pragma unroll
    for (int i = 0; i < 4; ++i) {
      const int c = (i * 64 + lane) * 4;
      const float4 ww = *reinterpret_cast<const float4*>(w + c);
      if (FINAL) {
        *reinterpret_cast<float4*>(f_out + (size_t)t * DM + c) = make_float4(v[i].x * rstd * ww.x, v[i].y * rstd * ww.y, v[i].z * rstd * ww.z, v[i].w * rstd * ww.w);
      } else {
        uint2 xo;
        xo.x = pack2(v[i].x, v[i].y); xo.y = pack2(v[i].z, v[i].w);
        *reinterpret_cast<uint2*>(xnew + (size_t)t * DM + c) = xo;
        uint2 o;
        o.x = pack2(v[i].x * rstd * ww.x, v[i].y * rstd * ww.y);
        o.y = pack2(v[i].z * rstd * ww.z, v[i].w * rstd * ww.w);
        *reinterpret_cast<uint2*>(hn_out + (size_t)t * DM + c) = o;
      }
    }
#pragma unroll
    for (int i = 0; i < 4; ++i) v[i] = bf4_to_f4(vnx[i]);
    myrow = myrow_nx;
  }
}

__global__ void __launch_bounds__(NTHR) mk(Params p) {
  extern __shared__ __attribute__((aligned(16))) char smem[];
  cg::grid_group grid = cg::this_grid();
  __shared__ uint4 xb_words;
  if (threadIdx.x == 0) xb_words = make_uint4(0u, 0u, 0u, 0u);
  __syncthreads();
  XcdBarrier xb = xcd_barrier_post(p.bar(), (volatile LAS unsigned*)&xb_words);
  ph_convert(p, smem);
  ph_rmsnorm_bf16(p.x, p.ln1_w, p.hn());
  xcd_barrier(xb);
  if (p.rep[12] == 0x7fffffff) grid.sync();
  for (int L = 0; L < 2; ++L) {
    u16* xout = p.xres();
    if (L == 1) {
      ph_combine_norm<false>(p, p.xres(), p.xres2(), p.ln1_w + DM, p.hn(), nullptr);
      xcd_barrier(xb);
    }
    ph_inproj(p, L, smem);
    xcd_barrier(xb);
    ph_post(p, L);
    xcd_barrier(xb);
    {
      unsigned* ctr = p.bar() + XCD_BAR_WORDS + 8 + L;
      __shared__ int q1_item;
      for (;;) {
        if (threadIdx.x == 0) q1_item = (int)atomicAdd(ctr, 1u);
        __syncthreads();
        const int it = q1_item;
        __syncthreads();
        if (it >= 1344) break;
        if (it < 256) ph_dil_pass<0>(p, smem, it);
        else if (it < 384) ph_ssd_a(p, L, smem, it - 256);
        else if (it < 576) ph_mla_up_q(p, L, smem, it - 384);
        else if (it < 832) ph_mla_up_kv(p, L, smem, it - 576);
        else ph_ret_a(p, smem, it - 832);
      }
    }
    xcd_barrier(xb);
    {
      { ph_ret_scan(p); ph_ssd_scan(p); }
      ph_mla_attn(p, smem, L);
      for (int bi = obid(); bi < 256; bi += gridDim.x) ph_dil_pass<1>(p, smem, bi);
    }
    xcd_barrier(xb);
    {
      unsigned* ctr = p.bar() + XCD_BAR_WORDS + L;
      __shared__ int q_item;
      for (;;) {
        if (threadIdx.x == 0) q_item = (int)atomicAdd(ctr, 1u);
        __syncthreads();
        const int it = q_item;
        __syncthreads();
        if (it >= 640) break;
        if (it < 128) ph_ssd_c(p, L, smem, it);
        else ph_ret_c(p, smem, it - 128);
      }
    }
    xcd_barrier(xb);
    ph_outproj(p, L, smem);
    xcd_barrier(xb);
    ph_rms2_router(p, L, xout, smem);
    xcd_barrier(xb);
    ph_topk(p, smem);
    if (gridDim.x == 256 && obid() >= CVT_IDLE_FIRST_BLK) cvt_tiles_idle(p, L, smem, CVT_A, CVT_NB);
    xcd_barrier(xb);
    ph_moe1(p, L, smem);
    xcd_barrier(xb);
    ph_moe2(p, L, smem);
    xcd_barrier(xb);
  }
  ph_combine_norm<true>(p, p.xres(), nullptr, p.final_w, nullptr, p.out);
}

extern "C" void kernel_launch(void* const* d_in, const int* in_sizes, int n_in, void* d_out, int out_size, void* d_ws,
                              size_t ws_size, hipStream_t stream) {
  static int grid_blocks = 0;
  if (!grid_blocks) {
    int dev = 0, cus = 0, per_cu = 0;
    (void)hipGetDevice(&dev);
    (void)hipDeviceGetAttribute(&cus, hipDeviceAttributeMultiprocessorCount, dev);
    (void)hipFuncSetAttribute((const void*)mk, hipFuncAttributeMaxDynamicSharedMemorySize, LDS_BYTES);
    (void)hipOccupancyMaxActiveBlocksPerMultiprocessor(&per_cu, (const void*)mk, NTHR, LDS_BYTES);
    if (per_cu < 1) { fprintf(stderr, "occupancy query says %d blocks/CU\n", per_cu); per_cu = 1; }
    grid_blocks = cus * 1;
  }
  Params p{};
  const float** fp = reinterpret_cast<const float**>(&p);
  for (int i = 0; i < 20; ++i) fp[i] = (const float*)d_in[i];
  p.out = (float*)d_out;
  p.ws = (char*)d_ws;
  const size_t off = WSO.total;
  { const int reps[16] = REPS_INIT; for (int i = 0; i < 16; ++i) p.rep[i] = reps[i]; }
  if (off > ws_size) { fprintf(stderr, "workspace too small: need %zu have %zu\n", off, ws_size); return; }
  (void)hipMemsetAsync(p.bar(), 0, (size_t)(XCD_BAR_WORDS + 64) * 4, stream);
  void* args[] = {&p};
  hipError_t e = hipLaunchCooperativeKernel((void*)mk, dim3(grid_blocks), dim3(NTHR), args, LDS_BYTES, stream);
  if (e != hipSuccess) fprintf(stderr, "cooperative launch failed: %s (grid %d)\n", hipGetErrorString(e), grid_blocks);
}
```

```cpp
#include <hip/hip_runtime.h>
#include <hip/hip_cooperative_groups.h>
#include <cstdio>
#include <cstdint>
namespace cg = cooperative_groups;

#define DI __device__ __forceinline__
typedef unsigned short u16;
typedef __attribute__((ext_vector_type(8))) short bf16x8;
typedef __attribute__((ext_vector_type(4))) float f32x4;

#ifndef REPS_INIT
#define REPS_INIT {1, 1, 1, 1, 1, 1, 1, 1, 1, 1, 1, 1, 0, 1, 1, 1}
#endif
constexpr int NTHR = 512;
constexpr int T = 16384, SEQ = 4096, DM = 1024;
constexpr int PW = 3240, PWP = 3328;
constexpr int C_RQ = 0, C_RK = 256, C_RV = 512, C_RG = 768, C_CQ = 1024, C_CKV = 1280, C_KR = 1408,
              C_Z = 1440, C_XBC = 1696, C_DT = 2464, C_DQ = 2472, C_DK = 2728, C_DV = 2984;
constexpr int LDS_BYTES = 131072 + 8192;

struct WsOff {
  size_t WinT;
  size_t WuqT;
  size_t WukvT;
  size_t WoutT;
  size_t Wgu8;
  size_t Wd8;
  size_t hn8;
  size_t xres;
  size_t hn;
  size_t proj;
  size_t cqn;
  size_t ckvn;
  size_t mq;
  size_t xbc;
  size_t mixed;
  size_t hid8;
  size_t kfull;
  size_t rS;
  size_t sS;
  size_t rU;
  size_t sU;
  size_t cdec;
  size_t vT;
  size_t rtab;
  size_t dpart;
  size_t dtv;
  size_t cs;
  size_t ybuf;
  size_t aff;
  size_t gate;
  size_t tok;
  size_t inv;
  size_t bar;
  size_t xres2;
  size_t total;
};
constexpr WsOff ws_layout() {
  WsOff o{};
  size_t off = 0;
  o.WinT = off; off += (((size_t)2 * PWP * DM * 2) + 255) & ~(size_t)255;
  o.WuqT = off; off += (((size_t)2 * 384 * 256 * 2) + 255) & ~(size_t)255;
  o.WukvT = off; off += (((size_t)2 * 512 * 128 * 2) + 255) & ~(size_t)255;
  o.WoutT = off; off += (((size_t)2 * DM * DM * 2) + 255) & ~(size_t)255;
  o.Wgu8 = off; off += (((size_t)2 * 16 * 4096 * DM) + 255) & ~(size_t)255;
  o.Wd8 = off; off += (((size_t)2 * 16 * DM * 2048) + 255) & ~(size_t)255;
  o.hn8 = off; off += (((size_t)T * DM) + 255) & ~(size_t)255;
  o.xres = off; off += (((size_t)T * DM * 2) + 255) & ~(size_t)255;
  o.hn = off; off += (((size_t)T * DM * 2) + 255) & ~(size_t)255;
  o.proj = off; off += (((size_t)T * PWP * 2) + 255) & ~(size_t)255;
  o.cqn = off; off += (((size_t)T * 256 * 2) + 255) & ~(size_t)255;
  o.ckvn = off; off += (((size_t)T * 128 * 2) + 255) & ~(size_t)255;
  o.mq = off; off += (((size_t)T * 384 * 2) + 255) & ~(size_t)255;
  o.xbc = off; off += (((size_t)T * 768 * 2) + 255) & ~(size_t)255;
  o.mixed = off; off += (((size_t)T * DM * 2) + 255) & ~(size_t)255;
  o.hid8 = off; off += (((size_t)32768 * 2048) + 255) & ~(size_t)255;
  o.kfull = off; off += (((size_t)T * 4 * 96 * 2) + 255) & ~(size_t)255;
  o.rS = off; off += (((size_t)16 * 32 * 2 * 4096 * 2) + 255) & ~(size_t)255;
  o.sS = off; off += (((size_t)128 * 8 * 8192 * 2) + 255) & ~(size_t)255;
  o.rU = off; off += (((size_t)16 * 32 * 2 * 4096 * 4) + 255) & ~(size_t)255;
  o.sU = off; off += (((size_t)128 * 8 * 8192 * 4) + 255) & ~(size_t)255;
  o.cdec = off; off += (((size_t)128 * 8 * 4) + 255) & ~(size_t)255;
  o.vT = off; off += (((size_t)T * 4 * 64 * 2) + 255) & ~(size_t)255;
  o.rtab = off; off += (((size_t)SEQ * 56 * 2 * 4) + 255) & ~(size_t)255;
  o.dpart = off; off += (((size_t)T * 4 * 68 * 4) + 255) & ~(size_t)255;
  o.dtv = off; off += (((size_t)T * 8 * 4) + 255) & ~(size_t)255;
  o.cs = off; off += (((size_t)T * 8 * 4) + 255) & ~(size_t)255;
  o.ybuf = off; off += (((size_t)T * 256 * 4) + 255) & ~(size_t)255;
  o.aff = off; off += (((size_t)T * 16 * 4) + 255) & ~(size_t)255;
  o.gate = off; off += (((size_t)64 * 512 * 4) + 255) & ~(size_t)255;
  o.tok = off; off += (((size_t)64 * 512 * 4) + 255) & ~(size_t)255;
  o.inv = off; off += (((size_t)T * 16 * 4) + 255) & ~(size_t)255;
  o.bar = off; off += (((size_t)(3456 + 64) * 4) + 255) & ~(size_t)255;
  o.xres2 = off; off += (((size_t)T * DM * 2) + 255) & ~(size_t)255;
  o.total = off;
  return o;
}
constexpr WsOff WSO = ws_layout();
struct Params {
  const float *x, *ln1_w, *w_in, *q_norm_w, *kv_norm_w, *w_uq, *w_ukv, *conv_w, *conv_b, *a_log, *dt_bias,
      *ssm_d, *ssm_norm_w, *w_out, *ln2_w, *router_w, *w_gate, *w_up, *w_down, *final_w;
  float* out;
  char* ws;
  int rep[16];
  __host__ DI u16* WinT() const { return reinterpret_cast<u16*>(ws + WSO.WinT); }
  __host__ DI u16* WuqT() const { return reinterpret_cast<u16*>(ws + WSO.WuqT); }
  __host__ DI u16* WukvT() const { return reinterpret_cast<u16*>(ws + WSO.WukvT); }
  __host__ DI u16* WoutT() const { return reinterpret_cast<u16*>(ws + WSO.WoutT); }
  __host__ DI unsigned char* Wgu8() const { return reinterpret_cast<unsigned char*>(ws + WSO.Wgu8); }
  __host__ DI unsigned char* Wd8() const { return reinterpret_cast<unsigned char*>(ws + WSO.Wd8); }
  __host__ DI unsigned char* hn8() const { return reinterpret_cast<unsigned char*>(ws + WSO.hn8); }
  __host__ DI u16* xres() const { return reinterpret_cast<u16*>(ws + WSO.xres); }
  __host__ DI u16* hn() const { return reinterpret_cast<u16*>(ws + WSO.hn); }
  __host__ DI u16* proj() const { return reinterpret_cast<u16*>(ws + WSO.proj); }
  __host__ DI u16* cqn() const { return reinterpret_cast<u16*>(ws + WSO.cqn); }
  __host__ DI u16* ckvn() const { return reinterpret_cast<u16*>(ws + WSO.ckvn); }
  __host__ DI u16* mq() const { return reinterpret_cast<u16*>(ws + WSO.mq); }
  __host__ DI u16* xbc() const { return reinterpret_cast<u16*>(ws + WSO.xbc); }
  __host__ DI u16* mixed() const { return reinterpret_cast<u16*>(ws + WSO.mixed); }
  __host__ DI unsigned char* hid8() const { return reinterpret_cast<unsigned char*>(ws + WSO.hid8); }
  __host__ DI u16* kfull() const { return reinterpret_cast<u16*>(ws + WSO.kfull); }
  __host__ DI u16* rS() const { return reinterpret_cast<u16*>(ws + WSO.rS); }
  __host__ DI u16* sS() const { return reinterpret_cast<u16*>(ws + WSO.sS); }
  __host__ DI float* rU() const { return reinterpret_cast<float*>(ws + WSO.rU); }
  __host__ DI float* sU() const { return reinterpret_cast<float*>(ws + WSO.sU); }
  __host__ DI float* cdec() const { return reinterpret_cast<float*>(ws + WSO.cdec); }
  __host__ DI u16* vT() const { return reinterpret_cast<u16*>(ws + WSO.vT); }
  __host__ DI float* rtab() const { return reinterpret_cast<float*>(ws + WSO.rtab); }
  __host__ DI float* dpart() const { return reinterpret_cast<float*>(ws + WSO.dpart); }
  __host__ DI float* dtv() const { return reinterpret_cast<float*>(ws + WSO.dtv); }
  __host__ DI float* cs() const { return reinterpret_cast<float*>(ws + WSO.cs); }
  __host__ DI float* ybuf() const { return reinterpret_cast<float*>(ws + WSO.ybuf); }
  __host__ DI float* aff() const { return reinterpret_cast<float*>(ws + WSO.aff); }
  __host__ DI float* gate() const { return reinterpret_cast<float*>(ws + WSO.gate); }
  __host__ DI int* tok() const { return reinterpret_cast<int*>(ws + WSO.tok); }
  __host__ DI int* inv() const { return reinterpret_cast<int*>(ws + WSO.inv); }
  __host__ DI unsigned* bar() const { return reinterpret_cast<unsigned*>(ws + WSO.bar); }
  __host__ DI u16* xres2() const { return reinterpret_cast<u16*>(ws + WSO.xres2); }
};


typedef __attribute__((ext_vector_type(2))) __bf16 bf16x2_t;
typedef __attribute__((ext_vector_type(2))) float f32x2_t;
typedef __attribute__((ext_vector_type(16))) float f32x16;
typedef __attribute__((ext_vector_type(4))) short s16x4;
typedef __attribute__((ext_vector_type(8))) int i32x8;
typedef __attribute__((ext_vector_type(4))) int i32x4;
DI unsigned pack2(float a, float b) {
  f32x2_t v = {a, b};
  return __builtin_bit_cast(unsigned, __builtin_convertvector(v, bf16x2_t));
}
DI u16 f2bf(float f) { return (u16)(pack2(f, 0.f) & 0xffffu); }
DI float bf2f(u16 h) { return __uint_as_float(((unsigned)h) << 16); }
DI void unpack8(const uint4& v, float* f) {
  f[0] = __uint_as_float(v.x << 16); f[1] = __uint_as_float(v.x & 0xffff0000u);
  f[2] = __uint_as_float(v.y << 16); f[3] = __uint_as_float(v.y & 0xffff0000u);
  f[4] = __uint_as_float(v.z << 16); f[5] = __uint_as_float(v.z & 0xffff0000u);
  f[6] = __uint_as_float(v.w << 16); f[7] = __uint_as_float(v.w & 0xffff0000u);
}
DI void ld8(const u16* p, float* f) { uint4 v = *reinterpret_cast<const uint4*>(p); unpack8(v, f); }
DI unsigned pk4_f8(float a, float b, float c, float d) {
  a = __builtin_amdgcn_fmed3f(a, -448.f, 448.f); b = __builtin_amdgcn_fmed3f(b, -448.f, 448.f);
  c = __builtin_amdgcn_fmed3f(c, -448.f, 448.f); d = __builtin_amdgcn_fmed3f(d, -448.f, 448.f);
  int w = __builtin_amdgcn_cvt_pk_fp8_f32(a, b, 0, false);
  w = __builtin_amdgcn_cvt_pk_fp8_f32(c, d, w, true);
  return (unsigned)w;
}
constexpr float F8_W_SCALE = 256.f, F8_H_SCALE = 16.f, F8_HID_SCALE = 8.f;
typedef short s16x2_t __attribute__((ext_vector_type(2)));
template <int SCALE> DI unsigned pk4_f8_scaled(float a, float b, float c, float d) {
  constexpr float inv = 1.f / (float)SCALE;
  s16x2_t r = {0, 0};
  r = __builtin_amdgcn_cvt_scalef32_pk_fp8_f32(r, a, b, inv, false);
  r = __builtin_amdgcn_cvt_scalef32_pk_fp8_f32(r, c, d, inv, true);
  return __builtin_bit_cast(unsigned, r);
}
DI float4 bf4_to_f4(const uint2& q) {
  return make_float4(__uint_as_float(q.x << 16), __uint_as_float(q.x & 0xffff0000u), __uint_as_float(q.y << 16), __uint_as_float(q.y & 0xffff0000u));
}
DI float wave_sum(float v) {
#pragma unroll
  for (int o = 32; o > 0; o >>= 1) v += __shfl_xor(v, o);
  return v;
}
DI float dot2acc(unsigned a, unsigned b, float c) {
  return __builtin_amdgcn_fdot2_f32_bf16(__builtin_bit_cast(bf16x2_t, a), __builtin_bit_cast(bf16x2_t, b), c, false);
}
DI float dot8(const uint4& a, const uint4& b, float c) {
  c = dot2acc(a.x, b.x, c); c = dot2acc(a.y, b.y, c); c = dot2acc(a.z, b.z, c); c = dot2acc(a.w, b.w, c);
  return c;
}
DI int otid() { int t = threadIdx.x; asm volatile("" : "+v"(t)); return t; }
DI int obid() { int b = blockIdx.x; asm volatile("" : "+s"(b)); return b; }
DI float silu(float x) { return x / (1.f + __expf(-x)); }
DI float fast_silu(float x) { return x * __builtin_amdgcn_rcpf(1.f + __expf(-x)); }


#define XB_TMO      128
#define XB_XCNT(j)  (256  + 64 * (j))
#define XB_XSUB(j)  (1280 + 64 * (j))
#define XB_XGEN(j)  (2304 + 64 * (j))
#define XB_TOP      3328
#define XB_TOPGEN   3392
#define XCD_BAR_WORDS 3456
#define XB_SPIN_CAP (1u << 20)
#define LAS __attribute__((address_space(3)))
DI unsigned xb_ld(unsigned* p) { return __hip_atomic_load(p, __ATOMIC_RELAXED, __HIP_MEMORY_SCOPE_AGENT); }
DI unsigned xb_add(unsigned* p, unsigned v) { return __hip_atomic_fetch_add(p, v, __ATOMIC_RELAXED, __HIP_MEMORY_SCOPE_AGENT); }
DI unsigned xb_xcc_id() { return (unsigned)__builtin_amdgcn_s_getreg((3 << 11) | 20) & 0xFu; }
#define XB_SPIN(cond, bar) do { unsigned _sp = 0; while (cond) { __builtin_amdgcn_s_sleep(1); \
    if ((++_sp & 255u) == 0u) { if (xb_ld(&(bar)[XB_TMO])) break; if (_sp > XB_SPIN_CAP) { atomicAdd(&(bar)[XB_TMO], 1u); break; } } } } while (0)
struct XcdBarrier { unsigned* bar; unsigned x; volatile LAS unsigned* st; };
DI XcdBarrier xcd_barrier_post(unsigned* bar, volatile LAS unsigned* st) {
  XcdBarrier b; b.bar = bar; b.x = xb_xcc_id(); b.st = st;
  if (threadIdx.x == 0) (void)xb_add(&bar[XB_XCNT(b.x)], 1u);
  return b;
}
DI void xcd_barrier_complete(unsigned* bar, unsigned x, unsigned& nloc, unsigned& nx) {
  const unsigned G = gridDim.x * gridDim.y * gridDim.z;
  unsigned sum, cnt, mine, sp = 0u;
  for (;;) {
    sum = 0u; cnt = 0u; mine = 0u;
#pragma unroll
    for (unsigned j = 0; j < 16; ++j) { const unsigned c = xb_ld(&bar[XB_XCNT(j)]); sum += c; cnt += (c > 0u) ? 1u : 0u; mine = (j == x) ? c : mine; }
    if (sum == G) break;
    __builtin_amdgcn_s_sleep(1);
    if ((++sp & 255u) == 0u) { if (xb_ld(&bar[XB_TMO])) break; if (sp > XB_SPIN_CAP) { atomicAdd(&bar[XB_TMO], 1u); break; } }
  }
  nloc = mine > 0u ? mine : 1u; nx = cnt > 0u ? cnt : 1u;
}
DI void xcd_barrier(const XcdBarrier& b) {
  asm volatile("s_waitcnt vmcnt(0)" ::: "memory");
  __syncthreads();
  if (threadIdx.x == 0) {
    unsigned* bar = b.bar;
    __builtin_amdgcn_s_waitcnt(0);
    unsigned nloc = b.st[0], nx = b.st[1];
    if (nloc == 0u) { xcd_barrier_complete(bar, b.x, nloc, nx); b.st[0] = nloc; b.st[1] = nx; }
    const unsigned old = xb_add(&bar[XB_XSUB(b.x)], 1u);
    const unsigned gen = old / nloc;
    if (old + 1u == (gen + 1u) * nloc) {
      __builtin_amdgcn_fence(__ATOMIC_RELEASE, "agent");
      asm volatile("s_waitcnt vmcnt(0)" ::: "memory");
      const unsigned og = xb_add(&bar[XB_TOP], 1u);
      const unsigned tg = og / nx;
      if (og + 1u == (tg + 1u) * nx) xb_add(&bar[XB_TOPGEN], 1u);
      else XB_SPIN(xb_ld(&bar[XB_TOPGEN]) == tg, bar);
      __builtin_amdgcn_fence(__ATOMIC_ACQUIRE, "agent");
      xb_add(&bar[XB_XGEN(b.x)], 1u);
      asm volatile("s_waitcnt vmcnt(0)" ::: "memory");
    } else {
      XB_SPIN(xb_ld(&bar[XB_XGEN(b.x)]) == gen, bar);
      __builtin_amdgcn_fence(__ATOMIC_ACQUIRE, "agent");
      asm volatile("s_waitcnt vmcnt(0)" ::: "memory");
    }
  }
  __syncthreads();
}

template <class F>
DI void transpose_convert(const float* __restrict__ src, int K, int N, int Npad, u16* __restrict__ dst, F rowmap,
                          int bid, int nb, char* smem) {
  u16* tile = reinterpret_cast<u16*>(smem);
  const int tid = otid();
  const int ntn = Npad / 128, ntk = K / 64;
  for (int t = bid; t < ntn * ntk; t += nb) {
    const int n0 = (t % ntn) * 128, k0 = (t / ntn) * 64;
    f32x4 v[4];
#pragma unroll
    for (int i = 0; i < 4; ++i) {
      const int kk = (tid >> 5) + 16 * i, nn = (tid & 31) * 4;
      v[i] = f32x4{0.f, 0.f, 0.f, 0.f};
      if (n0 + nn < N) v[i] = __builtin_nontemporal_load(reinterpret_cast<const f32x4*>(src + (size_t)(k0 + kk) * N + n0 + nn));
    }
#pragma unroll
    for (int i = 0; i < 4; ++i) {
      const int kk = (tid >> 5) + 16 * i, nn = (tid & 31) * 4;
      tile[(nn + 0) * 72 + kk] = f2bf(v[i][0]); tile[(nn + 1) * 72 + kk] = f2bf(v[i][1]);
      tile[(nn + 2) * 72 + kk] = f2bf(v[i][2]); tile[(nn + 3) * 72 + kk] = f2bf(v[i][3]);
    }
    __syncthreads();
#pragma unroll
    for (int j = 0; j < 2; ++j) {
      const int c = tid + NTHR * j, nn = c >> 3, k8 = (c & 7) * 8;
      const uint4 o = *reinterpret_cast<const uint4*>(tile + nn * 72 + k8);
      *reinterpret_cast<uint4*>(dst + (size_t)rowmap(n0 + nn) * K + k0 + k8) = o;
    }
    __syncthreads();
  }
}

template <class F>
DI void transpose_convert_f8(const float* __restrict__ src, int K, int N, unsigned char* __restrict__ dst, F rowmap,
                             int bid, int nb, char* smem) {
  unsigned char* tile = reinterpret_cast<unsigned char*>(smem);
  const int tid = otid();
  const int ntn = N / 128, ntk = K / 64;
  for (int t = bid; t < ntn * ntk; t += nb) {
    const int n0 = (t % ntn) * 128, k0 = (t / ntn) * 64;
    const int kq = (tid >> 5) * 4, nn = (tid & 31) * 4;
    f32x4 v[4];
#pragma unroll
    for (int r = 0; r < 4; ++r) v[r] = __builtin_nontemporal_load(reinterpret_cast<const f32x4*>(src + (size_t)(k0 + kq + r) * N + n0 + nn));
#pragma unroll
    for (int e = 0; e < 4; ++e)
      *reinterpret_cast<unsigned*>(tile + (nn + e) * 80 + kq) =
          pk4_f8(v[0][e] * F8_W_SCALE, v[1][e] * F8_W_SCALE, v[2][e] * F8_W_SCALE, v[3][e] * F8_W_SCALE);
    __syncthreads();
    {
      const int rn = tid >> 2, kc = (tid & 3) * 16;
      const uint4 o = *reinterpret_cast<const uint4*>(tile + rn * 80 + kc);
      *reinterpret_cast<uint4*>(dst + (size_t)rowmap(n0 + rn) * K + k0 + kc) = o;
    }
    __syncthreads();
  }
}

constexpr int CVT_IN_MLA_E = 16;
struct CvtTile { const float* src; unsigned char* dst; int N, K, n0, k0, mat; };
DI CvtTile cvt_tile(const Params& p, int L, int g) {
  const int e = g / 768, r = g - e * 768, mat = r >> 8, tt = r & 255;
  const size_t le = (size_t)(L * 16 + e);
  CvtTile c;
  c.mat = mat;
  if (mat < 2) { c.src = ((mat == 0) ? p.w_gate : p.w_up) + le * DM * 2048; c.N = 2048; c.dst = p.Wgu8() + le * 4096 * DM; c.K = 1024; c.n0 = (tt & 15) * 128; c.k0 = (tt >> 4) * 64; }
  else { c.src = p.w_down + le * 2048 * DM; c.N = 1024; c.dst = p.Wd8() + le * DM * 2048; c.K = 2048; c.n0 = (tt & 7) * 128; c.k0 = (tt >> 3) * 64; }
  return c;
}
DI int cvt_rowmap(int mat, int n) { return (mat == 2) ? n : ((n >> 7) * 256 + (mat == 1 ? 128 : 0) + (n & 127)); }

constexpr int CVT_IDLE_FIRST_BLK = 64, CVT_IDLE_BLKS = 192;
constexpr int CVT_NA = 14, CVT_NB = 10;
constexpr int CVT_A = CVT_IDLE_BLKS * CVT_NA, CVT_B = CVT_A + CVT_IDLE_BLKS * CVT_NB;
static_assert(CVT_B + 32 * 256 >= 12288 && CVT_B <= 12288, "the MLA loop (one tile per 128-key iteration, 32 iterations) must cover the rest");
DI void cvt_tiles_idle(const Params& p, int L, char* smem, int first, int per_blk) {
  const int tid = otid(), ib = obid() - CVT_IDLE_FIRST_BLK;
  unsigned char* tile = reinterpret_cast<unsigned char*>(smem);
  __syncthreads();
#pragma unroll 1
  for (int i = 0; i < per_blk; i += 2) {
    f32x4 v[2][4];
#pragma unroll
    for (int u = 0; u < 2; ++u) {
      const CvtTile ct = cvt_tile(p, L, first + ib + CVT_IDLE_BLKS * (i + u));
      const float* sp = ct.src + (size_t)(ct.k0 + (tid >> 5) * 4) * ct.N + ct.n0 + (tid & 31) * 4;
#pragma unroll
      for (int r = 0; r < 4; ++r) v[u][r] = __builtin_nontemporal_load(reinterpret_cast<const f32x4*>(sp + (size_t)r * ct.N));
    }
#pragma unroll
    for (int u = 0; u < 2; ++u) {
      unsigned char* cb = tile + u * 10240 + (tid & 31) * 4 * 80 + (tid >> 5) * 4;
#pragma unroll
      for (int c = 0; c < 4; ++c) *reinterpret_cast<unsigned*>(cb + c * 80) = pk4_f8_scaled<256>(v[u][0][c], v[u][1][c], v[u][2][c], v[u][3][c]);
    }
    __syncthreads();
#pragma unroll
    for (int u = 0; u < 2; ++u) {
      const CvtTile ct = cvt_tile(p, L, first + ib + CVT_IDLE_BLKS * (i + u));
      unsigned char* cd = ct.dst + (size_t)cvt_rowmap(ct.mat, ct.n0 + (tid >> 2)) * ct.K + ct.k0 + (tid & 3) * 16;
      *reinterpret_cast<uint4*>(cd) = *reinterpret_cast<const uint4*>(tile + u * 10240 + (tid >> 2) * 80 + (tid & 3) * 16);
    }
    __syncthreads();
  }
}

DI void ph_convert(const Params& p, char* smem) {
  const int nb = gridDim.x;
  int bid = obid();
  for (int idx = bid * NTHR + otid(); idx < SEQ * 56; idx += nb * NTHR) {
    const int pos = idx / 56, f = idx - pos * 56;
    float inv;
    if (f < 32) inv = exp2f(-(float)f * (13.287712379549449f / 32.f));
    else if (f < 40) inv = exp2f(-(float)(f - 32) * (18.931568569324174f / 8.f));
    else inv = exp2f(-(float)(f - 40) * (18.931568569324174f / 16.f));
    float sn, cs;
    sincosf((float)pos * inv, &sn, &cs);
    p.rtab()[(size_t)idx * 2] = cs;
    p.rtab()[(size_t)idx * 2 + 1] = sn;
  }
  auto ident = [](int n) { return n; };
  for (int L = 0; L < 2; ++L) {
    transpose_convert(p.w_in + (size_t)L * DM * PW, DM, PW, PWP, p.WinT() + (size_t)L * PWP * DM, ident, bid, nb, smem);
    transpose_convert(p.w_uq + (size_t)L * 256 * 384, 256, 384, 384, p.WuqT() + (size_t)L * 384 * 256, ident, bid, nb, smem);
    transpose_convert(p.w_ukv + (size_t)L * 128 * 512, 128, 512, 512, p.WukvT() + (size_t)L * 512 * 128, ident, bid, nb, smem);
    transpose_convert(p.w_out + (size_t)L * DM * DM, DM, DM, DM, p.WoutT() + (size_t)L * DM * DM, ident, bid, nb, smem);
    for (int e = ((nb == 256) ? CVT_IN_MLA_E : 0); e < 16; ++e) {
      const size_t le = (size_t)(L * 16 + e);
      auto gmap = [](int n) { return (n >> 7) * 256 + (n & 127); };
      auto umap = [](int n) { return (n >> 7) * 256 + 128 + (n & 127); };
      transpose_convert_f8(p.w_gate + le * DM * 2048, DM, 2048, p.Wgu8() + le * 4096 * DM, gmap, bid, nb, smem);
      transpose_convert_f8(p.w_up + le * DM * 2048, DM, 2048, p.Wgu8() + le * 4096 * DM, umap, bid, nb, smem);
      transpose_convert_f8(p.w_down + le * 2048 * DM, 2048, DM, p.Wd8() + le * DM * 2048, ident, bid, nb, smem);
    }
  }
}

template <class RowPtr, class Epi>
DI void gemm_tile(RowPtr arow, const u16* __restrict__ bt, int ldb, int K, char* smem, Epi epi) {
  u16* sa = reinterpret_cast<u16*>(smem);
  u16* sb = sa + 2 * 256 * 72;
  const int tid = otid(), wid = tid >> 6, lane = tid & 63, wr = wid >> 1, wc = wid & 1, fr = lane & 15, fq = lane >> 4;
  f32x4 acc[4][4];
#pragma unroll
  for (int m = 0; m < 4; ++m)
#pragma unroll
    for (int n = 0; n < 4; ++n) acc[m][n] = f32x4{0.f, 0.f, 0.f, 0.f};
  const int lr = tid >> 3, lc = (tid & 7) * 8;
  const u16* ap[4];
#pragma unroll
  for (int i = 0; i < 4; ++i) ap[i] = arow(lr + 64 * i) + lc;
  const u16* bp[2];
#pragma unroll
  for (int i = 0; i < 2; ++i) bp[i] = bt + (size_t)(lr + 64 * i) * ldb + lc;
  uint4 ra[4], rb[2];
  const int nk = K / 64;
#pragma unroll
  for (int i = 0; i < 4; ++i) ra[i] = *reinterpret_cast<const uint4*>(ap[i]);
#pragma unroll
  for (int i = 0; i < 2; ++i) rb[i] = *reinterpret_cast<const uint4*>(bp[i]);
#pragma unroll
  for (int i = 0; i < 4; ++i) *reinterpret_cast<uint4*>(sa + (lr + 64 * i) * 72 + lc) = ra[i];
#pragma unroll
  for (int i = 0; i < 2; ++i) *reinterpret_cast<uint4*>(sb + (lr + 64 * i) * 72 + lc) = rb[i];
  __syncthreads();
  for (int kt = 0; kt < nk; ++kt) {
    const int cur = kt & 1;
    if (kt + 1 < nk) {
#pragma unroll
      for (int i = 0; i < 4; ++i) ra[i] = *reinterpret_cast<const uint4*>(ap[i] + (kt + 1) * 64);
#pragma unroll
      for (int i = 0; i < 2; ++i) rb[i] = *reinterpret_cast<const uint4*>(bp[i] + (kt + 1) * 64);
    }
    const u16* ca = sa + cur * 256 * 72;
    const u16* cb = sb + cur * 128 * 72;
#pragma unroll
    for (int kk = 0; kk < 2; ++kk) {
      bf16x8 af[4], bfr[4];
#pragma unroll
      for (int m = 0; m < 4; ++m) af[m] = *reinterpret_cast<const bf16x8*>(ca + (wr * 64 + m * 16 + fr) * 72 + kk * 32 + fq * 8);
#pragma unroll
      for (int n = 0; n < 4; ++n) bfr[n] = *reinterpret_cast<const bf16x8*>(cb + (wc * 64 + n * 16 + fr) * 72 + kk * 32 + fq * 8);
#pragma unroll
      for (int m = 0; m < 4; ++m)
#pragma unroll
        for (int n = 0; n < 4; ++n) acc[m][n] = __builtin_amdgcn_mfma_f32_16x16x32_bf16(af[m], bfr[n], acc[m][n], 0, 0, 0);
    }
    if (kt + 1 < nk) {
      u16* na = sa + (cur ^ 1) * 256 * 72;
      u16* nbp = sb + (cur ^ 1) * 128 * 72;
#pragma unroll
      for (int i = 0; i < 4; ++i) *reinterpret_cast<uint4*>(na + (lr + 64 * i) * 72 + lc) = ra[i];
#pragma unroll
      for (int i = 0; i < 2; ++i) *reinterpret_cast<uint4*>(nbp + (lr + 64 * i) * 72 + lc) = rb[i];
    }
    __syncthreads();
  }
  epi(acc, wr, wc, fr, fq);
}

#define WAIT_V(n) asm volatile("s_waitcnt vmcnt(%0)" ::"n"(n) : "memory")
DI int lds_byte2(int r, int c) {
  const int st = (r >> 4) * 2 + (c >> 5), ob = (r & 15) * 64 + (c & 31) * 2;
  return st * 1024 + (ob ^ (((ob >> 9) & 1) << 5));
}
DI void stage_rc2(int b, int& R, int& C) {
  const int st = b >> 10, sb = b & 1023, swz = sb ^ (((sb >> 9) & 1) << 5);
  R = (st >> 1) * 16 + swz / 64;
  C = (st & 1) * 32 + (swz % 64) / 2;
}
typedef __attribute__((address_space(3))) unsigned lds_u32;
template <class RowPtr, class Epi>
DI void gemm256(RowPtr arow, const u16* __restrict__ bt, int ldb, int K, char* smem, Epi epi) {
  constexpr int TILE_B = 256 * 64 * 2, STAGE_B = 2 * TILE_B;
  const int tid = otid(), wid = tid >> 6, lane = tid & 63, wr = wid >> 2, wc = wid & 3, fr = lane & 15, fq = lane >> 4;
  const u16* ap[4];
  const u16* bp[4];
#pragma unroll
  for (int i = 0; i < 4; ++i) {
    int R, C;
    stage_rc2(wid * 1024 + i * 8192 + lane * 16, R, C);
    ap[i] = arow(R) + C;
    bp[i] = bt + (size_t)R * ldb + C;
  }
  f32x4 acc[8][4];
#pragma unroll
  for (int m = 0; m < 8; ++m)
#pragma unroll
    for (int n = 0; n < 4; ++n) acc[m][n] = f32x4{0.f, 0.f, 0.f, 0.f};
#define G2_STAGE(buf, kt)                                                                                              \
  do {                                                                                                                 \
    _Pragma("unroll") for (int i = 0; i < 4; ++i) {                                                                    \
      __builtin_amdgcn_global_load_lds((const unsigned*)(ap[i] + (kt) * 64),                                           \
                                       (lds_u32*)(smem + (buf) * STAGE_B + wid * 1024 + i * 8192), 16, 0, 0);          \
      __builtin_amdgcn_global_load_lds((const unsigned*)(bp[i] + (kt) * 64),                                           \
                                       (lds_u32*)(smem + (buf) * STAGE_B + TILE_B + wid * 1024 + i * 8192), 16, 0, 0); \
    }                                                                                                                  \
  } while (0)
  const int nt = K / 64;
  G2_STAGE(0, 0);
  WAIT_V(0);
  __syncthreads();
  for (int t = 0; t < nt; ++t) {
    const int cur = t & 1;
    if (t + 1 < nt) G2_STAGE(cur ^ 1, t + 1);
    const char* sA = smem + cur * STAGE_B;
    const char* sB = sA + TILE_B;
#pragma unroll
    for (int ks = 0; ks < 2; ++ks) {
      bf16x8 At[8], Bf[4];
#pragma unroll
      for (int m = 0; m < 8; ++m) At[m] = *reinterpret_cast<const bf16x8*>(sA + lds_byte2(wr * 128 + m * 16 + fr, ks * 32 + fq * 8));
#pragma unroll
      for (int n = 0; n < 4; ++n) Bf[n] = *reinterpret_cast<const bf16x8*>(sB + lds_byte2(wc * 64 + n * 16 + fr, ks * 32 + fq * 8));
#pragma unroll
      for (int m = 0; m < 8; ++m)
#pragma unroll
        for (int n = 0; n < 4; ++n) acc[m][n] = __builtin_amdgcn_mfma_f32_16x16x32_bf16(Bf[n], At[m], acc[m][n], 0, 0, 0);
      __builtin_amdgcn_sched_barrier(0);
    }
    WAIT_V(0);
    __syncthreads();
  }
  epi(acc, wr, wc, fr, fq);
}

namespace pg8 {
constexpr int BM = 256, BK = 64, HALF = 128, HTB = HALF * BK * 2;
DI int lds_byte(int r, int c) { const int st = (r >> 4) * 2 + (c >> 5), rr = r & 15, cc = c & 31, ob = rr * 64 + cc * 2; return st * 1024 + (ob ^ (((ob >> 9) & 1) << 5)); }
DI void stage_rc(int b, int& R, int& C) { const int st = b / 1024, sb = b % 1024, swz = sb ^ (((sb >> 9) & 1) << 5); R = (st >> 1) * 16 + swz / 64; C = (st & 1) * 32 + (swz % 64) / 2; }
DI int perm32(int rho) { const int n = rho >> 4, i = rho & 15; return 8 * (i >> 2) + 4 * n + (i & 3); }
struct Unit { int pm, pn; };
typedef __attribute__((address_space(3))) unsigned char lds_u8;
typedef __attribute__((address_space(3))) unsigned lds_u32;
typedef __attribute__((address_space(3))) bf16x8 lds_bf16x8;
typedef __attribute__((address_space(3))) i32x4 lds_i32x4;

template <class Cfg>
DI void gemm_phase(lds_u8* lds, const Cfg& S) {
  const int tid = otid(), wid = __builtin_amdgcn_readfirstlane(tid >> 6), lane = tid & 63, wr = wid >> 2, wc = wid & 3, fr = lane & 15, fq = lane >> 4;
  const int K = S.K, nt = K / BK;
  int R0, C0, R1, C1;
  stage_rc(tid * 16, R0, C0);
  stage_rc(tid * 16 + 8192, R1, C1);
  unsigned voffB[2];
  {
    const int Rb0 = Cfg::PERM ? ((R0 & ~31) + perm32(R0 & 31)) : R0, Rb1 = Cfg::PERM ? ((R1 & ~31) + perm32(R1 & 31)) : R1;
    voffB[0] = (unsigned)(Rb0 * K + C0) * 2u; voffB[1] = (unsigned)(Rb1 * K + C1) * 2u;
  }
  const size_t kstep = (size_t)(BK * 2);
  const size_t hstep = (size_t)HALF * K * 2;
  const unsigned ldsw = (unsigned)wid * 1024u;
  const int aoff = lds_byte(wr * 64 + fr, fq * 8), boff = lds_byte(wc * 32 + fr, fq * 8);
#define PG8_SA(b, h) (((b) * 2 + (h)) * HTB)
#define PG8_SB(b, h) ((4 + (b) * 2 + (h)) * HTB)
#define PG8_STAGE2(bufoff, gbase, o0, o1) do { \
    __builtin_amdgcn_global_load_lds((const unsigned*)((const char*)(gbase) + (o0)), (lds_u32*)(lds + (bufoff) + ldsw), 16, 0, 0); \
    __builtin_amdgcn_global_load_lds((const unsigned*)((const char*)(gbase) + (o1)), (lds_u32*)(lds + (bufoff) + ldsw + 8192), 16, 0, 0); } while (0)
#define PG8_STAGEB(bufoff, gbase) PG8_STAGE2(bufoff, gbase, voffB[0], voffB[1])
#define PG8_LDA(dst, b, h) do { _Pragma("unroll") for (int m = 0; m < 4; ++m) _Pragma("unroll") for (int k = 0; k < 2; ++k) dst[m][k] = *(const lds_bf16x8*)(lds + PG8_SA(b, h) + aoff + m * 2048 + k * 1024); } while (0)
#define PG8_LDB(dst, b, h) do { _Pragma("unroll") for (int n = 0; n < 2; ++n) _Pragma("unroll") for (int k = 0; k < 2; ++k) dst[n][k] = *(const lds_bf16x8*)(lds + PG8_SB(b, h) + boff + n * 2048 + k * 1024); } while (0)
#define PG8_MMA(ai, bj, At, Bt) do { __builtin_amdgcn_s_setprio(1); _Pragma("unroll") for (int m = 0; m < 4; ++m) _Pragma("unroll") for (int n = 0; n < 2; ++n) _Pragma("unroll") for (int k = 0; k < 2; ++k) \
    acc[ai][bj][m][n] = __builtin_amdgcn_mfma_f32_16x16x32_bf16(Bt[n][k], At[m][k], acc[ai][bj][m][n], 0, 0, 0); __builtin_amdgcn_s_setprio(0); } while (0)
#define PG8_WAIT_V(n) asm volatile("s_waitcnt vmcnt(" #n ")" ::: "memory")
#define PG8_WAIT_L(n) asm volatile("s_waitcnt lgkmcnt(" #n ")" ::: "memory")
#define PG8_BAR __builtin_amdgcn_s_barrier()
#define PG8_SCHED __builtin_amdgcn_sched_barrier(0)
  Unit cur, nxt; int ui = 0;
  if (!S.next(0, cur)) return;
  f32x4 acc[2][2][4][2];
#pragma unroll
  for (int a = 0; a < 2; ++a)
#pragma unroll
    for (int b = 0; b < 2; ++b)
#pragma unroll
      for (int m = 0; m < 4; ++m)
#pragma unroll
        for (int n = 0; n < 2; ++n) acc[a][b][m][n] = f32x4{0.f, 0.f, 0.f, 0.f};
  bf16x8 At[4][2], B0[2][2], B1[2][2];
  const char* cA = S.a_base(cur);
  const char* cB = S.b_base(cur);
  unsigned vc[4], vn[4];
  S.a_off(cur, R0, C0, R1, C1, vc);
  PG8_STAGEB(PG8_SB(0, 0), cB); PG8_STAGE2(PG8_SA(0, 0), cA, vc[0], vc[1]); PG8_STAGEB(PG8_SB(0, 1), cB + hstep); PG8_STAGE2(PG8_SA(0, 1), cA, vc[2], vc[3]);
  if (wr == 1) PG8_BAR;
  PG8_WAIT_V(4); PG8_BAR;
  PG8_STAGEB(PG8_SB(1, 0), cB + kstep); PG8_STAGE2(PG8_SA(1, 0), cA + kstep, vc[0], vc[1]); PG8_STAGEB(PG8_SB(1, 1), cB + hstep + kstep);
  PG8_WAIT_V(6); PG8_BAR;
  for (;;) {
    const bool has_next = S.next(ui + 1, nxt);
    const char* nA = has_next ? S.a_base(nxt) : cA;
    const char* nB = has_next ? S.b_base(nxt) : cB;
    if (has_next) S.a_off(nxt, R0, C0, R1, C1, vn);
    else { vn[0] = vc[0]; vn[1] = vc[1]; vn[2] = vc[2]; vn[3] = vc[3]; }
    for (int t = 0; t < nt; t += 2) {
      const bool last = (t == nt - 2);
      const char* a1 = cA + (size_t)(t + 1) * kstep;
      const char* a2 = last ? nA : cA + (size_t)(t + 2) * kstep;
      const char* b2 = last ? nB : cB + (size_t)(t + 2) * kstep;
      const char* a3 = a2 + kstep;
      const char* b3 = b2 + kstep;
      const unsigned w0 = last ? vn[0] : vc[0], w1 = last ? vn[1] : vc[1], w2 = last ? vn[2] : vc[2], w3 = last ? vn[3] : vc[3];
      PG8_LDB(B0, 0, 0); PG8_SCHED; PG8_LDA(At, 0, 0); PG8_STAGE2(PG8_SA(1, 1), a1, vc[2], vc[3]);
      PG8_WAIT_L(8); PG8_BAR; PG8_WAIT_L(0); PG8_MMA(0, 0, At, B0); PG8_BAR; PG8_SCHED;
      PG8_LDB(B1, 0, 1); PG8_STAGEB(PG8_SB(0, 0), b2);
      PG8_BAR; PG8_WAIT_L(0); PG8_MMA(0, 1, At, B1); PG8_BAR;
      PG8_LDA(At, 0, 1); PG8_STAGE2(PG8_SA(0, 0), a2, w0, w1);
      PG8_BAR; PG8_WAIT_L(0); PG8_MMA(1, 0, At, B0); PG8_BAR; PG8_SCHED;
      PG8_STAGEB(PG8_SB(0, 1), b2 + hstep);
      PG8_WAIT_V(6); PG8_BAR; PG8_MMA(1, 1, At, B1); PG8_BAR;
      PG8_LDB(B0, 1, 0); PG8_SCHED; PG8_LDA(At, 1, 0); PG8_STAGE2(PG8_SA(0, 1), a2, w2, w3);
      PG8_WAIT_L(8); PG8_BAR; PG8_WAIT_L(0); PG8_MMA(0, 0, At, B0); PG8_BAR; PG8_SCHED;
      PG8_LDB(B1, 1, 1); PG8_STAGEB(PG8_SB(1, 0), b3);
      PG8_BAR; PG8_WAIT_L(0); PG8_MMA(0, 1, At, B1); PG8_BAR;
      PG8_LDA(At, 1, 1); PG8_STAGE2(PG8_SA(1, 0), a3, w0, w1);
      PG8_BAR; PG8_WAIT_L(0); PG8_MMA(1, 0, At, B0); PG8_BAR; PG8_SCHED;
      PG8_STAGEB(PG8_SB(1, 1), b3 + hstep);
      PG8_WAIT_V(6); PG8_BAR; PG8_MMA(1, 1, At, B1); PG8_BAR;
    }
    S.epi(acc, cur, wr, wc, fr, fq);
    if (!has_next) break;
#pragma unroll
    for (int a = 0; a < 2; ++a)
#pragma unroll
      for (int b = 0; b < 2; ++b)
#pragma unroll
        for (int m = 0; m < 4; ++m)
#pragma unroll
          for (int n = 0; n < 2; ++n) acc[a][b][m][n] = f32x4{0.f, 0.f, 0.f, 0.f};
    cur = nxt; cA = nA; cB = nB; ++ui;
    vc[0] = vn[0]; vc[1] = vn[1]; vc[2] = vn[2]; vc[3] = vn[3];
  }
  PG8_WAIT_V(0);
  if (wr == 0) PG8_BAR;
  PG8_BAR;
#undef PG8_SA
#undef PG8_SB
#undef PG8_STAGE2
#undef PG8_STAGEB
#undef PG8_LDA
#undef PG8_LDB
#undef PG8_MMA
#undef PG8_WAIT_V
#undef PG8_WAIT_L
#undef PG8_BAR
#undef PG8_SCHED
}
template <class Cfg>
DI void gemm_phase_f8(lds_u8* lds, const Cfg& S) {
  const int tid = otid(), wid = __builtin_amdgcn_readfirstlane(tid >> 6), lane = tid & 63, wr = wid >> 2, wc = wid & 3, fr = lane & 15, fq = lane >> 4;
  const int K = S.K, nt = K / BK;
  int R0, C0, R1, C1;
  stage_rc(tid * 16, R0, C0);
  stage_rc(tid * 16 + 8192, R1, C1);
  unsigned voffB[2];
  {
    const int Rb0 = Cfg::PERM ? ((R0 & ~31) + perm32(R0 & 31)) : R0, Rb1 = Cfg::PERM ? ((R1 & ~31) + perm32(R1 & 31)) : R1;
    voffB[0] = (unsigned)(Rb0 * K + C0) * 2u; voffB[1] = (unsigned)(Rb1 * K + C1) * 2u;
  }
  const size_t kstep = (size_t)(BK * 2);
  const size_t hstep = (size_t)HALF * K * 2;
  const unsigned ldsw = (unsigned)wid * 1024u;
  const int cl = 2 * fq + (fq & 1), ch = 2 * fq + 1 - (fq & 1);
  const int aoffL = lds_byte(wr * 64 + fr, cl * 8), aoffH = lds_byte(wr * 64 + fr, ch * 8);
  const int boffL = lds_byte(wc * 32 + fr, cl * 8), boffH = lds_byte(wc * 32 + fr, ch * 8);
#define PG8_SA(b, h) (((b) * 2 + (h)) * HTB)
#define PG8_SB(b, h) ((4 + (b) * 2 + (h)) * HTB)
#define PG8_STAGE2(bufoff, gbase, o0, o1) do { \
    __builtin_amdgcn_global_load_lds((const unsigned*)((const char*)(gbase) + (o0)), (lds_u32*)(lds + (bufoff) + ldsw), 16, 0, 0); \
    __builtin_amdgcn_global_load_lds((const unsigned*)((const char*)(gbase) + (o1)), (lds_u32*)(lds + (bufoff) + ldsw + 8192), 16, 0, 0); } while (0)
#define PG8_STAGEB(bufoff, gbase) PG8_STAGE2(bufoff, gbase, voffB[0], voffB[1])
#define PG8_LDA(dst, b, h) do { _Pragma("unroll") for (int m = 0; m < 4; ++m) { const i32x4 lo_ = *(const lds_i32x4*)(lds + PG8_SA(b, h) + aoffL + m * 2048), hi_ = *(const lds_i32x4*)(lds + PG8_SA(b, h) + aoffH + m * 2048); dst[m] = __builtin_shufflevector(lo_, hi_, 0, 1, 2, 3, 4, 5, 6, 7); } } while (0)
#define PG8_LDB(dst, b, h) do { _Pragma("unroll") for (int n = 0; n < 2; ++n) { const i32x4 lo_ = *(const lds_i32x4*)(lds + PG8_SB(b, h) + boffL + n * 2048), hi_ = *(const lds_i32x4*)(lds + PG8_SB(b, h) + boffH + n * 2048); dst[n] = __builtin_shufflevector(lo_, hi_, 0, 1, 2, 3, 4, 5, 6, 7); } } while (0)
#define PG8_MMA(ai, bj, At, Bt) do { __builtin_amdgcn_s_setprio(1); _Pragma("unroll") for (int m = 0; m < 4; ++m) _Pragma("unroll") for (int n = 0; n < 2; ++n) \
    asm volatile("v_mfma_f32_16x16x128_f8f6f4 %0, %1, %2, %0" : "+v"(acc[ai][bj][m][n]) : "v"(Bt[n]), "v"(At[m])); __builtin_amdgcn_s_setprio(0); } while (0)
#define PG8_WAIT_V(n) asm volatile("s_waitcnt vmcnt(" #n ")" ::: "memory")
#define PG8_WAIT_L(n) asm volatile("s_waitcnt lgkmcnt(" #n ")" ::: "memory")
#define PG8_BAR __builtin_amdgcn_s_barrier()
#define PG8_SCHED __builtin_amdgcn_sched_barrier(0)
  Unit cur, nxt; int ui = 0;
  if (!S.next(0, cur)) return;
  f32x4 acc[2][2][4][2];
#pragma unroll
  for (int a = 0; a < 2; ++a)
#pragma unroll
    for (int b = 0; b < 2; ++b)
#pragma unroll
      for (int m = 0; m < 4; ++m)
#pragma unroll
        for (int n = 0; n < 2; ++n) acc[a][b][m][n] = f32x4{0.f, 0.f, 0.f, 0.f};
  i32x8 At[4], B0[2], B1[2];
  const char* cA = S.a_base(cur);
  const char* cB = S.b_base(cur);
  unsigned vc[4], vn[4];
  S.a_off(cur, R0, C0, R1, C1, vc, 0);
  PG8_STAGEB(PG8_SB(0, 0), cB); PG8_STAGE2(PG8_SA(0, 0), cA, vc[0], vc[1]); PG8_STAGEB(PG8_SB(0, 1), cB + hstep); PG8_STAGE2(PG8_SA(0, 1), cA, vc[2], vc[3]);
  if (wr == 1) PG8_BAR;
  PG8_WAIT_V(4); PG8_BAR;
  PG8_STAGEB(PG8_SB(1, 0), cB + kstep); PG8_STAGE2(PG8_SA(1, 0), cA + kstep, vc[0], vc[1]); PG8_STAGEB(PG8_SB(1, 1), cB + hstep + kstep);
  PG8_WAIT_V(6); PG8_BAR;
  for (;;) {
    const bool has_next = S.next(ui + 1, nxt);
    const char* nA = has_next ? S.a_base(nxt) : cA;
    const char* nB = has_next ? S.b_base(nxt) : cB;
    if (has_next) S.a_off(nxt, R0, C0, R1, C1, vn, ui + 1);
    else { vn[0] = vc[0]; vn[1] = vc[1]; vn[2] = vc[2]; vn[3] = vc[3]; }
    for (int t = 0; t < nt; t += 2) {
      const bool last = (t == nt - 2);
      const char* a1 = cA + (size_t)(t + 1) * kstep;
      const char* a2 = last ? nA : cA + (size_t)(t + 2) * kstep;
      const char* b2 = last ? nB : cB + (size_t)(t + 2) * kstep;
      const char* a3 = a2 + kstep;
      const char* b3 = b2 + kstep;
      const unsigned w0 = last ? vn[0] : vc[0], w1 = last ? vn[1] : vc[1], w2 = last ? vn[2] : vc[2], w3 = last ? vn[3] : vc[3];
      PG8_LDB(B0, 0, 0); PG8_SCHED; PG8_LDA(At, 0, 0); PG8_STAGE2(PG8_SA(1, 1), a1, vc[2], vc[3]);
      PG8_WAIT_L(8); PG8_BAR; PG8_WAIT_L(0); PG8_MMA(0, 0, At, B0); PG8_BAR; PG8_SCHED;
      PG8_LDB(B1, 0, 1); PG8_STAGEB(PG8_SB(0, 0), b2);
      PG8_BAR; PG8_WAIT_L(0); PG8_MMA(0, 1, At, B1); PG8_BAR;
      PG8_LDA(At, 0, 1); PG8_STAGE2(PG8_SA(0, 0), a2, w0, w1);
      PG8_BAR; PG8_WAIT_L(0); PG8_MMA(1, 0, At, B0); PG8_BAR; PG8_SCHED;
      PG8_STAGEB(PG8_SB(0, 1), b2 + hstep);
      PG8_WAIT_V(6); PG8_BAR; PG8_MMA(1, 1, At, B1); PG8_BAR;
      PG8_LDB(B0, 1, 0); PG8_SCHED; PG8_LDA(At, 1, 0); PG8_STAGE2(PG8_SA(0, 1), a2, w2, w3);
      PG8_WAIT_L(8); PG8_BAR; PG8_WAIT_L(0); PG8_MMA(0, 0, At, B0); PG8_BAR; PG8_SCHED;
      PG8_LDB(B1, 1, 1); PG8_STAGEB(PG8_SB(1, 0), b3);
      PG8_BAR; PG8_WAIT_L(0); PG8_MMA(0, 1, At, B1); PG8_BAR;
      PG8_LDA(At, 1, 1); PG8_STAGE2(PG8_SA(1, 0), a3, w0, w1);
      PG8_BAR; PG8_WAIT_L(0); PG8_MMA(1, 0, At, B0); PG8_BAR; PG8_SCHED;
      PG8_STAGEB(PG8_SB(1, 1), b3 + hstep);
      PG8_WAIT_V(6); PG8_BAR; PG8_MMA(1, 1, At, B1); PG8_BAR;
    }
    asm volatile("s_nop 15\n\ts_nop 15" ::: "memory");
    S.epi(acc, cur, wr, wc, fr, fq);
    if (!has_next) break;
#pragma unroll
    for (int a = 0; a < 2; ++a)
#pragma unroll
      for (int b = 0; b < 2; ++b)
#pragma unroll
        for (int m = 0; m < 4; ++m)
#pragma unroll
          for (int n = 0; n < 2; ++n) acc[a][b][m][n] = f32x4{0.f, 0.f, 0.f, 0.f};
    cur = nxt; cA = nA; cB = nB; ++ui;
    vc[0] = vn[0]; vc[1] = vn[1]; vc[2] = vn[2]; vc[3] = vn[3];
  }
  PG8_WAIT_V(0);
  if (wr == 0) PG8_BAR;
  PG8_BAR;
#undef PG8_SA
#undef PG8_SB
#undef PG8_STAGE2
#undef PG8_STAGEB
#undef PG8_LDA
#undef PG8_LDB
#undef PG8_MMA
#undef PG8_WAIT_V
#undef PG8_WAIT_L
#undef PG8_BAR
#undef PG8_SCHED
}
}

struct CfgInproj {
  static constexpr bool PERM = true;
  int K; const Params* p; int L; int bid, nb;
  DI bool next(int i, pg8::Unit& u) const { const int t = i * nb + bid; if (t >= 64 * 13) return false; u.pm = t & 63; u.pn = t >> 6; return true; }
  DI const char* a_base(const pg8::Unit& u) const { return (const char*)(p->hn() + (size_t)u.pm * 256 * DM); }
  DI const char* b_base(const pg8::Unit& u) const { return (const char*)(p->WinT() + ((size_t)L * PWP + (size_t)u.pn * 256) * DM); }
  DI void a_off(const pg8::Unit&, int R0, int C0, int R1, int C1, unsigned (&vo)[4]) const {
    vo[0] = (unsigned)(R0 * DM + C0) * 2u; vo[1] = (unsigned)(R1 * DM + C1) * 2u;
    vo[2] = vo[0] + 128u * DM * 2u; vo[3] = vo[1] + 128u * DM * 2u;
  }
  DI void epi(const f32x4 (&acc)[2][2][4][2], const pg8::Unit& u, int wr, int wc, int fr, int fq) const {
    const int row0 = u.pm * 256 + wr * 64 + fr, col0 = u.pn * 256 + wc * 32 + 8 * fq;
#pragma unroll
    for (int ai = 0; ai < 2; ++ai)
#pragma unroll
      for (int m = 0; m < 4; ++m) {
        u16* rowp = p->proj() + (size_t)(row0 + ai * 128 + m * 16) * PWP + col0;
#pragma unroll
        for (int bj = 0; bj < 2; ++bj) {
          uint4 w;
          w.x = pack2(acc[ai][bj][m][0][0], acc[ai][bj][m][0][1]); w.y = pack2(acc[ai][bj][m][0][2], acc[ai][bj][m][0][3]);
          w.z = pack2(acc[ai][bj][m][1][0], acc[ai][bj][m][1][1]); w.w = pack2(acc[ai][bj][m][1][2], acc[ai][bj][m][1][3]);
          *reinterpret_cast<uint4*>(rowp + bj * 128) = w;
        }
      }
  }
};
DI void ph_inproj_tail(const Params& p, int L, char* smem, int t) {
  const int m0 = (t & 63) * 256, n0 = 3072 + (t >> 6) * 128;
  const u16* Bt = p.WinT() + ((size_t)L * PWP + n0) * DM;
  gemm_tile([&](int r) { return p.hn() + (size_t)(m0 + r) * DM; }, Bt, DM, DM, smem,
            [&](f32x4 (&acc)[4][4], int wr, int wc, int fr, int fq) {
#pragma unroll
              for (int m = 0; m < 4; ++m)
#pragma unroll
                for (int n = 0; n < 4; ++n)
#pragma unroll
                  for (int j = 0; j < 4; ++j)
                    p.proj()[(size_t)(m0 + wr * 64 + m * 16 + fq * 4 + j) * PWP + n0 + wc * 64 + n * 16 + fr] = f2bf(acc[m][n][j]);
            });
}
DI void ph_inproj(const Params& p, int L, char* smem) {
  CfgInproj c; c.K = DM; c.p = &p; c.L = L; c.bid = obid(); c.nb = gridDim.x;
  pg8::gemm_phase((pg8::lds_u8*)smem, c);
  if (gridDim.x == 256 && obid() >= CVT_IDLE_FIRST_BLK) cvt_tiles_idle(p, L, smem, 0, CVT_NA);
}

DI void ph_gemm_store_bf16(const u16* A, int lda, const u16* Bt, int K, int M, int N, u16* C, int ldc, char* smem, int rot) {
  const int mt = M / 256, nt = N / 128;
  const int nb = gridDim.x;
  for (int t = (obid() + rot) % nb; t < mt * nt; t += nb) {
    const int m0 = (t % mt) * 256, n0 = (t / mt) * 128;
    gemm_tile([&](int r) { return A + (size_t)(m0 + r) * lda; }, Bt + (size_t)n0 * K, K, K, smem,
              [&](f32x4 (&acc)[4][4], int wr, int wc, int fr, int fq) {
#pragma unroll
                for (int m = 0; m < 4; ++m)
#pragma unroll
                  for (int n = 0; n < 4; ++n)
#pragma unroll
                    for (int j = 0; j < 4; ++j) {
                      const int row = m0 + wr * 64 + m * 16 + fq * 4 + j, col = n0 + wc * 64 + n * 16 + fr;
                      C[(size_t)row * ldc + col] = f2bf(acc[m][n][j]);
                    }
              });
  }
}

DI void ph_rmsnorm_bf16(const float* __restrict__ xin, const float* __restrict__ w, u16* __restrict__ outp) {
  const int tid_ = otid(); const int lane = tid_ & 63, gw = (obid() * NTHR + tid_) >> 6, nw = gridDim.x * (NTHR / 64);
  for (int t = gw; t < T; t += nw) {
    const float* xr = xin + (size_t)t * DM;
    float4 v[4];
    float ss = 0.f;
#pragma unroll
    for (int i = 0; i < 4; ++i) {
      v[i] = *reinterpret_cast<const float4*>(xr + (i * 64 + lane) * 4);
      ss += v[i].x * v[i].x + v[i].y * v[i].y + v[i].z * v[i].z + v[i].w * v[i].w;
    }
    ss = wave_sum(ss);
    const float rstd = rsqrtf(ss * (1.f / DM) + 1e-6f);
#pragma unroll
    for (int i = 0; i < 4; ++i) {
      const int c = (i * 64 + lane) * 4;
      const float4 ww = *reinterpret_cast<const float4*>(w + c);
      uint2 o;
      o.x = pack2(v[i].x * rstd * ww.x, v[i].y * rstd * ww.y);
      o.y = pack2(v[i].z * rstd * ww.z, v[i].w * rstd * ww.w);
      *reinterpret_cast<uint2*>(outp + (size_t)t * DM + c) = o;
    }
  }
}

DI void ph_final_norm(const float* __restrict__ xin, const float* __restrict__ w, float* __restrict__ outp) {
  const int tid_ = otid(); const int lane = tid_ & 63, gw = (obid() * NTHR + tid_) >> 6, nw = gridDim.x * (NTHR / 64);
  for (int t = gw; t < T; t += nw) {
    const float* xr = xin + (size_t)t * DM;
    float4 v[4];
    float ss = 0.f;
#pragma unroll
    for (int i = 0; i < 4; ++i) {
      v[i] = *reinterpret_cast<const float4*>(xr + (i * 64 + lane) * 4);
      ss += v[i].x * v[i].x + v[i].y * v[i].y + v[i].z * v[i].z + v[i].w * v[i].w;
    }
    ss = wave_sum(ss);
    const float rstd = rsqrtf(ss * (1.f / DM) + 1e-6f);
#pragma unroll
    for (int i = 0; i < 4; ++i) {
      const int c = (i * 64 + lane) * 4;
      const float4 ww = *reinterpret_cast<const float4*>(w + c);
      float4 o = make_float4(v[i].x * rstd * ww.x, v[i].y * rstd * ww.y, v[i].z * rstd * ww.z, v[i].w * rstd * ww.w);
      *reinterpret_cast<float4*>(outp + (size_t)t * DM + c) = o;
    }
  }
}

DI void rot8(const u16* x1p, const u16* x2p, const float* tab  , float scale, uint4& o1, uint4& o2) {
  float x1[8], x2[8], y1[8], y2[8];
  ld8(x1p, x1); ld8(x2p, x2);
#pragma unroll
  for (int e = 0; e < 8; e += 2) {
    const float4 cs = *reinterpret_cast<const float4*>(tab + e * 2);
    y1[e] = (x1[e] * cs.x - x2[e] * cs.y) * scale;
    y2[e] = (x2[e] * cs.x + x1[e] * cs.y) * scale;
    y1[e + 1] = (x1[e + 1] * cs.z - x2[e + 1] * cs.w) * scale;
    y2[e + 1] = (x2[e + 1] * cs.z + x1[e + 1] * cs.w) * scale;
  }
  o1.x = pack2(y1[0], y1[1]); o1.y = pack2(y1[2], y1[3]); o1.z = pack2(y1[4], y1[5]); o1.w = pack2(y1[6], y1[7]);
  o2.x = pack2(y2[0], y2[1]); o2.y = pack2(y2[2], y2[3]); o2.z = pack2(y2[4], y2[5]); o2.w = pack2(y2[6], y2[7]);
}
DI void ph_post(const Params& p, int L) {
  const int tid = otid();
  const int gt = obid() * NTHR + tid, gs = gridDim.x * NTHR;
  const int lane = tid & 63, gw = gt >> 6, nw = gs >> 6;
  const float* qnw = p.q_norm_w + L * 256;
  const float* kvnw = p.kv_norm_w + L * 128;
  const float* cw = p.conv_w + L * 5 * 768;
  const float* cb = p.conv_b + L * 768;
  const float* dtb = p.dt_bias + L * 8;
  {
    uint4 xr[5];
    auto load_taps = [&](int idx, uint4 (&r)[5]) {
      const int t = idx / 96, cg = idx - t * 96, s = t & (SEQ - 1);
#pragma unroll
      for (int w = 0; w < 5; ++w) {
        const int ss = s + w - 2;
        const int tt = (ss >= 0 && ss < SEQ) ? (t + w - 2) : t;
        r[w] = *reinterpret_cast<const uint4*>(p.proj() + (size_t)tt * PWP + C_XBC + cg * 8);
      }
    };
    if (gt < T * 96) load_taps(gt, xr);
    for (int idx = gt; idx < T * 96; idx += gs) {
      const int t = idx / 96, cg = idx - t * 96, s = t & (SEQ - 1);
      uint4 xn[5];
      const int idn = (idx + gs < T * 96) ? (idx + gs) : idx;
      load_taps(idn, xn);
      float acc[8];
      {
        const float4 b0 = *reinterpret_cast<const float4*>(cb + cg * 8), b1 = *reinterpret_cast<const float4*>(cb + cg * 8 + 4);
        acc[0] = b0.x; acc[1] = b0.y; acc[2] = b0.z; acc[3] = b0.w; acc[4] = b1.x; acc[5] = b1.y; acc[6] = b1.z; acc[7] = b1.w;
      }
#pragma unroll
      for (int w = 0; w < 5; ++w) {
        const int ss = s + w - 2;
        const float msk = (ss >= 0 && ss < SEQ) ? 1.f : 0.f;
        float xv[8];
        unpack8(xr[w], xv);
        const float4 w0 = *reinterpret_cast<const float4*>(cw + w * 768 + cg * 8), w1 = *reinterpret_cast<const float4*>(cw + w * 768 + cg * 8 + 4);
        acc[0] += msk * xv[0] * w0.x; acc[1] += msk * xv[1] * w0.y; acc[2] += msk * xv[2] * w0.z; acc[3] += msk * xv[3] * w0.w;
        acc[4] += msk * xv[4] * w1.x; acc[5] += msk * xv[5] * w1.y; acc[6] += msk * xv[6] * w1.z; acc[7] += msk * xv[7] * w1.w;
      }
      uint4 o;
      o.x = pack2(fast_silu(acc[0]), fast_silu(acc[1])); o.y = pack2(fast_silu(acc[2]), fast_silu(acc[3]));
      o.z = pack2(fast_silu(acc[4]), fast_silu(acc[5])); o.w = pack2(fast_silu(acc[6]), fast_silu(acc[7]));
      *reinterpret_cast<uint4*>(p.xbc() + (size_t)t * 768 + cg * 8) = o;
#pragma unroll
      for (int w = 0; w < 5; ++w) xr[w] = xn[w];
    }
  }
  for (int idx = gt; idx < T * 8; idx += gs) {
    const int t = idx >> 3, k = idx & 7;
    const float v = bf2f(p.proj()[(size_t)t * PWP + C_DT + k]) + dtb[k];
    p.dtv()[idx] = (v > 20.f) ? v : log1pf(expf(v));
  }
  {
    const int sub = lane >> 4, l16 = lane & 15;
    for (int t = gw * 4 + sub; t < T; t += nw * 4) {
      const u16* pr = p.proj() + (size_t)t * PWP;
      float v[16], u[8];
      ld8(pr + C_CQ + l16 * 16, v); ld8(pr + C_CQ + l16 * 16 + 8, v + 8);
      ld8(pr + C_CKV + l16 * 8, u);
      float ss = 0.f, s2 = 0.f;
#pragma unroll
      for (int i = 0; i < 16; ++i) ss += v[i] * v[i];
#pragma unroll
      for (int i = 0; i < 8; ++i) s2 += u[i] * u[i];
#pragma unroll
      for (int o = 1; o < 16; o <<= 1) { ss += __shfl_xor(ss, o); s2 += __shfl_xor(s2, o); }
      const float rstd = rsqrtf(ss * (1.f / 256.f) + 1e-6f), r2 = rsqrtf(s2 * (1.f / 128.f) + 1e-6f);
      uint4 o;
      const float* qw = qnw + l16 * 16;
      o.x = pack2(v[0] * rstd * qw[0], v[1] * rstd * qw[1]); o.y = pack2(v[2] * rstd * qw[2], v[3] * rstd * qw[3]);
      o.z = pack2(v[4] * rstd * qw[4], v[5] * rstd * qw[5]); o.w = pack2(v[6] * rstd * qw[6], v[7] * rstd * qw[7]);
      *reinterpret_cast<uint4*>(p.cqn() + (size_t)t * 256 + l16 * 16) = o;
      o.x = pack2(v[8] * rstd * qw[8], v[9] * rstd * qw[9]); o.y = pack2(v[10] * rstd * qw[10], v[11] * rstd * qw[11]);
      o.z = pack2(v[12] * rstd * qw[12], v[13] * rstd * qw[13]); o.w = pack2(v[14] * rstd * qw[14], v[15] * rstd * qw[15]);
      *reinterpret_cast<uint4*>(p.cqn() + (size_t)t * 256 + l16 * 16 + 8) = o;
      const float* kw = kvnw + l16 * 8;
      o.x = pack2(u[0] * r2 * kw[0], u[1] * r2 * kw[1]); o.y = pack2(u[2] * r2 * kw[2], u[3] * r2 * kw[3]);
      o.z = pack2(u[4] * r2 * kw[4], u[5] * r2 * kw[5]); o.w = pack2(u[6] * r2 * kw[6], u[7] * r2 * kw[7]);
      *reinterpret_cast<uint4*>(p.ckvn() + (size_t)t * 128 + l16 * 8) = o;
    }
  }
  {
    auto item_of = [&](int idx, u16*& a, int& off2, int& tabo, float& scale, int& krope_i0) {
      const int t = idx / 42, ri = idx - t * 42, s = t & (SEQ - 1);
      u16* pr = p.proj() + (size_t)t * PWP;
      krope_i0 = -1;
      if (ri < 32) {
        const int isk = ri >> 4, h = (ri >> 2) & 3, i0 = (ri & 3) * 8;
        a = pr + (isk ? C_RK : C_RQ) + h * 64 + i0; off2 = 32; tabo = (s * 56 + i0) * 2; scale = isk ? 1.f : 0.125f;
      } else if (ri < 40) {
        const int j = ri - 32, isk = j >> 2, h = j & 3;
        a = pr + (isk ? C_DK : C_DQ) + h * 64; off2 = 8; tabo = (s * 56 + 32) * 2; scale = 1.f;
      } else {
        const int i0 = (ri - 40) * 8;
        a = pr + C_KR + i0; off2 = 16; tabo = (s * 56 + 40 + i0) * 2; scale = 1.f; krope_i0 = i0;
      }
    };
    uint4 x1c = make_uint4(0, 0, 0, 0), x2c = make_uint4(0, 0, 0, 0);
    if (gt < T * 42) {
      u16* a; int off2, tabo, ki; float sc;
      item_of(gt, a, off2, tabo, sc, ki);
      x1c = *reinterpret_cast<const uint4*>(a); x2c = *reinterpret_cast<const uint4*>(a + off2);
    }
    for (int idx = gt; idx < T * 42; idx += gs) {
      u16* a; int off2, tabo, ki; float scale;
      item_of(idx, a, off2, tabo, scale, ki);
      uint4 x1n, x2n;
      {
        const int idn = (idx + gs < T * 42) ? (idx + gs) : idx;
        u16* an; int o2n, tn_, kn; float scn;
        item_of(idn, an, o2n, tn_, scn, kn);
        x1n = *reinterpret_cast<const uint4*>(an); x2n = *reinterpret_cast<const uint4*>(an + o2n);
      }
      float x1[8], x2[8], y1[8], y2[8];
      unpack8(x1c, x1); unpack8(x2c, x2);
      const float* tab = p.rtab() + tabo;
#pragma unroll
      for (int e = 0; e < 8; e += 2) {
        const float4 cs = *reinterpret_cast<const float4*>(tab + e * 2);
        y1[e] = (x1[e] * cs.x - x2[e] * cs.y) * scale;
        y2[e] = (x2[e] * cs.x + x1[e] * cs.y) * scale;
        y1[e + 1] = (x1[e + 1] * cs.z - x2[e + 1] * cs.w) * scale;
        y2[e + 1] = (x2[e + 1] * cs.z + x1[e + 1] * cs.w) * scale;
      }
      uint4 o1, o2;
      o1.x = pack2(y1[0], y1[1]); o1.y = pack2(y1[2], y1[3]); o1.z = pack2(y1[4], y1[5]); o1.w = pack2(y1[6], y1[7]);
      o2.x = pack2(y2[0], y2[1]); o2.y = pack2(y2[2], y2[3]); o2.z = pack2(y2[4], y2[5]); o2.w = pack2(y2[6], y2[7]);
      *reinterpret_cast<uint4*>(a) = o1;
      *reinterpret_cast<uint4*>(a + off2) = o2;
      if (ki >= 0) {
        const int t = idx / 42, s = t & (SEQ - 1), bb = t >> 12;
#pragma unroll
        for (int hd = 0; hd < 4; ++hd) {
          u16* kf = p.kfull() + ((size_t)(bb * 4 + hd) * SEQ + s) * 96 + 64 + ki;
          *reinterpret_cast<uint4*>(kf) = o1;
          *reinterpret_cast<uint4*>(kf + 16) = o2;
        }
      }
      x1c = x1n; x2c = x2n;
    }
  }
}

DI void ph_mla_up_q(const Params& p, int L, char* smem, int t) {
  const int mt = T / 256;
  const u16* Bq = p.WuqT() + (size_t)L * 384 * 256;
  {
    const int m0 = (t % mt) * 256, n0 = (t / mt) * 128;
    gemm_tile([&](int r) { return p.cqn() + (size_t)(m0 + r) * 256; }, Bq + (size_t)n0 * 256, 256, 256, smem,
              [&](f32x4 (&acc)[4][4], int wr, int wc, int fr, int fq) {
                const float scale = 0.10206207261596575f * 1.4426950408889634f;
#pragma unroll
                for (int m = 0; m < 4; ++m)
#pragma unroll
                  for (int j = 0; j < 4; ++j) {
                    const int row = m0 + wr * 64 + m * 16 + fq * 4 + j;
                    const float2 cssn = *reinterpret_cast<const float2*>(p.rtab() + ((size_t)(row & (SEQ - 1)) * 56 + 40 + fr) * 2);
                    const float cs = cssn.x, sn = cssn.y;
#pragma unroll
                    for (int n2 = 0; n2 < 4; n2 += 2) {
                      const int cb = n0 + wc * 64 + n2 * 16;
                      float x1 = acc[m][n2][j], x2 = acc[m][n2 + 1][j];
                      if (cb % 96 == 64) {
                        const float y1 = x1 * cs - x2 * sn, y2 = x2 * cs + x1 * sn;
                        x1 = y1; x2 = y2;
                      }
                      p.mq()[(size_t)row * 384 + cb + fr] = f2bf(x1 * scale);
                      p.mq()[(size_t)row * 384 + cb + 16 + fr] = f2bf(x2 * scale);
                    }
                  }
              });
  }
}
DI void ph_mla_up_kv(const Params& p, int L, char* smem, int t) {
  const int mt = T / 256;
  const u16* Bkv = p.WukvT() + (size_t)L * 512 * 128;
  {
    const int m0 = (t % mt) * 256, h = t / mt, n0 = h * 128;
    gemm_tile([&](int r) { return p.ckvn() + (size_t)(m0 + r) * 128; }, Bkv + (size_t)n0 * 128, 128, 128, smem,
              [&](f32x4 (&acc)[4][4], int wr, int wc, int fr, int fq) {
#pragma unroll
                for (int m = 0; m < 4; ++m) {
                  const int row = m0 + wr * 64 + m * 16 + fq * 4;
                  const int bb = row >> 12, sq = row & (SEQ - 1);
                  const size_t bh = (size_t)(bb * 4 + h);
#pragma unroll
                  for (int n = 0; n < 4; ++n) {
                    if (wc == 0) {
#pragma unroll
                      for (int j = 0; j < 4; ++j) p.kfull()[(bh * SEQ + sq + j) * 96 + n * 16 + fr] = f2bf(acc[m][n][j]);
                    } else {
                      uint2 v;
                      v.x = pack2(acc[m][n][0], acc[m][n][1]);
                      v.y = pack2(acc[m][n][2], acc[m][n][3]);
                      const int sqp = (sq & ~12) | ((sq & 4) << 1) | ((sq & 8) >> 1);
                      *reinterpret_cast<uint2*>(p.vT() + (bh * 64 + n * 16 + fr) * SEQ + sqp) = v;
                    }
                  }
                }
              });
  }
}

DI void ph_cumsum(const Params& p, int L) {
  const int tid_ = otid(); const int lane = tid_ & 63, gw = (obid() * NTHR + tid_) >> 6, nw = gridDim.x * (NTHR / 64);
  for (int it = gw; it < 32; it += nw) {
    const int h = it & 3, dir = (it >> 2) & 1, b = it >> 3;
    const float a = -expf(p.a_log[L * 8 + dir * 4 + h]);
    float running = 0.f;
    for (int c = 0; c < 64; ++c) {
      const int i = c * 64 + lane;
      const int s = dir ? (SEQ - 1 - i) : i;
      const size_t off = (size_t)(b * SEQ + s) * 8 + dir * 4 + h;
      float v = p.dtv()[off] * a;
#pragma unroll
      for (int o = 1; o < 64; o <<= 1) {
        const float u = __shfl_up(v, o);
        if (lane >= o) v += u;
      }
      v += running;
      p.cs()[off] = v;
      running = __shfl(v, 63);
    }
  }
}

DI void ph_ret_naive(const Params& p) {
  const int gt = obid() * NTHR + otid(), gs = gridDim.x * NTHR;
  for (int it = gt; it < 4 * 4 * SEQ; it += gs) {
    const int n = it & (SEQ - 1), h = (it >> 12) & 3, b = it >> 14;
    const u16* base = p.proj() + (size_t)(b * SEQ) * PWP;
    uint4 qp[8];
    float o[64];
#pragma unroll
    for (int d = 0; d < 8; ++d) qp[d] = *reinterpret_cast<const uint4*>(base + (size_t)n * PWP + C_RQ + h * 64 + d * 8);
#pragma unroll
    for (int d = 0; d < 64; ++d) o[d] = 0.f;
    const float lg0 = log1pf(-exp2f(-5.f - (float)h)), lg1 = log1pf(-exp2f(-5.5f - (float)h));
#pragma unroll 1
    for (int m = 0; m < SEQ; ++m) {
      const u16* kr = base + (size_t)m * PWP + C_RK + h * 64;
      const u16* vr = base + (size_t)m * PWP + C_RV + h * 64;
      float s = 0.f;
#pragma unroll
      for (int d = 0; d < 8; ++d) s = dot8(qp[d], *reinterpret_cast<const uint4*>(kr + d * 8), s);
      const float w = (m <= n) ? expf(lg0 * (float)(n - m)) : expf(lg1 * (float)(m - n));
      s *= w;
#pragma unroll
      for (int d = 0; d < 64; d += 8) {
        float vf[8];
        ld8(vr + d, vf);
#pragma unroll
        for (int j = 0; j < 8; ++j) o[d + j] += s * vf[j];
      }
    }
    float mu = 0.f;
#pragma unroll
    for (int d = 0; d < 64; ++d) mu += o[d];
    mu *= (1.f / 64.f);
    float var = 0.f;
#pragma unroll
    for (int d = 0; d < 64; ++d) var += (o[d] - mu) * (o[d] - mu);
    var *= (1.f / 64.f);
    const float rs = rsqrtf(var + 1e-5f);
    const size_t t = (size_t)b * SEQ + n;
#pragma unroll
    for (int d = 0; d < 64; d += 8) {
      float g[8];
      ld8(p.proj() + t * PWP + C_RG + h * 64 + d, g);
      uint4 ov;
      ov.x = pack2(silu(g[0]) * (o[d + 0] - mu) * rs, silu(g[1]) * (o[d + 1] - mu) * rs);
      ov.y = pack2(silu(g[2]) * (o[d + 2] - mu) * rs, silu(g[3]) * (o[d + 3] - mu) * rs);
      ov.z = pack2(silu(g[4]) * (o[d + 4] - mu) * rs, silu(g[5]) * (o[d + 5] - mu) * rs);
      ov.w = pack2(silu(g[6]) * (o[d + 6] - mu) * rs, silu(g[7]) * (o[d + 7] - mu) * rs);
      *reinterpret_cast<uint4*>(p.mixed() + t * DM + h * 64 + d) = ov;
    }
  }
}

DI void ph_mla_naive(const Params& p) {
  const int gt = obid() * NTHR + otid(), gs = gridDim.x * NTHR;
  for (int it = gt; it < 2 * 4 * 4 * SEQ; it += gs) {
    const int n = it & (SEQ - 1), vh = (it >> 12) & 1, h = (it >> 13) & 3, b = it >> 15;
    const size_t t = (size_t)b * SEQ + n;
    uint4 qp[12];
    float o[32];
#pragma unroll
    for (int d = 0; d < 12; ++d) qp[d] = *reinterpret_cast<const uint4*>(p.mq() + t * 384 + h * 96 + d * 8);
    const size_t tb = (size_t)b * SEQ;
    float mx = -1e30f;
#pragma unroll 1
    for (int m = 0; m < SEQ; ++m) {
      const u16* kn = ((u16*)nullptr) + (tb + m) * 512 + h * 128;
      const u16* kr = p.proj() + (tb + m) * PWP + C_KR;
      float s = 0.f;
#pragma unroll
      for (int d = 0; d < 8; ++d) s = dot8(qp[d], *reinterpret_cast<const uint4*>(kn + d * 8), s);
#pragma unroll
      for (int d = 0; d < 4; ++d) s = dot8(qp[8 + d], *reinterpret_cast<const uint4*>(kr + d * 8), s);
      mx = fmaxf(mx, s);
    }
#pragma unroll
    for (int d = 0; d < 32; ++d) o[d] = 0.f;
    float l = 0.f;
#pragma unroll 1
    for (int m = 0; m < SEQ; ++m) {
      const u16* kn = ((u16*)nullptr) + (tb + m) * 512 + h * 128;
      const u16* kr = p.proj() + (tb + m) * PWP + C_KR;
      float s = 0.f;
#pragma unroll
      for (int d = 0; d < 8; ++d) s = dot8(qp[d], *reinterpret_cast<const uint4*>(kn + d * 8), s);
#pragma unroll
      for (int d = 0; d < 4; ++d) s = dot8(qp[8 + d], *reinterpret_cast<const uint4*>(kr + d * 8), s);
      const float pe = exp2f(s - mx);
      l += pe;
#pragma unroll
      for (int d = 0; d < 32; d += 8) {
        float vf[8];
        ld8(kn + 64 + vh * 32 + d, vf);
#pragma unroll
        for (int j = 0; j < 8; ++j) o[d + j] += pe * vf[j];
      }
    }
    const float il = 1.f / l;
#pragma unroll
    for (int d = 0; d < 32; d += 8) {
      uint4 ov;
      ov.x = pack2(o[d + 0] * il, o[d + 1] * il);
      ov.y = pack2(o[d + 2] * il, o[d + 3] * il);
      ov.z = pack2(o[d + 4] * il, o[d + 5] * il);
      ov.w = pack2(o[d + 6] * il, o[d + 7] * il);
      *reinterpret_cast<uint4*>(p.mixed() + t * DM + 256 + h * 64 + vh * 32 + d) = ov;
    }
  }
}

#define MFMA32(a, b, c) __builtin_amdgcn_mfma_f32_32x32x16_bf16((a), (b), (c), 0, 0, 0)
DI float max16(const f32x16& v) {
  float a = fmaxf(fmaxf(v[0], v[1]), v[2]), b = fmaxf(fmaxf(v[3], v[4]), v[5]), c = fmaxf(fmaxf(v[6], v[7]), v[8]);
  float d = fmaxf(fmaxf(v[9], v[10]), v[11]), e = fmaxf(fmaxf(v[12], v[13]), v[14]);
  return fmaxf(fmaxf(fmaxf(a, b), fmaxf(c, d)), fmaxf(e, v[15]));
}
DI void ph_mla_attn(const Params& p, char* smem, int L) {
  const int tid = otid(), wid = tid >> 6, lane = tid & 63, l32 = lane & 31, hh = lane >> 5;
  u16* sK = reinterpret_cast<u16*>(smem);
  u16* sV = sK + 2 * 128 * 104;
  uint4 konev = make_uint4(hh == 0 ? 0x00003F80u : 0u, 0u, 0u, 0u);
  const bf16x8 kone = __builtin_bit_cast(bf16x8, konev);
  for (int item = obid(); item < 256; item += gridDim.x) {
    const int xcd_ = item & 7, jx_ = item >> 3, bh = xcd_ * 2 + (jx_ >> 4), qt = jx_ & 15, b = bh >> 2, h = bh & 3;
    const size_t t0 = (size_t)b * SEQ + qt * 256 + wid * 32;
    bf16x8 qf[6];
#pragma unroll
    for (int ks = 0; ks < 6; ++ks) qf[ks] = *reinterpret_cast<const bf16x8*>(p.mq() + (t0 + l32) * 384 + h * 96 + ks * 16 + hh * 8);
    const u16* kg = p.kfull() + (size_t)bh * SEQ * 96;
    const u16* vg = p.vT() + (size_t)bh * 64 * SEQ;
    f32x16 o0, o1;
#pragma unroll
    for (int i = 0; i < 16; ++i) { o0[i] = 0.f; o1[i] = 0.f; }
    float m = 0.f, l = 0.f;
    bf16x8 qf6 = __builtin_bit_cast(bf16x8, make_uint4(0u, 0u, 0u, 0u));
    const int kr0 = tid / 12, kc0 = tid % 12, kr1 = (512 + tid) / 12, kc1 = (512 + tid) % 12, kr2 = (1024 + tid) / 12, kc2 = (1024 + tid) % 12;
    const int vd0 = tid >> 4, vd1 = 32 + (tid >> 4), vkc = (tid & 15) * 8;
    uint4 ak0, ak1, ak2, av0, av1;
#define MLA_LD(dst_, ptr_) asm volatile("global_load_dwordx4 %0, %1, off" : "=v"(dst_) : "v"(ptr_) : "memory")
#define MLA_GLOAD(K0, K1, K2, V0, V1, kt_)                                               \
    {                                                                                    \
      const u16* kb_ = kg + (size_t)(kt_) * 128 * 96 + tid * 8;                          \
      MLA_LD(K0, kb_); MLA_LD(K1, kb_ + 512 * 8); MLA_LD(K2, kb_ + 1024 * 8);            \
      const u16* vp_ = vg + (size_t)vd0 * SEQ + (kt_) * 128 + vkc;                       \
      MLA_LD(V0, vp_); MLA_LD(V1, vp_ + (size_t)32 * SEQ);                               \
    }
#define MLA_SSTORE(K0, K1, K2, V0, V1, buf_)                                             \
    {                                                                                    \
      u16* kb_ = sK + (buf_) * 128 * 104;                                                \
      u16* vb_ = sV + (buf_) * 64 * 136;                                                 \
      *reinterpret_cast<uint4*>(kb_ + kr0 * 104 + kc0 * 8) = K0;                         \
      *reinterpret_cast<uint4*>(kb_ + kr1 * 104 + kc1 * 8) = K1;                         \
      *reinterpret_cast<uint4*>(kb_ + kr2 * 104 + kc2 * 8) = K2;                         \
      *reinterpret_cast<uint4*>(vb_ + vd0 * 136 + vkc) = V0;                             \
      *reinterpret_cast<uint4*>(vb_ + vd1 * 136 + vkc) = V1;                             \
    }
    float mxrun = 0.f;
#define SGB(mask, n) __builtin_amdgcn_sched_group_barrier((mask), (n), 0)
#define MLA_KFRAG(kb_, sub_, ks_) (*reinterpret_cast<const bf16x8*>((kb_) + ((sub_) * 32 + l32) * 104 + (ks_) * 16 + hh * 8))
#define MLA_VFRAG(dst_, vb_, sub_, ks2_, dvt_) \
    dst_ = *reinterpret_cast<const bf16x8*>((vb_) + ((dvt_) * 32 + l32) * 136 + (sub_) * 32 + (ks2_) * 16 + hh * 8)
#define MLA_SOFTMAX(sc_, pa_, pb_)                                                                         \
    {                                                                                                      \
      mxrun = fmaxf(mxrun, max16(sc_));                                                                    \
      float ps0_ = 0.f, ps1_ = 0.f;                                                                        \
      _Pragma("unroll") for (int i = 0; i < 16; i += 2) {                                                  \
        sc_[i] = __builtin_amdgcn_exp2f(sc_[i]); sc_[i + 1] = __builtin_amdgcn_exp2f(sc_[i + 1]);          \
        ps0_ += sc_[i]; ps1_ += sc_[i + 1];                                                                \
      }                                                                                                    \
      l += ps0_ + ps1_;                                                                                    \
      uint4 pk_;                                                                                           \
      pk_.x = pack2(sc_[0], sc_[1]); pk_.y = pack2(sc_[2], sc_[3]); pk_.z = pack2(sc_[4], sc_[5]); pk_.w = pack2(sc_[6], sc_[7]); \
      pa_ = __builtin_bit_cast(bf16x8, pk_);                                                               \
      pk_.x = pack2(sc_[8], sc_[9]); pk_.y = pack2(sc_[10], sc_[11]); pk_.z = pack2(sc_[12], sc_[13]); pk_.w = pack2(sc_[14], sc_[15]); \
      pb_ = __builtin_bit_cast(bf16x8, pk_);                                                               \
    }
    auto compute_tile = [&](int cur, int half) {
      const u16* kb = sK + cur * 128 * 104 + half * 64 * 104;
      const u16* vb = sV + cur * 64 * 136 + half * 64;
      bf16x8 k0[6], k1[6];
#pragma unroll
      for (int ks = 0; ks < 6; ++ks) { k0[ks] = MLA_KFRAG(kb, 0, ks); k1[ks] = MLA_KFRAG(kb, 1, ks); }
      f32x16 s0, s1;
#pragma unroll
      for (int i = 0; i < 16; ++i) { s0[i] = 0.f; s1[i] = 0.f; }
#pragma unroll
      for (int ks = 0; ks < 6; ++ks) s0 = MFMA32(k0[ks], qf[ks], s0);
      s0 = MFMA32(kone, qf6, s0);
      bf16x8 v00, v01, v02, v03, v10, v11, v12, v13;
      MLA_VFRAG(v00, vb, 0, 0, 0); MLA_VFRAG(v01, vb, 0, 0, 1); MLA_VFRAG(v02, vb, 0, 1, 0); MLA_VFRAG(v03, vb, 0, 1, 1);
#pragma unroll
      for (int ks = 0; ks < 6; ++ks) s1 = MFMA32(k1[ks], qf[ks], s1);
      s1 = MFMA32(kone, qf6, s1);
      MLA_VFRAG(v10, vb, 1, 0, 0); MLA_VFRAG(v11, vb, 1, 0, 1); MLA_VFRAG(v12, vb, 1, 1, 0); MLA_VFRAG(v13, vb, 1, 1, 1);
      bf16x8 p0a, p0b, p1a, p1b;
      MLA_SOFTMAX(s0, p0a, p0b);
      o0 = MFMA32(v00, p0a, o0); o1 = MFMA32(v01, p0a, o1); o0 = MFMA32(v02, p0b, o0); o1 = MFMA32(v03, p0b, o1);
      MLA_SOFTMAX(s1, p1a, p1b);
      o0 = MFMA32(v10, p1a, o0); o1 = MFMA32(v11, p1a, o1); o0 = MFMA32(v12, p1b, o0); o1 = MFMA32(v13, p1b, o1);
      SGB(0x100, 12);
#pragma unroll
      for (int i = 0; i < 7; ++i) { SGB(0x008, 1); if (i < 4) SGB(0x100, 1); }
#pragma unroll
      for (int i = 0; i < 7; ++i) { SGB(0x008, 1); if (i < 4) SGB(0x100, 1); SGB(0x402, 7); }
#pragma unroll
      for (int i = 0; i < 4; ++i) { SGB(0x008, 1); SGB(0x402, 12); }
#pragma unroll
      for (int i = 0; i < 4; ++i) SGB(0x008, 1);
    };
    auto lazy_update = [&]() {
      const float mxr = fmaxf(mxrun, __shfl_xor(mxrun, 32));
      if (__builtin_amdgcn_ballot_w64(mxr > 8.f) != 0ull) {
        float d = (mxr > 8.f) ? mxr : 0.f;
        const float mnew = bf2f(f2bf(m + d));
        d = mnew - m;
        m = mnew;
        const float alpha = __builtin_amdgcn_exp2f(-d);
        l *= alpha;
        mxrun -= d;
#pragma unroll
        for (int i = 0; i < 16; ++i) { o0[i] *= alpha; o1[i] *= alpha; }
        uint4 qv = make_uint4(0u, 0u, 0u, 0u);
        if (hh == 0) qv.x = (unsigned)f2bf(-m);
        qf6 = __builtin_bit_cast(bf16x8, qv);
      }
    };
    unsigned char* cbuf = reinterpret_cast<unsigned char*>(sV + 2 * 64 * 136);
    const bool cvt_on = (gridDim.x == 256);
    f32x4 cv0, cv1, cv2, cv3;
    bool cvalid = false;
#define CVT_ISSUE(j_)                                                                                                   \
    {                                                                                                                   \
      const int g_ = CVT_B + obid() + 256 * (j_);                                                                       \
      cvalid = cvt_on && (g_ < 12288);                                                                                  \
      if (cvalid) {                                                                                                     \
        const CvtTile ct_ = cvt_tile(p, L, g_);                                                                         \
        const float* sp_ = ct_.src + (size_t)(ct_.k0 + (tid >> 5) * 4) * ct_.N + ct_.n0 + (tid & 31) * 4;              \
        cv0 = __builtin_nontemporal_load(reinterpret_cast<const f32x4*>(sp_));                                          \
        cv1 = __builtin_nontemporal_load(reinterpret_cast<const f32x4*>(sp_ + ct_.N));                                  \
        cv2 = __builtin_nontemporal_load(reinterpret_cast<const f32x4*>(sp_ + 2 * ct_.N));                              \
        cv3 = __builtin_nontemporal_load(reinterpret_cast<const f32x4*>(sp_ + 3 * ct_.N));                              \
      }                                                                                                                 \
    }
#define CVT_TO_LDS(par_)                                                                                                \
    if (cvalid) {                                                                                                       \
      unsigned char* cb_ = cbuf + (par_) * 10240 + (tid & 31) * 4 * 80 + (tid >> 5) * 4;                                \
      *reinterpret_cast<unsigned*>(cb_) = pk4_f8_scaled<256>(cv0[0], cv1[0], cv2[0], cv3[0]);       \
      *reinterpret_cast<unsigned*>(cb_ + 80) = pk4_f8_scaled<256>(cv0[1], cv1[1], cv2[1], cv3[1]);  \
      *reinterpret_cast<unsigned*>(cb_ + 160) = pk4_f8_scaled<256>(cv0[2], cv1[2], cv2[2], cv3[2]); \
      *reinterpret_cast<unsigned*>(cb_ + 240) = pk4_f8_scaled<256>(cv0[3], cv1[3], cv2[3], cv3[3]); \
    }
#define CVT_TO_GLOBAL(par_, j_)                                                                                         \
    if (cvalid) {                                                                                                       \
      const CvtTile ct_ = cvt_tile(p, L, CVT_B + obid() + 256 * (j_));        \
      unsigned char* cd_ = ct_.dst + (size_t)cvt_rowmap(ct_.mat, ct_.n0 + (tid >> 2)) * ct_.K + ct_.k0 + (tid & 3) * 16;  \
      *reinterpret_cast<uint4*>(cd_) = *reinterpret_cast<const uint4*>(cbuf + (par_) * 10240 + (tid >> 2) * 80 + (tid & 3) * 16); \
    }
    MLA_GLOAD(ak0, ak1, ak2, av0, av1, 0);
    asm volatile("s_waitcnt vmcnt(0)" ::: "memory");
    MLA_SSTORE(ak0, ak1, ak2, av0, av1, 0);
    __syncthreads();
    {
      f32x16 s0, s1;
#pragma unroll
      for (int i = 0; i < 16; ++i) { s0[i] = 0.f; s1[i] = 0.f; }
#pragma unroll
      for (int ks = 0; ks < 6; ++ks) { s0 = MFMA32(MLA_KFRAG(sK, 0, ks), qf[ks], s0); s1 = MFMA32(MLA_KFRAG(sK, 1, ks), qf[ks], s1); }
      float mx = fmaxf(max16(s0), max16(s1));
      mx = fmaxf(mx, __shfl_xor(mx, 32));
      m = bf2f(f2bf(mx));
      uint4 qv = make_uint4(0u, 0u, 0u, 0u);
      if (hh == 0) qv.x = (unsigned)f2bf(-m);
      qf6 = __builtin_bit_cast(bf16x8, qv);
    }
#pragma unroll 1
    for (int kt = 0; kt < 32; kt += 2) {
      MLA_GLOAD(ak0, ak1, ak2, av0, av1, kt + 1);
      CVT_ISSUE(kt);
#pragma unroll 1
      for (int half = 0; half < 2; ++half) compute_tile(0, half);
      asm volatile("s_waitcnt vmcnt(0)" ::: "memory");
      MLA_SSTORE(ak0, ak1, ak2, av0, av1, 1);
      CVT_TO_LDS(0);
      __syncthreads();
      CVT_TO_GLOBAL(0, kt);
      lazy_update();
      if (kt + 2 < 32) MLA_GLOAD(ak0, ak1, ak2, av0, av1, kt + 2);
      CVT_ISSUE(kt + 1);
#pragma unroll 1
      for (int half = 0; half < 2; ++half) compute_tile(1, half);
      asm volatile("s_waitcnt vmcnt(0)" ::: "memory");
      if (kt + 2 < 32) MLA_SSTORE(ak0, ak1, ak2, av0, av1, 0);
      CVT_TO_LDS(1);
      __syncthreads();
      CVT_TO_GLOBAL(1, kt + 1);
      lazy_update();
    }
    l += __shfl_xor(l, 32);
    const float il = 1.f / l;
    u16* orow = p.mixed() + (t0 + l32) * DM + 256 + h * 64 + hh * 4;
#pragma unroll
    for (int g = 0; g < 4; ++g) {
      uint2 v;
      v.x = pack2(o0[4 * g + 0] * il, o0[4 * g + 1] * il);
      v.y = pack2(o0[4 * g + 2] * il, o0[4 * g + 3] * il);
      *reinterpret_cast<uint2*>(orow + g * 8) = v;
      v.x = pack2(o1[4 * g + 0] * il, o1[4 * g + 1] * il);
      v.y = pack2(o1[4 * g + 2] * il, o1[4 * g + 3] * il);
      *reinterpret_cast<uint2*>(orow + 32 + g * 8) = v;
    }
  }
}

typedef __attribute__((address_space(3))) s16x4 lds_s16x4;
template <int MODE>
DI void ph_dil_pass(const Params& p, char* smem, int blk_) {
  const int tid = otid(), wid = tid >> 6, lane = tid & 63, l32 = lane & 31, hh = lane >> 5;
  u16* sV = reinterpret_cast<u16*>(smem) + wid * (2 * 32 * 72);
  const int i16 = lane & 15, tq = i16 >> 2, tp = i16 & 3, tblk = (lane >> 4) & 1;
  {
    constexpr int NT = (MODE == 0) ? 13 : 5;
    const int it = wid, xcd_ = blk_ & 7, jx_ = blk_ >> 3, bh = xcd_ * 2 + (jx_ >> 4), r = jx_ & 15, b = bh >> 2, h = bh & 3;
    const int i0 = it * 32;
    const int q0 = (r * 8 + it) * 32;
    const int qpos = (MODE == 0) ? (r + 16 * (i0 + l32)) : (q0 + l32);
    const size_t tb = (size_t)b * SEQ;
    const u16* kbase = p.proj() + tb * PWP + C_DK + h * 64;
    const u16* vbase = p.proj() + tb * PWP + C_DV + h * 64;
    bf16x8 qf[4];
    {
      const u16* qp = p.proj() + (tb + qpos) * PWP + C_DQ + h * 64 + hh * 8;
#pragma unroll
      for (int ks = 0; ks < 4; ++ks) qf[ks] = *reinterpret_cast<const bf16x8*>(qp + ks * 16);
    }
    f32x16 o0, o1;
#pragma unroll
    for (int i = 0; i < 16; ++i) { o0[i] = 0.f; o1[i] = 0.f; }
    float m = -1e30f, l = 0.f;
    auto tile_params = [&](int tt, int& d, int& rd, int& ub, int& ulim, int& qb, int& qs) {
      if (MODE == 0) {
        if (tt < 5) { d = 16; rd = r; qb = i0; qs = 1; ulim = 256; ub = qb - 64 + 32 * tt; }
        else { d = 4; rd = r & 3; qb = (r >> 2) + 4 * i0; qs = 4; ulim = 1024; ub = qb - 64 + 32 * (tt - 5); }
      } else { d = 1; rd = 0; qb = q0; qs = 1; ulim = 4096; ub = qb - 64 + 32 * tt; }
    };
    bf16x8 ka0, ka1, ka2, ka3, kb0, kb1, kb2, kb3;
    uint4 va0, va1, va2, va3, vb0, vb1, vb2, vb3;
#define DIL_LD(dst_, ptr_) asm volatile("global_load_dwordx4 %0, %1, off" : "=v"(dst_) : "v"(ptr_) : "memory")
#define DIL_GLOAD(K0, K1, K2, K3, V0, V1, V2, V3, tt_)                                                   \
    {                                                                                                    \
      int d_, rd_, ub_, ulim_, qb_, qs_;                                                                 \
      tile_params((tt_), d_, rd_, ub_, ulim_, qb_, qs_);                                                 \
      int u_ = min(max(ub_ + l32, 0), ulim_ - 1);                                                        \
      const u16* kp_ = kbase + (size_t)(rd_ + d_ * u_) * PWP + hh * 8;                                   \
      DIL_LD(K0, kp_); DIL_LD(K1, kp_ + 16); DIL_LD(K2, kp_ + 32); DIL_LD(K3, kp_ + 48);                 \
      const int kr_ = ub_ + (lane >> 3);                                                                 \
      const u16* vp_;                                                                                    \
      u_ = min(max(kr_, 0), ulim_ - 1);      vp_ = vbase + (size_t)(rd_ + d_ * u_) * PWP + (lane & 7) * 8; DIL_LD(V0, vp_); \
      u_ = min(max(kr_ + 8, 0), ulim_ - 1);  vp_ = vbase + (size_t)(rd_ + d_ * u_) * PWP + (lane & 7) * 8; DIL_LD(V1, vp_); \
      u_ = min(max(kr_ + 16, 0), ulim_ - 1); vp_ = vbase + (size_t)(rd_ + d_ * u_) * PWP + (lane & 7) * 8; DIL_LD(V2, vp_); \
      u_ = min(max(kr_ + 24, 0), ulim_ - 1); vp_ = vbase + (size_t)(rd_ + d_ * u_) * PWP + (lane & 7) * 8; DIL_LD(V3, vp_); \
    }
#define DIL_VSTORE(V0, V1, V2, V3, buf_)                                                                 \
    {                                                                                                    \
      u16* vb_ = sV + (buf_) * 32 * 72 + (lane >> 3) * 72 + (lane & 7) * 8;                              \
      *reinterpret_cast<uint4*>(vb_) = V0;                                                               \
      *reinterpret_cast<uint4*>(vb_ + 8 * 72) = V1;                                                      \
      *reinterpret_cast<uint4*>(vb_ + 16 * 72) = V2;                                                     \
      *reinterpret_cast<uint4*>(vb_ + 24 * 72) = V3;                                                     \
    }
    auto tile_rest = [&](int tt, f32x16 sc, int cur) {
      int d, rd, ub, ulim, qb, qs;
      tile_params(tt, d, rd, ub, ulim, qb, qs);
      const int uq = qb + qs * l32;
      const float cs = 0.125f * 1.4426950408889634f;
      float mx = -1e30f;
#pragma unroll
      for (int i = 0; i < 16; ++i) {
        const int u = ub + (i & 3) + 8 * (i >> 2) + 4 * hh;
        const int du = u - uq;
        const bool valid = (u >= 0) && (u < ulim) && (du <= 64) && (du >= -64);
        sc[i] = valid ? sc[i] * cs : -1e30f;
        mx = fmaxf(mx, sc[i]);
      }
      mx = fmaxf(mx, __shfl_xor(mx, 32));
      const float mn = fmaxf(m, mx);
      const float alpha = __builtin_amdgcn_exp2f(m - mn);
      m = mn;
      float ps = 0.f;
#pragma unroll
      for (int i = 0; i < 16; ++i) {
        float pe = __builtin_amdgcn_exp2f(sc[i] - mn);
        pe = (sc[i] > -1e29f) ? pe : 0.f;
        ps += pe;
        sc[i] = pe;
      }
      l = l * alpha + ps;
#pragma unroll
      for (int i = 0; i < 16; ++i) { o0[i] *= alpha; o1[i] *= alpha; }
      const u16* vb = sV + cur * 32 * 72;
#pragma unroll
      for (int ks2 = 0; ks2 < 2; ++ks2) {
        uint4 pk;
        pk.x = pack2(sc[8 * ks2 + 0], sc[8 * ks2 + 1]);
        pk.y = pack2(sc[8 * ks2 + 2], sc[8 * ks2 + 3]);
        pk.z = pack2(sc[8 * ks2 + 4], sc[8 * ks2 + 5]);
        pk.w = pack2(sc[8 * ks2 + 6], sc[8 * ks2 + 7]);
        const bf16x8 pb = __builtin_bit_cast(bf16x8, pk);
#pragma unroll
        for (int dvt = 0; dvt < 2; ++dvt) {
          const u16* a0 = vb + (16 * ks2 + 4 * hh + tq) * 72 + dvt * 32 + tblk * 16 + tp * 4;
          const s16x4 lo = __builtin_amdgcn_ds_read_tr16_b64_v4i16((lds_s16x4*)(a0));
          const s16x4 hi = __builtin_amdgcn_ds_read_tr16_b64_v4i16((lds_s16x4*)(a0 + 8 * 72));
          const bf16x8 a = __builtin_shufflevector(lo, hi, 0, 1, 2, 3, 4, 5, 6, 7);
          if (dvt == 0) o0 = MFMA32(a, pb, o0); else o1 = MFMA32(a, pb, o1);
        }
      }
    };
    DIL_GLOAD(ka0, ka1, ka2, ka3, va0, va1, va2, va3, 0);
    DIL_GLOAD(kb0, kb1, kb2, kb3, vb0, vb1, vb2, vb3, 1);
    asm volatile("s_waitcnt vmcnt(8)" ::: "memory");
    DIL_VSTORE(va0, va1, va2, va3, 0);
#pragma unroll 1
    for (int tt = 0; tt < NT; tt += 2) {
      {
        f32x16 sc;
#pragma unroll
        for (int i = 0; i < 16; ++i) sc[i] = 0.f;
        sc = MFMA32(ka0, qf[0], sc); sc = MFMA32(ka1, qf[1], sc); sc = MFMA32(ka2, qf[2], sc); sc = MFMA32(ka3, qf[3], sc);
        asm volatile("" :: "v"(sc));
        if (tt + 2 < NT) DIL_GLOAD(ka0, ka1, ka2, ka3, va0, va1, va2, va3, tt + 2);
        tile_rest(tt, sc, 0);
        if (tt + 1 < NT) {
          if (tt + 2 < NT) asm volatile("s_waitcnt vmcnt(8)" ::: "memory"); else asm volatile("s_waitcnt vmcnt(0)" ::: "memory");
          DIL_VSTORE(vb0, vb1, vb2, vb3, 1);
        }
      }
      if (tt + 1 < NT) {
        f32x16 sc;
#pragma unroll
        for (int i = 0; i < 16; ++i) sc[i] = 0.f;
        sc = MFMA32(kb0, qf[0], sc); sc = MFMA32(kb1, qf[1], sc); sc = MFMA32(kb2, qf[2], sc); sc = MFMA32(kb3, qf[3], sc);
        asm volatile("" :: "v"(sc));
        if (tt + 3 < NT) DIL_GLOAD(kb0, kb1, kb2, kb3, vb0, vb1, vb2, vb3, tt + 3);
        tile_rest(tt + 1, sc, 1);
        if (tt + 2 < NT) {
          if (tt + 3 < NT) asm volatile("s_waitcnt vmcnt(8)" ::: "memory"); else asm volatile("s_waitcnt vmcnt(0)" ::: "memory");
          DIL_VSTORE(va0, va1, va2, va3, 0);
        }
      }
    }
    l += __shfl_xor(l, 32);
    float* part = p.dpart() + ((tb + qpos) * 4 + h) * 68 + hh * 4;
    if (MODE == 0) {
#pragma unroll
      for (int g = 0; g < 4; ++g) {
        *reinterpret_cast<float4*>(part + g * 8) = make_float4(o0[4 * g + 0], o0[4 * g + 1], o0[4 * g + 2], o0[4 * g + 3]);
        *reinterpret_cast<float4*>(part + 32 + g * 8) = make_float4(o1[4 * g + 0], o1[4 * g + 1], o1[4 * g + 2], o1[4 * g + 3]);
      }
      if (hh == 0) { part[64] = m; part[65] = l; }
    } else {
      const float mA = part[64 - hh * 4], lA = part[65 - hh * 4];
      const float M = fmaxf(m, mA), sa = __builtin_amdgcn_exp2f(m - M), sb = __builtin_amdgcn_exp2f(mA - M);
      const float il = 1.f / (l * sa + lA * sb);
      u16* orow = p.mixed() + (tb + qpos) * DM + 768 + h * 64 + hh * 4;
#pragma unroll
      for (int g = 0; g < 4; ++g) {
        const float4 a0 = *reinterpret_cast<const float4*>(part + g * 8), a1 = *reinterpret_cast<const float4*>(part + 32 + g * 8);
        uint2 v;
        v.x = pack2((o0[4 * g + 0] * sa + a0.x * sb) * il, (o0[4 * g + 1] * sa + a0.y * sb) * il);
        v.y = pack2((o0[4 * g + 2] * sa + a0.z * sb) * il, (o0[4 * g + 3] * sa + a0.w * sb) * il);
        *reinterpret_cast<uint2*>(orow + g * 8) = v;
        v.x = pack2((o1[4 * g + 0] * sa + a1.x * sb) * il, (o1[4 * g + 1] * sa + a1.y * sb) * il);
        v.y = pack2((o1[4 * g + 2] * sa + a1.z * sb) * il, (o1[4 * g + 3] * sa + a1.w * sb) * il);
        *reinterpret_cast<uint2*>(orow + 32 + g * 8) = v;
      }
    }
  }
}

DI void ph_dil_naive(const Params& p) {
  const int gt = obid() * NTHR + otid(), gs = gridDim.x * NTHR;
  for (int it = gt; it < 4 * 4 * SEQ; it += gs) {
    const int n = it & (SEQ - 1), h = (it >> 12) & 3, b = it >> 14;
    const size_t tb = (size_t)b * SEQ;
    uint4 qp[8];
    float o[64];
#pragma unroll
    for (int d = 0; d < 8; ++d) qp[d] = *reinterpret_cast<const uint4*>(p.proj() + (tb + n) * PWP + C_DQ + h * 64 + d * 8);
    float mx = -1e30f;
    for (int pat = 0; pat < 3; ++pat) {
      const int dil = (pat == 0) ? 1 : (pat == 1 ? 4 : 16);
#pragma unroll 1
      for (int j = -64; j <= 64; ++j) {
        const int pos = n + j * dil;
        if (pos < 0 || pos >= SEQ) continue;
        const u16* kr = p.proj() + (tb + pos) * PWP + C_DK + h * 64;
        float s = 0.f;
#pragma unroll
        for (int d = 0; d < 8; ++d) s = dot8(qp[d], *reinterpret_cast<const uint4*>(kr + d * 8), s);
        s *= 0.125f;
        mx = fmaxf(mx, s);
      }
    }
#pragma unroll
    for (int d = 0; d < 64; ++d) o[d] = 0.f;
    float l = 0.f;
    for (int pat = 0; pat < 3; ++pat) {
      const int dil = (pat == 0) ? 1 : (pat == 1 ? 4 : 16);
#pragma unroll 1
      for (int j = -64; j <= 64; ++j) {
        const int pos = n + j * dil;
        if (pos < 0 || pos >= SEQ) continue;
        const u16* kr = p.proj() + (tb + pos) * PWP + C_DK + h * 64;
        const u16* vr = p.proj() + (tb + pos) * PWP + C_DV + h * 64;
        float s = 0.f;
#pragma unroll
        for (int d = 0; d < 8; ++d) s = dot8(qp[d], *reinterpret_cast<const uint4*>(kr + d * 8), s);
        s *= 0.125f;
        const float pe = __expf(s - mx);
        l += pe;
#pragma unroll
        for (int d = 0; d < 64; d += 8) {
          float vf[8];
          ld8(vr + d, vf);
#pragma unroll
          for (int jj = 0; jj < 8; ++jj) o[d + jj] += pe * vf[jj];
        }
      }
    }
    const float il = 1.f / l;
#pragma unroll
    for (int d = 0; d < 64; d += 8) {
      uint4 ov;
      ov.x = pack2(o[d + 0] * il, o[d + 1] * il);
      ov.y = pack2(o[d + 2] * il, o[d + 3] * il);
      ov.z = pack2(o[d + 4] * il, o[d + 5] * il);
      ov.w = pack2(o[d + 6] * il, o[d + 7] * il);
      *reinterpret_cast<uint4*>(p.mixed() + (tb + n) * DM + 768 + h * 64 + d) = ov;
    }
  }
}

DI void ph_ssd_naive(const Params& p, int L) {
  const int gt = obid() * NTHR + otid(), gs = gridDim.x * NTHR;
  for (int it = gt; it < 4 * 4 * 4 * SEQ; it += gs) {
    const int l = it & (SEQ - 1), pq = (it >> 12) & 3, h = (it >> 14) & 3, b = it >> 16;
    const int g = h >> 1;
    const size_t tb = (size_t)b * SEQ;
    uint4 cl[16];
    float acc[16];
#pragma unroll
    for (int d = 0; d < 16; ++d) cl[d] = *reinterpret_cast<const uint4*>(p.xbc() + (tb + l) * 768 + 512 + g * 128 + d * 8);
#pragma unroll
    for (int d = 0; d < 16; ++d) acc[d] = 0.f;
    const float pl = p.cs()[(tb + l) * 8 + h], rl = p.cs()[(tb + l) * 8 + 4 + h];
#pragma unroll 1
    for (int s = 0; s < SEQ; ++s) {
      const u16* br = p.xbc() + (tb + s) * 768 + 256 + g * 128;
      float cbv = 0.f;
#pragma unroll
      for (int d = 0; d < 16; ++d) cbv = dot8(cl[d], *reinterpret_cast<const uint4*>(br + d * 8), cbv);
      float w;
      if (s <= l) w = expf(pl - p.cs()[(tb + s) * 8 + h]) * p.dtv()[(tb + s) * 8 + h];
      else w = expf(rl - p.cs()[(tb + s) * 8 + 4 + h]) * p.dtv()[(tb + s) * 8 + 4 + h];
      cbv *= w;
      const u16* xr = p.xbc() + (tb + s) * 768 + h * 64 + pq * 16;
#pragma unroll
      for (int d = 0; d < 16; d += 8) {
        float xf[8];
        ld8(xr + d, xf);
#pragma unroll
        for (int j = 0; j < 8; ++j) acc[d + j] += cbv * xf[j];
      }
    }
    const float dsk = p.ssm_d[L * 4 + h];
#pragma unroll
    for (int d = 0; d < 16; ++d) {
      const int c = h * 64 + pq * 16 + d;
      const float xv = bf2f(p.xbc()[(tb + l) * 768 + c]);
      const float z = bf2f(p.proj()[(tb + l) * PWP + C_Z + c]);
      p.ybuf()[(tb + l) * 256 + c] = (acc[d] + dsk * xv) * silu(z);
    }
  }
}

DI void ph_ssd_norm(const Params& p, int L) {
  const int tid_ = otid(); const int lane = tid_ & 63, gw = (obid() * NTHR + tid_) >> 6, nw = gridDim.x * (NTHR / 64);
  const float* nwt = p.ssm_norm_w + L * 256;
  for (int t = gw; t < T; t += nw) {
    const float4 v = *reinterpret_cast<const float4*>(p.ybuf() + (size_t)t * 256 + lane * 4);
    float ss = wave_sum(v.x * v.x + v.y * v.y + v.z * v.z + v.w * v.w);
    const float rstd = rsqrtf(ss * (1.f / 256.f) + 1e-6f);
    const float4 ww = *reinterpret_cast<const float4*>(nwt + lane * 4);
    uint2 o;
    o.x = pack2(v.x * rstd * ww.x, v.y * rstd * ww.y);
    o.y = pack2(v.z * rstd * ww.z, v.w * rstd * ww.w);
    *reinterpret_cast<uint2*>(p.mixed() + (size_t)t * DM + 512 + lane * 4) = o;
  }
}

#define MFMA16(a, b, c) __builtin_amdgcn_mfma_f32_16x16x32_bf16((a), (b), (c), 0, 0, 0)
template <int MT, int NT, int KS>
DI void wave_mm(f32x4 (&acc)[MT][NT], const u16* a0, int lda, const u16* b0, int ldb, int fr, int fq) {
#pragma unroll
  for (int ks = 0; ks < KS; ++ks) {
    bf16x8 af[MT], bfv[NT];
#pragma unroll
    for (int m = 0; m < MT; ++m) af[m] = *reinterpret_cast<const bf16x8*>(a0 + (m * 16 + fr) * lda + ks * 32 + fq * 8);
#pragma unroll
    for (int n = 0; n < NT; ++n) bfv[n] = *reinterpret_cast<const bf16x8*>(b0 + (n * 16 + fr) * ldb + ks * 32 + fq * 8);
#pragma unroll
    for (int m = 0; m < MT; ++m)
#pragma unroll
      for (int n = 0; n < NT; ++n) acc[m][n] = MFMA16(af[m], bfv[n], acc[m][n]);
  }
}
template <int MT, int NT>
DI void zero_acc(f32x4 (&acc)[MT][NT]) {
#pragma unroll
  for (int m = 0; m < MT; ++m)
#pragma unroll
    for (int n = 0; n < NT; ++n) acc[m][n] = f32x4{0.f, 0.f, 0.f, 0.f};
}
template <int NROWS, int NCOLS>
DI void stage_rows(u16* dst, int ldd, const u16* src, size_t lsrc, int tid) {
  constexpr int CPR = NCOLS / 8, NCH = NROWS * CPR / NTHR;
  static_assert(NROWS * CPR % NTHR == 0, "tile must be a multiple of 512 chunks");
  uint4 r[NCH];
#pragma unroll
  for (int i = 0; i < NCH; ++i) {
    const int c = tid + i * NTHR, row = c / CPR, cc = c % CPR;
    r[i] = *reinterpret_cast<const uint4*>(src + (size_t)row * lsrc + cc * 8);
  }
#pragma unroll
  for (int i = 0; i < NCH; ++i) {
    const int c = tid + i * NTHR, row = c / CPR, cc = c % CPR;
    *reinterpret_cast<uint4*>(dst + row * ldd + cc * 8) = r[i];
  }
}
template <int NCOLS, class W>
DI void stage_T(u16* dst, int ldd, const u16* src, size_t lsrc, int tid, W w) {
  constexpr int NCH = 128 * (NCOLS / 8) / NTHR;
  uint4 r[NCH];
#pragma unroll
  for (int i = 0; i < NCH; ++i) {
    const int c = tid + i * NTHR, j = c & 127, cc = c >> 7;
    r[i] = *reinterpret_cast<const uint4*>(src + (size_t)j * lsrc + cc * 8);
  }
#pragma unroll
  for (int i = 0; i < NCH; ++i) {
    const int c = tid + i * NTHR, j = c & 127, cc = c >> 7;
    float f[8];
    unpack8(r[i], f);
    const float wj = w(j);
#pragma unroll
    for (int e = 0; e < 8; ++e) dst[(cc * 8 + e) * ldd + j] = f2bf(f[e] * wj);
  }
}

template <int NROWS, int NCOLS>
DI void stage_rows_ld(uint4 (&r)[NROWS * (NCOLS / 8) / NTHR], const u16* src, size_t lsrc, int tid) {
  constexpr int CPR = NCOLS / 8, NCH = NROWS * CPR / NTHR;
#pragma unroll
  for (int i = 0; i < NCH; ++i) {
    const int c = tid + i * NTHR, row = c / CPR, cc = c % CPR;
    r[i] = *reinterpret_cast<const uint4*>(src + (size_t)row * lsrc + cc * 8);
  }
}
template <int NROWS, int NCOLS>
DI void stage_rows_st(u16* dst, int ldd, const uint4 (&r)[NROWS * (NCOLS / 8) / NTHR], int tid) {
  constexpr int CPR = NCOLS / 8, NCH = NROWS * CPR / NTHR;
#pragma unroll
  for (int i = 0; i < NCH; ++i) {
    const int c = tid + i * NTHR, row = c / CPR, cc = c % CPR;
    *reinterpret_cast<uint4*>(dst + row * ldd + cc * 8) = r[i];
  }
}
template <int NCOLS>
DI void stage_T_ld(uint4 (&r)[128 * (NCOLS / 8) / NTHR], const u16* src, size_t lsrc, int tid) {
  constexpr int NCH = 128 * (NCOLS / 8) / NTHR;
#pragma unroll
  for (int i = 0; i < NCH; ++i) {
    const int c = tid + i * NTHR, j = c & 127, cc = c >> 7;
    r[i] = *reinterpret_cast<const uint4*>(src + (size_t)j * lsrc + cc * 8);
  }
}
template <int NCOLS, class W>
DI void stage_T_st(u16* dst, int ldd, const uint4 (&r)[128 * (NCOLS / 8) / NTHR], int tid, W w) {
  constexpr int NCH = 128 * (NCOLS / 8) / NTHR;
#pragma unroll
  for (int i = 0; i < NCH; ++i) {
    const int c = tid + i * NTHR, j = c & 127, cc = c >> 7;
    float f[8];
    unpack8(r[i], f);
    const float wj = w(j);
#pragma unroll
    for (int e = 0; e < 8; ++e) dst[(cc * 8 + e) * ldd + j] = f2bf(f[e] * wj);
  }
}

DI void ph_ret_a(const Params& p, char* smem, int item) {
  const int tid = otid(), wid = tid >> 6, lane = tid & 63, fr = lane & 15, fq = lane >> 4;
  u16* sVt = reinterpret_cast<u16*>(smem);
  u16* sKf = sVt + 64 * 136;
  u16* sKb = sKf + 64 * 136;
  {
    const int c = item & 31, bh = item >> 5, b = bh >> 2, h = bh & 3;
    const float lg0 = log1pf(-exp2f(-5.f - (float)h)), lg1 = log1pf(-exp2f(-5.5f - (float)h));
    const u16* src = p.proj() + ((size_t)b * SEQ + c * 128) * PWP;
    {
      uint4 rv[2], rk[2];
      stage_T_ld<64>(rv, src + C_RV + h * 64, PWP, tid);
      stage_T_ld<64>(rk, src + C_RK + h * 64, PWP, tid);
      stage_T_st<64>(sVt, 136, rv, tid, [](int) { return 1.f; });
      stage_T_st<64>(sKf, 136, rk, tid, [&](int j) { return __expf(lg0 * (float)(127 - j)); });
      stage_T_st<64>(sKb, 136, rk, tid, [&](int j) { return __expf(lg1 * (float)j); });
    }
    __syncthreads();
    const int dir = wid >> 2, q = wid & 3;
    f32x4 acc[1][4];
    zero_acc(acc);
    wave_mm<1, 4, 4>(acc, sVt + q * 16 * 136, 136, dir ? sKb : sKf, 136, fr, fq);
    float* out = p.rU() + ((size_t)(bh * 32 + c) * 2 + dir) * 4096;
#pragma unroll
    for (int n = 0; n < 4; ++n)
#pragma unroll
      for (int j = 0; j < 4; ++j) out[(q * 16 + fq * 4 + j) * 64 + n * 16 + fr] = acc[0][n][j];
    __syncthreads();
  }
}
DI void ph_ret_scan(const Params& p) {
  const int gt = obid() * NTHR + otid(), gs = gridDim.x * NTHR;
  for (int it = gt; it < 16 * 2 * 4096; it += gs) {
    const int e = it & 4095, dir = (it >> 12) & 1, bh = it >> 13, h = bh & 3;
    const float lg = log1pf(-exp2f((dir ? -5.5f : -5.f) - (float)h));
    const float cd = __expf(lg * 128.f);
    float u[32];
#pragma unroll
    for (int c = 0; c < 32; ++c) u[c] = p.rU()[((size_t)(bh * 32 + c) * 2 + dir) * 4096 + e];
    float st = 0.f;
    if (dir == 0) {
#pragma unroll
      for (int c = 0; c < 32; ++c) {
        p.rS()[((size_t)(bh * 32 + c) * 2 + dir) * 4096 + e] = f2bf(st);
        st = st * cd + u[c];
      }
    } else {
#pragma unroll
      for (int c = 31; c >= 0; --c) {
        p.rS()[((size_t)(bh * 32 + c) * 2 + dir) * 4096 + e] = f2bf(st);
        st = st * cd + u[c];
      }
    }
  }
}
DI void ph_ret_c(const Params& p, char* smem, int item) {
  const int tid = otid(), wid = tid >> 6, lane = tid & 63, fr = lane & 15, fq = lane >> 4;
  u16* sQ = reinterpret_cast<u16*>(smem);
  u16* sK = sQ + 128 * 72;
  u16* sVt = sK + 128 * 72;
  u16* sSf = sVt + 64 * 136;
  u16* sSb = sSf + 64 * 72;
  u16* sP = sSb + 64 * 72;
  {
    const int c = item & 31, bh = item >> 5, b = bh >> 2, h = bh & 3;
    const float lg0 = log1pf(-exp2f(-5.f - (float)h)), lg1 = log1pf(-exp2f(-5.5f - (float)h));
    const size_t t0 = (size_t)b * SEQ + c * 128;
    const u16* src = p.proj() + t0 * PWP;
    {
      uint4 rq[2], rk[2], rv[2], rf[1], rb[1];
      stage_rows_ld<128, 64>(rq, src + C_RQ + h * 64, PWP, tid);
      stage_rows_ld<128, 64>(rk, src + C_RK + h * 64, PWP, tid);
      stage_T_ld<64>(rv, src + C_RV + h * 64, PWP, tid);
      stage_rows_ld<64, 64>(rf, p.rS() + ((size_t)(bh * 32 + c) * 2 + 0) * 4096, 64, tid);
      stage_rows_ld<64, 64>(rb, p.rS() + ((size_t)(bh * 32 + c) * 2 + 1) * 4096, 64, tid);
      stage_rows_st<128, 64>(sQ, 72, rq, tid);
      stage_rows_st<128, 64>(sK, 72, rk, tid);
      stage_T_st<64>(sVt, 136, rv, tid, [](int) { return 1.f; });
      stage_rows_st<64, 64>(sSf, 72, rf, tid);
      stage_rows_st<64, 64>(sSb, 72, rb, tid);
    }
    __syncthreads();
    {
      const int wr = wid >> 1, wc = wid & 1;
      f32x4 sacc[2][4];
      zero_acc(sacc);
      wave_mm<2, 4, 2>(sacc, sQ + wr * 32 * 72, 72, sK + wc * 64 * 72, 72, fr, fq);
#pragma unroll
      for (int m = 0; m < 2; ++m)
#pragma unroll
        for (int n = 0; n < 4; ++n)
#pragma unroll
          for (int j = 0; j < 4; ++j) {
            const int i = wr * 32 + m * 16 + fq * 4 + j, jj = wc * 64 + n * 16 + fr;
            const float dcy = (jj <= i) ? __expf(lg0 * (float)(i - jj)) : __expf(lg1 * (float)(jj - i));
            sP[i * 136 + jj] = f2bf(sacc[m][n][j] * dcy);
          }
    }
    __syncthreads();
    {
      f32x4 ai[1][4], af_[1][4], ab_[1][4];
      zero_acc(ai); zero_acc(af_); zero_acc(ab_);
      wave_mm<1, 4, 4>(ai, sP + wid * 16 * 136, 136, sVt, 136, fr, fq);
      wave_mm<1, 4, 2>(af_, sQ + wid * 16 * 72, 72, sSf, 72, fr, fq);
      wave_mm<1, 4, 2>(ab_, sQ + wid * 16 * 72, 72, sSb, 72, fr, fq);
#pragma unroll
      for (int j = 0; j < 4; ++j) {
        const int i = wid * 16 + fq * 4 + j;
        const float xf = __expf(lg0 * (float)(i + 1)), xb = __expf(lg1 * (float)(128 - i));
        float o[4], sum = 0.f;
#pragma unroll
        for (int n = 0; n < 4; ++n) { o[n] = ai[0][n][j] + xf * af_[0][n][j] + xb * ab_[0][n][j]; sum += o[n]; }
#pragma unroll
        for (int sft = 1; sft < 16; sft <<= 1) sum += __shfl_xor(sum, sft);
        const float mu = sum * (1.f / 64.f);
        float var = 0.f;
#pragma unroll
        for (int n = 0; n < 4; ++n) var += (o[n] - mu) * (o[n] - mu);
#pragma unroll
        for (int sft = 1; sft < 16; sft <<= 1) var += __shfl_xor(var, sft);
        const float rs = rsqrtf(var * (1.f / 64.f) + 1e-5f);
#pragma unroll
        for (int n = 0; n < 4; ++n) {
          const float g = bf2f(p.proj()[(t0 + i) * PWP + C_RG + h * 64 + n * 16 + fr]);
          p.mixed()[(t0 + i) * DM + h * 64 + n * 16 + fr] = f2bf(silu(g) * (o[n] - mu) * rs);
        }
      }
    }
    __syncthreads();
  }
}

DI void ssd_local_cumsum(const Params& p, int L, size_t t0, float* cum, float* dtl, int wid, int lane) {
  const int dir = wid >> 2, h = wid & 3;
  const float a = -__expf(p.a_log[L * 8 + dir * 4 + h]);
  float d0, d1;
  if (dir == 0) { d0 = p.dtv()[(t0 + 2 * lane) * 8 + h]; d1 = p.dtv()[(t0 + 2 * lane + 1) * 8 + h]; }
  else { d0 = p.dtv()[(t0 + 127 - 2 * lane) * 8 + 4 + h]; d1 = p.dtv()[(t0 + 126 - 2 * lane) * 8 + 4 + h]; }
  float v0 = d0 * a, v1 = v0 + d1 * a;
  float run = v1;
#pragma unroll
  for (int o = 1; o < 64; o <<= 1) {
    const float u = __shfl_up(run, o);
    if (lane >= o) run += u;
  }
  const float excl = run - v1;
  v0 += excl; v1 += excl;
  float* cr = cum + (dir * 4 + h) * 128;
  float* dr = dtl + (dir * 4 + h) * 128;
  if (dir == 0) { cr[2 * lane] = v0; cr[2 * lane + 1] = v1; dr[2 * lane] = d0; dr[2 * lane + 1] = d1; }
  else { cr[127 - 2 * lane] = v0; cr[126 - 2 * lane] = v1; dr[127 - 2 * lane] = d0; dr[126 - 2 * lane] = d1; }
}

DI void ph_ssd_a(const Params& p, int L, char* smem, int item) {
  const int tid = otid(), wid = tid >> 6, lane = tid & 63, fr = lane & 15, fq = lane >> 4;
  u16* sBt = reinterpret_cast<u16*>(smem);
  u16* sXf = sBt + 2 * 128 * 136;
  u16* sXb = sXf + 64 * 136;
  float* cum = reinterpret_cast<float*>(sXb + 64 * 136);
  float* dtl = cum + 8 * 128;
  {
    const int c = item & 31, b = item >> 5;
    const size_t t0 = (size_t)b * SEQ + c * 128;
    ssd_local_cumsum(p, L, t0, cum, dtl, wid, lane);
    stage_T<256>(sBt, 136, p.xbc() + t0 * 768 + 256, 768, tid, [](int) { return 1.f; });
    __syncthreads();
    if (tid < 8) {
      const int dir = tid >> 2;
      p.cdec()[(size_t)item * 8 + tid] = __expf(dir ? cum[tid * 128 + 0] : cum[tid * 128 + 127]);
    }
    for (int h = 0; h < 4; ++h) {
      const float* cf = cum + h * 128;
      const float* cb = cum + (4 + h) * 128;
      const float* df = dtl + h * 128;
      const float* db = dtl + (4 + h) * 128;
      const float endf = cf[127], endb = cb[0];
      {
        uint4 rx[2];
        stage_T_ld<64>(rx, p.xbc() + t0 * 768 + h * 64, 768, tid);
        stage_T_st<64>(sXf, 136, rx, tid, [&](int l) { return __expf(endf - cf[l]) * df[l]; });
        stage_T_st<64>(sXb, 136, rx, tid, [&](int l) { return __expf(endb - cb[l]) * db[l]; });
      }
      __syncthreads();
      const int dir = wid >> 2, q = wid & 3, g = h >> 1;
      f32x4 acc[4][2];
      zero_acc(acc);
      wave_mm<4, 2, 4>(acc, dir ? sXb : sXf, 136, sBt + (g * 128 + q * 32) * 136, 136, fr, fq);
      float* out = p.sU() + ((size_t)item * 8 + h * 2 + dir) * 8192;
#pragma unroll
      for (int m = 0; m < 4; ++m)
#pragma unroll
        for (int n = 0; n < 2; ++n)
#pragma unroll
          for (int j = 0; j < 4; ++j) out[(m * 16 + fq * 4 + j) * 128 + q * 32 + n * 16 + fr] = acc[m][n][j];
      __syncthreads();
    }
  }
}
DI void ph_ssd_scan(const Params& p) {
  const int gt = obid() * NTHR + otid(), gs = gridDim.x * NTHR;
  for (int it = gt; it < 4 * 8 * 8192; it += gs) {
    const int e = it & 8191, hd = (it >> 13) & 7, b = it >> 16;
    const int dir = hd & 1, h = hd >> 1;
    float u[32];
#pragma unroll
    for (int c = 0; c < 32; ++c) u[c] = p.sU()[((size_t)(b * 32 + c) * 8 + hd) * 8192 + e];
    float st = 0.f;
    if (dir == 0) {
#pragma unroll
      for (int c = 0; c < 32; ++c) {
        p.sS()[((size_t)(b * 32 + c) * 8 + hd) * 8192 + e] = f2bf(st);
        st = st * p.cdec()[(size_t)(b * 32 + c) * 8 + dir * 4 + h] + u[c];
      }
    } else {
#pragma unroll
      for (int c = 31; c >= 0; --c) {
        p.sS()[((size_t)(b * 32 + c) * 8 + hd) * 8192 + e] = f2bf(st);
        st = st * p.cdec()[(size_t)(b * 32 + c) * 8 + dir * 4 + h] + u[c];
      }
    }
  }
}
DI void ph_ssd_c(const Params& p, int L, char* smem, int item) {
  const int tid = otid(), wid = tid >> 6, lane = tid & 63, fr = lane & 15, fq = lane >> 4;
  u16* sC = reinterpret_cast<u16*>(smem);
  u16* sB = sC + 128 * 136;
  u16* sXt = sB + 128 * 136;
  u16* sSf = sXt + 64 * 136;
  u16* sSb = sSf + 64 * 136;
  float* cum = reinterpret_cast<float*>(sSb + 64 * 136);
  float* dtl = cum + 8 * 128;
  {
    const int c = item & 31, b = item >> 5;
    const size_t t0 = (size_t)b * SEQ + c * 128;
    ssd_local_cumsum(p, L, t0, cum, dtl, wid, lane);
    float ssq[4] = {0.f, 0.f, 0.f, 0.f};
#pragma unroll 1
    for (int g = 0; g < 2; ++g) {
      {
        uint4 rc[4], rb4[4];
        stage_rows_ld<128, 128>(rc, p.xbc() + t0 * 768 + 512 + g * 128, 768, tid);
        stage_rows_ld<128, 128>(rb4, p.xbc() + t0 * 768 + 256 + g * 128, 768, tid);
        stage_rows_st<128, 128>(sC, 136, rc, tid);
        stage_rows_st<128, 128>(sB, 136, rb4, tid);
      }
      __syncthreads();
      const int wr = wid >> 1, wc = wid & 1;
      f32x4 G[2][4];
      zero_acc(G);
      wave_mm<2, 4, 4>(G, sC + wr * 32 * 136, 136, sB + wc * 64 * 136, 136, fr, fq);
      __syncthreads();
#pragma unroll 1
      for (int hl = 0; hl < 2; ++hl) {
        const int h = g * 2 + hl;
        const float* cf = cum + h * 128;
        const float* cb = cum + (4 + h) * 128;
        const float* df = dtl + h * 128;
        const float* db = dtl + (4 + h) * 128;
        uint4 rxt[2], rsf[2], rsb[2];
        stage_T_ld<64>(rxt, p.xbc() + t0 * 768 + h * 64, 768, tid);
        stage_rows_ld<64, 128>(rsf, p.sS() + ((size_t)item * 8 + h * 2 + 0) * 8192, 128, tid);
        stage_rows_ld<64, 128>(rsb, p.sS() + ((size_t)item * 8 + h * 2 + 1) * 8192, 128, tid);
#pragma unroll
        for (int m = 0; m < 2; ++m)
#pragma unroll
          for (int n = 0; n < 4; ++n)
#pragma unroll
            for (int j = 0; j < 4; ++j) {
              const int l = wr * 32 + m * 16 + fq * 4 + j, sx = wc * 64 + n * 16 + fr;
              const float w = (sx <= l) ? __expf(cf[l] - cf[sx]) * df[sx] : __expf(cb[l] - cb[sx]) * db[sx];
              sB[l * 136 + sx] = f2bf(G[m][n][j] * w);
            }
        stage_T_st<64>(sXt, 136, rxt, tid, [](int) { return 1.f; });
        stage_rows_st<64, 128>(sSf, 136, rsf, tid);
        stage_rows_st<64, 128>(sSb, 136, rsb, tid);
        __syncthreads();
        f32x4 yd[1][4], yf[1][4], yb[1][4];
        zero_acc(yd); zero_acc(yf); zero_acc(yb);
        wave_mm<1, 4, 4>(yd, sB + wid * 16 * 136, 136, sXt, 136, fr, fq);
        wave_mm<1, 4, 4>(yf, sC + wid * 16 * 136, 136, sSf, 136, fr, fq);
        wave_mm<1, 4, 4>(yb, sC + wid * 16 * 136, 136, sSb, 136, fr, fq);
        const float dsk = p.ssm_d[L * 4 + h];
#pragma unroll
        for (int j = 0; j < 4; ++j) {
          const int l = wid * 16 + fq * 4 + j;
          const float ef = __expf(cf[l]), eb = __expf(cb[l]);
#pragma unroll
          for (int n = 0; n < 4; ++n) {
            const int ch = h * 64 + n * 16 + fr;
            const float xv = bf2f(p.xbc()[(t0 + l) * 768 + ch]);
            const float z = bf2f(p.proj()[(t0 + l) * PWP + C_Z + ch]);
            const float yv = (yd[0][n][j] + ef * yf[0][n][j] + eb * yb[0][n][j] + dsk * xv) * silu(z);
            ssq[j] += yv * yv;
            p.ybuf()[(t0 + l) * 256 + ch] = yv;
          }
        }
        __syncthreads();
      }
    }
    const float* nwt = p.ssm_norm_w + L * 256;
#pragma unroll
    for (int j = 0; j < 4; ++j) {
      float ss = ssq[j];
#pragma unroll
      for (int sft = 1; sft < 16; sft <<= 1) ss += __shfl_xor(ss, sft);
      const float rstd = rsqrtf(ss * (1.f / 256.f) + 1e-6f);
      const int l = wid * 16 + fq * 4 + j;
#pragma unroll
      for (int hn = 0; hn < 16; ++hn) {
        const int ch = hn * 16 + fr;
        p.mixed()[(t0 + l) * DM + 512 + ch] = f2bf(p.ybuf()[(t0 + l) * 256 + ch] * rstd * nwt[ch]);
      }
    }
  }
}

template <bool XIN_F32>
struct CfgOutproj {
  static constexpr bool PERM = true;
  int K; const Params* p; int L; int bid, nb; const void* xin; u16* xout;
  DI bool next(int i, pg8::Unit& u) const { const int t = i * nb + bid; if (t >= 64 * 4) return false; u.pm = t & 63; u.pn = t >> 6; return true; }
  DI const char* a_base(const pg8::Unit& u) const { return (const char*)(p->mixed() + (size_t)u.pm * 256 * DM); }
  DI const char* b_base(const pg8::Unit& u) const { return (const char*)(p->WoutT() + ((size_t)L * DM + (size_t)u.pn * 256) * DM); }
  DI void a_off(const pg8::Unit&, int R0, int C0, int R1, int C1, unsigned (&vo)[4]) const {
    vo[0] = (unsigned)(R0 * DM + C0) * 2u; vo[1] = (unsigned)(R1 * DM + C1) * 2u;
    vo[2] = vo[0] + 128u * DM * 2u; vo[3] = vo[1] + 128u * DM * 2u;
  }
  DI void epi(const f32x4 (&acc)[2][2][4][2], const pg8::Unit& u, int wr, int wc, int fr, int fq) const {
    const int row0 = u.pm * 256 + wr * 64 + fr, col0 = u.pn * 256 + wc * 32 + 8 * fq;
#pragma unroll
    for (int ai = 0; ai < 2; ++ai)
#pragma unroll
      for (int m = 0; m < 4; ++m) {
        const size_t ro = (size_t)(row0 + ai * 128 + m * 16) * DM + col0;
#pragma unroll
        for (int bj = 0; bj < 2; ++bj) {
          const size_t o = ro + bj * 128;
          float4 x0, x1;
          if (XIN_F32) {
            x0 = *reinterpret_cast<const float4*>(static_cast<const float*>(xin) + o);
            x1 = *reinterpret_cast<const float4*>(static_cast<const float*>(xin) + o + 4);
          } else {
            const uint4 q = *reinterpret_cast<const uint4*>(static_cast<const u16*>(xin) + o);
            x0 = bf4_to_f4(make_uint2(q.x, q.y)); x1 = bf4_to_f4(make_uint2(q.z, q.w));
          }
          const f32x4 a0 = acc[ai][bj][m][0], a1 = acc[ai][bj][m][1];
          uint4 w;
          w.x = pack2(x0.x + a0[0], x0.y + a0[1]); w.y = pack2(x0.z + a0[2], x0.w + a0[3]);
          w.z = pack2(x1.x + a1[0], x1.y + a1[1]); w.w = pack2(x1.z + a1[2], x1.w + a1[3]);
          *reinterpret_cast<uint4*>(xout + o) = w;
        }
      }
  }
};
DI void ph_outproj(const Params& p, int L, char* smem) {
  if (L == 0) {
    CfgOutproj<true> c; c.K = DM; c.p = &p; c.L = L; c.bid = obid(); c.nb = gridDim.x; c.xin = p.x; c.xout = p.xres();
    pg8::gemm_phase((pg8::lds_u8*)smem, c);
  } else {
    CfgOutproj<false> c; c.K = DM; c.p = &p; c.L = L; c.bid = obid(); c.nb = gridDim.x; c.xin = p.xres2(); c.xout = p.xres();
    pg8::gemm_phase((pg8::lds_u8*)smem, c);
  }
}

DI void ph_rms2_router(const Params& p, int L, const u16* xres, char* smem) {
  const int tid = otid(), lane = tid & 63, gw = (obid() * NTHR + tid) >> 6, nw = gridDim.x * (NTHR / 64);
  const float* w = p.ln2_w + L * DM;
  const float* rw = p.router_w + (size_t)L * DM * 16;
  float4* srw = reinterpret_cast<float4*>(smem);
  for (int i = tid; i < 4096; i += NTHR) {
    const int c = i >> 2, e4 = i & 3;
    srw[(e4 * 4 + (c & 3)) * 256 + (c >> 2)] = *reinterpret_cast<const float4*>(rw + (size_t)i * 4);
  }
  __syncthreads();
  const int b5 = (lane >> 5) & 1, b4 = (lane >> 4) & 1, b3 = (lane >> 3) & 1, b2 = (lane >> 2) & 1;
  const int my_e = 8 * b5 + 4 * b4 + 2 * b3 + b2;
  float4 v[4];
  if (gw < T) {
#pragma unroll
    for (int i = 0; i < 4; ++i) v[i] = bf4_to_f4(*reinterpret_cast<const uint2*>(xres + (size_t)gw * DM + (i * 64 + lane) * 4));
  }
  for (int t = gw; t < T; t += nw) {
    uint2 vnx[4];
    const int tn = (t + nw < T) ? (t + nw) : t;
#pragma unroll
    for (int i = 0; i < 4; ++i) vnx[i] = *reinterpret_cast<const uint2*>(xres + (size_t)tn * DM + (i * 64 + lane) * 4);
    float ss = 0.f;
#pragma unroll
    for (int i = 0; i < 4; ++i) ss += v[i].x * v[i].x + v[i].y * v[i].y + v[i].z * v[i].z + v[i].w * v[i].w;
    ss = wave_sum(ss);
    const float rstd = rsqrtf(ss * (1.f / DM) + 1e-6f);
    float lg[16];
#pragma unroll
    for (int e = 0; e < 16; ++e) lg[e] = 0.f;
#pragma unroll
    for (int i = 0; i < 4; ++i) {
      const int q = i * 64 + lane;
      const float4 ww = *reinterpret_cast<const float4*>(w + q * 4);
      const float hv[4] = {v[i].x * rstd * ww.x, v[i].y * rstd * ww.y, v[i].z * rstd * ww.z, v[i].w * rstd * ww.w};
      *reinterpret_cast<unsigned*>(p.hn8() + (size_t)t * DM + q * 4) =
          pk4_f8(hv[0] * F8_H_SCALE, hv[1] * F8_H_SCALE, hv[2] * F8_H_SCALE, hv[3] * F8_H_SCALE);
#pragma unroll
      for (int j = 0; j < 4; ++j)
#pragma unroll
        for (int e4 = 0; e4 < 4; ++e4) {
          const float4 r = srw[(e4 * 4 + j) * 256 + q];
          lg[e4 * 4 + 0] += hv[j] * r.x; lg[e4 * 4 + 1] += hv[j] * r.y;
          lg[e4 * 4 + 2] += hv[j] * r.z; lg[e4 * 4 + 3] += hv[j] * r.w;
        }
      __builtin_amdgcn_sched_barrier(0);
    }
#pragma unroll
    for (int k = 0; k < 8; ++k) {
      const float send = b5 ? lg[k] : lg[k + 8], keep = b5 ? lg[k + 8] : lg[k];
      lg[k] = keep + __shfl_xor(send, 32);
    }
#pragma unroll
    for (int k = 0; k < 4; ++k) {
      const float send = b4 ? lg[k] : lg[k + 4], keep = b4 ? lg[k + 4] : lg[k];
      lg[k] = keep + __shfl_xor(send, 16);
    }
#pragma unroll
    for (int k = 0; k < 2; ++k) {
      const float send = b3 ? lg[k] : lg[k + 2], keep = b3 ? lg[k + 2] : lg[k];
      lg[k] = keep + __shfl_xor(send, 8);
    }
    float lv;
    {
      const float send = b2 ? lg[0] : lg[1], keep = b2 ? lg[1] : lg[0];
      lv = keep + __shfl_xor(send, 4);
    }
    lv += __shfl_xor(lv, 2);
    lv += __shfl_xor(lv, 1);
    float mx = lv;
    mx = fmaxf(mx, __shfl_xor(mx, 4)); mx = fmaxf(mx, __shfl_xor(mx, 8));
    mx = fmaxf(mx, __shfl_xor(mx, 16)); mx = fmaxf(mx, __shfl_xor(mx, 32));
    const float ex = expf(lv - mx);
    float den = ex;
    den += __shfl_xor(den, 4); den += __shfl_xor(den, 8); den += __shfl_xor(den, 16); den += __shfl_xor(den, 32);
    if ((lane & 3) == 0) { p.aff()[(size_t)t * 16 + my_e] = ex / den; p.inv()[(size_t)t * 16 + my_e] = -1; }
#pragma unroll
    for (int i = 0; i < 4; ++i) v[i] = bf4_to_f4(vnx[i]);
  }
}

DI int block_sum_i(int v, int* red, int tid) {
#pragma unroll
  for (int o = 32; o > 0; o >>= 1) v += __shfl_xor(v, o);
  __syncthreads();
  if ((tid & 63) == 0) red[tid >> 6] = v;
  __syncthreads();
  int t = 0;
#pragma unroll
  for (int w = 0; w < NTHR / 64; ++w) t += red[w];
  return t;
}
DI void ph_topk(const Params& p, char* smem) {
  int* red = reinterpret_cast<int*>(smem);
  int* wsum = red + 16;
  const int tid = otid(), wid = tid >> 6, lane = tid & 63;
  for (int it = obid(); it < 64; it += gridDim.x) {
    const int e = it & 15, b = it >> 4;
    unsigned v[8];
#pragma unroll
    for (int i = 0; i < 8; ++i) v[i] = __float_as_uint(p.aff()[(size_t)(b * SEQ + tid * 8 + i) * 16 + e]);
    unsigned thr = 0;
#pragma unroll 1
    for (int bit = 30; bit >= 0; --bit) {
      const unsigned cand = thr | (1u << bit);
      int cnt = 0;
#pragma unroll
      for (int i = 0; i < 8; ++i) cnt += (v[i] >= cand) ? 1 : 0;
      if (block_sum_i(cnt, red, tid) >= 512) thr = cand;
    }
    int ngt = 0, ntie = 0;
#pragma unroll
    for (int i = 0; i < 8; ++i) { ngt += (v[i] > thr) ? 1 : 0; ntie += (v[i] == thr) ? 1 : 0; }
    int ig = ngt, itie = ntie;
#pragma unroll
    for (int o = 1; o < 64; o <<= 1) {
      const int a = __shfl_up(ig, o), c = __shfl_up(itie, o);
      if (lane >= o) { ig += a; itie += c; }
    }
    __syncthreads();
    if (lane == 63) { wsum[wid] = ig; wsum[8 + wid] = itie; }
    __syncthreads();
    int og = 0, ot = 0, totg = 0;
#pragma unroll
    for (int w = 0; w < 8; ++w) {
      const int a = wsum[w], c = wsum[8 + w];
      if (w < wid) { og += a; ot += c; }
      totg += a;
    }
    int pg = og + ig - ngt, pt = ot + itie - ntie;
    const int base = (e * 4 + b) * 512;
#pragma unroll
    for (int i = 0; i < 8; ++i) {
      int slot = -1;
      if (v[i] > thr) { slot = pg; ++pg; }
      else if (v[i] == thr) { if (totg + pt < 512) slot = totg + pt; ++pt; }
      if (slot >= 0) {
        p.tok()[base + slot] = b * SEQ + tid * 8 + i;
        p.inv()[(size_t)(b * SEQ + tid * 8 + i) * 16 + e] = base + slot;
        p.gate()[base + slot] = __uint_as_float(v[i]);
      }
    }
    __syncthreads();
  }
}

struct CfgMoe1 {
  static constexpr bool PERM = true;
  int K; const Params* p; int L; int bid, nb;
  DI bool next(int i, pg8::Unit& u) const {
    const int t = i * nb + bid; if (t >= 16 * 16 * 8) return false;
    const int rnd = t >> 8, w = t & 255, xcd = w & 7, jx = w >> 3, pid = xcd * 4 + (jx >> 3);
    const int mt = jx & 7, nt = pid & 15, e = rnd * 2 + (pid >> 4);
    u.pm = e * 8 + mt; u.pn = e * 16 + nt; return true;
  }
  DI const char* a_base(const pg8::Unit&) const { return (const char*)p->hn8(); }
  DI const char* b_base(const pg8::Unit& u) const { return (const char*)(p->Wgu8() + ((size_t)L * 16 * 4096 + (size_t)u.pn * 256) * DM); }
  const int* tokl;
  DI void a_off(const pg8::Unit&, int R0, int C0, int R1, int C1, unsigned (&vo)[4], int ui) const {
    const int* tk = tokl + ui * 256;
    vo[0] = (unsigned)(tk[R0] * 512 + C0) * 2u; vo[1] = (unsigned)(tk[R1] * 512 + C1) * 2u;
    vo[2] = (unsigned)(tk[128 + R0] * 512 + C0) * 2u; vo[3] = (unsigned)(tk[128 + R1] * 512 + C1) * 2u;
  }
  DI void epi(const f32x4 (&acc)[2][2][4][2], const pg8::Unit& u, int wr, int wc, int fr, int fq) const {
    const int row0 = u.pm * 256 + wr * 64 + fr, col0 = (u.pn & 15) * 128 + wc * 32 + 8 * fq;
    const float dq = 1.f / (F8_H_SCALE * F8_W_SCALE);
#pragma unroll
    for (int ai = 0; ai < 2; ++ai)
#pragma unroll
      for (int m = 0; m < 4; ++m) {
        const f32x4 g0 = acc[ai][0][m][0] * dq, g1 = acc[ai][0][m][1] * dq, u0 = acc[ai][1][m][0] * (dq * F8_HID_SCALE), u1 = acc[ai][1][m][1] * (dq * F8_HID_SCALE);
        uint2 w;
        w.x = pk4_f8(fast_silu(g0[0]) * u0[0], fast_silu(g0[1]) * u0[1], fast_silu(g0[2]) * u0[2], fast_silu(g0[3]) * u0[3]);
        w.y = pk4_f8(fast_silu(g1[0]) * u1[0], fast_silu(g1[1]) * u1[1], fast_silu(g1[2]) * u1[2], fast_silu(g1[3]) * u1[3]);
        *reinterpret_cast<uint2*>(p->hid8() + (size_t)(row0 + ai * 128 + m * 16) * 2048 + col0) = w;
      }
  }
};
DI void ph_moe1(const Params& p, int L, char* smem) {
  CfgMoe1 c; c.K = 512; c.p = &p; c.L = L; c.bid = obid(); c.nb = gridDim.x;
  int* tokl = reinterpret_cast<int*>(smem + 131072);
  c.tokl = tokl;
  for (int idx = otid(); idx < 8 * 256; idx += NTHR) {
    pg8::Unit u;
    if (c.next(idx >> 8, u)) tokl[idx] = p.tok()[u.pm * 256 + (idx & 255)];
  }
  __syncthreads();
  pg8::gemm_phase_f8((pg8::lds_u8*)smem, c);
}
struct CfgMoe2 {
  static constexpr bool PERM = true;
  int K; const Params* p; int L; int bid, nb;
  DI bool next(int i, pg8::Unit& u) const {
    const int t = i * nb + bid; if (t >= 16 * 4 * 8) return false;
    const int rnd = t >> 8, w = t & 255, xcd = w & 7, jx = w >> 3, pid = rnd * 32 + xcd * 4 + (jx >> 3);
    u.pm = (pid >> 2) * 8 + (jx & 7); u.pn = pid; return true;
  }
  DI const char* a_base(const pg8::Unit& u) const { return (const char*)(p->hid8() + (size_t)u.pm * 256 * 2048); }
  DI const char* b_base(const pg8::Unit& u) const { return (const char*)(p->Wd8() + ((size_t)L * 16 * DM + (size_t)u.pn * 256) * 2048); }
  DI void a_off(const pg8::Unit&, int R0, int C0, int R1, int C1, unsigned (&vo)[4], int) const {
    vo[0] = (unsigned)(R0 * 1024 + C0) * 2u; vo[1] = (unsigned)(R1 * 1024 + C1) * 2u;
    vo[2] = vo[0] + 128u * 1024u * 2u; vo[3] = vo[1] + 128u * 1024u * 2u;
  }
  DI void epi(const f32x4 (&acc)[2][2][4][2], const pg8::Unit& u, int wr, int wc, int fr, int fq) const {
    u16* eo = p->proj();
    const int row0 = u.pm * 256 + wr * 64 + fr, col0 = (u.pn & 3) * 256 + wc * 32 + 8 * fq;
#pragma unroll
    for (int ai = 0; ai < 2; ++ai)
#pragma unroll
      for (int m = 0; m < 4; ++m) {
        const int row = row0 + ai * 128 + m * 16;
        const float gt = p->gate()[row] * (1.f / (F8_HID_SCALE * F8_W_SCALE));
#pragma unroll
        for (int bj = 0; bj < 2; ++bj) {
          const f32x4 a0 = acc[ai][bj][m][0], a1 = acc[ai][bj][m][1];
          uint4 w;
          w.x = pack2(gt * a0[0], gt * a0[1]); w.y = pack2(gt * a0[2], gt * a0[3]);
          w.z = pack2(gt * a1[0], gt * a1[1]); w.w = pack2(gt * a1[2], gt * a1[3]);
          *reinterpret_cast<uint4*>(eo + (size_t)row * DM + col0 + bj * 128) = w;
        }
      }
  }
};
DI void ph_moe2(const Params& p, int L, char* smem) {
  CfgMoe2 c; c.K = 1024; c.p = &p; c.L = L; c.bid = obid(); c.nb = gridDim.x;
  pg8::gemm_phase_f8((pg8::lds_u8*)smem, c);
}
template <bool FINAL>
DI void ph_combine_norm(const Params& p, const u16* __restrict__ xa, u16* __restrict__ xnew, const float* __restrict__ w,
                        u16* __restrict__ hn_out, float* __restrict__ f_out) {
  const int tid_ = otid(), lane = tid_ & 63, gw = (obid() * NTHR + tid_) >> 6, nw = gridDim.x * (NTHR / 64);
  const u16* eo = p.proj();
  float4 v[4];
  int myrow = -1;
  if (gw < T) {
#pragma unroll
    for (int i = 0; i < 4; ++i) v[i] = bf4_to_f4(*reinterpret_cast<const uint2*>(xa + (size_t)gw * DM + (i * 64 + lane) * 4));
    myrow = (lane < 16) ? p.inv()[(size_t)gw * 16 + lane] : -1;
  }
  for (int t = gw; t < T; t += nw) {
    uint2 vnx[4];
    const int tn = (t + nw < T) ? (t + nw) : t;
#pragma unroll
    for (int i = 0; i < 4; ++i) vnx[i] = *reinterpret_cast<const uint2*>(xa + (size_t)tn * DM + (i * 64 + lane) * 4);
    const int myrow_nx = (lane < 16) ? p.inv()[(size_t)tn * 16 + lane] : -1;
    unsigned long long mask = __builtin_amdgcn_ballot_w64(myrow >= 0);
#pragma unroll 1
    while (mask != 0ull) {
      const int e0 = __builtin_ctzll(mask);
      mask &= mask - 1ull;
      const int r0 = __builtin_amdgcn_readlane(myrow, e0);
      int r1 = -1;
      if (mask != 0ull) { const int e1 = __builtin_ctzll(mask); mask &= mask - 1ull; r1 = __builtin_amdgcn_readlane(myrow, e1); }
      uint2 q0[4], q1[4];
#pragma unroll
      for (int i = 0; i < 4; ++i) q0[i] = *reinterpret_cast<const uint2*>(eo + (size_t)r0 * DM + (i * 64 + lane) * 4);
      const int r1c = (r1 >= 0) ? r1 : r0;
#pragma unroll
      for (int i = 0; i < 4; ++i) q1[i] = *reinterpret_cast<const uint2*>(eo + (size_t)r1c * DM + (i * 64 + lane) * 4);
      const float s1 = (r1 >= 0) ? 1.f : 0.f;
#pragma unroll
      for (int i = 0; i < 4; ++i) {
        v[i].x += __uint_as_float(q0[i].x << 16); v[i].y += __uint_as_float(q0[i].x & 0xffff0000u);
        v[i].z += __uint_as_float(q0[i].y << 16); v[i].w += __uint_as_float(q0[i].y & 0xffff0000u);
        v[i].x += s1 * __uint_as_float(q1[i].x << 16); v[i].y += s1 * __uint_as_float(q1[i].x & 0xffff0000u);
        v[i].z += s1 * __uint_as_float(q1[i].y << 16); v[i].w += s1 * __uint_as_float(q1[i].y & 0xffff0000u);
      }
    }
    float ss = 0.f;
#pragma unroll
    for (int i = 0; i < 4; ++i) ss += v[i].x * v[i].x + v[i].y * v[i].y + v[i].z * v[i].z + v[i].w * v[i].w;
    ss = wave_sum(ss);
    const float rstd = rsqrtf(ss * (1.f / DM) + 1e-6f);
#pragma unroll
    for (int i = 0; i < 4; ++i) {
      const int c = (i * 64 + lane) * 4;
      const float4 ww = *reinterpret_cast<const float4*>(w + c);
      if (FINAL) {
        *reinterpret_cast<float4*>(f_out + (size_t)t * DM + c) = make_float4(v[i].x * rstd * ww.x, v[i].y * rstd * ww.y, v[i].z * rstd * ww.z, v[i].w * rstd * ww.w);
      } else {
        uint2 xo;
        xo.x = pack2(v[i].x, v[i].y); xo.y = pack2(v[i].z, v[i].w);
        *reinterpret_cast<uint2*>(xnew + (size_t)t * DM + c) = xo;
        uint2 o;
        o.x = pack2(v[i].x * rstd * ww.x, v[i].y * rstd * ww.y);
        o.y = pack2(v[i].z * rstd * ww.z, v[i].w * rstd * ww.w);
        *reinterpret_cast<uint2*>(hn_out + (size_t)t * DM + c) = o;
      }
    }
#pragma unroll
    for (int i = 0; i < 4; ++i) v[i] = bf4_to_f4(vnx[i]);
    myrow = myrow_nx;
  }
}

__global__ void __launch_bounds__(NTHR) mk(Params p) {
  extern __shared__ __attribute__((aligned(16))) char smem[];
  cg::grid_group grid = cg::this_grid();
  __shared__ uint4 xb_words;
  if (threadIdx.x == 0) xb_words = make_uint4(0u, 0u, 0u, 0u);
  __syncthreads();
  XcdBarrier xb = xcd_barrier_post(p.bar(), (volatile LAS unsigned*)&xb_words);
  ph_convert(p, smem);
  ph_rmsnorm_bf16(p.x, p.ln1_w, p.hn());
  xcd_barrier(xb);
  if (p.rep[12] == 0x7fffffff) grid.sync();
  for (int L = 0; L < 2; ++L) {
    u16* xout = p.xres();
    if (L == 1) {
      ph_combine_norm<false>(p, p.xres(), p.xres2(), p.ln1_w + DM, p.hn(), nullptr);
      xcd_barrier(xb);
    }
    ph_inproj(p, L, smem);
    xcd_barrier(xb);
    ph_post(p, L);
    xcd_barrier(xb);
    {
      unsigned* ctr = p.bar() + XCD_BAR_WORDS + 8 + L;
      __shared__ int q1_item;
      for (;;) {
        if (threadIdx.x == 0) q1_item = (int)atomicAdd(ctr, 1u);
        __syncthreads();
        const int it = q1_item;
        __syncthreads();
        if (it >= 1344) break;
        if (it < 256) ph_dil_pass<0>(p, smem, it);
        else if (it < 384) ph_ssd_a(p, L, smem, it - 256);
        else if (it < 576) ph_mla_up_q(p, L, smem, it - 384);
        else if (it < 832) ph_mla_up_kv(p, L, smem, it - 576);
        else ph_ret_a(p, smem, it - 832);
      }
    }
    xcd_barrier(xb);
    {
      { ph_ret_scan(p); ph_ssd_scan(p); }
      ph_mla_attn(p, smem, L);
      for (int bi = obid(); bi < 256; bi += gridDim.x) ph_dil_pass<1>(p, smem, bi);
    }
    xcd_barrier(xb);
    {
      unsigned* ctr = p.bar() + XCD_BAR_WORDS + L;
      __shared__ int q_item;
      for (;;) {
        if (threadIdx.x == 0) q_item = (int)atomicAdd(ctr, 1u);
        __syncthreads();
        const int it = q_item;
        __syncthreads();
        if (it >= 640) break;
        if (it < 128) ph_ssd_c(p, L, smem, it);
        else ph_ret_c(p, smem, it - 128);
      }
    }
    xcd_barrier(xb);
    ph_outproj(p, L, smem);
    xcd_barrier(xb);
    ph_rms2_router(p, L, xout, smem);
    xcd_barrier(xb);
    ph_topk(p, smem);
    if (gridDim.x == 256 && obid() >= CVT_IDLE_FIRST_BLK) cvt_tiles_idle(p, L, smem, CVT_A, CVT_NB);
    xcd_barrier(xb);
    ph_moe1(p, L, smem);
    xcd_barrier(xb);
    ph_moe2(p, L, smem);
    xcd_barrier(xb);
  }
  ph_combine_norm<true>(p, p.xres(), nullptr, p.final_w, nullptr, p.out);
}

extern "C" void kernel_launch(void* const* d_in, const int* in_sizes, int n_in, void* d_out, int out_size, void* d_ws,
                              size_t ws_size, hipStream_t stream) {
  static int grid_blocks = 0;
  if (!grid_blocks) {
    int dev = 0, cus = 0, per_cu = 0;
    (void)hipGetDevice(&dev);
    (void)hipDeviceGetAttribute(&cus, hipDeviceAttributeMultiprocessorCount, dev);
    (void)hipFuncSetAttribute((const void*)mk, hipFuncAttributeMaxDynamicSharedMemorySize, LDS_BYTES);
    (void)hipOccupancyMaxActiveBlocksPerMultiprocessor(&per_cu, (const void*)mk, NTHR, LDS_BYTES);
    if (per_cu < 1) { fprintf(stderr, "occupancy query says %d blocks/CU\n", per_cu); per_cu = 1; }
    grid_blocks = cus * 1;
  }
  Params p{};
  const float** fp = reinterpret_cast<const float**>(&p);
  for (int i = 0; i < 20; ++i) fp[i] = (const float*)d_in[i];
  p.out = (float*)d_out;
  p.ws = (char*)d_ws;
  const size_t off = WSO.total;
  { const int reps[16] = REPS_INIT; for (int i = 0; i < 16; ++i) p.rep[i] = reps[i]; }
  if (off > ws_size) { fprintf(stderr, "workspace too small: need %zu have %zu\n", off, ws_size); return; }
  (void)hipMemsetAsync(p.bar(), 0, (size_t)(XCD_BAR_WORDS + 64) * 4, stream);
  void* args[] = {&p};
  hipError_t e = hipLaunchCooperativeKernel((void*)mk, dim3(grid_blocks), dim3(NTHR), args, LDS_BYTES, stream);
  if (e != hipSuccess) fprintf(stderr, "cooperative launch failed: %s (grid %d)\n", hipGetErrorString(e), grid_blocks);
}
```

```cpp
#include <hip/hip_runtime.h>
#include <hip/hip_cooperative_groups.h>
#include <cstdio>
#include <cstdint>
namespace cg = cooperative_groups;

#define DI __device__ __forceinline__
typedef unsigned short u16;
typedef __attribute__((ext_vector_type(8))) short bf16x8;
typedef __attribute__((ext_vector_type(4))) float f32x4;

#ifndef REPS_INIT
#define REPS_INIT {1, 1, 1, 1, 1, 1, 1, 1, 1, 1, 1, 1, 0, 1, 1, 1}
#endif
constexpr int NTHR = 512;
constexpr int T = 16384, SEQ = 4096, DM = 1024;
constexpr int PW = 3240, PWP = 3328;
constexpr int C_RQ = 0, C_RK = 256, C_RV = 512, C_RG = 768, C_CQ = 1024, C_CKV = 1280, C_KR = 1408,
              C_Z = 1440, C_XBC = 1696, C_DT = 2464, C_DQ = 2472, C_DK = 2728, C_DV = 2984;
constexpr int LDS_BYTES = 131072 + 8192;

struct WsOff {
  size_t WinT;
  size_t WuqT;
  size_t WukvT;
  size_t WoutT;
  size_t Wgu8;
  size_t Wd8;
  size_t hn8;
  size_t xres;
  size_t hn;
  size_t proj;
  size_t cqn;
  size_t ckvn;
  size_t mq;
  size_t xbc;
  size_t mixed;
  size_t hid8;
  size_t kfull;
  size_t rS;
  size_t sS;
  size_t rU;
  size_t sU;
  size_t cdec;
  size_t vT;
  size_t rtab;
  size_t dpart;
  size_t dtv;
  size_t cs;
  size_t ybuf;
  size_t aff;
  size_t gate;
  size_t tok;
  size_t inv;
  size_t bar;
  size_t xres2;
  size_t total;
};
constexpr WsOff ws_layout() {
  WsOff o{};
  size_t off = 0;
  o.WinT = off; off += (((size_t)2 * PWP * DM * 2) + 255) & ~(size_t)255;
  o.WuqT = off; off += (((size_t)2 * 384 * 256 * 2) + 255) & ~(size_t)255;
  o.WukvT = off; off += (((size_t)2 * 512 * 128 * 2) + 255) & ~(size_t)255;
  o.WoutT = off; off += (((size_t)2 * DM * DM * 2) + 255) & ~(size_t)255;
  o.Wgu8 = off; off += (((size_t)2 * 16 * 4096 * DM) + 255) & ~(size_t)255;
  o.Wd8 = off; off += (((size_t)2 * 16 * DM * 2048) + 255) & ~(size_t)255;
  o.hn8 = off; off += (((size_t)T * DM) + 255) & ~(size_t)255;
  o.xres = off; off += (((size_t)T * DM * 2) + 255) & ~(size_t)255;
  o.hn = off; off += (((size_t)T * DM * 2) + 255) & ~(size_t)255;
  o.proj = off; off += (((size_t)T * PWP * 2) + 255) & ~(size_t)255;
  o.cqn = off; off += (((size_t)T * 256 * 2) + 255) & ~(size_t)255;
  o.ckvn = off; off += (((size_t)T * 128 * 2) + 255) & ~(size_t)255;
  o.mq = off; off += (((size_t)T * 384 * 2) + 255) & ~(size_t)255;
  o.xbc = off; off += (((size_t)T * 768 * 2) + 255) & ~(size_t)255;
  o.mixed = off; off += (((size_t)T * DM * 2) + 255) & ~(size_t)255;
  o.hid8 = off; off += (((size_t)32768 * 2048) + 255) & ~(size_t)255;
  o.kfull = off; off += (((size_t)T * 4 * 96 * 2) + 255) & ~(size_t)255;
  o.rS = off; off += (((size_t)16 * 32 * 2 * 4096 * 2) + 255) & ~(size_t)255;
  o.sS = off; off += (((size_t)128 * 8 * 8192 * 2) + 255) & ~(size_t)255;
  o.rU = off; off += (((size_t)16 * 32 * 2 * 4096 * 4) + 255) & ~(size_t)255;
  o.sU = off; off += (((size_t)128 * 8 * 8192 * 4) + 255) & ~(size_t)255;
  o.cdec = off; off += (((size_t)128 * 8 * 4) + 255) & ~(size_t)255;
  o.vT = off; off += (((size_t)T * 4 * 64 * 2) + 255) & ~(size_t)255;
  o.rtab = off; off += (((size_t)SEQ * 56 * 2 * 4) + 255) & ~(size_t)255;
  o.dpart = off; off += (((size_t)T * 4 * 68 * 4) + 255) & ~(size_t)255;
  o.dtv = off; off += (((size_t)T * 8 * 4) + 255) & ~(size_t)255;
  o.cs = off; off += (((size_t)T * 8 * 4) + 255) & ~(size_t)255;
  o.ybuf = off; off += (((size_t)T * 256 * 4) + 255) & ~(size_t)255;
  o.aff = off; off += (((size_t)T * 16 * 4) + 255) & ~(size_t)255;
  o.gate = off; off += (((size_t)64 * 512 * 4) + 255) & ~(size_t)255;
  o.tok = off; off += (((size_t)64 * 512 * 4) + 255) & ~(size_t)255;
  o.inv = off; off += (((size_t)T * 16 * 4) + 255) & ~(size_t)255;
  o.bar = off; off += (((size_t)(3456 + 64) * 4) + 255) & ~(size_t)255;
  o.xres2 = off; off += (((size_t)T * DM * 2) + 255) & ~(size_t)255;
  o.total = off;
  return o;
}
constexpr WsOff WSO = ws_layout();
struct Params {
  const float *x, *ln1_w, *w_in, *q_norm_w, *kv_norm_w, *w_uq, *w_ukv, *conv_w, *conv_b, *a_log, *dt_bias,
      *ssm_d, *ssm_norm_w, *w_out, *ln2_w, *router_w, *w_gate, *w_up, *w_down, *final_w;
  float* out;
  char* ws;
  int rep[16];
  __host__ DI u16* WinT() const { return reinterpret_cast<u16*>(ws + WSO.WinT); }
  __host__ DI u16* WuqT() const { return reinterpret_cast<u16*>(ws + WSO.WuqT); }
  __host__ DI u16* WukvT() const { return reinterpret_cast<u16*>(ws + WSO.WukvT); }
  __host__ DI u16* WoutT() const { return reinterpret_cast<u16*>(ws + WSO.WoutT); }
  __host__ DI unsigned char* Wgu8() const { return reinterpret_cast<unsigned char*>(ws + WSO.Wgu8); }
  __host__ DI unsigned char* Wd8() const { return reinterpret_cast<unsigned char*>(ws + WSO.Wd8); }
  __host__ DI unsigned char* hn8() const { return reinterpret_cast<unsigned char*>(ws + WSO.hn8); }
  __host__ DI u16* xres() const { return reinterpret_cast<u16*>(ws + WSO.xres); }
  __host__ DI u16* hn() const { return reinterpret_cast<u16*>(ws + WSO.hn); }
  __host__ DI u16* proj() const { return reinterpret_cast<u16*>(ws + WSO.proj); }
  __host__ DI u16* cqn() const { return reinterpret_cast<u16*>(ws + WSO.cqn); }
  __host__ DI u16* ckvn() const { return reinterpret_cast<u16*>(ws + WSO.ckvn); }
  __host__ DI u16* mq() const { return reinterpret_cast<u16*>(ws + WSO.mq); }
  __host__ DI u16* xbc() const { return reinterpret_cast<u16*>(ws + WSO.xbc); }
  __host__ DI u16* mixed() const { return reinterpret_cast<u16*>(ws + WSO.mixed); }
  __host__ DI unsigned char* hid8() const { return reinterpret_cast<unsigned char*>(ws + WSO.hid8); }
  __host__ DI u16* kfull() const { return reinterpret_cast<u16*>(ws + WSO.kfull); }
  __host__ DI u16* rS() const { return reinterpret_cast<u16*>(ws + WSO.rS); }
  __host__ DI u16* sS() const { return reinterpret_cast<u16*>(ws + WSO.sS); }
  __host__ DI float* rU() const { return reinterpret_cast<float*>(ws + WSO.rU); }
  __host__ DI float* sU() const { return reinterpret_cast<float*>(ws + WSO.sU); }
  __host__ DI float* cdec() const { return reinterpret_cast<float*>(ws + WSO.cdec); }
  __host__ DI u16* vT() const { return reinterpret_cast<u16*>(ws + WSO.vT); }
  __host__ DI float* rtab() const { return reinterpret_cast<float*>(ws + WSO.rtab); }
  __host__ DI float* dpart() const { return reinterpret_cast<float*>(ws + WSO.dpart); }
  __host__ DI float* dtv() const { return reinterpret_cast<float*>(ws + WSO.dtv); }
  __host__ DI float* cs() const { return reinterpret_cast<float*>(ws + WSO.cs); }
  __host__ DI float* ybuf() const { return reinterpret_cast<float*>(ws + WSO.ybuf); }
  __host__ DI float* aff() const { return reinterpret_cast<float*>(ws + WSO.aff); }
  __host__ DI float* gate() const { return reinterpret_cast<float*>(ws + WSO.gate); }
  __host__ DI int* tok() const { return reinterpret_cast<int*>(ws + WSO.tok); }
  __host__ DI int* inv() const { return reinterpret_cast<int*>(ws + WSO.inv); }
  __host__ DI unsigned* bar() const { return reinterpret_cast<unsigned*>(ws + WSO.bar); }
  __host__ DI u16* xres2() const { return reinterpret_cast<u16*>(ws + WSO.xres2); }
};


typedef __attribute__((ext_vector_type(2))) __bf16 bf16x2_t;
typedef __attribute__((ext_vector_type(2))) float f32x2_t;
typedef __attribute__((ext_vector_type(16))) float f32x16;
typedef __attribute__((ext_vector_type(4))) short s16x4;
typedef __attribute__((ext_vector_type(8))) int i32x8;
typedef __attribute__((ext_vector_type(4))) int i32x4;
DI unsigned pack2(float a, float b) {
  f32x2_t v = {a, b};
  return __builtin_bit_cast(unsigned, __builtin_convertvector(v, bf16x2_t));
}
DI u16 f2bf(float f) { return (u16)(pack2(f, 0.f) & 0xffffu); }
DI float bf2f(u16 h) { return __uint_as_float(((unsigned)h) << 16); }
DI void unpack8(const uint4& v, float* f) {
  f[0] = __uint_as_float(v.x << 16); f[1] = __uint_as_float(v.x & 0xffff0000u);
  f[2] = __uint_as_float(v.y << 16); f[3] = __uint_as_float(v.y & 0xffff0000u);
  f[4] = __uint_as_float(v.z << 16); f[5] = __uint_as_float(v.z & 0xffff0000u);
  f[6] = __uint_as_float(v.w << 16); f[7] = __uint_as_float(v.w & 0xffff0000u);
}
DI void ld8(const u16* p, float* f) { uint4 v = *reinterpret_cast<const uint4*>(p); unpack8(v, f); }
DI unsigned pk4_f8(float a, float b, float c, float d) {
  a = __builtin_amdgcn_fmed3f(a, -448.f, 448.f); b = __builtin_amdgcn_fmed3f(b, -448.f, 448.f);
  c = __builtin_amdgcn_fmed3f(c, -448.f, 448.f); d = __builtin_amdgcn_fmed3f(d, -448.f, 448.f);
  int w = __builtin_amdgcn_cvt_pk_fp8_f32(a, b, 0, false);
  w = __builtin_amdgcn_cvt_pk_fp8_f32(c, d, w, true);
  return (unsigned)w;
}
constexpr float F8_W_SCALE = 256.f, F8_H_SCALE = 16.f, F8_HID_SCALE = 8.f;
constexpr float F8_EO_SCALE = 16.f;
typedef short s16x2_t __attribute__((ext_vector_type(2)));
template <int SCALE> DI unsigned pk4_f8_scaled(float a, float b, float c, float d) {
  constexpr float inv = 1.f / (float)SCALE;
  s16x2_t r = {0, 0};
  r = __builtin_amdgcn_cvt_scalef32_pk_fp8_f32(r, a, b, inv, false);
  r = __builtin_amdgcn_cvt_scalef32_pk_fp8_f32(r, c, d, inv, true);
  return __builtin_bit_cast(unsigned, r);
}
DI float4 bf4_to_f4(const uint2& q) {
  return make_float4(__uint_as_float(q.x << 16), __uint_as_float(q.x & 0xffff0000u), __uint_as_float(q.y << 16), __uint_as_float(q.y & 0xffff0000u));
}
DI float wave_sum(float v) {
  v += __builtin_bit_cast(float, __builtin_amdgcn_update_dpp(0, __builtin_bit_cast(int, v), 0xB1, 0xF, 0xF, false));
  v += __builtin_bit_cast(float, __builtin_amdgcn_update_dpp(0, __builtin_bit_cast(int, v), 0x4E, 0xF, 0xF, false));
  v += __builtin_bit_cast(float, __builtin_amdgcn_update_dpp(0, __builtin_bit_cast(int, v), 0x141, 0xF, 0xF, false));
  v += __builtin_bit_cast(float, __builtin_amdgcn_update_dpp(0, __builtin_bit_cast(int, v), 0x140, 0xF, 0xF, false));
  const int iv = __builtin_bit_cast(int, v);
  const float r0 = __builtin_bit_cast(float, __builtin_amdgcn_readlane(iv, 0)), r1 = __builtin_bit_cast(float, __builtin_amdgcn_readlane(iv, 16));
  const float r2 = __builtin_bit_cast(float, __builtin_amdgcn_readlane(iv, 32)), r3 = __builtin_bit_cast(float, __builtin_amdgcn_readlane(iv, 48));
  return (r0 + r1) + (r2 + r3);
}
DI float dot2acc(unsigned a, unsigned b, float c) {
  return __builtin_amdgcn_fdot2_f32_bf16(__builtin_bit_cast(bf16x2_t, a), __builtin_bit_cast(bf16x2_t, b), c, false);
}
DI float dot8(const uint4& a, const uint4& b, float c) {
  c = dot2acc(a.x, b.x, c); c = dot2acc(a.y, b.y, c); c = dot2acc(a.z, b.z, c); c = dot2acc(a.w, b.w, c);
  return c;
}
DI int otid() { int t = threadIdx.x; asm volatile("" : "+v"(t)); return t; }
DI int obid() { int b = blockIdx.x; asm volatile("" : "+s"(b)); return b; }
DI float silu(float x) { return x / (1.f + __expf(-x)); }
DI float fast_silu(float x) { return x * __builtin_amdgcn_rcpf(1.f + __expf(-x)); }


#define XB_TMO      128
#define XB_XCNT(j)  (256  + 64 * (j))
#define XB_XSUB(j)  (1280 + 64 * (j))
#define XB_XGEN(j)  (2304 + 64 * (j))
#define XB_TOP      3328
#define XB_TOPGEN   3392
#define XCD_BAR_WORDS 3456
#define XB_SPIN_CAP (1u << 20)
#define LAS __attribute__((address_space(3)))
DI unsigned xb_ld(unsigned* p) { return __hip_atomic_load(p, __ATOMIC_RELAXED, __HIP_MEMORY_SCOPE_AGENT); }
DI unsigned xb_add(unsigned* p, unsigned v) { return __hip_atomic_fetch_add(p, v, __ATOMIC_RELAXED, __HIP_MEMORY_SCOPE_AGENT); }
DI unsigned xb_xcc_id() { return (unsigned)__builtin_amdgcn_s_getreg((3 << 11) | 20) & 0xFu; }
#define XB_SPIN(cond, bar) do { unsigned _sp = 0; while (cond) { __builtin_amdgcn_s_sleep(1); \
    if ((++_sp & 255u) == 0u) { if (xb_ld(&(bar)[XB_TMO])) break; if (_sp > XB_SPIN_CAP) { atomicAdd(&(bar)[XB_TMO], 1u); break; } } } } while (0)
struct XcdBarrier { unsigned* bar; unsigned x; volatile LAS unsigned* st; };
DI XcdBarrier xcd_barrier_post(unsigned* bar, volatile LAS unsigned* st) {
  XcdBarrier b; b.bar = bar; b.x = xb_xcc_id(); b.st = st;
  if (threadIdx.x == 0) (void)xb_add(&bar[XB_XCNT(b.x)], 1u);
  return b;
}
DI void xcd_barrier_complete(unsigned* bar, unsigned x, unsigned& nloc, unsigned& nx) {
  const unsigned G = gridDim.x * gridDim.y * gridDim.z;
  unsigned sum, cnt, mine, sp = 0u;
  for (;;) {
    sum = 0u; cnt = 0u; mine = 0u;
#pragma unroll
    for (unsigned j = 0; j < 16; ++j) { const unsigned c = xb_ld(&bar[XB_XCNT(j)]); sum += c; cnt += (c > 0u) ? 1u : 0u; mine = (j == x) ? c : mine; }
    if (sum == G) break;
    __builtin_amdgcn_s_sleep(1);
    if ((++sp & 255u) == 0u) { if (xb_ld(&bar[XB_TMO])) break; if (sp > XB_SPIN_CAP) { atomicAdd(&bar[XB_TMO], 1u); break; } }
  }
  nloc = mine > 0u ? mine : 1u; nx = cnt > 0u ? cnt : 1u;
}
DI void xcd_barrier(const XcdBarrier& b) {
  asm volatile("s_waitcnt vmcnt(0)" ::: "memory");
  __syncthreads();
  if (threadIdx.x == 0) {
    unsigned* bar = b.bar;
    __builtin_amdgcn_s_waitcnt(0);
    unsigned nloc = b.st[0], nx = b.st[1];
    if (nloc == 0u) { xcd_barrier_complete(bar, b.x, nloc, nx); b.st[0] = nloc; b.st[1] = nx; }
    const unsigned old = xb_add(&bar[XB_XSUB(b.x)], 1u);
    const unsigned gen = old / nloc;
    if (old + 1u == (gen + 1u) * nloc) {
      __builtin_amdgcn_fence(__ATOMIC_RELEASE, "agent");
      asm volatile("s_waitcnt vmcnt(0)" ::: "memory");
      const unsigned og = xb_add(&bar[XB_TOP], 1u);
      const unsigned tg = og / nx;
      if (og + 1u == (tg + 1u) * nx) xb_add(&bar[XB_TOPGEN], 1u);
      else XB_SPIN(xb_ld(&bar[XB_TOPGEN]) == tg, bar);
      __builtin_amdgcn_fence(__ATOMIC_ACQUIRE, "agent");
      xb_add(&bar[XB_XGEN(b.x)], 1u);
      asm volatile("s_waitcnt vmcnt(0)" ::: "memory");
    } else {
      XB_SPIN(xb_ld(&bar[XB_XGEN(b.x)]) == gen, bar);
      __builtin_amdgcn_fence(__ATOMIC_ACQUIRE, "agent");
      asm volatile("s_waitcnt vmcnt(0)" ::: "memory");
    }
  }
  __syncthreads();
}

template <class F>
DI void transpose_convert(const float* __restrict__ src, int K, int N, int Npad, u16* __restrict__ dst, F rowmap,
                          int bid, int nb, char* smem) {
  u16* tile = reinterpret_cast<u16*>(smem);
  const int tid = otid();
  const int ntn = Npad / 128, ntk = K / 64;
  for (int t = bid; t < ntn * ntk; t += nb) {
    const int n0 = (t % ntn) * 128, k0 = (t / ntn) * 64;
    f32x4 v[4];
#pragma unroll
    for (int i = 0; i < 4; ++i) {
      const int kk = (tid >> 5) + 16 * i, nn = (tid & 31) * 4;
      v[i] = f32x4{0.f, 0.f, 0.f, 0.f};
      if (n0 + nn < N) v[i] = __builtin_nontemporal_load(reinterpret_cast<const f32x4*>(src + (size_t)(k0 + kk) * N + n0 + nn));
    }
#pragma unroll
    for (int i = 0; i < 4; ++i) {
      const int kk = (tid >> 5) + 16 * i, nn = (tid & 31) * 4;
      tile[(nn + 0) * 72 + kk] = f2bf(v[i][0]); tile[(nn + 1) * 72 + kk] = f2bf(v[i][1]);
      tile[(nn + 2) * 72 + kk] = f2bf(v[i][2]); tile[(nn + 3) * 72 + kk] = f2bf(v[i][3]);
    }
    __syncthreads();
#pragma unroll
    for (int j = 0; j < 2; ++j) {
      const int c = tid + NTHR * j, nn = c >> 3, k8 = (c & 7) * 8;
      const uint4 o = *reinterpret_cast<const uint4*>(tile + nn * 72 + k8);
      *reinterpret_cast<uint4*>(dst + (size_t)rowmap(n0 + nn) * K + k0 + k8) = o;
    }
    __syncthreads();
  }
}

template <class F>
DI void transpose_convert_f8(const float* __restrict__ src, int K, int N, unsigned char* __restrict__ dst, F rowmap,
                             int bid, int nb, char* smem) {
  unsigned char* tile = reinterpret_cast<unsigned char*>(smem);
  const int tid = otid();
  const int ntn = N / 128, ntk = K / 64;
  for (int t = bid; t < ntn * ntk; t += nb) {
    const int n0 = (t % ntn) * 128, k0 = (t / ntn) * 64;
    const int kq = (tid >> 5) * 4, nn = (tid & 31) * 4;
    f32x4 v[4];
#pragma unroll
    for (int r = 0; r < 4; ++r) v[r] = __builtin_nontemporal_load(reinterpret_cast<const f32x4*>(src + (size_t)(k0 + kq + r) * N + n0 + nn));
#pragma unroll
    for (int e = 0; e < 4; ++e)
      *reinterpret_cast<unsigned*>(tile + (nn + e) * 80 + kq) =
          pk4_f8(v[0][e] * F8_W_SCALE, v[1][e] * F8_W_SCALE, v[2][e] * F8_W_SCALE, v[3][e] * F8_W_SCALE);
    __syncthreads();
    {
      const int rn = tid >> 2, kc = (tid & 3) * 16;
      const uint4 o = *reinterpret_cast<const uint4*>(tile + rn * 80 + kc);
      *reinterpret_cast<uint4*>(dst + (size_t)rowmap(n0 + rn) * K + k0 + kc) = o;
    }
    __syncthreads();
  }
}

constexpr int CVT_IN_MLA_E = 16;
struct CvtTile { const float* src; unsigned char* dst; int N, K, n0, k0, mat; };
DI CvtTile cvt_tile(const Params& p, int L, int g) {
  const int e = g / 768, r = g - e * 768, mat = r >> 8, tt = r & 255;
  const size_t le = (size_t)(L * 16 + e);
  CvtTile c;
  c.mat = mat;
  if (mat < 2) { c.src = ((mat == 0) ? p.w_gate : p.w_up) + le * DM * 2048; c.N = 2048; c.dst = p.Wgu8() + le * 4096 * DM; c.K = 1024; c.n0 = (tt & 15) * 128; c.k0 = (tt >> 4) * 64; }
  else { c.src = p.w_down + le * 2048 * DM; c.N = 1024; c.dst = p.Wd8() + le * DM * 2048; c.K = 2048; c.n0 = (tt & 7) * 128; c.k0 = (tt >> 3) * 64; }
  return c;
}
DI int cvt_rowmap(int mat, int n) { return (mat == 2) ? n : ((n >> 7) * 256 + (mat == 1 ? 128 : 0) + (n & 127)); }

constexpr int CVT_IDLE_FIRST_BLK = 64, CVT_IDLE_BLKS = 192;
constexpr int CVT_NA = 12, CVT_NB = 12;
constexpr int CVT_A = CVT_IDLE_BLKS * CVT_NA, CVT_B = CVT_A + CVT_IDLE_BLKS * CVT_NB;
static_assert(CVT_B + 32 * 256 >= 12288 && CVT_B <= 12288, "the MLA loop (one tile per 128-key iteration, 32 iterations) must cover the rest");
DI void cvt_tiles_idle(const Params& p, int L, char* smem, int first, int per_blk) {
  const int tid = otid(), ib = obid() - CVT_IDLE_FIRST_BLK;
  unsigned char* tile = reinterpret_cast<unsigned char*>(smem);
  __syncthreads();
#pragma unroll 1
  for (int i = 0; i < per_blk; i += 2) {
    f32x4 v[2][4];
#pragma unroll
    for (int u = 0; u < 2; ++u) {
      const CvtTile ct = cvt_tile(p, L, first + ib + CVT_IDLE_BLKS * (i + u));
      const float* sp = ct.src + (size_t)(ct.k0 + (tid >> 5) * 4) * ct.N + ct.n0 + (tid & 31) * 4;
#pragma unroll
      for (int r = 0; r < 4; ++r) v[u][r] = __builtin_nontemporal_load(reinterpret_cast<const f32x4*>(sp + (size_t)r * ct.N));
    }
#pragma unroll
    for (int u = 0; u < 2; ++u) {
      unsigned char* cb = tile + u * 10240 + (tid & 31) * 4 * 80 + (tid >> 5) * 4;
#pragma unroll
      for (int c = 0; c < 4; ++c) *reinterpret_cast<unsigned*>(cb + c * 80) = pk4_f8_scaled<256>(v[u][0][c], v[u][1][c], v[u][2][c], v[u][3][c]);
    }
    __syncthreads();
#pragma unroll
    for (int u = 0; u < 2; ++u) {
      const CvtTile ct = cvt_tile(p, L, first + ib + CVT_IDLE_BLKS * (i + u));
      unsigned char* cd = ct.dst + (size_t)cvt_rowmap(ct.mat, ct.n0 + (tid >> 2)) * ct.K + ct.k0 + (tid & 3) * 16;
      *reinterpret_cast<uint4*>(cd) = *reinterpret_cast<const uint4*>(tile + u * 10240 + (tid >> 2) * 80 + (tid & 3) * 16);
    }
    __syncthreads();
  }
}

DI void ph_convert(const Params& p, char* smem) {
  const int nb = gridDim.x;
  int bid = obid();
  for (int idx = bid * NTHR + otid(); idx < SEQ * 56; idx += nb * NTHR) {
    const int pos = idx / 56, f = idx - pos * 56;
    float inv;
    if (f < 32) inv = exp2f(-(float)f * (13.287712379549449f / 32.f));
    else if (f < 40) inv = exp2f(-(float)(f - 32) * (18.931568569324174f / 8.f));
    else inv = exp2f(-(float)(f - 40) * (18.931568569324174f / 16.f));
    float sn, cs;
    sincosf((float)pos * inv, &sn, &cs);
    p.rtab()[(size_t)idx * 2] = cs;
    p.rtab()[(size_t)idx * 2 + 1] = sn;
  }
  auto ident = [](int n) { return n; };
  for (int L = 0; L < 2; ++L) {
    transpose_convert(p.w_in + (size_t)L * DM * PW, DM, PW, PWP, p.WinT() + (size_t)L * PWP * DM, ident, bid, nb, smem);
    transpose_convert(p.w_uq + (size_t)L * 256 * 384, 256, 384, 384, p.WuqT() + (size_t)L * 384 * 256, ident, bid, nb, smem);
    transpose_convert(p.w_ukv + (size_t)L * 128 * 512, 128, 512, 512, p.WukvT() + (size_t)L * 512 * 128, ident, bid, nb, smem);
    transpose_convert(p.w_out + (size_t)L * DM * DM, DM, DM, DM, p.WoutT() + (size_t)L * DM * DM, ident, bid, nb, smem);
    for (int e = ((nb == 256) ? CVT_IN_MLA_E : 0); e < 16; ++e) {
      const size_t le = (size_t)(L * 16 + e);
      auto gmap = [](int n) { return (n >> 7) * 256 + (n & 127); };
      auto umap = [](int n) { return (n >> 7) * 256 + 128 + (n & 127); };
      transpose_convert_f8(p.w_gate + le * DM * 2048, DM, 2048, p.Wgu8() + le * 4096 * DM, gmap, bid, nb, smem);
      transpose_convert_f8(p.w_up + le * DM * 2048, DM, 2048, p.Wgu8() + le * 4096 * DM, umap, bid, nb, smem);
      transpose_convert_f8(p.w_down + le * 2048 * DM, 2048, DM, p.Wd8() + le * DM * 2048, ident, bid, nb, smem);
    }
  }
}

template <class RowPtr, class Epi>
DI void gemm_tile(RowPtr arow, const u16* __restrict__ bt, int ldb, int K, char* smem, Epi epi) {
  u16* sa = reinterpret_cast<u16*>(smem);
  u16* sb = sa + 2 * 256 * 72;
  const int tid = otid(), wid = tid >> 6, lane = tid & 63, wr = wid >> 1, wc = wid & 1, fr = lane & 15, fq = lane >> 4;
  f32x4 acc[4][4];
#pragma unroll
  for (int m = 0; m < 4; ++m)
#pragma unroll
    for (int n = 0; n < 4; ++n) acc[m][n] = f32x4{0.f, 0.f, 0.f, 0.f};
  const int lr = tid >> 3, lc = (tid & 7) * 8;
  const u16* ap[4];
#pragma unroll
  for (int i = 0; i < 4; ++i) ap[i] = arow(lr + 64 * i) + lc;
  const u16* bp[2];
#pragma unroll
  for (int i = 0; i < 2; ++i) bp[i] = bt + (size_t)(lr + 64 * i) * ldb + lc;
  uint4 ra[4], rb[2];
  const int nk = K / 64;
#pragma unroll
  for (int i = 0; i < 4; ++i) ra[i] = *reinterpret_cast<const uint4*>(ap[i]);
#pragma unroll
  for (int i = 0; i < 2; ++i) rb[i] = *reinterpret_cast<const uint4*>(bp[i]);
#pragma unroll
  for (int i = 0; i < 4; ++i) *reinterpret_cast<uint4*>(sa + (lr + 64 * i) * 72 + lc) = ra[i];
#pragma unroll
  for (int i = 0; i < 2; ++i) *reinterpret_cast<uint4*>(sb + (lr + 64 * i) * 72 + lc) = rb[i];
  __syncthreads();
  for (int kt = 0; kt < nk; ++kt) {
    const int cur = kt & 1;
    if (kt + 1 < nk) {
#pragma unroll
      for (int i = 0; i < 4; ++i) ra[i] = *reinterpret_cast<const uint4*>(ap[i] + (kt + 1) * 64);
#pragma unroll
      for (int i = 0; i < 2; ++i) rb[i] = *reinterpret_cast<const uint4*>(bp[i] + (kt + 1) * 64);
    }
    const u16* ca = sa + cur * 256 * 72;
    const u16* cb = sb + cur * 128 * 72;
#pragma unroll
    for (int kk = 0; kk < 2; ++kk) {
      bf16x8 af[4], bfr[4];
#pragma unroll
      for (int m = 0; m < 4; ++m) af[m] = *reinterpret_cast<const bf16x8*>(ca + (wr * 64 + m * 16 + fr) * 72 + kk * 32 + fq * 8);
#pragma unroll
      for (int n = 0; n < 4; ++n) bfr[n] = *reinterpret_cast<const bf16x8*>(cb + (wc * 64 + n * 16 + fr) * 72 + kk * 32 + fq * 8);
#pragma unroll
      for (int m = 0; m < 4; ++m)
#pragma unroll
        for (int n = 0; n < 4; ++n) acc[m][n] = __builtin_amdgcn_mfma_f32_16x16x32_bf16(af[m], bfr[n], acc[m][n], 0, 0, 0);
    }
    if (kt + 1 < nk) {
      u16* na = sa + (cur ^ 1) * 256 * 72;
      u16* nbp = sb + (cur ^ 1) * 128 * 72;
#pragma unroll
      for (int i = 0; i < 4; ++i) *reinterpret_cast<uint4*>(na + (lr + 64 * i) * 72 + lc) = ra[i];
#pragma unroll
      for (int i = 0; i < 2; ++i) *reinterpret_cast<uint4*>(nbp + (lr + 64 * i) * 72 + lc) = rb[i];
    }
    __syncthreads();
  }
  epi(acc, wr, wc, fr, fq);
}

#define WAIT_V(n) asm volatile("s_waitcnt vmcnt(%0)" ::"n"(n) : "memory")
DI int lds_byte2(int r, int c) {
  const int st = (r >> 4) * 2 + (c >> 5), ob = (r & 15) * 64 + (c & 31) * 2;
  return st * 1024 + (ob ^ (((ob >> 9) & 1) << 5));
}
DI void stage_rc2(int b, int& R, int& C) {
  const int st = b >> 10, sb = b & 1023, swz = sb ^ (((sb >> 9) & 1) << 5);
  R = (st >> 1) * 16 + swz / 64;
  C = (st & 1) * 32 + (swz % 64) / 2;
}
typedef __attribute__((address_space(3))) unsigned lds_u32;
template <class RowPtr, class Epi>
DI void gemm256(RowPtr arow, const u16* __restrict__ bt, int ldb, int K, char* smem, Epi epi) {
  constexpr int TILE_B = 256 * 64 * 2, STAGE_B = 2 * TILE_B;
  const int tid = otid(), wid = tid >> 6, lane = tid & 63, wr = wid >> 2, wc = wid & 3, fr = lane & 15, fq = lane >> 4;
  const u16* ap[4];
  const u16* bp[4];
#pragma unroll
  for (int i = 0; i < 4; ++i) {
    int R, C;
    stage_rc2(wid * 1024 + i * 8192 + lane * 16, R, C);
    ap[i] = arow(R) + C;
    bp[i] = bt + (size_t)R * ldb + C;
  }
  f32x4 acc[8][4];
#pragma unroll
  for (int m = 0; m < 8; ++m)
#pragma unroll
    for (int n = 0; n < 4; ++n) acc[m][n] = f32x4{0.f, 0.f, 0.f, 0.f};
#define G2_STAGE(buf, kt)                                                                                              \
  do {                                                                                                                 \
    _Pragma("unroll") for (int i = 0; i < 4; ++i) {                                                                    \
      __builtin_amdgcn_global_load_lds((const unsigned*)(ap[i] + (kt) * 64),                                           \
                                       (lds_u32*)(smem + (buf) * STAGE_B + wid * 1024 + i * 8192), 16, 0, 0);          \
      __builtin_amdgcn_global_load_lds((const unsigned*)(bp[i] + (kt) * 64),                                           \
                                       (lds_u32*)(smem + (buf) * STAGE_B + TILE_B + wid * 1024 + i * 8192), 16, 0, 0); \
    }                                                                                                                  \
  } while (0)
  const int nt = K / 64;
  G2_STAGE(0, 0);
  WAIT_V(0);
  __syncthreads();
  for (int t = 0; t < nt; ++t) {
    const int cur = t & 1;
    if (t + 1 < nt) G2_STAGE(cur ^ 1, t + 1);
    const char* sA = smem + cur * STAGE_B;
    const char* sB = sA + TILE_B;
#pragma unroll
    for (int ks = 0; ks < 2; ++ks) {
      bf16x8 At[8], Bf[4];
#pragma unroll
      for (int m = 0; m < 8; ++m) At[m] = *reinterpret_cast<const bf16x8*>(sA + lds_byte2(wr * 128 + m * 16 + fr, ks * 32 + fq * 8));
#pragma unroll
      for (int n = 0; n < 4; ++n) Bf[n] = *reinterpret_cast<const bf16x8*>(sB + lds_byte2(wc * 64 + n * 16 + fr, ks * 32 + fq * 8));
#pragma unroll
      for (int m = 0; m < 8; ++m)
#pragma unroll
        for (int n = 0; n < 4; ++n) acc[m][n] = __builtin_amdgcn_mfma_f32_16x16x32_bf16(Bf[n], At[m], acc[m][n], 0, 0, 0);
      __builtin_amdgcn_sched_barrier(0);
    }
    WAIT_V(0);
    __syncthreads();
  }
  epi(acc, wr, wc, fr, fq);
}

namespace pg8 {
constexpr int BM = 256, BK = 64, HALF = 128, HTB = HALF * BK * 2;
DI int lds_byte(int r, int c) { const int st = (r >> 4) * 2 + (c >> 5), rr = r & 15, cc = c & 31, ob = rr * 64 + cc * 2; return st * 1024 + (ob ^ (((ob >> 9) & 1) << 5)); }
DI void stage_rc(int b, int& R, int& C) { const int st = b / 1024, sb = b % 1024, swz = sb ^ (((sb >> 9) & 1) << 5); R = (st >> 1) * 16 + swz / 64; C = (st & 1) * 32 + (swz % 64) / 2; }
DI int perm32(int rho) { const int n = rho >> 4, i = rho & 15; return 8 * (i >> 2) + 4 * n + (i & 3); }
struct Unit { int pm, pn; };
typedef __attribute__((address_space(3))) unsigned char lds_u8;
typedef __attribute__((address_space(3))) unsigned lds_u32;
typedef __attribute__((address_space(3))) bf16x8 lds_bf16x8;
typedef __attribute__((address_space(3))) i32x4 lds_i32x4;

template <class Cfg>
DI void gemm_phase(lds_u8* lds, const Cfg& S) {
  const int tid = otid(), wid = __builtin_amdgcn_readfirstlane(tid >> 6), lane = tid & 63, wr = wid >> 2, wc = wid & 3, fr = lane & 15, fq = lane >> 4;
  const int K = S.K, nt = K / BK;
  int R0, C0, R1, C1;
  stage_rc(tid * 16, R0, C0);
  stage_rc(tid * 16 + 8192, R1, C1);
  unsigned voffB[2];
  {
    const int Rb0 = Cfg::PERM ? ((R0 & ~31) + perm32(R0 & 31)) : R0, Rb1 = Cfg::PERM ? ((R1 & ~31) + perm32(R1 & 31)) : R1;
    voffB[0] = (unsigned)(Rb0 * K + C0) * 2u; voffB[1] = (unsigned)(Rb1 * K + C1) * 2u;
  }
  const size_t kstep = (size_t)(BK * 2);
  const size_t hstep = (size_t)HALF * K * 2;
  const unsigned ldsw = (unsigned)wid * 1024u;
  const int aoff = lds_byte(wr * 64 + fr, fq * 8), boff = lds_byte(wc * 32 + fr, fq * 8);
#define PG8_SA(b, h) (((b) * 2 + (h)) * HTB)
#define PG8_SB(b, h) ((4 + (b) * 2 + (h)) * HTB)
#define PG8_STAGE2(bufoff, gbase, o0, o1) do { \
    __builtin_amdgcn_global_load_lds((const unsigned*)((const char*)(gbase) + (o0)), (lds_u32*)(lds + (bufoff) + ldsw), 16, 0, 0); \
    __builtin_amdgcn_global_load_lds((const unsigned*)((const char*)(gbase) + (o1)), (lds_u32*)(lds + (bufoff) + ldsw + 8192), 16, 0, 0); } while (0)
#define PG8_STAGEB(bufoff, gbase) PG8_STAGE2(bufoff, gbase, voffB[0], voffB[1])
#define PG8_LDA(dst, b, h) do { _Pragma("unroll") for (int m = 0; m < 4; ++m) _Pragma("unroll") for (int k = 0; k < 2; ++k) dst[m][k] = *(const lds_bf16x8*)(lds + PG8_SA(b, h) + aoff + m * 2048 + k * 1024); } while (0)
#define PG8_LDB(dst, b, h) do { _Pragma("unroll") for (int n = 0; n < 2; ++n) _Pragma("unroll") for (int k = 0; k < 2; ++k) dst[n][k] = *(const lds_bf16x8*)(lds + PG8_SB(b, h) + boff + n * 2048 + k * 1024); } while (0)
#define PG8_MMA(ai, bj, At, Bt) do { __builtin_amdgcn_s_setprio(1); _Pragma("unroll") for (int m = 0; m < 4; ++m) _Pragma("unroll") for (int n = 0; n < 2; ++n) _Pragma("unroll") for (int k = 0; k < 2; ++k) \
    acc[ai][bj][m][n] = __builtin_amdgcn_mfma_f32_16x16x32_bf16(Bt[n][k], At[m][k], acc[ai][bj][m][n], 0, 0, 0); __builtin_amdgcn_s_setprio(0); } while (0)
#define PG8_WAIT_V(n) asm volatile("s_waitcnt vmcnt(" #n ")" ::: "memory")
#define PG8_WAIT_L(n) asm volatile("s_waitcnt lgkmcnt(" #n ")" ::: "memory")
#define PG8_BAR __builtin_amdgcn_s_barrier()
#define PG8_SCHED __builtin_amdgcn_sched_barrier(0)
  Unit cur, nxt; int ui = 0;
  if (!S.next(0, cur)) return;
  f32x4 acc[2][2][4][2];
#pragma unroll
  for (int a = 0; a < 2; ++a)
#pragma unroll
    for (int b = 0; b < 2; ++b)
#pragma unroll
      for (int m = 0; m < 4; ++m)
#pragma unroll
        for (int n = 0; n < 2; ++n) acc[a][b][m][n] = f32x4{0.f, 0.f, 0.f, 0.f};
  bf16x8 At[4][2], B0[2][2], B1[2][2];
  const char* cA = S.a_base(cur);
  const char* cB = S.b_base(cur);
  unsigned vc[4], vn[4];
  S.a_off(cur, R0, C0, R1, C1, vc);
  PG8_STAGEB(PG8_SB(0, 0), cB); PG8_STAGE2(PG8_SA(0, 0), cA, vc[0], vc[1]); PG8_STAGEB(PG8_SB(0, 1), cB + hstep); PG8_STAGE2(PG8_SA(0, 1), cA, vc[2], vc[3]);
  if (wr == 1) PG8_BAR;
  PG8_WAIT_V(4); PG8_BAR;
  PG8_STAGEB(PG8_SB(1, 0), cB + kstep); PG8_STAGE2(PG8_SA(1, 0), cA + kstep, vc[0], vc[1]); PG8_STAGEB(PG8_SB(1, 1), cB + hstep + kstep);
  PG8_WAIT_V(6); PG8_BAR;
  for (;;) {
    const bool has_next = S.next(ui + 1, nxt);
    const char* nA = has_next ? S.a_base(nxt) : cA;
    const char* nB = has_next ? S.b_base(nxt) : cB;
    if (has_next) S.a_off(nxt, R0, C0, R1, C1, vn);
    else { vn[0] = vc[0]; vn[1] = vc[1]; vn[2] = vc[2]; vn[3] = vc[3]; }
    for (int t = 0; t < nt; t += 2) {
      const bool last = (t == nt - 2);
      const char* a1 = cA + (size_t)(t + 1) * kstep;
      const char* a2 = last ? nA : cA + (size_t)(t + 2) * kstep;
      const char* b2 = last ? nB : cB + (size_t)(t + 2) * kstep;
      const char* a3 = a2 + kstep;
      const char* b3 = b2 + kstep;
      const unsigned w0 = last ? vn[0] : vc[0], w1 = last ? vn[1] : vc[1], w2 = last ? vn[2] : vc[2], w3 = last ? vn[3] : vc[3];
      PG8_LDB(B0, 0, 0); PG8_SCHED; PG8_LDA(At, 0, 0); PG8_STAGE2(PG8_SA(1, 1), a1, vc[2], vc[3]);
      PG8_WAIT_L(8); PG8_BAR; PG8_WAIT_L(0); PG8_MMA(0, 0, At, B0); PG8_BAR; PG8_SCHED;
      PG8_LDB(B1, 0, 1); PG8_STAGEB(PG8_SB(0, 0), b2);
      PG8_BAR; PG8_WAIT_L(0); PG8_MMA(0, 1, At, B1); PG8_BAR;
      PG8_LDA(At, 0, 1); PG8_STAGE2(PG8_SA(0, 0), a2, w0, w1);
      PG8_BAR; PG8_WAIT_L(0); PG8_MMA(1, 0, At, B0); PG8_BAR; PG8_SCHED;
      PG8_STAGEB(PG8_SB(0, 1), b2 + hstep);
      PG8_WAIT_V(6); PG8_BAR; PG8_MMA(1, 1, At, B1); PG8_BAR;
      PG8_LDB(B0, 1, 0); PG8_SCHED; PG8_LDA(At, 1, 0); PG8_STAGE2(PG8_SA(0, 1), a2, w2, w3);
      PG8_WAIT_L(8); PG8_BAR; PG8_WAIT_L(0); PG8_MMA(0, 0, At, B0); PG8_BAR; PG8_SCHED;
      PG8_LDB(B1, 1, 1); PG8_STAGEB(PG8_SB(1, 0), b3);
      PG8_BAR; PG8_WAIT_L(0); PG8_MMA(0, 1, At, B1); PG8_BAR;
      PG8_LDA(At, 1, 1); PG8_STAGE2(PG8_SA(1, 0), a3, w0, w1);
      PG8_BAR; PG8_WAIT_L(0); PG8_MMA(1, 0, At, B0); PG8_BAR; PG8_SCHED;
      PG8_STAGEB(PG8_SB(1, 1), b3 + hstep);
      PG8_WAIT_V(6); PG8_BAR; PG8_MMA(1, 1, At, B1); PG8_BAR;
    }
    S.epi(acc, cur, wr, wc, fr, fq);
    if (!has_next) break;
#pragma unroll
    for (int a = 0; a < 2; ++a)
#pragma unroll
      for (int b = 0; b < 2; ++b)
#pragma unroll
        for (int m = 0; m < 4; ++m)
#pragma unroll
          for (int n = 0; n < 2; ++n) acc[a][b][m][n] = f32x4{0.f, 0.f, 0.f, 0.f};
    cur = nxt; cA = nA; cB = nB; ++ui;
    vc[0] = vn[0]; vc[1] = vn[1]; vc[2] = vn[2]; vc[3] = vn[3];
  }
  PG8_WAIT_V(0);
  if (wr == 0) PG8_BAR;
  PG8_BAR;
#undef PG8_SA
#undef PG8_SB
#undef PG8_STAGE2
#undef PG8_STAGEB
#undef PG8_LDA
#undef PG8_LDB
#undef PG8_MMA
#undef PG8_WAIT_V
#undef PG8_WAIT_L
#undef PG8_BAR
#undef PG8_SCHED
}
template <class Cfg>
DI void gemm_phase_f8(lds_u8* lds, const Cfg& S) {
  const int tid = otid(), wid = __builtin_amdgcn_readfirstlane(tid >> 6), lane = tid & 63, wr = wid >> 2, wc = wid & 3, fr = lane & 15, fq = lane >> 4;
  const int K = S.K, nt = K / BK;
  int R0, C0, R1, C1;
  stage_rc(tid * 16, R0, C0);
  stage_rc(tid * 16 + 8192, R1, C1);
  unsigned voffB[2];
  {
    const int Rb0 = Cfg::PERM ? ((R0 & ~31) + perm32(R0 & 31)) : R0, Rb1 = Cfg::PERM ? ((R1 & ~31) + perm32(R1 & 31)) : R1;
    voffB[0] = (unsigned)(Rb0 * K + C0) * 2u; voffB[1] = (unsigned)(Rb1 * K + C1) * 2u;
  }
  const size_t kstep = (size_t)(BK * 2);
  const size_t hstep = (size_t)HALF * K * 2;
  const unsigned ldsw = (unsigned)wid * 1024u;
  const int cl = 2 * fq + (fq & 1), ch = 2 * fq + 1 - (fq & 1);
  const int aoffL = lds_byte(wr * 64 + fr, cl * 8), aoffH = lds_byte(wr * 64 + fr, ch * 8);
  const int boffL = lds_byte(wc * 32 + fr, cl * 8), boffH = lds_byte(wc * 32 + fr, ch * 8);
#define PG8_SA(b, h) (((b) * 2 + (h)) * HTB)
#define PG8_SB(b, h) ((4 + (b) * 2 + (h)) * HTB)
#define PG8_STAGE2(bufoff, gbase, o0, o1) do { \
    __builtin_amdgcn_global_load_lds((const unsigned*)((const char*)(gbase) + (o0)), (lds_u32*)(lds + (bufoff) + ldsw), 16, 0, 0); \
    __builtin_amdgcn_global_load_lds((const unsigned*)((const char*)(gbase) + (o1)), (lds_u32*)(lds + (bufoff) + ldsw + 8192), 16, 0, 0); } while (0)
#define PG8_STAGEB(bufoff, gbase) PG8_STAGE2(bufoff, gbase, voffB[0], voffB[1])
#define PG8_LDA(dst, b, h) do { _Pragma("unroll") for (int m = 0; m < 4; ++m) { const i32x4 lo_ = *(const lds_i32x4*)(lds + PG8_SA(b, h) + aoffL + m * 2048), hi_ = *(const lds_i32x4*)(lds + PG8_SA(b, h) + aoffH + m * 2048); dst[m] = __builtin_shufflevector(lo_, hi_, 0, 1, 2, 3, 4, 5, 6, 7); } } while (0)
#define PG8_LDB(dst, b, h) do { _Pragma("unroll") for (int n = 0; n < 2; ++n) { const i32x4 lo_ = *(const lds_i32x4*)(lds + PG8_SB(b, h) + boffL + n * 2048), hi_ = *(const lds_i32x4*)(lds + PG8_SB(b, h) + boffH + n * 2048); dst[n] = __builtin_shufflevector(lo_, hi_, 0, 1, 2, 3, 4, 5, 6, 7); } } while (0)
#define PG8_MMA(ai, bj, At, Bt) do { __builtin_amdgcn_s_setprio(1); _Pragma("unroll") for (int m = 0; m < 4; ++m) _Pragma("unroll") for (int n = 0; n < 2; ++n) \
    asm volatile("v_mfma_f32_16x16x128_f8f6f4 %0, %1, %2, %0" : "+v"(acc[ai][bj][m][n]) : "v"(Bt[n]), "v"(At[m])); __builtin_amdgcn_s_setprio(0); } while (0)
#define PG8_WAIT_V(n) asm volatile("s_waitcnt vmcnt(" #n ")" ::: "memory")
#define PG8_WAIT_L(n) asm volatile("s_waitcnt lgkmcnt(" #n ")" ::: "memory")
#define PG8_BAR __builtin_amdgcn_s_barrier()
#define PG8_SCHED __builtin_amdgcn_sched_barrier(0)
  Unit cur, nxt; int ui = 0;
  if (!S.next(0, cur)) return;
  f32x4 acc[2][2][4][2];
#pragma unroll
  for (int a = 0; a < 2; ++a)
#pragma unroll
    for (int b = 0; b < 2; ++b)
#pragma unroll
      for (int m = 0; m < 4; ++m)
#pragma unroll
        for (int n = 0; n < 2; ++n) acc[a][b][m][n] = f32x4{0.f, 0.f, 0.f, 0.f};
  i32x8 At[4], B0[2], B1[2];
  const char* cA = S.a_base(cur);
  const char* cB = S.b_base(cur);
  unsigned vc[4], vn[4];
  S.a_off(cur, R0, C0, R1, C1, vc, 0);
  PG8_STAGEB(PG8_SB(0, 0), cB); PG8_STAGE2(PG8_SA(0, 0), cA, vc[0], vc[1]); PG8_STAGEB(PG8_SB(0, 1), cB + hstep); PG8_STAGE2(PG8_SA(0, 1), cA, vc[2], vc[3]);
  if (wr == 1) PG8_BAR;
  PG8_WAIT_V(4); PG8_BAR;
  PG8_STAGEB(PG8_SB(1, 0), cB + kstep); PG8_STAGE2(PG8_SA(1, 0), cA + kstep, vc[0], vc[1]); PG8_STAGEB(PG8_SB(1, 1), cB + hstep + kstep);
  PG8_WAIT_V(6); PG8_BAR;
  for (;;) {
    const bool has_next = S.next(ui + 1, nxt);
    const char* nA = has_next ? S.a_base(nxt) : cA;
    const char* nB = has_next ? S.b_base(nxt) : cB;
    if (has_next) S.a_off(nxt, R0, C0, R1, C1, vn, ui + 1);
    else { vn[0] = vc[0]; vn[1] = vc[1]; vn[2] = vc[2]; vn[3] = vc[3]; }
    for (int t = 0; t < nt; t += 2) {
      const bool last = (t == nt - 2);
      const char* a1 = cA + (size_t)(t + 1) * kstep;
      const char* a2 = last ? nA : cA + (size_t)(t + 2) * kstep;
      const char* b2 = last ? nB : cB + (size_t)(t + 2) * kstep;
      const char* a3 = a2 + kstep;
      const char* b3 = b2 + kstep;
      const unsigned w0 = last ? vn[0] : vc[0], w1 = last ? vn[1] : vc[1], w2 = last ? vn[2] : vc[2], w3 = last ? vn[3] : vc[3];
      PG8_LDB(B0, 0, 0); PG8_SCHED; PG8_LDA(At, 0, 0); PG8_STAGE2(PG8_SA(1, 1), a1, vc[2], vc[3]);
      PG8_WAIT_L(8); PG8_BAR; PG8_WAIT_L(0); PG8_MMA(0, 0, At, B0); PG8_BAR; PG8_SCHED;
      PG8_LDB(B1, 0, 1); PG8_STAGEB(PG8_SB(0, 0), b2);
      PG8_BAR; PG8_WAIT_L(0); PG8_MMA(0, 1, At, B1); PG8_BAR;
      PG8_LDA(At, 0, 1); PG8_STAGE2(PG8_SA(0, 0), a2, w0, w1);
      PG8_BAR; PG8_WAIT_L(0); PG8_MMA(1, 0, At, B0); PG8_BAR; PG8_SCHED;
      PG8_STAGEB(PG8_SB(0, 1), b2 + hstep);
      PG8_WAIT_V(6); PG8_BAR; PG8_MMA(1, 1, At, B1); PG8_BAR;
      PG8_LDB(B0, 1, 0); PG8_SCHED; PG8_LDA(At, 1, 0); PG8_STAGE2(PG8_SA(0, 1), a2, w2, w3);
      PG8_WAIT_L(8); PG8_BAR; PG8_WAIT_L(0); PG8_MMA(0, 0, At, B0); PG8_BAR; PG8_SCHED;
      PG8_LDB(B1, 1, 1); PG8_STAGEB(PG8_SB(1, 0), b3);
      PG8_BAR; PG8_WAIT_L(0); PG8_MMA(0, 1, At, B1); PG8_BAR;
      PG8_LDA(At, 1, 1); PG8_STAGE2(PG8_SA(1, 0), a3, w0, w1);
      PG8_BAR; PG8_WAIT_L(0); PG8_MMA(1, 0, At, B0); PG8_BAR; PG8_SCHED;
      PG8_STAGEB(PG8_SB(1, 1), b3 + hstep);
      PG8_WAIT_V(6); PG8_BAR; PG8_MMA(1, 1, At, B1); PG8_BAR;
    }
    asm volatile("s_nop 15\n\ts_nop 15" ::: "memory");
    S.epi(acc, cur, wr, wc, fr, fq);
    if (!has_next) break;
#pragma unroll
    for (int a = 0; a < 2; ++a)
#pragma unroll
      for (int b = 0; b < 2; ++b)
#pragma unroll
        for (int m = 0; m < 4; ++m)
#pragma unroll
          for (int n = 0; n < 2; ++n) acc[a][b][m][n] = f32x4{0.f, 0.f, 0.f, 0.f};
    cur = nxt; cA = nA; cB = nB; ++ui;
    vc[0] = vn[0]; vc[1] = vn[1]; vc[2] = vn[2]; vc[3] = vn[3];
  }
  PG8_WAIT_V(0);
  if (wr == 0) PG8_BAR;
  PG8_BAR;
#undef PG8_SA
#undef PG8_SB
#undef PG8_STAGE2
#undef PG8_STAGEB
#undef PG8_LDA
#undef PG8_LDB
#undef PG8_MMA
#undef PG8_WAIT_V
#undef PG8_WAIT_L
#undef PG8_BAR
#undef PG8_SCHED
}
}

struct CfgInproj {
  static constexpr bool PERM = true;
  int K; const Params* p; int L; int bid, nb;
  DI bool next(int i, pg8::Unit& u) const { const int t = i * nb + bid; if (t >= 64 * 13) return false; u.pm = t & 63; u.pn = t >> 6; return true; }
  DI const char* a_base(const pg8::Unit& u) const { return (const char*)(p->hn() + (size_t)u.pm * 256 * DM); }
  DI const char* b_base(const pg8::Unit& u) const { return (const char*)(p->WinT() + ((size_t)L * PWP + (size_t)u.pn * 256) * DM); }
  DI void a_off(const pg8::Unit&, int R0, int C0, int R1, int C1, unsigned (&vo)[4]) const {
    vo[0] = (unsigned)(R0 * DM + C0) * 2u; vo[1] = (unsigned)(R1 * DM + C1) * 2u;
    vo[2] = vo[0] + 128u * DM * 2u; vo[3] = vo[1] + 128u * DM * 2u;
  }
  DI void epi(const f32x4 (&acc)[2][2][4][2], const pg8::Unit& u, int wr, int wc, int fr, int fq) const {
    const int row0 = u.pm * 256 + wr * 64 + fr, col0 = u.pn * 256 + wc * 32 + 8 * fq;
#pragma unroll
    for (int ai = 0; ai < 2; ++ai)
#pragma unroll
      for (int m = 0; m < 4; ++m) {
        u16* rowp = p->proj() + (size_t)(row0 + ai * 128 + m * 16) * PWP + col0;
#pragma unroll
        for (int bj = 0; bj < 2; ++bj) {
          uint4 w;
          w.x = pack2(acc[ai][bj][m][0][0], acc[ai][bj][m][0][1]); w.y = pack2(acc[ai][bj][m][0][2], acc[ai][bj][m][0][3]);
          w.z = pack2(acc[ai][bj][m][1][0], acc[ai][bj][m][1][1]); w.w = pack2(acc[ai][bj][m][1][2], acc[ai][bj][m][1][3]);
          *reinterpret_cast<uint4*>(rowp + bj * 128) = w;
        }
      }
  }
};
DI void ph_inproj_tail(const Params& p, int L, char* smem, int t) {
  const int m0 = (t & 63) * 256, n0 = 3072 + (t >> 6) * 128;
  const u16* Bt = p.WinT() + ((size_t)L * PWP + n0) * DM;
  gemm_tile([&](int r) { return p.hn() + (size_t)(m0 + r) * DM; }, Bt, DM, DM, smem,
            [&](f32x4 (&acc)[4][4], int wr, int wc, int fr, int fq) {
#pragma unroll
              for (int m = 0; m < 4; ++m)
#pragma unroll
                for (int n = 0; n < 4; ++n)
#pragma unroll
                  for (int j = 0; j < 4; ++j)
                    p.proj()[(size_t)(m0 + wr * 64 + m * 16 + fq * 4 + j) * PWP + n0 + wc * 64 + n * 16 + fr] = f2bf(acc[m][n][j]);
            });
}
DI void ph_inproj(const Params& p, int L, char* smem) {
  CfgInproj c; c.K = DM; c.p = &p; c.L = L; c.bid = obid(); c.nb = gridDim.x;
  pg8::gemm_phase((pg8::lds_u8*)smem, c);
  if (gridDim.x == 256 && obid() >= CVT_IDLE_FIRST_BLK) cvt_tiles_idle(p, L, smem, 0, CVT_NA);
}

DI void ph_gemm_store_bf16(const u16* A, int lda, const u16* Bt, int K, int M, int N, u16* C, int ldc, char* smem, int rot) {
  const int mt = M / 256, nt = N / 128;
  const int nb = gridDim.x;
  for (int t = (obid() + rot) % nb; t < mt * nt; t += nb) {
    const int m0 = (t % mt) * 256, n0 = (t / mt) * 128;
    gemm_tile([&](int r) { return A + (size_t)(m0 + r) * lda; }, Bt + (size_t)n0 * K, K, K, smem,
              [&](f32x4 (&acc)[4][4], int wr, int wc, int fr, int fq) {
#pragma unroll
                for (int m = 0; m < 4; ++m)
#pragma unroll
                  for (int n = 0; n < 4; ++n)
#pragma unroll
                    for (int j = 0; j < 4; ++j) {
                      const int row = m0 + wr * 64 + m * 16 + fq * 4 + j, col = n0 + wc * 64 + n * 16 + fr;
                      C[(size_t)row * ldc + col] = f2bf(acc[m][n][j]);
                    }
              });
  }
}

DI void ph_rmsnorm_bf16(const float* __restrict__ xin, const float* __restrict__ w, u16* __restrict__ outp) {
  const int tid_ = otid(); const int lane = tid_ & 63, gw = (obid() * NTHR + tid_) >> 6, nw = gridDim.x * (NTHR / 64);
  for (int t = gw; t < T; t += nw) {
    const float* xr = xin + (size_t)t * DM;
    float4 v[4];
    float ss = 0.f;
#pragma unroll
    for (int i = 0; i < 4; ++i) {
      v[i] = *reinterpret_cast<const float4*>(xr + (i * 64 + lane) * 4);
      ss += v[i].x * v[i].x + v[i].y * v[i].y + v[i].z * v[i].z + v[i].w * v[i].w;
    }
    ss = wave_sum(ss);
    const float rstd = rsqrtf(ss * (1.f / DM) + 1e-6f);
#pragma unroll
    for (int i = 0; i < 4; ++i) {
      const int c = (i * 64 + lane) * 4;
      const float4 ww = *reinterpret_cast<const float4*>(w + c);
      uint2 o;
      o.x = pack2(v[i].x * rstd * ww.x, v[i].y * rstd * ww.y);
      o.y = pack2(v[i].z * rstd * ww.z, v[i].w * rstd * ww.w);
      *reinterpret_cast<uint2*>(outp + (size_t)t * DM + c) = o;
    }
  }
}

DI void ph_final_norm(const float* __restrict__ xin, const float* __restrict__ w, float* __restrict__ outp) {
  const int tid_ = otid(); const int lane = tid_ & 63, gw = (obid() * NTHR + tid_) >> 6, nw = gridDim.x * (NTHR / 64);
  for (int t = gw; t < T; t += nw) {
    const float* xr = xin + (size_t)t * DM;
    float4 v[4];
    float ss = 0.f;
#pragma unroll
    for (int i = 0; i < 4; ++i) {
      v[i] = *reinterpret_cast<const float4*>(xr + (i * 64 + lane) * 4);
      ss += v[i].x * v[i].x + v[i].y * v[i].y + v[i].z * v[i].z + v[i].w * v[i].w;
    }
    ss = wave_sum(ss);
    const float rstd = rsqrtf(ss * (1.f / DM) + 1e-6f);
#pragma unroll
    for (int i = 0; i < 4; ++i) {
      const int c = (i * 64 + lane) * 4;
      const float4 ww = *reinterpret_cast<const float4*>(w + c);
      float4 o = make_float4(v[i].x * rstd * ww.x, v[i].y * rstd * ww.y, v[i].z * rstd * ww.z, v[i].w * rstd * ww.w);
      *reinterpret_cast<float4*>(outp + (size_t)t * DM + c) = o;
    }
  }
}

DI void rot8(const u16* x1p, const u16* x2p, const float* tab  , float scale, uint4& o1, uint4& o2) {
  float x1[8], x2[8], y1[8], y2[8];
  ld8(x1p, x1); ld8(x2p, x2);
#pragma unroll
  for (int e = 0; e < 8; e += 2) {
    const float4 cs = *reinterpret_cast<const float4*>(tab + e * 2);
    y1[e] = (x1[e] * cs.x - x2[e] * cs.y) * scale;
    y2[e] = (x2[e] * cs.x + x1[e] * cs.y) * scale;
    y1[e + 1] = (x1[e + 1] * cs.z - x2[e + 1] * cs.w) * scale;
    y2[e + 1] = (x2[e + 1] * cs.z + x1[e + 1] * cs.w) * scale;
  }
  o1.x = pack2(y1[0], y1[1]); o1.y = pack2(y1[2], y1[3]); o1.z = pack2(y1[4], y1[5]); o1.w = pack2(y1[6], y1[7]);
  o2.x = pack2(y2[0], y2[1]); o2.y = pack2(y2[2], y2[3]); o2.z = pack2(y2[4], y2[5]); o2.w = pack2(y2[6], y2[7]);
}
DI void ph_post(const Params& p, int L) {
  const int tid = otid();
  const int gt = obid() * NTHR + tid, gs = gridDim.x * NTHR;
  const int lane = tid & 63, gw = gt >> 6, nw = gs >> 6;
  const float* qnw = p.q_norm_w + L * 256;
  const float* kvnw = p.kv_norm_w + L * 128;
  const float* cw = p.conv_w + L * 5 * 768;
  const float* cb = p.conv_b + L * 768;
  const float* dtb = p.dt_bias + L * 8;
  {
    uint4 xr[5];
    auto load_taps = [&](int idx, uint4 (&r)[5]) {
      const int t = idx / 96, cg = idx - t * 96, s = t & (SEQ - 1);
#pragma unroll
      for (int w = 0; w < 5; ++w) {
        const int ss = s + w - 2;
        const int tt = (ss >= 0 && ss < SEQ) ? (t + w - 2) : t;
        r[w] = *reinterpret_cast<const uint4*>(p.proj() + (size_t)tt * PWP + C_XBC + cg * 8);
      }
    };
    if (gt < T * 96) load_taps(gt, xr);
    for (int idx = gt; idx < T * 96; idx += gs) {
      const int t = idx / 96, cg = idx - t * 96, s = t & (SEQ - 1);
      uint4 xn[5];
      const int idn = (idx + gs < T * 96) ? (idx + gs) : idx;
      load_taps(idn, xn);
      float acc[8];
      {
        const float4 b0 = *reinterpret_cast<const float4*>(cb + cg * 8), b1 = *reinterpret_cast<const float4*>(cb + cg * 8 + 4);
        acc[0] = b0.x; acc[1] = b0.y; acc[2] = b0.z; acc[3] = b0.w; acc[4] = b1.x; acc[5] = b1.y; acc[6] = b1.z; acc[7] = b1.w;
      }
#pragma unroll
      for (int w = 0; w < 5; ++w) {
        const int ss = s + w - 2;
        const float msk = (ss >= 0 && ss < SEQ) ? 1.f : 0.f;
        float xv[8];
        unpack8(xr[w], xv);
        const float4 w0 = *reinterpret_cast<const float4*>(cw + w * 768 + cg * 8), w1 = *reinterpret_cast<const float4*>(cw + w * 768 + cg * 8 + 4);
        acc[0] += msk * xv[0] * w0.x; acc[1] += msk * xv[1] * w0.y; acc[2] += msk * xv[2] * w0.z; acc[3] += msk * xv[3] * w0.w;
        acc[4] += msk * xv[4] * w1.x; acc[5] += msk * xv[5] * w1.y; acc[6] += msk * xv[6] * w1.z; acc[7] += msk * xv[7] * w1.w;
      }
      uint4 o;
      o.x = pack2(fast_silu(acc[0]), fast_silu(acc[1])); o.y = pack2(fast_silu(acc[2]), fast_silu(acc[3]));
      o.z = pack2(fast_silu(acc[4]), fast_silu(acc[5])); o.w = pack2(fast_silu(acc[6]), fast_silu(acc[7]));
      *reinterpret_cast<uint4*>(p.xbc() + (size_t)t * 768 + cg * 8) = o;
#pragma unroll
      for (int w = 0; w < 5; ++w) xr[w] = xn[w];
    }
  }
  for (int idx = gt; idx < T * 8; idx += gs) {
    const int t = idx >> 3, k = idx & 7;
    const float v = bf2f(p.proj()[(size_t)t * PWP + C_DT + k]) + dtb[k];
    p.dtv()[idx] = (v > 20.f) ? v : log1pf(expf(v));
  }
  {
    const int sub = lane >> 4, l16 = lane & 15;
    for (int t = gw * 4 + sub; t < T; t += nw * 4) {
      const u16* pr = p.proj() + (size_t)t * PWP;
      float v[16], u[8];
      ld8(pr + C_CQ + l16 * 16, v); ld8(pr + C_CQ + l16 * 16 + 8, v + 8);
      ld8(pr + C_CKV + l16 * 8, u);
      float ss = 0.f, s2 = 0.f;
#pragma unroll
      for (int i = 0; i < 16; ++i) ss += v[i] * v[i];
#pragma unroll
      for (int i = 0; i < 8; ++i) s2 += u[i] * u[i];
#pragma unroll
      for (int o = 1; o < 16; o <<= 1) { ss += __shfl_xor(ss, o); s2 += __shfl_xor(s2, o); }
      const float rstd = rsqrtf(ss * (1.f / 256.f) + 1e-6f), r2 = rsqrtf(s2 * (1.f / 128.f) + 1e-6f);
      uint4 o;
      const float* qw = qnw + l16 * 16;
      o.x = pack2(v[0] * rstd * qw[0], v[1] * rstd * qw[1]); o.y = pack2(v[2] * rstd * qw[2], v[3] * rstd * qw[3]);
      o.z = pack2(v[4] * rstd * qw[4], v[5] * rstd * qw[5]); o.w = pack2(v[6] * rstd * qw[6], v[7] * rstd * qw[7]);
      *reinterpret_cast<uint4*>(p.cqn() + (size_t)t * 256 + l16 * 16) = o;
      o.x = pack2(v[8] * rstd * qw[8], v[9] * rstd * qw[9]); o.y = pack2(v[10] * rstd * qw[10], v[11] * rstd * qw[11]);
      o.z = pack2(v[12] * rstd * qw[12], v[13] * rstd * qw[13]); o.w = pack2(v[14] * rstd * qw[14], v[15] * rstd * qw[15]);
      *reinterpret_cast<uint4*>(p.cqn() + (size_t)t * 256 + l16 * 16 + 8) = o;
      const float* kw = kvnw + l16 * 8;
      o.x = pack2(u[0] * r2 * kw[0], u[1] * r2 * kw[1]); o.y = pack2(u[2] * r2 * kw[2], u[3] * r2 * kw[3]);
      o.z = pack2(u[4] * r2 * kw[4], u[5] * r2 * kw[5]); o.w = pack2(u[6] * r2 * kw[6], u[7] * r2 * kw[7]);
      *reinterpret_cast<uint4*>(p.ckvn() + (size_t)t * 128 + l16 * 8) = o;
    }
  }
  {
    auto item_of = [&](int idx, u16*& a, int& off2, int& tabo, float& scale, int& krope_i0) {
      const int t = idx / 42, ri = idx - t * 42, s = t & (SEQ - 1);
      u16* pr = p.proj() + (size_t)t * PWP;
      krope_i0 = -1;
      if (ri < 32) {
        const int isk = ri >> 4, h = (ri >> 2) & 3, i0 = (ri & 3) * 8;
        a = pr + (isk ? C_RK : C_RQ) + h * 64 + i0; off2 = 32; tabo = (s * 56 + i0) * 2; scale = isk ? 1.f : 0.125f;
      } else if (ri < 40) {
        const int j = ri - 32, isk = j >> 2, h = j & 3;
        a = pr + (isk ? C_DK : C_DQ) + h * 64; off2 = 8; tabo = (s * 56 + 32) * 2; scale = 1.f;
      } else {
        const int i0 = (ri - 40) * 8;
        a = pr + C_KR + i0; off2 = 16; tabo = (s * 56 + 40 + i0) * 2; scale = 1.f; krope_i0 = i0;
      }
    };
    uint4 x1c = make_uint4(0, 0, 0, 0), x2c = make_uint4(0, 0, 0, 0);
    if (gt < T * 42) {
      u16* a; int off2, tabo, ki; float sc;
      item_of(gt, a, off2, tabo, sc, ki);
      x1c = *reinterpret_cast<const uint4*>(a); x2c = *reinterpret_cast<const uint4*>(a + off2);
    }
    for (int idx = gt; idx < T * 42; idx += gs) {
      u16* a; int off2, tabo, ki; float scale;
      item_of(idx, a, off2, tabo, scale, ki);
      uint4 x1n, x2n;
      {
        const int idn = (idx + gs < T * 42) ? (idx + gs) : idx;
        u16* an; int o2n, tn_, kn; float scn;
        item_of(idn, an, o2n, tn_, scn, kn);
        x1n = *reinterpret_cast<const uint4*>(an); x2n = *reinterpret_cast<const uint4*>(an + o2n);
      }
      float x1[8], x2[8], y1[8], y2[8];
      unpack8(x1c, x1); unpack8(x2c, x2);
      const float* tab = p.rtab() + tabo;
#pragma unroll
      for (int e = 0; e < 8; e += 2) {
        const float4 cs = *reinterpret_cast<const float4*>(tab + e * 2);
        y1[e] = (x1[e] * cs.x - x2[e] * cs.y) * scale;
        y2[e] = (x2[e] * cs.x + x1[e] * cs.y) * scale;
        y1[e + 1] = (x1[e + 1] * cs.z - x2[e + 1] * cs.w) * scale;
        y2[e + 1] = (x2[e + 1] * cs.z + x1[e + 1] * cs.w) * scale;
      }
      uint4 o1, o2;
      o1.x = pack2(y1[0], y1[1]); o1.y = pack2(y1[2], y1[3]); o1.z = pack2(y1[4], y1[5]); o1.w = pack2(y1[6], y1[7]);
      o2.x = pack2(y2[0], y2[1]); o2.y = pack2(y2[2], y2[3]); o2.z = pack2(y2[4], y2[5]); o2.w = pack2(y2[6], y2[7]);
      *reinterpret_cast<uint4*>(a) = o1;
      *reinterpret_cast<uint4*>(a + off2) = o2;
      if (ki >= 0) {
        const int t = idx / 42, s = t & (SEQ - 1), bb = t >> 12;
#pragma unroll
        for (int hd = 0; hd < 4; ++hd) {
          u16* kf = p.kfull() + ((size_t)(bb * 4 + hd) * SEQ + s) * 96 + 64 + ki;
          *reinterpret_cast<uint4*>(kf) = o1;
          *reinterpret_cast<uint4*>(kf + 16) = o2;
        }
      }
      x1c = x1n; x2c = x2n;
    }
  }
}

DI void ph_mla_up_q(const Params& p, int L, char* smem, int t) {
  const int mt = T / 256;
  const u16* Bq = p.WuqT() + (size_t)L * 384 * 256;
  {
    const int m0 = (t % mt) * 256, n0 = (t / mt) * 128;
    gemm_tile([&](int r) { return p.cqn() + (size_t)(m0 + r) * 256; }, Bq + (size_t)n0 * 256, 256, 256, smem,
              [&](f32x4 (&acc)[4][4], int wr, int wc, int fr, int fq) {
                const float scale = 0.10206207261596575f * 1.4426950408889634f;
#pragma unroll
                for (int m = 0; m < 4; ++m)
#pragma unroll
                  for (int j = 0; j < 4; ++j) {
                    const int row = m0 + wr * 64 + m * 16 + fq * 4 + j;
                    const float2 cssn = *reinterpret_cast<const float2*>(p.rtab() + ((size_t)(row & (SEQ - 1)) * 56 + 40 + fr) * 2);
                    const float cs = cssn.x, sn = cssn.y;
#pragma unroll
                    for (int n2 = 0; n2 < 4; n2 += 2) {
                      const int cb = n0 + wc * 64 + n2 * 16;
                      float x1 = acc[m][n2][j], x2 = acc[m][n2 + 1][j];
                      if (cb % 96 == 64) {
                        const float y1 = x1 * cs - x2 * sn, y2 = x2 * cs + x1 * sn;
                        x1 = y1; x2 = y2;
                      }
                      p.mq()[(size_t)row * 384 + cb + fr] = f2bf(x1 * scale);
                      p.mq()[(size_t)row * 384 + cb + 16 + fr] = f2bf(x2 * scale);
                    }
                  }
              });
  }
}
DI void ph_mla_up_kv(const Params& p, int L, char* smem, int t) {
  const int mt = T / 256;
  const u16* Bkv = p.WukvT() + (size_t)L * 512 * 128;
  {
    const int m0 = (t % mt) * 256, h = t / mt, n0 = h * 128;
    gemm_tile([&](int r) { return p.ckvn() + (size_t)(m0 + r) * 128; }, Bkv + (size_t)n0 * 128, 128, 128, smem,
              [&](f32x4 (&acc)[4][4], int wr, int wc, int fr, int fq) {
#pragma unroll
                for (int m = 0; m < 4; ++m) {
                  const int row = m0 + wr * 64 + m * 16 + fq * 4;
                  const int bb = row >> 12, sq = row & (SEQ - 1);
                  const size_t bh = (size_t)(bb * 4 + h);
#pragma unroll
                  for (int n = 0; n < 4; ++n) {
                    if (wc == 0) {
#pragma unroll
                      for (int j = 0; j < 4; ++j) p.kfull()[(bh * SEQ + sq + j) * 96 + n * 16 + fr] = f2bf(acc[m][n][j]);
                    } else {
                      uint2 v;
                      v.x = pack2(acc[m][n][0], acc[m][n][1]);
                      v.y = pack2(acc[m][n][2], acc[m][n][3]);
                      const int sqp = (sq & ~12) | ((sq & 4) << 1) | ((sq & 8) >> 1);
                      *reinterpret_cast<uint2*>(p.vT() + (bh * 64 + n * 16 + fr) * SEQ + sqp) = v;
                    }
                  }
                }
              });
  }
}

DI void ph_cumsum(const Params& p, int L) {
  const int tid_ = otid(); const int lane = tid_ & 63, gw = (obid() * NTHR + tid_) >> 6, nw = gridDim.x * (NTHR / 64);
  for (int it = gw; it < 32; it += nw) {
    const int h = it & 3, dir = (it >> 2) & 1, b = it >> 3;
    const float a = -expf(p.a_log[L * 8 + dir * 4 + h]);
    float running = 0.f;
    for (int c = 0; c < 64; ++c) {
      const int i = c * 64 + lane;
      const int s = dir ? (SEQ - 1 - i) : i;
      const size_t off = (size_t)(b * SEQ + s) * 8 + dir * 4 + h;
      float v = p.dtv()[off] * a;
#pragma unroll
      for (int o = 1; o < 64; o <<= 1) {
        const float u = __shfl_up(v, o);
        if (lane >= o) v += u;
      }
      v += running;
      p.cs()[off] = v;
      running = __shfl(v, 63);
    }
  }
}

DI void ph_ret_naive(const Params& p) {
  const int gt = obid() * NTHR + otid(), gs = gridDim.x * NTHR;
  for (int it = gt; it < 4 * 4 * SEQ; it += gs) {
    const int n = it & (SEQ - 1), h = (it >> 12) & 3, b = it >> 14;
    const u16* base = p.proj() + (size_t)(b * SEQ) * PWP;
    uint4 qp[8];
    float o[64];
#pragma unroll
    for (int d = 0; d < 8; ++d) qp[d] = *reinterpret_cast<const uint4*>(base + (size_t)n * PWP + C_RQ + h * 64 + d * 8);
#pragma unroll
    for (int d = 0; d < 64; ++d) o[d] = 0.f;
    const float lg0 = log1pf(-exp2f(-5.f - (float)h)), lg1 = log1pf(-exp2f(-5.5f - (float)h));
#pragma unroll 1
    for (int m = 0; m < SEQ; ++m) {
      const u16* kr = base + (size_t)m * PWP + C_RK + h * 64;
      const u16* vr = base + (size_t)m * PWP + C_RV + h * 64;
      float s = 0.f;
#pragma unroll
      for (int d = 0; d < 8; ++d) s = dot8(qp[d], *reinterpret_cast<const uint4*>(kr + d * 8), s);
      const float w = (m <= n) ? expf(lg0 * (float)(n - m)) : expf(lg1 * (float)(m - n));
      s *= w;
#pragma unroll
      for (int d = 0; d < 64; d += 8) {
        float vf[8];
        ld8(vr + d, vf);
#pragma unroll
        for (int j = 0; j < 8; ++j) o[d + j] += s * vf[j];
      }
    }
    float mu = 0.f;
#pragma unroll
    for (int d = 0; d < 64; ++d) mu += o[d];
    mu *= (1.f / 64.f);
    float var = 0.f;
#pragma unroll
    for (int d = 0; d < 64; ++d) var += (o[d] - mu) * (o[d] - mu);
    var *= (1.f / 64.f);
    const float rs = rsqrtf(var + 1e-5f);
    const size_t t = (size_t)b * SEQ + n;
#pragma unroll
    for (int d = 0; d < 64; d += 8) {
      float g[8];
      ld8(p.proj() + t * PWP + C_RG + h * 64 + d, g);
      uint4 ov;
      ov.x = pack2(silu(g[0]) * (o[d + 0] - mu) * rs, silu(g[1]) * (o[d + 1] - mu) * rs);
      ov.y = pack2(silu(g[2]) * (o[d + 2] - mu) * rs, silu(g[3]) * (o[d + 3] - mu) * rs);
      ov.z = pack2(silu(g[4]) * (o[d + 4] - mu) * rs, silu(g[5]) * (o[d + 5] - mu) * rs);
      ov.w = pack2(silu(g[6]) * (o[d + 6] - mu) * rs, silu(g[7]) * (o[d + 7] - mu) * rs);
      *reinterpret_cast<uint4*>(p.mixed() + t * DM + h * 64 + d) = ov;
    }
  }
}

DI void ph_mla_naive(const Params& p) {
  const int gt = obid() * NTHR + otid(), gs = gridDim.x * NTHR;
  for (int it = gt; it < 2 * 4 * 4 * SEQ; it += gs) {
    const int n = it & (SEQ - 1), vh = (it >> 12) & 1, h = (it >> 13) & 3, b = it >> 15;
    const size_t t = (size_t)b * SEQ + n;
    uint4 qp[12];
    float o[32];
#pragma unroll
    for (int d = 0; d < 12; ++d) qp[d] = *reinterpret_cast<const uint4*>(p.mq() + t * 384 + h * 96 + d * 8);
    const size_t tb = (size_t)b * SEQ;
    float mx = -1e30f;
#pragma unroll 1
    for (int m = 0; m < SEQ; ++m) {
      const u16* kn = ((u16*)nullptr) + (tb + m) * 512 + h * 128;
      const u16* kr = p.proj() + (tb + m) * PWP + C_KR;
      float s = 0.f;
#pragma unroll
      for (int d = 0; d < 8; ++d) s = dot8(qp[d], *reinterpret_cast<const uint4*>(kn + d * 8), s);
#pragma unroll
      for (int d = 0; d < 4; ++d) s = dot8(qp[8 + d], *reinterpret_cast<const uint4*>(kr + d * 8), s);
      mx = fmaxf(mx, s);
    }
#pragma unroll
    for (int d = 0; d < 32; ++d) o[d] = 0.f;
    float l = 0.f;
#pragma unroll 1
    for (int m = 0; m < SEQ; ++m) {
      const u16* kn = ((u16*)nullptr) + (tb + m) * 512 + h * 128;
      const u16* kr = p.proj() + (tb + m) * PWP + C_KR;
      float s = 0.f;
#pragma unroll
      for (int d = 0; d < 8; ++d) s = dot8(qp[d], *reinterpret_cast<const uint4*>(kn + d * 8), s);
#pragma unroll
      for (int d = 0; d < 4; ++d) s = dot8(qp[8 + d], *reinterpret_cast<const uint4*>(kr + d * 8), s);
      const float pe = exp2f(s - mx);
      l += pe;
#pragma unroll
      for (int d = 0; d < 32; d += 8) {
        float vf[8];
        ld8(kn + 64 + vh * 32 + d, vf);
#pragma unroll
        for (int j = 0; j < 8; ++j) o[d + j] += pe * vf[j];
      }
    }
    const float il = 1.f / l;
#pragma unroll
    for (int d = 0; d < 32; d += 8) {
      uint4 ov;
      ov.x = pack2(o[d + 0] * il, o[d + 1] * il);
      ov.y = pack2(o[d + 2] * il, o[d + 3] * il);
      ov.z = pack2(o[d + 4] * il, o[d + 5] * il);
      ov.w = pack2(o[d + 6] * il, o[d + 7] * il);
      *reinterpret_cast<uint4*>(p.mixed() + t * DM + 256 + h * 64 + vh * 32 + d) = ov;
    }
  }
}

#define MFMA32(a, b, c) __builtin_amdgcn_mfma_f32_32x32x16_bf16((a), (b), (c), 0, 0, 0)
DI float max16(const f32x16& v) {
  float a = fmaxf(fmaxf(v[0], v[1]), v[2]), b = fmaxf(fmaxf(v[3], v[4]), v[5]), c = fmaxf(fmaxf(v[6], v[7]), v[8]);
  float d = fmaxf(fmaxf(v[9], v[10]), v[11]), e = fmaxf(fmaxf(v[12], v[13]), v[14]);
  return fmaxf(fmaxf(fmaxf(a, b), fmaxf(c, d)), fmaxf(e, v[15]));
}
DI void ph_mla_attn(const Params& p, char* smem, int L) {
  const int tid = otid(), wid = tid >> 6, lane = tid & 63, l32 = lane & 31, hh = lane >> 5;
  u16* sK = reinterpret_cast<u16*>(smem);
  u16* sV = sK + 2 * 128 * 104;
  uint4 konev = make_uint4(hh == 0 ? 0x00003F80u : 0u, 0u, 0u, 0u);
  const bf16x8 kone = __builtin_bit_cast(bf16x8, konev);
  for (int item = obid(); item < 256; item += gridDim.x) {
    const int xcd_ = item & 7, jx_ = item >> 3, bh = xcd_ * 2 + (jx_ >> 4), qt = jx_ & 15, b = bh >> 2, h = bh & 3;
    const size_t t0 = (size_t)b * SEQ + qt * 256 + wid * 32;
    bf16x8 qf[6];
#pragma unroll
    for (int ks = 0; ks < 6; ++ks) qf[ks] = *reinterpret_cast<const bf16x8*>(p.mq() + (t0 + l32) * 384 + h * 96 + ks * 16 + hh * 8);
    const u16* kg = p.kfull() + (size_t)bh * SEQ * 96;
    const u16* vg = p.vT() + (size_t)bh * 64 * SEQ;
    f32x16 o0, o1;
#pragma unroll
    for (int i = 0; i < 16; ++i) { o0[i] = 0.f; o1[i] = 0.f; }
    float m = 0.f, l = 0.f;
    bf16x8 qf6 = __builtin_bit_cast(bf16x8, make_uint4(0u, 0u, 0u, 0u));
    const int kr0 = tid / 12, kc0 = tid % 12, kr1 = (512 + tid) / 12, kc1 = (512 + tid) % 12, kr2 = (1024 + tid) / 12, kc2 = (1024 + tid) % 12;
    const int vd0 = tid >> 4, vd1 = 32 + (tid >> 4), vkc = (tid & 15) * 8;
    uint4 ak0, ak1, ak2, av0, av1;
#define MLA_LD(dst_, ptr_) asm volatile("global_load_dwordx4 %0, %1, off" : "=v"(dst_) : "v"(ptr_) : "memory")
#define MLA_GLOAD(K0, K1, K2, V0, V1, kt_)                                               \
    {                                                                                    \
      const u16* kb_ = kg + (size_t)(kt_) * 128 * 96 + tid * 8;                          \
      MLA_LD(K0, kb_); MLA_LD(K1, kb_ + 512 * 8); MLA_LD(K2, kb_ + 1024 * 8);            \
      const u16* vp_ = vg + (size_t)vd0 * SEQ + (kt_) * 128 + vkc;                       \
      MLA_LD(V0, vp_); MLA_LD(V1, vp_ + (size_t)32 * SEQ);                               \
    }
#define MLA_SSTORE(K0, K1, K2, V0, V1, buf_)                                             \
    {                                                                                    \
      u16* kb_ = sK + (buf_) * 128 * 104;                                                \
      u16* vb_ = sV + (buf_) * 64 * 136;                                                 \
      *reinterpret_cast<uint4*>(kb_ + kr0 * 104 + kc0 * 8) = K0;                         \
      *reinterpret_cast<uint4*>(kb_ + kr1 * 104 + kc1 * 8) = K1;                         \
      *reinterpret_cast<uint4*>(kb_ + kr2 * 104 + kc2 * 8) = K2;                         \
      *reinterpret_cast<uint4*>(vb_ + vd0 * 136 + vkc) = V0;                             \
      *reinterpret_cast<uint4*>(vb_ + vd1 * 136 + vkc) = V1;                             \
    }
    float mxrun = 0.f;
#define SGB(mask, n) __builtin_amdgcn_sched_group_barrier((mask), (n), 0)
#define MLA_KFRAG(kb_, sub_, ks_) (*reinterpret_cast<const bf16x8*>((kb_) + ((sub_) * 32 + l32) * 104 + (ks_) * 16 + hh * 8))
#define MLA_VFRAG(dst_, vb_, sub_, ks2_, dvt_) \
    dst_ = *reinterpret_cast<const bf16x8*>((vb_) + ((dvt_) * 32 + l32) * 136 + (sub_) * 32 + (ks2_) * 16 + hh * 8)
#define MLA_SOFTMAX(sc_, pa_, pb_)                                                                         \
    {                                                                                                      \
      mxrun = fmaxf(mxrun, max16(sc_));                                                                    \
      float ps0_ = 0.f, ps1_ = 0.f;                                                                        \
      _Pragma("unroll") for (int i = 0; i < 16; i += 2) {                                                  \
        sc_[i] = __builtin_amdgcn_exp2f(sc_[i]); sc_[i + 1] = __builtin_amdgcn_exp2f(sc_[i + 1]);          \
        ps0_ += sc_[i]; ps1_ += sc_[i + 1];                                                                \
      }                                                                                                    \
      l += ps0_ + ps1_;                                                                                    \
      uint4 pk_;                                                                                           \
      pk_.x = pack2(sc_[0], sc_[1]); pk_.y = pack2(sc_[2], sc_[3]); pk_.z = pack2(sc_[4], sc_[5]); pk_.w = pack2(sc_[6], sc_[7]); \
      pa_ = __builtin_bit_cast(bf16x8, pk_);                                                               \
      pk_.x = pack2(sc_[8], sc_[9]); pk_.y = pack2(sc_[10], sc_[11]); pk_.z = pack2(sc_[12], sc_[13]); pk_.w = pack2(sc_[14], sc_[15]); \
      pb_ = __builtin_bit_cast(bf16x8, pk_);                                                               \
    }
    auto compute_tile = [&](int cur, int half) {
      const u16* kb = sK + cur * 128 * 104 + half * 64 * 104;
      const u16* vb = sV + cur * 64 * 136 + half * 64;
      bf16x8 k0[6], k1[6];
#pragma unroll
      for (int ks = 0; ks < 6; ++ks) { k0[ks] = MLA_KFRAG(kb, 0, ks); k1[ks] = MLA_KFRAG(kb, 1, ks); }
      f32x16 s0, s1;
#pragma unroll
      for (int i = 0; i < 16; ++i) { s0[i] = 0.f; s1[i] = 0.f; }
#pragma unroll
      for (int ks = 0; ks < 6; ++ks) s0 = MFMA32(k0[ks], qf[ks], s0);
      s0 = MFMA32(kone, qf6, s0);
      bf16x8 v00, v01, v02, v03, v10, v11, v12, v13;
      MLA_VFRAG(v00, vb, 0, 0, 0); MLA_VFRAG(v01, vb, 0, 0, 1); MLA_VFRAG(v02, vb, 0, 1, 0); MLA_VFRAG(v03, vb, 0, 1, 1);
#pragma unroll
      for (int ks = 0; ks < 6; ++ks) s1 = MFMA32(k1[ks], qf[ks], s1);
      s1 = MFMA32(kone, qf6, s1);
      MLA_VFRAG(v10, vb, 1, 0, 0); MLA_VFRAG(v11, vb, 1, 0, 1); MLA_VFRAG(v12, vb, 1, 1, 0); MLA_VFRAG(v13, vb, 1, 1, 1);
      bf16x8 p0a, p0b, p1a, p1b;
      MLA_SOFTMAX(s0, p0a, p0b);
      o0 = MFMA32(v00, p0a, o0); o1 = MFMA32(v01, p0a, o1); o0 = MFMA32(v02, p0b, o0); o1 = MFMA32(v03, p0b, o1);
      MLA_SOFTMAX(s1, p1a, p1b);
      o0 = MFMA32(v10, p1a, o0); o1 = MFMA32(v11, p1a, o1); o0 = MFMA32(v12, p1b, o0); o1 = MFMA32(v13, p1b, o1);
      SGB(0x100, 12);
#pragma unroll
      for (int i = 0; i < 7; ++i) { SGB(0x008, 1); if (i < 4) SGB(0x100, 1); }
#pragma unroll
      for (int i = 0; i < 7; ++i) { SGB(0x008, 1); if (i < 4) SGB(0x100, 1); SGB(0x402, 7); }
#pragma unroll
      for (int i = 0; i < 4; ++i) { SGB(0x008, 1); SGB(0x402, 12); }
#pragma unroll
      for (int i = 0; i < 4; ++i) SGB(0x008, 1);
    };
    auto lazy_update = [&]() {
      const float mxr = fmaxf(mxrun, __shfl_xor(mxrun, 32));
      if (__builtin_amdgcn_ballot_w64(mxr > 8.f) != 0ull) {
        float d = (mxr > 8.f) ? mxr : 0.f;
        const float mnew = bf2f(f2bf(m + d));
        d = mnew - m;
        m = mnew;
        const float alpha = __builtin_amdgcn_exp2f(-d);
        l *= alpha;
        mxrun -= d;
#pragma unroll
        for (int i = 0; i < 16; ++i) { o0[i] *= alpha; o1[i] *= alpha; }
        uint4 qv = make_uint4(0u, 0u, 0u, 0u);
        if (hh == 0) qv.x = (unsigned)f2bf(-m);
        qf6 = __builtin_bit_cast(bf16x8, qv);
      }
    };
    unsigned char* cbuf = reinterpret_cast<unsigned char*>(sV + 2 * 64 * 136);
    const bool cvt_on = (gridDim.x == 256);
    f32x4 cv0, cv1, cv2, cv3;
    bool cvalid = false;
#define CVT_ISSUE(j_)                                                                                                   \
    {                                                                                                                   \
      const int g_ = CVT_B + obid() + 256 * (j_);                                                                       \
      cvalid = cvt_on && (g_ < 12288);                                                                                  \
      if (cvalid) {                                                                                                     \
        const CvtTile ct_ = cvt_tile(p, L, g_);                                                                         \
        const float* sp_ = ct_.src + (size_t)(ct_.k0 + (tid >> 5) * 4) * ct_.N + ct_.n0 + (tid & 31) * 4;              \
        cv0 = __builtin_nontemporal_load(reinterpret_cast<const f32x4*>(sp_));                                          \
        cv1 = __builtin_nontemporal_load(reinterpret_cast<const f32x4*>(sp_ + ct_.N));                                  \
        cv2 = __builtin_nontemporal_load(reinterpret_cast<const f32x4*>(sp_ + 2 * ct_.N));                              \
        cv3 = __builtin_nontemporal_load(reinterpret_cast<const f32x4*>(sp_ + 3 * ct_.N));                              \
      }                                                                                                                 \
    }
#define CVT_TO_LDS(par_)                                                                                                \
    if (cvalid) {                                                                                                       \
      unsigned char* cb_ = cbuf + (par_) * 10240 + (tid & 31) * 4 * 80 + (tid >> 5) * 4;                                \
      *reinterpret_cast<unsigned*>(cb_) = pk4_f8_scaled<256>(cv0[0], cv1[0], cv2[0], cv3[0]);       \
      *reinterpret_cast<unsigned*>(cb_ + 80) = pk4_f8_scaled<256>(cv0[1], cv1[1], cv2[1], cv3[1]);  \
      *reinterpret_cast<unsigned*>(cb_ + 160) = pk4_f8_scaled<256>(cv0[2], cv1[2], cv2[2], cv3[2]); \
      *reinterpret_cast<unsigned*>(cb_ + 240) = pk4_f8_scaled<256>(cv0[3], cv1[3], cv2[3], cv3[3]); \
    }
#define CVT_TO_GLOBAL(par_, j_)                                                                                         \
    if (cvalid) {                                                                                                       \
      const CvtTile ct_ = cvt_tile(p, L, CVT_B + obid() + 256 * (j_));        \
      unsigned char* cd_ = ct_.dst + (size_t)cvt_rowmap(ct_.mat, ct_.n0 + (tid >> 2)) * ct_.K + ct_.k0 + (tid & 3) * 16;  \
      *reinterpret_cast<uint4*>(cd_) = *reinterpret_cast<const uint4*>(cbuf + (par_) * 10240 + (tid >> 2) * 80 + (tid & 3) * 16); \
    }
    MLA_GLOAD(ak0, ak1, ak2, av0, av1, 0);
    asm volatile("s_waitcnt vmcnt(0)" ::: "memory");
    MLA_SSTORE(ak0, ak1, ak2, av0, av1, 0);
    __syncthreads();
    {
      f32x16 s0, s1;
#pragma unroll
      for (int i = 0; i < 16; ++i) { s0[i] = 0.f; s1[i] = 0.f; }
#pragma unroll
      for (int ks = 0; ks < 6; ++ks) { s0 = MFMA32(MLA_KFRAG(sK, 0, ks), qf[ks], s0); s1 = MFMA32(MLA_KFRAG(sK, 1, ks), qf[ks], s1); }
      float mx = fmaxf(max16(s0), max16(s1));
      mx = fmaxf(mx, __shfl_xor(mx, 32));
      m = bf2f(f2bf(mx));
      uint4 qv = make_uint4(0u, 0u, 0u, 0u);
      if (hh == 0) qv.x = (unsigned)f2bf(-m);
      qf6 = __builtin_bit_cast(bf16x8, qv);
    }
#pragma unroll 1
    for (int kt = 0; kt < 32; kt += 2) {
      MLA_GLOAD(ak0, ak1, ak2, av0, av1, kt + 1);
      CVT_ISSUE(kt);
#pragma unroll 1
      for (int half = 0; half < 2; ++half) compute_tile(0, half);
      asm volatile("s_waitcnt vmcnt(0)" ::: "memory");
      MLA_SSTORE(ak0, ak1, ak2, av0, av1, 1);
      CVT_TO_LDS(0);
      __syncthreads();
      CVT_TO_GLOBAL(0, kt);
      lazy_update();
      if (kt + 2 < 32) MLA_GLOAD(ak0, ak1, ak2, av0, av1, kt + 2);
      CVT_ISSUE(kt + 1);
#pragma unroll 1
      for (int half = 0; half < 2; ++half) compute_tile(1, half);
      asm volatile("s_waitcnt vmcnt(0)" ::: "memory");
      if (kt + 2 < 32) MLA_SSTORE(ak0, ak1, ak2, av0, av1, 0);
      CVT_TO_LDS(1);
      __syncthreads();
      CVT_TO_GLOBAL(1, kt + 1);
      lazy_update();
    }
    l += __shfl_xor(l, 32);
    const float il = 1.f / l;
    u16* orow = p.mixed() + (t0 + l32) * DM + 256 + h * 64 + hh * 4;
#pragma unroll
    for (int g = 0; g < 4; ++g) {
      uint2 v;
      v.x = pack2(o0[4 * g + 0] * il, o0[4 * g + 1] * il);
      v.y = pack2(o0[4 * g + 2] * il, o0[4 * g + 3] * il);
      *reinterpret_cast<uint2*>(orow + g * 8) = v;
      v.x = pack2(o1[4 * g + 0] * il, o1[4 * g + 1] * il);
      v.y = pack2(o1[4 * g + 2] * il, o1[4 * g + 3] * il);
      *reinterpret_cast<uint2*>(orow + 32 + g * 8) = v;
    }
  }
}

typedef __attribute__((address_space(3))) s16x4 lds_s16x4;
template <int MODE>
DI void ph_dil_pass(const Params& p, char* smem, int blk_) {
  const int tid = otid(), wid = tid >> 6, lane = tid & 63, l32 = lane & 31, hh = lane >> 5;
  u16* sV = reinterpret_cast<u16*>(smem) + wid * (2 * 32 * 72);
  u16* sKd = reinterpret_cast<u16*>(smem) + 8 * (2 * 32 * 72) + wid * (32 * 72);
  const int i16 = lane & 15, tq = i16 >> 2, tp = i16 & 3, tblk = (lane >> 4) & 1;
  {
    constexpr int NT = (MODE == 0) ? 13 : 5;
    const int it = wid, xcd_ = blk_ & 7, jx_ = blk_ >> 3, bh = xcd_ * 2 + (jx_ >> 4), r = jx_ & 15, b = bh >> 2, h = bh & 3;
    const int i0 = it * 32;
    const int q0 = (r * 8 + it) * 32;
    const int qpos = (MODE == 0) ? (r + 16 * (i0 + l32)) : (q0 + l32);
    const size_t tb = (size_t)b * SEQ;
    const u16* kbase = p.proj() + tb * PWP + C_DK + h * 64;
    const u16* vbase = p.proj() + tb * PWP + C_DV + h * 64;
    bf16x8 qf[4];
    {
      const u16* qp = p.proj() + (tb + qpos) * PWP + C_DQ + h * 64 + hh * 8;
#pragma unroll
      for (int ks = 0; ks < 4; ++ks) qf[ks] = *reinterpret_cast<const bf16x8*>(qp + ks * 16);
    }
    f32x16 o0, o1;
#pragma unroll
    for (int i = 0; i < 16; ++i) { o0[i] = 0.f; o1[i] = 0.f; }
    float m = -1e30f, l = 0.f;
    auto tile_params = [&](int tt, int& d, int& rd, int& ub, int& ulim, int& qb, int& qs) {
      if (MODE == 0) {
        if (tt < 5) { d = 16; rd = r; qb = i0; qs = 1; ulim = 256; ub = qb - 64 + 32 * tt; }
        else { d = 4; rd = r & 3; qb = (r >> 2) + 4 * i0; qs = 4; ulim = 1024; ub = qb - 64 + 32 * (tt - 5); }
      } else { d = 1; rd = 0; qb = q0; qs = 1; ulim = 4096; ub = qb - 64 + 32 * tt; }
    };
    bf16x8 ka0, ka1, ka2, ka3, kb0, kb1, kb2, kb3;
    uint4 va0, va1, va2, va3, vb0, vb1, vb2, vb3;
#define DIL_LD(dst_, ptr_) asm volatile("global_load_dwordx4 %0, %1, off" : "=v"(dst_) : "v"(ptr_) : "memory")
#define DIL_GLOAD(K0, K1, K2, K3, V0, V1, V2, V3, tt_)                                                   \
    {                                                                                                    \
      int d_, rd_, ub_, ulim_, qb_, qs_;                                                                 \
      tile_params((tt_), d_, rd_, ub_, ulim_, qb_, qs_);                                                 \
      int u_;                                                                                            \
      const int kr_ = ub_ + (lane >> 3);                                                                 \
      const u16* vp_;                                                                                    \
      u_ = min(max(kr_, 0), ulim_ - 1);      vp_ = kbase + (size_t)(rd_ + d_ * u_) * PWP + (lane & 7) * 8; DIL_LD(K0, vp_); \
      u_ = min(max(kr_ + 8, 0), ulim_ - 1);  vp_ = kbase + (size_t)(rd_ + d_ * u_) * PWP + (lane & 7) * 8; DIL_LD(K1, vp_); \
      u_ = min(max(kr_ + 16, 0), ulim_ - 1); vp_ = kbase + (size_t)(rd_ + d_ * u_) * PWP + (lane & 7) * 8; DIL_LD(K2, vp_); \
      u_ = min(max(kr_ + 24, 0), ulim_ - 1); vp_ = kbase + (size_t)(rd_ + d_ * u_) * PWP + (lane & 7) * 8; DIL_LD(K3, vp_); \
      u_ = min(max(kr_, 0), ulim_ - 1);      vp_ = vbase + (size_t)(rd_ + d_ * u_) * PWP + (lane & 7) * 8; DIL_LD(V0, vp_); \
      u_ = min(max(kr_ + 8, 0), ulim_ - 1);  vp_ = vbase + (size_t)(rd_ + d_ * u_) * PWP + (lane & 7) * 8; DIL_LD(V1, vp_); \
      u_ = min(max(kr_ + 16, 0), ulim_ - 1); vp_ = vbase + (size_t)(rd_ + d_ * u_) * PWP + (lane & 7) * 8; DIL_LD(V2, vp_); \
      u_ = min(max(kr_ + 24, 0), ulim_ - 1); vp_ = vbase + (size_t)(rd_ + d_ * u_) * PWP + (lane & 7) * 8; DIL_LD(V3, vp_); \
    }
#define DIL_KSTORE(K0, K1, K2, K3)                                                                       \
    {                                                                                                    \
      u16* kb_ = sKd + (lane >> 3) * 72 + (lane & 7) * 8;                                                \
      *reinterpret_cast<bf16x8*>(kb_) = K0;                                                              \
      *reinterpret_cast<bf16x8*>(kb_ + 8 * 72) = K1;                                                     \
      *reinterpret_cast<bf16x8*>(kb_ + 16 * 72) = K2;                                                    \
      *reinterpret_cast<bf16x8*>(kb_ + 24 * 72) = K3;                                                    \
    }
#define DIL_QK(sc_)                                                                                      \
    {                                                                                                    \
      const u16* kf_ = sKd + l32 * 72 + hh * 8;                                                          \
      _Pragma("unroll") for (int ks = 0; ks < 4; ++ks) sc_ = MFMA32(*reinterpret_cast<const bf16x8*>(kf_ + ks * 16), qf[ks], sc_); \
    }
#define DIL_VSTORE(V0, V1, V2, V3, buf_)                                                                 \
    {                                                                                                    \
      u16* vb_ = sV + (buf_) * 32 * 72 + (lane >> 3) * 72 + (lane & 7) * 8;                              \
      *reinterpret_cast<uint4*>(vb_) = V0;                                                               \
      *reinterpret_cast<uint4*>(vb_ + 8 * 72) = V1;                                                      \
      *reinterpret_cast<uint4*>(vb_ + 16 * 72) = V2;                                                     \
      *reinterpret_cast<uint4*>(vb_ + 24 * 72) = V3;                                                     \
    }
    auto tile_rest = [&](int tt, f32x16 sc, int cur) {
      int d, rd, ub, ulim, qb, qs;
      tile_params(tt, d, rd, ub, ulim, qb, qs);
      const int uq = qb + qs * l32;
      const float cs = 0.125f * 1.4426950408889634f;
      float mx = -1e30f;
#pragma unroll
      for (int i = 0; i < 16; ++i) {
        const int u = ub + (i & 3) + 8 * (i >> 2) + 4 * hh;
        const int du = u - uq;
        const bool valid = (u >= 0) && (u < ulim) && (du <= 64) && (du >= -64);
        sc[i] = valid ? sc[i] * cs : -1e30f;
        mx = fmaxf(mx, sc[i]);
      }
      mx = fmaxf(mx, __shfl_xor(mx, 32));
      const float mn = fmaxf(m, mx);
      const float alpha = __builtin_amdgcn_exp2f(m - mn);
      m = mn;
      float ps = 0.f;
#pragma unroll
      for (int i = 0; i < 16; ++i) {
        float pe = __builtin_amdgcn_exp2f(sc[i] - mn);
        pe = (sc[i] > -1e29f) ? pe : 0.f;
        ps += pe;
        sc[i] = pe;
      }
      l = l * alpha + ps;
#pragma unroll
      for (int i = 0; i < 16; ++i) { o0[i] *= alpha; o1[i] *= alpha; }
      const u16* vb = sV + cur * 32 * 72;
#pragma unroll
      for (int ks2 = 0; ks2 < 2; ++ks2) {
        uint4 pk;
        pk.x = pack2(sc[8 * ks2 + 0], sc[8 * ks2 + 1]);
        pk.y = pack2(sc[8 * ks2 + 2], sc[8 * ks2 + 3]);
        pk.z = pack2(sc[8 * ks2 + 4], sc[8 * ks2 + 5]);
        pk.w = pack2(sc[8 * ks2 + 6], sc[8 * ks2 + 7]);
        const bf16x8 pb = __builtin_bit_cast(bf16x8, pk);
#pragma unroll
        for (int dvt = 0; dvt < 2; ++dvt) {
          const u16* a0 = vb + (16 * ks2 + 4 * hh + tq) * 72 + dvt * 32 + tblk * 16 + tp * 4;
          const s16x4 lo = __builtin_amdgcn_ds_read_tr16_b64_v4i16((lds_s16x4*)(a0));
          const s16x4 hi = __builtin_amdgcn_ds_read_tr16_b64_v4i16((lds_s16x4*)(a0 + 8 * 72));
          const bf16x8 a = __builtin_shufflevector(lo, hi, 0, 1, 2, 3, 4, 5, 6, 7);
          if (dvt == 0) o0 = MFMA32(a, pb, o0); else o1 = MFMA32(a, pb, o1);
        }
      }
    };
    DIL_GLOAD(ka0, ka1, ka2, ka3, va0, va1, va2, va3, 0);
    DIL_GLOAD(kb0, kb1, kb2, kb3, vb0, vb1, vb2, vb3, 1);
    asm volatile("s_waitcnt vmcnt(8)" ::: "memory");
    DIL_VSTORE(va0, va1, va2, va3, 0);
    DIL_KSTORE(ka0, ka1, ka2, ka3);
#pragma unroll 1
    for (int tt = 0; tt < NT; tt += 2) {
      {
        f32x16 sc;
#pragma unroll
        for (int i = 0; i < 16; ++i) sc[i] = 0.f;
        DIL_QK(sc);
        asm volatile("" :: "v"(sc));
        if (tt + 2 < NT) DIL_GLOAD(ka0, ka1, ka2, ka3, va0, va1, va2, va3, tt + 2);
        tile_rest(tt, sc, 0);
        if (tt + 1 < NT) {
          if (tt + 2 < NT) asm volatile("s_waitcnt vmcnt(8)" ::: "memory"); else asm volatile("s_waitcnt vmcnt(0)" ::: "memory");
          DIL_VSTORE(vb0, vb1, vb2, vb3, 1);
          DIL_KSTORE(kb0, kb1, kb2, kb3);
        }
      }
      if (tt + 1 < NT) {
        f32x16 sc;
#pragma unroll
        for (int i = 0; i < 16; ++i) sc[i] = 0.f;
        DIL_QK(sc);
        asm volatile("" :: "v"(sc));
        if (tt + 3 < NT) DIL_GLOAD(kb0, kb1, kb2, kb3, vb0, vb1, vb2, vb3, tt + 3);
        tile_rest(tt + 1, sc, 1);
        if (tt + 2 < NT) {
          if (tt + 3 < NT) asm volatile("s_waitcnt vmcnt(8)" ::: "memory"); else asm volatile("s_waitcnt vmcnt(0)" ::: "memory");
          DIL_VSTORE(va0, va1, va2, va3, 0);
          DIL_KSTORE(ka0, ka1, ka2, ka3);
        }
      }
    }
    l += __shfl_xor(l, 32);
    float* part = p.dpart() + ((tb + qpos) * 4 + h) * 68 + hh * 4;
    if (MODE == 0) {
#pragma unroll
      for (int g = 0; g < 4; ++g) {
        *reinterpret_cast<float4*>(part + g * 8) = make_float4(o0[4 * g + 0], o0[4 * g + 1], o0[4 * g + 2], o0[4 * g + 3]);
        *reinterpret_cast<float4*>(part + 32 + g * 8) = make_float4(o1[4 * g + 0], o1[4 * g + 1], o1[4 * g + 2], o1[4 * g + 3]);
      }
      if (hh == 0) { part[64] = m; part[65] = l; }
    } else {
      const float mA = part[64 - hh * 4], lA = part[65 - hh * 4];
      const float M = fmaxf(m, mA), sa = __builtin_amdgcn_exp2f(m - M), sb = __builtin_amdgcn_exp2f(mA - M);
      const float il = 1.f / (l * sa + lA * sb);
      u16* orow = p.mixed() + (tb + qpos) * DM + 768 + h * 64 + hh * 4;
#pragma unroll
      for (int g = 0; g < 4; ++g) {
        const float4 a0 = *reinterpret_cast<const float4*>(part + g * 8), a1 = *reinterpret_cast<const float4*>(part + 32 + g * 8);
        uint2 v;
        v.x = pack2((o0[4 * g + 0] * sa + a0.x * sb) * il, (o0[4 * g + 1] * sa + a0.y * sb) * il);
        v.y = pack2((o0[4 * g + 2] * sa + a0.z * sb) * il, (o0[4 * g + 3] * sa + a0.w * sb) * il);
        *reinterpret_cast<uint2*>(orow + g * 8) = v;
        v.x = pack2((o1[4 * g + 0] * sa + a1.x * sb) * il, (o1[4 * g + 1] * sa + a1.y * sb) * il);
        v.y = pack2((o1[4 * g + 2] * sa + a1.z * sb) * il, (o1[4 * g + 3] * sa + a1.w * sb) * il);
        *reinterpret_cast<uint2*>(orow + 32 + g * 8) = v;
      }
    }
  }
}

DI void ph_dil_naive(const Params& p) {
  const int gt = obid() * NTHR + otid(), gs = gridDim.x * NTHR;
  for (int it = gt; it < 4 * 4 * SEQ; it += gs) {
    const int n = it & (SEQ - 1), h = (it >> 12) & 3, b = it >> 14;
    const size_t tb = (size_t)b * SEQ;
    uint4 qp[8];
    float o[64];
#pragma unroll
    for (int d = 0; d < 8; ++d) qp[d] = *reinterpret_cast<const uint4*>(p.proj() + (tb + n) * PWP + C_DQ + h * 64 + d * 8);
    float mx = -1e30f;
    for (int pat = 0; pat < 3; ++pat) {
      const int dil = (pat == 0) ? 1 : (pat == 1 ? 4 : 16);
#pragma unroll 1
      for (int j = -64; j <= 64; ++j) {
        const int pos = n + j * dil;
        if (pos < 0 || pos >= SEQ) continue;
        const u16* kr = p.proj() + (tb + pos) * PWP + C_DK + h * 64;
        float s = 0.f;
#pragma unroll
        for (int d = 0; d < 8; ++d) s = dot8(qp[d], *reinterpret_cast<const uint4*>(kr + d * 8), s);
        s *= 0.125f;
        mx = fmaxf(mx, s);
      }
    }
#pragma unroll
    for (int d = 0; d < 64; ++d) o[d] = 0.f;
    float l = 0.f;
    for (int pat = 0; pat < 3; ++pat) {
      const int dil = (pat == 0) ? 1 : (pat == 1 ? 4 : 16);
#pragma unroll 1
      for (int j = -64; j <= 64; ++j) {
        const int pos = n + j * dil;
        if (pos < 0 || pos >= SEQ) continue;
        const u16* kr = p.proj() + (tb + pos) * PWP + C_DK + h * 64;
        const u16* vr = p.proj() + (tb + pos) * PWP + C_DV + h * 64;
        float s = 0.f;
#pragma unroll
        for (int d = 0; d < 8; ++d) s = dot8(qp[d], *reinterpret_cast<const uint4*>(kr + d * 8), s);
        s *= 0.125f;
        const float pe = __expf(s - mx);
        l += pe;
#pragma unroll
        for (int d = 0; d < 64; d += 8) {
          float vf[8];
          ld8(vr + d, vf);
#pragma unroll
          for (int jj = 0; jj < 8; ++jj) o[d + jj] += pe * vf[jj];
        }
      }
    }
    const float il = 1.f / l;
#pragma unroll
    for (int d = 0; d < 64; d += 8) {
      uint4 ov;
      ov.x = pack2(o[d + 0] * il, o[d + 1] * il);
      ov.y = pack2(o[d + 2] * il, o[d + 3] * il);
      ov.z = pack2(o[d + 4] * il, o[d + 5] * il);
      ov.w = pack2(o[d + 6] * il, o[d + 7] * il);
      *reinterpret_cast<uint4*>(p.mixed() + (tb + n) * DM + 768 + h * 64 + d) = ov;
    }
  }
}

DI void ph_ssd_naive(const Params& p, int L) {
  const int gt = obid() * NTHR + otid(), gs = gridDim.x * NTHR;
  for (int it = gt; it < 4 * 4 * 4 * SEQ; it += gs) {
    const int l = it & (SEQ - 1), pq = (it >> 12) & 3, h = (it >> 14) & 3, b = it >> 16;
    const int g = h >> 1;
    const size_t tb = (size_t)b * SEQ;
    uint4 cl[16];
    float acc[16];
#pragma unroll
    for (int d = 0; d < 16; ++d) cl[d] = *reinterpret_cast<const uint4*>(p.xbc() + (tb + l) * 768 + 512 + g * 128 + d * 8);
#pragma unroll
    for (int d = 0; d < 16; ++d) acc[d] = 0.f;
    const float pl = p.cs()[(tb + l) * 8 + h], rl = p.cs()[(tb + l) * 8 + 4 + h];
#pragma unroll 1
    for (int s = 0; s < SEQ; ++s) {
      const u16* br = p.xbc() + (tb + s) * 768 + 256 + g * 128;
      float cbv = 0.f;
#pragma unroll
      for (int d = 0; d < 16; ++d) cbv = dot8(cl[d], *reinterpret_cast<const uint4*>(br + d * 8), cbv);
      float w;
      if (s <= l) w = expf(pl - p.cs()[(tb + s) * 8 + h]) * p.dtv()[(tb + s) * 8 + h];
      else w = expf(rl - p.cs()[(tb + s) * 8 + 4 + h]) * p.dtv()[(tb + s) * 8 + 4 + h];
      cbv *= w;
      const u16* xr = p.xbc() + (tb + s) * 768 + h * 64 + pq * 16;
#pragma unroll
      for (int d = 0; d < 16; d += 8) {
        float xf[8];
        ld8(xr + d, xf);
#pragma unroll
        for (int j = 0; j < 8; ++j) acc[d + j] += cbv * xf[j];
      }
    }
    const float dsk = p.ssm_d[L * 4 + h];
#pragma unroll
    for (int d = 0; d < 16; ++d) {
      const int c = h * 64 + pq * 16 + d;
      const float xv = bf2f(p.xbc()[(tb + l) * 768 + c]);
      const float z = bf2f(p.proj()[(tb + l) * PWP + C_Z + c]);
      p.ybuf()[(tb + l) * 256 + c] = (acc[d] + dsk * xv) * silu(z);
    }
  }
}

DI void ph_ssd_norm(const Params& p, int L) {
  const int tid_ = otid(); const int lane = tid_ & 63, gw = (obid() * NTHR + tid_) >> 6, nw = gridDim.x * (NTHR / 64);
  const float* nwt = p.ssm_norm_w + L * 256;
  for (int t = gw; t < T; t += nw) {
    const float4 v = *reinterpret_cast<const float4*>(p.ybuf() + (size_t)t * 256 + lane * 4);
    float ss = wave_sum(v.x * v.x + v.y * v.y + v.z * v.z + v.w * v.w);
    const float rstd = rsqrtf(ss * (1.f / 256.f) + 1e-6f);
    const float4 ww = *reinterpret_cast<const float4*>(nwt + lane * 4);
    uint2 o;
    o.x = pack2(v.x * rstd * ww.x, v.y * rstd * ww.y);
    o.y = pack2(v.z * rstd * ww.z, v.w * rstd * ww.w);
    *reinterpret_cast<uint2*>(p.mixed() + (size_t)t * DM + 512 + lane * 4) = o;
  }
}

#define MFMA16(a, b, c) __builtin_amdgcn_mfma_f32_16x16x32_bf16((a), (b), (c), 0, 0, 0)
template <int MT, int NT, int KS>
DI void wave_mm(f32x4 (&acc)[MT][NT], const u16* a0, int lda, const u16* b0, int ldb, int fr, int fq) {
#pragma unroll
  for (int ks = 0; ks < KS; ++ks) {
    bf16x8 af[MT], bfv[NT];
#pragma unroll
    for (int m = 0; m < MT; ++m) af[m] = *reinterpret_cast<const bf16x8*>(a0 + (m * 16 + fr) * lda + ks * 32 + fq * 8);
#pragma unroll
    for (int n = 0; n < NT; ++n) bfv[n] = *reinterpret_cast<const bf16x8*>(b0 + (n * 16 + fr) * ldb + ks * 32 + fq * 8);
#pragma unroll
    for (int m = 0; m < MT; ++m)
#pragma unroll
      for (int n = 0; n < NT; ++n) acc[m][n] = MFMA16(af[m], bfv[n], acc[m][n]);
  }
}
template <int MT, int NT>
DI void zero_acc(f32x4 (&acc)[MT][NT]) {
#pragma unroll
  for (int m = 0; m < MT; ++m)
#pragma unroll
    for (int n = 0; n < NT; ++n) acc[m][n] = f32x4{0.f, 0.f, 0.f, 0.f};
}
template <int NROWS, int NCOLS>
DI void stage_rows(u16* dst, int ldd, const u16* src, size_t lsrc, int tid) {
  constexpr int CPR = NCOLS / 8, NCH = NROWS * CPR / NTHR;
  static_assert(NROWS * CPR % NTHR == 0, "tile must be a multiple of 512 chunks");
  uint4 r[NCH];
#pragma unroll
  for (int i = 0; i < NCH; ++i) {
    const int c = tid + i * NTHR, row = c / CPR, cc = c % CPR;
    r[i] = *reinterpret_cast<const uint4*>(src + (size_t)row * lsrc + cc * 8);
  }
#pragma unroll
  for (int i = 0; i < NCH; ++i) {
    const int c = tid + i * NTHR, row = c / CPR, cc = c % CPR;
    *reinterpret_cast<uint4*>(dst + row * ldd + cc * 8) = r[i];
  }
}
template <int NCOLS, class W>
DI void stage_T(u16* dst, int ldd, const u16* src, size_t lsrc, int tid, W w) {
  constexpr int NCH = 128 * (NCOLS / 8) / NTHR;
  uint4 r[NCH];
#pragma unroll
  for (int i = 0; i < NCH; ++i) {
    const int c = tid + i * NTHR, j = c & 127, cc = c >> 7;
    r[i] = *reinterpret_cast<const uint4*>(src + (size_t)j * lsrc + cc * 8);
  }
#pragma unroll
  for (int i = 0; i < NCH; ++i) {
    const int c = tid + i * NTHR, j = c & 127, cc = c >> 7;
    float f[8];
    unpack8(r[i], f);
    const float wj = w(j);
#pragma unroll
    for (int e = 0; e < 8; ++e) dst[(cc * 8 + e) * ldd + j] = f2bf(f[e] * wj);
  }
}

template <int NROWS, int NCOLS>
DI void stage_rows_ld(uint4 (&r)[NROWS * (NCOLS / 8) / NTHR], const u16* src, size_t lsrc, int tid) {
  constexpr int CPR = NCOLS / 8, NCH = NROWS * CPR / NTHR;
#pragma unroll
  for (int i = 0; i < NCH; ++i) {
    const int c = tid + i * NTHR, row = c / CPR, cc = c % CPR;
    r[i] = *reinterpret_cast<const uint4*>(src + (size_t)row * lsrc + cc * 8);
  }
}
template <int NROWS, int NCOLS>
DI void stage_rows_st(u16* dst, int ldd, const uint4 (&r)[NROWS * (NCOLS / 8) / NTHR], int tid) {
  constexpr int CPR = NCOLS / 8, NCH = NROWS * CPR / NTHR;
#pragma unroll
  for (int i = 0; i < NCH; ++i) {
    const int c = tid + i * NTHR, row = c / CPR, cc = c % CPR;
    *reinterpret_cast<uint4*>(dst + row * ldd + cc * 8) = r[i];
  }
}
template <int NCOLS>
DI void stage_T_ld(uint4 (&r)[128 * (NCOLS / 8) / NTHR], const u16* src, size_t lsrc, int tid) {
  constexpr int NCH = 128 * (NCOLS / 8) / NTHR;
#pragma unroll
  for (int i = 0; i < NCH; ++i) {
    const int c = tid + i * NTHR, j = c & 127, cc = c >> 7;
    r[i] = *reinterpret_cast<const uint4*>(src + (size_t)j * lsrc + cc * 8);
  }
}
template <int NCOLS, class W>
DI void stage_T_st(u16* dst, int ldd, const uint4 (&r)[128 * (NCOLS / 8) / NTHR], int tid, W w) {
  constexpr int NCH = 128 * (NCOLS / 8) / NTHR;
#pragma unroll
  for (int i = 0; i < NCH; ++i) {
    const int c = tid + i * NTHR, j = c & 127, cc = c >> 7;
    float f[8];
    unpack8(r[i], f);
    const float wj = w(j);
#pragma unroll
    for (int e = 0; e < 8; ++e) dst[(cc * 8 + e) * ldd + j] = f2bf(f[e] * wj);
  }
}

DI void ph_ret_a(const Params& p, char* smem, int item) {
  const int tid = otid(), wid = tid >> 6, lane = tid & 63, fr = lane & 15, fq = lane >> 4;
  u16* sVt = reinterpret_cast<u16*>(smem);
  u16* sKf = sVt + 64 * 136;
  u16* sKb = sKf + 64 * 136;
  {
    const int c = item & 31, bh = item >> 5, b = bh >> 2, h = bh & 3;
    const float lg0 = log1pf(-exp2f(-5.f - (float)h)), lg1 = log1pf(-exp2f(-5.5f - (float)h));
    const u16* src = p.proj() + ((size_t)b * SEQ + c * 128) * PWP;
    {
      uint4 rv[2], rk[2];
      stage_T_ld<64>(rv, src + C_RV + h * 64, PWP, tid);
      stage_T_ld<64>(rk, src + C_RK + h * 64, PWP, tid);
      stage_T_st<64>(sVt, 136, rv, tid, [](int) { return 1.f; });
      stage_T_st<64>(sKf, 136, rk, tid, [&](int j) { return __expf(lg0 * (float)(127 - j)); });
      stage_T_st<64>(sKb, 136, rk, tid, [&](int j) { return __expf(lg1 * (float)j); });
    }
    __syncthreads();
    const int dir = wid >> 2, q = wid & 3;
    f32x4 acc[1][4];
    zero_acc(acc);
    wave_mm<1, 4, 4>(acc, sVt + q * 16 * 136, 136, dir ? sKb : sKf, 136, fr, fq);
    float* out = p.rU() + ((size_t)(bh * 32 + c) * 2 + dir) * 4096;
#pragma unroll
    for (int n = 0; n < 4; ++n)
#pragma unroll
      for (int j = 0; j < 4; ++j) out[(q * 16 + fq * 4 + j) * 64 + n * 16 + fr] = acc[0][n][j];
    __syncthreads();
  }
}
DI void ph_ret_scan(const Params& p) {
  const int gt = obid() * NTHR + otid(), gs = gridDim.x * NTHR;
  for (int it = gt; it < 16 * 2 * 4096; it += gs) {
    const int e = it & 4095, dir = (it >> 12) & 1, bh = it >> 13, h = bh & 3;
    const float lg = log1pf(-exp2f((dir ? -5.5f : -5.f) - (float)h));
    const float cd = __expf(lg * 128.f);
    float u[32];
#pragma unroll
    for (int c = 0; c < 32; ++c) u[c] = p.rU()[((size_t)(bh * 32 + c) * 2 + dir) * 4096 + e];
    float st = 0.f;
    if (dir == 0) {
#pragma unroll
      for (int c = 0; c < 32; ++c) {
        p.rS()[((size_t)(bh * 32 + c) * 2 + dir) * 4096 + e] = f2bf(st);
        st = st * cd + u[c];
      }
    } else {
#pragma unroll
      for (int c = 31; c >= 0; --c) {
        p.rS()[((size_t)(bh * 32 + c) * 2 + dir) * 4096 + e] = f2bf(st);
        st = st * cd + u[c];
      }
    }
  }
}
DI void ph_ret_c(const Params& p, char* smem, int item) {
  const int tid = otid(), wid = tid >> 6, lane = tid & 63, fr = lane & 15, fq = lane >> 4;
  u16* sQ = reinterpret_cast<u16*>(smem);
  u16* sK = sQ + 128 * 72;
  u16* sVt = sK + 128 * 72;
  u16* sSf = sVt + 64 * 136;
  u16* sSb = sSf + 64 * 72;
  u16* sP = sSb + 64 * 72;
  {
    const int c = item & 31, bh = item >> 5, b = bh >> 2, h = bh & 3;
    const float lg0 = log1pf(-exp2f(-5.f - (float)h)), lg1 = log1pf(-exp2f(-5.5f - (float)h));
    const size_t t0 = (size_t)b * SEQ + c * 128;
    const u16* src = p.proj() + t0 * PWP;
    {
      uint4 rq[2], rk[2], rv[2], rf[1], rb[1];
      stage_rows_ld<128, 64>(rq, src + C_RQ + h * 64, PWP, tid);
      stage_rows_ld<128, 64>(rk, src + C_RK + h * 64, PWP, tid);
      stage_T_ld<64>(rv, src + C_RV + h * 64, PWP, tid);
      stage_rows_ld<64, 64>(rf, p.rS() + ((size_t)(bh * 32 + c) * 2 + 0) * 4096, 64, tid);
      stage_rows_ld<64, 64>(rb, p.rS() + ((size_t)(bh * 32 + c) * 2 + 1) * 4096, 64, tid);
      stage_rows_st<128, 64>(sQ, 72, rq, tid);
      stage_rows_st<128, 64>(sK, 72, rk, tid);
      stage_T_st<64>(sVt, 136, rv, tid, [](int) { return 1.f; });
      stage_rows_st<64, 64>(sSf, 72, rf, tid);
      stage_rows_st<64, 64>(sSb, 72, rb, tid);
    }
    __syncthreads();
    {
      const int wr = wid >> 1, wc = wid & 1;
      f32x4 sacc[2][4];
      zero_acc(sacc);
      wave_mm<2, 4, 2>(sacc, sQ + wr * 32 * 72, 72, sK + wc * 64 * 72, 72, fr, fq);
#pragma unroll
      for (int m = 0; m < 2; ++m)
#pragma unroll
        for (int n = 0; n < 4; ++n)
#pragma unroll
          for (int j = 0; j < 4; ++j) {
            const int i = wr * 32 + m * 16 + fq * 4 + j, jj = wc * 64 + n * 16 + fr;
            const float dcy = (jj <= i) ? __expf(lg0 * (float)(i - jj)) : __expf(lg1 * (float)(jj - i));
            sP[i * 136 + jj] = f2bf(sacc[m][n][j] * dcy);
          }
    }
    __syncthreads();
    {
      f32x4 ai[1][4], af_[1][4], ab_[1][4];
      zero_acc(ai); zero_acc(af_); zero_acc(ab_);
      wave_mm<1, 4, 4>(ai, sP + wid * 16 * 136, 136, sVt, 136, fr, fq);
      wave_mm<1, 4, 2>(af_, sQ + wid * 16 * 72, 72, sSf, 72, fr, fq);
      wave_mm<1, 4, 2>(ab_, sQ + wid * 16 * 72, 72, sSb, 72, fr, fq);
#pragma unroll
      for (int j = 0; j < 4; ++j) {
        const int i = wid * 16 + fq * 4 + j;
        const float xf = __expf(lg0 * (float)(i + 1)), xb = __expf(lg1 * (float)(128 - i));
        float o[4], sum = 0.f;
#pragma unroll
        for (int n = 0; n < 4; ++n) { o[n] = ai[0][n][j] + xf * af_[0][n][j] + xb * ab_[0][n][j]; sum += o[n]; }
#pragma unroll
        for (int sft = 1; sft < 16; sft <<= 1) sum += __shfl_xor(sum, sft);
        const float mu = sum * (1.f / 64.f);
        float var = 0.f;
#pragma unroll
        for (int n = 0; n < 4; ++n) var += (o[n] - mu) * (o[n] - mu);
#pragma unroll
        for (int sft = 1; sft < 16; sft <<= 1) var += __shfl_xor(var, sft);
        const float rs = rsqrtf(var * (1.f / 64.f) + 1e-5f);
#pragma unroll
        for (int n = 0; n < 4; ++n) {
          const float g = bf2f(p.proj()[(t0 + i) * PWP + C_RG + h * 64 + n * 16 + fr]);
          p.mixed()[(t0 + i) * DM + h * 64 + n * 16 + fr] = f2bf(silu(g) * (o[n] - mu) * rs);
        }
      }
    }
    __syncthreads();
  }
}

DI void ssd_local_cumsum(const Params& p, int L, size_t t0, float* cum, float* dtl, int wid, int lane) {
  const int dir = wid >> 2, h = wid & 3;
  const float a = -__expf(p.a_log[L * 8 + dir * 4 + h]);
  float d0, d1;
  if (dir == 0) { d0 = p.dtv()[(t0 + 2 * lane) * 8 + h]; d1 = p.dtv()[(t0 + 2 * lane + 1) * 8 + h]; }
  else { d0 = p.dtv()[(t0 + 127 - 2 * lane) * 8 + 4 + h]; d1 = p.dtv()[(t0 + 126 - 2 * lane) * 8 + 4 + h]; }
  float v0 = d0 * a, v1 = v0 + d1 * a;
  float run = v1;
#pragma unroll
  for (int o = 1; o < 64; o <<= 1) {
    const float u = __shfl_up(run, o);
    if (lane >= o) run += u;
  }
  const float excl = run - v1;
  v0 += excl; v1 += excl;
  float* cr = cum + (dir * 4 + h) * 128;
  float* dr = dtl + (dir * 4 + h) * 128;
  if (dir == 0) { cr[2 * lane] = v0; cr[2 * lane + 1] = v1; dr[2 * lane] = d0; dr[2 * lane + 1] = d1; }
  else { cr[127 - 2 * lane] = v0; cr[126 - 2 * lane] = v1; dr[127 - 2 * lane] = d0; dr[126 - 2 * lane] = d1; }
}

DI void ph_ssd_a(const Params& p, int L, char* smem, int item) {
  const int tid = otid(), wid = tid >> 6, lane = tid & 63, fr = lane & 15, fq = lane >> 4;
  u16* sBt = reinterpret_cast<u16*>(smem);
  u16* sXf = sBt + 2 * 128 * 136;
  u16* sXb = sXf + 64 * 136;
  float* cum = reinterpret_cast<float*>(sXb + 64 * 136);
  float* dtl = cum + 8 * 128;
  {
    const int c = item & 31, b = item >> 5;
    const size_t t0 = (size_t)b * SEQ + c * 128;
    ssd_local_cumsum(p, L, t0, cum, dtl, wid, lane);
    stage_T<256>(sBt, 136, p.xbc() + t0 * 768 + 256, 768, tid, [](int) { return 1.f; });
    __syncthreads();
    if (tid < 8) {
      const int dir = tid >> 2;
      p.cdec()[(size_t)item * 8 + tid] = __expf(dir ? cum[tid * 128 + 0] : cum[tid * 128 + 127]);
    }
    for (int h = 0; h < 4; ++h) {
      const float* cf = cum + h * 128;
      const float* cb = cum + (4 + h) * 128;
      const float* df = dtl + h * 128;
      const float* db = dtl + (4 + h) * 128;
      const float endf = cf[127], endb = cb[0];
      {
        uint4 rx[2];
        stage_T_ld<64>(rx, p.xbc() + t0 * 768 + h * 64, 768, tid);
        stage_T_st<64>(sXf, 136, rx, tid, [&](int l) { return __expf(endf - cf[l]) * df[l]; });
        stage_T_st<64>(sXb, 136, rx, tid, [&](int l) { return __expf(endb - cb[l]) * db[l]; });
      }
      __syncthreads();
      const int dir = wid >> 2, q = wid & 3, g = h >> 1;
      f32x4 acc[4][2];
      zero_acc(acc);
      wave_mm<4, 2, 4>(acc, dir ? sXb : sXf, 136, sBt + (g * 128 + q * 32) * 136, 136, fr, fq);
      float* out = p.sU() + ((size_t)item * 8 + h * 2 + dir) * 8192;
#pragma unroll
      for (int m = 0; m < 4; ++m)
#pragma unroll
        for (int n = 0; n < 2; ++n)
#pragma unroll
          for (int j = 0; j < 4; ++j) out[(m * 16 + fq * 4 + j) * 128 + q * 32 + n * 16 + fr] = acc[m][n][j];
      __syncthreads();
    }
  }
}
DI void ph_ssd_scan(const Params& p) {
  const int gt = obid() * NTHR + otid(), gs = gridDim.x * NTHR;
  for (int it = gt; it < 4 * 8 * 8192; it += gs) {
    const int e = it & 8191, hd = (it >> 13) & 7, b = it >> 16;
    const int dir = hd & 1, h = hd >> 1;
    float u[32];
#pragma unroll
    for (int c = 0; c < 32; ++c) u[c] = p.sU()[((size_t)(b * 32 + c) * 8 + hd) * 8192 + e];
    float st = 0.f;
    if (dir == 0) {
#pragma unroll
      for (int c = 0; c < 32; ++c) {
        p.sS()[((size_t)(b * 32 + c) * 8 + hd) * 8192 + e] = f2bf(st);
        st = st * p.cdec()[(size_t)(b * 32 + c) * 8 + dir * 4 + h] + u[c];
      }
    } else {
#pragma unroll
      for (int c = 31; c >= 0; --c) {
        p.sS()[((size_t)(b * 32 + c) * 8 + hd) * 8192 + e] = f2bf(st);
        st = st * p.cdec()[(size_t)(b * 32 + c) * 8 + dir * 4 + h] + u[c];
      }
    }
  }
}
DI void ph_ssd_c(const Params& p, int L, char* smem, int item) {
  const int tid = otid(), wid = tid >> 6, lane = tid & 63, fr = lane & 15, fq = lane >> 4;
  u16* sC = reinterpret_cast<u16*>(smem);
  u16* sB = sC + 128 * 136;
  u16* sXt = sB + 128 * 136;
  u16* sSf = sXt + 64 * 136;
  u16* sSb = sSf + 64 * 136;
  float* cum = reinterpret_cast<float*>(sSb + 64 * 136);
  float* dtl = cum + 8 * 128;
  {
    const int c = item & 31, b = item >> 5;
    const size_t t0 = (size_t)b * SEQ + c * 128;
    ssd_local_cumsum(p, L, t0, cum, dtl, wid, lane);
    float ssq[4] = {0.f, 0.f, 0.f, 0.f};
#pragma unroll 1
    for (int g = 0; g < 2; ++g) {
      {
        uint4 rc[4], rb4[4];
        stage_rows_ld<128, 128>(rc, p.xbc() + t0 * 768 + 512 + g * 128, 768, tid);
        stage_rows_ld<128, 128>(rb4, p.xbc() + t0 * 768 + 256 + g * 128, 768, tid);
        stage_rows_st<128, 128>(sC, 136, rc, tid);
        stage_rows_st<128, 128>(sB, 136, rb4, tid);
      }
      __syncthreads();
      const int wr = wid >> 1, wc = wid & 1;
      f32x4 G[2][4];
      zero_acc(G);
      wave_mm<2, 4, 4>(G, sC + wr * 32 * 136, 136, sB + wc * 64 * 136, 136, fr, fq);
      __syncthreads();
#pragma unroll 1
      for (int hl = 0; hl < 2; ++hl) {
        const int h = g * 2 + hl;
        const float* cf = cum + h * 128;
        const float* cb = cum + (4 + h) * 128;
        const float* df = dtl + h * 128;
        const float* db = dtl + (4 + h) * 128;
        uint4 rxt[2], rsf[2], rsb[2];
        stage_T_ld<64>(rxt, p.xbc() + t0 * 768 + h * 64, 768, tid);
        stage_rows_ld<64, 128>(rsf, p.sS() + ((size_t)item * 8 + h * 2 + 0) * 8192, 128, tid);
        stage_rows_ld<64, 128>(rsb, p.sS() + ((size_t)item * 8 + h * 2 + 1) * 8192, 128, tid);
#pragma unroll
        for (int m = 0; m < 2; ++m)
#pragma unroll
          for (int n = 0; n < 4; ++n)
#pragma unroll
            for (int j = 0; j < 4; ++j) {
              const int l = wr * 32 + m * 16 + fq * 4 + j, sx = wc * 64 + n * 16 + fr;
              const float w = (sx <= l) ? __expf(cf[l] - cf[sx]) * df[sx] : __expf(cb[l] - cb[sx]) * db[sx];
              sB[l * 136 + sx] = f2bf(G[m][n][j] * w);
            }
        stage_T_st<64>(sXt, 136, rxt, tid, [](int) { return 1.f; });
        stage_rows_st<64, 128>(sSf, 136, rsf, tid);
        stage_rows_st<64, 128>(sSb, 136, rsb, tid);
        __syncthreads();
        f32x4 yd[1][4], yf[1][4], yb[1][4];
        zero_acc(yd); zero_acc(yf); zero_acc(yb);
        wave_mm<1, 4, 4>(yd, sB + wid * 16 * 136, 136, sXt, 136, fr, fq);
        wave_mm<1, 4, 4>(yf, sC + wid * 16 * 136, 136, sSf, 136, fr, fq);
        wave_mm<1, 4, 4>(yb, sC + wid * 16 * 136, 136, sSb, 136, fr, fq);
        const float dsk = p.ssm_d[L * 4 + h];
#pragma unroll
        for (int j = 0; j < 4; ++j) {
          const int l = wid * 16 + fq * 4 + j;
          const float ef = __expf(cf[l]), eb = __expf(cb[l]);
#pragma unroll
          for (int n = 0; n < 4; ++n) {
            const int ch = h * 64 + n * 16 + fr;
            const float xv = bf2f(p.xbc()[(t0 + l) * 768 + ch]);
            const float z = bf2f(p.proj()[(t0 + l) * PWP + C_Z + ch]);
            const float yv = (yd[0][n][j] + ef * yf[0][n][j] + eb * yb[0][n][j] + dsk * xv) * silu(z);
            ssq[j] += yv * yv;
            p.ybuf()[(t0 + l) * 256 + ch] = yv;
          }
        }
        __syncthreads();
      }
    }
    const float* nwt = p.ssm_norm_w + L * 256;
#pragma unroll
    for (int j = 0; j < 4; ++j) {
      float ss = ssq[j];
#pragma unroll
      for (int sft = 1; sft < 16; sft <<= 1) ss += __shfl_xor(ss, sft);
      const float rstd = rsqrtf(ss * (1.f / 256.f) + 1e-6f);
      const int l = wid * 16 + fq * 4 + j;
#pragma unroll
      for (int hn = 0; hn < 16; ++hn) {
        const int ch = hn * 16 + fr;
        p.mixed()[(t0 + l) * DM + 512 + ch] = f2bf(p.ybuf()[(t0 + l) * 256 + ch] * rstd * nwt[ch]);
      }
    }
  }
}

template <bool XIN_F32>
struct CfgOutproj {
  static constexpr bool PERM = true;
  int K; const Params* p; int L; int bid, nb; const void* xin; u16* xout;
  DI bool next(int i, pg8::Unit& u) const { const int t = i * nb + bid; if (t >= 64 * 4) return false; u.pm = t & 63; u.pn = t >> 6; return true; }
  DI const char* a_base(const pg8::Unit& u) const { return (const char*)(p->mixed() + (size_t)u.pm * 256 * DM); }
  DI const char* b_base(const pg8::Unit& u) const { return (const char*)(p->WoutT() + ((size_t)L * DM + (size_t)u.pn * 256) * DM); }
  DI void a_off(const pg8::Unit&, int R0, int C0, int R1, int C1, unsigned (&vo)[4]) const {
    vo[0] = (unsigned)(R0 * DM + C0) * 2u; vo[1] = (unsigned)(R1 * DM + C1) * 2u;
    vo[2] = vo[0] + 128u * DM * 2u; vo[3] = vo[1] + 128u * DM * 2u;
  }
  DI void epi(const f32x4 (&acc)[2][2][4][2], const pg8::Unit& u, int wr, int wc, int fr, int fq) const {
    const int row0 = u.pm * 256 + wr * 64 + fr, col0 = u.pn * 256 + wc * 32 + 8 * fq;
#pragma unroll
    for (int ai = 0; ai < 2; ++ai)
#pragma unroll
      for (int m = 0; m < 4; ++m) {
        const size_t ro = (size_t)(row0 + ai * 128 + m * 16) * DM + col0;
#pragma unroll
        for (int bj = 0; bj < 2; ++bj) {
          const size_t o = ro + bj * 128;
          float4 x0, x1;
          if (XIN_F32) {
            x0 = *reinterpret_cast<const float4*>(static_cast<const float*>(xin) + o);
            x1 = *reinterpret_cast<const float4*>(static_cast<const float*>(xin) + o + 4);
          } else {
            const uint4 q = *reinterpret_cast<const uint4*>(static_cast<const u16*>(xin) + o);
            x0 = bf4_to_f4(make_uint2(q.x, q.y)); x1 = bf4_to_f4(make_uint2(q.z, q.w));
          }
          const f32x4 a0 = acc[ai][bj][m][0], a1 = acc[ai][bj][m][1];
          uint4 w;
          w.x = pack2(x0.x + a0[0], x0.y + a0[1]); w.y = pack2(x0.z + a0[2], x0.w + a0[3]);
          w.z = pack2(x1.x + a1[0], x1.y + a1[1]); w.w = pack2(x1.z + a1[2], x1.w + a1[3]);
          *reinterpret_cast<uint4*>(xout + o) = w;
        }
      }
  }
};
DI void ph_outproj(const Params& p, int L, char* smem) {
  if (L == 0) {
    CfgOutproj<true> c; c.K = DM; c.p = &p; c.L = L; c.bid = obid(); c.nb = gridDim.x; c.xin = p.x; c.xout = p.xres();
    pg8::gemm_phase((pg8::lds_u8*)smem, c);
  } else {
    CfgOutproj<false> c; c.K = DM; c.p = &p; c.L = L; c.bid = obid(); c.nb = gridDim.x; c.xin = p.xres2(); c.xout = p.xres();
    pg8::gemm_phase((pg8::lds_u8*)smem, c);
  }
}

DI void ph_rms2_router(const Params& p, int L, const u16* xres, char* smem) {
  const int tid = otid(), lane = tid & 63, gw = (obid() * NTHR + tid) >> 6, nw = gridDim.x * (NTHR / 64);
  const float* w = p.ln2_w + L * DM;
  const float* rw = p.router_w + (size_t)L * DM * 16;
  float4* srw = reinterpret_cast<float4*>(smem);
  for (int i = tid; i < 4096; i += NTHR) {
    const int c = i >> 2, e4 = i & 3;
    srw[(e4 * 4 + (c & 3)) * 256 + (c >> 2)] = *reinterpret_cast<const float4*>(rw + (size_t)i * 4);
  }
  __syncthreads();
  const int b5 = (lane >> 5) & 1, b4 = (lane >> 4) & 1, b3 = (lane >> 3) & 1, b2 = (lane >> 2) & 1;
  const int my_e = 8 * b5 + 4 * b4 + 2 * b3 + b2;
  float4 v[4];
  if (gw < T) {
#pragma unroll
    for (int i = 0; i < 4; ++i) v[i] = bf4_to_f4(*reinterpret_cast<const uint2*>(xres + (size_t)gw * DM + (i * 64 + lane) * 4));
  }
  for (int t = gw; t < T; t += nw) {
    uint2 vnx[4];
    const int tn = (t + nw < T) ? (t + nw) : t;
#pragma unroll
    for (int i = 0; i < 4; ++i) vnx[i] = *reinterpret_cast<const uint2*>(xres + (size_t)tn * DM + (i * 64 + lane) * 4);
    float ss = 0.f;
#pragma unroll
    for (int i = 0; i < 4; ++i) ss += v[i].x * v[i].x + v[i].y * v[i].y + v[i].z * v[i].z + v[i].w * v[i].w;
    ss = wave_sum(ss);
    const float rstd = rsqrtf(ss * (1.f / DM) + 1e-6f);
    float lg[16];
#pragma unroll
    for (int e = 0; e < 16; ++e) lg[e] = 0.f;
#pragma unroll
    for (int i = 0; i < 4; ++i) {
      const int q = i * 64 + lane;
      const float4 ww = *reinterpret_cast<const float4*>(w + q * 4);
      const float hv[4] = {v[i].x * rstd * ww.x, v[i].y * rstd * ww.y, v[i].z * rstd * ww.z, v[i].w * rstd * ww.w};
      *reinterpret_cast<unsigned*>(p.hn8() + (size_t)t * DM + q * 4) =
          pk4_f8(hv[0] * F8_H_SCALE, hv[1] * F8_H_SCALE, hv[2] * F8_H_SCALE, hv[3] * F8_H_SCALE);
#pragma unroll
      for (int j = 0; j < 4; ++j)
#pragma unroll
        for (int e4 = 0; e4 < 4; ++e4) {
          const float4 r = srw[(e4 * 4 + j) * 256 + q];
          lg[e4 * 4 + 0] += hv[j] * r.x; lg[e4 * 4 + 1] += hv[j] * r.y;
          lg[e4 * 4 + 2] += hv[j] * r.z; lg[e4 * 4 + 3] += hv[j] * r.w;
        }
      __builtin_amdgcn_sched_barrier(0);
    }
#pragma unroll
    for (int k = 0; k < 8; ++k) {
      const float send = b5 ? lg[k] : lg[k + 8], keep = b5 ? lg[k + 8] : lg[k];
      lg[k] = keep + __shfl_xor(send, 32);
    }
#pragma unroll
    for (int k = 0; k < 4; ++k) {
      const float send = b4 ? lg[k] : lg[k + 4], keep = b4 ? lg[k + 4] : lg[k];
      lg[k] = keep + __shfl_xor(send, 16);
    }
#pragma unroll
    for (int k = 0; k < 2; ++k) {
      const float send = b3 ? lg[k] : lg[k + 2], keep = b3 ? lg[k + 2] : lg[k];
      lg[k] = keep + __shfl_xor(send, 8);
    }
    float lv;
    {
      const float send = b2 ? lg[0] : lg[1], keep = b2 ? lg[1] : lg[0];
      lv = keep + __shfl_xor(send, 4);
    }
    lv += __shfl_xor(lv, 2);
    lv += __shfl_xor(lv, 1);
    float mx = lv;
    mx = fmaxf(mx, __shfl_xor(mx, 4)); mx = fmaxf(mx, __shfl_xor(mx, 8));
    mx = fmaxf(mx, __shfl_xor(mx, 16)); mx = fmaxf(mx, __shfl_xor(mx, 32));
    const float ex = expf(lv - mx);
    float den = ex;
    den += __shfl_xor(den, 4); den += __shfl_xor(den, 8); den += __shfl_xor(den, 16); den += __shfl_xor(den, 32);
    if ((lane & 3) == 0) { p.aff()[(size_t)t * 16 + my_e] = ex / den; p.inv()[(size_t)t * 16 + my_e] = -1; }
#pragma unroll
    for (int i = 0; i < 4; ++i) v[i] = bf4_to_f4(vnx[i]);
  }
}

DI int block_sum_i(int v, int* red, int tid) {
#pragma unroll
  for (int o = 32; o > 0; o >>= 1) v += __shfl_xor(v, o);
  __syncthreads();
  if ((tid & 63) == 0) red[tid >> 6] = v;
  __syncthreads();
  int t = 0;
#pragma unroll
  for (int w = 0; w < NTHR / 64; ++w) t += red[w];
  return t;
}
DI void ph_topk(const Params& p, char* smem) {
  int* red = reinterpret_cast<int*>(smem);
  int* wsum = red + 16;
  const int tid = otid(), wid = tid >> 6, lane = tid & 63;
  for (int it = obid(); it < 64; it += gridDim.x) {
    const int e = it & 15, b = it >> 4;
    unsigned v[8];
#pragma unroll
    for (int i = 0; i < 8; ++i) v[i] = __float_as_uint(p.aff()[(size_t)(b * SEQ + tid * 8 + i) * 16 + e]);
    unsigned thr = 0;
#pragma unroll 1
    for (int bit = 30; bit >= 0; --bit) {
      const unsigned cand = thr | (1u << bit);
      int cnt = 0;
#pragma unroll
      for (int i = 0; i < 8; ++i) cnt += (v[i] >= cand) ? 1 : 0;
      if (block_sum_i(cnt, red, tid) >= 512) thr = cand;
    }
    int ngt = 0, ntie = 0;
#pragma unroll
    for (int i = 0; i < 8; ++i) { ngt += (v[i] > thr) ? 1 : 0; ntie += (v[i] == thr) ? 1 : 0; }
    int ig = ngt, itie = ntie;
#pragma unroll
    for (int o = 1; o < 64; o <<= 1) {
      const int a = __shfl_up(ig, o), c = __shfl_up(itie, o);
      if (lane >= o) { ig += a; itie += c; }
    }
    __syncthreads();
    if (lane == 63) { wsum[wid] = ig; wsum[8 + wid] = itie; }
    __syncthreads();
    int og = 0, ot = 0, totg = 0;
#pragma unroll
    for (int w = 0; w < 8; ++w) {
      const int a = wsum[w], c = wsum[8 + w];
      if (w < wid) { og += a; ot += c; }
      totg += a;
    }
    int pg = og + ig - ngt, pt = ot + itie - ntie;
    const int base = (e * 4 + b) * 512;
#pragma unroll
    for (int i = 0; i < 8; ++i) {
      int slot = -1;
      if (v[i] > thr) { slot = pg; ++pg; }
      else if (v[i] == thr) { if (totg + pt < 512) slot = totg + pt; ++pt; }
      if (slot >= 0) {
        p.tok()[base + slot] = b * SEQ + tid * 8 + i;
        p.inv()[(size_t)(b * SEQ + tid * 8 + i) * 16 + e] = base + slot;
        p.gate()[base + slot] = __uint_as_float(v[i]);
      }
    }
    __syncthreads();
  }
}

struct CfgMoe1 {
  static constexpr bool PERM = true;
  int K; const Params* p; int L; int bid, nb;
  DI bool next(int i, pg8::Unit& u) const {
    const int t = i * nb + bid; if (t >= 16 * 16 * 8) return false;
    const int rnd = t >> 8, w = t & 255, xcd = w & 7, jx = w >> 3, pid = xcd * 4 + (jx >> 3);
    const int mt = jx & 7, nt = pid & 15, e = rnd * 2 + (pid >> 4);
    u.pm = e * 8 + mt; u.pn = e * 16 + nt; return true;
  }
  DI const char* a_base(const pg8::Unit&) const { return (const char*)p->hn8(); }
  DI const char* b_base(const pg8::Unit& u) const { return (const char*)(p->Wgu8() + ((size_t)L * 16 * 4096 + (size_t)u.pn * 256) * DM); }
  const int* tokl;
  DI void a_off(const pg8::Unit&, int R0, int C0, int R1, int C1, unsigned (&vo)[4], int ui) const {
    const int* tk = tokl + ui * 256;
    vo[0] = (unsigned)(tk[R0] * 512 + C0) * 2u; vo[1] = (unsigned)(tk[R1] * 512 + C1) * 2u;
    vo[2] = (unsigned)(tk[128 + R0] * 512 + C0) * 2u; vo[3] = (unsigned)(tk[128 + R1] * 512 + C1) * 2u;
  }
  DI void epi(const f32x4 (&acc)[2][2][4][2], const pg8::Unit& u, int wr, int wc, int fr, int fq) const {
    const int row0 = u.pm * 256 + wr * 64 + fr, col0 = (u.pn & 15) * 128 + wc * 32 + 8 * fq;
    const float dq = 1.f / (F8_H_SCALE * F8_W_SCALE);
#pragma unroll
    for (int ai = 0; ai < 2; ++ai)
#pragma unroll
      for (int m = 0; m < 4; ++m) {
        const f32x4 g0 = acc[ai][0][m][0] * dq, g1 = acc[ai][0][m][1] * dq, u0 = acc[ai][1][m][0] * (dq * F8_HID_SCALE), u1 = acc[ai][1][m][1] * (dq * F8_HID_SCALE);
        uint2 w;
        w.x = pk4_f8(fast_silu(g0[0]) * u0[0], fast_silu(g0[1]) * u0[1], fast_silu(g0[2]) * u0[2], fast_silu(g0[3]) * u0[3]);
        w.y = pk4_f8(fast_silu(g1[0]) * u1[0], fast_silu(g1[1]) * u1[1], fast_silu(g1[2]) * u1[2], fast_silu(g1[3]) * u1[3]);
        *reinterpret_cast<uint2*>(p->hid8() + (size_t)(row0 + ai * 128 + m * 16) * 2048 + col0) = w;
      }
  }
};
DI void ph_moe1(const Params& p, int L, char* smem) {
  CfgMoe1 c; c.K = 512; c.p = &p; c.L = L; c.bid = obid(); c.nb = gridDim.x;
  int* tokl = reinterpret_cast<int*>(smem + 131072);
  c.tokl = tokl;
  for (int idx = otid(); idx < 8 * 256; idx += NTHR) {
    pg8::Unit u;
    if (c.next(idx >> 8, u)) tokl[idx] = p.tok()[u.pm * 256 + (idx & 255)];
  }
  __syncthreads();
  pg8::gemm_phase_f8((pg8::lds_u8*)smem, c);
}
struct CfgMoe2 {
  static constexpr bool PERM = true;
  int K; const Params* p; int L; int bid, nb;
  DI bool next(int i, pg8::Unit& u) const {
    const int t = i * nb + bid; if (t >= 16 * 4 * 8) return false;
    const int rnd = t >> 8, w = t & 255, xcd = w & 7, jx = w >> 3, pid = rnd * 32 + xcd * 4 + (jx >> 3);
    u.pm = (pid >> 2) * 8 + (jx & 7); u.pn = pid; return true;
  }
  DI const char* a_base(const pg8::Unit& u) const { return (const char*)(p->hid8() + (size_t)u.pm * 256 * 2048); }
  DI const char* b_base(const pg8::Unit& u) const { return (const char*)(p->Wd8() + ((size_t)L * 16 * DM + (size_t)u.pn * 256) * 2048); }
  DI void a_off(const pg8::Unit&, int R0, int C0, int R1, int C1, unsigned (&vo)[4], int) const {
    vo[0] = (unsigned)(R0 * 1024 + C0) * 2u; vo[1] = (unsigned)(R1 * 1024 + C1) * 2u;
    vo[2] = vo[0] + 128u * 1024u * 2u; vo[3] = vo[1] + 128u * 1024u * 2u;
  }
  DI void epi(const f32x4 (&acc)[2][2][4][2], const pg8::Unit& u, int wr, int wc, int fr, int fq) const {
    unsigned char* eo = reinterpret_cast<unsigned char*>(p->proj());
    const int row0 = u.pm * 256 + wr * 64 + fr, col0 = (u.pn & 3) * 256 + wc * 32 + 8 * fq;
#pragma unroll
    for (int ai = 0; ai < 2; ++ai)
#pragma unroll
      for (int m = 0; m < 4; ++m) {
        const int row = row0 + ai * 128 + m * 16;
        const float gt = p->gate()[row] * (F8_EO_SCALE / (F8_HID_SCALE * F8_W_SCALE));
#pragma unroll
        for (int bj = 0; bj < 2; ++bj) {
          const f32x4 a0 = acc[ai][bj][m][0], a1 = acc[ai][bj][m][1];
          uint2 w;
          w.x = pk4_f8(gt * a0[0], gt * a0[1], gt * a0[2], gt * a0[3]);
          w.y = pk4_f8(gt * a1[0], gt * a1[1], gt * a1[2], gt * a1[3]);
          *reinterpret_cast<uint2*>(eo + (size_t)row * DM + col0 + bj * 128) = w;
        }
      }
  }
};
DI void ph_moe2(const Params& p, int L, char* smem) {
  CfgMoe2 c; c.K = 1024; c.p = &p; c.L = L; c.bid = obid(); c.nb = gridDim.x;
  pg8::gemm_phase_f8((pg8::lds_u8*)smem, c);
}
template <bool FINAL>
DI void ph_combine_norm(const Params& p, const u16* __restrict__ xa, u16* __restrict__ xnew, const float* __restrict__ w,
                        u16* __restrict__ hn_out, float* __restrict__ f_out) {
  const int tid_ = otid(), lane = tid_ & 63, gw = (obid() * NTHR + tid_) >> 6, nw = gridDim.x * (NTHR / 64);
  const unsigned char* eo = reinterpret_cast<const unsigned char*>(p.proj());
  float4 v[4];
  int myrow = -1;
  if (gw < T) {
#pragma unroll
    for (int i = 0; i < 4; ++i) v[i] = bf4_to_f4(*reinterpret_cast<const uint2*>(xa + (size_t)gw * DM + (i * 64 + lane) * 4));
    myrow = (lane < 16) ? p.inv()[(size_t)gw * 16 + lane] : -1;
  }
  for (int t = gw; t < T; t += nw) {
    uint2 vnx[4];
    const int tn = (t + nw < T) ? (t + nw) : t;
#pragma unroll
    for (int i = 0; i < 4; ++i) vnx[i] = *reinterpret_cast<const uint2*>(xa + (size_t)tn * DM + (i * 64 + lane) * 4);
    const int myrow_nx = (lane < 16) ? p.inv()[(size_t)tn * 16 + lane] : -1;
    unsigned long long mask = __builtin_amdgcn_ballot_w64(myrow >= 0);
#pragma unroll 1
    while (mask != 0ull) {
      const int e0 = __builtin_ctzll(mask);
      mask &= mask - 1ull;
      const int r0 = __builtin_amdgcn_readlane(myrow, e0);
      int r1 = -1;
      if (mask != 0ull) { const int e1 = __builtin_ctzll(mask); mask &= mask - 1ull; r1 = __builtin_amdgcn_readlane(myrow, e1); }
      unsigned q0[4], q1[4];
#pragma unroll
      for (int i = 0; i < 4; ++i) q0[i] = *reinterpret_cast<const unsigned*>(eo + (size_t)r0 * DM + (i * 64 + lane) * 4);
      const int r1c = (r1 >= 0) ? r1 : r0;
#pragma unroll
      for (int i = 0; i < 4; ++i) q1[i] = *reinterpret_cast<const unsigned*>(eo + (size_t)r1c * DM + (i * 64 + lane) * 4);
      const float s0 = 1.f / F8_EO_SCALE, s1 = (r1 >= 0) ? (1.f / F8_EO_SCALE) : 0.f;
#pragma unroll
      for (int i = 0; i < 4; ++i) {
        const auto a01 = __builtin_amdgcn_cvt_pk_f32_fp8((int)q0[i], false), a23 = __builtin_amdgcn_cvt_pk_f32_fp8((int)q0[i], true);
        const auto b01 = __builtin_amdgcn_cvt_pk_f32_fp8((int)q1[i], false), b23 = __builtin_amdgcn_cvt_pk_f32_fp8((int)q1[i], true);
        v[i].x += s0 * a01[0] + s1 * b01[0]; v[i].y += s0 * a01[1] + s1 * b01[1];
        v[i].z += s0 * a23[0] + s1 * b23[0]; v[i].w += s0 * a23[1] + s1 * b23[1];
      }
    }
    float ss = 0.f;
#pragma unroll
    for (int i = 0; i < 4; ++i) ss += v[i].x * v[i].x + v[i].y * v[i].y + v[i].z * v[i].z + v[i].w * v[i].w;
    ss = wave_sum(ss);
    const float rstd = rsqrtf(ss * (1.f / DM) + 1e-6f);
#pragma unroll
    for (int i = 0; i < 4; ++i) {
      const int c = (i * 64 + lane) * 4;
      const float4 ww = *reinterpret_cast<const float4*>(w + c);
      if (FINAL) {
        *reinterpret_cast<float4*>(f_out + (size_t)t * DM + c) = make_float4(v[i].x * rstd * ww.x, v[i].y * rstd * ww.y, v[i].z * rstd * ww.z, v[i].w * rstd * ww.w);
      } else {
        uint2 xo;
        xo.x = pack2(v[i].x, v[i].y); xo.y = pack2(v[i].z, v[i].w);
        *reinterpret_cast<uint2*>(xnew + (size_t)t * DM + c) = xo;
        uint2 o;
        o.x = pack2(v[i].x * rstd * ww.x, v[i].y * rstd * ww.y);
        o.y = pack2(v[i].z * rstd * ww.z, v[i].w * rstd * ww.w);
        *reinterpret_cast<uint2*>(hn_out + (size_t)t * DM + c) = o;
      }
    }
#pragma unroll
    for (int i = 0; i < 4; ++i) v[i] = bf4_to_f4(vnx[i]);
    myrow = myrow_nx;
  }
}

__global__ void __launch_bounds__(NTHR) mk(Params p) {
  extern __shared__ __attribute__((aligned(16))) char smem[];
  cg::grid_group grid = cg::this_grid();
  __shared__ uint4 xb_words;
  if (threadIdx.x == 0) xb_words = make_uint4(0u, 0u, 0u, 0u);
  __syncthreads();
  XcdBarrier xb = xcd_barrier_post(p.bar(), (volatile LAS unsigned*)&xb_words);
  ph_convert(p, smem);
  ph_rmsnorm_bf16(p.x, p.ln1_w, p.hn());
  xcd_barrier(xb);
  if (p.rep[12] == 0x7fffffff) grid.sync();
  for (int L = 0; L < 2; ++L) {
    u16* xout = p.xres();
    if (L == 1) {
      ph_combine_norm<false>(p, p.xres(), p.xres2(), p.ln1_w + DM, p.hn(), nullptr);
      xcd_barrier(xb);
    }
    ph_inproj(p, L, smem);
    xcd_barrier(xb);
    ph_post(p, L);
    xcd_barrier(xb);
    {
      unsigned* ctr = p.bar() + XCD_BAR_WORDS + 8 + L;
      __shared__ int q1_item;
      for (;;) {
        if (threadIdx.x == 0) q1_item = (int)atomicAdd(ctr, 1u);
        __syncthreads();
        const int it = q1_item;
        __syncthreads();
        if (it >= 1344) break;
        if (it < 256) ph_dil_pass<0>(p, smem, it);
        else if (it < 384) ph_ssd_a(p, L, smem, it - 256);
        else if (it < 576) ph_mla_up_q(p, L, smem, it - 384);
        else if (it < 832) ph_mla_up_kv(p, L, smem, it - 576);
        else ph_ret_a(p, smem, it - 832);
      }
    }
    xcd_barrier(xb);
    {
      { ph_ret_scan(p); ph_ssd_scan(p); }
      unsigned* scn = p.bar() + XCD_BAR_WORDS + 32 + L;
      asm volatile("s_waitcnt vmcnt(0)" ::: "memory");
      __syncthreads();
      if (threadIdx.x == 0) { __builtin_amdgcn_fence(__ATOMIC_RELEASE, "agent"); asm volatile("s_waitcnt vmcnt(0)" ::: "memory"); (void)xb_add(scn, 1u); }
      ph_mla_attn(p, smem, L);
      if (threadIdx.x == 0) {
        unsigned sp_ = 0;
        while (xb_ld(scn) < gridDim.x) { __builtin_amdgcn_s_sleep(1); if (++sp_ > XB_SPIN_CAP) break; }
        __builtin_amdgcn_fence(__ATOMIC_ACQUIRE, "agent");
        asm volatile("s_waitcnt vmcnt(0)" ::: "memory");
      }
      __syncthreads();
      unsigned* ctr = p.bar() + XCD_BAR_WORDS + L;
      __shared__ int q_item;
      for (;;) {
        if (threadIdx.x == 0) q_item = (int)atomicAdd(ctr, 1u);
        __syncthreads();
        const int it = q_item;
        __syncthreads();
        if (it >= 896) break;
        if (it < 128) ph_ssd_c(p, L, smem, it);
        else if (it < 384) ph_dil_pass<1>(p, smem, it - 128);
        else ph_ret_c(p, smem, it - 384);
      }
    }
    xcd_barrier(xb);
    ph_outproj(p, L, smem);
    xcd_barrier(xb);
    ph_rms2_router(p, L, xout, smem);
    xcd_barrier(xb);
    ph_topk(p, smem);
    if (gridDim.x == 256 && obid() >= CVT_IDLE_FIRST_BLK) cvt_tiles_idle(p, L, smem, CVT_A, CVT_NB);
    xcd_barrier(xb);
    ph_moe1(p, L, smem);
    xcd_barrier(xb);
    ph_moe2(p, L, smem);
    xcd_barrier(xb);
  }
  ph_combine_norm<true>(p, p.xres(), nullptr, p.final_w, nullptr, p.out);
}

extern "C" void kernel_launch(void* const* d_in, const int* in_sizes, int n_in, void* d_out, int out_size, void* d_ws,
                              size_t ws_size, hipStream_t stream) {
  static int grid_blocks = 0;
  if (!grid_blocks) {
    int dev = 0, cus = 0, per_cu = 0;
    (void)hipGetDevice(&dev);
    (void)hipDeviceGetAttribute(&cus, hipDeviceAttributeMultiprocessorCount, dev);
    (void)hipFuncSetAttribute((const void*)mk, hipFuncAttributeMaxDynamicSharedMemorySize, LDS_BYTES);
    (void)hipOccupancyMaxActiveBlocksPerMultiprocessor(&per_cu, (const void*)mk, NTHR, LDS_BYTES);
    if (per_cu < 1) { fprintf(stderr, "occupancy query says %d blocks/CU\n", per_cu); per_cu = 1; }
    grid_blocks = cus * 1;
  }
  Params p{};
  const float** fp = reinterpret_cast<const float**>(&p);
  for (int i = 0; i < 20; ++i) fp[i] = (const float*)d_in[i];
  p.out = (float*)d_out;
  p.ws = (char*)d_ws;
  const size_t off = WSO.total;
  { const int reps[16] = REPS_INIT; for (int i = 0; i < 16; ++i) p.rep[i] = reps[i]; }
  if (off > ws_size) { fprintf(stderr, "workspace too small: need %zu have %zu\n", off, ws_size); return; }
  (void)hipMemsetAsync(p.bar(), 0, (size_t)(XCD_BAR_WORDS + 64) * 4, stream);
  void* args[] = {&p};
  hipError_t e = hipLaunchCooperativeKernel((void*)mk, dim3(grid_blocks), dim3(NTHR), args, LDS_BYTES, stream);
  if (e != hipSuccess) fprintf(stderr, "cooperative launch failed: %s (grid %d)\n", hipGetErrorString(e), grid_blocks);
}
```
